# Optimizing an MI355X kernel written in HIP

```python
import math
import jax, jax.numpy as jnp
from jax import lax
import numpy as np

D_MODEL = 1024
BATCH = 2
SEQ = 8192
DEPTH = 4
DEC_BATCH = 128
DEC_SEQ = 1
PAST_LEN = 8192
PAGE_SIZE = 128

F32 = jnp.float32
A_HEADS = 4
A_QK = 64
A_V = 128
A_WIDTH = A_HEADS * A_V
B_HEADS = 8
B_P = 64
B_WIDTH = B_HEADS * B_P
B_GROUPS = 2
B_STATE = 128
CONV_W = 4
B_CONV_DIM = B_WIDTH + 2 * B_GROUPS * B_STATE
C_HEADS = 8
C_KV = 2
C_HD = 64
C_WIDTH = C_HEADS * C_HD
WINDOW = 128
ROPE_THETA = 10000.0
D_MIX = A_WIDTH + B_WIDTH + C_WIDTH
CHUNK = 64
NORM_EPS = 1e-6
IN_SIZES = (A_HEADS * A_QK, A_HEADS * A_QK, A_WIDTH, A_WIDTH, A_WIDTH, A_HEADS, A_HEADS,
            B_WIDTH, B_CONV_DIM, B_HEADS,
            C_WIDTH, C_KV * C_HD, C_KV * C_HD, C_WIDTH)
D_IN = 2 * A_HEADS * A_QK + 3 * A_WIDTH + 2 * A_HEADS + B_WIDTH + B_CONV_DIM + B_HEADS + 2 * C_WIDTH + 2 * C_KV * C_HD

kernel_name = 'hymba_mlstm_ssd_swa_step'


def _rmsnorm(x, w):
    xf = x.astype(F32)
    y = xf * lax.rsqrt(jnp.mean(xf * xf, axis=-1, keepdims=True) + NORM_EPS)
    return (y * w.astype(F32)).astype(x.dtype)


def _split(x, sizes):
    return jnp.split(x, np.cumsum(sizes)[:-1].tolist(), axis=-1)


def _rope(x, pos):
    half = x.shape[-1] // 2
    inv = ROPE_THETA ** (-jnp.arange(half, dtype=F32) / half)
    ang = pos.astype(F32)[:, None] * inv[None, :]
    cos = jnp.cos(ang)[None, :, None, :]
    sin = jnp.sin(ang)[None, :, None, :]
    xf = x.astype(F32)
    x1, x2 = xf[..., :half], xf[..., half:]
    return jnp.concatenate([x1 * cos - x2 * sin, x2 * cos + x1 * sin], axis=-1).astype(x.dtype)


def _sink_softmax(s, sink):
    sink = sink.astype(F32)
    m = jnp.maximum(jnp.max(s, axis=-1, keepdims=True), sink)
    e = jnp.exp(s - m)
    return e / (jnp.sum(e, axis=-1, keepdims=True) + jnp.exp(sink - m))


def _mlstm(q, k, v, ig, fg, C0, n0, m0):
    N, T, H, DK = q.shape
    DV = v.shape[-1]
    L = math.gcd(T, CHUNK)
    NC = T // L
    q = q.astype(F32).reshape(N, NC, L, H, DK)
    k = (k.astype(F32) * (DK ** -0.5)).reshape(N, NC, L, H, DK)
    v = v.astype(F32).reshape(N, NC, L, H, DV)
    ig = ig.reshape(N, NC, L, H)
    b = jnp.cumsum(jax.nn.log_sigmoid(fg).reshape(N, NC, L, H), axis=2)
    bL = b[:, :, -1]
    g = bL[:, :, None] - b + ig
    m_loc = jnp.max(g, axis=2)
    w = jnp.exp(g - m_loc[:, :, None])
    C_loc = jnp.einsum('nclh,nclhv,nclhk->nchvk', w, v, k)
    n_loc = jnp.einsum('nclh,nclhk->nchk', w, k)

    def step(carry, inp):
        C, n, m = carry
        Cl, nl, ml, bl = inp
        m_new = jnp.maximum(bl + m, ml)
        sp = jnp.exp(bl + m - m_new)
        sl = jnp.exp(ml - m_new)
        C_new = sp[..., None, None] * C + sl[..., None, None] * Cl
        n_new = sp[..., None] * n + sl[..., None] * nl
        return (C_new, n_new, m_new), (C, n, m)

    xs = (jnp.moveaxis(C_loc, 1, 0), jnp.moveaxis(n_loc, 1, 0), jnp.moveaxis(m_loc, 1, 0), jnp.moveaxis(bL, 1, 0))
    (Cf, nf, mf), (Cs, ns, ms) = lax.scan(step, (C0.astype(F32), n0.astype(F32), m0.astype(F32)), xs)
    Cs = jnp.moveaxis(Cs, 0, 1)
    ns = jnp.moveaxis(ns, 0, 1)
    ms = jnp.moveaxis(ms, 0, 1)
    causal = (jnp.arange(L)[:, None] >= jnp.arange(L)[None, :])[:, :, None]
    dmat = jnp.where(causal, b[:, :, :, None] - b[:, :, None] + ig[:, :, None], -jnp.inf)
    inter = b + ms[:, :, None]
    m_t = jnp.maximum(inter, jnp.max(dmat, axis=3))
    s = jnp.exp(dmat - m_t[:, :, :, None]) * jnp.einsum('ncthk,ncshk->nctsh', q, k)
    si = jnp.exp(inter - m_t)
    num = jnp.einsum('nctsh,ncshv->ncthv', s, v) + si[..., None] * jnp.einsum('nchvk,ncthk->ncthv', Cs, q)
    den = jnp.sum(s, axis=3) + si * jnp.einsum('nchk,ncthk->ncth', ns, q)
    h = num / jnp.maximum(jnp.abs(den), jnp.exp(-m_t))[..., None]
    return h.reshape(N, T, H, DV), Cf, nf, mf


def _causal_conv(u, buf, w, b):
    T = u.shape[1]
    full = jnp.concatenate([buf.astype(u.dtype), u], axis=1)
    acc = b
    for j in range(CONV_W):
        acc = acc + full[:, j:j + T] * w[j]
    return jax.nn.silu(acc), full[:, T:]


def _ssd(x, dt, A, Bm, Cm, h0):
    N, T, H, P = x.shape
    G, S = Bm.shape[2], Bm.shape[3]
    E = H // G
    L = math.gcd(T, CHUNK)
    NC = T // L
    x = x.astype(F32).reshape(N, NC, L, G, E, P)
    dt = dt.reshape(N, NC, L, G, E)
    Bm = Bm.astype(F32).reshape(N, NC, L, G, S)
    Cm = Cm.astype(F32).reshape(N, NC, L, G, S)
    a = jnp.cumsum(dt * A.reshape(G, E), axis=2)
    aL = a[:, :, -1]
    h_loc = jnp.einsum('nclge,nclgep,nclgs->ncgeps', jnp.exp(aL[:, :, None] - a) * dt, x, Bm)

    def step(h, inp):
        hl, al = inp
        return jnp.exp(al)[..., None, None] * h + hl, h

    hf, hs = lax.scan(step, h0.astype(F32).reshape(N, G, E, P, S),
                      (jnp.moveaxis(h_loc, 1, 0), jnp.moveaxis(aL, 1, 0)))
    hs = jnp.moveaxis(hs, 0, 1)
    causal = (jnp.arange(L)[:, None] >= jnp.arange(L)[None, :])[:, :, None, None]
    decay = jnp.exp(jnp.where(causal, a[:, :, :, None] - a[:, :, None], -jnp.inf))
    cb = jnp.einsum('nctgs,ncugs->nctug', Cm, Bm)
    wmat = decay * cb[..., None] * dt[:, :, None]
    y = jnp.einsum('nctuge,ncugep->nctgep', wmat, x) + \
        jnp.einsum('nctgs,ncgeps->nctgep', Cm, hs) * jnp.exp(a)[..., None]
    return y.reshape(N, T, H, P), hf.reshape(N, H, P, S)


def _swa_prompt(q, k, v, sinks):
    N, T, HQ, Dh = q.shape
    HK = k.shape[2]
    G = HQ // HK
    Bk = WINDOW
    NB = T // Bk
    q = q.reshape(N, NB, Bk, HK, G, Dh)
    k = k.reshape(N, NB, Bk, HK, Dh)
    v = v.reshape(N, NB, Bk, HK, Dh)
    pad = ((0, 0), (1, 0), (0, 0), (0, 0), (0, 0))
    kk = jnp.concatenate([jnp.pad(k, pad)[:, :-1], k], axis=2)
    vv = jnp.concatenate([jnp.pad(v, pad)[:, :-1], v], axis=2)
    s = jnp.einsum('nbqhgd,nbkhd->nbhgqk', q, kk).astype(F32) * (Dh ** -0.5)
    qpos = jnp.arange(NB)[:, None, None] * Bk + jnp.arange(Bk)[None, :, None]
    kpos = jnp.arange(NB)[:, None, None] * Bk - Bk + jnp.arange(2 * Bk)[None, None, :]
    delta = qpos - kpos
    mask = (delta >= 0) & (delta < WINDOW) & (kpos >= 0)
    s = jnp.where(mask[None, :, None, None], s, -jnp.inf)
    p = _sink_softmax(s, sinks.reshape(HK, G)[:, :, None, None])
    o = jnp.einsum('nbhgqk,nbkhd->nbqhgd', p.astype(vv.dtype), vv)
    return o.reshape(N, T, HQ, Dh)


def _swa_decode(q, k, v, kc, vc, sinks):
    N, T, HQ, Dh = q.shape
    HK = k.shape[2]
    G = HQ // HK
    Wc = kc.shape[1]
    kk = jnp.concatenate([kc.astype(k.dtype), k], axis=1)
    vv = jnp.concatenate([vc.astype(v.dtype), v], axis=1)
    s = jnp.einsum('nqhgd,nkhd->nhgqk', q.reshape(N, T, HK, G, Dh), kk).astype(F32) * (Dh ** -0.5)
    delta = (Wc + jnp.arange(T))[:, None] - jnp.arange(Wc + T)[None, :]
    mask = (delta >= 0) & (delta < WINDOW)
    s = jnp.where(mask, s, -jnp.inf)
    p = _sink_softmax(s, sinks.reshape(HK, G)[:, :, None, None])
    o = jnp.einsum('nhgqk,nkhd->nqhgd', p.astype(vv.dtype), vv).reshape(N, T, HQ, Dh)
    return o, kk[:, -Wc:], vv[:, -Wc:]


def _layer(x, pos, conv_buf, ssm_h, C0, n0, m0, kc, vc,
           norm_w, w_in, a_ib, a_fb, a_nw, conv_w, conv_b, dt_bias, A_log, D_skip, b_nw,
           qn_w, kn_w, sinks, w_out):
    N, T, _ = x.shape
    u = _rmsnorm(x, norm_w) @ w_in
    (aq, ak, av, ao, az, ai, af, bz, bxbc, bdt, cq, ck, cv, cz) = _split(u, IN_SIZES)
    ha, C1, n1, m1 = _mlstm(aq.reshape(N, T, A_HEADS, A_QK), ak.reshape(N, T, A_HEADS, A_QK),
                            av.reshape(N, T, A_HEADS, A_V),
                            ai.astype(F32) + a_ib.astype(F32), af.astype(F32) + a_fb.astype(F32), C0, n0, m0)
    ha = _rmsnorm(ha, a_nw.reshape(A_HEADS, A_V)).reshape(N, T, A_WIDTH)
    ya = (ha * jax.nn.sigmoid(ao.astype(F32)) * jax.nn.silu(az.astype(F32))).astype(x.dtype)
    xbc, conv1 = _causal_conv(bxbc, conv_buf, conv_w, conv_b)
    bx, bB, bC = _split(xbc, (B_WIDTH, B_GROUPS * B_STATE, B_GROUPS * B_STATE))
    dt = jax.nn.softplus(bdt.astype(F32) + dt_bias.astype(F32))
    A = -jnp.exp(A_log.astype(F32))
    bx = bx.reshape(N, T, B_HEADS, B_P)
    yb, h1 = _ssd(bx, dt, A, bB.reshape(N, T, B_GROUPS, B_STATE), bC.reshape(N, T, B_GROUPS, B_STATE), ssm_h)
    yb = yb + D_skip.astype(F32)[:, None] * bx.astype(F32)
    gb = (yb.reshape(N, T, B_WIDTH) * jax.nn.silu(bz.astype(F32))).reshape(N, T, B_GROUPS, B_WIDTH // B_GROUPS)
    yb = _rmsnorm(gb, b_nw.reshape(B_GROUPS, B_WIDTH // B_GROUPS)).reshape(N, T, B_WIDTH).astype(x.dtype)
    q = _rope(_rmsnorm(cq.reshape(N, T, C_HEADS, C_HD), qn_w), pos)
    k = _rope(_rmsnorm(ck.reshape(N, T, C_KV, C_HD), kn_w), pos)
    v = cv.reshape(N, T, C_KV, C_HD)
    if kc is None:
        o = _swa_prompt(q, k, v, sinks)
        k1, v1 = k[:, -WINDOW:], v[:, -WINDOW:]
    else:
        o, k1, v1 = _swa_decode(q, k, v, kc, vc, sinks)
    yc = (o.reshape(N, T, C_WIDTH).astype(F32) * jax.nn.silu(cz.astype(F32))).astype(x.dtype)
    y = jnp.concatenate([ya, yb, yc], axis=-1) @ w_out
    return x + y.astype(x.dtype), (C1, n1, m1, h1, conv1, k1, v1)


def setup_inputs(seed: int = 0) -> dict:
    key = jax.random.key(seed)
    ks = jax.random.split(key, 26)

    def nrm(k, shape, scale):
        return scale * jax.random.normal(k, shape, F32)

    win = min(WINDOW, PAST_LEN)
    dt0 = jnp.exp(jax.random.uniform(ks[16], (DEPTH, B_HEADS), F32, math.log(1e-3), math.log(1e-1)))
    return {
        'x_prompt': nrm(ks[0], (BATCH, SEQ, D_MODEL), 1.0),
        'x_sample': nrm(ks[1], (DEC_BATCH, DEC_SEQ, D_MODEL), 1.0),
        'state_mlstm_C': nrm(ks[2], (DEPTH, DEC_BATCH, A_HEADS, A_V, A_QK), 0.3),
        'state_mlstm_n': nrm(ks[3], (DEPTH, DEC_BATCH, A_HEADS, A_QK), 0.3),
        'state_mlstm_m': nrm(ks[4], (DEPTH, DEC_BATCH, A_HEADS), 1.0),
        'state_ssm': nrm(ks[5], (DEPTH, DEC_BATCH, B_HEADS, B_P, B_STATE), 0.3),
        'state_conv': nrm(ks[6], (DEPTH, DEC_BATCH, CONV_W - 1, B_CONV_DIM), 1.0),
        'cache_k': nrm(ks[7], (DEPTH, DEC_BATCH, win, C_KV, C_HD), 1.0),
        'cache_v': nrm(ks[8], (DEPTH, DEC_BATCH, win, C_KV, C_HD), 1.0),
        'norm_w': 1.0 + nrm(ks[9], (DEPTH, D_MODEL), 0.02),
        'w_in': nrm(ks[10], (DEPTH, D_MODEL, D_IN), D_MODEL ** -0.5),
        'a_igate_b': nrm(ks[11], (DEPTH, A_HEADS), 0.1) - 1.0,
        'a_fgate_b': jnp.linspace(3.0, 6.0, A_HEADS, dtype=F32)[None, :] + nrm(ks[12], (DEPTH, A_HEADS), 0.1),
        'a_norm_w': 1.0 + nrm(ks[13], (DEPTH, A_WIDTH), 0.02),
        'b_conv_w': nrm(ks[14], (DEPTH, CONV_W, B_CONV_DIM), CONV_W ** -0.5),
        'b_conv_b': nrm(ks[15], (DEPTH, B_CONV_DIM), 0.02),
        'b_dt_bias': dt0 + jnp.log(-jnp.expm1(-dt0)),
        'b_A_log': jnp.log(jax.random.uniform(ks[17], (DEPTH, B_HEADS), F32, 1.0, 16.0)),
        'b_D': 1.0 + nrm(ks[18], (DEPTH, B_HEADS), 0.1),
        'b_norm_w': 1.0 + nrm(ks[19], (DEPTH, B_WIDTH), 0.02),
        'c_qnorm_w': 1.0 + nrm(ks[20], (DEPTH, C_HD), 0.02),
        'c_knorm_w': 1.0 + nrm(ks[21], (DEPTH, C_HD), 0.02),
        'c_sinks': nrm(ks[22], (DEPTH, C_HEADS), 0.5),
        'w_out': nrm(ks[23], (DEPTH, D_MIX, D_MODEL), 0.5 * D_MIX ** -0.5),
    }


def reference(x_prompt, x_sample, state_mlstm_C, state_mlstm_n, state_mlstm_m, state_ssm, state_conv,
              cache_k, cache_v, norm_w, w_in, a_igate_b, a_fgate_b, a_norm_w, b_conv_w, b_conv_b,
              b_dt_bias, b_A_log, b_D, b_norm_w, c_qnorm_w, c_knorm_w, c_sinks, w_out):
    Bp, Tp, _ = x_prompt.shape
    Ts = x_sample.shape[1]
    pos_p = jnp.arange(Tp, dtype=jnp.int32)
    pos_s = PAST_LEN + jnp.arange(Ts, dtype=jnp.int32)
    zC = jnp.zeros((Bp, A_HEADS, A_V, A_QK), F32)
    zn = jnp.zeros((Bp, A_HEADS, A_QK), F32)
    zm = jnp.zeros((Bp, A_HEADS), F32)
    zh = jnp.zeros((Bp, B_HEADS, B_P, B_STATE), F32)
    zconv = jnp.zeros((Bp, CONV_W - 1, B_CONV_DIM), x_prompt.dtype)
    hp, hs = x_prompt, x_sample
    st_prompt, st_sample = [], []
    for l in range(DEPTH):
        lw = (norm_w[l], w_in[l], a_igate_b[l], a_fgate_b[l], a_norm_w[l], b_conv_w[l], b_conv_b[l],
              b_dt_bias[l], b_A_log[l], b_D[l], b_norm_w[l], c_qnorm_w[l], c_knorm_w[l], c_sinks[l], w_out[l])
        hp, sp = _layer(hp, pos_p, zconv, zh, zC, zn, zm, None, None, *lw)
        hs, ss = _layer(hs, pos_s, state_conv[l], state_ssm[l], state_mlstm_C[l], state_mlstm_n[l],
                        state_mlstm_m[l], cache_k[l], cache_v[l], *lw)
        st_prompt.append(sp)
        st_sample.append(ss)
    p_C, p_n, p_m, p_h, p_conv, p_k, p_v = [jnp.stack(t) for t in zip(*st_prompt)]
    s_C, s_n, s_m, s_h, s_conv, s_k, s_v = [jnp.stack(t) for t in zip(*st_sample)]
    return (hp, hs, p_C, p_n, p_m, p_h, p_conv, p_k, p_v, s_C, s_n, s_m, s_h, s_conv, s_k, s_v)
```

```cpp
#include <hip/hip_runtime.h>
#include <hip/hip_cooperative_groups.h>
#include <cstdio>
#include <cstdint>
namespace cg = cooperative_groups;

#ifndef MULTI_LAUNCH
#define MULTI_LAUNCH 0
#endif

#define LAS __attribute__((address_space(3)))
typedef unsigned short bf16_t;
typedef short bf16x8 __attribute__((ext_vector_type(8)));
typedef float f32x4 __attribute__((ext_vector_type(4)));
typedef float f32x2 __attribute__((ext_vector_type(2)));
typedef unsigned u32x4 __attribute__((ext_vector_type(4)));
typedef unsigned u32x2 __attribute__((ext_vector_type(2)));
typedef __bf16 bf16x2_t __attribute__((ext_vector_type(2)));
typedef LAS unsigned char* lptr;

constexpr int D = 1024, DIN = 4880, NIN = 5120, DMIX = 1536, TP = 16384, MTOK = 16512, MPAD = 16640, SEQ = 8192;
constexpr int C_AQ = 0, C_AK = 256, C_AV = 512, C_AO = 1024, C_AZ = 1536, C_AI = 2048, C_AF = 2052, C_BZ = 2056, C_BX = 2568, C_BB = 3080, C_BC = 3336,
              C_BDT = 3592, C_CQ = 3600, C_CK = 4112, C_CV = 4240, C_CZ = 4368;
constexpr float EPS = 1e-6f;
constexpr size_t O_YP = 0, O_YS = 16777216, O_PC = 16908288, O_PN = 17170432, O_PM = 17172480, O_PH = 17172512, O_PCONV = 17696800, O_PK = 17721376,
                 O_PV = 17852448, O_SC = 17983520, O_SN = 34760736, O_SM = 34891808, O_SH = 34893856, O_SCONV = 68448288, O_SK = 70021152, O_SV = 78409760;
constexpr size_t WS_PAR = 4096;
constexpr size_t WS_WIN = WS_PAR + 102400;
constexpr size_t WS_WOUT = WS_WIN + (size_t)4 * NIN * D * 2;
constexpr size_t WS_XB = WS_WOUT + (size_t)4 * D * DMIX * 2;
constexpr size_t WS_U = WS_XB + (size_t)MPAD * D * 2;
constexpr size_t WS_MIX = WS_U + (size_t)MPAD * NIN * 2;
constexpr size_t WS_SSQ = WS_MIX + (size_t)MPAD * DMIX * 2;
constexpr size_t WS_ROPE = WS_SSQ + (size_t)MPAD * 16 * 4;
constexpr size_t WS_MC = WS_ROPE + (size_t)8200 * 64 * 4;
constexpr size_t WS_MN = WS_MC + (size_t)8 * 128 * 8192 * 4;
constexpr size_t WS_ML = WS_MN + (size_t)8 * 128 * 64 * 4;
constexpr size_t WS_BL = WS_ML + 4096;
constexpr size_t WS_MS = WS_BL + 4096;
constexpr size_t WS_SA = WS_MS + 4096;
constexpr size_t WS_SH = WS_SA + 8192;
constexpr size_t WS_END = WS_SH + (size_t)16 * 128 * 8192 * 4;
constexpr int LDS_BYTES = 139264;
constexpr int NT = 512;

struct Args { const float* in[24]; float* out; unsigned char* ws; int ph_lo, ph_hi; };

__device__ __forceinline__ float bf2f(unsigned v) { return __uint_as_float(v << 16); }
__device__ __forceinline__ unsigned pk2(float lo, float hi) { f32x2 v = {lo, hi}; bf16x2_t b = __builtin_convertvector(v, bf16x2_t); return __builtin_bit_cast(unsigned, b); }
__device__ __forceinline__ unsigned f2bf(float f) { return pk2(f, 0.f) & 0xffffu; }
__device__ __forceinline__ void unpack8(u32x4 w, float (&f)[8]) {
#pragma unroll
    for (int i = 0; i < 4; ++i) { f[2 * i] = __uint_as_float(w[i] << 16); f[2 * i + 1] = __uint_as_float(w[i] & 0xffff0000u); }
}
__device__ __forceinline__ u32x4 pack8(const float (&f)[8]) { u32x4 w; w[0] = pk2(f[0], f[1]); w[1] = pk2(f[2], f[3]); w[2] = pk2(f[4], f[5]); w[3] = pk2(f[6], f[7]); return w; }
__device__ __forceinline__ u32x4 pack8v(f32x4 a, f32x4 b) { u32x4 w; w[0] = pk2(a[0], a[1]); w[1] = pk2(a[2], a[3]); w[2] = pk2(b[0], b[1]); w[3] = pk2(b[2], b[3]); return w; }
__device__ __forceinline__ bf16x8 as_frag(u32x4 w) { return __builtin_bit_cast(bf16x8, w); }
__device__ __forceinline__ bf16x8 ldg_f32_frag(const float* p) { f32x4 a = *(const f32x4*)p, b = *(const f32x4*)(p + 4); return as_frag(pack8v(a, b)); }
__device__ __forceinline__ bf16x8 lds_frag(lptr base, int row, int k, int stride) { return *(const LAS bf16x8*)(base + ((row * stride + k) << 1)); }
__device__ __forceinline__ f32x4 mfma16(bf16x8 a, bf16x8 b, f32x4 c) { return __builtin_amdgcn_mfma_f32_16x16x32_bf16(a, b, c, 0, 0, 0); }
__device__ __forceinline__ float sigmoidf_(float x) { return 1.f / (1.f + __expf(-x)); }
__device__ __forceinline__ float siluf_(float x) { return x / (1.f + __expf(-x)); }
__device__ __forceinline__ float softplusf_(float x) { return x > 20.f ? x : log1pf(__expf(x)); }
__device__ __forceinline__ float logsigf_(float x) { return fminf(x, 0.f) - log1pf(__expf(-fabsf(x))); }
__device__ __forceinline__ float wave_scan_sum(float v, int lane) {
#pragma unroll
    for (int o = 1; o < 64; o <<= 1) { float t = __shfl_up(v, o); if (lane >= o) v += t; }
    return v;
}
__device__ __forceinline__ float wave_scan_max(float v, int lane) {
#pragma unroll
    for (int o = 1; o < 64; o <<= 1) { float t = __shfl_up(v, o); if (lane >= o) v = fmaxf(v, t); }
    return v;
}
__device__ __forceinline__ float wave_sum(float v) {
#pragma unroll
    for (int o = 1; o < 64; o <<= 1) v += __shfl_xor(v, o);
    return v;
}
__device__ __forceinline__ float wave_max(float v) {
#pragma unroll
    for (int o = 1; o < 64; o <<= 1) v = fmaxf(v, __shfl_xor(v, o));
    return v;
}
__device__ __forceinline__ float red16(float v) { v += __shfl_xor(v, 1); v += __shfl_xor(v, 2); v += __shfl_xor(v, 4); v += __shfl_xor(v, 8); return v; }
__device__ __forceinline__ float red16max(float v) { v = fmaxf(v, __shfl_xor(v, 1)); v = fmaxf(v, __shfl_xor(v, 2)); v = fmaxf(v, __shfl_xor(v, 4)); v = fmaxf(v, __shfl_xor(v, 8)); return v; }
__device__ __forceinline__ int OPQ(int v) { asm volatile("" : "+v"(v)); return v; }
#define LDS_FENCE() asm volatile("s_waitcnt lgkmcnt(0)" ::: "memory")

namespace pg8 {
constexpr int BM = 256, BK = 64, HALF = 128, HTB = HALF * BK * 2, STAGE_BYTES = 8 * HTB, NXCD = 8, WGM = 8;
__host__ __device__ __forceinline__ int lds_byte(int r, int c) { const int st = (r >> 4) * 2 + (c >> 5), rr = r & 15, cc = c & 31, ob = rr * 64 + cc * 2; return st * 1024 + (ob ^ (((ob >> 9) & 1) << 5)); }
__host__ __device__ __forceinline__ void stage_rc(int b, int& R, int& C) { const int st = b / 1024, sb = b % 1024, swz = sb ^ (((sb >> 9) & 1) << 5); R = (st >> 1) * 16 + swz / 64; C = (st & 1) * 32 + (swz % 64) / 2; }
__host__ __device__ __forceinline__ int perm32(int rho) { const int n = rho >> 4, i = rho & 15; return 8 * (i >> 2) + 4 * n + (i & 3); }
struct Unit { int pm, pn; };
struct Gemm { const bf16_t* A; const bf16_t* Bt; int M, N, K; };
struct StaticOrder {
    int nM, nN, nwg, G, c;
    __device__ void init(int M, int N, int G_, int c_) { nM = M / BM; nN = N / BM; nwg = nM * nN; G = G_; c = c_; }
    __device__ bool next(int i, Unit& u) const {
        const long L = (long)i * G + c; if (L >= nwg) return false;
        int wgid = (int)L; { const int q = nwg / NXCD, r = nwg % NXCD, xcd = wgid % NXCD, off = wgid / NXCD; wgid = (xcd < r ? xcd * (q + 1) : r * (q + 1) + (xcd - r) * q) + off; }
        const int nig = WGM * nN, gid = wgid / nig, fm = gid * WGM, gsz = (nM - fm) < WGM ? (nM - fm) : WGM;
        u.pm = fm + ((wgid % nig) % gsz); u.pn = (wgid % nig) / gsz; return true;
    }
};
struct EpiU {
    bf16_t* U; const float* ssq;
    __device__ __forceinline__ void operator()(const f32x4 (&acc)[2][2][4][2], const Unit& u, int wr, int wc, int fr, int fq) const {
        const int row0 = u.pm * BM + wr * 64 + fr, col0 = u.pn * BM + wc * 32 + 8 * fq;
#pragma unroll
        for (int ai = 0; ai < 2; ++ai)
#pragma unroll
            for (int m = 0; m < 4; ++m) {
                const int r = row0 + ai * HALF + m * 16;
                const f32x4 s = *(const f32x4*)(ssq + (size_t)r * 16 + fq * 4);
                float st = s[0] + s[1] + s[2] + s[3]; st += __shfl_xor(st, 16); st += __shfl_xor(st, 32);
                const float rs = rsqrtf(st * (1.f / 1024.f) + EPS);
                bf16_t* rowp = U + (size_t)r * NIN + col0;
#pragma unroll
                for (int bj = 0; bj < 2; ++bj) *(u32x4*)(rowp + bj * HALF) = pack8v(acc[ai][bj][m][0] * rs, acc[ai][bj][m][1] * rs);
                __builtin_amdgcn_sched_barrier(0);
            }
    }
};
struct EpiRes {
    const float* xp; const float* xs; float* out; bf16_t* xb; float* ssq;
    __device__ __forceinline__ void operator()(const f32x4 (&acc)[2][2][4][2], const Unit& u, int wr, int wc, int fr, int fq) const {
        const int row0 = u.pm * BM + wr * 64 + fr, col0 = u.pn * BM + wc * 32 + 8 * fq;
#pragma unroll
        for (int ai = 0; ai < 2; ++ai)
#pragma unroll
            for (int m = 0; m < 4; ++m) {
                const int r = row0 + ai * HALF + m * 16;
                const bool valid = r < MTOK;
                const float* src = xp ? (r < TP ? xp + (size_t)r * D : xs + (size_t)(r - TP) * D) : out + (size_t)r * D;
                float part = 0.f;
#pragma unroll
                for (int bj = 0; bj < 2; ++bj) {
                    const int c = col0 + bj * HALF;
                    f32x4 o0 = {0.f, 0.f, 0.f, 0.f}, o1 = {0.f, 0.f, 0.f, 0.f};
                    if (valid) { o0 = *(const f32x4*)(src + c); o1 = *(const f32x4*)(src + c + 4); }
                    const f32x4 v0 = acc[ai][bj][m][0] + o0, v1 = acc[ai][bj][m][1] + o1;
                    if (valid) { *(f32x4*)(out + (size_t)r * D + c) = v0; *(f32x4*)(out + (size_t)r * D + c + 4) = v1; }
                    *(u32x4*)(xb + (size_t)r * D + c) = pack8v(v0, v1);
                    part += v0[0] * v0[0] + v0[1] * v0[1] + v0[2] * v0[2] + v0[3] * v0[3] + v1[0] * v1[0] + v1[1] * v1[1] + v1[2] * v1[2] + v1[3] * v1[3];
                }
                part += __shfl_xor(part, 16); part += __shfl_xor(part, 32);
                if (fq == 0) ssq[(size_t)r * 16 + u.pn * 4 + wc] = part;
                __builtin_amdgcn_sched_barrier(0);
            }
    }
};

template <class Epi>
__device__ __forceinline__ void gemm_phase(lptr lds, const Gemm g, const StaticOrder& S, const Epi& E, const int tid) {
    const int wid = __builtin_amdgcn_readfirstlane(tid >> 6), lane = tid & 63, wr = wid >> 2, wc = wid & 3, fr = lane & 15, fq = lane >> 4;
    const int K = g.K, nt = K / BK;
    unsigned voffA[2], voffB[2];
#pragma unroll
    for (int i = 0; i < 2; ++i) { int R, C; stage_rc(tid * 16 + i * 8192, R, C); const int Rb = (R & ~31) + perm32(R & 31);
        voffA[i] = (unsigned)(R * K + C) * 2u; voffB[i] = (unsigned)(Rb * K + C) * 2u; }
    const size_t kstep = (size_t)(BK * 2);
    const size_t hstep = (size_t)HALF * K * 2;
    const size_t tstep = 2 * hstep;
    const unsigned ldsw = (unsigned)wid * 1024u;
    const int aoff = lds_byte(wr * 64 + fr, fq * 8), boff = lds_byte(wc * 32 + fr, fq * 8);
#define PG8_SA(b, h) (((b) * 2 + (h)) * HTB)
#define PG8_SB(b, h) ((4 + (b) * 2 + (h)) * HTB)
#define PG8_STAGE(bufoff, gbase, voff) do { _Pragma("unroll") for (int _i = 0; _i < 2; ++_i) \
        __builtin_amdgcn_global_load_lds((const unsigned*)((const char*)(gbase) + (voff)[_i]), (LAS unsigned*)(lds + (bufoff) + ldsw + _i * 8192), 16, 0, 0); } while (0)
#define PG8_LDA(dst, b, h) do { _Pragma("unroll") for (int m = 0; m < 4; ++m) _Pragma("unroll") for (int k = 0; k < 2; ++k) dst[m][k] = *(const LAS bf16x8*)(lds + PG8_SA(b, h) + aoff + m * 2048 + k * 1024); } while (0)
#define PG8_LDB(dst, b, h) do { _Pragma("unroll") for (int n = 0; n < 2; ++n) _Pragma("unroll") for (int k = 0; k < 2; ++k) dst[n][k] = *(const LAS bf16x8*)(lds + PG8_SB(b, h) + boff + n * 2048 + k * 1024); } while (0)
#define PG8_MMA(ai, bj, At, Bt) do { __builtin_amdgcn_s_setprio(1); _Pragma("unroll") for (int m = 0; m < 4; ++m) _Pragma("unroll") for (int n = 0; n < 2; ++n) _Pragma("unroll") for (int k = 0; k < 2; ++k) \
        acc[ai][bj][m][n] = __builtin_amdgcn_mfma_f32_16x16x32_bf16(Bt[n][k], At[m][k], acc[ai][bj][m][n], 0, 0, 0); __builtin_amdgcn_s_setprio(0); } while (0)
#define PG8_WAIT_V(n) asm volatile("s_waitcnt vmcnt(" #n ")" ::: "memory")
#define PG8_WAIT_L(n) asm volatile("s_waitcnt lgkmcnt(" #n ")" ::: "memory")
#define PG8_BAR __builtin_amdgcn_s_barrier()
#define PG8_SCHED __builtin_amdgcn_sched_barrier(0)
    Unit cur, nxt; int ui = 0;
    if (!S.next(0, cur)) return;
    f32x4 acc[2][2][4][2];
#pragma unroll
    for (int a = 0; a < 2; ++a)
#pragma unroll
        for (int b = 0; b < 2; ++b)
#pragma unroll
            for (int m = 0; m < 4; ++m)
#pragma unroll
                for (int n = 0; n < 2; ++n) acc[a][b][m][n] = (f32x4){0.f, 0.f, 0.f, 0.f};
    bf16x8 At[4][2], B0[2][2], B1[2][2];
    const char* cA = (const char*)g.A + (size_t)cur.pm * tstep; const char* cB = (const char*)g.Bt + (size_t)cur.pn * tstep;
    PG8_STAGE(PG8_SB(0, 0), cB, voffB); PG8_STAGE(PG8_SA(0, 0), cA, voffA); PG8_STAGE(PG8_SB(0, 1), cB + hstep, voffB); PG8_STAGE(PG8_SA(0, 1), cA + hstep, voffA);
    if (wr == 1) PG8_BAR;
    PG8_WAIT_V(4); PG8_BAR;
    PG8_STAGE(PG8_SB(1, 0), cB + kstep, voffB); PG8_STAGE(PG8_SA(1, 0), cA + kstep, voffA); PG8_STAGE(PG8_SB(1, 1), cB + hstep + kstep, voffB);
    PG8_WAIT_V(6); PG8_BAR;
    for (;;) {
        const bool has_next = S.next(ui + 1, nxt);
        const char* nA = has_next ? (const char*)g.A + (size_t)nxt.pm * tstep : cA; const char* nB = has_next ? (const char*)g.Bt + (size_t)nxt.pn * tstep : cB;
        for (int t = 0; t < nt; t += 2) {
            const bool last = (t == nt - 2);
            const char* a1 = cA + (size_t)(t + 1) * kstep;
            const char* a2 = last ? nA : cA + (size_t)(t + 2) * kstep; const char* b2 = last ? nB : cB + (size_t)(t + 2) * kstep;
            const char* a3 = a2 + kstep; const char* b3 = b2 + kstep;
            PG8_LDB(B0, 0, 0); PG8_SCHED; PG8_LDA(At, 0, 0); PG8_STAGE(PG8_SA(1, 1), a1 + hstep, voffA);
            PG8_WAIT_L(8); PG8_BAR; PG8_WAIT_L(0); PG8_MMA(0, 0, At, B0); PG8_BAR; PG8_SCHED;
            PG8_LDB(B1, 0, 1); PG8_STAGE(PG8_SB(0, 0), b2, voffB);
            PG8_BAR; PG8_WAIT_L(0); PG8_MMA(0, 1, At, B1); PG8_BAR;
            PG8_LDA(At, 0, 1); PG8_STAGE(PG8_SA(0, 0), a2, voffA);
            PG8_BAR; PG8_WAIT_L(0); PG8_MMA(1, 0, At, B0); PG8_BAR; PG8_SCHED;
            PG8_STAGE(PG8_SB(0, 1), b2 + hstep, voffB);
            PG8_WAIT_V(6); PG8_BAR; PG8_MMA(1, 1, At, B1); PG8_BAR;
            PG8_LDB(B0, 1, 0); PG8_SCHED; PG8_LDA(At, 1, 0); PG8_STAGE(PG8_SA(0, 1), a2 + hstep, voffA);
            PG8_WAIT_L(8); PG8_BAR; PG8_WAIT_L(0); PG8_MMA(0, 0, At, B0); PG8_BAR; PG8_SCHED;
            PG8_LDB(B1, 1, 1); PG8_STAGE(PG8_SB(1, 0), b3, voffB);
            PG8_BAR; PG8_WAIT_L(0); PG8_MMA(0, 1, At, B1); PG8_BAR;
            PG8_LDA(At, 1, 1); PG8_STAGE(PG8_SA(1, 0), a3, voffA);
            PG8_BAR; PG8_WAIT_L(0); PG8_MMA(1, 0, At, B0); PG8_BAR; PG8_SCHED;
            PG8_STAGE(PG8_SB(1, 1), b3 + hstep, voffB);
            PG8_WAIT_V(6); PG8_BAR; PG8_MMA(1, 1, At, B1); PG8_BAR;
        }
        E(acc, cur, wr, wc, fr, fq);
        if (!has_next) break;
#pragma unroll
        for (int a = 0; a < 2; ++a)
#pragma unroll
            for (int b = 0; b < 2; ++b)
#pragma unroll
                for (int m = 0; m < 4; ++m)
#pragma unroll
                    for (int n = 0; n < 2; ++n) acc[a][b][m][n] = (f32x4){0.f, 0.f, 0.f, 0.f};
        cur = nxt; cA = nA; cB = nB; ++ui;
    }
    PG8_WAIT_V(0);
    if (wr == 0) PG8_BAR;
    PG8_BAR;
#undef PG8_SA
#undef PG8_SB
#undef PG8_STAGE
#undef PG8_LDA
#undef PG8_LDB
#undef PG8_MMA
#undef PG8_WAIT_V
#undef PG8_WAIT_L
#undef PG8_BAR
#undef PG8_SCHED
}
}

struct Ctx {
    const float* xp; const float* xs; const float* stC; const float* stN; const float* stM; const float* ssm; const float* conv; const float* ck; const float* cv;
    float* out; unsigned char* ws;
};
#define XWIN ((bf16_t*)(X.ws + WS_WIN))
#define XWOUT ((bf16_t*)(X.ws + WS_WOUT))
#define XXB ((bf16_t*)(X.ws + WS_XB))
#define XU ((bf16_t*)(X.ws + WS_U))
#define XMIX ((bf16_t*)(X.ws + WS_MIX))
#define XSSQ ((float*)(X.ws + WS_SSQ))
#define XROPE ((float*)(X.ws + WS_ROPE))
#define XMC ((float*)(X.ws + WS_MC))
#define XMN ((float*)(X.ws + WS_MN))
#define XML ((float*)(X.ws + WS_ML))
#define XBL ((float*)(X.ws + WS_BL))
#define XMS ((float*)(X.ws + WS_MS))
#define XSA ((float*)(X.ws + WS_SA))
#define XSH ((float*)(X.ws + WS_SH))
#define XPAR(off) ((const float*)(X.ws + WS_PAR) + (off))
constexpr int P_AIB = 0, P_AFB = 16, P_DTB = 32, P_ALOG = 64, P_BD = 96, P_SINK = 128, P_QNW = 160, P_KNW = 416, P_ANW = 672, P_BNW = 2720, P_CB = 4768, P_CW = 8864, P_END = 25248;
#define IN_XP 0
#define IN_XS 1
#define IN_STC 2
#define IN_STN 3
#define IN_STM 4
#define IN_SSM 5
#define IN_CONV 6
#define IN_CK 7
#define IN_CV 8
#define IN_NORMW 9
#define IN_WIN 10
#define IN_AIB 11
#define IN_AFB 12
#define IN_ANW 13
#define IN_CW 14
#define IN_CB 15
#define IN_DTB 16
#define IN_ALOG 17
#define IN_BD 18
#define IN_BNW 19
#define IN_QNW 20
#define IN_KNW 21
#define IN_SINK 22
#define IN_WOUT 23

__device__ __forceinline__ void transpose_tile(lptr lds, const float* src, int ldn, int nvalid, bf16_t* dst, int ldk, const float* scale, int k0, int n0, int tid) {
    LAS float* T = (LAS float*)lds;
#pragma unroll
    for (int it = 0; it < 2; ++it) {
        const int r = (tid >> 4) + it * 32, c4 = (tid & 15) * 4, n = n0 + c4;
        f32x4 v = {0.f, 0.f, 0.f, 0.f};
        if (n < nvalid) v = *(const f32x4*)(src + (size_t)(k0 + r) * ldn + n);
        const float sc = scale ? scale[k0 + r] : 1.f;
        T[r * 65 + c4 + 0] = v[0] * sc; T[r * 65 + c4 + 1] = v[1] * sc; T[r * 65 + c4 + 2] = v[2] * sc; T[r * 65 + c4 + 3] = v[3] * sc;
    }
    __syncthreads();
    {
        const int n = tid >> 3, k8 = (tid & 7) * 8; float f[8];
#pragma unroll
        for (int j = 0; j < 8; ++j) f[j] = T[(k8 + j) * 65 + n];
        *(u32x4*)(dst + (size_t)(n0 + n) * ldk + k0 + k8) = pack8(f);
    }
    __syncthreads();
}

__device__ __forceinline__ void prologue(lptr lds, const Ctx& X, const Args& args, int G, int bid, int tid) {
    const int lane = tid & 63, wave = tid >> 6;
    constexpr int T0 = 5120, T1 = T0 + 1536, T2 = T1 + 2080, T3 = T2 + 1, T4 = T3 + 513;
    for (int task = bid; task < T4; task += G) {
        if (task < T0) {
            const int l = task / 1280, r = task % 1280, kt = r / 80, ntl = r % 80;
            transpose_tile(lds, args.in[IN_WIN] + (size_t)l * D * DIN, DIN, DIN, XWIN + (size_t)l * NIN * D, D, args.in[IN_NORMW] + l * D, kt * 64, ntl * 64, tid);
        } else if (task < T1) {
            const int t = task - T0, l = t / 384, r = t % 384, kt = r / 16, ntl = r % 16;
            transpose_tile(lds, args.in[IN_WOUT] + (size_t)l * DMIX * D, D, D, XWOUT + (size_t)l * D * DMIX, DMIX, nullptr, kt * 64, ntl * 64, tid);
        } else if (task < T2) {
            const int r = (task - T1) * 8 + wave;
            float ss = 0.f;
            if (r < MTOK) {
                const float* src = r < TP ? X.xp + (size_t)r * D : X.xs + (size_t)(r - TP) * D;
#pragma unroll
                for (int i = 0; i < 4; ++i) {
                    const int c = lane * 4 + i * 256; f32x4 v = *(const f32x4*)(src + c);
                    ss += v[0] * v[0] + v[1] * v[1] + v[2] * v[2] + v[3] * v[3];
                    u32x2 w; w[0] = pk2(v[0], v[1]); w[1] = pk2(v[2], v[3]);
                    *(u32x2*)(XXB + (size_t)r * D + c) = w;
                }
            } else {
#pragma unroll
                for (int i = 0; i < 4; ++i) { u32x2 w = {0u, 0u}; *(u32x2*)(XXB + (size_t)r * D + lane * 4 + i * 256) = w; }
            }
            ss = wave_sum(ss);
            if (lane < 16) XSSQ[(size_t)r * 16 + lane] = (lane == 0) ? ss : 0.f;
        } else if (task < T3) {
            for (int i = tid; i < (MPAD - MTOK) * DMIX / 2; i += NT) ((unsigned*)(XMIX + (size_t)MTOK * DMIX))[i] = 0u;
            float* P = (float*)(X.ws + WS_PAR);
            const int po[12] = {P_AIB, P_AFB, P_DTB, P_ALOG, P_BD, P_SINK, P_QNW, P_KNW, P_ANW, P_BNW, P_CB, P_CW};
            const int pn[12] = {16, 16, 32, 32, 32, 32, 256, 256, 2048, 2048, 4096, 16384};
            const int pi[12] = {IN_AIB, IN_AFB, IN_DTB, IN_ALOG, IN_BD, IN_SINK, IN_QNW, IN_KNW, IN_ANW, IN_BNW, IN_CB, IN_CW};
#pragma unroll
            for (int a = 0; a < 12; ++a) { const float* src = args.in[pi[a]]; for (int i = tid; i < pn[a]; i += NT) P[po[a] + i] = src[i]; }
        } else {
            const int e = (task - T3) * 512 + tid;
            if (e < 8193 * 32) {
                const int pos = e >> 5, d = e & 31;
                const float inv = (float)exp2(-(double)d * (13.287712379549449 / 32.0));
                const float angf = (float)pos * inv;
                const double a = (double)angf;
                const double k = rint(a * 0.15915494309189535);
                const float rr = (float)(a - k * 6.283185307179586);
                XROPE[(size_t)e * 2] = cosf(rr); XROPE[(size_t)e * 2 + 1] = sinf(rr);
            }
        }
    }
}

__device__ __forceinline__ void conv8(const bf16_t* u, int seq0, int tt, int ch, const float* cw, const float* cb, float (&o)[8]) {
    float acc[8];
    { f32x4 b0 = *(const f32x4*)(cb + ch), b1 = *(const f32x4*)(cb + ch + 4);
#pragma unroll
      for (int j = 0; j < 4; ++j) { acc[j] = b0[j]; acc[4 + j] = b1[j]; } }
#pragma unroll
    for (int jj = 0; jj < 4; ++jj) {
        const int t2 = tt + jj - 3;
        if (t2 >= 0) {
            float x[8]; unpack8(*(const u32x4*)(u + (size_t)(seq0 + t2) * NIN + C_BX + ch), x);
            f32x4 w0 = *(const f32x4*)(cw + jj * 1024 + ch), w1 = *(const f32x4*)(cw + jj * 1024 + ch + 4);
#pragma unroll
            for (int j = 0; j < 4; ++j) { acc[j] += x[j] * w0[j]; acc[4 + j] += x[4 + j] * w1[j]; }
        }
    }
#pragma unroll
    for (int j = 0; j < 8; ++j) o[j] = siluf_(acc[j]);
}

__device__ __forceinline__ void mlstm_local(lptr lds, const Ctx& X, int l, int task, int tid) {
    const int h = task & 3, c = (task >> 2) & 127, n = task >> 9;
    const int lane = tid & 63, wave = tid >> 6, fr = lane & 15, fq = lane >> 4;
    const int row0 = n * SEQ + c * 64, nh = n * 4 + h;
    lptr VwT = lds;
    lptr KT = lds + 18432;
    LAS float* wv = (LAS float*)(lds + 27648);
    if (wave == 0) {
        const bf16_t* ur = XU + (size_t)(row0 + lane) * NIN;
        const float fg = bf2f(ur[C_AF + h]) + XPAR(P_AFB)[l * 4 + h], ig = bf2f(ur[C_AI + h]) + XPAR(P_AIB)[l * 4 + h];
        const float b = wave_scan_sum(logsigf_(fg), lane);
        const float bl = __shfl(b, 63);
        const float g = bl - b + ig;
        const float ml = wave_max(g);
        wv[lane] = __expf(g - ml);
        if (lane == 0) { XML[nh * 128 + c] = ml; XBL[nh * 128 + c] = bl; }
    }
    __syncthreads();
#pragma unroll
    for (int it = 0; it < 2; ++it) {
        const int p = tid + it * NT, tok = p >> 4, v8 = (p & 15) * 8;
        float x[8]; unpack8(*(const u32x4*)(XU + (size_t)(row0 + tok) * NIN + C_AV + h * 128 + v8), x);
        const float w = wv[tok];
#pragma unroll
        for (int j = 0; j < 8; ++j) *(LAS bf16_t*)(VwT + (((v8 + j) * 72 + tok) << 1)) = (bf16_t)f2bf(x[j] * w);
    }
    {
        const int tok = tid >> 3, k8 = (tid & 7) * 8;
        float x[8]; unpack8(*(const u32x4*)(XU + (size_t)(row0 + tok) * NIN + C_AK + h * 64 + k8), x);
#pragma unroll
        for (int j = 0; j < 8; ++j) *(LAS bf16_t*)(KT + (((k8 + j) * 72 + tok) << 1)) = (bf16_t)f2bf(x[j] * 0.125f);
    }
    __syncthreads();
    {
        float* dst = XMC + ((size_t)nh * 128 + c) * 8192;
        bf16x8 b0 = lds_frag(VwT, 16 * wave + fr, fq * 8, 72), b1 = lds_frag(VwT, 16 * wave + fr, 32 + fq * 8, 72);
#pragma unroll
        for (int mt = 0; mt < 4; ++mt) {
            f32x4 acc = {0.f, 0.f, 0.f, 0.f};
            acc = mfma16(lds_frag(KT, 16 * mt + fr, fq * 8, 72), b0, acc);
            acc = mfma16(lds_frag(KT, 16 * mt + fr, 32 + fq * 8, 72), b1, acc);
            *(f32x4*)(dst + (16 * wave + fr) * 64 + 16 * mt + 4 * fq) = acc;
        }
    }
    if (tid < 64) {
        float s = 0.f;
#pragma unroll 8
        for (int t = 0; t < 64; ++t) s += bf2f(*(const LAS bf16_t*)(KT + ((tid * 72 + t) << 1))) * wv[t];
        XMN[((size_t)nh * 128 + c) * 64 + tid] = s;
    }
    __syncthreads();
}

__device__ __forceinline__ void ssd_local(lptr lds, const Ctx& X, int l, int task, int tid) {
    const int g = task & 1, c = (task >> 1) & 127, n = task >> 8;
    const int lane = tid & 63, wave = tid >> 6, fr = lane & 15, fq = lane >> 4;
    const int seq0 = n * SEQ, row0 = seq0 + c * 64;
    lptr XwT = lds;
    lptr BT = lds + 36864;
    LAS float* wl = (LAS float*)(lds + 55296);
    if (wave < 4) {
        const int hh = 4 * g + wave;
        const float dt = softplusf_(bf2f(XU[(size_t)(row0 + lane) * NIN + C_BDT + hh]) + XPAR(P_DTB)[l * 8 + hh]);
        const float A = -__expf(XPAR(P_ALOG)[l * 8 + hh]);
        const float a = wave_scan_sum(dt * A, lane);
        const float aL = __shfl(a, 63);
        wl[wave * 64 + lane] = __expf(aL - a) * dt;
        if (lane == 0) XSA[(n * 8 + hh) * 128 + c] = aL;
    }
    __syncthreads();
    const float* cw = XPAR(P_CW) + l * 4096; const float* cb = XPAR(P_CB) + l * 1024;
#pragma unroll 1
    for (int it = 0; it < 6; ++it) {
        const int item = tid + it * NT;
        float o[8];
        if (item < 2048) {
            const int t = item >> 5, j8 = (item & 31) * 8;
            conv8(XU, seq0, c * 64 + t, g * 256 + j8, cw, cb, o);
            const float w = wl[(j8 >> 6) * 64 + t];
#pragma unroll
            for (int j = 0; j < 8; ++j) *(LAS bf16_t*)(XwT + (((j8 + j) * 72 + t) << 1)) = (bf16_t)f2bf(o[j] * w);
        } else {
            const int i2 = item - 2048, t = i2 >> 4, s8 = (i2 & 15) * 8;
            conv8(XU, seq0, c * 64 + t, 512 + g * 128 + s8, cw, cb, o);
#pragma unroll
            for (int j = 0; j < 8; ++j) *(LAS bf16_t*)(BT + (((s8 + j) * 72 + t) << 1)) = (bf16_t)f2bf(o[j]);
        }
    }
    __syncthreads();
    {
        const int hl = wave >> 1, ph = wave & 1, hh = 4 * g + hl;
        float* dst = XSH + ((size_t)(n * 8 + hh) * 128 + c) * 8192;
        bf16x8 bx[2][2];
#pragma unroll
        for (int ntl = 0; ntl < 2; ++ntl)
#pragma unroll
            for (int kk = 0; kk < 2; ++kk) bx[ntl][kk] = lds_frag(XwT, hl * 64 + ph * 32 + ntl * 16 + fr, kk * 32 + fq * 8, 72);
#pragma unroll
        for (int mt = 0; mt < 8; ++mt) {
            bf16x8 a0 = lds_frag(BT, 16 * mt + fr, fq * 8, 72), a1 = lds_frag(BT, 16 * mt + fr, 32 + fq * 8, 72);
#pragma unroll
            for (int ntl = 0; ntl < 2; ++ntl) {
                f32x4 acc = {0.f, 0.f, 0.f, 0.f};
                acc = mfma16(a0, bx[ntl][0], acc); acc = mfma16(a1, bx[ntl][1], acc);
                *(f32x4*)(dst + (ph * 32 + ntl * 16 + fr) * 128 + 16 * mt + 4 * fq) = acc;
            }
        }
    }
    __syncthreads();
}

__device__ __forceinline__ void swa_prompt(lptr lds, const Ctx& X, int l, int task, int tid) {
    const int kvh = task & 1, qb = (task >> 1) & 63, n = task >> 7;
    const int lane = tid & 63, wave = tid >> 6, fr = lane & 15, fq = lane >> 4;
    const int seq0 = n * SEQ;
    lptr Kn = lds;
    lptr Vt = lds + 36864;
    lptr Pw = lds + 70656 + wave * 8448;
    const float* knw = XPAR(P_KNW) + l * 64; const float* qnw = XPAR(P_QNW) + l * 64;
#pragma unroll
    for (int it = 0; it < 2; ++it) {
        const int item = tid + it * NT, j = item >> 2, qd = item & 3, t = qb * 128 - 128 + j;
        float o1[8], o2[8];
        if (t >= 0) {
            const bf16_t* kr = XU + (size_t)(seq0 + t) * NIN + C_CK + kvh * 64;
            float x1[8], x2[8]; unpack8(*(const u32x4*)(kr + qd * 8), x1); unpack8(*(const u32x4*)(kr + 32 + qd * 8), x2);
            float ss = 0.f;
#pragma unroll
            for (int jj = 0; jj < 8; ++jj) ss += x1[jj] * x1[jj] + x2[jj] * x2[jj];
            ss += __shfl_xor(ss, 1); ss += __shfl_xor(ss, 2);
            const float rs = rsqrtf(ss * (1.f / 64.f) + EPS);
            const float* cs = XROPE + ((size_t)t * 32 + qd * 8) * 2;
#pragma unroll
            for (int jj = 0; jj < 8; ++jj) {
                const float a = x1[jj] * rs * knw[qd * 8 + jj], b = x2[jj] * rs * knw[32 + qd * 8 + jj], co = cs[2 * jj], si = cs[2 * jj + 1];
                o1[jj] = a * co - b * si; o2[jj] = b * co + a * si;
            }
        } else {
#pragma unroll
            for (int jj = 0; jj < 8; ++jj) { o1[jj] = 0.f; o2[jj] = 0.f; }
        }
        *(LAS u32x4*)(Kn + ((j * 72 + qd * 8) << 1)) = pack8(o1);
        *(LAS u32x4*)(Kn + ((j * 72 + 32 + qd * 8) << 1)) = pack8(o2);
        if (qb == 63 && j >= 128) {
            float* ko = X.out + O_PK + ((((size_t)l * 2 + n) * 128 + (j - 128)) * 2 + kvh) * 64;
            *(f32x4*)(ko + qd * 8) = (f32x4){o1[0], o1[1], o1[2], o1[3]}; *(f32x4*)(ko + qd * 8 + 4) = (f32x4){o1[4], o1[5], o1[6], o1[7]};
            *(f32x4*)(ko + 32 + qd * 8) = (f32x4){o2[0], o2[1], o2[2], o2[3]}; *(f32x4*)(ko + 32 + qd * 8 + 4) = (f32x4){o2[4], o2[5], o2[6], o2[7]};
        }
    }
#pragma unroll
    for (int it = 0; it < 4; ++it) {
        const int item = tid + it * NT, j = item >> 3, d8 = (item & 7) * 8, t = qb * 128 - 128 + j;
        u32x4 w = {0u, 0u, 0u, 0u};
        if (t >= 0) w = *(const u32x4*)(XU + (size_t)(seq0 + t) * NIN + C_CV + kvh * 64 + d8);
#pragma unroll
        for (int jj = 0; jj < 8; ++jj) *(LAS bf16_t*)(Vt + (((d8 + jj) * 264 + j) << 1)) = (bf16_t)((w[jj >> 1] >> ((jj & 1) * 16)) & 0xffffu);
        if (qb == 63 && j >= 128) {
            float x[8]; unpack8(w, x);
            float* vo = X.out + O_PV + ((((size_t)l * 2 + n) * 128 + (j - 128)) * 2 + kvh) * 64 + d8;
            *(f32x4*)(vo) = (f32x4){x[0], x[1], x[2], x[3]}; *(f32x4*)(vo + 4) = (f32x4){x[4], x[5], x[6], x[7]};
        }
    }
    __syncthreads();
    const int hq = kvh * 4 + (wave >> 1), i0 = (wave & 1) * 64;
    const float sink = XPAR(P_SINK)[l * 8 + hq];
#pragma unroll 1
    for (int mt = 0; mt < 4; ++mt) {
        bf16x8 a0, a1;
        {
            const int i = i0 + mt * 16 + fr, t = qb * 128 + i;
            const bf16_t* qr = XU + (size_t)(seq0 + t) * NIN + C_CQ + hq * 64;
            float x1[8], x2[8]; unpack8(*(const u32x4*)(qr + fq * 8), x1); unpack8(*(const u32x4*)(qr + 32 + fq * 8), x2);
            float ss = 0.f;
#pragma unroll
            for (int jj = 0; jj < 8; ++jj) ss += x1[jj] * x1[jj] + x2[jj] * x2[jj];
            ss += __shfl_xor(ss, 16); ss += __shfl_xor(ss, 32);
            const float rs = rsqrtf(ss * (1.f / 64.f) + EPS) * 0.125f;
            const float* cs = XROPE + ((size_t)t * 32 + fq * 8) * 2;
            float o1[8], o2[8];
#pragma unroll
            for (int jj = 0; jj < 8; ++jj) {
                const float a = x1[jj] * rs * qnw[fq * 8 + jj], b = x2[jj] * rs * qnw[32 + fq * 8 + jj], co = cs[2 * jj], si = cs[2 * jj + 1];
                o1[jj] = a * co - b * si; o2[jj] = b * co + a * si;
            }
            a0 = as_frag(pack8(o1)); a1 = as_frag(pack8(o2));
        }
        f32x4 s[16];
#pragma unroll
        for (int ntl = 0; ntl < 16; ++ntl) {
            f32x4 acc = {0.f, 0.f, 0.f, 0.f};
            acc = mfma16(a0, lds_frag(Kn, 16 * ntl + fr, fq * 8, 72), acc);
            acc = mfma16(a1, lds_frag(Kn, 16 * ntl + fr, 32 + fq * 8, 72), acc);
            s[ntl] = acc;
        }
        float mx[4] = {-3.0e38f, -3.0e38f, -3.0e38f, -3.0e38f};
#pragma unroll
        for (int ntl = 0; ntl < 16; ++ntl)
#pragma unroll
            for (int ii = 0; ii < 4; ++ii) {
                const int qi = i0 + mt * 16 + fq * 4 + ii, j = 16 * ntl + fr;
                const bool valid = (j > qi) && (j <= qi + 128) && (qb > 0 || j >= 128);
                s[ntl][ii] = valid ? s[ntl][ii] : -3.0e38f;
                mx[ii] = fmaxf(mx[ii], s[ntl][ii]);
            }
        float sum[4];
#pragma unroll
        for (int ii = 0; ii < 4; ++ii) { mx[ii] = fmaxf(red16max(mx[ii]), sink); sum[ii] = 0.f; }
#pragma unroll
        for (int ntl = 0; ntl < 16; ++ntl)
#pragma unroll
            for (int ii = 0; ii < 4; ++ii) { const float e = (s[ntl][ii] > -1.0e38f) ? __expf(s[ntl][ii] - mx[ii]) : 0.f; s[ntl][ii] = e; sum[ii] += e; }
#pragma unroll
        for (int ii = 0; ii < 4; ++ii) sum[ii] = 1.f / (red16(sum[ii]) + __expf(sink - mx[ii]));
#pragma unroll
        for (int ntl = 0; ntl < 16; ++ntl)
#pragma unroll
            for (int ii = 0; ii < 4; ++ii) *(LAS bf16_t*)(Pw + (((fq * 4 + ii) * 264 + 16 * ntl + fr) << 1)) = (bf16_t)f2bf(s[ntl][ii] * sum[ii]);
        LDS_FENCE();
        f32x4 o[4];
#pragma unroll
        for (int ntl = 0; ntl < 4; ++ntl) o[ntl] = (f32x4){0.f, 0.f, 0.f, 0.f};
#pragma unroll
        for (int kk = 0; kk < 8; ++kk) {
            const bf16x8 a = lds_frag(Pw, fr, kk * 32 + fq * 8, 264);
#pragma unroll
            for (int ntl = 0; ntl < 4; ++ntl) o[ntl] = mfma16(a, lds_frag(Vt, 16 * ntl + fr, kk * 32 + fq * 8, 264), o[ntl]);
        }
        LDS_FENCE();
#pragma unroll
        for (int ii = 0; ii < 4; ++ii) {
            const size_t row = (size_t)seq0 + qb * 128 + i0 + mt * 16 + fq * 4 + ii;
#pragma unroll
            for (int ntl = 0; ntl < 4; ++ntl) {
                const int d = 16 * ntl + fr;
                const float cz = bf2f(XU[row * NIN + C_CZ + hq * 64 + d]);
                XMIX[row * DMIX + 1024 + hq * 64 + d] = (bf16_t)f2bf(o[ntl][ii] * siluf_(cz));
            }
        }
    }
    __syncthreads();
}

__device__ __forceinline__ void sample_task(lptr lds, const Ctx& X, int l, int b, int tid) {
    LAS float* uf = (LAS float*)lds;
    LAS float* xbc = (LAS float*)(lds + 19968);
    LAS float* numv = (LAS float*)(lds + 24064);
    LAS float* yv = (LAS float*)(lds + 26112);
    LAS float* red = (LAS float*)(lds + 28160);
    LAS float* qs = (LAS float*)(lds + 28416);
    LAS float* kn = (LAS float*)(lds + 30464);
    LAS float* sc = (LAS float*)(lds + 30976);
    const int lane = tid & 63, wave = tid >> 6;
    const size_t row = (size_t)TP + b;
    const bf16_t* ur = XU + row * NIN;
    const size_t lb = (size_t)l * 128 + b;
#pragma unroll 2
    for (int i = tid; i < DIN; i += NT) uf[i] = bf2f(ur[i]);
    __syncthreads();
#pragma unroll 1
    for (int h = 0; h < 4; ++h) {
        const float ig = uf[C_AI + h] + XPAR(P_AIB)[l * 4 + h], fg = uf[C_AF + h] + XPAR(P_AFB)[l * 4 + h];
        const float ls = logsigf_(fg), m0 = X.stM[lb * 4 + h];
        const float mn = fmaxf(ls + m0, ig), sp = __expf(ls + m0 - mn), sl = __expf(ig - mn);
        const float* C0 = X.stC + (lb * 4 + h) * 8192; float* C1 = X.out + O_SC + (lb * 4 + h) * 8192;
#pragma unroll
        for (int it = 0; it < 4; ++it) {
            const int e = (tid + it * NT) * 4, v = e >> 6, k = e & 63;
            const f32x4 c0 = *(const f32x4*)(C0 + e);
            const float vv = uf[C_AV + h * 128 + v] * sl;
            f32x4 c1; float part = 0.f;
#pragma unroll
            for (int j = 0; j < 4; ++j) { c1[j] = sp * c0[j] + vv * (uf[C_AK + h * 64 + k + j] * 0.125f); part += c1[j] * uf[C_AQ + h * 64 + k + j]; }
            *(f32x4*)(C1 + e) = c1;
            part = red16(part);
            if ((lane & 15) == 0) numv[h * 128 + v] = part;
        }
        if (wave == 0) {
            const float n1 = sp * X.stN[(lb * 4 + h) * 64 + lane] + sl * uf[C_AK + h * 64 + lane] * 0.125f;
            X.out[O_SN + (lb * 4 + h) * 64 + lane] = n1;
            const float dd = wave_sum(n1 * uf[C_AQ + h * 64 + lane]);
            if (lane == 0) { red[h] = dd; red[4 + h] = mn; X.out[O_SM + lb * 4 + h] = mn; }
        }
    }
    __syncthreads();
    float hv;
    { const int h = tid >> 7; hv = numv[tid] / fmaxf(fabsf(red[h]), __expf(-red[4 + h])); const float ss = wave_sum(hv * hv); if (lane == 0) red[8 + wave] = ss; }
    __syncthreads();
    { const int h = tid >> 7; const float rs = rsqrtf((red[8 + 2 * h] + red[9 + 2 * h]) * (1.f / 128.f) + EPS);
      XMIX[row * DMIX + tid] = (bf16_t)f2bf(hv * rs * XPAR(P_ANW)[l * 512 + tid] * sigmoidf_(uf[C_AO + tid]) * siluf_(uf[C_AZ + tid])); }
    {
        const float* buf = X.conv + lb * 3 * 1024; float* oc = X.out + O_SCONV + lb * 3 * 1024;
        const float* cw = XPAR(P_CW) + l * 4096;
#pragma unroll
        for (int it = 0; it < 2; ++it) {
            const int ch = tid + it * NT;
            const float f0 = buf[ch], f1 = buf[1024 + ch], f2 = buf[2048 + ch], f3 = uf[C_BX + ch];
            const float acc = XPAR(P_CB)[l * 1024 + ch] + f0 * cw[ch] + f1 * cw[1024 + ch] + f2 * cw[2048 + ch] + f3 * cw[3072 + ch];
            xbc[ch] = siluf_(acc);
            oc[ch] = f1; oc[1024 + ch] = f2; oc[2048 + ch] = f3;
        }
    }
    __syncthreads();
#pragma unroll 1
    for (int hh = 0; hh < 8; ++hh) {
        const float dt = softplusf_(uf[C_BDT + hh] + XPAR(P_DTB)[l * 8 + hh]);
        const float dA = __expf(-dt * __expf(XPAR(P_ALOG)[l * 8 + hh]));
        const int g = hh >> 2;
        const float* h0p = X.ssm + (lb * 8 + hh) * 8192; float* h1p = X.out + O_SH + (lb * 8 + hh) * 8192;
#pragma unroll
        for (int it = 0; it < 4; ++it) {
            const int e = (tid + it * NT) * 4, p = e >> 7, s = e & 127;
            const f32x4 h0 = *(const f32x4*)(h0p + e);
            const float xv = xbc[hh * 64 + p] * dt;
            f32x4 h1; float part = 0.f;
#pragma unroll
            for (int j = 0; j < 4; ++j) { h1[j] = dA * h0[j] + xv * xbc[512 + g * 128 + s + j]; part += h1[j] * xbc[768 + g * 128 + s + j]; }
            *(f32x4*)(h1p + e) = h1;
            part = red16(part); part += __shfl_xor(part, 16);
            if ((lane & 31) == 0) yv[hh * 64 + p] = part;
        }
    }
    __syncthreads();
    float gb;
    { const int hh = tid >> 6; const float y = yv[tid] + XPAR(P_BD)[l * 8 + hh] * xbc[tid]; gb = y * siluf_(uf[C_BZ + tid]); const float ss = wave_sum(gb * gb); if (lane == 0) red[16 + wave] = ss; }
    __syncthreads();
    { const int g = tid >> 8; const float rs = rsqrtf((red[16 + 4 * g] + red[17 + 4 * g] + red[18 + 4 * g] + red[19 + 4 * g]) * (1.f / 256.f) + EPS);
      XMIX[row * DMIX + 512 + tid] = (bf16_t)f2bf(gb * rs * XPAR(P_BNW)[l * 512 + tid]); }
    if (tid < 320) {
        const int vec = tid >> 5, d = tid & 31, base = vec < 8 ? C_CQ + vec * 64 : C_CK + (vec - 8) * 64;
        const float x1 = uf[base + d], x2 = uf[base + 32 + d];
        float ss = x1 * x1 + x2 * x2; ss = red16(ss); ss += __shfl_xor(ss, 16);
        const float rs = rsqrtf(ss * (1.f / 64.f) + EPS);
        const float* w = vec < 8 ? XPAR(P_QNW) + l * 64 : XPAR(P_KNW) + l * 64;
        const float a = x1 * rs * w[d], bb = x2 * rs * w[d + 32];
        const float co = XROPE[((size_t)8192 * 32 + d) * 2], si = XROPE[((size_t)8192 * 32 + d) * 2 + 1];
        const float o1 = a * co - bb * si, o2 = bb * co + a * si;
        if (vec < 8) { qs[vec * 64 + d] = o1 * 0.125f; qs[vec * 64 + 32 + d] = o2 * 0.125f; } else { kn[(vec - 8) * 64 + d] = o1; kn[(vec - 8) * 64 + 32 + d] = o2; }
    }
    __syncthreads();
    const float* kc = X.ck + lb * 16384; const float* vc = X.cv + lb * 16384;
    {
        float* ko = X.out + O_SK + lb * 16384; float* vo = X.out + O_SV + lb * 16384;
#pragma unroll 2
        for (int it = 0; it < 8; ++it) {
            const int e = (tid + it * NT) * 4, j = e >> 7, r = e & 127;
            f32x4 kv, vv;
            if (j < 127) { kv = *(const f32x4*)(kc + e + 128); vv = *(const f32x4*)(vc + e + 128); }
            else { kv = (f32x4){kn[r], kn[r + 1], kn[r + 2], kn[r + 3]}; vv = (f32x4){uf[C_CV + r], uf[C_CV + r + 1], uf[C_CV + r + 2], uf[C_CV + r + 3]}; }
            *(f32x4*)(ko + e) = kv; *(f32x4*)(vo + e) = vv;
        }
    }
    if (tid < 256) {
        const int kvh = tid >> 7, jj = tid & 127;
        float s0 = 0.f, s1 = 0.f, s2 = 0.f, s3 = 0.f;
#pragma unroll 2
        for (int d4 = 0; d4 < 16; ++d4) {
            f32x4 kv;
            if (jj < 127) kv = *(const f32x4*)(kc + (jj + 1) * 128 + kvh * 64 + d4 * 4);
            else kv = (f32x4){kn[kvh * 64 + d4 * 4], kn[kvh * 64 + d4 * 4 + 1], kn[kvh * 64 + d4 * 4 + 2], kn[kvh * 64 + d4 * 4 + 3]};
#pragma unroll
            for (int j = 0; j < 4; ++j) {
                s0 += kv[j] * qs[(kvh * 4 + 0) * 64 + d4 * 4 + j]; s1 += kv[j] * qs[(kvh * 4 + 1) * 64 + d4 * 4 + j];
                s2 += kv[j] * qs[(kvh * 4 + 2) * 64 + d4 * 4 + j]; s3 += kv[j] * qs[(kvh * 4 + 3) * 64 + d4 * 4 + j];
            }
        }
        sc[(kvh * 4 + 0) * 128 + jj] = s0; sc[(kvh * 4 + 1) * 128 + jj] = s1; sc[(kvh * 4 + 2) * 128 + jj] = s2; sc[(kvh * 4 + 3) * 128 + jj] = s3;
    }
    __syncthreads();
    {
        const int hq = wave; const float s0 = sc[hq * 128 + lane], s1 = sc[hq * 128 + 64 + lane], sink = XPAR(P_SINK)[l * 8 + hq];
        const float m = fmaxf(wave_max(fmaxf(s0, s1)), sink);
        const float e0 = __expf(s0 - m), e1 = __expf(s1 - m);
        const float inv = 1.f / (wave_sum(e0 + e1) + __expf(sink - m));
        sc[hq * 128 + lane] = e0 * inv; sc[hq * 128 + 64 + lane] = e1 * inv;
    }
    __syncthreads();
    {
        const int hq = tid >> 6, d = tid & 63, kvh = hq >> 2;
        float o = 0.f;
#pragma unroll 8
        for (int jj = 0; jj < 127; ++jj) o += sc[hq * 128 + jj] * vc[(jj + 1) * 128 + kvh * 64 + d];
        o += sc[hq * 128 + 127] * uf[C_CV + kvh * 64 + d];
        XMIX[row * DMIX + 1024 + tid] = (bf16_t)f2bf(o * siluf_(uf[C_CZ + tid]));
    }
    __syncthreads();
}

__device__ __forceinline__ void scans(const Ctx& X, int l, int gt, int nthreads) {
    for (int item = gt; item < 98816; item += nthreads) {
        if (item < 32768) {
            const int nh = item >> 12, e = (item & 4095) * 2;
            float* base = XMC + (size_t)nh * 128 * 8192 + e;
            const float* ml = XML + nh * 128; const float* bl = XBL + nh * 128;
            float m = 0.f; f32x2 st = {0.f, 0.f};
            for (int c0 = 0; c0 < 128; c0 += 8) {
                f32x2 cl[8];
#pragma unroll
                for (int j = 0; j < 8; ++j) cl[j] = *(const f32x2*)(base + (size_t)(c0 + j) * 8192);
#pragma unroll
                for (int j = 0; j < 8; ++j) {
                    const float mlj = ml[c0 + j], blj = bl[c0 + j], mn = fmaxf(blj + m, mlj), sp = __expf(blj + m - mn), sl = __expf(mlj - mn);
                    *(f32x2*)(base + (size_t)(c0 + j) * 8192) = st;
                    if (e == 0) XMS[nh * 128 + c0 + j] = m;
                    st = st * sp + cl[j] * sl; m = mn;
                }
            }
            *(f32x2*)(X.out + O_PC + ((size_t)l * 8 + nh) * 8192 + e) = st;
            if (e == 0) X.out[O_PM + l * 8 + nh] = m;
        } else if (item < 98304) {
            const int i1 = item - 32768, nhh = i1 >> 12, e = (i1 & 4095) * 2;
            float* base = XSH + (size_t)nhh * 128 * 8192 + e;
            const float* al = XSA + nhh * 128;
            f32x2 st = {0.f, 0.f};
            for (int c0 = 0; c0 < 128; c0 += 8) {
                f32x2 cl[8];
#pragma unroll
                for (int j = 0; j < 8; ++j) cl[j] = *(const f32x2*)(base + (size_t)(c0 + j) * 8192);
#pragma unroll
                for (int j = 0; j < 8; ++j) {
                    const float dec = __expf(al[c0 + j]);
                    *(f32x2*)(base + (size_t)(c0 + j) * 8192) = st;
                    st = st * dec + cl[j];
                }
            }
            *(f32x2*)(X.out + O_PH + ((size_t)l * 16 + nhh) * 8192 + e) = st;
        } else {
            const int i2 = item - 98304, nh = i2 >> 6, k = i2 & 63;
            float* base = XMN + (size_t)nh * 128 * 64 + k;
            const float* ml = XML + nh * 128; const float* bl = XBL + nh * 128;
            float m = 0.f, st = 0.f;
            for (int c = 0; c < 128; ++c) {
                const float mlj = ml[c], blj = bl[c], mn = fmaxf(blj + m, mlj), sp = __expf(blj + m - mn), sl = __expf(mlj - mn);
                const float cl = base[c * 64];
                base[c * 64] = st;
                st = st * sp + cl * sl; m = mn;
            }
            X.out[O_PN + ((size_t)l * 8 + nh) * 64 + k] = st;
        }
    }
}

__device__ __forceinline__ void mlstm_out(lptr lds, const Ctx& X, int l, int task, int tid) {
    const int h = task & 3, c = (task >> 2) & 127, n = task >> 9;
    const int lane = tid & 63, wave = tid >> 6, fr = lane & 15, fq = lane >> 4;
    const int row0 = n * SEQ + c * 64, nh = n * 4 + h;
    lptr Qs = lds;
    lptr Ks = lds + 9216;
    lptr Vt = lds + 18432;
    lptr Sb = lds + 36864 + wave * 2304;
    LAS float* bv = (LAS float*)(lds + 55296);
    LAS float* dv = bv + 64;
    LAS float* mtv = bv + 128;
    LAS float* siv = bv + 192;
    LAS float* qnv = bv + 256;
    LAS float* ssqp = bv + 384;
    LAS float* nsv = bv + 512;
    if (wave == 0) {
        const bf16_t* ur = XU + (size_t)(row0 + lane) * NIN;
        const float fg = bf2f(ur[C_AF + h]) + XPAR(P_AFB)[l * 4 + h], ig = bf2f(ur[C_AI + h]) + XPAR(P_AIB)[l * 4 + h];
        const float b = wave_scan_sum(logsigf_(fg), lane);
        const float dd = ig - b;
        const float cm = wave_scan_max(dd, lane);
        const float ms = XMS[nh * 128 + c];
        const float mt = b + fmaxf(ms, cm);
        bv[lane] = b; dv[lane] = dd; mtv[lane] = mt; siv[lane] = __expf(b + ms - mt);
        nsv[lane] = XMN[((size_t)nh * 128 + c) * 64 + lane];
    }
    {
        const int tok = tid >> 3, k8 = (tid & 7) * 8;
        const bf16_t* ur = XU + (size_t)(row0 + tok) * NIN;
        *(LAS u32x4*)(Qs + ((tok * 72 + k8) << 1)) = *(const u32x4*)(ur + C_AQ + h * 64 + k8);
        float x[8]; unpack8(*(const u32x4*)(ur + C_AK + h * 64 + k8), x);
#pragma unroll
        for (int j = 0; j < 8; ++j) x[j] *= 0.125f;
        *(LAS u32x4*)(Ks + ((tok * 72 + k8) << 1)) = pack8(x);
    }
#pragma unroll
    for (int it = 0; it < 2; ++it) {
        const int p = tid + it * NT, tok = p >> 4, v8 = (p & 15) * 8;
        const u32x4 w = *(const u32x4*)(XU + (size_t)(row0 + tok) * NIN + C_AV + h * 128 + v8);
#pragma unroll
        for (int j = 0; j < 8; ++j) *(LAS bf16_t*)(Vt + (((v8 + j) * 72 + tok) << 1)) = (bf16_t)((w[j >> 1] >> ((j & 1) * 16)) & 0xffffu);
    }
    __syncthreads();
    const int mti = wave >> 1, half = wave & 1;
    bf16x8 qa[2];
    qa[0] = lds_frag(Qs, 16 * mti + fr, fq * 8, 72); qa[1] = lds_frag(Qs, 16 * mti + fr, 32 + fq * 8, 72);
    {
        float x0[8], x1[8]; unpack8(__builtin_bit_cast(u32x4, qa[0]), x0); unpack8(__builtin_bit_cast(u32x4, qa[1]), x1);
        float d = 0.f;
#pragma unroll
        for (int j = 0; j < 8; ++j) d += x0[j] * nsv[fq * 8 + j] + x1[j] * nsv[32 + fq * 8 + j];
        d += __shfl_xor(d, 16); d += __shfl_xor(d, 32);
        if (fq == 0) qnv[wave * 16 + fr] = d;
    }
    float rsum[4] = {0.f, 0.f, 0.f, 0.f};
#pragma unroll
    for (int ntl = 0; ntl < 4; ++ntl) {
        f32x4 s = {0.f, 0.f, 0.f, 0.f};
        s = mfma16(qa[0], lds_frag(Ks, 16 * ntl + fr, fq * 8, 72), s);
        s = mfma16(qa[1], lds_frag(Ks, 16 * ntl + fr, 32 + fq * 8, 72), s);
#pragma unroll
        for (int ii = 0; ii < 4; ++ii) {
            const int t = 16 * mti + fq * 4 + ii, sidx = 16 * ntl + fr;
            const float wgt = (sidx <= t) ? __expf(bv[t] + dv[sidx] - mtv[t]) : 0.f;
            const float sv = wgt * s[ii];
            rsum[ii] += sv;
            *(LAS bf16_t*)(Sb + (((fq * 4 + ii) * 72 + sidx) << 1)) = (bf16_t)f2bf(sv);
        }
    }
    LDS_FENCE();
    f32x4 acc[4];
#pragma unroll
    for (int ntl = 0; ntl < 4; ++ntl) acc[ntl] = (f32x4){0.f, 0.f, 0.f, 0.f};
#pragma unroll
    for (int kk = 0; kk < 2; ++kk) {
        const bf16x8 a = lds_frag(Sb, fr, kk * 32 + fq * 8, 72);
#pragma unroll
        for (int ntl = 0; ntl < 4; ++ntl) acc[ntl] = mfma16(a, lds_frag(Vt, 64 * half + 16 * ntl + fr, kk * 32 + fq * 8, 72), acc[ntl]);
    }
    {
        const float sia = siv[16 * mti + fr];
        const float* Cs = XMC + ((size_t)nh * 128 + c) * 8192;
#pragma unroll
        for (int kk = 0; kk < 2; ++kk) {
            float x[8]; unpack8(__builtin_bit_cast(u32x4, qa[kk]), x);
#pragma unroll
            for (int j = 0; j < 8; ++j) x[j] *= sia;
            const bf16x8 a = as_frag(pack8(x));
#pragma unroll
            for (int ntl = 0; ntl < 4; ++ntl) acc[ntl] = mfma16(a, ldg_f32_frag(Cs + (64 * half + 16 * ntl + fr) * 64 + kk * 32 + fq * 8), acc[ntl]);
        }
    }
    float hv[4][4], ssl[4];
#pragma unroll
    for (int ii = 0; ii < 4; ++ii) {
        const int t = 16 * mti + fq * 4 + ii;
        const float den = red16(rsum[ii]) + siv[t] * qnv[wave * 16 + fq * 4 + ii];
        const float inv = 1.f / fmaxf(fabsf(den), __expf(-mtv[t]));
        float ss = 0.f;
#pragma unroll
        for (int ntl = 0; ntl < 4; ++ntl) { hv[ntl][ii] = acc[ntl][ii] * inv; ss += hv[ntl][ii] * hv[ntl][ii]; }
        ssl[ii] = red16(ss);
        if (fr == 0) ssqp[t * 2 + half] = ssl[ii];
    }
    __syncthreads();
#pragma unroll
    for (int ii = 0; ii < 4; ++ii) {
        const int t = 16 * mti + fq * 4 + ii;
        const float rs = rsqrtf((ssqp[t * 2] + ssqp[t * 2 + 1]) * (1.f / 128.f) + EPS);
        const size_t row = (size_t)row0 + t;
#pragma unroll
        for (int ntl = 0; ntl < 4; ++ntl) {
            const int v = h * 128 + 64 * half + 16 * ntl + fr;
            const float ao = bf2f(XU[row * NIN + C_AO + v]), az = bf2f(XU[row * NIN + C_AZ + v]);
            XMIX[row * DMIX + v] = (bf16_t)f2bf(hv[ntl][ii] * rs * XPAR(P_ANW)[l * 512 + v] * sigmoidf_(ao) * siluf_(az));
        }
    }
    __syncthreads();
}

__device__ __forceinline__ void ssd_out(lptr lds, const Ctx& X, int l, int task, int tid) {
    const int g = task & 1, c = (task >> 1) & 127, n = task >> 8;
    const int lane = tid & 63, wave = tid >> 6, fr = lane & 15, fq = lane >> 4;
    const int seq0 = n * SEQ, row0 = seq0 + c * 64;
    lptr Cm = lds;
    lptr Bm = lds + 17408;
    lptr Xt = lds + 34816;
    LAS float* CBf = (LAS float*)(lds + 71680);
    LAS float* av = (LAS float*)(lds + 89088);
    LAS float* dtv = (LAS float*)(lds + 90112);
    LAS float* ssq = (LAS float*)(lds + 91136);
    if (wave < 4) {
        const int hh = 4 * g + wave;
        const float dt = softplusf_(bf2f(XU[(size_t)(row0 + lane) * NIN + C_BDT + hh]) + XPAR(P_DTB)[l * 8 + hh]);
        const float A = -__expf(XPAR(P_ALOG)[l * 8 + hh]);
        av[wave * 64 + lane] = wave_scan_sum(dt * A, lane);
        dtv[wave * 64 + lane] = dt;
    }
    const float* cw = XPAR(P_CW) + l * 4096; const float* cb = XPAR(P_CB) + l * 1024;
#pragma unroll 1
    for (int it = 0; it < 8; ++it) {
        const int item = tid + it * NT;
        float o[8];
        if (item < 2048) {
            const int t = item >> 5, j8 = (item & 31) * 8;
            conv8(XU, seq0, c * 64 + t, g * 256 + j8, cw, cb, o);
#pragma unroll
            for (int j = 0; j < 8; ++j) *(LAS bf16_t*)(Xt + (((j8 + j) * 72 + t) << 1)) = (bf16_t)f2bf(o[j]);
        } else if (item < 3072) {
            const int i2 = item - 2048, t = i2 >> 4, s8 = (i2 & 15) * 8;
            conv8(XU, seq0, c * 64 + t, 512 + g * 128 + s8, cw, cb, o);
            *(LAS u32x4*)(Bm + ((t * 136 + s8) << 1)) = pack8(o);
        } else {
            const int i2 = item - 3072, t = i2 >> 4, s8 = (i2 & 15) * 8;
            conv8(XU, seq0, c * 64 + t, 768 + g * 128 + s8, cw, cb, o);
            *(LAS u32x4*)(Cm + ((t * 136 + s8) << 1)) = pack8(o);
        }
    }
    __syncthreads();
    {
        const int mt = wave >> 1;
#pragma unroll
        for (int q = 0; q < 2; ++q) {
            const int ntl = 2 * (wave & 1) + q;
            f32x4 acc = {0.f, 0.f, 0.f, 0.f};
#pragma unroll
            for (int kk = 0; kk < 4; ++kk) acc = mfma16(lds_frag(Cm, 16 * mt + fr, kk * 32 + fq * 8, 136), lds_frag(Bm, 16 * ntl + fr, kk * 32 + fq * 8, 136), acc);
#pragma unroll
            for (int ii = 0; ii < 4; ++ii) CBf[(16 * mt + fq * 4 + ii) * 68 + 16 * ntl + fr] = acc[ii];
        }
    }
    __syncthreads();
    const int hl = wave >> 1, th = wave & 1, hh = 4 * g + hl;
    f32x4 y1[2][4], y2[2][4];
#pragma unroll
    for (int mi = 0; mi < 2; ++mi)
#pragma unroll
        for (int ntl = 0; ntl < 4; ++ntl) { y1[mi][ntl] = (f32x4){0.f, 0.f, 0.f, 0.f}; y2[mi][ntl] = (f32x4){0.f, 0.f, 0.f, 0.f}; }
#pragma unroll
    for (int kk = 0; kk < 2; ++kk) {
        bf16x8 bx[4];
#pragma unroll
        for (int ntl = 0; ntl < 4; ++ntl) bx[ntl] = lds_frag(Xt, hl * 64 + 16 * ntl + fr, kk * 32 + fq * 8, 72);
#pragma unroll
        for (int mi = 0; mi < 2; ++mi) {
            const int t = 16 * (2 * th + mi) + fr, u0 = kk * 32 + fq * 8;
            const float at = av[hl * 64 + t];
            float w[8];
#pragma unroll
            for (int j = 0; j < 8; ++j) {
                const int uu = u0 + j;
                w[j] = (uu <= t) ? CBf[t * 68 + uu] * __expf(at - av[hl * 64 + uu]) * dtv[hl * 64 + uu] : 0.f;
            }
            const bf16x8 a = as_frag(pack8(w));
#pragma unroll
            for (int ntl = 0; ntl < 4; ++ntl) y1[mi][ntl] = mfma16(a, bx[ntl], y1[mi][ntl]);
        }
    }
    {
        const float* hs = XSH + ((size_t)(n * 8 + hh) * 128 + c) * 8192;
#pragma unroll
        for (int kk = 0; kk < 4; ++kk) {
            bf16x8 bh[4];
#pragma unroll
            for (int ntl = 0; ntl < 4; ++ntl) bh[ntl] = ldg_f32_frag(hs + (16 * ntl + fr) * 128 + kk * 32 + fq * 8);
#pragma unroll
            for (int mi = 0; mi < 2; ++mi) {
                const bf16x8 a = lds_frag(Cm, 16 * (2 * th + mi) + fr, kk * 32 + fq * 8, 136);
#pragma unroll
                for (int ntl = 0; ntl < 4; ++ntl) y2[mi][ntl] = mfma16(a, bh[ntl], y2[mi][ntl]);
            }
        }
    }
    const float Dh = XPAR(P_BD)[l * 8 + hh];
#pragma unroll
    for (int mi = 0; mi < 2; ++mi)
#pragma unroll
        for (int ii = 0; ii < 4; ++ii) {
            const int t = 16 * (2 * th + mi) + fq * 4 + ii;
            const float ea = __expf(av[hl * 64 + t]);
            const size_t row = (size_t)row0 + t;
            float ss = 0.f;
#pragma unroll
            for (int ntl = 0; ntl < 4; ++ntl) {
                const int p = 16 * ntl + fr;
                const float xv = bf2f(*(const LAS bf16_t*)(Xt + (((hl * 64 + p) * 72 + t) << 1)));
                const float y = y1[mi][ntl][ii] + ea * y2[mi][ntl][ii] + Dh * xv;
                const float gbv = y * siluf_(bf2f(XU[row * NIN + C_BZ + hh * 64 + p]));
                y1[mi][ntl][ii] = gbv; ss += gbv * gbv;
            }
            ss = red16(ss);
            if (fr == 0) ssq[t * 4 + hl] = ss;
        }
    __syncthreads();
#pragma unroll
    for (int mi = 0; mi < 2; ++mi)
#pragma unroll
        for (int ii = 0; ii < 4; ++ii) {
            const int t = 16 * (2 * th + mi) + fq * 4 + ii;
            const float rs = rsqrtf((ssq[t * 4] + ssq[t * 4 + 1] + ssq[t * 4 + 2] + ssq[t * 4 + 3]) * (1.f / 256.f) + EPS);
            const size_t row = (size_t)row0 + t;
#pragma unroll
            for (int ntl = 0; ntl < 4; ++ntl) {
                const int p = hh * 64 + 16 * ntl + fr;
                XMIX[row * DMIX + 512 + p] = (bf16_t)f2bf(y1[mi][ntl][ii] * rs * XPAR(P_BNW)[l * 512 + p]);
            }
        }
    __syncthreads();
}

__global__ void __launch_bounds__(NT, 2) mega(Args args) {
    __shared__ __attribute__((aligned(16))) unsigned char lds_raw[LDS_BYTES];
    lptr lds = (lptr)lds_raw;
    cg::grid_group grid = cg::this_grid();
    const int tid = threadIdx.x, bid = blockIdx.x, G = gridDim.x;
    Ctx X;
    X.xp = args.in[IN_XP]; X.xs = args.in[IN_XS]; X.stC = args.in[IN_STC]; X.stN = args.in[IN_STN]; X.stM = args.in[IN_STM]; X.ssm = args.in[IN_SSM];
    X.conv = args.in[IN_CONV]; X.ck = args.in[IN_CK]; X.cv = args.in[IN_CV]; X.out = args.out; X.ws = args.ws;
    const int lo = args.ph_lo, hi = args.ph_hi;
#define IN(k) (lo <= (k) && (k) < hi)
#define SEAM(k) do { if (IN(k) && IN((k) + 1)) grid.sync(); } while (0)
    if (IN(0)) { prologue(lds, X, args, G, bid, tid); }
    SEAM(0);
    for (int l = 0; l < 4; ++l) {
        const int pb = 1 + l * 5;
        if (IN(pb)) {
            pg8::Gemm g{XXB, XWIN + (size_t)l * NIN * D, MPAD, NIN, D}; pg8::StaticOrder S; S.init(MPAD, NIN, G, bid);
            pg8::EpiU E{XU, XSSQ};
            pg8::gemm_phase<pg8::EpiU>(lds, g, S, E, OPQ(tid));
        }
        SEAM(pb);
        if (IN(pb + 1)) {
            for (int task = bid; task < 1921; task += G) {
                if (task < 128) sample_task(lds, X, l, task, OPQ(tid));
                else if (task < 384) swa_prompt(lds, X, l, task - 128, OPQ(tid));
                else if (task < 1408) mlstm_local(lds, X, l, task - 384, OPQ(tid));
                else if (task < 1920) ssd_local(lds, X, l, task - 1408, OPQ(tid));
                else {
                    for (int i = tid; i < 2 * 3 * 1024; i += NT) {
                        const int ch = i & 1023, j = (i >> 10) % 3, n = i / 3072;
                        X.out[O_PCONV + (((size_t)l * 2 + n) * 3 + j) * 1024 + ch] = bf2f(XU[(size_t)(n * SEQ + SEQ - 3 + j) * NIN + C_BX + ch]);
                    }
                }
            }
        }
        SEAM(pb + 1);
        if (IN(pb + 2)) scans(X, l, bid * NT + OPQ(tid), G * NT);
        SEAM(pb + 2);
        if (IN(pb + 3)) {
            for (int task = bid; task < 1536; task += G) {
                if (task < 512) ssd_out(lds, X, l, task, OPQ(tid));
                else mlstm_out(lds, X, l, task - 512, OPQ(tid));
            }
        }
        SEAM(pb + 3);
        if (IN(pb + 4)) {
            pg8::Gemm g{XMIX, XWOUT + (size_t)l * D * DMIX, MPAD, D, DMIX}; pg8::StaticOrder S; S.init(MPAD, D, G, bid);
            pg8::EpiRes E{l == 0 ? X.xp : nullptr, X.xs, X.out, XXB, XSSQ};
            pg8::gemm_phase<pg8::EpiRes>(lds, g, S, E, OPQ(tid));
        }
        SEAM(pb + 4);
    }
#undef IN
#undef SEAM
}

extern "C" void kernel_launch(void* const* d_in, const int* in_sizes, int n_in, void* d_out, int out_size, void* d_ws, size_t ws_size, hipStream_t stream) {
    static int grid_blocks = 0;
    if (!grid_blocks) {
        int dev = 0, cus = 0, per_cu = 0;
        hipGetDevice(&dev);
        hipDeviceGetAttribute(&cus, hipDeviceAttributeMultiprocessorCount, dev);
        hipOccupancyMaxActiveBlocksPerMultiprocessor(&per_cu, mega, NT, 0);
        if (per_cu < 1) { fprintf(stderr, "occupancy query returned %d\n", per_cu); per_cu = 1; }
        grid_blocks = cus * 1;
        if (ws_size < WS_END) fprintf(stderr, "workspace too small: %zu < %zu\n", ws_size, (size_t)WS_END);
    }
    Args a{};
    for (int i = 0; i < 24; ++i) a.in[i] = (const float*)d_in[i];
    a.out = (float*)d_out; a.ws = (unsigned char*)d_ws;
    const int NPH = 21;
#if MULTI_LAUNCH
    for (int p = 0; p < NPH; ++p) {
        a.ph_lo = p; a.ph_hi = p + 1;
        void* kargs[] = {&a};
        hipError_t e = hipLaunchCooperativeKernel((void*)mega, dim3(grid_blocks), dim3(NT), kargs, 0, stream);
        if (e != hipSuccess) fprintf(stderr, "cooperative launch failed: %s (grid %d)\n", hipGetErrorString(e), grid_blocks);
    }
#else
    a.ph_lo = 0; a.ph_hi = NPH;
    void* kargs[] = {&a};
    hipError_t e = hipLaunchCooperativeKernel((void*)mega, dim3(grid_blocks), dim3(NT), kargs, 0, stream);
    if (e != hipSuccess) fprintf(stderr, "cooperative launch failed: %s (grid %d)\n", hipGetErrorString(e), grid_blocks);
#endif
}
```

```cpp
#include <hip/hip_runtime.h>
#include <hip/hip_cooperative_groups.h>
#include <cstdio>
#include <cstdint>
namespace cg = cooperative_groups;

#ifndef REP_SYNC
#define REP_SYNC 1
#endif
#ifndef REP_P1
#define REP_P1 1
#endif
#ifndef REP_P2
#define REP_P2 1
#endif
#ifndef REP_P4
#define REP_P4 1
#endif
#ifndef MULTI_LAUNCH
#define MULTI_LAUNCH 0
#endif

#define LAS __attribute__((address_space(3)))
typedef unsigned short bf16_t;
typedef short bf16x8 __attribute__((ext_vector_type(8)));
typedef float f32x4 __attribute__((ext_vector_type(4)));
typedef float f32x2 __attribute__((ext_vector_type(2)));
typedef unsigned u32x4 __attribute__((ext_vector_type(4)));
typedef unsigned u32x2 __attribute__((ext_vector_type(2)));
typedef __bf16 bf16x2_t __attribute__((ext_vector_type(2)));
typedef LAS unsigned char* lptr;

constexpr int D = 1024, DIN = 4880, NIN = 5120, DMIX = 1536, TP = 16384, MTOK = 16512, MPAD = 16640, SEQ = 8192;
constexpr int C_AQ = 0, C_AK = 256, C_AV = 512, C_AO = 1024, C_AZ = 1536, C_AI = 2048, C_AF = 2052, C_BZ = 2056, C_BX = 2568, C_BB = 3080, C_BC = 3336,
              C_BDT = 3592, C_CQ = 3600, C_CK = 4112, C_CV = 4240, C_CZ = 4368;
constexpr float EPS = 1e-6f;
constexpr size_t O_YP = 0, O_YS = 16777216, O_PC = 16908288, O_PN = 17170432, O_PM = 17172480, O_PH = 17172512, O_PCONV = 17696800, O_PK = 17721376,
                 O_PV = 17852448, O_SC = 17983520, O_SN = 34760736, O_SM = 34891808, O_SH = 34893856, O_SCONV = 68448288, O_SK = 70021152, O_SV = 78409760;
constexpr size_t WS_BAR = 0;
constexpr size_t WS_PAR = 16384;
constexpr size_t WS_WIN = WS_PAR + 102400;
constexpr size_t WS_WOUT = WS_WIN + (size_t)4 * NIN * D * 2;
constexpr size_t WS_XB = WS_WOUT + (size_t)4 * D * DMIX * 2;
constexpr size_t WS_U = WS_XB + (size_t)MPAD * D * 2;
constexpr size_t WS_MIX = WS_U + (size_t)MPAD * NIN * 2;
constexpr size_t WS_SSQ = WS_MIX + (size_t)MPAD * DMIX * 2;
constexpr size_t WS_ROPE = WS_SSQ + (size_t)MPAD * 16 * 4;
constexpr size_t WS_MC = WS_ROPE + (size_t)8200 * 64 * 4;
constexpr size_t WS_MN = WS_MC + (size_t)8 * 128 * 8192 * 4;
constexpr size_t WS_ML = WS_MN + (size_t)8 * 128 * 64 * 4;
constexpr size_t WS_BL = WS_ML + 4096;
constexpr size_t WS_MS = WS_BL + 4096;
constexpr size_t WS_SA = WS_MS + 4096;
constexpr size_t WS_SH = WS_SA + 8192;
constexpr size_t WS_END = WS_SH + (size_t)16 * 128 * 8192 * 4;
constexpr int LDS_BYTES = 139264;
constexpr int NT = 512;

struct Args { const float* in[24]; float* out; unsigned char* ws; int ph_lo, ph_hi; };

__device__ __forceinline__ float bf2f(unsigned v) { return __uint_as_float(v << 16); }
__device__ __forceinline__ unsigned pk2(float lo, float hi) { f32x2 v = {lo, hi}; bf16x2_t b = __builtin_convertvector(v, bf16x2_t); return __builtin_bit_cast(unsigned, b); }
__device__ __forceinline__ unsigned f2bf(float f) { return pk2(f, 0.f) & 0xffffu; }
__device__ __forceinline__ void unpack8(u32x4 w, float (&f)[8]) {
#pragma unroll
    for (int i = 0; i < 4; ++i) { f[2 * i] = __uint_as_float(w[i] << 16); f[2 * i + 1] = __uint_as_float(w[i] & 0xffff0000u); }
}
__device__ __forceinline__ u32x4 pack8(const float (&f)[8]) { u32x4 w; w[0] = pk2(f[0], f[1]); w[1] = pk2(f[2], f[3]); w[2] = pk2(f[4], f[5]); w[3] = pk2(f[6], f[7]); return w; }
__device__ __forceinline__ u32x4 pack8v(f32x4 a, f32x4 b) { u32x4 w; w[0] = pk2(a[0], a[1]); w[1] = pk2(a[2], a[3]); w[2] = pk2(b[0], b[1]); w[3] = pk2(b[2], b[3]); return w; }
__device__ __forceinline__ bf16x8 as_frag(u32x4 w) { return __builtin_bit_cast(bf16x8, w); }
__device__ __forceinline__ bf16x8 ldg_f32_frag(const float* p) { f32x4 a = *(const f32x4*)p, b = *(const f32x4*)(p + 4); return as_frag(pack8v(a, b)); }
__device__ __forceinline__ bf16x8 lds_frag(lptr base, int row, int k, int stride) { return *(const LAS bf16x8*)(base + ((row * stride + k) << 1)); }
__device__ __forceinline__ f32x4 mfma16(bf16x8 a, bf16x8 b, f32x4 c) { return __builtin_amdgcn_mfma_f32_16x16x32_bf16(a, b, c, 0, 0, 0); }
__device__ __forceinline__ float sigmoidf_(float x) { return 1.f / (1.f + __expf(-x)); }
__device__ __forceinline__ float siluf_(float x) { return x / (1.f + __expf(-x)); }
__device__ __forceinline__ float softplusf_(float x) { return x > 20.f ? x : log1pf(__expf(x)); }
__device__ __forceinline__ float logsigf_(float x) { return fminf(x, 0.f) - log1pf(__expf(-fabsf(x))); }
__device__ __forceinline__ float wave_scan_sum(float v, int lane) {
#pragma unroll
    for (int o = 1; o < 64; o <<= 1) { float t = __shfl_up(v, o); if (lane >= o) v += t; }
    return v;
}
__device__ __forceinline__ float wave_scan_max(float v, int lane) {
#pragma unroll
    for (int o = 1; o < 64; o <<= 1) { float t = __shfl_up(v, o); if (lane >= o) v = fmaxf(v, t); }
    return v;
}
__device__ __forceinline__ float wave_sum(float v) {
#pragma unroll
    for (int o = 1; o < 64; o <<= 1) v += __shfl_xor(v, o);
    return v;
}
__device__ __forceinline__ float wave_max(float v) {
#pragma unroll
    for (int o = 1; o < 64; o <<= 1) v = fmaxf(v, __shfl_xor(v, o));
    return v;
}
__device__ __forceinline__ float red16(float v) { v += __shfl_xor(v, 1); v += __shfl_xor(v, 2); v += __shfl_xor(v, 4); v += __shfl_xor(v, 8); return v; }
__device__ __forceinline__ float red16max(float v) { v = fmaxf(v, __shfl_xor(v, 1)); v = fmaxf(v, __shfl_xor(v, 2)); v = fmaxf(v, __shfl_xor(v, 4)); v = fmaxf(v, __shfl_xor(v, 8)); return v; }
__device__ __forceinline__ int OPQ(int v) { asm volatile("" : "+v"(v)); return v; }
#define LDS_FENCE() asm volatile("s_waitcnt lgkmcnt(0)" ::: "memory")

namespace pg8 {
constexpr int BM = 256, BK = 64, HALF = 128, HTB = HALF * BK * 2, STAGE_BYTES = 8 * HTB, NXCD = 8, WGM = 8;
__host__ __device__ __forceinline__ int lds_byte(int r, int c) { const int st = (r >> 4) * 2 + (c >> 5), rr = r & 15, cc = c & 31, ob = rr * 64 + cc * 2; return st * 1024 + (ob ^ (((ob >> 9) & 1) << 5)); }
__host__ __device__ __forceinline__ void stage_rc(int b, int& R, int& C) { const int st = b / 1024, sb = b % 1024, swz = sb ^ (((sb >> 9) & 1) << 5); R = (st >> 1) * 16 + swz / 64; C = (st & 1) * 32 + (swz % 64) / 2; }
__host__ __device__ __forceinline__ int perm32(int rho) { const int n = rho >> 4, i = rho & 15; return 8 * (i >> 2) + 4 * n + (i & 3); }
struct Unit { int pm, pn; };
struct Gemm { const bf16_t* A; const bf16_t* Bt; int M, N, K; };
struct StaticOrder {
    int nM, nN, nwg, G, c;
    __device__ void init(int M, int N, int G_, int c_) { nM = M / BM; nN = N / BM; nwg = nM * nN; G = G_; c = c_; }
    __device__ bool next(int i, Unit& u) const {
        const long L = (long)i * G + c; if (L >= nwg) return false;
        int wgid = (int)L; { const int q = nwg / NXCD, r = nwg % NXCD, xcd = wgid % NXCD, off = wgid / NXCD; wgid = (xcd < r ? xcd * (q + 1) : r * (q + 1) + (xcd - r) * q) + off; }
        const int nig = WGM * nN, gid = wgid / nig, fm = gid * WGM, gsz = (nM - fm) < WGM ? (nM - fm) : WGM;
        u.pm = fm + ((wgid % nig) % gsz); u.pn = (wgid % nig) / gsz; return true;
    }
};
struct EpiU {
    bf16_t* U; const float* ssq;
    __device__ __forceinline__ void operator()(const f32x4 (&acc)[2][2][4][2], const Unit& u, int wr, int wc, int fr, int fq) const {
        const int row0 = u.pm * BM + wr * 64 + fr, col0 = u.pn * BM + wc * 32 + 8 * fq;
#pragma unroll
        for (int ai = 0; ai < 2; ++ai)
#pragma unroll
            for (int m = 0; m < 4; ++m) {
                const int r = row0 + ai * HALF + m * 16;
                const f32x4 s = *(const f32x4*)(ssq + (size_t)r * 16 + fq * 4);
                float st = s[0] + s[1] + s[2] + s[3]; st += __shfl_xor(st, 16); st += __shfl_xor(st, 32);
                const float rs = rsqrtf(st * (1.f / 1024.f) + EPS);
                bf16_t* rowp = U + (size_t)r * NIN + col0;
#pragma unroll
                for (int bj = 0; bj < 2; ++bj) *(u32x4*)(rowp + bj * HALF) = pack8v(acc[ai][bj][m][0] * rs, acc[ai][bj][m][1] * rs);
                __builtin_amdgcn_sched_barrier(0);
            }
    }
};
struct EpiRes {
    const float* xp; const float* xs; float* out; bf16_t* xb; float* ssq;
    __device__ __forceinline__ void operator()(const f32x4 (&acc)[2][2][4][2], const Unit& u, int wr, int wc, int fr, int fq) const {
        const int row0 = u.pm * BM + wr * 64 + fr, col0 = u.pn * BM + wc * 32 + 8 * fq;
#pragma unroll
        for (int ai = 0; ai < 2; ++ai)
#pragma unroll
            for (int m = 0; m < 4; ++m) {
                const int r = row0 + ai * HALF + m * 16;
                const bool valid = r < MTOK;
                const float* src = xp ? (r < TP ? xp + (size_t)r * D : xs + (size_t)(r - TP) * D) : out + (size_t)r * D;
                float part = 0.f;
#pragma unroll
                for (int bj = 0; bj < 2; ++bj) {
                    const int c = col0 + bj * HALF;
                    f32x4 o0 = {0.f, 0.f, 0.f, 0.f}, o1 = {0.f, 0.f, 0.f, 0.f};
                    if (valid) { o0 = *(const f32x4*)(src + c); o1 = *(const f32x4*)(src + c + 4); }
                    const f32x4 v0 = acc[ai][bj][m][0] + o0, v1 = acc[ai][bj][m][1] + o1;
                    if (valid) { *(f32x4*)(out + (size_t)r * D + c) = v0; *(f32x4*)(out + (size_t)r * D + c + 4) = v1; }
                    *(u32x4*)(xb + (size_t)r * D + c) = pack8v(v0, v1);
                    part += v0[0] * v0[0] + v0[1] * v0[1] + v0[2] * v0[2] + v0[3] * v0[3] + v1[0] * v1[0] + v1[1] * v1[1] + v1[2] * v1[2] + v1[3] * v1[3];
                }
                part += __shfl_xor(part, 16); part += __shfl_xor(part, 32);
                if (fq == 0) ssq[(size_t)r * 16 + u.pn * 4 + wc] = part;
                __builtin_amdgcn_sched_barrier(0);
            }
    }
};

template <class Epi>
__device__ __forceinline__ void gemm_phase(lptr lds, const Gemm g, const StaticOrder& S, const Epi& E, const int tid) {
    const int wid = __builtin_amdgcn_readfirstlane(tid >> 6), lane = tid & 63, wr = wid >> 2, wc = wid & 3, fr = lane & 15, fq = lane >> 4;
    const int K = g.K, nt = K / BK;
    unsigned voffA[2], voffB[2];
#pragma unroll
    for (int i = 0; i < 2; ++i) { int R, C; stage_rc(tid * 16 + i * 8192, R, C); const int Rb = (R & ~31) + perm32(R & 31);
        voffA[i] = (unsigned)(R * K + C) * 2u; voffB[i] = (unsigned)(Rb * K + C) * 2u; }
    const size_t kstep = (size_t)(BK * 2);
    const size_t hstep = (size_t)HALF * K * 2;
    const size_t tstep = 2 * hstep;
    const unsigned ldsw = (unsigned)wid * 1024u;
    const int aoff = lds_byte(wr * 64 + fr, fq * 8), boff = lds_byte(wc * 32 + fr, fq * 8);
#define PG8_SA(b, h) (((b) * 2 + (h)) * HTB)
#define PG8_SB(b, h) ((4 + (b) * 2 + (h)) * HTB)
#define PG8_STAGE(bufoff, gbase, voff) do { _Pragma("unroll") for (int _i = 0; _i < 2; ++_i) \
        __builtin_amdgcn_global_load_lds((const unsigned*)((const char*)(gbase) + (voff)[_i]), (LAS unsigned*)(lds + (bufoff) + ldsw + _i * 8192), 16, 0, 0); } while (0)
#define PG8_LDA(dst, b, h) do { _Pragma("unroll") for (int m = 0; m < 4; ++m) _Pragma("unroll") for (int k = 0; k < 2; ++k) dst[m][k] = *(const LAS bf16x8*)(lds + PG8_SA(b, h) + aoff + m * 2048 + k * 1024); } while (0)
#define PG8_LDB(dst, b, h) do { _Pragma("unroll") for (int n = 0; n < 2; ++n) _Pragma("unroll") for (int k = 0; k < 2; ++k) dst[n][k] = *(const LAS bf16x8*)(lds + PG8_SB(b, h) + boff + n * 2048 + k * 1024); } while (0)
#define PG8_MMA(ai, bj, At, Bt) do { __builtin_amdgcn_s_setprio(1); _Pragma("unroll") for (int m = 0; m < 4; ++m) _Pragma("unroll") for (int n = 0; n < 2; ++n) _Pragma("unroll") for (int k = 0; k < 2; ++k) \
        acc[ai][bj][m][n] = __builtin_amdgcn_mfma_f32_16x16x32_bf16(Bt[n][k], At[m][k], acc[ai][bj][m][n], 0, 0, 0); __builtin_amdgcn_s_setprio(0); } while (0)
#define PG8_WAIT_V(n) asm volatile("s_waitcnt vmcnt(" #n ")" ::: "memory")
#define PG8_WAIT_L(n) asm volatile("s_waitcnt lgkmcnt(" #n ")" ::: "memory")
#define PG8_BAR __builtin_amdgcn_s_barrier()
#define PG8_SCHED __builtin_amdgcn_sched_barrier(0)
    Unit cur, nxt; int ui = 0;
    if (!S.next(0, cur)) return;
    f32x4 acc[2][2][4][2];
#pragma unroll
    for (int a = 0; a < 2; ++a)
#pragma unroll
        for (int b = 0; b < 2; ++b)
#pragma unroll
            for (int m = 0; m < 4; ++m)
#pragma unroll
                for (int n = 0; n < 2; ++n) acc[a][b][m][n] = (f32x4){0.f, 0.f, 0.f, 0.f};
    bf16x8 At[4][2], B0[2][2], B1[2][2];
    const char* cA = (const char*)g.A + (size_t)cur.pm * tstep; const char* cB = (const char*)g.Bt + (size_t)cur.pn * tstep;
    PG8_STAGE(PG8_SB(0, 0), cB, voffB); PG8_STAGE(PG8_SA(0, 0), cA, voffA); PG8_STAGE(PG8_SB(0, 1), cB + hstep, voffB); PG8_STAGE(PG8_SA(0, 1), cA + hstep, voffA);
    if (wr == 1) PG8_BAR;
    PG8_WAIT_V(4); PG8_BAR;
    PG8_STAGE(PG8_SB(1, 0), cB + kstep, voffB); PG8_STAGE(PG8_SA(1, 0), cA + kstep, voffA); PG8_STAGE(PG8_SB(1, 1), cB + hstep + kstep, voffB);
    PG8_WAIT_V(6); PG8_BAR;
    for (;;) {
        const bool has_next = S.next(ui + 1, nxt);
        const char* nA = has_next ? (const char*)g.A + (size_t)nxt.pm * tstep : cA; const char* nB = has_next ? (const char*)g.Bt + (size_t)nxt.pn * tstep : cB;
        for (int t = 0; t < nt; t += 2) {
            const bool last = (t == nt - 2);
            const char* a1 = cA + (size_t)(t + 1) * kstep;
            const char* a2 = last ? nA : cA + (size_t)(t + 2) * kstep; const char* b2 = last ? nB : cB + (size_t)(t + 2) * kstep;
            const char* a3 = a2 + kstep; const char* b3 = b2 + kstep;
            PG8_LDB(B0, 0, 0); PG8_SCHED; PG8_LDA(At, 0, 0); PG8_STAGE(PG8_SA(1, 1), a1 + hstep, voffA);
            PG8_WAIT_L(8); PG8_BAR; PG8_WAIT_L(0); PG8_MMA(0, 0, At, B0); PG8_BAR; PG8_SCHED;
            PG8_LDB(B1, 0, 1); PG8_STAGE(PG8_SB(0, 0), b2, voffB);
            PG8_BAR; PG8_WAIT_L(0); PG8_MMA(0, 1, At, B1); PG8_BAR;
            PG8_LDA(At, 0, 1); PG8_STAGE(PG8_SA(0, 0), a2, voffA);
            PG8_BAR; PG8_WAIT_L(0); PG8_MMA(1, 0, At, B0); PG8_BAR; PG8_SCHED;
            PG8_STAGE(PG8_SB(0, 1), b2 + hstep, voffB);
            PG8_WAIT_V(6); PG8_BAR; PG8_MMA(1, 1, At, B1); PG8_BAR;
            PG8_LDB(B0, 1, 0); PG8_SCHED; PG8_LDA(At, 1, 0); PG8_STAGE(PG8_SA(0, 1), a2 + hstep, voffA);
            PG8_WAIT_L(8); PG8_BAR; PG8_WAIT_L(0); PG8_MMA(0, 0, At, B0); PG8_BAR; PG8_SCHED;
            PG8_LDB(B1, 1, 1); PG8_STAGE(PG8_SB(1, 0), b3, voffB);
            PG8_BAR; PG8_WAIT_L(0); PG8_MMA(0, 1, At, B1); PG8_BAR;
            PG8_LDA(At, 1, 1); PG8_STAGE(PG8_SA(1, 0), a3, voffA);
            PG8_BAR; PG8_WAIT_L(0); PG8_MMA(1, 0, At, B0); PG8_BAR; PG8_SCHED;
            PG8_STAGE(PG8_SB(1, 1), b3 + hstep, voffB);
            PG8_WAIT_V(6); PG8_BAR; PG8_MMA(1, 1, At, B1); PG8_BAR;
        }
        E(acc, cur, wr, wc, fr, fq);
        if (!has_next) break;
#pragma unroll
        for (int a = 0; a < 2; ++a)
#pragma unroll
            for (int b = 0; b < 2; ++b)
#pragma unroll
                for (int m = 0; m < 4; ++m)
#pragma unroll
                    for (int n = 0; n < 2; ++n) acc[a][b][m][n] = (f32x4){0.f, 0.f, 0.f, 0.f};
        cur = nxt; cA = nA; cB = nB; ++ui;
    }
    PG8_WAIT_V(0);
    if (wr == 0) PG8_BAR;
    PG8_BAR;
#undef PG8_SA
#undef PG8_SB
#undef PG8_STAGE
#undef PG8_LDA
#undef PG8_LDB
#undef PG8_MMA
#undef PG8_WAIT_V
#undef PG8_WAIT_L
#undef PG8_BAR
#undef PG8_SCHED
}
}

struct Ctx {
    const float* xp; const float* xs; const float* stC; const float* stN; const float* stM; const float* ssm; const float* conv; const float* ck; const float* cv;
    float* out; unsigned char* ws;
};
#define XWIN ((bf16_t*)(X.ws + WS_WIN))
#define XWOUT ((bf16_t*)(X.ws + WS_WOUT))
#define XXB ((bf16_t*)(X.ws + WS_XB))
#define XU ((bf16_t*)(X.ws + WS_U))
#define XMIX ((bf16_t*)(X.ws + WS_MIX))
#define XSSQ ((float*)(X.ws + WS_SSQ))
#define XROPE ((float*)(X.ws + WS_ROPE))
#define XMC ((float*)(X.ws + WS_MC))
#define XMN ((float*)(X.ws + WS_MN))
#define XML ((float*)(X.ws + WS_ML))
#define XBL ((float*)(X.ws + WS_BL))
#define XMS ((float*)(X.ws + WS_MS))
#define XSA ((float*)(X.ws + WS_SA))
#define XSH ((float*)(X.ws + WS_SH))
#define XPAR(off) ((const float*)(X.ws + WS_PAR) + (off))
constexpr int P_AIB = 0, P_AFB = 16, P_DTB = 32, P_ALOG = 64, P_BD = 96, P_SINK = 128, P_QNW = 160, P_KNW = 416, P_ANW = 672, P_BNW = 2720, P_CB = 4768, P_CW = 8864, P_END = 25248;
#define IN_XP 0
#define IN_XS 1
#define IN_STC 2
#define IN_STN 3
#define IN_STM 4
#define IN_SSM 5
#define IN_CONV 6
#define IN_CK 7
#define IN_CV 8
#define IN_NORMW 9
#define IN_WIN 10
#define IN_AIB 11
#define IN_AFB 12
#define IN_ANW 13
#define IN_CW 14
#define IN_CB 15
#define IN_DTB 16
#define IN_ALOG 17
#define IN_BD 18
#define IN_BNW 19
#define IN_QNW 20
#define IN_KNW 21
#define IN_SINK 22
#define IN_WOUT 23

__device__ __forceinline__ void transpose_tile(lptr lds, const float* src, int ldn, int nvalid, bf16_t* dst, int ldk, const float* scale, int k0, int n0, int tid) {
    LAS float* T = (LAS float*)lds;
#pragma unroll
    for (int it = 0; it < 2; ++it) {
        const int r = (tid >> 4) + it * 32, c4 = (tid & 15) * 4, n = n0 + c4;
        f32x4 v = {0.f, 0.f, 0.f, 0.f};
        if (n < nvalid) v = *(const f32x4*)(src + (size_t)(k0 + r) * ldn + n);
        const float sc = scale ? scale[k0 + r] : 1.f;
        T[r * 65 + c4 + 0] = v[0] * sc; T[r * 65 + c4 + 1] = v[1] * sc; T[r * 65 + c4 + 2] = v[2] * sc; T[r * 65 + c4 + 3] = v[3] * sc;
    }
    __syncthreads();
    {
        const int n = tid >> 3, k8 = (tid & 7) * 8; float f[8];
#pragma unroll
        for (int j = 0; j < 8; ++j) f[j] = T[(k8 + j) * 65 + n];
        *(u32x4*)(dst + (size_t)(n0 + n) * ldk + k0 + k8) = pack8(f);
    }
    __syncthreads();
}

__device__ __forceinline__ void prologue(lptr lds, const Ctx& X, const Args& args, int G, int bid, int tid) {
    const int lane = tid & 63, wave = tid >> 6;
    constexpr int T0 = 5120, T1 = T0 + 1536, T2 = T1 + 2080, T3 = T2 + 1, T4 = T3 + 513;
    for (int task = bid; task < T4; task += G) {
        if (task < T0) {
            const int l = task / 1280, r = task % 1280, kt = r / 80, ntl = r % 80;
            transpose_tile(lds, args.in[IN_WIN] + (size_t)l * D * DIN, DIN, DIN, XWIN + (size_t)l * NIN * D, D, args.in[IN_NORMW] + l * D, kt * 64, ntl * 64, tid);
        } else if (task < T1) {
            const int t = task - T0, l = t / 384, r = t % 384, kt = r / 16, ntl = r % 16;
            transpose_tile(lds, args.in[IN_WOUT] + (size_t)l * DMIX * D, D, D, XWOUT + (size_t)l * D * DMIX, DMIX, nullptr, kt * 64, ntl * 64, tid);
        } else if (task < T2) {
            const int r = (task - T1) * 8 + wave;
            float ss = 0.f;
            if (r < MTOK) {
                const float* src = r < TP ? X.xp + (size_t)r * D : X.xs + (size_t)(r - TP) * D;
#pragma unroll
                for (int i = 0; i < 4; ++i) {
                    const int c = lane * 4 + i * 256; f32x4 v = *(const f32x4*)(src + c);
                    ss += v[0] * v[0] + v[1] * v[1] + v[2] * v[2] + v[3] * v[3];
                    u32x2 w; w[0] = pk2(v[0], v[1]); w[1] = pk2(v[2], v[3]);
                    *(u32x2*)(XXB + (size_t)r * D + c) = w;
                }
            } else {
#pragma unroll
                for (int i = 0; i < 4; ++i) { u32x2 w = {0u, 0u}; *(u32x2*)(XXB + (size_t)r * D + lane * 4 + i * 256) = w; }
            }
            ss = wave_sum(ss);
            if (lane < 16) XSSQ[(size_t)r * 16 + lane] = (lane == 0) ? ss : 0.f;
        } else if (task < T3) {
            for (int i = tid; i < (MPAD - MTOK) * DMIX / 2; i += NT) ((unsigned*)(XMIX + (size_t)MTOK * DMIX))[i] = 0u;
            float* P = (float*)(X.ws + WS_PAR);
            const int po[12] = {P_AIB, P_AFB, P_DTB, P_ALOG, P_BD, P_SINK, P_QNW, P_KNW, P_ANW, P_BNW, P_CB, P_CW};
            const int pn[12] = {16, 16, 32, 32, 32, 32, 256, 256, 2048, 2048, 4096, 16384};
            const int pi[12] = {IN_AIB, IN_AFB, IN_DTB, IN_ALOG, IN_BD, IN_SINK, IN_QNW, IN_KNW, IN_ANW, IN_BNW, IN_CB, IN_CW};
#pragma unroll
            for (int a = 0; a < 12; ++a) { const float* src = args.in[pi[a]]; for (int i = tid; i < pn[a]; i += NT) P[po[a] + i] = src[i]; }
        } else {
            const int e = (task - T3) * 512 + tid;
            if (e < 8193 * 32) {
                const int pos = e >> 5, d = e & 31;
                const float inv = (float)exp2(-(double)d * (13.287712379549449 / 32.0));
                const float angf = (float)pos * inv;
                const double a = (double)angf;
                const double k = rint(a * 0.15915494309189535);
                const float rr = (float)(a - k * 6.283185307179586);
                XROPE[(size_t)e * 2] = cosf(rr); XROPE[(size_t)e * 2 + 1] = sinf(rr);
            }
        }
    }
}

__device__ __forceinline__ void conv8(const bf16_t* u, int seq0, int tt, int ch, const float* cw, const float* cb, float (&o)[8]) {
    float acc[8];
    { f32x4 b0 = *(const f32x4*)(cb + ch), b1 = *(const f32x4*)(cb + ch + 4);
#pragma unroll
      for (int j = 0; j < 4; ++j) { acc[j] = b0[j]; acc[4 + j] = b1[j]; } }
#pragma unroll
    for (int jj = 0; jj < 4; ++jj) {
        const int t2 = tt + jj - 3;
        if (t2 >= 0) {
            float x[8]; unpack8(*(const u32x4*)(u + (size_t)(seq0 + t2) * NIN + C_BX + ch), x);
            f32x4 w0 = *(const f32x4*)(cw + jj * 1024 + ch), w1 = *(const f32x4*)(cw + jj * 1024 + ch + 4);
#pragma unroll
            for (int j = 0; j < 4; ++j) { acc[j] += x[j] * w0[j]; acc[4 + j] += x[4 + j] * w1[j]; }
        }
    }
#pragma unroll
    for (int j = 0; j < 8; ++j) o[j] = siluf_(acc[j]);
}

__device__ __forceinline__ void mlstm_local(lptr lds, const Ctx& X, int l, int task, int tid) {
    const int h = task & 3, c = (task >> 2) & 127, n = task >> 9;
    const int lane = tid & 63, wave = tid >> 6, fr = lane & 15, fq = lane >> 4;
    const int row0 = n * SEQ + c * 64, nh = n * 4 + h;
    lptr VwT = lds;
    lptr KT = lds + 18432;
    LAS float* wv = (LAS float*)(lds + 27648);
    if (wave == 0) {
        const bf16_t* ur = XU + (size_t)(row0 + lane) * NIN;
        const float fg = bf2f(ur[C_AF + h]) + XPAR(P_AFB)[l * 4 + h], ig = bf2f(ur[C_AI + h]) + XPAR(P_AIB)[l * 4 + h];
        const float b = wave_scan_sum(logsigf_(fg), lane);
        const float bl = __shfl(b, 63);
        const float g = bl - b + ig;
        const float ml = wave_max(g);
        wv[lane] = __expf(g - ml);
        if (lane == 0) { XML[nh * 128 + c] = ml; XBL[nh * 128 + c] = bl; }
    }
    __syncthreads();
#pragma unroll
    for (int it = 0; it < 2; ++it) {
        const int p = tid + it * NT, tok = p >> 4, v8 = (p & 15) * 8;
        float x[8]; unpack8(*(const u32x4*)(XU + (size_t)(row0 + tok) * NIN + C_AV + h * 128 + v8), x);
        const float w = wv[tok];
#pragma unroll
        for (int j = 0; j < 8; ++j) *(LAS bf16_t*)(VwT + (((v8 + j) * 72 + tok) << 1)) = (bf16_t)f2bf(x[j] * w);
    }
    {
        const int tok = tid >> 3, k8 = (tid & 7) * 8;
        float x[8]; unpack8(*(const u32x4*)(XU + (size_t)(row0 + tok) * NIN + C_AK + h * 64 + k8), x);
#pragma unroll
        for (int j = 0; j < 8; ++j) *(LAS bf16_t*)(KT + (((k8 + j) * 72 + tok) << 1)) = (bf16_t)f2bf(x[j] * 0.125f);
    }
    __syncthreads();
    {
        float* dst = XMC + ((size_t)nh * 128 + c) * 8192;
        bf16x8 b0 = lds_frag(VwT, 16 * wave + fr, fq * 8, 72), b1 = lds_frag(VwT, 16 * wave + fr, 32 + fq * 8, 72);
#pragma unroll
        for (int mt = 0; mt < 4; ++mt) {
            f32x4 acc = {0.f, 0.f, 0.f, 0.f};
            acc = mfma16(lds_frag(KT, 16 * mt + fr, fq * 8, 72), b0, acc);
            acc = mfma16(lds_frag(KT, 16 * mt + fr, 32 + fq * 8, 72), b1, acc);
            *(f32x4*)(dst + (16 * wave + fr) * 64 + 16 * mt + 4 * fq) = acc;
        }
    }
    if (tid < 64) {
        float s = 0.f;
#pragma unroll 8
        for (int t = 0; t < 64; ++t) s += bf2f(*(const LAS bf16_t*)(KT + ((tid * 72 + t) << 1))) * wv[t];
        XMN[((size_t)nh * 128 + c) * 64 + tid] = s;
    }
    __syncthreads();
}

__device__ __forceinline__ void ssd_local(lptr lds, const Ctx& X, int l, int task, int tid) {
    const int g = task & 1, c = (task >> 1) & 127, n = task >> 8;
    const int lane = tid & 63, wave = tid >> 6, fr = lane & 15, fq = lane >> 4;
    const int seq0 = n * SEQ, row0 = seq0 + c * 64;
    lptr XwT = lds;
    lptr BT = lds + 36864;
    LAS float* wl = (LAS float*)(lds + 55296);
    if (wave < 4) {
        const int hh = 4 * g + wave;
        const float dt = softplusf_(bf2f(XU[(size_t)(row0 + lane) * NIN + C_BDT + hh]) + XPAR(P_DTB)[l * 8 + hh]);
        const float A = -__expf(XPAR(P_ALOG)[l * 8 + hh]);
        const float a = wave_scan_sum(dt * A, lane);
        const float aL = __shfl(a, 63);
        wl[wave * 64 + lane] = __expf(aL - a) * dt;
        if (lane == 0) XSA[(n * 8 + hh) * 128 + c] = aL;
    }
    __syncthreads();
    const float* cw = XPAR(P_CW) + l * 4096; const float* cb = XPAR(P_CB) + l * 1024;
#pragma unroll 1
    for (int it = 0; it < 6; ++it) {
        const int item = tid + it * NT;
        float o[8];
        if (item < 2048) {
            const int t = item >> 5, j8 = (item & 31) * 8;
            conv8(XU, seq0, c * 64 + t, g * 256 + j8, cw, cb, o);
            const float w = wl[(j8 >> 6) * 64 + t];
#pragma unroll
            for (int j = 0; j < 8; ++j) *(LAS bf16_t*)(XwT + (((j8 + j) * 72 + t) << 1)) = (bf16_t)f2bf(o[j] * w);
        } else {
            const int i2 = item - 2048, t = i2 >> 4, s8 = (i2 & 15) * 8;
            conv8(XU, seq0, c * 64 + t, 512 + g * 128 + s8, cw, cb, o);
#pragma unroll
            for (int j = 0; j < 8; ++j) *(LAS bf16_t*)(BT + (((s8 + j) * 72 + t) << 1)) = (bf16_t)f2bf(o[j]);
        }
    }
    __syncthreads();
    {
        const int hl = wave >> 1, ph = wave & 1, hh = 4 * g + hl;
        float* dst = XSH + ((size_t)(n * 8 + hh) * 128 + c) * 8192;
        bf16x8 bx[2][2];
#pragma unroll
        for (int ntl = 0; ntl < 2; ++ntl)
#pragma unroll
            for (int kk = 0; kk < 2; ++kk) bx[ntl][kk] = lds_frag(XwT, hl * 64 + ph * 32 + ntl * 16 + fr, kk * 32 + fq * 8, 72);
#pragma unroll
        for (int mt = 0; mt < 8; ++mt) {
            bf16x8 a0 = lds_frag(BT, 16 * mt + fr, fq * 8, 72), a1 = lds_frag(BT, 16 * mt + fr, 32 + fq * 8, 72);
#pragma unroll
            for (int ntl = 0; ntl < 2; ++ntl) {
                f32x4 acc = {0.f, 0.f, 0.f, 0.f};
                acc = mfma16(a0, bx[ntl][0], acc); acc = mfma16(a1, bx[ntl][1], acc);
                *(f32x4*)(dst + (ph * 32 + ntl * 16 + fr) * 128 + 16 * mt + 4 * fq) = acc;
            }
        }
    }
    __syncthreads();
}

__device__ __forceinline__ void swa_prompt(lptr lds, const Ctx& X, int l, int task, int tid) {
    const int kvh = task & 1, qb = (task >> 1) & 63, n = task >> 7;
    const int lane = tid & 63, wave = tid >> 6, fr = lane & 15, fq = lane >> 4;
    const int seq0 = n * SEQ;
    lptr Kn = lds;
    lptr Vt = lds + 36864;
    lptr Pw = lds + 70656 + wave * 8448;
    const float* knw = XPAR(P_KNW) + l * 64; const float* qnw = XPAR(P_QNW) + l * 64;
#pragma unroll
    for (int it = 0; it < 2; ++it) {
        const int item = tid + it * NT, j = item >> 2, qd = item & 3, t = qb * 128 - 128 + j;
        float o1[8], o2[8];
        if (t >= 0) {
            const bf16_t* kr = XU + (size_t)(seq0 + t) * NIN + C_CK + kvh * 64;
            float x1[8], x2[8]; unpack8(*(const u32x4*)(kr + qd * 8), x1); unpack8(*(const u32x4*)(kr + 32 + qd * 8), x2);
            float ss = 0.f;
#pragma unroll
            for (int jj = 0; jj < 8; ++jj) ss += x1[jj] * x1[jj] + x2[jj] * x2[jj];
            ss += __shfl_xor(ss, 1); ss += __shfl_xor(ss, 2);
            const float rs = rsqrtf(ss * (1.f / 64.f) + EPS);
            const float* cs = XROPE + ((size_t)t * 32 + qd * 8) * 2;
#pragma unroll
            for (int jj = 0; jj < 8; ++jj) {
                const float a = x1[jj] * rs * knw[qd * 8 + jj], b = x2[jj] * rs * knw[32 + qd * 8 + jj], co = cs[2 * jj], si = cs[2 * jj + 1];
                o1[jj] = a * co - b * si; o2[jj] = b * co + a * si;
            }
        } else {
#pragma unroll
            for (int jj = 0; jj < 8; ++jj) { o1[jj] = 0.f; o2[jj] = 0.f; }
        }
        *(LAS u32x4*)(Kn + ((j * 72 + qd * 8) << 1)) = pack8(o1);
        *(LAS u32x4*)(Kn + ((j * 72 + 32 + qd * 8) << 1)) = pack8(o2);
        if (qb == 63 && j >= 128) {
            float* ko = X.out + O_PK + ((((size_t)l * 2 + n) * 128 + (j - 128)) * 2 + kvh) * 64;
            *(f32x4*)(ko + qd * 8) = (f32x4){o1[0], o1[1], o1[2], o1[3]}; *(f32x4*)(ko + qd * 8 + 4) = (f32x4){o1[4], o1[5], o1[6], o1[7]};
            *(f32x4*)(ko + 32 + qd * 8) = (f32x4){o2[0], o2[1], o2[2], o2[3]}; *(f32x4*)(ko + 32 + qd * 8 + 4) = (f32x4){o2[4], o2[5], o2[6], o2[7]};
        }
    }
#pragma unroll
    for (int it = 0; it < 4; ++it) {
        const int item = tid + it * NT, j = item >> 3, d8 = (item & 7) * 8, t = qb * 128 - 128 + j;
        u32x4 w = {0u, 0u, 0u, 0u};
        if (t >= 0) w = *(const u32x4*)(XU + (size_t)(seq0 + t) * NIN + C_CV + kvh * 64 + d8);
#pragma unroll
        for (int jj = 0; jj < 8; ++jj) *(LAS bf16_t*)(Vt + (((d8 + jj) * 264 + j) << 1)) = (bf16_t)((w[jj >> 1] >> ((jj & 1) * 16)) & 0xffffu);
        if (qb == 63 && j >= 128) {
            float x[8]; unpack8(w, x);
            float* vo = X.out + O_PV + ((((size_t)l * 2 + n) * 128 + (j - 128)) * 2 + kvh) * 64 + d8;
            *(f32x4*)(vo) = (f32x4){x[0], x[1], x[2], x[3]}; *(f32x4*)(vo + 4) = (f32x4){x[4], x[5], x[6], x[7]};
        }
    }
    __syncthreads();
    const int hq = kvh * 4 + (wave >> 1), i0 = (wave & 1) * 64;
    const float sink = XPAR(P_SINK)[l * 8 + hq];
#pragma unroll 1
    for (int mt = 0; mt < 4; ++mt) {
        bf16x8 a0, a1;
        {
            const int i = i0 + mt * 16 + fr, t = qb * 128 + i;
            const bf16_t* qr = XU + (size_t)(seq0 + t) * NIN + C_CQ + hq * 64;
            float x1[8], x2[8]; unpack8(*(const u32x4*)(qr + fq * 8), x1); unpack8(*(const u32x4*)(qr + 32 + fq * 8), x2);
            float ss = 0.f;
#pragma unroll
            for (int jj = 0; jj < 8; ++jj) ss += x1[jj] * x1[jj] + x2[jj] * x2[jj];
            ss += __shfl_xor(ss, 16); ss += __shfl_xor(ss, 32);
            const float rs = rsqrtf(ss * (1.f / 64.f) + EPS) * 0.125f;
            const float* cs = XROPE + ((size_t)t * 32 + fq * 8) * 2;
            float o1[8], o2[8];
#pragma unroll
            for (int jj = 0; jj < 8; ++jj) {
                const float a = x1[jj] * rs * qnw[fq * 8 + jj], b = x2[jj] * rs * qnw[32 + fq * 8 + jj], co = cs[2 * jj], si = cs[2 * jj + 1];
                o1[jj] = a * co - b * si; o2[jj] = b * co + a * si;
            }
            a0 = as_frag(pack8(o1)); a1 = as_frag(pack8(o2));
        }
        f32x4 s[16];
#pragma unroll
        for (int ntl = 0; ntl < 16; ++ntl) {
            f32x4 acc = {0.f, 0.f, 0.f, 0.f};
            acc = mfma16(a0, lds_frag(Kn, 16 * ntl + fr, fq * 8, 72), acc);
            acc = mfma16(a1, lds_frag(Kn, 16 * ntl + fr, 32 + fq * 8, 72), acc);
            s[ntl] = acc;
        }
        float mx[4] = {-3.0e38f, -3.0e38f, -3.0e38f, -3.0e38f};
#pragma unroll
        for (int ntl = 0; ntl < 16; ++ntl)
#pragma unroll
            for (int ii = 0; ii < 4; ++ii) {
                const int qi = i0 + mt * 16 + fq * 4 + ii, j = 16 * ntl + fr;
                const bool valid = (j > qi) && (j <= qi + 128) && (qb > 0 || j >= 128);
                s[ntl][ii] = valid ? s[ntl][ii] : -3.0e38f;
                mx[ii] = fmaxf(mx[ii], s[ntl][ii]);
            }
        float sum[4];
#pragma unroll
        for (int ii = 0; ii < 4; ++ii) { mx[ii] = fmaxf(red16max(mx[ii]), sink); sum[ii] = 0.f; }
#pragma unroll
        for (int ntl = 0; ntl < 16; ++ntl)
#pragma unroll
            for (int ii = 0; ii < 4; ++ii) { const float e = (s[ntl][ii] > -1.0e38f) ? __expf(s[ntl][ii] - mx[ii]) : 0.f; s[ntl][ii] = e; sum[ii] += e; }
#pragma unroll
        for (int ii = 0; ii < 4; ++ii) sum[ii] = 1.f / (red16(sum[ii]) + __expf(sink - mx[ii]));
#pragma unroll
        for (int ntl = 0; ntl < 16; ++ntl)
#pragma unroll
            for (int ii = 0; ii < 4; ++ii) *(LAS bf16_t*)(Pw + (((fq * 4 + ii) * 264 + 16 * ntl + fr) << 1)) = (bf16_t)f2bf(s[ntl][ii] * sum[ii]);
        LDS_FENCE();
        f32x4 o[4];
#pragma unroll
        for (int ntl = 0; ntl < 4; ++ntl) o[ntl] = (f32x4){0.f, 0.f, 0.f, 0.f};
#pragma unroll
        for (int kk = 0; kk < 8; ++kk) {
            const bf16x8 a = lds_frag(Pw, fr, kk * 32 + fq * 8, 264);
#pragma unroll
            for (int ntl = 0; ntl < 4; ++ntl) o[ntl] = mfma16(a, lds_frag(Vt, 16 * ntl + fr, kk * 32 + fq * 8, 264), o[ntl]);
        }
        LDS_FENCE();
#pragma unroll
        for (int ii = 0; ii < 4; ++ii) {
            const size_t row = (size_t)seq0 + qb * 128 + i0 + mt * 16 + fq * 4 + ii;
#pragma unroll
            for (int ntl = 0; ntl < 4; ++ntl) {
                const int d = 16 * ntl + fr;
                const float cz = bf2f(XU[row * NIN + C_CZ + hq * 64 + d]);
                XMIX[row * DMIX + 1024 + hq * 64 + d] = (bf16_t)f2bf(o[ntl][ii] * siluf_(cz));
            }
        }
    }
    __syncthreads();
}

__device__ __forceinline__ void sample_task(lptr lds, const Ctx& X, int l, int b, int tid) {
    LAS float* uf = (LAS float*)lds;
    LAS float* xbc = (LAS float*)(lds + 19968);
    LAS float* numv = (LAS float*)(lds + 24064);
    LAS float* yv = (LAS float*)(lds + 26112);
    LAS float* red = (LAS float*)(lds + 28160);
    LAS float* qs = (LAS float*)(lds + 28416);
    LAS float* kn = (LAS float*)(lds + 30464);
    LAS float* sc = (LAS float*)(lds + 30976);
    const int lane = tid & 63, wave = tid >> 6;
    const size_t row = (size_t)TP + b;
    const bf16_t* ur = XU + row * NIN;
    const size_t lb = (size_t)l * 128 + b;
#pragma unroll 2
    for (int i = tid; i < DIN; i += NT) uf[i] = bf2f(ur[i]);
    __syncthreads();
#pragma unroll 1
    for (int h = 0; h < 4; ++h) {
        const float ig = uf[C_AI + h] + XPAR(P_AIB)[l * 4 + h], fg = uf[C_AF + h] + XPAR(P_AFB)[l * 4 + h];
        const float ls = logsigf_(fg), m0 = X.stM[lb * 4 + h];
        const float mn = fmaxf(ls + m0, ig), sp = __expf(ls + m0 - mn), sl = __expf(ig - mn);
        const float* C0 = X.stC + (lb * 4 + h) * 8192; float* C1 = X.out + O_SC + (lb * 4 + h) * 8192;
#pragma unroll
        for (int it = 0; it < 4; ++it) {
            const int e = (tid + it * NT) * 4, v = e >> 6, k = e & 63;
            const f32x4 c0 = *(const f32x4*)(C0 + e);
            const float vv = uf[C_AV + h * 128 + v] * sl;
            f32x4 c1; float part = 0.f;
#pragma unroll
            for (int j = 0; j < 4; ++j) { c1[j] = sp * c0[j] + vv * (uf[C_AK + h * 64 + k + j] * 0.125f); part += c1[j] * uf[C_AQ + h * 64 + k + j]; }
            *(f32x4*)(C1 + e) = c1;
            part = red16(part);
            if ((lane & 15) == 0) numv[h * 128 + v] = part;
        }
        if (wave == 0) {
            const float n1 = sp * X.stN[(lb * 4 + h) * 64 + lane] + sl * uf[C_AK + h * 64 + lane] * 0.125f;
            X.out[O_SN + (lb * 4 + h) * 64 + lane] = n1;
            const float dd = wave_sum(n1 * uf[C_AQ + h * 64 + lane]);
            if (lane == 0) { red[h] = dd; red[4 + h] = mn; X.out[O_SM + lb * 4 + h] = mn; }
        }
    }
    __syncthreads();
    float hv;
    { const int h = tid >> 7; hv = numv[tid] / fmaxf(fabsf(red[h]), __expf(-red[4 + h])); const float ss = wave_sum(hv * hv); if (lane == 0) red[8 + wave] = ss; }
    __syncthreads();
    { const int h = tid >> 7; const float rs = rsqrtf((red[8 + 2 * h] + red[9 + 2 * h]) * (1.f / 128.f) + EPS);
      XMIX[row * DMIX + tid] = (bf16_t)f2bf(hv * rs * XPAR(P_ANW)[l * 512 + tid] * sigmoidf_(uf[C_AO + tid]) * siluf_(uf[C_AZ + tid])); }
    {
        const float* buf = X.conv + lb * 3 * 1024; float* oc = X.out + O_SCONV + lb * 3 * 1024;
        const float* cw = XPAR(P_CW) + l * 4096;
#pragma unroll
        for (int it = 0; it < 2; ++it) {
            const int ch = tid + it * NT;
            const float f0 = buf[ch], f1 = buf[1024 + ch], f2 = buf[2048 + ch], f3 = uf[C_BX + ch];
            const float acc = XPAR(P_CB)[l * 1024 + ch] + f0 * cw[ch] + f1 * cw[1024 + ch] + f2 * cw[2048 + ch] + f3 * cw[3072 + ch];
            xbc[ch] = siluf_(acc);
            oc[ch] = f1; oc[1024 + ch] = f2; oc[2048 + ch] = f3;
        }
    }
    __syncthreads();
#pragma unroll 1
    for (int hh = 0; hh < 8; ++hh) {
        const float dt = softplusf_(uf[C_BDT + hh] + XPAR(P_DTB)[l * 8 + hh]);
        const float dA = __expf(-dt * __expf(XPAR(P_ALOG)[l * 8 + hh]));
        const int g = hh >> 2;
        const float* h0p = X.ssm + (lb * 8 + hh) * 8192; float* h1p = X.out + O_SH + (lb * 8 + hh) * 8192;
#pragma unroll
        for (int it = 0; it < 4; ++it) {
            const int e = (tid + it * NT) * 4, p = e >> 7, s = e & 127;
            const f32x4 h0 = *(const f32x4*)(h0p + e);
            const float xv = xbc[hh * 64 + p] * dt;
            f32x4 h1; float part = 0.f;
#pragma unroll
            for (int j = 0; j < 4; ++j) { h1[j] = dA * h0[j] + xv * xbc[512 + g * 128 + s + j]; part += h1[j] * xbc[768 + g * 128 + s + j]; }
            *(f32x4*)(h1p + e) = h1;
            part = red16(part); part += __shfl_xor(part, 16);
            if ((lane & 31) == 0) yv[hh * 64 + p] = part;
        }
    }
    __syncthreads();
    float gb;
    { const int hh = tid >> 6; const float y = yv[tid] + XPAR(P_BD)[l * 8 + hh] * xbc[tid]; gb = y * siluf_(uf[C_BZ + tid]); const float ss = wave_sum(gb * gb); if (lane == 0) red[16 + wave] = ss; }
    __syncthreads();
    { const int g = tid >> 8; const float rs = rsqrtf((red[16 + 4 * g] + red[17 + 4 * g] + red[18 + 4 * g] + red[19 + 4 * g]) * (1.f / 256.f) + EPS);
      XMIX[row * DMIX + 512 + tid] = (bf16_t)f2bf(gb * rs * XPAR(P_BNW)[l * 512 + tid]); }
    if (tid < 320) {
        const int vec = tid >> 5, d = tid & 31, base = vec < 8 ? C_CQ + vec * 64 : C_CK + (vec - 8) * 64;
        const float x1 = uf[base + d], x2 = uf[base + 32 + d];
        float ss = x1 * x1 + x2 * x2; ss = red16(ss); ss += __shfl_xor(ss, 16);
        const float rs = rsqrtf(ss * (1.f / 64.f) + EPS);
        const float* w = vec < 8 ? XPAR(P_QNW) + l * 64 : XPAR(P_KNW) + l * 64;
        const float a = x1 * rs * w[d], bb = x2 * rs * w[d + 32];
        const float co = XROPE[((size_t)8192 * 32 + d) * 2], si = XROPE[((size_t)8192 * 32 + d) * 2 + 1];
        const float o1 = a * co - bb * si, o2 = bb * co + a * si;
        if (vec < 8) { qs[vec * 64 + d] = o1 * 0.125f; qs[vec * 64 + 32 + d] = o2 * 0.125f; } else { kn[(vec - 8) * 64 + d] = o1; kn[(vec - 8) * 64 + 32 + d] = o2; }
    }
    __syncthreads();
    const float* kc = X.ck + lb * 16384; const float* vc = X.cv + lb * 16384;
    {
        float* ko = X.out + O_SK + lb * 16384; float* vo = X.out + O_SV + lb * 16384;
#pragma unroll 2
        for (int it = 0; it < 8; ++it) {
            const int e = (tid + it * NT) * 4, j = e >> 7, r = e & 127;
            f32x4 kv, vv;
            if (j < 127) { kv = *(const f32x4*)(kc + e + 128); vv = *(const f32x4*)(vc + e + 128); }
            else { kv = (f32x4){kn[r], kn[r + 1], kn[r + 2], kn[r + 3]}; vv = (f32x4){uf[C_CV + r], uf[C_CV + r + 1], uf[C_CV + r + 2], uf[C_CV + r + 3]}; }
            *(f32x4*)(ko + e) = kv; *(f32x4*)(vo + e) = vv;
        }
    }
    if (tid < 256) {
        const int kvh = tid >> 7, jj = tid & 127;
        float s0 = 0.f, s1 = 0.f, s2 = 0.f, s3 = 0.f;
#pragma unroll 2
        for (int d4 = 0; d4 < 16; ++d4) {
            f32x4 kv;
            if (jj < 127) kv = *(const f32x4*)(kc + (jj + 1) * 128 + kvh * 64 + d4 * 4);
            else kv = (f32x4){kn[kvh * 64 + d4 * 4], kn[kvh * 64 + d4 * 4 + 1], kn[kvh * 64 + d4 * 4 + 2], kn[kvh * 64 + d4 * 4 + 3]};
#pragma unroll
            for (int j = 0; j < 4; ++j) {
                s0 += kv[j] * qs[(kvh * 4 + 0) * 64 + d4 * 4 + j]; s1 += kv[j] * qs[(kvh * 4 + 1) * 64 + d4 * 4 + j];
                s2 += kv[j] * qs[(kvh * 4 + 2) * 64 + d4 * 4 + j]; s3 += kv[j] * qs[(kvh * 4 + 3) * 64 + d4 * 4 + j];
            }
        }
        sc[(kvh * 4 + 0) * 128 + jj] = s0; sc[(kvh * 4 + 1) * 128 + jj] = s1; sc[(kvh * 4 + 2) * 128 + jj] = s2; sc[(kvh * 4 + 3) * 128 + jj] = s3;
    }
    __syncthreads();
    {
        const int hq = wave; const float s0 = sc[hq * 128 + lane], s1 = sc[hq * 128 + 64 + lane], sink = XPAR(P_SINK)[l * 8 + hq];
        const float m = fmaxf(wave_max(fmaxf(s0, s1)), sink);
        const float e0 = __expf(s0 - m), e1 = __expf(s1 - m);
        const float inv = 1.f / (wave_sum(e0 + e1) + __expf(sink - m));
        sc[hq * 128 + lane] = e0 * inv; sc[hq * 128 + 64 + lane] = e1 * inv;
    }
    __syncthreads();
    {
        const int hq = tid >> 6, d = tid & 63, kvh = hq >> 2;
        float o = 0.f;
#pragma unroll 8
        for (int jj = 0; jj < 127; ++jj) o += sc[hq * 128 + jj] * vc[(jj + 1) * 128 + kvh * 64 + d];
        o += sc[hq * 128 + 127] * uf[C_CV + kvh * 64 + d];
        XMIX[row * DMIX + 1024 + tid] = (bf16_t)f2bf(o * siluf_(uf[C_CZ + tid]));
    }
    __syncthreads();
}

__device__ __forceinline__ void scans(const Ctx& X, int l, int gt, int nthreads) {
    for (int item = gt; item < 98816; item += nthreads) {
        if (item < 32768) {
            const int nh = item >> 12, e = (item & 4095) * 2;
            float* base = XMC + (size_t)nh * 128 * 8192 + e;
            const float* ml = XML + nh * 128; const float* bl = XBL + nh * 128;
            float m = 0.f; f32x2 st = {0.f, 0.f};
            for (int c0 = 0; c0 < 128; c0 += 8) {
                f32x2 cl[8];
#pragma unroll
                for (int j = 0; j < 8; ++j) cl[j] = *(const f32x2*)(base + (size_t)(c0 + j) * 8192);
#pragma unroll
                for (int j = 0; j < 8; ++j) {
                    const float mlj = ml[c0 + j], blj = bl[c0 + j], mn = fmaxf(blj + m, mlj), sp = __expf(blj + m - mn), sl = __expf(mlj - mn);
                    *(f32x2*)(base + (size_t)(c0 + j) * 8192) = st;
                    if (e == 0) XMS[nh * 128 + c0 + j] = m;
                    st = st * sp + cl[j] * sl; m = mn;
                }
            }
            *(f32x2*)(X.out + O_PC + ((size_t)l * 8 + nh) * 8192 + e) = st;
            if (e == 0) X.out[O_PM + l * 8 + nh] = m;
        } else if (item < 98304) {
            const int i1 = item - 32768, nhh = i1 >> 12, e = (i1 & 4095) * 2;
            float* base = XSH + (size_t)nhh * 128 * 8192 + e;
            const float* al = XSA + nhh * 128;
            f32x2 st = {0.f, 0.f};
            for (int c0 = 0; c0 < 128; c0 += 8) {
                f32x2 cl[8];
#pragma unroll
                for (int j = 0; j < 8; ++j) cl[j] = *(const f32x2*)(base + (size_t)(c0 + j) * 8192);
#pragma unroll
                for (int j = 0; j < 8; ++j) {
                    const float dec = __expf(al[c0 + j]);
                    *(f32x2*)(base + (size_t)(c0 + j) * 8192) = st;
                    st = st * dec + cl[j];
                }
            }
            *(f32x2*)(X.out + O_PH + ((size_t)l * 16 + nhh) * 8192 + e) = st;
        } else {
            const int i2 = item - 98304, nh = i2 >> 6, k = i2 & 63;
            float* base = XMN + (size_t)nh * 128 * 64 + k;
            const float* ml = XML + nh * 128; const float* bl = XBL + nh * 128;
            float m = 0.f, st = 0.f;
            for (int c = 0; c < 128; ++c) {
                const float mlj = ml[c], blj = bl[c], mn = fmaxf(blj + m, mlj), sp = __expf(blj + m - mn), sl = __expf(mlj - mn);
                const float cl = base[c * 64];
                base[c * 64] = st;
                st = st * sp + cl * sl; m = mn;
            }
            X.out[O_PN + ((size_t)l * 8 + nh) * 64 + k] = st;
        }
    }
}

__device__ __forceinline__ void mlstm_out(lptr lds, const Ctx& X, int l, int task, int tid) {
    const int h = task & 3, c = (task >> 2) & 127, n = task >> 9;
    const int lane = tid & 63, wave = tid >> 6, fr = lane & 15, fq = lane >> 4;
    const int row0 = n * SEQ + c * 64, nh = n * 4 + h;
    lptr Qs = lds;
    lptr Ks = lds + 9216;
    lptr Vt = lds + 18432;
    lptr Sb = lds + 36864 + wave * 2304;
    LAS float* bv = (LAS float*)(lds + 55296);
    LAS float* dv = bv + 64;
    LAS float* mtv = bv + 128;
    LAS float* siv = bv + 192;
    LAS float* qnv = bv + 256;
    LAS float* ssqp = bv + 384;
    LAS float* nsv = bv + 512;
    if (wave == 0) {
        const bf16_t* ur = XU + (size_t)(row0 + lane) * NIN;
        const float fg = bf2f(ur[C_AF + h]) + XPAR(P_AFB)[l * 4 + h], ig = bf2f(ur[C_AI + h]) + XPAR(P_AIB)[l * 4 + h];
        const float b = wave_scan_sum(logsigf_(fg), lane);
        const float dd = ig - b;
        const float cm = wave_scan_max(dd, lane);
        const float ms = XMS[nh * 128 + c];
        const float mt = b + fmaxf(ms, cm);
        bv[lane] = b; dv[lane] = dd; mtv[lane] = mt; siv[lane] = __expf(b + ms - mt);
        nsv[lane] = XMN[((size_t)nh * 128 + c) * 64 + lane];
    }
    {
        const int tok = tid >> 3, k8 = (tid & 7) * 8;
        const bf16_t* ur = XU + (size_t)(row0 + tok) * NIN;
        *(LAS u32x4*)(Qs + ((tok * 72 + k8) << 1)) = *(const u32x4*)(ur + C_AQ + h * 64 + k8);
        float x[8]; unpack8(*(const u32x4*)(ur + C_AK + h * 64 + k8), x);
#pragma unroll
        for (int j = 0; j < 8; ++j) x[j] *= 0.125f;
        *(LAS u32x4*)(Ks + ((tok * 72 + k8) << 1)) = pack8(x);
    }
#pragma unroll
    for (int it = 0; it < 2; ++it) {
        const int p = tid + it * NT, tok = p >> 4, v8 = (p & 15) * 8;
        const u32x4 w = *(const u32x4*)(XU + (size_t)(row0 + tok) * NIN + C_AV + h * 128 + v8);
#pragma unroll
        for (int j = 0; j < 8; ++j) *(LAS bf16_t*)(Vt + (((v8 + j) * 72 + tok) << 1)) = (bf16_t)((w[j >> 1] >> ((j & 1) * 16)) & 0xffffu);
    }
    __syncthreads();
    const int mti = wave >> 1, half = wave & 1;
    bf16x8 qa[2];
    qa[0] = lds_frag(Qs, 16 * mti + fr, fq * 8, 72); qa[1] = lds_frag(Qs, 16 * mti + fr, 32 + fq * 8, 72);
    {
        float x0[8], x1[8]; unpack8(__builtin_bit_cast(u32x4, qa[0]), x0); unpack8(__builtin_bit_cast(u32x4, qa[1]), x1);
        float d = 0.f;
#pragma unroll
        for (int j = 0; j < 8; ++j) d += x0[j] * nsv[fq * 8 + j] + x1[j] * nsv[32 + fq * 8 + j];
        d += __shfl_xor(d, 16); d += __shfl_xor(d, 32);
        if (fq == 0) qnv[wave * 16 + fr] = d;
    }
    float rsum[4] = {0.f, 0.f, 0.f, 0.f};
#pragma unroll
    for (int ntl = 0; ntl < 4; ++ntl) {
        f32x4 s = {0.f, 0.f, 0.f, 0.f};
        s = mfma16(qa[0], lds_frag(Ks, 16 * ntl + fr, fq * 8, 72), s);
        s = mfma16(qa[1], lds_frag(Ks, 16 * ntl + fr, 32 + fq * 8, 72), s);
#pragma unroll
        for (int ii = 0; ii < 4; ++ii) {
            const int t = 16 * mti + fq * 4 + ii, sidx = 16 * ntl + fr;
            const float wgt = (sidx <= t) ? __expf(bv[t] + dv[sidx] - mtv[t]) : 0.f;
            const float sv = wgt * s[ii];
            rsum[ii] += sv;
            *(LAS bf16_t*)(Sb + (((fq * 4 + ii) * 72 + sidx) << 1)) = (bf16_t)f2bf(sv);
        }
    }
    LDS_FENCE();
    f32x4 acc[4];
#pragma unroll
    for (int ntl = 0; ntl < 4; ++ntl) acc[ntl] = (f32x4){0.f, 0.f, 0.f, 0.f};
#pragma unroll
    for (int kk = 0; kk < 2; ++kk) {
        const bf16x8 a = lds_frag(Sb, fr, kk * 32 + fq * 8, 72);
#pragma unroll
        for (int ntl = 0; ntl < 4; ++ntl) acc[ntl] = mfma16(a, lds_frag(Vt, 64 * half + 16 * ntl + fr, kk * 32 + fq * 8, 72), acc[ntl]);
    }
    {
        const float sia = siv[16 * mti + fr];
        const float* Cs = XMC + ((size_t)nh * 128 + c) * 8192;
#pragma unroll
        for (int kk = 0; kk < 2; ++kk) {
            float x[8]; unpack8(__builtin_bit_cast(u32x4, qa[kk]), x);
#pragma unroll
            for (int j = 0; j < 8; ++j) x[j] *= sia;
            const bf16x8 a = as_frag(pack8(x));
#pragma unroll
            for (int ntl = 0; ntl < 4; ++ntl) acc[ntl] = mfma16(a, ldg_f32_frag(Cs + (64 * half + 16 * ntl + fr) * 64 + kk * 32 + fq * 8), acc[ntl]);
        }
    }
    float hv[4][4], ssl[4];
#pragma unroll
    for (int ii = 0; ii < 4; ++ii) {
        const int t = 16 * mti + fq * 4 + ii;
        const float den = red16(rsum[ii]) + siv[t] * qnv[wave * 16 + fq * 4 + ii];
        const float inv = 1.f / fmaxf(fabsf(den), __expf(-mtv[t]));
        float ss = 0.f;
#pragma unroll
        for (int ntl = 0; ntl < 4; ++ntl) { hv[ntl][ii] = acc[ntl][ii] * inv; ss += hv[ntl][ii] * hv[ntl][ii]; }
        ssl[ii] = red16(ss);
        if (fr == 0) ssqp[t * 2 + half] = ssl[ii];
    }
    __syncthreads();
#pragma unroll
    for (int ii = 0; ii < 4; ++ii) {
        const int t = 16 * mti + fq * 4 + ii;
        const float rs = rsqrtf((ssqp[t * 2] + ssqp[t * 2 + 1]) * (1.f / 128.f) + EPS);
        const size_t row = (size_t)row0 + t;
#pragma unroll
        for (int ntl = 0; ntl < 4; ++ntl) {
            const int v = h * 128 + 64 * half + 16 * ntl + fr;
            const float ao = bf2f(XU[row * NIN + C_AO + v]), az = bf2f(XU[row * NIN + C_AZ + v]);
            XMIX[row * DMIX + v] = (bf16_t)f2bf(hv[ntl][ii] * rs * XPAR(P_ANW)[l * 512 + v] * sigmoidf_(ao) * siluf_(az));
        }
    }
    __syncthreads();
}

__device__ __forceinline__ void ssd_out(lptr lds, const Ctx& X, int l, int task, int tid) {
    const int g = task & 1, c = (task >> 1) & 127, n = task >> 8;
    const int lane = tid & 63, wave = tid >> 6, fr = lane & 15, fq = lane >> 4;
    const int seq0 = n * SEQ, row0 = seq0 + c * 64;
    lptr Cm = lds;
    lptr Bm = lds + 17408;
    lptr Xt = lds + 34816;
    LAS float* CBf = (LAS float*)(lds + 71680);
    LAS float* av = (LAS float*)(lds + 89088);
    LAS float* dtv = (LAS float*)(lds + 90112);
    LAS float* ssq = (LAS float*)(lds + 91136);
    if (wave < 4) {
        const int hh = 4 * g + wave;
        const float dt = softplusf_(bf2f(XU[(size_t)(row0 + lane) * NIN + C_BDT + hh]) + XPAR(P_DTB)[l * 8 + hh]);
        const float A = -__expf(XPAR(P_ALOG)[l * 8 + hh]);
        av[wave * 64 + lane] = wave_scan_sum(dt * A, lane);
        dtv[wave * 64 + lane] = dt;
    }
    const float* cw = XPAR(P_CW) + l * 4096; const float* cb = XPAR(P_CB) + l * 1024;
#pragma unroll 1
    for (int it = 0; it < 8; ++it) {
        const int item = tid + it * NT;
        float o[8];
        if (item < 2048) {
            const int t = item >> 5, j8 = (item & 31) * 8;
            conv8(XU, seq0, c * 64 + t, g * 256 + j8, cw, cb, o);
#pragma unroll
            for (int j = 0; j < 8; ++j) *(LAS bf16_t*)(Xt + (((j8 + j) * 72 + t) << 1)) = (bf16_t)f2bf(o[j]);
        } else if (item < 3072) {
            const int i2 = item - 2048, t = i2 >> 4, s8 = (i2 & 15) * 8;
            conv8(XU, seq0, c * 64 + t, 512 + g * 128 + s8, cw, cb, o);
            *(LAS u32x4*)(Bm + ((t * 136 + s8) << 1)) = pack8(o);
        } else {
            const int i2 = item - 3072, t = i2 >> 4, s8 = (i2 & 15) * 8;
            conv8(XU, seq0, c * 64 + t, 768 + g * 128 + s8, cw, cb, o);
            *(LAS u32x4*)(Cm + ((t * 136 + s8) << 1)) = pack8(o);
        }
    }
    __syncthreads();
    {
        const int mt = wave >> 1;
#pragma unroll
        for (int q = 0; q < 2; ++q) {
            const int ntl = 2 * (wave & 1) + q;
            f32x4 acc = {0.f, 0.f, 0.f, 0.f};
#pragma unroll
            for (int kk = 0; kk < 4; ++kk) acc = mfma16(lds_frag(Cm, 16 * mt + fr, kk * 32 + fq * 8, 136), lds_frag(Bm, 16 * ntl + fr, kk * 32 + fq * 8, 136), acc);
#pragma unroll
            for (int ii = 0; ii < 4; ++ii) CBf[(16 * mt + fq * 4 + ii) * 68 + 16 * ntl + fr] = acc[ii];
        }
    }
    __syncthreads();
    const int hl = wave >> 1, th = wave & 1, hh = 4 * g + hl;
    f32x4 y1[2][4], y2[2][4];
#pragma unroll
    for (int mi = 0; mi < 2; ++mi)
#pragma unroll
        for (int ntl = 0; ntl < 4; ++ntl) { y1[mi][ntl] = (f32x4){0.f, 0.f, 0.f, 0.f}; y2[mi][ntl] = (f32x4){0.f, 0.f, 0.f, 0.f}; }
#pragma unroll
    for (int kk = 0; kk < 2; ++kk) {
        bf16x8 bx[4];
#pragma unroll
        for (int ntl = 0; ntl < 4; ++ntl) bx[ntl] = lds_frag(Xt, hl * 64 + 16 * ntl + fr, kk * 32 + fq * 8, 72);
#pragma unroll
        for (int mi = 0; mi < 2; ++mi) {
            const int t = 16 * (2 * th + mi) + fr, u0 = kk * 32 + fq * 8;
            const float at = av[hl * 64 + t];
            float w[8];
#pragma unroll
            for (int j = 0; j < 8; ++j) {
                const int uu = u0 + j;
                w[j] = (uu <= t) ? CBf[t * 68 + uu] * __expf(at - av[hl * 64 + uu]) * dtv[hl * 64 + uu] : 0.f;
            }
            const bf16x8 a = as_frag(pack8(w));
#pragma unroll
            for (int ntl = 0; ntl < 4; ++ntl) y1[mi][ntl] = mfma16(a, bx[ntl], y1[mi][ntl]);
        }
    }
    {
        const float* hs = XSH + ((size_t)(n * 8 + hh) * 128 + c) * 8192;
#pragma unroll
        for (int kk = 0; kk < 4; ++kk) {
            bf16x8 bh[4];
#pragma unroll
            for (int ntl = 0; ntl < 4; ++ntl) bh[ntl] = ldg_f32_frag(hs + (16 * ntl + fr) * 128 + kk * 32 + fq * 8);
#pragma unroll
            for (int mi = 0; mi < 2; ++mi) {
                const bf16x8 a = lds_frag(Cm, 16 * (2 * th + mi) + fr, kk * 32 + fq * 8, 136);
#pragma unroll
                for (int ntl = 0; ntl < 4; ++ntl) y2[mi][ntl] = mfma16(a, bh[ntl], y2[mi][ntl]);
            }
        }
    }
    const float Dh = XPAR(P_BD)[l * 8 + hh];
#pragma unroll
    for (int mi = 0; mi < 2; ++mi)
#pragma unroll
        for (int ii = 0; ii < 4; ++ii) {
            const int t = 16 * (2 * th + mi) + fq * 4 + ii;
            const float ea = __expf(av[hl * 64 + t]);
            const size_t row = (size_t)row0 + t;
            float ss = 0.f;
#pragma unroll
            for (int ntl = 0; ntl < 4; ++ntl) {
                const int p = 16 * ntl + fr;
                const float xv = bf2f(*(const LAS bf16_t*)(Xt + (((hl * 64 + p) * 72 + t) << 1)));
                const float y = y1[mi][ntl][ii] + ea * y2[mi][ntl][ii] + Dh * xv;
                const float gbv = y * siluf_(bf2f(XU[row * NIN + C_BZ + hh * 64 + p]));
                y1[mi][ntl][ii] = gbv; ss += gbv * gbv;
            }
            ss = red16(ss);
            if (fr == 0) ssq[t * 4 + hl] = ss;
        }
    __syncthreads();
#pragma unroll
    for (int mi = 0; mi < 2; ++mi)
#pragma unroll
        for (int ii = 0; ii < 4; ++ii) {
            const int t = 16 * (2 * th + mi) + fq * 4 + ii;
            const float rs = rsqrtf((ssq[t * 4] + ssq[t * 4 + 1] + ssq[t * 4 + 2] + ssq[t * 4 + 3]) * (1.f / 256.f) + EPS);
            const size_t row = (size_t)row0 + t;
#pragma unroll
            for (int ntl = 0; ntl < 4; ++ntl) {
                const int p = hh * 64 + 16 * ntl + fr;
                XMIX[row * DMIX + 512 + p] = (bf16_t)f2bf(y1[mi][ntl][ii] * rs * XPAR(P_BNW)[l * 512 + p]);
            }
        }
    __syncthreads();
}


#define XB_TMO      128
#define XB_XCNT(j)  (256  + 64 * (j))
#define XB_XSUB(j)  (1280 + 64 * (j))
#define XB_XGEN(j)  (2304 + 64 * (j))
#define XB_TOP      3328
#define XB_TOPGEN   3392
#define XCD_BAR_WORDS 3456
#define XB_SPIN_CAP (1u << 18)
__device__ __forceinline__ unsigned xb_ld(unsigned* p)              { return __hip_atomic_load(p, __ATOMIC_RELAXED, __HIP_MEMORY_SCOPE_AGENT); }
__device__ __forceinline__ unsigned xb_add(unsigned* p, unsigned v) { return __hip_atomic_fetch_add(p, v, __ATOMIC_RELAXED, __HIP_MEMORY_SCOPE_AGENT); }
__device__ __forceinline__ unsigned xb_xcc_id() { return (unsigned)__builtin_amdgcn_s_getreg((3 << 11) | 20) & 0xFu; }
#define XB_SPIN(cond, bar) do { unsigned _sp = 0; while (cond) { __builtin_amdgcn_s_sleep(1); \
    if ((++_sp & 255u) == 0u) { if (xb_ld(&(bar)[XB_TMO])) break; if (_sp > XB_SPIN_CAP) { atomicAdd(&(bar)[XB_TMO], 1u); break; } } } } while (0)
struct XcdBarrier { unsigned* bar; unsigned x; volatile LAS unsigned* st; };
__device__ __forceinline__ XcdBarrier xcd_barrier_post(unsigned* bar, volatile LAS unsigned* st) {
    XcdBarrier b; b.bar = bar; b.x = xb_xcc_id(); b.st = st;
    if (threadIdx.x == 0) (void)xb_add(&bar[XB_XCNT(b.x)], 1u);
    return b;
}
__device__ __forceinline__ void xcd_barrier_complete(unsigned* bar, unsigned x, unsigned& nloc, unsigned& nx) {
    const unsigned G = gridDim.x * gridDim.y * gridDim.z;
    unsigned sum, cnt, mine, sp = 0u;
    for (;;) {
        sum = 0u; cnt = 0u; mine = 0u;
#pragma unroll
        for (unsigned j = 0; j < 16; ++j) { const unsigned c = xb_ld(&bar[XB_XCNT(j)]); sum += c; cnt += (c > 0u) ? 1u : 0u; mine = (j == x) ? c : mine; }
        if (sum == G) break;
        __builtin_amdgcn_s_sleep(1);
        if ((++sp & 255u) == 0u) { if (xb_ld(&bar[XB_TMO])) break; if (sp > XB_SPIN_CAP) { atomicAdd(&bar[XB_TMO], 1u); break; } }
    }
    nloc = mine > 0u ? mine : 1u; nx = cnt > 0u ? cnt : 1u;
}
__device__ __forceinline__ void xcd_barrier(const XcdBarrier& b) {
    asm volatile("s_waitcnt vmcnt(0)" ::: "memory");
    __syncthreads();
    if (threadIdx.x == 0) {
        unsigned* bar = b.bar;
        __builtin_amdgcn_s_waitcnt(0);
        unsigned nloc = b.st[0], nx = b.st[1];
        if (nloc == 0u) { xcd_barrier_complete(bar, b.x, nloc, nx); b.st[0] = nloc; b.st[1] = nx; }
        const unsigned old = xb_add(&bar[XB_XSUB(b.x)], 1u);
        const unsigned gen = old / nloc;
        if (old + 1u == (gen + 1u) * nloc) {
            __builtin_amdgcn_fence(__ATOMIC_RELEASE, "agent");
            asm volatile("s_waitcnt vmcnt(0)" ::: "memory");
            const unsigned og = xb_add(&bar[XB_TOP], 1u);
            const unsigned tg = og / nx;
            if (og + 1u == (tg + 1u) * nx) xb_add(&bar[XB_TOPGEN], 1u);
            else XB_SPIN(xb_ld(&bar[XB_TOPGEN]) == tg, bar);
            __builtin_amdgcn_fence(__ATOMIC_ACQUIRE, "agent");
            xb_add(&bar[XB_XGEN(b.x)], 1u);
            asm volatile("s_waitcnt vmcnt(0)" ::: "memory");
        } else {
            XB_SPIN(xb_ld(&bar[XB_XGEN(b.x)]) == gen, bar);
            __builtin_amdgcn_fence(__ATOMIC_ACQUIRE, "agent");
            asm volatile("s_waitcnt vmcnt(0)" ::: "memory");
        }
    }
    __syncthreads();
}

__global__ void __launch_bounds__(NT, 2) mega(Args args) {
    __shared__ __attribute__((aligned(16))) unsigned char lds_raw[LDS_BYTES];
    lptr lds = (lptr)lds_raw;
    cg::grid_group grid = cg::this_grid();
    const int tid = threadIdx.x, bid = blockIdx.x, G = gridDim.x;
    Ctx X;
    X.xp = args.in[IN_XP]; X.xs = args.in[IN_XS]; X.stC = args.in[IN_STC]; X.stN = args.in[IN_STN]; X.stM = args.in[IN_STM]; X.ssm = args.in[IN_SSM];
    X.conv = args.in[IN_CONV]; X.ck = args.in[IN_CK]; X.cv = args.in[IN_CV]; X.out = args.out; X.ws = args.ws;
    const int lo = args.ph_lo, hi = args.ph_hi;
    volatile LAS unsigned* xst = (volatile LAS unsigned*)(lds + LDS_BYTES - 16);
    if (tid == 0) { xst[0] = 0u; xst[1] = 0u; }
    __syncthreads();
    XcdBarrier xbar = xcd_barrier_post((unsigned*)(args.ws + WS_BAR), xst);
#define IN(k) (lo <= (k) && (k) < hi)
#define SEAM(k) do { if (IN(k) && IN((k) + 1)) { for (int _r = 0; _r < REP_SYNC; ++_r) { if ((k) == 0) grid.sync(); else xcd_barrier(xbar); } } } while (0)
    if (IN(0)) { prologue(lds, X, args, G, bid, tid); }
    SEAM(0);
    for (int l = 0; l < 4; ++l) {
        const int pb = 1 + l * 5;
        if (IN(pb)) for (int _r = 0; _r < REP_P1; ++_r) {
            pg8::Gemm g{XXB, XWIN + (size_t)l * NIN * D, MPAD, NIN, D}; pg8::StaticOrder S; S.init(MPAD, NIN, G, bid);
            pg8::EpiU E{XU, XSSQ};
            pg8::gemm_phase<pg8::EpiU>(lds, g, S, E, OPQ(tid));
        }
        SEAM(pb);
        if (IN(pb + 1)) for (int _r = 0; _r < REP_P2; ++_r) {
            for (int task = bid; task < 1921; task += G) {
                if (task < 128) sample_task(lds, X, l, task, OPQ(tid));
                else if (task < 384) swa_prompt(lds, X, l, task - 128, OPQ(tid));
                else if (task < 1408) mlstm_local(lds, X, l, task - 384, OPQ(tid));
                else if (task < 1920) ssd_local(lds, X, l, task - 1408, OPQ(tid));
                else {
                    for (int i = tid; i < 2 * 3 * 1024; i += NT) {
                        const int ch = i & 1023, j = (i >> 10) % 3, n = i / 3072;
                        X.out[O_PCONV + (((size_t)l * 2 + n) * 3 + j) * 1024 + ch] = bf2f(XU[(size_t)(n * SEQ + SEQ - 3 + j) * NIN + C_BX + ch]);
                    }
                }
            }
        }
        SEAM(pb + 1);
        if (IN(pb + 2)) scans(X, l, bid * NT + OPQ(tid), G * NT);
        SEAM(pb + 2);
        if (IN(pb + 3)) for (int _r = 0; _r < REP_P4; ++_r) {
            for (int task = bid; task < 1536; task += G) {
                if (task < 512) ssd_out(lds, X, l, task, OPQ(tid));
                else mlstm_out(lds, X, l, task - 512, OPQ(tid));
            }
        }
        SEAM(pb + 3);
        if (IN(pb + 4)) {
            pg8::Gemm g{XMIX, XWOUT + (size_t)l * D * DMIX, MPAD, D, DMIX}; pg8::StaticOrder S; S.init(MPAD, D, G, bid);
            pg8::EpiRes E{l == 0 ? X.xp : nullptr, X.xs, X.out, XXB, XSSQ};
            pg8::gemm_phase<pg8::EpiRes>(lds, g, S, E, OPQ(tid));
        }
        SEAM(pb + 4);
    }
#undef IN
#undef SEAM
}

extern "C" void kernel_launch(void* const* d_in, const int* in_sizes, int n_in, void* d_out, int out_size, void* d_ws, size_t ws_size, hipStream_t stream) {
    static int grid_blocks = 0;
    if (!grid_blocks) {
        int dev = 0, cus = 0, per_cu = 0;
        hipGetDevice(&dev);
        hipDeviceGetAttribute(&cus, hipDeviceAttributeMultiprocessorCount, dev);
        hipOccupancyMaxActiveBlocksPerMultiprocessor(&per_cu, mega, NT, 0);
        if (per_cu < 1) { fprintf(stderr, "occupancy query returned %d\n", per_cu); per_cu = 1; }
        grid_blocks = cus * 1;
        if (ws_size < WS_END) fprintf(stderr, "workspace too small: %zu < %zu\n", ws_size, (size_t)WS_END);
    }
    (void)hipMemsetAsync(d_ws, 0, 16384, stream);
    Args a{};
    for (int i = 0; i < 24; ++i) a.in[i] = (const float*)d_in[i];
    a.out = (float*)d_out; a.ws = (unsigned char*)d_ws;
    const int NPH = 21;
#if MULTI_LAUNCH
    for (int p = 0; p < NPH; ++p) {
        a.ph_lo = p; a.ph_hi = p + 1;
        void* kargs[] = {&a};
        hipError_t e = hipLaunchCooperativeKernel((void*)mega, dim3(grid_blocks), dim3(NT), kargs, 0, stream);
        if (e != hipSuccess) fprintf(stderr, "cooperative launch failed: %s (grid %d)\n", hipGetErrorString(e), grid_blocks);
    }
#else
    a.ph_lo = 0; a.ph_hi = NPH;
    void* kargs[] = {&a};
    hipError_t e = hipLaunchCooperativeKernel((void*)mega, dim3(grid_blocks), dim3(NT), kargs, 0, stream);
    if (e != hipSuccess) fprintf(stderr, "cooperative launch failed: %s (grid %d)\n", hipGetErrorString(e), grid_blocks);
#endif
}
```

```cpp
#include <hip/hip_runtime.h>
#include <hip/hip_cooperative_groups.h>
#include <cstdio>
#include <cstdint>
namespace cg = cooperative_groups;

#ifndef REP_SYNC
#define REP_SYNC 1
#endif
#ifndef REP_P1
#define REP_P1 1
#endif
#ifndef REP_P2
#define REP_P2 1
#endif
#ifndef REP_P4
#define REP_P4 1
#endif
#ifndef MULTI_LAUNCH
#define MULTI_LAUNCH 0
#endif

#define LAS __attribute__((address_space(3)))
typedef unsigned short bf16_t;
typedef short bf16x8 __attribute__((ext_vector_type(8)));
typedef float f32x4 __attribute__((ext_vector_type(4)));
typedef float f32x2 __attribute__((ext_vector_type(2)));
typedef unsigned u32x4 __attribute__((ext_vector_type(4)));
typedef unsigned u32x2 __attribute__((ext_vector_type(2)));
typedef __bf16 bf16x2_t __attribute__((ext_vector_type(2)));
typedef LAS unsigned char* lptr;

constexpr int D = 1024, DIN = 4880, NIN = 5120, DMIX = 1536, TP = 16384, MTOK = 16512, MPAD = 16640, SEQ = 8192;
constexpr int C_AQ = 0, C_AK = 256, C_AV = 512, C_AO = 1024, C_AZ = 1536, C_AI = 2048, C_AF = 2052, C_BZ = 2056, C_BX = 2568, C_BB = 3080, C_BC = 3336,
              C_BDT = 3592, C_CQ = 3600, C_CK = 4112, C_CV = 4240, C_CZ = 4368;
constexpr float EPS = 1e-6f;
constexpr size_t O_YP = 0, O_YS = 16777216, O_PC = 16908288, O_PN = 17170432, O_PM = 17172480, O_PH = 17172512, O_PCONV = 17696800, O_PK = 17721376,
                 O_PV = 17852448, O_SC = 17983520, O_SN = 34760736, O_SM = 34891808, O_SH = 34893856, O_SCONV = 68448288, O_SK = 70021152, O_SV = 78409760;
constexpr size_t WS_BAR = 0;
constexpr size_t WS_PAR = 16384;
constexpr size_t WS_WIN = WS_PAR + 102400;
constexpr size_t WS_WOUT = WS_WIN + (size_t)4 * NIN * D * 2;
constexpr size_t WS_XB = WS_WOUT + (size_t)4 * D * DMIX * 2;
constexpr size_t WS_U = WS_XB + (size_t)MPAD * D * 2;
constexpr size_t WS_MIX = WS_U + (size_t)MPAD * NIN * 2;
constexpr size_t WS_SSQ = WS_MIX + (size_t)MPAD * DMIX * 2;
constexpr size_t WS_ROPE = WS_SSQ + (size_t)MPAD * 16 * 4;
constexpr size_t WS_MC = WS_ROPE + (size_t)8200 * 64 * 4;
constexpr size_t WS_MN = WS_MC + (size_t)8 * 128 * 8192 * 4;
constexpr size_t WS_ML = WS_MN + (size_t)8 * 128 * 64 * 4;
constexpr size_t WS_BL = WS_ML + 4096;
constexpr size_t WS_MS = WS_BL + 4096;
constexpr size_t WS_SA = WS_MS + 4096;
constexpr size_t WS_SH = WS_SA + 8192;
constexpr size_t WS_END = WS_SH + (size_t)16 * 128 * 8192 * 4;
constexpr int LDS_BYTES = 139264;
constexpr int NT = 512;

struct Args { const float* in[24]; float* out; unsigned char* ws; int ph_lo, ph_hi; };

__device__ __forceinline__ float bf2f(unsigned v) { return __uint_as_float(v << 16); }
__device__ __forceinline__ unsigned pk2(float lo, float hi) { f32x2 v = {lo, hi}; bf16x2_t b = __builtin_convertvector(v, bf16x2_t); return __builtin_bit_cast(unsigned, b); }
__device__ __forceinline__ unsigned f2bf(float f) { return pk2(f, 0.f) & 0xffffu; }
__device__ __forceinline__ void unpack8(u32x4 w, float (&f)[8]) {
#pragma unroll
    for (int i = 0; i < 4; ++i) { f[2 * i] = __uint_as_float(w[i] << 16); f[2 * i + 1] = __uint_as_float(w[i] & 0xffff0000u); }
}
__device__ __forceinline__ u32x4 pack8(const float (&f)[8]) { u32x4 w; w[0] = pk2(f[0], f[1]); w[1] = pk2(f[2], f[3]); w[2] = pk2(f[4], f[5]); w[3] = pk2(f[6], f[7]); return w; }
__device__ __forceinline__ u32x4 pack8v(f32x4 a, f32x4 b) { u32x4 w; w[0] = pk2(a[0], a[1]); w[1] = pk2(a[2], a[3]); w[2] = pk2(b[0], b[1]); w[3] = pk2(b[2], b[3]); return w; }
__device__ __forceinline__ bf16x8 as_frag(u32x4 w) { return __builtin_bit_cast(bf16x8, w); }
__device__ __forceinline__ bf16x8 ldg_f32_frag(const float* p) { f32x4 a = *(const f32x4*)p, b = *(const f32x4*)(p + 4); return as_frag(pack8v(a, b)); }
__device__ __forceinline__ bf16x8 lds_frag(lptr base, int row, int k, int stride) { return *(const LAS bf16x8*)(base + ((row * stride + k) << 1)); }
__device__ __forceinline__ f32x4 mfma16(bf16x8 a, bf16x8 b, f32x4 c) { return __builtin_amdgcn_mfma_f32_16x16x32_bf16(a, b, c, 0, 0, 0); }
__device__ __forceinline__ float sigmoidf_(float x) { return 1.f / (1.f + __expf(-x)); }
__device__ __forceinline__ float siluf_(float x) { return x / (1.f + __expf(-x)); }
__device__ __forceinline__ float softplusf_(float x) { return x > 20.f ? x : log1pf(__expf(x)); }
__device__ __forceinline__ float logsigf_(float x) { return fminf(x, 0.f) - log1pf(__expf(-fabsf(x))); }
__device__ __forceinline__ float wave_scan_sum(float v, int lane) {
#pragma unroll
    for (int o = 1; o < 64; o <<= 1) { float t = __shfl_up(v, o); if (lane >= o) v += t; }
    return v;
}
__device__ __forceinline__ float wave_scan_max(float v, int lane) {
#pragma unroll
    for (int o = 1; o < 64; o <<= 1) { float t = __shfl_up(v, o); if (lane >= o) v = fmaxf(v, t); }
    return v;
}
__device__ __forceinline__ float wave_sum(float v) {
#pragma unroll
    for (int o = 1; o < 64; o <<= 1) v += __shfl_xor(v, o);
    return v;
}
__device__ __forceinline__ float wave_max(float v) {
#pragma unroll
    for (int o = 1; o < 64; o <<= 1) v = fmaxf(v, __shfl_xor(v, o));
    return v;
}
__device__ __forceinline__ float red16(float v) { v += __shfl_xor(v, 1); v += __shfl_xor(v, 2); v += __shfl_xor(v, 4); v += __shfl_xor(v, 8); return v; }
__device__ __forceinline__ float red16max(float v) { v = fmaxf(v, __shfl_xor(v, 1)); v = fmaxf(v, __shfl_xor(v, 2)); v = fmaxf(v, __shfl_xor(v, 4)); v = fmaxf(v, __shfl_xor(v, 8)); return v; }
__device__ __forceinline__ int OPQ(int v) { asm volatile("" : "+v"(v)); return v; }
#define LDS_FENCE() asm volatile("s_waitcnt lgkmcnt(0)" ::: "memory")

namespace pg8 {
constexpr int BM = 256, BK = 64, HALF = 128, HTB = HALF * BK * 2, STAGE_BYTES = 8 * HTB, NXCD = 8, WGM = 8;
__host__ __device__ __forceinline__ int lds_byte(int r, int c) { const int st = (r >> 4) * 2 + (c >> 5), rr = r & 15, cc = c & 31, ob = rr * 64 + cc * 2; return st * 1024 + (ob ^ (((ob >> 9) & 1) << 5)); }
__host__ __device__ __forceinline__ void stage_rc(int b, int& R, int& C) { const int st = b / 1024, sb = b % 1024, swz = sb ^ (((sb >> 9) & 1) << 5); R = (st >> 1) * 16 + swz / 64; C = (st & 1) * 32 + (swz % 64) / 2; }
__host__ __device__ __forceinline__ int perm32(int rho) { const int n = rho >> 4, i = rho & 15; return 8 * (i >> 2) + 4 * n + (i & 3); }
struct Unit { int pm, pn; };
struct Gemm { const bf16_t* A; const bf16_t* Bt; int M, N, K; };
struct StaticOrder {
    int nM, nN, nwg, G, c;
    __device__ void init(int M, int N, int G_, int c_) { nM = M / BM; nN = N / BM; nwg = nM * nN; G = G_; c = c_; }
    __device__ bool next(int i, Unit& u) const {
        const long L = (long)i * G + c; if (L >= nwg) return false;
        int wgid = (int)L; { const int q = nwg / NXCD, r = nwg % NXCD, xcd = wgid % NXCD, off = wgid / NXCD; wgid = (xcd < r ? xcd * (q + 1) : r * (q + 1) + (xcd - r) * q) + off; }
        const int nig = WGM * nN, gid = wgid / nig, fm = gid * WGM, gsz = (nM - fm) < WGM ? (nM - fm) : WGM;
        u.pm = fm + ((wgid % nig) % gsz); u.pn = (wgid % nig) / gsz; return true;
    }
};
struct EpiU {
    bf16_t* U; const float* ssq;
    __device__ __forceinline__ void operator()(const f32x4 (&acc)[2][2][4][2], const Unit& u, int wr, int wc, int fr, int fq) const {
        const int row0 = u.pm * BM + wr * 64 + fr, col0 = u.pn * BM + wc * 32 + 8 * fq;
#pragma unroll
        for (int ai = 0; ai < 2; ++ai)
#pragma unroll
            for (int m = 0; m < 4; ++m) {
                const int r = row0 + ai * HALF + m * 16;
                const f32x4 s = *(const f32x4*)(ssq + (size_t)r * 16 + fq * 4);
                float st = s[0] + s[1] + s[2] + s[3]; st += __shfl_xor(st, 16); st += __shfl_xor(st, 32);
                const float rs = rsqrtf(st * (1.f / 1024.f) + EPS);
                bf16_t* rowp = U + (size_t)r * NIN + col0;
#pragma unroll
                for (int bj = 0; bj < 2; ++bj) *(u32x4*)(rowp + bj * HALF) = pack8v(acc[ai][bj][m][0] * rs, acc[ai][bj][m][1] * rs);
                __builtin_amdgcn_sched_barrier(0);
            }
    }
};
struct EpiRes {
    const float* xp; const float* xs; float* out; bf16_t* xb; float* ssq;
    __device__ __forceinline__ void operator()(const f32x4 (&acc)[2][2][4][2], const Unit& u, int wr, int wc, int fr, int fq) const {
        const int row0 = u.pm * BM + wr * 64 + fr, col0 = u.pn * BM + wc * 32 + 8 * fq;
#pragma unroll
        for (int ai = 0; ai < 2; ++ai)
#pragma unroll
            for (int m = 0; m < 4; ++m) {
                const int r = row0 + ai * HALF + m * 16;
                const bool valid = r < MTOK;
                const float* src = xp ? (r < TP ? xp + (size_t)r * D : xs + (size_t)(r - TP) * D) : out + (size_t)r * D;
                float part = 0.f;
#pragma unroll
                for (int bj = 0; bj < 2; ++bj) {
                    const int c = col0 + bj * HALF;
                    f32x4 o0 = {0.f, 0.f, 0.f, 0.f}, o1 = {0.f, 0.f, 0.f, 0.f};
                    if (valid) { o0 = *(const f32x4*)(src + c); o1 = *(const f32x4*)(src + c + 4); }
                    const f32x4 v0 = acc[ai][bj][m][0] + o0, v1 = acc[ai][bj][m][1] + o1;
                    if (valid) { *(f32x4*)(out + (size_t)r * D + c) = v0; *(f32x4*)(out + (size_t)r * D + c + 4) = v1; }
                    *(u32x4*)(xb + (size_t)r * D + c) = pack8v(v0, v1);
                    part += v0[0] * v0[0] + v0[1] * v0[1] + v0[2] * v0[2] + v0[3] * v0[3] + v1[0] * v1[0] + v1[1] * v1[1] + v1[2] * v1[2] + v1[3] * v1[3];
                }
                part += __shfl_xor(part, 16); part += __shfl_xor(part, 32);
                if (fq == 0) ssq[(size_t)r * 16 + u.pn * 4 + wc] = part;
                __builtin_amdgcn_sched_barrier(0);
            }
    }
};

struct SampleOrder {
    int first, cnt, c;
    __device__ bool next(int i, Unit& u) const { if (i != 0 || c < first || c >= first + cnt) return false; u.pm = 64; u.pn = c - first; return true; }
};
template <class Epi, class Sched>
__device__ __forceinline__ void gemm_phase(lptr lds, const Gemm g, const Sched& S, const Epi& E, const int tid) {
    const int wid = __builtin_amdgcn_readfirstlane(tid >> 6), lane = tid & 63, wr = wid >> 2, wc = wid & 3, fr = lane & 15, fq = lane >> 4;
    const int K = g.K, nt = K / BK;
    unsigned voffA[2], voffB[2];
#pragma unroll
    for (int i = 0; i < 2; ++i) { int R, C; stage_rc(tid * 16 + i * 8192, R, C); const int Rb = (R & ~31) + perm32(R & 31);
        voffA[i] = (unsigned)(R * K + C) * 2u; voffB[i] = (unsigned)(Rb * K + C) * 2u; }
    const size_t kstep = (size_t)(BK * 2);
    const size_t hstep = (size_t)HALF * K * 2;
    const size_t tstep = 2 * hstep;
    const unsigned ldsw = (unsigned)wid * 1024u;
    const int aoff = lds_byte(wr * 64 + fr, fq * 8), boff = lds_byte(wc * 32 + fr, fq * 8);
#define PG8_SA(b, h) (((b) * 2 + (h)) * HTB)
#define PG8_SB(b, h) ((4 + (b) * 2 + (h)) * HTB)
#define PG8_STAGE(bufoff, gbase, voff) do { _Pragma("unroll") for (int _i = 0; _i < 2; ++_i) \
        __builtin_amdgcn_global_load_lds((const unsigned*)((const char*)(gbase) + (voff)[_i]), (LAS unsigned*)(lds + (bufoff) + ldsw + _i * 8192), 16, 0, 0); } while (0)
#define PG8_LDA(dst, b, h) do { _Pragma("unroll") for (int m = 0; m < 4; ++m) _Pragma("unroll") for (int k = 0; k < 2; ++k) dst[m][k] = *(const LAS bf16x8*)(lds + PG8_SA(b, h) + aoff + m * 2048 + k * 1024); } while (0)
#define PG8_LDB(dst, b, h) do { _Pragma("unroll") for (int n = 0; n < 2; ++n) _Pragma("unroll") for (int k = 0; k < 2; ++k) dst[n][k] = *(const LAS bf16x8*)(lds + PG8_SB(b, h) + boff + n * 2048 + k * 1024); } while (0)
#define PG8_MMA(ai, bj, At, Bt) do { __builtin_amdgcn_s_setprio(1); _Pragma("unroll") for (int m = 0; m < 4; ++m) _Pragma("unroll") for (int n = 0; n < 2; ++n) _Pragma("unroll") for (int k = 0; k < 2; ++k) \
        acc[ai][bj][m][n] = __builtin_amdgcn_mfma_f32_16x16x32_bf16(Bt[n][k], At[m][k], acc[ai][bj][m][n], 0, 0, 0); __builtin_amdgcn_s_setprio(0); } while (0)
#define PG8_WAIT_V(n) asm volatile("s_waitcnt vmcnt(" #n ")" ::: "memory")
#define PG8_WAIT_L(n) asm volatile("s_waitcnt lgkmcnt(" #n ")" ::: "memory")
#define PG8_BAR __builtin_amdgcn_s_barrier()
#define PG8_SCHED __builtin_amdgcn_sched_barrier(0)
    Unit cur, nxt; int ui = 0;
    if (!S.next(0, cur)) return;
    f32x4 acc[2][2][4][2];
#pragma unroll
    for (int a = 0; a < 2; ++a)
#pragma unroll
        for (int b = 0; b < 2; ++b)
#pragma unroll
            for (int m = 0; m < 4; ++m)
#pragma unroll
                for (int n = 0; n < 2; ++n) acc[a][b][m][n] = (f32x4){0.f, 0.f, 0.f, 0.f};
    bf16x8 At[4][2], B0[2][2], B1[2][2];
    const char* cA = (const char*)g.A + (size_t)cur.pm * tstep; const char* cB = (const char*)g.Bt + (size_t)cur.pn * tstep;
    PG8_STAGE(PG8_SB(0, 0), cB, voffB); PG8_STAGE(PG8_SA(0, 0), cA, voffA); PG8_STAGE(PG8_SB(0, 1), cB + hstep, voffB); PG8_STAGE(PG8_SA(0, 1), cA + hstep, voffA);
    if (wr == 1) PG8_BAR;
    PG8_WAIT_V(4); PG8_BAR;
    PG8_STAGE(PG8_SB(1, 0), cB + kstep, voffB); PG8_STAGE(PG8_SA(1, 0), cA + kstep, voffA); PG8_STAGE(PG8_SB(1, 1), cB + hstep + kstep, voffB);
    PG8_WAIT_V(6); PG8_BAR;
    for (;;) {
        const bool has_next = S.next(ui + 1, nxt);
        const char* nA = has_next ? (const char*)g.A + (size_t)nxt.pm * tstep : cA; const char* nB = has_next ? (const char*)g.Bt + (size_t)nxt.pn * tstep : cB;
        for (int t = 0; t < nt; t += 2) {
            const bool last = (t == nt - 2);
            const char* a1 = cA + (size_t)(t + 1) * kstep;
            const char* a2 = last ? nA : cA + (size_t)(t + 2) * kstep; const char* b2 = last ? nB : cB + (size_t)(t + 2) * kstep;
            const char* a3 = a2 + kstep; const char* b3 = b2 + kstep;
            PG8_LDB(B0, 0, 0); PG8_SCHED; PG8_LDA(At, 0, 0); PG8_STAGE(PG8_SA(1, 1), a1 + hstep, voffA);
            PG8_WAIT_L(8); PG8_BAR; PG8_WAIT_L(0); PG8_MMA(0, 0, At, B0); PG8_BAR; PG8_SCHED;
            PG8_LDB(B1, 0, 1); PG8_STAGE(PG8_SB(0, 0), b2, voffB);
            PG8_BAR; PG8_WAIT_L(0); PG8_MMA(0, 1, At, B1); PG8_BAR;
            PG8_LDA(At, 0, 1); PG8_STAGE(PG8_SA(0, 0), a2, voffA);
            PG8_BAR; PG8_WAIT_L(0); PG8_MMA(1, 0, At, B0); PG8_BAR; PG8_SCHED;
            PG8_STAGE(PG8_SB(0, 1), b2 + hstep, voffB);
            PG8_WAIT_V(6); PG8_BAR; PG8_MMA(1, 1, At, B1); PG8_BAR;
            PG8_LDB(B0, 1, 0); PG8_SCHED; PG8_LDA(At, 1, 0); PG8_STAGE(PG8_SA(0, 1), a2 + hstep, voffA);
            PG8_WAIT_L(8); PG8_BAR; PG8_WAIT_L(0); PG8_MMA(0, 0, At, B0); PG8_BAR; PG8_SCHED;
            PG8_LDB(B1, 1, 1); PG8_STAGE(PG8_SB(1, 0), b3, voffB);
            PG8_BAR; PG8_WAIT_L(0); PG8_MMA(0, 1, At, B1); PG8_BAR;
            PG8_LDA(At, 1, 1); PG8_STAGE(PG8_SA(1, 0), a3, voffA);
            PG8_BAR; PG8_WAIT_L(0); PG8_MMA(1, 0, At, B0); PG8_BAR; PG8_SCHED;
            PG8_STAGE(PG8_SB(1, 1), b3 + hstep, voffB);
            PG8_WAIT_V(6); PG8_BAR; PG8_MMA(1, 1, At, B1); PG8_BAR;
        }
        E(acc, cur, wr, wc, fr, fq);
        if (!has_next) break;
#pragma unroll
        for (int a = 0; a < 2; ++a)
#pragma unroll
            for (int b = 0; b < 2; ++b)
#pragma unroll
                for (int m = 0; m < 4; ++m)
#pragma unroll
                    for (int n = 0; n < 2; ++n) acc[a][b][m][n] = (f32x4){0.f, 0.f, 0.f, 0.f};
        cur = nxt; cA = nA; cB = nB; ++ui;
    }
    PG8_WAIT_V(0);
    if (wr == 0) PG8_BAR;
    PG8_BAR;
#undef PG8_SA
#undef PG8_SB
#undef PG8_STAGE
#undef PG8_LDA
#undef PG8_LDB
#undef PG8_MMA
#undef PG8_WAIT_V
#undef PG8_WAIT_L
#undef PG8_BAR
#undef PG8_SCHED
}
}

struct Ctx {
    const float* xp; const float* xs; const float* stC; const float* stN; const float* stM; const float* ssm; const float* conv; const float* ck; const float* cv;
    float* out; unsigned char* ws;
};
#define XWIN ((bf16_t*)(X.ws + WS_WIN))
#define XWOUT ((bf16_t*)(X.ws + WS_WOUT))
#define XXB ((bf16_t*)(X.ws + WS_XB))
#define XU ((bf16_t*)(X.ws + WS_U))
#define XMIX ((bf16_t*)(X.ws + WS_MIX))
#define XSSQ ((float*)(X.ws + WS_SSQ))
#define XROPE ((float*)(X.ws + WS_ROPE))
#define XMC ((float*)(X.ws + WS_MC))
#define XMN ((float*)(X.ws + WS_MN))
#define XML ((float*)(X.ws + WS_ML))
#define XBL ((float*)(X.ws + WS_BL))
#define XMS ((float*)(X.ws + WS_MS))
#define XSA ((float*)(X.ws + WS_SA))
#define XSH ((float*)(X.ws + WS_SH))
#define XPAR(off) ((const float*)(X.ws + WS_PAR) + (off))
constexpr int P_AIB = 0, P_AFB = 16, P_DTB = 32, P_ALOG = 64, P_BD = 96, P_SINK = 128, P_QNW = 160, P_KNW = 416, P_ANW = 672, P_BNW = 2720, P_CB = 4768, P_CW = 8864, P_END = 25248;
#define IN_XP 0
#define IN_XS 1
#define IN_STC 2
#define IN_STN 3
#define IN_STM 4
#define IN_SSM 5
#define IN_CONV 6
#define IN_CK 7
#define IN_CV 8
#define IN_NORMW 9
#define IN_WIN 10
#define IN_AIB 11
#define IN_AFB 12
#define IN_ANW 13
#define IN_CW 14
#define IN_CB 15
#define IN_DTB 16
#define IN_ALOG 17
#define IN_BD 18
#define IN_BNW 19
#define IN_QNW 20
#define IN_KNW 21
#define IN_SINK 22
#define IN_WOUT 23

__device__ __forceinline__ void transpose_tile(lptr lds, const float* src, int ldn, int nvalid, bf16_t* dst, int ldk, const float* scale, int k0, int n0, int tid) {
    LAS float* T = (LAS float*)lds;
#pragma unroll
    for (int it = 0; it < 2; ++it) {
        const int r = (tid >> 4) + it * 32, c4 = (tid & 15) * 4, n = n0 + c4;
        f32x4 v = {0.f, 0.f, 0.f, 0.f};
        if (n < nvalid) v = *(const f32x4*)(src + (size_t)(k0 + r) * ldn + n);
        const float sc = scale ? scale[k0 + r] : 1.f;
        T[r * 65 + c4 + 0] = v[0] * sc; T[r * 65 + c4 + 1] = v[1] * sc; T[r * 65 + c4 + 2] = v[2] * sc; T[r * 65 + c4 + 3] = v[3] * sc;
    }
    __syncthreads();
    {
        const int n = tid >> 3, k8 = (tid & 7) * 8; float f[8];
#pragma unroll
        for (int j = 0; j < 8; ++j) f[j] = T[(k8 + j) * 65 + n];
        *(u32x4*)(dst + (size_t)(n0 + n) * ldk + k0 + k8) = pack8(f);
    }
    __syncthreads();
}

__device__ __forceinline__ void prologue(lptr lds, const Ctx& X, const Args& args, int G, int bid, int tid) {
    const int lane = tid & 63, wave = tid >> 6;
    constexpr int T0 = 5120, T1 = T0 + 1536, T2 = T1 + 2080, T3 = T2 + 1, T4 = T3 + 513;
    for (int task = bid; task < T4; task += G) {
        if (task < T0) {
            const int l = task / 1280, r = task % 1280, kt = r / 80, ntl = r % 80;
            transpose_tile(lds, args.in[IN_WIN] + (size_t)l * D * DIN, DIN, DIN, XWIN + (size_t)l * NIN * D, D, args.in[IN_NORMW] + l * D, kt * 64, ntl * 64, tid);
        } else if (task < T1) {
            const int t = task - T0, l = t / 384, r = t % 384, kt = r / 16, ntl = r % 16;
            transpose_tile(lds, args.in[IN_WOUT] + (size_t)l * DMIX * D, D, D, XWOUT + (size_t)l * D * DMIX, DMIX, nullptr, kt * 64, ntl * 64, tid);
        } else if (task < T2) {
            const int r = (task - T1) * 8 + wave;
            float ss = 0.f;
            if (r < MTOK) {
                const float* src = r < TP ? X.xp + (size_t)r * D : X.xs + (size_t)(r - TP) * D;
#pragma unroll
                for (int i = 0; i < 4; ++i) {
                    const int c = lane * 4 + i * 256; f32x4 v = *(const f32x4*)(src + c);
                    ss += v[0] * v[0] + v[1] * v[1] + v[2] * v[2] + v[3] * v[3];
                    u32x2 w; w[0] = pk2(v[0], v[1]); w[1] = pk2(v[2], v[3]);
                    *(u32x2*)(XXB + (size_t)r * D + c) = w;
                }
            } else {
#pragma unroll
                for (int i = 0; i < 4; ++i) { u32x2 w = {0u, 0u}; *(u32x2*)(XXB + (size_t)r * D + lane * 4 + i * 256) = w; }
            }
            ss = wave_sum(ss);
            if (lane < 16) XSSQ[(size_t)r * 16 + lane] = (lane == 0) ? ss : 0.f;
        } else if (task < T3) {
            for (int i = tid; i < (MPAD - MTOK) * DMIX / 2; i += NT) ((unsigned*)(XMIX + (size_t)MTOK * DMIX))[i] = 0u;
            float* P = (float*)(X.ws + WS_PAR);
            const int po[12] = {P_AIB, P_AFB, P_DTB, P_ALOG, P_BD, P_SINK, P_QNW, P_KNW, P_ANW, P_BNW, P_CB, P_CW};
            const int pn[12] = {16, 16, 32, 32, 32, 32, 256, 256, 2048, 2048, 4096, 16384};
            const int pi[12] = {IN_AIB, IN_AFB, IN_DTB, IN_ALOG, IN_BD, IN_SINK, IN_QNW, IN_KNW, IN_ANW, IN_BNW, IN_CB, IN_CW};
#pragma unroll
            for (int a = 0; a < 12; ++a) { const float* src = args.in[pi[a]]; for (int i = tid; i < pn[a]; i += NT) P[po[a] + i] = src[i]; }
        } else {
            const int e = (task - T3) * 512 + tid;
            if (e < 8193 * 32) {
                const int pos = e >> 5, d = e & 31;
                const float inv = (float)exp2(-(double)d * (13.287712379549449 / 32.0));
                const float angf = (float)pos * inv;
                const double a = (double)angf;
                const double k = rint(a * 0.15915494309189535);
                const float rr = (float)(a - k * 6.283185307179586);
                XROPE[(size_t)e * 2] = cosf(rr); XROPE[(size_t)e * 2 + 1] = sinf(rr);
            }
        }
    }
}

__device__ __forceinline__ void conv8(const bf16_t* u, int seq0, int tt, int ch, const float* cw, const float* cb, float (&o)[8]) {
    float acc[8];
    { f32x4 b0 = *(const f32x4*)(cb + ch), b1 = *(const f32x4*)(cb + ch + 4);
#pragma unroll
      for (int j = 0; j < 4; ++j) { acc[j] = b0[j]; acc[4 + j] = b1[j]; } }
#pragma unroll
    for (int jj = 0; jj < 4; ++jj) {
        const int t2 = tt + jj - 3;
        if (t2 >= 0) {
            float x[8]; unpack8(*(const u32x4*)(u + (size_t)(seq0 + t2) * NIN + C_BX + ch), x);
            f32x4 w0 = *(const f32x4*)(cw + jj * 1024 + ch), w1 = *(const f32x4*)(cw + jj * 1024 + ch + 4);
#pragma unroll
            for (int j = 0; j < 4; ++j) { acc[j] += x[j] * w0[j]; acc[4 + j] += x[4 + j] * w1[j]; }
        }
    }
#pragma unroll
    for (int j = 0; j < 8; ++j) o[j] = siluf_(acc[j]);
}


__device__ __forceinline__ void conv8x8(const bf16_t* u, int seq0, int tt0, int ch, const float* cw, const float* cb, float (&o)[8][8]) {
    float w[4][8];
#pragma unroll
    for (int jj = 0; jj < 4; ++jj) { f32x4 w0 = *(const f32x4*)(cw + jj * 1024 + ch), w1 = *(const f32x4*)(cw + jj * 1024 + ch + 4);
#pragma unroll
        for (int j = 0; j < 4; ++j) { w[jj][j] = w0[j]; w[jj][4 + j] = w1[j]; } }
    { f32x4 b0 = *(const f32x4*)(cb + ch), b1 = *(const f32x4*)(cb + ch + 4);
#pragma unroll
      for (int t = 0; t < 8; ++t)
#pragma unroll
          for (int j = 0; j < 4; ++j) { o[t][j] = b0[j]; o[t][4 + j] = b1[j]; } }
    u32x4 raw[11];
#pragma unroll
    for (int r = 0; r < 11; ++r) {
        const int t2 = tt0 + r - 3;
        raw[r] = (u32x4){0u, 0u, 0u, 0u};
        if (t2 >= 0) raw[r] = *(const u32x4*)(u + (size_t)(seq0 + t2) * NIN + C_BX + ch);
    }
#pragma unroll
    for (int r = 0; r < 11; ++r) {
        float x[8]; unpack8(raw[r], x);
#pragma unroll
        for (int jj = 0; jj < 4; ++jj) {
            const int t = r - jj;
            if (t >= 0 && t < 8) {
#pragma unroll
                for (int j = 0; j < 8; ++j) o[t][j] += x[j] * w[jj][j];
            }
        }
    }
#pragma unroll
    for (int t = 0; t < 8; ++t)
#pragma unroll
        for (int j = 0; j < 8; ++j) o[t][j] = siluf_(o[t][j]);
}

__device__ __forceinline__ void mlstm_local(lptr lds, const Ctx& X, int l, int task, int tid) {
    const int h = task & 3, c = (task >> 2) & 127, n = task >> 9;
    const int lane = tid & 63, wave = tid >> 6, fr = lane & 15, fq = lane >> 4;
    const int row0 = n * SEQ + c * 64, nh = n * 4 + h;
    lptr VwT = lds;
    lptr KT = lds + 18432;
    LAS float* wv = (LAS float*)(lds + 27648);
    u32x4 vraw[2], kraw;
#pragma unroll
    for (int it = 0; it < 2; ++it) { const int p = tid + it * NT, tok = p >> 4, v8 = (p & 15) * 8; vraw[it] = *(const u32x4*)(XU + (size_t)(row0 + tok) * NIN + C_AV + h * 128 + v8); }
    { const int tok = tid >> 3, k8 = (tid & 7) * 8; kraw = *(const u32x4*)(XU + (size_t)(row0 + tok) * NIN + C_AK + h * 64 + k8); }
    if (wave == 0) {
        const bf16_t* ur = XU + (size_t)(row0 + lane) * NIN;
        const float fg = bf2f(ur[C_AF + h]) + XPAR(P_AFB)[l * 4 + h], ig = bf2f(ur[C_AI + h]) + XPAR(P_AIB)[l * 4 + h];
        const float b = wave_scan_sum(logsigf_(fg), lane);
        const float bl = __shfl(b, 63);
        const float g = bl - b + ig;
        const float ml = wave_max(g);
        wv[lane] = __expf(g - ml);
        if (lane == 0) { XML[nh * 128 + c] = ml; XBL[nh * 128 + c] = bl; }
    }
    __syncthreads();
#pragma unroll
    for (int it = 0; it < 2; ++it) {
        const int p = tid + it * NT, tok = p >> 4, v8 = (p & 15) * 8;
        float x[8]; unpack8(vraw[it], x);
        const float w = wv[tok];
#pragma unroll
        for (int j = 0; j < 8; ++j) *(LAS bf16_t*)(VwT + (((v8 + j) * 72 + tok) << 1)) = (bf16_t)f2bf(x[j] * w);
    }
    {
        const int tok = tid >> 3, k8 = (tid & 7) * 8;
        float x[8]; unpack8(kraw, x);
#pragma unroll
        for (int j = 0; j < 8; ++j) *(LAS bf16_t*)(KT + (((k8 + j) * 72 + tok) << 1)) = (bf16_t)f2bf(x[j] * 0.125f);
    }
    __syncthreads();
    {
        float* dst = XMC + ((size_t)nh * 128 + c) * 8192;
        bf16x8 b0 = lds_frag(VwT, 16 * wave + fr, fq * 8, 72), b1 = lds_frag(VwT, 16 * wave + fr, 32 + fq * 8, 72);
#pragma unroll
        for (int mt = 0; mt < 4; ++mt) {
            f32x4 acc = {0.f, 0.f, 0.f, 0.f};
            acc = mfma16(lds_frag(KT, 16 * mt + fr, fq * 8, 72), b0, acc);
            acc = mfma16(lds_frag(KT, 16 * mt + fr, 32 + fq * 8, 72), b1, acc);
            *(f32x4*)(dst + (16 * wave + fr) * 64 + 16 * mt + 4 * fq) = acc;
        }
    }
    if (tid < 64) {
        float s = 0.f;
#pragma unroll 8
        for (int t = 0; t < 64; ++t) s += bf2f(*(const LAS bf16_t*)(KT + ((tid * 72 + t) << 1))) * wv[t];
        XMN[((size_t)nh * 128 + c) * 64 + tid] = s;
    }
    __syncthreads();
}

__device__ __forceinline__ void ssd_local(lptr lds, const Ctx& X, int l, int task, int tid) {
    const int g = task & 1, c = (task >> 1) & 127, n = task >> 8;
    const int lane = tid & 63, wave = tid >> 6, fr = lane & 15, fq = lane >> 4;
    const int seq0 = n * SEQ, row0 = seq0 + c * 64;
    lptr XwT = lds;
    lptr BT = lds + 36864;
    LAS float* wl = (LAS float*)(lds + 55296);
    {
        const float* cw = XPAR(P_CW) + l * 4096; const float* cb = XPAR(P_CB) + l * 1024;
        const int cg = lane;
        float o[8][8];
        {
            const int cgc = cg < 48 ? cg : 47;
            const int ch = cgc < 32 ? g * 256 + cgc * 8 : 512 + g * 128 + (cgc - 32) * 8;
            conv8x8(XU, seq0, c * 64 + 8 * wave, ch, cw, cb, o);
        }
    if (wave < 4) {
        const int hh = 4 * g + wave;
        const float dt = softplusf_(bf2f(XU[(size_t)(row0 + lane) * NIN + C_BDT + hh]) + XPAR(P_DTB)[l * 8 + hh]);
        const float A = -__expf(XPAR(P_ALOG)[l * 8 + hh]);
        const float a = wave_scan_sum(dt * A, lane);
        const float aL = __shfl(a, 63);
        wl[wave * 64 + lane] = __expf(aL - a) * dt;
        if (lane == 0) XSA[(n * 8 + hh) * 128 + c] = aL;
    }
    __syncthreads();
        if (cg < 48) {
            if (cg < 32) {
                float wt[8];
#pragma unroll
                for (int t = 0; t < 8; ++t) wt[t] = wl[(cg >> 3) * 64 + 8 * wave + t];
#pragma unroll
                for (int jx = 0; jx < 8; ++jx) {
                    float v[8];
#pragma unroll
                    for (int t = 0; t < 8; ++t) v[t] = o[t][jx] * wt[t];
                    *(LAS u32x4*)(XwT + (((cg * 8 + jx) * 72 + 8 * wave) << 1)) = pack8(v);
                }
            } else {
#pragma unroll
                for (int jx = 0; jx < 8; ++jx) {
                    float v[8];
#pragma unroll
                    for (int t = 0; t < 8; ++t) v[t] = o[t][jx];
                    *(LAS u32x4*)(BT + ((((cg - 32) * 8 + jx) * 72 + 8 * wave) << 1)) = pack8(v);
                }
            }
        }
    }
    __syncthreads();
    {
        const int hl = wave >> 1, ph = wave & 1, hh = 4 * g + hl;
        float* dst = XSH + ((size_t)(n * 8 + hh) * 128 + c) * 8192;
        bf16x8 bx[2][2];
#pragma unroll
        for (int ntl = 0; ntl < 2; ++ntl)
#pragma unroll
            for (int kk = 0; kk < 2; ++kk) bx[ntl][kk] = lds_frag(XwT, hl * 64 + ph * 32 + ntl * 16 + fr, kk * 32 + fq * 8, 72);
#pragma unroll
        for (int mt = 0; mt < 8; ++mt) {
            bf16x8 a0 = lds_frag(BT, 16 * mt + fr, fq * 8, 72), a1 = lds_frag(BT, 16 * mt + fr, 32 + fq * 8, 72);
#pragma unroll
            for (int ntl = 0; ntl < 2; ++ntl) {
                f32x4 acc = {0.f, 0.f, 0.f, 0.f};
                acc = mfma16(a0, bx[ntl][0], acc); acc = mfma16(a1, bx[ntl][1], acc);
                *(f32x4*)(dst + (ph * 32 + ntl * 16 + fr) * 128 + 16 * mt + 4 * fq) = acc;
            }
        }
    }
    __syncthreads();
}

__device__ __forceinline__ void swa_prompt(lptr lds, const Ctx& X, int l, int task, int tid) {
    const int kvh = task & 1, qb = (task >> 1) & 63, n = task >> 7;
    const int lane = tid & 63, wave = tid >> 6, fr = lane & 15, fq = lane >> 4;
    const int seq0 = n * SEQ;
    lptr Kn = lds;
    lptr Vt = lds + 36864;
    lptr Pw = lds + 70656 + wave * 8448;
    const float* knw = XPAR(P_KNW) + l * 64; const float* qnw = XPAR(P_QNW) + l * 64;
#pragma unroll
    for (int it = 0; it < 2; ++it) {
        const int item = tid + it * NT, j = item >> 2, qd = item & 3, t = qb * 128 - 128 + j;
        float o1[8], o2[8];
        if (t >= 0) {
            const bf16_t* kr = XU + (size_t)(seq0 + t) * NIN + C_CK + kvh * 64;
            float x1[8], x2[8]; unpack8(*(const u32x4*)(kr + qd * 8), x1); unpack8(*(const u32x4*)(kr + 32 + qd * 8), x2);
            float ss = 0.f;
#pragma unroll
            for (int jj = 0; jj < 8; ++jj) ss += x1[jj] * x1[jj] + x2[jj] * x2[jj];
            ss += __shfl_xor(ss, 1); ss += __shfl_xor(ss, 2);
            const float rs = rsqrtf(ss * (1.f / 64.f) + EPS);
            const float* cs = XROPE + ((size_t)t * 32 + qd * 8) * 2;
#pragma unroll
            for (int jj = 0; jj < 8; ++jj) {
                const float a = x1[jj] * rs * knw[qd * 8 + jj], b = x2[jj] * rs * knw[32 + qd * 8 + jj], co = cs[2 * jj], si = cs[2 * jj + 1];
                o1[jj] = a * co - b * si; o2[jj] = b * co + a * si;
            }
        } else {
#pragma unroll
            for (int jj = 0; jj < 8; ++jj) { o1[jj] = 0.f; o2[jj] = 0.f; }
        }
        *(LAS u32x4*)(Kn + ((j * 72 + qd * 8) << 1)) = pack8(o1);
        *(LAS u32x4*)(Kn + ((j * 72 + 32 + qd * 8) << 1)) = pack8(o2);
        if (qb == 63 && j >= 128) {
            float* ko = X.out + O_PK + ((((size_t)l * 2 + n) * 128 + (j - 128)) * 2 + kvh) * 64;
            *(f32x4*)(ko + qd * 8) = (f32x4){o1[0], o1[1], o1[2], o1[3]}; *(f32x4*)(ko + qd * 8 + 4) = (f32x4){o1[4], o1[5], o1[6], o1[7]};
            *(f32x4*)(ko + 32 + qd * 8) = (f32x4){o2[0], o2[1], o2[2], o2[3]}; *(f32x4*)(ko + 32 + qd * 8 + 4) = (f32x4){o2[4], o2[5], o2[6], o2[7]};
        }
    }
#pragma unroll
    for (int it = 0; it < 4; ++it) {
        const int item = tid + it * NT, j = item >> 3, d8 = (item & 7) * 8, t = qb * 128 - 128 + j;
        u32x4 w = {0u, 0u, 0u, 0u};
        if (t >= 0) w = *(const u32x4*)(XU + (size_t)(seq0 + t) * NIN + C_CV + kvh * 64 + d8);
#pragma unroll
        for (int jj = 0; jj < 8; ++jj) *(LAS bf16_t*)(Vt + (((d8 + jj) * 264 + j) << 1)) = (bf16_t)((w[jj >> 1] >> ((jj & 1) * 16)) & 0xffffu);
        if (qb == 63 && j >= 128) {
            float x[8]; unpack8(w, x);
            float* vo = X.out + O_PV + ((((size_t)l * 2 + n) * 128 + (j - 128)) * 2 + kvh) * 64 + d8;
            *(f32x4*)(vo) = (f32x4){x[0], x[1], x[2], x[3]}; *(f32x4*)(vo + 4) = (f32x4){x[4], x[5], x[6], x[7]};
        }
    }
    __syncthreads();
    const int hq = kvh * 4 + (wave >> 1), i0 = (wave & 1) * 64;
    const float sink = XPAR(P_SINK)[l * 8 + hq];
#pragma unroll 1
    for (int mt = 0; mt < 4; ++mt) {
        bf16x8 a0, a1;
        {
            const int i = i0 + mt * 16 + fr, t = qb * 128 + i;
            const bf16_t* qr = XU + (size_t)(seq0 + t) * NIN + C_CQ + hq * 64;
            float x1[8], x2[8]; unpack8(*(const u32x4*)(qr + fq * 8), x1); unpack8(*(const u32x4*)(qr + 32 + fq * 8), x2);
            float ss = 0.f;
#pragma unroll
            for (int jj = 0; jj < 8; ++jj) ss += x1[jj] * x1[jj] + x2[jj] * x2[jj];
            ss += __shfl_xor(ss, 16); ss += __shfl_xor(ss, 32);
            const float rs = rsqrtf(ss * (1.f / 64.f) + EPS) * 0.125f;
            const float* cs = XROPE + ((size_t)t * 32 + fq * 8) * 2;
            float o1[8], o2[8];
#pragma unroll
            for (int jj = 0; jj < 8; ++jj) {
                const float a = x1[jj] * rs * qnw[fq * 8 + jj], b = x2[jj] * rs * qnw[32 + fq * 8 + jj], co = cs[2 * jj], si = cs[2 * jj + 1];
                o1[jj] = a * co - b * si; o2[jj] = b * co + a * si;
            }
            a0 = as_frag(pack8(o1)); a1 = as_frag(pack8(o2));
        }
        f32x4 s[16];
#pragma unroll
        for (int ntl = 0; ntl < 16; ++ntl) {
            f32x4 acc = {0.f, 0.f, 0.f, 0.f};
            acc = mfma16(a0, lds_frag(Kn, 16 * ntl + fr, fq * 8, 72), acc);
            acc = mfma16(a1, lds_frag(Kn, 16 * ntl + fr, 32 + fq * 8, 72), acc);
            s[ntl] = acc;
        }
        float mx[4] = {-3.0e38f, -3.0e38f, -3.0e38f, -3.0e38f};
#pragma unroll
        for (int ntl = 0; ntl < 16; ++ntl)
#pragma unroll
            for (int ii = 0; ii < 4; ++ii) {
                const int qi = i0 + mt * 16 + fq * 4 + ii, j = 16 * ntl + fr;
                const bool valid = (j > qi) && (j <= qi + 128) && (qb > 0 || j >= 128);
                s[ntl][ii] = valid ? s[ntl][ii] : -3.0e38f;
                mx[ii] = fmaxf(mx[ii], s[ntl][ii]);
            }
        float sum[4];
#pragma unroll
        for (int ii = 0; ii < 4; ++ii) { mx[ii] = fmaxf(red16max(mx[ii]), sink); sum[ii] = 0.f; }
#pragma unroll
        for (int ntl = 0; ntl < 16; ++ntl)
#pragma unroll
            for (int ii = 0; ii < 4; ++ii) { const float e = (s[ntl][ii] > -1.0e38f) ? __expf(s[ntl][ii] - mx[ii]) : 0.f; s[ntl][ii] = e; sum[ii] += e; }
#pragma unroll
        for (int ii = 0; ii < 4; ++ii) sum[ii] = 1.f / (red16(sum[ii]) + __expf(sink - mx[ii]));
#pragma unroll
        for (int ntl = 0; ntl < 16; ++ntl)
#pragma unroll
            for (int ii = 0; ii < 4; ++ii) *(LAS bf16_t*)(Pw + (((fq * 4 + ii) * 264 + 16 * ntl + fr) << 1)) = (bf16_t)f2bf(s[ntl][ii] * sum[ii]);
        LDS_FENCE();
        f32x4 o[4];
#pragma unroll
        for (int ntl = 0; ntl < 4; ++ntl) o[ntl] = (f32x4){0.f, 0.f, 0.f, 0.f};
#pragma unroll
        for (int kk = 0; kk < 8; ++kk) {
            const bf16x8 a = lds_frag(Pw, fr, kk * 32 + fq * 8, 264);
#pragma unroll
            for (int ntl = 0; ntl < 4; ++ntl) o[ntl] = mfma16(a, lds_frag(Vt, 16 * ntl + fr, kk * 32 + fq * 8, 264), o[ntl]);
        }
        LDS_FENCE();
#pragma unroll
        for (int ii = 0; ii < 4; ++ii) {
            const size_t row = (size_t)seq0 + qb * 128 + i0 + mt * 16 + fq * 4 + ii;
#pragma unroll
            for (int ntl = 0; ntl < 4; ++ntl) {
                const int d = 16 * ntl + fr;
                const float cz = bf2f(XU[row * NIN + C_CZ + hq * 64 + d]);
                XMIX[row * DMIX + 1024 + hq * 64 + d] = (bf16_t)f2bf(o[ntl][ii] * siluf_(cz));
            }
        }
    }
    __syncthreads();
}

__device__ __forceinline__ void sample_task(lptr lds, const Ctx& X, int l, int b, int part, int tid) {
    LAS float* uf = (LAS float*)lds;
    LAS float* xbc = (LAS float*)(lds + 19968);
    LAS float* numv = (LAS float*)(lds + 24064);
    LAS float* yv = (LAS float*)(lds + 26112);
    LAS float* red = (LAS float*)(lds + 28160);
    LAS float* qs = (LAS float*)(lds + 28416);
    LAS float* kn = (LAS float*)(lds + 30464);
    LAS float* sc = (LAS float*)(lds + 30976);
    const int lane = tid & 63, wave = tid >> 6;
    const size_t row = (size_t)TP + b;
    const bf16_t* ur = XU + row * NIN;
    const size_t lb = (size_t)l * 128 + b;
    {
        const int c_lo = part == 0 ? 0 : (part == 1 ? C_BZ : C_CQ), c_hi = part == 0 ? C_BZ : (part == 1 ? C_CQ : DIN);
#pragma unroll 2
        for (int i = c_lo + tid; i < c_hi; i += NT) uf[i] = bf2f(ur[i]);
    }
    __syncthreads();
    if (part == 0) {
#pragma unroll 2
    for (int h = 0; h < 4; ++h) {
        const float ig = uf[C_AI + h] + XPAR(P_AIB)[l * 4 + h], fg = uf[C_AF + h] + XPAR(P_AFB)[l * 4 + h];
        const float ls = logsigf_(fg), m0 = X.stM[lb * 4 + h];
        const float mn = fmaxf(ls + m0, ig), sp = __expf(ls + m0 - mn), sl = __expf(ig - mn);
        const float* C0 = X.stC + (lb * 4 + h) * 8192; float* C1 = X.out + O_SC + (lb * 4 + h) * 8192;
#pragma unroll
        for (int it = 0; it < 4; ++it) {
            const int e = (tid + it * NT) * 4, v = e >> 6, k = e & 63;
            const f32x4 c0 = *(const f32x4*)(C0 + e);
            const float vv = uf[C_AV + h * 128 + v] * sl;
            f32x4 c1; float part = 0.f;
#pragma unroll
            for (int j = 0; j < 4; ++j) { c1[j] = sp * c0[j] + vv * (uf[C_AK + h * 64 + k + j] * 0.125f); part += c1[j] * uf[C_AQ + h * 64 + k + j]; }
            *(f32x4*)(C1 + e) = c1;
            part = red16(part);
            if ((lane & 15) == 0) numv[h * 128 + v] = part;
        }
        if (wave == 0) {
            const float n1 = sp * X.stN[(lb * 4 + h) * 64 + lane] + sl * uf[C_AK + h * 64 + lane] * 0.125f;
            X.out[O_SN + (lb * 4 + h) * 64 + lane] = n1;
            const float dd = wave_sum(n1 * uf[C_AQ + h * 64 + lane]);
            if (lane == 0) { red[h] = dd; red[4 + h] = mn; X.out[O_SM + lb * 4 + h] = mn; }
        }
    }
    __syncthreads();
    float hv;
    { const int h = tid >> 7; hv = numv[tid] / fmaxf(fabsf(red[h]), __expf(-red[4 + h])); const float ss = wave_sum(hv * hv); if (lane == 0) red[8 + wave] = ss; }
    __syncthreads();
    { const int h = tid >> 7; const float rs = rsqrtf((red[8 + 2 * h] + red[9 + 2 * h]) * (1.f / 128.f) + EPS);
      XMIX[row * DMIX + tid] = (bf16_t)f2bf(hv * rs * XPAR(P_ANW)[l * 512 + tid] * sigmoidf_(uf[C_AO + tid]) * siluf_(uf[C_AZ + tid])); }
    }
    if (part == 1) {
    {
        const float* buf = X.conv + lb * 3 * 1024; float* oc = X.out + O_SCONV + lb * 3 * 1024;
        const float* cw = XPAR(P_CW) + l * 4096;
#pragma unroll
        for (int it = 0; it < 2; ++it) {
            const int ch = tid + it * NT;
            const float f0 = buf[ch], f1 = buf[1024 + ch], f2 = buf[2048 + ch], f3 = uf[C_BX + ch];
            const float acc = XPAR(P_CB)[l * 1024 + ch] + f0 * cw[ch] + f1 * cw[1024 + ch] + f2 * cw[2048 + ch] + f3 * cw[3072 + ch];
            xbc[ch] = siluf_(acc);
            oc[ch] = f1; oc[1024 + ch] = f2; oc[2048 + ch] = f3;
        }
    }
    __syncthreads();
#pragma unroll 2
    for (int hh = 0; hh < 8; ++hh) {
        const float dt = softplusf_(uf[C_BDT + hh] + XPAR(P_DTB)[l * 8 + hh]);
        const float dA = __expf(-dt * __expf(XPAR(P_ALOG)[l * 8 + hh]));
        const int g = hh >> 2;
        const float* h0p = X.ssm + (lb * 8 + hh) * 8192; float* h1p = X.out + O_SH + (lb * 8 + hh) * 8192;
#pragma unroll
        for (int it = 0; it < 4; ++it) {
            const int e = (tid + it * NT) * 4, p = e >> 7, s = e & 127;
            const f32x4 h0 = *(const f32x4*)(h0p + e);
            const float xv = xbc[hh * 64 + p] * dt;
            f32x4 h1; float part = 0.f;
#pragma unroll
            for (int j = 0; j < 4; ++j) { h1[j] = dA * h0[j] + xv * xbc[512 + g * 128 + s + j]; part += h1[j] * xbc[768 + g * 128 + s + j]; }
            *(f32x4*)(h1p + e) = h1;
            part = red16(part); part += __shfl_xor(part, 16);
            if ((lane & 31) == 0) yv[hh * 64 + p] = part;
        }
    }
    __syncthreads();
    float gb;
    { const int hh = tid >> 6; const float y = yv[tid] + XPAR(P_BD)[l * 8 + hh] * xbc[tid]; gb = y * siluf_(uf[C_BZ + tid]); const float ss = wave_sum(gb * gb); if (lane == 0) red[16 + wave] = ss; }
    __syncthreads();
    { const int g = tid >> 8; const float rs = rsqrtf((red[16 + 4 * g] + red[17 + 4 * g] + red[18 + 4 * g] + red[19 + 4 * g]) * (1.f / 256.f) + EPS);
      XMIX[row * DMIX + 512 + tid] = (bf16_t)f2bf(gb * rs * XPAR(P_BNW)[l * 512 + tid]); }
    }
    if (part == 2) {
    if (tid < 320) {
        const int vec = tid >> 5, d = tid & 31, base = vec < 8 ? C_CQ + vec * 64 : C_CK + (vec - 8) * 64;
        const float x1 = uf[base + d], x2 = uf[base + 32 + d];
        float ss = x1 * x1 + x2 * x2; ss = red16(ss); ss += __shfl_xor(ss, 16);
        const float rs = rsqrtf(ss * (1.f / 64.f) + EPS);
        const float* w = vec < 8 ? XPAR(P_QNW) + l * 64 : XPAR(P_KNW) + l * 64;
        const float a = x1 * rs * w[d], bb = x2 * rs * w[d + 32];
        const float co = XROPE[((size_t)8192 * 32 + d) * 2], si = XROPE[((size_t)8192 * 32 + d) * 2 + 1];
        const float o1 = a * co - bb * si, o2 = bb * co + a * si;
        if (vec < 8) { qs[vec * 64 + d] = o1 * 0.125f; qs[vec * 64 + 32 + d] = o2 * 0.125f; } else { kn[(vec - 8) * 64 + d] = o1; kn[(vec - 8) * 64 + 32 + d] = o2; }
    }
    __syncthreads();
    const float* kc = X.ck + lb * 16384; const float* vc = X.cv + lb * 16384;
    {
        float* ko = X.out + O_SK + lb * 16384; float* vo = X.out + O_SV + lb * 16384;
#pragma unroll 4
        for (int it = 0; it < 8; ++it) {
            const int e = (tid + it * NT) * 4, j = e >> 7, r = e & 127;
            f32x4 kv, vv;
            if (j < 127) { kv = *(const f32x4*)(kc + e + 128); vv = *(const f32x4*)(vc + e + 128); }
            else { kv = (f32x4){kn[r], kn[r + 1], kn[r + 2], kn[r + 3]}; vv = (f32x4){uf[C_CV + r], uf[C_CV + r + 1], uf[C_CV + r + 2], uf[C_CV + r + 3]}; }
            *(f32x4*)(ko + e) = kv; *(f32x4*)(vo + e) = vv;
        }
    }
    if (tid < 256) {
        const int kvh = tid >> 7, jj = tid & 127;
        float s0 = 0.f, s1 = 0.f, s2 = 0.f, s3 = 0.f;
#pragma unroll 4
        for (int d4 = 0; d4 < 16; ++d4) {
            f32x4 kv;
            if (jj < 127) kv = *(const f32x4*)(kc + (jj + 1) * 128 + kvh * 64 + d4 * 4);
            else kv = (f32x4){kn[kvh * 64 + d4 * 4], kn[kvh * 64 + d4 * 4 + 1], kn[kvh * 64 + d4 * 4 + 2], kn[kvh * 64 + d4 * 4 + 3]};
#pragma unroll
            for (int j = 0; j < 4; ++j) {
                s0 += kv[j] * qs[(kvh * 4 + 0) * 64 + d4 * 4 + j]; s1 += kv[j] * qs[(kvh * 4 + 1) * 64 + d4 * 4 + j];
                s2 += kv[j] * qs[(kvh * 4 + 2) * 64 + d4 * 4 + j]; s3 += kv[j] * qs[(kvh * 4 + 3) * 64 + d4 * 4 + j];
            }
        }
        sc[(kvh * 4 + 0) * 128 + jj] = s0; sc[(kvh * 4 + 1) * 128 + jj] = s1; sc[(kvh * 4 + 2) * 128 + jj] = s2; sc[(kvh * 4 + 3) * 128 + jj] = s3;
    }
    __syncthreads();
    {
        const int hq = wave; const float s0 = sc[hq * 128 + lane], s1 = sc[hq * 128 + 64 + lane], sink = XPAR(P_SINK)[l * 8 + hq];
        const float m = fmaxf(wave_max(fmaxf(s0, s1)), sink);
        const float e0 = __expf(s0 - m), e1 = __expf(s1 - m);
        const float inv = 1.f / (wave_sum(e0 + e1) + __expf(sink - m));
        sc[hq * 128 + lane] = e0 * inv; sc[hq * 128 + 64 + lane] = e1 * inv;
    }
    __syncthreads();
    {
        const int hq = tid >> 6, d = tid & 63, kvh = hq >> 2;
        float o = 0.f;
#pragma unroll 16
        for (int jj = 0; jj < 127; ++jj) o += sc[hq * 128 + jj] * vc[(jj + 1) * 128 + kvh * 64 + d];
        o += sc[hq * 128 + 127] * uf[C_CV + kvh * 64 + d];
        XMIX[row * DMIX + 1024 + tid] = (bf16_t)f2bf(o * siluf_(uf[C_CZ + tid]));
    }
    }
    __syncthreads();
}

__device__ __forceinline__ void scans(const Ctx& X, int l, int gt, int nthreads) {
    for (int item = gt; item < 98816; item += nthreads) {
        if (item < 32768) {
            const int nh = item >> 12, e = (item & 4095) * 2;
            float* base = XMC + (size_t)nh * 128 * 8192 + e;
            const float* ml = XML + nh * 128; const float* bl = XBL + nh * 128;
            float m = 0.f; f32x2 st = {0.f, 0.f};
            for (int c0 = 0; c0 < 128; c0 += 8) {
                f32x2 cl[8];
#pragma unroll
                for (int j = 0; j < 8; ++j) cl[j] = *(const f32x2*)(base + (size_t)(c0 + j) * 8192);
#pragma unroll
                for (int j = 0; j < 8; ++j) {
                    const float mlj = ml[c0 + j], blj = bl[c0 + j], mn = fmaxf(blj + m, mlj), sp = __expf(blj + m - mn), sl = __expf(mlj - mn);
                    *(f32x2*)(base + (size_t)(c0 + j) * 8192) = st;
                    if (e == 0) XMS[nh * 128 + c0 + j] = m;
                    st = st * sp + cl[j] * sl; m = mn;
                }
            }
            *(f32x2*)(X.out + O_PC + ((size_t)l * 8 + nh) * 8192 + e) = st;
            if (e == 0) X.out[O_PM + l * 8 + nh] = m;
        } else if (item < 98304) {
            const int i1 = item - 32768, nhh = i1 >> 12, e = (i1 & 4095) * 2;
            float* base = XSH + (size_t)nhh * 128 * 8192 + e;
            const float* al = XSA + nhh * 128;
            f32x2 st = {0.f, 0.f};
            for (int c0 = 0; c0 < 128; c0 += 8) {
                f32x2 cl[8];
#pragma unroll
                for (int j = 0; j < 8; ++j) cl[j] = *(const f32x2*)(base + (size_t)(c0 + j) * 8192);
#pragma unroll
                for (int j = 0; j < 8; ++j) {
                    const float dec = __expf(al[c0 + j]);
                    *(f32x2*)(base + (size_t)(c0 + j) * 8192) = st;
                    st = st * dec + cl[j];
                }
            }
            *(f32x2*)(X.out + O_PH + ((size_t)l * 16 + nhh) * 8192 + e) = st;
        } else {
            const int i2 = item - 98304, nh = i2 >> 6, k = i2 & 63;
            float* base = XMN + (size_t)nh * 128 * 64 + k;
            const float* ml = XML + nh * 128; const float* bl = XBL + nh * 128;
            float m = 0.f, st = 0.f;
            for (int c = 0; c < 128; ++c) {
                const float mlj = ml[c], blj = bl[c], mn = fmaxf(blj + m, mlj), sp = __expf(blj + m - mn), sl = __expf(mlj - mn);
                const float cl = base[c * 64];
                base[c * 64] = st;
                st = st * sp + cl * sl; m = mn;
            }
            X.out[O_PN + ((size_t)l * 8 + nh) * 64 + k] = st;
        }
    }
}

__device__ __forceinline__ void mlstm_out(lptr lds, const Ctx& X, int l, int task, int tid) {
    const int h = task & 3, c = (task >> 2) & 127, n = task >> 9;
    const int lane = tid & 63, wave = tid >> 6, fr = lane & 15, fq = lane >> 4;
    const int row0 = n * SEQ + c * 64, nh = n * 4 + h;
    lptr Qs = lds;
    lptr Ks = lds + 9216;
    lptr Vt = lds + 18432;
    lptr Sb = lds + 36864 + wave * 2304;
    LAS float* bv = (LAS float*)(lds + 55296);
    LAS float* dv = bv + 64;
    LAS float* mtv = bv + 128;
    LAS float* siv = bv + 192;
    LAS float* qnv = bv + 256;
    LAS float* ssqp = bv + 384;
    LAS float* nsv = bv + 512;
    if (wave == 0) {
        const bf16_t* ur = XU + (size_t)(row0 + lane) * NIN;
        const float fg = bf2f(ur[C_AF + h]) + XPAR(P_AFB)[l * 4 + h], ig = bf2f(ur[C_AI + h]) + XPAR(P_AIB)[l * 4 + h];
        const float b = wave_scan_sum(logsigf_(fg), lane);
        const float dd = ig - b;
        const float cm = wave_scan_max(dd, lane);
        const float ms = XMS[nh * 128 + c];
        const float mt = b + fmaxf(ms, cm);
        bv[lane] = b; dv[lane] = dd; mtv[lane] = mt; siv[lane] = __expf(b + ms - mt);
        nsv[lane] = XMN[((size_t)nh * 128 + c) * 64 + lane];
    }
    {
        const int tok = tid >> 3, k8 = (tid & 7) * 8;
        const bf16_t* ur = XU + (size_t)(row0 + tok) * NIN;
        *(LAS u32x4*)(Qs + ((tok * 72 + k8) << 1)) = *(const u32x4*)(ur + C_AQ + h * 64 + k8);
        float x[8]; unpack8(*(const u32x4*)(ur + C_AK + h * 64 + k8), x);
#pragma unroll
        for (int j = 0; j < 8; ++j) x[j] *= 0.125f;
        *(LAS u32x4*)(Ks + ((tok * 72 + k8) << 1)) = pack8(x);
    }
#pragma unroll
    for (int it = 0; it < 2; ++it) {
        const int p = tid + it * NT, tok = p >> 4, v8 = (p & 15) * 8;
        const u32x4 w = *(const u32x4*)(XU + (size_t)(row0 + tok) * NIN + C_AV + h * 128 + v8);
#pragma unroll
        for (int j = 0; j < 8; ++j) *(LAS bf16_t*)(Vt + (((v8 + j) * 72 + tok) << 1)) = (bf16_t)((w[j >> 1] >> ((j & 1) * 16)) & 0xffffu);
    }
    __syncthreads();
    const int mti = wave >> 1, half = wave & 1;
    bf16x8 qa[2];
    qa[0] = lds_frag(Qs, 16 * mti + fr, fq * 8, 72); qa[1] = lds_frag(Qs, 16 * mti + fr, 32 + fq * 8, 72);
    {
        float x0[8], x1[8]; unpack8(__builtin_bit_cast(u32x4, qa[0]), x0); unpack8(__builtin_bit_cast(u32x4, qa[1]), x1);
        float d = 0.f;
#pragma unroll
        for (int j = 0; j < 8; ++j) d += x0[j] * nsv[fq * 8 + j] + x1[j] * nsv[32 + fq * 8 + j];
        d += __shfl_xor(d, 16); d += __shfl_xor(d, 32);
        if (fq == 0) qnv[wave * 16 + fr] = d;
    }
    float rsum[4] = {0.f, 0.f, 0.f, 0.f};
#pragma unroll
    for (int ntl = 0; ntl < 4; ++ntl) {
        f32x4 s = {0.f, 0.f, 0.f, 0.f};
        s = mfma16(qa[0], lds_frag(Ks, 16 * ntl + fr, fq * 8, 72), s);
        s = mfma16(qa[1], lds_frag(Ks, 16 * ntl + fr, 32 + fq * 8, 72), s);
#pragma unroll
        for (int ii = 0; ii < 4; ++ii) {
            const int t = 16 * mti + fq * 4 + ii, sidx = 16 * ntl + fr;
            const float wgt = (sidx <= t) ? __expf(bv[t] + dv[sidx] - mtv[t]) : 0.f;
            const float sv = wgt * s[ii];
            rsum[ii] += sv;
            *(LAS bf16_t*)(Sb + (((fq * 4 + ii) * 72 + sidx) << 1)) = (bf16_t)f2bf(sv);
        }
    }
    LDS_FENCE();
    f32x4 acc[4];
#pragma unroll
    for (int ntl = 0; ntl < 4; ++ntl) acc[ntl] = (f32x4){0.f, 0.f, 0.f, 0.f};
#pragma unroll
    for (int kk = 0; kk < 2; ++kk) {
        const bf16x8 a = lds_frag(Sb, fr, kk * 32 + fq * 8, 72);
#pragma unroll
        for (int ntl = 0; ntl < 4; ++ntl) acc[ntl] = mfma16(a, lds_frag(Vt, 64 * half + 16 * ntl + fr, kk * 32 + fq * 8, 72), acc[ntl]);
    }
    {
        const float sia = siv[16 * mti + fr];
        const float* Cs = XMC + ((size_t)nh * 128 + c) * 8192;
#pragma unroll
        for (int kk = 0; kk < 2; ++kk) {
            float x[8]; unpack8(__builtin_bit_cast(u32x4, qa[kk]), x);
#pragma unroll
            for (int j = 0; j < 8; ++j) x[j] *= sia;
            const bf16x8 a = as_frag(pack8(x));
#pragma unroll
            for (int ntl = 0; ntl < 4; ++ntl) acc[ntl] = mfma16(a, ldg_f32_frag(Cs + (64 * half + 16 * ntl + fr) * 64 + kk * 32 + fq * 8), acc[ntl]);
        }
    }
    float hv[4][4], ssl[4];
#pragma unroll
    for (int ii = 0; ii < 4; ++ii) {
        const int t = 16 * mti + fq * 4 + ii;
        const float den = red16(rsum[ii]) + siv[t] * qnv[wave * 16 + fq * 4 + ii];
        const float inv = 1.f / fmaxf(fabsf(den), __expf(-mtv[t]));
        float ss = 0.f;
#pragma unroll
        for (int ntl = 0; ntl < 4; ++ntl) { hv[ntl][ii] = acc[ntl][ii] * inv; ss += hv[ntl][ii] * hv[ntl][ii]; }
        ssl[ii] = red16(ss);
        if (fr == 0) ssqp[t * 2 + half] = ssl[ii];
    }
    __syncthreads();
#pragma unroll
    for (int ii = 0; ii < 4; ++ii) {
        const int t = 16 * mti + fq * 4 + ii;
        const float rs = rsqrtf((ssqp[t * 2] + ssqp[t * 2 + 1]) * (1.f / 128.f) + EPS);
        const size_t row = (size_t)row0 + t;
#pragma unroll
        for (int ntl = 0; ntl < 4; ++ntl) {
            const int v = h * 128 + 64 * half + 16 * ntl + fr;
            const float ao = bf2f(XU[row * NIN + C_AO + v]), az = bf2f(XU[row * NIN + C_AZ + v]);
            XMIX[row * DMIX + v] = (bf16_t)f2bf(hv[ntl][ii] * rs * XPAR(P_ANW)[l * 512 + v] * sigmoidf_(ao) * siluf_(az));
        }
    }
    __syncthreads();
}

__device__ __forceinline__ void ssd_out(lptr lds, const Ctx& X, int l, int task, int tid) {
    const int g = task & 1, c = (task >> 1) & 127, n = task >> 8;
    const int lane = tid & 63, wave = tid >> 6, fr = lane & 15, fq = lane >> 4;
    const int seq0 = n * SEQ, row0 = seq0 + c * 64;
    lptr Cm = lds;
    lptr Bm = lds + 17408;
    lptr Xt = lds + 34816;
    LAS float* CBf = (LAS float*)(lds + 71680);
    LAS float* av = (LAS float*)(lds + 89088);
    LAS float* dtv = (LAS float*)(lds + 90112);
    LAS float* ssq = (LAS float*)(lds + 91136);
    if (wave < 4) {
        const int hh = 4 * g + wave;
        const float dt = softplusf_(bf2f(XU[(size_t)(row0 + lane) * NIN + C_BDT + hh]) + XPAR(P_DTB)[l * 8 + hh]);
        const float A = -__expf(XPAR(P_ALOG)[l * 8 + hh]);
        av[wave * 64 + lane] = wave_scan_sum(dt * A, lane);
        dtv[wave * 64 + lane] = dt;
    }
    {
        const float* cw = XPAR(P_CW) + l * 4096; const float* cb = XPAR(P_CB) + l * 1024;
        const int cg = lane;
        const int ch = cg < 32 ? g * 256 + cg * 8 : (cg < 48 ? 512 + g * 128 + (cg - 32) * 8 : 768 + g * 128 + (cg - 48) * 8);
        float o[8][8];
        conv8x8(XU, seq0, c * 64 + 8 * wave, ch, cw, cb, o);
        if (cg < 32) {
#pragma unroll
            for (int jx = 0; jx < 8; ++jx) {
                float v[8];
#pragma unroll
                for (int t = 0; t < 8; ++t) v[t] = o[t][jx];
                *(LAS u32x4*)(Xt + (((cg * 8 + jx) * 72 + 8 * wave) << 1)) = pack8(v);
            }
        } else {
            lptr dstm = cg < 48 ? Bm : Cm; const int s8 = (cg < 48 ? cg - 32 : cg - 48) * 8;
#pragma unroll
            for (int t = 0; t < 8; ++t) *(LAS u32x4*)(dstm + (((8 * wave + t) * 136 + s8) << 1)) = pack8(o[t]);
        }
    }
    __syncthreads();
    {
        const int mt = wave >> 1;
#pragma unroll
        for (int q = 0; q < 2; ++q) {
            const int ntl = 2 * (wave & 1) + q;
            f32x4 acc = {0.f, 0.f, 0.f, 0.f};
#pragma unroll
            for (int kk = 0; kk < 4; ++kk) acc = mfma16(lds_frag(Cm, 16 * mt + fr, kk * 32 + fq * 8, 136), lds_frag(Bm, 16 * ntl + fr, kk * 32 + fq * 8, 136), acc);
#pragma unroll
            for (int ii = 0; ii < 4; ++ii) CBf[(16 * mt + fq * 4 + ii) * 68 + 16 * ntl + fr] = acc[ii];
        }
    }
    __syncthreads();
    const int hl = wave >> 1, th = wave & 1, hh = 4 * g + hl;
    f32x4 y1[2][4], y2[2][4];
#pragma unroll
    for (int mi = 0; mi < 2; ++mi)
#pragma unroll
        for (int ntl = 0; ntl < 4; ++ntl) { y1[mi][ntl] = (f32x4){0.f, 0.f, 0.f, 0.f}; y2[mi][ntl] = (f32x4){0.f, 0.f, 0.f, 0.f}; }
#pragma unroll
    for (int kk = 0; kk < 2; ++kk) {
        bf16x8 bx[4];
#pragma unroll
        for (int ntl = 0; ntl < 4; ++ntl) bx[ntl] = lds_frag(Xt, hl * 64 + 16 * ntl + fr, kk * 32 + fq * 8, 72);
#pragma unroll
        for (int mi = 0; mi < 2; ++mi) {
            const int t = 16 * (2 * th + mi) + fr, u0 = kk * 32 + fq * 8;
            const float at = av[hl * 64 + t];
            float w[8];
#pragma unroll
            for (int j = 0; j < 8; ++j) {
                const int uu = u0 + j;
                w[j] = (uu <= t) ? CBf[t * 68 + uu] * __expf(at - av[hl * 64 + uu]) * dtv[hl * 64 + uu] : 0.f;
            }
            const bf16x8 a = as_frag(pack8(w));
#pragma unroll
            for (int ntl = 0; ntl < 4; ++ntl) y1[mi][ntl] = mfma16(a, bx[ntl], y1[mi][ntl]);
        }
    }
    {
        const float* hs = XSH + ((size_t)(n * 8 + hh) * 128 + c) * 8192;
#pragma unroll
        for (int kk = 0; kk < 4; ++kk) {
            bf16x8 bh[4];
#pragma unroll
            for (int ntl = 0; ntl < 4; ++ntl) bh[ntl] = ldg_f32_frag(hs + (16 * ntl + fr) * 128 + kk * 32 + fq * 8);
#pragma unroll
            for (int mi = 0; mi < 2; ++mi) {
                const bf16x8 a = lds_frag(Cm, 16 * (2 * th + mi) + fr, kk * 32 + fq * 8, 136);
#pragma unroll
                for (int ntl = 0; ntl < 4; ++ntl) y2[mi][ntl] = mfma16(a, bh[ntl], y2[mi][ntl]);
            }
        }
    }
    const float Dh = XPAR(P_BD)[l * 8 + hh];
#pragma unroll
    for (int mi = 0; mi < 2; ++mi)
#pragma unroll
        for (int ii = 0; ii < 4; ++ii) {
            const int t = 16 * (2 * th + mi) + fq * 4 + ii;
            const float ea = __expf(av[hl * 64 + t]);
            const size_t row = (size_t)row0 + t;
            float ss = 0.f;
#pragma unroll
            for (int ntl = 0; ntl < 4; ++ntl) {
                const int p = 16 * ntl + fr;
                const float xv = bf2f(*(const LAS bf16_t*)(Xt + (((hl * 64 + p) * 72 + t) << 1)));
                const float y = y1[mi][ntl][ii] + ea * y2[mi][ntl][ii] + Dh * xv;
                const float gbv = y * siluf_(bf2f(XU[row * NIN + C_BZ + hh * 64 + p]));
                y1[mi][ntl][ii] = gbv; ss += gbv * gbv;
            }
            ss = red16(ss);
            if (fr == 0) ssq[t * 4 + hl] = ss;
        }
    __syncthreads();
#pragma unroll
    for (int mi = 0; mi < 2; ++mi)
#pragma unroll
        for (int ii = 0; ii < 4; ++ii) {
            const int t = 16 * (2 * th + mi) + fq * 4 + ii;
            const float rs = rsqrtf((ssq[t * 4] + ssq[t * 4 + 1] + ssq[t * 4 + 2] + ssq[t * 4 + 3]) * (1.f / 256.f) + EPS);
            const size_t row = (size_t)row0 + t;
#pragma unroll
            for (int ntl = 0; ntl < 4; ++ntl) {
                const int p = hh * 64 + 16 * ntl + fr;
                XMIX[row * DMIX + 512 + p] = (bf16_t)f2bf(y1[mi][ntl][ii] * rs * XPAR(P_BNW)[l * 512 + p]);
            }
        }
    __syncthreads();
}


#define XB_TMO      128
#define XB_XCNT(j)  (256  + 64 * (j))
#define XB_XSUB(j)  (1280 + 64 * (j))
#define XB_XGEN(j)  (2304 + 64 * (j))
#define XB_TOP      3328
#define XB_TOPGEN   3392
#define XCD_BAR_WORDS 3456
#define XB_SPIN_CAP (1u << 18)
__device__ __forceinline__ unsigned xb_ld(unsigned* p)              { return __hip_atomic_load(p, __ATOMIC_RELAXED, __HIP_MEMORY_SCOPE_AGENT); }
__device__ __forceinline__ unsigned xb_add(unsigned* p, unsigned v) { return __hip_atomic_fetch_add(p, v, __ATOMIC_RELAXED, __HIP_MEMORY_SCOPE_AGENT); }
__device__ __forceinline__ unsigned xb_xcc_id() { return (unsigned)__builtin_amdgcn_s_getreg((3 << 11) | 20) & 0xFu; }
#define XB_SPIN(cond, bar) do { unsigned _sp = 0; while (cond) { __builtin_amdgcn_s_sleep(1); \
    if ((++_sp & 255u) == 0u) { if (xb_ld(&(bar)[XB_TMO])) break; if (_sp > XB_SPIN_CAP) { atomicAdd(&(bar)[XB_TMO], 1u); break; } } } } while (0)
struct XcdBarrier { unsigned* bar; unsigned x; volatile LAS unsigned* st; };
__device__ __forceinline__ XcdBarrier xcd_barrier_post(unsigned* bar, volatile LAS unsigned* st) {
    XcdBarrier b; b.bar = bar; b.x = xb_xcc_id(); b.st = st;
    if (threadIdx.x == 0) (void)xb_add(&bar[XB_XCNT(b.x)], 1u);
    return b;
}
__device__ __forceinline__ void xcd_barrier_complete(unsigned* bar, unsigned x, unsigned& nloc, unsigned& nx) {
    const unsigned G = gridDim.x * gridDim.y * gridDim.z;
    unsigned sum, cnt, mine, sp = 0u;
    for (;;) {
        sum = 0u; cnt = 0u; mine = 0u;
#pragma unroll
        for (unsigned j = 0; j < 16; ++j) { const unsigned c = xb_ld(&bar[XB_XCNT(j)]); sum += c; cnt += (c > 0u) ? 1u : 0u; mine = (j == x) ? c : mine; }
        if (sum == G) break;
        __builtin_amdgcn_s_sleep(1);
        if ((++sp & 255u) == 0u) { if (xb_ld(&bar[XB_TMO])) break; if (sp > XB_SPIN_CAP) { atomicAdd(&bar[XB_TMO], 1u); break; } }
    }
    nloc = mine > 0u ? mine : 1u; nx = cnt > 0u ? cnt : 1u;
}
__device__ __forceinline__ void xcd_barrier(const XcdBarrier& b) {
    asm volatile("s_waitcnt vmcnt(0)" ::: "memory");
    __syncthreads();
    if (threadIdx.x == 0) {
        unsigned* bar = b.bar;
        __builtin_amdgcn_s_waitcnt(0);
        unsigned nloc = b.st[0], nx = b.st[1];
        if (nloc == 0u) { xcd_barrier_complete(bar, b.x, nloc, nx); b.st[0] = nloc; b.st[1] = nx; }
        const unsigned old = xb_add(&bar[XB_XSUB(b.x)], 1u);
        const unsigned gen = old / nloc;
        if (old + 1u == (gen + 1u) * nloc) {
            __builtin_amdgcn_fence(__ATOMIC_RELEASE, "agent");
            asm volatile("s_waitcnt vmcnt(0)" ::: "memory");
            const unsigned og = xb_add(&bar[XB_TOP], 1u);
            const unsigned tg = og / nx;
            if (og + 1u == (tg + 1u) * nx) xb_add(&bar[XB_TOPGEN], 1u);
            else XB_SPIN(xb_ld(&bar[XB_TOPGEN]) == tg, bar);
            __builtin_amdgcn_fence(__ATOMIC_ACQUIRE, "agent");
            xb_add(&bar[XB_XGEN(b.x)], 1u);
            asm volatile("s_waitcnt vmcnt(0)" ::: "memory");
        } else {
            XB_SPIN(xb_ld(&bar[XB_XGEN(b.x)]) == gen, bar);
            __builtin_amdgcn_fence(__ATOMIC_ACQUIRE, "agent");
            asm volatile("s_waitcnt vmcnt(0)" ::: "memory");
        }
    }
    __syncthreads();
}

__global__ void __launch_bounds__(NT, 2) mega(Args args) {
    __shared__ __attribute__((aligned(16))) unsigned char lds_raw[LDS_BYTES];
    lptr lds = (lptr)lds_raw;
    cg::grid_group grid = cg::this_grid();
    const int tid = threadIdx.x, bid = blockIdx.x, G = gridDim.x;
    Ctx X;
    X.xp = args.in[IN_XP]; X.xs = args.in[IN_XS]; X.stC = args.in[IN_STC]; X.stN = args.in[IN_STN]; X.stM = args.in[IN_STM]; X.ssm = args.in[IN_SSM];
    X.conv = args.in[IN_CONV]; X.ck = args.in[IN_CK]; X.cv = args.in[IN_CV]; X.out = args.out; X.ws = args.ws;
    const int lo = args.ph_lo, hi = args.ph_hi;
    volatile LAS unsigned* xst = (volatile LAS unsigned*)(lds + LDS_BYTES - 16);
    if (tid == 0) { xst[0] = 0u; xst[1] = 0u; }
    __syncthreads();
    XcdBarrier xbar = xcd_barrier_post((unsigned*)(args.ws + WS_BAR), xst);
#define IN(k) (lo <= (k) && (k) < hi)
#define SEAM(k) do { if (IN(k) && IN((k) + 1)) { for (int _r = 0; _r < REP_SYNC; ++_r) { if ((k) == 0) grid.sync(); else xcd_barrier(xbar); } } } while (0)
    if (IN(0)) { prologue(lds, X, args, G, bid, tid); }
    SEAM(0);
    for (int l = 0; l < 4; ++l) {
        const int pb = 1 + l * 5;
        if (IN(pb)) for (int _r = 0; _r < REP_P1; ++_r) {
            pg8::Gemm g{XXB, XWIN + (size_t)l * NIN * D, MPAD, NIN, D}; pg8::StaticOrder S; S.init(l == 0 ? MPAD : TP, NIN, G, bid);
            pg8::EpiU E{XU, XSSQ};
            pg8::gemm_phase<pg8::EpiU, pg8::StaticOrder>(lds, g, S, E, OPQ(tid));
        }
        SEAM(pb);
        if (IN(pb + 1)) for (int _r = 0; _r < REP_P2; ++_r) {
            for (int task = bid; task < 2177; task += G) {
                if (task < 384) sample_task(lds, X, l, task & 127, task < 128 ? 1 : (task < 256 ? 0 : 2), OPQ(tid));
                else if (task < 640) swa_prompt(lds, X, l, task - 384, OPQ(tid));
                else if (task < 1152) ssd_local(lds, X, l, task - 640, OPQ(tid));
                else if (task < 2176) mlstm_local(lds, X, l, task - 1152, OPQ(tid));
                else {
                    for (int i = tid; i < 2 * 3 * 1024; i += NT) {
                        const int ch = i & 1023, j = (i >> 10) % 3, n = i / 3072;
                        X.out[O_PCONV + (((size_t)l * 2 + n) * 3 + j) * 1024 + ch] = bf2f(XU[(size_t)(n * SEQ + SEQ - 3 + j) * NIN + C_BX + ch]);
                    }
                }
            }
        }
        SEAM(pb + 1);
        if (IN(pb + 2)) {
            if (bid >= G - 4) {
                pg8::Gemm g{XMIX, XWOUT + (size_t)l * D * DMIX, MPAD, D, DMIX}; pg8::SampleOrder S{G - 4, 4, bid};
                pg8::EpiRes E{l == 0 ? X.xp : nullptr, X.xs, X.out, XXB, XSSQ};
                pg8::gemm_phase<pg8::EpiRes, pg8::SampleOrder>(lds, g, S, E, OPQ(tid));
            }
            scans(X, l, bid * NT + OPQ(tid), G * NT);
        }
        SEAM(pb + 2);
        if (IN(pb + 3)) for (int _r = 0; _r < REP_P4; ++_r) {
            for (int task = bid; task < 1536; task += G) {
                if (task < 512) ssd_out(lds, X, l, task, OPQ(tid));
                else mlstm_out(lds, X, l, task - 512, OPQ(tid));
            }
        }
        SEAM(pb + 3);
        if (IN(pb + 4)) {
            {
                pg8::Gemm g{XMIX, XWOUT + (size_t)l * D * DMIX, MPAD, D, DMIX}; pg8::StaticOrder S; S.init(TP, D, G, bid);
                pg8::EpiRes E{l == 0 ? X.xp : nullptr, X.xs, X.out, XXB, XSSQ};
                pg8::gemm_phase<pg8::EpiRes, pg8::StaticOrder>(lds, g, S, E, OPQ(tid));
            }
            if (l < 3 && bid < 20) {
                pg8::Gemm g{XXB, XWIN + (size_t)(l + 1) * NIN * D, MPAD, NIN, D}; pg8::SampleOrder S{0, 20, bid};
                pg8::EpiU E{XU, XSSQ};
                pg8::gemm_phase<pg8::EpiU, pg8::SampleOrder>(lds, g, S, E, OPQ(tid));
            }
        }
        SEAM(pb + 4);
    }
#undef IN
#undef SEAM
}

extern "C" void kernel_launch(void* const* d_in, const int* in_sizes, int n_in, void* d_out, int out_size, void* d_ws, size_t ws_size, hipStream_t stream) {
    static int grid_blocks = 0;
    if (!grid_blocks) {
        int dev = 0, cus = 0, per_cu = 0;
        hipGetDevice(&dev);
        hipDeviceGetAttribute(&cus, hipDeviceAttributeMultiprocessorCount, dev);
        hipOccupancyMaxActiveBlocksPerMultiprocessor(&per_cu, mega, NT, 0);
        if (per_cu < 1) { fprintf(stderr, "occupancy query returned %d\n", per_cu); per_cu = 1; }
        grid_blocks = cus * 1;
        if (ws_size < WS_END) fprintf(stderr, "workspace too small: %zu < %zu\n", ws_size, (size_t)WS_END);
    }
    (void)hipMemsetAsync(d_ws, 0, 16384, stream);
    Args a{};
    for (int i = 0; i < 24; ++i) a.in[i] = (const float*)d_in[i];
    a.out = (float*)d_out; a.ws = (unsigned char*)d_ws;
    const int NPH = 21;
#if MULTI_LAUNCH
    for (int p = 0; p < NPH; ++p) {
        a.ph_lo = p; a.ph_hi = p + 1;
        void* kargs[] = {&a};
        hipError_t e = hipLaunchCooperativeKernel((void*)mega, dim3(grid_blocks), dim3(NT), kargs, 0, stream);
        if (e != hipSuccess) fprintf(stderr, "cooperative launch failed: %s (grid %d)\n", hipGetErrorString(e), grid_blocks);
    }
#else
    a.ph_lo = 0; a.ph_hi = NPH;
    void* kargs[] = {&a};
    hipError_t e = hipLaunchCooperativeKernel((void*)mega, dim3(grid_blocks), dim3(NT), kargs, 0, stream);
    if (e != hipSuccess) fprintf(stderr, "cooperative launch failed: %s (grid %d)\n", hipGetErrorString(e), grid_blocks);
#endif
}
```

```cpp
#include <hip/hip_runtime.h>
#include <hip/hip_cooperative_groups.h>
#include <cstdio>
#include <cstdint>
namespace cg = cooperative_groups;

#ifndef REP_SYNC
#define REP_SYNC 1
#endif
#ifndef REP_P1
#define REP_P1 1
#endif
#ifndef REP_P2
#define REP_P2 1
#endif
#ifndef REP_P4
#define REP_P4 1
#endif
#ifndef RT_SAMPLE
#define RT_SAMPLE 1
#endif
#ifndef RT_SWA
#define RT_SWA 1
#endif
#ifndef RT_SLOC
#define RT_SLOC 1
#endif
#ifndef RT_MLOC
#define RT_MLOC 1
#endif
#ifndef RT_SOUT
#define RT_SOUT 1
#endif
#ifndef MULTI_LAUNCH
#define MULTI_LAUNCH 0
#endif

#define LAS __attribute__((address_space(3)))
typedef unsigned short bf16_t;
typedef short bf16x8 __attribute__((ext_vector_type(8)));
typedef float f32x4 __attribute__((ext_vector_type(4)));
typedef float f32x2 __attribute__((ext_vector_type(2)));
typedef unsigned u32x4 __attribute__((ext_vector_type(4)));
typedef unsigned u32x2 __attribute__((ext_vector_type(2)));
typedef __bf16 bf16x2_t __attribute__((ext_vector_type(2)));
typedef LAS unsigned char* lptr;

constexpr int D = 1024, DIN = 4880, NIN = 5120, DMIX = 1536, TP = 16384, MTOK = 16512, MPAD = 16640, SEQ = 8192;
constexpr int C_AQ = 0, C_AK = 256, C_AV = 512, C_AO = 1024, C_AZ = 1536, C_AI = 2048, C_AF = 2052, C_BZ = 2056, C_BX = 2568, C_BB = 3080, C_BC = 3336,
              C_BDT = 3592, C_CQ = 3600, C_CK = 4112, C_CV = 4240, C_CZ = 4368;
constexpr float EPS = 1e-6f;
constexpr size_t O_YP = 0, O_YS = 16777216, O_PC = 16908288, O_PN = 17170432, O_PM = 17172480, O_PH = 17172512, O_PCONV = 17696800, O_PK = 17721376,
                 O_PV = 17852448, O_SC = 17983520, O_SN = 34760736, O_SM = 34891808, O_SH = 34893856, O_SCONV = 68448288, O_SK = 70021152, O_SV = 78409760;
constexpr size_t WS_BAR = 0;
constexpr size_t WS_PAR = 16384;
constexpr size_t WS_WIN = WS_PAR + 102400;
constexpr size_t WS_WOUT = WS_WIN + (size_t)4 * NIN * D * 2;
constexpr size_t WS_XB = WS_WOUT + (size_t)4 * D * DMIX * 2;
constexpr size_t WS_U = WS_XB + (size_t)MPAD * D * 2;
constexpr size_t WS_MIX = WS_U + (size_t)MPAD * NIN * 2;
constexpr size_t WS_SSQ = WS_MIX + (size_t)MPAD * DMIX * 2;
constexpr size_t WS_ROPE = WS_SSQ + (size_t)MPAD * 16 * 4;
constexpr size_t WS_MC = WS_ROPE + (size_t)8200 * 64 * 4;
constexpr size_t WS_MN = WS_MC + (size_t)8 * 128 * 8192 * 4;
constexpr size_t WS_ML = WS_MN + (size_t)8 * 128 * 64 * 4;
constexpr size_t WS_BL = WS_ML + 4096;
constexpr size_t WS_MS = WS_BL + 4096;
constexpr size_t WS_SA = WS_MS + 4096;
constexpr size_t WS_SH = WS_SA + 8192;
constexpr size_t WS_CSB = WS_SH + (size_t)16 * 128 * 8192 * 4;
constexpr size_t WS_HSB = WS_CSB + (size_t)8 * 128 * 8192 * 2;
constexpr size_t WS_END = WS_HSB + (size_t)16 * 128 * 8192 * 2;
constexpr int LDS_BYTES = 139264;
constexpr int NT = 512;

struct Args { const float* in[24]; float* out; unsigned char* ws; int ph_lo, ph_hi; };

__device__ __forceinline__ float bf2f(unsigned v) { return __uint_as_float(v << 16); }
__device__ __forceinline__ unsigned pk2(float lo, float hi) { f32x2 v = {lo, hi}; bf16x2_t b = __builtin_convertvector(v, bf16x2_t); return __builtin_bit_cast(unsigned, b); }
__device__ __forceinline__ unsigned f2bf(float f) { return pk2(f, 0.f) & 0xffffu; }
__device__ __forceinline__ void unpack8(u32x4 w, float (&f)[8]) {
#pragma unroll
    for (int i = 0; i < 4; ++i) { f[2 * i] = __uint_as_float(w[i] << 16); f[2 * i + 1] = __uint_as_float(w[i] & 0xffff0000u); }
}
__device__ __forceinline__ u32x4 pack8(const float (&f)[8]) { u32x4 w; w[0] = pk2(f[0], f[1]); w[1] = pk2(f[2], f[3]); w[2] = pk2(f[4], f[5]); w[3] = pk2(f[6], f[7]); return w; }
__device__ __forceinline__ u32x4 pack8v(f32x4 a, f32x4 b) { u32x4 w; w[0] = pk2(a[0], a[1]); w[1] = pk2(a[2], a[3]); w[2] = pk2(b[0], b[1]); w[3] = pk2(b[2], b[3]); return w; }
__device__ __forceinline__ bf16x8 as_frag(u32x4 w) { return __builtin_bit_cast(bf16x8, w); }
__device__ __forceinline__ bf16x8 ldg_f32_frag(const float* p) { f32x4 a = *(const f32x4*)p, b = *(const f32x4*)(p + 4); return as_frag(pack8v(a, b)); }
__device__ __forceinline__ bf16x8 lds_frag(lptr base, int row, int k, int stride) { return *(const LAS bf16x8*)(base + ((row * stride + k) << 1)); }
__device__ __forceinline__ f32x4 mfma16(bf16x8 a, bf16x8 b, f32x4 c) { return __builtin_amdgcn_mfma_f32_16x16x32_bf16(a, b, c, 0, 0, 0); }
__device__ __forceinline__ float sigmoidf_(float x) { return 1.f / (1.f + __expf(-x)); }
__device__ __forceinline__ float siluf_(float x) { return x / (1.f + __expf(-x)); }
__device__ __forceinline__ float softplusf_(float x) { return x > 20.f ? x : log1pf(__expf(x)); }
__device__ __forceinline__ float logsigf_(float x) { return fminf(x, 0.f) - log1pf(__expf(-fabsf(x))); }
__device__ __forceinline__ float wave_scan_sum(float v, int lane) {
#pragma unroll
    for (int o = 1; o < 64; o <<= 1) { float t = __shfl_up(v, o); if (lane >= o) v += t; }
    return v;
}
__device__ __forceinline__ float wave_scan_max(float v, int lane) {
#pragma unroll
    for (int o = 1; o < 64; o <<= 1) { float t = __shfl_up(v, o); if (lane >= o) v = fmaxf(v, t); }
    return v;
}
__device__ __forceinline__ float wave_sum(float v) {
#pragma unroll
    for (int o = 1; o < 64; o <<= 1) v += __shfl_xor(v, o);
    return v;
}
__device__ __forceinline__ float wave_max(float v) {
#pragma unroll
    for (int o = 1; o < 64; o <<= 1) v = fmaxf(v, __shfl_xor(v, o));
    return v;
}
__device__ __forceinline__ float red16(float v) { v += __shfl_xor(v, 1); v += __shfl_xor(v, 2); v += __shfl_xor(v, 4); v += __shfl_xor(v, 8); return v; }
__device__ __forceinline__ float red16max(float v) { v = fmaxf(v, __shfl_xor(v, 1)); v = fmaxf(v, __shfl_xor(v, 2)); v = fmaxf(v, __shfl_xor(v, 4)); v = fmaxf(v, __shfl_xor(v, 8)); return v; }
__device__ __forceinline__ int OPQ(int v) { asm volatile("" : "+v"(v)); return v; }
#define LDS_FENCE() asm volatile("s_waitcnt lgkmcnt(0)" ::: "memory")

namespace pg8 {
constexpr int BM = 256, BK = 64, HALF = 128, HTB = HALF * BK * 2, STAGE_BYTES = 8 * HTB, NXCD = 8, WGM = 8;
__host__ __device__ __forceinline__ int lds_byte(int r, int c) { const int st = (r >> 4) * 2 + (c >> 5), rr = r & 15, cc = c & 31, ob = rr * 64 + cc * 2; return st * 1024 + (ob ^ (((ob >> 9) & 1) << 5)); }
__host__ __device__ __forceinline__ void stage_rc(int b, int& R, int& C) { const int st = b / 1024, sb = b % 1024, swz = sb ^ (((sb >> 9) & 1) << 5); R = (st >> 1) * 16 + swz / 64; C = (st & 1) * 32 + (swz % 64) / 2; }
__host__ __device__ __forceinline__ int perm32(int rho) { const int n = rho >> 4, i = rho & 15; return 8 * (i >> 2) + 4 * n + (i & 3); }
struct Unit { int pm, pn; };
struct Gemm { const bf16_t* A; const bf16_t* Bt; int M, N, K; };
struct StaticOrder {
    int nM, nN, nwg, G, c;
    __device__ void init(int M, int N, int G_, int c_) { nM = M / BM; nN = N / BM; nwg = nM * nN; G = G_; c = c_; }
    __device__ bool next(int i, Unit& u) const {
        const long L = (long)i * G + c; if (L >= nwg) return false;
        int wgid = (int)L; { const int q = nwg / NXCD, r = nwg % NXCD, xcd = wgid % NXCD, off = wgid / NXCD; wgid = (xcd < r ? xcd * (q + 1) : r * (q + 1) + (xcd - r) * q) + off; }
        const int nig = WGM * nN, gid = wgid / nig, fm = gid * WGM, gsz = (nM - fm) < WGM ? (nM - fm) : WGM;
        u.pm = fm + ((wgid % nig) % gsz); u.pn = (wgid % nig) / gsz; return true;
    }
};
struct EpiU {
    bf16_t* U; const float* ssq;
    __device__ __forceinline__ void operator()(const f32x4 (&acc)[2][2][4][2], const Unit& u, int wr, int wc, int fr, int fq) const {
        const int row0 = u.pm * BM + wr * 64 + fr, col0 = u.pn * BM + wc * 32 + 8 * fq;
#pragma unroll
        for (int ai = 0; ai < 2; ++ai)
#pragma unroll
            for (int m = 0; m < 4; ++m) {
                const int r = row0 + ai * HALF + m * 16;
                const f32x4 s = *(const f32x4*)(ssq + (size_t)r * 16 + fq * 4);
                float st = s[0] + s[1] + s[2] + s[3]; st += __shfl_xor(st, 16); st += __shfl_xor(st, 32);
                const float rs = rsqrtf(st * (1.f / 1024.f) + EPS);
                bf16_t* rowp = U + (size_t)r * NIN + col0;
#pragma unroll
                for (int bj = 0; bj < 2; ++bj) *(u32x4*)(rowp + bj * HALF) = pack8v(acc[ai][bj][m][0] * rs, acc[ai][bj][m][1] * rs);
                __builtin_amdgcn_sched_barrier(0);
            }
    }
};
struct EpiRes {
    const float* xp; const float* xs; float* out; bf16_t* xb; float* ssq;
    __device__ __forceinline__ void operator()(const f32x4 (&acc)[2][2][4][2], const Unit& u, int wr, int wc, int fr, int fq) const {
        const int row0 = u.pm * BM + wr * 64 + fr, col0 = u.pn * BM + wc * 32 + 8 * fq;
#pragma unroll
        for (int ai = 0; ai < 2; ++ai)
#pragma unroll
            for (int m = 0; m < 4; ++m) {
                const int r = row0 + ai * HALF + m * 16;
                const bool valid = r < MTOK;
                const float* src = xp ? (r < TP ? xp + (size_t)r * D : xs + (size_t)(r - TP) * D) : out + (size_t)r * D;
                float part = 0.f;
#pragma unroll
                for (int bj = 0; bj < 2; ++bj) {
                    const int c = col0 + bj * HALF;
                    f32x4 o0 = {0.f, 0.f, 0.f, 0.f}, o1 = {0.f, 0.f, 0.f, 0.f};
                    if (valid) { o0 = *(const f32x4*)(src + c); o1 = *(const f32x4*)(src + c + 4); }
                    const f32x4 v0 = acc[ai][bj][m][0] + o0, v1 = acc[ai][bj][m][1] + o1;
                    if (valid) { *(f32x4*)(out + (size_t)r * D + c) = v0; *(f32x4*)(out + (size_t)r * D + c + 4) = v1; }
                    *(u32x4*)(xb + (size_t)r * D + c) = pack8v(v0, v1);
                    part += v0[0] * v0[0] + v0[1] * v0[1] + v0[2] * v0[2] + v0[3] * v0[3] + v1[0] * v1[0] + v1[1] * v1[1] + v1[2] * v1[2] + v1[3] * v1[3];
                }
                part += __shfl_xor(part, 16); part += __shfl_xor(part, 32);
                if (fq == 0) ssq[(size_t)r * 16 + u.pn * 4 + wc] = part;
                __builtin_amdgcn_sched_barrier(0);
            }
    }
};

struct SampleOrder {
    int first, cnt, c;
    __device__ bool next(int i, Unit& u) const { if (i != 0 || c < first || c >= first + cnt) return false; u.pm = 64; u.pn = c - first; return true; }
};
template <class Epi, class Sched>
__device__ __forceinline__ void gemm_phase(lptr lds, const Gemm g, const Sched& S, const Epi& E, const int tid) {
    const int wid = __builtin_amdgcn_readfirstlane(tid >> 6), lane = tid & 63, wr = wid >> 2, wc = wid & 3, fr = lane & 15, fq = lane >> 4;
    const int K = g.K, nt = K / BK;
    unsigned voffA[2], voffB[2];
#pragma unroll
    for (int i = 0; i < 2; ++i) { int R, C; stage_rc(tid * 16 + i * 8192, R, C); const int Rb = (R & ~31) + perm32(R & 31);
        voffA[i] = (unsigned)(R * K + C) * 2u; voffB[i] = (unsigned)(Rb * K + C) * 2u; }
    const size_t kstep = (size_t)(BK * 2);
    const size_t hstep = (size_t)HALF * K * 2;
    const size_t tstep = 2 * hstep;
    const unsigned ldsw = (unsigned)wid * 1024u;
    const int aoff = lds_byte(wr * 64 + fr, fq * 8), boff = lds_byte(wc * 32 + fr, fq * 8);
#define PG8_SA(b, h) (((b) * 2 + (h)) * HTB)
#define PG8_SB(b, h) ((4 + (b) * 2 + (h)) * HTB)
#define PG8_STAGE(bufoff, gbase, voff) do { _Pragma("unroll") for (int _i = 0; _i < 2; ++_i) \
        __builtin_amdgcn_global_load_lds((const unsigned*)((const char*)(gbase) + (voff)[_i]), (LAS unsigned*)(lds + (bufoff) + ldsw + _i * 8192), 16, 0, 0); } while (0)
#define PG8_LDA(dst, b, h) do { _Pragma("unroll") for (int m = 0; m < 4; ++m) _Pragma("unroll") for (int k = 0; k < 2; ++k) dst[m][k] = *(const LAS bf16x8*)(lds + PG8_SA(b, h) + aoff + m * 2048 + k * 1024); } while (0)
#define PG8_LDB(dst, b, h) do { _Pragma("unroll") for (int n = 0; n < 2; ++n) _Pragma("unroll") for (int k = 0; k < 2; ++k) dst[n][k] = *(const LAS bf16x8*)(lds + PG8_SB(b, h) + boff + n * 2048 + k * 1024); } while (0)
#define PG8_MMA(ai, bj, At, Bt) do { __builtin_amdgcn_s_setprio(1); _Pragma("unroll") for (int m = 0; m < 4; ++m) _Pragma("unroll") for (int n = 0; n < 2; ++n) _Pragma("unroll") for (int k = 0; k < 2; ++k) \
        acc[ai][bj][m][n] = __builtin_amdgcn_mfma_f32_16x16x32_bf16(Bt[n][k], At[m][k], acc[ai][bj][m][n], 0, 0, 0); __builtin_amdgcn_s_setprio(0); } while (0)
#define PG8_WAIT_V(n) asm volatile("s_waitcnt vmcnt(" #n ")" ::: "memory")
#define PG8_WAIT_L(n) asm volatile("s_waitcnt lgkmcnt(" #n ")" ::: "memory")
#define PG8_BAR __builtin_amdgcn_s_barrier()
#define PG8_SCHED __builtin_amdgcn_sched_barrier(0)
    Unit cur, nxt; int ui = 0;
    if (!S.next(0, cur)) return;
    f32x4 acc[2][2][4][2];
#pragma unroll
    for (int a = 0; a < 2; ++a)
#pragma unroll
        for (int b = 0; b < 2; ++b)
#pragma unroll
            for (int m = 0; m < 4; ++m)
#pragma unroll
                for (int n = 0; n < 2; ++n) acc[a][b][m][n] = (f32x4){0.f, 0.f, 0.f, 0.f};
    bf16x8 At[4][2], B0[2][2], B1[2][2];
    const char* cA = (const char*)g.A + (size_t)cur.pm * tstep; const char* cB = (const char*)g.Bt + (size_t)cur.pn * tstep;
    PG8_STAGE(PG8_SB(0, 0), cB, voffB); PG8_STAGE(PG8_SA(0, 0), cA, voffA); PG8_STAGE(PG8_SB(0, 1), cB + hstep, voffB); PG8_STAGE(PG8_SA(0, 1), cA + hstep, voffA);
    if (wr == 1) PG8_BAR;
    PG8_WAIT_V(4); PG8_BAR;
    PG8_STAGE(PG8_SB(1, 0), cB + kstep, voffB); PG8_STAGE(PG8_SA(1, 0), cA + kstep, voffA); PG8_STAGE(PG8_SB(1, 1), cB + hstep + kstep, voffB);
    PG8_WAIT_V(6); PG8_BAR;
    for (;;) {
        const bool has_next = S.next(ui + 1, nxt);
        const char* nA = has_next ? (const char*)g.A + (size_t)nxt.pm * tstep : cA; const char* nB = has_next ? (const char*)g.Bt + (size_t)nxt.pn * tstep : cB;
        for (int t = 0; t < nt; t += 2) {
            const bool last = (t == nt - 2);
            const char* a1 = cA + (size_t)(t + 1) * kstep;
            const char* a2 = last ? nA : cA + (size_t)(t + 2) * kstep; const char* b2 = last ? nB : cB + (size_t)(t + 2) * kstep;
            const char* a3 = a2 + kstep; const char* b3 = b2 + kstep;
            PG8_LDB(B0, 0, 0); PG8_SCHED; PG8_LDA(At, 0, 0); PG8_STAGE(PG8_SA(1, 1), a1 + hstep, voffA);
            PG8_WAIT_L(8); PG8_BAR; PG8_WAIT_L(0); PG8_MMA(0, 0, At, B0); PG8_BAR; PG8_SCHED;
            PG8_LDB(B1, 0, 1); PG8_STAGE(PG8_SB(0, 0), b2, voffB);
            PG8_BAR; PG8_WAIT_L(0); PG8_MMA(0, 1, At, B1); PG8_BAR;
            PG8_LDA(At, 0, 1); PG8_STAGE(PG8_SA(0, 0), a2, voffA);
            PG8_BAR; PG8_WAIT_L(0); PG8_MMA(1, 0, At, B0); PG8_BAR; PG8_SCHED;
            PG8_STAGE(PG8_SB(0, 1), b2 + hstep, voffB);
            PG8_WAIT_V(6); PG8_BAR; PG8_MMA(1, 1, At, B1); PG8_BAR;
            PG8_LDB(B0, 1, 0); PG8_SCHED; PG8_LDA(At, 1, 0); PG8_STAGE(PG8_SA(0, 1), a2 + hstep, voffA);
            PG8_WAIT_L(8); PG8_BAR; PG8_WAIT_L(0); PG8_MMA(0, 0, At, B0); PG8_BAR; PG8_SCHED;
            PG8_LDB(B1, 1, 1); PG8_STAGE(PG8_SB(1, 0), b3, voffB);
            PG8_BAR; PG8_WAIT_L(0); PG8_MMA(0, 1, At, B1); PG8_BAR;
            PG8_LDA(At, 1, 1); PG8_STAGE(PG8_SA(1, 0), a3, voffA);
            PG8_BAR; PG8_WAIT_L(0); PG8_MMA(1, 0, At, B0); PG8_BAR; PG8_SCHED;
            PG8_STAGE(PG8_SB(1, 1), b3 + hstep, voffB);
            PG8_WAIT_V(6); PG8_BAR; PG8_MMA(1, 1, At, B1); PG8_BAR;
        }
        E(acc, cur, wr, wc, fr, fq);
        if (!has_next) break;
#pragma unroll
        for (int a = 0; a < 2; ++a)
#pragma unroll
            for (int b = 0; b < 2; ++b)
#pragma unroll
                for (int m = 0; m < 4; ++m)
#pragma unroll
                    for (int n = 0; n < 2; ++n) acc[a][b][m][n] = (f32x4){0.f, 0.f, 0.f, 0.f};
        cur = nxt; cA = nA; cB = nB; ++ui;
    }
    PG8_WAIT_V(0);
    if (wr == 0) PG8_BAR;
    PG8_BAR;
#undef PG8_SA
#undef PG8_SB
#undef PG8_STAGE
#undef PG8_LDA
#undef PG8_LDB
#undef PG8_MMA
#undef PG8_WAIT_V
#undef PG8_WAIT_L
#undef PG8_BAR
#undef PG8_SCHED
}
}

struct Ctx {
    const float* xp; const float* xs; const float* stC; const float* stN; const float* stM; const float* ssm; const float* conv; const float* ck; const float* cv;
    float* out; unsigned char* ws;
};
#define XWIN ((bf16_t*)(X.ws + WS_WIN))
#define XWOUT ((bf16_t*)(X.ws + WS_WOUT))
#define XXB ((bf16_t*)(X.ws + WS_XB))
#define XU ((bf16_t*)(X.ws + WS_U))
#define XMIX ((bf16_t*)(X.ws + WS_MIX))
#define XSSQ ((float*)(X.ws + WS_SSQ))
#define XROPE ((float*)(X.ws + WS_ROPE))
#define XMC ((float*)(X.ws + WS_MC))
#define XMN ((float*)(X.ws + WS_MN))
#define XML ((float*)(X.ws + WS_ML))
#define XBL ((float*)(X.ws + WS_BL))
#define XMS ((float*)(X.ws + WS_MS))
#define XSA ((float*)(X.ws + WS_SA))
#define XSH ((float*)(X.ws + WS_SH))
#define XCSB ((bf16_t*)(X.ws + WS_CSB))
#define XHSB ((bf16_t*)(X.ws + WS_HSB))
#define XPAR(off) ((const float*)(X.ws + WS_PAR) + (off))
constexpr int P_AIB = 0, P_AFB = 16, P_DTB = 32, P_ALOG = 64, P_BD = 96, P_SINK = 128, P_QNW = 160, P_KNW = 416, P_ANW = 672, P_BNW = 2720, P_CB = 4768, P_CW = 8864, P_END = 25248;
#define IN_XP 0
#define IN_XS 1
#define IN_STC 2
#define IN_STN 3
#define IN_STM 4
#define IN_SSM 5
#define IN_CONV 6
#define IN_CK 7
#define IN_CV 8
#define IN_NORMW 9
#define IN_WIN 10
#define IN_AIB 11
#define IN_AFB 12
#define IN_ANW 13
#define IN_CW 14
#define IN_CB 15
#define IN_DTB 16
#define IN_ALOG 17
#define IN_BD 18
#define IN_BNW 19
#define IN_QNW 20
#define IN_KNW 21
#define IN_SINK 22
#define IN_WOUT 23

__device__ __forceinline__ void transpose_tile(lptr lds, const float* src, int ldn, int nvalid, bf16_t* dst, int ldk, const float* scale, int k0, int n0, int tid) {
    LAS float* T = (LAS float*)lds;
#pragma unroll
    for (int it = 0; it < 2; ++it) {
        const int r = (tid >> 4) + it * 32, c4 = (tid & 15) * 4, n = n0 + c4;
        f32x4 v = {0.f, 0.f, 0.f, 0.f};
        if (n < nvalid) v = *(const f32x4*)(src + (size_t)(k0 + r) * ldn + n);
        const float sc = scale ? scale[k0 + r] : 1.f;
        T[r * 65 + c4 + 0] = v[0] * sc; T[r * 65 + c4 + 1] = v[1] * sc; T[r * 65 + c4 + 2] = v[2] * sc; T[r * 65 + c4 + 3] = v[3] * sc;
    }
    __syncthreads();
    {
        const int n = tid >> 3, k8 = (tid & 7) * 8; float f[8];
#pragma unroll
        for (int j = 0; j < 8; ++j) f[j] = T[(k8 + j) * 65 + n];
        *(u32x4*)(dst + (size_t)(n0 + n) * ldk + k0 + k8) = pack8(f);
    }
    __syncthreads();
}

__device__ __forceinline__ void prologue(lptr lds, const Ctx& X, const Args& args, int G, int bid, int tid) {
    const int lane = tid & 63, wave = tid >> 6;
    constexpr int T0 = 5120, T1 = T0 + 1536, T2 = T1 + 2080, T3 = T2 + 1, T4 = T3 + 513;
    for (int task = bid; task < T4; task += G) {
        if (task < T0) {
            const int l = task / 1280, r = task % 1280, kt = r / 80, ntl = r % 80;
            transpose_tile(lds, args.in[IN_WIN] + (size_t)l * D * DIN, DIN, DIN, XWIN + (size_t)l * NIN * D, D, args.in[IN_NORMW] + l * D, kt * 64, ntl * 64, tid);
        } else if (task < T1) {
            const int t = task - T0, l = t / 384, r = t % 384, kt = r / 16, ntl = r % 16;
            transpose_tile(lds, args.in[IN_WOUT] + (size_t)l * DMIX * D, D, D, XWOUT + (size_t)l * D * DMIX, DMIX, nullptr, kt * 64, ntl * 64, tid);
        } else if (task < T2) {
            const int r = (task - T1) * 8 + wave;
            float ss = 0.f;
            if (r < MTOK) {
                const float* src = r < TP ? X.xp + (size_t)r * D : X.xs + (size_t)(r - TP) * D;
#pragma unroll
                for (int i = 0; i < 4; ++i) {
                    const int c = lane * 4 + i * 256; f32x4 v = *(const f32x4*)(src + c);
                    ss += v[0] * v[0] + v[1] * v[1] + v[2] * v[2] + v[3] * v[3];
                    u32x2 w; w[0] = pk2(v[0], v[1]); w[1] = pk2(v[2], v[3]);
                    *(u32x2*)(XXB + (size_t)r * D + c) = w;
                }
            } else {
#pragma unroll
                for (int i = 0; i < 4; ++i) { u32x2 w = {0u, 0u}; *(u32x2*)(XXB + (size_t)r * D + lane * 4 + i * 256) = w; }
            }
            ss = wave_sum(ss);
            if (lane < 16) XSSQ[(size_t)r * 16 + lane] = (lane == 0) ? ss : 0.f;
        } else if (task < T3) {
            for (int i = tid; i < (MPAD - MTOK) * DMIX / 2; i += NT) ((unsigned*)(XMIX + (size_t)MTOK * DMIX))[i] = 0u;
            float* P = (float*)(X.ws + WS_PAR);
            const int po[12] = {P_AIB, P_AFB, P_DTB, P_ALOG, P_BD, P_SINK, P_QNW, P_KNW, P_ANW, P_BNW, P_CB, P_CW};
            const int pn[12] = {16, 16, 32, 32, 32, 32, 256, 256, 2048, 2048, 4096, 16384};
            const int pi[12] = {IN_AIB, IN_AFB, IN_DTB, IN_ALOG, IN_BD, IN_SINK, IN_QNW, IN_KNW, IN_ANW, IN_BNW, IN_CB, IN_CW};
#pragma unroll
            for (int a = 0; a < 12; ++a) { const float* src = args.in[pi[a]]; for (int i = tid; i < pn[a]; i += NT) P[po[a] + i] = src[i]; }
        } else {
            const int e = (task - T3) * 512 + tid;
            if (e < 8193 * 32) {
                const int pos = e >> 5, d = e & 31;
                const float inv = (float)exp2(-(double)d * (13.287712379549449 / 32.0));
                const float angf = (float)pos * inv;
                const double a = (double)angf;
                const double k = rint(a * 0.15915494309189535);
                const float rr = (float)(a - k * 6.283185307179586);
                XROPE[(size_t)e * 2] = cosf(rr); XROPE[(size_t)e * 2 + 1] = sinf(rr);
            }
        }
    }
}

__device__ __forceinline__ void conv8(const bf16_t* u, int seq0, int tt, int ch, const float* cw, const float* cb, float (&o)[8]) {
    float acc[8];
    { f32x4 b0 = *(const f32x4*)(cb + ch), b1 = *(const f32x4*)(cb + ch + 4);
#pragma unroll
      for (int j = 0; j < 4; ++j) { acc[j] = b0[j]; acc[4 + j] = b1[j]; } }
#pragma unroll
    for (int jj = 0; jj < 4; ++jj) {
        const int t2 = tt + jj - 3;
        if (t2 >= 0) {
            float x[8]; unpack8(*(const u32x4*)(u + (size_t)(seq0 + t2) * NIN + C_BX + ch), x);
            f32x4 w0 = *(const f32x4*)(cw + jj * 1024 + ch), w1 = *(const f32x4*)(cw + jj * 1024 + ch + 4);
#pragma unroll
            for (int j = 0; j < 4; ++j) { acc[j] += x[j] * w0[j]; acc[4 + j] += x[4 + j] * w1[j]; }
        }
    }
#pragma unroll
    for (int j = 0; j < 8; ++j) o[j] = siluf_(acc[j]);
}


__device__ __forceinline__ void conv8x8(const bf16_t* u, int seq0, int tt0, int ch, const float* cw, const float* cb, float (&o)[8][8]) {
    float w[4][8];
#pragma unroll
    for (int jj = 0; jj < 4; ++jj) { f32x4 w0 = *(const f32x4*)(cw + jj * 1024 + ch), w1 = *(const f32x4*)(cw + jj * 1024 + ch + 4);
#pragma unroll
        for (int j = 0; j < 4; ++j) { w[jj][j] = w0[j]; w[jj][4 + j] = w1[j]; } }
    { f32x4 b0 = *(const f32x4*)(cb + ch), b1 = *(const f32x4*)(cb + ch + 4);
#pragma unroll
      for (int t = 0; t < 8; ++t)
#pragma unroll
          for (int j = 0; j < 4; ++j) { o[t][j] = b0[j]; o[t][4 + j] = b1[j]; } }
    u32x4 raw[11];
#pragma unroll
    for (int r = 0; r < 11; ++r) {
        const int t2 = tt0 + r - 3;
        raw[r] = (u32x4){0u, 0u, 0u, 0u};
        if (t2 >= 0) raw[r] = *(const u32x4*)(u + (size_t)(seq0 + t2) * NIN + C_BX + ch);
    }
#pragma unroll
    for (int r = 0; r < 11; ++r) {
        float x[8]; unpack8(raw[r], x);
#pragma unroll
        for (int jj = 0; jj < 4; ++jj) {
            const int t = r - jj;
            if (t >= 0 && t < 8) {
#pragma unroll
                for (int j = 0; j < 8; ++j) o[t][j] += x[j] * w[jj][j];
            }
        }
    }
#pragma unroll
    for (int t = 0; t < 8; ++t)
#pragma unroll
        for (int j = 0; j < 8; ++j) o[t][j] = siluf_(o[t][j]);
}

__device__ __forceinline__ void mlstm_local(lptr lds, const Ctx& X, int l, int task, int tid) {
    const int h = task & 3, c = (task >> 2) & 127, n = task >> 9;
    const int lane = tid & 63, wave = tid >> 6, fr = lane & 15, fq = lane >> 4;
    const int row0 = n * SEQ + c * 64, nh = n * 4 + h;
    lptr VwT = lds;
    lptr KT = lds + 18432;
    LAS float* wv = (LAS float*)(lds + 27648);
    u32x4 vraw[2], kraw;
#pragma unroll
    for (int it = 0; it < 2; ++it) { const int p = tid + it * NT, tok = p >> 4, v8 = (p & 15) * 8; vraw[it] = *(const u32x4*)(XU + (size_t)(row0 + tok) * NIN + C_AV + h * 128 + v8); }
    { const int tok = tid >> 3, k8 = (tid & 7) * 8; kraw = *(const u32x4*)(XU + (size_t)(row0 + tok) * NIN + C_AK + h * 64 + k8); }
    if (wave == 0) {
        const bf16_t* ur = XU + (size_t)(row0 + lane) * NIN;
        const float fg = bf2f(ur[C_AF + h]) + XPAR(P_AFB)[l * 4 + h], ig = bf2f(ur[C_AI + h]) + XPAR(P_AIB)[l * 4 + h];
        const float b = wave_scan_sum(logsigf_(fg), lane);
        const float bl = __shfl(b, 63);
        const float g = bl - b + ig;
        const float ml = wave_max(g);
        wv[lane] = __expf(g - ml);
        if (lane == 0) { XML[nh * 128 + c] = ml; XBL[nh * 128 + c] = bl; }
    }
    __syncthreads();
#pragma unroll
    for (int it = 0; it < 2; ++it) {
        const int p = tid + it * NT, tok = p >> 4, v8 = (p & 15) * 8;
        float x[8]; unpack8(vraw[it], x);
        const float w = wv[tok];
#pragma unroll
        for (int j = 0; j < 8; ++j) *(LAS bf16_t*)(VwT + (((v8 + j) * 72 + tok) << 1)) = (bf16_t)f2bf(x[j] * w);
    }
    {
        const int tok = tid >> 3, k8 = (tid & 7) * 8;
        float x[8]; unpack8(kraw, x);
#pragma unroll
        for (int j = 0; j < 8; ++j) *(LAS bf16_t*)(KT + (((k8 + j) * 72 + tok) << 1)) = (bf16_t)f2bf(x[j] * 0.125f);
    }
    __syncthreads();
    {
        float* dst = XMC + ((size_t)nh * 128 + c) * 8192;
        bf16x8 b0 = lds_frag(VwT, 16 * wave + fr, fq * 8, 72), b1 = lds_frag(VwT, 16 * wave + fr, 32 + fq * 8, 72);
#pragma unroll
        for (int mt = 0; mt < 4; ++mt) {
            f32x4 acc = {0.f, 0.f, 0.f, 0.f};
            acc = mfma16(lds_frag(KT, 16 * mt + fr, fq * 8, 72), b0, acc);
            acc = mfma16(lds_frag(KT, 16 * mt + fr, 32 + fq * 8, 72), b1, acc);
            *(f32x4*)(dst + (16 * wave + fr) * 64 + 16 * mt + 4 * fq) = acc;
        }
    }
    if (tid < 64) {
        float s = 0.f;
#pragma unroll 8
        for (int t = 0; t < 64; ++t) s += bf2f(*(const LAS bf16_t*)(KT + ((tid * 72 + t) << 1))) * wv[t];
        XMN[((size_t)nh * 128 + c) * 64 + tid] = s;
    }
    __syncthreads();
}

__device__ __forceinline__ void ssd_local(lptr lds, const Ctx& X, int l, int task, int tid) {
    const int g = task & 1, c = (task >> 1) & 127, n = task >> 8;
    const int lane = tid & 63, wave = tid >> 6, fr = lane & 15, fq = lane >> 4;
    const int seq0 = n * SEQ, row0 = seq0 + c * 64;
    lptr XwT = lds;
    lptr BT = lds + 36864;
    LAS float* wl = (LAS float*)(lds + 55296);
    {
        const float* cw = XPAR(P_CW) + l * 4096; const float* cb = XPAR(P_CB) + l * 1024;
        const int cg = lane;
        float o[8][8];
        {
            const int cgc = cg < 48 ? cg : 47;
            const int ch = cgc < 32 ? g * 256 + cgc * 8 : 512 + g * 128 + (cgc - 32) * 8;
            conv8x8(XU, seq0, c * 64 + 8 * wave, ch, cw, cb, o);
        }
    if (wave < 4) {
        const int hh = 4 * g + wave;
        const float dt = softplusf_(bf2f(XU[(size_t)(row0 + lane) * NIN + C_BDT + hh]) + XPAR(P_DTB)[l * 8 + hh]);
        const float A = -__expf(XPAR(P_ALOG)[l * 8 + hh]);
        const float a = wave_scan_sum(dt * A, lane);
        const float aL = __shfl(a, 63);
        wl[wave * 64 + lane] = __expf(aL - a) * dt;
        if (lane == 0) XSA[(n * 8 + hh) * 128 + c] = aL;
    }
    __syncthreads();
        if (cg < 48) {
            if (cg < 32) {
                float wt[8];
#pragma unroll
                for (int t = 0; t < 8; ++t) wt[t] = wl[(cg >> 3) * 64 + 8 * wave + t];
#pragma unroll
                for (int jx = 0; jx < 8; ++jx) {
                    float v[8];
#pragma unroll
                    for (int t = 0; t < 8; ++t) v[t] = o[t][jx] * wt[t];
                    *(LAS u32x4*)(XwT + (((cg * 8 + jx) * 72 + 8 * wave) << 1)) = pack8(v);
                }
            } else {
#pragma unroll
                for (int jx = 0; jx < 8; ++jx) {
                    float v[8];
#pragma unroll
                    for (int t = 0; t < 8; ++t) v[t] = o[t][jx];
                    *(LAS u32x4*)(BT + ((((cg - 32) * 8 + jx) * 72 + 8 * wave) << 1)) = pack8(v);
                }
            }
        }
    }
    __syncthreads();
    {
        const int hl = wave >> 1, ph = wave & 1, hh = 4 * g + hl;
        float* dst = XSH + ((size_t)(n * 8 + hh) * 128 + c) * 8192;
        bf16x8 bx[2][2];
#pragma unroll
        for (int ntl = 0; ntl < 2; ++ntl)
#pragma unroll
            for (int kk = 0; kk < 2; ++kk) bx[ntl][kk] = lds_frag(XwT, hl * 64 + ph * 32 + ntl * 16 + fr, kk * 32 + fq * 8, 72);
#pragma unroll
        for (int mt = 0; mt < 8; ++mt) {
            bf16x8 a0 = lds_frag(BT, 16 * mt + fr, fq * 8, 72), a1 = lds_frag(BT, 16 * mt + fr, 32 + fq * 8, 72);
#pragma unroll
            for (int ntl = 0; ntl < 2; ++ntl) {
                f32x4 acc = {0.f, 0.f, 0.f, 0.f};
                acc = mfma16(a0, bx[ntl][0], acc); acc = mfma16(a1, bx[ntl][1], acc);
                *(f32x4*)(dst + (ph * 32 + ntl * 16 + fr) * 128 + 16 * mt + 4 * fq) = acc;
            }
        }
    }
    __syncthreads();
}

__device__ __forceinline__ void swa_prompt(lptr lds, const Ctx& X, int l, int task, int tid) {
    const int kvh = task & 1, qb = (task >> 1) & 63, n = task >> 7;
    const int lane = tid & 63, wave = tid >> 6, fr = lane & 15, fq = lane >> 4;
    const int seq0 = n * SEQ;
    lptr Kn = lds;
    lptr Vt = lds + 36864;
    lptr Pw = lds + 70656 + wave * 8448;
    const float* knw = XPAR(P_KNW) + l * 64; const float* qnw = XPAR(P_QNW) + l * 64;
#pragma unroll
    for (int it = 0; it < 2; ++it) {
        const int item = tid + it * NT, j = item >> 2, qd = item & 3, t = qb * 128 - 128 + j;
        float o1[8], o2[8];
        if (t >= 0) {
            const bf16_t* kr = XU + (size_t)(seq0 + t) * NIN + C_CK + kvh * 64;
            float x1[8], x2[8]; unpack8(*(const u32x4*)(kr + qd * 8), x1); unpack8(*(const u32x4*)(kr + 32 + qd * 8), x2);
            float ss = 0.f;
#pragma unroll
            for (int jj = 0; jj < 8; ++jj) ss += x1[jj] * x1[jj] + x2[jj] * x2[jj];
            ss += __shfl_xor(ss, 1); ss += __shfl_xor(ss, 2);
            const float rs = rsqrtf(ss * (1.f / 64.f) + EPS);
            const float* cs = XROPE + ((size_t)t * 32 + qd * 8) * 2;
#pragma unroll
            for (int jj = 0; jj < 8; ++jj) {
                const float a = x1[jj] * rs * knw[qd * 8 + jj], b = x2[jj] * rs * knw[32 + qd * 8 + jj], co = cs[2 * jj], si = cs[2 * jj + 1];
                o1[jj] = a * co - b * si; o2[jj] = b * co + a * si;
            }
        } else {
#pragma unroll
            for (int jj = 0; jj < 8; ++jj) { o1[jj] = 0.f; o2[jj] = 0.f; }
        }
        *(LAS u32x4*)(Kn + ((j * 72 + qd * 8) << 1)) = pack8(o1);
        *(LAS u32x4*)(Kn + ((j * 72 + 32 + qd * 8) << 1)) = pack8(o2);
        if (qb == 63 && j >= 128) {
            float* ko = X.out + O_PK + ((((size_t)l * 2 + n) * 128 + (j - 128)) * 2 + kvh) * 64;
            *(f32x4*)(ko + qd * 8) = (f32x4){o1[0], o1[1], o1[2], o1[3]}; *(f32x4*)(ko + qd * 8 + 4) = (f32x4){o1[4], o1[5], o1[6], o1[7]};
            *(f32x4*)(ko + 32 + qd * 8) = (f32x4){o2[0], o2[1], o2[2], o2[3]}; *(f32x4*)(ko + 32 + qd * 8 + 4) = (f32x4){o2[4], o2[5], o2[6], o2[7]};
        }
    }
#pragma unroll
    for (int it = 0; it < 4; ++it) {
        const int item = tid + it * NT, j = item >> 3, d8 = (item & 7) * 8, t = qb * 128 - 128 + j;
        u32x4 w = {0u, 0u, 0u, 0u};
        if (t >= 0) w = *(const u32x4*)(XU + (size_t)(seq0 + t) * NIN + C_CV + kvh * 64 + d8);
#pragma unroll
        for (int jj = 0; jj < 8; ++jj) *(LAS bf16_t*)(Vt + (((d8 + jj) * 264 + j) << 1)) = (bf16_t)((w[jj >> 1] >> ((jj & 1) * 16)) & 0xffffu);
        if (qb == 63 && j >= 128) {
            float x[8]; unpack8(w, x);
            float* vo = X.out + O_PV + ((((size_t)l * 2 + n) * 128 + (j - 128)) * 2 + kvh) * 64 + d8;
            *(f32x4*)(vo) = (f32x4){x[0], x[1], x[2], x[3]}; *(f32x4*)(vo + 4) = (f32x4){x[4], x[5], x[6], x[7]};
        }
    }
    __syncthreads();
    const int hq = kvh * 4 + (wave >> 1), i0 = (wave & 1) * 64;
    const float sink = XPAR(P_SINK)[l * 8 + hq];
#pragma unroll 1
    for (int mt = 0; mt < 4; ++mt) {
        bf16x8 a0, a1;
        {
            const int i = i0 + mt * 16 + fr, t = qb * 128 + i;
            const bf16_t* qr = XU + (size_t)(seq0 + t) * NIN + C_CQ + hq * 64;
            float x1[8], x2[8]; unpack8(*(const u32x4*)(qr + fq * 8), x1); unpack8(*(const u32x4*)(qr + 32 + fq * 8), x2);
            float ss = 0.f;
#pragma unroll
            for (int jj = 0; jj < 8; ++jj) ss += x1[jj] * x1[jj] + x2[jj] * x2[jj];
            ss += __shfl_xor(ss, 16); ss += __shfl_xor(ss, 32);
            const float rs = rsqrtf(ss * (1.f / 64.f) + EPS) * 0.125f;
            const float* cs = XROPE + ((size_t)t * 32 + fq * 8) * 2;
            float o1[8], o2[8];
#pragma unroll
            for (int jj = 0; jj < 8; ++jj) {
                const float a = x1[jj] * rs * qnw[fq * 8 + jj], b = x2[jj] * rs * qnw[32 + fq * 8 + jj], co = cs[2 * jj], si = cs[2 * jj + 1];
                o1[jj] = a * co - b * si; o2[jj] = b * co + a * si;
            }
            a0 = as_frag(pack8(o1)); a1 = as_frag(pack8(o2));
        }
        f32x4 s[16];
#pragma unroll
        for (int ntl = 0; ntl < 16; ++ntl) {
            f32x4 acc = {0.f, 0.f, 0.f, 0.f};
            acc = mfma16(a0, lds_frag(Kn, 16 * ntl + fr, fq * 8, 72), acc);
            acc = mfma16(a1, lds_frag(Kn, 16 * ntl + fr, 32 + fq * 8, 72), acc);
            s[ntl] = acc;
        }
        float mx[4] = {-3.0e38f, -3.0e38f, -3.0e38f, -3.0e38f};
#pragma unroll
        for (int ntl = 0; ntl < 16; ++ntl)
#pragma unroll
            for (int ii = 0; ii < 4; ++ii) {
                const int qi = i0 + mt * 16 + fq * 4 + ii, j = 16 * ntl + fr;
                const bool valid = (j > qi) && (j <= qi + 128) && (qb > 0 || j >= 128);
                s[ntl][ii] = valid ? s[ntl][ii] : -3.0e38f;
                mx[ii] = fmaxf(mx[ii], s[ntl][ii]);
            }
        float sum[4];
#pragma unroll
        for (int ii = 0; ii < 4; ++ii) { mx[ii] = fmaxf(red16max(mx[ii]), sink); sum[ii] = 0.f; }
#pragma unroll
        for (int ntl = 0; ntl < 16; ++ntl)
#pragma unroll
            for (int ii = 0; ii < 4; ++ii) { const float e = (s[ntl][ii] > -1.0e38f) ? __expf(s[ntl][ii] - mx[ii]) : 0.f; s[ntl][ii] = e; sum[ii] += e; }
#pragma unroll
        for (int ii = 0; ii < 4; ++ii) sum[ii] = 1.f / (red16(sum[ii]) + __expf(sink - mx[ii]));
#pragma unroll
        for (int ntl = 0; ntl < 16; ++ntl)
#pragma unroll
            for (int ii = 0; ii < 4; ++ii) *(LAS bf16_t*)(Pw + (((fq * 4 + ii) * 264 + 16 * ntl + fr) << 1)) = (bf16_t)f2bf(s[ntl][ii] * sum[ii]);
        LDS_FENCE();
        f32x4 o[4];
#pragma unroll
        for (int ntl = 0; ntl < 4; ++ntl) o[ntl] = (f32x4){0.f, 0.f, 0.f, 0.f};
#pragma unroll
        for (int kk = 0; kk < 8; ++kk) {
            const bf16x8 a = lds_frag(Pw, fr, kk * 32 + fq * 8, 264);
#pragma unroll
            for (int ntl = 0; ntl < 4; ++ntl) o[ntl] = mfma16(a, lds_frag(Vt, 16 * ntl + fr, kk * 32 + fq * 8, 264), o[ntl]);
        }
        LDS_FENCE();
#pragma unroll
        for (int ii = 0; ii < 4; ++ii) {
            const size_t row = (size_t)seq0 + qb * 128 + i0 + mt * 16 + fq * 4 + ii;
#pragma unroll
            for (int ntl = 0; ntl < 4; ++ntl) {
                const int d = 16 * ntl + fr;
                const float cz = bf2f(XU[row * NIN + C_CZ + hq * 64 + d]);
                XMIX[row * DMIX + 1024 + hq * 64 + d] = (bf16_t)f2bf(o[ntl][ii] * siluf_(cz));
            }
        }
    }
    __syncthreads();
}

__device__ __forceinline__ void sample_task(lptr lds, const Ctx& X, int l, int b, int part, int tid) {
    LAS float* uf = (LAS float*)lds;
    LAS float* xbc = (LAS float*)(lds + 19968);
    LAS float* numv = (LAS float*)(lds + 24064);
    LAS float* yv = (LAS float*)(lds + 26112);
    LAS float* red = (LAS float*)(lds + 28160);
    LAS float* qs = (LAS float*)(lds + 28416);
    LAS float* kn = (LAS float*)(lds + 30464);
    LAS float* sc = (LAS float*)(lds + 30976);
    const int lane = tid & 63, wave = tid >> 6;
    const size_t row = (size_t)TP + b;
    const bf16_t* ur = XU + row * NIN;
    const size_t lb = (size_t)l * 128 + b;
    {
        const int c_lo = part == 0 ? 0 : (part == 1 ? C_BZ : C_CQ), c_hi = part == 0 ? C_BZ : (part == 1 ? C_CQ : DIN);
#pragma unroll 2
        for (int i = c_lo + tid; i < c_hi; i += NT) uf[i] = bf2f(ur[i]);
    }
    __syncthreads();
    if (part == 0) {
#pragma unroll 2
    for (int h = 0; h < 4; ++h) {
        const float ig = uf[C_AI + h] + XPAR(P_AIB)[l * 4 + h], fg = uf[C_AF + h] + XPAR(P_AFB)[l * 4 + h];
        const float ls = logsigf_(fg), m0 = X.stM[lb * 4 + h];
        const float mn = fmaxf(ls + m0, ig), sp = __expf(ls + m0 - mn), sl = __expf(ig - mn);
        const float* C0 = X.stC + (lb * 4 + h) * 8192; float* C1 = X.out + O_SC + (lb * 4 + h) * 8192;
#pragma unroll
        for (int it = 0; it < 4; ++it) {
            const int e = (tid + it * NT) * 4, v = e >> 6, k = e & 63;
            const f32x4 c0 = *(const f32x4*)(C0 + e);
            const float vv = uf[C_AV + h * 128 + v] * sl;
            f32x4 c1; float part = 0.f;
#pragma unroll
            for (int j = 0; j < 4; ++j) { c1[j] = sp * c0[j] + vv * (uf[C_AK + h * 64 + k + j] * 0.125f); part += c1[j] * uf[C_AQ + h * 64 + k + j]; }
            *(f32x4*)(C1 + e) = c1;
            part = red16(part);
            if ((lane & 15) == 0) numv[h * 128 + v] = part;
        }
        if (wave == 0) {
            const float n1 = sp * X.stN[(lb * 4 + h) * 64 + lane] + sl * uf[C_AK + h * 64 + lane] * 0.125f;
            X.out[O_SN + (lb * 4 + h) * 64 + lane] = n1;
            const float dd = wave_sum(n1 * uf[C_AQ + h * 64 + lane]);
            if (lane == 0) { red[h] = dd; red[4 + h] = mn; X.out[O_SM + lb * 4 + h] = mn; }
        }
    }
    __syncthreads();
    float hv;
    { const int h = tid >> 7; hv = numv[tid] / fmaxf(fabsf(red[h]), __expf(-red[4 + h])); const float ss = wave_sum(hv * hv); if (lane == 0) red[8 + wave] = ss; }
    __syncthreads();
    { const int h = tid >> 7; const float rs = rsqrtf((red[8 + 2 * h] + red[9 + 2 * h]) * (1.f / 128.f) + EPS);
      XMIX[row * DMIX + tid] = (bf16_t)f2bf(hv * rs * XPAR(P_ANW)[l * 512 + tid] * sigmoidf_(uf[C_AO + tid]) * siluf_(uf[C_AZ + tid])); }
    }
    if (part == 1) {
    {
        const float* buf = X.conv + lb * 3 * 1024; float* oc = X.out + O_SCONV + lb * 3 * 1024;
        const float* cw = XPAR(P_CW) + l * 4096;
#pragma unroll
        for (int it = 0; it < 2; ++it) {
            const int ch = tid + it * NT;
            const float f0 = buf[ch], f1 = buf[1024 + ch], f2 = buf[2048 + ch], f3 = uf[C_BX + ch];
            const float acc = XPAR(P_CB)[l * 1024 + ch] + f0 * cw[ch] + f1 * cw[1024 + ch] + f2 * cw[2048 + ch] + f3 * cw[3072 + ch];
            xbc[ch] = siluf_(acc);
            oc[ch] = f1; oc[1024 + ch] = f2; oc[2048 + ch] = f3;
        }
    }
    __syncthreads();
#pragma unroll 2
    for (int hh = 0; hh < 8; ++hh) {
        const float dt = softplusf_(uf[C_BDT + hh] + XPAR(P_DTB)[l * 8 + hh]);
        const float dA = __expf(-dt * __expf(XPAR(P_ALOG)[l * 8 + hh]));
        const int g = hh >> 2;
        const float* h0p = X.ssm + (lb * 8 + hh) * 8192; float* h1p = X.out + O_SH + (lb * 8 + hh) * 8192;
#pragma unroll
        for (int it = 0; it < 4; ++it) {
            const int e = (tid + it * NT) * 4, p = e >> 7, s = e & 127;
            const f32x4 h0 = *(const f32x4*)(h0p + e);
            const float xv = xbc[hh * 64 + p] * dt;
            f32x4 h1; float part = 0.f;
#pragma unroll
            for (int j = 0; j < 4; ++j) { h1[j] = dA * h0[j] + xv * xbc[512 + g * 128 + s + j]; part += h1[j] * xbc[768 + g * 128 + s + j]; }
            *(f32x4*)(h1p + e) = h1;
            part = red16(part); part += __shfl_xor(part, 16);
            if ((lane & 31) == 0) yv[hh * 64 + p] = part;
        }
    }
    __syncthreads();
    float gb;
    { const int hh = tid >> 6; const float y = yv[tid] + XPAR(P_BD)[l * 8 + hh] * xbc[tid]; gb = y * siluf_(uf[C_BZ + tid]); const float ss = wave_sum(gb * gb); if (lane == 0) red[16 + wave] = ss; }
    __syncthreads();
    { const int g = tid >> 8; const float rs = rsqrtf((red[16 + 4 * g] + red[17 + 4 * g] + red[18 + 4 * g] + red[19 + 4 * g]) * (1.f / 256.f) + EPS);
      XMIX[row * DMIX + 512 + tid] = (bf16_t)f2bf(gb * rs * XPAR(P_BNW)[l * 512 + tid]); }
    }
    if (part == 2) {
    if (tid < 320) {
        const int vec = tid >> 5, d = tid & 31, base = vec < 8 ? C_CQ + vec * 64 : C_CK + (vec - 8) * 64;
        const float x1 = uf[base + d], x2 = uf[base + 32 + d];
        float ss = x1 * x1 + x2 * x2; ss = red16(ss); ss += __shfl_xor(ss, 16);
        const float rs = rsqrtf(ss * (1.f / 64.f) + EPS);
        const float* w = vec < 8 ? XPAR(P_QNW) + l * 64 : XPAR(P_KNW) + l * 64;
        const float a = x1 * rs * w[d], bb = x2 * rs * w[d + 32];
        const float co = XROPE[((size_t)8192 * 32 + d) * 2], si = XROPE[((size_t)8192 * 32 + d) * 2 + 1];
        const float o1 = a * co - bb * si, o2 = bb * co + a * si;
        if (vec < 8) { qs[vec * 64 + d] = o1 * 0.125f; qs[vec * 64 + 32 + d] = o2 * 0.125f; } else { kn[(vec - 8) * 64 + d] = o1; kn[(vec - 8) * 64 + 32 + d] = o2; }
    }
    __syncthreads();
    const float* kc = X.ck + lb * 16384; const float* vc = X.cv + lb * 16384;
    {
        float* ko = X.out + O_SK + lb * 16384; float* vo = X.out + O_SV + lb * 16384;
#pragma unroll 4
        for (int it = 0; it < 8; ++it) {
            const int e = (tid + it * NT) * 4, j = e >> 7, r = e & 127;
            f32x4 kv, vv;
            if (j < 127) { kv = *(const f32x4*)(kc + e + 128); vv = *(const f32x4*)(vc + e + 128); }
            else { kv = (f32x4){kn[r], kn[r + 1], kn[r + 2], kn[r + 3]}; vv = (f32x4){uf[C_CV + r], uf[C_CV + r + 1], uf[C_CV + r + 2], uf[C_CV + r + 3]}; }
            *(f32x4*)(ko + e) = kv; *(f32x4*)(vo + e) = vv;
        }
    }
    if (tid < 256) {
        const int kvh = tid >> 7, jj = tid & 127;
        float s0 = 0.f, s1 = 0.f, s2 = 0.f, s3 = 0.f;
#pragma unroll 4
        for (int d4 = 0; d4 < 16; ++d4) {
            f32x4 kv;
            if (jj < 127) kv = *(const f32x4*)(kc + (jj + 1) * 128 + kvh * 64 + d4 * 4);
            else kv = (f32x4){kn[kvh * 64 + d4 * 4], kn[kvh * 64 + d4 * 4 + 1], kn[kvh * 64 + d4 * 4 + 2], kn[kvh * 64 + d4 * 4 + 3]};
#pragma unroll
            for (int j = 0; j < 4; ++j) {
                s0 += kv[j] * qs[(kvh * 4 + 0) * 64 + d4 * 4 + j]; s1 += kv[j] * qs[(kvh * 4 + 1) * 64 + d4 * 4 + j];
                s2 += kv[j] * qs[(kvh * 4 + 2) * 64 + d4 * 4 + j]; s3 += kv[j] * qs[(kvh * 4 + 3) * 64 + d4 * 4 + j];
            }
        }
        sc[(kvh * 4 + 0) * 128 + jj] = s0; sc[(kvh * 4 + 1) * 128 + jj] = s1; sc[(kvh * 4 + 2) * 128 + jj] = s2; sc[(kvh * 4 + 3) * 128 + jj] = s3;
    }
    __syncthreads();
    {
        const int hq = wave; const float s0 = sc[hq * 128 + lane], s1 = sc[hq * 128 + 64 + lane], sink = XPAR(P_SINK)[l * 8 + hq];
        const float m = fmaxf(wave_max(fmaxf(s0, s1)), sink);
        const float e0 = __expf(s0 - m), e1 = __expf(s1 - m);
        const float inv = 1.f / (wave_sum(e0 + e1) + __expf(sink - m));
        sc[hq * 128 + lane] = e0 * inv; sc[hq * 128 + 64 + lane] = e1 * inv;
    }
    __syncthreads();
    {
        const int hq = tid >> 6, d = tid & 63, kvh = hq >> 2;
        float o = 0.f;
#pragma unroll 16
        for (int jj = 0; jj < 127; ++jj) o += sc[hq * 128 + jj] * vc[(jj + 1) * 128 + kvh * 64 + d];
        o += sc[hq * 128 + 127] * uf[C_CV + kvh * 64 + d];
        XMIX[row * DMIX + 1024 + tid] = (bf16_t)f2bf(o * siluf_(uf[C_CZ + tid]));
    }
    }
    __syncthreads();
}

__device__ __forceinline__ void scans(const Ctx& X, int l, int gt, int nthreads) {
    for (int item = gt; item < 98816; item += nthreads) {
        if (item < 32768) {
            const int nh = item >> 12, e = (item & 4095) * 2;
            float* base = XMC + (size_t)nh * 128 * 8192 + e;
            const float* ml = XML + nh * 128; const float* bl = XBL + nh * 128;
            float m = 0.f; f32x2 st = {0.f, 0.f};
            for (int c0 = 0; c0 < 128; c0 += 8) {
                f32x2 cl[8];
#pragma unroll
                for (int j = 0; j < 8; ++j) cl[j] = *(const f32x2*)(base + (size_t)(c0 + j) * 8192);
#pragma unroll
                for (int j = 0; j < 8; ++j) {
                    const float mlj = ml[c0 + j], blj = bl[c0 + j], mn = fmaxf(blj + m, mlj), sp = __expf(blj + m - mn), sl = __expf(mlj - mn);
                    *(unsigned*)(XCSB + ((size_t)nh * 128 + c0 + j) * 8192 + e) = pk2(st[0], st[1]);
                    if (e == 0) XMS[nh * 128 + c0 + j] = m;
                    st = st * sp + cl[j] * sl; m = mn;
                }
            }
            *(f32x2*)(X.out + O_PC + ((size_t)l * 8 + nh) * 8192 + e) = st;
            if (e == 0) X.out[O_PM + l * 8 + nh] = m;
        } else if (item < 98304) {
            const int i1 = item - 32768, nhh = i1 >> 12, e = (i1 & 4095) * 2;
            float* base = XSH + (size_t)nhh * 128 * 8192 + e;
            const float* al = XSA + nhh * 128;
            f32x2 st = {0.f, 0.f};
            for (int c0 = 0; c0 < 128; c0 += 8) {
                f32x2 cl[8];
#pragma unroll
                for (int j = 0; j < 8; ++j) cl[j] = *(const f32x2*)(base + (size_t)(c0 + j) * 8192);
#pragma unroll
                for (int j = 0; j < 8; ++j) {
                    const float dec = __expf(al[c0 + j]);
                    *(unsigned*)(XHSB + ((size_t)nhh * 128 + c0 + j) * 8192 + e) = pk2(st[0], st[1]);
                    st = st * dec + cl[j];
                }
            }
            *(f32x2*)(X.out + O_PH + ((size_t)l * 16 + nhh) * 8192 + e) = st;
        } else {
            const int i2 = item - 98304, nh = i2 >> 6, k = i2 & 63;
            float* base = XMN + (size_t)nh * 128 * 64 + k;
            const float* ml = XML + nh * 128; const float* bl = XBL + nh * 128;
            float m = 0.f, st = 0.f;
            for (int c = 0; c < 128; ++c) {
                const float mlj = ml[c], blj = bl[c], mn = fmaxf(blj + m, mlj), sp = __expf(blj + m - mn), sl = __expf(mlj - mn);
                const float cl = base[c * 64];
                base[c * 64] = st;
                st = st * sp + cl * sl; m = mn;
            }
            X.out[O_PN + ((size_t)l * 8 + nh) * 64 + k] = st;
        }
    }
}

__device__ __forceinline__ void mlstm_out(lptr lds, const Ctx& X, int l, int task, int tid) {
    const int h = task & 3, c = (task >> 2) & 127, n = task >> 9;
    const int lane = tid & 63, wave = tid >> 6, fr = lane & 15, fq = lane >> 4;
    const int row0 = n * SEQ + c * 64, nh = n * 4 + h;
    lptr Qs = lds;
    lptr Ks = lds + 9216;
    lptr Vt = lds + 18432;
    lptr Sb = lds + 36864 + wave * 2304;
    LAS float* bv = (LAS float*)(lds + 55296);
    LAS float* dv = bv + 64;
    LAS float* mtv = bv + 128;
    LAS float* siv = bv + 192;
    LAS float* qnv = bv + 256;
    LAS float* ssqp = bv + 384;
    LAS float* nsv = bv + 512;
    const int mti = wave >> 1, half = wave & 1;
    u32x4 csf[2][4];
    {
        const bf16_t* Cs = XCSB + ((size_t)nh * 128 + c) * 8192;
#pragma unroll
        for (int kk = 0; kk < 2; ++kk)
#pragma unroll
            for (int ntl = 0; ntl < 4; ++ntl) csf[kk][ntl] = *(const u32x4*)(Cs + (64 * half + 16 * ntl + fr) * 64 + kk * 32 + fq * 8);
    }
    unsigned short aov[4][4], azv[4][4]; float anw[4];
#pragma unroll
    for (int ntl = 0; ntl < 4; ++ntl) {
        const int v = h * 128 + 64 * half + 16 * ntl + fr;
        anw[ntl] = XPAR(P_ANW)[l * 512 + v];
#pragma unroll
        for (int ii = 0; ii < 4; ++ii) {
            const size_t row = (size_t)row0 + 16 * mti + fq * 4 + ii;
            aov[ntl][ii] = XU[row * NIN + C_AO + v]; azv[ntl][ii] = XU[row * NIN + C_AZ + v];
        }
    }
    u32x4 qraw, kraw, vraw[2];
    {
        const int tok = tid >> 3, k8 = (tid & 7) * 8;
        const bf16_t* ur = XU + (size_t)(row0 + tok) * NIN;
        qraw = *(const u32x4*)(ur + C_AQ + h * 64 + k8); kraw = *(const u32x4*)(ur + C_AK + h * 64 + k8);
#pragma unroll
        for (int it = 0; it < 2; ++it) { const int p = tid + it * NT, tk = p >> 4, v8 = (p & 15) * 8; vraw[it] = *(const u32x4*)(XU + (size_t)(row0 + tk) * NIN + C_AV + h * 128 + v8); }
    }
    if (wave == 0) {
        const bf16_t* ur = XU + (size_t)(row0 + lane) * NIN;
        const float fg = bf2f(ur[C_AF + h]) + XPAR(P_AFB)[l * 4 + h], ig = bf2f(ur[C_AI + h]) + XPAR(P_AIB)[l * 4 + h];
        const float b = wave_scan_sum(logsigf_(fg), lane);
        const float dd = ig - b;
        const float cm = wave_scan_max(dd, lane);
        const float ms = XMS[nh * 128 + c];
        const float mt = b + fmaxf(ms, cm);
        bv[lane] = b; dv[lane] = dd; mtv[lane] = mt; siv[lane] = __expf(b + ms - mt);
        nsv[lane] = XMN[((size_t)nh * 128 + c) * 64 + lane];
    }
    {
        const int tok = tid >> 3, k8 = (tid & 7) * 8;
        *(LAS u32x4*)(Qs + ((tok * 72 + k8) << 1)) = qraw;
        float x[8]; unpack8(kraw, x);
#pragma unroll
        for (int j = 0; j < 8; ++j) x[j] *= 0.125f;
        *(LAS u32x4*)(Ks + ((tok * 72 + k8) << 1)) = pack8(x);
    }
#pragma unroll
    for (int it = 0; it < 2; ++it) {
        const int p = tid + it * NT, tok = p >> 4, v8 = (p & 15) * 8;
        const u32x4 w = vraw[it];
#pragma unroll
        for (int j = 0; j < 8; ++j) *(LAS bf16_t*)(Vt + (((v8 + j) * 72 + tok) << 1)) = (bf16_t)((w[j >> 1] >> ((j & 1) * 16)) & 0xffffu);
    }
    __syncthreads();
    bf16x8 qa[2];
    qa[0] = lds_frag(Qs, 16 * mti + fr, fq * 8, 72); qa[1] = lds_frag(Qs, 16 * mti + fr, 32 + fq * 8, 72);
    {
        float x0[8], x1[8]; unpack8(__builtin_bit_cast(u32x4, qa[0]), x0); unpack8(__builtin_bit_cast(u32x4, qa[1]), x1);
        float d = 0.f;
#pragma unroll
        for (int j = 0; j < 8; ++j) d += x0[j] * nsv[fq * 8 + j] + x1[j] * nsv[32 + fq * 8 + j];
        d += __shfl_xor(d, 16); d += __shfl_xor(d, 32);
        if (fq == 0) qnv[wave * 16 + fr] = d;
    }
    float rsum[4] = {0.f, 0.f, 0.f, 0.f};
#pragma unroll
    for (int ntl = 0; ntl < 4; ++ntl) {
        f32x4 s = {0.f, 0.f, 0.f, 0.f};
        s = mfma16(qa[0], lds_frag(Ks, 16 * ntl + fr, fq * 8, 72), s);
        s = mfma16(qa[1], lds_frag(Ks, 16 * ntl + fr, 32 + fq * 8, 72), s);
#pragma unroll
        for (int ii = 0; ii < 4; ++ii) {
            const int t = 16 * mti + fq * 4 + ii, sidx = 16 * ntl + fr;
            const float wgt = (sidx <= t) ? __expf(bv[t] + dv[sidx] - mtv[t]) : 0.f;
            const float sv = wgt * s[ii];
            rsum[ii] += sv;
            *(LAS bf16_t*)(Sb + (((fq * 4 + ii) * 72 + sidx) << 1)) = (bf16_t)f2bf(sv);
        }
    }
    LDS_FENCE();
    f32x4 acc[4];
#pragma unroll
    for (int ntl = 0; ntl < 4; ++ntl) acc[ntl] = (f32x4){0.f, 0.f, 0.f, 0.f};
#pragma unroll
    for (int kk = 0; kk < 2; ++kk) {
        const bf16x8 a = lds_frag(Sb, fr, kk * 32 + fq * 8, 72);
#pragma unroll
        for (int ntl = 0; ntl < 4; ++ntl) acc[ntl] = mfma16(a, lds_frag(Vt, 64 * half + 16 * ntl + fr, kk * 32 + fq * 8, 72), acc[ntl]);
    }
    {
        const float sia = siv[16 * mti + fr];
#pragma unroll
        for (int kk = 0; kk < 2; ++kk) {
            float x[8]; unpack8(__builtin_bit_cast(u32x4, qa[kk]), x);
#pragma unroll
            for (int j = 0; j < 8; ++j) x[j] *= sia;
            const bf16x8 a = as_frag(pack8(x));
#pragma unroll
            for (int ntl = 0; ntl < 4; ++ntl) acc[ntl] = mfma16(a, as_frag(csf[kk][ntl]), acc[ntl]);
        }
    }
    float hv[4][4], ssl[4];
#pragma unroll
    for (int ii = 0; ii < 4; ++ii) {
        const int t = 16 * mti + fq * 4 + ii;
        const float den = red16(rsum[ii]) + siv[t] * qnv[wave * 16 + fq * 4 + ii];
        const float inv = 1.f / fmaxf(fabsf(den), __expf(-mtv[t]));
        float ss = 0.f;
#pragma unroll
        for (int ntl = 0; ntl < 4; ++ntl) { hv[ntl][ii] = acc[ntl][ii] * inv; ss += hv[ntl][ii] * hv[ntl][ii]; }
        ssl[ii] = red16(ss);
        if (fr == 0) ssqp[t * 2 + half] = ssl[ii];
    }
    __syncthreads();
#pragma unroll
    for (int ii = 0; ii < 4; ++ii) {
        const int t = 16 * mti + fq * 4 + ii;
        const float rs = rsqrtf((ssqp[t * 2] + ssqp[t * 2 + 1]) * (1.f / 128.f) + EPS);
        const size_t row = (size_t)row0 + t;
#pragma unroll
        for (int ntl = 0; ntl < 4; ++ntl) {
            const int v = h * 128 + 64 * half + 16 * ntl + fr;
            const float ao = bf2f(aov[ntl][ii]), az = bf2f(azv[ntl][ii]);
            XMIX[row * DMIX + v] = (bf16_t)f2bf(hv[ntl][ii] * rs * anw[ntl] * sigmoidf_(ao) * siluf_(az));
        }
    }
    __syncthreads();
}

__device__ __forceinline__ void ssd_out(lptr lds, const Ctx& X, int l, int task, int tid) {
    const int g = task & 1, c = (task >> 1) & 127, n = task >> 8;
    const int lane = tid & 63, wave = tid >> 6, fr = lane & 15, fq = lane >> 4;
    const int seq0 = n * SEQ, row0 = seq0 + c * 64;
    lptr Cm = lds;
    lptr Bm = lds + 17408;
    lptr Xt = lds + 34816;
    LAS float* CBf = (LAS float*)(lds + 71680);
    LAS float* av = (LAS float*)(lds + 89088);
    LAS float* dtv = (LAS float*)(lds + 90112);
    LAS float* ssq = (LAS float*)(lds + 91136);
    const int hl = wave >> 1, th = wave & 1, hh = 4 * g + hl;
    u32x4 hsf[4][4];
    {
        const bf16_t* hs = XHSB + ((size_t)(n * 8 + hh) * 128 + c) * 8192;
#pragma unroll
        for (int kk = 0; kk < 4; ++kk)
#pragma unroll
            for (int ntl = 0; ntl < 4; ++ntl) hsf[kk][ntl] = *(const u32x4*)(hs + (16 * ntl + fr) * 128 + kk * 32 + fq * 8);
    }
    if (wave < 4) {
        const int hh = 4 * g + wave;
        const float dt = softplusf_(bf2f(XU[(size_t)(row0 + lane) * NIN + C_BDT + hh]) + XPAR(P_DTB)[l * 8 + hh]);
        const float A = -__expf(XPAR(P_ALOG)[l * 8 + hh]);
        av[wave * 64 + lane] = wave_scan_sum(dt * A, lane);
        dtv[wave * 64 + lane] = dt;
    }
    {
        const float* cw = XPAR(P_CW) + l * 4096; const float* cb = XPAR(P_CB) + l * 1024;
        const int cg = lane;
        const int ch = cg < 32 ? g * 256 + cg * 8 : (cg < 48 ? 512 + g * 128 + (cg - 32) * 8 : 768 + g * 128 + (cg - 48) * 8);
        float o[8][8];
        conv8x8(XU, seq0, c * 64 + 8 * wave, ch, cw, cb, o);
        if (cg < 32) {
#pragma unroll
            for (int jx = 0; jx < 8; ++jx) {
                float v[8];
#pragma unroll
                for (int t = 0; t < 8; ++t) v[t] = o[t][jx];
                *(LAS u32x4*)(Xt + (((cg * 8 + jx) * 72 + 8 * wave) << 1)) = pack8(v);
            }
        } else {
            lptr dstm = cg < 48 ? Bm : Cm; const int s8 = (cg < 48 ? cg - 32 : cg - 48) * 8;
#pragma unroll
            for (int t = 0; t < 8; ++t) *(LAS u32x4*)(dstm + (((8 * wave + t) * 136 + s8) << 1)) = pack8(o[t]);
        }
    }
    __syncthreads();
    unsigned short bzv[2][4][4]; float bnw[4];
#pragma unroll
    for (int ntl = 0; ntl < 4; ++ntl) {
        bnw[ntl] = XPAR(P_BNW)[l * 512 + hh * 64 + 16 * ntl + fr];
#pragma unroll
        for (int mi = 0; mi < 2; ++mi)
#pragma unroll
            for (int ii = 0; ii < 4; ++ii) bzv[mi][ntl][ii] = XU[((size_t)row0 + 16 * (2 * th + mi) + fq * 4 + ii) * NIN + C_BZ + hh * 64 + 16 * ntl + fr];
    }
    {
        const int mt = wave >> 1;
#pragma unroll
        for (int q = 0; q < 2; ++q) {
            const int ntl = 2 * (wave & 1) + q;
            f32x4 acc = {0.f, 0.f, 0.f, 0.f};
#pragma unroll
            for (int kk = 0; kk < 4; ++kk) acc = mfma16(lds_frag(Cm, 16 * mt + fr, kk * 32 + fq * 8, 136), lds_frag(Bm, 16 * ntl + fr, kk * 32 + fq * 8, 136), acc);
#pragma unroll
            for (int ii = 0; ii < 4; ++ii) CBf[(16 * mt + fq * 4 + ii) * 68 + 16 * ntl + fr] = acc[ii];
        }
    }
    __syncthreads();
    f32x4 y1[2][4], y2[2][4];
#pragma unroll
    for (int mi = 0; mi < 2; ++mi)
#pragma unroll
        for (int ntl = 0; ntl < 4; ++ntl) { y1[mi][ntl] = (f32x4){0.f, 0.f, 0.f, 0.f}; y2[mi][ntl] = (f32x4){0.f, 0.f, 0.f, 0.f}; }
#pragma unroll
    for (int kk = 0; kk < 2; ++kk) {
        bf16x8 bx[4];
#pragma unroll
        for (int ntl = 0; ntl < 4; ++ntl) bx[ntl] = lds_frag(Xt, hl * 64 + 16 * ntl + fr, kk * 32 + fq * 8, 72);
#pragma unroll
        for (int mi = 0; mi < 2; ++mi) {
            const int t = 16 * (2 * th + mi) + fr, u0 = kk * 32 + fq * 8;
            const float at = av[hl * 64 + t];
            float w[8];
#pragma unroll
            for (int j = 0; j < 8; ++j) {
                const int uu = u0 + j;
                w[j] = (uu <= t) ? CBf[t * 68 + uu] * __expf(at - av[hl * 64 + uu]) * dtv[hl * 64 + uu] : 0.f;
            }
            const bf16x8 a = as_frag(pack8(w));
#pragma unroll
            for (int ntl = 0; ntl < 4; ++ntl) y1[mi][ntl] = mfma16(a, bx[ntl], y1[mi][ntl]);
        }
    }
    {
#pragma unroll
        for (int kk = 0; kk < 4; ++kk) {
            bf16x8 bh[4];
#pragma unroll
            for (int ntl = 0; ntl < 4; ++ntl) bh[ntl] = as_frag(hsf[kk][ntl]);
#pragma unroll
            for (int mi = 0; mi < 2; ++mi) {
                const bf16x8 a = lds_frag(Cm, 16 * (2 * th + mi) + fr, kk * 32 + fq * 8, 136);
#pragma unroll
                for (int ntl = 0; ntl < 4; ++ntl) y2[mi][ntl] = mfma16(a, bh[ntl], y2[mi][ntl]);
            }
        }
    }
    const float Dh = XPAR(P_BD)[l * 8 + hh];
#pragma unroll
    for (int mi = 0; mi < 2; ++mi)
#pragma unroll
        for (int ii = 0; ii < 4; ++ii) {
            const int t = 16 * (2 * th + mi) + fq * 4 + ii;
            const float ea = __expf(av[hl * 64 + t]);
            const size_t row = (size_t)row0 + t;
            float ss = 0.f;
#pragma unroll
            for (int ntl = 0; ntl < 4; ++ntl) {
                const int p = 16 * ntl + fr;
                const float xv = bf2f(*(const LAS bf16_t*)(Xt + (((hl * 64 + p) * 72 + t) << 1)));
                const float y = y1[mi][ntl][ii] + ea * y2[mi][ntl][ii] + Dh * xv;
                const float gbv = y * siluf_(bf2f(bzv[mi][ntl][ii]));
                y1[mi][ntl][ii] = gbv; ss += gbv * gbv;
            }
            ss = red16(ss);
            if (fr == 0) ssq[t * 4 + hl] = ss;
        }
    __syncthreads();
#pragma unroll
    for (int mi = 0; mi < 2; ++mi)
#pragma unroll
        for (int ii = 0; ii < 4; ++ii) {
            const int t = 16 * (2 * th + mi) + fq * 4 + ii;
            const float rs = rsqrtf((ssq[t * 4] + ssq[t * 4 + 1] + ssq[t * 4 + 2] + ssq[t * 4 + 3]) * (1.f / 256.f) + EPS);
            const size_t row = (size_t)row0 + t;
#pragma unroll
            for (int ntl = 0; ntl < 4; ++ntl) {
                const int p = hh * 64 + 16 * ntl + fr;
                XMIX[row * DMIX + 512 + p] = (bf16_t)f2bf(y1[mi][ntl][ii] * rs * bnw[ntl]);
            }
        }
    __syncthreads();
}


#define XB_TMO      128
#define XB_XCNT(j)  (256  + 64 * (j))
#define XB_XSUB(j)  (1280 + 64 * (j))
#define XB_XGEN(j)  (2304 + 64 * (j))
#define XB_TOP      3328
#define XB_TOPGEN   3392
#define XCD_BAR_WORDS 3456
#define XB_SPIN_CAP (1u << 18)
__device__ __forceinline__ unsigned xb_ld(unsigned* p)              { return __hip_atomic_load(p, __ATOMIC_RELAXED, __HIP_MEMORY_SCOPE_AGENT); }
__device__ __forceinline__ unsigned xb_add(unsigned* p, unsigned v) { return __hip_atomic_fetch_add(p, v, __ATOMIC_RELAXED, __HIP_MEMORY_SCOPE_AGENT); }
__device__ __forceinline__ unsigned xb_xcc_id() { return (unsigned)__builtin_amdgcn_s_getreg((3 << 11) | 20) & 0xFu; }
#define XB_SPIN(cond, bar) do { unsigned _sp = 0; while (cond) { __builtin_amdgcn_s_sleep(1); \
    if ((++_sp & 255u) == 0u) { if (xb_ld(&(bar)[XB_TMO])) break; if (_sp > XB_SPIN_CAP) { atomicAdd(&(bar)[XB_TMO], 1u); break; } } } } while (0)
struct XcdBarrier { unsigned* bar; unsigned x; volatile LAS unsigned* st; };
__device__ __forceinline__ XcdBarrier xcd_barrier_post(unsigned* bar, volatile LAS unsigned* st) {
    XcdBarrier b; b.bar = bar; b.x = xb_xcc_id(); b.st = st;
    if (threadIdx.x == 0) (void)xb_add(&bar[XB_XCNT(b.x)], 1u);
    return b;
}
__device__ __forceinline__ void xcd_barrier_complete(unsigned* bar, unsigned x, unsigned& nloc, unsigned& nx) {
    const unsigned G = gridDim.x * gridDim.y * gridDim.z;
    unsigned sum, cnt, mine, sp = 0u;
    for (;;) {
        sum = 0u; cnt = 0u; mine = 0u;
#pragma unroll
        for (unsigned j = 0; j < 16; ++j) { const unsigned c = xb_ld(&bar[XB_XCNT(j)]); sum += c; cnt += (c > 0u) ? 1u : 0u; mine = (j == x) ? c : mine; }
        if (sum == G) break;
        __builtin_amdgcn_s_sleep(1);
        if ((++sp & 255u) == 0u) { if (xb_ld(&bar[XB_TMO])) break; if (sp > XB_SPIN_CAP) { atomicAdd(&bar[XB_TMO], 1u); break; } }
    }
    nloc = mine > 0u ? mine : 1u; nx = cnt > 0u ? cnt : 1u;
}
__device__ __forceinline__ void xcd_barrier(const XcdBarrier& b) {
    asm volatile("s_waitcnt vmcnt(0)" ::: "memory");
    __syncthreads();
    if (threadIdx.x == 0) {
        unsigned* bar = b.bar;
        __builtin_amdgcn_s_waitcnt(0);
        unsigned nloc = b.st[0], nx = b.st[1];
        if (nloc == 0u) { xcd_barrier_complete(bar, b.x, nloc, nx); b.st[0] = nloc; b.st[1] = nx; }
        const unsigned old = xb_add(&bar[XB_XSUB(b.x)], 1u);
        const unsigned gen = old / nloc;
        if (old + 1u == (gen + 1u) * nloc) {
            __builtin_amdgcn_fence(__ATOMIC_RELEASE, "agent");
            asm volatile("s_waitcnt vmcnt(0)" ::: "memory");
            const unsigned og = xb_add(&bar[XB_TOP], 1u);
            const unsigned tg = og / nx;
            if (og + 1u == (tg + 1u) * nx) xb_add(&bar[XB_TOPGEN], 1u);
            else XB_SPIN(xb_ld(&bar[XB_TOPGEN]) == tg, bar);
            __builtin_amdgcn_fence(__ATOMIC_ACQUIRE, "agent");
            xb_add(&bar[XB_XGEN(b.x)], 1u);
            asm volatile("s_waitcnt vmcnt(0)" ::: "memory");
        } else {
            XB_SPIN(xb_ld(&bar[XB_XGEN(b.x)]) == gen, bar);
            __builtin_amdgcn_fence(__ATOMIC_ACQUIRE, "agent");
            asm volatile("s_waitcnt vmcnt(0)" ::: "memory");
        }
    }
    __syncthreads();
}

__global__ void __launch_bounds__(NT, 2) mega(Args args) {
    __shared__ __attribute__((aligned(16))) unsigned char lds_raw[LDS_BYTES];
    lptr lds = (lptr)lds_raw;
    cg::grid_group grid = cg::this_grid();
    const int tid = threadIdx.x, bid = blockIdx.x, G = gridDim.x;
    Ctx X;
    X.xp = args.in[IN_XP]; X.xs = args.in[IN_XS]; X.stC = args.in[IN_STC]; X.stN = args.in[IN_STN]; X.stM = args.in[IN_STM]; X.ssm = args.in[IN_SSM];
    X.conv = args.in[IN_CONV]; X.ck = args.in[IN_CK]; X.cv = args.in[IN_CV]; X.out = args.out; X.ws = args.ws;
    const int lo = args.ph_lo, hi = args.ph_hi;
    volatile LAS unsigned* xst = (volatile LAS unsigned*)(lds + LDS_BYTES - 16);
    if (tid == 0) { xst[0] = 0u; xst[1] = 0u; }
    __syncthreads();
    XcdBarrier xbar = xcd_barrier_post((unsigned*)(args.ws + WS_BAR), xst);
#define IN(k) (lo <= (k) && (k) < hi)
#define SEAM(k) do { if (IN(k) && IN((k) + 1)) { for (int _r = 0; _r < REP_SYNC; ++_r) { if ((k) == 0) grid.sync(); else xcd_barrier(xbar); } } } while (0)
    if (IN(0)) { prologue(lds, X, args, G, bid, tid); }
    SEAM(0);
    for (int l = 0; l < 4; ++l) {
        const int pb = 1 + l * 5;
        if (IN(pb)) for (int _r = 0; _r < REP_P1; ++_r) {
            pg8::Gemm g{XXB, XWIN + (size_t)l * NIN * D, MPAD, NIN, D}; pg8::StaticOrder S; S.init(l == 0 ? MPAD : TP, NIN, G, bid);
            pg8::EpiU E{XU, XSSQ};
            pg8::gemm_phase<pg8::EpiU, pg8::StaticOrder>(lds, g, S, E, OPQ(tid));
        }
        SEAM(pb);
        if (IN(pb + 1)) for (int _r = 0; _r < REP_P2; ++_r) {
            for (int task = bid; task < 2177; task += G) {
                if (task < 384) for (int _q = 0; _q < RT_SAMPLE; ++_q) sample_task(lds, X, l, task & 127, task < 128 ? 1 : (task < 256 ? 0 : 2), OPQ(tid));
                else if (task < 640) for (int _q = 0; _q < RT_SWA; ++_q) swa_prompt(lds, X, l, task - 384, OPQ(tid));
                else if (task < 1152) for (int _q = 0; _q < RT_SLOC; ++_q) ssd_local(lds, X, l, task - 640, OPQ(tid));
                else if (task < 2176) for (int _q = 0; _q < RT_MLOC; ++_q) mlstm_local(lds, X, l, task - 1152, OPQ(tid));
                else {
                    for (int i = tid; i < 2 * 3 * 1024; i += NT) {
                        const int ch = i & 1023, j = (i >> 10) % 3, n = i / 3072;
                        X.out[O_PCONV + (((size_t)l * 2 + n) * 3 + j) * 1024 + ch] = bf2f(XU[(size_t)(n * SEQ + SEQ - 3 + j) * NIN + C_BX + ch]);
                    }
                }
            }
        }
        SEAM(pb + 1);
        if (IN(pb + 2)) {
            if (bid >= G - 4) {
                pg8::Gemm g{XMIX, XWOUT + (size_t)l * D * DMIX, MPAD, D, DMIX}; pg8::SampleOrder S{G - 4, 4, bid};
                pg8::EpiRes E{l == 0 ? X.xp : nullptr, X.xs, X.out, XXB, XSSQ};
                pg8::gemm_phase<pg8::EpiRes, pg8::SampleOrder>(lds, g, S, E, OPQ(tid));
            }
            scans(X, l, bid * NT + OPQ(tid), G * NT);
        }
        SEAM(pb + 2);
        if (IN(pb + 3)) for (int _r = 0; _r < REP_P4; ++_r) {
            for (int task = bid; task < 1536; task += G) {
                if (task < 512) for (int _q = 0; _q < RT_SOUT; ++_q) ssd_out(lds, X, l, task, OPQ(tid));
                else mlstm_out(lds, X, l, task - 512, OPQ(tid));
            }
        }
        SEAM(pb + 3);
        if (IN(pb + 4)) {
            {
                pg8::Gemm g{XMIX, XWOUT + (size_t)l * D * DMIX, MPAD, D, DMIX}; pg8::StaticOrder S; S.init(TP, D, G, bid);
                pg8::EpiRes E{l == 0 ? X.xp : nullptr, X.xs, X.out, XXB, XSSQ};
                pg8::gemm_phase<pg8::EpiRes, pg8::StaticOrder>(lds, g, S, E, OPQ(tid));
            }
            if (l < 3 && bid < 20) {
                pg8::Gemm g{XXB, XWIN + (size_t)(l + 1) * NIN * D, MPAD, NIN, D}; pg8::SampleOrder S{0, 20, bid};
                pg8::EpiU E{XU, XSSQ};
                pg8::gemm_phase<pg8::EpiU, pg8::SampleOrder>(lds, g, S, E, OPQ(tid));
            }
        }
        SEAM(pb + 4);
    }
#undef IN
#undef SEAM
}

extern "C" void kernel_launch(void* const* d_in, const int* in_sizes, int n_in, void* d_out, int out_size, void* d_ws, size_t ws_size, hipStream_t stream) {
    static int grid_blocks = 0;
    if (!grid_blocks) {
        int dev = 0, cus = 0, per_cu = 0;
        hipGetDevice(&dev);
        hipDeviceGetAttribute(&cus, hipDeviceAttributeMultiprocessorCount, dev);
        hipOccupancyMaxActiveBlocksPerMultiprocessor(&per_cu, mega, NT, 0);
        if (per_cu < 1) { fprintf(stderr, "occupancy query returned %d\n", per_cu); per_cu = 1; }
        grid_blocks = cus * 1;
        if (ws_size < WS_END) fprintf(stderr, "workspace too small: %zu < %zu\n", ws_size, (size_t)WS_END);
    }
    (void)hipMemsetAsync(d_ws, 0, 16384, stream);
    Args a{};
    for (int i = 0; i < 24; ++i) a.in[i] = (const float*)d_in[i];
    a.out = (float*)d_out; a.ws = (unsigned char*)d_ws;
    const int NPH = 21;
#if MULTI_LAUNCH
    for (int p = 0; p < NPH; ++p) {
        a.ph_lo = p; a.ph_hi = p + 1;
        void* kargs[] = {&a};
        hipError_t e = hipLaunchCooperativeKernel((void*)mega, dim3(grid_blocks), dim3(NT), kargs, 0, stream);
        if (e != hipSuccess) fprintf(stderr, "cooperative launch failed: %s (grid %d)\n", hipGetErrorString(e), grid_blocks);
    }
#else
    a.ph_lo = 0; a.ph_hi = NPH;
    void* kargs[] = {&a};
    hipError_t e = hipLaunchCooperativeKernel((void*)mega, dim3(grid_blocks), dim3(NT), kargs, 0, stream);
    if (e != hipSuccess) fprintf(stderr, "cooperative launch failed: %s (grid %d)\n", hipGetErrorString(e), grid_blocks);
#endif
}
```

```cpp
#include <hip/hip_runtime.h>
#include <hip/hip_cooperative_groups.h>
#include <cstdio>
#include <cstdint>
namespace cg = cooperative_groups;

#ifndef REP_SYNC
#define REP_SYNC 1
#endif
#ifndef REP_P1
#define REP_P1 1
#endif
#ifndef REP_P2
#define REP_P2 1
#endif
#ifndef REP_P4
#define REP_P4 1
#endif
#ifndef RT_SAMPLE
#define RT_SAMPLE 1
#endif
#ifndef RT_SWA
#define RT_SWA 1
#endif
#ifndef RT_SLOC
#define RT_SLOC 1
#endif
#ifndef RT_MLOC
#define RT_MLOC 1
#endif
#ifndef RT_SOUT
#define RT_SOUT 1
#endif
#ifndef MULTI_LAUNCH
#define MULTI_LAUNCH 0
#endif

#define LAS __attribute__((address_space(3)))
typedef unsigned short bf16_t;
typedef short bf16x8 __attribute__((ext_vector_type(8)));
typedef float f32x4 __attribute__((ext_vector_type(4)));
typedef float f32x2 __attribute__((ext_vector_type(2)));
typedef unsigned u32x4 __attribute__((ext_vector_type(4)));
typedef unsigned u32x2 __attribute__((ext_vector_type(2)));
typedef __bf16 bf16x2_t __attribute__((ext_vector_type(2)));
typedef LAS unsigned char* lptr;

constexpr int D = 1024, DIN = 4880, NIN = 5120, DMIX = 1536, TP = 16384, MTOK = 16512, MPAD = 16640, SEQ = 8192;
constexpr int C_AQ = 0, C_AK = 256, C_AV = 512, C_AO = 1024, C_AZ = 1536, C_AI = 2048, C_AF = 2052, C_BZ = 2056, C_BX = 2568, C_BB = 3080, C_BC = 3336,
              C_BDT = 3592, C_CQ = 3600, C_CK = 4112, C_CV = 4240, C_CZ = 4368;
constexpr float EPS = 1e-6f;
constexpr size_t O_YP = 0, O_YS = 16777216, O_PC = 16908288, O_PN = 17170432, O_PM = 17172480, O_PH = 17172512, O_PCONV = 17696800, O_PK = 17721376,
                 O_PV = 17852448, O_SC = 17983520, O_SN = 34760736, O_SM = 34891808, O_SH = 34893856, O_SCONV = 68448288, O_SK = 70021152, O_SV = 78409760;
constexpr size_t WS_BAR = 0;
constexpr size_t WS_PAR = 16384;
constexpr size_t WS_WIN = WS_PAR + 102400;
constexpr size_t WS_WOUT = WS_WIN + (size_t)4 * NIN * D * 2;
constexpr size_t WS_XB = WS_WOUT + (size_t)4 * D * DMIX * 2;
constexpr size_t WS_U = WS_XB + (size_t)MPAD * D * 2;
constexpr size_t WS_MIX = WS_U + (size_t)MPAD * NIN * 2;
constexpr size_t WS_SSQ = WS_MIX + (size_t)MPAD * DMIX * 2;
constexpr size_t WS_ROPE = WS_SSQ + (size_t)MPAD * 16 * 4;
constexpr size_t WS_MC = WS_ROPE + (size_t)8200 * 64 * 4;
constexpr size_t WS_MN = WS_MC + (size_t)8 * 128 * 8192 * 4;
constexpr size_t WS_ML = WS_MN + (size_t)8 * 128 * 64 * 4;
constexpr size_t WS_BL = WS_ML + 4096;
constexpr size_t WS_MS = WS_BL + 4096;
constexpr size_t WS_SA = WS_MS + 4096;
constexpr size_t WS_SH = WS_SA + 8192;
constexpr size_t WS_CSB = WS_SH + (size_t)16 * 128 * 8192 * 4;
constexpr size_t WS_HSB = WS_CSB + (size_t)8 * 128 * 8192 * 2;
constexpr size_t WS_END = WS_HSB + (size_t)16 * 128 * 8192 * 2;
constexpr int LDS_BYTES = 139264;
constexpr int NT = 512;

struct Args { const float* in[24]; float* out; unsigned char* ws; int ph_lo, ph_hi; };

__device__ __forceinline__ float bf2f(unsigned v) { return __uint_as_float(v << 16); }
__device__ __forceinline__ unsigned pk2(float lo, float hi) { f32x2 v = {lo, hi}; bf16x2_t b = __builtin_convertvector(v, bf16x2_t); return __builtin_bit_cast(unsigned, b); }
__device__ __forceinline__ unsigned f2bf(float f) { return pk2(f, 0.f) & 0xffffu; }
__device__ __forceinline__ void unpack8(u32x4 w, float (&f)[8]) {
#pragma unroll
    for (int i = 0; i < 4; ++i) { f[2 * i] = __uint_as_float(w[i] << 16); f[2 * i + 1] = __uint_as_float(w[i] & 0xffff0000u); }
}
__device__ __forceinline__ u32x4 pack8(const float (&f)[8]) { u32x4 w; w[0] = pk2(f[0], f[1]); w[1] = pk2(f[2], f[3]); w[2] = pk2(f[4], f[5]); w[3] = pk2(f[6], f[7]); return w; }
__device__ __forceinline__ u32x4 pack8v(f32x4 a, f32x4 b) { u32x4 w; w[0] = pk2(a[0], a[1]); w[1] = pk2(a[2], a[3]); w[2] = pk2(b[0], b[1]); w[3] = pk2(b[2], b[3]); return w; }
__device__ __forceinline__ bf16x8 as_frag(u32x4 w) { return __builtin_bit_cast(bf16x8, w); }
__device__ __forceinline__ bf16x8 ldg_f32_frag(const float* p) { f32x4 a = *(const f32x4*)p, b = *(const f32x4*)(p + 4); return as_frag(pack8v(a, b)); }
__device__ __forceinline__ bf16x8 lds_frag(lptr base, int row, int k, int stride) { return *(const LAS bf16x8*)(base + ((row * stride + k) << 1)); }
__device__ __forceinline__ f32x4 mfma16(bf16x8 a, bf16x8 b, f32x4 c) { return __builtin_amdgcn_mfma_f32_16x16x32_bf16(a, b, c, 0, 0, 0); }
__device__ __forceinline__ float sigmoidf_(float x) { return 1.f / (1.f + __expf(-x)); }
__device__ __forceinline__ float siluf_(float x) { return x / (1.f + __expf(-x)); }
__device__ __forceinline__ float softplusf_(float x) { return x > 20.f ? x : log1pf(__expf(x)); }
__device__ __forceinline__ float logsigf_(float x) { return fminf(x, 0.f) - log1pf(__expf(-fabsf(x))); }
__device__ __forceinline__ float wave_scan_sum(float v, int lane) {
#pragma unroll
    for (int o = 1; o < 64; o <<= 1) { float t = __shfl_up(v, o); if (lane >= o) v += t; }
    return v;
}
__device__ __forceinline__ float wave_scan_max(float v, int lane) {
#pragma unroll
    for (int o = 1; o < 64; o <<= 1) { float t = __shfl_up(v, o); if (lane >= o) v = fmaxf(v, t); }
    return v;
}
__device__ __forceinline__ float wave_sum(float v) {
#pragma unroll
    for (int o = 1; o < 64; o <<= 1) v += __shfl_xor(v, o);
    return v;
}
__device__ __forceinline__ float wave_max(float v) {
#pragma unroll
    for (int o = 1; o < 64; o <<= 1) v = fmaxf(v, __shfl_xor(v, o));
    return v;
}
__device__ __forceinline__ float red16(float v) { v += __shfl_xor(v, 1); v += __shfl_xor(v, 2); v += __shfl_xor(v, 4); v += __shfl_xor(v, 8); return v; }
__device__ __forceinline__ float red16max(float v) { v = fmaxf(v, __shfl_xor(v, 1)); v = fmaxf(v, __shfl_xor(v, 2)); v = fmaxf(v, __shfl_xor(v, 4)); v = fmaxf(v, __shfl_xor(v, 8)); return v; }
__device__ __forceinline__ int OPQ(int v) { asm volatile("" : "+v"(v)); return v; }
#define LDS_FENCE() asm volatile("s_waitcnt lgkmcnt(0)" ::: "memory")

namespace pg8 {
constexpr int BM = 256, BK = 64, HALF = 128, HTB = HALF * BK * 2, STAGE_BYTES = 8 * HTB, NXCD = 8, WGM = 8;
__host__ __device__ __forceinline__ int lds_byte(int r, int c) { const int st = (r >> 4) * 2 + (c >> 5), rr = r & 15, cc = c & 31, ob = rr * 64 + cc * 2; return st * 1024 + (ob ^ (((ob >> 9) & 1) << 5)); }
__host__ __device__ __forceinline__ void stage_rc(int b, int& R, int& C) { const int st = b / 1024, sb = b % 1024, swz = sb ^ (((sb >> 9) & 1) << 5); R = (st >> 1) * 16 + swz / 64; C = (st & 1) * 32 + (swz % 64) / 2; }
__host__ __device__ __forceinline__ int perm32(int rho) { const int n = rho >> 4, i = rho & 15; return 8 * (i >> 2) + 4 * n + (i & 3); }
struct Unit { int pm, pn; };
struct Gemm { const bf16_t* A; const bf16_t* Bt; int M, N, K; };
struct StaticOrder {
    int nM, nN, nwg, G, c;
    __device__ void init(int M, int N, int G_, int c_) { nM = M / BM; nN = N / BM; nwg = nM * nN; G = G_; c = c_; }
    __device__ bool next(int i, Unit& u) const {
        const long L = (long)i * G + c; if (L >= nwg) return false;
        int wgid = (int)L; { const int q = nwg / NXCD, r = nwg % NXCD, xcd = wgid % NXCD, off = wgid / NXCD; wgid = (xcd < r ? xcd * (q + 1) : r * (q + 1) + (xcd - r) * q) + off; }
        const int nig = WGM * nN, gid = wgid / nig, fm = gid * WGM, gsz = (nM - fm) < WGM ? (nM - fm) : WGM;
        u.pm = fm + ((wgid % nig) % gsz); u.pn = (wgid % nig) / gsz; return true;
    }
};
struct EpiU {
    bf16_t* U; const float* ssq;
    __device__ __forceinline__ void operator()(const f32x4 (&acc)[2][2][4][2], const Unit& u, int wr, int wc, int fr, int fq) const {
        const int row0 = u.pm * BM + wr * 64 + fr, col0 = u.pn * BM + wc * 32 + 8 * fq;
#pragma unroll
        for (int ai = 0; ai < 2; ++ai)
#pragma unroll
            for (int m = 0; m < 4; ++m) {
                const int r = row0 + ai * HALF + m * 16;
                const f32x4 s = *(const f32x4*)(ssq + (size_t)r * 16 + fq * 4);
                float st = s[0] + s[1] + s[2] + s[3]; st += __shfl_xor(st, 16); st += __shfl_xor(st, 32);
                const float rs = rsqrtf(st * (1.f / 1024.f) + EPS);
                bf16_t* rowp = U + (size_t)r * NIN + col0;
#pragma unroll
                for (int bj = 0; bj < 2; ++bj) *(u32x4*)(rowp + bj * HALF) = pack8v(acc[ai][bj][m][0] * rs, acc[ai][bj][m][1] * rs);
                __builtin_amdgcn_sched_barrier(0);
            }
    }
};
struct EpiRes {
    const float* xp; const float* xs; float* out; bf16_t* xb; float* ssq;
    __device__ __forceinline__ void operator()(const f32x4 (&acc)[2][2][4][2], const Unit& u, int wr, int wc, int fr, int fq) const {
        const int row0 = u.pm * BM + wr * 64 + fr, col0 = u.pn * BM + wc * 32 + 8 * fq;
#pragma unroll
        for (int ai = 0; ai < 2; ++ai)
#pragma unroll
            for (int m = 0; m < 4; ++m) {
                const int r = row0 + ai * HALF + m * 16;
                const bool valid = r < MTOK;
                const float* src = xp ? (r < TP ? xp + (size_t)r * D : xs + (size_t)(r - TP) * D) : out + (size_t)r * D;
                float part = 0.f;
#pragma unroll
                for (int bj = 0; bj < 2; ++bj) {
                    const int c = col0 + bj * HALF;
                    f32x4 o0 = {0.f, 0.f, 0.f, 0.f}, o1 = {0.f, 0.f, 0.f, 0.f};
                    if (valid) { o0 = *(const f32x4*)(src + c); o1 = *(const f32x4*)(src + c + 4); }
                    const f32x4 v0 = acc[ai][bj][m][0] + o0, v1 = acc[ai][bj][m][1] + o1;
                    if (valid) { *(f32x4*)(out + (size_t)r * D + c) = v0; *(f32x4*)(out + (size_t)r * D + c + 4) = v1; }
                    *(u32x4*)(xb + (size_t)r * D + c) = pack8v(v0, v1);
                    part += v0[0] * v0[0] + v0[1] * v0[1] + v0[2] * v0[2] + v0[3] * v0[3] + v1[0] * v1[0] + v1[1] * v1[1] + v1[2] * v1[2] + v1[3] * v1[3];
                }
                part += __shfl_xor(part, 16); part += __shfl_xor(part, 32);
                if (fq == 0) ssq[(size_t)r * 16 + u.pn * 4 + wc] = part;
                __builtin_amdgcn_sched_barrier(0);
            }
    }
};

struct SampleOrder {
    int first, cnt, c;
    __device__ bool next(int i, Unit& u) const { if (i != 0 || c < first || c >= first + cnt) return false; u.pm = 64; u.pn = c - first; return true; }
};
template <class Epi, class Sched>
__device__ __forceinline__ void gemm_phase(lptr lds, const Gemm g, const Sched& S, const Epi& E, const int tid) {
    const int wid = __builtin_amdgcn_readfirstlane(tid >> 6), lane = tid & 63, wr = wid >> 2, wc = wid & 3, fr = lane & 15, fq = lane >> 4;
    const int K = g.K, nt = K / BK;
    unsigned voffA[2], voffB[2];
#pragma unroll
    for (int i = 0; i < 2; ++i) { int R, C; stage_rc(tid * 16 + i * 8192, R, C); const int Rb = (R & ~31) + perm32(R & 31);
        voffA[i] = (unsigned)(R * K + C) * 2u; voffB[i] = (unsigned)(Rb * K + C) * 2u; }
    const size_t kstep = (size_t)(BK * 2);
    const size_t hstep = (size_t)HALF * K * 2;
    const size_t tstep = 2 * hstep;
    const unsigned ldsw = (unsigned)wid * 1024u;
    const int aoff = lds_byte(wr * 64 + fr, fq * 8), boff = lds_byte(wc * 32 + fr, fq * 8);
#define PG8_SA(b, h) (((b) * 2 + (h)) * HTB)
#define PG8_SB(b, h) ((4 + (b) * 2 + (h)) * HTB)
#define PG8_STAGE(bufoff, gbase, voff) do { _Pragma("unroll") for (int _i = 0; _i < 2; ++_i) \
        __builtin_amdgcn_global_load_lds((const unsigned*)((const char*)(gbase) + (voff)[_i]), (LAS unsigned*)(lds + (bufoff) + ldsw + _i * 8192), 16, 0, 0); } while (0)
#define PG8_LDA(dst, b, h) do { _Pragma("unroll") for (int m = 0; m < 4; ++m) _Pragma("unroll") for (int k = 0; k < 2; ++k) dst[m][k] = *(const LAS bf16x8*)(lds + PG8_SA(b, h) + aoff + m * 2048 + k * 1024); } while (0)
#define PG8_LDB(dst, b, h) do { _Pragma("unroll") for (int n = 0; n < 2; ++n) _Pragma("unroll") for (int k = 0; k < 2; ++k) dst[n][k] = *(const LAS bf16x8*)(lds + PG8_SB(b, h) + boff + n * 2048 + k * 1024); } while (0)
#define PG8_MMA(ai, bj, At, Bt) do { __builtin_amdgcn_s_setprio(1); _Pragma("unroll") for (int m = 0; m < 4; ++m) _Pragma("unroll") for (int n = 0; n < 2; ++n) _Pragma("unroll") for (int k = 0; k < 2; ++k) \
        acc[ai][bj][m][n] = __builtin_amdgcn_mfma_f32_16x16x32_bf16(Bt[n][k], At[m][k], acc[ai][bj][m][n], 0, 0, 0); __builtin_amdgcn_s_setprio(0); } while (0)
#define PG8_WAIT_V(n) asm volatile("s_waitcnt vmcnt(" #n ")" ::: "memory")
#define PG8_WAIT_L(n) asm volatile("s_waitcnt lgkmcnt(" #n ")" ::: "memory")
#define PG8_BAR __builtin_amdgcn_s_barrier()
#define PG8_SCHED __builtin_amdgcn_sched_barrier(0)
    Unit cur, nxt; int ui = 0;
    if (!S.next(0, cur)) return;
    f32x4 acc[2][2][4][2];
#pragma unroll
    for (int a = 0; a < 2; ++a)
#pragma unroll
        for (int b = 0; b < 2; ++b)
#pragma unroll
            for (int m = 0; m < 4; ++m)
#pragma unroll
                for (int n = 0; n < 2; ++n) acc[a][b][m][n] = (f32x4){0.f, 0.f, 0.f, 0.f};
    bf16x8 At[4][2], B0[2][2], B1[2][2];
    const char* cA = (const char*)g.A + (size_t)cur.pm * tstep; const char* cB = (const char*)g.Bt + (size_t)cur.pn * tstep;
    PG8_STAGE(PG8_SB(0, 0), cB, voffB); PG8_STAGE(PG8_SA(0, 0), cA, voffA); PG8_STAGE(PG8_SB(0, 1), cB + hstep, voffB); PG8_STAGE(PG8_SA(0, 1), cA + hstep, voffA);
    if (wr == 1) PG8_BAR;
    PG8_WAIT_V(4); PG8_BAR;
    PG8_STAGE(PG8_SB(1, 0), cB + kstep, voffB); PG8_STAGE(PG8_SA(1, 0), cA + kstep, voffA); PG8_STAGE(PG8_SB(1, 1), cB + hstep + kstep, voffB);
    PG8_WAIT_V(6); PG8_BAR;
    for (;;) {
        const bool has_next = S.next(ui + 1, nxt);
        const char* nA = has_next ? (const char*)g.A + (size_t)nxt.pm * tstep : cA; const char* nB = has_next ? (const char*)g.Bt + (size_t)nxt.pn * tstep : cB;
        for (int t = 0; t < nt; t += 2) {
            const bool last = (t == nt - 2);
            const char* a1 = cA + (size_t)(t + 1) * kstep;
            const char* a2 = last ? nA : cA + (size_t)(t + 2) * kstep; const char* b2 = last ? nB : cB + (size_t)(t + 2) * kstep;
            const char* a3 = a2 + kstep; const char* b3 = b2 + kstep;
            PG8_LDB(B0, 0, 0); PG8_SCHED; PG8_LDA(At, 0, 0); PG8_STAGE(PG8_SA(1, 1), a1 + hstep, voffA);
            PG8_WAIT_L(8); PG8_BAR; PG8_WAIT_L(0); PG8_MMA(0, 0, At, B0); PG8_BAR; PG8_SCHED;
            PG8_LDB(B1, 0, 1); PG8_STAGE(PG8_SB(0, 0), b2, voffB);
            PG8_BAR; PG8_WAIT_L(0); PG8_MMA(0, 1, At, B1); PG8_BAR;
            PG8_LDA(At, 0, 1); PG8_STAGE(PG8_SA(0, 0), a2, voffA);
            PG8_BAR; PG8_WAIT_L(0); PG8_MMA(1, 0, At, B0); PG8_BAR; PG8_SCHED;
            PG8_STAGE(PG8_SB(0, 1), b2 + hstep, voffB);
            PG8_WAIT_V(6); PG8_BAR; PG8_MMA(1, 1, At, B1); PG8_BAR;
            PG8_LDB(B0, 1, 0); PG8_SCHED; PG8_LDA(At, 1, 0); PG8_STAGE(PG8_SA(0, 1), a2 + hstep, voffA);
            PG8_WAIT_L(8); PG8_BAR; PG8_WAIT_L(0); PG8_MMA(0, 0, At, B0); PG8_BAR; PG8_SCHED;
            PG8_LDB(B1, 1, 1); PG8_STAGE(PG8_SB(1, 0), b3, voffB);
            PG8_BAR; PG8_WAIT_L(0); PG8_MMA(0, 1, At, B1); PG8_BAR;
            PG8_LDA(At, 1, 1); PG8_STAGE(PG8_SA(1, 0), a3, voffA);
            PG8_BAR; PG8_WAIT_L(0); PG8_MMA(1, 0, At, B0); PG8_BAR; PG8_SCHED;
            PG8_STAGE(PG8_SB(1, 1), b3 + hstep, voffB);
            PG8_WAIT_V(6); PG8_BAR; PG8_MMA(1, 1, At, B1); PG8_BAR;
        }
        E(acc, cur, wr, wc, fr, fq);
        if (!has_next) break;
#pragma unroll
        for (int a = 0; a < 2; ++a)
#pragma unroll
            for (int b = 0; b < 2; ++b)
#pragma unroll
                for (int m = 0; m < 4; ++m)
#pragma unroll
                    for (int n = 0; n < 2; ++n) acc[a][b][m][n] = (f32x4){0.f, 0.f, 0.f, 0.f};
        cur = nxt; cA = nA; cB = nB; ++ui;
    }
    PG8_WAIT_V(0);
    if (wr == 0) PG8_BAR;
    PG8_BAR;
#undef PG8_SA
#undef PG8_SB
#undef PG8_STAGE
#undef PG8_LDA
#undef PG8_LDB
#undef PG8_MMA
#undef PG8_WAIT_V
#undef PG8_WAIT_L
#undef PG8_BAR
#undef PG8_SCHED
}
}

struct Ctx {
    const float* xp; const float* xs; const float* stC; const float* stN; const float* stM; const float* ssm; const float* conv; const float* ck; const float* cv;
    float* out; unsigned char* ws;
};
#define XWIN ((bf16_t*)(X.ws + WS_WIN))
#define XWOUT ((bf16_t*)(X.ws + WS_WOUT))
#define XXB ((bf16_t*)(X.ws + WS_XB))
#define XU ((bf16_t*)(X.ws + WS_U))
#define XMIX ((bf16_t*)(X.ws + WS_MIX))
#define XSSQ ((float*)(X.ws + WS_SSQ))
#define XROPE ((float*)(X.ws + WS_ROPE))
#define XMC ((float*)(X.ws + WS_MC))
#define XMN ((float*)(X.ws + WS_MN))
#define XML ((float*)(X.ws + WS_ML))
#define XBL ((float*)(X.ws + WS_BL))
#define XMS ((float*)(X.ws + WS_MS))
#define XSA ((float*)(X.ws + WS_SA))
#define XSH ((float*)(X.ws + WS_SH))
#define XCSB ((bf16_t*)(X.ws + WS_CSB))
#define XHSB ((bf16_t*)(X.ws + WS_HSB))
#define XPAR(off) ((const float*)(X.ws + WS_PAR) + (off))
constexpr int P_AIB = 0, P_AFB = 16, P_DTB = 32, P_ALOG = 64, P_BD = 96, P_SINK = 128, P_QNW = 160, P_KNW = 416, P_ANW = 672, P_BNW = 2720, P_CB = 4768, P_CW = 8864, P_END = 25248;
#define IN_XP 0
#define IN_XS 1
#define IN_STC 2
#define IN_STN 3
#define IN_STM 4
#define IN_SSM 5
#define IN_CONV 6
#define IN_CK 7
#define IN_CV 8
#define IN_NORMW 9
#define IN_WIN 10
#define IN_AIB 11
#define IN_AFB 12
#define IN_ANW 13
#define IN_CW 14
#define IN_CB 15
#define IN_DTB 16
#define IN_ALOG 17
#define IN_BD 18
#define IN_BNW 19
#define IN_QNW 20
#define IN_KNW 21
#define IN_SINK 22
#define IN_WOUT 23

__device__ __forceinline__ void transpose_tile(lptr lds, const float* src, int ldn, int nvalid, bf16_t* dst, int ldk, const float* scale, int k0, int n0, int tid) {
    LAS float* T = (LAS float*)lds;
#pragma unroll
    for (int it = 0; it < 2; ++it) {
        const int r = (tid >> 4) + it * 32, c4 = (tid & 15) * 4, n = n0 + c4;
        f32x4 v = {0.f, 0.f, 0.f, 0.f};
        if (n < nvalid) v = *(const f32x4*)(src + (size_t)(k0 + r) * ldn + n);
        const float sc = scale ? scale[k0 + r] : 1.f;
        T[r * 65 + c4 + 0] = v[0] * sc; T[r * 65 + c4 + 1] = v[1] * sc; T[r * 65 + c4 + 2] = v[2] * sc; T[r * 65 + c4 + 3] = v[3] * sc;
    }
    __syncthreads();
    {
        const int n = tid >> 3, k8 = (tid & 7) * 8; float f[8];
#pragma unroll
        for (int j = 0; j < 8; ++j) f[j] = T[(k8 + j) * 65 + n];
        *(u32x4*)(dst + (size_t)(n0 + n) * ldk + k0 + k8) = pack8(f);
    }
    __syncthreads();
}

__device__ __forceinline__ void prologue(lptr lds, const Ctx& X, const Args& args, int G, int bid, int tid) {
    const int lane = tid & 63, wave = tid >> 6;
    constexpr int T0 = 5120, T1 = T0 + 1536, T2 = T1 + 2080, T3 = T2 + 1, T4 = T3 + 513;
    for (int task = bid; task < T4; task += G) {
        if (task < T0) {
            const int l = task / 1280, r = task % 1280, kt = r / 80, ntl = r % 80;
            transpose_tile(lds, args.in[IN_WIN] + (size_t)l * D * DIN, DIN, DIN, XWIN + (size_t)l * NIN * D, D, args.in[IN_NORMW] + l * D, kt * 64, ntl * 64, tid);
        } else if (task < T1) {
            const int t = task - T0, l = t / 384, r = t % 384, kt = r / 16, ntl = r % 16;
            transpose_tile(lds, args.in[IN_WOUT] + (size_t)l * DMIX * D, D, D, XWOUT + (size_t)l * D * DMIX, DMIX, nullptr, kt * 64, ntl * 64, tid);
        } else if (task < T2) {
            const int r = (task - T1) * 8 + wave;
            float ss = 0.f;
            if (r < MTOK) {
                const float* src = r < TP ? X.xp + (size_t)r * D : X.xs + (size_t)(r - TP) * D;
#pragma unroll
                for (int i = 0; i < 4; ++i) {
                    const int c = lane * 4 + i * 256; f32x4 v = *(const f32x4*)(src + c);
                    ss += v[0] * v[0] + v[1] * v[1] + v[2] * v[2] + v[3] * v[3];
                    u32x2 w; w[0] = pk2(v[0], v[1]); w[1] = pk2(v[2], v[3]);
                    *(u32x2*)(XXB + (size_t)r * D + c) = w;
                }
            } else {
#pragma unroll
                for (int i = 0; i < 4; ++i) { u32x2 w = {0u, 0u}; *(u32x2*)(XXB + (size_t)r * D + lane * 4 + i * 256) = w; }
            }
            ss = wave_sum(ss);
            if (lane < 16) XSSQ[(size_t)r * 16 + lane] = (lane == 0) ? ss : 0.f;
        } else if (task < T3) {
            for (int i = tid; i < (MPAD - MTOK) * DMIX / 2; i += NT) ((unsigned*)(XMIX + (size_t)MTOK * DMIX))[i] = 0u;
            float* P = (float*)(X.ws + WS_PAR);
            const int po[12] = {P_AIB, P_AFB, P_DTB, P_ALOG, P_BD, P_SINK, P_QNW, P_KNW, P_ANW, P_BNW, P_CB, P_CW};
            const int pn[12] = {16, 16, 32, 32, 32, 32, 256, 256, 2048, 2048, 4096, 16384};
            const int pi[12] = {IN_AIB, IN_AFB, IN_DTB, IN_ALOG, IN_BD, IN_SINK, IN_QNW, IN_KNW, IN_ANW, IN_BNW, IN_CB, IN_CW};
#pragma unroll
            for (int a = 0; a < 12; ++a) { const float* src = args.in[pi[a]]; for (int i = tid; i < pn[a]; i += NT) P[po[a] + i] = src[i]; }
        } else {
            const int e = (task - T3) * 512 + tid;
            if (e < 8193 * 32) {
                const int pos = e >> 5, d = e & 31;
                const float inv = (float)exp2(-(double)d * (13.287712379549449 / 32.0));
                const float angf = (float)pos * inv;
                const double a = (double)angf;
                const double k = rint(a * 0.15915494309189535);
                const float rr = (float)(a - k * 6.283185307179586);
                XROPE[(size_t)e * 2] = cosf(rr); XROPE[(size_t)e * 2 + 1] = sinf(rr);
            }
        }
    }
}

__device__ __forceinline__ void conv8(const bf16_t* u, int seq0, int tt, int ch, const float* cw, const float* cb, float (&o)[8]) {
    float acc[8];
    { f32x4 b0 = *(const f32x4*)(cb + ch), b1 = *(const f32x4*)(cb + ch + 4);
#pragma unroll
      for (int j = 0; j < 4; ++j) { acc[j] = b0[j]; acc[4 + j] = b1[j]; } }
#pragma unroll
    for (int jj = 0; jj < 4; ++jj) {
        const int t2 = tt + jj - 3;
        if (t2 >= 0) {
            float x[8]; unpack8(*(const u32x4*)(u + (size_t)(seq0 + t2) * NIN + C_BX + ch), x);
            f32x4 w0 = *(const f32x4*)(cw + jj * 1024 + ch), w1 = *(const f32x4*)(cw + jj * 1024 + ch + 4);
#pragma unroll
            for (int j = 0; j < 4; ++j) { acc[j] += x[j] * w0[j]; acc[4 + j] += x[4 + j] * w1[j]; }
        }
    }
#pragma unroll
    for (int j = 0; j < 8; ++j) o[j] = siluf_(acc[j]);
}


__device__ __forceinline__ void conv8x8(const bf16_t* u, int seq0, int tt0, int ch, const float* cw, const float* cb, float (&o)[8][8]) {
    float w[4][8];
#pragma unroll
    for (int jj = 0; jj < 4; ++jj) { f32x4 w0 = *(const f32x4*)(cw + jj * 1024 + ch), w1 = *(const f32x4*)(cw + jj * 1024 + ch + 4);
#pragma unroll
        for (int j = 0; j < 4; ++j) { w[jj][j] = w0[j]; w[jj][4 + j] = w1[j]; } }
    { f32x4 b0 = *(const f32x4*)(cb + ch), b1 = *(const f32x4*)(cb + ch + 4);
#pragma unroll
      for (int t = 0; t < 8; ++t)
#pragma unroll
          for (int j = 0; j < 4; ++j) { o[t][j] = b0[j]; o[t][4 + j] = b1[j]; } }
    u32x4 raw[11];
#pragma unroll
    for (int r = 0; r < 11; ++r) {
        const int t2 = tt0 + r - 3;
        raw[r] = (u32x4){0u, 0u, 0u, 0u};
        if (t2 >= 0) raw[r] = *(const u32x4*)(u + (size_t)(seq0 + t2) * NIN + C_BX + ch);
    }
#pragma unroll
    for (int r = 0; r < 11; ++r) {
        float x[8]; unpack8(raw[r], x);
#pragma unroll
        for (int jj = 0; jj < 4; ++jj) {
            const int t = r - jj;
            if (t >= 0 && t < 8) {
#pragma unroll
                for (int j = 0; j < 8; ++j) o[t][j] += x[j] * w[jj][j];
            }
        }
    }
#pragma unroll
    for (int t = 0; t < 8; ++t)
#pragma unroll
        for (int j = 0; j < 8; ++j) o[t][j] = siluf_(o[t][j]);
}

__device__ __forceinline__ void mlstm_local(lptr lds, const Ctx& X, int l, int task, int tid) {
    const int h = task & 3, c = (task >> 2) & 127, n = task >> 9;
    const int lane = tid & 63, wave = tid >> 6, fr = lane & 15, fq = lane >> 4;
    const int row0 = n * SEQ + c * 64, nh = n * 4 + h;
    lptr VwT = lds;
    lptr KT = lds + 18432;
    LAS float* wv = (LAS float*)(lds + 27648);
    u32x4 vraw[2], kraw;
#pragma unroll
    for (int it = 0; it < 2; ++it) { const int p = tid + it * NT, tok = p >> 4, v8 = (p & 15) * 8; vraw[it] = *(const u32x4*)(XU + (size_t)(row0 + tok) * NIN + C_AV + h * 128 + v8); }
    { const int tok = tid >> 3, k8 = (tid & 7) * 8; kraw = *(const u32x4*)(XU + (size_t)(row0 + tok) * NIN + C_AK + h * 64 + k8); }
    if (wave == 0) {
        const bf16_t* ur = XU + (size_t)(row0 + lane) * NIN;
        const float fg = bf2f(ur[C_AF + h]) + XPAR(P_AFB)[l * 4 + h], ig = bf2f(ur[C_AI + h]) + XPAR(P_AIB)[l * 4 + h];
        const float b = wave_scan_sum(logsigf_(fg), lane);
        const float bl = __shfl(b, 63);
        const float g = bl - b + ig;
        const float ml = wave_max(g);
        wv[lane] = __expf(g - ml);
        if (lane == 0) { XML[nh * 128 + c] = ml; XBL[nh * 128 + c] = bl; }
    }
    __syncthreads();
#pragma unroll
    for (int it = 0; it < 2; ++it) {
        const int p = tid + it * NT, tok = p >> 4, v8 = (p & 15) * 8;
        float x[8]; unpack8(vraw[it], x);
        const float w = wv[tok];
#pragma unroll
        for (int j = 0; j < 8; ++j) *(LAS bf16_t*)(VwT + (((v8 + j) * 72 + tok) << 1)) = (bf16_t)f2bf(x[j] * w);
    }
    {
        const int tok = tid >> 3, k8 = (tid & 7) * 8;
        float x[8]; unpack8(kraw, x);
#pragma unroll
        for (int j = 0; j < 8; ++j) *(LAS bf16_t*)(KT + (((k8 + j) * 72 + tok) << 1)) = (bf16_t)f2bf(x[j] * 0.125f);
    }
    __syncthreads();
    {
        float* dst = XMC + ((size_t)nh * 128 + c) * 8192;
        bf16x8 b0 = lds_frag(VwT, 16 * wave + fr, fq * 8, 72), b1 = lds_frag(VwT, 16 * wave + fr, 32 + fq * 8, 72);
#pragma unroll
        for (int mt = 0; mt < 4; ++mt) {
            f32x4 acc = {0.f, 0.f, 0.f, 0.f};
            acc = mfma16(lds_frag(KT, 16 * mt + fr, fq * 8, 72), b0, acc);
            acc = mfma16(lds_frag(KT, 16 * mt + fr, 32 + fq * 8, 72), b1, acc);
            *(f32x4*)(dst + (16 * wave + fr) * 64 + 16 * mt + 4 * fq) = acc;
        }
    }
    if (tid < 64) {
        float s = 0.f;
#pragma unroll 8
        for (int t = 0; t < 64; ++t) s += bf2f(*(const LAS bf16_t*)(KT + ((tid * 72 + t) << 1))) * wv[t];
        XMN[((size_t)nh * 128 + c) * 64 + tid] = s;
    }
    __syncthreads();
}

__device__ __forceinline__ void ssd_local(lptr lds, const Ctx& X, int l, int task, int tid) {
    const int g = task & 1, c = (task >> 1) & 127, n = task >> 8;
    const int lane = tid & 63, wave = tid >> 6, fr = lane & 15, fq = lane >> 4;
    const int seq0 = n * SEQ, row0 = seq0 + c * 64;
    lptr XwT = lds;
    lptr BT = lds + 36864;
    LAS float* wl = (LAS float*)(lds + 55296);
    {
        const float* cw = XPAR(P_CW) + l * 4096; const float* cb = XPAR(P_CB) + l * 1024;
        const int cg = lane;
        float o[8][8];
        {
            const int cgc = cg < 48 ? cg : 47;
            const int ch = cgc < 32 ? g * 256 + cgc * 8 : 512 + g * 128 + (cgc - 32) * 8;
            conv8x8(XU, seq0, c * 64 + 8 * wave, ch, cw, cb, o);
        }
    if (wave < 4) {
        const int hh = 4 * g + wave;
        const float dt = softplusf_(bf2f(XU[(size_t)(row0 + lane) * NIN + C_BDT + hh]) + XPAR(P_DTB)[l * 8 + hh]);
        const float A = -__expf(XPAR(P_ALOG)[l * 8 + hh]);
        const float a = wave_scan_sum(dt * A, lane);
        const float aL = __shfl(a, 63);
        wl[wave * 64 + lane] = __expf(aL - a) * dt;
        if (lane == 0) XSA[(n * 8 + hh) * 128 + c] = aL;
    }
    __syncthreads();
        if (cg < 48) {
            if (cg < 32) {
                float wt[8];
#pragma unroll
                for (int t = 0; t < 8; ++t) wt[t] = wl[(cg >> 3) * 64 + 8 * wave + t];
#pragma unroll
                for (int jx = 0; jx < 8; ++jx) {
                    float v[8];
#pragma unroll
                    for (int t = 0; t < 8; ++t) v[t] = o[t][jx] * wt[t];
                    *(LAS u32x4*)(XwT + (((cg * 8 + jx) * 72 + 8 * wave) << 1)) = pack8(v);
                }
            } else {
#pragma unroll
                for (int jx = 0; jx < 8; ++jx) {
                    float v[8];
#pragma unroll
                    for (int t = 0; t < 8; ++t) v[t] = o[t][jx];
                    *(LAS u32x4*)(BT + ((((cg - 32) * 8 + jx) * 72 + 8 * wave) << 1)) = pack8(v);
                }
            }
        }
    }
    __syncthreads();
    {
        const int hl = wave >> 1, ph = wave & 1, hh = 4 * g + hl;
        float* dst = XSH + ((size_t)(n * 8 + hh) * 128 + c) * 8192;
        bf16x8 bx[2][2];
#pragma unroll
        for (int ntl = 0; ntl < 2; ++ntl)
#pragma unroll
            for (int kk = 0; kk < 2; ++kk) bx[ntl][kk] = lds_frag(XwT, hl * 64 + ph * 32 + ntl * 16 + fr, kk * 32 + fq * 8, 72);
#pragma unroll
        for (int mt = 0; mt < 8; ++mt) {
            bf16x8 a0 = lds_frag(BT, 16 * mt + fr, fq * 8, 72), a1 = lds_frag(BT, 16 * mt + fr, 32 + fq * 8, 72);
#pragma unroll
            for (int ntl = 0; ntl < 2; ++ntl) {
                f32x4 acc = {0.f, 0.f, 0.f, 0.f};
                acc = mfma16(a0, bx[ntl][0], acc); acc = mfma16(a1, bx[ntl][1], acc);
                *(f32x4*)(dst + (ph * 32 + ntl * 16 + fr) * 128 + 16 * mt + 4 * fq) = acc;
            }
        }
    }
    __syncthreads();
}

__device__ __forceinline__ void swa_prompt(lptr lds, const Ctx& X, int l, int task, int tid) {
    const int kvh = task & 1, qb = (task >> 1) & 63, n = task >> 7;
    const int lane = tid & 63, wave = tid >> 6, fr = lane & 15, fq = lane >> 4;
    const int seq0 = n * SEQ;
    lptr Kn = lds;
    lptr Vt = lds + 36864;
    lptr Pw = lds + 70656 + wave * 8448;
    const float* knw = XPAR(P_KNW) + l * 64; const float* qnw = XPAR(P_QNW) + l * 64;
#pragma unroll
    for (int it = 0; it < 2; ++it) {
        const int item = tid + it * NT, j = item >> 2, qd = item & 3, t = qb * 128 - 128 + j;
        float o1[8], o2[8];
        if (t >= 0) {
            const bf16_t* kr = XU + (size_t)(seq0 + t) * NIN + C_CK + kvh * 64;
            float x1[8], x2[8]; unpack8(*(const u32x4*)(kr + qd * 8), x1); unpack8(*(const u32x4*)(kr + 32 + qd * 8), x2);
            float ss = 0.f;
#pragma unroll
            for (int jj = 0; jj < 8; ++jj) ss += x1[jj] * x1[jj] + x2[jj] * x2[jj];
            ss += __shfl_xor(ss, 1); ss += __shfl_xor(ss, 2);
            const float rs = rsqrtf(ss * (1.f / 64.f) + EPS);
            const float* cs = XROPE + ((size_t)t * 32 + qd * 8) * 2;
#pragma unroll
            for (int jj = 0; jj < 8; ++jj) {
                const float a = x1[jj] * rs * knw[qd * 8 + jj], b = x2[jj] * rs * knw[32 + qd * 8 + jj], co = cs[2 * jj], si = cs[2 * jj + 1];
                o1[jj] = a * co - b * si; o2[jj] = b * co + a * si;
            }
        } else {
#pragma unroll
            for (int jj = 0; jj < 8; ++jj) { o1[jj] = 0.f; o2[jj] = 0.f; }
        }
        *(LAS u32x4*)(Kn + ((j * 72 + qd * 8) << 1)) = pack8(o1);
        *(LAS u32x4*)(Kn + ((j * 72 + 32 + qd * 8) << 1)) = pack8(o2);
        if (qb == 63 && j >= 128) {
            float* ko = X.out + O_PK + ((((size_t)l * 2 + n) * 128 + (j - 128)) * 2 + kvh) * 64;
            *(f32x4*)(ko + qd * 8) = (f32x4){o1[0], o1[1], o1[2], o1[3]}; *(f32x4*)(ko + qd * 8 + 4) = (f32x4){o1[4], o1[5], o1[6], o1[7]};
            *(f32x4*)(ko + 32 + qd * 8) = (f32x4){o2[0], o2[1], o2[2], o2[3]}; *(f32x4*)(ko + 32 + qd * 8 + 4) = (f32x4){o2[4], o2[5], o2[6], o2[7]};
        }
    }
#pragma unroll
    for (int it = 0; it < 4; ++it) {
        const int item = tid + it * NT, j = item >> 3, d8 = (item & 7) * 8, t = qb * 128 - 128 + j;
        u32x4 w = {0u, 0u, 0u, 0u};
        if (t >= 0) w = *(const u32x4*)(XU + (size_t)(seq0 + t) * NIN + C_CV + kvh * 64 + d8);
#pragma unroll
        for (int jj = 0; jj < 8; ++jj) *(LAS bf16_t*)(Vt + (((d8 + jj) * 264 + j) << 1)) = (bf16_t)((w[jj >> 1] >> ((jj & 1) * 16)) & 0xffffu);
        if (qb == 63 && j >= 128) {
            float x[8]; unpack8(w, x);
            float* vo = X.out + O_PV + ((((size_t)l * 2 + n) * 128 + (j - 128)) * 2 + kvh) * 64 + d8;
            *(f32x4*)(vo) = (f32x4){x[0], x[1], x[2], x[3]}; *(f32x4*)(vo + 4) = (f32x4){x[4], x[5], x[6], x[7]};
        }
    }
    __syncthreads();
    const int hq = kvh * 4 + (wave >> 1), i0 = (wave & 1) * 64;
    const float sink = XPAR(P_SINK)[l * 8 + hq];
    float qw1[8], qw2[8];
#pragma unroll
    for (int jj = 0; jj < 8; ++jj) { qw1[jj] = qnw[fq * 8 + jj]; qw2[jj] = qnw[32 + fq * 8 + jj]; }
    u32x4 qn0, qn1; f32x4 csn[4];
    {
        const int t = qb * 128 + i0 + fr;
        const bf16_t* qr = XU + (size_t)(seq0 + t) * NIN + C_CQ + hq * 64;
        qn0 = *(const u32x4*)(qr + fq * 8); qn1 = *(const u32x4*)(qr + 32 + fq * 8);
        const f32x4* cs = (const f32x4*)(XROPE + ((size_t)t * 32 + fq * 8) * 2);
#pragma unroll
        for (int q4 = 0; q4 < 4; ++q4) csn[q4] = cs[q4];
    }
#pragma unroll 1
    for (int mt = 0; mt < 4; ++mt) {
        const int q0 = i0 + mt * 16;
        const u32x4 q0r = qn0, q1r = qn1; f32x4 csc[4];
#pragma unroll
        for (int q4 = 0; q4 < 4; ++q4) csc[q4] = csn[q4];
        unsigned short czv[4][4];
#pragma unroll
        for (int ii = 0; ii < 4; ++ii)
#pragma unroll
            for (int ntl = 0; ntl < 4; ++ntl) czv[ntl][ii] = XU[((size_t)seq0 + qb * 128 + q0 + fq * 4 + ii) * NIN + C_CZ + hq * 64 + 16 * ntl + fr];
        {
            const int mn = mt < 3 ? mt + 1 : 3;
            const int t = qb * 128 + i0 + mn * 16 + fr;
            const bf16_t* qr = XU + (size_t)(seq0 + t) * NIN + C_CQ + hq * 64;
            qn0 = *(const u32x4*)(qr + fq * 8); qn1 = *(const u32x4*)(qr + 32 + fq * 8);
            const f32x4* cs = (const f32x4*)(XROPE + ((size_t)t * 32 + fq * 8) * 2);
#pragma unroll
            for (int q4 = 0; q4 < 4; ++q4) csn[q4] = cs[q4];
        }
        bf16x8 a0, a1;
        {
            float x1[8], x2[8]; unpack8(q0r, x1); unpack8(q1r, x2);
            float ss = 0.f;
#pragma unroll
            for (int jj = 0; jj < 8; ++jj) ss += x1[jj] * x1[jj] + x2[jj] * x2[jj];
            ss += __shfl_xor(ss, 16); ss += __shfl_xor(ss, 32);
            const float rs = rsqrtf(ss * (1.f / 64.f) + EPS) * 0.125f;
            float o1[8], o2[8];
#pragma unroll
            for (int jj = 0; jj < 8; ++jj) {
                const float a = x1[jj] * rs * qw1[jj], b = x2[jj] * rs * qw2[jj], co = csc[jj >> 1][(jj & 1) * 2], si = csc[jj >> 1][(jj & 1) * 2 + 1];
                o1[jj] = a * co - b * si; o2[jj] = b * co + a * si;
            }
            a0 = as_frag(pack8(o1)); a1 = as_frag(pack8(o2));
        }
        const int tlo = q0 >> 4;
        const int qi = q0 + fr;
        f32x4 s[16];
        float mx = -3.0e38f;
#pragma unroll
        for (int ntl = 0; ntl < 16; ++ntl) {
            if (ntl >= tlo && ntl <= tlo + 8) {
                f32x4 acc = {0.f, 0.f, 0.f, 0.f};
                acc = mfma16(lds_frag(Kn, 16 * ntl + fr, fq * 8, 72), a0, acc);
                acc = mfma16(lds_frag(Kn, 16 * ntl + fr, 32 + fq * 8, 72), a1, acc);
#pragma unroll
                for (int ii = 0; ii < 4; ++ii) {
                    const int jk = 16 * ntl + 4 * fq + ii;
                    const bool valid = (jk > qi) && (jk <= qi + 128) && (qb > 0 || jk >= 128);
                    acc[ii] = valid ? acc[ii] : -3.0e38f;
                    mx = fmaxf(mx, acc[ii]);
                }
                s[ntl] = acc;
            }
        }
        mx = fmaxf(mx, __shfl_xor(mx, 16)); mx = fmaxf(mx, __shfl_xor(mx, 32));
        mx = fmaxf(mx, sink);
        float sum = 0.f;
#pragma unroll
        for (int ntl = 0; ntl < 16; ++ntl) {
            if (ntl >= tlo && ntl <= tlo + 8) {
#pragma unroll
                for (int ii = 0; ii < 4; ++ii) { const float e = (s[ntl][ii] > -1.0e38f) ? __expf(s[ntl][ii] - mx) : 0.f; s[ntl][ii] = e; sum += e; }
            }
        }
        sum += __shfl_xor(sum, 16); sum += __shfl_xor(sum, 32);
        const float inv = 1.f / (sum + __expf(sink - mx));
        const int klo = q0 >> 5, khi = (q0 + 143) >> 5;
#pragma unroll
        for (int ntl = 0; ntl < 16; ++ntl) {
            if (ntl >= tlo && ntl <= tlo + 8) {
                u32x2 w; w[0] = pk2(s[ntl][0] * inv, s[ntl][1] * inv); w[1] = pk2(s[ntl][2] * inv, s[ntl][3] * inv);
                *(LAS u32x2*)(Pw + ((fr * 264 + 16 * ntl + 4 * fq) << 1)) = w;
            } else if ((ntl >> 1) >= klo && (ntl >> 1) <= khi) {
                u32x2 w = {0u, 0u};
                *(LAS u32x2*)(Pw + ((fr * 264 + 16 * ntl + 4 * fq) << 1)) = w;
            }
        }
        LDS_FENCE();
        f32x4 o[4];
#pragma unroll
        for (int ntl = 0; ntl < 4; ++ntl) o[ntl] = (f32x4){0.f, 0.f, 0.f, 0.f};
#pragma unroll
        for (int kk = 0; kk < 8; ++kk) {
            if (kk >= klo && kk <= khi) {
                const bf16x8 a = lds_frag(Pw, fr, kk * 32 + fq * 8, 264);
#pragma unroll
                for (int ntl = 0; ntl < 4; ++ntl) o[ntl] = mfma16(a, lds_frag(Vt, 16 * ntl + fr, kk * 32 + fq * 8, 264), o[ntl]);
            }
        }
        LDS_FENCE();
#pragma unroll
        for (int ii = 0; ii < 4; ++ii) {
            const size_t row = (size_t)seq0 + qb * 128 + q0 + fq * 4 + ii;
#pragma unroll
            for (int ntl = 0; ntl < 4; ++ntl) {
                const int d = 16 * ntl + fr;
                XMIX[row * DMIX + 1024 + hq * 64 + d] = (bf16_t)f2bf(o[ntl][ii] * siluf_(bf2f(czv[ntl][ii])));
            }
        }
    }
    __syncthreads();
}

__device__ __forceinline__ void sample_task(lptr lds, const Ctx& X, int l, int b, int part, int tid) {
    LAS float* uf = (LAS float*)lds;
    LAS float* xbc = (LAS float*)(lds + 19968);
    LAS float* numv = (LAS float*)(lds + 24064);
    LAS float* yv = (LAS float*)(lds + 26112);
    LAS float* red = (LAS float*)(lds + 28160);
    LAS float* qs = (LAS float*)(lds + 28416);
    LAS float* kn = (LAS float*)(lds + 30464);
    LAS float* sc = (LAS float*)(lds + 30976);
    const int lane = tid & 63, wave = tid >> 6;
    const size_t row = (size_t)TP + b;
    const bf16_t* ur = XU + row * NIN;
    const size_t lb = (size_t)l * 128 + b;
    {
        const int c_lo = part == 0 ? 0 : (part == 1 ? C_BZ : C_CQ), c_hi = part == 0 ? C_BZ : (part == 1 ? C_CQ : DIN);
#pragma unroll 2
        for (int i = c_lo + tid; i < c_hi; i += NT) uf[i] = bf2f(ur[i]);
    }
    __syncthreads();
    if (part == 0) {
#pragma unroll 2
    for (int h = 0; h < 4; ++h) {
        const float ig = uf[C_AI + h] + XPAR(P_AIB)[l * 4 + h], fg = uf[C_AF + h] + XPAR(P_AFB)[l * 4 + h];
        const float ls = logsigf_(fg), m0 = X.stM[lb * 4 + h];
        const float mn = fmaxf(ls + m0, ig), sp = __expf(ls + m0 - mn), sl = __expf(ig - mn);
        const float* C0 = X.stC + (lb * 4 + h) * 8192; float* C1 = X.out + O_SC + (lb * 4 + h) * 8192;
#pragma unroll
        for (int it = 0; it < 4; ++it) {
            const int e = (tid + it * NT) * 4, v = e >> 6, k = e & 63;
            const f32x4 c0 = *(const f32x4*)(C0 + e);
            const float vv = uf[C_AV + h * 128 + v] * sl;
            f32x4 c1; float part = 0.f;
#pragma unroll
            for (int j = 0; j < 4; ++j) { c1[j] = sp * c0[j] + vv * (uf[C_AK + h * 64 + k + j] * 0.125f); part += c1[j] * uf[C_AQ + h * 64 + k + j]; }
            *(f32x4*)(C1 + e) = c1;
            part = red16(part);
            if ((lane & 15) == 0) numv[h * 128 + v] = part;
        }
        if (wave == 0) {
            const float n1 = sp * X.stN[(lb * 4 + h) * 64 + lane] + sl * uf[C_AK + h * 64 + lane] * 0.125f;
            X.out[O_SN + (lb * 4 + h) * 64 + lane] = n1;
            const float dd = wave_sum(n1 * uf[C_AQ + h * 64 + lane]);
            if (lane == 0) { red[h] = dd; red[4 + h] = mn; X.out[O_SM + lb * 4 + h] = mn; }
        }
    }
    __syncthreads();
    float hv;
    { const int h = tid >> 7; hv = numv[tid] / fmaxf(fabsf(red[h]), __expf(-red[4 + h])); const float ss = wave_sum(hv * hv); if (lane == 0) red[8 + wave] = ss; }
    __syncthreads();
    { const int h = tid >> 7; const float rs = rsqrtf((red[8 + 2 * h] + red[9 + 2 * h]) * (1.f / 128.f) + EPS);
      XMIX[row * DMIX + tid] = (bf16_t)f2bf(hv * rs * XPAR(P_ANW)[l * 512 + tid] * sigmoidf_(uf[C_AO + tid]) * siluf_(uf[C_AZ + tid])); }
    }
    if (part == 1) {
    {
        const float* buf = X.conv + lb * 3 * 1024; float* oc = X.out + O_SCONV + lb * 3 * 1024;
        const float* cw = XPAR(P_CW) + l * 4096;
#pragma unroll
        for (int it = 0; it < 2; ++it) {
            const int ch = tid + it * NT;
            const float f0 = buf[ch], f1 = buf[1024 + ch], f2 = buf[2048 + ch], f3 = uf[C_BX + ch];
            const float acc = XPAR(P_CB)[l * 1024 + ch] + f0 * cw[ch] + f1 * cw[1024 + ch] + f2 * cw[2048 + ch] + f3 * cw[3072 + ch];
            xbc[ch] = siluf_(acc);
            oc[ch] = f1; oc[1024 + ch] = f2; oc[2048 + ch] = f3;
        }
    }
    __syncthreads();
#pragma unroll 2
    for (int hh = 0; hh < 8; ++hh) {
        const float dt = softplusf_(uf[C_BDT + hh] + XPAR(P_DTB)[l * 8 + hh]);
        const float dA = __expf(-dt * __expf(XPAR(P_ALOG)[l * 8 + hh]));
        const int g = hh >> 2;
        const float* h0p = X.ssm + (lb * 8 + hh) * 8192; float* h1p = X.out + O_SH + (lb * 8 + hh) * 8192;
#pragma unroll
        for (int it = 0; it < 4; ++it) {
            const int e = (tid + it * NT) * 4, p = e >> 7, s = e & 127;
            const f32x4 h0 = *(const f32x4*)(h0p + e);
            const float xv = xbc[hh * 64 + p] * dt;
            f32x4 h1; float part = 0.f;
#pragma unroll
            for (int j = 0; j < 4; ++j) { h1[j] = dA * h0[j] + xv * xbc[512 + g * 128 + s + j]; part += h1[j] * xbc[768 + g * 128 + s + j]; }
            *(f32x4*)(h1p + e) = h1;
            part = red16(part); part += __shfl_xor(part, 16);
            if ((lane & 31) == 0) yv[hh * 64 + p] = part;
        }
    }
    __syncthreads();
    float gb;
    { const int hh = tid >> 6; const float y = yv[tid] + XPAR(P_BD)[l * 8 + hh] * xbc[tid]; gb = y * siluf_(uf[C_BZ + tid]); const float ss = wave_sum(gb * gb); if (lane == 0) red[16 + wave] = ss; }
    __syncthreads();
    { const int g = tid >> 8; const float rs = rsqrtf((red[16 + 4 * g] + red[17 + 4 * g] + red[18 + 4 * g] + red[19 + 4 * g]) * (1.f / 256.f) + EPS);
      XMIX[row * DMIX + 512 + tid] = (bf16_t)f2bf(gb * rs * XPAR(P_BNW)[l * 512 + tid]); }
    }
    if (part == 2) {
    if (tid < 320) {
        const int vec = tid >> 5, d = tid & 31, base = vec < 8 ? C_CQ + vec * 64 : C_CK + (vec - 8) * 64;
        const float x1 = uf[base + d], x2 = uf[base + 32 + d];
        float ss = x1 * x1 + x2 * x2; ss = red16(ss); ss += __shfl_xor(ss, 16);
        const float rs = rsqrtf(ss * (1.f / 64.f) + EPS);
        const float* w = vec < 8 ? XPAR(P_QNW) + l * 64 : XPAR(P_KNW) + l * 64;
        const float a = x1 * rs * w[d], bb = x2 * rs * w[d + 32];
        const float co = XROPE[((size_t)8192 * 32 + d) * 2], si = XROPE[((size_t)8192 * 32 + d) * 2 + 1];
        const float o1 = a * co - bb * si, o2 = bb * co + a * si;
        if (vec < 8) { qs[vec * 64 + d] = o1 * 0.125f; qs[vec * 64 + 32 + d] = o2 * 0.125f; } else { kn[(vec - 8) * 64 + d] = o1; kn[(vec - 8) * 64 + 32 + d] = o2; }
    }
    __syncthreads();
    const float* kc = X.ck + lb * 16384; const float* vc = X.cv + lb * 16384;
    {
        float* ko = X.out + O_SK + lb * 16384; float* vo = X.out + O_SV + lb * 16384;
#pragma unroll 4
        for (int it = 0; it < 8; ++it) {
            const int e = (tid + it * NT) * 4, j = e >> 7, r = e & 127;
            f32x4 kv, vv;
            if (j < 127) { kv = *(const f32x4*)(kc + e + 128); vv = *(const f32x4*)(vc + e + 128); }
            else { kv = (f32x4){kn[r], kn[r + 1], kn[r + 2], kn[r + 3]}; vv = (f32x4){uf[C_CV + r], uf[C_CV + r + 1], uf[C_CV + r + 2], uf[C_CV + r + 3]}; }
            *(f32x4*)(ko + e) = kv; *(f32x4*)(vo + e) = vv;
        }
    }
    if (tid < 256) {
        const int kvh = tid >> 7, jj = tid & 127;
        float s0 = 0.f, s1 = 0.f, s2 = 0.f, s3 = 0.f;
#pragma unroll 4
        for (int d4 = 0; d4 < 16; ++d4) {
            f32x4 kv;
            if (jj < 127) kv = *(const f32x4*)(kc + (jj + 1) * 128 + kvh * 64 + d4 * 4);
            else kv = (f32x4){kn[kvh * 64 + d4 * 4], kn[kvh * 64 + d4 * 4 + 1], kn[kvh * 64 + d4 * 4 + 2], kn[kvh * 64 + d4 * 4 + 3]};
#pragma unroll
            for (int j = 0; j < 4; ++j) {
                s0 += kv[j] * qs[(kvh * 4 + 0) * 64 + d4 * 4 + j]; s1 += kv[j] * qs[(kvh * 4 + 1) * 64 + d4 * 4 + j];
                s2 += kv[j] * qs[(kvh * 4 + 2) * 64 + d4 * 4 + j]; s3 += kv[j] * qs[(kvh * 4 + 3) * 64 + d4 * 4 + j];
            }
        }
        sc[(kvh * 4 + 0) * 128 + jj] = s0; sc[(kvh * 4 + 1) * 128 + jj] = s1; sc[(kvh * 4 + 2) * 128 + jj] = s2; sc[(kvh * 4 + 3) * 128 + jj] = s3;
    }
    __syncthreads();
    {
        const int hq = wave; const float s0 = sc[hq * 128 + lane], s1 = sc[hq * 128 + 64 + lane], sink = XPAR(P_SINK)[l * 8 + hq];
        const float m = fmaxf(wave_max(fmaxf(s0, s1)), sink);
        const float e0 = __expf(s0 - m), e1 = __expf(s1 - m);
        const float inv = 1.f / (wave_sum(e0 + e1) + __expf(sink - m));
        sc[hq * 128 + lane] = e0 * inv; sc[hq * 128 + 64 + lane] = e1 * inv;
    }
    __syncthreads();
    {
        const int hq = tid >> 6, d = tid & 63, kvh = hq >> 2;
        float o = 0.f;
#pragma unroll 16
        for (int jj = 0; jj < 127; ++jj) o += sc[hq * 128 + jj] * vc[(jj + 1) * 128 + kvh * 64 + d];
        o += sc[hq * 128 + 127] * uf[C_CV + kvh * 64 + d];
        XMIX[row * DMIX + 1024 + tid] = (bf16_t)f2bf(o * siluf_(uf[C_CZ + tid]));
    }
    }
    __syncthreads();
}

__device__ __forceinline__ void scans(const Ctx& X, int l, int gt, int nthreads) {
    for (int item = gt; item < 98816; item += nthreads) {
        if (item < 32768) {
            const int nh = item >> 12, e = (item & 4095) * 2;
            float* base = XMC + (size_t)nh * 128 * 8192 + e;
            const float* ml = XML + nh * 128; const float* bl = XBL + nh * 128;
            float m = 0.f; f32x2 st = {0.f, 0.f};
            for (int c0 = 0; c0 < 128; c0 += 8) {
                f32x2 cl[8];
#pragma unroll
                for (int j = 0; j < 8; ++j) cl[j] = *(const f32x2*)(base + (size_t)(c0 + j) * 8192);
#pragma unroll
                for (int j = 0; j < 8; ++j) {
                    const float mlj = ml[c0 + j], blj = bl[c0 + j], mn = fmaxf(blj + m, mlj), sp = __expf(blj + m - mn), sl = __expf(mlj - mn);
                    *(unsigned*)(XCSB + ((size_t)nh * 128 + c0 + j) * 8192 + e) = pk2(st[0], st[1]);
                    if (e == 0) XMS[nh * 128 + c0 + j] = m;
                    st = st * sp + cl[j] * sl; m = mn;
                }
            }
            *(f32x2*)(X.out + O_PC + ((size_t)l * 8 + nh) * 8192 + e) = st;
            if (e == 0) X.out[O_PM + l * 8 + nh] = m;
        } else if (item < 98304) {
            const int i1 = item - 32768, nhh = i1 >> 12, e = (i1 & 4095) * 2;
            float* base = XSH + (size_t)nhh * 128 * 8192 + e;
            const float* al = XSA + nhh * 128;
            f32x2 st = {0.f, 0.f};
            for (int c0 = 0; c0 < 128; c0 += 8) {
                f32x2 cl[8];
#pragma unroll
                for (int j = 0; j < 8; ++j) cl[j] = *(const f32x2*)(base + (size_t)(c0 + j) * 8192);
#pragma unroll
                for (int j = 0; j < 8; ++j) {
                    const float dec = __expf(al[c0 + j]);
                    *(unsigned*)(XHSB + ((size_t)nhh * 128 + c0 + j) * 8192 + e) = pk2(st[0], st[1]);
                    st = st * dec + cl[j];
                }
            }
            *(f32x2*)(X.out + O_PH + ((size_t)l * 16 + nhh) * 8192 + e) = st;
        } else {
            const int i2 = item - 98304, nh = i2 >> 6, k = i2 & 63;
            float* base = XMN + (size_t)nh * 128 * 64 + k;
            const float* ml = XML + nh * 128; const float* bl = XBL + nh * 128;
            float m = 0.f, st = 0.f;
            for (int c = 0; c < 128; ++c) {
                const float mlj = ml[c], blj = bl[c], mn = fmaxf(blj + m, mlj), sp = __expf(blj + m - mn), sl = __expf(mlj - mn);
                const float cl = base[c * 64];
                base[c * 64] = st;
                st = st * sp + cl * sl; m = mn;
            }
            X.out[O_PN + ((size_t)l * 8 + nh) * 64 + k] = st;
        }
    }
}

__device__ __forceinline__ void mlstm_out(lptr lds, const Ctx& X, int l, int task, int tid) {
    const int h = task & 3, c = (task >> 2) & 127, n = task >> 9;
    const int lane = tid & 63, wave = tid >> 6, fr = lane & 15, fq = lane >> 4;
    const int row0 = n * SEQ + c * 64, nh = n * 4 + h;
    lptr Qs = lds;
    lptr Ks = lds + 9216;
    lptr Vt = lds + 18432;
    lptr Sb = lds + 36864 + wave * 2304;
    LAS float* bv = (LAS float*)(lds + 55296);
    LAS float* dv = bv + 64;
    LAS float* mtv = bv + 128;
    LAS float* siv = bv + 192;
    LAS float* qnv = bv + 256;
    LAS float* ssqp = bv + 384;
    LAS float* nsv = bv + 512;
    const int mti = wave >> 1, half = wave & 1;
    u32x4 csf[2][4];
    {
        const bf16_t* Cs = XCSB + ((size_t)nh * 128 + c) * 8192;
#pragma unroll
        for (int kk = 0; kk < 2; ++kk)
#pragma unroll
            for (int ntl = 0; ntl < 4; ++ntl) csf[kk][ntl] = *(const u32x4*)(Cs + (64 * half + 16 * ntl + fr) * 64 + kk * 32 + fq * 8);
    }
    unsigned short aov[4][4], azv[4][4]; float anw[4];
#pragma unroll
    for (int ntl = 0; ntl < 4; ++ntl) {
        const int v = h * 128 + 64 * half + 16 * ntl + fr;
        anw[ntl] = XPAR(P_ANW)[l * 512 + v];
#pragma unroll
        for (int ii = 0; ii < 4; ++ii) {
            const size_t row = (size_t)row0 + 16 * mti + fq * 4 + ii;
            aov[ntl][ii] = XU[row * NIN + C_AO + v]; azv[ntl][ii] = XU[row * NIN + C_AZ + v];
        }
    }
    u32x4 qraw, kraw, vraw[2];
    {
        const int tok = tid >> 3, k8 = (tid & 7) * 8;
        const bf16_t* ur = XU + (size_t)(row0 + tok) * NIN;
        qraw = *(const u32x4*)(ur + C_AQ + h * 64 + k8); kraw = *(const u32x4*)(ur + C_AK + h * 64 + k8);
#pragma unroll
        for (int it = 0; it < 2; ++it) { const int p = tid + it * NT, tk = p >> 4, v8 = (p & 15) * 8; vraw[it] = *(const u32x4*)(XU + (size_t)(row0 + tk) * NIN + C_AV + h * 128 + v8); }
    }
    if (wave == 0) {
        const bf16_t* ur = XU + (size_t)(row0 + lane) * NIN;
        const float fg = bf2f(ur[C_AF + h]) + XPAR(P_AFB)[l * 4 + h], ig = bf2f(ur[C_AI + h]) + XPAR(P_AIB)[l * 4 + h];
        const float b = wave_scan_sum(logsigf_(fg), lane);
        const float dd = ig - b;
        const float cm = wave_scan_max(dd, lane);
        const float ms = XMS[nh * 128 + c];
        const float mt = b + fmaxf(ms, cm);
        bv[lane] = b; dv[lane] = dd; mtv[lane] = mt; siv[lane] = __expf(b + ms - mt);
        nsv[lane] = XMN[((size_t)nh * 128 + c) * 64 + lane];
    }
    {
        const int tok = tid >> 3, k8 = (tid & 7) * 8;
        *(LAS u32x4*)(Qs + ((tok * 72 + k8) << 1)) = qraw;
        float x[8]; unpack8(kraw, x);
#pragma unroll
        for (int j = 0; j < 8; ++j) x[j] *= 0.125f;
        *(LAS u32x4*)(Ks + ((tok * 72 + k8) << 1)) = pack8(x);
    }
#pragma unroll
    for (int it = 0; it < 2; ++it) {
        const int p = tid + it * NT, tok = p >> 4, v8 = (p & 15) * 8;
        const u32x4 w = vraw[it];
#pragma unroll
        for (int j = 0; j < 8; ++j) *(LAS bf16_t*)(Vt + (((v8 + j) * 72 + tok) << 1)) = (bf16_t)((w[j >> 1] >> ((j & 1) * 16)) & 0xffffu);
    }
    __syncthreads();
    bf16x8 qa[2];
    qa[0] = lds_frag(Qs, 16 * mti + fr, fq * 8, 72); qa[1] = lds_frag(Qs, 16 * mti + fr, 32 + fq * 8, 72);
    {
        float x0[8], x1[8]; unpack8(__builtin_bit_cast(u32x4, qa[0]), x0); unpack8(__builtin_bit_cast(u32x4, qa[1]), x1);
        float d = 0.f;
#pragma unroll
        for (int j = 0; j < 8; ++j) d += x0[j] * nsv[fq * 8 + j] + x1[j] * nsv[32 + fq * 8 + j];
        d += __shfl_xor(d, 16); d += __shfl_xor(d, 32);
        if (fq == 0) qnv[wave * 16 + fr] = d;
    }
    float rsum[4] = {0.f, 0.f, 0.f, 0.f};
#pragma unroll
    for (int ntl = 0; ntl < 4; ++ntl) {
        f32x4 s = {0.f, 0.f, 0.f, 0.f};
        s = mfma16(qa[0], lds_frag(Ks, 16 * ntl + fr, fq * 8, 72), s);
        s = mfma16(qa[1], lds_frag(Ks, 16 * ntl + fr, 32 + fq * 8, 72), s);
#pragma unroll
        for (int ii = 0; ii < 4; ++ii) {
            const int t = 16 * mti + fq * 4 + ii, sidx = 16 * ntl + fr;
            const float wgt = (sidx <= t) ? __expf(bv[t] + dv[sidx] - mtv[t]) : 0.f;
            const float sv = wgt * s[ii];
            rsum[ii] += sv;
            *(LAS bf16_t*)(Sb + (((fq * 4 + ii) * 72 + sidx) << 1)) = (bf16_t)f2bf(sv);
        }
    }
    LDS_FENCE();
    f32x4 acc[4];
#pragma unroll
    for (int ntl = 0; ntl < 4; ++ntl) acc[ntl] = (f32x4){0.f, 0.f, 0.f, 0.f};
#pragma unroll
    for (int kk = 0; kk < 2; ++kk) {
        const bf16x8 a = lds_frag(Sb, fr, kk * 32 + fq * 8, 72);
#pragma unroll
        for (int ntl = 0; ntl < 4; ++ntl) acc[ntl] = mfma16(a, lds_frag(Vt, 64 * half + 16 * ntl + fr, kk * 32 + fq * 8, 72), acc[ntl]);
    }
    {
        const float sia = siv[16 * mti + fr];
#pragma unroll
        for (int kk = 0; kk < 2; ++kk) {
            float x[8]; unpack8(__builtin_bit_cast(u32x4, qa[kk]), x);
#pragma unroll
            for (int j = 0; j < 8; ++j) x[j] *= sia;
            const bf16x8 a = as_frag(pack8(x));
#pragma unroll
            for (int ntl = 0; ntl < 4; ++ntl) acc[ntl] = mfma16(a, as_frag(csf[kk][ntl]), acc[ntl]);
        }
    }
    float hv[4][4], ssl[4];
#pragma unroll
    for (int ii = 0; ii < 4; ++ii) {
        const int t = 16 * mti + fq * 4 + ii;
        const float den = red16(rsum[ii]) + siv[t] * qnv[wave * 16 + fq * 4 + ii];
        const float inv = 1.f / fmaxf(fabsf(den), __expf(-mtv[t]));
        float ss = 0.f;
#pragma unroll
        for (int ntl = 0; ntl < 4; ++ntl) { hv[ntl][ii] = acc[ntl][ii] * inv; ss += hv[ntl][ii] * hv[ntl][ii]; }
        ssl[ii] = red16(ss);
        if (fr == 0) ssqp[t * 2 + half] = ssl[ii];
    }
    __syncthreads();
#pragma unroll
    for (int ii = 0; ii < 4; ++ii) {
        const int t = 16 * mti + fq * 4 + ii;
        const float rs = rsqrtf((ssqp[t * 2] + ssqp[t * 2 + 1]) * (1.f / 128.f) + EPS);
        const size_t row = (size_t)row0 + t;
#pragma unroll
        for (int ntl = 0; ntl < 4; ++ntl) {
            const int v = h * 128 + 64 * half + 16 * ntl + fr;
            const float ao = bf2f(aov[ntl][ii]), az = bf2f(azv[ntl][ii]);
            XMIX[row * DMIX + v] = (bf16_t)f2bf(hv[ntl][ii] * rs * anw[ntl] * sigmoidf_(ao) * siluf_(az));
        }
    }
    __syncthreads();
}

__device__ __forceinline__ void ssd_out(lptr lds, const Ctx& X, int l, int task, int tid) {
    const int g = task & 1, c = (task >> 1) & 127, n = task >> 8;
    const int lane = tid & 63, wave = tid >> 6, fr = lane & 15, fq = lane >> 4;
    const int seq0 = n * SEQ, row0 = seq0 + c * 64;
    lptr Cm = lds;
    lptr Bm = lds + 17408;
    lptr Xt = lds + 34816;
    LAS float* CBf = (LAS float*)(lds + 71680);
    LAS float* av = (LAS float*)(lds + 89088);
    LAS float* dtv = (LAS float*)(lds + 90112);
    LAS float* ssq = (LAS float*)(lds + 91136);
    const int hl = wave >> 1, th = wave & 1, hh = 4 * g + hl;
    u32x4 hsf[4][4];
    {
        const bf16_t* hs = XHSB + ((size_t)(n * 8 + hh) * 128 + c) * 8192;
#pragma unroll
        for (int kk = 0; kk < 4; ++kk)
#pragma unroll
            for (int ntl = 0; ntl < 4; ++ntl) hsf[kk][ntl] = *(const u32x4*)(hs + (16 * ntl + fr) * 128 + kk * 32 + fq * 8);
    }
    if (wave < 4) {
        const int hh = 4 * g + wave;
        const float dt = softplusf_(bf2f(XU[(size_t)(row0 + lane) * NIN + C_BDT + hh]) + XPAR(P_DTB)[l * 8 + hh]);
        const float A = -__expf(XPAR(P_ALOG)[l * 8 + hh]);
        av[wave * 64 + lane] = wave_scan_sum(dt * A, lane);
        dtv[wave * 64 + lane] = dt;
    }
    {
        const float* cw = XPAR(P_CW) + l * 4096; const float* cb = XPAR(P_CB) + l * 1024;
        const int cg = lane;
        const int ch = cg < 32 ? g * 256 + cg * 8 : (cg < 48 ? 512 + g * 128 + (cg - 32) * 8 : 768 + g * 128 + (cg - 48) * 8);
        float o[8][8];
        conv8x8(XU, seq0, c * 64 + 8 * wave, ch, cw, cb, o);
        if (cg < 32) {
#pragma unroll
            for (int jx = 0; jx < 8; ++jx) {
                float v[8];
#pragma unroll
                for (int t = 0; t < 8; ++t) v[t] = o[t][jx];
                *(LAS u32x4*)(Xt + (((cg * 8 + jx) * 72 + 8 * wave) << 1)) = pack8(v);
            }
        } else {
            lptr dstm = cg < 48 ? Bm : Cm; const int s8 = (cg < 48 ? cg - 32 : cg - 48) * 8;
#pragma unroll
            for (int t = 0; t < 8; ++t) *(LAS u32x4*)(dstm + (((8 * wave + t) * 136 + s8) << 1)) = pack8(o[t]);
        }
    }
    __syncthreads();
    unsigned short bzv[2][4][4]; float bnw[4];
#pragma unroll
    for (int ntl = 0; ntl < 4; ++ntl) {
        bnw[ntl] = XPAR(P_BNW)[l * 512 + hh * 64 + 16 * ntl + fr];
#pragma unroll
        for (int mi = 0; mi < 2; ++mi)
#pragma unroll
            for (int ii = 0; ii < 4; ++ii) bzv[mi][ntl][ii] = XU[((size_t)row0 + 16 * (2 * th + mi) + fq * 4 + ii) * NIN + C_BZ + hh * 64 + 16 * ntl + fr];
    }
    {
        const int mt = wave >> 1;
#pragma unroll
        for (int q = 0; q < 2; ++q) {
            const int ntl = 2 * (wave & 1) + q;
            f32x4 acc = {0.f, 0.f, 0.f, 0.f};
#pragma unroll
            for (int kk = 0; kk < 4; ++kk) acc = mfma16(lds_frag(Cm, 16 * mt + fr, kk * 32 + fq * 8, 136), lds_frag(Bm, 16 * ntl + fr, kk * 32 + fq * 8, 136), acc);
#pragma unroll
            for (int ii = 0; ii < 4; ++ii) CBf[(16 * mt + fq * 4 + ii) * 68 + 16 * ntl + fr] = acc[ii];
        }
    }
    __syncthreads();
    f32x4 y1[2][4], y2[2][4];
#pragma unroll
    for (int mi = 0; mi < 2; ++mi)
#pragma unroll
        for (int ntl = 0; ntl < 4; ++ntl) { y1[mi][ntl] = (f32x4){0.f, 0.f, 0.f, 0.f}; y2[mi][ntl] = (f32x4){0.f, 0.f, 0.f, 0.f}; }
#pragma unroll
    for (int kk = 0; kk < 2; ++kk) {
        bf16x8 bx[4];
#pragma unroll
        for (int ntl = 0; ntl < 4; ++ntl) bx[ntl] = lds_frag(Xt, hl * 64 + 16 * ntl + fr, kk * 32 + fq * 8, 72);
#pragma unroll
        for (int mi = 0; mi < 2; ++mi) {
            const int t = 16 * (2 * th + mi) + fr, u0 = kk * 32 + fq * 8;
            const float at = av[hl * 64 + t];
            float w[8];
#pragma unroll
            for (int j = 0; j < 8; ++j) {
                const int uu = u0 + j;
                w[j] = (uu <= t) ? CBf[t * 68 + uu] * __expf(at - av[hl * 64 + uu]) * dtv[hl * 64 + uu] : 0.f;
            }
            const bf16x8 a = as_frag(pack8(w));
#pragma unroll
            for (int ntl = 0; ntl < 4; ++ntl) y1[mi][ntl] = mfma16(a, bx[ntl], y1[mi][ntl]);
        }
    }
    {
#pragma unroll
        for (int kk = 0; kk < 4; ++kk) {
            bf16x8 bh[4];
#pragma unroll
            for (int ntl = 0; ntl < 4; ++ntl) bh[ntl] = as_frag(hsf[kk][ntl]);
#pragma unroll
            for (int mi = 0; mi < 2; ++mi) {
                const bf16x8 a = lds_frag(Cm, 16 * (2 * th + mi) + fr, kk * 32 + fq * 8, 136);
#pragma unroll
                for (int ntl = 0; ntl < 4; ++ntl) y2[mi][ntl] = mfma16(a, bh[ntl], y2[mi][ntl]);
            }
        }
    }
    const float Dh = XPAR(P_BD)[l * 8 + hh];
#pragma unroll
    for (int mi = 0; mi < 2; ++mi)
#pragma unroll
        for (int ii = 0; ii < 4; ++ii) {
            const int t = 16 * (2 * th + mi) + fq * 4 + ii;
            const float ea = __expf(av[hl * 64 + t]);
            const size_t row = (size_t)row0 + t;
            float ss = 0.f;
#pragma unroll
            for (int ntl = 0; ntl < 4; ++ntl) {
                const int p = 16 * ntl + fr;
                const float xv = bf2f(*(const LAS bf16_t*)(Xt + (((hl * 64 + p) * 72 + t) << 1)));
                const float y = y1[mi][ntl][ii] + ea * y2[mi][ntl][ii] + Dh * xv;
                const float gbv = y * siluf_(bf2f(bzv[mi][ntl][ii]));
                y1[mi][ntl][ii] = gbv; ss += gbv * gbv;
            }
            ss = red16(ss);
            if (fr == 0) ssq[t * 4 + hl] = ss;
        }
    __syncthreads();
#pragma unroll
    for (int mi = 0; mi < 2; ++mi)
#pragma unroll
        for (int ii = 0; ii < 4; ++ii) {
            const int t = 16 * (2 * th + mi) + fq * 4 + ii;
            const float rs = rsqrtf((ssq[t * 4] + ssq[t * 4 + 1] + ssq[t * 4 + 2] + ssq[t * 4 + 3]) * (1.f / 256.f) + EPS);
            const size_t row = (size_t)row0 + t;
#pragma unroll
            for (int ntl = 0; ntl < 4; ++ntl) {
                const int p = hh * 64 + 16 * ntl + fr;
                XMIX[row * DMIX + 512 + p] = (bf16_t)f2bf(y1[mi][ntl][ii] * rs * bnw[ntl]);
            }
        }
    __syncthreads();
}


#define XB_TMO      128
#define XB_XCNT(j)  (256  + 64 * (j))
#define XB_XSUB(j)  (1280 + 64 * (j))
#define XB_XGEN(j)  (2304 + 64 * (j))
#define XB_TOP      3328
#define XB_TOPGEN   3392
#define XCD_BAR_WORDS 3456
#define XB_SPIN_CAP (1u << 18)
__device__ __forceinline__ unsigned xb_ld(unsigned* p)              { return __hip_atomic_load(p, __ATOMIC_RELAXED, __HIP_MEMORY_SCOPE_AGENT); }
__device__ __forceinline__ unsigned xb_add(unsigned* p, unsigned v) { return __hip_atomic_fetch_add(p, v, __ATOMIC_RELAXED, __HIP_MEMORY_SCOPE_AGENT); }
__device__ __forceinline__ unsigned xb_xcc_id() { return (unsigned)__builtin_amdgcn_s_getreg((3 << 11) | 20) & 0xFu; }
#define XB_SPIN(cond, bar) do { unsigned _sp = 0; while (cond) { __builtin_amdgcn_s_sleep(1); \
    if ((++_sp & 255u) == 0u) { if (xb_ld(&(bar)[XB_TMO])) break; if (_sp > XB_SPIN_CAP) { atomicAdd(&(bar)[XB_TMO], 1u); break; } } } } while (0)
struct XcdBarrier { unsigned* bar; unsigned x; volatile LAS unsigned* st; };
__device__ __forceinline__ XcdBarrier xcd_barrier_post(unsigned* bar, volatile LAS unsigned* st) {
    XcdBarrier b; b.bar = bar; b.x = xb_xcc_id(); b.st = st;
    if (threadIdx.x == 0) (void)xb_add(&bar[XB_XCNT(b.x)], 1u);
    return b;
}
__device__ __forceinline__ void xcd_barrier_complete(unsigned* bar, unsigned x, unsigned& nloc, unsigned& nx) {
    const unsigned G = gridDim.x * gridDim.y * gridDim.z;
    unsigned sum, cnt, mine, sp = 0u;
    for (;;) {
        sum = 0u; cnt = 0u; mine = 0u;
#pragma unroll
        for (unsigned j = 0; j < 16; ++j) { const unsigned c = xb_ld(&bar[XB_XCNT(j)]); sum += c; cnt += (c > 0u) ? 1u : 0u; mine = (j == x) ? c : mine; }
        if (sum == G) break;
        __builtin_amdgcn_s_sleep(1);
        if ((++sp & 255u) == 0u) { if (xb_ld(&bar[XB_TMO])) break; if (sp > XB_SPIN_CAP) { atomicAdd(&bar[XB_TMO], 1u); break; } }
    }
    nloc = mine > 0u ? mine : 1u; nx = cnt > 0u ? cnt : 1u;
}
__device__ __forceinline__ void xcd_barrier(const XcdBarrier& b) {
    asm volatile("s_waitcnt vmcnt(0)" ::: "memory");
    __syncthreads();
    if (threadIdx.x == 0) {
        unsigned* bar = b.bar;
        __builtin_amdgcn_s_waitcnt(0);
        unsigned nloc = b.st[0], nx = b.st[1];
        if (nloc == 0u) { xcd_barrier_complete(bar, b.x, nloc, nx); b.st[0] = nloc; b.st[1] = nx; }
        const unsigned old = xb_add(&bar[XB_XSUB(b.x)], 1u);
        const unsigned gen = old / nloc;
        if (old + 1u == (gen + 1u) * nloc) {
            __builtin_amdgcn_fence(__ATOMIC_RELEASE, "agent");
            asm volatile("s_waitcnt vmcnt(0)" ::: "memory");
            const unsigned og = xb_add(&bar[XB_TOP], 1u);
            const unsigned tg = og / nx;
            if (og + 1u == (tg + 1u) * nx) xb_add(&bar[XB_TOPGEN], 1u);
            else XB_SPIN(xb_ld(&bar[XB_TOPGEN]) == tg, bar);
            __builtin_amdgcn_fence(__ATOMIC_ACQUIRE, "agent");
            xb_add(&bar[XB_XGEN(b.x)], 1u);
            asm volatile("s_waitcnt vmcnt(0)" ::: "memory");
        } else {
            XB_SPIN(xb_ld(&bar[XB_XGEN(b.x)]) == gen, bar);
            __builtin_amdgcn_fence(__ATOMIC_ACQUIRE, "agent");
            asm volatile("s_waitcnt vmcnt(0)" ::: "memory");
        }
    }
    __syncthreads();
}

__global__ void __launch_bounds__(NT, 2) mega(Args args) {
    __shared__ __attribute__((aligned(16))) unsigned char lds_raw[LDS_BYTES];
    lptr lds = (lptr)lds_raw;
    cg::grid_group grid = cg::this_grid();
    const int tid = threadIdx.x, bid = blockIdx.x, G = gridDim.x;
    Ctx X;
    X.xp = args.in[IN_XP]; X.xs = args.in[IN_XS]; X.stC = args.in[IN_STC]; X.stN = args.in[IN_STN]; X.stM = args.in[IN_STM]; X.ssm = args.in[IN_SSM];
    X.conv = args.in[IN_CONV]; X.ck = args.in[IN_CK]; X.cv = args.in[IN_CV]; X.out = args.out; X.ws = args.ws;
    const int lo = args.ph_lo, hi = args.ph_hi;
    volatile LAS unsigned* xst = (volatile LAS unsigned*)(lds + LDS_BYTES - 16);
    if (tid == 0) { xst[0] = 0u; xst[1] = 0u; }
    __syncthreads();
    XcdBarrier xbar = xcd_barrier_post((unsigned*)(args.ws + WS_BAR), xst);
#define IN(k) (lo <= (k) && (k) < hi)
#define SEAM(k) do { if (IN(k) && IN((k) + 1)) { for (int _r = 0; _r < REP_SYNC; ++_r) { if ((k) == 0) grid.sync(); else xcd_barrier(xbar); } } } while (0)
    if (IN(0)) { prologue(lds, X, args, G, bid, tid); }
    SEAM(0);
    for (int l = 0; l < 4; ++l) {
        const int pb = 1 + l * 5;
        if (IN(pb)) for (int _r = 0; _r < REP_P1; ++_r) {
            pg8::Gemm g{XXB, XWIN + (size_t)l * NIN * D, MPAD, NIN, D}; pg8::StaticOrder S; S.init(l == 0 ? MPAD : TP, NIN, G, bid);
            pg8::EpiU E{XU, XSSQ};
            pg8::gemm_phase<pg8::EpiU, pg8::StaticOrder>(lds, g, S, E, OPQ(tid));
        }
        SEAM(pb);
        if (IN(pb + 1)) for (int _r = 0; _r < REP_P2; ++_r) {
            for (int t = bid; t < 256; t += G) for (int _q = 0; _q < RT_SWA; ++_q) swa_prompt(lds, X, l, t, OPQ(tid));
            for (int t = bid; t < 256; t += G) for (int _q = 0; _q < RT_SAMPLE; ++_q) {
                if (t < 128) sample_task(lds, X, l, t, 1, OPQ(tid));
                else { sample_task(lds, X, l, t - 128, 0, OPQ(tid)); sample_task(lds, X, l, t - 128, 2, OPQ(tid)); }
            }
            for (int t = bid; t < 512; t += G) for (int _q = 0; _q < RT_SLOC; ++_q) ssd_local(lds, X, l, t, OPQ(tid));
            for (int t = bid; t < 1024; t += G) for (int _q = 0; _q < RT_MLOC; ++_q) mlstm_local(lds, X, l, t, OPQ(tid));
            if (bid == G - 1) {
                for (int i = tid; i < 2 * 3 * 1024; i += NT) {
                    const int ch = i & 1023, j = (i >> 10) % 3, n = i / 3072;
                    X.out[O_PCONV + (((size_t)l * 2 + n) * 3 + j) * 1024 + ch] = bf2f(XU[(size_t)(n * SEQ + SEQ - 3 + j) * NIN + C_BX + ch]);
                }
            }
        }
        SEAM(pb + 1);
        if (IN(pb + 2)) {
            if (bid >= G - 4) {
                pg8::Gemm g{XMIX, XWOUT + (size_t)l * D * DMIX, MPAD, D, DMIX}; pg8::SampleOrder S{G - 4, 4, bid};
                pg8::EpiRes E{l == 0 ? X.xp : nullptr, X.xs, X.out, XXB, XSSQ};
                pg8::gemm_phase<pg8::EpiRes, pg8::SampleOrder>(lds, g, S, E, OPQ(tid));
            }
            scans(X, l, bid * NT + OPQ(tid), G * NT);
        }
        SEAM(pb + 2);
        if (IN(pb + 3)) for (int _r = 0; _r < REP_P4; ++_r) {
            for (int task = bid; task < 1536; task += G) {
                if (task < 512) for (int _q = 0; _q < RT_SOUT; ++_q) ssd_out(lds, X, l, task, OPQ(tid));
                else mlstm_out(lds, X, l, task - 512, OPQ(tid));
            }
        }
        SEAM(pb + 3);
        if (IN(pb + 4)) {
            {
                pg8::Gemm g{XMIX, XWOUT + (size_t)l * D * DMIX, MPAD, D, DMIX}; pg8::StaticOrder S; S.init(TP, D, G, bid);
                pg8::EpiRes E{l == 0 ? X.xp : nullptr, X.xs, X.out, XXB, XSSQ};
                pg8::gemm_phase<pg8::EpiRes, pg8::StaticOrder>(lds, g, S, E, OPQ(tid));
            }
            if (l < 3 && bid < 20) {
                pg8::Gemm g{XXB, XWIN + (size_t)(l + 1) * NIN * D, MPAD, NIN, D}; pg8::SampleOrder S{0, 20, bid};
                pg8::EpiU E{XU, XSSQ};
                pg8::gemm_phase<pg8::EpiU, pg8::SampleOrder>(lds, g, S, E, OPQ(tid));
            }
        }
        SEAM(pb + 4);
    }
#undef IN
#undef SEAM
}

extern "C" void kernel_launch(void* const* d_in, const int* in_sizes, int n_in, void* d_out, int out_size, void* d_ws, size_t ws_size, hipStream_t stream) {
    static int grid_blocks = 0;
    if (!grid_blocks) {
        int dev = 0, cus = 0, per_cu = 0;
        hipGetDevice(&dev);
        hipDeviceGetAttribute(&cus, hipDeviceAttributeMultiprocessorCount, dev);
        hipOccupancyMaxActiveBlocksPerMultiprocessor(&per_cu, mega, NT, 0);
        if (per_cu < 1) { fprintf(stderr, "occupancy query returned %d\n", per_cu); per_cu = 1; }
        grid_blocks = cus * 1;
        if (ws_size < WS_END) fprintf(stderr, "workspace too small: %zu < %zu\n", ws_size, (size_t)WS_END);
    }
    (void)hipMemsetAsync(d_ws, 0, 16384, stream);
    Args a{};
    for (int i = 0; i < 24; ++i) a.in[i] = (const float*)d_in[i];
    a.out = (float*)d_out; a.ws = (unsigned char*)d_ws;
    const int NPH = 21;
#if MULTI_LAUNCH
    for (int p = 0; p < NPH; ++p) {
        a.ph_lo = p; a.ph_hi = p + 1;
        void* kargs[] = {&a};
        hipError_t e = hipLaunchCooperativeKernel((void*)mega, dim3(grid_blocks), dim3(NT), kargs, 0, stream);
        if (e != hipSuccess) fprintf(stderr, "cooperative launch failed: %s (grid %d)\n", hipGetErrorString(e), grid_blocks);
    }
#else
    a.ph_lo = 0; a.ph_hi = NPH;
    void* kargs[] = {&a};
    hipError_t e = hipLaunchCooperativeKernel((void*)mega, dim3(grid_blocks), dim3(NT), kargs, 0, stream);
    if (e != hipSuccess) fprintf(stderr, "cooperative launch failed: %s (grid %d)\n", hipGetErrorString(e), grid_blocks);
#endif
}
```

```cpp
#include <hip/hip_runtime.h>
#include <hip/hip_cooperative_groups.h>
#include <cstdio>
#include <cstdint>
namespace cg = cooperative_groups;

#ifndef REP_SYNC
#define REP_SYNC 1
#endif
#ifndef REP_P1
#define REP_P1 1
#endif
#ifndef REP_P2
#define REP_P2 1
#endif
#ifndef REP_P3
#define REP_P3 1
#endif
#ifndef REP_P0
#define REP_P0 1
#endif
#ifndef REP_P4
#define REP_P4 1
#endif
#ifndef RT_SAMPLE
#define RT_SAMPLE 1
#endif
#ifndef RT_SWA
#define RT_SWA 1
#endif
#ifndef RT_SLOC
#define RT_SLOC 1
#endif
#ifndef RT_MLOC
#define RT_MLOC 1
#endif
#ifndef RT_SOUT
#define RT_SOUT 1
#endif
#ifndef MULTI_LAUNCH
#define MULTI_LAUNCH 0
#endif

#define LAS __attribute__((address_space(3)))
typedef unsigned short bf16_t;
typedef short bf16x8 __attribute__((ext_vector_type(8)));
typedef float f32x4 __attribute__((ext_vector_type(4)));
typedef float f32x2 __attribute__((ext_vector_type(2)));
typedef unsigned u32x4 __attribute__((ext_vector_type(4)));
typedef unsigned u32x2 __attribute__((ext_vector_type(2)));
typedef __bf16 bf16x2_t __attribute__((ext_vector_type(2)));
typedef LAS unsigned char* lptr;

constexpr int D = 1024, DIN = 4880, NIN = 5120, DMIX = 1536, TP = 16384, MTOK = 16512, MPAD = 16640, SEQ = 8192;
constexpr int C_AQ = 0, C_AK = 256, C_AV = 512, C_AO = 1024, C_AZ = 1536, C_AI = 2048, C_AF = 2052, C_BZ = 2056, C_BX = 2568, C_BB = 3080, C_BC = 3336,
              C_BDT = 3592, C_CQ = 3600, C_CK = 4112, C_CV = 4240, C_CZ = 4368;
constexpr float EPS = 1e-6f;
constexpr size_t O_YP = 0, O_YS = 16777216, O_PC = 16908288, O_PN = 17170432, O_PM = 17172480, O_PH = 17172512, O_PCONV = 17696800, O_PK = 17721376,
                 O_PV = 17852448, O_SC = 17983520, O_SN = 34760736, O_SM = 34891808, O_SH = 34893856, O_SCONV = 68448288, O_SK = 70021152, O_SV = 78409760;
constexpr size_t WS_BAR = 0;
constexpr size_t WS_PAR = 16384;
constexpr size_t WS_WIN = WS_PAR + 102400;
constexpr size_t WS_WOUT = WS_WIN + (size_t)4 * NIN * D * 2;
constexpr size_t WS_XB = WS_WOUT + (size_t)4 * D * DMIX * 2;
constexpr size_t WS_U = WS_XB + (size_t)MPAD * D * 2;
constexpr size_t WS_MIX = WS_U + (size_t)MPAD * NIN * 2;
constexpr size_t WS_SSQ = WS_MIX + (size_t)MPAD * DMIX * 2;
constexpr size_t WS_ROPE = WS_SSQ + (size_t)MPAD * 16 * 4;
constexpr size_t WS_MC = WS_ROPE + (size_t)8200 * 64 * 4;
constexpr size_t WS_MN = WS_MC + (size_t)8 * 128 * 8192 * 4;
constexpr size_t WS_ML = WS_MN + (size_t)8 * 128 * 64 * 4;
constexpr size_t WS_BL = WS_ML + 4096;
constexpr size_t WS_MS = WS_BL + 4096;
constexpr size_t WS_SA = WS_MS + 4096;
constexpr size_t WS_SH = WS_SA + 8192;
constexpr size_t WS_CSB = WS_SH + (size_t)16 * 128 * 8192 * 4;
constexpr size_t WS_HSB = WS_CSB + (size_t)8 * 128 * 8192 * 2;
constexpr size_t WS_NS = WS_HSB + (size_t)16 * 128 * 8192 * 2;
constexpr size_t WS_END = WS_NS + (size_t)8 * 128 * 64 * 4;
constexpr int LDS_BYTES = 139264;
constexpr int NT = 512;

struct Args { const float* in[24]; float* out; unsigned char* ws; int ph_lo, ph_hi; };

__device__ __forceinline__ float bf2f(unsigned v) { return __uint_as_float(v << 16); }
__device__ __forceinline__ unsigned pk2(float lo, float hi) { f32x2 v = {lo, hi}; bf16x2_t b = __builtin_convertvector(v, bf16x2_t); return __builtin_bit_cast(unsigned, b); }
__device__ __forceinline__ unsigned f2bf(float f) { return pk2(f, 0.f) & 0xffffu; }
__device__ __forceinline__ void unpack8(u32x4 w, float (&f)[8]) {
#pragma unroll
    for (int i = 0; i < 4; ++i) { f[2 * i] = __uint_as_float(w[i] << 16); f[2 * i + 1] = __uint_as_float(w[i] & 0xffff0000u); }
}
__device__ __forceinline__ u32x4 pack8(const float (&f)[8]) { u32x4 w; w[0] = pk2(f[0], f[1]); w[1] = pk2(f[2], f[3]); w[2] = pk2(f[4], f[5]); w[3] = pk2(f[6], f[7]); return w; }
__device__ __forceinline__ u32x4 pack8v(f32x4 a, f32x4 b) { u32x4 w; w[0] = pk2(a[0], a[1]); w[1] = pk2(a[2], a[3]); w[2] = pk2(b[0], b[1]); w[3] = pk2(b[2], b[3]); return w; }
__device__ __forceinline__ bf16x8 as_frag(u32x4 w) { return __builtin_bit_cast(bf16x8, w); }
__device__ __forceinline__ bf16x8 ldg_f32_frag(const float* p) { f32x4 a = *(const f32x4*)p, b = *(const f32x4*)(p + 4); return as_frag(pack8v(a, b)); }
__device__ __forceinline__ bf16x8 lds_frag(lptr base, int row, int k, int stride) { return *(const LAS bf16x8*)(base + ((row * stride + k) << 1)); }
__device__ __forceinline__ f32x4 mfma16(bf16x8 a, bf16x8 b, f32x4 c) { return __builtin_amdgcn_mfma_f32_16x16x32_bf16(a, b, c, 0, 0, 0); }
__device__ __forceinline__ float sigmoidf_(float x) { return 1.f / (1.f + __expf(-x)); }
__device__ __forceinline__ float siluf_(float x) { return x / (1.f + __expf(-x)); }
__device__ __forceinline__ float softplusf_(float x) { return x > 20.f ? x : log1pf(__expf(x)); }
__device__ __forceinline__ float logsigf_(float x) { return fminf(x, 0.f) - log1pf(__expf(-fabsf(x))); }
__device__ __forceinline__ float wave_scan_sum(float v, int lane) {
#pragma unroll
    for (int o = 1; o < 64; o <<= 1) { float t = __shfl_up(v, o); if (lane >= o) v += t; }
    return v;
}
__device__ __forceinline__ float wave_scan_max(float v, int lane) {
#pragma unroll
    for (int o = 1; o < 64; o <<= 1) { float t = __shfl_up(v, o); if (lane >= o) v = fmaxf(v, t); }
    return v;
}
__device__ __forceinline__ float red16(float v);
__device__ __forceinline__ float red16max(float v);
__device__ __forceinline__ float wave_sum(float v) { v = red16(v); v += __shfl_xor(v, 16); v += __shfl_xor(v, 32); return v; }
__device__ __forceinline__ float wave_max(float v) { v = red16max(v); v = fmaxf(v, __shfl_xor(v, 16)); v = fmaxf(v, __shfl_xor(v, 32)); return v; }
template <int CTRL> __device__ __forceinline__ float dppf(float v) { return __int_as_float(__builtin_amdgcn_update_dpp(0, __float_as_int(v), CTRL, 0xf, 0xf, true)); }
__device__ __forceinline__ float red16(float v) { v += dppf<0xB1>(v); v += dppf<0x4E>(v); v += dppf<0x141>(v); v += dppf<0x140>(v); return v; }
__device__ __forceinline__ float red16max(float v) { v = fmaxf(v, dppf<0xB1>(v)); v = fmaxf(v, dppf<0x4E>(v)); v = fmaxf(v, dppf<0x141>(v)); v = fmaxf(v, dppf<0x140>(v)); return v; }
__device__ __forceinline__ int OPQ(int v) { asm volatile("" : "+v"(v)); return v; }
#define LDS_FENCE() asm volatile("s_waitcnt lgkmcnt(0)" ::: "memory")

namespace pg8 {
constexpr int BM = 256, BK = 64, HALF = 128, HTB = HALF * BK * 2, STAGE_BYTES = 8 * HTB, NXCD = 8, WGM = 8;
__host__ __device__ __forceinline__ int lds_byte(int r, int c) { const int st = (r >> 4) * 2 + (c >> 5), rr = r & 15, cc = c & 31, ob = rr * 64 + cc * 2; return st * 1024 + (ob ^ (((ob >> 9) & 1) << 5)); }
__host__ __device__ __forceinline__ void stage_rc(int b, int& R, int& C) { const int st = b / 1024, sb = b % 1024, swz = sb ^ (((sb >> 9) & 1) << 5); R = (st >> 1) * 16 + swz / 64; C = (st & 1) * 32 + (swz % 64) / 2; }
__host__ __device__ __forceinline__ int perm32(int rho) { const int n = rho >> 4, i = rho & 15; return 8 * (i >> 2) + 4 * n + (i & 3); }
struct Unit { int pm, pn; };
struct Gemm { const bf16_t* A; const bf16_t* Bt; int M, N, K; };
struct StaticOrder {
    int nM, nN, nwg, G, c;
    __device__ void init(int M, int N, int G_, int c_) { nM = M / BM; nN = N / BM; nwg = nM * nN; G = G_; c = c_; }
    __device__ bool next(int i, Unit& u) const {
        const long L = (long)i * G + c; if (L >= nwg) return false;
        int wgid = (int)L; { const int q = nwg / NXCD, r = nwg % NXCD, xcd = wgid % NXCD, off = wgid / NXCD; wgid = (xcd < r ? xcd * (q + 1) : r * (q + 1) + (xcd - r) * q) + off; }
        const int nig = WGM * nN, gid = wgid / nig, fm = gid * WGM, gsz = (nM - fm) < WGM ? (nM - fm) : WGM;
        u.pm = fm + ((wgid % nig) % gsz); u.pn = (wgid % nig) / gsz; return true;
    }
};
template <int NAI> struct EpiU_ {
    bf16_t* U; const float* ssq;
    __device__ __forceinline__ void operator()(const f32x4 (&acc)[2][2][4][2], const Unit& u, int wr, int wc, int fr, int fq) const {
        const int row0 = u.pm * BM + wr * 64 + fr, col0 = u.pn * BM + wc * 32 + 8 * fq;
#pragma unroll
        for (int ai = 0; ai < NAI; ++ai)
#pragma unroll
            for (int m = 0; m < 4; ++m) {
                const int r = row0 + ai * HALF + m * 16;
                const f32x4 s = *(const f32x4*)(ssq + (size_t)r * 16 + fq * 4);
                float st = s[0] + s[1] + s[2] + s[3]; st += __shfl_xor(st, 16); st += __shfl_xor(st, 32);
                const float rs = rsqrtf(st * (1.f / 1024.f) + EPS);
                bf16_t* rowp = U + (size_t)r * NIN + col0;
#pragma unroll
                for (int bj = 0; bj < 2; ++bj) *(u32x4*)(rowp + bj * HALF) = pack8v(acc[ai][bj][m][0] * rs, acc[ai][bj][m][1] * rs);
                __builtin_amdgcn_sched_barrier(0);
            }
    }
};
template <int NAI> struct EpiRes_ {
    const float* xp; const float* xs; float* out; bf16_t* xb; float* ssq;
    __device__ __forceinline__ void operator()(const f32x4 (&acc)[2][2][4][2], const Unit& u, int wr, int wc, int fr, int fq) const {
        const int row0 = u.pm * BM + wr * 64 + fr, col0 = u.pn * BM + wc * 32 + 8 * fq;
#pragma unroll
        for (int ai = 0; ai < NAI; ++ai)
#pragma unroll
            for (int m = 0; m < 4; ++m) {
                const int r = row0 + ai * HALF + m * 16;
                const bool valid = r < MTOK;
                const float* src = xp ? (r < TP ? xp + (size_t)r * D : xs + (size_t)(r - TP) * D) : out + (size_t)r * D;
                float part = 0.f;
#pragma unroll
                for (int bj = 0; bj < 2; ++bj) {
                    const int c = col0 + bj * HALF;
                    f32x4 o0 = {0.f, 0.f, 0.f, 0.f}, o1 = {0.f, 0.f, 0.f, 0.f};
                    if (valid) { o0 = *(const f32x4*)(src + c); o1 = *(const f32x4*)(src + c + 4); }
                    const f32x4 v0 = acc[ai][bj][m][0] + o0, v1 = acc[ai][bj][m][1] + o1;
                    if (valid) { *(f32x4*)(out + (size_t)r * D + c) = v0; *(f32x4*)(out + (size_t)r * D + c + 4) = v1; }
                    *(u32x4*)(xb + (size_t)r * D + c) = pack8v(v0, v1);
                    part += v0[0] * v0[0] + v0[1] * v0[1] + v0[2] * v0[2] + v0[3] * v0[3] + v1[0] * v1[0] + v1[1] * v1[1] + v1[2] * v1[2] + v1[3] * v1[3];
                }
                part += __shfl_xor(part, 16); part += __shfl_xor(part, 32);
                if (fq == 0) ssq[(size_t)r * 16 + u.pn * 4 + wc] = part;
                __builtin_amdgcn_sched_barrier(0);
            }
    }
};

typedef EpiU_<2> EpiU; typedef EpiU_<1> EpiUh; typedef EpiRes_<2> EpiRes; typedef EpiRes_<1> EpiResh;
struct SampleOrder {
    int first, cnt, c;
    __device__ bool next(int i, Unit& u) const { if (i != 0 || c < first || c >= first + cnt) return false; u.pm = 64; u.pn = c - first; return true; }
};
template <class Epi, class Sched, bool HALF_M = false>
__device__ __forceinline__ void gemm_phase(lptr lds, const Gemm g, const Sched& S, const Epi& E, const int tid) {
    const int wid = __builtin_amdgcn_readfirstlane(tid >> 6), lane = tid & 63, wr = wid >> 2, wc = wid & 3, fr = lane & 15, fq = lane >> 4;
    const int K = g.K, nt = K / BK;
    unsigned voffA[2], voffB[2];
#pragma unroll
    for (int i = 0; i < 2; ++i) { int R, C; stage_rc(tid * 16 + i * 8192, R, C); const int Rb = (R & ~31) + perm32(R & 31);
        voffA[i] = (unsigned)(R * K + C) * 2u; voffB[i] = (unsigned)(Rb * K + C) * 2u; }
    const size_t kstep = (size_t)(BK * 2);
    const size_t hstep = (size_t)HALF * K * 2;
    const size_t tstep = 2 * hstep;
    const unsigned ldsw = (unsigned)wid * 1024u;
    const int aoff = lds_byte(wr * 64 + fr, fq * 8), boff = lds_byte(wc * 32 + fr, fq * 8);
#define PG8_SA(b, h) (((b) * 2 + (h)) * HTB)
#define PG8_SB(b, h) ((4 + (b) * 2 + (h)) * HTB)
#define PG8_STAGE(bufoff, gbase, voff) do { _Pragma("unroll") for (int _i = 0; _i < 2; ++_i) \
        __builtin_amdgcn_global_load_lds((const unsigned*)((const char*)(gbase) + (voff)[_i]), (LAS unsigned*)(lds + (bufoff) + ldsw + _i * 8192), 16, 0, 0); } while (0)
#define PG8_LDA(dst, b, h) do { _Pragma("unroll") for (int m = 0; m < 4; ++m) _Pragma("unroll") for (int k = 0; k < 2; ++k) dst[m][k] = *(const LAS bf16x8*)(lds + PG8_SA(b, h) + aoff + m * 2048 + k * 1024); } while (0)
#define PG8_LDB(dst, b, h) do { _Pragma("unroll") for (int n = 0; n < 2; ++n) _Pragma("unroll") for (int k = 0; k < 2; ++k) dst[n][k] = *(const LAS bf16x8*)(lds + PG8_SB(b, h) + boff + n * 2048 + k * 1024); } while (0)
#define PG8_MMA(ai, bj, At, Bt) do { __builtin_amdgcn_s_setprio(1); _Pragma("unroll") for (int m = 0; m < 4; ++m) _Pragma("unroll") for (int n = 0; n < 2; ++n) _Pragma("unroll") for (int k = 0; k < 2; ++k) \
        acc[ai][bj][m][n] = __builtin_amdgcn_mfma_f32_16x16x32_bf16(Bt[n][k], At[m][k], acc[ai][bj][m][n], 0, 0, 0); __builtin_amdgcn_s_setprio(0); } while (0)
#define PG8_WAIT_V(n) asm volatile("s_waitcnt vmcnt(" #n ")" ::: "memory")
#define PG8_WAIT_L(n) asm volatile("s_waitcnt lgkmcnt(" #n ")" ::: "memory")
#define PG8_BAR __builtin_amdgcn_s_barrier()
#define PG8_SCHED __builtin_amdgcn_sched_barrier(0)
    Unit cur, nxt; int ui = 0;
    if (!S.next(0, cur)) return;
    f32x4 acc[2][2][4][2];
#pragma unroll
    for (int a = 0; a < 2; ++a)
#pragma unroll
        for (int b = 0; b < 2; ++b)
#pragma unroll
            for (int m = 0; m < 4; ++m)
#pragma unroll
                for (int n = 0; n < 2; ++n) acc[a][b][m][n] = (f32x4){0.f, 0.f, 0.f, 0.f};
    bf16x8 At[4][2], B0[2][2], B1[2][2];
    const char* cA = (const char*)g.A + (size_t)cur.pm * tstep; const char* cB = (const char*)g.Bt + (size_t)cur.pn * tstep;
    PG8_STAGE(PG8_SB(0, 0), cB, voffB); PG8_STAGE(PG8_SA(0, 0), cA, voffA); PG8_STAGE(PG8_SB(0, 1), cB + hstep, voffB); PG8_STAGE(PG8_SA(0, 1), cA + hstep, voffA);
    if (wr == 1) PG8_BAR;
    PG8_WAIT_V(4); PG8_BAR;
    PG8_STAGE(PG8_SB(1, 0), cB + kstep, voffB); PG8_STAGE(PG8_SA(1, 0), cA + kstep, voffA); PG8_STAGE(PG8_SB(1, 1), cB + hstep + kstep, voffB);
    PG8_WAIT_V(6); PG8_BAR;
    for (;;) {
        const bool has_next = S.next(ui + 1, nxt);
        const char* nA = has_next ? (const char*)g.A + (size_t)nxt.pm * tstep : cA; const char* nB = has_next ? (const char*)g.Bt + (size_t)nxt.pn * tstep : cB;
        for (int t = 0; t < nt; t += 2) {
            const bool last = (t == nt - 2);
            const char* a1 = cA + (size_t)(t + 1) * kstep;
            const char* a2 = last ? nA : cA + (size_t)(t + 2) * kstep; const char* b2 = last ? nB : cB + (size_t)(t + 2) * kstep;
            const char* a3 = a2 + kstep; const char* b3 = b2 + kstep;
            PG8_LDB(B0, 0, 0); PG8_SCHED; PG8_LDA(At, 0, 0); PG8_STAGE(PG8_SA(1, 1), a1 + hstep, voffA);
            PG8_WAIT_L(8); PG8_BAR; PG8_WAIT_L(0); PG8_MMA(0, 0, At, B0); PG8_BAR; PG8_SCHED;
            PG8_LDB(B1, 0, 1); PG8_STAGE(PG8_SB(0, 0), b2, voffB);
            PG8_BAR; PG8_WAIT_L(0); PG8_MMA(0, 1, At, B1); PG8_BAR;
            if constexpr (!HALF_M) PG8_LDA(At, 0, 1);
            PG8_STAGE(PG8_SA(0, 0), a2, voffA);
            PG8_BAR; PG8_WAIT_L(0); if constexpr (!HALF_M) PG8_MMA(1, 0, At, B0); PG8_BAR; PG8_SCHED;
            PG8_STAGE(PG8_SB(0, 1), b2 + hstep, voffB);
            PG8_WAIT_V(6); PG8_BAR; if constexpr (!HALF_M) PG8_MMA(1, 1, At, B1); PG8_BAR;
            PG8_LDB(B0, 1, 0); PG8_SCHED; PG8_LDA(At, 1, 0); PG8_STAGE(PG8_SA(0, 1), a2 + hstep, voffA);
            PG8_WAIT_L(8); PG8_BAR; PG8_WAIT_L(0); PG8_MMA(0, 0, At, B0); PG8_BAR; PG8_SCHED;
            PG8_LDB(B1, 1, 1); PG8_STAGE(PG8_SB(1, 0), b3, voffB);
            PG8_BAR; PG8_WAIT_L(0); PG8_MMA(0, 1, At, B1); PG8_BAR;
            if constexpr (!HALF_M) PG8_LDA(At, 1, 1);
            PG8_STAGE(PG8_SA(1, 0), a3, voffA);
            PG8_BAR; PG8_WAIT_L(0); if constexpr (!HALF_M) PG8_MMA(1, 0, At, B0); PG8_BAR; PG8_SCHED;
            PG8_STAGE(PG8_SB(1, 1), b3 + hstep, voffB);
            PG8_WAIT_V(6); PG8_BAR; if constexpr (!HALF_M) PG8_MMA(1, 1, At, B1); PG8_BAR;
        }
        E(acc, cur, wr, wc, fr, fq);
        if (!has_next) break;
#pragma unroll
        for (int a = 0; a < 2; ++a)
#pragma unroll
            for (int b = 0; b < 2; ++b)
#pragma unroll
                for (int m = 0; m < 4; ++m)
#pragma unroll
                    for (int n = 0; n < 2; ++n) acc[a][b][m][n] = (f32x4){0.f, 0.f, 0.f, 0.f};
        cur = nxt; cA = nA; cB = nB; ++ui;
    }
    PG8_WAIT_V(0);
    if (wr == 0) PG8_BAR;
    PG8_BAR;
#undef PG8_SA
#undef PG8_SB
#undef PG8_STAGE
#undef PG8_LDA
#undef PG8_LDB
#undef PG8_MMA
#undef PG8_WAIT_V
#undef PG8_WAIT_L
#undef PG8_BAR
#undef PG8_SCHED
}
}

struct Ctx {
    const float* xp; const float* xs; const float* stC; const float* stN; const float* stM; const float* ssm; const float* conv; const float* ck; const float* cv;
    float* out; unsigned char* ws;
};
#define XWIN ((bf16_t*)(X.ws + WS_WIN))
#define XWOUT ((bf16_t*)(X.ws + WS_WOUT))
#define XXB ((bf16_t*)(X.ws + WS_XB))
#define XU ((bf16_t*)(X.ws + WS_U))
#define XMIX ((bf16_t*)(X.ws + WS_MIX))
#define XSSQ ((float*)(X.ws + WS_SSQ))
#define XROPE ((float*)(X.ws + WS_ROPE))
#define XMC ((float*)(X.ws + WS_MC))
#define XMN ((float*)(X.ws + WS_MN))
#define XML ((float*)(X.ws + WS_ML))
#define XBL ((float*)(X.ws + WS_BL))
#define XMS ((float*)(X.ws + WS_MS))
#define XSA ((float*)(X.ws + WS_SA))
#define XSH ((float*)(X.ws + WS_SH))
#define XCSB ((bf16_t*)(X.ws + WS_CSB))
#define XNS ((float*)(X.ws + WS_NS))
#define XHSB ((bf16_t*)(X.ws + WS_HSB))
#define XPAR(off) ((const float*)(X.ws + WS_PAR) + (off))
constexpr int P_AIB = 0, P_AFB = 16, P_DTB = 32, P_ALOG = 64, P_BD = 96, P_SINK = 128, P_QNW = 160, P_KNW = 416, P_ANW = 672, P_BNW = 2720, P_CB = 4768, P_CW = 8864, P_END = 25248;
#define IN_XP 0
#define IN_XS 1
#define IN_STC 2
#define IN_STN 3
#define IN_STM 4
#define IN_SSM 5
#define IN_CONV 6
#define IN_CK 7
#define IN_CV 8
#define IN_NORMW 9
#define IN_WIN 10
#define IN_AIB 11
#define IN_AFB 12
#define IN_ANW 13
#define IN_CW 14
#define IN_CB 15
#define IN_DTB 16
#define IN_ALOG 17
#define IN_BD 18
#define IN_BNW 19
#define IN_QNW 20
#define IN_KNW 21
#define IN_SINK 22
#define IN_WOUT 23

__device__ __forceinline__ void transpose_tile(lptr lds, const float* src, int ldn, int nvalid, bf16_t* dst, int ldk, const float* scale, int k0, int n0, int tid) {
    LAS float* T = (LAS float*)lds;
#pragma unroll
    for (int it = 0; it < 2; ++it) {
        const int r = (tid >> 4) + it * 32, c4 = (tid & 15) * 4, n = n0 + c4;
        f32x4 v = {0.f, 0.f, 0.f, 0.f};
        if (n < nvalid) v = *(const f32x4*)(src + (size_t)(k0 + r) * ldn + n);
        const float sc = scale ? scale[k0 + r] : 1.f;
        T[r * 65 + c4 + 0] = v[0] * sc; T[r * 65 + c4 + 1] = v[1] * sc; T[r * 65 + c4 + 2] = v[2] * sc; T[r * 65 + c4 + 3] = v[3] * sc;
    }
    __syncthreads();
    {
        const int n = tid >> 3, k8 = (tid & 7) * 8; float f[8];
#pragma unroll
        for (int j = 0; j < 8; ++j) f[j] = T[(k8 + j) * 65 + n];
        *(u32x4*)(dst + (size_t)(n0 + n) * ldk + k0 + k8) = pack8(f);
    }
    __syncthreads();
}

__device__ __forceinline__ void prologue(lptr lds, const Ctx& X, const Args& args, int G, int bid, int tid) {
    const int lane = tid & 63, wave = tid >> 6;
    constexpr int T0 = 5120, T1 = T0 + 1536, T2 = T1 + 2080, T3 = T2 + 1, T4 = T3 + 513;
    for (int task = bid; task < T4; task += G) {
        if (task < T0) {
            const int l = task / 1280, r = task % 1280, kt = r / 80, ntl = r % 80;
            transpose_tile(lds, args.in[IN_WIN] + (size_t)l * D * DIN, DIN, DIN, XWIN + (size_t)l * NIN * D, D, args.in[IN_NORMW] + l * D, kt * 64, ntl * 64, tid);
        } else if (task < T1) {
            const int t = task - T0, l = t / 384, r = t % 384, kt = r / 16, ntl = r % 16;
            transpose_tile(lds, args.in[IN_WOUT] + (size_t)l * DMIX * D, D, D, XWOUT + (size_t)l * D * DMIX, DMIX, nullptr, kt * 64, ntl * 64, tid);
        } else if (task < T2) {
            const int r = (task - T1) * 8 + wave;
            float ss = 0.f;
            if (r < MTOK) {
                const float* src = r < TP ? X.xp + (size_t)r * D : X.xs + (size_t)(r - TP) * D;
#pragma unroll
                for (int i = 0; i < 4; ++i) {
                    const int c = lane * 4 + i * 256; f32x4 v = *(const f32x4*)(src + c);
                    ss += v[0] * v[0] + v[1] * v[1] + v[2] * v[2] + v[3] * v[3];
                    u32x2 w; w[0] = pk2(v[0], v[1]); w[1] = pk2(v[2], v[3]);
                    *(u32x2*)(XXB + (size_t)r * D + c) = w;
                }
            } else {
#pragma unroll
                for (int i = 0; i < 4; ++i) { u32x2 w = {0u, 0u}; *(u32x2*)(XXB + (size_t)r * D + lane * 4 + i * 256) = w; }
            }
            ss = wave_sum(ss);
            if (lane < 16) XSSQ[(size_t)r * 16 + lane] = (lane == 0) ? ss : 0.f;
        } else if (task < T3) {
            for (int i = tid; i < (MPAD - MTOK) * DMIX / 2; i += NT) ((unsigned*)(XMIX + (size_t)MTOK * DMIX))[i] = 0u;
            float* P = (float*)(X.ws + WS_PAR);
            const int po[12] = {P_AIB, P_AFB, P_DTB, P_ALOG, P_BD, P_SINK, P_QNW, P_KNW, P_ANW, P_BNW, P_CB, P_CW};
            const int pn[12] = {16, 16, 32, 32, 32, 32, 256, 256, 2048, 2048, 4096, 16384};
            const int pi[12] = {IN_AIB, IN_AFB, IN_DTB, IN_ALOG, IN_BD, IN_SINK, IN_QNW, IN_KNW, IN_ANW, IN_BNW, IN_CB, IN_CW};
#pragma unroll
            for (int a = 0; a < 12; ++a) { const float* src = args.in[pi[a]]; for (int i = tid; i < pn[a]; i += NT) P[po[a] + i] = src[i]; }
        } else {
            const int e = (task - T3) * 512 + tid;
            if (e < 8193 * 32) {
                const int pos = e >> 5, d = e & 31;
                const float inv = (float)exp2(-(double)d * (13.287712379549449 / 32.0));
                const float angf = (float)pos * inv;
                const double a = (double)angf;
                const double k = rint(a * 0.15915494309189535);
                const float rr = (float)(a - k * 6.283185307179586);
                XROPE[(size_t)e * 2] = cosf(rr); XROPE[(size_t)e * 2 + 1] = sinf(rr);
            }
        }
    }
}

__device__ __forceinline__ void conv8(const bf16_t* u, int seq0, int tt, int ch, const float* cw, const float* cb, float (&o)[8]) {
    float acc[8];
    { f32x4 b0 = *(const f32x4*)(cb + ch), b1 = *(const f32x4*)(cb + ch + 4);
#pragma unroll
      for (int j = 0; j < 4; ++j) { acc[j] = b0[j]; acc[4 + j] = b1[j]; } }
#pragma unroll
    for (int jj = 0; jj < 4; ++jj) {
        const int t2 = tt + jj - 3;
        if (t2 >= 0) {
            float x[8]; unpack8(*(const u32x4*)(u + (size_t)(seq0 + t2) * NIN + C_BX + ch), x);
            f32x4 w0 = *(const f32x4*)(cw + jj * 1024 + ch), w1 = *(const f32x4*)(cw + jj * 1024 + ch + 4);
#pragma unroll
            for (int j = 0; j < 4; ++j) { acc[j] += x[j] * w0[j]; acc[4 + j] += x[4 + j] * w1[j]; }
        }
    }
#pragma unroll
    for (int j = 0; j < 8; ++j) o[j] = siluf_(acc[j]);
}


__device__ __forceinline__ void conv8x8(const bf16_t* u, int seq0, int tt0, int ch, const float* cw, const float* cb, float (&o)[8][8]) {
    float w[4][8];
#pragma unroll
    for (int jj = 0; jj < 4; ++jj) { f32x4 w0 = *(const f32x4*)(cw + jj * 1024 + ch), w1 = *(const f32x4*)(cw + jj * 1024 + ch + 4);
#pragma unroll
        for (int j = 0; j < 4; ++j) { w[jj][j] = w0[j]; w[jj][4 + j] = w1[j]; } }
    { f32x4 b0 = *(const f32x4*)(cb + ch), b1 = *(const f32x4*)(cb + ch + 4);
#pragma unroll
      for (int t = 0; t < 8; ++t)
#pragma unroll
          for (int j = 0; j < 4; ++j) { o[t][j] = b0[j]; o[t][4 + j] = b1[j]; } }
    u32x4 raw[11];
#pragma unroll
    for (int r = 0; r < 11; ++r) {
        const int t2 = tt0 + r - 3;
        raw[r] = (u32x4){0u, 0u, 0u, 0u};
        if (t2 >= 0) raw[r] = *(const u32x4*)(u + (size_t)(seq0 + t2) * NIN + C_BX + ch);
    }
#pragma unroll
    for (int r = 0; r < 11; ++r) {
        float x[8]; unpack8(raw[r], x);
#pragma unroll
        for (int jj = 0; jj < 4; ++jj) {
            const int t = r - jj;
            if (t >= 0 && t < 8) {
#pragma unroll
                for (int j = 0; j < 8; ++j) o[t][j] += x[j] * w[jj][j];
            }
        }
    }
#pragma unroll
    for (int t = 0; t < 8; ++t)
#pragma unroll
        for (int j = 0; j < 8; ++j) o[t][j] = siluf_(o[t][j]);
}

__device__ __forceinline__ void mlstm_local(lptr lds, const Ctx& X, int l, int task, int tid) {
    const int h = task & 3, c = (task >> 2) & 127, n = task >> 9;
    const int lane = tid & 63, wave = tid >> 6, fr = lane & 15, fq = lane >> 4;
    const int row0 = n * SEQ + c * 64, nh = n * 4 + h;
    lptr VwT = lds;
    lptr KT = lds + 18432;
    LAS float* wv = (LAS float*)(lds + 27648);
    u32x4 vraw[2], kraw;
#pragma unroll
    for (int it = 0; it < 2; ++it) { const int p = tid + it * NT, tok = p >> 4, v8 = (p & 15) * 8; vraw[it] = *(const u32x4*)(XU + (size_t)(row0 + tok) * NIN + C_AV + h * 128 + v8); }
    { const int tok = tid >> 3, k8 = (tid & 7) * 8; kraw = *(const u32x4*)(XU + (size_t)(row0 + tok) * NIN + C_AK + h * 64 + k8); }
    if (wave == 0) {
        const bf16_t* ur = XU + (size_t)(row0 + lane) * NIN;
        const float fg = bf2f(ur[C_AF + h]) + XPAR(P_AFB)[l * 4 + h], ig = bf2f(ur[C_AI + h]) + XPAR(P_AIB)[l * 4 + h];
        const float b = wave_scan_sum(logsigf_(fg), lane);
        const float bl = __shfl(b, 63);
        const float g = bl - b + ig;
        const float ml = wave_max(g);
        wv[lane] = __expf(g - ml);
        if (lane == 0) { XML[nh * 128 + c] = ml; XBL[nh * 128 + c] = bl; }
    }
    __syncthreads();
#pragma unroll
    for (int it = 0; it < 2; ++it) {
        const int p = tid + it * NT, tok = p >> 4, v8 = (p & 15) * 8;
        float x[8]; unpack8(vraw[it], x);
        const float w = wv[tok];
#pragma unroll
        for (int j = 0; j < 8; ++j) *(LAS bf16_t*)(VwT + (((v8 + j) * 72 + tok) << 1)) = (bf16_t)f2bf(x[j] * w);
    }
    {
        const int tok = tid >> 3, k8 = (tid & 7) * 8;
        float x[8]; unpack8(kraw, x);
#pragma unroll
        for (int j = 0; j < 8; ++j) *(LAS bf16_t*)(KT + (((k8 + j) * 72 + tok) << 1)) = (bf16_t)f2bf(x[j] * 0.125f);
    }
    __syncthreads();
    {
        float* dst = XMC + ((size_t)nh * 128 + c) * 8192;
        bf16x8 b0 = lds_frag(VwT, 16 * wave + fr, fq * 8, 72), b1 = lds_frag(VwT, 16 * wave + fr, 32 + fq * 8, 72);
#pragma unroll
        for (int mt = 0; mt < 4; ++mt) {
            f32x4 acc = {0.f, 0.f, 0.f, 0.f};
            acc = mfma16(lds_frag(KT, 16 * mt + fr, fq * 8, 72), b0, acc);
            acc = mfma16(lds_frag(KT, 16 * mt + fr, 32 + fq * 8, 72), b1, acc);
            *(f32x4*)(dst + (16 * wave + fr) * 64 + 16 * mt + 4 * fq) = acc;
        }
    }
    if (tid < 64) {
        float s = 0.f;
#pragma unroll 8
        for (int t = 0; t < 64; ++t) s += bf2f(*(const LAS bf16_t*)(KT + ((tid * 72 + t) << 1))) * wv[t];
        XMN[((size_t)nh * 128 + c) * 64 + tid] = s;
    }
    __syncthreads();
}

__device__ __forceinline__ void ssd_local(lptr lds, const Ctx& X, int l, int task, int tid) {
    const int g = task & 1, c = (task >> 1) & 127, n = task >> 8;
    const int lane = tid & 63, wave = tid >> 6, fr = lane & 15, fq = lane >> 4;
    const int seq0 = n * SEQ, row0 = seq0 + c * 64;
    lptr XwT = lds;
    lptr BT = lds + 36864;
    LAS float* wl = (LAS float*)(lds + 55296);
    {
        const float* cw = XPAR(P_CW) + l * 4096; const float* cb = XPAR(P_CB) + l * 1024;
        const int cg = lane;
        float o[8][8];
        {
            const int cgc = cg < 48 ? cg : 47;
            const int ch = cgc < 32 ? g * 256 + cgc * 8 : 512 + g * 128 + (cgc - 32) * 8;
            conv8x8(XU, seq0, c * 64 + 8 * wave, ch, cw, cb, o);
        }
    if (wave < 4) {
        const int hh = 4 * g + wave;
        const float dt = softplusf_(bf2f(XU[(size_t)(row0 + lane) * NIN + C_BDT + hh]) + XPAR(P_DTB)[l * 8 + hh]);
        const float A = -__expf(XPAR(P_ALOG)[l * 8 + hh]);
        const float a = wave_scan_sum(dt * A, lane);
        const float aL = __shfl(a, 63);
        wl[wave * 64 + lane] = __expf(aL - a) * dt;
        if (lane == 0) XSA[(n * 8 + hh) * 128 + c] = aL;
    }
    __syncthreads();
        if (cg < 48) {
            if (cg < 32) {
                float wt[8];
#pragma unroll
                for (int t = 0; t < 8; ++t) wt[t] = wl[(cg >> 3) * 64 + 8 * wave + t];
#pragma unroll
                for (int jx = 0; jx < 8; ++jx) {
                    float v[8];
#pragma unroll
                    for (int t = 0; t < 8; ++t) v[t] = o[t][jx] * wt[t];
                    *(LAS u32x4*)(XwT + (((cg * 8 + jx) * 72 + 8 * wave) << 1)) = pack8(v);
                }
            } else {
#pragma unroll
                for (int jx = 0; jx < 8; ++jx) {
                    float v[8];
#pragma unroll
                    for (int t = 0; t < 8; ++t) v[t] = o[t][jx];
                    *(LAS u32x4*)(BT + ((((cg - 32) * 8 + jx) * 72 + 8 * wave) << 1)) = pack8(v);
                }
            }
        }
    }
    __syncthreads();
    {
        const int hl = wave >> 1, ph = wave & 1, hh = 4 * g + hl;
        float* dst = XSH + ((size_t)(n * 8 + hh) * 128 + c) * 8192;
        bf16x8 bx[2][2];
#pragma unroll
        for (int ntl = 0; ntl < 2; ++ntl)
#pragma unroll
            for (int kk = 0; kk < 2; ++kk) bx[ntl][kk] = lds_frag(XwT, hl * 64 + ph * 32 + ntl * 16 + fr, kk * 32 + fq * 8, 72);
#pragma unroll
        for (int mt = 0; mt < 8; ++mt) {
            bf16x8 a0 = lds_frag(BT, 16 * mt + fr, fq * 8, 72), a1 = lds_frag(BT, 16 * mt + fr, 32 + fq * 8, 72);
#pragma unroll
            for (int ntl = 0; ntl < 2; ++ntl) {
                f32x4 acc = {0.f, 0.f, 0.f, 0.f};
                acc = mfma16(a0, bx[ntl][0], acc); acc = mfma16(a1, bx[ntl][1], acc);
                *(f32x4*)(dst + (ph * 32 + ntl * 16 + fr) * 128 + 16 * mt + 4 * fq) = acc;
            }
        }
    }
    __syncthreads();
}

__device__ __forceinline__ void swa_prompt(lptr lds, const Ctx& X, int l, int task, int tid) {
    const int kvh = task & 1, qb = (task >> 1) & 63, n = task >> 7;
    const int lane = tid & 63, wave = tid >> 6, fr = lane & 15, fq = lane >> 4;
    const int seq0 = n * SEQ;
    lptr Kn = lds;
    lptr Vt = lds + 36864;
    lptr Pw = lds + 70656 + wave * 8448;
    const float* knw = XPAR(P_KNW) + l * 64; const float* qnw = XPAR(P_QNW) + l * 64;
#pragma unroll
    for (int it = 0; it < 2; ++it) {
        const int item = tid + it * NT, j = item >> 2, qd = item & 3, t = qb * 128 - 128 + j;
        float o1[8], o2[8];
        if (t >= 0) {
            const bf16_t* kr = XU + (size_t)(seq0 + t) * NIN + C_CK + kvh * 64;
            float x1[8], x2[8]; unpack8(*(const u32x4*)(kr + qd * 8), x1); unpack8(*(const u32x4*)(kr + 32 + qd * 8), x2);
            float ss = 0.f;
#pragma unroll
            for (int jj = 0; jj < 8; ++jj) ss += x1[jj] * x1[jj] + x2[jj] * x2[jj];
            ss += __shfl_xor(ss, 1); ss += __shfl_xor(ss, 2);
            const float rs = rsqrtf(ss * (1.f / 64.f) + EPS);
            const float* cs = XROPE + ((size_t)t * 32 + qd * 8) * 2;
#pragma unroll
            for (int jj = 0; jj < 8; ++jj) {
                const float a = x1[jj] * rs * knw[qd * 8 + jj], b = x2[jj] * rs * knw[32 + qd * 8 + jj], co = cs[2 * jj], si = cs[2 * jj + 1];
                o1[jj] = a * co - b * si; o2[jj] = b * co + a * si;
            }
        } else {
#pragma unroll
            for (int jj = 0; jj < 8; ++jj) { o1[jj] = 0.f; o2[jj] = 0.f; }
        }
        *(LAS u32x4*)(Kn + ((j * 72 + qd * 8) << 1)) = pack8(o1);
        *(LAS u32x4*)(Kn + ((j * 72 + 32 + qd * 8) << 1)) = pack8(o2);
        if (qb == 63 && j >= 128) {
            float* ko = X.out + O_PK + ((((size_t)l * 2 + n) * 128 + (j - 128)) * 2 + kvh) * 64;
            *(f32x4*)(ko + qd * 8) = (f32x4){o1[0], o1[1], o1[2], o1[3]}; *(f32x4*)(ko + qd * 8 + 4) = (f32x4){o1[4], o1[5], o1[6], o1[7]};
            *(f32x4*)(ko + 32 + qd * 8) = (f32x4){o2[0], o2[1], o2[2], o2[3]}; *(f32x4*)(ko + 32 + qd * 8 + 4) = (f32x4){o2[4], o2[5], o2[6], o2[7]};
        }
    }
#pragma unroll
    for (int it = 0; it < 4; ++it) {
        const int item = tid + it * NT, j = item >> 3, d8 = (item & 7) * 8, t = qb * 128 - 128 + j;
        u32x4 w = {0u, 0u, 0u, 0u};
        if (t >= 0) w = *(const u32x4*)(XU + (size_t)(seq0 + t) * NIN + C_CV + kvh * 64 + d8);
#pragma unroll
        for (int jj = 0; jj < 8; ++jj) *(LAS bf16_t*)(Vt + (((d8 + jj) * 264 + j) << 1)) = (bf16_t)((w[jj >> 1] >> ((jj & 1) * 16)) & 0xffffu);
        if (qb == 63 && j >= 128) {
            float x[8]; unpack8(w, x);
            float* vo = X.out + O_PV + ((((size_t)l * 2 + n) * 128 + (j - 128)) * 2 + kvh) * 64 + d8;
            *(f32x4*)(vo) = (f32x4){x[0], x[1], x[2], x[3]}; *(f32x4*)(vo + 4) = (f32x4){x[4], x[5], x[6], x[7]};
        }
    }
    __syncthreads();
    const int hq = kvh * 4 + (wave >> 1), i0 = (wave & 1) * 64;
    const float sink = XPAR(P_SINK)[l * 8 + hq];
    float qw1[8], qw2[8];
#pragma unroll
    for (int jj = 0; jj < 8; ++jj) { qw1[jj] = qnw[fq * 8 + jj]; qw2[jj] = qnw[32 + fq * 8 + jj]; }
    u32x4 qn0, qn1; f32x4 csn[4];
    {
        const int t = qb * 128 + i0 + fr;
        const bf16_t* qr = XU + (size_t)(seq0 + t) * NIN + C_CQ + hq * 64;
        qn0 = *(const u32x4*)(qr + fq * 8); qn1 = *(const u32x4*)(qr + 32 + fq * 8);
        const f32x4* cs = (const f32x4*)(XROPE + ((size_t)t * 32 + fq * 8) * 2);
#pragma unroll
        for (int q4 = 0; q4 < 4; ++q4) csn[q4] = cs[q4];
    }
#pragma unroll 1
    for (int mt = 0; mt < 4; ++mt) {
        const int q0 = i0 + mt * 16;
        const u32x4 q0r = qn0, q1r = qn1; f32x4 csc[4];
#pragma unroll
        for (int q4 = 0; q4 < 4; ++q4) csc[q4] = csn[q4];
        unsigned short czv[4][4];
#pragma unroll
        for (int ii = 0; ii < 4; ++ii)
#pragma unroll
            for (int ntl = 0; ntl < 4; ++ntl) czv[ntl][ii] = XU[((size_t)seq0 + qb * 128 + q0 + fq * 4 + ii) * NIN + C_CZ + hq * 64 + 16 * ntl + fr];
        {
            const int mn = mt < 3 ? mt + 1 : 3;
            const int t = qb * 128 + i0 + mn * 16 + fr;
            const bf16_t* qr = XU + (size_t)(seq0 + t) * NIN + C_CQ + hq * 64;
            qn0 = *(const u32x4*)(qr + fq * 8); qn1 = *(const u32x4*)(qr + 32 + fq * 8);
            const f32x4* cs = (const f32x4*)(XROPE + ((size_t)t * 32 + fq * 8) * 2);
#pragma unroll
            for (int q4 = 0; q4 < 4; ++q4) csn[q4] = cs[q4];
        }
        bf16x8 a0, a1;
        {
            float x1[8], x2[8]; unpack8(q0r, x1); unpack8(q1r, x2);
            float ss = 0.f;
#pragma unroll
            for (int jj = 0; jj < 8; ++jj) ss += x1[jj] * x1[jj] + x2[jj] * x2[jj];
            ss += __shfl_xor(ss, 16); ss += __shfl_xor(ss, 32);
            const float rs = rsqrtf(ss * (1.f / 64.f) + EPS) * 0.125f;
            float o1[8], o2[8];
#pragma unroll
            for (int jj = 0; jj < 8; ++jj) {
                const float a = x1[jj] * rs * qw1[jj], b = x2[jj] * rs * qw2[jj], co = csc[jj >> 1][(jj & 1) * 2], si = csc[jj >> 1][(jj & 1) * 2 + 1];
                o1[jj] = a * co - b * si; o2[jj] = b * co + a * si;
            }
            a0 = as_frag(pack8(o1)); a1 = as_frag(pack8(o2));
        }
        const int tlo = q0 >> 4;
        const int qi = q0 + fr;
        f32x4 s[16];
        float mx = -3.0e38f;
#pragma unroll
        for (int ntl = 0; ntl < 16; ++ntl) {
            if (ntl >= tlo && ntl <= tlo + 8) {
                f32x4 acc = {0.f, 0.f, 0.f, 0.f};
                acc = mfma16(lds_frag(Kn, 16 * ntl + fr, fq * 8, 72), a0, acc);
                acc = mfma16(lds_frag(Kn, 16 * ntl + fr, 32 + fq * 8, 72), a1, acc);
#pragma unroll
                for (int ii = 0; ii < 4; ++ii) {
                    const int jk = 16 * ntl + 4 * fq + ii;
                    const bool valid = (jk > qi) && (jk <= qi + 128) && (qb > 0 || jk >= 128);
                    acc[ii] = valid ? acc[ii] : -3.0e38f;
                    mx = fmaxf(mx, acc[ii]);
                }
                s[ntl] = acc;
            }
        }
        mx = fmaxf(mx, __shfl_xor(mx, 16)); mx = fmaxf(mx, __shfl_xor(mx, 32));
        mx = fmaxf(mx, sink);
        float sum = 0.f;
#pragma unroll
        for (int ntl = 0; ntl < 16; ++ntl) {
            if (ntl >= tlo && ntl <= tlo + 8) {
#pragma unroll
                for (int ii = 0; ii < 4; ++ii) { const float e = (s[ntl][ii] > -1.0e38f) ? __expf(s[ntl][ii] - mx) : 0.f; s[ntl][ii] = e; sum += e; }
            }
        }
        sum += __shfl_xor(sum, 16); sum += __shfl_xor(sum, 32);
        const float inv = 1.f / (sum + __expf(sink - mx));
        const int klo = q0 >> 5, khi = (q0 + 143) >> 5;
#pragma unroll
        for (int ntl = 0; ntl < 16; ++ntl) {
            if (ntl >= tlo && ntl <= tlo + 8) {
                u32x2 w; w[0] = pk2(s[ntl][0] * inv, s[ntl][1] * inv); w[1] = pk2(s[ntl][2] * inv, s[ntl][3] * inv);
                *(LAS u32x2*)(Pw + ((fr * 264 + 16 * ntl + 4 * fq) << 1)) = w;
            } else if ((ntl >> 1) >= klo && (ntl >> 1) <= khi) {
                u32x2 w = {0u, 0u};
                *(LAS u32x2*)(Pw + ((fr * 264 + 16 * ntl + 4 * fq) << 1)) = w;
            }
        }
        LDS_FENCE();
        f32x4 o[4];
#pragma unroll
        for (int ntl = 0; ntl < 4; ++ntl) o[ntl] = (f32x4){0.f, 0.f, 0.f, 0.f};
#pragma unroll
        for (int kk = 0; kk < 8; ++kk) {
            if (kk >= klo && kk <= khi) {
                const bf16x8 a = lds_frag(Pw, fr, kk * 32 + fq * 8, 264);
#pragma unroll
                for (int ntl = 0; ntl < 4; ++ntl) o[ntl] = mfma16(a, lds_frag(Vt, 16 * ntl + fr, kk * 32 + fq * 8, 264), o[ntl]);
            }
        }
        LDS_FENCE();
#pragma unroll
        for (int ii = 0; ii < 4; ++ii) {
            const size_t row = (size_t)seq0 + qb * 128 + q0 + fq * 4 + ii;
#pragma unroll
            for (int ntl = 0; ntl < 4; ++ntl) {
                const int d = 16 * ntl + fr;
                XMIX[row * DMIX + 1024 + hq * 64 + d] = (bf16_t)f2bf(o[ntl][ii] * siluf_(bf2f(czv[ntl][ii])));
            }
        }
    }
    __syncthreads();
}

__device__ __forceinline__ void sample_task(lptr lds, const Ctx& X, int l, int b, int part, int tid) {
    LAS float* uf = (LAS float*)lds;
    LAS float* xbc = (LAS float*)(lds + 19968);
    LAS float* numv = (LAS float*)(lds + 24064);
    LAS float* yv = (LAS float*)(lds + 26112);
    LAS float* red = (LAS float*)(lds + 28160);
    LAS float* qs = (LAS float*)(lds + 28416);
    LAS float* kn = (LAS float*)(lds + 30464);
    LAS float* sc = (LAS float*)(lds + 30976);
    const int lane = tid & 63, wave = tid >> 6;
    const size_t row = (size_t)TP + b;
    const bf16_t* ur = XU + row * NIN;
    const size_t lb = (size_t)l * 128 + b;
    f32x4 kpre[8], vpre[8];
    if (part == 2) {
        const float* kc = X.ck + lb * 16384; const float* vc = X.cv + lb * 16384;
#pragma unroll
        for (int it = 0; it < 8; ++it) {
            const int e = (tid + it * NT) * 4, e2 = e < 127 * 128 ? e + 128 : e;
            kpre[it] = *(const f32x4*)(kc + e2); vpre[it] = *(const f32x4*)(vc + e2);
        }
    }
    {
        const int c_lo = part == 0 ? 0 : (part == 1 ? C_BZ : C_CQ), c_hi = part == 0 ? C_BZ : (part == 1 ? C_CQ : DIN);
#pragma unroll 2
        for (int i = c_lo + tid; i < c_hi; i += NT) uf[i] = bf2f(ur[i]);
    }
    __syncthreads();
    if (part == 0) {
#pragma unroll
    for (int h = 0; h < 4; ++h) {
        const float ig = uf[C_AI + h] + XPAR(P_AIB)[l * 4 + h], fg = uf[C_AF + h] + XPAR(P_AFB)[l * 4 + h];
        const float ls = logsigf_(fg), m0 = X.stM[lb * 4 + h];
        const float mn = fmaxf(ls + m0, ig), sp = __expf(ls + m0 - mn), sl = __expf(ig - mn);
        const float* C0 = X.stC + (lb * 4 + h) * 8192; float* C1 = X.out + O_SC + (lb * 4 + h) * 8192;
#pragma unroll
        for (int it = 0; it < 4; ++it) {
            const int e = (tid + it * NT) * 4, v = e >> 6, k = e & 63;
            const f32x4 c0 = *(const f32x4*)(C0 + e);
            const float vv = uf[C_AV + h * 128 + v] * sl;
            f32x4 c1; float part = 0.f;
#pragma unroll
            for (int j = 0; j < 4; ++j) { c1[j] = sp * c0[j] + vv * (uf[C_AK + h * 64 + k + j] * 0.125f); part += c1[j] * uf[C_AQ + h * 64 + k + j]; }
            *(f32x4*)(C1 + e) = c1;
            part = red16(part);
            if ((lane & 15) == 0) numv[h * 128 + v] = part;
        }
        if (wave == 0) {
            const float n1 = sp * X.stN[(lb * 4 + h) * 64 + lane] + sl * uf[C_AK + h * 64 + lane] * 0.125f;
            X.out[O_SN + (lb * 4 + h) * 64 + lane] = n1;
            const float dd = wave_sum(n1 * uf[C_AQ + h * 64 + lane]);
            if (lane == 0) { red[h] = dd; red[4 + h] = mn; X.out[O_SM + lb * 4 + h] = mn; }
        }
    }
    __syncthreads();
    float hv;
    { const int h = tid >> 7; hv = numv[tid] / fmaxf(fabsf(red[h]), __expf(-red[4 + h])); const float ss = wave_sum(hv * hv); if (lane == 0) red[8 + wave] = ss; }
    __syncthreads();
    { const int h = tid >> 7; const float rs = rsqrtf((red[8 + 2 * h] + red[9 + 2 * h]) * (1.f / 128.f) + EPS);
      XMIX[row * DMIX + tid] = (bf16_t)f2bf(hv * rs * XPAR(P_ANW)[l * 512 + tid] * sigmoidf_(uf[C_AO + tid]) * siluf_(uf[C_AZ + tid])); }
    }
    if (part == 1) {
    {
        const float* buf = X.conv + lb * 3 * 1024; float* oc = X.out + O_SCONV + lb * 3 * 1024;
        const float* cw = XPAR(P_CW) + l * 4096;
#pragma unroll
        for (int it = 0; it < 2; ++it) {
            const int ch = tid + it * NT;
            const float f0 = buf[ch], f1 = buf[1024 + ch], f2 = buf[2048 + ch], f3 = uf[C_BX + ch];
            const float acc = XPAR(P_CB)[l * 1024 + ch] + f0 * cw[ch] + f1 * cw[1024 + ch] + f2 * cw[2048 + ch] + f3 * cw[3072 + ch];
            xbc[ch] = siluf_(acc);
            oc[ch] = f1; oc[1024 + ch] = f2; oc[2048 + ch] = f3;
        }
    }
    __syncthreads();
#pragma unroll 4
    for (int hh = 0; hh < 8; ++hh) {
        const float dt = softplusf_(uf[C_BDT + hh] + XPAR(P_DTB)[l * 8 + hh]);
        const float dA = __expf(-dt * __expf(XPAR(P_ALOG)[l * 8 + hh]));
        const int g = hh >> 2;
        const float* h0p = X.ssm + (lb * 8 + hh) * 8192; float* h1p = X.out + O_SH + (lb * 8 + hh) * 8192;
#pragma unroll
        for (int it = 0; it < 4; ++it) {
            const int e = (tid + it * NT) * 4, p = e >> 7, s = e & 127;
            const f32x4 h0 = *(const f32x4*)(h0p + e);
            const float xv = xbc[hh * 64 + p] * dt;
            f32x4 h1; float part = 0.f;
#pragma unroll
            for (int j = 0; j < 4; ++j) { h1[j] = dA * h0[j] + xv * xbc[512 + g * 128 + s + j]; part += h1[j] * xbc[768 + g * 128 + s + j]; }
            *(f32x4*)(h1p + e) = h1;
            part = red16(part); part += __shfl_xor(part, 16);
            if ((lane & 31) == 0) yv[hh * 64 + p] = part;
        }
    }
    __syncthreads();
    float gb;
    { const int hh = tid >> 6; const float y = yv[tid] + XPAR(P_BD)[l * 8 + hh] * xbc[tid]; gb = y * siluf_(uf[C_BZ + tid]); const float ss = wave_sum(gb * gb); if (lane == 0) red[16 + wave] = ss; }
    __syncthreads();
    { const int g = tid >> 8; const float rs = rsqrtf((red[16 + 4 * g] + red[17 + 4 * g] + red[18 + 4 * g] + red[19 + 4 * g]) * (1.f / 256.f) + EPS);
      XMIX[row * DMIX + 512 + tid] = (bf16_t)f2bf(gb * rs * XPAR(P_BNW)[l * 512 + tid]); }
    }
    if (part == 2) {
    lptr Kl = lds + 36864;
    lptr Vl = lds + 36864 + 34816;
    if (tid < 320) {
        const int vec = tid >> 5, d = tid & 31, base = vec < 8 ? C_CQ + vec * 64 : C_CK + (vec - 8) * 64;
        const float x1 = uf[base + d], x2 = uf[base + 32 + d];
        float ss = x1 * x1 + x2 * x2; ss = red16(ss); ss += __shfl_xor(ss, 16);
        const float rs = rsqrtf(ss * (1.f / 64.f) + EPS);
        const float* w = vec < 8 ? XPAR(P_QNW) + l * 64 : XPAR(P_KNW) + l * 64;
        const float a = x1 * rs * w[d], bb = x2 * rs * w[d + 32];
        const float co = XROPE[((size_t)8192 * 32 + d) * 2], si = XROPE[((size_t)8192 * 32 + d) * 2 + 1];
        const float o1 = a * co - bb * si, o2 = bb * co + a * si;
        if (vec < 8) { qs[vec * 64 + d] = o1 * 0.125f; qs[vec * 64 + 32 + d] = o2 * 0.125f; } else { kn[(vec - 8) * 64 + d] = o1; kn[(vec - 8) * 64 + 32 + d] = o2; }
    }
    __syncthreads();
    {
        float* ko = X.out + O_SK + lb * 16384; float* vo = X.out + O_SV + lb * 16384;
#pragma unroll
        for (int it = 0; it < 8; ++it) {
            const int e = (tid + it * NT) * 4, j = e >> 7, r = e & 127;
            f32x4 kv = kpre[it], vv = vpre[it];
            if (j == 127) { kv = (f32x4){kn[r], kn[r + 1], kn[r + 2], kn[r + 3]}; vv = (f32x4){uf[C_CV + r], uf[C_CV + r + 1], uf[C_CV + r + 2], uf[C_CV + r + 3]}; }
            *(f32x4*)(ko + e) = kv; *(f32x4*)(vo + e) = vv;
            u32x2 wk, wv2; wk[0] = pk2(kv[0], kv[1]); wk[1] = pk2(kv[2], kv[3]); wv2[0] = pk2(vv[0], vv[1]); wv2[1] = pk2(vv[2], vv[3]);
            *(LAS u32x2*)(Kl + ((j * 136 + r) << 1)) = wk; *(LAS u32x2*)(Vl + ((j * 136 + r) << 1)) = wv2;
        }
    }
    __syncthreads();
    if (tid < 256) {
        const int kvh = tid >> 7, jj = tid & 127;
        float s0 = 0.f, s1 = 0.f, s2 = 0.f, s3 = 0.f;
#pragma unroll 2
        for (int d8 = 0; d8 < 8; ++d8) {
            float kf[8]; unpack8(*(const LAS u32x4*)(Kl + ((jj * 136 + kvh * 64 + d8 * 8) << 1)), kf);
#pragma unroll
            for (int j = 0; j < 8; ++j) {
                s0 += kf[j] * qs[(kvh * 4 + 0) * 64 + d8 * 8 + j]; s1 += kf[j] * qs[(kvh * 4 + 1) * 64 + d8 * 8 + j];
                s2 += kf[j] * qs[(kvh * 4 + 2) * 64 + d8 * 8 + j]; s3 += kf[j] * qs[(kvh * 4 + 3) * 64 + d8 * 8 + j];
            }
        }
        sc[(kvh * 4 + 0) * 128 + jj] = s0; sc[(kvh * 4 + 1) * 128 + jj] = s1; sc[(kvh * 4 + 2) * 128 + jj] = s2; sc[(kvh * 4 + 3) * 128 + jj] = s3;
    }
    __syncthreads();
    {
        const int hq = wave; const float s0 = sc[hq * 128 + lane], s1 = sc[hq * 128 + 64 + lane], sink = XPAR(P_SINK)[l * 8 + hq];
        const float m = fmaxf(wave_max(fmaxf(s0, s1)), sink);
        const float e0 = __expf(s0 - m), e1 = __expf(s1 - m);
        const float inv = 1.f / (wave_sum(e0 + e1) + __expf(sink - m));
        sc[hq * 128 + lane] = e0 * inv; sc[hq * 128 + 64 + lane] = e1 * inv;
    }
    __syncthreads();
    {
        const int hq = tid >> 6, d = tid & 63, kvh = hq >> 2;
        float o = 0.f;
#pragma unroll 16
        for (int jj = 0; jj < 128; ++jj) o += sc[hq * 128 + jj] * bf2f(*(const LAS bf16_t*)(Vl + ((jj * 136 + kvh * 64 + d) << 1)));
        XMIX[row * DMIX + 1024 + tid] = (bf16_t)f2bf(o * siluf_(uf[C_CZ + tid]));
    }
    }
    __syncthreads();
}

__device__ __forceinline__ void scans(const Ctx& X, int l, int gt, int nthreads) {
    for (int item = gt; item < 98816; item += nthreads) {
        if (item < 32768) {
            const int nh = item >> 12, e = (item & 4095) * 2;
            float* base = XMC + (size_t)nh * 128 * 8192 + e;
            const float* ml = XML + nh * 128; const float* bl = XBL + nh * 128;
            float m = 0.f; f32x2 st = {0.f, 0.f};
            for (int c0 = 0; c0 < 128; c0 += 8) {
                f32x2 cl[8];
#pragma unroll
                for (int j = 0; j < 8; ++j) cl[j] = *(const f32x2*)(base + (size_t)(c0 + j) * 8192);
#pragma unroll
                for (int j = 0; j < 8; ++j) {
                    const float mlj = ml[c0 + j], blj = bl[c0 + j], mn = fmaxf(blj + m, mlj), sp = __expf(blj + m - mn), sl = __expf(mlj - mn);
                    *(unsigned*)(XCSB + ((size_t)nh * 128 + c0 + j) * 8192 + e) = pk2(st[0], st[1]);
                    if (e == 0) XMS[nh * 128 + c0 + j] = m;
                    st = st * sp + cl[j] * sl; m = mn;
                }
            }
            *(f32x2*)(X.out + O_PC + ((size_t)l * 8 + nh) * 8192 + e) = st;
            if (e == 0) X.out[O_PM + l * 8 + nh] = m;
        } else if (item < 98304) {
            const int i1 = item - 32768, nhh = i1 >> 12, e = (i1 & 4095) * 2;
            float* base = XSH + (size_t)nhh * 128 * 8192 + e;
            const float* al = XSA + nhh * 128;
            f32x2 st = {0.f, 0.f};
            for (int c0 = 0; c0 < 128; c0 += 8) {
                f32x2 cl[8];
#pragma unroll
                for (int j = 0; j < 8; ++j) cl[j] = *(const f32x2*)(base + (size_t)(c0 + j) * 8192);
#pragma unroll
                for (int j = 0; j < 8; ++j) {
                    const float dec = __expf(al[c0 + j]);
                    *(unsigned*)(XHSB + ((size_t)nhh * 128 + c0 + j) * 8192 + e) = pk2(st[0], st[1]);
                    st = st * dec + cl[j];
                }
            }
            *(f32x2*)(X.out + O_PH + ((size_t)l * 16 + nhh) * 8192 + e) = st;
        } else {
            const int i2 = item - 98304, nh = i2 >> 6, k = i2 & 63;
            float* base = XMN + (size_t)nh * 128 * 64 + k;
            const float* ml = XML + nh * 128; const float* bl = XBL + nh * 128;
            float m = 0.f, st = 0.f;
            for (int c = 0; c < 128; ++c) {
                const float mlj = ml[c], blj = bl[c], mn = fmaxf(blj + m, mlj), sp = __expf(blj + m - mn), sl = __expf(mlj - mn);
                const float cl = base[c * 64];
                XNS[(size_t)nh * 128 * 64 + c * 64 + k] = st;
                st = st * sp + cl * sl; m = mn;
            }
            X.out[O_PN + ((size_t)l * 8 + nh) * 64 + k] = st;
        }
    }
}

__device__ __forceinline__ void mlstm_out(lptr lds, const Ctx& X, int l, int task, int tid) {
    const int h = task & 3, c = (task >> 2) & 127, n = task >> 9;
    const int lane = tid & 63, wave = tid >> 6, fr = lane & 15, fq = lane >> 4;
    const int row0 = n * SEQ + c * 64, nh = n * 4 + h;
    lptr Qs = lds;
    lptr Ks = lds + 9216;
    lptr Vt = lds + 18432;
    lptr Sb = lds + 36864 + wave * 2304;
    LAS float* bv = (LAS float*)(lds + 55296);
    LAS float* dv = bv + 64;
    LAS float* mtv = bv + 128;
    LAS float* siv = bv + 192;
    LAS float* qnv = bv + 256;
    LAS float* ssqp = bv + 384;
    LAS float* nsv = bv + 512;
    const int mti = wave >> 1, half = wave & 1;
    u32x4 csf[2][4];
    {
        const bf16_t* Cs = XCSB + ((size_t)nh * 128 + c) * 8192;
#pragma unroll
        for (int kk = 0; kk < 2; ++kk)
#pragma unroll
            for (int ntl = 0; ntl < 4; ++ntl) csf[kk][ntl] = *(const u32x4*)(Cs + (64 * half + 16 * ntl + fr) * 64 + kk * 32 + fq * 8);
    }
    unsigned short aov[4][4], azv[4][4]; float anw[4];
#pragma unroll
    for (int ntl = 0; ntl < 4; ++ntl) {
        const int v = h * 128 + 64 * half + 16 * ntl + fr;
        anw[ntl] = XPAR(P_ANW)[l * 512 + v];
#pragma unroll
        for (int ii = 0; ii < 4; ++ii) {
            const size_t row = (size_t)row0 + 16 * mti + fq * 4 + ii;
            aov[ntl][ii] = XU[row * NIN + C_AO + v]; azv[ntl][ii] = XU[row * NIN + C_AZ + v];
        }
    }
    u32x4 qraw, kraw, vraw[2];
    {
        const int tok = tid >> 3, k8 = (tid & 7) * 8;
        const bf16_t* ur = XU + (size_t)(row0 + tok) * NIN;
        qraw = *(const u32x4*)(ur + C_AQ + h * 64 + k8); kraw = *(const u32x4*)(ur + C_AK + h * 64 + k8);
#pragma unroll
        for (int it = 0; it < 2; ++it) { const int p = tid + it * NT, tk = p >> 4, v8 = (p & 15) * 8; vraw[it] = *(const u32x4*)(XU + (size_t)(row0 + tk) * NIN + C_AV + h * 128 + v8); }
    }
    if (wave == 0) {
        const bf16_t* ur = XU + (size_t)(row0 + lane) * NIN;
        const float fg = bf2f(ur[C_AF + h]) + XPAR(P_AFB)[l * 4 + h], ig = bf2f(ur[C_AI + h]) + XPAR(P_AIB)[l * 4 + h];
        const float b = wave_scan_sum(logsigf_(fg), lane);
        const float dd = ig - b;
        const float cm = wave_scan_max(dd, lane);
        const float ms = XMS[nh * 128 + c];
        const float mt = b + fmaxf(ms, cm);
        bv[lane] = b; dv[lane] = dd; mtv[lane] = mt; siv[lane] = __expf(b + ms - mt);
        nsv[lane] = XNS[((size_t)nh * 128 + c) * 64 + lane];
    }
    {
        const int tok = tid >> 3, k8 = (tid & 7) * 8;
        *(LAS u32x4*)(Qs + ((tok * 72 + k8) << 1)) = qraw;
        float x[8]; unpack8(kraw, x);
#pragma unroll
        for (int j = 0; j < 8; ++j) x[j] *= 0.125f;
        *(LAS u32x4*)(Ks + ((tok * 72 + k8) << 1)) = pack8(x);
    }
#pragma unroll
    for (int it = 0; it < 2; ++it) {
        const int p = tid + it * NT, tok = p >> 4, v8 = (p & 15) * 8;
        const u32x4 w = vraw[it];
#pragma unroll
        for (int j = 0; j < 8; ++j) *(LAS bf16_t*)(Vt + (((v8 + j) * 72 + tok) << 1)) = (bf16_t)((w[j >> 1] >> ((j & 1) * 16)) & 0xffffu);
    }
    __syncthreads();
    bf16x8 qa[2];
    qa[0] = lds_frag(Qs, 16 * mti + fr, fq * 8, 72); qa[1] = lds_frag(Qs, 16 * mti + fr, 32 + fq * 8, 72);
    {
        float x0[8], x1[8]; unpack8(__builtin_bit_cast(u32x4, qa[0]), x0); unpack8(__builtin_bit_cast(u32x4, qa[1]), x1);
        float d = 0.f;
#pragma unroll
        for (int j = 0; j < 8; ++j) d += x0[j] * nsv[fq * 8 + j] + x1[j] * nsv[32 + fq * 8 + j];
        d += __shfl_xor(d, 16); d += __shfl_xor(d, 32);
        if (fq == 0) qnv[wave * 16 + fr] = d;
    }
    float rsum[4] = {0.f, 0.f, 0.f, 0.f};
#pragma unroll
    for (int ntl = 0; ntl < 4; ++ntl) {
        f32x4 s = {0.f, 0.f, 0.f, 0.f};
        s = mfma16(qa[0], lds_frag(Ks, 16 * ntl + fr, fq * 8, 72), s);
        s = mfma16(qa[1], lds_frag(Ks, 16 * ntl + fr, 32 + fq * 8, 72), s);
#pragma unroll
        for (int ii = 0; ii < 4; ++ii) {
            const int t = 16 * mti + fq * 4 + ii, sidx = 16 * ntl + fr;
            const float wgt = (sidx <= t) ? __expf(bv[t] + dv[sidx] - mtv[t]) : 0.f;
            const float sv = wgt * s[ii];
            rsum[ii] += sv;
            *(LAS bf16_t*)(Sb + (((fq * 4 + ii) * 72 + sidx) << 1)) = (bf16_t)f2bf(sv);
        }
    }
    LDS_FENCE();
    f32x4 acc[4];
#pragma unroll
    for (int ntl = 0; ntl < 4; ++ntl) acc[ntl] = (f32x4){0.f, 0.f, 0.f, 0.f};
#pragma unroll
    for (int kk = 0; kk < 2; ++kk) {
        const bf16x8 a = lds_frag(Sb, fr, kk * 32 + fq * 8, 72);
#pragma unroll
        for (int ntl = 0; ntl < 4; ++ntl) acc[ntl] = mfma16(a, lds_frag(Vt, 64 * half + 16 * ntl + fr, kk * 32 + fq * 8, 72), acc[ntl]);
    }
    {
        const float sia = siv[16 * mti + fr];
#pragma unroll
        for (int kk = 0; kk < 2; ++kk) {
            float x[8]; unpack8(__builtin_bit_cast(u32x4, qa[kk]), x);
#pragma unroll
            for (int j = 0; j < 8; ++j) x[j] *= sia;
            const bf16x8 a = as_frag(pack8(x));
#pragma unroll
            for (int ntl = 0; ntl < 4; ++ntl) acc[ntl] = mfma16(a, as_frag(csf[kk][ntl]), acc[ntl]);
        }
    }
    float hv[4][4], ssl[4];
#pragma unroll
    for (int ii = 0; ii < 4; ++ii) {
        const int t = 16 * mti + fq * 4 + ii;
        const float den = red16(rsum[ii]) + siv[t] * qnv[wave * 16 + fq * 4 + ii];
        const float inv = 1.f / fmaxf(fabsf(den), __expf(-mtv[t]));
        float ss = 0.f;
#pragma unroll
        for (int ntl = 0; ntl < 4; ++ntl) { hv[ntl][ii] = acc[ntl][ii] * inv; ss += hv[ntl][ii] * hv[ntl][ii]; }
        ssl[ii] = red16(ss);
        if (fr == 0) ssqp[t * 2 + half] = ssl[ii];
    }
    __syncthreads();
#pragma unroll
    for (int ii = 0; ii < 4; ++ii) {
        const int t = 16 * mti + fq * 4 + ii;
        const float rs = rsqrtf((ssqp[t * 2] + ssqp[t * 2 + 1]) * (1.f / 128.f) + EPS);
        const size_t row = (size_t)row0 + t;
#pragma unroll
        for (int ntl = 0; ntl < 4; ++ntl) {
            const int v = h * 128 + 64 * half + 16 * ntl + fr;
            const float ao = bf2f(aov[ntl][ii]), az = bf2f(azv[ntl][ii]);
            XMIX[row * DMIX + v] = (bf16_t)f2bf(hv[ntl][ii] * rs * anw[ntl] * sigmoidf_(ao) * siluf_(az));
        }
    }
    __syncthreads();
}

__device__ __forceinline__ void ssd_out(lptr lds, const Ctx& X, int l, int task, int tid) {
    const int g = task & 1, c = (task >> 1) & 127, n = task >> 8;
    const int lane = tid & 63, wave = tid >> 6, fr = lane & 15, fq = lane >> 4;
    const int seq0 = n * SEQ, row0 = seq0 + c * 64;
    lptr Cm = lds;
    lptr Bm = lds + 17408;
    lptr Xt = lds + 34816;
    LAS float* CBf = (LAS float*)(lds + 71680);
    LAS float* av = (LAS float*)(lds + 89088);
    LAS float* dtv = (LAS float*)(lds + 90112);
    LAS float* ssq = (LAS float*)(lds + 91136);
    const int hl = wave >> 1, th = wave & 1, hh = 4 * g + hl;
    u32x4 hsf[4][4];
    {
        const bf16_t* hs = XHSB + ((size_t)(n * 8 + hh) * 128 + c) * 8192;
#pragma unroll
        for (int kk = 0; kk < 4; ++kk)
#pragma unroll
            for (int ntl = 0; ntl < 4; ++ntl) hsf[kk][ntl] = *(const u32x4*)(hs + (16 * ntl + fr) * 128 + kk * 32 + fq * 8);
    }
    if (wave < 4) {
        const int hh = 4 * g + wave;
        const float dt = softplusf_(bf2f(XU[(size_t)(row0 + lane) * NIN + C_BDT + hh]) + XPAR(P_DTB)[l * 8 + hh]);
        const float A = -__expf(XPAR(P_ALOG)[l * 8 + hh]);
        av[wave * 64 + lane] = wave_scan_sum(dt * A, lane);
        dtv[wave * 64 + lane] = dt;
    }
    {
        const float* cw = XPAR(P_CW) + l * 4096; const float* cb = XPAR(P_CB) + l * 1024;
        const int cg = lane;
        const int ch = cg < 32 ? g * 256 + cg * 8 : (cg < 48 ? 512 + g * 128 + (cg - 32) * 8 : 768 + g * 128 + (cg - 48) * 8);
        float o[8][8];
        conv8x8(XU, seq0, c * 64 + 8 * wave, ch, cw, cb, o);
        if (cg < 32) {
#pragma unroll
            for (int jx = 0; jx < 8; ++jx) {
                float v[8];
#pragma unroll
                for (int t = 0; t < 8; ++t) v[t] = o[t][jx];
                *(LAS u32x4*)(Xt + (((cg * 8 + jx) * 72 + 8 * wave) << 1)) = pack8(v);
            }
        } else {
            lptr dstm = cg < 48 ? Bm : Cm; const int s8 = (cg < 48 ? cg - 32 : cg - 48) * 8;
#pragma unroll
            for (int t = 0; t < 8; ++t) *(LAS u32x4*)(dstm + (((8 * wave + t) * 136 + s8) << 1)) = pack8(o[t]);
        }
    }
    __syncthreads();
    unsigned short bzv[2][4][4]; float bnw[4];
#pragma unroll
    for (int ntl = 0; ntl < 4; ++ntl) {
        bnw[ntl] = XPAR(P_BNW)[l * 512 + hh * 64 + 16 * ntl + fr];
#pragma unroll
        for (int mi = 0; mi < 2; ++mi)
#pragma unroll
            for (int ii = 0; ii < 4; ++ii) bzv[mi][ntl][ii] = XU[((size_t)row0 + 16 * (2 * th + mi) + fq * 4 + ii) * NIN + C_BZ + hh * 64 + 16 * ntl + fr];
    }
    {
        const int mt = wave >> 1;
#pragma unroll
        for (int q = 0; q < 2; ++q) {
            const int ntl = 2 * (wave & 1) + q;
            f32x4 acc = {0.f, 0.f, 0.f, 0.f};
#pragma unroll
            for (int kk = 0; kk < 4; ++kk) acc = mfma16(lds_frag(Cm, 16 * mt + fr, kk * 32 + fq * 8, 136), lds_frag(Bm, 16 * ntl + fr, kk * 32 + fq * 8, 136), acc);
#pragma unroll
            for (int ii = 0; ii < 4; ++ii) CBf[(16 * mt + fq * 4 + ii) * 68 + 16 * ntl + fr] = acc[ii];
        }
    }
    __syncthreads();
    f32x4 y1[2][4], y2[2][4];
#pragma unroll
    for (int mi = 0; mi < 2; ++mi)
#pragma unroll
        for (int ntl = 0; ntl < 4; ++ntl) { y1[mi][ntl] = (f32x4){0.f, 0.f, 0.f, 0.f}; y2[mi][ntl] = (f32x4){0.f, 0.f, 0.f, 0.f}; }
#pragma unroll
    for (int kk = 0; kk < 2; ++kk) {
        bf16x8 bx[4];
#pragma unroll
        for (int ntl = 0; ntl < 4; ++ntl) bx[ntl] = lds_frag(Xt, hl * 64 + 16 * ntl + fr, kk * 32 + fq * 8, 72);
#pragma unroll
        for (int mi = 0; mi < 2; ++mi) {
            const int t = 16 * (2 * th + mi) + fr, u0 = kk * 32 + fq * 8;
            const float at = av[hl * 64 + t];
            float w[8];
#pragma unroll
            for (int j = 0; j < 8; ++j) {
                const int uu = u0 + j;
                w[j] = (uu <= t) ? CBf[t * 68 + uu] * __expf(at - av[hl * 64 + uu]) * dtv[hl * 64 + uu] : 0.f;
            }
            const bf16x8 a = as_frag(pack8(w));
#pragma unroll
            for (int ntl = 0; ntl < 4; ++ntl) y1[mi][ntl] = mfma16(a, bx[ntl], y1[mi][ntl]);
        }
    }
    {
#pragma unroll
        for (int kk = 0; kk < 4; ++kk) {
            bf16x8 bh[4];
#pragma unroll
            for (int ntl = 0; ntl < 4; ++ntl) bh[ntl] = as_frag(hsf[kk][ntl]);
#pragma unroll
            for (int mi = 0; mi < 2; ++mi) {
                const bf16x8 a = lds_frag(Cm, 16 * (2 * th + mi) + fr, kk * 32 + fq * 8, 136);
#pragma unroll
                for (int ntl = 0; ntl < 4; ++ntl) y2[mi][ntl] = mfma16(a, bh[ntl], y2[mi][ntl]);
            }
        }
    }
    const float Dh = XPAR(P_BD)[l * 8 + hh];
#pragma unroll
    for (int mi = 0; mi < 2; ++mi)
#pragma unroll
        for (int ii = 0; ii < 4; ++ii) {
            const int t = 16 * (2 * th + mi) + fq * 4 + ii;
            const float ea = __expf(av[hl * 64 + t]);
            const size_t row = (size_t)row0 + t;
            float ss = 0.f;
#pragma unroll
            for (int ntl = 0; ntl < 4; ++ntl) {
                const int p = 16 * ntl + fr;
                const float xv = bf2f(*(const LAS bf16_t*)(Xt + (((hl * 64 + p) * 72 + t) << 1)));
                const float y = y1[mi][ntl][ii] + ea * y2[mi][ntl][ii] + Dh * xv;
                const float gbv = y * siluf_(bf2f(bzv[mi][ntl][ii]));
                y1[mi][ntl][ii] = gbv; ss += gbv * gbv;
            }
            ss = red16(ss);
            if (fr == 0) ssq[t * 4 + hl] = ss;
        }
    __syncthreads();
#pragma unroll
    for (int mi = 0; mi < 2; ++mi)
#pragma unroll
        for (int ii = 0; ii < 4; ++ii) {
            const int t = 16 * (2 * th + mi) + fq * 4 + ii;
            const float rs = rsqrtf((ssq[t * 4] + ssq[t * 4 + 1] + ssq[t * 4 + 2] + ssq[t * 4 + 3]) * (1.f / 256.f) + EPS);
            const size_t row = (size_t)row0 + t;
#pragma unroll
            for (int ntl = 0; ntl < 4; ++ntl) {
                const int p = hh * 64 + 16 * ntl + fr;
                XMIX[row * DMIX + 512 + p] = (bf16_t)f2bf(y1[mi][ntl][ii] * rs * bnw[ntl]);
            }
        }
    __syncthreads();
}


#define XB_TMO      128
#define XB_XCNT(j)  (256  + 64 * (j))
#define XB_XSUB(j)  (1280 + 64 * (j))
#define XB_XGEN(j)  (2304 + 64 * (j))
#define XB_TOP      3328
#define XB_TOPGEN   3392
#define XCD_BAR_WORDS 3456
#define XB_SPIN_CAP (1u << 18)
__device__ __forceinline__ unsigned xb_ld(unsigned* p)              { return __hip_atomic_load(p, __ATOMIC_RELAXED, __HIP_MEMORY_SCOPE_AGENT); }
__device__ __forceinline__ unsigned xb_add(unsigned* p, unsigned v) { return __hip_atomic_fetch_add(p, v, __ATOMIC_RELAXED, __HIP_MEMORY_SCOPE_AGENT); }
__device__ __forceinline__ unsigned xb_xcc_id() { return (unsigned)__builtin_amdgcn_s_getreg((3 << 11) | 20) & 0xFu; }
#define XB_SPIN(cond, bar) do { unsigned _sp = 0; while (cond) { __builtin_amdgcn_s_sleep(1); \
    if ((++_sp & 255u) == 0u) { if (xb_ld(&(bar)[XB_TMO])) break; if (_sp > XB_SPIN_CAP) { atomicAdd(&(bar)[XB_TMO], 1u); break; } } } } while (0)
struct XcdBarrier { unsigned* bar; unsigned x; volatile LAS unsigned* st; };
__device__ __forceinline__ XcdBarrier xcd_barrier_post(unsigned* bar, volatile LAS unsigned* st) {
    XcdBarrier b; b.bar = bar; b.x = xb_xcc_id(); b.st = st;
    if (threadIdx.x == 0) (void)xb_add(&bar[XB_XCNT(b.x)], 1u);
    return b;
}
__device__ __forceinline__ void xcd_barrier_complete(unsigned* bar, unsigned x, unsigned& nloc, unsigned& nx) {
    const unsigned G = gridDim.x * gridDim.y * gridDim.z;
    unsigned sum, cnt, mine, sp = 0u;
    for (;;) {
        sum = 0u; cnt = 0u; mine = 0u;
#pragma unroll
        for (unsigned j = 0; j < 16; ++j) { const unsigned c = xb_ld(&bar[XB_XCNT(j)]); sum += c; cnt += (c > 0u) ? 1u : 0u; mine = (j == x) ? c : mine; }
        if (sum == G) break;
        __builtin_amdgcn_s_sleep(1);
        if ((++sp & 255u) == 0u) { if (xb_ld(&bar[XB_TMO])) break; if (sp > XB_SPIN_CAP) { atomicAdd(&bar[XB_TMO], 1u); break; } }
    }
    nloc = mine > 0u ? mine : 1u; nx = cnt > 0u ? cnt : 1u;
}
__device__ __forceinline__ void xcd_barrier(const XcdBarrier& b) {
    asm volatile("s_waitcnt vmcnt(0)" ::: "memory");
    __syncthreads();
    if (threadIdx.x == 0) {
        unsigned* bar = b.bar;
        __builtin_amdgcn_s_waitcnt(0);
        unsigned nloc = b.st[0], nx = b.st[1];
        if (nloc == 0u) { xcd_barrier_complete(bar, b.x, nloc, nx); b.st[0] = nloc; b.st[1] = nx; }
        const unsigned old = xb_add(&bar[XB_XSUB(b.x)], 1u);
        const unsigned gen = old / nloc;
        if (old + 1u == (gen + 1u) * nloc) {
            __builtin_amdgcn_fence(__ATOMIC_RELEASE, "agent");
            asm volatile("s_waitcnt vmcnt(0)" ::: "memory");
            const unsigned og = xb_add(&bar[XB_TOP], 1u);
            const unsigned tg = og / nx;
            if (og + 1u == (tg + 1u) * nx) xb_add(&bar[XB_TOPGEN], 1u);
            else XB_SPIN(xb_ld(&bar[XB_TOPGEN]) == tg, bar);
            __builtin_amdgcn_fence(__ATOMIC_ACQUIRE, "agent");
            xb_add(&bar[XB_XGEN(b.x)], 1u);
            asm volatile("s_waitcnt vmcnt(0)" ::: "memory");
        } else {
            XB_SPIN(xb_ld(&bar[XB_XGEN(b.x)]) == gen, bar);
            __builtin_amdgcn_fence(__ATOMIC_ACQUIRE, "agent");
            asm volatile("s_waitcnt vmcnt(0)" ::: "memory");
        }
    }
    __syncthreads();
}

__global__ void __launch_bounds__(NT, 2) mega(Args args) {
    __shared__ __attribute__((aligned(16))) unsigned char lds_raw[LDS_BYTES];
    lptr lds = (lptr)lds_raw;
    cg::grid_group grid = cg::this_grid();
    const int tid = threadIdx.x, bid = blockIdx.x, G = gridDim.x;
    Ctx X;
    X.xp = args.in[IN_XP]; X.xs = args.in[IN_XS]; X.stC = args.in[IN_STC]; X.stN = args.in[IN_STN]; X.stM = args.in[IN_STM]; X.ssm = args.in[IN_SSM];
    X.conv = args.in[IN_CONV]; X.ck = args.in[IN_CK]; X.cv = args.in[IN_CV]; X.out = args.out; X.ws = args.ws;
    const int lo = args.ph_lo, hi = args.ph_hi;
    volatile LAS unsigned* xst = (volatile LAS unsigned*)(lds + LDS_BYTES - 16);
    if (tid == 0) { xst[0] = 0u; xst[1] = 0u; }
    __syncthreads();
    XcdBarrier xbar = xcd_barrier_post((unsigned*)(args.ws + WS_BAR), xst);
#define IN(k) (lo <= (k) && (k) < hi)
#define SEAM(k) do { if (IN(k) && IN((k) + 1)) { for (int _r = 0; _r < REP_SYNC; ++_r) { if ((k) == 0) grid.sync(); else xcd_barrier(xbar); } } } while (0)
    if (IN(0)) { for (int _r = 0; _r < REP_P0; ++_r) prologue(lds, X, args, G, bid, tid); }
    SEAM(0);
    for (int l = 0; l < 4; ++l) {
        const int pb = 1 + l * 5;
        if (IN(pb)) for (int _r = 0; _r < REP_P1; ++_r) {
            pg8::Gemm g{XXB, XWIN + (size_t)l * NIN * D, MPAD, NIN, D}; pg8::StaticOrder S; S.init(l == 0 ? MPAD : TP, NIN, G, bid);
            pg8::EpiU E{XU, XSSQ};
            pg8::gemm_phase<pg8::EpiU, pg8::StaticOrder>(lds, g, S, E, OPQ(tid));
        }
        SEAM(pb);
        if (IN(pb + 1)) for (int _r = 0; _r < REP_P2; ++_r) {
            for (int t = bid; t < 256; t += G) for (int _q = 0; _q < RT_SWA; ++_q) swa_prompt(lds, X, l, t, OPQ(tid));
            for (int t = bid; t < 256; t += G) for (int _q = 0; _q < RT_SAMPLE; ++_q) {
                if (t < 128) sample_task(lds, X, l, t, 1, OPQ(tid));
                else { sample_task(lds, X, l, t - 128, 0, OPQ(tid)); sample_task(lds, X, l, t - 128, 2, OPQ(tid)); }
            }
            for (int t = bid; t < 512; t += G) for (int _q = 0; _q < RT_SLOC; ++_q) ssd_local(lds, X, l, t, OPQ(tid));
            for (int t = bid; t < 1024; t += G) for (int _q = 0; _q < RT_MLOC; ++_q) mlstm_local(lds, X, l, t, OPQ(tid));
            if (bid == G - 1) {
                for (int i = tid; i < 2 * 3 * 1024; i += NT) {
                    const int ch = i & 1023, j = (i >> 10) % 3, n = i / 3072;
                    X.out[O_PCONV + (((size_t)l * 2 + n) * 3 + j) * 1024 + ch] = bf2f(XU[(size_t)(n * SEQ + SEQ - 3 + j) * NIN + C_BX + ch]);
                }
            }
        }
        SEAM(pb + 1);
        if (IN(pb + 2)) {
            if (bid >= G - 4) {
                pg8::Gemm g{XMIX, XWOUT + (size_t)l * D * DMIX, MPAD, D, DMIX}; pg8::SampleOrder S{G - 4, 4, bid};
                pg8::EpiResh E{l == 0 ? X.xp : nullptr, X.xs, X.out, XXB, XSSQ};
                pg8::gemm_phase<pg8::EpiResh, pg8::SampleOrder, true>(lds, g, S, E, OPQ(tid));
            }
            for (int _r = 0; _r < REP_P3; ++_r) scans(X, l, bid * NT + OPQ(tid), G * NT);
        }
        SEAM(pb + 2);
        if (IN(pb + 3)) for (int _r = 0; _r < REP_P4; ++_r) {
            for (int task = bid; task < 1536; task += G) {
                if (task < 512) for (int _q = 0; _q < RT_SOUT; ++_q) ssd_out(lds, X, l, task, OPQ(tid));
                else mlstm_out(lds, X, l, task - 512, OPQ(tid));
            }
        }
        SEAM(pb + 3);
        if (IN(pb + 4)) {
            {
                pg8::Gemm g{XMIX, XWOUT + (size_t)l * D * DMIX, MPAD, D, DMIX}; pg8::StaticOrder S; S.init(TP, D, G, bid);
                pg8::EpiRes E{l == 0 ? X.xp : nullptr, X.xs, X.out, XXB, XSSQ};
                pg8::gemm_phase<pg8::EpiRes, pg8::StaticOrder>(lds, g, S, E, OPQ(tid));
            }
            if (l < 3 && bid < 20) {
                pg8::Gemm g{XXB, XWIN + (size_t)(l + 1) * NIN * D, MPAD, NIN, D}; pg8::SampleOrder S{0, 20, bid};
                pg8::EpiUh E{XU, XSSQ};
                pg8::gemm_phase<pg8::EpiUh, pg8::SampleOrder, true>(lds, g, S, E, OPQ(tid));
            }
        }
        SEAM(pb + 4);
    }
#undef IN
#undef SEAM
}

extern "C" void kernel_launch(void* const* d_in, const int* in_sizes, int n_in, void* d_out, int out_size, void* d_ws, size_t ws_size, hipStream_t stream) {
    static int grid_blocks = 0;
    if (!grid_blocks) {
        int dev = 0, cus = 0, per_cu = 0;
        hipGetDevice(&dev);
        hipDeviceGetAttribute(&cus, hipDeviceAttributeMultiprocessorCount, dev);
        hipOccupancyMaxActiveBlocksPerMultiprocessor(&per_cu, mega, NT, 0);
        if (per_cu < 1) { fprintf(stderr, "occupancy query returned %d\n", per_cu); per_cu = 1; }
        grid_blocks = cus * 1;
        if (ws_size < WS_END) fprintf(stderr, "workspace too small: %zu < %zu\n", ws_size, (size_t)WS_END);
    }
    (void)hipMemsetAsync(d_ws, 0, 16384, stream);
    Args a{};
    for (int i = 0; i < 24; ++i) a.in[i] = (const float*)d_in[i];
    a.out = (float*)d_out; a.ws = (unsigned char*)d_ws;
    const int NPH = 21;
#if MULTI_LAUNCH
    for (int p = 0; p < NPH; ++p) {
        a.ph_lo = p; a.ph_hi = p + 1;
        void* kargs[] = {&a};
        hipError_t e = hipLaunchCooperativeKernel((void*)mega, dim3(grid_blocks), dim3(NT), kargs, 0, stream);
        if (e != hipSuccess) fprintf(stderr, "cooperative launch failed: %s (grid %d)\n", hipGetErrorString(e), grid_blocks);
    }
#else
    a.ph_lo = 0; a.ph_hi = NPH;
    void* kargs[] = {&a};
    hipError_t e = hipLaunchCooperativeKernel((void*)mega, dim3(grid_blocks), dim3(NT), kargs, 0, stream);
    if (e != hipSuccess) fprintf(stderr, "cooperative launch failed: %s (grid %d)\n", hipGetErrorString(e), grid_blocks);
#endif
}
```

```cpp
#include <hip/hip_runtime.h>
#include <hip/hip_cooperative_groups.h>
#include <cstdio>
#include <cstdint>
namespace cg = cooperative_groups;

#ifndef REP_SYNC
#define REP_SYNC 1
#endif
#ifndef REP_P1
#define REP_P1 1
#endif
#ifndef REP_P2
#define REP_P2 1
#endif
#ifndef REP_P3
#define REP_P3 1
#endif
#ifndef REP_P0
#define REP_P0 1
#endif
#ifndef REP_P4
#define REP_P4 1
#endif
#ifndef RT_SAMPLE
#define RT_SAMPLE 1
#endif
#ifndef RT_SWA
#define RT_SWA 1
#endif
#ifndef RT_SLOC
#define RT_SLOC 1
#endif
#ifndef RT_MLOC
#define RT_MLOC 1
#endif
#ifndef RT_SOUT
#define RT_SOUT 1
#endif
#ifndef MULTI_LAUNCH
#define MULTI_LAUNCH 0
#endif

#define LAS __attribute__((address_space(3)))
typedef unsigned short bf16_t;
typedef short bf16x8 __attribute__((ext_vector_type(8)));
typedef float f32x4 __attribute__((ext_vector_type(4)));
typedef float f32x2 __attribute__((ext_vector_type(2)));
typedef unsigned u32x4 __attribute__((ext_vector_type(4)));
typedef unsigned u32x2 __attribute__((ext_vector_type(2)));
typedef __bf16 bf16x2_t __attribute__((ext_vector_type(2)));
typedef LAS unsigned char* lptr;

constexpr int D = 1024, DIN = 4880, NIN = 5120, DMIX = 1536, TP = 16384, MTOK = 16512, MPAD = 16640, SEQ = 8192;
constexpr int C_AQ = 0, C_AK = 256, C_AV = 512, C_AO = 1024, C_AZ = 1536, C_AI = 2048, C_AF = 2052, C_BZ = 2056, C_BX = 2568, C_BB = 3080, C_BC = 3336,
              C_BDT = 3592, C_CQ = 3600, C_CK = 4112, C_CV = 4240, C_CZ = 4368;
constexpr float EPS = 1e-6f;
constexpr size_t O_YP = 0, O_YS = 16777216, O_PC = 16908288, O_PN = 17170432, O_PM = 17172480, O_PH = 17172512, O_PCONV = 17696800, O_PK = 17721376,
                 O_PV = 17852448, O_SC = 17983520, O_SN = 34760736, O_SM = 34891808, O_SH = 34893856, O_SCONV = 68448288, O_SK = 70021152, O_SV = 78409760;
constexpr size_t WS_BAR = 0;
constexpr size_t WS_PAR = 16384;
constexpr size_t WS_WIN = WS_PAR + 102400;
constexpr size_t WS_WOUT = WS_WIN + (size_t)4 * NIN * D * 2;
constexpr size_t WS_XB = WS_WOUT + (size_t)4 * D * DMIX * 2;
constexpr size_t WS_U = WS_XB + (size_t)MPAD * D * 2;
constexpr size_t WS_MIX = WS_U + (size_t)MPAD * NIN * 2;
constexpr size_t WS_SSQ = WS_MIX + (size_t)MPAD * DMIX * 2;
constexpr size_t WS_ROPE = WS_SSQ + (size_t)MPAD * 16 * 4;
constexpr size_t WS_MC = WS_ROPE + (size_t)8200 * 64 * 4;
constexpr size_t WS_MN = WS_MC + (size_t)8 * 128 * 8192 * 4;
constexpr size_t WS_ML = WS_MN + (size_t)8 * 128 * 64 * 4;
constexpr size_t WS_BL = WS_ML + 4096;
constexpr size_t WS_MS = WS_BL + 4096;
constexpr size_t WS_SA = WS_MS + 4096;
constexpr size_t WS_SH = WS_SA + 8192;
constexpr size_t WS_CSB = WS_SH + (size_t)16 * 128 * 8192 * 4;
constexpr size_t WS_HSB = WS_CSB + (size_t)8 * 128 * 8192 * 2;
constexpr size_t WS_NS = WS_HSB + (size_t)16 * 128 * 8192 * 2;
constexpr size_t WS_END = WS_NS + (size_t)8 * 128 * 64 * 4;
constexpr int LDS_BYTES = 139264;
constexpr int NT = 512;

struct Args { const float* in[24]; float* out; unsigned char* ws; int ph_lo, ph_hi; };

__device__ __forceinline__ float bf2f(unsigned v) { return __uint_as_float(v << 16); }
__device__ __forceinline__ unsigned pk2(float lo, float hi) { f32x2 v = {lo, hi}; bf16x2_t b = __builtin_convertvector(v, bf16x2_t); return __builtin_bit_cast(unsigned, b); }
__device__ __forceinline__ unsigned f2bf(float f) { return pk2(f, 0.f) & 0xffffu; }
__device__ __forceinline__ void unpack8(u32x4 w, float (&f)[8]) {
#pragma unroll
    for (int i = 0; i < 4; ++i) { f[2 * i] = __uint_as_float(w[i] << 16); f[2 * i + 1] = __uint_as_float(w[i] & 0xffff0000u); }
}
__device__ __forceinline__ u32x4 pack8(const float (&f)[8]) { u32x4 w; w[0] = pk2(f[0], f[1]); w[1] = pk2(f[2], f[3]); w[2] = pk2(f[4], f[5]); w[3] = pk2(f[6], f[7]); return w; }
__device__ __forceinline__ u32x4 pack8v(f32x4 a, f32x4 b) { u32x4 w; w[0] = pk2(a[0], a[1]); w[1] = pk2(a[2], a[3]); w[2] = pk2(b[0], b[1]); w[3] = pk2(b[2], b[3]); return w; }
__device__ __forceinline__ bf16x8 as_frag(u32x4 w) { return __builtin_bit_cast(bf16x8, w); }
__device__ __forceinline__ bf16x8 ldg_f32_frag(const float* p) { f32x4 a = *(const f32x4*)p, b = *(const f32x4*)(p + 4); return as_frag(pack8v(a, b)); }
__device__ __forceinline__ bf16x8 lds_frag(lptr base, int row, int k, int stride) { return *(const LAS bf16x8*)(base + ((row * stride + k) << 1)); }
__device__ __forceinline__ f32x4 mfma16(bf16x8 a, bf16x8 b, f32x4 c) { return __builtin_amdgcn_mfma_f32_16x16x32_bf16(a, b, c, 0, 0, 0); }
__device__ __forceinline__ float sigmoidf_(float x) { return 1.f / (1.f + __expf(-x)); }
__device__ __forceinline__ float siluf_(float x) { return x / (1.f + __expf(-x)); }
__device__ __forceinline__ float softplusf_(float x) { return x > 20.f ? x : log1pf(__expf(x)); }
__device__ __forceinline__ float logsigf_(float x) { return fminf(x, 0.f) - log1pf(__expf(-fabsf(x))); }
__device__ __forceinline__ float wave_scan_sum(float v, int lane) {
#pragma unroll
    for (int o = 1; o < 64; o <<= 1) { float t = __shfl_up(v, o); if (lane >= o) v += t; }
    return v;
}
__device__ __forceinline__ float wave_scan_max(float v, int lane) {
#pragma unroll
    for (int o = 1; o < 64; o <<= 1) { float t = __shfl_up(v, o); if (lane >= o) v = fmaxf(v, t); }
    return v;
}
__device__ __forceinline__ float red16(float v);
__device__ __forceinline__ float red16max(float v);
__device__ __forceinline__ float wave_sum(float v) { v = red16(v); v += __shfl_xor(v, 16); v += __shfl_xor(v, 32); return v; }
__device__ __forceinline__ float wave_max(float v) { v = red16max(v); v = fmaxf(v, __shfl_xor(v, 16)); v = fmaxf(v, __shfl_xor(v, 32)); return v; }
template <int CTRL> __device__ __forceinline__ float dppf(float v) { return __int_as_float(__builtin_amdgcn_update_dpp(0, __float_as_int(v), CTRL, 0xf, 0xf, true)); }
__device__ __forceinline__ float red16(float v) { v += dppf<0xB1>(v); v += dppf<0x4E>(v); v += dppf<0x141>(v); v += dppf<0x140>(v); return v; }
__device__ __forceinline__ float red16max(float v) { v = fmaxf(v, dppf<0xB1>(v)); v = fmaxf(v, dppf<0x4E>(v)); v = fmaxf(v, dppf<0x141>(v)); v = fmaxf(v, dppf<0x140>(v)); return v; }
__device__ __forceinline__ int OPQ(int v) { asm volatile("" : "+v"(v)); return v; }
#define LDS_FENCE() asm volatile("s_waitcnt lgkmcnt(0)" ::: "memory")

namespace pg8 {
constexpr int BM = 256, BK = 64, HALF = 128, HTB = HALF * BK * 2, STAGE_BYTES = 8 * HTB, NXCD = 8, WGM = 8;
__host__ __device__ __forceinline__ int lds_byte(int r, int c) { const int st = (r >> 4) * 2 + (c >> 5), rr = r & 15, cc = c & 31, ob = rr * 64 + cc * 2; return st * 1024 + (ob ^ (((ob >> 9) & 1) << 5)); }
__host__ __device__ __forceinline__ void stage_rc(int b, int& R, int& C) { const int st = b / 1024, sb = b % 1024, swz = sb ^ (((sb >> 9) & 1) << 5); R = (st >> 1) * 16 + swz / 64; C = (st & 1) * 32 + (swz % 64) / 2; }
__host__ __device__ __forceinline__ int perm32(int rho) { const int n = rho >> 4, i = rho & 15; return 8 * (i >> 2) + 4 * n + (i & 3); }
struct Unit { int pm, pn; };
struct Gemm { const bf16_t* A; const bf16_t* Bt; int M, N, K; };
struct StaticOrder {
    int nM, nN, nwg, G, c;
    __device__ void init(int M, int N, int G_, int c_) { nM = M / BM; nN = N / BM; nwg = nM * nN; G = G_; c = c_; }
    __device__ bool next(int i, Unit& u) const {
        const long L = (long)i * G + c; if (L >= nwg) return false;
        int wgid = (int)L; { const int q = nwg / NXCD, r = nwg % NXCD, xcd = wgid % NXCD, off = wgid / NXCD; wgid = (xcd < r ? xcd * (q + 1) : r * (q + 1) + (xcd - r) * q) + off; }
        const int nig = WGM * nN, gid = wgid / nig, fm = gid * WGM, gsz = (nM - fm) < WGM ? (nM - fm) : WGM;
        u.pm = fm + ((wgid % nig) % gsz); u.pn = (wgid % nig) / gsz; return true;
    }
};
template <int NAI> struct EpiU_ {
    bf16_t* U; const float* ssq;
    __device__ __forceinline__ void operator()(const f32x4 (&acc)[2][2][4][2], const Unit& u, int wr, int wc, int fr, int fq) const {
        const int row0 = u.pm * BM + wr * 64 + fr, col0 = u.pn * BM + wc * 32 + 8 * fq;
#pragma unroll
        for (int ai = 0; ai < NAI; ++ai)
#pragma unroll
            for (int m = 0; m < 4; ++m) {
                const int r = row0 + ai * HALF + m * 16;
                const f32x4 s = *(const f32x4*)(ssq + (size_t)r * 16 + fq * 4);
                float st = s[0] + s[1] + s[2] + s[3]; st += __shfl_xor(st, 16); st += __shfl_xor(st, 32);
                const float rs = rsqrtf(st * (1.f / 1024.f) + EPS);
                bf16_t* rowp = U + (size_t)r * NIN + col0;
#pragma unroll
                for (int bj = 0; bj < 2; ++bj) *(u32x4*)(rowp + bj * HALF) = pack8v(acc[ai][bj][m][0] * rs, acc[ai][bj][m][1] * rs);
                __builtin_amdgcn_sched_barrier(0);
            }
    }
};
template <int NAI, int MODE> struct EpiRes_ {
    const float* xp; const float* xs; float* out; bf16_t* xb; float* ssq;
    __device__ __forceinline__ void operator()(const f32x4 (&acc)[2][2][4][2], const Unit& u, int wr, int wc, int fr, int fq) const {
        const int row0 = u.pm * BM + wr * 64 + fr, col0 = u.pn * BM + wc * 32 + 8 * fq;
#pragma unroll
        for (int ai = 0; ai < NAI; ++ai)
#pragma unroll
            for (int m = 0; m < 4; ++m) {
                const int r = row0 + ai * HALF + m * 16;
                const bool valid = r < MTOK;
                float part = 0.f;
#pragma unroll
                for (int bj = 0; bj < 2; ++bj) {
                    const int c = col0 + bj * HALF;
                    f32x4 o0 = {0.f, 0.f, 0.f, 0.f}, o1 = {0.f, 0.f, 0.f, 0.f};
                    if (MODE == 0) {
                        const float* src = r < TP ? xp + (size_t)r * D : xs + (size_t)(r - TP) * D;
                        if (valid) { o0 = *(const f32x4*)(src + c); o1 = *(const f32x4*)(src + c + 4); }
                    } else {
                        float f[8]; unpack8(*(const u32x4*)(xb + (size_t)r * D + c), f);
                        o0 = (f32x4){f[0], f[1], f[2], f[3]}; o1 = (f32x4){f[4], f[5], f[6], f[7]};
                    }
                    const f32x4 v0 = acc[ai][bj][m][0] + o0, v1 = acc[ai][bj][m][1] + o1;
                    if (MODE == 2) {
                        if (valid) { *(f32x4*)(out + (size_t)r * D + c) = v0; *(f32x4*)(out + (size_t)r * D + c + 4) = v1; }
                    } else {
                        *(u32x4*)(xb + (size_t)r * D + c) = pack8v(v0, v1);
                        part += v0[0] * v0[0] + v0[1] * v0[1] + v0[2] * v0[2] + v0[3] * v0[3] + v1[0] * v1[0] + v1[1] * v1[1] + v1[2] * v1[2] + v1[3] * v1[3];
                    }
                }
                if (MODE != 2) {
                    part += __shfl_xor(part, 16); part += __shfl_xor(part, 32);
                    if (fq == 0) ssq[(size_t)r * 16 + u.pn * 4 + wc] = part;
                }
                __builtin_amdgcn_sched_barrier(0);
            }
    }
};

typedef EpiU_<2> EpiU; typedef EpiU_<1> EpiUh;
struct SampleOrder {
    int first, cnt, c;
    __device__ bool next(int i, Unit& u) const { if (i != 0 || c < first || c >= first + cnt) return false; u.pm = 64; u.pn = c - first; return true; }
};
template <class Epi, class Sched, bool HALF_M = false>
__device__ __forceinline__ void gemm_phase(lptr lds, const Gemm g, const Sched& S, const Epi& E, const int tid) {
    const int wid = __builtin_amdgcn_readfirstlane(tid >> 6), lane = tid & 63, wr = wid >> 2, wc = wid & 3, fr = lane & 15, fq = lane >> 4;
    const int K = g.K, nt = K / BK;
    unsigned voffA[2], voffB[2];
#pragma unroll
    for (int i = 0; i < 2; ++i) { int R, C; stage_rc(tid * 16 + i * 8192, R, C); const int Rb = (R & ~31) + perm32(R & 31);
        voffA[i] = (unsigned)(R * K + C) * 2u; voffB[i] = (unsigned)(Rb * K + C) * 2u; }
    const size_t kstep = (size_t)(BK * 2);
    const size_t hstep = (size_t)HALF * K * 2;
    const size_t tstep = 2 * hstep;
    const unsigned ldsw = (unsigned)wid * 1024u;
    const int aoff = lds_byte(wr * 64 + fr, fq * 8), boff = lds_byte(wc * 32 + fr, fq * 8);
#define PG8_SA(b, h) (((b) * 2 + (h)) * HTB)
#define PG8_SB(b, h) ((4 + (b) * 2 + (h)) * HTB)
#define PG8_STAGE(bufoff, gbase, voff) do { _Pragma("unroll") for (int _i = 0; _i < 2; ++_i) \
        __builtin_amdgcn_global_load_lds((const unsigned*)((const char*)(gbase) + (voff)[_i]), (LAS unsigned*)(lds + (bufoff) + ldsw + _i * 8192), 16, 0, 0); } while (0)
#define PG8_LDA(dst, b, h) do { _Pragma("unroll") for (int m = 0; m < 4; ++m) _Pragma("unroll") for (int k = 0; k < 2; ++k) dst[m][k] = *(const LAS bf16x8*)(lds + PG8_SA(b, h) + aoff + m * 2048 + k * 1024); } while (0)
#define PG8_LDB(dst, b, h) do { _Pragma("unroll") for (int n = 0; n < 2; ++n) _Pragma("unroll") for (int k = 0; k < 2; ++k) dst[n][k] = *(const LAS bf16x8*)(lds + PG8_SB(b, h) + boff + n * 2048 + k * 1024); } while (0)
#define PG8_MMA(ai, bj, At, Bt) do { __builtin_amdgcn_s_setprio(1); _Pragma("unroll") for (int m = 0; m < 4; ++m) _Pragma("unroll") for (int n = 0; n < 2; ++n) _Pragma("unroll") for (int k = 0; k < 2; ++k) \
        acc[ai][bj][m][n] = __builtin_amdgcn_mfma_f32_16x16x32_bf16(Bt[n][k], At[m][k], acc[ai][bj][m][n], 0, 0, 0); __builtin_amdgcn_s_setprio(0); } while (0)
#define PG8_WAIT_V(n) asm volatile("s_waitcnt vmcnt(" #n ")" ::: "memory")
#define PG8_WAIT_L(n) asm volatile("s_waitcnt lgkmcnt(" #n ")" ::: "memory")
#define PG8_BAR __builtin_amdgcn_s_barrier()
#define PG8_SCHED __builtin_amdgcn_sched_barrier(0)
    Unit cur, nxt; int ui = 0;
    if (!S.next(0, cur)) return;
    f32x4 acc[2][2][4][2];
#pragma unroll
    for (int a = 0; a < 2; ++a)
#pragma unroll
        for (int b = 0; b < 2; ++b)
#pragma unroll
            for (int m = 0; m < 4; ++m)
#pragma unroll
                for (int n = 0; n < 2; ++n) acc[a][b][m][n] = (f32x4){0.f, 0.f, 0.f, 0.f};
    bf16x8 At[4][2], B0[2][2], B1[2][2];
    const char* cA = (const char*)g.A + (size_t)cur.pm * tstep; const char* cB = (const char*)g.Bt + (size_t)cur.pn * tstep;
    PG8_STAGE(PG8_SB(0, 0), cB, voffB); PG8_STAGE(PG8_SA(0, 0), cA, voffA); PG8_STAGE(PG8_SB(0, 1), cB + hstep, voffB); PG8_STAGE(PG8_SA(0, 1), cA + hstep, voffA);
    if (wr == 1) PG8_BAR;
    PG8_WAIT_V(4); PG8_BAR;
    PG8_STAGE(PG8_SB(1, 0), cB + kstep, voffB); PG8_STAGE(PG8_SA(1, 0), cA + kstep, voffA); PG8_STAGE(PG8_SB(1, 1), cB + hstep + kstep, voffB);
    PG8_WAIT_V(6); PG8_BAR;
    for (;;) {
        const bool has_next = S.next(ui + 1, nxt);
        const char* nA = has_next ? (const char*)g.A + (size_t)nxt.pm * tstep : cA; const char* nB = has_next ? (const char*)g.Bt + (size_t)nxt.pn * tstep : cB;
        for (int t = 0; t < nt; t += 2) {
            const bool last = (t == nt - 2);
            const char* a1 = cA + (size_t)(t + 1) * kstep;
            const char* a2 = last ? nA : cA + (size_t)(t + 2) * kstep; const char* b2 = last ? nB : cB + (size_t)(t + 2) * kstep;
            const char* a3 = a2 + kstep; const char* b3 = b2 + kstep;
            PG8_LDB(B0, 0, 0); PG8_SCHED; PG8_LDA(At, 0, 0); PG8_STAGE(PG8_SA(1, 1), a1 + hstep, voffA);
            PG8_WAIT_L(8); PG8_BAR; PG8_WAIT_L(0); PG8_MMA(0, 0, At, B0); PG8_BAR; PG8_SCHED;
            PG8_LDB(B1, 0, 1); PG8_STAGE(PG8_SB(0, 0), b2, voffB);
            PG8_BAR; PG8_WAIT_L(0); PG8_MMA(0, 1, At, B1); PG8_BAR;
            if constexpr (!HALF_M) PG8_LDA(At, 0, 1);
            PG8_STAGE(PG8_SA(0, 0), a2, voffA);
            PG8_BAR; PG8_WAIT_L(0); if constexpr (!HALF_M) PG8_MMA(1, 0, At, B0); PG8_BAR; PG8_SCHED;
            PG8_STAGE(PG8_SB(0, 1), b2 + hstep, voffB);
            PG8_WAIT_V(6); PG8_BAR; if constexpr (!HALF_M) PG8_MMA(1, 1, At, B1); PG8_BAR;
            PG8_LDB(B0, 1, 0); PG8_SCHED; PG8_LDA(At, 1, 0); PG8_STAGE(PG8_SA(0, 1), a2 + hstep, voffA);
            PG8_WAIT_L(8); PG8_BAR; PG8_WAIT_L(0); PG8_MMA(0, 0, At, B0); PG8_BAR; PG8_SCHED;
            PG8_LDB(B1, 1, 1); PG8_STAGE(PG8_SB(1, 0), b3, voffB);
            PG8_BAR; PG8_WAIT_L(0); PG8_MMA(0, 1, At, B1); PG8_BAR;
            if constexpr (!HALF_M) PG8_LDA(At, 1, 1);
            PG8_STAGE(PG8_SA(1, 0), a3, voffA);
            PG8_BAR; PG8_WAIT_L(0); if constexpr (!HALF_M) PG8_MMA(1, 0, At, B0); PG8_BAR; PG8_SCHED;
            PG8_STAGE(PG8_SB(1, 1), b3 + hstep, voffB);
            PG8_WAIT_V(6); PG8_BAR; if constexpr (!HALF_M) PG8_MMA(1, 1, At, B1); PG8_BAR;
        }
        E(acc, cur, wr, wc, fr, fq);
        if (!has_next) break;
#pragma unroll
        for (int a = 0; a < 2; ++a)
#pragma unroll
            for (int b = 0; b < 2; ++b)
#pragma unroll
                for (int m = 0; m < 4; ++m)
#pragma unroll
                    for (int n = 0; n < 2; ++n) acc[a][b][m][n] = (f32x4){0.f, 0.f, 0.f, 0.f};
        cur = nxt; cA = nA; cB = nB; ++ui;
    }
    PG8_WAIT_V(0);
    if (wr == 0) PG8_BAR;
    PG8_BAR;
#undef PG8_SA
#undef PG8_SB
#undef PG8_STAGE
#undef PG8_LDA
#undef PG8_LDB
#undef PG8_MMA
#undef PG8_WAIT_V
#undef PG8_WAIT_L
#undef PG8_BAR
#undef PG8_SCHED
}
}

struct Ctx {
    const float* xp; const float* xs; const float* stC; const float* stN; const float* stM; const float* ssm; const float* conv; const float* ck; const float* cv;
    float* out; unsigned char* ws;
};
#define XWIN ((bf16_t*)(X.ws + WS_WIN))
#define XWOUT ((bf16_t*)(X.ws + WS_WOUT))
#define XXB ((bf16_t*)(X.ws + WS_XB))
#define XU ((bf16_t*)(X.ws + WS_U))
#define XMIX ((bf16_t*)(X.ws + WS_MIX))
#define XSSQ ((float*)(X.ws + WS_SSQ))
#define XROPE ((float*)(X.ws + WS_ROPE))
#define XMC ((float*)(X.ws + WS_MC))
#define XMN ((float*)(X.ws + WS_MN))
#define XML ((float*)(X.ws + WS_ML))
#define XBL ((float*)(X.ws + WS_BL))
#define XMS ((float*)(X.ws + WS_MS))
#define XSA ((float*)(X.ws + WS_SA))
#define XSH ((float*)(X.ws + WS_SH))
#define XCSB ((bf16_t*)(X.ws + WS_CSB))
#define XNS ((float*)(X.ws + WS_NS))
#define XHSB ((bf16_t*)(X.ws + WS_HSB))
#define XPAR(off) ((const float*)(X.ws + WS_PAR) + (off))
constexpr int P_AIB = 0, P_AFB = 16, P_DTB = 32, P_ALOG = 64, P_BD = 96, P_SINK = 128, P_QNW = 160, P_KNW = 416, P_ANW = 672, P_BNW = 2720, P_CB = 4768, P_CW = 8864, P_END = 25248;
#define IN_XP 0
#define IN_XS 1
#define IN_STC 2
#define IN_STN 3
#define IN_STM 4
#define IN_SSM 5
#define IN_CONV 6
#define IN_CK 7
#define IN_CV 8
#define IN_NORMW 9
#define IN_WIN 10
#define IN_AIB 11
#define IN_AFB 12
#define IN_ANW 13
#define IN_CW 14
#define IN_CB 15
#define IN_DTB 16
#define IN_ALOG 17
#define IN_BD 18
#define IN_BNW 19
#define IN_QNW 20
#define IN_KNW 21
#define IN_SINK 22
#define IN_WOUT 23

__device__ __forceinline__ void transpose_tile(lptr lds, const float* src, int ldn, int nvalid, bf16_t* dst, int ldk, const float* scale, int k0, int n0, int tid) {
    LAS float* T = (LAS float*)lds;
#pragma unroll
    for (int it = 0; it < 2; ++it) {
        const int r = (tid >> 4) + it * 32, c4 = (tid & 15) * 4, n = n0 + c4;
        f32x4 v = {0.f, 0.f, 0.f, 0.f};
        if (n < nvalid) v = *(const f32x4*)(src + (size_t)(k0 + r) * ldn + n);
        const float sc = scale ? scale[k0 + r] : 1.f;
        T[r * 65 + c4 + 0] = v[0] * sc; T[r * 65 + c4 + 1] = v[1] * sc; T[r * 65 + c4 + 2] = v[2] * sc; T[r * 65 + c4 + 3] = v[3] * sc;
    }
    __syncthreads();
    {
        const int n = tid >> 3, k8 = (tid & 7) * 8; float f[8];
#pragma unroll
        for (int j = 0; j < 8; ++j) f[j] = T[(k8 + j) * 65 + n];
        *(u32x4*)(dst + (size_t)(n0 + n) * ldk + k0 + k8) = pack8(f);
    }
    __syncthreads();
}

__device__ __forceinline__ void prologue(lptr lds, const Ctx& X, const Args& args, int G, int bid, int tid) {
    const int lane = tid & 63, wave = tid >> 6;
    constexpr int T0 = 5120, T1 = T0 + 1536, T2 = T1 + 2080, T3 = T2 + 1, T4 = T3 + 513;
    for (int task = bid; task < T4; task += G) {
        if (task < T0) {
            const int l = task / 1280, r = task % 1280, kt = r / 80, ntl = r % 80;
            transpose_tile(lds, args.in[IN_WIN] + (size_t)l * D * DIN, DIN, DIN, XWIN + (size_t)l * NIN * D, D, args.in[IN_NORMW] + l * D, kt * 64, ntl * 64, tid);
        } else if (task < T1) {
            const int t = task - T0, l = t / 384, r = t % 384, kt = r / 16, ntl = r % 16;
            transpose_tile(lds, args.in[IN_WOUT] + (size_t)l * DMIX * D, D, D, XWOUT + (size_t)l * D * DMIX, DMIX, nullptr, kt * 64, ntl * 64, tid);
        } else if (task < T2) {
            const int r = (task - T1) * 8 + wave;
            float ss = 0.f;
            if (r < MTOK) {
                const float* src = r < TP ? X.xp + (size_t)r * D : X.xs + (size_t)(r - TP) * D;
#pragma unroll
                for (int i = 0; i < 4; ++i) {
                    const int c = lane * 4 + i * 256; f32x4 v = *(const f32x4*)(src + c);
                    ss += v[0] * v[0] + v[1] * v[1] + v[2] * v[2] + v[3] * v[3];
                    u32x2 w; w[0] = pk2(v[0], v[1]); w[1] = pk2(v[2], v[3]);
                    *(u32x2*)(XXB + (size_t)r * D + c) = w;
                }
            } else {
#pragma unroll
                for (int i = 0; i < 4; ++i) { u32x2 w = {0u, 0u}; *(u32x2*)(XXB + (size_t)r * D + lane * 4 + i * 256) = w; }
            }
            ss = wave_sum(ss);
            if (lane < 16) XSSQ[(size_t)r * 16 + lane] = (lane == 0) ? ss : 0.f;
        } else if (task < T3) {
            for (int i = tid; i < (MPAD - MTOK) * DMIX / 2; i += NT) ((unsigned*)(XMIX + (size_t)MTOK * DMIX))[i] = 0u;
            float* P = (float*)(X.ws + WS_PAR);
            const int po[12] = {P_AIB, P_AFB, P_DTB, P_ALOG, P_BD, P_SINK, P_QNW, P_KNW, P_ANW, P_BNW, P_CB, P_CW};
            const int pn[12] = {16, 16, 32, 32, 32, 32, 256, 256, 2048, 2048, 4096, 16384};
            const int pi[12] = {IN_AIB, IN_AFB, IN_DTB, IN_ALOG, IN_BD, IN_SINK, IN_QNW, IN_KNW, IN_ANW, IN_BNW, IN_CB, IN_CW};
#pragma unroll
            for (int a = 0; a < 12; ++a) { const float* src = args.in[pi[a]]; for (int i = tid; i < pn[a]; i += NT) P[po[a] + i] = src[i]; }
        } else {
            const int e = (task - T3) * 512 + tid;
            if (e < 8193 * 32) {
                const int pos = e >> 5, d = e & 31;
                const float inv = (float)exp2(-(double)d * (13.287712379549449 / 32.0));
                const float angf = (float)pos * inv;
                const double a = (double)angf;
                const double k = rint(a * 0.15915494309189535);
                const float rr = (float)(a - k * 6.283185307179586);
                XROPE[(size_t)e * 2] = cosf(rr); XROPE[(size_t)e * 2 + 1] = sinf(rr);
            }
        }
    }
}

__device__ __forceinline__ void conv8(const bf16_t* u, int seq0, int tt, int ch, const float* cw, const float* cb, float (&o)[8]) {
    float acc[8];
    { f32x4 b0 = *(const f32x4*)(cb + ch), b1 = *(const f32x4*)(cb + ch + 4);
#pragma unroll
      for (int j = 0; j < 4; ++j) { acc[j] = b0[j]; acc[4 + j] = b1[j]; } }
#pragma unroll
    for (int jj = 0; jj < 4; ++jj) {
        const int t2 = tt + jj - 3;
        if (t2 >= 0) {
            float x[8]; unpack8(*(const u32x4*)(u + (size_t)(seq0 + t2) * NIN + C_BX + ch), x);
            f32x4 w0 = *(const f32x4*)(cw + jj * 1024 + ch), w1 = *(const f32x4*)(cw + jj * 1024 + ch + 4);
#pragma unroll
            for (int j = 0; j < 4; ++j) { acc[j] += x[j] * w0[j]; acc[4 + j] += x[4 + j] * w1[j]; }
        }
    }
#pragma unroll
    for (int j = 0; j < 8; ++j) o[j] = siluf_(acc[j]);
}


__device__ __forceinline__ void conv8x8(const bf16_t* u, int seq0, int tt0, int ch, const float* cw, const float* cb, float (&o)[8][8]) {
    float w[4][8];
#pragma unroll
    for (int jj = 0; jj < 4; ++jj) { f32x4 w0 = *(const f32x4*)(cw + jj * 1024 + ch), w1 = *(const f32x4*)(cw + jj * 1024 + ch + 4);
#pragma unroll
        for (int j = 0; j < 4; ++j) { w[jj][j] = w0[j]; w[jj][4 + j] = w1[j]; } }
    { f32x4 b0 = *(const f32x4*)(cb + ch), b1 = *(const f32x4*)(cb + ch + 4);
#pragma unroll
      for (int t = 0; t < 8; ++t)
#pragma unroll
          for (int j = 0; j < 4; ++j) { o[t][j] = b0[j]; o[t][4 + j] = b1[j]; } }
    u32x4 raw[11];
#pragma unroll
    for (int r = 0; r < 11; ++r) {
        const int t2 = tt0 + r - 3;
        const u32x4 v = *(const u32x4*)(u + (size_t)(seq0 + (t2 >= 0 ? t2 : 0)) * NIN + C_BX + ch);
        const unsigned msk = t2 >= 0 ? 0xffffffffu : 0u;
        raw[r] = (u32x4){v[0] & msk, v[1] & msk, v[2] & msk, v[3] & msk};
    }
#pragma unroll
    for (int r = 0; r < 11; ++r) {
        float x[8]; unpack8(raw[r], x);
#pragma unroll
        for (int jj = 0; jj < 4; ++jj) {
            const int t = r - jj;
            if (t >= 0 && t < 8) {
#pragma unroll
                for (int j = 0; j < 8; ++j) o[t][j] += x[j] * w[jj][j];
            }
        }
    }
#pragma unroll
    for (int t = 0; t < 8; ++t)
#pragma unroll
        for (int j = 0; j < 8; ++j) o[t][j] = siluf_(o[t][j]);
}

__device__ __forceinline__ void mlstm_local(lptr lds, const Ctx& X, int l, int task, int tid) {
    const int h = task & 3, c = (task >> 2) & 127, n = task >> 9;
    const int lane = tid & 63, wave = tid >> 6, fr = lane & 15, fq = lane >> 4;
    const int row0 = n * SEQ + c * 64, nh = n * 4 + h;
    lptr VwT = lds;
    lptr KT = lds + 18432;
    LAS float* wv = (LAS float*)(lds + 27648);
    u32x4 vraw[2], kraw;
#pragma unroll
    for (int it = 0; it < 2; ++it) { const int p = tid + it * NT, tok = p >> 4, v8 = (p & 15) * 8; vraw[it] = *(const u32x4*)(XU + (size_t)(row0 + tok) * NIN + C_AV + h * 128 + v8); }
    { const int tok = tid >> 3, k8 = (tid & 7) * 8; kraw = *(const u32x4*)(XU + (size_t)(row0 + tok) * NIN + C_AK + h * 64 + k8); }
    if (wave == 0) {
        const bf16_t* ur = XU + (size_t)(row0 + lane) * NIN;
        const float fg = bf2f(ur[C_AF + h]) + XPAR(P_AFB)[l * 4 + h], ig = bf2f(ur[C_AI + h]) + XPAR(P_AIB)[l * 4 + h];
        const float b = wave_scan_sum(logsigf_(fg), lane);
        const float bl = __shfl(b, 63);
        const float g = bl - b + ig;
        const float ml = wave_max(g);
        wv[lane] = __expf(g - ml);
        if (lane == 0) { XML[nh * 128 + c] = ml; XBL[nh * 128 + c] = bl; }
    }
    __syncthreads();
#pragma unroll
    for (int it = 0; it < 2; ++it) {
        const int p = tid + it * NT, tok = p >> 4, v8 = (p & 15) * 8;
        float x[8]; unpack8(vraw[it], x);
        const float w = wv[tok];
#pragma unroll
        for (int j = 0; j < 8; ++j) *(LAS bf16_t*)(VwT + (((v8 + j) * 72 + tok) << 1)) = (bf16_t)f2bf(x[j] * w);
    }
    {
        const int tok = tid >> 3, k8 = (tid & 7) * 8;
        float x[8]; unpack8(kraw, x);
#pragma unroll
        for (int j = 0; j < 8; ++j) *(LAS bf16_t*)(KT + (((k8 + j) * 72 + tok) << 1)) = (bf16_t)f2bf(x[j] * 0.125f);
    }
    __syncthreads();
    {
        bf16_t* dst = (bf16_t*)XMC + ((size_t)nh * 128 + c) * 8192;
        bf16x8 b0 = lds_frag(VwT, 16 * wave + fr, fq * 8, 72), b1 = lds_frag(VwT, 16 * wave + fr, 32 + fq * 8, 72);
#pragma unroll
        for (int mt = 0; mt < 4; ++mt) {
            f32x4 acc = {0.f, 0.f, 0.f, 0.f};
            acc = mfma16(lds_frag(KT, 16 * mt + fr, fq * 8, 72), b0, acc);
            acc = mfma16(lds_frag(KT, 16 * mt + fr, 32 + fq * 8, 72), b1, acc);
            { u32x2 w; w[0] = pk2(acc[0], acc[1]); w[1] = pk2(acc[2], acc[3]); *(u32x2*)(dst + (16 * wave + fr) * 64 + 16 * mt + 4 * fq) = w; }
        }
    }
    if (tid < 64) {
        float s = 0.f;
#pragma unroll 8
        for (int t = 0; t < 64; ++t) s += bf2f(*(const LAS bf16_t*)(KT + ((tid * 72 + t) << 1))) * wv[t];
        XMN[((size_t)nh * 128 + c) * 64 + tid] = s;
    }
    __syncthreads();
}

__device__ __forceinline__ void ssd_local(lptr lds, const Ctx& X, int l, int task, int tid) {
    const int g = task & 1, c = (task >> 1) & 127, n = task >> 8;
    const int lane = tid & 63, wave = tid >> 6, fr = lane & 15, fq = lane >> 4;
    const int seq0 = n * SEQ, row0 = seq0 + c * 64;
    lptr XwT = lds;
    lptr BT = lds + 36864;
    LAS float* wl = (LAS float*)(lds + 55296);
    {
        const float* cw = XPAR(P_CW) + l * 4096; const float* cb = XPAR(P_CB) + l * 1024;
        const int cg = lane;
        float o[8][8];
        {
            const int cgc = cg < 48 ? cg : 47;
            const int ch = cgc < 32 ? g * 256 + cgc * 8 : 512 + g * 128 + (cgc - 32) * 8;
            conv8x8(XU, seq0, c * 64 + 8 * wave, ch, cw, cb, o);
        }
    if (wave < 4) {
        const int hh = 4 * g + wave;
        const float dt = softplusf_(bf2f(XU[(size_t)(row0 + lane) * NIN + C_BDT + hh]) + XPAR(P_DTB)[l * 8 + hh]);
        const float A = -__expf(XPAR(P_ALOG)[l * 8 + hh]);
        const float a = wave_scan_sum(dt * A, lane);
        const float aL = __shfl(a, 63);
        wl[wave * 64 + lane] = __expf(aL - a) * dt;
        if (lane == 0) XSA[(n * 8 + hh) * 128 + c] = aL;
    }
    __syncthreads();
        if (cg < 48) {
            if (cg < 32) {
                float wt[8];
#pragma unroll
                for (int t = 0; t < 8; ++t) wt[t] = wl[(cg >> 3) * 64 + 8 * wave + t];
#pragma unroll
                for (int jx = 0; jx < 8; ++jx) {
                    float v[8];
#pragma unroll
                    for (int t = 0; t < 8; ++t) v[t] = o[t][jx] * wt[t];
                    *(LAS u32x4*)(XwT + (((cg * 8 + jx) * 72 + 8 * wave) << 1)) = pack8(v);
                }
            } else {
#pragma unroll
                for (int jx = 0; jx < 8; ++jx) {
                    float v[8];
#pragma unroll
                    for (int t = 0; t < 8; ++t) v[t] = o[t][jx];
                    *(LAS u32x4*)(BT + ((((cg - 32) * 8 + jx) * 72 + 8 * wave) << 1)) = pack8(v);
                }
            }
        }
    }
    __syncthreads();
    {
        const int hl = wave >> 1, ph = wave & 1, hh = 4 * g + hl;
        bf16_t* dst = (bf16_t*)XSH + ((size_t)(n * 8 + hh) * 128 + c) * 8192;
        bf16x8 bx[2][2];
#pragma unroll
        for (int ntl = 0; ntl < 2; ++ntl)
#pragma unroll
            for (int kk = 0; kk < 2; ++kk) bx[ntl][kk] = lds_frag(XwT, hl * 64 + ph * 32 + ntl * 16 + fr, kk * 32 + fq * 8, 72);
#pragma unroll
        for (int mt = 0; mt < 8; ++mt) {
            bf16x8 a0 = lds_frag(BT, 16 * mt + fr, fq * 8, 72), a1 = lds_frag(BT, 16 * mt + fr, 32 + fq * 8, 72);
#pragma unroll
            for (int ntl = 0; ntl < 2; ++ntl) {
                f32x4 acc = {0.f, 0.f, 0.f, 0.f};
                acc = mfma16(a0, bx[ntl][0], acc); acc = mfma16(a1, bx[ntl][1], acc);
                { u32x2 w; w[0] = pk2(acc[0], acc[1]); w[1] = pk2(acc[2], acc[3]); *(u32x2*)(dst + (ph * 32 + ntl * 16 + fr) * 128 + 16 * mt + 4 * fq) = w; }
            }
        }
    }
    __syncthreads();
}

__device__ __forceinline__ void swa_prompt(lptr lds, const Ctx& X, int l, int task, int tid) {
    const int kvh = task & 1, qb = (task >> 1) & 63, n = task >> 7;
    const int lane = tid & 63, wave = tid >> 6, fr = lane & 15, fq = lane >> 4;
    const int seq0 = n * SEQ;
    lptr Kn = lds;
    lptr Vt = lds + 36864;
    lptr Pw = lds + 70656 + wave * 8448;
    const float* knw = XPAR(P_KNW) + l * 64; const float* qnw = XPAR(P_QNW) + l * 64;
#pragma unroll
    for (int it = 0; it < 2; ++it) {
        const int item = tid + it * NT, j = item >> 2, qd = item & 3, t = qb * 128 - 128 + j;
        float o1[8], o2[8];
        {
            const int tc = t >= 0 ? t : 0;
            const bf16_t* kr = XU + (size_t)(seq0 + tc) * NIN + C_CK + kvh * 64;
            float x1[8], x2[8]; unpack8(*(const u32x4*)(kr + qd * 8), x1); unpack8(*(const u32x4*)(kr + 32 + qd * 8), x2);
            float ss = 0.f;
#pragma unroll
            for (int jj = 0; jj < 8; ++jj) ss += x1[jj] * x1[jj] + x2[jj] * x2[jj];
            ss += __shfl_xor(ss, 1); ss += __shfl_xor(ss, 2);
            const float rs = rsqrtf(ss * (1.f / 64.f) + EPS);
            const f32x4* cs = (const f32x4*)(XROPE + ((size_t)tc * 32 + qd * 8) * 2);
            f32x4 csv[4];
#pragma unroll
            for (int q4 = 0; q4 < 4; ++q4) csv[q4] = cs[q4];
            const float zm = t >= 0 ? 1.f : 0.f;
#pragma unroll
            for (int jj = 0; jj < 8; ++jj) {
                const float a = x1[jj] * rs * knw[qd * 8 + jj], b = x2[jj] * rs * knw[32 + qd * 8 + jj], co = csv[jj >> 1][(jj & 1) * 2], si = csv[jj >> 1][(jj & 1) * 2 + 1];
                o1[jj] = (a * co - b * si) * zm; o2[jj] = (b * co + a * si) * zm;
            }
        }
        *(LAS u32x4*)(Kn + ((j * 72 + qd * 8) << 1)) = pack8(o1);
        *(LAS u32x4*)(Kn + ((j * 72 + 32 + qd * 8) << 1)) = pack8(o2);
        if (qb == 63 && j >= 128) {
            float* ko = X.out + O_PK + ((((size_t)l * 2 + n) * 128 + (j - 128)) * 2 + kvh) * 64;
            *(f32x4*)(ko + qd * 8) = (f32x4){o1[0], o1[1], o1[2], o1[3]}; *(f32x4*)(ko + qd * 8 + 4) = (f32x4){o1[4], o1[5], o1[6], o1[7]};
            *(f32x4*)(ko + 32 + qd * 8) = (f32x4){o2[0], o2[1], o2[2], o2[3]}; *(f32x4*)(ko + 32 + qd * 8 + 4) = (f32x4){o2[4], o2[5], o2[6], o2[7]};
        }
    }
#pragma unroll
    for (int it = 0; it < 4; ++it) {
        const int item = tid + it * NT, j = item >> 3, d8 = (item & 7) * 8, t = qb * 128 - 128 + j;
        u32x4 w = *(const u32x4*)(XU + (size_t)(seq0 + (t >= 0 ? t : 0)) * NIN + C_CV + kvh * 64 + d8);
        { const unsigned msk = t >= 0 ? 0xffffffffu : 0u; w = (u32x4){w[0] & msk, w[1] & msk, w[2] & msk, w[3] & msk}; }
#pragma unroll
        for (int jj = 0; jj < 8; ++jj) *(LAS bf16_t*)(Vt + (((d8 + jj) * 264 + j) << 1)) = (bf16_t)((w[jj >> 1] >> ((jj & 1) * 16)) & 0xffffu);
        if (qb == 63 && j >= 128) {
            float x[8]; unpack8(w, x);
            float* vo = X.out + O_PV + ((((size_t)l * 2 + n) * 128 + (j - 128)) * 2 + kvh) * 64 + d8;
            *(f32x4*)(vo) = (f32x4){x[0], x[1], x[2], x[3]}; *(f32x4*)(vo + 4) = (f32x4){x[4], x[5], x[6], x[7]};
        }
    }
    __syncthreads();
    const int hq = kvh * 4 + (wave >> 1), i0 = (wave & 1) * 64;
    const float sink = XPAR(P_SINK)[l * 8 + hq];
    float qw1[8], qw2[8];
#pragma unroll
    for (int jj = 0; jj < 8; ++jj) { qw1[jj] = qnw[fq * 8 + jj]; qw2[jj] = qnw[32 + fq * 8 + jj]; }
    u32x4 qn0, qn1; f32x4 csn[4];
    {
        const int t = qb * 128 + i0 + fr;
        const bf16_t* qr = XU + (size_t)(seq0 + t) * NIN + C_CQ + hq * 64;
        qn0 = *(const u32x4*)(qr + fq * 8); qn1 = *(const u32x4*)(qr + 32 + fq * 8);
        const f32x4* cs = (const f32x4*)(XROPE + ((size_t)t * 32 + fq * 8) * 2);
#pragma unroll
        for (int q4 = 0; q4 < 4; ++q4) csn[q4] = cs[q4];
    }
#pragma unroll 1
    for (int mt = 0; mt < 4; ++mt) {
        const int q0 = i0 + mt * 16;
        const u32x4 q0r = qn0, q1r = qn1; f32x4 csc[4];
#pragma unroll
        for (int q4 = 0; q4 < 4; ++q4) csc[q4] = csn[q4];
        unsigned short czv[4][4];
#pragma unroll
        for (int ii = 0; ii < 4; ++ii)
#pragma unroll
            for (int ntl = 0; ntl < 4; ++ntl) czv[ntl][ii] = XU[((size_t)seq0 + qb * 128 + q0 + fq * 4 + ii) * NIN + C_CZ + hq * 64 + 16 * ntl + fr];
        {
            const int mn = mt < 3 ? mt + 1 : 3;
            const int t = qb * 128 + i0 + mn * 16 + fr;
            const bf16_t* qr = XU + (size_t)(seq0 + t) * NIN + C_CQ + hq * 64;
            qn0 = *(const u32x4*)(qr + fq * 8); qn1 = *(const u32x4*)(qr + 32 + fq * 8);
            const f32x4* cs = (const f32x4*)(XROPE + ((size_t)t * 32 + fq * 8) * 2);
#pragma unroll
            for (int q4 = 0; q4 < 4; ++q4) csn[q4] = cs[q4];
        }
        bf16x8 a0, a1;
        {
            float x1[8], x2[8]; unpack8(q0r, x1); unpack8(q1r, x2);
            float ss = 0.f;
#pragma unroll
            for (int jj = 0; jj < 8; ++jj) ss += x1[jj] * x1[jj] + x2[jj] * x2[jj];
            ss += __shfl_xor(ss, 16); ss += __shfl_xor(ss, 32);
            const float rs = rsqrtf(ss * (1.f / 64.f) + EPS) * 0.125f;
            float o1[8], o2[8];
#pragma unroll
            for (int jj = 0; jj < 8; ++jj) {
                const float a = x1[jj] * rs * qw1[jj], b = x2[jj] * rs * qw2[jj], co = csc[jj >> 1][(jj & 1) * 2], si = csc[jj >> 1][(jj & 1) * 2 + 1];
                o1[jj] = a * co - b * si; o2[jj] = b * co + a * si;
            }
            a0 = as_frag(pack8(o1)); a1 = as_frag(pack8(o2));
        }
        const int tlo = q0 >> 4;
        const int qi = q0 + fr;
        f32x4 s[16];
        float mx = -3.0e38f;
#pragma unroll
        for (int ntl = 0; ntl < 16; ++ntl) {
            if (ntl >= tlo && ntl <= tlo + 8) {
                f32x4 acc = {0.f, 0.f, 0.f, 0.f};
                acc = mfma16(lds_frag(Kn, 16 * ntl + fr, fq * 8, 72), a0, acc);
                acc = mfma16(lds_frag(Kn, 16 * ntl + fr, 32 + fq * 8, 72), a1, acc);
#pragma unroll
                for (int ii = 0; ii < 4; ++ii) {
                    const int jk = 16 * ntl + 4 * fq + ii;
                    const bool valid = (jk > qi) && (jk <= qi + 128) && (qb > 0 || jk >= 128);
                    acc[ii] = valid ? acc[ii] : -3.0e38f;
                    mx = fmaxf(mx, acc[ii]);
                }
                s[ntl] = acc;
            }
        }
        mx = fmaxf(mx, __shfl_xor(mx, 16)); mx = fmaxf(mx, __shfl_xor(mx, 32));
        mx = fmaxf(mx, sink);
        float sum = 0.f;
#pragma unroll
        for (int ntl = 0; ntl < 16; ++ntl) {
            if (ntl >= tlo && ntl <= tlo + 8) {
#pragma unroll
                for (int ii = 0; ii < 4; ++ii) { const float e = (s[ntl][ii] > -1.0e38f) ? __expf(s[ntl][ii] - mx) : 0.f; s[ntl][ii] = e; sum += e; }
            }
        }
        sum += __shfl_xor(sum, 16); sum += __shfl_xor(sum, 32);
        const float inv = 1.f / (sum + __expf(sink - mx));
        const int klo = q0 >> 5, khi = (q0 + 143) >> 5;
#pragma unroll
        for (int ntl = 0; ntl < 16; ++ntl) {
            if (ntl >= tlo && ntl <= tlo + 8) {
                u32x2 w; w[0] = pk2(s[ntl][0] * inv, s[ntl][1] * inv); w[1] = pk2(s[ntl][2] * inv, s[ntl][3] * inv);
                *(LAS u32x2*)(Pw + ((fr * 264 + 16 * ntl + 4 * fq) << 1)) = w;
            } else if ((ntl >> 1) >= klo && (ntl >> 1) <= khi) {
                u32x2 w = {0u, 0u};
                *(LAS u32x2*)(Pw + ((fr * 264 + 16 * ntl + 4 * fq) << 1)) = w;
            }
        }
        LDS_FENCE();
        f32x4 o[4];
#pragma unroll
        for (int ntl = 0; ntl < 4; ++ntl) o[ntl] = (f32x4){0.f, 0.f, 0.f, 0.f};
#pragma unroll
        for (int kk = 0; kk < 8; ++kk) {
            if (kk >= klo && kk <= khi) {
                const bf16x8 a = lds_frag(Pw, fr, kk * 32 + fq * 8, 264);
#pragma unroll
                for (int ntl = 0; ntl < 4; ++ntl) o[ntl] = mfma16(a, lds_frag(Vt, 16 * ntl + fr, kk * 32 + fq * 8, 264), o[ntl]);
            }
        }
        LDS_FENCE();
#pragma unroll
        for (int ii = 0; ii < 4; ++ii) {
            const size_t row = (size_t)seq0 + qb * 128 + q0 + fq * 4 + ii;
#pragma unroll
            for (int ntl = 0; ntl < 4; ++ntl) {
                const int d = 16 * ntl + fr;
                XMIX[row * DMIX + 1024 + hq * 64 + d] = (bf16_t)f2bf(o[ntl][ii] * siluf_(bf2f(czv[ntl][ii])));
            }
        }
    }
    __syncthreads();
}

__device__ __forceinline__ void sample_task(lptr lds, const Ctx& X, int l, int b, int part, int tid) {
    LAS float* uf = (LAS float*)lds;
    LAS float* xbc = (LAS float*)(lds + 19968);
    LAS float* numv = (LAS float*)(lds + 24064);
    LAS float* yv = (LAS float*)(lds + 26112);
    LAS float* red = (LAS float*)(lds + 28160);
    LAS float* qs = (LAS float*)(lds + 28416);
    LAS float* kn = (LAS float*)(lds + 30464);
    LAS float* sc = (LAS float*)(lds + 30976);
    const int lane = tid & 63, wave = tid >> 6;
    const size_t row = (size_t)TP + b;
    const bf16_t* ur = XU + row * NIN;
    const size_t lb = (size_t)l * 128 + b;
    f32x4 kpre[8], vpre[8];
    if (part == 2) {
        const float* kc = X.ck + lb * 16384; const float* vc = X.cv + lb * 16384;
#pragma unroll
        for (int it = 0; it < 8; ++it) {
            const int e = (tid + it * NT) * 4, e2 = e < 127 * 128 ? e + 128 : e;
            kpre[it] = *(const f32x4*)(kc + e2); vpre[it] = *(const f32x4*)(vc + e2);
        }
    }
    {
        const int c_lo = part == 0 ? 0 : (part == 1 ? C_BZ : C_CQ), c_hi = part == 0 ? C_BZ : (part == 1 ? C_CQ : DIN);
#pragma unroll 2
        for (int i = c_lo + tid; i < c_hi; i += NT) uf[i] = bf2f(ur[i]);
    }
    __syncthreads();
    if (part == 0) {
#pragma unroll
    for (int h = 0; h < 4; ++h) {
        const float ig = uf[C_AI + h] + XPAR(P_AIB)[l * 4 + h], fg = uf[C_AF + h] + XPAR(P_AFB)[l * 4 + h];
        const float ls = logsigf_(fg), m0 = X.stM[lb * 4 + h];
        const float mn = fmaxf(ls + m0, ig), sp = __expf(ls + m0 - mn), sl = __expf(ig - mn);
        const float* C0 = X.stC + (lb * 4 + h) * 8192; float* C1 = X.out + O_SC + (lb * 4 + h) * 8192;
#pragma unroll
        for (int it = 0; it < 4; ++it) {
            const int e = (tid + it * NT) * 4, v = e >> 6, k = e & 63;
            const f32x4 c0 = *(const f32x4*)(C0 + e);
            const float vv = uf[C_AV + h * 128 + v] * sl;
            f32x4 c1; float part = 0.f;
#pragma unroll
            for (int j = 0; j < 4; ++j) { c1[j] = sp * c0[j] + vv * (uf[C_AK + h * 64 + k + j] * 0.125f); part += c1[j] * uf[C_AQ + h * 64 + k + j]; }
            *(f32x4*)(C1 + e) = c1;
            part = red16(part);
            if ((lane & 15) == 0) numv[h * 128 + v] = part;
        }
        if (wave == 0) {
            const float n1 = sp * X.stN[(lb * 4 + h) * 64 + lane] + sl * uf[C_AK + h * 64 + lane] * 0.125f;
            X.out[O_SN + (lb * 4 + h) * 64 + lane] = n1;
            const float dd = wave_sum(n1 * uf[C_AQ + h * 64 + lane]);
            if (lane == 0) { red[h] = dd; red[4 + h] = mn; X.out[O_SM + lb * 4 + h] = mn; }
        }
    }
    __syncthreads();
    float hv;
    { const int h = tid >> 7; hv = numv[tid] / fmaxf(fabsf(red[h]), __expf(-red[4 + h])); const float ss = wave_sum(hv * hv); if (lane == 0) red[8 + wave] = ss; }
    __syncthreads();
    { const int h = tid >> 7; const float rs = rsqrtf((red[8 + 2 * h] + red[9 + 2 * h]) * (1.f / 128.f) + EPS);
      XMIX[row * DMIX + tid] = (bf16_t)f2bf(hv * rs * XPAR(P_ANW)[l * 512 + tid] * sigmoidf_(uf[C_AO + tid]) * siluf_(uf[C_AZ + tid])); }
    }
    if (part == 1) {
    {
        const float* buf = X.conv + lb * 3 * 1024; float* oc = X.out + O_SCONV + lb * 3 * 1024;
        const float* cw = XPAR(P_CW) + l * 4096;
#pragma unroll
        for (int it = 0; it < 2; ++it) {
            const int ch = tid + it * NT;
            const float f0 = buf[ch], f1 = buf[1024 + ch], f2 = buf[2048 + ch], f3 = uf[C_BX + ch];
            const float acc = XPAR(P_CB)[l * 1024 + ch] + f0 * cw[ch] + f1 * cw[1024 + ch] + f2 * cw[2048 + ch] + f3 * cw[3072 + ch];
            xbc[ch] = siluf_(acc);
            oc[ch] = f1; oc[1024 + ch] = f2; oc[2048 + ch] = f3;
        }
    }
    __syncthreads();
#pragma unroll 4
    for (int hh = 0; hh < 8; ++hh) {
        const float dt = softplusf_(uf[C_BDT + hh] + XPAR(P_DTB)[l * 8 + hh]);
        const float dA = __expf(-dt * __expf(XPAR(P_ALOG)[l * 8 + hh]));
        const int g = hh >> 2;
        const float* h0p = X.ssm + (lb * 8 + hh) * 8192; float* h1p = X.out + O_SH + (lb * 8 + hh) * 8192;
#pragma unroll
        for (int it = 0; it < 4; ++it) {
            const int e = (tid + it * NT) * 4, p = e >> 7, s = e & 127;
            const f32x4 h0 = *(const f32x4*)(h0p + e);
            const float xv = xbc[hh * 64 + p] * dt;
            f32x4 h1; float part = 0.f;
#pragma unroll
            for (int j = 0; j < 4; ++j) { h1[j] = dA * h0[j] + xv * xbc[512 + g * 128 + s + j]; part += h1[j] * xbc[768 + g * 128 + s + j]; }
            *(f32x4*)(h1p + e) = h1;
            part = red16(part); part += __shfl_xor(part, 16);
            if ((lane & 31) == 0) yv[hh * 64 + p] = part;
        }
    }
    __syncthreads();
    float gb;
    { const int hh = tid >> 6; const float y = yv[tid] + XPAR(P_BD)[l * 8 + hh] * xbc[tid]; gb = y * siluf_(uf[C_BZ + tid]); const float ss = wave_sum(gb * gb); if (lane == 0) red[16 + wave] = ss; }
    __syncthreads();
    { const int g = tid >> 8; const float rs = rsqrtf((red[16 + 4 * g] + red[17 + 4 * g] + red[18 + 4 * g] + red[19 + 4 * g]) * (1.f / 256.f) + EPS);
      XMIX[row * DMIX + 512 + tid] = (bf16_t)f2bf(gb * rs * XPAR(P_BNW)[l * 512 + tid]); }
    }
    if (part == 2) {
    lptr Kl = lds + 36864;
    lptr Vl = lds + 36864 + 34816;
    if (tid < 320) {
        const int vec = tid >> 5, d = tid & 31, base = vec < 8 ? C_CQ + vec * 64 : C_CK + (vec - 8) * 64;
        const float x1 = uf[base + d], x2 = uf[base + 32 + d];
        float ss = x1 * x1 + x2 * x2; ss = red16(ss); ss += __shfl_xor(ss, 16);
        const float rs = rsqrtf(ss * (1.f / 64.f) + EPS);
        const float* w = vec < 8 ? XPAR(P_QNW) + l * 64 : XPAR(P_KNW) + l * 64;
        const float a = x1 * rs * w[d], bb = x2 * rs * w[d + 32];
        const float co = XROPE[((size_t)8192 * 32 + d) * 2], si = XROPE[((size_t)8192 * 32 + d) * 2 + 1];
        const float o1 = a * co - bb * si, o2 = bb * co + a * si;
        if (vec < 8) { qs[vec * 64 + d] = o1 * 0.125f; qs[vec * 64 + 32 + d] = o2 * 0.125f; } else { kn[(vec - 8) * 64 + d] = o1; kn[(vec - 8) * 64 + 32 + d] = o2; }
    }
    __syncthreads();
    {
        float* ko = X.out + O_SK + lb * 16384; float* vo = X.out + O_SV + lb * 16384;
#pragma unroll
        for (int it = 0; it < 8; ++it) {
            const int e = (tid + it * NT) * 4, j = e >> 7, r = e & 127;
            f32x4 kv = kpre[it], vv = vpre[it];
            if (j == 127) { kv = (f32x4){kn[r], kn[r + 1], kn[r + 2], kn[r + 3]}; vv = (f32x4){uf[C_CV + r], uf[C_CV + r + 1], uf[C_CV + r + 2], uf[C_CV + r + 3]}; }
            *(f32x4*)(ko + e) = kv; *(f32x4*)(vo + e) = vv;
            u32x2 wk, wv2; wk[0] = pk2(kv[0], kv[1]); wk[1] = pk2(kv[2], kv[3]); wv2[0] = pk2(vv[0], vv[1]); wv2[1] = pk2(vv[2], vv[3]);
            *(LAS u32x2*)(Kl + ((j * 136 + r) << 1)) = wk; *(LAS u32x2*)(Vl + ((j * 136 + r) << 1)) = wv2;
        }
    }
    __syncthreads();
    if (tid < 256) {
        const int kvh = tid >> 7, jj = tid & 127;
        float s0 = 0.f, s1 = 0.f, s2 = 0.f, s3 = 0.f;
#pragma unroll 2
        for (int d8 = 0; d8 < 8; ++d8) {
            float kf[8]; unpack8(*(const LAS u32x4*)(Kl + ((jj * 136 + kvh * 64 + d8 * 8) << 1)), kf);
#pragma unroll
            for (int j = 0; j < 8; ++j) {
                s0 += kf[j] * qs[(kvh * 4 + 0) * 64 + d8 * 8 + j]; s1 += kf[j] * qs[(kvh * 4 + 1) * 64 + d8 * 8 + j];
                s2 += kf[j] * qs[(kvh * 4 + 2) * 64 + d8 * 8 + j]; s3 += kf[j] * qs[(kvh * 4 + 3) * 64 + d8 * 8 + j];
            }
        }
        sc[(kvh * 4 + 0) * 128 + jj] = s0; sc[(kvh * 4 + 1) * 128 + jj] = s1; sc[(kvh * 4 + 2) * 128 + jj] = s2; sc[(kvh * 4 + 3) * 128 + jj] = s3;
    }
    __syncthreads();
    {
        const int hq = wave; const float s0 = sc[hq * 128 + lane], s1 = sc[hq * 128 + 64 + lane], sink = XPAR(P_SINK)[l * 8 + hq];
        const float m = fmaxf(wave_max(fmaxf(s0, s1)), sink);
        const float e0 = __expf(s0 - m), e1 = __expf(s1 - m);
        const float inv = 1.f / (wave_sum(e0 + e1) + __expf(sink - m));
        sc[hq * 128 + lane] = e0 * inv; sc[hq * 128 + 64 + lane] = e1 * inv;
    }
    __syncthreads();
    {
        const int hq = tid >> 6, d = tid & 63, kvh = hq >> 2;
        float o = 0.f;
#pragma unroll 16
        for (int jj = 0; jj < 128; ++jj) o += sc[hq * 128 + jj] * bf2f(*(const LAS bf16_t*)(Vl + ((jj * 136 + kvh * 64 + d) << 1)));
        XMIX[row * DMIX + 1024 + tid] = (bf16_t)f2bf(o * siluf_(uf[C_CZ + tid]));
    }
    }
    __syncthreads();
}

__device__ __forceinline__ void scans(const Ctx& X, int l, int gt, int nthreads) {
    for (int item = gt; item < 98816; item += nthreads) {
        if (item < 32768) {
            const int nh = item >> 12, e = (item & 4095) * 2;
            const bf16_t* base = (const bf16_t*)XMC + (size_t)nh * 128 * 8192 + e;
            const float* ml = XML + nh * 128; const float* bl = XBL + nh * 128;
            float m = 0.f; f32x2 st = {0.f, 0.f};
            for (int c0 = 0; c0 < 128; c0 += 8) {
                f32x2 cl[8];
#pragma unroll
                for (int j = 0; j < 8; ++j) { const unsigned w = *(const unsigned*)(base + (size_t)(c0 + j) * 8192); cl[j] = (f32x2){__uint_as_float(w << 16), __uint_as_float(w & 0xffff0000u)}; }
#pragma unroll
                for (int j = 0; j < 8; ++j) {
                    const float mlj = ml[c0 + j], blj = bl[c0 + j], mn = fmaxf(blj + m, mlj), sp = __expf(blj + m - mn), sl = __expf(mlj - mn);
                    *(unsigned*)(XCSB + ((size_t)nh * 128 + c0 + j) * 8192 + e) = pk2(st[0], st[1]);
                    if (e == 0) XMS[nh * 128 + c0 + j] = m;
                    st = st * sp + cl[j] * sl; m = mn;
                }
            }
            *(f32x2*)(X.out + O_PC + ((size_t)l * 8 + nh) * 8192 + e) = st;
            if (e == 0) X.out[O_PM + l * 8 + nh] = m;
        } else if (item < 98304) {
            const int i1 = item - 32768, nhh = i1 >> 12, e = (i1 & 4095) * 2;
            const bf16_t* base = (const bf16_t*)XSH + (size_t)nhh * 128 * 8192 + e;
            const float* al = XSA + nhh * 128;
            f32x2 st = {0.f, 0.f};
            for (int c0 = 0; c0 < 128; c0 += 8) {
                f32x2 cl[8];
#pragma unroll
                for (int j = 0; j < 8; ++j) { const unsigned w = *(const unsigned*)(base + (size_t)(c0 + j) * 8192); cl[j] = (f32x2){__uint_as_float(w << 16), __uint_as_float(w & 0xffff0000u)}; }
#pragma unroll
                for (int j = 0; j < 8; ++j) {
                    const float dec = __expf(al[c0 + j]);
                    *(unsigned*)(XHSB + ((size_t)nhh * 128 + c0 + j) * 8192 + e) = pk2(st[0], st[1]);
                    st = st * dec + cl[j];
                }
            }
            *(f32x2*)(X.out + O_PH + ((size_t)l * 16 + nhh) * 8192 + e) = st;
        } else {
            const int i2 = item - 98304, nh = i2 >> 6, k = i2 & 63;
            float* base = XMN + (size_t)nh * 128 * 64 + k;
            const float* ml = XML + nh * 128; const float* bl = XBL + nh * 128;
            float m = 0.f, st = 0.f;
            for (int c = 0; c < 128; ++c) {
                const float mlj = ml[c], blj = bl[c], mn = fmaxf(blj + m, mlj), sp = __expf(blj + m - mn), sl = __expf(mlj - mn);
                const float cl = base[c * 64];
                XNS[(size_t)nh * 128 * 64 + c * 64 + k] = st;
                st = st * sp + cl * sl; m = mn;
            }
            X.out[O_PN + ((size_t)l * 8 + nh) * 64 + k] = st;
        }
    }
}

__device__ __forceinline__ void mlstm_out(lptr lds, const Ctx& X, int l, int task, int tid) {
    const int h = task & 3, c = (task >> 2) & 127, n = task >> 9;
    const int lane = tid & 63, wave = tid >> 6, fr = lane & 15, fq = lane >> 4;
    const int row0 = n * SEQ + c * 64, nh = n * 4 + h;
    lptr Qs = lds;
    lptr Ks = lds + 9216;
    lptr Vt = lds + 18432;
    lptr Sb = lds + 36864 + wave * 2304;
    LAS float* bv = (LAS float*)(lds + 55296);
    LAS float* dv = bv + 64;
    LAS float* mtv = bv + 128;
    LAS float* siv = bv + 192;
    LAS float* qnv = bv + 256;
    LAS float* ssqp = bv + 384;
    LAS float* nsv = bv + 512;
    const int mti = wave >> 1, half = wave & 1;
    u32x4 csf[2][4];
    {
        const bf16_t* Cs = XCSB + ((size_t)nh * 128 + c) * 8192;
#pragma unroll
        for (int kk = 0; kk < 2; ++kk)
#pragma unroll
            for (int ntl = 0; ntl < 4; ++ntl) csf[kk][ntl] = *(const u32x4*)(Cs + (64 * half + 16 * ntl + fr) * 64 + kk * 32 + fq * 8);
    }
    unsigned short aov[4][4], azv[4][4]; float anw[4];
#pragma unroll
    for (int ntl = 0; ntl < 4; ++ntl) {
        const int v = h * 128 + 64 * half + 16 * ntl + fr;
        anw[ntl] = XPAR(P_ANW)[l * 512 + v];
#pragma unroll
        for (int ii = 0; ii < 4; ++ii) {
            const size_t row = (size_t)row0 + 16 * mti + fq * 4 + ii;
            aov[ntl][ii] = XU[row * NIN + C_AO + v]; azv[ntl][ii] = XU[row * NIN + C_AZ + v];
        }
    }
    u32x4 qraw, kraw, vraw[2];
    {
        const int tok = tid >> 3, k8 = (tid & 7) * 8;
        const bf16_t* ur = XU + (size_t)(row0 + tok) * NIN;
        qraw = *(const u32x4*)(ur + C_AQ + h * 64 + k8); kraw = *(const u32x4*)(ur + C_AK + h * 64 + k8);
#pragma unroll
        for (int it = 0; it < 2; ++it) { const int p = tid + it * NT, tk = p >> 4, v8 = (p & 15) * 8; vraw[it] = *(const u32x4*)(XU + (size_t)(row0 + tk) * NIN + C_AV + h * 128 + v8); }
    }
    if (wave == 0) {
        const bf16_t* ur = XU + (size_t)(row0 + lane) * NIN;
        const float fg = bf2f(ur[C_AF + h]) + XPAR(P_AFB)[l * 4 + h], ig = bf2f(ur[C_AI + h]) + XPAR(P_AIB)[l * 4 + h];
        const float b = wave_scan_sum(logsigf_(fg), lane);
        const float dd = ig - b;
        const float cm = wave_scan_max(dd, lane);
        const float ms = XMS[nh * 128 + c];
        const float mt = b + fmaxf(ms, cm);
        bv[lane] = b; dv[lane] = dd; mtv[lane] = mt; siv[lane] = __expf(b + ms - mt);
        nsv[lane] = XNS[((size_t)nh * 128 + c) * 64 + lane];
    }
    {
        const int tok = tid >> 3, k8 = (tid & 7) * 8;
        *(LAS u32x4*)(Qs + ((tok * 72 + k8) << 1)) = qraw;
        float x[8]; unpack8(kraw, x);
#pragma unroll
        for (int j = 0; j < 8; ++j) x[j] *= 0.125f;
        *(LAS u32x4*)(Ks + ((tok * 72 + k8) << 1)) = pack8(x);
    }
#pragma unroll
    for (int it = 0; it < 2; ++it) {
        const int p = tid + it * NT, tok = p >> 4, v8 = (p & 15) * 8;
        const u32x4 w = vraw[it];
#pragma unroll
        for (int j = 0; j < 8; ++j) *(LAS bf16_t*)(Vt + (((v8 + j) * 72 + tok) << 1)) = (bf16_t)((w[j >> 1] >> ((j & 1) * 16)) & 0xffffu);
    }
    __syncthreads();
    bf16x8 qa[2];
    qa[0] = lds_frag(Qs, 16 * mti + fr, fq * 8, 72); qa[1] = lds_frag(Qs, 16 * mti + fr, 32 + fq * 8, 72);
    {
        float x0[8], x1[8]; unpack8(__builtin_bit_cast(u32x4, qa[0]), x0); unpack8(__builtin_bit_cast(u32x4, qa[1]), x1);
        float d = 0.f;
#pragma unroll
        for (int j = 0; j < 8; ++j) d += x0[j] * nsv[fq * 8 + j] + x1[j] * nsv[32 + fq * 8 + j];
        d += __shfl_xor(d, 16); d += __shfl_xor(d, 32);
        if (fq == 0) qnv[wave * 16 + fr] = d;
    }
    float rsum[4] = {0.f, 0.f, 0.f, 0.f};
#pragma unroll
    for (int ntl = 0; ntl < 4; ++ntl) {
        f32x4 s = {0.f, 0.f, 0.f, 0.f};
        s = mfma16(qa[0], lds_frag(Ks, 16 * ntl + fr, fq * 8, 72), s);
        s = mfma16(qa[1], lds_frag(Ks, 16 * ntl + fr, 32 + fq * 8, 72), s);
#pragma unroll
        for (int ii = 0; ii < 4; ++ii) {
            const int t = 16 * mti + fq * 4 + ii, sidx = 16 * ntl + fr;
            const float wgt = (sidx <= t) ? __expf(bv[t] + dv[sidx] - mtv[t]) : 0.f;
            const float sv = wgt * s[ii];
            rsum[ii] += sv;
            *(LAS bf16_t*)(Sb + (((fq * 4 + ii) * 72 + sidx) << 1)) = (bf16_t)f2bf(sv);
        }
    }
    LDS_FENCE();
    f32x4 acc[4];
#pragma unroll
    for (int ntl = 0; ntl < 4; ++ntl) acc[ntl] = (f32x4){0.f, 0.f, 0.f, 0.f};
#pragma unroll
    for (int kk = 0; kk < 2; ++kk) {
        const bf16x8 a = lds_frag(Sb, fr, kk * 32 + fq * 8, 72);
#pragma unroll
        for (int ntl = 0; ntl < 4; ++ntl) acc[ntl] = mfma16(a, lds_frag(Vt, 64 * half + 16 * ntl + fr, kk * 32 + fq * 8, 72), acc[ntl]);
    }
    {
        const float sia = siv[16 * mti + fr];
#pragma unroll
        for (int kk = 0; kk < 2; ++kk) {
            float x[8]; unpack8(__builtin_bit_cast(u32x4, qa[kk]), x);
#pragma unroll
            for (int j = 0; j < 8; ++j) x[j] *= sia;
            const bf16x8 a = as_frag(pack8(x));
#pragma unroll
            for (int ntl = 0; ntl < 4; ++ntl) acc[ntl] = mfma16(a, as_frag(csf[kk][ntl]), acc[ntl]);
        }
    }
    float hv[4][4], ssl[4];
#pragma unroll
    for (int ii = 0; ii < 4; ++ii) {
        const int t = 16 * mti + fq * 4 + ii;
        const float den = red16(rsum[ii]) + siv[t] * qnv[wave * 16 + fq * 4 + ii];
        const float inv = 1.f / fmaxf(fabsf(den), __expf(-mtv[t]));
        float ss = 0.f;
#pragma unroll
        for (int ntl = 0; ntl < 4; ++ntl) { hv[ntl][ii] = acc[ntl][ii] * inv; ss += hv[ntl][ii] * hv[ntl][ii]; }
        ssl[ii] = red16(ss);
        if (fr == 0) ssqp[t * 2 + half] = ssl[ii];
    }
    __syncthreads();
#pragma unroll
    for (int ii = 0; ii < 4; ++ii) {
        const int t = 16 * mti + fq * 4 + ii;
        const float rs = rsqrtf((ssqp[t * 2] + ssqp[t * 2 + 1]) * (1.f / 128.f) + EPS);
        const size_t row = (size_t)row0 + t;
#pragma unroll
        for (int ntl = 0; ntl < 4; ++ntl) {
            const int v = h * 128 + 64 * half + 16 * ntl + fr;
            const float ao = bf2f(aov[ntl][ii]), az = bf2f(azv[ntl][ii]);
            XMIX[row * DMIX + v] = (bf16_t)f2bf(hv[ntl][ii] * rs * anw[ntl] * sigmoidf_(ao) * siluf_(az));
        }
    }
    __syncthreads();
}

__device__ __forceinline__ void ssd_out(lptr lds, const Ctx& X, int l, int task, int tid) {
    const int g = task & 1, c = (task >> 1) & 127, n = task >> 8;
    const int lane = tid & 63, wave = tid >> 6, fr = lane & 15, fq = lane >> 4;
    const int seq0 = n * SEQ, row0 = seq0 + c * 64;
    lptr Cm = lds;
    lptr Bm = lds + 17408;
    lptr Xt = lds + 34816;
    LAS float* CBf = (LAS float*)(lds + 71680);
    LAS float* av = (LAS float*)(lds + 89088);
    LAS float* dtv = (LAS float*)(lds + 90112);
    LAS float* ssq = (LAS float*)(lds + 91136);
    const int hl = wave >> 1, th = wave & 1, hh = 4 * g + hl;
    u32x4 hsf[4][4];
    {
        const bf16_t* hs = XHSB + ((size_t)(n * 8 + hh) * 128 + c) * 8192;
#pragma unroll
        for (int kk = 0; kk < 4; ++kk)
#pragma unroll
            for (int ntl = 0; ntl < 4; ++ntl) hsf[kk][ntl] = *(const u32x4*)(hs + (16 * ntl + fr) * 128 + kk * 32 + fq * 8);
    }
    if (wave < 4) {
        const int hh = 4 * g + wave;
        const float dt = softplusf_(bf2f(XU[(size_t)(row0 + lane) * NIN + C_BDT + hh]) + XPAR(P_DTB)[l * 8 + hh]);
        const float A = -__expf(XPAR(P_ALOG)[l * 8 + hh]);
        av[wave * 64 + lane] = wave_scan_sum(dt * A, lane);
        dtv[wave * 64 + lane] = dt;
    }
    {
        const float* cw = XPAR(P_CW) + l * 4096; const float* cb = XPAR(P_CB) + l * 1024;
        const int cg = lane;
        const int ch = cg < 32 ? g * 256 + cg * 8 : (cg < 48 ? 512 + g * 128 + (cg - 32) * 8 : 768 + g * 128 + (cg - 48) * 8);
        float o[8][8];
        conv8x8(XU, seq0, c * 64 + 8 * wave, ch, cw, cb, o);
        if (cg < 32) {
#pragma unroll
            for (int jx = 0; jx < 8; ++jx) {
                float v[8];
#pragma unroll
                for (int t = 0; t < 8; ++t) v[t] = o[t][jx];
                *(LAS u32x4*)(Xt + (((cg * 8 + jx) * 72 + 8 * wave) << 1)) = pack8(v);
            }
        } else {
            lptr dstm = cg < 48 ? Bm : Cm; const int s8 = (cg < 48 ? cg - 32 : cg - 48) * 8;
#pragma unroll
            for (int t = 0; t < 8; ++t) *(LAS u32x4*)(dstm + (((8 * wave + t) * 136 + s8) << 1)) = pack8(o[t]);
        }
    }
    __syncthreads();
    unsigned short bzv[2][4][4]; float bnw[4];
#pragma unroll
    for (int ntl = 0; ntl < 4; ++ntl) {
        bnw[ntl] = XPAR(P_BNW)[l * 512 + hh * 64 + 16 * ntl + fr];
#pragma unroll
        for (int mi = 0; mi < 2; ++mi)
#pragma unroll
            for (int ii = 0; ii < 4; ++ii) bzv[mi][ntl][ii] = XU[((size_t)row0 + 16 * (2 * th + mi) + fq * 4 + ii) * NIN + C_BZ + hh * 64 + 16 * ntl + fr];
    }
    {
        const int mt = wave >> 1;
#pragma unroll
        for (int q = 0; q < 2; ++q) {
            const int ntl = 2 * (wave & 1) + q;
            f32x4 acc = {0.f, 0.f, 0.f, 0.f};
#pragma unroll
            for (int kk = 0; kk < 4; ++kk) acc = mfma16(lds_frag(Cm, 16 * mt + fr, kk * 32 + fq * 8, 136), lds_frag(Bm, 16 * ntl + fr, kk * 32 + fq * 8, 136), acc);
#pragma unroll
            for (int ii = 0; ii < 4; ++ii) CBf[(16 * mt + fq * 4 + ii) * 68 + 16 * ntl + fr] = acc[ii];
        }
    }
    __syncthreads();
    f32x4 y1[2][4], y2[2][4];
#pragma unroll
    for (int mi = 0; mi < 2; ++mi)
#pragma unroll
        for (int ntl = 0; ntl < 4; ++ntl) { y1[mi][ntl] = (f32x4){0.f, 0.f, 0.f, 0.f}; y2[mi][ntl] = (f32x4){0.f, 0.f, 0.f, 0.f}; }
#pragma unroll
    for (int kk = 0; kk < 2; ++kk) {
        bf16x8 bx[4];
#pragma unroll
        for (int ntl = 0; ntl < 4; ++ntl) bx[ntl] = lds_frag(Xt, hl * 64 + 16 * ntl + fr, kk * 32 + fq * 8, 72);
#pragma unroll
        for (int mi = 0; mi < 2; ++mi) {
            const int t = 16 * (2 * th + mi) + fr, u0 = kk * 32 + fq * 8;
            const float at = av[hl * 64 + t];
            float w[8];
#pragma unroll
            for (int j = 0; j < 8; ++j) {
                const int uu = u0 + j;
                w[j] = (uu <= t) ? CBf[t * 68 + uu] * __expf(at - av[hl * 64 + uu]) * dtv[hl * 64 + uu] : 0.f;
            }
            const bf16x8 a = as_frag(pack8(w));
#pragma unroll
            for (int ntl = 0; ntl < 4; ++ntl) y1[mi][ntl] = mfma16(a, bx[ntl], y1[mi][ntl]);
        }
    }
    {
#pragma unroll
        for (int kk = 0; kk < 4; ++kk) {
            bf16x8 bh[4];
#pragma unroll
            for (int ntl = 0; ntl < 4; ++ntl) bh[ntl] = as_frag(hsf[kk][ntl]);
#pragma unroll
            for (int mi = 0; mi < 2; ++mi) {
                const bf16x8 a = lds_frag(Cm, 16 * (2 * th + mi) + fr, kk * 32 + fq * 8, 136);
#pragma unroll
                for (int ntl = 0; ntl < 4; ++ntl) y2[mi][ntl] = mfma16(a, bh[ntl], y2[mi][ntl]);
            }
        }
    }
    const float Dh = XPAR(P_BD)[l * 8 + hh];
#pragma unroll
    for (int mi = 0; mi < 2; ++mi)
#pragma unroll
        for (int ii = 0; ii < 4; ++ii) {
            const int t = 16 * (2 * th + mi) + fq * 4 + ii;
            const float ea = __expf(av[hl * 64 + t]);
            const size_t row = (size_t)row0 + t;
            float ss = 0.f;
#pragma unroll
            for (int ntl = 0; ntl < 4; ++ntl) {
                const int p = 16 * ntl + fr;
                const float xv = bf2f(*(const LAS bf16_t*)(Xt + (((hl * 64 + p) * 72 + t) << 1)));
                const float y = y1[mi][ntl][ii] + ea * y2[mi][ntl][ii] + Dh * xv;
                const float gbv = y * siluf_(bf2f(bzv[mi][ntl][ii]));
                y1[mi][ntl][ii] = gbv; ss += gbv * gbv;
            }
            ss = red16(ss);
            if (fr == 0) ssq[t * 4 + hl] = ss;
        }
    __syncthreads();
#pragma unroll
    for (int mi = 0; mi < 2; ++mi)
#pragma unroll
        for (int ii = 0; ii < 4; ++ii) {
            const int t = 16 * (2 * th + mi) + fq * 4 + ii;
            const float rs = rsqrtf((ssq[t * 4] + ssq[t * 4 + 1] + ssq[t * 4 + 2] + ssq[t * 4 + 3]) * (1.f / 256.f) + EPS);
            const size_t row = (size_t)row0 + t;
#pragma unroll
            for (int ntl = 0; ntl < 4; ++ntl) {
                const int p = hh * 64 + 16 * ntl + fr;
                XMIX[row * DMIX + 512 + p] = (bf16_t)f2bf(y1[mi][ntl][ii] * rs * bnw[ntl]);
            }
        }
    __syncthreads();
}


#define XB_TMO      128
#define XB_XCNT(j)  (256  + 64 * (j))
#define XB_XSUB(j)  (1280 + 64 * (j))
#define XB_XGEN(j)  (2304 + 64 * (j))
#define XB_TOP      3328
#define XB_TOPGEN   3392
#define XCD_BAR_WORDS 3456
#define XB_SPIN_CAP (1u << 18)
__device__ __forceinline__ unsigned xb_ld(unsigned* p)              { return __hip_atomic_load(p, __ATOMIC_RELAXED, __HIP_MEMORY_SCOPE_AGENT); }
__device__ __forceinline__ unsigned xb_add(unsigned* p, unsigned v) { return __hip_atomic_fetch_add(p, v, __ATOMIC_RELAXED, __HIP_MEMORY_SCOPE_AGENT); }
__device__ __forceinline__ unsigned xb_xcc_id() { return (unsigned)__builtin_amdgcn_s_getreg((3 << 11) | 20) & 0xFu; }
#define XB_SPIN(cond, bar) do { unsigned _sp = 0; while (cond) { __builtin_amdgcn_s_sleep(1); \
    if ((++_sp & 255u) == 0u) { if (xb_ld(&(bar)[XB_TMO])) break; if (_sp > XB_SPIN_CAP) { atomicAdd(&(bar)[XB_TMO], 1u); break; } } } } while (0)
struct XcdBarrier { unsigned* bar; unsigned x; volatile LAS unsigned* st; };
__device__ __forceinline__ XcdBarrier xcd_barrier_post(unsigned* bar, volatile LAS unsigned* st) {
    XcdBarrier b; b.bar = bar; b.x = xb_xcc_id(); b.st = st;
    if (threadIdx.x == 0) (void)xb_add(&bar[XB_XCNT(b.x)], 1u);
    return b;
}
__device__ __forceinline__ void xcd_barrier_complete(unsigned* bar, unsigned x, unsigned& nloc, unsigned& nx) {
    const unsigned G = gridDim.x * gridDim.y * gridDim.z;
    unsigned sum, cnt, mine, sp = 0u;
    for (;;) {
        sum = 0u; cnt = 0u; mine = 0u;
#pragma unroll
        for (unsigned j = 0; j < 16; ++j) { const unsigned c = xb_ld(&bar[XB_XCNT(j)]); sum += c; cnt += (c > 0u) ? 1u : 0u; mine = (j == x) ? c : mine; }
        if (sum == G) break;
        __builtin_amdgcn_s_sleep(1);
        if ((++sp & 255u) == 0u) { if (xb_ld(&bar[XB_TMO])) break; if (sp > XB_SPIN_CAP) { atomicAdd(&bar[XB_TMO], 1u); break; } }
    }
    nloc = mine > 0u ? mine : 1u; nx = cnt > 0u ? cnt : 1u;
}
__device__ __forceinline__ void xcd_barrier(const XcdBarrier& b) {
    asm volatile("s_waitcnt vmcnt(0)" ::: "memory");
    __syncthreads();
    if (threadIdx.x == 0) {
        unsigned* bar = b.bar;
        __builtin_amdgcn_s_waitcnt(0);
        unsigned nloc = b.st[0], nx = b.st[1];
        if (nloc == 0u) { xcd_barrier_complete(bar, b.x, nloc, nx); b.st[0] = nloc; b.st[1] = nx; }
        const unsigned old = xb_add(&bar[XB_XSUB(b.x)], 1u);
        const unsigned gen = old / nloc;
        if (old + 1u == (gen + 1u) * nloc) {
            __builtin_amdgcn_fence(__ATOMIC_RELEASE, "agent");
            asm volatile("s_waitcnt vmcnt(0)" ::: "memory");
            const unsigned og = xb_add(&bar[XB_TOP], 1u);
            const unsigned tg = og / nx;
            if (og + 1u == (tg + 1u) * nx) xb_add(&bar[XB_TOPGEN], 1u);
            else XB_SPIN(xb_ld(&bar[XB_TOPGEN]) == tg, bar);
            __builtin_amdgcn_fence(__ATOMIC_ACQUIRE, "agent");
            xb_add(&bar[XB_XGEN(b.x)], 1u);
            asm volatile("s_waitcnt vmcnt(0)" ::: "memory");
        } else {
            XB_SPIN(xb_ld(&bar[XB_XGEN(b.x)]) == gen, bar);
            __builtin_amdgcn_fence(__ATOMIC_ACQUIRE, "agent");
            asm volatile("s_waitcnt vmcnt(0)" ::: "memory");
        }
    }
    __syncthreads();
}

__global__ void __launch_bounds__(NT, 2) mega(Args args) {
    __shared__ __attribute__((aligned(16))) unsigned char lds_raw[LDS_BYTES];
    lptr lds = (lptr)lds_raw;
    cg::grid_group grid = cg::this_grid();
    const int tid = threadIdx.x, bid = blockIdx.x, G = gridDim.x;
    Ctx X;
    X.xp = args.in[IN_XP]; X.xs = args.in[IN_XS]; X.stC = args.in[IN_STC]; X.stN = args.in[IN_STN]; X.stM = args.in[IN_STM]; X.ssm = args.in[IN_SSM];
    X.conv = args.in[IN_CONV]; X.ck = args.in[IN_CK]; X.cv = args.in[IN_CV]; X.out = args.out; X.ws = args.ws;
    const int lo = args.ph_lo, hi = args.ph_hi;
    volatile LAS unsigned* xst = (volatile LAS unsigned*)(lds + LDS_BYTES - 16);
    if (tid == 0) { xst[0] = 0u; xst[1] = 0u; }
    __syncthreads();
    XcdBarrier xbar = xcd_barrier_post((unsigned*)(args.ws + WS_BAR), xst);
#define IN(k) (lo <= (k) && (k) < hi)
#define SEAM(k) do { if (IN(k) && IN((k) + 1)) { for (int _r = 0; _r < REP_SYNC; ++_r) { if ((k) == 0) grid.sync(); else xcd_barrier(xbar); } } } while (0)
    if (IN(0)) { for (int _r = 0; _r < REP_P0; ++_r) prologue(lds, X, args, G, bid, tid); }
    SEAM(0);
    for (int l = 0; l < 4; ++l) {
        const int pb = 1 + l * 5;
        if (IN(pb)) for (int _r = 0; _r < REP_P1; ++_r) {
            pg8::Gemm g{XXB, XWIN + (size_t)l * NIN * D, MPAD, NIN, D}; pg8::StaticOrder S; S.init(l == 0 ? MPAD : TP, NIN, G, bid);
            pg8::EpiU E{XU, XSSQ};
            pg8::gemm_phase<pg8::EpiU, pg8::StaticOrder>(lds, g, S, E, OPQ(tid));
        }
        SEAM(pb);
        if (IN(pb + 1)) for (int _r = 0; _r < REP_P2; ++_r) {
            for (int t = bid; t < 256; t += G) for (int _q = 0; _q < RT_SWA; ++_q) swa_prompt(lds, X, l, t, OPQ(tid));
            for (int t = bid; t < 256; t += G) for (int _q = 0; _q < RT_SAMPLE; ++_q) {
                if (t < 128) sample_task(lds, X, l, t, 1, OPQ(tid));
                else { sample_task(lds, X, l, t - 128, 0, OPQ(tid)); sample_task(lds, X, l, t - 128, 2, OPQ(tid)); }
            }
            for (int t = bid; t < 512; t += G) for (int _q = 0; _q < RT_SLOC; ++_q) ssd_local(lds, X, l, t, OPQ(tid));
            for (int t = bid; t < 1024; t += G) for (int _q = 0; _q < RT_MLOC; ++_q) mlstm_local(lds, X, l, t, OPQ(tid));
            if (bid == G - 1) {
                for (int i = tid; i < 2 * 3 * 1024; i += NT) {
                    const int ch = i & 1023, j = (i >> 10) % 3, n = i / 3072;
                    X.out[O_PCONV + (((size_t)l * 2 + n) * 3 + j) * 1024 + ch] = bf2f(XU[(size_t)(n * SEQ + SEQ - 3 + j) * NIN + C_BX + ch]);
                }
            }
        }
        SEAM(pb + 1);
        if (IN(pb + 2)) {
            if (bid >= G - 4) {
                pg8::Gemm g{XMIX, XWOUT + (size_t)l * D * DMIX, MPAD, D, DMIX}; pg8::SampleOrder S{G - 4, 4, bid};
                if (l == 0) { pg8::EpiRes_<1, 0> E{X.xp, X.xs, X.out, XXB, XSSQ}; pg8::gemm_phase<pg8::EpiRes_<1, 0>, pg8::SampleOrder, true>(lds, g, S, E, OPQ(tid)); }
                else if (l < 3) { pg8::EpiRes_<1, 1> E{X.xp, X.xs, X.out, XXB, XSSQ}; pg8::gemm_phase<pg8::EpiRes_<1, 1>, pg8::SampleOrder, true>(lds, g, S, E, OPQ(tid)); }
                else { pg8::EpiRes_<1, 2> E{X.xp, X.xs, X.out, XXB, XSSQ}; pg8::gemm_phase<pg8::EpiRes_<1, 2>, pg8::SampleOrder, true>(lds, g, S, E, OPQ(tid)); }
            }
            for (int _r = 0; _r < REP_P3; ++_r) scans(X, l, bid * NT + OPQ(tid), G * NT);
        }
        SEAM(pb + 2);
        if (IN(pb + 3)) for (int _r = 0; _r < REP_P4; ++_r) {
            for (int task = bid; task < 1536; task += G) {
                if (task < 512) for (int _q = 0; _q < RT_SOUT; ++_q) ssd_out(lds, X, l, task, OPQ(tid));
                else mlstm_out(lds, X, l, task - 512, OPQ(tid));
            }
        }
        SEAM(pb + 3);
        if (IN(pb + 4)) {
            {
                pg8::Gemm g{XMIX, XWOUT + (size_t)l * D * DMIX, MPAD, D, DMIX}; pg8::StaticOrder S; S.init(TP, D, G, bid);
                if (l == 0) { pg8::EpiRes_<2, 0> E{X.xp, X.xs, X.out, XXB, XSSQ}; pg8::gemm_phase<pg8::EpiRes_<2, 0>, pg8::StaticOrder>(lds, g, S, E, OPQ(tid)); }
                else if (l < 3) { pg8::EpiRes_<2, 1> E{X.xp, X.xs, X.out, XXB, XSSQ}; pg8::gemm_phase<pg8::EpiRes_<2, 1>, pg8::StaticOrder>(lds, g, S, E, OPQ(tid)); }
                else { pg8::EpiRes_<2, 2> E{X.xp, X.xs, X.out, XXB, XSSQ}; pg8::gemm_phase<pg8::EpiRes_<2, 2>, pg8::StaticOrder>(lds, g, S, E, OPQ(tid)); }
            }
            if (l < 3 && bid < 20) {
                pg8::Gemm g{XXB, XWIN + (size_t)(l + 1) * NIN * D, MPAD, NIN, D}; pg8::SampleOrder S{0, 20, bid};
                pg8::EpiUh E{XU, XSSQ};
                pg8::gemm_phase<pg8::EpiUh, pg8::SampleOrder, true>(lds, g, S, E, OPQ(tid));
            }
        }
        SEAM(pb + 4);
    }
#undef IN
#undef SEAM
}

extern "C" void kernel_launch(void* const* d_in, const int* in_sizes, int n_in, void* d_out, int out_size, void* d_ws, size_t ws_size, hipStream_t stream) {
    static int grid_blocks = 0;
    if (!grid_blocks) {
        int dev = 0, cus = 0, per_cu = 0;
        hipGetDevice(&dev);
        hipDeviceGetAttribute(&cus, hipDeviceAttributeMultiprocessorCount, dev);
        hipOccupancyMaxActiveBlocksPerMultiprocessor(&per_cu, mega, NT, 0);
        if (per_cu < 1) { fprintf(stderr, "occupancy query returned %d\n", per_cu); per_cu = 1; }
        grid_blocks = cus * 1;
        if (ws_size < WS_END) fprintf(stderr, "workspace too small: %zu < %zu\n", ws_size, (size_t)WS_END);
    }
    (void)hipMemsetAsync(d_ws, 0, 16384, stream);
    Args a{};
    for (int i = 0; i < 24; ++i) a.in[i] = (const float*)d_in[i];
    a.out = (float*)d_out; a.ws = (unsigned char*)d_ws;
    const int NPH = 21;
#if MULTI_LAUNCH
    for (int p = 0; p < NPH; ++p) {
        a.ph_lo = p; a.ph_hi = p + 1;
        void* kargs[] = {&a};
        hipError_t e = hipLaunchCooperativeKernel((void*)mega, dim3(grid_blocks), dim3(NT), kargs, 0, stream);
        if (e != hipSuccess) fprintf(stderr, "cooperative launch failed: %s (grid %d)\n", hipGetErrorString(e), grid_blocks);
    }
#else
    a.ph_lo = 0; a.ph_hi = NPH;
    void* kargs[] = {&a};
    hipError_t e = hipLaunchCooperativeKernel((void*)mega, dim3(grid_blocks), dim3(NT), kargs, 0, stream);
    if (e != hipSuccess) fprintf(stderr, "cooperative launch failed: %s (grid %d)\n", hipGetErrorString(e), grid_blocks);
#endif
}
```

```cpp
#include <hip/hip_runtime.h>
#include <hip/hip_cooperative_groups.h>
#include <cstdio>
#include <cstdint>
namespace cg = cooperative_groups;

#ifndef REP_SYNC
#define REP_SYNC 1
#endif
#ifndef REP_P1
#define REP_P1 1
#endif
#ifndef REP_P2
#define REP_P2 1
#endif
#ifndef REP_P3
#define REP_P3 1
#endif
#ifndef REP_P0
#define REP_P0 1
#endif
#ifndef REP_P4
#define REP_P4 1
#endif
#ifndef RT_SAMPLE
#define RT_SAMPLE 1
#endif
#ifndef RT_SWA
#define RT_SWA 1
#endif
#ifndef RT_SLOC
#define RT_SLOC 1
#endif
#ifndef RT_MLOC
#define RT_MLOC 1
#endif
#ifndef RT_SOUT
#define RT_SOUT 1
#endif
#ifndef GEMM_SP2
#define GEMM_SP2 true
#endif
#ifndef GEMM_ALIGN
#define GEMM_ALIGN true
#endif
#ifndef MULTI_LAUNCH
#define MULTI_LAUNCH 0
#endif

#define LAS __attribute__((address_space(3)))
typedef unsigned short bf16_t;
typedef short bf16x8 __attribute__((ext_vector_type(8)));
typedef float f32x4 __attribute__((ext_vector_type(4)));
typedef float f32x2 __attribute__((ext_vector_type(2)));
typedef unsigned u32x4 __attribute__((ext_vector_type(4)));
typedef unsigned u32x2 __attribute__((ext_vector_type(2)));
typedef __bf16 bf16x2_t __attribute__((ext_vector_type(2)));
typedef LAS unsigned char* lptr;

constexpr int D = 1024, DIN = 4880, NIN = 5120, DMIX = 1536, TP = 16384, MTOK = 16512, MPAD = 16640, SEQ = 8192;
constexpr int C_AQ = 0, C_AK = 256, C_AV = 512, C_AO = 1024, C_AZ = 1536, C_AI = 2048, C_AF = 2052, C_BZ = 2056, C_BX = 2568, C_BB = 3080, C_BC = 3336,
              C_BDT = 3592, C_CQ = 3600, C_CK = 4112, C_CV = 4240, C_CZ = 4368;
constexpr float EPS = 1e-6f;
constexpr size_t O_YP = 0, O_YS = 16777216, O_PC = 16908288, O_PN = 17170432, O_PM = 17172480, O_PH = 17172512, O_PCONV = 17696800, O_PK = 17721376,
                 O_PV = 17852448, O_SC = 17983520, O_SN = 34760736, O_SM = 34891808, O_SH = 34893856, O_SCONV = 68448288, O_SK = 70021152, O_SV = 78409760;
constexpr size_t WS_BAR = 0;
constexpr size_t WS_PAR = 16384;
constexpr size_t WS_WIN = WS_PAR + 102400;
constexpr size_t WS_WOUT = WS_WIN + (size_t)4 * NIN * D * 2;
constexpr size_t WS_XB = WS_WOUT + (size_t)4 * D * DMIX * 2;
constexpr size_t WS_U = WS_XB + (size_t)MPAD * D * 2;
constexpr size_t WS_MIX = WS_U + (size_t)MPAD * NIN * 2;
constexpr size_t WS_SSQ = WS_MIX + (size_t)MPAD * DMIX * 2;
constexpr size_t WS_ROPE = WS_SSQ + (size_t)MPAD * 16 * 4;
constexpr size_t WS_MC = WS_ROPE + (size_t)8200 * 64 * 4;
constexpr size_t WS_MN = WS_MC + (size_t)8 * 128 * 8192 * 4;
constexpr size_t WS_ML = WS_MN + (size_t)8 * 128 * 64 * 4;
constexpr size_t WS_BL = WS_ML + 4096;
constexpr size_t WS_MS = WS_BL + 4096;
constexpr size_t WS_SA = WS_MS + 4096;
constexpr size_t WS_SH = WS_SA + 8192;
constexpr size_t WS_CSB = WS_SH + (size_t)16 * 128 * 8192 * 4;
constexpr size_t WS_HSB = WS_CSB + (size_t)8 * 128 * 8192 * 2;
constexpr size_t WS_NS = WS_HSB + (size_t)16 * 128 * 8192 * 2;
constexpr size_t WS_END = WS_NS + (size_t)8 * 128 * 64 * 4;
constexpr int LDS_BYTES = 139264;
constexpr int NT = 512;

struct Args { const float* in[24]; float* out; unsigned char* ws; int ph_lo, ph_hi; };

__device__ __forceinline__ float bf2f(unsigned v) { return __uint_as_float(v << 16); }
__device__ __forceinline__ unsigned pk2(float lo, float hi) { f32x2 v = {lo, hi}; bf16x2_t b = __builtin_convertvector(v, bf16x2_t); return __builtin_bit_cast(unsigned, b); }
__device__ __forceinline__ unsigned f2bf(float f) { return pk2(f, 0.f) & 0xffffu; }
__device__ __forceinline__ void unpack8(u32x4 w, float (&f)[8]) {
#pragma unroll
    for (int i = 0; i < 4; ++i) { f[2 * i] = __uint_as_float(w[i] << 16); f[2 * i + 1] = __uint_as_float(w[i] & 0xffff0000u); }
}
__device__ __forceinline__ u32x4 pack8(const float (&f)[8]) { u32x4 w; w[0] = pk2(f[0], f[1]); w[1] = pk2(f[2], f[3]); w[2] = pk2(f[4], f[5]); w[3] = pk2(f[6], f[7]); return w; }
__device__ __forceinline__ u32x4 pack8v(f32x4 a, f32x4 b) { u32x4 w; w[0] = pk2(a[0], a[1]); w[1] = pk2(a[2], a[3]); w[2] = pk2(b[0], b[1]); w[3] = pk2(b[2], b[3]); return w; }
__device__ __forceinline__ bf16x8 as_frag(u32x4 w) { return __builtin_bit_cast(bf16x8, w); }
__device__ __forceinline__ bf16x8 ldg_f32_frag(const float* p) { f32x4 a = *(const f32x4*)p, b = *(const f32x4*)(p + 4); return as_frag(pack8v(a, b)); }
__device__ __forceinline__ bf16x8 lds_frag(lptr base, int row, int k, int stride) { return *(const LAS bf16x8*)(base + ((row * stride + k) << 1)); }
__device__ __forceinline__ f32x4 mfma16(bf16x8 a, bf16x8 b, f32x4 c) { return __builtin_amdgcn_mfma_f32_16x16x32_bf16(a, b, c, 0, 0, 0); }
__device__ __forceinline__ float sigmoidf_(float x) { return 1.f / (1.f + __expf(-x)); }
__device__ __forceinline__ float siluf_(float x) { return x / (1.f + __expf(-x)); }
__device__ __forceinline__ float softplusf_(float x) { return x > 20.f ? x : log1pf(__expf(x)); }
__device__ __forceinline__ float logsigf_(float x) { return fminf(x, 0.f) - log1pf(__expf(-fabsf(x))); }
__device__ __forceinline__ float wave_scan_sum(float v, int lane) {
#pragma unroll
    for (int o = 1; o < 64; o <<= 1) { float t = __shfl_up(v, o); if (lane >= o) v += t; }
    return v;
}
__device__ __forceinline__ float wave_scan_max(float v, int lane) {
#pragma unroll
    for (int o = 1; o < 64; o <<= 1) { float t = __shfl_up(v, o); if (lane >= o) v = fmaxf(v, t); }
    return v;
}
__device__ __forceinline__ float red16(float v);
__device__ __forceinline__ float red16max(float v);
__device__ __forceinline__ float wave_sum(float v) { v = red16(v); v += __shfl_xor(v, 16); v += __shfl_xor(v, 32); return v; }
__device__ __forceinline__ float wave_max(float v) { v = red16max(v); v = fmaxf(v, __shfl_xor(v, 16)); v = fmaxf(v, __shfl_xor(v, 32)); return v; }
template <int CTRL> __device__ __forceinline__ float dppf(float v) { return __int_as_float(__builtin_amdgcn_update_dpp(0, __float_as_int(v), CTRL, 0xf, 0xf, true)); }
__device__ __forceinline__ float red16(float v) { v += dppf<0xB1>(v); v += dppf<0x4E>(v); v += dppf<0x141>(v); v += dppf<0x140>(v); return v; }
__device__ __forceinline__ float red16max(float v) { v = fmaxf(v, dppf<0xB1>(v)); v = fmaxf(v, dppf<0x4E>(v)); v = fmaxf(v, dppf<0x141>(v)); v = fmaxf(v, dppf<0x140>(v)); return v; }
__device__ __forceinline__ int OPQ(int v) { asm volatile("" : "+v"(v)); return v; }
#define LDS_FENCE() asm volatile("s_waitcnt lgkmcnt(0)" ::: "memory")

namespace pg8 {
constexpr int BM = 256, BK = 64, HALF = 128, HTB = HALF * BK * 2, STAGE_BYTES = 8 * HTB, NXCD = 8, WGM = 8;
__host__ __device__ __forceinline__ int lds_byte(int r, int c) { const int st = (r >> 4) * 2 + (c >> 5), rr = r & 15, cc = c & 31, ob = rr * 64 + cc * 2; return st * 1024 + (ob ^ (((ob >> 9) & 1) << 5)); }
__host__ __device__ __forceinline__ void stage_rc(int b, int& R, int& C) { const int st = b / 1024, sb = b % 1024, swz = sb ^ (((sb >> 9) & 1) << 5); R = (st >> 1) * 16 + swz / 64; C = (st & 1) * 32 + (swz % 64) / 2; }
__host__ __device__ __forceinline__ int perm32(int rho) { const int n = rho >> 4, i = rho & 15; return 8 * (i >> 2) + 4 * n + (i & 3); }
struct Unit { int pm, pn; };
struct Gemm { const bf16_t* A; const bf16_t* Bt; int M, N, K; };
struct StaticOrder {
    int nM, nN, nwg, G, c;
    __device__ void init(int M, int N, int G_, int c_) { nM = M / BM; nN = N / BM; nwg = nM * nN; G = G_; c = c_; }
    __device__ bool next(int i, Unit& u) const {
        const long L = (long)i * G + c; if (L >= nwg) return false;
        int wgid = (int)L; { const int q = nwg / NXCD, r = nwg % NXCD, xcd = wgid % NXCD, off = wgid / NXCD; wgid = (xcd < r ? xcd * (q + 1) : r * (q + 1) + (xcd - r) * q) + off; }
        const int nig = WGM * nN, gid = wgid / nig, fm = gid * WGM, gsz = (nM - fm) < WGM ? (nM - fm) : WGM;
        u.pm = fm + ((wgid % nig) % gsz); u.pn = (wgid % nig) / gsz; return true;
    }
};
template <int NAI> struct EpiU_ {
    bf16_t* U; const float* ssq;
    __device__ __forceinline__ void operator()(const f32x4 (&acc)[2][2][4][2], const Unit& u, int wr, int wc, int fr, int fq) const {
        const int row0 = u.pm * BM + wr * 64 + fr, col0 = u.pn * BM + wc * 32 + 8 * fq;
#pragma unroll
        for (int ai = 0; ai < NAI; ++ai)
#pragma unroll
            for (int m = 0; m < 4; ++m) {
                const int r = row0 + ai * HALF + m * 16;
                const f32x4 s = *(const f32x4*)(ssq + (size_t)r * 16 + fq * 4);
                float st = s[0] + s[1] + s[2] + s[3]; st += __shfl_xor(st, 16); st += __shfl_xor(st, 32);
                const float rs = rsqrtf(st * (1.f / 1024.f) + EPS);
                bf16_t* rowp = U + (size_t)r * NIN + col0;
#pragma unroll
                for (int bj = 0; bj < 2; ++bj) *(u32x4*)(rowp + bj * HALF) = pack8v(acc[ai][bj][m][0] * rs, acc[ai][bj][m][1] * rs);
                __builtin_amdgcn_sched_barrier(0);
            }
    }
};
template <int NAI, int MODE> struct EpiRes_ {
    const float* xp; const float* xs; float* out; bf16_t* xb; float* ssq;
    __device__ __forceinline__ void operator()(const f32x4 (&acc)[2][2][4][2], const Unit& u, int wr, int wc, int fr, int fq) const {
        const int row0 = u.pm * BM + wr * 64 + fr, col0 = u.pn * BM + wc * 32 + 8 * fq;
#pragma unroll
        for (int ai = 0; ai < NAI; ++ai)
#pragma unroll
            for (int m = 0; m < 4; ++m) {
                const int r = row0 + ai * HALF + m * 16;
                const bool valid = r < MTOK;
                float part = 0.f;
#pragma unroll
                for (int bj = 0; bj < 2; ++bj) {
                    const int c = col0 + bj * HALF;
                    f32x4 o0 = {0.f, 0.f, 0.f, 0.f}, o1 = {0.f, 0.f, 0.f, 0.f};
                    if (MODE == 0) {
                        const float* src = r < TP ? xp + (size_t)r * D : xs + (size_t)(r - TP) * D;
                        if (valid) { o0 = *(const f32x4*)(src + c); o1 = *(const f32x4*)(src + c + 4); }
                    } else {
                        float f[8]; unpack8(*(const u32x4*)(xb + (size_t)r * D + c), f);
                        o0 = (f32x4){f[0], f[1], f[2], f[3]}; o1 = (f32x4){f[4], f[5], f[6], f[7]};
                    }
                    const f32x4 v0 = acc[ai][bj][m][0] + o0, v1 = acc[ai][bj][m][1] + o1;
                    if (MODE == 2) {
                        if (valid) { *(f32x4*)(out + (size_t)r * D + c) = v0; *(f32x4*)(out + (size_t)r * D + c + 4) = v1; }
                    } else {
                        *(u32x4*)(xb + (size_t)r * D + c) = pack8v(v0, v1);
                        part += v0[0] * v0[0] + v0[1] * v0[1] + v0[2] * v0[2] + v0[3] * v0[3] + v1[0] * v1[0] + v1[1] * v1[1] + v1[2] * v1[2] + v1[3] * v1[3];
                    }
                }
                if (MODE != 2) {
                    part += __shfl_xor(part, 16); part += __shfl_xor(part, 32);
                    if (fq == 0) ssq[(size_t)r * 16 + u.pn * 4 + wc] = part;
                }
                __builtin_amdgcn_sched_barrier(0);
            }
    }
};

typedef EpiU_<2> EpiU; typedef EpiU_<1> EpiUh;
struct EpiProbe {
    const unsigned* flag; float* dst;
    __device__ __forceinline__ void operator()(const f32x4 (&acc)[2][2][4][2], const Unit& u, int wr, int wc, int fr, int fq) const {
        if (__hip_atomic_load(flag, __ATOMIC_RELAXED, __HIP_MEMORY_SCOPE_AGENT) == 12345u) {
            f32x4 t = {0.f, 0.f, 0.f, 0.f};
#pragma unroll
            for (int a = 0; a < 2; ++a)
#pragma unroll
                for (int b = 0; b < 2; ++b)
#pragma unroll
                    for (int m = 0; m < 4; ++m)
#pragma unroll
                        for (int n = 0; n < 2; ++n) t += acc[a][b][m][n];
            *(f32x4*)(dst + (size_t)(u.pm * 4 + u.pn) * 2048 + (wr * 4 + wc) * 256 + (fq * 16 + fr) * 4) = t;
        }
    }
};
struct SampleOrder {
    int first, cnt, c;
    __device__ bool next(int i, Unit& u) const { if (i != 0 || c < first || c >= first + cnt) return false; u.pm = 64; u.pn = c - first; return true; }
};
template <class Epi, class Sched, bool HALF_M = false, bool SP2 = false, bool ALIGN_EPI = false>
__device__ __forceinline__ void gemm_phase(lptr lds, const Gemm g, const Sched& S, const Epi& E, const int tid) {
    const int wid = __builtin_amdgcn_readfirstlane(tid >> 6), lane = tid & 63, wr = wid >> 2, wc = wid & 3, fr = lane & 15, fq = lane >> 4;
    const int K = g.K, nt = K / BK;
    unsigned voffA[2], voffB[2];
#pragma unroll
    for (int i = 0; i < 2; ++i) { int R, C; stage_rc(tid * 16 + i * 8192, R, C); const int Rb = (R & ~31) + perm32(R & 31);
        voffA[i] = (unsigned)(R * K + C) * 2u; voffB[i] = (unsigned)(Rb * K + C) * 2u; }
    const size_t kstep = (size_t)(BK * 2);
    const size_t hstep = (size_t)HALF * K * 2;
    const size_t tstep = 2 * hstep;
    const unsigned ldsw = (unsigned)wid * 1024u;
    const int aoff = lds_byte(wr * 64 + fr, fq * 8), boff = lds_byte(wc * 32 + fr, fq * 8);
#define PG8_SA(b, h) (((b) * 2 + (h)) * HTB)
#define PG8_SB(b, h) ((4 + (b) * 2 + (h)) * HTB)
#define PG8_STAGE(bufoff, gbase, voff) do { _Pragma("unroll") for (int _i = 0; _i < 2; ++_i) \
        __builtin_amdgcn_global_load_lds((const unsigned*)((const char*)(gbase) + (voff)[_i]), (LAS unsigned*)(lds + (bufoff) + ldsw + _i * 8192), 16, 0, 0); } while (0)
#define PG8_LDA(dst, b, h) do { _Pragma("unroll") for (int m = 0; m < 4; ++m) _Pragma("unroll") for (int k = 0; k < 2; ++k) dst[m][k] = *(const LAS bf16x8*)(lds + PG8_SA(b, h) + aoff + m * 2048 + k * 1024); } while (0)
#define PG8_LDB(dst, b, h) do { _Pragma("unroll") for (int n = 0; n < 2; ++n) _Pragma("unroll") for (int k = 0; k < 2; ++k) dst[n][k] = *(const LAS bf16x8*)(lds + PG8_SB(b, h) + boff + n * 2048 + k * 1024); } while (0)
#define PG8_MMA(ai, bj, At, Bt) do { __builtin_amdgcn_s_setprio(1); _Pragma("unroll") for (int m = 0; m < 4; ++m) _Pragma("unroll") for (int n = 0; n < 2; ++n) _Pragma("unroll") for (int k = 0; k < 2; ++k) \
        acc[ai][bj][m][n] = __builtin_amdgcn_mfma_f32_16x16x32_bf16(Bt[n][k], At[m][k], acc[ai][bj][m][n], 0, 0, 0); __builtin_amdgcn_s_setprio(0); } while (0)
#define PG8_WAIT_V(n) asm volatile("s_waitcnt vmcnt(" #n ")" ::: "memory")
#define PG8_WAIT_L(n) asm volatile("s_waitcnt lgkmcnt(" #n ")" ::: "memory")
#define PG8_BAR __builtin_amdgcn_s_barrier()
#define PG8_SCHED __builtin_amdgcn_sched_barrier(0)
    Unit cur, nxt; int ui = 0;
    if (!S.next(0, cur)) return;
    f32x4 acc[2][2][4][2];
#pragma unroll
    for (int a = 0; a < 2; ++a)
#pragma unroll
        for (int b = 0; b < 2; ++b)
#pragma unroll
            for (int m = 0; m < 4; ++m)
#pragma unroll
                for (int n = 0; n < 2; ++n) acc[a][b][m][n] = (f32x4){0.f, 0.f, 0.f, 0.f};
    bf16x8 At[4][2], B0[2][2], B1[2][2];
    const char* cA = (const char*)g.A + (size_t)cur.pm * tstep; const char* cB = (const char*)g.Bt + (size_t)cur.pn * tstep;
    if constexpr (SP2) {
        PG8_STAGE(PG8_SB(0, 0), cB, voffB); PG8_STAGE(PG8_SB(0, 1), cB + hstep, voffB); PG8_STAGE(PG8_SA(0, 0), cA, voffA); PG8_STAGE(PG8_SA(0, 1), cA + hstep, voffA);
        if (wr == 1) PG8_BAR;
        PG8_WAIT_V(2); PG8_BAR;
        PG8_STAGE(PG8_SB(1, 0), cB + kstep, voffB); PG8_STAGE(PG8_SA(1, 0), cA + kstep, voffA); PG8_STAGE(PG8_SB(1, 1), cB + hstep + kstep, voffB);
        PG8_WAIT_V(6); PG8_BAR;
    } else {
    PG8_STAGE(PG8_SB(0, 0), cB, voffB); PG8_STAGE(PG8_SA(0, 0), cA, voffA); PG8_STAGE(PG8_SB(0, 1), cB + hstep, voffB); PG8_STAGE(PG8_SA(0, 1), cA + hstep, voffA);
    if (wr == 1) PG8_BAR;
    PG8_WAIT_V(4); PG8_BAR;
    PG8_STAGE(PG8_SB(1, 0), cB + kstep, voffB); PG8_STAGE(PG8_SA(1, 0), cA + kstep, voffA); PG8_STAGE(PG8_SB(1, 1), cB + hstep + kstep, voffB);
    PG8_WAIT_V(6); PG8_BAR;
    }
    for (;;) {
        const bool has_next = S.next(ui + 1, nxt);
        const char* nA = has_next ? (const char*)g.A + (size_t)nxt.pm * tstep : cA; const char* nB = has_next ? (const char*)g.Bt + (size_t)nxt.pn * tstep : cB;
        for (int t = 0; t < nt; t += 2) {
            const bool last = (t == nt - 2);
            const char* a1 = cA + (size_t)(t + 1) * kstep;
            const char* a2 = last ? nA : cA + (size_t)(t + 2) * kstep; const char* b2 = last ? nB : cB + (size_t)(t + 2) * kstep;
            const char* a3 = a2 + kstep; const char* b3 = b2 + kstep;
            if constexpr (SP2) {
            PG8_LDB(B0, 0, 0); PG8_LDB(B1, 0, 1); PG8_SCHED; PG8_LDA(At, 0, 0); PG8_STAGE(PG8_SA(1, 1), a1 + hstep, voffA);
            PG8_WAIT_V(8); PG8_WAIT_L(0); PG8_BAR; PG8_MMA(0, 0, At, B0); PG8_MMA(0, 1, At, B1); PG8_BAR; PG8_SCHED;
            PG8_LDA(At, 0, 1); PG8_STAGE(PG8_SB(0, 0), b2, voffB); PG8_STAGE(PG8_SB(0, 1), b2 + hstep, voffB); PG8_STAGE(PG8_SA(0, 0), a2, voffA);
            PG8_WAIT_V(8); PG8_WAIT_L(0); PG8_BAR; PG8_MMA(1, 0, At, B0); PG8_MMA(1, 1, At, B1); PG8_BAR; PG8_SCHED;
            PG8_LDB(B0, 1, 0); PG8_LDB(B1, 1, 1); PG8_SCHED; PG8_LDA(At, 1, 0); PG8_STAGE(PG8_SA(0, 1), a2 + hstep, voffA);
            PG8_WAIT_V(8); PG8_WAIT_L(0); PG8_BAR; PG8_MMA(0, 0, At, B0); PG8_MMA(0, 1, At, B1); PG8_BAR; PG8_SCHED;
            PG8_LDA(At, 1, 1); PG8_STAGE(PG8_SB(1, 0), b3, voffB); PG8_STAGE(PG8_SB(1, 1), b3 + hstep, voffB); PG8_STAGE(PG8_SA(1, 0), a3, voffA);
            PG8_WAIT_V(8); PG8_WAIT_L(0); PG8_BAR; PG8_MMA(1, 0, At, B0); PG8_MMA(1, 1, At, B1); PG8_BAR; PG8_SCHED;
            } else {
            PG8_LDB(B0, 0, 0); PG8_SCHED; PG8_LDA(At, 0, 0); PG8_STAGE(PG8_SA(1, 1), a1 + hstep, voffA);
            PG8_WAIT_L(8); PG8_BAR; PG8_WAIT_L(0); PG8_MMA(0, 0, At, B0); PG8_BAR; PG8_SCHED;
            PG8_LDB(B1, 0, 1); PG8_STAGE(PG8_SB(0, 0), b2, voffB);
            PG8_BAR; PG8_WAIT_L(0); PG8_MMA(0, 1, At, B1); PG8_BAR;
            if constexpr (!HALF_M) PG8_LDA(At, 0, 1);
            PG8_STAGE(PG8_SA(0, 0), a2, voffA);
            PG8_BAR; PG8_WAIT_L(0); if constexpr (!HALF_M) PG8_MMA(1, 0, At, B0); PG8_BAR; PG8_SCHED;
            PG8_STAGE(PG8_SB(0, 1), b2 + hstep, voffB);
            PG8_WAIT_V(6); PG8_BAR; if constexpr (!HALF_M) PG8_MMA(1, 1, At, B1); PG8_BAR;
            PG8_LDB(B0, 1, 0); PG8_SCHED; PG8_LDA(At, 1, 0); PG8_STAGE(PG8_SA(0, 1), a2 + hstep, voffA);
            PG8_WAIT_L(8); PG8_BAR; PG8_WAIT_L(0); PG8_MMA(0, 0, At, B0); PG8_BAR; PG8_SCHED;
            PG8_LDB(B1, 1, 1); PG8_STAGE(PG8_SB(1, 0), b3, voffB);
            PG8_BAR; PG8_WAIT_L(0); PG8_MMA(0, 1, At, B1); PG8_BAR;
            if constexpr (!HALF_M) PG8_LDA(At, 1, 1);
            PG8_STAGE(PG8_SA(1, 0), a3, voffA);
            PG8_BAR; PG8_WAIT_L(0); if constexpr (!HALF_M) PG8_MMA(1, 0, At, B0); PG8_BAR; PG8_SCHED;
            PG8_STAGE(PG8_SB(1, 1), b3 + hstep, voffB);
            PG8_WAIT_V(6); PG8_BAR; if constexpr (!HALF_M) PG8_MMA(1, 1, At, B1); PG8_BAR;
            }
        }
        if constexpr (ALIGN_EPI) { if (wr == 0) PG8_BAR; }
        E(acc, cur, wr, wc, fr, fq);
        if (!has_next) break;
#pragma unroll
        for (int a = 0; a < 2; ++a)
#pragma unroll
            for (int b = 0; b < 2; ++b)
#pragma unroll
                for (int m = 0; m < 4; ++m)
#pragma unroll
                    for (int n = 0; n < 2; ++n) acc[a][b][m][n] = (f32x4){0.f, 0.f, 0.f, 0.f};
        cur = nxt; cA = nA; cB = nB; ++ui;
        if constexpr (ALIGN_EPI) { if (wr == 1) PG8_BAR; }
    }
    PG8_WAIT_V(0);
    if constexpr (!ALIGN_EPI) { if (wr == 0) PG8_BAR; }
    PG8_BAR;
#undef PG8_SA
#undef PG8_SB
#undef PG8_STAGE
#undef PG8_LDA
#undef PG8_LDB
#undef PG8_MMA
#undef PG8_WAIT_V
#undef PG8_WAIT_L
#undef PG8_BAR
#undef PG8_SCHED
}
}

struct Ctx {
    const float* xp; const float* xs; const float* stC; const float* stN; const float* stM; const float* ssm; const float* conv; const float* ck; const float* cv;
    float* out; unsigned char* ws;
};
#define XWIN ((bf16_t*)(X.ws + WS_WIN))
#define XWOUT ((bf16_t*)(X.ws + WS_WOUT))
#define XXB ((bf16_t*)(X.ws + WS_XB))
#define XU ((bf16_t*)(X.ws + WS_U))
#define XMIX ((bf16_t*)(X.ws + WS_MIX))
#define XSSQ ((float*)(X.ws + WS_SSQ))
#define XROPE ((float*)(X.ws + WS_ROPE))
#define XMC ((float*)(X.ws + WS_MC))
#define XMN ((float*)(X.ws + WS_MN))
#define XML ((float*)(X.ws + WS_ML))
#define XBL ((float*)(X.ws + WS_BL))
#define XMS ((float*)(X.ws + WS_MS))
#define XSA ((float*)(X.ws + WS_SA))
#define XSH ((float*)(X.ws + WS_SH))
#define XCSB ((bf16_t*)(X.ws + WS_CSB))
#define XNS ((float*)(X.ws + WS_NS))
#define XHSB ((bf16_t*)(X.ws + WS_HSB))
#define XPAR(off) ((const float*)(X.ws + WS_PAR) + (off))
constexpr int P_AIB = 0, P_AFB = 16, P_DTB = 32, P_ALOG = 64, P_BD = 96, P_SINK = 128, P_QNW = 160, P_KNW = 416, P_ANW = 672, P_BNW = 2720, P_CB = 4768, P_CW = 8864, P_END = 25248;
#define IN_XP 0
#define IN_XS 1
#define IN_STC 2
#define IN_STN 3
#define IN_STM 4
#define IN_SSM 5
#define IN_CONV 6
#define IN_CK 7
#define IN_CV 8
#define IN_NORMW 9
#define IN_WIN 10
#define IN_AIB 11
#define IN_AFB 12
#define IN_ANW 13
#define IN_CW 14
#define IN_CB 15
#define IN_DTB 16
#define IN_ALOG 17
#define IN_BD 18
#define IN_BNW 19
#define IN_QNW 20
#define IN_KNW 21
#define IN_SINK 22
#define IN_WOUT 23

__device__ __forceinline__ void transpose_strip(lptr lds, const float* src, int ldn, int nvalid, bf16_t* dst, int ldk, const float* scale, int k0, int n0, int tid) {
    LAS float* T = (LAS float*)lds;
    f32x4 v[8];
#pragma unroll
    for (int i = 0; i < 8; ++i) {
        const int f = tid + i * NT, r = f >> 6, c4 = (f & 63) * 4, n = n0 + c4;
        const f32x4 t = *(const f32x4*)(src + (size_t)(k0 + r) * ldn + (n < nvalid ? n : 0));
        const float m = n < nvalid ? (scale ? scale[k0 + r] : 1.f) : 0.f;
        v[i] = t * m;
    }
#pragma unroll
    for (int i = 0; i < 8; ++i) {
        const int f = tid + i * NT, r = f >> 6, c4 = (f & 63) * 4;
        T[r * 257 + c4 + 0] = v[i][0]; T[r * 257 + c4 + 1] = v[i][1]; T[r * 257 + c4 + 2] = v[i][2]; T[r * 257 + c4 + 3] = v[i][3];
    }
    __syncthreads();
#pragma unroll
    for (int i = 0; i < 4; ++i) {
        const int p = tid + i * NT, n = p >> 3, k8 = (p & 7) * 8; float f[8];
#pragma unroll
        for (int jx = 0; jx < 8; ++jx) f[jx] = T[(k8 + jx) * 257 + n];
        *(u32x4*)(dst + (size_t)(n0 + n) * ldk + k0 + k8) = pack8(f);
    }
    __syncthreads();
}

__device__ __forceinline__ void prologue(lptr lds, const Ctx& X, const Args& args, int G, int bid, int tid) {
    const int lane = tid & 63, wave = tid >> 6;
    constexpr int T0 = 1280, T1 = T0 + 384, T2 = T1 + 2080, T3 = T2 + 1, T4 = T3 + 513;
    for (int task = bid; task < T4; task += G) {
        if (task < T0) {
            const int l = task / 320, r = task % 320, kt = r / 20, ntl = r % 20;
            transpose_strip(lds, args.in[IN_WIN] + (size_t)l * D * DIN, DIN, DIN, XWIN + (size_t)l * NIN * D, D, args.in[IN_NORMW] + l * D, kt * 64, ntl * 256, tid);
        } else if (task < T1) {
            const int t = task - T0, l = t / 96, r = t % 96, kt = r / 4, ntl = r % 4;
            transpose_strip(lds, args.in[IN_WOUT] + (size_t)l * DMIX * D, D, D, XWOUT + (size_t)l * D * DMIX, DMIX, nullptr, kt * 64, ntl * 256, tid);
        } else if (task < T2) {
            const int r = (task - T1) * 8 + wave;
            float ss = 0.f;
            if (r < MTOK) {
                const float* src = r < TP ? X.xp + (size_t)r * D : X.xs + (size_t)(r - TP) * D;
#pragma unroll
                for (int i = 0; i < 4; ++i) {
                    const int c = lane * 4 + i * 256; f32x4 v = *(const f32x4*)(src + c);
                    ss += v[0] * v[0] + v[1] * v[1] + v[2] * v[2] + v[3] * v[3];
                    u32x2 w; w[0] = pk2(v[0], v[1]); w[1] = pk2(v[2], v[3]);
                    *(u32x2*)(XXB + (size_t)r * D + c) = w;
                }
            } else {
#pragma unroll
                for (int i = 0; i < 4; ++i) { u32x2 w = {0u, 0u}; *(u32x2*)(XXB + (size_t)r * D + lane * 4 + i * 256) = w; }
            }
            ss = wave_sum(ss);
            if (lane < 16) XSSQ[(size_t)r * 16 + lane] = (lane == 0) ? ss : 0.f;
        } else if (task < T3) {
            for (int i = tid; i < (MPAD - MTOK) * DMIX / 2; i += NT) ((unsigned*)(XMIX + (size_t)MTOK * DMIX))[i] = 0u;
            float* P = (float*)(X.ws + WS_PAR);
            const int po[12] = {P_AIB, P_AFB, P_DTB, P_ALOG, P_BD, P_SINK, P_QNW, P_KNW, P_ANW, P_BNW, P_CB, P_CW};
            const int pn[12] = {16, 16, 32, 32, 32, 32, 256, 256, 2048, 2048, 4096, 16384};
            const int pi[12] = {IN_AIB, IN_AFB, IN_DTB, IN_ALOG, IN_BD, IN_SINK, IN_QNW, IN_KNW, IN_ANW, IN_BNW, IN_CB, IN_CW};
#pragma unroll
            for (int a = 0; a < 12; ++a) { const float* src = args.in[pi[a]]; for (int i = tid; i < pn[a]; i += NT) P[po[a] + i] = src[i]; }
        } else {
            const int e = (task - T3) * 512 + tid;
            if (e < 8193 * 32) {
                const int pos = e >> 5, d = e & 31;
                const float inv = (float)exp2(-(double)d * (13.287712379549449 / 32.0));
                const float angf = (float)pos * inv;
                const double a = (double)angf;
                const double k = rint(a * 0.15915494309189535);
                const float rr = (float)(a - k * 6.283185307179586);
                XROPE[(size_t)e * 2] = cosf(rr); XROPE[(size_t)e * 2 + 1] = sinf(rr);
            }
        }
    }
}

__device__ __forceinline__ void conv8(const bf16_t* u, int seq0, int tt, int ch, const float* cw, const float* cb, float (&o)[8]) {
    float acc[8];
    { f32x4 b0 = *(const f32x4*)(cb + ch), b1 = *(const f32x4*)(cb + ch + 4);
#pragma unroll
      for (int j = 0; j < 4; ++j) { acc[j] = b0[j]; acc[4 + j] = b1[j]; } }
#pragma unroll
    for (int jj = 0; jj < 4; ++jj) {
        const int t2 = tt + jj - 3;
        if (t2 >= 0) {
            float x[8]; unpack8(*(const u32x4*)(u + (size_t)(seq0 + t2) * NIN + C_BX + ch), x);
            f32x4 w0 = *(const f32x4*)(cw + jj * 1024 + ch), w1 = *(const f32x4*)(cw + jj * 1024 + ch + 4);
#pragma unroll
            for (int j = 0; j < 4; ++j) { acc[j] += x[j] * w0[j]; acc[4 + j] += x[4 + j] * w1[j]; }
        }
    }
#pragma unroll
    for (int j = 0; j < 8; ++j) o[j] = siluf_(acc[j]);
}


__device__ __forceinline__ void conv8x8(const bf16_t* u, int seq0, int tt0, int ch, const float* cw, const float* cb, float (&o)[8][8]) {
    float w[4][8];
#pragma unroll
    for (int jj = 0; jj < 4; ++jj) { f32x4 w0 = *(const f32x4*)(cw + jj * 1024 + ch), w1 = *(const f32x4*)(cw + jj * 1024 + ch + 4);
#pragma unroll
        for (int j = 0; j < 4; ++j) { w[jj][j] = w0[j]; w[jj][4 + j] = w1[j]; } }
    { f32x4 b0 = *(const f32x4*)(cb + ch), b1 = *(const f32x4*)(cb + ch + 4);
#pragma unroll
      for (int t = 0; t < 8; ++t)
#pragma unroll
          for (int j = 0; j < 4; ++j) { o[t][j] = b0[j]; o[t][4 + j] = b1[j]; } }
    u32x4 raw[11];
#pragma unroll
    for (int r = 0; r < 11; ++r) {
        const int t2 = tt0 + r - 3;
        const u32x4 v = *(const u32x4*)(u + (size_t)(seq0 + (t2 >= 0 ? t2 : 0)) * NIN + C_BX + ch);
        const unsigned msk = t2 >= 0 ? 0xffffffffu : 0u;
        raw[r] = (u32x4){v[0] & msk, v[1] & msk, v[2] & msk, v[3] & msk};
    }
#pragma unroll
    for (int r = 0; r < 11; ++r) {
        float x[8]; unpack8(raw[r], x);
#pragma unroll
        for (int jj = 0; jj < 4; ++jj) {
            const int t = r - jj;
            if (t >= 0 && t < 8) {
#pragma unroll
                for (int j = 0; j < 8; ++j) o[t][j] += x[j] * w[jj][j];
            }
        }
    }
#pragma unroll
    for (int t = 0; t < 8; ++t)
#pragma unroll
        for (int j = 0; j < 8; ++j) o[t][j] = siluf_(o[t][j]);
}

__device__ __forceinline__ void mlstm_local(lptr lds, const Ctx& X, int l, int task, int tid) {
    const int h = task & 3, c = (task >> 2) & 127, n = task >> 9;
    const int lane = tid & 63, wave = tid >> 6, fr = lane & 15, fq = lane >> 4;
    const int row0 = n * SEQ + c * 64, nh = n * 4 + h;
    lptr VwT = lds;
    lptr KT = lds + 18432;
    LAS float* wv = (LAS float*)(lds + 27648);
    u32x4 vraw[2], kraw;
#pragma unroll
    for (int it = 0; it < 2; ++it) { const int p = tid + it * NT, tok = p >> 4, v8 = (p & 15) * 8; vraw[it] = *(const u32x4*)(XU + (size_t)(row0 + tok) * NIN + C_AV + h * 128 + v8); }
    { const int tok = tid >> 3, k8 = (tid & 7) * 8; kraw = *(const u32x4*)(XU + (size_t)(row0 + tok) * NIN + C_AK + h * 64 + k8); }
    if (wave == 0) {
        const bf16_t* ur = XU + (size_t)(row0 + lane) * NIN;
        const float fg = bf2f(ur[C_AF + h]) + XPAR(P_AFB)[l * 4 + h], ig = bf2f(ur[C_AI + h]) + XPAR(P_AIB)[l * 4 + h];
        const float b = wave_scan_sum(logsigf_(fg), lane);
        const float bl = __shfl(b, 63);
        const float g = bl - b + ig;
        const float ml = wave_max(g);
        wv[lane] = __expf(g - ml);
        if (lane == 0) { XML[nh * 128 + c] = ml; XBL[nh * 128 + c] = bl; }
    }
    __syncthreads();
#pragma unroll
    for (int it = 0; it < 2; ++it) {
        const int p = tid + it * NT, tok = p >> 4, v8 = (p & 15) * 8;
        float x[8]; unpack8(vraw[it], x);
        const float w = wv[tok];
#pragma unroll
        for (int j = 0; j < 8; ++j) *(LAS bf16_t*)(VwT + (((v8 + j) * 72 + tok) << 1)) = (bf16_t)f2bf(x[j] * w);
    }
    {
        const int tok = tid >> 3, k8 = (tid & 7) * 8;
        float x[8]; unpack8(kraw, x);
#pragma unroll
        for (int j = 0; j < 8; ++j) *(LAS bf16_t*)(KT + (((k8 + j) * 72 + tok) << 1)) = (bf16_t)f2bf(x[j] * 0.125f);
    }
    __syncthreads();
    {
        bf16_t* dst = (bf16_t*)XMC + ((size_t)nh * 128 + c) * 8192;
        bf16x8 b0 = lds_frag(VwT, 16 * wave + fr, fq * 8, 72), b1 = lds_frag(VwT, 16 * wave + fr, 32 + fq * 8, 72);
#pragma unroll
        for (int mt = 0; mt < 4; ++mt) {
            f32x4 acc = {0.f, 0.f, 0.f, 0.f};
            acc = mfma16(lds_frag(KT, 16 * mt + fr, fq * 8, 72), b0, acc);
            acc = mfma16(lds_frag(KT, 16 * mt + fr, 32 + fq * 8, 72), b1, acc);
            { u32x2 w; w[0] = pk2(acc[0], acc[1]); w[1] = pk2(acc[2], acc[3]); *(u32x2*)(dst + (16 * wave + fr) * 64 + 16 * mt + 4 * fq) = w; }
        }
    }
    if (tid < 64) {
        float s = 0.f;
#pragma unroll 8
        for (int t = 0; t < 64; ++t) s += bf2f(*(const LAS bf16_t*)(KT + ((tid * 72 + t) << 1))) * wv[t];
        XMN[((size_t)nh * 128 + c) * 64 + tid] = s;
    }
    __syncthreads();
}

__device__ __forceinline__ void ssd_local(lptr lds, const Ctx& X, int l, int task, int tid) {
    const int g = task & 1, c = (task >> 1) & 127, n = task >> 8;
    const int lane = tid & 63, wave = tid >> 6, fr = lane & 15, fq = lane >> 4;
    const int seq0 = n * SEQ, row0 = seq0 + c * 64;
    lptr XwT = lds;
    lptr BT = lds + 36864;
    LAS float* wl = (LAS float*)(lds + 55296);
    {
        const float* cw = XPAR(P_CW) + l * 4096; const float* cb = XPAR(P_CB) + l * 1024;
        const int cg = lane;
        float o[8][8];
        {
            const int cgc = cg < 48 ? cg : 47;
            const int ch = cgc < 32 ? g * 256 + cgc * 8 : 512 + g * 128 + (cgc - 32) * 8;
            conv8x8(XU, seq0, c * 64 + 8 * wave, ch, cw, cb, o);
        }
    if (wave < 4) {
        const int hh = 4 * g + wave;
        const float dt = softplusf_(bf2f(XU[(size_t)(row0 + lane) * NIN + C_BDT + hh]) + XPAR(P_DTB)[l * 8 + hh]);
        const float A = -__expf(XPAR(P_ALOG)[l * 8 + hh]);
        const float a = wave_scan_sum(dt * A, lane);
        const float aL = __shfl(a, 63);
        wl[wave * 64 + lane] = __expf(aL - a) * dt;
        if (lane == 0) XSA[(n * 8 + hh) * 128 + c] = aL;
    }
    __syncthreads();
        if (cg < 48) {
            if (cg < 32) {
                float wt[8];
#pragma unroll
                for (int t = 0; t < 8; ++t) wt[t] = wl[(cg >> 3) * 64 + 8 * wave + t];
#pragma unroll
                for (int jx = 0; jx < 8; ++jx) {
                    float v[8];
#pragma unroll
                    for (int t = 0; t < 8; ++t) v[t] = o[t][jx] * wt[t];
                    *(LAS u32x4*)(XwT + (((cg * 8 + jx) * 72 + 8 * wave) << 1)) = pack8(v);
                }
            } else {
#pragma unroll
                for (int jx = 0; jx < 8; ++jx) {
                    float v[8];
#pragma unroll
                    for (int t = 0; t < 8; ++t) v[t] = o[t][jx];
                    *(LAS u32x4*)(BT + ((((cg - 32) * 8 + jx) * 72 + 8 * wave) << 1)) = pack8(v);
                }
            }
        }
    }
    __syncthreads();
    {
        const int hl = wave >> 1, ph = wave & 1, hh = 4 * g + hl;
        bf16_t* dst = (bf16_t*)XSH + ((size_t)(n * 8 + hh) * 128 + c) * 8192;
        bf16x8 bx[2][2];
#pragma unroll
        for (int ntl = 0; ntl < 2; ++ntl)
#pragma unroll
            for (int kk = 0; kk < 2; ++kk) bx[ntl][kk] = lds_frag(XwT, hl * 64 + ph * 32 + ntl * 16 + fr, kk * 32 + fq * 8, 72);
#pragma unroll
        for (int mt = 0; mt < 8; ++mt) {
            bf16x8 a0 = lds_frag(BT, 16 * mt + fr, fq * 8, 72), a1 = lds_frag(BT, 16 * mt + fr, 32 + fq * 8, 72);
#pragma unroll
            for (int ntl = 0; ntl < 2; ++ntl) {
                f32x4 acc = {0.f, 0.f, 0.f, 0.f};
                acc = mfma16(a0, bx[ntl][0], acc); acc = mfma16(a1, bx[ntl][1], acc);
                { u32x2 w; w[0] = pk2(acc[0], acc[1]); w[1] = pk2(acc[2], acc[3]); *(u32x2*)(dst + (ph * 32 + ntl * 16 + fr) * 128 + 16 * mt + 4 * fq) = w; }
            }
        }
    }
    __syncthreads();
}

__device__ __forceinline__ void swa_prompt(lptr lds, const Ctx& X, int l, int task, int tid) {
    const int kvh = task & 1, qb = (task >> 1) & 63, n = task >> 7;
    const int lane = tid & 63, wave = tid >> 6, fr = lane & 15, fq = lane >> 4;
    const int seq0 = n * SEQ;
    lptr Kn = lds;
    lptr Vt = lds + 36864;
    lptr Pw = lds + 70656 + wave * 8448;
    const float* knw = XPAR(P_KNW) + l * 64; const float* qnw = XPAR(P_QNW) + l * 64;
#pragma unroll
    for (int it = 0; it < 2; ++it) {
        const int item = tid + it * NT, j = item >> 2, qd = item & 3, t = qb * 128 - 128 + j;
        float o1[8], o2[8];
        {
            const int tc = t >= 0 ? t : 0;
            const bf16_t* kr = XU + (size_t)(seq0 + tc) * NIN + C_CK + kvh * 64;
            float x1[8], x2[8]; unpack8(*(const u32x4*)(kr + qd * 8), x1); unpack8(*(const u32x4*)(kr + 32 + qd * 8), x2);
            float ss = 0.f;
#pragma unroll
            for (int jj = 0; jj < 8; ++jj) ss += x1[jj] * x1[jj] + x2[jj] * x2[jj];
            ss += __shfl_xor(ss, 1); ss += __shfl_xor(ss, 2);
            const float rs = rsqrtf(ss * (1.f / 64.f) + EPS);
            const f32x4* cs = (const f32x4*)(XROPE + ((size_t)tc * 32 + qd * 8) * 2);
            f32x4 csv[4];
#pragma unroll
            for (int q4 = 0; q4 < 4; ++q4) csv[q4] = cs[q4];
            const float zm = t >= 0 ? 1.f : 0.f;
#pragma unroll
            for (int jj = 0; jj < 8; ++jj) {
                const float a = x1[jj] * rs * knw[qd * 8 + jj], b = x2[jj] * rs * knw[32 + qd * 8 + jj], co = csv[jj >> 1][(jj & 1) * 2], si = csv[jj >> 1][(jj & 1) * 2 + 1];
                o1[jj] = (a * co - b * si) * zm; o2[jj] = (b * co + a * si) * zm;
            }
        }
        *(LAS u32x4*)(Kn + ((j * 72 + qd * 8) << 1)) = pack8(o1);
        *(LAS u32x4*)(Kn + ((j * 72 + 32 + qd * 8) << 1)) = pack8(o2);
        if (qb == 63 && j >= 128) {
            float* ko = X.out + O_PK + ((((size_t)l * 2 + n) * 128 + (j - 128)) * 2 + kvh) * 64;
            *(f32x4*)(ko + qd * 8) = (f32x4){o1[0], o1[1], o1[2], o1[3]}; *(f32x4*)(ko + qd * 8 + 4) = (f32x4){o1[4], o1[5], o1[6], o1[7]};
            *(f32x4*)(ko + 32 + qd * 8) = (f32x4){o2[0], o2[1], o2[2], o2[3]}; *(f32x4*)(ko + 32 + qd * 8 + 4) = (f32x4){o2[4], o2[5], o2[6], o2[7]};
        }
    }
#pragma unroll
    for (int it = 0; it < 4; ++it) {
        const int item = tid + it * NT, j = item >> 3, d8 = (item & 7) * 8, t = qb * 128 - 128 + j;
        u32x4 w = *(const u32x4*)(XU + (size_t)(seq0 + (t >= 0 ? t : 0)) * NIN + C_CV + kvh * 64 + d8);
        { const unsigned msk = t >= 0 ? 0xffffffffu : 0u; w = (u32x4){w[0] & msk, w[1] & msk, w[2] & msk, w[3] & msk}; }
#pragma unroll
        for (int jj = 0; jj < 8; ++jj) *(LAS bf16_t*)(Vt + (((d8 + jj) * 264 + j) << 1)) = (bf16_t)((w[jj >> 1] >> ((jj & 1) * 16)) & 0xffffu);
        if (qb == 63 && j >= 128) {
            float x[8]; unpack8(w, x);
            float* vo = X.out + O_PV + ((((size_t)l * 2 + n) * 128 + (j - 128)) * 2 + kvh) * 64 + d8;
            *(f32x4*)(vo) = (f32x4){x[0], x[1], x[2], x[3]}; *(f32x4*)(vo + 4) = (f32x4){x[4], x[5], x[6], x[7]};
        }
    }
    __syncthreads();
    const int hq = kvh * 4 + (wave >> 1), i0 = (wave & 1) * 64;
    const float sink = XPAR(P_SINK)[l * 8 + hq];
    float qw1[8], qw2[8];
#pragma unroll
    for (int jj = 0; jj < 8; ++jj) { qw1[jj] = qnw[fq * 8 + jj]; qw2[jj] = qnw[32 + fq * 8 + jj]; }
    u32x4 qn0, qn1; f32x4 csn[4];
    {
        const int t = qb * 128 + i0 + fr;
        const bf16_t* qr = XU + (size_t)(seq0 + t) * NIN + C_CQ + hq * 64;
        qn0 = *(const u32x4*)(qr + fq * 8); qn1 = *(const u32x4*)(qr + 32 + fq * 8);
        const f32x4* cs = (const f32x4*)(XROPE + ((size_t)t * 32 + fq * 8) * 2);
#pragma unroll
        for (int q4 = 0; q4 < 4; ++q4) csn[q4] = cs[q4];
    }
#pragma unroll 1
    for (int mt = 0; mt < 4; ++mt) {
        const int q0 = i0 + mt * 16;
        const u32x4 q0r = qn0, q1r = qn1; f32x4 csc[4];
#pragma unroll
        for (int q4 = 0; q4 < 4; ++q4) csc[q4] = csn[q4];
        unsigned short czv[4][4];
#pragma unroll
        for (int ii = 0; ii < 4; ++ii)
#pragma unroll
            for (int ntl = 0; ntl < 4; ++ntl) czv[ntl][ii] = XU[((size_t)seq0 + qb * 128 + q0 + fq * 4 + ii) * NIN + C_CZ + hq * 64 + 16 * ntl + fr];
        {
            const int mn = mt < 3 ? mt + 1 : 3;
            const int t = qb * 128 + i0 + mn * 16 + fr;
            const bf16_t* qr = XU + (size_t)(seq0 + t) * NIN + C_CQ + hq * 64;
            qn0 = *(const u32x4*)(qr + fq * 8); qn1 = *(const u32x4*)(qr + 32 + fq * 8);
            const f32x4* cs = (const f32x4*)(XROPE + ((size_t)t * 32 + fq * 8) * 2);
#pragma unroll
            for (int q4 = 0; q4 < 4; ++q4) csn[q4] = cs[q4];
        }
        bf16x8 a0, a1;
        {
            float x1[8], x2[8]; unpack8(q0r, x1); unpack8(q1r, x2);
            float ss = 0.f;
#pragma unroll
            for (int jj = 0; jj < 8; ++jj) ss += x1[jj] * x1[jj] + x2[jj] * x2[jj];
            ss += __shfl_xor(ss, 16); ss += __shfl_xor(ss, 32);
            const float rs = rsqrtf(ss * (1.f / 64.f) + EPS) * 0.125f;
            float o1[8], o2[8];
#pragma unroll
            for (int jj = 0; jj < 8; ++jj) {
                const float a = x1[jj] * rs * qw1[jj], b = x2[jj] * rs * qw2[jj], co = csc[jj >> 1][(jj & 1) * 2], si = csc[jj >> 1][(jj & 1) * 2 + 1];
                o1[jj] = a * co - b * si; o2[jj] = b * co + a * si;
            }
            a0 = as_frag(pack8(o1)); a1 = as_frag(pack8(o2));
        }
        const int tlo = q0 >> 4;
        const int qi = q0 + fr;
        f32x4 s[16];
        float mx = -3.0e38f;
#pragma unroll
        for (int ntl = 0; ntl < 16; ++ntl) {
            if (ntl >= tlo && ntl <= tlo + 8) {
                f32x4 acc = {0.f, 0.f, 0.f, 0.f};
                acc = mfma16(lds_frag(Kn, 16 * ntl + fr, fq * 8, 72), a0, acc);
                acc = mfma16(lds_frag(Kn, 16 * ntl + fr, 32 + fq * 8, 72), a1, acc);
#pragma unroll
                for (int ii = 0; ii < 4; ++ii) {
                    const int jk = 16 * ntl + 4 * fq + ii;
                    const bool valid = (jk > qi) && (jk <= qi + 128) && (qb > 0 || jk >= 128);
                    acc[ii] = valid ? acc[ii] : -3.0e38f;
                    mx = fmaxf(mx, acc[ii]);
                }
                s[ntl] = acc;
            }
        }
        mx = fmaxf(mx, __shfl_xor(mx, 16)); mx = fmaxf(mx, __shfl_xor(mx, 32));
        mx = fmaxf(mx, sink);
        float sum = 0.f;
#pragma unroll
        for (int ntl = 0; ntl < 16; ++ntl) {
            if (ntl >= tlo && ntl <= tlo + 8) {
#pragma unroll
                for (int ii = 0; ii < 4; ++ii) { const float e = (s[ntl][ii] > -1.0e38f) ? __expf(s[ntl][ii] - mx) : 0.f; s[ntl][ii] = e; sum += e; }
            }
        }
        sum += __shfl_xor(sum, 16); sum += __shfl_xor(sum, 32);
        const float inv = 1.f / (sum + __expf(sink - mx));
        const int klo = q0 >> 5, khi = (q0 + 143) >> 5;
#pragma unroll
        for (int ntl = 0; ntl < 16; ++ntl) {
            if (ntl >= tlo && ntl <= tlo + 8) {
                u32x2 w; w[0] = pk2(s[ntl][0] * inv, s[ntl][1] * inv); w[1] = pk2(s[ntl][2] * inv, s[ntl][3] * inv);
                *(LAS u32x2*)(Pw + ((fr * 264 + 16 * ntl + 4 * fq) << 1)) = w;
            } else if ((ntl >> 1) >= klo && (ntl >> 1) <= khi) {
                u32x2 w = {0u, 0u};
                *(LAS u32x2*)(Pw + ((fr * 264 + 16 * ntl + 4 * fq) << 1)) = w;
            }
        }
        LDS_FENCE();
        f32x4 o[4];
#pragma unroll
        for (int ntl = 0; ntl < 4; ++ntl) o[ntl] = (f32x4){0.f, 0.f, 0.f, 0.f};
#pragma unroll
        for (int kk = 0; kk < 8; ++kk) {
            if (kk >= klo && kk <= khi) {
                const bf16x8 a = lds_frag(Pw, fr, kk * 32 + fq * 8, 264);
#pragma unroll
                for (int ntl = 0; ntl < 4; ++ntl) o[ntl] = mfma16(a, lds_frag(Vt, 16 * ntl + fr, kk * 32 + fq * 8, 264), o[ntl]);
            }
        }
        LDS_FENCE();
#pragma unroll
        for (int ii = 0; ii < 4; ++ii) {
            const size_t row = (size_t)seq0 + qb * 128 + q0 + fq * 4 + ii;
#pragma unroll
            for (int ntl = 0; ntl < 4; ++ntl) {
                const int d = 16 * ntl + fr;
                XMIX[row * DMIX + 1024 + hq * 64 + d] = (bf16_t)f2bf(o[ntl][ii] * siluf_(bf2f(czv[ntl][ii])));
            }
        }
    }
    __syncthreads();
}

__device__ __forceinline__ void sample_task(lptr lds, const Ctx& X, int l, int b, int part, int tid) {
    LAS float* uf = (LAS float*)lds;
    LAS float* xbc = (LAS float*)(lds + 19968);
    LAS float* numv = (LAS float*)(lds + 24064);
    LAS float* yv = (LAS float*)(lds + 26112);
    LAS float* red = (LAS float*)(lds + 28160);
    LAS float* qs = (LAS float*)(lds + 28416);
    LAS float* kn = (LAS float*)(lds + 30464);
    LAS float* sc = (LAS float*)(lds + 30976);
    const int lane = tid & 63, wave = tid >> 6;
    const size_t row = (size_t)TP + b;
    const bf16_t* ur = XU + row * NIN;
    const size_t lb = (size_t)l * 128 + b;
    f32x4 kpre[8], vpre[8];
    if (part == 2) {
        const float* kc = X.ck + lb * 16384; const float* vc = X.cv + lb * 16384;
#pragma unroll
        for (int it = 0; it < 8; ++it) {
            const int e = (tid + it * NT) * 4, e2 = e < 127 * 128 ? e + 128 : e;
            kpre[it] = *(const f32x4*)(kc + e2); vpre[it] = *(const f32x4*)(vc + e2);
        }
    }
    {
        const int c_lo = part == 0 ? 0 : (part == 1 ? C_BZ : C_CQ), c_hi = part == 0 ? C_BZ : (part == 1 ? C_CQ : DIN);
#pragma unroll 2
        for (int i = c_lo + tid; i < c_hi; i += NT) uf[i] = bf2f(ur[i]);
    }
    __syncthreads();
    if (part == 0) {
#pragma unroll
    for (int h = 0; h < 4; ++h) {
        const float ig = uf[C_AI + h] + XPAR(P_AIB)[l * 4 + h], fg = uf[C_AF + h] + XPAR(P_AFB)[l * 4 + h];
        const float ls = logsigf_(fg), m0 = X.stM[lb * 4 + h];
        const float mn = fmaxf(ls + m0, ig), sp = __expf(ls + m0 - mn), sl = __expf(ig - mn);
        const float* C0 = X.stC + (lb * 4 + h) * 8192; float* C1 = X.out + O_SC + (lb * 4 + h) * 8192;
#pragma unroll
        for (int it = 0; it < 4; ++it) {
            const int e = (tid + it * NT) * 4, v = e >> 6, k = e & 63;
            const f32x4 c0 = *(const f32x4*)(C0 + e);
            const float vv = uf[C_AV + h * 128 + v] * sl;
            f32x4 c1; float part = 0.f;
#pragma unroll
            for (int j = 0; j < 4; ++j) { c1[j] = sp * c0[j] + vv * (uf[C_AK + h * 64 + k + j] * 0.125f); part += c1[j] * uf[C_AQ + h * 64 + k + j]; }
            *(f32x4*)(C1 + e) = c1;
            part = red16(part);
            if ((lane & 15) == 0) numv[h * 128 + v] = part;
        }
        if (wave == 0) {
            const float n1 = sp * X.stN[(lb * 4 + h) * 64 + lane] + sl * uf[C_AK + h * 64 + lane] * 0.125f;
            X.out[O_SN + (lb * 4 + h) * 64 + lane] = n1;
            const float dd = wave_sum(n1 * uf[C_AQ + h * 64 + lane]);
            if (lane == 0) { red[h] = dd; red[4 + h] = mn; X.out[O_SM + lb * 4 + h] = mn; }
        }
    }
    __syncthreads();
    float hv;
    { const int h = tid >> 7; hv = numv[tid] / fmaxf(fabsf(red[h]), __expf(-red[4 + h])); const float ss = wave_sum(hv * hv); if (lane == 0) red[8 + wave] = ss; }
    __syncthreads();
    { const int h = tid >> 7; const float rs = rsqrtf((red[8 + 2 * h] + red[9 + 2 * h]) * (1.f / 128.f) + EPS);
      XMIX[row * DMIX + tid] = (bf16_t)f2bf(hv * rs * XPAR(P_ANW)[l * 512 + tid] * sigmoidf_(uf[C_AO + tid]) * siluf_(uf[C_AZ + tid])); }
    }
    if (part == 1) {
    {
        const float* buf = X.conv + lb * 3 * 1024; float* oc = X.out + O_SCONV + lb * 3 * 1024;
        const float* cw = XPAR(P_CW) + l * 4096;
#pragma unroll
        for (int it = 0; it < 2; ++it) {
            const int ch = tid + it * NT;
            const float f0 = buf[ch], f1 = buf[1024 + ch], f2 = buf[2048 + ch], f3 = uf[C_BX + ch];
            const float acc = XPAR(P_CB)[l * 1024 + ch] + f0 * cw[ch] + f1 * cw[1024 + ch] + f2 * cw[2048 + ch] + f3 * cw[3072 + ch];
            xbc[ch] = siluf_(acc);
            oc[ch] = f1; oc[1024 + ch] = f2; oc[2048 + ch] = f3;
        }
    }
    __syncthreads();
#pragma unroll 4
    for (int hh = 0; hh < 8; ++hh) {
        const float dt = softplusf_(uf[C_BDT + hh] + XPAR(P_DTB)[l * 8 + hh]);
        const float dA = __expf(-dt * __expf(XPAR(P_ALOG)[l * 8 + hh]));
        const int g = hh >> 2;
        const float* h0p = X.ssm + (lb * 8 + hh) * 8192; float* h1p = X.out + O_SH + (lb * 8 + hh) * 8192;
#pragma unroll
        for (int it = 0; it < 4; ++it) {
            const int e = (tid + it * NT) * 4, p = e >> 7, s = e & 127;
            const f32x4 h0 = *(const f32x4*)(h0p + e);
            const float xv = xbc[hh * 64 + p] * dt;
            f32x4 h1; float part = 0.f;
#pragma unroll
            for (int j = 0; j < 4; ++j) { h1[j] = dA * h0[j] + xv * xbc[512 + g * 128 + s + j]; part += h1[j] * xbc[768 + g * 128 + s + j]; }
            *(f32x4*)(h1p + e) = h1;
            part = red16(part); part += __shfl_xor(part, 16);
            if ((lane & 31) == 0) yv[hh * 64 + p] = part;
        }
    }
    __syncthreads();
    float gb;
    { const int hh = tid >> 6; const float y = yv[tid] + XPAR(P_BD)[l * 8 + hh] * xbc[tid]; gb = y * siluf_(uf[C_BZ + tid]); const float ss = wave_sum(gb * gb); if (lane == 0) red[16 + wave] = ss; }
    __syncthreads();
    { const int g = tid >> 8; const float rs = rsqrtf((red[16 + 4 * g] + red[17 + 4 * g] + red[18 + 4 * g] + red[19 + 4 * g]) * (1.f / 256.f) + EPS);
      XMIX[row * DMIX + 512 + tid] = (bf16_t)f2bf(gb * rs * XPAR(P_BNW)[l * 512 + tid]); }
    }
    if (part == 2) {
    lptr Kl = lds + 36864;
    lptr Vl = lds + 36864 + 34816;
    if (tid < 320) {
        const int vec = tid >> 5, d = tid & 31, base = vec < 8 ? C_CQ + vec * 64 : C_CK + (vec - 8) * 64;
        const float x1 = uf[base + d], x2 = uf[base + 32 + d];
        float ss = x1 * x1 + x2 * x2; ss = red16(ss); ss += __shfl_xor(ss, 16);
        const float rs = rsqrtf(ss * (1.f / 64.f) + EPS);
        const float* w = vec < 8 ? XPAR(P_QNW) + l * 64 : XPAR(P_KNW) + l * 64;
        const float a = x1 * rs * w[d], bb = x2 * rs * w[d + 32];
        const float co = XROPE[((size_t)8192 * 32 + d) * 2], si = XROPE[((size_t)8192 * 32 + d) * 2 + 1];
        const float o1 = a * co - bb * si, o2 = bb * co + a * si;
        if (vec < 8) { qs[vec * 64 + d] = o1 * 0.125f; qs[vec * 64 + 32 + d] = o2 * 0.125f; } else { kn[(vec - 8) * 64 + d] = o1; kn[(vec - 8) * 64 + 32 + d] = o2; }
    }
    __syncthreads();
    {
        float* ko = X.out + O_SK + lb * 16384; float* vo = X.out + O_SV + lb * 16384;
#pragma unroll
        for (int it = 0; it < 8; ++it) {
            const int e = (tid + it * NT) * 4, j = e >> 7, r = e & 127;
            f32x4 kv = kpre[it], vv = vpre[it];
            if (j == 127) { kv = (f32x4){kn[r], kn[r + 1], kn[r + 2], kn[r + 3]}; vv = (f32x4){uf[C_CV + r], uf[C_CV + r + 1], uf[C_CV + r + 2], uf[C_CV + r + 3]}; }
            *(f32x4*)(ko + e) = kv; *(f32x4*)(vo + e) = vv;
            u32x2 wk, wv2; wk[0] = pk2(kv[0], kv[1]); wk[1] = pk2(kv[2], kv[3]); wv2[0] = pk2(vv[0], vv[1]); wv2[1] = pk2(vv[2], vv[3]);
            *(LAS u32x2*)(Kl + ((j * 136 + r) << 1)) = wk; *(LAS u32x2*)(Vl + ((j * 136 + r) << 1)) = wv2;
        }
    }
    __syncthreads();
    if (tid < 256) {
        const int kvh = tid >> 7, jj = tid & 127;
        float s0 = 0.f, s1 = 0.f, s2 = 0.f, s3 = 0.f;
#pragma unroll 2
        for (int d8 = 0; d8 < 8; ++d8) {
            float kf[8]; unpack8(*(const LAS u32x4*)(Kl + ((jj * 136 + kvh * 64 + d8 * 8) << 1)), kf);
#pragma unroll
            for (int j = 0; j < 8; ++j) {
                s0 += kf[j] * qs[(kvh * 4 + 0) * 64 + d8 * 8 + j]; s1 += kf[j] * qs[(kvh * 4 + 1) * 64 + d8 * 8 + j];
                s2 += kf[j] * qs[(kvh * 4 + 2) * 64 + d8 * 8 + j]; s3 += kf[j] * qs[(kvh * 4 + 3) * 64 + d8 * 8 + j];
            }
        }
        sc[(kvh * 4 + 0) * 128 + jj] = s0; sc[(kvh * 4 + 1) * 128 + jj] = s1; sc[(kvh * 4 + 2) * 128 + jj] = s2; sc[(kvh * 4 + 3) * 128 + jj] = s3;
    }
    __syncthreads();
    {
        const int hq = wave; const float s0 = sc[hq * 128 + lane], s1 = sc[hq * 128 + 64 + lane], sink = XPAR(P_SINK)[l * 8 + hq];
        const float m = fmaxf(wave_max(fmaxf(s0, s1)), sink);
        const float e0 = __expf(s0 - m), e1 = __expf(s1 - m);
        const float inv = 1.f / (wave_sum(e0 + e1) + __expf(sink - m));
        sc[hq * 128 + lane] = e0 * inv; sc[hq * 128 + 64 + lane] = e1 * inv;
    }
    __syncthreads();
    {
        const int hq = tid >> 6, d = tid & 63, kvh = hq >> 2;
        float o = 0.f;
#pragma unroll 16
        for (int jj = 0; jj < 128; ++jj) o += sc[hq * 128 + jj] * bf2f(*(const LAS bf16_t*)(Vl + ((jj * 136 + kvh * 64 + d) << 1)));
        XMIX[row * DMIX + 1024 + tid] = (bf16_t)f2bf(o * siluf_(uf[C_CZ + tid]));
    }
    }
    __syncthreads();
}

__device__ __forceinline__ void scans(const Ctx& X, int l, int gt, int nthreads) {
    for (int item = gt; item < 98816; item += nthreads) {
        if (item < 32768) {
            const int nh = item >> 12, e = (item & 4095) * 2;
            const bf16_t* base = (const bf16_t*)XMC + (size_t)nh * 128 * 8192 + e;
            const float* ml = XML + nh * 128; const float* bl = XBL + nh * 128;
            float m = 0.f; f32x2 st = {0.f, 0.f};
            for (int c0 = 0; c0 < 128; c0 += 8) {
                f32x2 cl[8];
#pragma unroll
                for (int j = 0; j < 8; ++j) { const unsigned w = *(const unsigned*)(base + (size_t)(c0 + j) * 8192); cl[j] = (f32x2){__uint_as_float(w << 16), __uint_as_float(w & 0xffff0000u)}; }
#pragma unroll
                for (int j = 0; j < 8; ++j) {
                    const float mlj = ml[c0 + j], blj = bl[c0 + j], mn = fmaxf(blj + m, mlj), sp = __expf(blj + m - mn), sl = __expf(mlj - mn);
                    *(unsigned*)(XCSB + ((size_t)nh * 128 + c0 + j) * 8192 + e) = pk2(st[0], st[1]);
                    if (e == 0) XMS[nh * 128 + c0 + j] = m;
                    st = st * sp + cl[j] * sl; m = mn;
                }
            }
            *(f32x2*)(X.out + O_PC + ((size_t)l * 8 + nh) * 8192 + e) = st;
            if (e == 0) X.out[O_PM + l * 8 + nh] = m;
        } else if (item < 98304) {
            const int i1 = item - 32768, nhh = i1 >> 12, e = (i1 & 4095) * 2;
            const bf16_t* base = (const bf16_t*)XSH + (size_t)nhh * 128 * 8192 + e;
            const float* al = XSA + nhh * 128;
            f32x2 st = {0.f, 0.f};
            for (int c0 = 0; c0 < 128; c0 += 8) {
                f32x2 cl[8];
#pragma unroll
                for (int j = 0; j < 8; ++j) { const unsigned w = *(const unsigned*)(base + (size_t)(c0 + j) * 8192); cl[j] = (f32x2){__uint_as_float(w << 16), __uint_as_float(w & 0xffff0000u)}; }
#pragma unroll
                for (int j = 0; j < 8; ++j) {
                    const float dec = __expf(al[c0 + j]);
                    *(unsigned*)(XHSB + ((size_t)nhh * 128 + c0 + j) * 8192 + e) = pk2(st[0], st[1]);
                    st = st * dec + cl[j];
                }
            }
            *(f32x2*)(X.out + O_PH + ((size_t)l * 16 + nhh) * 8192 + e) = st;
        } else {
            const int i2 = item - 98304, nh = i2 >> 6, k = i2 & 63;
            float* base = XMN + (size_t)nh * 128 * 64 + k;
            const float* ml = XML + nh * 128; const float* bl = XBL + nh * 128;
            float m = 0.f, st = 0.f;
            for (int c = 0; c < 128; ++c) {
                const float mlj = ml[c], blj = bl[c], mn = fmaxf(blj + m, mlj), sp = __expf(blj + m - mn), sl = __expf(mlj - mn);
                const float cl = base[c * 64];
                XNS[(size_t)nh * 128 * 64 + c * 64 + k] = st;
                st = st * sp + cl * sl; m = mn;
            }
            X.out[O_PN + ((size_t)l * 8 + nh) * 64 + k] = st;
        }
    }
}

__device__ __forceinline__ void mlstm_out(lptr lds, const Ctx& X, int l, int task, int tid) {
    const int h = task & 3, c = (task >> 2) & 127, n = task >> 9;
    const int lane = tid & 63, wave = tid >> 6, fr = lane & 15, fq = lane >> 4;
    const int row0 = n * SEQ + c * 64, nh = n * 4 + h;
    lptr Qs = lds;
    lptr Ks = lds + 9216;
    lptr Vt = lds + 18432;
    lptr Sb = lds + 36864 + wave * 2304;
    LAS float* bv = (LAS float*)(lds + 55296);
    LAS float* dv = bv + 64;
    LAS float* mtv = bv + 128;
    LAS float* siv = bv + 192;
    LAS float* qnv = bv + 256;
    LAS float* ssqp = bv + 384;
    LAS float* nsv = bv + 512;
    const int mti = wave >> 1, half = wave & 1;
    u32x4 csf[2][4];
    {
        const bf16_t* Cs = XCSB + ((size_t)nh * 128 + c) * 8192;
#pragma unroll
        for (int kk = 0; kk < 2; ++kk)
#pragma unroll
            for (int ntl = 0; ntl < 4; ++ntl) csf[kk][ntl] = *(const u32x4*)(Cs + (64 * half + 16 * ntl + fr) * 64 + kk * 32 + fq * 8);
    }
    unsigned short aov[4][4], azv[4][4]; float anw[4];
#pragma unroll
    for (int ntl = 0; ntl < 4; ++ntl) {
        const int v = h * 128 + 64 * half + 16 * ntl + fr;
        anw[ntl] = XPAR(P_ANW)[l * 512 + v];
#pragma unroll
        for (int ii = 0; ii < 4; ++ii) {
            const size_t row = (size_t)row0 + 16 * mti + fq * 4 + ii;
            aov[ntl][ii] = XU[row * NIN + C_AO + v]; azv[ntl][ii] = XU[row * NIN + C_AZ + v];
        }
    }
    u32x4 qraw, kraw, vraw[2];
    {
        const int tok = tid >> 3, k8 = (tid & 7) * 8;
        const bf16_t* ur = XU + (size_t)(row0 + tok) * NIN;
        qraw = *(const u32x4*)(ur + C_AQ + h * 64 + k8); kraw = *(const u32x4*)(ur + C_AK + h * 64 + k8);
#pragma unroll
        for (int it = 0; it < 2; ++it) { const int p = tid + it * NT, tk = p >> 4, v8 = (p & 15) * 8; vraw[it] = *(const u32x4*)(XU + (size_t)(row0 + tk) * NIN + C_AV + h * 128 + v8); }
    }
    if (wave == 0) {
        const bf16_t* ur = XU + (size_t)(row0 + lane) * NIN;
        const float fg = bf2f(ur[C_AF + h]) + XPAR(P_AFB)[l * 4 + h], ig = bf2f(ur[C_AI + h]) + XPAR(P_AIB)[l * 4 + h];
        const float b = wave_scan_sum(logsigf_(fg), lane);
        const float dd = ig - b;
        const float cm = wave_scan_max(dd, lane);
        const float ms = XMS[nh * 128 + c];
        const float mt = b + fmaxf(ms, cm);
        bv[lane] = b; dv[lane] = dd; mtv[lane] = mt; siv[lane] = __expf(b + ms - mt);
        nsv[lane] = XNS[((size_t)nh * 128 + c) * 64 + lane];
    }
    {
        const int tok = tid >> 3, k8 = (tid & 7) * 8;
        *(LAS u32x4*)(Qs + ((tok * 72 + k8) << 1)) = qraw;
        float x[8]; unpack8(kraw, x);
#pragma unroll
        for (int j = 0; j < 8; ++j) x[j] *= 0.125f;
        *(LAS u32x4*)(Ks + ((tok * 72 + k8) << 1)) = pack8(x);
    }
#pragma unroll
    for (int it = 0; it < 2; ++it) {
        const int p = tid + it * NT, tok = p >> 4, v8 = (p & 15) * 8;
        const u32x4 w = vraw[it];
#pragma unroll
        for (int j = 0; j < 8; ++j) *(LAS bf16_t*)(Vt + (((v8 + j) * 72 + tok) << 1)) = (bf16_t)((w[j >> 1] >> ((j & 1) * 16)) & 0xffffu);
    }
    __syncthreads();
    bf16x8 qa[2];
    qa[0] = lds_frag(Qs, 16 * mti + fr, fq * 8, 72); qa[1] = lds_frag(Qs, 16 * mti + fr, 32 + fq * 8, 72);
    {
        float x0[8], x1[8]; unpack8(__builtin_bit_cast(u32x4, qa[0]), x0); unpack8(__builtin_bit_cast(u32x4, qa[1]), x1);
        float d = 0.f;
#pragma unroll
        for (int j = 0; j < 8; ++j) d += x0[j] * nsv[fq * 8 + j] + x1[j] * nsv[32 + fq * 8 + j];
        d += __shfl_xor(d, 16); d += __shfl_xor(d, 32);
        if (fq == 0) qnv[wave * 16 + fr] = d;
    }
    float rsum[4] = {0.f, 0.f, 0.f, 0.f};
#pragma unroll
    for (int ntl = 0; ntl < 4; ++ntl) {
        f32x4 s = {0.f, 0.f, 0.f, 0.f};
        s = mfma16(qa[0], lds_frag(Ks, 16 * ntl + fr, fq * 8, 72), s);
        s = mfma16(qa[1], lds_frag(Ks, 16 * ntl + fr, 32 + fq * 8, 72), s);
#pragma unroll
        for (int ii = 0; ii < 4; ++ii) {
            const int t = 16 * mti + fq * 4 + ii, sidx = 16 * ntl + fr;
            const float wgt = (sidx <= t) ? __expf(bv[t] + dv[sidx] - mtv[t]) : 0.f;
            const float sv = wgt * s[ii];
            rsum[ii] += sv;
            *(LAS bf16_t*)(Sb + (((fq * 4 + ii) * 72 + sidx) << 1)) = (bf16_t)f2bf(sv);
        }
    }
    LDS_FENCE();
    f32x4 acc[4];
#pragma unroll
    for (int ntl = 0; ntl < 4; ++ntl) acc[ntl] = (f32x4){0.f, 0.f, 0.f, 0.f};
#pragma unroll
    for (int kk = 0; kk < 2; ++kk) {
        const bf16x8 a = lds_frag(Sb, fr, kk * 32 + fq * 8, 72);
#pragma unroll
        for (int ntl = 0; ntl < 4; ++ntl) acc[ntl] = mfma16(a, lds_frag(Vt, 64 * half + 16 * ntl + fr, kk * 32 + fq * 8, 72), acc[ntl]);
    }
    {
        const float sia = siv[16 * mti + fr];
#pragma unroll
        for (int kk = 0; kk < 2; ++kk) {
            float x[8]; unpack8(__builtin_bit_cast(u32x4, qa[kk]), x);
#pragma unroll
            for (int j = 0; j < 8; ++j) x[j] *= sia;
            const bf16x8 a = as_frag(pack8(x));
#pragma unroll
            for (int ntl = 0; ntl < 4; ++ntl) acc[ntl] = mfma16(a, as_frag(csf[kk][ntl]), acc[ntl]);
        }
    }
    float hv[4][4], ssl[4];
#pragma unroll
    for (int ii = 0; ii < 4; ++ii) {
        const int t = 16 * mti + fq * 4 + ii;
        const float den = red16(rsum[ii]) + siv[t] * qnv[wave * 16 + fq * 4 + ii];
        const float inv = 1.f / fmaxf(fabsf(den), __expf(-mtv[t]));
        float ss = 0.f;
#pragma unroll
        for (int ntl = 0; ntl < 4; ++ntl) { hv[ntl][ii] = acc[ntl][ii] * inv; ss += hv[ntl][ii] * hv[ntl][ii]; }
        ssl[ii] = red16(ss);
        if (fr == 0) ssqp[t * 2 + half] = ssl[ii];
    }
    __syncthreads();
#pragma unroll
    for (int ii = 0; ii < 4; ++ii) {
        const int t = 16 * mti + fq * 4 + ii;
        const float rs = rsqrtf((ssqp[t * 2] + ssqp[t * 2 + 1]) * (1.f / 128.f) + EPS);
        const size_t row = (size_t)row0 + t;
#pragma unroll
        for (int ntl = 0; ntl < 4; ++ntl) {
            const int v = h * 128 + 64 * half + 16 * ntl + fr;
            const float ao = bf2f(aov[ntl][ii]), az = bf2f(azv[ntl][ii]);
            XMIX[row * DMIX + v] = (bf16_t)f2bf(hv[ntl][ii] * rs * anw[ntl] * sigmoidf_(ao) * siluf_(az));
        }
    }
    __syncthreads();
}

__device__ __forceinline__ void ssd_out(lptr lds, const Ctx& X, int l, int task, int tid) {
    const int g = task & 1, c = (task >> 1) & 127, n = task >> 8;
    const int lane = tid & 63, wave = tid >> 6, fr = lane & 15, fq = lane >> 4;
    const int seq0 = n * SEQ, row0 = seq0 + c * 64;
    lptr Cm = lds;
    lptr Bm = lds + 17408;
    lptr Xt = lds + 34816;
    LAS float* CBf = (LAS float*)(lds + 71680);
    LAS float* av = (LAS float*)(lds + 89088);
    LAS float* dtv = (LAS float*)(lds + 90112);
    LAS float* ssq = (LAS float*)(lds + 91136);
    const int hl = wave >> 1, th = wave & 1, hh = 4 * g + hl;
    u32x4 hsf[4][4];
    {
        const bf16_t* hs = XHSB + ((size_t)(n * 8 + hh) * 128 + c) * 8192;
#pragma unroll
        for (int kk = 0; kk < 4; ++kk)
#pragma unroll
            for (int ntl = 0; ntl < 4; ++ntl) hsf[kk][ntl] = *(const u32x4*)(hs + (16 * ntl + fr) * 128 + kk * 32 + fq * 8);
    }
    if (wave < 4) {
        const int hh = 4 * g + wave;
        const float dt = softplusf_(bf2f(XU[(size_t)(row0 + lane) * NIN + C_BDT + hh]) + XPAR(P_DTB)[l * 8 + hh]);
        const float A = -__expf(XPAR(P_ALOG)[l * 8 + hh]);
        av[wave * 64 + lane] = wave_scan_sum(dt * A, lane);
        dtv[wave * 64 + lane] = dt;
    }
    {
        const float* cw = XPAR(P_CW) + l * 4096; const float* cb = XPAR(P_CB) + l * 1024;
        const int cg = lane;
        const int ch = cg < 32 ? g * 256 + cg * 8 : (cg < 48 ? 512 + g * 128 + (cg - 32) * 8 : 768 + g * 128 + (cg - 48) * 8);
        float o[8][8];
        conv8x8(XU, seq0, c * 64 + 8 * wave, ch, cw, cb, o);
        if (cg < 32) {
#pragma unroll
            for (int jx = 0; jx < 8; ++jx) {
                float v[8];
#pragma unroll
                for (int t = 0; t < 8; ++t) v[t] = o[t][jx];
                *(LAS u32x4*)(Xt + (((cg * 8 + jx) * 72 + 8 * wave) << 1)) = pack8(v);
            }
        } else {
            lptr dstm = cg < 48 ? Bm : Cm; const int s8 = (cg < 48 ? cg - 32 : cg - 48) * 8;
#pragma unroll
            for (int t = 0; t < 8; ++t) *(LAS u32x4*)(dstm + (((8 * wave + t) * 136 + s8) << 1)) = pack8(o[t]);
        }
    }
    __syncthreads();
    unsigned short bzv[2][4][4]; float bnw[4];
#pragma unroll
    for (int ntl = 0; ntl < 4; ++ntl) {
        bnw[ntl] = XPAR(P_BNW)[l * 512 + hh * 64 + 16 * ntl + fr];
#pragma unroll
        for (int mi = 0; mi < 2; ++mi)
#pragma unroll
            for (int ii = 0; ii < 4; ++ii) bzv[mi][ntl][ii] = XU[((size_t)row0 + 16 * (2 * th + mi) + fq * 4 + ii) * NIN + C_BZ + hh * 64 + 16 * ntl + fr];
    }
    {
        const int mt = wave >> 1;
#pragma unroll
        for (int q = 0; q < 2; ++q) {
            const int ntl = 2 * (wave & 1) + q;
            f32x4 acc = {0.f, 0.f, 0.f, 0.f};
#pragma unroll
            for (int kk = 0; kk < 4; ++kk) acc = mfma16(lds_frag(Cm, 16 * mt + fr, kk * 32 + fq * 8, 136), lds_frag(Bm, 16 * ntl + fr, kk * 32 + fq * 8, 136), acc);
#pragma unroll
            for (int ii = 0; ii < 4; ++ii) CBf[(16 * mt + fq * 4 + ii) * 68 + 16 * ntl + fr] = acc[ii];
        }
    }
    __syncthreads();
    f32x4 y1[2][4], y2[2][4];
#pragma unroll
    for (int mi = 0; mi < 2; ++mi)
#pragma unroll
        for (int ntl = 0; ntl < 4; ++ntl) { y1[mi][ntl] = (f32x4){0.f, 0.f, 0.f, 0.f}; y2[mi][ntl] = (f32x4){0.f, 0.f, 0.f, 0.f}; }
#pragma unroll
    for (int kk = 0; kk < 2; ++kk) {
        bf16x8 bx[4];
#pragma unroll
        for (int ntl = 0; ntl < 4; ++ntl) bx[ntl] = lds_frag(Xt, hl * 64 + 16 * ntl + fr, kk * 32 + fq * 8, 72);
#pragma unroll
        for (int mi = 0; mi < 2; ++mi) {
            const int t = 16 * (2 * th + mi) + fr, u0 = kk * 32 + fq * 8;
            const float at = av[hl * 64 + t];
            float w[8];
#pragma unroll
            for (int j = 0; j < 8; ++j) {
                const int uu = u0 + j;
                w[j] = (uu <= t) ? CBf[t * 68 + uu] * __expf(at - av[hl * 64 + uu]) * dtv[hl * 64 + uu] : 0.f;
            }
            const bf16x8 a = as_frag(pack8(w));
#pragma unroll
            for (int ntl = 0; ntl < 4; ++ntl) y1[mi][ntl] = mfma16(a, bx[ntl], y1[mi][ntl]);
        }
    }
    {
#pragma unroll
        for (int kk = 0; kk < 4; ++kk) {
            bf16x8 bh[4];
#pragma unroll
            for (int ntl = 0; ntl < 4; ++ntl) bh[ntl] = as_frag(hsf[kk][ntl]);
#pragma unroll
            for (int mi = 0; mi < 2; ++mi) {
                const bf16x8 a = lds_frag(Cm, 16 * (2 * th + mi) + fr, kk * 32 + fq * 8, 136);
#pragma unroll
                for (int ntl = 0; ntl < 4; ++ntl) y2[mi][ntl] = mfma16(a, bh[ntl], y2[mi][ntl]);
            }
        }
    }
    const float Dh = XPAR(P_BD)[l * 8 + hh];
#pragma unroll
    for (int mi = 0; mi < 2; ++mi)
#pragma unroll
        for (int ii = 0; ii < 4; ++ii) {
            const int t = 16 * (2 * th + mi) + fq * 4 + ii;
            const float ea = __expf(av[hl * 64 + t]);
            const size_t row = (size_t)row0 + t;
            float ss = 0.f;
#pragma unroll
            for (int ntl = 0; ntl < 4; ++ntl) {
                const int p = 16 * ntl + fr;
                const float xv = bf2f(*(const LAS bf16_t*)(Xt + (((hl * 64 + p) * 72 + t) << 1)));
                const float y = y1[mi][ntl][ii] + ea * y2[mi][ntl][ii] + Dh * xv;
                const float gbv = y * siluf_(bf2f(bzv[mi][ntl][ii]));
                y1[mi][ntl][ii] = gbv; ss += gbv * gbv;
            }
            ss = red16(ss);
            if (fr == 0) ssq[t * 4 + hl] = ss;
        }
    __syncthreads();
#pragma unroll
    for (int mi = 0; mi < 2; ++mi)
#pragma unroll
        for (int ii = 0; ii < 4; ++ii) {
            const int t = 16 * (2 * th + mi) + fq * 4 + ii;
            const float rs = rsqrtf((ssq[t * 4] + ssq[t * 4 + 1] + ssq[t * 4 + 2] + ssq[t * 4 + 3]) * (1.f / 256.f) + EPS);
            const size_t row = (size_t)row0 + t;
#pragma unroll
            for (int ntl = 0; ntl < 4; ++ntl) {
                const int p = hh * 64 + 16 * ntl + fr;
                XMIX[row * DMIX + 512 + p] = (bf16_t)f2bf(y1[mi][ntl][ii] * rs * bnw[ntl]);
            }
        }
    __syncthreads();
}


#define XB_TMO      128
#define XB_XCNT(j)  (256  + 64 * (j))
#define XB_XSUB(j)  (1280 + 64 * (j))
#define XB_XGEN(j)  (2304 + 64 * (j))
#define XB_TOP      3328
#define XB_TOPGEN   3392
#define XCD_BAR_WORDS 3456
#define XB_SPIN_CAP (1u << 18)
__device__ __forceinline__ unsigned xb_ld(unsigned* p)              { return __hip_atomic_load(p, __ATOMIC_RELAXED, __HIP_MEMORY_SCOPE_AGENT); }
__device__ __forceinline__ unsigned xb_add(unsigned* p, unsigned v) { return __hip_atomic_fetch_add(p, v, __ATOMIC_RELAXED, __HIP_MEMORY_SCOPE_AGENT); }
__device__ __forceinline__ unsigned xb_xcc_id() { return (unsigned)__builtin_amdgcn_s_getreg((3 << 11) | 20) & 0xFu; }
#define XB_SPIN(cond, bar) do { unsigned _sp = 0; while (cond) { __builtin_amdgcn_s_sleep(1); \
    if ((++_sp & 255u) == 0u) { if (xb_ld(&(bar)[XB_TMO])) break; if (_sp > XB_SPIN_CAP) { atomicAdd(&(bar)[XB_TMO], 1u); break; } } } } while (0)
struct XcdBarrier { unsigned* bar; unsigned x; volatile LAS unsigned* st; };
__device__ __forceinline__ XcdBarrier xcd_barrier_post(unsigned* bar, volatile LAS unsigned* st) {
    XcdBarrier b; b.bar = bar; b.x = xb_xcc_id(); b.st = st;
    if (threadIdx.x == 0) (void)xb_add(&bar[XB_XCNT(b.x)], 1u);
    return b;
}
__device__ __forceinline__ void xcd_barrier_complete(unsigned* bar, unsigned x, unsigned& nloc, unsigned& nx) {
    const unsigned G = gridDim.x * gridDim.y * gridDim.z;
    unsigned sum, cnt, mine, sp = 0u;
    for (;;) {
        sum = 0u; cnt = 0u; mine = 0u;
#pragma unroll
        for (unsigned j = 0; j < 16; ++j) { const unsigned c = xb_ld(&bar[XB_XCNT(j)]); sum += c; cnt += (c > 0u) ? 1u : 0u; mine = (j == x) ? c : mine; }
        if (sum == G) break;
        __builtin_amdgcn_s_sleep(1);
        if ((++sp & 255u) == 0u) { if (xb_ld(&bar[XB_TMO])) break; if (sp > XB_SPIN_CAP) { atomicAdd(&bar[XB_TMO], 1u); break; } }
    }
    nloc = mine > 0u ? mine : 1u; nx = cnt > 0u ? cnt : 1u;
}
__device__ __forceinline__ void xcd_barrier(const XcdBarrier& b) {
    asm volatile("s_waitcnt vmcnt(0)" ::: "memory");
    __syncthreads();
    if (threadIdx.x == 0) {
        unsigned* bar = b.bar;
        __builtin_amdgcn_s_waitcnt(0);
        unsigned nloc = b.st[0], nx = b.st[1];
        if (nloc == 0u) { xcd_barrier_complete(bar, b.x, nloc, nx); b.st[0] = nloc; b.st[1] = nx; }
        const unsigned old = xb_add(&bar[XB_XSUB(b.x)], 1u);
        const unsigned gen = old / nloc;
        if (old + 1u == (gen + 1u) * nloc) {
            __builtin_amdgcn_fence(__ATOMIC_RELEASE, "agent");
            asm volatile("s_waitcnt vmcnt(0)" ::: "memory");
            const unsigned og = xb_add(&bar[XB_TOP], 1u);
            const unsigned tg = og / nx;
            if (og + 1u == (tg + 1u) * nx) xb_add(&bar[XB_TOPGEN], 1u);
            else XB_SPIN(xb_ld(&bar[XB_TOPGEN]) == tg, bar);
            __builtin_amdgcn_fence(__ATOMIC_ACQUIRE, "agent");
            xb_add(&bar[XB_XGEN(b.x)], 1u);
            asm volatile("s_waitcnt vmcnt(0)" ::: "memory");
        } else {
            XB_SPIN(xb_ld(&bar[XB_XGEN(b.x)]) == gen, bar);
            __builtin_amdgcn_fence(__ATOMIC_ACQUIRE, "agent");
            asm volatile("s_waitcnt vmcnt(0)" ::: "memory");
        }
    }
    __syncthreads();
}

__global__ void __launch_bounds__(NT, 2) mega(Args args) {
    __shared__ __attribute__((aligned(16))) unsigned char lds_raw[LDS_BYTES];
    lptr lds = (lptr)lds_raw;
    cg::grid_group grid = cg::this_grid();
    const int tid = threadIdx.x, bid = blockIdx.x, G = gridDim.x;
    Ctx X;
    X.xp = args.in[IN_XP]; X.xs = args.in[IN_XS]; X.stC = args.in[IN_STC]; X.stN = args.in[IN_STN]; X.stM = args.in[IN_STM]; X.ssm = args.in[IN_SSM];
    X.conv = args.in[IN_CONV]; X.ck = args.in[IN_CK]; X.cv = args.in[IN_CV]; X.out = args.out; X.ws = args.ws;
    const int lo = args.ph_lo, hi = args.ph_hi;
    volatile LAS unsigned* xst = (volatile LAS unsigned*)(lds + LDS_BYTES - 16);
    if (tid == 0) { xst[0] = 0u; xst[1] = 0u; }
    __syncthreads();
    XcdBarrier xbar = xcd_barrier_post((unsigned*)(args.ws + WS_BAR), xst);
#define IN(k) (lo <= (k) && (k) < hi)
#define SEAM(k) do { if (IN(k) && IN((k) + 1)) { for (int _r = 0; _r < REP_SYNC; ++_r) { if (lo < 0) grid.sync(); xcd_barrier(xbar); } } } while (0)
    if (IN(0)) { for (int _r = 0; _r < REP_P0; ++_r) prologue(lds, X, args, G, bid, tid); }
    SEAM(0);
    for (int l = 0; l < 4; ++l) {
        const int pb = 1 + l * 5;
        if (IN(pb)) for (int _r = 0; _r < REP_P1; ++_r) {
            pg8::Gemm g{XXB, XWIN + (size_t)l * NIN * D, MPAD, NIN, D}; pg8::StaticOrder S; S.init(TP, NIN, G, bid);
            pg8::EpiU E{XU, XSSQ};
            pg8::gemm_phase<pg8::EpiU, pg8::StaticOrder, false, GEMM_SP2, GEMM_ALIGN>(lds, g, S, E, OPQ(tid));
            if (l == 0 && bid >= G - 20) {
                pg8::SampleOrder S2{G - 20, 20, bid}; pg8::EpiUh E2{XU, XSSQ};
                pg8::gemm_phase<pg8::EpiUh, pg8::SampleOrder, true>(lds, g, S2, E2, OPQ(tid));
            }
        }
        SEAM(pb);
        if (IN(pb + 1)) for (int _r = 0; _r < REP_P2; ++_r) {
            for (int t = bid; t < 256; t += G) for (int _q = 0; _q < RT_SWA; ++_q) swa_prompt(lds, X, l, t, OPQ(tid));
            for (int t = bid; t < 256; t += G) for (int _q = 0; _q < RT_SAMPLE; ++_q) {
                if (t < 128) sample_task(lds, X, l, t, 1, OPQ(tid));
                else { sample_task(lds, X, l, t - 128, 0, OPQ(tid)); sample_task(lds, X, l, t - 128, 2, OPQ(tid)); }
            }
            for (int t = bid; t < 512; t += G) for (int _q = 0; _q < RT_SLOC; ++_q) ssd_local(lds, X, l, t, OPQ(tid));
            for (int t = bid; t < 1024; t += G) for (int _q = 0; _q < RT_MLOC; ++_q) mlstm_local(lds, X, l, t, OPQ(tid));
            if (bid == G - 1) {
                for (int i = tid; i < 2 * 3 * 1024; i += NT) {
                    const int ch = i & 1023, j = (i >> 10) % 3, n = i / 3072;
                    X.out[O_PCONV + (((size_t)l * 2 + n) * 3 + j) * 1024 + ch] = bf2f(XU[(size_t)(n * SEQ + SEQ - 3 + j) * NIN + C_BX + ch]);
                }
            }
        }
        SEAM(pb + 1);
        if (IN(pb + 2)) {
            if (bid >= G - 4) {
                pg8::Gemm g{XMIX, XWOUT + (size_t)l * D * DMIX, MPAD, D, DMIX}; pg8::SampleOrder S{G - 4, 4, bid};
                if (l == 0) { pg8::EpiRes_<1, 0> E{X.xp, X.xs, X.out, XXB, XSSQ}; pg8::gemm_phase<pg8::EpiRes_<1, 0>, pg8::SampleOrder, true>(lds, g, S, E, OPQ(tid)); }
                else if (l < 3) { pg8::EpiRes_<1, 1> E{X.xp, X.xs, X.out, XXB, XSSQ}; pg8::gemm_phase<pg8::EpiRes_<1, 1>, pg8::SampleOrder, true>(lds, g, S, E, OPQ(tid)); }
                else { pg8::EpiRes_<1, 2> E{X.xp, X.xs, X.out, XXB, XSSQ}; pg8::gemm_phase<pg8::EpiRes_<1, 2>, pg8::SampleOrder, true>(lds, g, S, E, OPQ(tid)); }
            }
            for (int _r = 0; _r < REP_P3; ++_r) scans(X, l, bid * NT + OPQ(tid), G * NT);
        }
        SEAM(pb + 2);
        if (IN(pb + 3)) for (int _r = 0; _r < REP_P4; ++_r) {
            for (int task = bid; task < 1536; task += G) {
                if (task < 512) for (int _q = 0; _q < RT_SOUT; ++_q) ssd_out(lds, X, l, task, OPQ(tid));
                else mlstm_out(lds, X, l, task - 512, OPQ(tid));
            }
        }
        SEAM(pb + 3);
        if (IN(pb + 4)) {
            {
                pg8::Gemm g{XMIX, XWOUT + (size_t)l * D * DMIX, MPAD, D, DMIX}; pg8::StaticOrder S; S.init(TP, D, G, bid);
#ifdef PROBE_P5
                { pg8::EpiProbe EP{(const unsigned*)(X.ws + 64), XSSQ}; pg8::gemm_phase<pg8::EpiProbe, pg8::StaticOrder, false, GEMM_SP2>(lds, g, S, EP, OPQ(tid)); }
#endif
                if (l == 0) { pg8::EpiRes_<2, 0> E{X.xp, X.xs, X.out, XXB, XSSQ}; pg8::gemm_phase<pg8::EpiRes_<2, 0>, pg8::StaticOrder, false, GEMM_SP2>(lds, g, S, E, OPQ(tid)); }
                else if (l < 3) { pg8::EpiRes_<2, 1> E{X.xp, X.xs, X.out, XXB, XSSQ}; pg8::gemm_phase<pg8::EpiRes_<2, 1>, pg8::StaticOrder, false, GEMM_SP2>(lds, g, S, E, OPQ(tid)); }
                else { pg8::EpiRes_<2, 2> E{X.xp, X.xs, X.out, XXB, XSSQ}; pg8::gemm_phase<pg8::EpiRes_<2, 2>, pg8::StaticOrder, false, GEMM_SP2>(lds, g, S, E, OPQ(tid)); }
            }
            if (l < 3 && bid < 20) {
                pg8::Gemm g{XXB, XWIN + (size_t)(l + 1) * NIN * D, MPAD, NIN, D}; pg8::SampleOrder S{0, 20, bid};
                pg8::EpiUh E{XU, XSSQ};
                pg8::gemm_phase<pg8::EpiUh, pg8::SampleOrder, true>(lds, g, S, E, OPQ(tid));
            }
        }
        SEAM(pb + 4);
    }
#undef IN
#undef SEAM
}

extern "C" void kernel_launch(void* const* d_in, const int* in_sizes, int n_in, void* d_out, int out_size, void* d_ws, size_t ws_size, hipStream_t stream) {
    static int grid_blocks = 0;
    if (!grid_blocks) {
        int dev = 0, cus = 0, per_cu = 0;
        hipGetDevice(&dev);
        hipDeviceGetAttribute(&cus, hipDeviceAttributeMultiprocessorCount, dev);
        hipOccupancyMaxActiveBlocksPerMultiprocessor(&per_cu, mega, NT, 0);
        if (per_cu < 1) { fprintf(stderr, "occupancy query returned %d\n", per_cu); per_cu = 1; }
        grid_blocks = cus * 1;
        if (ws_size < WS_END) fprintf(stderr, "workspace too small: %zu < %zu\n", ws_size, (size_t)WS_END);
    }
    (void)hipMemsetAsync(d_ws, 0, 16384, stream);
    Args a{};
    for (int i = 0; i < 24; ++i) a.in[i] = (const float*)d_in[i];
    a.out = (float*)d_out; a.ws = (unsigned char*)d_ws;
    const int NPH = 21;
#if MULTI_LAUNCH
    for (int p = 0; p < NPH; ++p) {
        a.ph_lo = p; a.ph_hi = p + 1;
        void* kargs[] = {&a};
        hipError_t e = hipLaunchCooperativeKernel((void*)mega, dim3(grid_blocks), dim3(NT), kargs, 0, stream);
        if (e != hipSuccess) fprintf(stderr, "cooperative launch failed: %s (grid %d)\n", hipGetErrorString(e), grid_blocks);
    }
#else
    a.ph_lo = 0; a.ph_hi = NPH;
    void* kargs[] = {&a};
    hipError_t e = hipLaunchCooperativeKernel((void*)mega, dim3(grid_blocks), dim3(NT), kargs, 0, stream);
    if (e != hipSuccess) fprintf(stderr, "cooperative launch failed: %s (grid %d)\n", hipGetErrorString(e), grid_blocks);
#endif
}
```

```cpp
#include <hip/hip_runtime.h>
#include <hip/hip_cooperative_groups.h>
#include <cstdio>
#include <cstdint>
namespace cg = cooperative_groups;

#ifndef REP_SYNC
#define REP_SYNC 1
#endif
#ifndef REP_P1
#define REP_P1 1
#endif
#ifndef REP_P2
#define REP_P2 1
#endif
#ifndef REP_P3
#define REP_P3 1
#endif
#ifndef REP_P0
#define REP_P0 1
#endif
#ifndef REP_P4
#define REP_P4 1
#endif
#ifndef RT_SAMPLE
#define RT_SAMPLE 1
#endif
#ifndef RT_SWA
#define RT_SWA 1
#endif
#ifndef RT_SLOC
#define RT_SLOC 1
#endif
#ifndef RT_MLOC
#define RT_MLOC 1
#endif
#ifndef RT_SOUT
#define RT_SOUT 1
#endif
#ifndef GEMM_SP2
#define GEMM_SP2 true
#endif
#ifndef GEMM_ALIGN
#define GEMM_ALIGN true
#endif
#ifndef MULTI_LAUNCH
#define MULTI_LAUNCH 0
#endif

#define LAS __attribute__((address_space(3)))
typedef unsigned short bf16_t;
typedef short bf16x8 __attribute__((ext_vector_type(8)));
typedef float f32x4 __attribute__((ext_vector_type(4)));
typedef float f32x2 __attribute__((ext_vector_type(2)));
typedef unsigned u32x4 __attribute__((ext_vector_type(4)));
typedef unsigned u32x2 __attribute__((ext_vector_type(2)));
typedef __bf16 bf16x2_t __attribute__((ext_vector_type(2)));
typedef LAS unsigned char* lptr;

constexpr int D = 1024, DIN = 4880, NIN = 5120, DMIX = 1536, TP = 16384, MTOK = 16512, MPAD = 16640, SEQ = 8192;
constexpr int C_AQ = 0, C_AK = 256, C_AV = 512, C_AO = 1024, C_AZ = 1536, C_AI = 2048, C_AF = 2052, C_BZ = 2056, C_BX = 2568, C_BB = 3080, C_BC = 3336,
              C_BDT = 3592, C_CQ = 3600, C_CK = 4112, C_CV = 4240, C_CZ = 4368;
constexpr float EPS = 1e-6f;
constexpr size_t O_YP = 0, O_YS = 16777216, O_PC = 16908288, O_PN = 17170432, O_PM = 17172480, O_PH = 17172512, O_PCONV = 17696800, O_PK = 17721376,
                 O_PV = 17852448, O_SC = 17983520, O_SN = 34760736, O_SM = 34891808, O_SH = 34893856, O_SCONV = 68448288, O_SK = 70021152, O_SV = 78409760;
constexpr size_t WS_BAR = 0;
constexpr size_t WS_PAR = 16384;
constexpr size_t WS_WIN = WS_PAR + 102400;
constexpr size_t WS_WOUT = WS_WIN + (size_t)4 * NIN * D * 2;
constexpr size_t WS_XB = WS_WOUT + (size_t)4 * D * DMIX * 2;
constexpr size_t WS_U = WS_XB + (size_t)MPAD * D * 2;
constexpr size_t WS_MIX = WS_U + (size_t)MPAD * NIN * 2;
constexpr size_t WS_SSQ = WS_MIX + (size_t)MPAD * DMIX * 2;
constexpr size_t WS_ROPE = WS_SSQ + (size_t)MPAD * 16 * 4;
constexpr size_t WS_MC = WS_ROPE + (size_t)8200 * 64 * 4;
constexpr size_t WS_MN = WS_MC + (size_t)8 * 128 * 8192 * 4;
constexpr size_t WS_ML = WS_MN + (size_t)8 * 128 * 64 * 4;
constexpr size_t WS_BL = WS_ML + 4096;
constexpr size_t WS_MS = WS_BL + 4096;
constexpr size_t WS_SA = WS_MS + 4096;
constexpr size_t WS_SH = WS_SA + 8192;
constexpr size_t WS_CSB = WS_SH + (size_t)16 * 128 * 8192 * 4;
constexpr size_t WS_HSB = WS_CSB + (size_t)8 * 128 * 8192 * 2;
constexpr size_t WS_NS = WS_HSB + (size_t)16 * 128 * 8192 * 2;
constexpr size_t WS_END = WS_NS + (size_t)8 * 128 * 64 * 4;
constexpr int LDS_BYTES = 139264;
constexpr int NT = 512;

struct Args { const float* in[24]; float* out; unsigned char* ws; int ph_lo, ph_hi; };

__device__ __forceinline__ float bf2f(unsigned v) { return __uint_as_float(v << 16); }
__device__ __forceinline__ unsigned pk2(float lo, float hi) { f32x2 v = {lo, hi}; bf16x2_t b = __builtin_convertvector(v, bf16x2_t); return __builtin_bit_cast(unsigned, b); }
__device__ __forceinline__ unsigned f2bf(float f) { return pk2(f, 0.f) & 0xffffu; }
__device__ __forceinline__ void unpack8(u32x4 w, float (&f)[8]) {
#pragma unroll
    for (int i = 0; i < 4; ++i) { f[2 * i] = __uint_as_float(w[i] << 16); f[2 * i + 1] = __uint_as_float(w[i] & 0xffff0000u); }
}
__device__ __forceinline__ u32x4 pack8(const float (&f)[8]) { u32x4 w; w[0] = pk2(f[0], f[1]); w[1] = pk2(f[2], f[3]); w[2] = pk2(f[4], f[5]); w[3] = pk2(f[6], f[7]); return w; }
__device__ __forceinline__ u32x4 pack8v(f32x4 a, f32x4 b) { u32x4 w; w[0] = pk2(a[0], a[1]); w[1] = pk2(a[2], a[3]); w[2] = pk2(b[0], b[1]); w[3] = pk2(b[2], b[3]); return w; }
__device__ __forceinline__ bf16x8 as_frag(u32x4 w) { return __builtin_bit_cast(bf16x8, w); }
__device__ __forceinline__ bf16x8 ldg_f32_frag(const float* p) { f32x4 a = *(const f32x4*)p, b = *(const f32x4*)(p + 4); return as_frag(pack8v(a, b)); }
__device__ __forceinline__ bf16x8 lds_frag(lptr base, int row, int k, int stride) { return *(const LAS bf16x8*)(base + ((row * stride + k) << 1)); }
__device__ __forceinline__ f32x4 mfma16(bf16x8 a, bf16x8 b, f32x4 c) { return __builtin_amdgcn_mfma_f32_16x16x32_bf16(a, b, c, 0, 0, 0); }
__device__ __forceinline__ float sigmoidf_(float x) { return 1.f / (1.f + __expf(-x)); }
__device__ __forceinline__ float siluf_(float x) { return x / (1.f + __expf(-x)); }
__device__ __forceinline__ float softplusf_(float x) { return x > 20.f ? x : log1pf(__expf(x)); }
__device__ __forceinline__ float logsigf_(float x) { return fminf(x, 0.f) - log1pf(__expf(-fabsf(x))); }
__device__ __forceinline__ float wave_scan_sum(float v, int lane) {
#pragma unroll
    for (int o = 1; o < 64; o <<= 1) { float t = __shfl_up(v, o); if (lane >= o) v += t; }
    return v;
}
__device__ __forceinline__ float wave_scan_max(float v, int lane) {
#pragma unroll
    for (int o = 1; o < 64; o <<= 1) { float t = __shfl_up(v, o); if (lane >= o) v = fmaxf(v, t); }
    return v;
}
__device__ __forceinline__ float red16(float v);
__device__ __forceinline__ float red16max(float v);
__device__ __forceinline__ float wave_sum(float v) { v = red16(v); v += __shfl_xor(v, 16); v += __shfl_xor(v, 32); return v; }
__device__ __forceinline__ float wave_max(float v) { v = red16max(v); v = fmaxf(v, __shfl_xor(v, 16)); v = fmaxf(v, __shfl_xor(v, 32)); return v; }
template <int CTRL> __device__ __forceinline__ float dppf(float v) { return __int_as_float(__builtin_amdgcn_update_dpp(0, __float_as_int(v), CTRL, 0xf, 0xf, true)); }
__device__ __forceinline__ float red16(float v) { v += dppf<0xB1>(v); v += dppf<0x4E>(v); v += dppf<0x141>(v); v += dppf<0x140>(v); return v; }
__device__ __forceinline__ float red16max(float v) { v = fmaxf(v, dppf<0xB1>(v)); v = fmaxf(v, dppf<0x4E>(v)); v = fmaxf(v, dppf<0x141>(v)); v = fmaxf(v, dppf<0x140>(v)); return v; }
__device__ __forceinline__ int OPQ(int v) { asm volatile("" : "+v"(v)); return v; }
#define LDS_FENCE() asm volatile("s_waitcnt lgkmcnt(0)" ::: "memory")

namespace pg8 {
constexpr int BM = 256, BK = 64, HALF = 128, HTB = HALF * BK * 2, STAGE_BYTES = 8 * HTB, NXCD = 8, WGM = 8;
__host__ __device__ __forceinline__ int lds_byte(int r, int c) { const int st = (r >> 4) * 2 + (c >> 5), rr = r & 15, cc = c & 31, ob = rr * 64 + cc * 2; return st * 1024 + (ob ^ (((ob >> 9) & 1) << 5)); }
__host__ __device__ __forceinline__ void stage_rc(int b, int& R, int& C) { const int st = b / 1024, sb = b % 1024, swz = sb ^ (((sb >> 9) & 1) << 5); R = (st >> 1) * 16 + swz / 64; C = (st & 1) * 32 + (swz % 64) / 2; }
__host__ __device__ __forceinline__ int perm32(int rho) { const int n = rho >> 4, i = rho & 15; return 8 * (i >> 2) + 4 * n + (i & 3); }
struct Unit { int pm, pn; };
struct Gemm { const bf16_t* A; const bf16_t* Bt; int M, N, K; };
struct StaticOrder {
    int nM, nN, nwg, G, c;
    __device__ void init(int M, int N, int G_, int c_) { nM = M / BM; nN = N / BM; nwg = nM * nN; G = G_; c = c_; }
    __device__ bool next(int i, Unit& u) const {
        const long L = (long)i * G + c; if (L >= nwg) return false;
        int wgid = (int)L; { const int q = nwg / NXCD, r = nwg % NXCD, xcd = wgid % NXCD, off = wgid / NXCD; wgid = (xcd < r ? xcd * (q + 1) : r * (q + 1) + (xcd - r) * q) + off; }
        const int nig = WGM * nN, gid = wgid / nig, fm = gid * WGM, gsz = (nM - fm) < WGM ? (nM - fm) : WGM;
        u.pm = fm + ((wgid % nig) % gsz); u.pn = (wgid % nig) / gsz; return true;
    }
};
template <int NAI> struct EpiU_ {
    bf16_t* U; const float* ssq;
    __device__ __forceinline__ void operator()(const f32x4 (&acc)[2][2][4][2], const Unit& u, int wr, int wc, int fr, int fq) const {
        const int row0 = u.pm * BM + wr * 64 + fr, col0 = u.pn * BM + wc * 32 + 8 * fq;
#pragma unroll
        for (int ai = 0; ai < NAI; ++ai)
#pragma unroll
            for (int m = 0; m < 4; ++m) {
                const int r = row0 + ai * HALF + m * 16;
                const f32x4 s = *(const f32x4*)(ssq + (size_t)r * 16 + fq * 4);
                float st = s[0] + s[1] + s[2] + s[3]; st += __shfl_xor(st, 16); st += __shfl_xor(st, 32);
                const float rs = rsqrtf(st * (1.f / 1024.f) + EPS);
                bf16_t* rowp = U + (size_t)r * NIN + col0;
#pragma unroll
                for (int bj = 0; bj < 2; ++bj) *(u32x4*)(rowp + bj * HALF) = pack8v(acc[ai][bj][m][0] * rs, acc[ai][bj][m][1] * rs);
                __builtin_amdgcn_sched_barrier(0);
            }
    }
};
template <int NAI, int MODE> struct EpiRes_ {
    const float* xp; const float* xs; float* out; bf16_t* xb; float* ssq;
    __device__ __forceinline__ void operator()(const f32x4 (&acc)[2][2][4][2], const Unit& u, int wr, int wc, int fr, int fq) const {
        const int row0 = u.pm * BM + wr * 64 + fr, col0 = u.pn * BM + wc * 32 + 8 * fq;
#pragma unroll
        for (int ai = 0; ai < NAI; ++ai)
#pragma unroll
            for (int m = 0; m < 4; ++m) {
                const int r = row0 + ai * HALF + m * 16;
                const bool valid = r < MTOK;
                float part = 0.f;
#pragma unroll
                for (int bj = 0; bj < 2; ++bj) {
                    const int c = col0 + bj * HALF;
                    f32x4 o0 = {0.f, 0.f, 0.f, 0.f}, o1 = {0.f, 0.f, 0.f, 0.f};
                    if (MODE == 0) {
                        const float* src = r < TP ? xp + (size_t)r * D : xs + (size_t)(r - TP) * D;
                        if (valid) { o0 = *(const f32x4*)(src + c); o1 = *(const f32x4*)(src + c + 4); }
                    } else {
                        float f[8]; unpack8(*(const u32x4*)(xb + (size_t)r * D + c), f);
                        o0 = (f32x4){f[0], f[1], f[2], f[3]}; o1 = (f32x4){f[4], f[5], f[6], f[7]};
                    }
                    const f32x4 v0 = acc[ai][bj][m][0] + o0, v1 = acc[ai][bj][m][1] + o1;
                    if (MODE == 2) {
                        if (valid) { *(f32x4*)(out + (size_t)r * D + c) = v0; *(f32x4*)(out + (size_t)r * D + c + 4) = v1; }
                    } else {
                        *(u32x4*)(xb + (size_t)r * D + c) = pack8v(v0, v1);
                        part += v0[0] * v0[0] + v0[1] * v0[1] + v0[2] * v0[2] + v0[3] * v0[3] + v1[0] * v1[0] + v1[1] * v1[1] + v1[2] * v1[2] + v1[3] * v1[3];
                    }
                }
                if (MODE != 2) {
                    part += __shfl_xor(part, 16); part += __shfl_xor(part, 32);
                    if (fq == 0) ssq[(size_t)r * 16 + u.pn * 4 + wc] = part;
                }
                __builtin_amdgcn_sched_barrier(0);
            }
    }
};

typedef EpiU_<2> EpiU; typedef EpiU_<1> EpiUh;
struct EpiProbe {
    const unsigned* flag; float* dst;
    __device__ __forceinline__ void operator()(const f32x4 (&acc)[2][2][4][2], const Unit& u, int wr, int wc, int fr, int fq) const {
        if (__hip_atomic_load(flag, __ATOMIC_RELAXED, __HIP_MEMORY_SCOPE_AGENT) == 12345u) {
            f32x4 t = {0.f, 0.f, 0.f, 0.f};
#pragma unroll
            for (int a = 0; a < 2; ++a)
#pragma unroll
                for (int b = 0; b < 2; ++b)
#pragma unroll
                    for (int m = 0; m < 4; ++m)
#pragma unroll
                        for (int n = 0; n < 2; ++n) t += acc[a][b][m][n];
            *(f32x4*)(dst + (size_t)(u.pm * 4 + u.pn) * 2048 + (wr * 4 + wc) * 256 + (fq * 16 + fr) * 4) = t;
        }
    }
};
struct SampleOrder {
    int first, cnt, c;
    __device__ bool next(int i, Unit& u) const { if (i != 0 || c < first || c >= first + cnt) return false; u.pm = 64; u.pn = c - first; return true; }
};
template <class Epi, class Sched, bool HALF_M = false, bool SP2 = false, bool ALIGN_EPI = false>
__device__ __forceinline__ void gemm_phase(lptr lds, const Gemm g, const Sched& S, const Epi& E, const int tid) {
    const int wid = __builtin_amdgcn_readfirstlane(tid >> 6), lane = tid & 63, wr = wid >> 2, wc = wid & 3, fr = lane & 15, fq = lane >> 4;
    const int K = g.K, nt = K / BK;
    unsigned voffA[2], voffB[2];
#pragma unroll
    for (int i = 0; i < 2; ++i) { int R, C; stage_rc(tid * 16 + i * 8192, R, C); const int Rb = (R & ~31) + perm32(R & 31);
        voffA[i] = (unsigned)(R * K + C) * 2u; voffB[i] = (unsigned)(Rb * K + C) * 2u; }
    const size_t kstep = (size_t)(BK * 2);
    const size_t hstep = (size_t)HALF * K * 2;
    const size_t tstep = 2 * hstep;
    const unsigned ldsw = (unsigned)wid * 1024u;
    const int aoff = lds_byte(wr * 64 + fr, fq * 8), boff = lds_byte(wc * 32 + fr, fq * 8);
#define PG8_SA(b, h) (((b) * 2 + (h)) * HTB)
#define PG8_SB(b, h) ((4 + (b) * 2 + (h)) * HTB)
#define PG8_STAGE(bufoff, gbase, voff) do { _Pragma("unroll") for (int _i = 0; _i < 2; ++_i) \
        __builtin_amdgcn_global_load_lds((const unsigned*)((const char*)(gbase) + (voff)[_i]), (LAS unsigned*)(lds + (bufoff) + ldsw + _i * 8192), 16, 0, 0); } while (0)
#define PG8_LDA(dst, b, h) do { _Pragma("unroll") for (int m = 0; m < 4; ++m) _Pragma("unroll") for (int k = 0; k < 2; ++k) dst[m][k] = *(const LAS bf16x8*)(lds + PG8_SA(b, h) + aoff + m * 2048 + k * 1024); } while (0)
#define PG8_LDB(dst, b, h) do { _Pragma("unroll") for (int n = 0; n < 2; ++n) _Pragma("unroll") for (int k = 0; k < 2; ++k) dst[n][k] = *(const LAS bf16x8*)(lds + PG8_SB(b, h) + boff + n * 2048 + k * 1024); } while (0)
#define PG8_MMA(ai, bj, At, Bt) do { __builtin_amdgcn_s_setprio(1); _Pragma("unroll") for (int m = 0; m < 4; ++m) _Pragma("unroll") for (int n = 0; n < 2; ++n) _Pragma("unroll") for (int k = 0; k < 2; ++k) \
        acc[ai][bj][m][n] = __builtin_amdgcn_mfma_f32_16x16x32_bf16(Bt[n][k], At[m][k], acc[ai][bj][m][n], 0, 0, 0); __builtin_amdgcn_s_setprio(0); } while (0)
#define PG8_WAIT_V(n) asm volatile("s_waitcnt vmcnt(" #n ")" ::: "memory")
#define PG8_WAIT_L(n) asm volatile("s_waitcnt lgkmcnt(" #n ")" ::: "memory")
#define PG8_BAR __builtin_amdgcn_s_barrier()
#define PG8_SCHED __builtin_amdgcn_sched_barrier(0)
    Unit cur, nxt; int ui = 0;
    if (!S.next(0, cur)) return;
    f32x4 acc[2][2][4][2];
#pragma unroll
    for (int a = 0; a < 2; ++a)
#pragma unroll
        for (int b = 0; b < 2; ++b)
#pragma unroll
            for (int m = 0; m < 4; ++m)
#pragma unroll
                for (int n = 0; n < 2; ++n) acc[a][b][m][n] = (f32x4){0.f, 0.f, 0.f, 0.f};
    bf16x8 At[4][2], B0[2][2], B1[2][2];
    const char* cA = (const char*)g.A + (size_t)cur.pm * tstep; const char* cB = (const char*)g.Bt + (size_t)cur.pn * tstep;
    if constexpr (SP2) {
        PG8_STAGE(PG8_SB(0, 0), cB, voffB); PG8_STAGE(PG8_SB(0, 1), cB + hstep, voffB); PG8_STAGE(PG8_SA(0, 0), cA, voffA); PG8_STAGE(PG8_SA(0, 1), cA + hstep, voffA);
        if (wr == 1) PG8_BAR;
        PG8_WAIT_V(2); PG8_BAR;
        PG8_STAGE(PG8_SB(1, 0), cB + kstep, voffB); PG8_STAGE(PG8_SA(1, 0), cA + kstep, voffA); PG8_STAGE(PG8_SB(1, 1), cB + hstep + kstep, voffB);
        PG8_WAIT_V(6); PG8_BAR;
    } else {
    PG8_STAGE(PG8_SB(0, 0), cB, voffB); PG8_STAGE(PG8_SA(0, 0), cA, voffA); PG8_STAGE(PG8_SB(0, 1), cB + hstep, voffB); PG8_STAGE(PG8_SA(0, 1), cA + hstep, voffA);
    if (wr == 1) PG8_BAR;
    PG8_WAIT_V(4); PG8_BAR;
    PG8_STAGE(PG8_SB(1, 0), cB + kstep, voffB); PG8_STAGE(PG8_SA(1, 0), cA + kstep, voffA); PG8_STAGE(PG8_SB(1, 1), cB + hstep + kstep, voffB);
    PG8_WAIT_V(6); PG8_BAR;
    }
    for (;;) {
        const bool has_next = S.next(ui + 1, nxt);
        const char* nA = has_next ? (const char*)g.A + (size_t)nxt.pm * tstep : cA; const char* nB = has_next ? (const char*)g.Bt + (size_t)nxt.pn * tstep : cB;
        for (int t = 0; t < nt; t += 2) {
            const bool last = (t == nt - 2);
            const char* a1 = cA + (size_t)(t + 1) * kstep;
            const char* a2 = last ? nA : cA + (size_t)(t + 2) * kstep; const char* b2 = last ? nB : cB + (size_t)(t + 2) * kstep;
            const char* a3 = a2 + kstep; const char* b3 = b2 + kstep;
            if constexpr (SP2) {
            PG8_LDB(B0, 0, 0); PG8_LDB(B1, 0, 1); PG8_SCHED; PG8_LDA(At, 0, 0); PG8_STAGE(PG8_SA(1, 1), a1 + hstep, voffA);
            PG8_WAIT_V(8); PG8_WAIT_L(0); PG8_BAR; PG8_MMA(0, 0, At, B0); PG8_MMA(0, 1, At, B1); PG8_BAR; PG8_SCHED;
            PG8_LDA(At, 0, 1); PG8_STAGE(PG8_SB(0, 0), b2, voffB); PG8_STAGE(PG8_SB(0, 1), b2 + hstep, voffB); PG8_STAGE(PG8_SA(0, 0), a2, voffA);
            PG8_WAIT_V(8); PG8_WAIT_L(0); PG8_BAR; PG8_MMA(1, 0, At, B0); PG8_MMA(1, 1, At, B1); PG8_BAR; PG8_SCHED;
            PG8_LDB(B0, 1, 0); PG8_LDB(B1, 1, 1); PG8_SCHED; PG8_LDA(At, 1, 0); PG8_STAGE(PG8_SA(0, 1), a2 + hstep, voffA);
            PG8_WAIT_V(8); PG8_WAIT_L(0); PG8_BAR; PG8_MMA(0, 0, At, B0); PG8_MMA(0, 1, At, B1); PG8_BAR; PG8_SCHED;
            PG8_LDA(At, 1, 1); PG8_STAGE(PG8_SB(1, 0), b3, voffB); PG8_STAGE(PG8_SB(1, 1), b3 + hstep, voffB); PG8_STAGE(PG8_SA(1, 0), a3, voffA);
            PG8_WAIT_V(8); PG8_WAIT_L(0); PG8_BAR; PG8_MMA(1, 0, At, B0); PG8_MMA(1, 1, At, B1); PG8_BAR; PG8_SCHED;
            } else {
            PG8_LDB(B0, 0, 0); PG8_SCHED; PG8_LDA(At, 0, 0); PG8_STAGE(PG8_SA(1, 1), a1 + hstep, voffA);
            PG8_WAIT_L(8); PG8_BAR; PG8_WAIT_L(0); PG8_MMA(0, 0, At, B0); PG8_BAR; PG8_SCHED;
            PG8_LDB(B1, 0, 1); PG8_STAGE(PG8_SB(0, 0), b2, voffB);
            PG8_BAR; PG8_WAIT_L(0); PG8_MMA(0, 1, At, B1); PG8_BAR;
            if constexpr (!HALF_M) PG8_LDA(At, 0, 1);
            PG8_STAGE(PG8_SA(0, 0), a2, voffA);
            PG8_BAR; PG8_WAIT_L(0); if constexpr (!HALF_M) PG8_MMA(1, 0, At, B0); PG8_BAR; PG8_SCHED;
            PG8_STAGE(PG8_SB(0, 1), b2 + hstep, voffB);
            PG8_WAIT_V(6); PG8_BAR; if constexpr (!HALF_M) PG8_MMA(1, 1, At, B1); PG8_BAR;
            PG8_LDB(B0, 1, 0); PG8_SCHED; PG8_LDA(At, 1, 0); PG8_STAGE(PG8_SA(0, 1), a2 + hstep, voffA);
            PG8_WAIT_L(8); PG8_BAR; PG8_WAIT_L(0); PG8_MMA(0, 0, At, B0); PG8_BAR; PG8_SCHED;
            PG8_LDB(B1, 1, 1); PG8_STAGE(PG8_SB(1, 0), b3, voffB);
            PG8_BAR; PG8_WAIT_L(0); PG8_MMA(0, 1, At, B1); PG8_BAR;
            if constexpr (!HALF_M) PG8_LDA(At, 1, 1);
            PG8_STAGE(PG8_SA(1, 0), a3, voffA);
            PG8_BAR; PG8_WAIT_L(0); if constexpr (!HALF_M) PG8_MMA(1, 0, At, B0); PG8_BAR; PG8_SCHED;
            PG8_STAGE(PG8_SB(1, 1), b3 + hstep, voffB);
            PG8_WAIT_V(6); PG8_BAR; if constexpr (!HALF_M) PG8_MMA(1, 1, At, B1); PG8_BAR;
            }
        }
        if constexpr (ALIGN_EPI) { if (wr == 0) PG8_BAR; }
        E(acc, cur, wr, wc, fr, fq);
        if (!has_next) break;
#pragma unroll
        for (int a = 0; a < 2; ++a)
#pragma unroll
            for (int b = 0; b < 2; ++b)
#pragma unroll
                for (int m = 0; m < 4; ++m)
#pragma unroll
                    for (int n = 0; n < 2; ++n) acc[a][b][m][n] = (f32x4){0.f, 0.f, 0.f, 0.f};
        cur = nxt; cA = nA; cB = nB; ++ui;
        if constexpr (ALIGN_EPI) { if (wr == 1) PG8_BAR; }
    }
    PG8_WAIT_V(0);
    if constexpr (!ALIGN_EPI) { if (wr == 0) PG8_BAR; }
    PG8_BAR;
#undef PG8_SA
#undef PG8_SB
#undef PG8_STAGE
#undef PG8_LDA
#undef PG8_LDB
#undef PG8_MMA
#undef PG8_WAIT_V
#undef PG8_WAIT_L
#undef PG8_BAR
#undef PG8_SCHED
}
}

struct Ctx {
    const float* xp; const float* xs; const float* stC; const float* stN; const float* stM; const float* ssm; const float* conv; const float* ck; const float* cv;
    float* out; unsigned char* ws;
};
#define XWIN ((bf16_t*)(X.ws + WS_WIN))
#define XWOUT ((bf16_t*)(X.ws + WS_WOUT))
#define XXB ((bf16_t*)(X.ws + WS_XB))
#define XU ((bf16_t*)(X.ws + WS_U))
#define XMIX ((bf16_t*)(X.ws + WS_MIX))
#define XSSQ ((float*)(X.ws + WS_SSQ))
#define XROPE ((float*)(X.ws + WS_ROPE))
#define XMC ((float*)(X.ws + WS_MC))
#define XMN ((float*)(X.ws + WS_MN))
#define XML ((float*)(X.ws + WS_ML))
#define XBL ((float*)(X.ws + WS_BL))
#define XMS ((float*)(X.ws + WS_MS))
#define XSA ((float*)(X.ws + WS_SA))
#define XSH ((float*)(X.ws + WS_SH))
#define XCSB ((bf16_t*)(X.ws + WS_CSB))
#define XNS ((float*)(X.ws + WS_NS))
#define XHSB ((bf16_t*)(X.ws + WS_HSB))
#define XPAR(off) ((const float*)(X.ws + WS_PAR) + (off))
constexpr int P_AIB = 0, P_AFB = 16, P_DTB = 32, P_ALOG = 64, P_BD = 96, P_SINK = 128, P_QNW = 160, P_KNW = 416, P_ANW = 672, P_BNW = 2720, P_CB = 4768, P_CW = 8864, P_END = 25248;
#define IN_XP 0
#define IN_XS 1
#define IN_STC 2
#define IN_STN 3
#define IN_STM 4
#define IN_SSM 5
#define IN_CONV 6
#define IN_CK 7
#define IN_CV 8
#define IN_NORMW 9
#define IN_WIN 10
#define IN_AIB 11
#define IN_AFB 12
#define IN_ANW 13
#define IN_CW 14
#define IN_CB 15
#define IN_DTB 16
#define IN_ALOG 17
#define IN_BD 18
#define IN_BNW 19
#define IN_QNW 20
#define IN_KNW 21
#define IN_SINK 22
#define IN_WOUT 23

__device__ __forceinline__ void transpose_strip(lptr lds, const float* src, int ldn, int nvalid, bf16_t* dst, int ldk, const float* scale, int k0, int n0, int tid) {
    LAS float* T = (LAS float*)lds;
    f32x4 v[8];
#pragma unroll
    for (int i = 0; i < 8; ++i) {
        const int f = tid + i * NT, r = f >> 6, c4 = (f & 63) * 4, n = n0 + c4;
        const f32x4 t = *(const f32x4*)(src + (size_t)(k0 + r) * ldn + (n < nvalid ? n : 0));
        const float m = n < nvalid ? (scale ? scale[k0 + r] : 1.f) : 0.f;
        v[i] = t * m;
    }
#pragma unroll
    for (int i = 0; i < 8; ++i) {
        const int f = tid + i * NT, r = f >> 6, c4 = (f & 63) * 4;
        T[r * 257 + c4 + 0] = v[i][0]; T[r * 257 + c4 + 1] = v[i][1]; T[r * 257 + c4 + 2] = v[i][2]; T[r * 257 + c4 + 3] = v[i][3];
    }
    __syncthreads();
#pragma unroll
    for (int i = 0; i < 4; ++i) {
        const int p = tid + i * NT, n = p >> 3, k8 = (p & 7) * 8; float f[8];
#pragma unroll
        for (int jx = 0; jx < 8; ++jx) f[jx] = T[(k8 + jx) * 257 + n];
        *(u32x4*)(dst + (size_t)(n0 + n) * ldk + k0 + k8) = pack8(f);
    }
    __syncthreads();
}

__device__ __forceinline__ void prologue(lptr lds, const Ctx& X, const Args& args, int G, int bid, int tid) {
    const int lane = tid & 63, wave = tid >> 6;
    constexpr int T0 = 1280, T1 = T0 + 384, T2 = T1 + 2080, T3 = T2 + 1, T4 = T3 + 513;
    for (int task = bid; task < T4; task += G) {
        if (task < T0) {
            const int l = task / 320, r = task % 320, kt = r / 20, ntl = r % 20;
            transpose_strip(lds, args.in[IN_WIN] + (size_t)l * D * DIN, DIN, DIN, XWIN + (size_t)l * NIN * D, D, args.in[IN_NORMW] + l * D, kt * 64, ntl * 256, tid);
        } else if (task < T1) {
            const int t = task - T0, l = t / 96, r = t % 96, kt = r / 4, ntl = r % 4;
            transpose_strip(lds, args.in[IN_WOUT] + (size_t)l * DMIX * D, D, D, XWOUT + (size_t)l * D * DMIX, DMIX, nullptr, kt * 64, ntl * 256, tid);
        } else if (task < T2) {
            const int r = (task - T1) * 8 + wave;
            float ss = 0.f;
            if (r < MTOK) {
                const float* src = r < TP ? X.xp + (size_t)r * D : X.xs + (size_t)(r - TP) * D;
#pragma unroll
                for (int i = 0; i < 4; ++i) {
                    const int c = lane * 4 + i * 256; f32x4 v = *(const f32x4*)(src + c);
                    ss += v[0] * v[0] + v[1] * v[1] + v[2] * v[2] + v[3] * v[3];
                    u32x2 w; w[0] = pk2(v[0], v[1]); w[1] = pk2(v[2], v[3]);
                    *(u32x2*)(XXB + (size_t)r * D + c) = w;
                }
            } else {
#pragma unroll
                for (int i = 0; i < 4; ++i) { u32x2 w = {0u, 0u}; *(u32x2*)(XXB + (size_t)r * D + lane * 4 + i * 256) = w; }
            }
            ss = wave_sum(ss);
            if (lane < 16) XSSQ[(size_t)r * 16 + lane] = (lane == 0) ? ss : 0.f;
        } else if (task < T3) {
            for (int i = tid; i < (MPAD - MTOK) * DMIX / 2; i += NT) ((unsigned*)(XMIX + (size_t)MTOK * DMIX))[i] = 0u;
            float* P = (float*)(X.ws + WS_PAR);
            const int po[12] = {P_AIB, P_AFB, P_DTB, P_ALOG, P_BD, P_SINK, P_QNW, P_KNW, P_ANW, P_BNW, P_CB, P_CW};
            const int pn[12] = {16, 16, 32, 32, 32, 32, 256, 256, 2048, 2048, 4096, 16384};
            const int pi[12] = {IN_AIB, IN_AFB, IN_DTB, IN_ALOG, IN_BD, IN_SINK, IN_QNW, IN_KNW, IN_ANW, IN_BNW, IN_CB, IN_CW};
#pragma unroll
            for (int a = 0; a < 12; ++a) { const float* src = args.in[pi[a]]; for (int i = tid; i < pn[a]; i += NT) P[po[a] + i] = src[i]; }
        } else {
            const int e = (task - T3) * 512 + tid;
            if (e < 8193 * 32) {
                const int pos = e >> 5, d = e & 31;
                const float inv = (float)exp2(-(double)d * (13.287712379549449 / 32.0));
                const float angf = (float)pos * inv;
                const double a = (double)angf;
                const double k = rint(a * 0.15915494309189535);
                const float rr = (float)(a - k * 6.283185307179586);
                XROPE[(size_t)e * 2] = cosf(rr); XROPE[(size_t)e * 2 + 1] = sinf(rr);
            }
        }
    }
}

__device__ __forceinline__ void conv8(const bf16_t* u, int seq0, int tt, int ch, const float* cw, const float* cb, float (&o)[8]) {
    float acc[8];
    { f32x4 b0 = *(const f32x4*)(cb + ch), b1 = *(const f32x4*)(cb + ch + 4);
#pragma unroll
      for (int j = 0; j < 4; ++j) { acc[j] = b0[j]; acc[4 + j] = b1[j]; } }
#pragma unroll
    for (int jj = 0; jj < 4; ++jj) {
        const int t2 = tt + jj - 3;
        if (t2 >= 0) {
            float x[8]; unpack8(*(const u32x4*)(u + (size_t)(seq0 + t2) * NIN + C_BX + ch), x);
            f32x4 w0 = *(const f32x4*)(cw + jj * 1024 + ch), w1 = *(const f32x4*)(cw + jj * 1024 + ch + 4);
#pragma unroll
            for (int j = 0; j < 4; ++j) { acc[j] += x[j] * w0[j]; acc[4 + j] += x[4 + j] * w1[j]; }
        }
    }
#pragma unroll
    for (int j = 0; j < 8; ++j) o[j] = siluf_(acc[j]);
}


__device__ __forceinline__ void conv8x8(const bf16_t* u, int seq0, int tt0, int ch, const float* cw, const float* cb, float (&o)[8][8]) {
    float w[4][8];
#pragma unroll
    for (int jj = 0; jj < 4; ++jj) { f32x4 w0 = *(const f32x4*)(cw + jj * 1024 + ch), w1 = *(const f32x4*)(cw + jj * 1024 + ch + 4);
#pragma unroll
        for (int j = 0; j < 4; ++j) { w[jj][j] = w0[j]; w[jj][4 + j] = w1[j]; } }
    { f32x4 b0 = *(const f32x4*)(cb + ch), b1 = *(const f32x4*)(cb + ch + 4);
#pragma unroll
      for (int t = 0; t < 8; ++t)
#pragma unroll
          for (int j = 0; j < 4; ++j) { o[t][j] = b0[j]; o[t][4 + j] = b1[j]; } }
    u32x4 raw[11];
#pragma unroll
    for (int r = 0; r < 11; ++r) {
        const int t2 = tt0 + r - 3;
        const u32x4 v = *(const u32x4*)(u + (size_t)(seq0 + (t2 >= 0 ? t2 : 0)) * NIN + C_BX + ch);
        const unsigned msk = t2 >= 0 ? 0xffffffffu : 0u;
        raw[r] = (u32x4){v[0] & msk, v[1] & msk, v[2] & msk, v[3] & msk};
    }
#pragma unroll
    for (int r = 0; r < 11; ++r) {
        float x[8]; unpack8(raw[r], x);
#pragma unroll
        for (int jj = 0; jj < 4; ++jj) {
            const int t = r - jj;
            if (t >= 0 && t < 8) {
#pragma unroll
                for (int j = 0; j < 8; ++j) o[t][j] += x[j] * w[jj][j];
            }
        }
    }
#pragma unroll
    for (int t = 0; t < 8; ++t)
#pragma unroll
        for (int j = 0; j < 8; ++j) o[t][j] = siluf_(o[t][j]);
}

__device__ __forceinline__ void mlstm_local(lptr lds, const Ctx& X, int l, int task, int tid) {
    const int h = task & 3, c = (task >> 2) & 127, n = task >> 9;
    const int lane = tid & 63, wave = tid >> 6, fr = lane & 15, fq = lane >> 4;
    const int row0 = n * SEQ + c * 64, nh = n * 4 + h;
    lptr VwT = lds;
    lptr KT = lds + 18432;
    LAS float* wv = (LAS float*)(lds + 27648);
    const int tg = lane & 7, cgq = lane >> 3;
    u32x4 blk[8];
    if (wave >= 1 && wave <= 3) {
        const int col = wave < 3 ? C_AV + h * 128 + ((wave - 1) * 8 + cgq) * 8 : C_AK + h * 64 + cgq * 8;
#pragma unroll
        for (int t = 0; t < 8; ++t) blk[t] = *(const u32x4*)(XU + (size_t)(row0 + 8 * tg + t) * NIN + col);
    }
    if (wave == 0) {
        const bf16_t* ur = XU + (size_t)(row0 + lane) * NIN;
        const float fg = bf2f(ur[C_AF + h]) + XPAR(P_AFB)[l * 4 + h], ig = bf2f(ur[C_AI + h]) + XPAR(P_AIB)[l * 4 + h];
        const float b = wave_scan_sum(logsigf_(fg), lane);
        const float bl = __shfl(b, 63);
        const float g = bl - b + ig;
        const float ml = wave_max(g);
        wv[lane] = __expf(g - ml);
        if (lane == 0) { XML[nh * 128 + c] = ml; XBL[nh * 128 + c] = bl; }
    }
    __syncthreads();
    if (wave >= 1 && wave <= 3) {
        float xs[8][8];
#pragma unroll
        for (int t = 0; t < 8; ++t) { unpack8(blk[t], xs[t]); const float w = wave < 3 ? wv[8 * tg + t] : 0.125f;
#pragma unroll
            for (int j = 0; j < 8; ++j) xs[t][j] *= w; }
        lptr dstT = wave < 3 ? VwT + ((((wave - 1) * 8 + cgq) * 8 * 72) << 1) : KT + ((cgq * 8 * 72) << 1);
#pragma unroll
        for (int j = 0; j < 8; ++j) {
            float v[8];
#pragma unroll
            for (int t = 0; t < 8; ++t) v[t] = xs[t][j];
            *(LAS u32x4*)(dstT + ((j * 72 + 8 * tg) << 1)) = pack8(v);
        }
    }
    __syncthreads();
    {
        bf16_t* dst = (bf16_t*)XMC + ((size_t)nh * 128 + c) * 8192;
        bf16x8 b0 = lds_frag(VwT, 16 * wave + fr, fq * 8, 72), b1 = lds_frag(VwT, 16 * wave + fr, 32 + fq * 8, 72);
#pragma unroll
        for (int mt = 0; mt < 4; ++mt) {
            f32x4 acc = {0.f, 0.f, 0.f, 0.f};
            acc = mfma16(lds_frag(KT, 16 * mt + fr, fq * 8, 72), b0, acc);
            acc = mfma16(lds_frag(KT, 16 * mt + fr, 32 + fq * 8, 72), b1, acc);
            { u32x2 w; w[0] = pk2(acc[0], acc[1]); w[1] = pk2(acc[2], acc[3]); *(u32x2*)(dst + (16 * wave + fr) * 64 + 16 * mt + 4 * fq) = w; }
        }
    }
    if (tid < 64) {
        float s = 0.f;
#pragma unroll
        for (int t8 = 0; t8 < 8; ++t8) {
            float kf[8]; unpack8(*(const LAS u32x4*)(KT + ((tid * 72 + t8 * 8) << 1)), kf);
#pragma unroll
            for (int jx = 0; jx < 8; ++jx) s += kf[jx] * wv[t8 * 8 + jx];
        }
        XMN[((size_t)nh * 128 + c) * 64 + tid] = s;
    }
    __syncthreads();
}

__device__ __forceinline__ void ssd_local(lptr lds, const Ctx& X, int l, int task, int tid) {
    const int g = task & 1, c = (task >> 1) & 127, n = task >> 8;
    const int lane = tid & 63, wave = tid >> 6, fr = lane & 15, fq = lane >> 4;
    const int seq0 = n * SEQ, row0 = seq0 + c * 64;
    lptr XwT = lds;
    lptr BT = lds + 36864;
    LAS float* wl = (LAS float*)(lds + 55296);
    {
        const float* cw = XPAR(P_CW) + l * 4096; const float* cb = XPAR(P_CB) + l * 1024;
        const int tg = lane & 7, cg = wave * 8 + (lane >> 3);
        float o[8][8];
        if (wave < 6) {
            const int ch = cg < 32 ? g * 256 + cg * 8 : 512 + g * 128 + (cg - 32) * 8;
            conv8x8(XU, seq0, c * 64 + 8 * tg, ch, cw, cb, o);
        }
        if (wave < 4) {
            const int hh = 4 * g + wave;
            const float dt = softplusf_(bf2f(XU[(size_t)(row0 + lane) * NIN + C_BDT + hh]) + XPAR(P_DTB)[l * 8 + hh]);
            const float A = -__expf(XPAR(P_ALOG)[l * 8 + hh]);
            const float a = wave_scan_sum(dt * A, lane);
            const float aL = __shfl(a, 63);
            wl[wave * 64 + lane] = __expf(aL - a) * dt;
            if (lane == 0) XSA[(n * 8 + hh) * 128 + c] = aL;
        }
        __syncthreads();
        if (wave < 4) {
            float wt[8];
#pragma unroll
            for (int t = 0; t < 8; ++t) wt[t] = wl[wave * 64 + 8 * tg + t];
#pragma unroll
            for (int jx = 0; jx < 8; ++jx) {
                float v[8];
#pragma unroll
                for (int t = 0; t < 8; ++t) v[t] = o[t][jx] * wt[t];
                *(LAS u32x4*)(XwT + (((cg * 8 + jx) * 72 + 8 * tg) << 1)) = pack8(v);
            }
        } else if (wave < 6) {
#pragma unroll
            for (int jx = 0; jx < 8; ++jx) {
                float v[8];
#pragma unroll
                for (int t = 0; t < 8; ++t) v[t] = o[t][jx];
                *(LAS u32x4*)(BT + ((((cg - 32) * 8 + jx) * 72 + 8 * tg) << 1)) = pack8(v);
            }
        }
    }
    __syncthreads();
    {
        const int hl = wave >> 1, ph = wave & 1, hh = 4 * g + hl;
        bf16_t* dst = (bf16_t*)XSH + ((size_t)(n * 8 + hh) * 128 + c) * 8192;
        bf16x8 bx[2][2];
#pragma unroll
        for (int ntl = 0; ntl < 2; ++ntl)
#pragma unroll
            for (int kk = 0; kk < 2; ++kk) bx[ntl][kk] = lds_frag(XwT, hl * 64 + ph * 32 + ntl * 16 + fr, kk * 32 + fq * 8, 72);
#pragma unroll
        for (int mt = 0; mt < 8; ++mt) {
            bf16x8 a0 = lds_frag(BT, 16 * mt + fr, fq * 8, 72), a1 = lds_frag(BT, 16 * mt + fr, 32 + fq * 8, 72);
#pragma unroll
            for (int ntl = 0; ntl < 2; ++ntl) {
                f32x4 acc = {0.f, 0.f, 0.f, 0.f};
                acc = mfma16(a0, bx[ntl][0], acc); acc = mfma16(a1, bx[ntl][1], acc);
                { u32x2 w; w[0] = pk2(acc[0], acc[1]); w[1] = pk2(acc[2], acc[3]); *(u32x2*)(dst + (ph * 32 + ntl * 16 + fr) * 128 + 16 * mt + 4 * fq) = w; }
            }
        }
    }
    __syncthreads();
}

__device__ __forceinline__ void swa_prompt(lptr lds, const Ctx& X, int l, int task, int tid) {
    const int kvh = task & 1, qb = (task >> 1) & 63, n = task >> 7;
    const int lane = tid & 63, wave = tid >> 6, fr = lane & 15, fq = lane >> 4;
    const int seq0 = n * SEQ;
    lptr Kn = lds;
    lptr Vt = lds + 36864;
    lptr Pw = lds + 70656 + wave * 8448;
    const float* knw = XPAR(P_KNW) + l * 64; const float* qnw = XPAR(P_QNW) + l * 64;
#pragma unroll
    for (int it = 0; it < 2; ++it) {
        const int item = tid + it * NT, j = item >> 2, qd = item & 3, t = qb * 128 - 128 + j;
        float o1[8], o2[8];
        {
            const int tc = t >= 0 ? t : 0;
            const bf16_t* kr = XU + (size_t)(seq0 + tc) * NIN + C_CK + kvh * 64;
            float x1[8], x2[8]; unpack8(*(const u32x4*)(kr + qd * 8), x1); unpack8(*(const u32x4*)(kr + 32 + qd * 8), x2);
            float ss = 0.f;
#pragma unroll
            for (int jj = 0; jj < 8; ++jj) ss += x1[jj] * x1[jj] + x2[jj] * x2[jj];
            ss += __shfl_xor(ss, 1); ss += __shfl_xor(ss, 2);
            const float rs = rsqrtf(ss * (1.f / 64.f) + EPS);
            const f32x4* cs = (const f32x4*)(XROPE + ((size_t)tc * 32 + qd * 8) * 2);
            f32x4 csv[4];
#pragma unroll
            for (int q4 = 0; q4 < 4; ++q4) csv[q4] = cs[q4];
            const float zm = t >= 0 ? 1.f : 0.f;
#pragma unroll
            for (int jj = 0; jj < 8; ++jj) {
                const float a = x1[jj] * rs * knw[qd * 8 + jj], b = x2[jj] * rs * knw[32 + qd * 8 + jj], co = csv[jj >> 1][(jj & 1) * 2], si = csv[jj >> 1][(jj & 1) * 2 + 1];
                o1[jj] = (a * co - b * si) * zm; o2[jj] = (b * co + a * si) * zm;
            }
        }
        *(LAS u32x4*)(Kn + ((j * 72 + qd * 8) << 1)) = pack8(o1);
        *(LAS u32x4*)(Kn + ((j * 72 + 32 + qd * 8) << 1)) = pack8(o2);
        if (qb == 63 && j >= 128) {
            float* ko = X.out + O_PK + ((((size_t)l * 2 + n) * 128 + (j - 128)) * 2 + kvh) * 64;
            *(f32x4*)(ko + qd * 8) = (f32x4){o1[0], o1[1], o1[2], o1[3]}; *(f32x4*)(ko + qd * 8 + 4) = (f32x4){o1[4], o1[5], o1[6], o1[7]};
            *(f32x4*)(ko + 32 + qd * 8) = (f32x4){o2[0], o2[1], o2[2], o2[3]}; *(f32x4*)(ko + 32 + qd * 8 + 4) = (f32x4){o2[4], o2[5], o2[6], o2[7]};
        }
    }
    if (wave < 4) {
        const int tg = tid & 31, cg = tid >> 5;
        u32x4 vb[8];
#pragma unroll
        for (int t8 = 0; t8 < 8; ++t8) {
            const int jk = 8 * tg + t8, t = qb * 128 - 128 + jk;
            u32x4 w = *(const u32x4*)(XU + (size_t)(seq0 + (t >= 0 ? t : 0)) * NIN + C_CV + kvh * 64 + cg * 8);
            const unsigned msk = t >= 0 ? 0xffffffffu : 0u;
            vb[t8] = (u32x4){w[0] & msk, w[1] & msk, w[2] & msk, w[3] & msk};
        }
#pragma unroll
        for (int jj = 0; jj < 8; ++jj) {
            u32x4 w;
#pragma unroll
            for (int tp = 0; tp < 4; ++tp) {
                const unsigned lo = (vb[2 * tp][jj >> 1] >> ((jj & 1) * 16)) & 0xffffu, hi = (vb[2 * tp + 1][jj >> 1] >> ((jj & 1) * 16)) & 0xffffu;
                w[tp] = lo | (hi << 16);
            }
            *(LAS u32x4*)(Vt + (((cg * 8 + jj) * 264 + 8 * tg) << 1)) = w;
        }
        if (qb == 63 && tg >= 16) {
#pragma unroll
            for (int t8 = 0; t8 < 8; ++t8) {
                float x[8]; unpack8(vb[t8], x);
                float* vo = X.out + O_PV + ((((size_t)l * 2 + n) * 128 + (8 * tg + t8 - 128)) * 2 + kvh) * 64 + cg * 8;
                *(f32x4*)(vo) = (f32x4){x[0], x[1], x[2], x[3]}; *(f32x4*)(vo + 4) = (f32x4){x[4], x[5], x[6], x[7]};
            }
        }
    }
    __syncthreads();
    const int hq = kvh * 4 + (wave >> 1), i0 = (wave & 1) * 64;
    const float sink = XPAR(P_SINK)[l * 8 + hq];
    float qw1[8], qw2[8];
#pragma unroll
    for (int jj = 0; jj < 8; ++jj) { qw1[jj] = qnw[fq * 8 + jj]; qw2[jj] = qnw[32 + fq * 8 + jj]; }
    u32x4 qn0, qn1; f32x4 csn[4];
    {
        const int t = qb * 128 + i0 + fr;
        const bf16_t* qr = XU + (size_t)(seq0 + t) * NIN + C_CQ + hq * 64;
        qn0 = *(const u32x4*)(qr + fq * 8); qn1 = *(const u32x4*)(qr + 32 + fq * 8);
        const f32x4* cs = (const f32x4*)(XROPE + ((size_t)t * 32 + fq * 8) * 2);
#pragma unroll
        for (int q4 = 0; q4 < 4; ++q4) csn[q4] = cs[q4];
    }
#pragma unroll 1
    for (int mt = 0; mt < 4; ++mt) {
        const int q0 = i0 + mt * 16;
        const u32x4 q0r = qn0, q1r = qn1; f32x4 csc[4];
#pragma unroll
        for (int q4 = 0; q4 < 4; ++q4) csc[q4] = csn[q4];
        unsigned short czv[4][4];
#pragma unroll
        for (int ii = 0; ii < 4; ++ii)
#pragma unroll
            for (int ntl = 0; ntl < 4; ++ntl) czv[ntl][ii] = XU[((size_t)seq0 + qb * 128 + q0 + fq * 4 + ii) * NIN + C_CZ + hq * 64 + 16 * ntl + fr];
        {
            const int mn = mt < 3 ? mt + 1 : 3;
            const int t = qb * 128 + i0 + mn * 16 + fr;
            const bf16_t* qr = XU + (size_t)(seq0 + t) * NIN + C_CQ + hq * 64;
            qn0 = *(const u32x4*)(qr + fq * 8); qn1 = *(const u32x4*)(qr + 32 + fq * 8);
            const f32x4* cs = (const f32x4*)(XROPE + ((size_t)t * 32 + fq * 8) * 2);
#pragma unroll
            for (int q4 = 0; q4 < 4; ++q4) csn[q4] = cs[q4];
        }
        bf16x8 a0, a1;
        {
            float x1[8], x2[8]; unpack8(q0r, x1); unpack8(q1r, x2);
            float ss = 0.f;
#pragma unroll
            for (int jj = 0; jj < 8; ++jj) ss += x1[jj] * x1[jj] + x2[jj] * x2[jj];
            ss += __shfl_xor(ss, 16); ss += __shfl_xor(ss, 32);
            const float rs = rsqrtf(ss * (1.f / 64.f) + EPS) * 0.125f;
            float o1[8], o2[8];
#pragma unroll
            for (int jj = 0; jj < 8; ++jj) {
                const float a = x1[jj] * rs * qw1[jj], b = x2[jj] * rs * qw2[jj], co = csc[jj >> 1][(jj & 1) * 2], si = csc[jj >> 1][(jj & 1) * 2 + 1];
                o1[jj] = a * co - b * si; o2[jj] = b * co + a * si;
            }
            a0 = as_frag(pack8(o1)); a1 = as_frag(pack8(o2));
        }
        const int tlo = q0 >> 4;
        const int qi = q0 + fr;
        f32x4 s[16];
        float mx = -3.0e38f;
#pragma unroll
        for (int ntl = 0; ntl < 16; ++ntl) {
            if (ntl >= tlo && ntl <= tlo + 8) {
                f32x4 acc = {0.f, 0.f, 0.f, 0.f};
                acc = mfma16(lds_frag(Kn, 16 * ntl + fr, fq * 8, 72), a0, acc);
                acc = mfma16(lds_frag(Kn, 16 * ntl + fr, 32 + fq * 8, 72), a1, acc);
#pragma unroll
                for (int ii = 0; ii < 4; ++ii) {
                    const int jk = 16 * ntl + 4 * fq + ii;
                    const bool valid = (jk > qi) && (jk <= qi + 128) && (qb > 0 || jk >= 128);
                    acc[ii] = valid ? acc[ii] : -3.0e38f;
                    mx = fmaxf(mx, acc[ii]);
                }
                s[ntl] = acc;
            }
        }
        mx = fmaxf(mx, __shfl_xor(mx, 16)); mx = fmaxf(mx, __shfl_xor(mx, 32));
        mx = fmaxf(mx, sink);
        float sum = 0.f;
#pragma unroll
        for (int ntl = 0; ntl < 16; ++ntl) {
            if (ntl >= tlo && ntl <= tlo + 8) {
#pragma unroll
                for (int ii = 0; ii < 4; ++ii) { const float e = (s[ntl][ii] > -1.0e38f) ? __expf(s[ntl][ii] - mx) : 0.f; s[ntl][ii] = e; sum += e; }
            }
        }
        sum += __shfl_xor(sum, 16); sum += __shfl_xor(sum, 32);
        const float inv = 1.f / (sum + __expf(sink - mx));
        const int klo = q0 >> 5, khi = (q0 + 143) >> 5;
#pragma unroll
        for (int ntl = 0; ntl < 16; ++ntl) {
            if (ntl >= tlo && ntl <= tlo + 8) {
                u32x2 w; w[0] = pk2(s[ntl][0] * inv, s[ntl][1] * inv); w[1] = pk2(s[ntl][2] * inv, s[ntl][3] * inv);
                *(LAS u32x2*)(Pw + ((fr * 264 + 16 * ntl + 4 * fq) << 1)) = w;
            } else if ((ntl >> 1) >= klo && (ntl >> 1) <= khi) {
                u32x2 w = {0u, 0u};
                *(LAS u32x2*)(Pw + ((fr * 264 + 16 * ntl + 4 * fq) << 1)) = w;
            }
        }
        LDS_FENCE();
        f32x4 o[4];
#pragma unroll
        for (int ntl = 0; ntl < 4; ++ntl) o[ntl] = (f32x4){0.f, 0.f, 0.f, 0.f};
#pragma unroll
        for (int kk = 0; kk < 8; ++kk) {
            if (kk >= klo && kk <= khi) {
                const bf16x8 a = lds_frag(Pw, fr, kk * 32 + fq * 8, 264);
#pragma unroll
                for (int ntl = 0; ntl < 4; ++ntl) o[ntl] = mfma16(a, lds_frag(Vt, 16 * ntl + fr, kk * 32 + fq * 8, 264), o[ntl]);
            }
        }
        LDS_FENCE();
#pragma unroll
        for (int ii = 0; ii < 4; ++ii) {
            const size_t row = (size_t)seq0 + qb * 128 + q0 + fq * 4 + ii;
#pragma unroll
            for (int ntl = 0; ntl < 4; ++ntl) {
                const int d = 16 * ntl + fr;
                XMIX[row * DMIX + 1024 + hq * 64 + d] = (bf16_t)f2bf(o[ntl][ii] * siluf_(bf2f(czv[ntl][ii])));
            }
        }
    }
    __syncthreads();
}

__device__ __forceinline__ void sample_task(lptr lds, const Ctx& X, int l, int b, int part, int tid) {
    LAS float* uf = (LAS float*)lds;
    LAS float* xbc = (LAS float*)(lds + 19968);
    LAS float* numv = (LAS float*)(lds + 24064);
    LAS float* yv = (LAS float*)(lds + 26112);
    LAS float* red = (LAS float*)(lds + 28160);
    LAS float* qs = (LAS float*)(lds + 28416);
    LAS float* kn = (LAS float*)(lds + 30464);
    LAS float* sc = (LAS float*)(lds + 30976);
    const int lane = tid & 63, wave = tid >> 6;
    const size_t row = (size_t)TP + b;
    const bf16_t* ur = XU + row * NIN;
    const size_t lb = (size_t)l * 128 + b;
    f32x4 kpre[8], vpre[8];
    if (part == 2) {
        const float* kc = X.ck + lb * 16384; const float* vc = X.cv + lb * 16384;
#pragma unroll
        for (int it = 0; it < 8; ++it) {
            const int e = (tid + it * NT) * 4, e2 = e < 127 * 128 ? e + 128 : e;
            kpre[it] = *(const f32x4*)(kc + e2); vpre[it] = *(const f32x4*)(vc + e2);
        }
    }
    {
        const int c_lo = part == 0 ? 0 : (part == 1 ? C_BZ : C_CQ), c_hi = part == 0 ? C_BZ : (part == 1 ? C_CQ : DIN);
#pragma unroll 2
        for (int i = c_lo + tid; i < c_hi; i += NT) uf[i] = bf2f(ur[i]);
    }
    __syncthreads();
    if (part == 0) {
#pragma unroll
    for (int h = 0; h < 4; ++h) {
        const float ig = uf[C_AI + h] + XPAR(P_AIB)[l * 4 + h], fg = uf[C_AF + h] + XPAR(P_AFB)[l * 4 + h];
        const float ls = logsigf_(fg), m0 = X.stM[lb * 4 + h];
        const float mn = fmaxf(ls + m0, ig), sp = __expf(ls + m0 - mn), sl = __expf(ig - mn);
        const float* C0 = X.stC + (lb * 4 + h) * 8192; float* C1 = X.out + O_SC + (lb * 4 + h) * 8192;
#pragma unroll
        for (int it = 0; it < 4; ++it) {
            const int e = (tid + it * NT) * 4, v = e >> 6, k = e & 63;
            const f32x4 c0 = *(const f32x4*)(C0 + e);
            const float vv = uf[C_AV + h * 128 + v] * sl;
            f32x4 c1; float part = 0.f;
#pragma unroll
            for (int j = 0; j < 4; ++j) { c1[j] = sp * c0[j] + vv * (uf[C_AK + h * 64 + k + j] * 0.125f); part += c1[j] * uf[C_AQ + h * 64 + k + j]; }
            *(f32x4*)(C1 + e) = c1;
            part = red16(part);
            if ((lane & 15) == 0) numv[h * 128 + v] = part;
        }
        if (wave == 0) {
            const float n1 = sp * X.stN[(lb * 4 + h) * 64 + lane] + sl * uf[C_AK + h * 64 + lane] * 0.125f;
            X.out[O_SN + (lb * 4 + h) * 64 + lane] = n1;
            const float dd = wave_sum(n1 * uf[C_AQ + h * 64 + lane]);
            if (lane == 0) { red[h] = dd; red[4 + h] = mn; X.out[O_SM + lb * 4 + h] = mn; }
        }
    }
    __syncthreads();
    float hv;
    { const int h = tid >> 7; hv = numv[tid] / fmaxf(fabsf(red[h]), __expf(-red[4 + h])); const float ss = wave_sum(hv * hv); if (lane == 0) red[8 + wave] = ss; }
    __syncthreads();
    { const int h = tid >> 7; const float rs = rsqrtf((red[8 + 2 * h] + red[9 + 2 * h]) * (1.f / 128.f) + EPS);
      XMIX[row * DMIX + tid] = (bf16_t)f2bf(hv * rs * XPAR(P_ANW)[l * 512 + tid] * sigmoidf_(uf[C_AO + tid]) * siluf_(uf[C_AZ + tid])); }
    }
    if (part == 1) {
    {
        const float* buf = X.conv + lb * 3 * 1024; float* oc = X.out + O_SCONV + lb * 3 * 1024;
        const float* cw = XPAR(P_CW) + l * 4096;
#pragma unroll
        for (int it = 0; it < 2; ++it) {
            const int ch = tid + it * NT;
            const float f0 = buf[ch], f1 = buf[1024 + ch], f2 = buf[2048 + ch], f3 = uf[C_BX + ch];
            const float acc = XPAR(P_CB)[l * 1024 + ch] + f0 * cw[ch] + f1 * cw[1024 + ch] + f2 * cw[2048 + ch] + f3 * cw[3072 + ch];
            xbc[ch] = siluf_(acc);
            oc[ch] = f1; oc[1024 + ch] = f2; oc[2048 + ch] = f3;
        }
    }
    __syncthreads();
#pragma unroll 4
    for (int hh = 0; hh < 8; ++hh) {
        const float dt = softplusf_(uf[C_BDT + hh] + XPAR(P_DTB)[l * 8 + hh]);
        const float dA = __expf(-dt * __expf(XPAR(P_ALOG)[l * 8 + hh]));
        const int g = hh >> 2;
        const float* h0p = X.ssm + (lb * 8 + hh) * 8192; float* h1p = X.out + O_SH + (lb * 8 + hh) * 8192;
#pragma unroll
        for (int it = 0; it < 4; ++it) {
            const int e = (tid + it * NT) * 4, p = e >> 7, s = e & 127;
            const f32x4 h0 = *(const f32x4*)(h0p + e);
            const float xv = xbc[hh * 64 + p] * dt;
            f32x4 h1; float part = 0.f;
#pragma unroll
            for (int j = 0; j < 4; ++j) { h1[j] = dA * h0[j] + xv * xbc[512 + g * 128 + s + j]; part += h1[j] * xbc[768 + g * 128 + s + j]; }
            *(f32x4*)(h1p + e) = h1;
            part = red16(part); part += __shfl_xor(part, 16);
            if ((lane & 31) == 0) yv[hh * 64 + p] = part;
        }
    }
    __syncthreads();
    float gb;
    { const int hh = tid >> 6; const float y = yv[tid] + XPAR(P_BD)[l * 8 + hh] * xbc[tid]; gb = y * siluf_(uf[C_BZ + tid]); const float ss = wave_sum(gb * gb); if (lane == 0) red[16 + wave] = ss; }
    __syncthreads();
    { const int g = tid >> 8; const float rs = rsqrtf((red[16 + 4 * g] + red[17 + 4 * g] + red[18 + 4 * g] + red[19 + 4 * g]) * (1.f / 256.f) + EPS);
      XMIX[row * DMIX + 512 + tid] = (bf16_t)f2bf(gb * rs * XPAR(P_BNW)[l * 512 + tid]); }
    }
    if (part == 2) {
    lptr Kl = lds + 36864;
    lptr Vl = lds + 36864 + 34816;
    if (tid < 320) {
        const int vec = tid >> 5, d = tid & 31, base = vec < 8 ? C_CQ + vec * 64 : C_CK + (vec - 8) * 64;
        const float x1 = uf[base + d], x2 = uf[base + 32 + d];
        float ss = x1 * x1 + x2 * x2; ss = red16(ss); ss += __shfl_xor(ss, 16);
        const float rs = rsqrtf(ss * (1.f / 64.f) + EPS);
        const float* w = vec < 8 ? XPAR(P_QNW) + l * 64 : XPAR(P_KNW) + l * 64;
        const float a = x1 * rs * w[d], bb = x2 * rs * w[d + 32];
        const float co = XROPE[((size_t)8192 * 32 + d) * 2], si = XROPE[((size_t)8192 * 32 + d) * 2 + 1];
        const float o1 = a * co - bb * si, o2 = bb * co + a * si;
        if (vec < 8) { qs[vec * 64 + d] = o1 * 0.125f; qs[vec * 64 + 32 + d] = o2 * 0.125f; } else { kn[(vec - 8) * 64 + d] = o1; kn[(vec - 8) * 64 + 32 + d] = o2; }
    }
    __syncthreads();
    {
        float* ko = X.out + O_SK + lb * 16384; float* vo = X.out + O_SV + lb * 16384;
#pragma unroll
        for (int it = 0; it < 8; ++it) {
            const int e = (tid + it * NT) * 4, j = e >> 7, r = e & 127;
            f32x4 kv = kpre[it], vv = vpre[it];
            if (j == 127) { kv = (f32x4){kn[r], kn[r + 1], kn[r + 2], kn[r + 3]}; vv = (f32x4){uf[C_CV + r], uf[C_CV + r + 1], uf[C_CV + r + 2], uf[C_CV + r + 3]}; }
            *(f32x4*)(ko + e) = kv; *(f32x4*)(vo + e) = vv;
            u32x2 wk, wv2; wk[0] = pk2(kv[0], kv[1]); wk[1] = pk2(kv[2], kv[3]); wv2[0] = pk2(vv[0], vv[1]); wv2[1] = pk2(vv[2], vv[3]);
            *(LAS u32x2*)(Kl + ((j * 136 + r) << 1)) = wk; *(LAS u32x2*)(Vl + ((j * 136 + r) << 1)) = wv2;
        }
    }
    __syncthreads();
    if (tid < 256) {
        const int kvh = tid >> 7, jj = tid & 127;
        float s0 = 0.f, s1 = 0.f, s2 = 0.f, s3 = 0.f;
#pragma unroll 2
        for (int d8 = 0; d8 < 8; ++d8) {
            float kf[8]; unpack8(*(const LAS u32x4*)(Kl + ((jj * 136 + kvh * 64 + d8 * 8) << 1)), kf);
#pragma unroll
            for (int j = 0; j < 8; ++j) {
                s0 += kf[j] * qs[(kvh * 4 + 0) * 64 + d8 * 8 + j]; s1 += kf[j] * qs[(kvh * 4 + 1) * 64 + d8 * 8 + j];
                s2 += kf[j] * qs[(kvh * 4 + 2) * 64 + d8 * 8 + j]; s3 += kf[j] * qs[(kvh * 4 + 3) * 64 + d8 * 8 + j];
            }
        }
        sc[(kvh * 4 + 0) * 128 + jj] = s0; sc[(kvh * 4 + 1) * 128 + jj] = s1; sc[(kvh * 4 + 2) * 128 + jj] = s2; sc[(kvh * 4 + 3) * 128 + jj] = s3;
    }
    __syncthreads();
    {
        const int hq = wave; const float s0 = sc[hq * 128 + lane], s1 = sc[hq * 128 + 64 + lane], sink = XPAR(P_SINK)[l * 8 + hq];
        const float m = fmaxf(wave_max(fmaxf(s0, s1)), sink);
        const float e0 = __expf(s0 - m), e1 = __expf(s1 - m);
        const float inv = 1.f / (wave_sum(e0 + e1) + __expf(sink - m));
        sc[hq * 128 + lane] = e0 * inv; sc[hq * 128 + 64 + lane] = e1 * inv;
    }
    __syncthreads();
    {
        const int hq = tid >> 6, d = tid & 63, kvh = hq >> 2;
        float o = 0.f;
#pragma unroll 16
        for (int jj = 0; jj < 128; ++jj) o += sc[hq * 128 + jj] * bf2f(*(const LAS bf16_t*)(Vl + ((jj * 136 + kvh * 64 + d) << 1)));
        XMIX[row * DMIX + 1024 + tid] = (bf16_t)f2bf(o * siluf_(uf[C_CZ + tid]));
    }
    }
    __syncthreads();
}

__device__ __forceinline__ void scans(const Ctx& X, int l, int gt, int nthreads) {
    for (int item = gt; item < 98816; item += nthreads) {
        if (item < 32768) {
            const int nh = item >> 12, e = (item & 4095) * 2;
            const bf16_t* base = (const bf16_t*)XMC + (size_t)nh * 128 * 8192 + e;
            const float* ml = XML + nh * 128; const float* bl = XBL + nh * 128;
            float m = 0.f; f32x2 st = {0.f, 0.f};
            for (int c0 = 0; c0 < 128; c0 += 16) {
                f32x2 cl[16];
#pragma unroll
                for (int j = 0; j < 16; ++j) { const unsigned w = *(const unsigned*)(base + (size_t)(c0 + j) * 8192); cl[j] = (f32x2){__uint_as_float(w << 16), __uint_as_float(w & 0xffff0000u)}; }
#pragma unroll
                for (int j = 0; j < 16; ++j) {
                    const float mlj = ml[c0 + j], blj = bl[c0 + j], mn = fmaxf(blj + m, mlj), sp = __expf(blj + m - mn), sl = __expf(mlj - mn);
                    *(unsigned*)(XCSB + ((size_t)nh * 128 + c0 + j) * 8192 + e) = pk2(st[0], st[1]);
                    if (e == 0) XMS[nh * 128 + c0 + j] = m;
                    st = st * sp + cl[j] * sl; m = mn;
                }
            }
            *(f32x2*)(X.out + O_PC + ((size_t)l * 8 + nh) * 8192 + e) = st;
            if (e == 0) X.out[O_PM + l * 8 + nh] = m;
        } else if (item < 98304) {
            const int i1 = item - 32768, nhh = i1 >> 12, e = (i1 & 4095) * 2;
            const bf16_t* base = (const bf16_t*)XSH + (size_t)nhh * 128 * 8192 + e;
            const float* al = XSA + nhh * 128;
            f32x2 st = {0.f, 0.f};
            for (int c0 = 0; c0 < 128; c0 += 16) {
                f32x2 cl[16];
#pragma unroll
                for (int j = 0; j < 16; ++j) { const unsigned w = *(const unsigned*)(base + (size_t)(c0 + j) * 8192); cl[j] = (f32x2){__uint_as_float(w << 16), __uint_as_float(w & 0xffff0000u)}; }
#pragma unroll
                for (int j = 0; j < 16; ++j) {
                    const float dec = __expf(al[c0 + j]);
                    *(unsigned*)(XHSB + ((size_t)nhh * 128 + c0 + j) * 8192 + e) = pk2(st[0], st[1]);
                    st = st * dec + cl[j];
                }
            }
            *(f32x2*)(X.out + O_PH + ((size_t)l * 16 + nhh) * 8192 + e) = st;
        } else {
            const int i2 = item - 98304, nh = i2 >> 6, k = i2 & 63;
            float* base = XMN + (size_t)nh * 128 * 64 + k;
            const float* ml = XML + nh * 128; const float* bl = XBL + nh * 128;
            float m = 0.f, st = 0.f;
            for (int c = 0; c < 128; ++c) {
                const float mlj = ml[c], blj = bl[c], mn = fmaxf(blj + m, mlj), sp = __expf(blj + m - mn), sl = __expf(mlj - mn);
                const float cl = base[c * 64];
                XNS[(size_t)nh * 128 * 64 + c * 64 + k] = st;
                st = st * sp + cl * sl; m = mn;
            }
            X.out[O_PN + ((size_t)l * 8 + nh) * 64 + k] = st;
        }
    }
}

__device__ __forceinline__ void mlstm_out(lptr lds, const Ctx& X, int l, int task, int tid) {
    const int h = task & 3, c = (task >> 2) & 127, n = task >> 9;
    const int lane = tid & 63, wave = tid >> 6, fr = lane & 15, fq = lane >> 4;
    const int row0 = n * SEQ + c * 64, nh = n * 4 + h;
    lptr Qs = lds;
    lptr Ks = lds + 9216;
    lptr Vt = lds + 18432;
    lptr Sb = lds + 36864 + wave * 2304;
    LAS float* bv = (LAS float*)(lds + 55296);
    LAS float* dv = bv + 64;
    LAS float* mtv = bv + 128;
    LAS float* siv = bv + 192;
    LAS float* qnv = bv + 256;
    LAS float* ssqp = bv + 384;
    LAS float* nsv = bv + 512;
    const int mti = wave >> 1, half = wave & 1;
    u32x4 csf[2][4];
    {
        const bf16_t* Cs = XCSB + ((size_t)nh * 128 + c) * 8192;
#pragma unroll
        for (int kk = 0; kk < 2; ++kk)
#pragma unroll
            for (int ntl = 0; ntl < 4; ++ntl) csf[kk][ntl] = *(const u32x4*)(Cs + (64 * half + 16 * ntl + fr) * 64 + kk * 32 + fq * 8);
    }
    unsigned short aov[4][4], azv[4][4]; float anw[4];
#pragma unroll
    for (int ntl = 0; ntl < 4; ++ntl) {
        const int v = h * 128 + 64 * half + 16 * ntl + fr;
        anw[ntl] = XPAR(P_ANW)[l * 512 + v];
#pragma unroll
        for (int ii = 0; ii < 4; ++ii) {
            const size_t row = (size_t)row0 + 16 * mti + fq * 4 + ii;
            aov[ntl][ii] = XU[row * NIN + C_AO + v]; azv[ntl][ii] = XU[row * NIN + C_AZ + v];
        }
    }
    u32x4 qraw, kraw, vblk[8];
    const int tgv = lane & 7, cgv = (wave & 1) * 8 + (lane >> 3);
    {
        const int tok = tid >> 3, k8 = (tid & 7) * 8;
        const bf16_t* ur = XU + (size_t)(row0 + tok) * NIN;
        qraw = *(const u32x4*)(ur + C_AQ + h * 64 + k8); kraw = *(const u32x4*)(ur + C_AK + h * 64 + k8);
        if (wave == 2 || wave == 3) {
#pragma unroll
            for (int t = 0; t < 8; ++t) vblk[t] = *(const u32x4*)(XU + (size_t)(row0 + 8 * tgv + t) * NIN + C_AV + h * 128 + cgv * 8);
        }
    }
    if (wave == 0) {
        const bf16_t* ur = XU + (size_t)(row0 + lane) * NIN;
        const float fg = bf2f(ur[C_AF + h]) + XPAR(P_AFB)[l * 4 + h], ig = bf2f(ur[C_AI + h]) + XPAR(P_AIB)[l * 4 + h];
        const float b = wave_scan_sum(logsigf_(fg), lane);
        const float dd = ig - b;
        const float cm = wave_scan_max(dd, lane);
        const float ms = XMS[nh * 128 + c];
        const float mt = b + fmaxf(ms, cm);
        bv[lane] = b; dv[lane] = dd; mtv[lane] = mt; siv[lane] = __expf(b + ms - mt);
        nsv[lane] = XNS[((size_t)nh * 128 + c) * 64 + lane];
    }
    {
        const int tok = tid >> 3, k8 = (tid & 7) * 8;
        *(LAS u32x4*)(Qs + ((tok * 72 + k8) << 1)) = qraw;
        float x[8]; unpack8(kraw, x);
#pragma unroll
        for (int j = 0; j < 8; ++j) x[j] *= 0.125f;
        *(LAS u32x4*)(Ks + ((tok * 72 + k8) << 1)) = pack8(x);
    }
    if (wave == 2 || wave == 3) {
#pragma unroll
        for (int j = 0; j < 8; ++j) {
            u32x4 w;
#pragma unroll
            for (int tp = 0; tp < 4; ++tp) {
                const unsigned lo = (vblk[2 * tp][j >> 1] >> ((j & 1) * 16)) & 0xffffu, hi = (vblk[2 * tp + 1][j >> 1] >> ((j & 1) * 16)) & 0xffffu;
                w[tp] = lo | (hi << 16);
            }
            *(LAS u32x4*)(Vt + (((cgv * 8 + j) * 72 + 8 * tgv) << 1)) = w;
        }
    }
    __syncthreads();
    bf16x8 qa[2];
    qa[0] = lds_frag(Qs, 16 * mti + fr, fq * 8, 72); qa[1] = lds_frag(Qs, 16 * mti + fr, 32 + fq * 8, 72);
    {
        float x0[8], x1[8]; unpack8(__builtin_bit_cast(u32x4, qa[0]), x0); unpack8(__builtin_bit_cast(u32x4, qa[1]), x1);
        float d = 0.f;
#pragma unroll
        for (int j = 0; j < 8; ++j) d += x0[j] * nsv[fq * 8 + j] + x1[j] * nsv[32 + fq * 8 + j];
        d += __shfl_xor(d, 16); d += __shfl_xor(d, 32);
        if (fq == 0) qnv[wave * 16 + fr] = d;
    }
    float rsum[4] = {0.f, 0.f, 0.f, 0.f};
#pragma unroll
    for (int ntl = 0; ntl < 4; ++ntl) {
        f32x4 s = {0.f, 0.f, 0.f, 0.f};
        s = mfma16(qa[0], lds_frag(Ks, 16 * ntl + fr, fq * 8, 72), s);
        s = mfma16(qa[1], lds_frag(Ks, 16 * ntl + fr, 32 + fq * 8, 72), s);
#pragma unroll
        for (int ii = 0; ii < 4; ++ii) {
            const int t = 16 * mti + fq * 4 + ii, sidx = 16 * ntl + fr;
            const float wgt = (sidx <= t) ? __expf(bv[t] + dv[sidx] - mtv[t]) : 0.f;
            const float sv = wgt * s[ii];
            rsum[ii] += sv;
            *(LAS bf16_t*)(Sb + (((fq * 4 + ii) * 72 + sidx) << 1)) = (bf16_t)f2bf(sv);
        }
    }
    LDS_FENCE();
    f32x4 acc[4];
#pragma unroll
    for (int ntl = 0; ntl < 4; ++ntl) acc[ntl] = (f32x4){0.f, 0.f, 0.f, 0.f};
#pragma unroll
    for (int kk = 0; kk < 2; ++kk) {
        const bf16x8 a = lds_frag(Sb, fr, kk * 32 + fq * 8, 72);
#pragma unroll
        for (int ntl = 0; ntl < 4; ++ntl) acc[ntl] = mfma16(a, lds_frag(Vt, 64 * half + 16 * ntl + fr, kk * 32 + fq * 8, 72), acc[ntl]);
    }
    {
        const float sia = siv[16 * mti + fr];
#pragma unroll
        for (int kk = 0; kk < 2; ++kk) {
            float x[8]; unpack8(__builtin_bit_cast(u32x4, qa[kk]), x);
#pragma unroll
            for (int j = 0; j < 8; ++j) x[j] *= sia;
            const bf16x8 a = as_frag(pack8(x));
#pragma unroll
            for (int ntl = 0; ntl < 4; ++ntl) acc[ntl] = mfma16(a, as_frag(csf[kk][ntl]), acc[ntl]);
        }
    }
    float hv[4][4], ssl[4];
#pragma unroll
    for (int ii = 0; ii < 4; ++ii) {
        const int t = 16 * mti + fq * 4 + ii;
        const float den = red16(rsum[ii]) + siv[t] * qnv[wave * 16 + fq * 4 + ii];
        const float inv = 1.f / fmaxf(fabsf(den), __expf(-mtv[t]));
        float ss = 0.f;
#pragma unroll
        for (int ntl = 0; ntl < 4; ++ntl) { hv[ntl][ii] = acc[ntl][ii] * inv; ss += hv[ntl][ii] * hv[ntl][ii]; }
        ssl[ii] = red16(ss);
        if (fr == 0) ssqp[t * 2 + half] = ssl[ii];
    }
    __syncthreads();
#pragma unroll
    for (int ii = 0; ii < 4; ++ii) {
        const int t = 16 * mti + fq * 4 + ii;
        const float rs = rsqrtf((ssqp[t * 2] + ssqp[t * 2 + 1]) * (1.f / 128.f) + EPS);
        const size_t row = (size_t)row0 + t;
#pragma unroll
        for (int ntl = 0; ntl < 4; ++ntl) {
            const int v = h * 128 + 64 * half + 16 * ntl + fr;
            const float ao = bf2f(aov[ntl][ii]), az = bf2f(azv[ntl][ii]);
            XMIX[row * DMIX + v] = (bf16_t)f2bf(hv[ntl][ii] * rs * anw[ntl] * sigmoidf_(ao) * siluf_(az));
        }
    }
    __syncthreads();
}

__device__ __forceinline__ void ssd_out(lptr lds, const Ctx& X, int l, int task, int tid) {
    const int g = task & 1, c = (task >> 1) & 127, n = task >> 8;
    const int lane = tid & 63, wave = tid >> 6, fr = lane & 15, fq = lane >> 4;
    const int seq0 = n * SEQ, row0 = seq0 + c * 64;
    lptr Cm = lds;
    lptr Bm = lds + 17408;
    lptr Xt = lds + 34816;
    LAS float* CBf = (LAS float*)(lds + 71680);
    LAS float* av = (LAS float*)(lds + 89088);
    LAS float* dtv = (LAS float*)(lds + 90112);
    LAS float* ssq = (LAS float*)(lds + 91136);
    const int hl = wave >> 1, th = wave & 1, hh = 4 * g + hl;
    u32x4 hsf[4][4];
    {
        const bf16_t* hs = XHSB + ((size_t)(n * 8 + hh) * 128 + c) * 8192;
#pragma unroll
        for (int kk = 0; kk < 4; ++kk)
#pragma unroll
            for (int ntl = 0; ntl < 4; ++ntl) hsf[kk][ntl] = *(const u32x4*)(hs + (16 * ntl + fr) * 128 + kk * 32 + fq * 8);
    }
    if (wave < 4) {
        const int hh = 4 * g + wave;
        const float dt = softplusf_(bf2f(XU[(size_t)(row0 + lane) * NIN + C_BDT + hh]) + XPAR(P_DTB)[l * 8 + hh]);
        const float A = -__expf(XPAR(P_ALOG)[l * 8 + hh]);
        av[wave * 64 + lane] = wave_scan_sum(dt * A, lane);
        dtv[wave * 64 + lane] = dt;
    }
    {
        const float* cw = XPAR(P_CW) + l * 4096; const float* cb = XPAR(P_CB) + l * 1024;
        float o[8][8];
        if (wave < 4) {
            const int tg = lane & 7, cg = wave * 8 + (lane >> 3);
            conv8x8(XU, seq0, c * 64 + 8 * tg, g * 256 + cg * 8, cw, cb, o);
#pragma unroll
            for (int jx = 0; jx < 8; ++jx) {
                float v[8];
#pragma unroll
                for (int t = 0; t < 8; ++t) v[t] = o[t][jx];
                *(LAS u32x4*)(Xt + (((cg * 8 + jx) * 72 + 8 * tg) << 1)) = pack8(v);
            }
        } else {
            const int tg = lane >> 3, s8 = ((wave & 1) * 8 + (lane & 7)) * 8;
            conv8x8(XU, seq0, c * 64 + 8 * tg, (wave < 6 ? 512 : 768) + g * 128 + s8, cw, cb, o);
            lptr dstm = wave < 6 ? Bm : Cm;
#pragma unroll
            for (int t = 0; t < 8; ++t) *(LAS u32x4*)(dstm + (((8 * tg + t) * 136 + s8) << 1)) = pack8(o[t]);
        }
    }
    __syncthreads();
    unsigned short bzv[2][4][4]; float bnw[4];
#pragma unroll
    for (int ntl = 0; ntl < 4; ++ntl) {
        bnw[ntl] = XPAR(P_BNW)[l * 512 + hh * 64 + 16 * ntl + fr];
#pragma unroll
        for (int mi = 0; mi < 2; ++mi)
#pragma unroll
            for (int ii = 0; ii < 4; ++ii) bzv[mi][ntl][ii] = XU[((size_t)row0 + 16 * (2 * th + mi) + fq * 4 + ii) * NIN + C_BZ + hh * 64 + 16 * ntl + fr];
    }
    {
        const int mt = wave >> 1;
#pragma unroll
        for (int q = 0; q < 2; ++q) {
            const int ntl = 2 * (wave & 1) + q;
            f32x4 acc = {0.f, 0.f, 0.f, 0.f};
#pragma unroll
            for (int kk = 0; kk < 4; ++kk) acc = mfma16(lds_frag(Cm, 16 * mt + fr, kk * 32 + fq * 8, 136), lds_frag(Bm, 16 * ntl + fr, kk * 32 + fq * 8, 136), acc);
#pragma unroll
            for (int ii = 0; ii < 4; ++ii) CBf[(16 * mt + fq * 4 + ii) * 68 + 16 * ntl + fr] = acc[ii];
        }
    }
    __syncthreads();
    f32x4 y1[2][4], y2[2][4];
#pragma unroll
    for (int mi = 0; mi < 2; ++mi)
#pragma unroll
        for (int ntl = 0; ntl < 4; ++ntl) { y1[mi][ntl] = (f32x4){0.f, 0.f, 0.f, 0.f}; y2[mi][ntl] = (f32x4){0.f, 0.f, 0.f, 0.f}; }
#pragma unroll
    for (int kk = 0; kk < 2; ++kk) {
        bf16x8 bx[4];
#pragma unroll
        for (int ntl = 0; ntl < 4; ++ntl) bx[ntl] = lds_frag(Xt, hl * 64 + 16 * ntl + fr, kk * 32 + fq * 8, 72);
#pragma unroll
        for (int mi = 0; mi < 2; ++mi) {
            const int t = 16 * (2 * th + mi) + fr, u0 = kk * 32 + fq * 8;
            const float at = av[hl * 64 + t];
            float w[8];
#pragma unroll
            for (int j = 0; j < 8; ++j) {
                const int uu = u0 + j;
                w[j] = (uu <= t) ? CBf[t * 68 + uu] * __expf(at - av[hl * 64 + uu]) * dtv[hl * 64 + uu] : 0.f;
            }
            const bf16x8 a = as_frag(pack8(w));
#pragma unroll
            for (int ntl = 0; ntl < 4; ++ntl) y1[mi][ntl] = mfma16(a, bx[ntl], y1[mi][ntl]);
        }
    }
    {
#pragma unroll
        for (int kk = 0; kk < 4; ++kk) {
            bf16x8 bh[4];
#pragma unroll
            for (int ntl = 0; ntl < 4; ++ntl) bh[ntl] = as_frag(hsf[kk][ntl]);
#pragma unroll
            for (int mi = 0; mi < 2; ++mi) {
                const bf16x8 a = lds_frag(Cm, 16 * (2 * th + mi) + fr, kk * 32 + fq * 8, 136);
#pragma unroll
                for (int ntl = 0; ntl < 4; ++ntl) y2[mi][ntl] = mfma16(a, bh[ntl], y2[mi][ntl]);
            }
        }
    }
    const float Dh = XPAR(P_BD)[l * 8 + hh];
#pragma unroll
    for (int mi = 0; mi < 2; ++mi)
#pragma unroll
        for (int ii = 0; ii < 4; ++ii) {
            const int t = 16 * (2 * th + mi) + fq * 4 + ii;
            const float ea = __expf(av[hl * 64 + t]);
            const size_t row = (size_t)row0 + t;
            float ss = 0.f;
#pragma unroll
            for (int ntl = 0; ntl < 4; ++ntl) {
                const int p = 16 * ntl + fr;
                const float xv = bf2f(*(const LAS bf16_t*)(Xt + (((hl * 64 + p) * 72 + t) << 1)));
                const float y = y1[mi][ntl][ii] + ea * y2[mi][ntl][ii] + Dh * xv;
                const float gbv = y * siluf_(bf2f(bzv[mi][ntl][ii]));
                y1[mi][ntl][ii] = gbv; ss += gbv * gbv;
            }
            ss = red16(ss);
            if (fr == 0) ssq[t * 4 + hl] = ss;
        }
    __syncthreads();
#pragma unroll
    for (int mi = 0; mi < 2; ++mi)
#pragma unroll
        for (int ii = 0; ii < 4; ++ii) {
            const int t = 16 * (2 * th + mi) + fq * 4 + ii;
            const float rs = rsqrtf((ssq[t * 4] + ssq[t * 4 + 1] + ssq[t * 4 + 2] + ssq[t * 4 + 3]) * (1.f / 256.f) + EPS);
            const size_t row = (size_t)row0 + t;
#pragma unroll
            for (int ntl = 0; ntl < 4; ++ntl) {
                const int p = hh * 64 + 16 * ntl + fr;
                XMIX[row * DMIX + 512 + p] = (bf16_t)f2bf(y1[mi][ntl][ii] * rs * bnw[ntl]);
            }
        }
    __syncthreads();
}


#define XB_TMO      128
#define XB_XCNT(j)  (256  + 64 * (j))
#define XB_XSUB(j)  (1280 + 64 * (j))
#define XB_XGEN(j)  (2304 + 64 * (j))
#define XB_TOP      3328
#define XB_TOPGEN   3392
#define XCD_BAR_WORDS 3456
#define XB_SPIN_CAP (1u << 18)
__device__ __forceinline__ unsigned xb_ld(unsigned* p)              { return __hip_atomic_load(p, __ATOMIC_RELAXED, __HIP_MEMORY_SCOPE_AGENT); }
__device__ __forceinline__ unsigned xb_add(unsigned* p, unsigned v) { return __hip_atomic_fetch_add(p, v, __ATOMIC_RELAXED, __HIP_MEMORY_SCOPE_AGENT); }
__device__ __forceinline__ unsigned xb_xcc_id() { return (unsigned)__builtin_amdgcn_s_getreg((3 << 11) | 20) & 0xFu; }
#define XB_SPIN(cond, bar) do { unsigned _sp = 0; while (cond) { __builtin_amdgcn_s_sleep(1); \
    if ((++_sp & 255u) == 0u) { if (xb_ld(&(bar)[XB_TMO])) break; if (_sp > XB_SPIN_CAP) { atomicAdd(&(bar)[XB_TMO], 1u); break; } } } } while (0)
struct XcdBarrier { unsigned* bar; unsigned x; volatile LAS unsigned* st; };
__device__ __forceinline__ XcdBarrier xcd_barrier_post(unsigned* bar, volatile LAS unsigned* st) {
    XcdBarrier b; b.bar = bar; b.x = xb_xcc_id(); b.st = st;
    if (threadIdx.x == 0) (void)xb_add(&bar[XB_XCNT(b.x)], 1u);
    return b;
}
__device__ __forceinline__ void xcd_barrier_complete(unsigned* bar, unsigned x, unsigned& nloc, unsigned& nx) {
    const unsigned G = gridDim.x * gridDim.y * gridDim.z;
    unsigned sum, cnt, mine, sp = 0u;
    for (;;) {
        sum = 0u; cnt = 0u; mine = 0u;
#pragma unroll
        for (unsigned j = 0; j < 16; ++j) { const unsigned c = xb_ld(&bar[XB_XCNT(j)]); sum += c; cnt += (c > 0u) ? 1u : 0u; mine = (j == x) ? c : mine; }
        if (sum == G) break;
        __builtin_amdgcn_s_sleep(1);
        if ((++sp & 255u) == 0u) { if (xb_ld(&bar[XB_TMO])) break; if (sp > XB_SPIN_CAP) { atomicAdd(&bar[XB_TMO], 1u); break; } }
    }
    nloc = mine > 0u ? mine : 1u; nx = cnt > 0u ? cnt : 1u;
}
__device__ __forceinline__ void xcd_barrier(const XcdBarrier& b) {
    asm volatile("s_waitcnt vmcnt(0)" ::: "memory");
    __syncthreads();
    if (threadIdx.x == 0) {
        unsigned* bar = b.bar;
        __builtin_amdgcn_s_waitcnt(0);
        unsigned nloc = b.st[0], nx = b.st[1];
        if (nloc == 0u) { xcd_barrier_complete(bar, b.x, nloc, nx); b.st[0] = nloc; b.st[1] = nx; }
        const unsigned old = xb_add(&bar[XB_XSUB(b.x)], 1u);
        const unsigned gen = old / nloc;
        if (old + 1u == (gen + 1u) * nloc) {
            __builtin_amdgcn_fence(__ATOMIC_RELEASE, "agent");
            asm volatile("s_waitcnt vmcnt(0)" ::: "memory");
            const unsigned og = xb_add(&bar[XB_TOP], 1u);
            const unsigned tg = og / nx;
            if (og + 1u == (tg + 1u) * nx) xb_add(&bar[XB_TOPGEN], 1u);
            else XB_SPIN(xb_ld(&bar[XB_TOPGEN]) == tg, bar);
            __builtin_amdgcn_fence(__ATOMIC_ACQUIRE, "agent");
            xb_add(&bar[XB_XGEN(b.x)], 1u);
            asm volatile("s_waitcnt vmcnt(0)" ::: "memory");
        } else {
            XB_SPIN(xb_ld(&bar[XB_XGEN(b.x)]) == gen, bar);
            __builtin_amdgcn_fence(__ATOMIC_ACQUIRE, "agent");
            asm volatile("s_waitcnt vmcnt(0)" ::: "memory");
        }
    }
    __syncthreads();
}

__global__ void __launch_bounds__(NT, 2) mega(Args args) {
    __shared__ __attribute__((aligned(16))) unsigned char lds_raw[LDS_BYTES];
    lptr lds = (lptr)lds_raw;
    cg::grid_group grid = cg::this_grid();
    const int tid = threadIdx.x, bid = blockIdx.x, G = gridDim.x;
    Ctx X;
    X.xp = args.in[IN_XP]; X.xs = args.in[IN_XS]; X.stC = args.in[IN_STC]; X.stN = args.in[IN_STN]; X.stM = args.in[IN_STM]; X.ssm = args.in[IN_SSM];
    X.conv = args.in[IN_CONV]; X.ck = args.in[IN_CK]; X.cv = args.in[IN_CV]; X.out = args.out; X.ws = args.ws;
    const int lo = args.ph_lo, hi = args.ph_hi;
    volatile LAS unsigned* xst = (volatile LAS unsigned*)(lds + LDS_BYTES - 16);
    if (tid == 0) { xst[0] = 0u; xst[1] = 0u; }
    __syncthreads();
    XcdBarrier xbar = xcd_barrier_post((unsigned*)(args.ws + WS_BAR), xst);
#define IN(k) (lo <= (k) && (k) < hi)
#define SEAM(k) do { if (IN(k) && IN((k) + 1)) { for (int _r = 0; _r < REP_SYNC; ++_r) { if (lo < 0) grid.sync(); xcd_barrier(xbar); } } } while (0)
    if (IN(0)) { for (int _r = 0; _r < REP_P0; ++_r) prologue(lds, X, args, G, bid, tid); }
    SEAM(0);
    for (int l = 0; l < 4; ++l) {
        const int pb = 1 + l * 5;
        if (IN(pb)) for (int _r = 0; _r < REP_P1; ++_r) {
            pg8::Gemm g{XXB, XWIN + (size_t)l * NIN * D, MPAD, NIN, D}; pg8::StaticOrder S; S.init(TP, NIN, G, bid);
            pg8::EpiU E{XU, XSSQ};
            pg8::gemm_phase<pg8::EpiU, pg8::StaticOrder, false, GEMM_SP2, GEMM_ALIGN>(lds, g, S, E, OPQ(tid));
            if (l == 0 && bid >= G - 20) {
                pg8::SampleOrder S2{G - 20, 20, bid}; pg8::EpiUh E2{XU, XSSQ};
                pg8::gemm_phase<pg8::EpiUh, pg8::SampleOrder, true>(lds, g, S2, E2, OPQ(tid));
            }
        }
        SEAM(pb);
        if (IN(pb + 1)) for (int _r = 0; _r < REP_P2; ++_r) {
            for (int t = bid; t < 256; t += G) for (int _q = 0; _q < RT_SWA; ++_q) swa_prompt(lds, X, l, t, OPQ(tid));
            for (int t = bid; t < 256; t += G) for (int _q = 0; _q < RT_SAMPLE; ++_q) {
                if (t < 128) sample_task(lds, X, l, t, 1, OPQ(tid));
                else { sample_task(lds, X, l, t - 128, 0, OPQ(tid)); sample_task(lds, X, l, t - 128, 2, OPQ(tid)); }
            }
            for (int t = bid; t < 512; t += G) for (int _q = 0; _q < RT_SLOC; ++_q) ssd_local(lds, X, l, t, OPQ(tid));
            for (int t = bid; t < 1024; t += G) for (int _q = 0; _q < RT_MLOC; ++_q) mlstm_local(lds, X, l, t, OPQ(tid));
            if (bid == G - 1) {
                for (int i = tid; i < 2 * 3 * 1024; i += NT) {
                    const int ch = i & 1023, j = (i >> 10) % 3, n = i / 3072;
                    X.out[O_PCONV + (((size_t)l * 2 + n) * 3 + j) * 1024 + ch] = bf2f(XU[(size_t)(n * SEQ + SEQ - 3 + j) * NIN + C_BX + ch]);
                }
            }
        }
        SEAM(pb + 1);
        if (IN(pb + 2)) {
            if (bid >= G - 4) {
                pg8::Gemm g{XMIX, XWOUT + (size_t)l * D * DMIX, MPAD, D, DMIX}; pg8::SampleOrder S{G - 4, 4, bid};
                if (l == 0) { pg8::EpiRes_<1, 0> E{X.xp, X.xs, X.out, XXB, XSSQ}; pg8::gemm_phase<pg8::EpiRes_<1, 0>, pg8::SampleOrder, true>(lds, g, S, E, OPQ(tid)); }
                else if (l < 3) { pg8::EpiRes_<1, 1> E{X.xp, X.xs, X.out, XXB, XSSQ}; pg8::gemm_phase<pg8::EpiRes_<1, 1>, pg8::SampleOrder, true>(lds, g, S, E, OPQ(tid)); }
                else { pg8::EpiRes_<1, 2> E{X.xp, X.xs, X.out, XXB, XSSQ}; pg8::gemm_phase<pg8::EpiRes_<1, 2>, pg8::SampleOrder, true>(lds, g, S, E, OPQ(tid)); }
            }
            for (int _r = 0; _r < REP_P3; ++_r) scans(X, l, bid * NT + OPQ(tid), G * NT);
        }
        SEAM(pb + 2);
        if (IN(pb + 3)) for (int _r = 0; _r < REP_P4; ++_r) {
            for (int task = bid; task < 1536; task += G) {
                if (task < 512) for (int _q = 0; _q < RT_SOUT; ++_q) ssd_out(lds, X, l, task, OPQ(tid));
                else mlstm_out(lds, X, l, task - 512, OPQ(tid));
            }
        }
        SEAM(pb + 3);
        if (IN(pb + 4)) {
            {
                pg8::Gemm g{XMIX, XWOUT + (size_t)l * D * DMIX, MPAD, D, DMIX}; pg8::StaticOrder S; S.init(TP, D, G, bid);
#ifdef PROBE_P5
                { pg8::EpiProbe EP{(const unsigned*)(X.ws + 64), XSSQ}; pg8::gemm_phase<pg8::EpiProbe, pg8::StaticOrder, false, GEMM_SP2>(lds, g, S, EP, OPQ(tid)); }
#endif
                if (l == 0) { pg8::EpiRes_<2, 0> E{X.xp, X.xs, X.out, XXB, XSSQ}; pg8::gemm_phase<pg8::EpiRes_<2, 0>, pg8::StaticOrder, false, GEMM_SP2, GEMM_ALIGN>(lds, g, S, E, OPQ(tid)); }
                else if (l < 3) { pg8::EpiRes_<2, 1> E{X.xp, X.xs, X.out, XXB, XSSQ}; pg8::gemm_phase<pg8::EpiRes_<2, 1>, pg8::StaticOrder, false, GEMM_SP2, GEMM_ALIGN>(lds, g, S, E, OPQ(tid)); }
                else { pg8::EpiRes_<2, 2> E{X.xp, X.xs, X.out, XXB, XSSQ}; pg8::gemm_phase<pg8::EpiRes_<2, 2>, pg8::StaticOrder, false, GEMM_SP2, GEMM_ALIGN>(lds, g, S, E, OPQ(tid)); }
            }
            if (l < 3 && bid < 20) {
                pg8::Gemm g{XXB, XWIN + (size_t)(l + 1) * NIN * D, MPAD, NIN, D}; pg8::SampleOrder S{0, 20, bid};
                pg8::EpiUh E{XU, XSSQ};
                pg8::gemm_phase<pg8::EpiUh, pg8::SampleOrder, true>(lds, g, S, E, OPQ(tid));
            }
        }
        SEAM(pb + 4);
    }
#undef IN
#undef SEAM
}

extern "C" void kernel_launch(void* const* d_in, const int* in_sizes, int n_in, void* d_out, int out_size, void* d_ws, size_t ws_size, hipStream_t stream) {
    static int grid_blocks = 0;
    if (!grid_blocks) {
        int dev = 0, cus = 0, per_cu = 0;
        hipGetDevice(&dev);
        hipDeviceGetAttribute(&cus, hipDeviceAttributeMultiprocessorCount, dev);
        hipOccupancyMaxActiveBlocksPerMultiprocessor(&per_cu, mega, NT, 0);
        if (per_cu < 1) { fprintf(stderr, "occupancy query returned %d\n", per_cu); per_cu = 1; }
        grid_blocks = cus * 1;
        if (ws_size < WS_END) fprintf(stderr, "workspace too small: %zu < %zu\n", ws_size, (size_t)WS_END);
    }
    (void)hipMemsetAsync(d_ws, 0, 16384, stream);
    Args a{};
    for (int i = 0; i < 24; ++i) a.in[i] = (const float*)d_in[i];
    a.out = (float*)d_out; a.ws = (unsigned char*)d_ws;
    const int NPH = 21;
#if MULTI_LAUNCH
    for (int p = 0; p < NPH; ++p) {
        a.ph_lo = p; a.ph_hi = p + 1;
        void* kargs[] = {&a};
        hipError_t e = hipLaunchCooperativeKernel((void*)mega, dim3(grid_blocks), dim3(NT), kargs, 0, stream);
        if (e != hipSuccess) fprintf(stderr, "cooperative launch failed: %s (grid %d)\n", hipGetErrorString(e), grid_blocks);
    }
#else
    a.ph_lo = 0; a.ph_hi = NPH;
    void* kargs[] = {&a};
    hipError_t e = hipLaunchCooperativeKernel((void*)mega, dim3(grid_blocks), dim3(NT), kargs, 0, stream);
    if (e != hipSuccess) fprintf(stderr, "cooperative launch failed: %s (grid %d)\n", hipGetErrorString(e), grid_blocks);
#endif
}
```

```cpp
#include <hip/hip_runtime.h>
#include <hip/hip_cooperative_groups.h>
#include <cstdio>
#include <cstdint>
namespace cg = cooperative_groups;

#ifndef REP_SYNC
#define REP_SYNC 1
#endif
#ifndef REP_P1
#define REP_P1 1
#endif
#ifndef REP_P2
#define REP_P2 1
#endif
#ifndef REP_P3
#define REP_P3 1
#endif
#ifndef REP_P0
#define REP_P0 1
#endif
#ifndef REP_P4
#define REP_P4 1
#endif
#ifndef RT_SAMPLE
#define RT_SAMPLE 1
#endif
#ifndef RT_SWA
#define RT_SWA 1
#endif
#ifndef RT_SLOC
#define RT_SLOC 1
#endif
#ifndef RT_MLOC
#define RT_MLOC 1
#endif
#ifndef RT_SOUT
#define RT_SOUT 1
#endif
#ifndef GEMM_SP2
#define GEMM_SP2 true
#endif
#ifndef GEMM_ALIGN
#define GEMM_ALIGN true
#endif
#ifndef MULTI_LAUNCH
#define MULTI_LAUNCH 0
#endif

#define LAS __attribute__((address_space(3)))
typedef unsigned short bf16_t;
typedef short bf16x8 __attribute__((ext_vector_type(8)));
typedef float f32x4 __attribute__((ext_vector_type(4)));
typedef float f32x2 __attribute__((ext_vector_type(2)));
typedef unsigned u32x4 __attribute__((ext_vector_type(4)));
typedef unsigned u32x2 __attribute__((ext_vector_type(2)));
typedef __bf16 bf16x2_t __attribute__((ext_vector_type(2)));
typedef LAS unsigned char* lptr;

constexpr int D = 1024, DIN = 4880, NIN = 5120, DMIX = 1536, TP = 16384, MTOK = 16512, MPAD = 16640, SEQ = 8192;
constexpr int C_AQ = 0, C_AK = 256, C_AV = 512, C_AO = 1024, C_AZ = 1536, C_AI = 2048, C_AF = 2052, C_BZ = 2056, C_BX = 2568, C_BB = 3080, C_BC = 3336,
              C_BDT = 3592, C_CQ = 3600, C_CK = 4112, C_CV = 4240, C_CZ = 4368;
constexpr float EPS = 1e-6f;
constexpr size_t O_YP = 0, O_YS = 16777216, O_PC = 16908288, O_PN = 17170432, O_PM = 17172480, O_PH = 17172512, O_PCONV = 17696800, O_PK = 17721376,
                 O_PV = 17852448, O_SC = 17983520, O_SN = 34760736, O_SM = 34891808, O_SH = 34893856, O_SCONV = 68448288, O_SK = 70021152, O_SV = 78409760;
constexpr size_t WS_BAR = 0;
constexpr size_t WS_PAR = 16384;
constexpr size_t WS_WIN = WS_PAR + 102400;
constexpr size_t WS_WOUT = WS_WIN + (size_t)4 * NIN * D * 2;
constexpr size_t WS_XB = WS_WOUT + (size_t)4 * D * DMIX * 2;
constexpr size_t WS_U = WS_XB + (size_t)MPAD * D * 2;
constexpr size_t WS_MIX = WS_U + (size_t)MPAD * NIN * 2;
constexpr size_t WS_SSQ = WS_MIX + (size_t)MPAD * DMIX * 2;
constexpr size_t WS_ROPE = WS_SSQ + (size_t)MPAD * 16 * 4;
constexpr size_t WS_MC = WS_ROPE + (size_t)8200 * 64 * 4;
constexpr size_t WS_MN = WS_MC + (size_t)8 * 128 * 8192 * 4;
constexpr size_t WS_ML = WS_MN + (size_t)8 * 128 * 64 * 4;
constexpr size_t WS_BL = WS_ML + 4096;
constexpr size_t WS_MS = WS_BL + 4096;
constexpr size_t WS_SA = WS_MS + 4096;
constexpr size_t WS_SH = WS_SA + 8192;
constexpr size_t WS_CSB = WS_SH + (size_t)16 * 128 * 8192 * 4;
constexpr size_t WS_HSB = WS_CSB + (size_t)8 * 128 * 8192 * 2;
constexpr size_t WS_NS = WS_HSB + (size_t)16 * 128 * 8192 * 2;
constexpr size_t WS_END = WS_NS + (size_t)8 * 128 * 64 * 4;
constexpr int LDS_BYTES = 139264;
constexpr int NT = 512;

struct Args { const float* in[24]; float* out; unsigned char* ws; int ph_lo, ph_hi; };

__device__ __forceinline__ float bf2f(unsigned v) { return __uint_as_float(v << 16); }
__device__ __forceinline__ unsigned pk2(float lo, float hi) { f32x2 v = {lo, hi}; bf16x2_t b = __builtin_convertvector(v, bf16x2_t); return __builtin_bit_cast(unsigned, b); }
__device__ __forceinline__ unsigned f2bf(float f) { return pk2(f, 0.f) & 0xffffu; }
__device__ __forceinline__ void unpack8(u32x4 w, float (&f)[8]) {
#pragma unroll
    for (int i = 0; i < 4; ++i) { f[2 * i] = __uint_as_float(w[i] << 16); f[2 * i + 1] = __uint_as_float(w[i] & 0xffff0000u); }
}
__device__ __forceinline__ u32x4 pack8(const float (&f)[8]) { u32x4 w; w[0] = pk2(f[0], f[1]); w[1] = pk2(f[2], f[3]); w[2] = pk2(f[4], f[5]); w[3] = pk2(f[6], f[7]); return w; }
__device__ __forceinline__ u32x4 pack8v(f32x4 a, f32x4 b) { u32x4 w; w[0] = pk2(a[0], a[1]); w[1] = pk2(a[2], a[3]); w[2] = pk2(b[0], b[1]); w[3] = pk2(b[2], b[3]); return w; }
__device__ __forceinline__ bf16x8 as_frag(u32x4 w) { return __builtin_bit_cast(bf16x8, w); }
__device__ __forceinline__ bf16x8 ldg_f32_frag(const float* p) { f32x4 a = *(const f32x4*)p, b = *(const f32x4*)(p + 4); return as_frag(pack8v(a, b)); }
__device__ __forceinline__ bf16x8 lds_frag(lptr base, int row, int k, int stride) { return *(const LAS bf16x8*)(base + ((row * stride + k) << 1)); }
__device__ __forceinline__ f32x4 mfma16(bf16x8 a, bf16x8 b, f32x4 c) { return __builtin_amdgcn_mfma_f32_16x16x32_bf16(a, b, c, 0, 0, 0); }
__device__ __forceinline__ float rcpf_(float x) { return __builtin_amdgcn_rcpf(x); }
__device__ __forceinline__ float sigmoidf_(float x) { return rcpf_(1.f + __expf(-x)); }
__device__ __forceinline__ float siluf_(float x) { return x * rcpf_(1.f + __expf(-x)); }
__device__ __forceinline__ float softplusf_(float x) { return x > 20.f ? x : log1pf(__expf(x)); }
__device__ __forceinline__ float logsigf_(float x) { return fminf(x, 0.f) - log1pf(__expf(-fabsf(x))); }
template <int CTRL, int RM> __device__ __forceinline__ float dpps(float ident, float v) { return __int_as_float(__builtin_amdgcn_update_dpp(__float_as_int(ident), __float_as_int(v), CTRL, RM, 0xf, false)); }
__device__ __forceinline__ float wave_scan_sum(float v, int) {
    v += dpps<0x111, 0xf>(0.f, v); v += dpps<0x112, 0xf>(0.f, v); v += dpps<0x114, 0xf>(0.f, v); v += dpps<0x118, 0xf>(0.f, v);
    v += dpps<0x142, 0xa>(0.f, v); v += dpps<0x143, 0xc>(0.f, v);
    return v;
}
__device__ __forceinline__ float wave_scan_max(float v, int) {
    const float NI = -3.0e38f;
    v = fmaxf(v, dpps<0x111, 0xf>(NI, v)); v = fmaxf(v, dpps<0x112, 0xf>(NI, v)); v = fmaxf(v, dpps<0x114, 0xf>(NI, v)); v = fmaxf(v, dpps<0x118, 0xf>(NI, v));
    v = fmaxf(v, dpps<0x142, 0xa>(NI, v)); v = fmaxf(v, dpps<0x143, 0xc>(NI, v));
    return v;
}
__device__ __forceinline__ float lane63(float v) { return __int_as_float(__builtin_amdgcn_readlane(__float_as_int(v), 63)); }
__device__ __forceinline__ float red16(float v);
__device__ __forceinline__ float red16max(float v);
__device__ __forceinline__ float wave_sum(float v) { v = red16(v); v += __shfl_xor(v, 16); v += __shfl_xor(v, 32); return v; }
__device__ __forceinline__ float wave_max(float v) { v = red16max(v); v = fmaxf(v, __shfl_xor(v, 16)); v = fmaxf(v, __shfl_xor(v, 32)); return v; }
template <int CTRL> __device__ __forceinline__ float dppf(float v) { return __int_as_float(__builtin_amdgcn_update_dpp(0, __float_as_int(v), CTRL, 0xf, 0xf, true)); }
__device__ __forceinline__ float red16(float v) { v += dppf<0xB1>(v); v += dppf<0x4E>(v); v += dppf<0x141>(v); v += dppf<0x140>(v); return v; }
__device__ __forceinline__ float red16max(float v) { v = fmaxf(v, dppf<0xB1>(v)); v = fmaxf(v, dppf<0x4E>(v)); v = fmaxf(v, dppf<0x141>(v)); v = fmaxf(v, dppf<0x140>(v)); return v; }
__device__ __forceinline__ int OPQ(int v) { asm volatile("" : "+v"(v)); return v; }
#define LDS_FENCE() asm volatile("s_waitcnt lgkmcnt(0)" ::: "memory")

namespace pg8 {
constexpr int BM = 256, BK = 64, HALF = 128, HTB = HALF * BK * 2, STAGE_BYTES = 8 * HTB, NXCD = 8, WGM = 8;
__host__ __device__ __forceinline__ int lds_byte(int r, int c) { const int st = (r >> 4) * 2 + (c >> 5), rr = r & 15, cc = c & 31, ob = rr * 64 + cc * 2; return st * 1024 + (ob ^ (((ob >> 9) & 1) << 5)); }
__host__ __device__ __forceinline__ void stage_rc(int b, int& R, int& C) { const int st = b / 1024, sb = b % 1024, swz = sb ^ (((sb >> 9) & 1) << 5); R = (st >> 1) * 16 + swz / 64; C = (st & 1) * 32 + (swz % 64) / 2; }
__host__ __device__ __forceinline__ int perm32(int rho) { const int n = rho >> 4, i = rho & 15; return 8 * (i >> 2) + 4 * n + (i & 3); }
struct Unit { int pm, pn; };
struct Gemm { const bf16_t* A; const bf16_t* Bt; int M, N, K; };
struct StaticOrder {
    int nM, nN, nwg, G, c;
    __device__ void init(int M, int N, int G_, int c_) { nM = M / BM; nN = N / BM; nwg = nM * nN; G = G_; c = c_; }
    __device__ bool next(int i, Unit& u) const {
        const long L = (long)i * G + c; if (L >= nwg) return false;
        int wgid = (int)L; { const int q = nwg / NXCD, r = nwg % NXCD, xcd = wgid % NXCD, off = wgid / NXCD; wgid = (xcd < r ? xcd * (q + 1) : r * (q + 1) + (xcd - r) * q) + off; }
        const int nig = WGM * nN, gid = wgid / nig, fm = gid * WGM, gsz = (nM - fm) < WGM ? (nM - fm) : WGM;
        u.pm = fm + ((wgid % nig) % gsz); u.pn = (wgid % nig) / gsz; return true;
    }
};
template <int NAI> struct EpiU_ {
    bf16_t* U; const float* ssq;
    __device__ __forceinline__ void operator()(const f32x4 (&acc)[2][2][4][2], const Unit& u, int wr, int wc, int fr, int fq) const {
        const int row0 = u.pm * BM + wr * 64 + fr, col0 = u.pn * BM + wc * 32 + 8 * fq;
#pragma unroll
        for (int ai = 0; ai < NAI; ++ai)
#pragma unroll
            for (int m = 0; m < 4; ++m) {
                const int r = row0 + ai * HALF + m * 16;
                const f32x4 s = *(const f32x4*)(ssq + (size_t)r * 16 + fq * 4);
                float st = s[0] + s[1] + s[2] + s[3]; st += __shfl_xor(st, 16); st += __shfl_xor(st, 32);
                const float rs = rsqrtf(st * (1.f / 1024.f) + EPS);
                bf16_t* rowp = U + (size_t)r * NIN + col0;
#pragma unroll
                for (int bj = 0; bj < 2; ++bj) *(u32x4*)(rowp + bj * HALF) = pack8v(acc[ai][bj][m][0] * rs, acc[ai][bj][m][1] * rs);
                __builtin_amdgcn_sched_barrier(0);
            }
    }
};
template <int NAI, int MODE> struct EpiRes_ {
    const float* xp; const float* xs; float* out; bf16_t* xb; float* ssq;
    __device__ __forceinline__ void operator()(const f32x4 (&acc)[2][2][4][2], const Unit& u, int wr, int wc, int fr, int fq) const {
        const int row0 = u.pm * BM + wr * 64 + fr, col0 = u.pn * BM + wc * 32 + 8 * fq;
#pragma unroll
        for (int ai = 0; ai < NAI; ++ai)
#pragma unroll
            for (int m = 0; m < 4; ++m) {
                const int r = row0 + ai * HALF + m * 16;
                const bool valid = r < MTOK;
                float part = 0.f;
#pragma unroll
                for (int bj = 0; bj < 2; ++bj) {
                    const int c = col0 + bj * HALF;
                    f32x4 o0 = {0.f, 0.f, 0.f, 0.f}, o1 = {0.f, 0.f, 0.f, 0.f};
                    if (MODE == 0) {
                        const float* src = r < TP ? xp + (size_t)r * D : xs + (size_t)(r - TP) * D;
                        if (valid) { o0 = *(const f32x4*)(src + c); o1 = *(const f32x4*)(src + c + 4); }
                    } else {
                        float f[8]; unpack8(*(const u32x4*)(xb + (size_t)r * D + c), f);
                        o0 = (f32x4){f[0], f[1], f[2], f[3]}; o1 = (f32x4){f[4], f[5], f[6], f[7]};
                    }
                    const f32x4 v0 = acc[ai][bj][m][0] + o0, v1 = acc[ai][bj][m][1] + o1;
                    if (MODE == 2) {
                        if (valid) { *(f32x4*)(out + (size_t)r * D + c) = v0; *(f32x4*)(out + (size_t)r * D + c + 4) = v1; }
                    } else {
                        *(u32x4*)(xb + (size_t)r * D + c) = pack8v(v0, v1);
                        part += v0[0] * v0[0] + v0[1] * v0[1] + v0[2] * v0[2] + v0[3] * v0[3] + v1[0] * v1[0] + v1[1] * v1[1] + v1[2] * v1[2] + v1[3] * v1[3];
                    }
                }
                if (MODE != 2) {
                    part += __shfl_xor(part, 16); part += __shfl_xor(part, 32);
                    if (fq == 0) ssq[(size_t)r * 16 + u.pn * 4 + wc] = part;
                }
                __builtin_amdgcn_sched_barrier(0);
            }
    }
};

typedef EpiU_<2> EpiU; typedef EpiU_<1> EpiUh;
struct EpiProbe {
    const unsigned* flag; float* dst;
    __device__ __forceinline__ void operator()(const f32x4 (&acc)[2][2][4][2], const Unit& u, int wr, int wc, int fr, int fq) const {
        if (__hip_atomic_load(flag, __ATOMIC_RELAXED, __HIP_MEMORY_SCOPE_AGENT) == 12345u) {
            f32x4 t = {0.f, 0.f, 0.f, 0.f};
#pragma unroll
            for (int a = 0; a < 2; ++a)
#pragma unroll
                for (int b = 0; b < 2; ++b)
#pragma unroll
                    for (int m = 0; m < 4; ++m)
#pragma unroll
                        for (int n = 0; n < 2; ++n) t += acc[a][b][m][n];
            *(f32x4*)(dst + (size_t)(u.pm * 4 + u.pn) * 2048 + (wr * 4 + wc) * 256 + (fq * 16 + fr) * 4) = t;
        }
    }
};
struct SampleOrder {
    int first, cnt, c;
    __device__ bool next(int i, Unit& u) const { if (i != 0 || c < first || c >= first + cnt) return false; u.pm = 64; u.pn = c - first; return true; }
};
template <class Epi, class Sched, bool HALF_M = false, bool SP2 = false, bool ALIGN_EPI = false>
__device__ __forceinline__ void gemm_phase(lptr lds, const Gemm g, const Sched& S, const Epi& E, const int tid) {
    const int wid = __builtin_amdgcn_readfirstlane(tid >> 6), lane = tid & 63, wr = wid >> 2, wc = wid & 3, fr = lane & 15, fq = lane >> 4;
    const int K = g.K, nt = K / BK;
    unsigned voffA[2], voffB[2];
#pragma unroll
    for (int i = 0; i < 2; ++i) { int R, C; stage_rc(tid * 16 + i * 8192, R, C); const int Rb = (R & ~31) + perm32(R & 31);
        voffA[i] = (unsigned)(R * K + C) * 2u; voffB[i] = (unsigned)(Rb * K + C) * 2u; }
    const size_t kstep = (size_t)(BK * 2);
    const size_t hstep = (size_t)HALF * K * 2;
    const size_t tstep = 2 * hstep;
    const unsigned ldsw = (unsigned)wid * 1024u;
    const int aoff = lds_byte(wr * 64 + fr, fq * 8), boff = lds_byte(wc * 32 + fr, fq * 8);
#define PG8_SA(b, h) (((b) * 2 + (h)) * HTB)
#define PG8_SB(b, h) ((4 + (b) * 2 + (h)) * HTB)
#define PG8_STAGE(bufoff, gbase, voff) do { _Pragma("unroll") for (int _i = 0; _i < 2; ++_i) \
        __builtin_amdgcn_global_load_lds((const unsigned*)((const char*)(gbase) + (voff)[_i]), (LAS unsigned*)(lds + (bufoff) + ldsw + _i * 8192), 16, 0, 0); } while (0)
#define PG8_LDA(dst, b, h) do { _Pragma("unroll") for (int m = 0; m < 4; ++m) _Pragma("unroll") for (int k = 0; k < 2; ++k) dst[m][k] = *(const LAS bf16x8*)(lds + PG8_SA(b, h) + aoff + m * 2048 + k * 1024); } while (0)
#define PG8_LDB(dst, b, h) do { _Pragma("unroll") for (int n = 0; n < 2; ++n) _Pragma("unroll") for (int k = 0; k < 2; ++k) dst[n][k] = *(const LAS bf16x8*)(lds + PG8_SB(b, h) + boff + n * 2048 + k * 1024); } while (0)
#define PG8_MMA(ai, bj, At, Bt) do { __builtin_amdgcn_s_setprio(1); _Pragma("unroll") for (int m = 0; m < 4; ++m) _Pragma("unroll") for (int n = 0; n < 2; ++n) _Pragma("unroll") for (int k = 0; k < 2; ++k) \
        acc[ai][bj][m][n] = __builtin_amdgcn_mfma_f32_16x16x32_bf16(Bt[n][k], At[m][k], acc[ai][bj][m][n], 0, 0, 0); __builtin_amdgcn_s_setprio(0); } while (0)
#define PG8_WAIT_V(n) asm volatile("s_waitcnt vmcnt(" #n ")" ::: "memory")
#define PG8_WAIT_L(n) asm volatile("s_waitcnt lgkmcnt(" #n ")" ::: "memory")
#define PG8_BAR __builtin_amdgcn_s_barrier()
#define PG8_SCHED __builtin_amdgcn_sched_barrier(0)
    Unit cur, nxt; int ui = 0;
    if (!S.next(0, cur)) return;
    f32x4 acc[2][2][4][2];
#pragma unroll
    for (int a = 0; a < 2; ++a)
#pragma unroll
        for (int b = 0; b < 2; ++b)
#pragma unroll
            for (int m = 0; m < 4; ++m)
#pragma unroll
                for (int n = 0; n < 2; ++n) acc[a][b][m][n] = (f32x4){0.f, 0.f, 0.f, 0.f};
    bf16x8 At[4][2], B0[2][2], B1[2][2];
    const char* cA = (const char*)g.A + (size_t)cur.pm * tstep; const char* cB = (const char*)g.Bt + (size_t)cur.pn * tstep;
    if constexpr (SP2) {
        PG8_STAGE(PG8_SB(0, 0), cB, voffB); PG8_STAGE(PG8_SB(0, 1), cB + hstep, voffB); PG8_STAGE(PG8_SA(0, 0), cA, voffA); PG8_STAGE(PG8_SA(0, 1), cA + hstep, voffA);
        if (wr == 1) PG8_BAR;
        PG8_WAIT_V(2); PG8_BAR;
        PG8_STAGE(PG8_SB(1, 0), cB + kstep, voffB); PG8_STAGE(PG8_SA(1, 0), cA + kstep, voffA); PG8_STAGE(PG8_SB(1, 1), cB + hstep + kstep, voffB);
        PG8_WAIT_V(6); PG8_BAR;
    } else {
    PG8_STAGE(PG8_SB(0, 0), cB, voffB); PG8_STAGE(PG8_SA(0, 0), cA, voffA); PG8_STAGE(PG8_SB(0, 1), cB + hstep, voffB); PG8_STAGE(PG8_SA(0, 1), cA + hstep, voffA);
    if (wr == 1) PG8_BAR;
    PG8_WAIT_V(4); PG8_BAR;
    PG8_STAGE(PG8_SB(1, 0), cB + kstep, voffB); PG8_STAGE(PG8_SA(1, 0), cA + kstep, voffA); PG8_STAGE(PG8_SB(1, 1), cB + hstep + kstep, voffB);
    PG8_WAIT_V(6); PG8_BAR;
    }
    for (;;) {
        const bool has_next = S.next(ui + 1, nxt);
        const char* nA = has_next ? (const char*)g.A + (size_t)nxt.pm * tstep : cA; const char* nB = has_next ? (const char*)g.Bt + (size_t)nxt.pn * tstep : cB;
        for (int t = 0; t < nt; t += 2) {
            const bool last = (t == nt - 2);
            const char* a1 = cA + (size_t)(t + 1) * kstep;
            const char* a2 = last ? nA : cA + (size_t)(t + 2) * kstep; const char* b2 = last ? nB : cB + (size_t)(t + 2) * kstep;
            const char* a3 = a2 + kstep; const char* b3 = b2 + kstep;
            if constexpr (SP2) {
            PG8_LDB(B0, 0, 0); PG8_LDB(B1, 0, 1); PG8_SCHED; PG8_LDA(At, 0, 0); PG8_STAGE(PG8_SA(1, 1), a1 + hstep, voffA);
            PG8_WAIT_V(8); PG8_WAIT_L(0); PG8_BAR; PG8_MMA(0, 0, At, B0); PG8_MMA(0, 1, At, B1); PG8_BAR; PG8_SCHED;
            PG8_LDA(At, 0, 1); PG8_STAGE(PG8_SB(0, 0), b2, voffB); PG8_STAGE(PG8_SB(0, 1), b2 + hstep, voffB); PG8_STAGE(PG8_SA(0, 0), a2, voffA);
            PG8_WAIT_V(8); PG8_WAIT_L(0); PG8_BAR; PG8_MMA(1, 0, At, B0); PG8_MMA(1, 1, At, B1); PG8_BAR; PG8_SCHED;
            PG8_LDB(B0, 1, 0); PG8_LDB(B1, 1, 1); PG8_SCHED; PG8_LDA(At, 1, 0); PG8_STAGE(PG8_SA(0, 1), a2 + hstep, voffA);
            PG8_WAIT_V(8); PG8_WAIT_L(0); PG8_BAR; PG8_MMA(0, 0, At, B0); PG8_MMA(0, 1, At, B1); PG8_BAR; PG8_SCHED;
            PG8_LDA(At, 1, 1); PG8_STAGE(PG8_SB(1, 0), b3, voffB); PG8_STAGE(PG8_SB(1, 1), b3 + hstep, voffB); PG8_STAGE(PG8_SA(1, 0), a3, voffA);
            PG8_WAIT_V(8); PG8_WAIT_L(0); PG8_BAR; PG8_MMA(1, 0, At, B0); PG8_MMA(1, 1, At, B1); PG8_BAR; PG8_SCHED;
            } else {
            PG8_LDB(B0, 0, 0); PG8_SCHED; PG8_LDA(At, 0, 0); PG8_STAGE(PG8_SA(1, 1), a1 + hstep, voffA);
            PG8_WAIT_L(8); PG8_BAR; PG8_WAIT_L(0); PG8_MMA(0, 0, At, B0); PG8_BAR; PG8_SCHED;
            PG8_LDB(B1, 0, 1); PG8_STAGE(PG8_SB(0, 0), b2, voffB);
            PG8_BAR; PG8_WAIT_L(0); PG8_MMA(0, 1, At, B1); PG8_BAR;
            if constexpr (!HALF_M) PG8_LDA(At, 0, 1);
            PG8_STAGE(PG8_SA(0, 0), a2, voffA);
            PG8_BAR; PG8_WAIT_L(0); if constexpr (!HALF_M) PG8_MMA(1, 0, At, B0); PG8_BAR; PG8_SCHED;
            PG8_STAGE(PG8_SB(0, 1), b2 + hstep, voffB);
            PG8_WAIT_V(6); PG8_BAR; if constexpr (!HALF_M) PG8_MMA(1, 1, At, B1); PG8_BAR;
            PG8_LDB(B0, 1, 0); PG8_SCHED; PG8_LDA(At, 1, 0); PG8_STAGE(PG8_SA(0, 1), a2 + hstep, voffA);
            PG8_WAIT_L(8); PG8_BAR; PG8_WAIT_L(0); PG8_MMA(0, 0, At, B0); PG8_BAR; PG8_SCHED;
            PG8_LDB(B1, 1, 1); PG8_STAGE(PG8_SB(1, 0), b3, voffB);
            PG8_BAR; PG8_WAIT_L(0); PG8_MMA(0, 1, At, B1); PG8_BAR;
            if constexpr (!HALF_M) PG8_LDA(At, 1, 1);
            PG8_STAGE(PG8_SA(1, 0), a3, voffA);
            PG8_BAR; PG8_WAIT_L(0); if constexpr (!HALF_M) PG8_MMA(1, 0, At, B0); PG8_BAR; PG8_SCHED;
            PG8_STAGE(PG8_SB(1, 1), b3 + hstep, voffB);
            PG8_WAIT_V(6); PG8_BAR; if constexpr (!HALF_M) PG8_MMA(1, 1, At, B1); PG8_BAR;
            }
        }
        if constexpr (ALIGN_EPI) { if (wr == 0) PG8_BAR; }
        E(acc, cur, wr, wc, fr, fq);
        if (!has_next) break;
#pragma unroll
        for (int a = 0; a < 2; ++a)
#pragma unroll
            for (int b = 0; b < 2; ++b)
#pragma unroll
                for (int m = 0; m < 4; ++m)
#pragma unroll
                    for (int n = 0; n < 2; ++n) acc[a][b][m][n] = (f32x4){0.f, 0.f, 0.f, 0.f};
        cur = nxt; cA = nA; cB = nB; ++ui;
        if constexpr (ALIGN_EPI) { if (wr == 1) PG8_BAR; }
    }
    PG8_WAIT_V(0);
    if constexpr (!ALIGN_EPI) { if (wr == 0) PG8_BAR; }
    PG8_BAR;
#undef PG8_SA
#undef PG8_SB
#undef PG8_STAGE
#undef PG8_LDA
#undef PG8_LDB
#undef PG8_MMA
#undef PG8_WAIT_V
#undef PG8_WAIT_L
#undef PG8_BAR
#undef PG8_SCHED
}
}

struct Ctx {
    const float* xp; const float* xs; const float* stC; const float* stN; const float* stM; const float* ssm; const float* conv; const float* ck; const float* cv;
    float* out; unsigned char* ws;
};
#define XWIN ((bf16_t*)(X.ws + WS_WIN))
#define XWOUT ((bf16_t*)(X.ws + WS_WOUT))
#define XXB ((bf16_t*)(X.ws + WS_XB))
#define XU ((bf16_t*)(X.ws + WS_U))
#define XMIX ((bf16_t*)(X.ws + WS_MIX))
#define XSSQ ((float*)(X.ws + WS_SSQ))
#define XROPE ((float*)(X.ws + WS_ROPE))
#define XMC ((float*)(X.ws + WS_MC))
#define XMN ((float*)(X.ws + WS_MN))
#define XML ((float*)(X.ws + WS_ML))
#define XBL ((float*)(X.ws + WS_BL))
#define XMS ((float*)(X.ws + WS_MS))
#define XSA ((float*)(X.ws + WS_SA))
#define XSH ((float*)(X.ws + WS_SH))
#define XCSB ((bf16_t*)(X.ws + WS_CSB))
#define XNS ((float*)(X.ws + WS_NS))
#define XHSB ((bf16_t*)(X.ws + WS_HSB))
#define XPAR(off) ((const float*)(X.ws + WS_PAR) + (off))
constexpr int P_AIB = 0, P_AFB = 16, P_DTB = 32, P_ALOG = 64, P_BD = 96, P_SINK = 128, P_QNW = 160, P_KNW = 416, P_ANW = 672, P_BNW = 2720, P_CB = 4768, P_CW = 8864, P_END = 25248;
#define IN_XP 0
#define IN_XS 1
#define IN_STC 2
#define IN_STN 3
#define IN_STM 4
#define IN_SSM 5
#define IN_CONV 6
#define IN_CK 7
#define IN_CV 8
#define IN_NORMW 9
#define IN_WIN 10
#define IN_AIB 11
#define IN_AFB 12
#define IN_ANW 13
#define IN_CW 14
#define IN_CB 15
#define IN_DTB 16
#define IN_ALOG 17
#define IN_BD 18
#define IN_BNW 19
#define IN_QNW 20
#define IN_KNW 21
#define IN_SINK 22
#define IN_WOUT 23

__device__ __forceinline__ void transpose_strip(lptr lds, const float* src, int ldn, int nvalid, bf16_t* dst, int ldk, const float* scale, int k0, int n0, int tid) {
    LAS float* T = (LAS float*)lds;
    f32x4 v[8];
#pragma unroll
    for (int i = 0; i < 8; ++i) {
        const int f = tid + i * NT, r = f >> 6, c4 = (f & 63) * 4, n = n0 + c4;
        const f32x4 t = *(const f32x4*)(src + (size_t)(k0 + r) * ldn + (n < nvalid ? n : 0));
        const float m = n < nvalid ? (scale ? scale[k0 + r] : 1.f) : 0.f;
        v[i] = t * m;
    }
#pragma unroll
    for (int i = 0; i < 8; ++i) {
        const int f = tid + i * NT, r = f >> 6, c4 = (f & 63) * 4;
        T[r * 257 + c4 + 0] = v[i][0]; T[r * 257 + c4 + 1] = v[i][1]; T[r * 257 + c4 + 2] = v[i][2]; T[r * 257 + c4 + 3] = v[i][3];
    }
    __syncthreads();
#pragma unroll
    for (int i = 0; i < 4; ++i) {
        const int p = tid + i * NT, n = p >> 3, k8 = (p & 7) * 8; float f[8];
#pragma unroll
        for (int jx = 0; jx < 8; ++jx) f[jx] = T[(k8 + jx) * 257 + n];
        *(u32x4*)(dst + (size_t)(n0 + n) * ldk + k0 + k8) = pack8(f);
    }
    __syncthreads();
}

__device__ __forceinline__ void prologue(lptr lds, const Ctx& X, const Args& args, int G, int bid, int tid) {
    const int lane = tid & 63, wave = tid >> 6;
    constexpr int T0 = 1280, T1 = T0 + 384, T2 = T1 + 2080, T3 = T2 + 1, T4 = T3 + 513;
    for (int task = bid; task < T4; task += G) {
        if (task < T0) {
            const int l = task / 320, r = task % 320, kt = r / 20, ntl = r % 20;
            transpose_strip(lds, args.in[IN_WIN] + (size_t)l * D * DIN, DIN, DIN, XWIN + (size_t)l * NIN * D, D, args.in[IN_NORMW] + l * D, kt * 64, ntl * 256, tid);
        } else if (task < T1) {
            const int t = task - T0, l = t / 96, r = t % 96, kt = r / 4, ntl = r % 4;
            transpose_strip(lds, args.in[IN_WOUT] + (size_t)l * DMIX * D, D, D, XWOUT + (size_t)l * D * DMIX, DMIX, nullptr, kt * 64, ntl * 256, tid);
        } else if (task < T2) {
            const int r = (task - T1) * 8 + wave;
            float ss = 0.f;
            if (r < MTOK) {
                const float* src = r < TP ? X.xp + (size_t)r * D : X.xs + (size_t)(r - TP) * D;
#pragma unroll
                for (int i = 0; i < 4; ++i) {
                    const int c = lane * 4 + i * 256; f32x4 v = *(const f32x4*)(src + c);
                    ss += v[0] * v[0] + v[1] * v[1] + v[2] * v[2] + v[3] * v[3];
                    u32x2 w; w[0] = pk2(v[0], v[1]); w[1] = pk2(v[2], v[3]);
                    *(u32x2*)(XXB + (size_t)r * D + c) = w;
                }
            } else {
#pragma unroll
                for (int i = 0; i < 4; ++i) { u32x2 w = {0u, 0u}; *(u32x2*)(XXB + (size_t)r * D + lane * 4 + i * 256) = w; }
            }
            ss = wave_sum(ss);
            if (lane < 16) XSSQ[(size_t)r * 16 + lane] = (lane == 0) ? ss : 0.f;
        } else if (task < T3) {
            for (int i = tid; i < (MPAD - MTOK) * DMIX / 2; i += NT) ((unsigned*)(XMIX + (size_t)MTOK * DMIX))[i] = 0u;
            float* P = (float*)(X.ws + WS_PAR);
            const int po[12] = {P_AIB, P_AFB, P_DTB, P_ALOG, P_BD, P_SINK, P_QNW, P_KNW, P_ANW, P_BNW, P_CB, P_CW};
            const int pn[12] = {16, 16, 32, 32, 32, 32, 256, 256, 2048, 2048, 4096, 16384};
            const int pi[12] = {IN_AIB, IN_AFB, IN_DTB, IN_ALOG, IN_BD, IN_SINK, IN_QNW, IN_KNW, IN_ANW, IN_BNW, IN_CB, IN_CW};
#pragma unroll
            for (int a = 0; a < 12; ++a) { const float* src = args.in[pi[a]]; for (int i = tid; i < pn[a]; i += NT) P[po[a] + i] = src[i]; }
        } else {
            const int e = (task - T3) * 512 + tid;
            if (e < 8193 * 32) {
                const int pos = e >> 5, d = e & 31;
                const float inv = (float)exp2(-(double)d * (13.287712379549449 / 32.0));
                const float angf = (float)pos * inv;
                const double a = (double)angf;
                const double k = rint(a * 0.15915494309189535);
                const float rr = (float)(a - k * 6.283185307179586);
                XROPE[(size_t)e * 2] = cosf(rr); XROPE[(size_t)e * 2 + 1] = sinf(rr);
            }
        }
    }
}

__device__ __forceinline__ void conv8(const bf16_t* u, int seq0, int tt, int ch, const float* cw, const float* cb, float (&o)[8]) {
    float acc[8];
    { f32x4 b0 = *(const f32x4*)(cb + ch), b1 = *(const f32x4*)(cb + ch + 4);
#pragma unroll
      for (int j = 0; j < 4; ++j) { acc[j] = b0[j]; acc[4 + j] = b1[j]; } }
#pragma unroll
    for (int jj = 0; jj < 4; ++jj) {
        const int t2 = tt + jj - 3;
        if (t2 >= 0) {
            float x[8]; unpack8(*(const u32x4*)(u + (size_t)(seq0 + t2) * NIN + C_BX + ch), x);
            f32x4 w0 = *(const f32x4*)(cw + jj * 1024 + ch), w1 = *(const f32x4*)(cw + jj * 1024 + ch + 4);
#pragma unroll
            for (int j = 0; j < 4; ++j) { acc[j] += x[j] * w0[j]; acc[4 + j] += x[4 + j] * w1[j]; }
        }
    }
#pragma unroll
    for (int j = 0; j < 8; ++j) o[j] = siluf_(acc[j]);
}


__device__ __forceinline__ void conv8x8(const bf16_t* u, int seq0, int tt0, int ch, const float* cw, const float* cb, float (&o)[8][8]) {
    float w[4][8];
#pragma unroll
    for (int jj = 0; jj < 4; ++jj) { f32x4 w0 = *(const f32x4*)(cw + jj * 1024 + ch), w1 = *(const f32x4*)(cw + jj * 1024 + ch + 4);
#pragma unroll
        for (int j = 0; j < 4; ++j) { w[jj][j] = w0[j]; w[jj][4 + j] = w1[j]; } }
    { f32x4 b0 = *(const f32x4*)(cb + ch), b1 = *(const f32x4*)(cb + ch + 4);
#pragma unroll
      for (int t = 0; t < 8; ++t)
#pragma unroll
          for (int j = 0; j < 4; ++j) { o[t][j] = b0[j]; o[t][4 + j] = b1[j]; } }
    u32x4 raw[11];
#pragma unroll
    for (int r = 0; r < 11; ++r) {
        const int t2 = tt0 + r - 3;
        const u32x4 v = *(const u32x4*)(u + (unsigned)(seq0 + (t2 >= 0 ? t2 : 0)) * NIN + C_BX + ch);
        const unsigned msk = t2 >= 0 ? 0xffffffffu : 0u;
        raw[r] = (u32x4){v[0] & msk, v[1] & msk, v[2] & msk, v[3] & msk};
    }
#pragma unroll
    for (int r = 0; r < 11; ++r) {
        float x[8]; unpack8(raw[r], x);
#pragma unroll
        for (int jj = 0; jj < 4; ++jj) {
            const int t = r - jj;
            if (t >= 0 && t < 8) {
#pragma unroll
                for (int j = 0; j < 8; ++j) o[t][j] += x[j] * w[jj][j];
            }
        }
    }
#pragma unroll
    for (int t = 0; t < 8; ++t)
#pragma unroll
        for (int j = 0; j < 8; ++j) o[t][j] = siluf_(o[t][j]);
}

__device__ __forceinline__ void mlstm_local(lptr lds, const Ctx& X, int l, int task, int tid) {
    const int h = task & 3, c = (task >> 2) & 127, n = task >> 9;
    const int lane = tid & 63, wave = tid >> 6, fr = lane & 15, fq = lane >> 4;
    const int row0 = n * SEQ + c * 64, nh = n * 4 + h;
    lptr VwT = lds;
    lptr KT = lds + 18432;
    LAS float* wv = (LAS float*)(lds + 27648);
    const int tg = lane & 7, cgq = lane >> 3;
    u32x4 blk[8];
    if (wave >= 1 && wave <= 3) {
        const int col = wave < 3 ? C_AV + h * 128 + ((wave - 1) * 8 + cgq) * 8 : C_AK + h * 64 + cgq * 8;
#pragma unroll
        for (int t = 0; t < 8; ++t) blk[t] = *(const u32x4*)(XU + (unsigned)(row0 + 8 * tg + t) * NIN + col);
    }
    if (wave == 0) {
        const bf16_t* ur = XU + (unsigned)(row0 + lane) * NIN;
        const float fg = bf2f(ur[C_AF + h]) + XPAR(P_AFB)[l * 4 + h], ig = bf2f(ur[C_AI + h]) + XPAR(P_AIB)[l * 4 + h];
        const float b = wave_scan_sum(logsigf_(fg), lane);
        const float bl = lane63(b);
        const float g = bl - b + ig;
        const float ml = wave_max(g);
        wv[lane] = __expf(g - ml);
        if (lane == 0) { XML[nh * 128 + c] = ml; XBL[nh * 128 + c] = bl; }
    }
    __syncthreads();
    if (wave >= 1 && wave <= 3) {
        float xs[8][8];
#pragma unroll
        for (int t = 0; t < 8; ++t) { unpack8(blk[t], xs[t]); const float w = wave < 3 ? wv[8 * tg + t] : 0.125f;
#pragma unroll
            for (int j = 0; j < 8; ++j) xs[t][j] *= w; }
        lptr dstT = wave < 3 ? VwT + ((((wave - 1) * 8 + cgq) * 8 * 72) << 1) : KT + ((cgq * 8 * 72) << 1);
#pragma unroll
        for (int j = 0; j < 8; ++j) {
            float v[8];
#pragma unroll
            for (int t = 0; t < 8; ++t) v[t] = xs[t][j];
            *(LAS u32x4*)(dstT + ((j * 72 + 8 * tg) << 1)) = pack8(v);
        }
    }
    __syncthreads();
    {
        bf16_t* dst = (bf16_t*)XMC + ((size_t)nh * 128 + c) * 8192;
        bf16x8 b0 = lds_frag(VwT, 16 * wave + fr, fq * 8, 72), b1 = lds_frag(VwT, 16 * wave + fr, 32 + fq * 8, 72);
#pragma unroll
        for (int mt = 0; mt < 4; ++mt) {
            f32x4 acc = {0.f, 0.f, 0.f, 0.f};
            acc = mfma16(lds_frag(KT, 16 * mt + fr, fq * 8, 72), b0, acc);
            acc = mfma16(lds_frag(KT, 16 * mt + fr, 32 + fq * 8, 72), b1, acc);
            { u32x2 w; w[0] = pk2(acc[0], acc[1]); w[1] = pk2(acc[2], acc[3]); *(u32x2*)(dst + (16 * wave + fr) * 64 + 16 * mt + 4 * fq) = w; }
        }
    }
    if (tid < 64) {
        float s = 0.f;
#pragma unroll
        for (int t8 = 0; t8 < 8; ++t8) {
            float kf[8]; unpack8(*(const LAS u32x4*)(KT + ((tid * 72 + t8 * 8) << 1)), kf);
#pragma unroll
            for (int jx = 0; jx < 8; ++jx) s += kf[jx] * wv[t8 * 8 + jx];
        }
        XMN[((size_t)nh * 128 + c) * 64 + tid] = s;
    }
    __syncthreads();
}

__device__ __forceinline__ void ssd_local(lptr lds, const Ctx& X, int l, int task, int tid) {
    const int g = task & 1, c = (task >> 1) & 127, n = task >> 8;
    const int lane = tid & 63, wave = tid >> 6, fr = lane & 15, fq = lane >> 4;
    const int seq0 = n * SEQ, row0 = seq0 + c * 64;
    lptr XwT = lds;
    lptr BT = lds + 36864;
    LAS float* wl = (LAS float*)(lds + 55296);
    {
        const float* cw = XPAR(P_CW) + l * 4096; const float* cb = XPAR(P_CB) + l * 1024;
        const int tg = lane & 7, cg = wave * 8 + (lane >> 3);
        float o[8][8];
        if (wave < 6) {
            const int ch = cg < 32 ? g * 256 + cg * 8 : 512 + g * 128 + (cg - 32) * 8;
            conv8x8(XU, seq0, c * 64 + 8 * tg, ch, cw, cb, o);
        }
        if (wave < 4) {
            const int hh = 4 * g + wave;
            const float dt = softplusf_(bf2f(XU[(unsigned)(row0 + lane) * NIN + C_BDT + hh]) + XPAR(P_DTB)[l * 8 + hh]);
            const float A = -__expf(XPAR(P_ALOG)[l * 8 + hh]);
            const float a = wave_scan_sum(dt * A, lane);
            const float aL = lane63(a);
            wl[wave * 64 + lane] = __expf(aL - a) * dt;
            if (lane == 0) XSA[(n * 8 + hh) * 128 + c] = aL;
        }
        __syncthreads();
        if (wave < 4) {
            float wt[8];
#pragma unroll
            for (int t = 0; t < 8; ++t) wt[t] = wl[wave * 64 + 8 * tg + t];
#pragma unroll
            for (int jx = 0; jx < 8; ++jx) {
                float v[8];
#pragma unroll
                for (int t = 0; t < 8; ++t) v[t] = o[t][jx] * wt[t];
                *(LAS u32x4*)(XwT + (((cg * 8 + jx) * 72 + 8 * tg) << 1)) = pack8(v);
            }
        } else if (wave < 6) {
#pragma unroll
            for (int jx = 0; jx < 8; ++jx) {
                float v[8];
#pragma unroll
                for (int t = 0; t < 8; ++t) v[t] = o[t][jx];
                *(LAS u32x4*)(BT + ((((cg - 32) * 8 + jx) * 72 + 8 * tg) << 1)) = pack8(v);
            }
        }
    }
    __syncthreads();
    {
        const int hl = wave >> 1, ph = wave & 1, hh = 4 * g + hl;
        bf16_t* dst = (bf16_t*)XSH + ((size_t)(n * 8 + hh) * 128 + c) * 8192;
        bf16x8 bx[2][2];
#pragma unroll
        for (int ntl = 0; ntl < 2; ++ntl)
#pragma unroll
            for (int kk = 0; kk < 2; ++kk) bx[ntl][kk] = lds_frag(XwT, hl * 64 + ph * 32 + ntl * 16 + fr, kk * 32 + fq * 8, 72);
#pragma unroll
        for (int mt = 0; mt < 8; ++mt) {
            bf16x8 a0 = lds_frag(BT, 16 * mt + fr, fq * 8, 72), a1 = lds_frag(BT, 16 * mt + fr, 32 + fq * 8, 72);
#pragma unroll
            for (int ntl = 0; ntl < 2; ++ntl) {
                f32x4 acc = {0.f, 0.f, 0.f, 0.f};
                acc = mfma16(a0, bx[ntl][0], acc); acc = mfma16(a1, bx[ntl][1], acc);
                { u32x2 w; w[0] = pk2(acc[0], acc[1]); w[1] = pk2(acc[2], acc[3]); *(u32x2*)(dst + (ph * 32 + ntl * 16 + fr) * 128 + 16 * mt + 4 * fq) = w; }
            }
        }
    }
    __syncthreads();
}

__device__ __forceinline__ void swa_prompt(lptr lds, const Ctx& X, int l, int task, int tid) {
    const int kvh = task & 1, qb = (task >> 1) & 63, n = task >> 7;
    const int lane = tid & 63, wave = tid >> 6, fr = lane & 15, fq = lane >> 4;
    const int seq0 = n * SEQ;
    lptr Kn = lds;
    lptr Vt = lds + 36864;
    lptr Pw = lds + 70656 + wave * 8448;
    const float* knw = XPAR(P_KNW) + l * 64; const float* qnw = XPAR(P_QNW) + l * 64;
#pragma unroll
    for (int it = 0; it < 2; ++it) {
        const int item = tid + it * NT, j = item >> 2, qd = item & 3, t = qb * 128 - 128 + j;
        float o1[8], o2[8];
        {
            const int tc = t >= 0 ? t : 0;
            const bf16_t* kr = XU + (unsigned)(seq0 + tc) * NIN + C_CK + kvh * 64;
            float x1[8], x2[8]; unpack8(*(const u32x4*)(kr + qd * 8), x1); unpack8(*(const u32x4*)(kr + 32 + qd * 8), x2);
            float ss = 0.f;
#pragma unroll
            for (int jj = 0; jj < 8; ++jj) ss += x1[jj] * x1[jj] + x2[jj] * x2[jj];
            ss += __shfl_xor(ss, 1); ss += __shfl_xor(ss, 2);
            const float rs = rsqrtf(ss * (1.f / 64.f) + EPS);
            const f32x4* cs = (const f32x4*)(XROPE + ((size_t)tc * 32 + qd * 8) * 2);
            f32x4 csv[4];
#pragma unroll
            for (int q4 = 0; q4 < 4; ++q4) csv[q4] = cs[q4];
            const float zm = t >= 0 ? 1.f : 0.f;
#pragma unroll
            for (int jj = 0; jj < 8; ++jj) {
                const float a = x1[jj] * rs * knw[qd * 8 + jj], b = x2[jj] * rs * knw[32 + qd * 8 + jj], co = csv[jj >> 1][(jj & 1) * 2], si = csv[jj >> 1][(jj & 1) * 2 + 1];
                o1[jj] = (a * co - b * si) * zm; o2[jj] = (b * co + a * si) * zm;
            }
        }
        *(LAS u32x4*)(Kn + ((j * 72 + qd * 8) << 1)) = pack8(o1);
        *(LAS u32x4*)(Kn + ((j * 72 + 32 + qd * 8) << 1)) = pack8(o2);
        if (qb == 63 && j >= 128) {
            float* ko = X.out + O_PK + ((((size_t)l * 2 + n) * 128 + (j - 128)) * 2 + kvh) * 64;
            *(f32x4*)(ko + qd * 8) = (f32x4){o1[0], o1[1], o1[2], o1[3]}; *(f32x4*)(ko + qd * 8 + 4) = (f32x4){o1[4], o1[5], o1[6], o1[7]};
            *(f32x4*)(ko + 32 + qd * 8) = (f32x4){o2[0], o2[1], o2[2], o2[3]}; *(f32x4*)(ko + 32 + qd * 8 + 4) = (f32x4){o2[4], o2[5], o2[6], o2[7]};
        }
    }
    if (wave < 4) {
        const int tg = tid & 31, cg = tid >> 5;
        u32x4 vb[8];
#pragma unroll
        for (int t8 = 0; t8 < 8; ++t8) {
            const int jk = 8 * tg + t8, t = qb * 128 - 128 + jk;
            u32x4 w = *(const u32x4*)(XU + (unsigned)(seq0 + (t >= 0 ? t : 0)) * NIN + C_CV + kvh * 64 + cg * 8);
            const unsigned msk = t >= 0 ? 0xffffffffu : 0u;
            vb[t8] = (u32x4){w[0] & msk, w[1] & msk, w[2] & msk, w[3] & msk};
        }
#pragma unroll
        for (int jj = 0; jj < 8; ++jj) {
            u32x4 w;
#pragma unroll
            for (int tp = 0; tp < 4; ++tp) {
                const unsigned lo = (vb[2 * tp][jj >> 1] >> ((jj & 1) * 16)) & 0xffffu, hi = (vb[2 * tp + 1][jj >> 1] >> ((jj & 1) * 16)) & 0xffffu;
                w[tp] = lo | (hi << 16);
            }
            *(LAS u32x4*)(Vt + (((cg * 8 + jj) * 264 + 8 * tg) << 1)) = w;
        }
        if (qb == 63 && tg >= 16) {
#pragma unroll
            for (int t8 = 0; t8 < 8; ++t8) {
                float x[8]; unpack8(vb[t8], x);
                float* vo = X.out + O_PV + ((((size_t)l * 2 + n) * 128 + (8 * tg + t8 - 128)) * 2 + kvh) * 64 + cg * 8;
                *(f32x4*)(vo) = (f32x4){x[0], x[1], x[2], x[3]}; *(f32x4*)(vo + 4) = (f32x4){x[4], x[5], x[6], x[7]};
            }
        }
    }
    __syncthreads();
    const int hq = kvh * 4 + (wave >> 1), i0 = (wave & 1) * 64;
    const float sink = XPAR(P_SINK)[l * 8 + hq];
    float qw1[8], qw2[8];
#pragma unroll
    for (int jj = 0; jj < 8; ++jj) { qw1[jj] = qnw[fq * 8 + jj]; qw2[jj] = qnw[32 + fq * 8 + jj]; }
    u32x4 qn0, qn1; f32x4 csn[4];
    {
        const int t = qb * 128 + i0 + fr;
        const bf16_t* qr = XU + (unsigned)(seq0 + t) * NIN + C_CQ + hq * 64;
        qn0 = *(const u32x4*)(qr + fq * 8); qn1 = *(const u32x4*)(qr + 32 + fq * 8);
        const f32x4* cs = (const f32x4*)(XROPE + ((size_t)t * 32 + fq * 8) * 2);
#pragma unroll
        for (int q4 = 0; q4 < 4; ++q4) csn[q4] = cs[q4];
    }
#pragma unroll 1
    for (int mt = 0; mt < 4; ++mt) {
        const int q0 = i0 + mt * 16;
        const u32x4 q0r = qn0, q1r = qn1; f32x4 csc[4];
#pragma unroll
        for (int q4 = 0; q4 < 4; ++q4) csc[q4] = csn[q4];
        unsigned short czv[4][4];
#pragma unroll
        for (int ii = 0; ii < 4; ++ii)
#pragma unroll
            for (int ntl = 0; ntl < 4; ++ntl) czv[ntl][ii] = XU[((unsigned)seq0 + qb * 128 + q0 + fq * 4 + ii) * NIN + C_CZ + hq * 64 + 16 * ntl + fr];
        {
            const int mn = mt < 3 ? mt + 1 : 3;
            const int t = qb * 128 + i0 + mn * 16 + fr;
            const bf16_t* qr = XU + (unsigned)(seq0 + t) * NIN + C_CQ + hq * 64;
            qn0 = *(const u32x4*)(qr + fq * 8); qn1 = *(const u32x4*)(qr + 32 + fq * 8);
            const f32x4* cs = (const f32x4*)(XROPE + ((size_t)t * 32 + fq * 8) * 2);
#pragma unroll
            for (int q4 = 0; q4 < 4; ++q4) csn[q4] = cs[q4];
        }
        bf16x8 a0, a1;
        {
            float x1[8], x2[8]; unpack8(q0r, x1); unpack8(q1r, x2);
            float ss = 0.f;
#pragma unroll
            for (int jj = 0; jj < 8; ++jj) ss += x1[jj] * x1[jj] + x2[jj] * x2[jj];
            ss += __shfl_xor(ss, 16); ss += __shfl_xor(ss, 32);
            const float rs = rsqrtf(ss * (1.f / 64.f) + EPS) * 0.125f;
            float o1[8], o2[8];
#pragma unroll
            for (int jj = 0; jj < 8; ++jj) {
                const float a = x1[jj] * rs * qw1[jj], b = x2[jj] * rs * qw2[jj], co = csc[jj >> 1][(jj & 1) * 2], si = csc[jj >> 1][(jj & 1) * 2 + 1];
                o1[jj] = a * co - b * si; o2[jj] = b * co + a * si;
            }
            a0 = as_frag(pack8(o1)); a1 = as_frag(pack8(o2));
        }
        const int tlo = q0 >> 4;
        const int qi = q0 + fr;
        const int dlo = qb > 0 ? 1 : (128 - qi > 1 ? 128 - qi : 1);
        f32x4 s[16];
        float mx = -3.0e38f;
#pragma unroll
        for (int ntl = 0; ntl < 16; ++ntl) {
            if (ntl >= tlo && ntl <= tlo + 8) {
                f32x4 acc = {0.f, 0.f, 0.f, 0.f};
                acc = mfma16(lds_frag(Kn, 16 * ntl + fr, fq * 8, 72), a0, acc);
                acc = mfma16(lds_frag(Kn, 16 * ntl + fr, 32 + fq * 8, 72), a1, acc);
                if (ntl == tlo || ntl == tlo + 8 || qb == 0) {
#pragma unroll
                    for (int ii = 0; ii < 4; ++ii) {
                        const int dk = 16 * ntl + 4 * fq + ii - qi;
                        acc[ii] = ((unsigned)(dk - dlo) <= (unsigned)(128 - dlo)) ? acc[ii] : -3.0e38f;
                    }
                }
                mx = fmaxf(mx, fmaxf(fmaxf(acc[0], acc[1]), fmaxf(acc[2], acc[3])));
                s[ntl] = acc;
            }
        }
        mx = fmaxf(mx, __shfl_xor(mx, 16)); mx = fmaxf(mx, __shfl_xor(mx, 32));
        mx = fmaxf(mx, sink);
        float sum = 0.f;
#pragma unroll
        for (int ntl = 0; ntl < 16; ++ntl) {
            if (ntl >= tlo && ntl <= tlo + 8) {
#pragma unroll
                for (int ii = 0; ii < 4; ++ii) { const float e = __expf(s[ntl][ii] - mx); s[ntl][ii] = e; sum += e; }
            }
        }
        sum += __shfl_xor(sum, 16); sum += __shfl_xor(sum, 32);
        const float inv = rcpf_(sum + __expf(sink - mx));
        const int klo = q0 >> 5, khi = (q0 + 143) >> 5;
#pragma unroll
        for (int ntl = 0; ntl < 16; ++ntl) {
            if (ntl >= tlo && ntl <= tlo + 8) {
                u32x2 w; w[0] = pk2(s[ntl][0] * inv, s[ntl][1] * inv); w[1] = pk2(s[ntl][2] * inv, s[ntl][3] * inv);
                *(LAS u32x2*)(Pw + ((fr * 264 + 16 * ntl + 4 * fq) << 1)) = w;
            } else if ((ntl >> 1) >= klo && (ntl >> 1) <= khi) {
                u32x2 w = {0u, 0u};
                *(LAS u32x2*)(Pw + ((fr * 264 + 16 * ntl + 4 * fq) << 1)) = w;
            }
        }
        LDS_FENCE();
        f32x4 o[4];
#pragma unroll
        for (int ntl = 0; ntl < 4; ++ntl) o[ntl] = (f32x4){0.f, 0.f, 0.f, 0.f};
#pragma unroll
        for (int kk = 0; kk < 8; ++kk) {
            if (kk >= klo && kk <= khi) {
                const bf16x8 a = lds_frag(Pw, fr, kk * 32 + fq * 8, 264);
#pragma unroll
                for (int ntl = 0; ntl < 4; ++ntl) o[ntl] = mfma16(a, lds_frag(Vt, 16 * ntl + fr, kk * 32 + fq * 8, 264), o[ntl]);
            }
        }
        LDS_FENCE();
#pragma unroll
        for (int ii = 0; ii < 4; ++ii) {
            const unsigned row = (unsigned)seq0 + qb * 128 + q0 + fq * 4 + ii;
#pragma unroll
            for (int ntl = 0; ntl < 4; ++ntl) {
                const int d = 16 * ntl + fr;
                XMIX[row * DMIX + 1024 + hq * 64 + d] = (bf16_t)f2bf(o[ntl][ii] * siluf_(bf2f(czv[ntl][ii])));
            }
        }
    }
    __syncthreads();
}

__device__ __forceinline__ void sample_task(lptr lds, const Ctx& X, int l, int b, int part, int tid) {
    LAS float* uf = (LAS float*)lds;
    LAS float* xbc = (LAS float*)(lds + 19968);
    LAS float* numv = (LAS float*)(lds + 24064);
    LAS float* yv = (LAS float*)(lds + 26112);
    LAS float* red = (LAS float*)(lds + 28160);
    LAS float* qs = (LAS float*)(lds + 28416);
    LAS float* kn = (LAS float*)(lds + 30464);
    LAS float* sc = (LAS float*)(lds + 30976);
    const int lane = tid & 63, wave = tid >> 6;
    const size_t row = (size_t)TP + b;
    const bf16_t* ur = XU + row * NIN;
    const size_t lb = (size_t)l * 128 + b;
    f32x4 kpre[8], vpre[8];
    if (part == 2) {
        const float* kc = X.ck + lb * 16384; const float* vc = X.cv + lb * 16384;
#pragma unroll
        for (int it = 0; it < 8; ++it) {
            const int e = (tid + it * NT) * 4, e2 = e < 127 * 128 ? e + 128 : e;
            kpre[it] = *(const f32x4*)(kc + e2); vpre[it] = *(const f32x4*)(vc + e2);
        }
    }
    {
        const int c_lo = part == 0 ? 0 : (part == 1 ? C_BZ : C_CQ), c_hi = part == 0 ? C_BZ : (part == 1 ? C_CQ : DIN);
#pragma unroll 2
        for (int i = c_lo + tid; i < c_hi; i += NT) uf[i] = bf2f(ur[i]);
    }
    __syncthreads();
    if (part == 0) {
#pragma unroll
    for (int h = 0; h < 4; ++h) {
        const float ig = uf[C_AI + h] + XPAR(P_AIB)[l * 4 + h], fg = uf[C_AF + h] + XPAR(P_AFB)[l * 4 + h];
        const float ls = logsigf_(fg), m0 = X.stM[lb * 4 + h];
        const float mn = fmaxf(ls + m0, ig), sp = __expf(ls + m0 - mn), sl = __expf(ig - mn);
        const float* C0 = X.stC + (lb * 4 + h) * 8192; float* C1 = X.out + O_SC + (lb * 4 + h) * 8192;
#pragma unroll
        for (int it = 0; it < 4; ++it) {
            const int e = (tid + it * NT) * 4, v = e >> 6, k = e & 63;
            const f32x4 c0 = *(const f32x4*)(C0 + e);
            const float vv = uf[C_AV + h * 128 + v] * sl;
            f32x4 c1; float part = 0.f;
#pragma unroll
            for (int j = 0; j < 4; ++j) { c1[j] = sp * c0[j] + vv * (uf[C_AK + h * 64 + k + j] * 0.125f); part += c1[j] * uf[C_AQ + h * 64 + k + j]; }
            *(f32x4*)(C1 + e) = c1;
            part = red16(part);
            if ((lane & 15) == 0) numv[h * 128 + v] = part;
        }
        if (wave == 0) {
            const float n1 = sp * X.stN[(lb * 4 + h) * 64 + lane] + sl * uf[C_AK + h * 64 + lane] * 0.125f;
            X.out[O_SN + (lb * 4 + h) * 64 + lane] = n1;
            const float dd = wave_sum(n1 * uf[C_AQ + h * 64 + lane]);
            if (lane == 0) { red[h] = dd; red[4 + h] = mn; X.out[O_SM + lb * 4 + h] = mn; }
        }
    }
    __syncthreads();
    float hv;
    { const int h = tid >> 7; hv = numv[tid] * rcpf_(fmaxf(fabsf(red[h]), __expf(-red[4 + h]))); const float ss = wave_sum(hv * hv); if (lane == 0) red[8 + wave] = ss; }
    __syncthreads();
    { const int h = tid >> 7; const float rs = rsqrtf((red[8 + 2 * h] + red[9 + 2 * h]) * (1.f / 128.f) + EPS);
      XMIX[row * DMIX + tid] = (bf16_t)f2bf(hv * rs * XPAR(P_ANW)[l * 512 + tid] * sigmoidf_(uf[C_AO + tid]) * siluf_(uf[C_AZ + tid])); }
    }
    if (part == 1) {
    {
        const float* buf = X.conv + lb * 3 * 1024; float* oc = X.out + O_SCONV + lb * 3 * 1024;
        const float* cw = XPAR(P_CW) + l * 4096;
#pragma unroll
        for (int it = 0; it < 2; ++it) {
            const int ch = tid + it * NT;
            const float f0 = buf[ch], f1 = buf[1024 + ch], f2 = buf[2048 + ch], f3 = uf[C_BX + ch];
            const float acc = XPAR(P_CB)[l * 1024 + ch] + f0 * cw[ch] + f1 * cw[1024 + ch] + f2 * cw[2048 + ch] + f3 * cw[3072 + ch];
            xbc[ch] = siluf_(acc);
            oc[ch] = f1; oc[1024 + ch] = f2; oc[2048 + ch] = f3;
        }
    }
    __syncthreads();
#pragma unroll 4
    for (int hh = 0; hh < 8; ++hh) {
        const float dt = softplusf_(uf[C_BDT + hh] + XPAR(P_DTB)[l * 8 + hh]);
        const float dA = __expf(-dt * __expf(XPAR(P_ALOG)[l * 8 + hh]));
        const int g = hh >> 2;
        const float* h0p = X.ssm + (lb * 8 + hh) * 8192; float* h1p = X.out + O_SH + (lb * 8 + hh) * 8192;
#pragma unroll
        for (int it = 0; it < 4; ++it) {
            const int e = (tid + it * NT) * 4, p = e >> 7, s = e & 127;
            const f32x4 h0 = *(const f32x4*)(h0p + e);
            const float xv = xbc[hh * 64 + p] * dt;
            f32x4 h1; float part = 0.f;
#pragma unroll
            for (int j = 0; j < 4; ++j) { h1[j] = dA * h0[j] + xv * xbc[512 + g * 128 + s + j]; part += h1[j] * xbc[768 + g * 128 + s + j]; }
            *(f32x4*)(h1p + e) = h1;
            part = red16(part); part += __shfl_xor(part, 16);
            if ((lane & 31) == 0) yv[hh * 64 + p] = part;
        }
    }
    __syncthreads();
    float gb;
    { const int hh = tid >> 6; const float y = yv[tid] + XPAR(P_BD)[l * 8 + hh] * xbc[tid]; gb = y * siluf_(uf[C_BZ + tid]); const float ss = wave_sum(gb * gb); if (lane == 0) red[16 + wave] = ss; }
    __syncthreads();
    { const int g = tid >> 8; const float rs = rsqrtf((red[16 + 4 * g] + red[17 + 4 * g] + red[18 + 4 * g] + red[19 + 4 * g]) * (1.f / 256.f) + EPS);
      XMIX[row * DMIX + 512 + tid] = (bf16_t)f2bf(gb * rs * XPAR(P_BNW)[l * 512 + tid]); }
    }
    if (part == 2) {
    lptr Kl = lds + 36864;
    lptr Vl = lds + 36864 + 34816;
    if (tid < 320) {
        const int vec = tid >> 5, d = tid & 31, base = vec < 8 ? C_CQ + vec * 64 : C_CK + (vec - 8) * 64;
        const float x1 = uf[base + d], x2 = uf[base + 32 + d];
        float ss = x1 * x1 + x2 * x2; ss = red16(ss); ss += __shfl_xor(ss, 16);
        const float rs = rsqrtf(ss * (1.f / 64.f) + EPS);
        const float* w = vec < 8 ? XPAR(P_QNW) + l * 64 : XPAR(P_KNW) + l * 64;
        const float a = x1 * rs * w[d], bb = x2 * rs * w[d + 32];
        const float co = XROPE[((size_t)8192 * 32 + d) * 2], si = XROPE[((size_t)8192 * 32 + d) * 2 + 1];
        const float o1 = a * co - bb * si, o2 = bb * co + a * si;
        if (vec < 8) { qs[vec * 64 + d] = o1 * 0.125f; qs[vec * 64 + 32 + d] = o2 * 0.125f; } else { kn[(vec - 8) * 64 + d] = o1; kn[(vec - 8) * 64 + 32 + d] = o2; }
    }
    __syncthreads();
    {
        float* ko = X.out + O_SK + lb * 16384; float* vo = X.out + O_SV + lb * 16384;
#pragma unroll
        for (int it = 0; it < 8; ++it) {
            const int e = (tid + it * NT) * 4, j = e >> 7, r = e & 127;
            f32x4 kv = kpre[it], vv = vpre[it];
            if (j == 127) { kv = (f32x4){kn[r], kn[r + 1], kn[r + 2], kn[r + 3]}; vv = (f32x4){uf[C_CV + r], uf[C_CV + r + 1], uf[C_CV + r + 2], uf[C_CV + r + 3]}; }
            *(f32x4*)(ko + e) = kv; *(f32x4*)(vo + e) = vv;
            u32x2 wk, wv2; wk[0] = pk2(kv[0], kv[1]); wk[1] = pk2(kv[2], kv[3]); wv2[0] = pk2(vv[0], vv[1]); wv2[1] = pk2(vv[2], vv[3]);
            *(LAS u32x2*)(Kl + ((j * 136 + r) << 1)) = wk; *(LAS u32x2*)(Vl + ((j * 136 + r) << 1)) = wv2;
        }
    }
    __syncthreads();
    if (tid < 256) {
        const int kvh = tid >> 7, jj = tid & 127;
        float s0 = 0.f, s1 = 0.f, s2 = 0.f, s3 = 0.f;
#pragma unroll 2
        for (int d8 = 0; d8 < 8; ++d8) {
            float kf[8]; unpack8(*(const LAS u32x4*)(Kl + ((jj * 136 + kvh * 64 + d8 * 8) << 1)), kf);
#pragma unroll
            for (int j = 0; j < 8; ++j) {
                s0 += kf[j] * qs[(kvh * 4 + 0) * 64 + d8 * 8 + j]; s1 += kf[j] * qs[(kvh * 4 + 1) * 64 + d8 * 8 + j];
                s2 += kf[j] * qs[(kvh * 4 + 2) * 64 + d8 * 8 + j]; s3 += kf[j] * qs[(kvh * 4 + 3) * 64 + d8 * 8 + j];
            }
        }
        sc[(kvh * 4 + 0) * 128 + jj] = s0; sc[(kvh * 4 + 1) * 128 + jj] = s1; sc[(kvh * 4 + 2) * 128 + jj] = s2; sc[(kvh * 4 + 3) * 128 + jj] = s3;
    }
    __syncthreads();
    {
        const int hq = wave; const float s0 = sc[hq * 128 + lane], s1 = sc[hq * 128 + 64 + lane], sink = XPAR(P_SINK)[l * 8 + hq];
        const float m = fmaxf(wave_max(fmaxf(s0, s1)), sink);
        const float e0 = __expf(s0 - m), e1 = __expf(s1 - m);
        const float inv = rcpf_(wave_sum(e0 + e1) + __expf(sink - m));
        sc[hq * 128 + lane] = e0 * inv; sc[hq * 128 + 64 + lane] = e1 * inv;
    }
    __syncthreads();
    {
        const int hq = tid >> 6, d = tid & 63, kvh = hq >> 2;
        float o = 0.f;
#pragma unroll 16
        for (int jj = 0; jj < 128; ++jj) o += sc[hq * 128 + jj] * bf2f(*(const LAS bf16_t*)(Vl + ((jj * 136 + kvh * 64 + d) << 1)));
        XMIX[row * DMIX + 1024 + tid] = (bf16_t)f2bf(o * siluf_(uf[C_CZ + tid]));
    }
    }
    __syncthreads();
}

__device__ __forceinline__ void scans(const Ctx& X, int l, int gt, int nthreads) {
    for (int item = gt; item < 98816; item += nthreads) {
        if (item < 32768) {
            const int nh = item >> 12, e = (item & 4095) * 2;
            const bf16_t* base = (const bf16_t*)XMC + (size_t)nh * 128 * 8192 + e;
            const float* ml = XML + nh * 128; const float* bl = XBL + nh * 128;
            float m = 0.f; f32x2 st = {0.f, 0.f};
            for (int c0 = 0; c0 < 128; c0 += 16) {
                f32x2 cl[16];
#pragma unroll
                for (int j = 0; j < 16; ++j) { const unsigned w = *(const unsigned*)(base + (size_t)(c0 + j) * 8192); cl[j] = (f32x2){__uint_as_float(w << 16), __uint_as_float(w & 0xffff0000u)}; }
#pragma unroll
                for (int j = 0; j < 16; ++j) {
                    const float mlj = ml[c0 + j], blj = bl[c0 + j], mn = fmaxf(blj + m, mlj), sp = __expf(blj + m - mn), sl = __expf(mlj - mn);
                    *(unsigned*)(XCSB + ((size_t)nh * 128 + c0 + j) * 8192 + e) = pk2(st[0], st[1]);
                    if (e == 0) XMS[nh * 128 + c0 + j] = m;
                    st = st * sp + cl[j] * sl; m = mn;
                }
            }
            *(f32x2*)(X.out + O_PC + ((size_t)l * 8 + nh) * 8192 + e) = st;
            if (e == 0) X.out[O_PM + l * 8 + nh] = m;
        } else if (item < 98304) {
            const int i1 = item - 32768, nhh = i1 >> 12, e = (i1 & 4095) * 2;
            const bf16_t* base = (const bf16_t*)XSH + (size_t)nhh * 128 * 8192 + e;
            const float* al = XSA + nhh * 128;
            f32x2 st = {0.f, 0.f};
            for (int c0 = 0; c0 < 128; c0 += 16) {
                f32x2 cl[16];
#pragma unroll
                for (int j = 0; j < 16; ++j) { const unsigned w = *(const unsigned*)(base + (size_t)(c0 + j) * 8192); cl[j] = (f32x2){__uint_as_float(w << 16), __uint_as_float(w & 0xffff0000u)}; }
#pragma unroll
                for (int j = 0; j < 16; ++j) {
                    const float dec = __expf(al[c0 + j]);
                    *(unsigned*)(XHSB + ((size_t)nhh * 128 + c0 + j) * 8192 + e) = pk2(st[0], st[1]);
                    st = st * dec + cl[j];
                }
            }
            *(f32x2*)(X.out + O_PH + ((size_t)l * 16 + nhh) * 8192 + e) = st;
        } else {
            const int i2 = item - 98304, nh = i2 >> 6, k = i2 & 63;
            float* base = XMN + (size_t)nh * 128 * 64 + k;
            const float* ml = XML + nh * 128; const float* bl = XBL + nh * 128;
            float m = 0.f, st = 0.f;
            for (int c = 0; c < 128; ++c) {
                const float mlj = ml[c], blj = bl[c], mn = fmaxf(blj + m, mlj), sp = __expf(blj + m - mn), sl = __expf(mlj - mn);
                const float cl = base[c * 64];
                XNS[(size_t)nh * 128 * 64 + c * 64 + k] = st;
                st = st * sp + cl * sl; m = mn;
            }
            X.out[O_PN + ((size_t)l * 8 + nh) * 64 + k] = st;
        }
    }
}

__device__ __forceinline__ void mlstm_out(lptr lds, const Ctx& X, int l, int task, int tid) {
    const int h = task & 3, c = (task >> 2) & 127, n = task >> 9;
    const int lane = tid & 63, wave = tid >> 6, fr = lane & 15, fq = lane >> 4;
    const int row0 = n * SEQ + c * 64, nh = n * 4 + h;
    lptr Qs = lds;
    lptr Ks = lds + 9216;
    lptr Vt = lds + 18432;
    lptr Sb = lds + 36864 + wave * 2304;
    LAS float* bv = (LAS float*)(lds + 55296);
    LAS float* dv = bv + 64;
    LAS float* mtv = bv + 128;
    LAS float* siv = bv + 192;
    LAS float* qnv = bv + 256;
    LAS float* ssqp = bv + 384;
    LAS float* nsv = bv + 512;
    const int mti = wave >> 1, half = wave & 1;
    u32x4 csf[2][4];
    {
        const bf16_t* Cs = XCSB + ((size_t)nh * 128 + c) * 8192;
#pragma unroll
        for (int kk = 0; kk < 2; ++kk)
#pragma unroll
            for (int ntl = 0; ntl < 4; ++ntl) csf[kk][ntl] = *(const u32x4*)(Cs + (64 * half + 16 * ntl + fr) * 64 + kk * 32 + fq * 8);
    }
    unsigned short aov[4][4], azv[4][4]; float anw[4];
#pragma unroll
    for (int ntl = 0; ntl < 4; ++ntl) {
        const int v = h * 128 + 64 * half + 16 * ntl + fr;
        anw[ntl] = XPAR(P_ANW)[l * 512 + v];
#pragma unroll
        for (int ii = 0; ii < 4; ++ii) {
            const unsigned row = (unsigned)row0 + 16 * mti + fq * 4 + ii;
            aov[ntl][ii] = XU[row * NIN + C_AO + v]; azv[ntl][ii] = XU[row * NIN + C_AZ + v];
        }
    }
    u32x4 qraw, kraw, vblk[8];
    const int tgv = lane & 7, cgv = (wave & 1) * 8 + (lane >> 3);
    {
        const int tok = tid >> 3, k8 = (tid & 7) * 8;
        const bf16_t* ur = XU + (unsigned)(row0 + tok) * NIN;
        qraw = *(const u32x4*)(ur + C_AQ + h * 64 + k8); kraw = *(const u32x4*)(ur + C_AK + h * 64 + k8);
        if (wave == 2 || wave == 3) {
#pragma unroll
            for (int t = 0; t < 8; ++t) vblk[t] = *(const u32x4*)(XU + (unsigned)(row0 + 8 * tgv + t) * NIN + C_AV + h * 128 + cgv * 8);
        }
    }
    if (wave == 0) {
        const bf16_t* ur = XU + (unsigned)(row0 + lane) * NIN;
        const float fg = bf2f(ur[C_AF + h]) + XPAR(P_AFB)[l * 4 + h], ig = bf2f(ur[C_AI + h]) + XPAR(P_AIB)[l * 4 + h];
        const float b = wave_scan_sum(logsigf_(fg), lane);
        const float dd = ig - b;
        const float cm = wave_scan_max(dd, lane);
        const float ms = XMS[nh * 128 + c];
        const float mt = b + fmaxf(ms, cm);
        bv[lane] = b; dv[lane] = dd; mtv[lane] = mt; siv[lane] = __expf(b + ms - mt);
        nsv[lane] = XNS[((size_t)nh * 128 + c) * 64 + lane];
    }
    {
        const int tok = tid >> 3, k8 = (tid & 7) * 8;
        *(LAS u32x4*)(Qs + ((tok * 72 + k8) << 1)) = qraw;
        float x[8]; unpack8(kraw, x);
#pragma unroll
        for (int j = 0; j < 8; ++j) x[j] *= 0.125f;
        *(LAS u32x4*)(Ks + ((tok * 72 + k8) << 1)) = pack8(x);
    }
    if (wave == 2 || wave == 3) {
#pragma unroll
        for (int j = 0; j < 8; ++j) {
            u32x4 w;
#pragma unroll
            for (int tp = 0; tp < 4; ++tp) {
                const unsigned lo = (vblk[2 * tp][j >> 1] >> ((j & 1) * 16)) & 0xffffu, hi = (vblk[2 * tp + 1][j >> 1] >> ((j & 1) * 16)) & 0xffffu;
                w[tp] = lo | (hi << 16);
            }
            *(LAS u32x4*)(Vt + (((cgv * 8 + j) * 72 + 8 * tgv) << 1)) = w;
        }
    }
    __syncthreads();
    bf16x8 qa[2];
    qa[0] = lds_frag(Qs, 16 * mti + fr, fq * 8, 72); qa[1] = lds_frag(Qs, 16 * mti + fr, 32 + fq * 8, 72);
    {
        float x0[8], x1[8]; unpack8(__builtin_bit_cast(u32x4, qa[0]), x0); unpack8(__builtin_bit_cast(u32x4, qa[1]), x1);
        float d = 0.f;
#pragma unroll
        for (int j = 0; j < 8; ++j) d += x0[j] * nsv[fq * 8 + j] + x1[j] * nsv[32 + fq * 8 + j];
        d += __shfl_xor(d, 16); d += __shfl_xor(d, 32);
        if (fq == 0) qnv[wave * 16 + fr] = d;
    }
    float rsum[4] = {0.f, 0.f, 0.f, 0.f};
#pragma unroll
    for (int ntl = 0; ntl < 4; ++ntl) {
        f32x4 s = {0.f, 0.f, 0.f, 0.f};
        s = mfma16(qa[0], lds_frag(Ks, 16 * ntl + fr, fq * 8, 72), s);
        s = mfma16(qa[1], lds_frag(Ks, 16 * ntl + fr, 32 + fq * 8, 72), s);
#pragma unroll
        for (int ii = 0; ii < 4; ++ii) {
            const int t = 16 * mti + fq * 4 + ii, sidx = 16 * ntl + fr;
            const float wgt = (sidx <= t) ? __expf(bv[t] + dv[sidx] - mtv[t]) : 0.f;
            const float sv = wgt * s[ii];
            rsum[ii] += sv;
            *(LAS bf16_t*)(Sb + (((fq * 4 + ii) * 72 + sidx) << 1)) = (bf16_t)f2bf(sv);
        }
    }
    LDS_FENCE();
    f32x4 acc[4];
#pragma unroll
    for (int ntl = 0; ntl < 4; ++ntl) acc[ntl] = (f32x4){0.f, 0.f, 0.f, 0.f};
#pragma unroll
    for (int kk = 0; kk < 2; ++kk) {
        const bf16x8 a = lds_frag(Sb, fr, kk * 32 + fq * 8, 72);
#pragma unroll
        for (int ntl = 0; ntl < 4; ++ntl) acc[ntl] = mfma16(a, lds_frag(Vt, 64 * half + 16 * ntl + fr, kk * 32 + fq * 8, 72), acc[ntl]);
    }
    {
        const float sia = siv[16 * mti + fr];
#pragma unroll
        for (int kk = 0; kk < 2; ++kk) {
            float x[8]; unpack8(__builtin_bit_cast(u32x4, qa[kk]), x);
#pragma unroll
            for (int j = 0; j < 8; ++j) x[j] *= sia;
            const bf16x8 a = as_frag(pack8(x));
#pragma unroll
            for (int ntl = 0; ntl < 4; ++ntl) acc[ntl] = mfma16(a, as_frag(csf[kk][ntl]), acc[ntl]);
        }
    }
    float hv[4][4], ssl[4];
#pragma unroll
    for (int ii = 0; ii < 4; ++ii) {
        const int t = 16 * mti + fq * 4 + ii;
        const float den = red16(rsum[ii]) + siv[t] * qnv[wave * 16 + fq * 4 + ii];
        const float inv = rcpf_(fmaxf(fabsf(den), __expf(-mtv[t])));
        float ss = 0.f;
#pragma unroll
        for (int ntl = 0; ntl < 4; ++ntl) { hv[ntl][ii] = acc[ntl][ii] * inv; ss += hv[ntl][ii] * hv[ntl][ii]; }
        ssl[ii] = red16(ss);
        if (fr == 0) ssqp[t * 2 + half] = ssl[ii];
    }
    __syncthreads();
#pragma unroll
    for (int ii = 0; ii < 4; ++ii) {
        const int t = 16 * mti + fq * 4 + ii;
        const float rs = rsqrtf((ssqp[t * 2] + ssqp[t * 2 + 1]) * (1.f / 128.f) + EPS);
        const unsigned row = (unsigned)row0 + t;
#pragma unroll
        for (int ntl = 0; ntl < 4; ++ntl) {
            const int v = h * 128 + 64 * half + 16 * ntl + fr;
            const float ao = bf2f(aov[ntl][ii]), az = bf2f(azv[ntl][ii]);
            XMIX[row * DMIX + v] = (bf16_t)f2bf(hv[ntl][ii] * rs * anw[ntl] * sigmoidf_(ao) * siluf_(az));
        }
    }
    __syncthreads();
}

__device__ __forceinline__ void ssd_out(lptr lds, const Ctx& X, int l, int task, int tid) {
    const int g = task & 1, c = (task >> 1) & 127, n = task >> 8;
    const int lane = tid & 63, wave = tid >> 6, fr = lane & 15, fq = lane >> 4;
    const int seq0 = n * SEQ, row0 = seq0 + c * 64;
    lptr Cm = lds;
    lptr Bm = lds + 17408;
    lptr Xt = lds + 34816;
    LAS float* CBf = (LAS float*)(lds + 71680);
    LAS float* av = (LAS float*)(lds + 89088);
    LAS float* dtv = (LAS float*)(lds + 90112);
    LAS float* ssq = (LAS float*)(lds + 91136);
    const int hl = wave >> 1, th = wave & 1, hh = 4 * g + hl;
    u32x4 hsf[4][4];
    {
        const bf16_t* hs = XHSB + ((size_t)(n * 8 + hh) * 128 + c) * 8192;
#pragma unroll
        for (int kk = 0; kk < 4; ++kk)
#pragma unroll
            for (int ntl = 0; ntl < 4; ++ntl) hsf[kk][ntl] = *(const u32x4*)(hs + (16 * ntl + fr) * 128 + kk * 32 + fq * 8);
    }
    if (wave < 4) {
        const int hh = 4 * g + wave;
        const float dt = softplusf_(bf2f(XU[(unsigned)(row0 + lane) * NIN + C_BDT + hh]) + XPAR(P_DTB)[l * 8 + hh]);
        const float A = -__expf(XPAR(P_ALOG)[l * 8 + hh]);
        av[wave * 64 + lane] = wave_scan_sum(dt * A, lane);
        dtv[wave * 64 + lane] = dt;
    }
    {
        const float* cw = XPAR(P_CW) + l * 4096; const float* cb = XPAR(P_CB) + l * 1024;
        float o[8][8];
        if (wave < 4) {
            const int tg = lane & 7, cg = wave * 8 + (lane >> 3);
            conv8x8(XU, seq0, c * 64 + 8 * tg, g * 256 + cg * 8, cw, cb, o);
#pragma unroll
            for (int jx = 0; jx < 8; ++jx) {
                float v[8];
#pragma unroll
                for (int t = 0; t < 8; ++t) v[t] = o[t][jx];
                *(LAS u32x4*)(Xt + (((cg * 8 + jx) * 72 + 8 * tg) << 1)) = pack8(v);
            }
        } else {
            const int tg = lane >> 3, s8 = ((wave & 1) * 8 + (lane & 7)) * 8;
            conv8x8(XU, seq0, c * 64 + 8 * tg, (wave < 6 ? 512 : 768) + g * 128 + s8, cw, cb, o);
            lptr dstm = wave < 6 ? Bm : Cm;
#pragma unroll
            for (int t = 0; t < 8; ++t) *(LAS u32x4*)(dstm + (((8 * tg + t) * 136 + s8) << 1)) = pack8(o[t]);
        }
    }
    __syncthreads();
    unsigned short bzv[2][4][4]; float bnw[4];
#pragma unroll
    for (int ntl = 0; ntl < 4; ++ntl) {
        bnw[ntl] = XPAR(P_BNW)[l * 512 + hh * 64 + 16 * ntl + fr];
#pragma unroll
        for (int mi = 0; mi < 2; ++mi)
#pragma unroll
            for (int ii = 0; ii < 4; ++ii) bzv[mi][ntl][ii] = XU[((unsigned)row0 + 16 * (2 * th + mi) + fq * 4 + ii) * NIN + C_BZ + hh * 64 + 16 * ntl + fr];
    }
    {
        const int mt = wave >> 1;
#pragma unroll
        for (int q = 0; q < 2; ++q) {
            const int ntl = 2 * (wave & 1) + q;
            f32x4 acc = {0.f, 0.f, 0.f, 0.f};
#pragma unroll
            for (int kk = 0; kk < 4; ++kk) acc = mfma16(lds_frag(Cm, 16 * mt + fr, kk * 32 + fq * 8, 136), lds_frag(Bm, 16 * ntl + fr, kk * 32 + fq * 8, 136), acc);
#pragma unroll
            for (int ii = 0; ii < 4; ++ii) CBf[(16 * mt + fq * 4 + ii) * 68 + 16 * ntl + fr] = acc[ii];
        }
    }
    __syncthreads();
    f32x4 y1[2][4], y2[2][4];
#pragma unroll
    for (int mi = 0; mi < 2; ++mi)
#pragma unroll
        for (int ntl = 0; ntl < 4; ++ntl) { y1[mi][ntl] = (f32x4){0.f, 0.f, 0.f, 0.f}; y2[mi][ntl] = (f32x4){0.f, 0.f, 0.f, 0.f}; }
#pragma unroll
    for (int kk = 0; kk < 2; ++kk) {
        bf16x8 bx[4];
#pragma unroll
        for (int ntl = 0; ntl < 4; ++ntl) bx[ntl] = lds_frag(Xt, hl * 64 + 16 * ntl + fr, kk * 32 + fq * 8, 72);
#pragma unroll
        for (int mi = 0; mi < 2; ++mi) {
            const int t = 16 * (2 * th + mi) + fr, u0 = kk * 32 + fq * 8;
            const float at = av[hl * 64 + t];
            float w[8];
#pragma unroll
            for (int j = 0; j < 8; ++j) {
                const int uu = u0 + j;
                w[j] = (uu <= t) ? CBf[t * 68 + uu] * __expf(at - av[hl * 64 + uu]) * dtv[hl * 64 + uu] : 0.f;
            }
            const bf16x8 a = as_frag(pack8(w));
#pragma unroll
            for (int ntl = 0; ntl < 4; ++ntl) y1[mi][ntl] = mfma16(a, bx[ntl], y1[mi][ntl]);
        }
    }
    {
#pragma unroll
        for (int kk = 0; kk < 4; ++kk) {
            bf16x8 bh[4];
#pragma unroll
            for (int ntl = 0; ntl < 4; ++ntl) bh[ntl] = as_frag(hsf[kk][ntl]);
#pragma unroll
            for (int mi = 0; mi < 2; ++mi) {
                const bf16x8 a = lds_frag(Cm, 16 * (2 * th + mi) + fr, kk * 32 + fq * 8, 136);
#pragma unroll
                for (int ntl = 0; ntl < 4; ++ntl) y2[mi][ntl] = mfma16(a, bh[ntl], y2[mi][ntl]);
            }
        }
    }
    const float Dh = XPAR(P_BD)[l * 8 + hh];
#pragma unroll
    for (int mi = 0; mi < 2; ++mi)
#pragma unroll
        for (int ii = 0; ii < 4; ++ii) {
            const int t = 16 * (2 * th + mi) + fq * 4 + ii;
            const float ea = __expf(av[hl * 64 + t]);
            const unsigned row = (unsigned)row0 + t;
            float ss = 0.f;
#pragma unroll
            for (int ntl = 0; ntl < 4; ++ntl) {
                const int p = 16 * ntl + fr;
                const float xv = bf2f(*(const LAS bf16_t*)(Xt + (((hl * 64 + p) * 72 + t) << 1)));
                const float y = y1[mi][ntl][ii] + ea * y2[mi][ntl][ii] + Dh * xv;
                const float gbv = y * siluf_(bf2f(bzv[mi][ntl][ii]));
                y1[mi][ntl][ii] = gbv; ss += gbv * gbv;
            }
            ss = red16(ss);
            if (fr == 0) ssq[t * 4 + hl] = ss;
        }
    __syncthreads();
#pragma unroll
    for (int mi = 0; mi < 2; ++mi)
#pragma unroll
        for (int ii = 0; ii < 4; ++ii) {
            const int t = 16 * (2 * th + mi) + fq * 4 + ii;
            const float rs = rsqrtf((ssq[t * 4] + ssq[t * 4 + 1] + ssq[t * 4 + 2] + ssq[t * 4 + 3]) * (1.f / 256.f) + EPS);
            const unsigned row = (unsigned)row0 + t;
#pragma unroll
            for (int ntl = 0; ntl < 4; ++ntl) {
                const int p = hh * 64 + 16 * ntl + fr;
                XMIX[row * DMIX + 512 + p] = (bf16_t)f2bf(y1[mi][ntl][ii] * rs * bnw[ntl]);
            }
        }
    __syncthreads();
}


#define XB_TMO      128
#define XB_XCNT(j)  (256  + 64 * (j))
#define XB_XSUB(j)  (1280 + 64 * (j))
#define XB_XGEN(j)  (2304 + 64 * (j))
#define XB_TOP      3328
#define XB_TOPGEN   3392
#define XCD_BAR_WORDS 3456
#define XB_SPIN_CAP (1u << 18)
__device__ __forceinline__ unsigned xb_ld(unsigned* p)              { return __hip_atomic_load(p, __ATOMIC_RELAXED, __HIP_MEMORY_SCOPE_AGENT); }
__device__ __forceinline__ unsigned xb_add(unsigned* p, unsigned v) { return __hip_atomic_fetch_add(p, v, __ATOMIC_RELAXED, __HIP_MEMORY_SCOPE_AGENT); }
__device__ __forceinline__ unsigned xb_xcc_id() { return (unsigned)__builtin_amdgcn_s_getreg((3 << 11) | 20) & 0xFu; }
#define XB_SPIN(cond, bar) do { unsigned _sp = 0; while (cond) { __builtin_amdgcn_s_sleep(1); \
    if ((++_sp & 255u) == 0u) { if (xb_ld(&(bar)[XB_TMO])) break; if (_sp > XB_SPIN_CAP) { atomicAdd(&(bar)[XB_TMO], 1u); break; } } } } while (0)
struct XcdBarrier { unsigned* bar; unsigned x; volatile LAS unsigned* st; };
__device__ __forceinline__ XcdBarrier xcd_barrier_post(unsigned* bar, volatile LAS unsigned* st) {
    XcdBarrier b; b.bar = bar; b.x = xb_xcc_id(); b.st = st;
    if (threadIdx.x == 0) (void)xb_add(&bar[XB_XCNT(b.x)], 1u);
    return b;
}
__device__ __forceinline__ void xcd_barrier_complete(unsigned* bar, unsigned x, unsigned& nloc, unsigned& nx) {
    const unsigned G = gridDim.x * gridDim.y * gridDim.z;
    unsigned sum, cnt, mine, sp = 0u;
    for (;;) {
        sum = 0u; cnt = 0u; mine = 0u;
#pragma unroll
        for (unsigned j = 0; j < 16; ++j) { const unsigned c = xb_ld(&bar[XB_XCNT(j)]); sum += c; cnt += (c > 0u) ? 1u : 0u; mine = (j == x) ? c : mine; }
        if (sum == G) break;
        __builtin_amdgcn_s_sleep(1);
        if ((++sp & 255u) == 0u) { if (xb_ld(&bar[XB_TMO])) break; if (sp > XB_SPIN_CAP) { atomicAdd(&bar[XB_TMO], 1u); break; } }
    }
    nloc = mine > 0u ? mine : 1u; nx = cnt > 0u ? cnt : 1u;
}
__device__ __forceinline__ void xcd_barrier(const XcdBarrier& b) {
    asm volatile("s_waitcnt vmcnt(0)" ::: "memory");
    __syncthreads();
    if (threadIdx.x == 0) {
        unsigned* bar = b.bar;
        __builtin_amdgcn_s_waitcnt(0);
        unsigned nloc = b.st[0], nx = b.st[1];
        if (nloc == 0u) { xcd_barrier_complete(bar, b.x, nloc, nx); b.st[0] = nloc; b.st[1] = nx; }
        const unsigned old = xb_add(&bar[XB_XSUB(b.x)], 1u);
        const unsigned gen = old / nloc;
        if (old + 1u == (gen + 1u) * nloc) {
            __builtin_amdgcn_fence(__ATOMIC_RELEASE, "agent");
            asm volatile("s_waitcnt vmcnt(0)" ::: "memory");
            const unsigned og = xb_add(&bar[XB_TOP], 1u);
            const unsigned tg = og / nx;
            if (og + 1u == (tg + 1u) * nx) xb_add(&bar[XB_TOPGEN], 1u);
            else XB_SPIN(xb_ld(&bar[XB_TOPGEN]) == tg, bar);
            __builtin_amdgcn_fence(__ATOMIC_ACQUIRE, "agent");
            xb_add(&bar[XB_XGEN(b.x)], 1u);
            asm volatile("s_waitcnt vmcnt(0)" ::: "memory");
        } else {
            XB_SPIN(xb_ld(&bar[XB_XGEN(b.x)]) == gen, bar);
            __builtin_amdgcn_fence(__ATOMIC_ACQUIRE, "agent");
            asm volatile("s_waitcnt vmcnt(0)" ::: "memory");
        }
    }
    __syncthreads();
}

__global__ void __launch_bounds__(NT, 2) mega(Args args) {
    __shared__ __attribute__((aligned(16))) unsigned char lds_raw[LDS_BYTES];
    lptr lds = (lptr)lds_raw;
    cg::grid_group grid = cg::this_grid();
    const int tid = threadIdx.x, bid = blockIdx.x, G = gridDim.x;
    Ctx X;
    X.xp = args.in[IN_XP]; X.xs = args.in[IN_XS]; X.stC = args.in[IN_STC]; X.stN = args.in[IN_STN]; X.stM = args.in[IN_STM]; X.ssm = args.in[IN_SSM];
    X.conv = args.in[IN_CONV]; X.ck = args.in[IN_CK]; X.cv = args.in[IN_CV]; X.out = args.out; X.ws = args.ws;
    const int lo = args.ph_lo, hi = args.ph_hi;
    volatile LAS unsigned* xst = (volatile LAS unsigned*)(lds + LDS_BYTES - 16);
    if (tid == 0) { xst[0] = 0u; xst[1] = 0u; }
    __syncthreads();
    XcdBarrier xbar = xcd_barrier_post((unsigned*)(args.ws + WS_BAR), xst);
#define IN(k) (lo <= (k) && (k) < hi)
#define SEAM(k) do { if (IN(k) && IN((k) + 1)) { for (int _r = 0; _r < REP_SYNC; ++_r) { if (lo < 0) grid.sync(); xcd_barrier(xbar); } } } while (0)
    if (IN(0)) { for (int _r = 0; _r < REP_P0; ++_r) prologue(lds, X, args, G, bid, tid); }
    SEAM(0);
    for (int l = 0; l < 4; ++l) {
        const int pb = 1 + l * 5;
        if (IN(pb)) for (int _r = 0; _r < REP_P1; ++_r) {
            pg8::Gemm g{XXB, XWIN + (size_t)l * NIN * D, MPAD, NIN, D}; pg8::StaticOrder S; S.init(TP, NIN, G, bid);
            pg8::EpiU E{XU, XSSQ};
            pg8::gemm_phase<pg8::EpiU, pg8::StaticOrder, false, GEMM_SP2, GEMM_ALIGN>(lds, g, S, E, OPQ(tid));
            if (l == 0 && bid >= G - 20) {
                pg8::SampleOrder S2{G - 20, 20, bid}; pg8::EpiUh E2{XU, XSSQ};
                pg8::gemm_phase<pg8::EpiUh, pg8::SampleOrder, true>(lds, g, S2, E2, OPQ(tid));
            }
        }
        SEAM(pb);
        if (IN(pb + 1)) for (int _r = 0; _r < REP_P2; ++_r) {
            for (int t = bid; t < 256; t += G) for (int _q = 0; _q < RT_SWA; ++_q) swa_prompt(lds, X, l, t, OPQ(tid));
            for (int t = bid; t < 256; t += G) for (int _q = 0; _q < RT_SAMPLE; ++_q) {
                if (t < 128) sample_task(lds, X, l, t, 1, OPQ(tid));
                else { sample_task(lds, X, l, t - 128, 0, OPQ(tid)); sample_task(lds, X, l, t - 128, 2, OPQ(tid)); }
            }
            for (int t = bid; t < 512; t += G) for (int _q = 0; _q < RT_SLOC; ++_q) ssd_local(lds, X, l, t, OPQ(tid));
            for (int t = bid; t < 1024; t += G) for (int _q = 0; _q < RT_MLOC; ++_q) mlstm_local(lds, X, l, t, OPQ(tid));
            if (bid == G - 1) {
                for (int i = tid; i < 2 * 3 * 1024; i += NT) {
                    const int ch = i & 1023, j = (i >> 10) % 3, n = i / 3072;
                    X.out[O_PCONV + (((size_t)l * 2 + n) * 3 + j) * 1024 + ch] = bf2f(XU[(size_t)(n * SEQ + SEQ - 3 + j) * NIN + C_BX + ch]);
                }
            }
        }
        SEAM(pb + 1);
        if (IN(pb + 2)) {
            if (bid >= G - 4) {
                pg8::Gemm g{XMIX, XWOUT + (size_t)l * D * DMIX, MPAD, D, DMIX}; pg8::SampleOrder S{G - 4, 4, bid};
                if (l == 0) { pg8::EpiRes_<1, 0> E{X.xp, X.xs, X.out, XXB, XSSQ}; pg8::gemm_phase<pg8::EpiRes_<1, 0>, pg8::SampleOrder, true>(lds, g, S, E, OPQ(tid)); }
                else if (l < 3) { pg8::EpiRes_<1, 1> E{X.xp, X.xs, X.out, XXB, XSSQ}; pg8::gemm_phase<pg8::EpiRes_<1, 1>, pg8::SampleOrder, true>(lds, g, S, E, OPQ(tid)); }
                else { pg8::EpiRes_<1, 2> E{X.xp, X.xs, X.out, XXB, XSSQ}; pg8::gemm_phase<pg8::EpiRes_<1, 2>, pg8::SampleOrder, true>(lds, g, S, E, OPQ(tid)); }
            }
            for (int _r = 0; _r < REP_P3; ++_r) scans(X, l, bid * NT + OPQ(tid), G * NT);
        }
        SEAM(pb + 2);
        if (IN(pb + 3)) for (int _r = 0; _r < REP_P4; ++_r) {
            for (int task = bid; task < 1536; task += G) {
                if (task < 512) for (int _q = 0; _q < RT_SOUT; ++_q) ssd_out(lds, X, l, task, OPQ(tid));
                else mlstm_out(lds, X, l, task - 512, OPQ(tid));
            }
        }
        SEAM(pb + 3);
        if (IN(pb + 4)) {
            {
                pg8::Gemm g{XMIX, XWOUT + (size_t)l * D * DMIX, MPAD, D, DMIX}; pg8::StaticOrder S; S.init(TP, D, G, bid);
#ifdef PROBE_P5
                { pg8::EpiProbe EP{(const unsigned*)(X.ws + 64), XSSQ}; pg8::gemm_phase<pg8::EpiProbe, pg8::StaticOrder, false, GEMM_SP2>(lds, g, S, EP, OPQ(tid)); }
#endif
                if (l == 0) { pg8::EpiRes_<2, 0> E{X.xp, X.xs, X.out, XXB, XSSQ}; pg8::gemm_phase<pg8::EpiRes_<2, 0>, pg8::StaticOrder, false, GEMM_SP2, GEMM_ALIGN>(lds, g, S, E, OPQ(tid)); }
                else if (l < 3) { pg8::EpiRes_<2, 1> E{X.xp, X.xs, X.out, XXB, XSSQ}; pg8::gemm_phase<pg8::EpiRes_<2, 1>, pg8::StaticOrder, false, GEMM_SP2, GEMM_ALIGN>(lds, g, S, E, OPQ(tid)); }
                else { pg8::EpiRes_<2, 2> E{X.xp, X.xs, X.out, XXB, XSSQ}; pg8::gemm_phase<pg8::EpiRes_<2, 2>, pg8::StaticOrder, false, GEMM_SP2, GEMM_ALIGN>(lds, g, S, E, OPQ(tid)); }
            }
            if (l < 3 && bid < 20) {
                pg8::Gemm g{XXB, XWIN + (size_t)(l + 1) * NIN * D, MPAD, NIN, D}; pg8::SampleOrder S{0, 20, bid};
                pg8::EpiUh E{XU, XSSQ};
                pg8::gemm_phase<pg8::EpiUh, pg8::SampleOrder, true>(lds, g, S, E, OPQ(tid));
            }
        }
        SEAM(pb + 4);
    }
#undef IN
#undef SEAM
}

extern "C" void kernel_launch(void* const* d_in, const int* in_sizes, int n_in, void* d_out, int out_size, void* d_ws, size_t ws_size, hipStream_t stream) {
    static int grid_blocks = 0;
    if (!grid_blocks) {
        int dev = 0, cus = 0, per_cu = 0;
        hipGetDevice(&dev);
        hipDeviceGetAttribute(&cus, hipDeviceAttributeMultiprocessorCount, dev);
        hipOccupancyMaxActiveBlocksPerMultiprocessor(&per_cu, mega, NT, 0);
        if (per_cu < 1) { fprintf(stderr, "occupancy query returned %d\n", per_cu); per_cu = 1; }
        grid_blocks = cus * 1;
        if (ws_size < WS_END) fprintf(stderr, "workspace too small: %zu < %zu\n", ws_size, (size_t)WS_END);
    }
    (void)hipMemsetAsync(d_ws, 0, 16384, stream);
    Args a{};
    for (int i = 0; i < 24; ++i) a.in[i] = (const float*)d_in[i];
    a.out = (float*)d_out; a.ws = (unsigned char*)d_ws;
    const int NPH = 21;
#if MULTI_LAUNCH
    for (int p = 0; p < NPH; ++p) {
        a.ph_lo = p; a.ph_hi = p + 1;
        void* kargs[] = {&a};
        hipError_t e = hipLaunchCooperativeKernel((void*)mega, dim3(grid_blocks), dim3(NT), kargs, 0, stream);
        if (e != hipSuccess) fprintf(stderr, "cooperative launch failed: %s (grid %d)\n", hipGetErrorString(e), grid_blocks);
    }
#else
    a.ph_lo = 0; a.ph_hi = NPH;
    void* kargs[] = {&a};
    hipError_t e = hipLaunchCooperativeKernel((void*)mega, dim3(grid_blocks), dim3(NT), kargs, 0, stream);
    if (e != hipSuccess) fprintf(stderr, "cooperative launch failed: %s (grid %d)\n", hipGetErrorString(e), grid_blocks);
#endif
}
```

```cpp
#include <hip/hip_runtime.h>
#include <hip/hip_cooperative_groups.h>
#include <cstdio>
#include <cstdint>
namespace cg = cooperative_groups;

#ifndef REP_SYNC
#define REP_SYNC 1
#endif
#ifndef REP_P1
#define REP_P1 1
#endif
#ifndef REP_P2
#define REP_P2 1
#endif
#ifndef REP_P3
#define REP_P3 1
#endif
#ifndef REP_P0
#define REP_P0 1
#endif
#ifndef REP_P4
#define REP_P4 1
#endif
#ifndef RT_SAMPLE
#define RT_SAMPLE 1
#endif
#ifndef RT_SWA
#define RT_SWA 1
#endif
#ifndef RT_SLOC
#define RT_SLOC 1
#endif
#ifndef RT_MLOC
#define RT_MLOC 1
#endif
#ifndef RT_SOUT
#define RT_SOUT 1
#endif
#ifndef GEMM_SP2
#define GEMM_SP2 true
#endif
#ifndef GEMM_ALIGN
#define GEMM_ALIGN true
#endif
#ifndef MULTI_LAUNCH
#define MULTI_LAUNCH 0
#endif

#define LAS __attribute__((address_space(3)))
typedef unsigned short bf16_t;
typedef short bf16x8 __attribute__((ext_vector_type(8)));
typedef float f32x4 __attribute__((ext_vector_type(4)));
typedef float f32x2 __attribute__((ext_vector_type(2)));
typedef unsigned u32x4 __attribute__((ext_vector_type(4)));
typedef unsigned u32x2 __attribute__((ext_vector_type(2)));
typedef __bf16 bf16x2_t __attribute__((ext_vector_type(2)));
typedef LAS unsigned char* lptr;

constexpr int D = 1024, DIN = 4880, NIN = 5120, DMIX = 1536, TP = 16384, MTOK = 16512, MPAD = 16640, SEQ = 8192;
constexpr int C_AQ = 0, C_AK = 256, C_AV = 512, C_AO = 1024, C_AZ = 1536, C_AI = 2048, C_AF = 2052, C_BZ = 2056, C_BX = 2568, C_BB = 3080, C_BC = 3336,
              C_BDT = 3592, C_CQ = 3600, C_CK = 4112, C_CV = 4240, C_CZ = 4368;
constexpr float EPS = 1e-6f;
constexpr size_t O_YP = 0, O_YS = 16777216, O_PC = 16908288, O_PN = 17170432, O_PM = 17172480, O_PH = 17172512, O_PCONV = 17696800, O_PK = 17721376,
                 O_PV = 17852448, O_SC = 17983520, O_SN = 34760736, O_SM = 34891808, O_SH = 34893856, O_SCONV = 68448288, O_SK = 70021152, O_SV = 78409760;
constexpr size_t WS_BAR = 0;
constexpr size_t WS_PAR = 16384;
constexpr size_t WS_WIN = WS_PAR + 102400;
constexpr size_t WS_WOUT = WS_WIN + (size_t)4 * NIN * D * 2;
constexpr size_t WS_XB = WS_WOUT + (size_t)4 * D * DMIX * 2;
constexpr size_t WS_U = WS_XB + (size_t)MPAD * D * 2;
constexpr size_t WS_MIX = WS_U + (size_t)MPAD * NIN * 2;
constexpr size_t WS_SSQ = WS_MIX + (size_t)MPAD * DMIX * 2;
constexpr size_t WS_ROPE = WS_SSQ + (size_t)MPAD * 16 * 4;
constexpr size_t WS_MC = WS_ROPE + (size_t)8200 * 64 * 4;
constexpr size_t WS_MN = WS_MC + (size_t)8 * 128 * 8192 * 4;
constexpr size_t WS_ML = WS_MN + (size_t)8 * 128 * 64 * 4;
constexpr size_t WS_BL = WS_ML + 4096;
constexpr size_t WS_MS = WS_BL + 4096;
constexpr size_t WS_SA = WS_MS + 4096;
constexpr size_t WS_SH = WS_SA + 8192;
constexpr size_t WS_CSB = WS_SH + (size_t)16 * 128 * 8192 * 4;
constexpr size_t WS_HSB = WS_CSB + (size_t)8 * 128 * 8192 * 2;
constexpr size_t WS_NS = WS_HSB + (size_t)16 * 128 * 8192 * 2;
constexpr size_t WS_END = WS_NS + (size_t)8 * 128 * 64 * 4;
constexpr int LDS_BYTES = 139264;
constexpr int NT = 512;

struct Args { const float* in[24]; float* out; unsigned char* ws; int ph_lo, ph_hi; };

__device__ __forceinline__ float bf2f(unsigned v) { return __uint_as_float(v << 16); }
__device__ __forceinline__ unsigned pk2(float lo, float hi) { f32x2 v = {lo, hi}; bf16x2_t b = __builtin_convertvector(v, bf16x2_t); return __builtin_bit_cast(unsigned, b); }
__device__ __forceinline__ unsigned f2bf(float f) { return pk2(f, 0.f) & 0xffffu; }
__device__ __forceinline__ void unpack8(u32x4 w, float (&f)[8]) {
#pragma unroll
    for (int i = 0; i < 4; ++i) { f[2 * i] = __uint_as_float(w[i] << 16); f[2 * i + 1] = __uint_as_float(w[i] & 0xffff0000u); }
}
__device__ __forceinline__ u32x4 pack8(const float (&f)[8]) { u32x4 w; w[0] = pk2(f[0], f[1]); w[1] = pk2(f[2], f[3]); w[2] = pk2(f[4], f[5]); w[3] = pk2(f[6], f[7]); return w; }
__device__ __forceinline__ u32x4 pack8v(f32x4 a, f32x4 b) { u32x4 w; w[0] = pk2(a[0], a[1]); w[1] = pk2(a[2], a[3]); w[2] = pk2(b[0], b[1]); w[3] = pk2(b[2], b[3]); return w; }
__device__ __forceinline__ bf16x8 as_frag(u32x4 w) { return __builtin_bit_cast(bf16x8, w); }
__device__ __forceinline__ bf16x8 ldg_f32_frag(const float* p) { f32x4 a = *(const f32x4*)p, b = *(const f32x4*)(p + 4); return as_frag(pack8v(a, b)); }
__device__ __forceinline__ bf16x8 lds_frag(lptr base, int row, int k, int stride) { return *(const LAS bf16x8*)(base + ((row * stride + k) << 1)); }
__device__ __forceinline__ f32x4 mfma16(bf16x8 a, bf16x8 b, f32x4 c) { return __builtin_amdgcn_mfma_f32_16x16x32_bf16(a, b, c, 0, 0, 0); }
__device__ __forceinline__ float rcpf_(float x) { return __builtin_amdgcn_rcpf(x); }
__device__ __forceinline__ float sigmoidf_(float x) { return rcpf_(1.f + __expf(-x)); }
__device__ __forceinline__ float siluf_(float x) { return x * rcpf_(1.f + __expf(-x)); }
__device__ __forceinline__ float softplusf_(float x) { return x > 20.f ? x : log1pf(__expf(x)); }
__device__ __forceinline__ float logsigf_(float x) { return fminf(x, 0.f) - log1pf(__expf(-fabsf(x))); }
template <int CTRL, int RM> __device__ __forceinline__ float dpps(float ident, float v) { return __int_as_float(__builtin_amdgcn_update_dpp(__float_as_int(ident), __float_as_int(v), CTRL, RM, 0xf, false)); }
__device__ __forceinline__ float wave_scan_sum(float v, int) {
    v += dpps<0x111, 0xf>(0.f, v); v += dpps<0x112, 0xf>(0.f, v); v += dpps<0x114, 0xf>(0.f, v); v += dpps<0x118, 0xf>(0.f, v);
    v += dpps<0x142, 0xa>(0.f, v); v += dpps<0x143, 0xc>(0.f, v);
    return v;
}
__device__ __forceinline__ float wave_scan_max(float v, int) {
    const float NI = -3.0e38f;
    v = fmaxf(v, dpps<0x111, 0xf>(NI, v)); v = fmaxf(v, dpps<0x112, 0xf>(NI, v)); v = fmaxf(v, dpps<0x114, 0xf>(NI, v)); v = fmaxf(v, dpps<0x118, 0xf>(NI, v));
    v = fmaxf(v, dpps<0x142, 0xa>(NI, v)); v = fmaxf(v, dpps<0x143, 0xc>(NI, v));
    return v;
}
__device__ __forceinline__ float lane63(float v) { return __int_as_float(__builtin_amdgcn_readlane(__float_as_int(v), 63)); }
__device__ __forceinline__ float red16(float v);
__device__ __forceinline__ float red16max(float v);
__device__ __forceinline__ float wave_sum(float v) { v = red16(v); v += __shfl_xor(v, 16); v += __shfl_xor(v, 32); return v; }
__device__ __forceinline__ float wave_max(float v) { v = red16max(v); v = fmaxf(v, __shfl_xor(v, 16)); v = fmaxf(v, __shfl_xor(v, 32)); return v; }
template <int CTRL> __device__ __forceinline__ float dppf(float v) { return __int_as_float(__builtin_amdgcn_update_dpp(0, __float_as_int(v), CTRL, 0xf, 0xf, true)); }
__device__ __forceinline__ float red16(float v) { v += dppf<0xB1>(v); v += dppf<0x4E>(v); v += dppf<0x141>(v); v += dppf<0x140>(v); return v; }
__device__ __forceinline__ float red16max(float v) { v = fmaxf(v, dppf<0xB1>(v)); v = fmaxf(v, dppf<0x4E>(v)); v = fmaxf(v, dppf<0x141>(v)); v = fmaxf(v, dppf<0x140>(v)); return v; }
__device__ __forceinline__ int OPQ(int v) { asm volatile("" : "+v"(v)); return v; }
#define LDS_FENCE() asm volatile("s_waitcnt lgkmcnt(0)" ::: "memory")

namespace pg8 {
constexpr int BM = 256, BK = 64, HALF = 128, HTB = HALF * BK * 2, STAGE_BYTES = 8 * HTB, NXCD = 8, WGM = 8;
__host__ __device__ __forceinline__ int lds_byte(int r, int c) { const int st = (r >> 4) * 2 + (c >> 5), rr = r & 15, cc = c & 31, ob = rr * 64 + cc * 2; return st * 1024 + (ob ^ (((ob >> 9) & 1) << 5)); }
__host__ __device__ __forceinline__ void stage_rc(int b, int& R, int& C) { const int st = b / 1024, sb = b % 1024, swz = sb ^ (((sb >> 9) & 1) << 5); R = (st >> 1) * 16 + swz / 64; C = (st & 1) * 32 + (swz % 64) / 2; }
__host__ __device__ __forceinline__ int perm32(int rho) { const int n = rho >> 4, i = rho & 15; return 8 * (i >> 2) + 4 * n + (i & 3); }
struct Unit { int pm, pn; };
struct Gemm { const bf16_t* A; const bf16_t* Bt; int M, N, K; };
struct StaticOrder {
    int nM, nN, nwg, G, c;
    __device__ void init(int M, int N, int G_, int c_) { nM = M / BM; nN = N / BM; nwg = nM * nN; G = G_; c = c_; }
    __device__ bool next(int i, Unit& u) const {
        const long L = (long)i * G + c; if (L >= nwg) return false;
        int wgid = (int)L; { const int q = nwg / NXCD, r = nwg % NXCD, xcd = wgid % NXCD, off = wgid / NXCD; wgid = (xcd < r ? xcd * (q + 1) : r * (q + 1) + (xcd - r) * q) + off; }
        const int nig = WGM * nN, gid = wgid / nig, fm = gid * WGM, gsz = (nM - fm) < WGM ? (nM - fm) : WGM;
        u.pm = fm + ((wgid % nig) % gsz); u.pn = (wgid % nig) / gsz; return true;
    }
};
template <int NAI> struct EpiU_ {
    bf16_t* U; const float* ssq;
    __device__ __forceinline__ void operator()(const f32x4 (&acc)[2][2][4][2], const Unit& u, int wr, int wc, int fr, int fq) const {
        const int row0 = u.pm * BM + wr * 64 + fr, col0 = u.pn * BM + wc * 32 + 8 * fq;
#pragma unroll
        for (int ai = 0; ai < NAI; ++ai)
#pragma unroll
            for (int m = 0; m < 4; ++m) {
                const int r = row0 + ai * HALF + m * 16;
                const f32x4 s = *(const f32x4*)(ssq + (size_t)r * 16 + fq * 4);
                float st = s[0] + s[1] + s[2] + s[3]; st += __shfl_xor(st, 16); st += __shfl_xor(st, 32);
                const float rs = rsqrtf(st * (1.f / 1024.f) + EPS);
                bf16_t* rowp = U + (size_t)r * NIN + col0;
#pragma unroll
                for (int bj = 0; bj < 2; ++bj) *(u32x4*)(rowp + bj * HALF) = pack8v(acc[ai][bj][m][0] * rs, acc[ai][bj][m][1] * rs);
                __builtin_amdgcn_sched_barrier(0);
            }
    }
};
template <int NAI, int MODE> struct EpiRes_ {
    const float* xp; const float* xs; float* out; bf16_t* xb; float* ssq;
    __device__ __forceinline__ void operator()(const f32x4 (&acc)[2][2][4][2], const Unit& u, int wr, int wc, int fr, int fq) const {
        const int row0 = u.pm * BM + wr * 64 + fr, col0 = u.pn * BM + wc * 32 + 8 * fq;
#pragma unroll
        for (int ai = 0; ai < NAI; ++ai)
#pragma unroll
            for (int m = 0; m < 4; ++m) {
                const int r = row0 + ai * HALF + m * 16;
                const bool valid = r < MTOK;
                float part = 0.f;
#pragma unroll
                for (int bj = 0; bj < 2; ++bj) {
                    const int c = col0 + bj * HALF;
                    f32x4 o0 = {0.f, 0.f, 0.f, 0.f}, o1 = {0.f, 0.f, 0.f, 0.f};
                    if (MODE == 0) {
                        const float* src = r < TP ? xp + (size_t)r * D : xs + (size_t)(r - TP) * D;
                        if (valid) { o0 = __builtin_nontemporal_load((const f32x4*)(src + c)); o1 = __builtin_nontemporal_load((const f32x4*)(src + c + 4)); }
                    } else {
                        float f[8]; unpack8(*(const u32x4*)(xb + (size_t)r * D + c), f);
                        o0 = (f32x4){f[0], f[1], f[2], f[3]}; o1 = (f32x4){f[4], f[5], f[6], f[7]};
                    }
                    const f32x4 v0 = acc[ai][bj][m][0] + o0, v1 = acc[ai][bj][m][1] + o1;
                    if (MODE == 2) {
                        if (valid) { __builtin_nontemporal_store(v0, (f32x4*)(out + (size_t)r * D + c)); __builtin_nontemporal_store(v1, (f32x4*)(out + (size_t)r * D + c + 4)); }
                    } else {
                        *(u32x4*)(xb + (size_t)r * D + c) = pack8v(v0, v1);
                        part += v0[0] * v0[0] + v0[1] * v0[1] + v0[2] * v0[2] + v0[3] * v0[3] + v1[0] * v1[0] + v1[1] * v1[1] + v1[2] * v1[2] + v1[3] * v1[3];
                    }
                }
                if (MODE != 2) {
                    part += __shfl_xor(part, 16); part += __shfl_xor(part, 32);
                    if (fq == 0) ssq[(size_t)r * 16 + u.pn * 4 + wc] = part;
                }
                __builtin_amdgcn_sched_barrier(0);
            }
    }
};

typedef EpiU_<2> EpiU; typedef EpiU_<1> EpiUh;
struct EpiProbe {
    const unsigned* flag; float* dst;
    __device__ __forceinline__ void operator()(const f32x4 (&acc)[2][2][4][2], const Unit& u, int wr, int wc, int fr, int fq) const {
        if (__hip_atomic_load(flag, __ATOMIC_RELAXED, __HIP_MEMORY_SCOPE_AGENT) == 12345u) {
            f32x4 t = {0.f, 0.f, 0.f, 0.f};
#pragma unroll
            for (int a = 0; a < 2; ++a)
#pragma unroll
                for (int b = 0; b < 2; ++b)
#pragma unroll
                    for (int m = 0; m < 4; ++m)
#pragma unroll
                        for (int n = 0; n < 2; ++n) t += acc[a][b][m][n];
            *(f32x4*)(dst + (size_t)(u.pm * 4 + u.pn) * 2048 + (wr * 4 + wc) * 256 + (fq * 16 + fr) * 4) = t;
        }
    }
};
struct SampleOrder {
    int first, cnt, c;
    __device__ bool next(int i, Unit& u) const { if (i != 0 || c < first || c >= first + cnt) return false; u.pm = 64; u.pn = c - first; return true; }
};
template <class Epi, class Sched, bool HALF_M = false, bool SP2 = false, bool ALIGN_EPI = false>
__device__ __forceinline__ void gemm_phase(lptr lds, const Gemm g, const Sched& S, const Epi& E, const int tid) {
    const int wid = __builtin_amdgcn_readfirstlane(tid >> 6), lane = tid & 63, wr = wid >> 2, wc = wid & 3, fr = lane & 15, fq = lane >> 4;
    const int K = g.K, nt = K / BK;
    unsigned voffA[2], voffB[2];
#pragma unroll
    for (int i = 0; i < 2; ++i) { int R, C; stage_rc(tid * 16 + i * 8192, R, C); const int Rb = (R & ~31) + perm32(R & 31);
        voffA[i] = (unsigned)(R * K + C) * 2u; voffB[i] = (unsigned)(Rb * K + C) * 2u; }
    const size_t kstep = (size_t)(BK * 2);
    const size_t hstep = (size_t)HALF * K * 2;
    const size_t tstep = 2 * hstep;
    const unsigned ldsw = (unsigned)wid * 1024u;
    const int aoff = lds_byte(wr * 64 + fr, fq * 8), boff = lds_byte(wc * 32 + fr, fq * 8);
#define PG8_SA(b, h) (((b) * 2 + (h)) * HTB)
#define PG8_SB(b, h) ((4 + (b) * 2 + (h)) * HTB)
#define PG8_STAGE(bufoff, gbase, voff) do { _Pragma("unroll") for (int _i = 0; _i < 2; ++_i) \
        __builtin_amdgcn_global_load_lds((const unsigned*)((const char*)(gbase) + (voff)[_i]), (LAS unsigned*)(lds + (bufoff) + ldsw + _i * 8192), 16, 0, 0); } while (0)
#define PG8_LDA(dst, b, h) do { _Pragma("unroll") for (int m = 0; m < 4; ++m) _Pragma("unroll") for (int k = 0; k < 2; ++k) dst[m][k] = *(const LAS bf16x8*)(lds + PG8_SA(b, h) + aoff + m * 2048 + k * 1024); } while (0)
#define PG8_LDB(dst, b, h) do { _Pragma("unroll") for (int n = 0; n < 2; ++n) _Pragma("unroll") for (int k = 0; k < 2; ++k) dst[n][k] = *(const LAS bf16x8*)(lds + PG8_SB(b, h) + boff + n * 2048 + k * 1024); } while (0)
#define PG8_MMA(ai, bj, At, Bt) do { __builtin_amdgcn_s_setprio(1); _Pragma("unroll") for (int m = 0; m < 4; ++m) _Pragma("unroll") for (int n = 0; n < 2; ++n) _Pragma("unroll") for (int k = 0; k < 2; ++k) \
        acc[ai][bj][m][n] = __builtin_amdgcn_mfma_f32_16x16x32_bf16(Bt[n][k], At[m][k], acc[ai][bj][m][n], 0, 0, 0); __builtin_amdgcn_s_setprio(0); } while (0)
#define PG8_WAIT_V(n) asm volatile("s_waitcnt vmcnt(" #n ")" ::: "memory")
#define PG8_WAIT_L(n) asm volatile("s_waitcnt lgkmcnt(" #n ")" ::: "memory")
#define PG8_BAR __builtin_amdgcn_s_barrier()
#define PG8_SCHED __builtin_amdgcn_sched_barrier(0)
    Unit cur, nxt; int ui = 0;
    if (!S.next(0, cur)) return;
    f32x4 acc[2][2][4][2];
#pragma unroll
    for (int a = 0; a < 2; ++a)
#pragma unroll
        for (int b = 0; b < 2; ++b)
#pragma unroll
            for (int m = 0; m < 4; ++m)
#pragma unroll
                for (int n = 0; n < 2; ++n) acc[a][b][m][n] = (f32x4){0.f, 0.f, 0.f, 0.f};
    bf16x8 At[4][2], B0[2][2], B1[2][2];
    const char* cA = (const char*)g.A + (size_t)cur.pm * tstep; const char* cB = (const char*)g.Bt + (size_t)cur.pn * tstep;
    if constexpr (SP2) {
        PG8_STAGE(PG8_SB(0, 0), cB, voffB); PG8_STAGE(PG8_SB(0, 1), cB + hstep, voffB); PG8_STAGE(PG8_SA(0, 0), cA, voffA); PG8_STAGE(PG8_SA(0, 1), cA + hstep, voffA);
        if (wr == 1) PG8_BAR;
        PG8_WAIT_V(2); PG8_BAR;
        PG8_STAGE(PG8_SB(1, 0), cB + kstep, voffB); PG8_STAGE(PG8_SA(1, 0), cA + kstep, voffA); PG8_STAGE(PG8_SB(1, 1), cB + hstep + kstep, voffB);
        PG8_WAIT_V(6); PG8_BAR;
    } else {
    PG8_STAGE(PG8_SB(0, 0), cB, voffB); PG8_STAGE(PG8_SA(0, 0), cA, voffA); PG8_STAGE(PG8_SB(0, 1), cB + hstep, voffB); PG8_STAGE(PG8_SA(0, 1), cA + hstep, voffA);
    if (wr == 1) PG8_BAR;
    PG8_WAIT_V(4); PG8_BAR;
    PG8_STAGE(PG8_SB(1, 0), cB + kstep, voffB); PG8_STAGE(PG8_SA(1, 0), cA + kstep, voffA); PG8_STAGE(PG8_SB(1, 1), cB + hstep + kstep, voffB);
    PG8_WAIT_V(6); PG8_BAR;
    }
    for (;;) {
        const bool has_next = S.next(ui + 1, nxt);
        const char* nA = has_next ? (const char*)g.A + (size_t)nxt.pm * tstep : cA; const char* nB = has_next ? (const char*)g.Bt + (size_t)nxt.pn * tstep : cB;
        for (int t = 0; t < nt; t += 2) {
            const bool last = (t == nt - 2);
            const char* a1 = cA + (size_t)(t + 1) * kstep;
            const char* a2 = last ? nA : cA + (size_t)(t + 2) * kstep; const char* b2 = last ? nB : cB + (size_t)(t + 2) * kstep;
            const char* a3 = a2 + kstep; const char* b3 = b2 + kstep;
            if constexpr (SP2) {
            PG8_LDB(B0, 0, 0); PG8_LDB(B1, 0, 1); PG8_SCHED; PG8_LDA(At, 0, 0); PG8_STAGE(PG8_SA(1, 1), a1 + hstep, voffA);
            PG8_WAIT_V(8); PG8_WAIT_L(0); PG8_BAR; PG8_MMA(0, 0, At, B0); PG8_MMA(0, 1, At, B1); PG8_BAR; PG8_SCHED;
            PG8_LDA(At, 0, 1); PG8_STAGE(PG8_SB(0, 0), b2, voffB); PG8_STAGE(PG8_SB(0, 1), b2 + hstep, voffB); PG8_STAGE(PG8_SA(0, 0), a2, voffA);
            PG8_WAIT_V(8); PG8_WAIT_L(0); PG8_BAR; PG8_MMA(1, 0, At, B0); PG8_MMA(1, 1, At, B1); PG8_BAR; PG8_SCHED;
            PG8_LDB(B0, 1, 0); PG8_LDB(B1, 1, 1); PG8_SCHED; PG8_LDA(At, 1, 0); PG8_STAGE(PG8_SA(0, 1), a2 + hstep, voffA);
            PG8_WAIT_V(8); PG8_WAIT_L(0); PG8_BAR; PG8_MMA(0, 0, At, B0); PG8_MMA(0, 1, At, B1); PG8_BAR; PG8_SCHED;
            PG8_LDA(At, 1, 1); PG8_STAGE(PG8_SB(1, 0), b3, voffB); PG8_STAGE(PG8_SB(1, 1), b3 + hstep, voffB); PG8_STAGE(PG8_SA(1, 0), a3, voffA);
            PG8_WAIT_V(8); PG8_WAIT_L(0); PG8_BAR; PG8_MMA(1, 0, At, B0); PG8_MMA(1, 1, At, B1); PG8_BAR; PG8_SCHED;
            } else {
            PG8_LDB(B0, 0, 0); PG8_SCHED; PG8_LDA(At, 0, 0); PG8_STAGE(PG8_SA(1, 1), a1 + hstep, voffA);
            PG8_WAIT_L(8); PG8_BAR; PG8_WAIT_L(0); PG8_MMA(0, 0, At, B0); PG8_BAR; PG8_SCHED;
            PG8_LDB(B1, 0, 1); PG8_STAGE(PG8_SB(0, 0), b2, voffB);
            PG8_BAR; PG8_WAIT_L(0); PG8_MMA(0, 1, At, B1); PG8_BAR;
            if constexpr (!HALF_M) PG8_LDA(At, 0, 1);
            PG8_STAGE(PG8_SA(0, 0), a2, voffA);
            PG8_BAR; PG8_WAIT_L(0); if constexpr (!HALF_M) PG8_MMA(1, 0, At, B0); PG8_BAR; PG8_SCHED;
            PG8_STAGE(PG8_SB(0, 1), b2 + hstep, voffB);
            PG8_WAIT_V(6); PG8_BAR; if constexpr (!HALF_M) PG8_MMA(1, 1, At, B1); PG8_BAR;
            PG8_LDB(B0, 1, 0); PG8_SCHED; PG8_LDA(At, 1, 0); PG8_STAGE(PG8_SA(0, 1), a2 + hstep, voffA);
            PG8_WAIT_L(8); PG8_BAR; PG8_WAIT_L(0); PG8_MMA(0, 0, At, B0); PG8_BAR; PG8_SCHED;
            PG8_LDB(B1, 1, 1); PG8_STAGE(PG8_SB(1, 0), b3, voffB);
            PG8_BAR; PG8_WAIT_L(0); PG8_MMA(0, 1, At, B1); PG8_BAR;
            if constexpr (!HALF_M) PG8_LDA(At, 1, 1);
            PG8_STAGE(PG8_SA(1, 0), a3, voffA);
            PG8_BAR; PG8_WAIT_L(0); if constexpr (!HALF_M) PG8_MMA(1, 0, At, B0); PG8_BAR; PG8_SCHED;
            PG8_STAGE(PG8_SB(1, 1), b3 + hstep, voffB);
            PG8_WAIT_V(6); PG8_BAR; if constexpr (!HALF_M) PG8_MMA(1, 1, At, B1); PG8_BAR;
            }
        }
        if constexpr (ALIGN_EPI) { if (wr == 0) PG8_BAR; }
        E(acc, cur, wr, wc, fr, fq);
        if (!has_next) break;
#pragma unroll
        for (int a = 0; a < 2; ++a)
#pragma unroll
            for (int b = 0; b < 2; ++b)
#pragma unroll
                for (int m = 0; m < 4; ++m)
#pragma unroll
                    for (int n = 0; n < 2; ++n) acc[a][b][m][n] = (f32x4){0.f, 0.f, 0.f, 0.f};
        cur = nxt; cA = nA; cB = nB; ++ui;
        if constexpr (ALIGN_EPI) { if (wr == 1) PG8_BAR; }
    }
    PG8_WAIT_V(0);
    if constexpr (!ALIGN_EPI) { if (wr == 0) PG8_BAR; }
    PG8_BAR;
#undef PG8_SA
#undef PG8_SB
#undef PG8_STAGE
#undef PG8_LDA
#undef PG8_LDB
#undef PG8_MMA
#undef PG8_WAIT_V
#undef PG8_WAIT_L
#undef PG8_BAR
#undef PG8_SCHED
}
}

struct Ctx {
    const float* xp; const float* xs; const float* stC; const float* stN; const float* stM; const float* ssm; const float* conv; const float* ck; const float* cv;
    float* out; unsigned char* ws;
};
#define XWIN ((bf16_t*)(X.ws + WS_WIN))
#define XWOUT ((bf16_t*)(X.ws + WS_WOUT))
#define XXB ((bf16_t*)(X.ws + WS_XB))
#define XU ((bf16_t*)(X.ws + WS_U))
#define XMIX ((bf16_t*)(X.ws + WS_MIX))
#define XSSQ ((float*)(X.ws + WS_SSQ))
#define XROPE ((float*)(X.ws + WS_ROPE))
#define XMC ((float*)(X.ws + WS_MC))
#define XMN ((float*)(X.ws + WS_MN))
#define XML ((float*)(X.ws + WS_ML))
#define XBL ((float*)(X.ws + WS_BL))
#define XMS ((float*)(X.ws + WS_MS))
#define XSA ((float*)(X.ws + WS_SA))
#define XSH ((float*)(X.ws + WS_SH))
#define XCSB ((bf16_t*)(X.ws + WS_CSB))
#define XNS ((float*)(X.ws + WS_NS))
#define XHSB ((bf16_t*)(X.ws + WS_HSB))
#define XPAR(off) ((const float*)(X.ws + WS_PAR) + (off))
constexpr int P_AIB = 0, P_AFB = 16, P_DTB = 32, P_ALOG = 64, P_BD = 96, P_SINK = 128, P_QNW = 160, P_KNW = 416, P_ANW = 672, P_BNW = 2720, P_CB = 4768, P_CW = 8864, P_END = 25248;
#define IN_XP 0
#define IN_XS 1
#define IN_STC 2
#define IN_STN 3
#define IN_STM 4
#define IN_SSM 5
#define IN_CONV 6
#define IN_CK 7
#define IN_CV 8
#define IN_NORMW 9
#define IN_WIN 10
#define IN_AIB 11
#define IN_AFB 12
#define IN_ANW 13
#define IN_CW 14
#define IN_CB 15
#define IN_DTB 16
#define IN_ALOG 17
#define IN_BD 18
#define IN_BNW 19
#define IN_QNW 20
#define IN_KNW 21
#define IN_SINK 22
#define IN_WOUT 23

__device__ __forceinline__ void transpose_strip(lptr lds, const float* src, int ldn, int nvalid, bf16_t* dst, int ldk, const float* scale, int k0, int n0, int tid) {
    LAS float* T = (LAS float*)lds;
    f32x4 v[8];
#pragma unroll
    for (int i = 0; i < 8; ++i) {
        const int f = tid + i * NT, r = f >> 6, c4 = (f & 63) * 4, n = n0 + c4;
        const f32x4 t = __builtin_nontemporal_load((const f32x4*)(src + (size_t)(k0 + r) * ldn + (n < nvalid ? n : 0)));
        const float m = n < nvalid ? (scale ? scale[k0 + r] : 1.f) : 0.f;
        v[i] = t * m;
    }
#pragma unroll
    for (int i = 0; i < 8; ++i) {
        const int f = tid + i * NT, r = f >> 6, c4 = (f & 63) * 4;
        T[r * 257 + c4 + 0] = v[i][0]; T[r * 257 + c4 + 1] = v[i][1]; T[r * 257 + c4 + 2] = v[i][2]; T[r * 257 + c4 + 3] = v[i][3];
    }
    __syncthreads();
#pragma unroll
    for (int i = 0; i < 4; ++i) {
        const int p = tid + i * NT, n = p >> 3, k8 = (p & 7) * 8; float f[8];
#pragma unroll
        for (int jx = 0; jx < 8; ++jx) f[jx] = T[(k8 + jx) * 257 + n];
        *(u32x4*)(dst + (size_t)(n0 + n) * ldk + k0 + k8) = pack8(f);
    }
    __syncthreads();
}

__device__ __forceinline__ void prologue(lptr lds, const Ctx& X, const Args& args, int G, int bid, int tid) {
    const int lane = tid & 63, wave = tid >> 6;
    constexpr int T0 = 1280, T1 = T0 + 384, T2 = T1 + 2080, T3 = T2 + 1, T4 = T3 + 513;
    for (int task = bid; task < T4; task += G) {
        if (task < T0) {
            const int l = task / 320, r = task % 320, kt = r / 20, ntl = r % 20;
            transpose_strip(lds, args.in[IN_WIN] + (size_t)l * D * DIN, DIN, DIN, XWIN + (size_t)l * NIN * D, D, args.in[IN_NORMW] + l * D, kt * 64, ntl * 256, tid);
        } else if (task < T1) {
            const int t = task - T0, l = t / 96, r = t % 96, kt = r / 4, ntl = r % 4;
            transpose_strip(lds, args.in[IN_WOUT] + (size_t)l * DMIX * D, D, D, XWOUT + (size_t)l * D * DMIX, DMIX, nullptr, kt * 64, ntl * 256, tid);
        } else if (task < T2) {
            const int r = (task - T1) * 8 + wave;
            float ss = 0.f;
            if (r < MTOK) {
                const float* src = r < TP ? X.xp + (size_t)r * D : X.xs + (size_t)(r - TP) * D;
#pragma unroll
                for (int i = 0; i < 4; ++i) {
                    const int c = lane * 4 + i * 256; f32x4 v = __builtin_nontemporal_load((const f32x4*)(src + c));
                    ss += v[0] * v[0] + v[1] * v[1] + v[2] * v[2] + v[3] * v[3];
                    u32x2 w; w[0] = pk2(v[0], v[1]); w[1] = pk2(v[2], v[3]);
                    *(u32x2*)(XXB + (size_t)r * D + c) = w;
                }
            } else {
#pragma unroll
                for (int i = 0; i < 4; ++i) { u32x2 w = {0u, 0u}; *(u32x2*)(XXB + (size_t)r * D + lane * 4 + i * 256) = w; }
            }
            ss = wave_sum(ss);
            if (lane < 16) XSSQ[(size_t)r * 16 + lane] = (lane == 0) ? ss : 0.f;
        } else if (task < T3) {
            for (int i = tid; i < (MPAD - MTOK) * DMIX / 2; i += NT) ((unsigned*)(XMIX + (size_t)MTOK * DMIX))[i] = 0u;
            float* P = (float*)(X.ws + WS_PAR);
            const int po[12] = {P_AIB, P_AFB, P_DTB, P_ALOG, P_BD, P_SINK, P_QNW, P_KNW, P_ANW, P_BNW, P_CB, P_CW};
            const int pn[12] = {16, 16, 32, 32, 32, 32, 256, 256, 2048, 2048, 4096, 16384};
            const int pi[12] = {IN_AIB, IN_AFB, IN_DTB, IN_ALOG, IN_BD, IN_SINK, IN_QNW, IN_KNW, IN_ANW, IN_BNW, IN_CB, IN_CW};
#pragma unroll
            for (int a = 0; a < 12; ++a) { const float* src = args.in[pi[a]]; for (int i = tid; i < pn[a]; i += NT) P[po[a] + i] = src[i]; }
        } else {
            const int e = (task - T3) * 512 + tid;
            if (e < 8193 * 32) {
                const int pos = e >> 5, d = e & 31;
                const float inv = (float)exp2(-(double)d * (13.287712379549449 / 32.0));
                const float angf = (float)pos * inv;
                const double a = (double)angf;
                const double k = rint(a * 0.15915494309189535);
                const float rr = (float)(a - k * 6.283185307179586);
                XROPE[(size_t)e * 2] = cosf(rr); XROPE[(size_t)e * 2 + 1] = sinf(rr);
            }
        }
    }
}

__device__ __forceinline__ void conv8(const bf16_t* u, int seq0, int tt, int ch, const float* cw, const float* cb, float (&o)[8]) {
    float acc[8];
    { f32x4 b0 = *(const f32x4*)(cb + ch), b1 = *(const f32x4*)(cb + ch + 4);
#pragma unroll
      for (int j = 0; j < 4; ++j) { acc[j] = b0[j]; acc[4 + j] = b1[j]; } }
#pragma unroll
    for (int jj = 0; jj < 4; ++jj) {
        const int t2 = tt + jj - 3;
        if (t2 >= 0) {
            float x[8]; unpack8(*(const u32x4*)(u + (size_t)(seq0 + t2) * NIN + C_BX + ch), x);
            f32x4 w0 = *(const f32x4*)(cw + jj * 1024 + ch), w1 = *(const f32x4*)(cw + jj * 1024 + ch + 4);
#pragma unroll
            for (int j = 0; j < 4; ++j) { acc[j] += x[j] * w0[j]; acc[4 + j] += x[4 + j] * w1[j]; }
        }
    }
#pragma unroll
    for (int j = 0; j < 8; ++j) o[j] = siluf_(acc[j]);
}


__device__ __forceinline__ void conv8x8(const bf16_t* u, int seq0, int tt0, int ch, const float* cw, const float* cb, float (&o)[8][8]) {
    float w[4][8];
#pragma unroll
    for (int jj = 0; jj < 4; ++jj) { f32x4 w0 = *(const f32x4*)(cw + jj * 1024 + ch), w1 = *(const f32x4*)(cw + jj * 1024 + ch + 4);
#pragma unroll
        for (int j = 0; j < 4; ++j) { w[jj][j] = w0[j]; w[jj][4 + j] = w1[j]; } }
    { f32x4 b0 = *(const f32x4*)(cb + ch), b1 = *(const f32x4*)(cb + ch + 4);
#pragma unroll
      for (int t = 0; t < 8; ++t)
#pragma unroll
          for (int j = 0; j < 4; ++j) { o[t][j] = b0[j]; o[t][4 + j] = b1[j]; } }
    u32x4 raw[11];
#pragma unroll
    for (int r = 0; r < 11; ++r) {
        const int t2 = tt0 + r - 3;
        const u32x4 v = *(const u32x4*)(u + (unsigned)(seq0 + (t2 >= 0 ? t2 : 0)) * NIN + C_BX + ch);
        const unsigned msk = t2 >= 0 ? 0xffffffffu : 0u;
        raw[r] = (u32x4){v[0] & msk, v[1] & msk, v[2] & msk, v[3] & msk};
    }
#pragma unroll
    for (int r = 0; r < 11; ++r) {
        float x[8]; unpack8(raw[r], x);
#pragma unroll
        for (int jj = 0; jj < 4; ++jj) {
            const int t = r - jj;
            if (t >= 0 && t < 8) {
#pragma unroll
                for (int j = 0; j < 8; ++j) o[t][j] += x[j] * w[jj][j];
            }
        }
    }
#pragma unroll
    for (int t = 0; t < 8; ++t)
#pragma unroll
        for (int j = 0; j < 8; ++j) o[t][j] = siluf_(o[t][j]);
}

__device__ __forceinline__ void mlstm_local(lptr lds, const Ctx& X, int l, int task, int tid) {
    const int h = task & 3, c = (task >> 2) & 127, n = task >> 9;
    const int lane = tid & 63, wave = tid >> 6, fr = lane & 15, fq = lane >> 4;
    const int row0 = n * SEQ + c * 64, nh = n * 4 + h;
    lptr VwT = lds;
    lptr KT = lds + 18432;
    LAS float* wv = (LAS float*)(lds + 27648);
    const int tg = lane & 7, cgq = lane >> 3;
    u32x4 blk[8];
    if (wave >= 1 && wave <= 3) {
        const int col = wave < 3 ? C_AV + h * 128 + ((wave - 1) * 8 + cgq) * 8 : C_AK + h * 64 + cgq * 8;
#pragma unroll
        for (int t = 0; t < 8; ++t) blk[t] = *(const u32x4*)(XU + (unsigned)(row0 + 8 * tg + t) * NIN + col);
    }
    if (wave == 0) {
        const bf16_t* ur = XU + (unsigned)(row0 + lane) * NIN;
        const float fg = bf2f(ur[C_AF + h]) + XPAR(P_AFB)[l * 4 + h], ig = bf2f(ur[C_AI + h]) + XPAR(P_AIB)[l * 4 + h];
        const float b = wave_scan_sum(logsigf_(fg), lane);
        const float bl = lane63(b);
        const float g = bl - b + ig;
        const float ml = wave_max(g);
        wv[lane] = __expf(g - ml);
        if (lane == 0) { XML[nh * 128 + c] = ml; XBL[nh * 128 + c] = bl; }
    }
    __syncthreads();
    if (wave >= 1 && wave <= 3) {
        float xs[8][8];
#pragma unroll
        for (int t = 0; t < 8; ++t) { unpack8(blk[t], xs[t]); const float w = wave < 3 ? wv[8 * tg + t] : 0.125f;
#pragma unroll
            for (int j = 0; j < 8; ++j) xs[t][j] *= w; }
        lptr dstT = wave < 3 ? VwT + ((((wave - 1) * 8 + cgq) * 8 * 72) << 1) : KT + ((cgq * 8 * 72) << 1);
#pragma unroll
        for (int j = 0; j < 8; ++j) {
            float v[8];
#pragma unroll
            for (int t = 0; t < 8; ++t) v[t] = xs[t][j];
            *(LAS u32x4*)(dstT + ((j * 72 + 8 * tg) << 1)) = pack8(v);
        }
    }
    __syncthreads();
    {
        bf16_t* dst = (bf16_t*)XMC + ((size_t)nh * 128 + c) * 8192;
        bf16x8 b0 = lds_frag(VwT, 16 * wave + fr, fq * 8, 72), b1 = lds_frag(VwT, 16 * wave + fr, 32 + fq * 8, 72);
#pragma unroll
        for (int mt = 0; mt < 4; ++mt) {
            f32x4 acc = {0.f, 0.f, 0.f, 0.f};
            acc = mfma16(lds_frag(KT, 16 * mt + fr, fq * 8, 72), b0, acc);
            acc = mfma16(lds_frag(KT, 16 * mt + fr, 32 + fq * 8, 72), b1, acc);
            { u32x2 w; w[0] = pk2(acc[0], acc[1]); w[1] = pk2(acc[2], acc[3]); *(u32x2*)(dst + (16 * wave + fr) * 64 + 16 * mt + 4 * fq) = w; }
        }
    }
    if (tid < 64) {
        float s = 0.f;
#pragma unroll
        for (int t8 = 0; t8 < 8; ++t8) {
            float kf[8]; unpack8(*(const LAS u32x4*)(KT + ((tid * 72 + t8 * 8) << 1)), kf);
#pragma unroll
            for (int jx = 0; jx < 8; ++jx) s += kf[jx] * wv[t8 * 8 + jx];
        }
        XMN[((size_t)nh * 128 + c) * 64 + tid] = s;
    }
    __syncthreads();
}

__device__ __forceinline__ void ssd_local(lptr lds, const Ctx& X, int l, int task, int tid) {
    const int g = task & 1, c = (task >> 1) & 127, n = task >> 8;
    const int lane = tid & 63, wave = tid >> 6, fr = lane & 15, fq = lane >> 4;
    const int seq0 = n * SEQ, row0 = seq0 + c * 64;
    lptr XwT = lds;
    lptr BT = lds + 36864;
    LAS float* wl = (LAS float*)(lds + 55296);
    {
        const float* cw = XPAR(P_CW) + l * 4096; const float* cb = XPAR(P_CB) + l * 1024;
        const int tg = lane & 7, cg = wave * 8 + (lane >> 3);
        float o[8][8];
        if (wave < 6) {
            const int ch = cg < 32 ? g * 256 + cg * 8 : 512 + g * 128 + (cg - 32) * 8;
            conv8x8(XU, seq0, c * 64 + 8 * tg, ch, cw, cb, o);
        }
        if (wave < 4) {
            const int hh = 4 * g + wave;
            const float dt = softplusf_(bf2f(XU[(unsigned)(row0 + lane) * NIN + C_BDT + hh]) + XPAR(P_DTB)[l * 8 + hh]);
            const float A = -__expf(XPAR(P_ALOG)[l * 8 + hh]);
            const float a = wave_scan_sum(dt * A, lane);
            const float aL = lane63(a);
            wl[wave * 64 + lane] = __expf(aL - a) * dt;
            if (lane == 0) XSA[(n * 8 + hh) * 128 + c] = aL;
        }
        __syncthreads();
        if (wave < 4) {
            float wt[8];
#pragma unroll
            for (int t = 0; t < 8; ++t) wt[t] = wl[wave * 64 + 8 * tg + t];
#pragma unroll
            for (int jx = 0; jx < 8; ++jx) {
                float v[8];
#pragma unroll
                for (int t = 0; t < 8; ++t) v[t] = o[t][jx] * wt[t];
                *(LAS u32x4*)(XwT + (((cg * 8 + jx) * 72 + 8 * tg) << 1)) = pack8(v);
            }
        } else if (wave < 6) {
#pragma unroll
            for (int jx = 0; jx < 8; ++jx) {
                float v[8];
#pragma unroll
                for (int t = 0; t < 8; ++t) v[t] = o[t][jx];
                *(LAS u32x4*)(BT + ((((cg - 32) * 8 + jx) * 72 + 8 * tg) << 1)) = pack8(v);
            }
        }
    }
    __syncthreads();
    {
        const int hl = wave >> 1, ph = wave & 1, hh = 4 * g + hl;
        bf16_t* dst = (bf16_t*)XSH + ((size_t)(n * 8 + hh) * 128 + c) * 8192;
        bf16x8 bx[2][2];
#pragma unroll
        for (int ntl = 0; ntl < 2; ++ntl)
#pragma unroll
            for (int kk = 0; kk < 2; ++kk) bx[ntl][kk] = lds_frag(XwT, hl * 64 + ph * 32 + ntl * 16 + fr, kk * 32 + fq * 8, 72);
#pragma unroll
        for (int mt = 0; mt < 8; ++mt) {
            bf16x8 a0 = lds_frag(BT, 16 * mt + fr, fq * 8, 72), a1 = lds_frag(BT, 16 * mt + fr, 32 + fq * 8, 72);
#pragma unroll
            for (int ntl = 0; ntl < 2; ++ntl) {
                f32x4 acc = {0.f, 0.f, 0.f, 0.f};
                acc = mfma16(a0, bx[ntl][0], acc); acc = mfma16(a1, bx[ntl][1], acc);
                { u32x2 w; w[0] = pk2(acc[0], acc[1]); w[1] = pk2(acc[2], acc[3]); *(u32x2*)(dst + (ph * 32 + ntl * 16 + fr) * 128 + 16 * mt + 4 * fq) = w; }
            }
        }
    }
    __syncthreads();
}

__device__ __forceinline__ void swa_prompt(lptr lds, const Ctx& X, int l, int task, int tid) {
    const int kvh = task & 1, qb = (task >> 1) & 63, n = task >> 7;
    const int lane = tid & 63, wave = tid >> 6, fr = lane & 15, fq = lane >> 4;
    const int seq0 = n * SEQ;
    lptr Kn = lds;
    lptr Vt = lds + 36864;
    lptr Pw = lds + 70656 + wave * 8448;
    const float* knw = XPAR(P_KNW) + l * 64; const float* qnw = XPAR(P_QNW) + l * 64;
#pragma unroll
    for (int it = 0; it < 2; ++it) {
        const int item = tid + it * NT, j = item >> 2, qd = item & 3, t = qb * 128 - 128 + j;
        float o1[8], o2[8];
        {
            const int tc = t >= 0 ? t : 0;
            const bf16_t* kr = XU + (unsigned)(seq0 + tc) * NIN + C_CK + kvh * 64;
            float x1[8], x2[8]; unpack8(*(const u32x4*)(kr + qd * 8), x1); unpack8(*(const u32x4*)(kr + 32 + qd * 8), x2);
            float ss = 0.f;
#pragma unroll
            for (int jj = 0; jj < 8; ++jj) ss += x1[jj] * x1[jj] + x2[jj] * x2[jj];
            ss += __shfl_xor(ss, 1); ss += __shfl_xor(ss, 2);
            const float rs = rsqrtf(ss * (1.f / 64.f) + EPS);
            const f32x4* cs = (const f32x4*)(XROPE + ((size_t)tc * 32 + qd * 8) * 2);
            f32x4 csv[4];
#pragma unroll
            for (int q4 = 0; q4 < 4; ++q4) csv[q4] = cs[q4];
            const float zm = t >= 0 ? 1.f : 0.f;
#pragma unroll
            for (int jj = 0; jj < 8; ++jj) {
                const float a = x1[jj] * rs * knw[qd * 8 + jj], b = x2[jj] * rs * knw[32 + qd * 8 + jj], co = csv[jj >> 1][(jj & 1) * 2], si = csv[jj >> 1][(jj & 1) * 2 + 1];
                o1[jj] = (a * co - b * si) * zm; o2[jj] = (b * co + a * si) * zm;
            }
        }
        *(LAS u32x4*)(Kn + ((j * 72 + qd * 8) << 1)) = pack8(o1);
        *(LAS u32x4*)(Kn + ((j * 72 + 32 + qd * 8) << 1)) = pack8(o2);
        if (qb == 63 && j >= 128) {
            float* ko = X.out + O_PK + ((((size_t)l * 2 + n) * 128 + (j - 128)) * 2 + kvh) * 64;
            *(f32x4*)(ko + qd * 8) = (f32x4){o1[0], o1[1], o1[2], o1[3]}; *(f32x4*)(ko + qd * 8 + 4) = (f32x4){o1[4], o1[5], o1[6], o1[7]};
            *(f32x4*)(ko + 32 + qd * 8) = (f32x4){o2[0], o2[1], o2[2], o2[3]}; *(f32x4*)(ko + 32 + qd * 8 + 4) = (f32x4){o2[4], o2[5], o2[6], o2[7]};
        }
    }
    if (wave < 4) {
        const int tg = tid & 31, cg = tid >> 5;
        u32x4 vb[8];
#pragma unroll
        for (int t8 = 0; t8 < 8; ++t8) {
            const int jk = 8 * tg + t8, t = qb * 128 - 128 + jk;
            u32x4 w = *(const u32x4*)(XU + (unsigned)(seq0 + (t >= 0 ? t : 0)) * NIN + C_CV + kvh * 64 + cg * 8);
            const unsigned msk = t >= 0 ? 0xffffffffu : 0u;
            vb[t8] = (u32x4){w[0] & msk, w[1] & msk, w[2] & msk, w[3] & msk};
        }
#pragma unroll
        for (int jj = 0; jj < 8; ++jj) {
            u32x4 w;
#pragma unroll
            for (int tp = 0; tp < 4; ++tp) {
                const unsigned lo = (vb[2 * tp][jj >> 1] >> ((jj & 1) * 16)) & 0xffffu, hi = (vb[2 * tp + 1][jj >> 1] >> ((jj & 1) * 16)) & 0xffffu;
                w[tp] = lo | (hi << 16);
            }
            *(LAS u32x4*)(Vt + (((cg * 8 + jj) * 264 + 8 * tg) << 1)) = w;
        }
        if (qb == 63 && tg >= 16) {
#pragma unroll
            for (int t8 = 0; t8 < 8; ++t8) {
                float x[8]; unpack8(vb[t8], x);
                float* vo = X.out + O_PV + ((((size_t)l * 2 + n) * 128 + (8 * tg + t8 - 128)) * 2 + kvh) * 64 + cg * 8;
                *(f32x4*)(vo) = (f32x4){x[0], x[1], x[2], x[3]}; *(f32x4*)(vo + 4) = (f32x4){x[4], x[5], x[6], x[7]};
            }
        }
    }
    __syncthreads();
    const int hq = kvh * 4 + (wave >> 1), i0 = (wave & 1) * 64;
    const float sink = XPAR(P_SINK)[l * 8 + hq];
    float qw1[8], qw2[8];
#pragma unroll
    for (int jj = 0; jj < 8; ++jj) { qw1[jj] = qnw[fq * 8 + jj]; qw2[jj] = qnw[32 + fq * 8 + jj]; }
    u32x4 qn0, qn1; f32x4 csn[4];
    {
        const int t = qb * 128 + i0 + fr;
        const bf16_t* qr = XU + (unsigned)(seq0 + t) * NIN + C_CQ + hq * 64;
        qn0 = *(const u32x4*)(qr + fq * 8); qn1 = *(const u32x4*)(qr + 32 + fq * 8);
        const f32x4* cs = (const f32x4*)(XROPE + ((size_t)t * 32 + fq * 8) * 2);
#pragma unroll
        for (int q4 = 0; q4 < 4; ++q4) csn[q4] = cs[q4];
    }
#pragma unroll 1
    for (int mt = 0; mt < 4; ++mt) {
        const int q0 = i0 + mt * 16;
        const u32x4 q0r = qn0, q1r = qn1; f32x4 csc[4];
#pragma unroll
        for (int q4 = 0; q4 < 4; ++q4) csc[q4] = csn[q4];
        unsigned short czv[4][4];
#pragma unroll
        for (int ii = 0; ii < 4; ++ii)
#pragma unroll
            for (int ntl = 0; ntl < 4; ++ntl) czv[ntl][ii] = XU[((unsigned)seq0 + qb * 128 + q0 + fq * 4 + ii) * NIN + C_CZ + hq * 64 + 16 * ntl + fr];
        {
            const int mn = mt < 3 ? mt + 1 : 3;
            const int t = qb * 128 + i0 + mn * 16 + fr;
            const bf16_t* qr = XU + (unsigned)(seq0 + t) * NIN + C_CQ + hq * 64;
            qn0 = *(const u32x4*)(qr + fq * 8); qn1 = *(const u32x4*)(qr + 32 + fq * 8);
            const f32x4* cs = (const f32x4*)(XROPE + ((size_t)t * 32 + fq * 8) * 2);
#pragma unroll
            for (int q4 = 0; q4 < 4; ++q4) csn[q4] = cs[q4];
        }
        bf16x8 a0, a1;
        {
            float x1[8], x2[8]; unpack8(q0r, x1); unpack8(q1r, x2);
            float ss = 0.f;
#pragma unroll
            for (int jj = 0; jj < 8; ++jj) ss += x1[jj] * x1[jj] + x2[jj] * x2[jj];
            ss += __shfl_xor(ss, 16); ss += __shfl_xor(ss, 32);
            const float rs = rsqrtf(ss * (1.f / 64.f) + EPS) * 0.125f;
            float o1[8], o2[8];
#pragma unroll
            for (int jj = 0; jj < 8; ++jj) {
                const float a = x1[jj] * rs * qw1[jj], b = x2[jj] * rs * qw2[jj], co = csc[jj >> 1][(jj & 1) * 2], si = csc[jj >> 1][(jj & 1) * 2 + 1];
                o1[jj] = a * co - b * si; o2[jj] = b * co + a * si;
            }
            a0 = as_frag(pack8(o1)); a1 = as_frag(pack8(o2));
        }
        const int tlo = q0 >> 4;
        const int qi = q0 + fr;
        const int dlo = qb > 0 ? 1 : (128 - qi > 1 ? 128 - qi : 1);
        f32x4 s[16];
        float mx = -3.0e38f;
#pragma unroll
        for (int ntl = 0; ntl < 16; ++ntl) {
            if (ntl >= tlo && ntl <= tlo + 8) {
                f32x4 acc = {0.f, 0.f, 0.f, 0.f};
                acc = mfma16(lds_frag(Kn, 16 * ntl + fr, fq * 8, 72), a0, acc);
                acc = mfma16(lds_frag(Kn, 16 * ntl + fr, 32 + fq * 8, 72), a1, acc);
                if (ntl == tlo || ntl == tlo + 8 || qb == 0) {
#pragma unroll
                    for (int ii = 0; ii < 4; ++ii) {
                        const int dk = 16 * ntl + 4 * fq + ii - qi;
                        acc[ii] = ((unsigned)(dk - dlo) <= (unsigned)(128 - dlo)) ? acc[ii] : -3.0e38f;
                    }
                }
                mx = fmaxf(mx, fmaxf(fmaxf(acc[0], acc[1]), fmaxf(acc[2], acc[3])));
                s[ntl] = acc;
            }
        }
        mx = fmaxf(mx, __shfl_xor(mx, 16)); mx = fmaxf(mx, __shfl_xor(mx, 32));
        mx = fmaxf(mx, sink);
        float sum = 0.f;
#pragma unroll
        for (int ntl = 0; ntl < 16; ++ntl) {
            if (ntl >= tlo && ntl <= tlo + 8) {
#pragma unroll
                for (int ii = 0; ii < 4; ++ii) { const float e = __expf(s[ntl][ii] - mx); s[ntl][ii] = e; sum += e; }
            }
        }
        sum += __shfl_xor(sum, 16); sum += __shfl_xor(sum, 32);
        const float inv = rcpf_(sum + __expf(sink - mx));
        const int klo = q0 >> 5, khi = (q0 + 143) >> 5;
#pragma unroll
        for (int ntl = 0; ntl < 16; ++ntl) {
            if (ntl >= tlo && ntl <= tlo + 8) {
                u32x2 w; w[0] = pk2(s[ntl][0] * inv, s[ntl][1] * inv); w[1] = pk2(s[ntl][2] * inv, s[ntl][3] * inv);
                *(LAS u32x2*)(Pw + ((fr * 264 + 16 * ntl + 4 * fq) << 1)) = w;
            } else if ((ntl >> 1) >= klo && (ntl >> 1) <= khi) {
                u32x2 w = {0u, 0u};
                *(LAS u32x2*)(Pw + ((fr * 264 + 16 * ntl + 4 * fq) << 1)) = w;
            }
        }
        LDS_FENCE();
        f32x4 o[4];
#pragma unroll
        for (int ntl = 0; ntl < 4; ++ntl) o[ntl] = (f32x4){0.f, 0.f, 0.f, 0.f};
#pragma unroll
        for (int kk = 0; kk < 8; ++kk) {
            if (kk >= klo && kk <= khi) {
                const bf16x8 a = lds_frag(Pw, fr, kk * 32 + fq * 8, 264);
#pragma unroll
                for (int ntl = 0; ntl < 4; ++ntl) o[ntl] = mfma16(a, lds_frag(Vt, 16 * ntl + fr, kk * 32 + fq * 8, 264), o[ntl]);
            }
        }
        LDS_FENCE();
#pragma unroll
        for (int ii = 0; ii < 4; ++ii) {
            const unsigned row = (unsigned)seq0 + qb * 128 + q0 + fq * 4 + ii;
#pragma unroll
            for (int ntl = 0; ntl < 4; ++ntl) {
                const int d = 16 * ntl + fr;
                XMIX[row * DMIX + 1024 + hq * 64 + d] = (bf16_t)f2bf(o[ntl][ii] * siluf_(bf2f(czv[ntl][ii])));
            }
        }
    }
    __syncthreads();
}

__device__ __forceinline__ void sample_task(lptr lds, const Ctx& X, int l, int b, int part, int tid) {
    LAS float* uf = (LAS float*)lds;
    LAS float* xbc = (LAS float*)(lds + 19968);
    LAS float* numv = (LAS float*)(lds + 24064);
    LAS float* yv = (LAS float*)(lds + 26112);
    LAS float* red = (LAS float*)(lds + 28160);
    LAS float* qs = (LAS float*)(lds + 28416);
    LAS float* kn = (LAS float*)(lds + 30464);
    LAS float* sc = (LAS float*)(lds + 30976);
    const int lane = tid & 63, wave = tid >> 6;
    const size_t row = (size_t)TP + b;
    const bf16_t* ur = XU + row * NIN;
    const size_t lb = (size_t)l * 128 + b;
    f32x4 kpre[8], vpre[8];
    if (part == 2) {
        const float* kc = X.ck + lb * 16384; const float* vc = X.cv + lb * 16384;
#pragma unroll
        for (int it = 0; it < 8; ++it) {
            const int e = (tid + it * NT) * 4, e2 = e < 127 * 128 ? e + 128 : e;
            kpre[it] = __builtin_nontemporal_load((const f32x4*)(kc + e2)); vpre[it] = __builtin_nontemporal_load((const f32x4*)(vc + e2));
        }
    }
    {
        const int c_lo = part == 0 ? 0 : (part == 1 ? C_BZ : C_CQ), c_hi = part == 0 ? C_BZ : (part == 1 ? C_CQ : DIN);
#pragma unroll 2
        for (int i = c_lo + tid; i < c_hi; i += NT) uf[i] = bf2f(ur[i]);
    }
    __syncthreads();
    if (part == 0) {
#pragma unroll
    for (int h = 0; h < 4; ++h) {
        const float ig = uf[C_AI + h] + XPAR(P_AIB)[l * 4 + h], fg = uf[C_AF + h] + XPAR(P_AFB)[l * 4 + h];
        const float ls = logsigf_(fg), m0 = X.stM[lb * 4 + h];
        const float mn = fmaxf(ls + m0, ig), sp = __expf(ls + m0 - mn), sl = __expf(ig - mn);
        const float* C0 = X.stC + (lb * 4 + h) * 8192; float* C1 = X.out + O_SC + (lb * 4 + h) * 8192;
#pragma unroll
        for (int it = 0; it < 4; ++it) {
            const int e = (tid + it * NT) * 4, v = e >> 6, k = e & 63;
            const f32x4 c0 = __builtin_nontemporal_load((const f32x4*)(C0 + e));
            const float vv = uf[C_AV + h * 128 + v] * sl;
            f32x4 c1; float part = 0.f;
#pragma unroll
            for (int j = 0; j < 4; ++j) { c1[j] = sp * c0[j] + vv * (uf[C_AK + h * 64 + k + j] * 0.125f); part += c1[j] * uf[C_AQ + h * 64 + k + j]; }
            __builtin_nontemporal_store(c1, (f32x4*)(C1 + e));
            part = red16(part);
            if ((lane & 15) == 0) numv[h * 128 + v] = part;
        }
        if (wave == 0) {
            const float n1 = sp * X.stN[(lb * 4 + h) * 64 + lane] + sl * uf[C_AK + h * 64 + lane] * 0.125f;
            X.out[O_SN + (lb * 4 + h) * 64 + lane] = n1;
            const float dd = wave_sum(n1 * uf[C_AQ + h * 64 + lane]);
            if (lane == 0) { red[h] = dd; red[4 + h] = mn; X.out[O_SM + lb * 4 + h] = mn; }
        }
    }
    __syncthreads();
    float hv;
    { const int h = tid >> 7; hv = numv[tid] * rcpf_(fmaxf(fabsf(red[h]), __expf(-red[4 + h]))); const float ss = wave_sum(hv * hv); if (lane == 0) red[8 + wave] = ss; }
    __syncthreads();
    { const int h = tid >> 7; const float rs = rsqrtf((red[8 + 2 * h] + red[9 + 2 * h]) * (1.f / 128.f) + EPS);
      XMIX[row * DMIX + tid] = (bf16_t)f2bf(hv * rs * XPAR(P_ANW)[l * 512 + tid] * sigmoidf_(uf[C_AO + tid]) * siluf_(uf[C_AZ + tid])); }
    }
    if (part == 1) {
    {
        const float* buf = X.conv + lb * 3 * 1024; float* oc = X.out + O_SCONV + lb * 3 * 1024;
        const float* cw = XPAR(P_CW) + l * 4096;
#pragma unroll
        for (int it = 0; it < 2; ++it) {
            const int ch = tid + it * NT;
            const float f0 = buf[ch], f1 = buf[1024 + ch], f2 = buf[2048 + ch], f3 = uf[C_BX + ch];
            const float acc = XPAR(P_CB)[l * 1024 + ch] + f0 * cw[ch] + f1 * cw[1024 + ch] + f2 * cw[2048 + ch] + f3 * cw[3072 + ch];
            xbc[ch] = siluf_(acc);
            oc[ch] = f1; oc[1024 + ch] = f2; oc[2048 + ch] = f3;
        }
    }
    __syncthreads();
#pragma unroll 4
    for (int hh = 0; hh < 8; ++hh) {
        const float dt = softplusf_(uf[C_BDT + hh] + XPAR(P_DTB)[l * 8 + hh]);
        const float dA = __expf(-dt * __expf(XPAR(P_ALOG)[l * 8 + hh]));
        const int g = hh >> 2;
        const float* h0p = X.ssm + (lb * 8 + hh) * 8192; float* h1p = X.out + O_SH + (lb * 8 + hh) * 8192;
#pragma unroll
        for (int it = 0; it < 4; ++it) {
            const int e = (tid + it * NT) * 4, p = e >> 7, s = e & 127;
            const f32x4 h0 = __builtin_nontemporal_load((const f32x4*)(h0p + e));
            const float xv = xbc[hh * 64 + p] * dt;
            f32x4 h1; float part = 0.f;
#pragma unroll
            for (int j = 0; j < 4; ++j) { h1[j] = dA * h0[j] + xv * xbc[512 + g * 128 + s + j]; part += h1[j] * xbc[768 + g * 128 + s + j]; }
            __builtin_nontemporal_store(h1, (f32x4*)(h1p + e));
            part = red16(part); part += __shfl_xor(part, 16);
            if ((lane & 31) == 0) yv[hh * 64 + p] = part;
        }
    }
    __syncthreads();
    float gb;
    { const int hh = tid >> 6; const float y = yv[tid] + XPAR(P_BD)[l * 8 + hh] * xbc[tid]; gb = y * siluf_(uf[C_BZ + tid]); const float ss = wave_sum(gb * gb); if (lane == 0) red[16 + wave] = ss; }
    __syncthreads();
    { const int g = tid >> 8; const float rs = rsqrtf((red[16 + 4 * g] + red[17 + 4 * g] + red[18 + 4 * g] + red[19 + 4 * g]) * (1.f / 256.f) + EPS);
      XMIX[row * DMIX + 512 + tid] = (bf16_t)f2bf(gb * rs * XPAR(P_BNW)[l * 512 + tid]); }
    }
    if (part == 2) {
    lptr Kl = lds + 36864;
    lptr Vl = lds + 36864 + 34816;
    if (tid < 320) {
        const int vec = tid >> 5, d = tid & 31, base = vec < 8 ? C_CQ + vec * 64 : C_CK + (vec - 8) * 64;
        const float x1 = uf[base + d], x2 = uf[base + 32 + d];
        float ss = x1 * x1 + x2 * x2; ss = red16(ss); ss += __shfl_xor(ss, 16);
        const float rs = rsqrtf(ss * (1.f / 64.f) + EPS);
        const float* w = vec < 8 ? XPAR(P_QNW) + l * 64 : XPAR(P_KNW) + l * 64;
        const float a = x1 * rs * w[d], bb = x2 * rs * w[d + 32];
        const float co = XROPE[((size_t)8192 * 32 + d) * 2], si = XROPE[((size_t)8192 * 32 + d) * 2 + 1];
        const float o1 = a * co - bb * si, o2 = bb * co + a * si;
        if (vec < 8) { qs[vec * 64 + d] = o1 * 0.125f; qs[vec * 64 + 32 + d] = o2 * 0.125f; } else { kn[(vec - 8) * 64 + d] = o1; kn[(vec - 8) * 64 + 32 + d] = o2; }
    }
    __syncthreads();
    {
        float* ko = X.out + O_SK + lb * 16384; float* vo = X.out + O_SV + lb * 16384;
#pragma unroll
        for (int it = 0; it < 8; ++it) {
            const int e = (tid + it * NT) * 4, j = e >> 7, r = e & 127;
            f32x4 kv = kpre[it], vv = vpre[it];
            if (j == 127) { kv = (f32x4){kn[r], kn[r + 1], kn[r + 2], kn[r + 3]}; vv = (f32x4){uf[C_CV + r], uf[C_CV + r + 1], uf[C_CV + r + 2], uf[C_CV + r + 3]}; }
            __builtin_nontemporal_store(kv, (f32x4*)(ko + e)); __builtin_nontemporal_store(vv, (f32x4*)(vo + e));
            u32x2 wk, wv2; wk[0] = pk2(kv[0], kv[1]); wk[1] = pk2(kv[2], kv[3]); wv2[0] = pk2(vv[0], vv[1]); wv2[1] = pk2(vv[2], vv[3]);
            *(LAS u32x2*)(Kl + ((j * 136 + r) << 1)) = wk; *(LAS u32x2*)(Vl + ((j * 136 + r) << 1)) = wv2;
        }
    }
    __syncthreads();
    if (tid < 256) {
        const int kvh = tid >> 7, jj = tid & 127;
        float s0 = 0.f, s1 = 0.f, s2 = 0.f, s3 = 0.f;
#pragma unroll 2
        for (int d8 = 0; d8 < 8; ++d8) {
            float kf[8]; unpack8(*(const LAS u32x4*)(Kl + ((jj * 136 + kvh * 64 + d8 * 8) << 1)), kf);
#pragma unroll
            for (int j = 0; j < 8; ++j) {
                s0 += kf[j] * qs[(kvh * 4 + 0) * 64 + d8 * 8 + j]; s1 += kf[j] * qs[(kvh * 4 + 1) * 64 + d8 * 8 + j];
                s2 += kf[j] * qs[(kvh * 4 + 2) * 64 + d8 * 8 + j]; s3 += kf[j] * qs[(kvh * 4 + 3) * 64 + d8 * 8 + j];
            }
        }
        sc[(kvh * 4 + 0) * 128 + jj] = s0; sc[(kvh * 4 + 1) * 128 + jj] = s1; sc[(kvh * 4 + 2) * 128 + jj] = s2; sc[(kvh * 4 + 3) * 128 + jj] = s3;
    }
    __syncthreads();
    {
        const int hq = wave; const float s0 = sc[hq * 128 + lane], s1 = sc[hq * 128 + 64 + lane], sink = XPAR(P_SINK)[l * 8 + hq];
        const float m = fmaxf(wave_max(fmaxf(s0, s1)), sink);
        const float e0 = __expf(s0 - m), e1 = __expf(s1 - m);
        const float inv = rcpf_(wave_sum(e0 + e1) + __expf(sink - m));
        sc[hq * 128 + lane] = e0 * inv; sc[hq * 128 + 64 + lane] = e1 * inv;
    }
    __syncthreads();
    {
        const int hq = tid >> 6, d = tid & 63, kvh = hq >> 2;
        float o = 0.f;
#pragma unroll 16
        for (int jj = 0; jj < 128; ++jj) o += sc[hq * 128 + jj] * bf2f(*(const LAS bf16_t*)(Vl + ((jj * 136 + kvh * 64 + d) << 1)));
        XMIX[row * DMIX + 1024 + tid] = (bf16_t)f2bf(o * siluf_(uf[C_CZ + tid]));
    }
    }
    __syncthreads();
}

__device__ __forceinline__ void scans(const Ctx& X, int l, int gt, int nthreads) {
    for (int item = gt; item < 98816; item += nthreads) {
        if (item < 32768) {
            const int nh = item >> 12, e = (item & 4095) * 2;
            const bf16_t* base = (const bf16_t*)XMC + (size_t)nh * 128 * 8192 + e;
            const float* ml = XML + nh * 128; const float* bl = XBL + nh * 128;
            float m = 0.f; f32x2 st = {0.f, 0.f};
            for (int c0 = 0; c0 < 128; c0 += 16) {
                f32x2 cl[16];
#pragma unroll
                for (int j = 0; j < 16; ++j) { const unsigned w = *(const unsigned*)(base + (size_t)(c0 + j) * 8192); cl[j] = (f32x2){__uint_as_float(w << 16), __uint_as_float(w & 0xffff0000u)}; }
#pragma unroll
                for (int j = 0; j < 16; ++j) {
                    const float mlj = ml[c0 + j], blj = bl[c0 + j], mn = fmaxf(blj + m, mlj), sp = __expf(blj + m - mn), sl = __expf(mlj - mn);
                    *(unsigned*)(XCSB + ((size_t)nh * 128 + c0 + j) * 8192 + e) = pk2(st[0], st[1]);
                    if (e == 0) XMS[nh * 128 + c0 + j] = m;
                    st = st * sp + cl[j] * sl; m = mn;
                }
            }
            *(f32x2*)(X.out + O_PC + ((size_t)l * 8 + nh) * 8192 + e) = st;
            if (e == 0) X.out[O_PM + l * 8 + nh] = m;
        } else if (item < 98304) {
            const int i1 = item - 32768, nhh = i1 >> 12, e = (i1 & 4095) * 2;
            const bf16_t* base = (const bf16_t*)XSH + (size_t)nhh * 128 * 8192 + e;
            const float* al = XSA + nhh * 128;
            f32x2 st = {0.f, 0.f};
            for (int c0 = 0; c0 < 128; c0 += 16) {
                f32x2 cl[16];
#pragma unroll
                for (int j = 0; j < 16; ++j) { const unsigned w = *(const unsigned*)(base + (size_t)(c0 + j) * 8192); cl[j] = (f32x2){__uint_as_float(w << 16), __uint_as_float(w & 0xffff0000u)}; }
#pragma unroll
                for (int j = 0; j < 16; ++j) {
                    const float dec = __expf(al[c0 + j]);
                    *(unsigned*)(XHSB + ((size_t)nhh * 128 + c0 + j) * 8192 + e) = pk2(st[0], st[1]);
                    st = st * dec + cl[j];
                }
            }
            *(f32x2*)(X.out + O_PH + ((size_t)l * 16 + nhh) * 8192 + e) = st;
        } else {
            const int i2 = item - 98304, nh = i2 >> 6, k = i2 & 63;
            float* base = XMN + (size_t)nh * 128 * 64 + k;
            const float* ml = XML + nh * 128; const float* bl = XBL + nh * 128;
            float m = 0.f, st = 0.f;
            for (int c = 0; c < 128; ++c) {
                const float mlj = ml[c], blj = bl[c], mn = fmaxf(blj + m, mlj), sp = __expf(blj + m - mn), sl = __expf(mlj - mn);
                const float cl = base[c * 64];
                XNS[(size_t)nh * 128 * 64 + c * 64 + k] = st;
                st = st * sp + cl * sl; m = mn;
            }
            X.out[O_PN + ((size_t)l * 8 + nh) * 64 + k] = st;
        }
    }
}

__device__ __forceinline__ void mlstm_out(lptr lds, const Ctx& X, int l, int task, int tid) {
    const int h = task & 3, c = (task >> 2) & 127, n = task >> 9;
    const int lane = tid & 63, wave = tid >> 6, fr = lane & 15, fq = lane >> 4;
    const int row0 = n * SEQ + c * 64, nh = n * 4 + h;
    lptr Qs = lds;
    lptr Ks = lds + 9216;
    lptr Vt = lds + 18432;
    lptr Sb = lds + 36864 + wave * 2304;
    LAS float* bv = (LAS float*)(lds + 55296);
    LAS float* dv = bv + 64;
    LAS float* mtv = bv + 128;
    LAS float* siv = bv + 192;
    LAS float* qnv = bv + 256;
    LAS float* ssqp = bv + 384;
    LAS float* nsv = bv + 512;
    const int mti = wave >> 1, half = wave & 1;
    u32x4 csf[2][4];
    {
        const bf16_t* Cs = XCSB + ((size_t)nh * 128 + c) * 8192;
#pragma unroll
        for (int kk = 0; kk < 2; ++kk)
#pragma unroll
            for (int ntl = 0; ntl < 4; ++ntl) csf[kk][ntl] = *(const u32x4*)(Cs + (64 * half + 16 * ntl + fr) * 64 + kk * 32 + fq * 8);
    }
    unsigned short aov[4][4], azv[4][4]; float anw[4];
#pragma unroll
    for (int ntl = 0; ntl < 4; ++ntl) {
        const int v = h * 128 + 64 * half + 16 * ntl + fr;
        anw[ntl] = XPAR(P_ANW)[l * 512 + v];
#pragma unroll
        for (int ii = 0; ii < 4; ++ii) {
            const unsigned row = (unsigned)row0 + 16 * mti + fq * 4 + ii;
            aov[ntl][ii] = XU[row * NIN + C_AO + v]; azv[ntl][ii] = XU[row * NIN + C_AZ + v];
        }
    }
    u32x4 qraw, kraw, vblk[8];
    const int tgv = lane & 7, cgv = (wave & 1) * 8 + (lane >> 3);
    {
        const int tok = tid >> 3, k8 = (tid & 7) * 8;
        const bf16_t* ur = XU + (unsigned)(row0 + tok) * NIN;
        qraw = *(const u32x4*)(ur + C_AQ + h * 64 + k8); kraw = *(const u32x4*)(ur + C_AK + h * 64 + k8);
        if (wave == 2 || wave == 3) {
#pragma unroll
            for (int t = 0; t < 8; ++t) vblk[t] = *(const u32x4*)(XU + (unsigned)(row0 + 8 * tgv + t) * NIN + C_AV + h * 128 + cgv * 8);
        }
    }
    if (wave == 0) {
        const bf16_t* ur = XU + (unsigned)(row0 + lane) * NIN;
        const float fg = bf2f(ur[C_AF + h]) + XPAR(P_AFB)[l * 4 + h], ig = bf2f(ur[C_AI + h]) + XPAR(P_AIB)[l * 4 + h];
        const float b = wave_scan_sum(logsigf_(fg), lane);
        const float dd = ig - b;
        const float cm = wave_scan_max(dd, lane);
        const float ms = XMS[nh * 128 + c];
        const float mt = b + fmaxf(ms, cm);
        bv[lane] = b; dv[lane] = dd; mtv[lane] = mt; siv[lane] = __expf(b + ms - mt);
        nsv[lane] = XNS[((size_t)nh * 128 + c) * 64 + lane];
    }
    {
        const int tok = tid >> 3, k8 = (tid & 7) * 8;
        *(LAS u32x4*)(Qs + ((tok * 72 + k8) << 1)) = qraw;
        float x[8]; unpack8(kraw, x);
#pragma unroll
        for (int j = 0; j < 8; ++j) x[j] *= 0.125f;
        *(LAS u32x4*)(Ks + ((tok * 72 + k8) << 1)) = pack8(x);
    }
    if (wave == 2 || wave == 3) {
#pragma unroll
        for (int j = 0; j < 8; ++j) {
            u32x4 w;
#pragma unroll
            for (int tp = 0; tp < 4; ++tp) {
                const unsigned lo = (vblk[2 * tp][j >> 1] >> ((j & 1) * 16)) & 0xffffu, hi = (vblk[2 * tp + 1][j >> 1] >> ((j & 1) * 16)) & 0xffffu;
                w[tp] = lo | (hi << 16);
            }
            *(LAS u32x4*)(Vt + (((cgv * 8 + j) * 72 + 8 * tgv) << 1)) = w;
        }
    }
    __syncthreads();
    bf16x8 qa[2];
    qa[0] = lds_frag(Qs, 16 * mti + fr, fq * 8, 72); qa[1] = lds_frag(Qs, 16 * mti + fr, 32 + fq * 8, 72);
    {
        float x0[8], x1[8]; unpack8(__builtin_bit_cast(u32x4, qa[0]), x0); unpack8(__builtin_bit_cast(u32x4, qa[1]), x1);
        float d = 0.f;
#pragma unroll
        for (int j = 0; j < 8; ++j) d += x0[j] * nsv[fq * 8 + j] + x1[j] * nsv[32 + fq * 8 + j];
        d += __shfl_xor(d, 16); d += __shfl_xor(d, 32);
        if (fq == 0) qnv[wave * 16 + fr] = d;
    }
    float rsum[4] = {0.f, 0.f, 0.f, 0.f};
#pragma unroll
    for (int ntl = 0; ntl < 4; ++ntl) {
        f32x4 s = {0.f, 0.f, 0.f, 0.f};
        s = mfma16(qa[0], lds_frag(Ks, 16 * ntl + fr, fq * 8, 72), s);
        s = mfma16(qa[1], lds_frag(Ks, 16 * ntl + fr, 32 + fq * 8, 72), s);
#pragma unroll
        for (int ii = 0; ii < 4; ++ii) {
            const int t = 16 * mti + fq * 4 + ii, sidx = 16 * ntl + fr;
            const float wgt = (sidx <= t) ? __expf(bv[t] + dv[sidx] - mtv[t]) : 0.f;
            const float sv = wgt * s[ii];
            rsum[ii] += sv;
            *(LAS bf16_t*)(Sb + (((fq * 4 + ii) * 72 + sidx) << 1)) = (bf16_t)f2bf(sv);
        }
    }
    LDS_FENCE();
    f32x4 acc[4];
#pragma unroll
    for (int ntl = 0; ntl < 4; ++ntl) acc[ntl] = (f32x4){0.f, 0.f, 0.f, 0.f};
#pragma unroll
    for (int kk = 0; kk < 2; ++kk) {
        const bf16x8 a = lds_frag(Sb, fr, kk * 32 + fq * 8, 72);
#pragma unroll
        for (int ntl = 0; ntl < 4; ++ntl) acc[ntl] = mfma16(a, lds_frag(Vt, 64 * half + 16 * ntl + fr, kk * 32 + fq * 8, 72), acc[ntl]);
    }
    {
        const float sia = siv[16 * mti + fr];
#pragma unroll
        for (int kk = 0; kk < 2; ++kk) {
            float x[8]; unpack8(__builtin_bit_cast(u32x4, qa[kk]), x);
#pragma unroll
            for (int j = 0; j < 8; ++j) x[j] *= sia;
            const bf16x8 a = as_frag(pack8(x));
#pragma unroll
            for (int ntl = 0; ntl < 4; ++ntl) acc[ntl] = mfma16(a, as_frag(csf[kk][ntl]), acc[ntl]);
        }
    }
    float hv[4][4], ssl[4];
#pragma unroll
    for (int ii = 0; ii < 4; ++ii) {
        const int t = 16 * mti + fq * 4 + ii;
        const float den = red16(rsum[ii]) + siv[t] * qnv[wave * 16 + fq * 4 + ii];
        const float inv = rcpf_(fmaxf(fabsf(den), __expf(-mtv[t])));
        float ss = 0.f;
#pragma unroll
        for (int ntl = 0; ntl < 4; ++ntl) { hv[ntl][ii] = acc[ntl][ii] * inv; ss += hv[ntl][ii] * hv[ntl][ii]; }
        ssl[ii] = red16(ss);
        if (fr == 0) ssqp[t * 2 + half] = ssl[ii];
    }
    __syncthreads();
#pragma unroll
    for (int ii = 0; ii < 4; ++ii) {
        const int t = 16 * mti + fq * 4 + ii;
        const float rs = rsqrtf((ssqp[t * 2] + ssqp[t * 2 + 1]) * (1.f / 128.f) + EPS);
        const unsigned row = (unsigned)row0 + t;
#pragma unroll
        for (int ntl = 0; ntl < 4; ++ntl) {
            const int v = h * 128 + 64 * half + 16 * ntl + fr;
            const float ao = bf2f(aov[ntl][ii]), az = bf2f(azv[ntl][ii]);
            XMIX[row * DMIX + v] = (bf16_t)f2bf(hv[ntl][ii] * rs * anw[ntl] * sigmoidf_(ao) * siluf_(az));
        }
    }
    __syncthreads();
}

__device__ __forceinline__ void ssd_out(lptr lds, const Ctx& X, int l, int task, int tid) {
    const int g = task & 1, c = (task >> 1) & 127, n = task >> 8;
    const int lane = tid & 63, wave = tid >> 6, fr = lane & 15, fq = lane >> 4;
    const int seq0 = n * SEQ, row0 = seq0 + c * 64;
    lptr Cm = lds;
    lptr Bm = lds + 17408;
    lptr Xt = lds + 34816;
    LAS float* CBf = (LAS float*)(lds + 71680);
    LAS float* av = (LAS float*)(lds + 89088);
    LAS float* dtv = (LAS float*)(lds + 90112);
    LAS float* ssq = (LAS float*)(lds + 91136);
    const int hl = wave >> 1, th = wave & 1, hh = 4 * g + hl;
    u32x4 hsf[4][4];
    {
        const bf16_t* hs = XHSB + ((size_t)(n * 8 + hh) * 128 + c) * 8192;
#pragma unroll
        for (int kk = 0; kk < 4; ++kk)
#pragma unroll
            for (int ntl = 0; ntl < 4; ++ntl) hsf[kk][ntl] = *(const u32x4*)(hs + (16 * ntl + fr) * 128 + kk * 32 + fq * 8);
    }
    if (wave < 4) {
        const int hh = 4 * g + wave;
        const float dt = softplusf_(bf2f(XU[(unsigned)(row0 + lane) * NIN + C_BDT + hh]) + XPAR(P_DTB)[l * 8 + hh]);
        const float A = -__expf(XPAR(P_ALOG)[l * 8 + hh]);
        av[wave * 64 + lane] = wave_scan_sum(dt * A, lane);
        dtv[wave * 64 + lane] = dt;
    }
    {
        const float* cw = XPAR(P_CW) + l * 4096; const float* cb = XPAR(P_CB) + l * 1024;
        float o[8][8];
        if (wave < 4) {
            const int tg = lane & 7, cg = wave * 8 + (lane >> 3);
            conv8x8(XU, seq0, c * 64 + 8 * tg, g * 256 + cg * 8, cw, cb, o);
#pragma unroll
            for (int jx = 0; jx < 8; ++jx) {
                float v[8];
#pragma unroll
                for (int t = 0; t < 8; ++t) v[t] = o[t][jx];
                *(LAS u32x4*)(Xt + (((cg * 8 + jx) * 72 + 8 * tg) << 1)) = pack8(v);
            }
        } else {
            const int tg = lane >> 3, s8 = ((wave & 1) * 8 + (lane & 7)) * 8;
            conv8x8(XU, seq0, c * 64 + 8 * tg, (wave < 6 ? 512 : 768) + g * 128 + s8, cw, cb, o);
            lptr dstm = wave < 6 ? Bm : Cm;
#pragma unroll
            for (int t = 0; t < 8; ++t) *(LAS u32x4*)(dstm + (((8 * tg + t) * 136 + s8) << 1)) = pack8(o[t]);
        }
    }
    __syncthreads();
    unsigned short bzv[2][4][4]; float bnw[4];
#pragma unroll
    for (int ntl = 0; ntl < 4; ++ntl) {
        bnw[ntl] = XPAR(P_BNW)[l * 512 + hh * 64 + 16 * ntl + fr];
#pragma unroll
        for (int mi = 0; mi < 2; ++mi)
#pragma unroll
            for (int ii = 0; ii < 4; ++ii) bzv[mi][ntl][ii] = XU[((unsigned)row0 + 16 * (2 * th + mi) + fq * 4 + ii) * NIN + C_BZ + hh * 64 + 16 * ntl + fr];
    }
    {
        const int mt = wave >> 1;
#pragma unroll
        for (int q = 0; q < 2; ++q) {
            const int ntl = 2 * (wave & 1) + q;
            f32x4 acc = {0.f, 0.f, 0.f, 0.f};
#pragma unroll
            for (int kk = 0; kk < 4; ++kk) acc = mfma16(lds_frag(Cm, 16 * mt + fr, kk * 32 + fq * 8, 136), lds_frag(Bm, 16 * ntl + fr, kk * 32 + fq * 8, 136), acc);
#pragma unroll
            for (int ii = 0; ii < 4; ++ii) CBf[(16 * mt + fq * 4 + ii) * 68 + 16 * ntl + fr] = acc[ii];
        }
    }
    __syncthreads();
    f32x4 y1[2][4], y2[2][4];
#pragma unroll
    for (int mi = 0; mi < 2; ++mi)
#pragma unroll
        for (int ntl = 0; ntl < 4; ++ntl) { y1[mi][ntl] = (f32x4){0.f, 0.f, 0.f, 0.f}; y2[mi][ntl] = (f32x4){0.f, 0.f, 0.f, 0.f}; }
#pragma unroll
    for (int kk = 0; kk < 2; ++kk) {
        bf16x8 bx[4];
#pragma unroll
        for (int ntl = 0; ntl < 4; ++ntl) bx[ntl] = lds_frag(Xt, hl * 64 + 16 * ntl + fr, kk * 32 + fq * 8, 72);
#pragma unroll
        for (int mi = 0; mi < 2; ++mi) {
            const int t = 16 * (2 * th + mi) + fr, u0 = kk * 32 + fq * 8;
            const float at = av[hl * 64 + t];
            float w[8];
#pragma unroll
            for (int j = 0; j < 8; ++j) {
                const int uu = u0 + j;
                w[j] = (uu <= t) ? CBf[t * 68 + uu] * __expf(at - av[hl * 64 + uu]) * dtv[hl * 64 + uu] : 0.f;
            }
            const bf16x8 a = as_frag(pack8(w));
#pragma unroll
            for (int ntl = 0; ntl < 4; ++ntl) y1[mi][ntl] = mfma16(a, bx[ntl], y1[mi][ntl]);
        }
    }
    {
#pragma unroll
        for (int kk = 0; kk < 4; ++kk) {
            bf16x8 bh[4];
#pragma unroll
            for (int ntl = 0; ntl < 4; ++ntl) bh[ntl] = as_frag(hsf[kk][ntl]);
#pragma unroll
            for (int mi = 0; mi < 2; ++mi) {
                const bf16x8 a = lds_frag(Cm, 16 * (2 * th + mi) + fr, kk * 32 + fq * 8, 136);
#pragma unroll
                for (int ntl = 0; ntl < 4; ++ntl) y2[mi][ntl] = mfma16(a, bh[ntl], y2[mi][ntl]);
            }
        }
    }
    const float Dh = XPAR(P_BD)[l * 8 + hh];
#pragma unroll
    for (int mi = 0; mi < 2; ++mi)
#pragma unroll
        for (int ii = 0; ii < 4; ++ii) {
            const int t = 16 * (2 * th + mi) + fq * 4 + ii;
            const float ea = __expf(av[hl * 64 + t]);
            const unsigned row = (unsigned)row0 + t;
            float ss = 0.f;
#pragma unroll
            for (int ntl = 0; ntl < 4; ++ntl) {
                const int p = 16 * ntl + fr;
                const float xv = bf2f(*(const LAS bf16_t*)(Xt + (((hl * 64 + p) * 72 + t) << 1)));
                const float y = y1[mi][ntl][ii] + ea * y2[mi][ntl][ii] + Dh * xv;
                const float gbv = y * siluf_(bf2f(bzv[mi][ntl][ii]));
                y1[mi][ntl][ii] = gbv; ss += gbv * gbv;
            }
            ss = red16(ss);
            if (fr == 0) ssq[t * 4 + hl] = ss;
        }
    __syncthreads();
#pragma unroll
    for (int mi = 0; mi < 2; ++mi)
#pragma unroll
        for (int ii = 0; ii < 4; ++ii) {
            const int t = 16 * (2 * th + mi) + fq * 4 + ii;
            const float rs = rsqrtf((ssq[t * 4] + ssq[t * 4 + 1] + ssq[t * 4 + 2] + ssq[t * 4 + 3]) * (1.f / 256.f) + EPS);
            const unsigned row = (unsigned)row0 + t;
#pragma unroll
            for (int ntl = 0; ntl < 4; ++ntl) {
                const int p = hh * 64 + 16 * ntl + fr;
                XMIX[row * DMIX + 512 + p] = (bf16_t)f2bf(y1[mi][ntl][ii] * rs * bnw[ntl]);
            }
        }
    __syncthreads();
}


#define XB_TMO      128
#define XB_XCNT(j)  (256  + 64 * (j))
#define XB_XSUB(j)  (1280 + 64 * (j))
#define XB_XGEN(j)  (2304 + 64 * (j))
#define XB_TOP      3328
#define XB_TOPGEN   3392
#define XCD_BAR_WORDS 3456
#define XB_SPIN_CAP (1u << 18)
__device__ __forceinline__ unsigned xb_ld(unsigned* p)              { return __hip_atomic_load(p, __ATOMIC_RELAXED, __HIP_MEMORY_SCOPE_AGENT); }
__device__ __forceinline__ unsigned xb_add(unsigned* p, unsigned v) { return __hip_atomic_fetch_add(p, v, __ATOMIC_RELAXED, __HIP_MEMORY_SCOPE_AGENT); }
__device__ __forceinline__ unsigned xb_xcc_id() { return (unsigned)__builtin_amdgcn_s_getreg((3 << 11) | 20) & 0xFu; }
#define XB_SPIN(cond, bar) do { unsigned _sp = 0; while (cond) { __builtin_amdgcn_s_sleep(1); \
    if ((++_sp & 255u) == 0u) { if (xb_ld(&(bar)[XB_TMO])) break; if (_sp > XB_SPIN_CAP) { atomicAdd(&(bar)[XB_TMO], 1u); break; } } } } while (0)
struct XcdBarrier { unsigned* bar; unsigned x; volatile LAS unsigned* st; };
__device__ __forceinline__ XcdBarrier xcd_barrier_post(unsigned* bar, volatile LAS unsigned* st) {
    XcdBarrier b; b.bar = bar; b.x = xb_xcc_id(); b.st = st;
    if (threadIdx.x == 0) (void)xb_add(&bar[XB_XCNT(b.x)], 1u);
    return b;
}
__device__ __forceinline__ void xcd_barrier_complete(unsigned* bar, unsigned x, unsigned& nloc, unsigned& nx) {
    const unsigned G = gridDim.x * gridDim.y * gridDim.z;
    unsigned sum, cnt, mine, sp = 0u;
    for (;;) {
        sum = 0u; cnt = 0u; mine = 0u;
#pragma unroll
        for (unsigned j = 0; j < 16; ++j) { const unsigned c = xb_ld(&bar[XB_XCNT(j)]); sum += c; cnt += (c > 0u) ? 1u : 0u; mine = (j == x) ? c : mine; }
        if (sum == G) break;
        __builtin_amdgcn_s_sleep(1);
        if ((++sp & 255u) == 0u) { if (xb_ld(&bar[XB_TMO])) break; if (sp > XB_SPIN_CAP) { atomicAdd(&bar[XB_TMO], 1u); break; } }
    }
    nloc = mine > 0u ? mine : 1u; nx = cnt > 0u ? cnt : 1u;
}
__device__ __forceinline__ void xcd_barrier(const XcdBarrier& b) {
    asm volatile("s_waitcnt vmcnt(0)" ::: "memory");
    __syncthreads();
    if (threadIdx.x == 0) {
        unsigned* bar = b.bar;
        __builtin_amdgcn_s_waitcnt(0);
        unsigned nloc = b.st[0], nx = b.st[1];
        if (nloc == 0u) { xcd_barrier_complete(bar, b.x, nloc, nx); b.st[0] = nloc; b.st[1] = nx; }
        const unsigned old = xb_add(&bar[XB_XSUB(b.x)], 1u);
        const unsigned gen = old / nloc;
        if (old + 1u == (gen + 1u) * nloc) {
            __builtin_amdgcn_fence(__ATOMIC_RELEASE, "agent");
            asm volatile("s_waitcnt vmcnt(0)" ::: "memory");
            const unsigned og = xb_add(&bar[XB_TOP], 1u);
            const unsigned tg = og / nx;
            if (og + 1u == (tg + 1u) * nx) xb_add(&bar[XB_TOPGEN], 1u);
            else XB_SPIN(xb_ld(&bar[XB_TOPGEN]) == tg, bar);
            __builtin_amdgcn_fence(__ATOMIC_ACQUIRE, "agent");
            xb_add(&bar[XB_XGEN(b.x)], 1u);
            asm volatile("s_waitcnt vmcnt(0)" ::: "memory");
        } else {
            XB_SPIN(xb_ld(&bar[XB_XGEN(b.x)]) == gen, bar);
            __builtin_amdgcn_fence(__ATOMIC_ACQUIRE, "agent");
            asm volatile("s_waitcnt vmcnt(0)" ::: "memory");
        }
    }
    __syncthreads();
}

__global__ void __launch_bounds__(NT, 2) mega(Args args) {
    __shared__ __attribute__((aligned(16))) unsigned char lds_raw[LDS_BYTES];
    lptr lds = (lptr)lds_raw;
    cg::grid_group grid = cg::this_grid();
    const int tid = threadIdx.x, bid = blockIdx.x, G = gridDim.x;
    Ctx X;
    X.xp = args.in[IN_XP]; X.xs = args.in[IN_XS]; X.stC = args.in[IN_STC]; X.stN = args.in[IN_STN]; X.stM = args.in[IN_STM]; X.ssm = args.in[IN_SSM];
    X.conv = args.in[IN_CONV]; X.ck = args.in[IN_CK]; X.cv = args.in[IN_CV]; X.out = args.out; X.ws = args.ws;
    const int lo = args.ph_lo, hi = args.ph_hi;
    volatile LAS unsigned* xst = (volatile LAS unsigned*)(lds + LDS_BYTES - 16);
    if (tid == 0) { xst[0] = 0u; xst[1] = 0u; }
    __syncthreads();
    XcdBarrier xbar = xcd_barrier_post((unsigned*)(args.ws + WS_BAR), xst);
#define IN(k) (lo <= (k) && (k) < hi)
#define SEAM(k) do { if (IN(k) && IN((k) + 1)) { for (int _r = 0; _r < REP_SYNC; ++_r) { if (lo < 0) grid.sync(); xcd_barrier(xbar); } } } while (0)
    if (IN(0)) { for (int _r = 0; _r < REP_P0; ++_r) prologue(lds, X, args, G, bid, tid); }
    SEAM(0);
    for (int l = 0; l < 4; ++l) {
        const int pb = 1 + l * 5;
        if (IN(pb)) for (int _r = 0; _r < REP_P1; ++_r) {
            pg8::Gemm g{XXB, XWIN + (size_t)l * NIN * D, MPAD, NIN, D}; pg8::StaticOrder S; S.init(TP, NIN, G, bid);
            pg8::EpiU E{XU, XSSQ};
            pg8::gemm_phase<pg8::EpiU, pg8::StaticOrder, false, GEMM_SP2, GEMM_ALIGN>(lds, g, S, E, OPQ(tid));
            if (l == 0 && bid >= G - 20) {
                pg8::SampleOrder S2{G - 20, 20, bid}; pg8::EpiUh E2{XU, XSSQ};
                pg8::gemm_phase<pg8::EpiUh, pg8::SampleOrder, true>(lds, g, S2, E2, OPQ(tid));
            }
        }
        SEAM(pb);
        if (IN(pb + 1)) for (int _r = 0; _r < REP_P2; ++_r) {
            for (int t = bid; t < 256; t += G) for (int _q = 0; _q < RT_SWA; ++_q) swa_prompt(lds, X, l, t, OPQ(tid));
            for (int t = bid; t < 256; t += G) for (int _q = 0; _q < RT_SAMPLE; ++_q) {
                if (t < 128) sample_task(lds, X, l, t, 1, OPQ(tid));
                else { sample_task(lds, X, l, t - 128, 0, OPQ(tid)); sample_task(lds, X, l, t - 128, 2, OPQ(tid)); }
            }
            for (int t = bid; t < 512; t += G) for (int _q = 0; _q < RT_SLOC; ++_q) ssd_local(lds, X, l, t, OPQ(tid));
            for (int t = bid; t < 1024; t += G) for (int _q = 0; _q < RT_MLOC; ++_q) mlstm_local(lds, X, l, t, OPQ(tid));
            if (bid == G - 1) {
                for (int i = tid; i < 2 * 3 * 1024; i += NT) {
                    const int ch = i & 1023, j = (i >> 10) % 3, n = i / 3072;
                    X.out[O_PCONV + (((size_t)l * 2 + n) * 3 + j) * 1024 + ch] = bf2f(XU[(size_t)(n * SEQ + SEQ - 3 + j) * NIN + C_BX + ch]);
                }
            }
        }
        SEAM(pb + 1);
        if (IN(pb + 2)) {
            if (bid >= G - 4) {
                pg8::Gemm g{XMIX, XWOUT + (size_t)l * D * DMIX, MPAD, D, DMIX}; pg8::SampleOrder S{G - 4, 4, bid};
                if (l == 0) { pg8::EpiRes_<1, 0> E{X.xp, X.xs, X.out, XXB, XSSQ}; pg8::gemm_phase<pg8::EpiRes_<1, 0>, pg8::SampleOrder, true>(lds, g, S, E, OPQ(tid)); }
                else if (l < 3) { pg8::EpiRes_<1, 1> E{X.xp, X.xs, X.out, XXB, XSSQ}; pg8::gemm_phase<pg8::EpiRes_<1, 1>, pg8::SampleOrder, true>(lds, g, S, E, OPQ(tid)); }
                else { pg8::EpiRes_<1, 2> E{X.xp, X.xs, X.out, XXB, XSSQ}; pg8::gemm_phase<pg8::EpiRes_<1, 2>, pg8::SampleOrder, true>(lds, g, S, E, OPQ(tid)); }
            }
            for (int _r = 0; _r < REP_P3; ++_r) scans(X, l, bid * NT + OPQ(tid), G * NT);
        }
        SEAM(pb + 2);
        if (IN(pb + 3)) for (int _r = 0; _r < REP_P4; ++_r) {
            for (int task = bid; task < 1536; task += G) {
                if (task < 512) for (int _q = 0; _q < RT_SOUT; ++_q) ssd_out(lds, X, l, task, OPQ(tid));
                else mlstm_out(lds, X, l, task - 512, OPQ(tid));
            }
        }
        SEAM(pb + 3);
        if (IN(pb + 4)) {
            {
                pg8::Gemm g{XMIX, XWOUT + (size_t)l * D * DMIX, MPAD, D, DMIX}; pg8::StaticOrder S; S.init(TP, D, G, bid);
#ifdef PROBE_P5
                { pg8::EpiProbe EP{(const unsigned*)(X.ws + 64), XSSQ}; pg8::gemm_phase<pg8::EpiProbe, pg8::StaticOrder, false, GEMM_SP2>(lds, g, S, EP, OPQ(tid)); }
#endif
                if (l == 0) { pg8::EpiRes_<2, 0> E{X.xp, X.xs, X.out, XXB, XSSQ}; pg8::gemm_phase<pg8::EpiRes_<2, 0>, pg8::StaticOrder, false, GEMM_SP2, GEMM_ALIGN>(lds, g, S, E, OPQ(tid)); }
                else if (l < 3) { pg8::EpiRes_<2, 1> E{X.xp, X.xs, X.out, XXB, XSSQ}; pg8::gemm_phase<pg8::EpiRes_<2, 1>, pg8::StaticOrder, false, GEMM_SP2, GEMM_ALIGN>(lds, g, S, E, OPQ(tid)); }
                else { pg8::EpiRes_<2, 2> E{X.xp, X.xs, X.out, XXB, XSSQ}; pg8::gemm_phase<pg8::EpiRes_<2, 2>, pg8::StaticOrder, false, GEMM_SP2, GEMM_ALIGN>(lds, g, S, E, OPQ(tid)); }
            }
            if (l < 3 && bid < 20) {
                pg8::Gemm g{XXB, XWIN + (size_t)(l + 1) * NIN * D, MPAD, NIN, D}; pg8::SampleOrder S{0, 20, bid};
                pg8::EpiUh E{XU, XSSQ};
                pg8::gemm_phase<pg8::EpiUh, pg8::SampleOrder, true>(lds, g, S, E, OPQ(tid));
            }
        }
        SEAM(pb + 4);
    }
#undef IN
#undef SEAM
}

extern "C" void kernel_launch(void* const* d_in, const int* in_sizes, int n_in, void* d_out, int out_size, void* d_ws, size_t ws_size, hipStream_t stream) {
    static int grid_blocks = 0;
    if (!grid_blocks) {
        int dev = 0, cus = 0, per_cu = 0;
        hipGetDevice(&dev);
        hipDeviceGetAttribute(&cus, hipDeviceAttributeMultiprocessorCount, dev);
        hipOccupancyMaxActiveBlocksPerMultiprocessor(&per_cu, mega, NT, 0);
        if (per_cu < 1) { fprintf(stderr, "occupancy query returned %d\n", per_cu); per_cu = 1; }
        grid_blocks = cus * 1;
        if (ws_size < WS_END) fprintf(stderr, "workspace too small: %zu < %zu\n", ws_size, (size_t)WS_END);
    }
    (void)hipMemsetAsync(d_ws, 0, 16384, stream);
    Args a{};
    for (int i = 0; i < 24; ++i) a.in[i] = (const float*)d_in[i];
    a.out = (float*)d_out; a.ws = (unsigned char*)d_ws;
    const int NPH = 21;
#if MULTI_LAUNCH
    for (int p = 0; p < NPH; ++p) {
        a.ph_lo = p; a.ph_hi = p + 1;
        void* kargs[] = {&a};
        hipError_t e = hipLaunchCooperativeKernel((void*)mega, dim3(grid_blocks), dim3(NT), kargs, 0, stream);
        if (e != hipSuccess) fprintf(stderr, "cooperative launch failed: %s (grid %d)\n", hipGetErrorString(e), grid_blocks);
    }
#else
    a.ph_lo = 0; a.ph_hi = NPH;
    void* kargs[] = {&a};
    hipError_t e = hipLaunchCooperativeKernel((void*)mega, dim3(grid_blocks), dim3(NT), kargs, 0, stream);
    if (e != hipSuccess) fprintf(stderr, "cooperative launch failed: %s (grid %d)\n", hipGetErrorString(e), grid_blocks);
#endif
}
```

```cpp
#include <hip/hip_runtime.h>
#include <hip/hip_cooperative_groups.h>
#include <cstdio>
#include <cstdint>
namespace cg = cooperative_groups;

#ifndef REP_SYNC
#define REP_SYNC 1
#endif
#ifndef REP_P1
#define REP_P1 1
#endif
#ifndef REP_P2
#define REP_P2 1
#endif
#ifndef REP_P3
#define REP_P3 1
#endif
#ifndef REP_P0
#define REP_P0 1
#endif
#ifndef REP_P4
#define REP_P4 1
#endif
#ifndef RT_SAMPLE
#define RT_SAMPLE 1
#endif
#ifndef RT_SWA
#define RT_SWA 1
#endif
#ifndef RT_SLOC
#define RT_SLOC 1
#endif
#ifndef RT_MLOC
#define RT_MLOC 1
#endif
#ifndef RT_SOUT
#define RT_SOUT 1
#endif
#ifndef GEMM_SP2
#define GEMM_SP2 true
#endif
#ifndef GEMM_ALIGN
#define GEMM_ALIGN true
#endif
#ifndef MULTI_LAUNCH
#define MULTI_LAUNCH 0
#endif

#define LAS __attribute__((address_space(3)))
typedef unsigned short bf16_t;
typedef short bf16x8 __attribute__((ext_vector_type(8)));
typedef float f32x4 __attribute__((ext_vector_type(4)));
typedef float f32x2 __attribute__((ext_vector_type(2)));
typedef unsigned u32x4 __attribute__((ext_vector_type(4)));
typedef unsigned u32x2 __attribute__((ext_vector_type(2)));
typedef __bf16 bf16x2_t __attribute__((ext_vector_type(2)));
typedef LAS unsigned char* lptr;

constexpr int D = 1024, DIN = 4880, NIN = 5120, DMIX = 1536, TP = 16384, MTOK = 16512, MPAD = 16640, SEQ = 8192;
constexpr int C_AQ = 0, C_AK = 256, C_AV = 512, C_AO = 1024, C_AZ = 1536, C_AI = 2048, C_AF = 2052, C_BZ = 2056, C_BX = 2568, C_BB = 3080, C_BC = 3336,
              C_BDT = 3592, C_CQ = 3600, C_CK = 4112, C_CV = 4240, C_CZ = 4368;
constexpr float EPS = 1e-6f;
constexpr size_t O_YP = 0, O_YS = 16777216, O_PC = 16908288, O_PN = 17170432, O_PM = 17172480, O_PH = 17172512, O_PCONV = 17696800, O_PK = 17721376,
                 O_PV = 17852448, O_SC = 17983520, O_SN = 34760736, O_SM = 34891808, O_SH = 34893856, O_SCONV = 68448288, O_SK = 70021152, O_SV = 78409760;
constexpr size_t WS_BAR = 0;
constexpr size_t WS_PAR = 16384;
constexpr size_t WS_WIN = WS_PAR + 102400;
constexpr size_t WS_WOUT = WS_WIN + (size_t)4 * NIN * D * 2;
constexpr size_t WS_XB = WS_WOUT + (size_t)4 * D * DMIX * 2;
constexpr size_t WS_U = WS_XB + (size_t)MPAD * D * 2;
constexpr size_t WS_MIX = WS_U + (size_t)MPAD * NIN * 2;
constexpr size_t WS_SSQ = WS_MIX + (size_t)MPAD * DMIX * 2;
constexpr size_t WS_ROPE = WS_SSQ + (size_t)MPAD * 16 * 4;
constexpr size_t WS_MC = WS_ROPE + (size_t)8200 * 64 * 4;
constexpr size_t WS_MN = WS_MC + (size_t)8 * 128 * 8192 * 4;
constexpr size_t WS_ML = WS_MN + (size_t)8 * 128 * 64 * 4;
constexpr size_t WS_BL = WS_ML + 4096;
constexpr size_t WS_MS = WS_BL + 4096;
constexpr size_t WS_SA = WS_MS + 4096;
constexpr size_t WS_SH = WS_SA + 8192;
constexpr size_t WS_CSB = WS_SH + (size_t)16 * 128 * 8192 * 4;
constexpr size_t WS_HSB = WS_CSB + (size_t)8 * 128 * 8192 * 2;
constexpr size_t WS_NS = WS_HSB + (size_t)16 * 128 * 8192 * 2;
constexpr size_t WS_END = WS_NS + (size_t)8 * 128 * 64 * 4;
constexpr int LDS_BYTES = 139264;
constexpr int NT = 512;

struct Args { const float* in[24]; float* out; unsigned char* ws; int ph_lo, ph_hi; };

__device__ __forceinline__ float bf2f(unsigned v) { return __uint_as_float(v << 16); }
__device__ __forceinline__ unsigned pk2(float lo, float hi) { f32x2 v = {lo, hi}; bf16x2_t b = __builtin_convertvector(v, bf16x2_t); return __builtin_bit_cast(unsigned, b); }
__device__ __forceinline__ unsigned f2bf(float f) { return pk2(f, 0.f) & 0xffffu; }
__device__ __forceinline__ void unpack8(u32x4 w, float (&f)[8]) {
#pragma unroll
    for (int i = 0; i < 4; ++i) { f[2 * i] = __uint_as_float(w[i] << 16); f[2 * i + 1] = __uint_as_float(w[i] & 0xffff0000u); }
}
__device__ __forceinline__ u32x4 pack8(const float (&f)[8]) { u32x4 w; w[0] = pk2(f[0], f[1]); w[1] = pk2(f[2], f[3]); w[2] = pk2(f[4], f[5]); w[3] = pk2(f[6], f[7]); return w; }
__device__ __forceinline__ u32x4 pack8v(f32x4 a, f32x4 b) { u32x4 w; w[0] = pk2(a[0], a[1]); w[1] = pk2(a[2], a[3]); w[2] = pk2(b[0], b[1]); w[3] = pk2(b[2], b[3]); return w; }
__device__ __forceinline__ bf16x8 as_frag(u32x4 w) { return __builtin_bit_cast(bf16x8, w); }
__device__ __forceinline__ bf16x8 ldg_f32_frag(const float* p) { f32x4 a = *(const f32x4*)p, b = *(const f32x4*)(p + 4); return as_frag(pack8v(a, b)); }
__device__ __forceinline__ bf16x8 lds_frag(lptr base, int row, int k, int stride) { return *(const LAS bf16x8*)(base + ((row * stride + k) << 1)); }
__device__ __forceinline__ f32x4 mfma16(bf16x8 a, bf16x8 b, f32x4 c) { return __builtin_amdgcn_mfma_f32_16x16x32_bf16(a, b, c, 0, 0, 0); }
__device__ __forceinline__ float rcpf_(float x) { return __builtin_amdgcn_rcpf(x); }
__device__ __forceinline__ float sigmoidf_(float x) { return rcpf_(1.f + __expf(-x)); }
__device__ __forceinline__ float siluf_(float x) { return x * rcpf_(1.f + __expf(-x)); }
__device__ __forceinline__ float softplusf_(float x) { return x > 20.f ? x : log1pf(__expf(x)); }
__device__ __forceinline__ float logsigf_(float x) { return fminf(x, 0.f) - log1pf(__expf(-fabsf(x))); }
template <int CTRL, int RM> __device__ __forceinline__ float dpps(float ident, float v) { return __int_as_float(__builtin_amdgcn_update_dpp(__float_as_int(ident), __float_as_int(v), CTRL, RM, 0xf, false)); }
__device__ __forceinline__ float wave_scan_sum(float v, int) {
    v += dpps<0x111, 0xf>(0.f, v); v += dpps<0x112, 0xf>(0.f, v); v += dpps<0x114, 0xf>(0.f, v); v += dpps<0x118, 0xf>(0.f, v);
    v += dpps<0x142, 0xa>(0.f, v); v += dpps<0x143, 0xc>(0.f, v);
    return v;
}
__device__ __forceinline__ float wave_scan_max(float v, int) {
    const float NI = -3.0e38f;
    v = fmaxf(v, dpps<0x111, 0xf>(NI, v)); v = fmaxf(v, dpps<0x112, 0xf>(NI, v)); v = fmaxf(v, dpps<0x114, 0xf>(NI, v)); v = fmaxf(v, dpps<0x118, 0xf>(NI, v));
    v = fmaxf(v, dpps<0x142, 0xa>(NI, v)); v = fmaxf(v, dpps<0x143, 0xc>(NI, v));
    return v;
}
__device__ __forceinline__ float lane63(float v) { return __int_as_float(__builtin_amdgcn_readlane(__float_as_int(v), 63)); }
__device__ __forceinline__ float red16(float v);
__device__ __forceinline__ float red16max(float v);
__device__ __forceinline__ float wave_sum(float v) { v = red16(v); v += __shfl_xor(v, 16); v += __shfl_xor(v, 32); return v; }
__device__ __forceinline__ float wave_max(float v) { v = red16max(v); v = fmaxf(v, __shfl_xor(v, 16)); v = fmaxf(v, __shfl_xor(v, 32)); return v; }
template <int CTRL> __device__ __forceinline__ float dppf(float v) { return __int_as_float(__builtin_amdgcn_update_dpp(0, __float_as_int(v), CTRL, 0xf, 0xf, true)); }
__device__ __forceinline__ float red16(float v) { v += dppf<0xB1>(v); v += dppf<0x4E>(v); v += dppf<0x141>(v); v += dppf<0x140>(v); return v; }
__device__ __forceinline__ float red16max(float v) { v = fmaxf(v, dppf<0xB1>(v)); v = fmaxf(v, dppf<0x4E>(v)); v = fmaxf(v, dppf<0x141>(v)); v = fmaxf(v, dppf<0x140>(v)); return v; }
__device__ __forceinline__ int OPQ(int v) { asm volatile("" : "+v"(v)); return v; }
#define LDS_FENCE() asm volatile("s_waitcnt lgkmcnt(0)" ::: "memory")

namespace pg8 {
constexpr int BM = 256, BK = 64, HALF = 128, HTB = HALF * BK * 2, STAGE_BYTES = 8 * HTB, NXCD = 8, WGM = 8;
__host__ __device__ __forceinline__ int lds_byte(int r, int c) { const int st = (r >> 4) * 2 + (c >> 5), rr = r & 15, cc = c & 31, ob = rr * 64 + cc * 2; return st * 1024 + (ob ^ (((ob >> 9) & 1) << 5)); }
__host__ __device__ __forceinline__ void stage_rc(int b, int& R, int& C) { const int st = b / 1024, sb = b % 1024, swz = sb ^ (((sb >> 9) & 1) << 5); R = (st >> 1) * 16 + swz / 64; C = (st & 1) * 32 + (swz % 64) / 2; }
__host__ __device__ __forceinline__ int perm32(int rho) { const int n = rho >> 4, i = rho & 15; return 8 * (i >> 2) + 4 * n + (i & 3); }
struct Unit { int pm, pn; };
struct Gemm { const bf16_t* A; const bf16_t* Bt; int M, N, K; };
struct StaticOrder {
    int nM, nN, nwg, G, c;
    __device__ void init(int M, int N, int G_, int c_) { nM = M / BM; nN = N / BM; nwg = nM * nN; G = G_; c = c_; }
    __device__ bool next(int i, Unit& u) const {
        const long L = (long)i * G + c; if (L >= nwg) return false;
        int wgid = (int)L; { const int q = nwg / NXCD, r = nwg % NXCD, xcd = wgid % NXCD, off = wgid / NXCD; wgid = (xcd < r ? xcd * (q + 1) : r * (q + 1) + (xcd - r) * q) + off; }
        const int nig = WGM * nN, gid = wgid / nig, fm = gid * WGM, gsz = (nM - fm) < WGM ? (nM - fm) : WGM;
        u.pm = fm + ((wgid % nig) % gsz); u.pn = (wgid % nig) / gsz; return true;
    }
};
template <int NAI> struct EpiU_ {
    bf16_t* U; const float* ssq;
    __device__ __forceinline__ void operator()(const f32x4 (&acc)[2][2][4][2], const Unit& u, int wr, int wc, int fr, int fq) const {
        const int row0 = u.pm * BM + wr * 64 + fr, col0 = u.pn * BM + wc * 32 + 8 * fq;
#pragma unroll
        for (int ai = 0; ai < NAI; ++ai)
#pragma unroll
            for (int m = 0; m < 4; ++m) {
                const int r = row0 + ai * HALF + m * 16;
                const f32x4 s = *(const f32x4*)(ssq + (size_t)r * 16 + fq * 4);
                float st = s[0] + s[1] + s[2] + s[3]; st += __shfl_xor(st, 16); st += __shfl_xor(st, 32);
                const float rs = rsqrtf(st * (1.f / 1024.f) + EPS);
                bf16_t* rowp = U + (size_t)r * NIN + col0;
#pragma unroll
                for (int bj = 0; bj < 2; ++bj) *(u32x4*)(rowp + bj * HALF) = pack8v(acc[ai][bj][m][0] * rs, acc[ai][bj][m][1] * rs);
                __builtin_amdgcn_sched_barrier(0);
            }
    }
};
template <int NAI, int MODE> struct EpiRes_ {
    const float* xp; const float* xs; float* out; bf16_t* xb; float* ssq;
    __device__ __forceinline__ void operator()(const f32x4 (&acc)[2][2][4][2], const Unit& u, int wr, int wc, int fr, int fq) const {
        const int row0 = u.pm * BM + wr * 64 + fr, col0 = u.pn * BM + wc * 32 + 8 * fq;
#pragma unroll
        for (int ai = 0; ai < NAI; ++ai)
#pragma unroll
            for (int m = 0; m < 4; ++m) {
                const int r = row0 + ai * HALF + m * 16;
                const bool valid = r < MTOK;
                float part = 0.f;
#pragma unroll
                for (int bj = 0; bj < 2; ++bj) {
                    const int c = col0 + bj * HALF;
                    f32x4 o0 = {0.f, 0.f, 0.f, 0.f}, o1 = {0.f, 0.f, 0.f, 0.f};
                    if (MODE == 0) {
                        const float* src = r < TP ? xp + (size_t)r * D : xs + (size_t)(r - TP) * D;
                        if (valid) { o0 = __builtin_nontemporal_load((const f32x4*)(src + c)); o1 = __builtin_nontemporal_load((const f32x4*)(src + c + 4)); }
                    } else {
                        float f[8]; unpack8(*(const u32x4*)(xb + (size_t)r * D + c), f);
                        o0 = (f32x4){f[0], f[1], f[2], f[3]}; o1 = (f32x4){f[4], f[5], f[6], f[7]};
                    }
                    const f32x4 v0 = acc[ai][bj][m][0] + o0, v1 = acc[ai][bj][m][1] + o1;
                    if (MODE == 2) {
                        if (valid) { __builtin_nontemporal_store(v0, (f32x4*)(out + (size_t)r * D + c)); __builtin_nontemporal_store(v1, (f32x4*)(out + (size_t)r * D + c + 4)); }
                    } else {
                        *(u32x4*)(xb + (size_t)r * D + c) = pack8v(v0, v1);
                        part += v0[0] * v0[0] + v0[1] * v0[1] + v0[2] * v0[2] + v0[3] * v0[3] + v1[0] * v1[0] + v1[1] * v1[1] + v1[2] * v1[2] + v1[3] * v1[3];
                    }
                }
                if (MODE != 2) {
                    part += __shfl_xor(part, 16); part += __shfl_xor(part, 32);
                    if (fq == 0) ssq[(size_t)r * 16 + u.pn * 4 + wc] = part;
                }
                __builtin_amdgcn_sched_barrier(0);
            }
    }
};

typedef EpiU_<2> EpiU; typedef EpiU_<1> EpiUh;
struct EpiProbe {
    const unsigned* flag; float* dst;
    __device__ __forceinline__ void operator()(const f32x4 (&acc)[2][2][4][2], const Unit& u, int wr, int wc, int fr, int fq) const {
        if (__hip_atomic_load(flag, __ATOMIC_RELAXED, __HIP_MEMORY_SCOPE_AGENT) == 12345u) {
            f32x4 t = {0.f, 0.f, 0.f, 0.f};
#pragma unroll
            for (int a = 0; a < 2; ++a)
#pragma unroll
                for (int b = 0; b < 2; ++b)
#pragma unroll
                    for (int m = 0; m < 4; ++m)
#pragma unroll
                        for (int n = 0; n < 2; ++n) t += acc[a][b][m][n];
            *(f32x4*)(dst + (size_t)(u.pm * 4 + u.pn) * 2048 + (wr * 4 + wc) * 256 + (fq * 16 + fr) * 4) = t;
        }
    }
};
struct SampleOrder {
    int first, cnt, c;
    __device__ bool next(int i, Unit& u) const { if (i != 0 || c < first || c >= first + cnt) return false; u.pm = 64; u.pn = c - first; return true; }
};
template <class Epi, class Sched, bool HALF_M = false, bool SP2 = false, bool ALIGN_EPI = false>
__device__ __forceinline__ void gemm_phase(lptr lds, const Gemm g, const Sched& S, const Epi& E, const int tid) {
    const int wid = __builtin_amdgcn_readfirstlane(tid >> 6), lane = tid & 63, wr = wid >> 2, wc = wid & 3, fr = lane & 15, fq = lane >> 4;
    const int K = g.K, nt = K / BK;
    unsigned voffA[2], voffB[2];
#pragma unroll
    for (int i = 0; i < 2; ++i) { int R, C; stage_rc(tid * 16 + i * 8192, R, C); const int Rb = (R & ~31) + perm32(R & 31);
        voffA[i] = (unsigned)(R * K + C) * 2u; voffB[i] = (unsigned)(Rb * K + C) * 2u; }
    const size_t kstep = (size_t)(BK * 2);
    const size_t hstep = (size_t)HALF * K * 2;
    const size_t tstep = 2 * hstep;
    const unsigned ldsw = (unsigned)wid * 1024u;
    const int aoff = lds_byte(wr * 64 + fr, fq * 8), boff = lds_byte(wc * 32 + fr, fq * 8);
#define PG8_SA(b, h) (((b) * 2 + (h)) * HTB)
#define PG8_SB(b, h) ((4 + (b) * 2 + (h)) * HTB)
#define PG8_STAGE(bufoff, gbase, voff) do { _Pragma("unroll") for (int _i = 0; _i < 2; ++_i) \
        __builtin_amdgcn_global_load_lds((const unsigned*)((const char*)(gbase) + (voff)[_i]), (LAS unsigned*)(lds + (bufoff) + ldsw + _i * 8192), 16, 0, 0); } while (0)
#define PG8_LDA(dst, b, h) do { _Pragma("unroll") for (int m = 0; m < 4; ++m) _Pragma("unroll") for (int k = 0; k < 2; ++k) dst[m][k] = *(const LAS bf16x8*)(lds + PG8_SA(b, h) + aoff + m * 2048 + k * 1024); } while (0)
#define PG8_LDB(dst, b, h) do { _Pragma("unroll") for (int n = 0; n < 2; ++n) _Pragma("unroll") for (int k = 0; k < 2; ++k) dst[n][k] = *(const LAS bf16x8*)(lds + PG8_SB(b, h) + boff + n * 2048 + k * 1024); } while (0)
#define PG8_MMA(ai, bj, At, Bt) do { __builtin_amdgcn_s_setprio(1); _Pragma("unroll") for (int m = 0; m < 4; ++m) _Pragma("unroll") for (int n = 0; n < 2; ++n) _Pragma("unroll") for (int k = 0; k < 2; ++k) \
        acc[ai][bj][m][n] = __builtin_amdgcn_mfma_f32_16x16x32_bf16(Bt[n][k], At[m][k], acc[ai][bj][m][n], 0, 0, 0); __builtin_amdgcn_s_setprio(0); } while (0)
#define PG8_WAIT_V(n) asm volatile("s_waitcnt vmcnt(" #n ")" ::: "memory")
#define PG8_WAIT_L(n) asm volatile("s_waitcnt lgkmcnt(" #n ")" ::: "memory")
#define PG8_BAR __builtin_amdgcn_s_barrier()
#define PG8_SCHED __builtin_amdgcn_sched_barrier(0)
    Unit cur, nxt; int ui = 0;
    if (!S.next(0, cur)) return;
    f32x4 acc[2][2][4][2];
#pragma unroll
    for (int a = 0; a < 2; ++a)
#pragma unroll
        for (int b = 0; b < 2; ++b)
#pragma unroll
            for (int m = 0; m < 4; ++m)
#pragma unroll
                for (int n = 0; n < 2; ++n) acc[a][b][m][n] = (f32x4){0.f, 0.f, 0.f, 0.f};
    bf16x8 At[4][2], B0[2][2], B1[2][2];
    const char* cA = (const char*)g.A + (size_t)cur.pm * tstep; const char* cB = (const char*)g.Bt + (size_t)cur.pn * tstep;
    if constexpr (SP2) {
        PG8_STAGE(PG8_SB(0, 0), cB, voffB); PG8_STAGE(PG8_SB(0, 1), cB + hstep, voffB); PG8_STAGE(PG8_SA(0, 0), cA, voffA); PG8_STAGE(PG8_SA(0, 1), cA + hstep, voffA);
        if (wr == 1) PG8_BAR;
        PG8_WAIT_V(2); PG8_BAR;
        PG8_STAGE(PG8_SB(1, 0), cB + kstep, voffB); PG8_STAGE(PG8_SA(1, 0), cA + kstep, voffA); PG8_STAGE(PG8_SB(1, 1), cB + hstep + kstep, voffB);
        PG8_WAIT_V(6); PG8_BAR;
    } else {
    PG8_STAGE(PG8_SB(0, 0), cB, voffB); PG8_STAGE(PG8_SA(0, 0), cA, voffA); PG8_STAGE(PG8_SB(0, 1), cB + hstep, voffB); PG8_STAGE(PG8_SA(0, 1), cA + hstep, voffA);
    if (wr == 1) PG8_BAR;
    PG8_WAIT_V(4); PG8_BAR;
    PG8_STAGE(PG8_SB(1, 0), cB + kstep, voffB); PG8_STAGE(PG8_SA(1, 0), cA + kstep, voffA); PG8_STAGE(PG8_SB(1, 1), cB + hstep + kstep, voffB);
    PG8_WAIT_V(6); PG8_BAR;
    }
    for (;;) {
        const bool has_next = S.next(ui + 1, nxt);
        const char* nA = has_next ? (const char*)g.A + (size_t)nxt.pm * tstep : cA; const char* nB = has_next ? (const char*)g.Bt + (size_t)nxt.pn * tstep : cB;
        for (int t = 0; t < nt; t += 2) {
            const bool last = (t == nt - 2);
            const char* a1 = cA + (size_t)(t + 1) * kstep;
            const char* a2 = last ? nA : cA + (size_t)(t + 2) * kstep; const char* b2 = last ? nB : cB + (size_t)(t + 2) * kstep;
            const char* a3 = a2 + kstep; const char* b3 = b2 + kstep;
            if constexpr (SP2) {
            PG8_LDB(B0, 0, 0); PG8_LDB(B1, 0, 1); PG8_SCHED; PG8_LDA(At, 0, 0); PG8_STAGE(PG8_SA(1, 1), a1 + hstep, voffA);
            PG8_WAIT_V(8); PG8_WAIT_L(0); PG8_BAR; PG8_MMA(0, 0, At, B0); PG8_MMA(0, 1, At, B1); PG8_BAR; PG8_SCHED;
            PG8_LDA(At, 0, 1); PG8_STAGE(PG8_SB(0, 0), b2, voffB); PG8_STAGE(PG8_SB(0, 1), b2 + hstep, voffB); PG8_STAGE(PG8_SA(0, 0), a2, voffA);
            PG8_WAIT_V(8); PG8_WAIT_L(0); PG8_BAR; PG8_MMA(1, 0, At, B0); PG8_MMA(1, 1, At, B1); PG8_BAR; PG8_SCHED;
            PG8_LDB(B0, 1, 0); PG8_LDB(B1, 1, 1); PG8_SCHED; PG8_LDA(At, 1, 0); PG8_STAGE(PG8_SA(0, 1), a2 + hstep, voffA);
            PG8_WAIT_V(8); PG8_WAIT_L(0); PG8_BAR; PG8_MMA(0, 0, At, B0); PG8_MMA(0, 1, At, B1); PG8_BAR; PG8_SCHED;
            PG8_LDA(At, 1, 1); PG8_STAGE(PG8_SB(1, 0), b3, voffB); PG8_STAGE(PG8_SB(1, 1), b3 + hstep, voffB); PG8_STAGE(PG8_SA(1, 0), a3, voffA);
            PG8_WAIT_V(8); PG8_WAIT_L(0); PG8_BAR; PG8_MMA(1, 0, At, B0); PG8_MMA(1, 1, At, B1); PG8_BAR; PG8_SCHED;
            } else {
            PG8_LDB(B0, 0, 0); PG8_SCHED; PG8_LDA(At, 0, 0); PG8_STAGE(PG8_SA(1, 1), a1 + hstep, voffA);
            PG8_WAIT_L(8); PG8_BAR; PG8_WAIT_L(0); PG8_MMA(0, 0, At, B0); PG8_BAR; PG8_SCHED;
            PG8_LDB(B1, 0, 1); PG8_STAGE(PG8_SB(0, 0), b2, voffB);
            PG8_BAR; PG8_WAIT_L(0); PG8_MMA(0, 1, At, B1); PG8_BAR;
            if constexpr (!HALF_M) PG8_LDA(At, 0, 1);
            PG8_STAGE(PG8_SA(0, 0), a2, voffA);
            PG8_BAR; PG8_WAIT_L(0); if constexpr (!HALF_M) PG8_MMA(1, 0, At, B0); PG8_BAR; PG8_SCHED;
            PG8_STAGE(PG8_SB(0, 1), b2 + hstep, voffB);
            PG8_WAIT_V(6); PG8_BAR; if constexpr (!HALF_M) PG8_MMA(1, 1, At, B1); PG8_BAR;
            PG8_LDB(B0, 1, 0); PG8_SCHED; PG8_LDA(At, 1, 0); PG8_STAGE(PG8_SA(0, 1), a2 + hstep, voffA);
            PG8_WAIT_L(8); PG8_BAR; PG8_WAIT_L(0); PG8_MMA(0, 0, At, B0); PG8_BAR; PG8_SCHED;
            PG8_LDB(B1, 1, 1); PG8_STAGE(PG8_SB(1, 0), b3, voffB);
            PG8_BAR; PG8_WAIT_L(0); PG8_MMA(0, 1, At, B1); PG8_BAR;
            if constexpr (!HALF_M) PG8_LDA(At, 1, 1);
            PG8_STAGE(PG8_SA(1, 0), a3, voffA);
            PG8_BAR; PG8_WAIT_L(0); if constexpr (!HALF_M) PG8_MMA(1, 0, At, B0); PG8_BAR; PG8_SCHED;
            PG8_STAGE(PG8_SB(1, 1), b3 + hstep, voffB);
            PG8_WAIT_V(6); PG8_BAR; if constexpr (!HALF_M) PG8_MMA(1, 1, At, B1); PG8_BAR;
            }
        }
        if constexpr (ALIGN_EPI) { if (wr == 0) PG8_BAR; }
        E(acc, cur, wr, wc, fr, fq);
        if (!has_next) break;
#pragma unroll
        for (int a = 0; a < 2; ++a)
#pragma unroll
            for (int b = 0; b < 2; ++b)
#pragma unroll
                for (int m = 0; m < 4; ++m)
#pragma unroll
                    for (int n = 0; n < 2; ++n) acc[a][b][m][n] = (f32x4){0.f, 0.f, 0.f, 0.f};
        cur = nxt; cA = nA; cB = nB; ++ui;
        if constexpr (ALIGN_EPI) { if (wr == 1) PG8_BAR; }
    }
    PG8_WAIT_V(0);
    if constexpr (!ALIGN_EPI) { if (wr == 0) PG8_BAR; }
    PG8_BAR;
#undef PG8_SA
#undef PG8_SB
#undef PG8_STAGE
#undef PG8_LDA
#undef PG8_LDB
#undef PG8_MMA
#undef PG8_WAIT_V
#undef PG8_WAIT_L
#undef PG8_BAR
#undef PG8_SCHED
}
}

struct Ctx {
    const float* xp; const float* xs; const float* stC; const float* stN; const float* stM; const float* ssm; const float* conv; const float* ck; const float* cv;
    float* out; unsigned char* ws;
};
#define XWIN ((bf16_t*)(X.ws + WS_WIN))
#define XWOUT ((bf16_t*)(X.ws + WS_WOUT))
#define XXB ((bf16_t*)(X.ws + WS_XB))
#define XU ((bf16_t*)(X.ws + WS_U))
#define XMIX ((bf16_t*)(X.ws + WS_MIX))
#define XSSQ ((float*)(X.ws + WS_SSQ))
#define XROPE ((float*)(X.ws + WS_ROPE))
#define XMC ((float*)(X.ws + WS_MC))
#define XMN ((float*)(X.ws + WS_MN))
#define XML ((float*)(X.ws + WS_ML))
#define XBL ((float*)(X.ws + WS_BL))
#define XMS ((float*)(X.ws + WS_MS))
#define XSA ((float*)(X.ws + WS_SA))
#define XSH ((float*)(X.ws + WS_SH))
#define XCSB ((bf16_t*)(X.ws + WS_CSB))
#define XNS ((float*)(X.ws + WS_NS))
#define XHSB ((bf16_t*)(X.ws + WS_HSB))
#define XPAR(off) ((const float*)(X.ws + WS_PAR) + (off))
constexpr int P_AIB = 0, P_AFB = 16, P_DTB = 32, P_ALOG = 64, P_BD = 96, P_SINK = 128, P_QNW = 160, P_KNW = 416, P_ANW = 672, P_BNW = 2720, P_CB = 4768, P_CW = 8864, P_END = 25248;
#define IN_XP 0
#define IN_XS 1
#define IN_STC 2
#define IN_STN 3
#define IN_STM 4
#define IN_SSM 5
#define IN_CONV 6
#define IN_CK 7
#define IN_CV 8
#define IN_NORMW 9
#define IN_WIN 10
#define IN_AIB 11
#define IN_AFB 12
#define IN_ANW 13
#define IN_CW 14
#define IN_CB 15
#define IN_DTB 16
#define IN_ALOG 17
#define IN_BD 18
#define IN_BNW 19
#define IN_QNW 20
#define IN_KNW 21
#define IN_SINK 22
#define IN_WOUT 23

__device__ __forceinline__ void transpose_strip(lptr lds, const float* src, int ldn, int nvalid, bf16_t* dst, int ldk, const float* scale, int k0, int n0, int tid) {
    LAS float* T = (LAS float*)lds;
    f32x4 v[8];
#pragma unroll
    for (int i = 0; i < 8; ++i) {
        const int f = tid + i * NT, r = f >> 6, c4 = (f & 63) * 4, n = n0 + c4;
        const f32x4 t = __builtin_nontemporal_load((const f32x4*)(src + (size_t)(k0 + r) * ldn + (n < nvalid ? n : 0)));
        const float m = n < nvalid ? (scale ? scale[k0 + r] : 1.f) : 0.f;
        v[i] = t * m;
    }
#pragma unroll
    for (int i = 0; i < 8; ++i) {
        const int f = tid + i * NT, r = f >> 6, c4 = (f & 63) * 4;
        T[r * 257 + c4 + 0] = v[i][0]; T[r * 257 + c4 + 1] = v[i][1]; T[r * 257 + c4 + 2] = v[i][2]; T[r * 257 + c4 + 3] = v[i][3];
    }
    __syncthreads();
#pragma unroll
    for (int i = 0; i < 4; ++i) {
        const int p = tid + i * NT, n = p >> 3, k8 = (p & 7) * 8; float f[8];
#pragma unroll
        for (int jx = 0; jx < 8; ++jx) f[jx] = T[(k8 + jx) * 257 + n];
        *(u32x4*)(dst + (size_t)(n0 + n) * ldk + k0 + k8) = pack8(f);
    }
    __syncthreads();
}

__device__ __forceinline__ void prologue(lptr lds, const Ctx& X, const Args& args, int G, int bid, int tid) {
    const int lane = tid & 63, wave = tid >> 6;
    constexpr int T0 = 1280, T1 = T0 + 384, T2 = T1 + 2080, T3 = T2 + 1, T4 = T3 + 513;
    for (int task = bid; task < T4; task += G) {
        if (task < T0) {
            const int l = task / 320, r = task % 320, kt = r / 20, ntl = r % 20;
            transpose_strip(lds, args.in[IN_WIN] + (size_t)l * D * DIN, DIN, DIN, XWIN + (size_t)l * NIN * D, D, args.in[IN_NORMW] + l * D, kt * 64, ntl * 256, tid);
        } else if (task < T1) {
            const int t = task - T0, l = t / 96, r = t % 96, kt = r / 4, ntl = r % 4;
            transpose_strip(lds, args.in[IN_WOUT] + (size_t)l * DMIX * D, D, D, XWOUT + (size_t)l * D * DMIX, DMIX, nullptr, kt * 64, ntl * 256, tid);
        } else if (task < T2) {
            const int r = (task - T1) * 8 + wave;
            float ss = 0.f;
            if (r < MTOK) {
                const float* src = r < TP ? X.xp + (size_t)r * D : X.xs + (size_t)(r - TP) * D;
#pragma unroll
                for (int i = 0; i < 4; ++i) {
                    const int c = lane * 4 + i * 256; f32x4 v = __builtin_nontemporal_load((const f32x4*)(src + c));
                    ss += v[0] * v[0] + v[1] * v[1] + v[2] * v[2] + v[3] * v[3];
                    u32x2 w; w[0] = pk2(v[0], v[1]); w[1] = pk2(v[2], v[3]);
                    *(u32x2*)(XXB + (size_t)r * D + c) = w;
                }
            } else {
#pragma unroll
                for (int i = 0; i < 4; ++i) { u32x2 w = {0u, 0u}; *(u32x2*)(XXB + (size_t)r * D + lane * 4 + i * 256) = w; }
            }
            ss = wave_sum(ss);
            if (lane < 16) XSSQ[(size_t)r * 16 + lane] = (lane == 0) ? ss : 0.f;
        } else if (task < T3) {
            for (int i = tid; i < (MPAD - MTOK) * DMIX / 2; i += NT) ((unsigned*)(XMIX + (size_t)MTOK * DMIX))[i] = 0u;
            float* P = (float*)(X.ws + WS_PAR);
            const int po[12] = {P_AIB, P_AFB, P_DTB, P_ALOG, P_BD, P_SINK, P_QNW, P_KNW, P_ANW, P_BNW, P_CB, P_CW};
            const int pn[12] = {16, 16, 32, 32, 32, 32, 256, 256, 2048, 2048, 4096, 16384};
            const int pi[12] = {IN_AIB, IN_AFB, IN_DTB, IN_ALOG, IN_BD, IN_SINK, IN_QNW, IN_KNW, IN_ANW, IN_BNW, IN_CB, IN_CW};
#pragma unroll
            for (int a = 0; a < 12; ++a) { const float* src = args.in[pi[a]]; for (int i = tid; i < pn[a]; i += NT) P[po[a] + i] = src[i]; }
        } else {
            const int e = (task - T3) * 512 + tid;
            if (e < 8193 * 32) {
                const int pos = e >> 5, d = e & 31;
                const float inv = (float)exp2(-(double)d * (13.287712379549449 / 32.0));
                const float angf = (float)pos * inv;
                const double a = (double)angf;
                const double k = rint(a * 0.15915494309189535);
                const float rr = (float)(a - k * 6.283185307179586);
                XROPE[(size_t)e * 2] = cosf(rr); XROPE[(size_t)e * 2 + 1] = sinf(rr);
            }
        }
    }
}

__device__ __forceinline__ void conv8(const bf16_t* u, int seq0, int tt, int ch, const float* cw, const float* cb, float (&o)[8]) {
    float acc[8];
    { f32x4 b0 = *(const f32x4*)(cb + ch), b1 = *(const f32x4*)(cb + ch + 4);
#pragma unroll
      for (int j = 0; j < 4; ++j) { acc[j] = b0[j]; acc[4 + j] = b1[j]; } }
#pragma unroll
    for (int jj = 0; jj < 4; ++jj) {
        const int t2 = tt + jj - 3;
        if (t2 >= 0) {
            float x[8]; unpack8(*(const u32x4*)(u + (size_t)(seq0 + t2) * NIN + C_BX + ch), x);
            f32x4 w0 = *(const f32x4*)(cw + jj * 1024 + ch), w1 = *(const f32x4*)(cw + jj * 1024 + ch + 4);
#pragma unroll
            for (int j = 0; j < 4; ++j) { acc[j] += x[j] * w0[j]; acc[4 + j] += x[4 + j] * w1[j]; }
        }
    }
#pragma unroll
    for (int j = 0; j < 8; ++j) o[j] = siluf_(acc[j]);
}


__device__ __forceinline__ void conv8x8(const bf16_t* u, int seq0, int tt0, int ch, const float* cw, const float* cb, float (&o)[8][8]) {
    float w[4][8];
#pragma unroll
    for (int jj = 0; jj < 4; ++jj) { f32x4 w0 = *(const f32x4*)(cw + jj * 1024 + ch), w1 = *(const f32x4*)(cw + jj * 1024 + ch + 4);
#pragma unroll
        for (int j = 0; j < 4; ++j) { w[jj][j] = w0[j]; w[jj][4 + j] = w1[j]; } }
    { f32x4 b0 = *(const f32x4*)(cb + ch), b1 = *(const f32x4*)(cb + ch + 4);
#pragma unroll
      for (int t = 0; t < 8; ++t)
#pragma unroll
          for (int j = 0; j < 4; ++j) { o[t][j] = b0[j]; o[t][4 + j] = b1[j]; } }
    u32x4 raw[11];
#pragma unroll
    for (int r = 0; r < 11; ++r) {
        const int t2 = tt0 + r - 3;
        const u32x4 v = *(const u32x4*)(u + (unsigned)(seq0 + (t2 >= 0 ? t2 : 0)) * NIN + C_BX + ch);
        const unsigned msk = t2 >= 0 ? 0xffffffffu : 0u;
        raw[r] = (u32x4){v[0] & msk, v[1] & msk, v[2] & msk, v[3] & msk};
    }
#pragma unroll
    for (int r = 0; r < 11; ++r) {
        float x[8]; unpack8(raw[r], x);
#pragma unroll
        for (int jj = 0; jj < 4; ++jj) {
            const int t = r - jj;
            if (t >= 0 && t < 8) {
#pragma unroll
                for (int j = 0; j < 8; ++j) o[t][j] += x[j] * w[jj][j];
            }
        }
    }
#pragma unroll
    for (int t = 0; t < 8; ++t)
#pragma unroll
        for (int j = 0; j < 8; ++j) o[t][j] = siluf_(o[t][j]);
}

__device__ __forceinline__ void mlstm_local(lptr lds, const Ctx& X, int l, int task, int tid) {
    const int h = task & 3, c = (task >> 2) & 127, n = task >> 9;
    const int lane = tid & 63, wave = tid >> 6, fr = lane & 15, fq = lane >> 4;
    const int row0 = n * SEQ + c * 64, nh = n * 4 + h;
    lptr VwT = lds;
    lptr KT = lds + 18432;
    LAS float* wv = (LAS float*)(lds + 27648);
    const int tg = lane & 7, cgq = lane >> 3;
    u32x4 blk[8];
    if (wave >= 1 && wave <= 3) {
        const int col = wave < 3 ? C_AV + h * 128 + ((wave - 1) * 8 + cgq) * 8 : C_AK + h * 64 + cgq * 8;
#pragma unroll
        for (int t = 0; t < 8; ++t) blk[t] = *(const u32x4*)(XU + (unsigned)(row0 + 8 * tg + t) * NIN + col);
    }
    if (wave == 0) {
        const bf16_t* ur = XU + (unsigned)(row0 + lane) * NIN;
        const float fg = bf2f(ur[C_AF + h]) + XPAR(P_AFB)[l * 4 + h], ig = bf2f(ur[C_AI + h]) + XPAR(P_AIB)[l * 4 + h];
        const float b = wave_scan_sum(logsigf_(fg), lane);
        const float bl = lane63(b);
        const float g = bl - b + ig;
        const float ml = wave_max(g);
        wv[lane] = __expf(g - ml);
        if (lane == 0) { XML[nh * 128 + c] = ml; XBL[nh * 128 + c] = bl; }
    }
    __syncthreads();
    if (wave >= 1 && wave <= 3) {
        float xs[8][8];
#pragma unroll
        for (int t = 0; t < 8; ++t) { unpack8(blk[t], xs[t]); const float w = wave < 3 ? wv[8 * tg + t] : 0.125f;
#pragma unroll
            for (int j = 0; j < 8; ++j) xs[t][j] *= w; }
        lptr dstT = wave < 3 ? VwT + ((((wave - 1) * 8 + cgq) * 8 * 72) << 1) : KT + ((cgq * 8 * 72) << 1);
#pragma unroll
        for (int j = 0; j < 8; ++j) {
            float v[8];
#pragma unroll
            for (int t = 0; t < 8; ++t) v[t] = xs[t][j];
            *(LAS u32x4*)(dstT + ((j * 72 + 8 * tg) << 1)) = pack8(v);
        }
    }
    __syncthreads();
    {
        bf16_t* dst = (bf16_t*)XMC + ((size_t)nh * 128 + c) * 8192;
        bf16x8 b0 = lds_frag(VwT, 16 * wave + fr, fq * 8, 72), b1 = lds_frag(VwT, 16 * wave + fr, 32 + fq * 8, 72);
#pragma unroll
        for (int mt = 0; mt < 4; ++mt) {
            f32x4 acc = {0.f, 0.f, 0.f, 0.f};
            acc = mfma16(lds_frag(KT, 16 * mt + fr, fq * 8, 72), b0, acc);
            acc = mfma16(lds_frag(KT, 16 * mt + fr, 32 + fq * 8, 72), b1, acc);
            { u32x2 w; w[0] = pk2(acc[0], acc[1]); w[1] = pk2(acc[2], acc[3]); *(u32x2*)(dst + (16 * wave + fr) * 64 + 16 * mt + 4 * fq) = w; }
        }
    }
    if (tid < 64) {
        float s = 0.f;
#pragma unroll
        for (int t8 = 0; t8 < 8; ++t8) {
            float kf[8]; unpack8(*(const LAS u32x4*)(KT + ((tid * 72 + t8 * 8) << 1)), kf);
#pragma unroll
            for (int jx = 0; jx < 8; ++jx) s += kf[jx] * wv[t8 * 8 + jx];
        }
        XMN[((size_t)nh * 128 + c) * 64 + tid] = s;
    }
    __syncthreads();
}

__device__ __forceinline__ void ssd_local(lptr lds, const Ctx& X, int l, int task, int tid) {
    const int g = task & 1, c = (task >> 1) & 127, n = task >> 8;
    const int lane = tid & 63, wave = tid >> 6, fr = lane & 15, fq = lane >> 4;
    const int seq0 = n * SEQ, row0 = seq0 + c * 64;
    lptr XwT = lds;
    lptr BT = lds + 36864;
    LAS float* wl = (LAS float*)(lds + 55296);
    {
        const float* cw = XPAR(P_CW) + l * 4096; const float* cb = XPAR(P_CB) + l * 1024;
        const int tg = lane & 7, cg = wave * 8 + (lane >> 3);
        float o[8][8];
        if (wave < 6) {
            const int ch = cg < 32 ? g * 256 + cg * 8 : 512 + g * 128 + (cg - 32) * 8;
            conv8x8(XU, seq0, c * 64 + 8 * tg, ch, cw, cb, o);
        }
        if (wave < 4) {
            const int hh = 4 * g + wave;
            const float dt = softplusf_(bf2f(XU[(unsigned)(row0 + lane) * NIN + C_BDT + hh]) + XPAR(P_DTB)[l * 8 + hh]);
            const float A = -__expf(XPAR(P_ALOG)[l * 8 + hh]);
            const float a = wave_scan_sum(dt * A, lane);
            const float aL = lane63(a);
            wl[wave * 64 + lane] = __expf(aL - a) * dt;
            if (lane == 0) XSA[(n * 8 + hh) * 128 + c] = aL;
        }
        __syncthreads();
        if (wave < 4) {
            float wt[8];
#pragma unroll
            for (int t = 0; t < 8; ++t) wt[t] = wl[wave * 64 + 8 * tg + t];
#pragma unroll
            for (int jx = 0; jx < 8; ++jx) {
                float v[8];
#pragma unroll
                for (int t = 0; t < 8; ++t) v[t] = o[t][jx] * wt[t];
                *(LAS u32x4*)(XwT + (((cg * 8 + jx) * 72 + 8 * tg) << 1)) = pack8(v);
            }
        } else if (wave < 6) {
#pragma unroll
            for (int jx = 0; jx < 8; ++jx) {
                float v[8];
#pragma unroll
                for (int t = 0; t < 8; ++t) v[t] = o[t][jx];
                *(LAS u32x4*)(BT + ((((cg - 32) * 8 + jx) * 72 + 8 * tg) << 1)) = pack8(v);
            }
        }
    }
    __syncthreads();
    {
        const int hl = wave >> 1, ph = wave & 1, hh = 4 * g + hl;
        bf16_t* dst = (bf16_t*)XSH + ((size_t)(n * 8 + hh) * 128 + c) * 8192;
        bf16x8 bx[2][2];
#pragma unroll
        for (int ntl = 0; ntl < 2; ++ntl)
#pragma unroll
            for (int kk = 0; kk < 2; ++kk) bx[ntl][kk] = lds_frag(XwT, hl * 64 + ph * 32 + ntl * 16 + fr, kk * 32 + fq * 8, 72);
#pragma unroll
        for (int mt = 0; mt < 8; ++mt) {
            bf16x8 a0 = lds_frag(BT, 16 * mt + fr, fq * 8, 72), a1 = lds_frag(BT, 16 * mt + fr, 32 + fq * 8, 72);
#pragma unroll
            for (int ntl = 0; ntl < 2; ++ntl) {
                f32x4 acc = {0.f, 0.f, 0.f, 0.f};
                acc = mfma16(a0, bx[ntl][0], acc); acc = mfma16(a1, bx[ntl][1], acc);
                { u32x2 w; w[0] = pk2(acc[0], acc[1]); w[1] = pk2(acc[2], acc[3]); *(u32x2*)(dst + (ph * 32 + ntl * 16 + fr) * 128 + 16 * mt + 4 * fq) = w; }
            }
        }
    }
    __syncthreads();
}

__device__ __forceinline__ void swa_prompt(lptr lds, const Ctx& X, int l, int task, int tid) {
    const int kvh = task & 1, qb = (task >> 1) & 63, n = task >> 7;
    const int lane = tid & 63, wave = tid >> 6, fr = lane & 15, fq = lane >> 4;
    const int seq0 = n * SEQ;
    lptr Kn = lds;
    lptr Vt = lds + 36864;
    lptr Pw = lds + 70656 + wave * 8448;
    const float* knw = XPAR(P_KNW) + l * 64; const float* qnw = XPAR(P_QNW) + l * 64;
#pragma unroll
    for (int it = 0; it < 2; ++it) {
        const int item = tid + it * NT, j = item >> 2, qd = item & 3, t = qb * 128 - 128 + j;
        float o1[8], o2[8];
        {
            const int tc = t >= 0 ? t : 0;
            const bf16_t* kr = XU + (unsigned)(seq0 + tc) * NIN + C_CK + kvh * 64;
            float x1[8], x2[8]; unpack8(*(const u32x4*)(kr + qd * 8), x1); unpack8(*(const u32x4*)(kr + 32 + qd * 8), x2);
            float ss = 0.f;
#pragma unroll
            for (int jj = 0; jj < 8; ++jj) ss += x1[jj] * x1[jj] + x2[jj] * x2[jj];
            ss += __shfl_xor(ss, 1); ss += __shfl_xor(ss, 2);
            const float rs = rsqrtf(ss * (1.f / 64.f) + EPS);
            const f32x4* cs = (const f32x4*)(XROPE + ((size_t)tc * 32 + qd * 8) * 2);
            f32x4 csv[4];
#pragma unroll
            for (int q4 = 0; q4 < 4; ++q4) csv[q4] = cs[q4];
            const float zm = t >= 0 ? 1.f : 0.f;
#pragma unroll
            for (int jj = 0; jj < 8; ++jj) {
                const float a = x1[jj] * rs * knw[qd * 8 + jj], b = x2[jj] * rs * knw[32 + qd * 8 + jj], co = csv[jj >> 1][(jj & 1) * 2], si = csv[jj >> 1][(jj & 1) * 2 + 1];
                o1[jj] = (a * co - b * si) * zm; o2[jj] = (b * co + a * si) * zm;
            }
        }
        *(LAS u32x4*)(Kn + ((j * 72 + qd * 8) << 1)) = pack8(o1);
        *(LAS u32x4*)(Kn + ((j * 72 + 32 + qd * 8) << 1)) = pack8(o2);
        if (qb == 63 && j >= 128) {
            float* ko = X.out + O_PK + ((((size_t)l * 2 + n) * 128 + (j - 128)) * 2 + kvh) * 64;
            *(f32x4*)(ko + qd * 8) = (f32x4){o1[0], o1[1], o1[2], o1[3]}; *(f32x4*)(ko + qd * 8 + 4) = (f32x4){o1[4], o1[5], o1[6], o1[7]};
            *(f32x4*)(ko + 32 + qd * 8) = (f32x4){o2[0], o2[1], o2[2], o2[3]}; *(f32x4*)(ko + 32 + qd * 8 + 4) = (f32x4){o2[4], o2[5], o2[6], o2[7]};
        }
    }
    if (wave < 4) {
        const int tg = tid & 31, cg = tid >> 5;
        u32x4 vb[8];
#pragma unroll
        for (int t8 = 0; t8 < 8; ++t8) {
            const int jk = 8 * tg + t8, t = qb * 128 - 128 + jk;
            u32x4 w = *(const u32x4*)(XU + (unsigned)(seq0 + (t >= 0 ? t : 0)) * NIN + C_CV + kvh * 64 + cg * 8);
            const unsigned msk = t >= 0 ? 0xffffffffu : 0u;
            vb[t8] = (u32x4){w[0] & msk, w[1] & msk, w[2] & msk, w[3] & msk};
        }
#pragma unroll
        for (int jj = 0; jj < 8; ++jj) {
            u32x4 w;
#pragma unroll
            for (int tp = 0; tp < 4; ++tp) {
                const unsigned lo = (vb[2 * tp][jj >> 1] >> ((jj & 1) * 16)) & 0xffffu, hi = (vb[2 * tp + 1][jj >> 1] >> ((jj & 1) * 16)) & 0xffffu;
                w[tp] = lo | (hi << 16);
            }
            *(LAS u32x4*)(Vt + (((cg * 8 + jj) * 264 + 8 * tg) << 1)) = w;
        }
        if (qb == 63 && tg >= 16) {
#pragma unroll
            for (int t8 = 0; t8 < 8; ++t8) {
                float x[8]; unpack8(vb[t8], x);
                float* vo = X.out + O_PV + ((((size_t)l * 2 + n) * 128 + (8 * tg + t8 - 128)) * 2 + kvh) * 64 + cg * 8;
                *(f32x4*)(vo) = (f32x4){x[0], x[1], x[2], x[3]}; *(f32x4*)(vo + 4) = (f32x4){x[4], x[5], x[6], x[7]};
            }
        }
    }
    __syncthreads();
    const int hq = kvh * 4 + (wave >> 1), i0 = (wave & 1) * 64;
    const float sink = XPAR(P_SINK)[l * 8 + hq];
    float qw1[8], qw2[8];
#pragma unroll
    for (int jj = 0; jj < 8; ++jj) { qw1[jj] = qnw[fq * 8 + jj]; qw2[jj] = qnw[32 + fq * 8 + jj]; }
    u32x4 qn0, qn1; f32x4 csn[4];
    {
        const int t = qb * 128 + i0 + fr;
        const bf16_t* qr = XU + (unsigned)(seq0 + t) * NIN + C_CQ + hq * 64;
        qn0 = *(const u32x4*)(qr + fq * 8); qn1 = *(const u32x4*)(qr + 32 + fq * 8);
        const f32x4* cs = (const f32x4*)(XROPE + ((size_t)t * 32 + fq * 8) * 2);
#pragma unroll
        for (int q4 = 0; q4 < 4; ++q4) csn[q4] = cs[q4];
    }
#pragma unroll 1
    for (int mt = 0; mt < 4; ++mt) {
        const int q0 = i0 + mt * 16;
        const u32x4 q0r = qn0, q1r = qn1; f32x4 csc[4];
#pragma unroll
        for (int q4 = 0; q4 < 4; ++q4) csc[q4] = csn[q4];
        {
            const int mn = mt < 3 ? mt + 1 : 3;
            const int t = qb * 128 + i0 + mn * 16 + fr;
            const bf16_t* qr = XU + (unsigned)(seq0 + t) * NIN + C_CQ + hq * 64;
            qn0 = *(const u32x4*)(qr + fq * 8); qn1 = *(const u32x4*)(qr + 32 + fq * 8);
            const f32x4* cs = (const f32x4*)(XROPE + ((size_t)t * 32 + fq * 8) * 2);
#pragma unroll
            for (int q4 = 0; q4 < 4; ++q4) csn[q4] = cs[q4];
        }
        bf16x8 a0, a1;
        {
            float x1[8], x2[8]; unpack8(q0r, x1); unpack8(q1r, x2);
            float ss = 0.f;
#pragma unroll
            for (int jj = 0; jj < 8; ++jj) ss += x1[jj] * x1[jj] + x2[jj] * x2[jj];
            ss += __shfl_xor(ss, 16); ss += __shfl_xor(ss, 32);
            const float rs = rsqrtf(ss * (1.f / 64.f) + EPS) * 0.125f;
            float o1[8], o2[8];
#pragma unroll
            for (int jj = 0; jj < 8; ++jj) {
                const float a = x1[jj] * rs * qw1[jj], b = x2[jj] * rs * qw2[jj], co = csc[jj >> 1][(jj & 1) * 2], si = csc[jj >> 1][(jj & 1) * 2 + 1];
                o1[jj] = a * co - b * si; o2[jj] = b * co + a * si;
            }
            a0 = as_frag(pack8(o1)); a1 = as_frag(pack8(o2));
        }
        const int tlo = q0 >> 4;
        const int qi = q0 + fr;
        const int dlo = qb > 0 ? 1 : (128 - qi > 1 ? 128 - qi : 1);
        f32x4 s[16];
        float mx = -3.0e38f;
#pragma unroll
        for (int ntl = 0; ntl < 16; ++ntl) {
            if (ntl >= tlo && ntl <= tlo + 8) {
                f32x4 acc = {0.f, 0.f, 0.f, 0.f};
                acc = mfma16(lds_frag(Kn, 16 * ntl + fr, fq * 8, 72), a0, acc);
                acc = mfma16(lds_frag(Kn, 16 * ntl + fr, 32 + fq * 8, 72), a1, acc);
                if (ntl == tlo || ntl == tlo + 8 || qb == 0) {
#pragma unroll
                    for (int ii = 0; ii < 4; ++ii) {
                        const int dk = 16 * ntl + 4 * fq + ii - qi;
                        acc[ii] = ((unsigned)(dk - dlo) <= (unsigned)(128 - dlo)) ? acc[ii] : -3.0e38f;
                    }
                }
                mx = fmaxf(mx, fmaxf(fmaxf(acc[0], acc[1]), fmaxf(acc[2], acc[3])));
                s[ntl] = acc;
            }
        }
        mx = fmaxf(mx, __shfl_xor(mx, 16)); mx = fmaxf(mx, __shfl_xor(mx, 32));
        mx = fmaxf(mx, sink);
        float sum = 0.f;
#pragma unroll
        for (int ntl = 0; ntl < 16; ++ntl) {
            if (ntl >= tlo && ntl <= tlo + 8) {
#pragma unroll
                for (int ii = 0; ii < 4; ++ii) { const float e = __expf(s[ntl][ii] - mx); s[ntl][ii] = e; sum += e; }
            }
        }
        sum += __shfl_xor(sum, 16); sum += __shfl_xor(sum, 32);
        const float inv = rcpf_(sum + __expf(sink - mx));
        const int klo = q0 >> 5, khi = (q0 + 143) >> 5;
#pragma unroll
        for (int ntl = 0; ntl < 16; ++ntl) {
            if (ntl >= tlo && ntl <= tlo + 8) {
                u32x2 w; w[0] = pk2(s[ntl][0] * inv, s[ntl][1] * inv); w[1] = pk2(s[ntl][2] * inv, s[ntl][3] * inv);
                *(LAS u32x2*)(Pw + ((fr * 264 + 16 * ntl + 4 * fq) << 1)) = w;
            } else if ((ntl >> 1) >= klo && (ntl >> 1) <= khi) {
                u32x2 w = {0u, 0u};
                *(LAS u32x2*)(Pw + ((fr * 264 + 16 * ntl + 4 * fq) << 1)) = w;
            }
        }
        u32x2 czv[4];
#pragma unroll
        for (int ntl = 0; ntl < 4; ++ntl) czv[ntl] = *(const u32x2*)(XU + ((unsigned)seq0 + qb * 128 + q0 + fr) * NIN + C_CZ + hq * 64 + 16 * ntl + 4 * fq);
        LDS_FENCE();
        f32x4 o[4];
#pragma unroll
        for (int ntl = 0; ntl < 4; ++ntl) o[ntl] = (f32x4){0.f, 0.f, 0.f, 0.f};
#pragma unroll
        for (int kk = 0; kk < 8; ++kk) {
            if (kk >= klo && kk <= khi) {
                const bf16x8 a = lds_frag(Pw, fr, kk * 32 + fq * 8, 264);
#pragma unroll
                for (int ntl = 0; ntl < 4; ++ntl) o[ntl] = mfma16(lds_frag(Vt, 16 * ntl + fr, kk * 32 + fq * 8, 264), a, o[ntl]);
            }
        }
        LDS_FENCE();
        {
            const unsigned row = (unsigned)seq0 + qb * 128 + q0 + fr;
#pragma unroll
            for (int ntl = 0; ntl < 4; ++ntl) {
                const float z0 = __uint_as_float(czv[ntl][0] << 16), z1 = __uint_as_float(czv[ntl][0] & 0xffff0000u), z2 = __uint_as_float(czv[ntl][1] << 16), z3 = __uint_as_float(czv[ntl][1] & 0xffff0000u);
                u32x2 w; w[0] = pk2(o[ntl][0] * siluf_(z0), o[ntl][1] * siluf_(z1)); w[1] = pk2(o[ntl][2] * siluf_(z2), o[ntl][3] * siluf_(z3));
                *(u32x2*)(XMIX + row * DMIX + 1024 + hq * 64 + 16 * ntl + 4 * fq) = w;
            }
        }
    }
    __syncthreads();
}

__device__ __forceinline__ void sample_task(lptr lds, const Ctx& X, int l, int b, int part, int tid) {
    LAS float* uf = (LAS float*)lds;
    LAS float* xbc = (LAS float*)(lds + 19968);
    LAS float* numv = (LAS float*)(lds + 24064);
    LAS float* yv = (LAS float*)(lds + 26112);
    LAS float* red = (LAS float*)(lds + 28160);
    LAS float* qs = (LAS float*)(lds + 28416);
    LAS float* kn = (LAS float*)(lds + 30464);
    LAS float* sc = (LAS float*)(lds + 30976);
    const int lane = tid & 63, wave = tid >> 6;
    const size_t row = (size_t)TP + b;
    const bf16_t* ur = XU + row * NIN;
    const size_t lb = (size_t)l * 128 + b;
    f32x4 kpre[8], vpre[8];
    if (part == 2) {
        const float* kc = X.ck + lb * 16384; const float* vc = X.cv + lb * 16384;
#pragma unroll
        for (int it = 0; it < 8; ++it) {
            const int e = (tid + it * NT) * 4, e2 = e < 127 * 128 ? e + 128 : e;
            kpre[it] = __builtin_nontemporal_load((const f32x4*)(kc + e2)); vpre[it] = __builtin_nontemporal_load((const f32x4*)(vc + e2));
        }
    }
    {
        const int c_lo = part == 0 ? 0 : (part == 1 ? C_BZ : C_CQ), c_hi = part == 0 ? C_BZ : (part == 1 ? C_CQ : DIN);
#pragma unroll 2
        for (int i = c_lo + tid; i < c_hi; i += NT) uf[i] = bf2f(ur[i]);
    }
    __syncthreads();
    if (part == 0) {
#pragma unroll
    for (int h = 0; h < 4; ++h) {
        const float ig = uf[C_AI + h] + XPAR(P_AIB)[l * 4 + h], fg = uf[C_AF + h] + XPAR(P_AFB)[l * 4 + h];
        const float ls = logsigf_(fg), m0 = X.stM[lb * 4 + h];
        const float mn = fmaxf(ls + m0, ig), sp = __expf(ls + m0 - mn), sl = __expf(ig - mn);
        const float* C0 = X.stC + (lb * 4 + h) * 8192; float* C1 = X.out + O_SC + (lb * 4 + h) * 8192;
#pragma unroll
        for (int it = 0; it < 4; ++it) {
            const int e = (tid + it * NT) * 4, v = e >> 6, k = e & 63;
            const f32x4 c0 = __builtin_nontemporal_load((const f32x4*)(C0 + e));
            const float vv = uf[C_AV + h * 128 + v] * sl;
            f32x4 c1; float part = 0.f;
#pragma unroll
            for (int j = 0; j < 4; ++j) { c1[j] = sp * c0[j] + vv * (uf[C_AK + h * 64 + k + j] * 0.125f); part += c1[j] * uf[C_AQ + h * 64 + k + j]; }
            __builtin_nontemporal_store(c1, (f32x4*)(C1 + e));
            part = red16(part);
            if ((lane & 15) == 0) numv[h * 128 + v] = part;
        }
        if (wave == 0) {
            const float n1 = sp * X.stN[(lb * 4 + h) * 64 + lane] + sl * uf[C_AK + h * 64 + lane] * 0.125f;
            X.out[O_SN + (lb * 4 + h) * 64 + lane] = n1;
            const float dd = wave_sum(n1 * uf[C_AQ + h * 64 + lane]);
            if (lane == 0) { red[h] = dd; red[4 + h] = mn; X.out[O_SM + lb * 4 + h] = mn; }
        }
    }
    __syncthreads();
    float hv;
    { const int h = tid >> 7; hv = numv[tid] * rcpf_(fmaxf(fabsf(red[h]), __expf(-red[4 + h]))); const float ss = wave_sum(hv * hv); if (lane == 0) red[8 + wave] = ss; }
    __syncthreads();
    { const int h = tid >> 7; const float rs = rsqrtf((red[8 + 2 * h] + red[9 + 2 * h]) * (1.f / 128.f) + EPS);
      XMIX[row * DMIX + tid] = (bf16_t)f2bf(hv * rs * XPAR(P_ANW)[l * 512 + tid] * sigmoidf_(uf[C_AO + tid]) * siluf_(uf[C_AZ + tid])); }
    }
    if (part == 1) {
    {
        const float* buf = X.conv + lb * 3 * 1024; float* oc = X.out + O_SCONV + lb * 3 * 1024;
        const float* cw = XPAR(P_CW) + l * 4096;
#pragma unroll
        for (int it = 0; it < 2; ++it) {
            const int ch = tid + it * NT;
            const float f0 = buf[ch], f1 = buf[1024 + ch], f2 = buf[2048 + ch], f3 = uf[C_BX + ch];
            const float acc = XPAR(P_CB)[l * 1024 + ch] + f0 * cw[ch] + f1 * cw[1024 + ch] + f2 * cw[2048 + ch] + f3 * cw[3072 + ch];
            xbc[ch] = siluf_(acc);
            oc[ch] = f1; oc[1024 + ch] = f2; oc[2048 + ch] = f3;
        }
    }
    __syncthreads();
#pragma unroll 4
    for (int hh = 0; hh < 8; ++hh) {
        const float dt = softplusf_(uf[C_BDT + hh] + XPAR(P_DTB)[l * 8 + hh]);
        const float dA = __expf(-dt * __expf(XPAR(P_ALOG)[l * 8 + hh]));
        const int g = hh >> 2;
        const float* h0p = X.ssm + (lb * 8 + hh) * 8192; float* h1p = X.out + O_SH + (lb * 8 + hh) * 8192;
#pragma unroll
        for (int it = 0; it < 4; ++it) {
            const int e = (tid + it * NT) * 4, p = e >> 7, s = e & 127;
            const f32x4 h0 = __builtin_nontemporal_load((const f32x4*)(h0p + e));
            const float xv = xbc[hh * 64 + p] * dt;
            f32x4 h1; float part = 0.f;
#pragma unroll
            for (int j = 0; j < 4; ++j) { h1[j] = dA * h0[j] + xv * xbc[512 + g * 128 + s + j]; part += h1[j] * xbc[768 + g * 128 + s + j]; }
            __builtin_nontemporal_store(h1, (f32x4*)(h1p + e));
            part = red16(part); part += __shfl_xor(part, 16);
            if ((lane & 31) == 0) yv[hh * 64 + p] = part;
        }
    }
    __syncthreads();
    float gb;
    { const int hh = tid >> 6; const float y = yv[tid] + XPAR(P_BD)[l * 8 + hh] * xbc[tid]; gb = y * siluf_(uf[C_BZ + tid]); const float ss = wave_sum(gb * gb); if (lane == 0) red[16 + wave] = ss; }
    __syncthreads();
    { const int g = tid >> 8; const float rs = rsqrtf((red[16 + 4 * g] + red[17 + 4 * g] + red[18 + 4 * g] + red[19 + 4 * g]) * (1.f / 256.f) + EPS);
      XMIX[row * DMIX + 512 + tid] = (bf16_t)f2bf(gb * rs * XPAR(P_BNW)[l * 512 + tid]); }
    }
    if (part == 2) {
    lptr Kl = lds + 36864;
    lptr Vl = lds + 36864 + 34816;
    if (tid < 320) {
        const int vec = tid >> 5, d = tid & 31, base = vec < 8 ? C_CQ + vec * 64 : C_CK + (vec - 8) * 64;
        const float x1 = uf[base + d], x2 = uf[base + 32 + d];
        float ss = x1 * x1 + x2 * x2; ss = red16(ss); ss += __shfl_xor(ss, 16);
        const float rs = rsqrtf(ss * (1.f / 64.f) + EPS);
        const float* w = vec < 8 ? XPAR(P_QNW) + l * 64 : XPAR(P_KNW) + l * 64;
        const float a = x1 * rs * w[d], bb = x2 * rs * w[d + 32];
        const float co = XROPE[((size_t)8192 * 32 + d) * 2], si = XROPE[((size_t)8192 * 32 + d) * 2 + 1];
        const float o1 = a * co - bb * si, o2 = bb * co + a * si;
        if (vec < 8) { qs[vec * 64 + d] = o1 * 0.125f; qs[vec * 64 + 32 + d] = o2 * 0.125f; } else { kn[(vec - 8) * 64 + d] = o1; kn[(vec - 8) * 64 + 32 + d] = o2; }
    }
    __syncthreads();
    {
        float* ko = X.out + O_SK + lb * 16384; float* vo = X.out + O_SV + lb * 16384;
#pragma unroll
        for (int it = 0; it < 8; ++it) {
            const int e = (tid + it * NT) * 4, j = e >> 7, r = e & 127;
            f32x4 kv = kpre[it], vv = vpre[it];
            if (j == 127) { kv = (f32x4){kn[r], kn[r + 1], kn[r + 2], kn[r + 3]}; vv = (f32x4){uf[C_CV + r], uf[C_CV + r + 1], uf[C_CV + r + 2], uf[C_CV + r + 3]}; }
            __builtin_nontemporal_store(kv, (f32x4*)(ko + e)); __builtin_nontemporal_store(vv, (f32x4*)(vo + e));
            u32x2 wk, wv2; wk[0] = pk2(kv[0], kv[1]); wk[1] = pk2(kv[2], kv[3]); wv2[0] = pk2(vv[0], vv[1]); wv2[1] = pk2(vv[2], vv[3]);
            *(LAS u32x2*)(Kl + ((j * 136 + r) << 1)) = wk; *(LAS u32x2*)(Vl + ((j * 136 + r) << 1)) = wv2;
        }
    }
    __syncthreads();
    if (tid < 256) {
        const int kvh = tid >> 7, jj = tid & 127;
        float s0 = 0.f, s1 = 0.f, s2 = 0.f, s3 = 0.f;
#pragma unroll 2
        for (int d8 = 0; d8 < 8; ++d8) {
            float kf[8]; unpack8(*(const LAS u32x4*)(Kl + ((jj * 136 + kvh * 64 + d8 * 8) << 1)), kf);
#pragma unroll
            for (int j = 0; j < 8; ++j) {
                s0 += kf[j] * qs[(kvh * 4 + 0) * 64 + d8 * 8 + j]; s1 += kf[j] * qs[(kvh * 4 + 1) * 64 + d8 * 8 + j];
                s2 += kf[j] * qs[(kvh * 4 + 2) * 64 + d8 * 8 + j]; s3 += kf[j] * qs[(kvh * 4 + 3) * 64 + d8 * 8 + j];
            }
        }
        sc[(kvh * 4 + 0) * 128 + jj] = s0; sc[(kvh * 4 + 1) * 128 + jj] = s1; sc[(kvh * 4 + 2) * 128 + jj] = s2; sc[(kvh * 4 + 3) * 128 + jj] = s3;
    }
    __syncthreads();
    {
        const int hq = wave; const float s0 = sc[hq * 128 + lane], s1 = sc[hq * 128 + 64 + lane], sink = XPAR(P_SINK)[l * 8 + hq];
        const float m = fmaxf(wave_max(fmaxf(s0, s1)), sink);
        const float e0 = __expf(s0 - m), e1 = __expf(s1 - m);
        const float inv = rcpf_(wave_sum(e0 + e1) + __expf(sink - m));
        sc[hq * 128 + lane] = e0 * inv; sc[hq * 128 + 64 + lane] = e1 * inv;
    }
    __syncthreads();
    {
        const int hq = tid >> 6, d = tid & 63, kvh = hq >> 2;
        float o = 0.f;
#pragma unroll 16
        for (int jj = 0; jj < 128; ++jj) o += sc[hq * 128 + jj] * bf2f(*(const LAS bf16_t*)(Vl + ((jj * 136 + kvh * 64 + d) << 1)));
        XMIX[row * DMIX + 1024 + tid] = (bf16_t)f2bf(o * siluf_(uf[C_CZ + tid]));
    }
    }
    __syncthreads();
}

__device__ __forceinline__ void scans(const Ctx& X, int l, int gt, int nthreads) {
    for (int item = gt; item < 98816; item += nthreads) {
        if (item < 32768) {
            const int nh = item >> 12, e = (item & 4095) * 2;
            const bf16_t* base = (const bf16_t*)XMC + (size_t)nh * 128 * 8192 + e;
            const float* ml = XML + nh * 128; const float* bl = XBL + nh * 128;
            float m = 0.f; f32x2 st = {0.f, 0.f};
            for (int c0 = 0; c0 < 128; c0 += 16) {
                f32x2 cl[16];
#pragma unroll
                for (int j = 0; j < 16; ++j) { const unsigned w = *(const unsigned*)(base + (size_t)(c0 + j) * 8192); cl[j] = (f32x2){__uint_as_float(w << 16), __uint_as_float(w & 0xffff0000u)}; }
#pragma unroll
                for (int j = 0; j < 16; ++j) {
                    const float mlj = ml[c0 + j], blj = bl[c0 + j], mn = fmaxf(blj + m, mlj), sp = __expf(blj + m - mn), sl = __expf(mlj - mn);
                    *(unsigned*)(XCSB + ((size_t)nh * 128 + c0 + j) * 8192 + e) = pk2(st[0], st[1]);
                    if (e == 0) XMS[nh * 128 + c0 + j] = m;
                    st = st * sp + cl[j] * sl; m = mn;
                }
            }
            *(f32x2*)(X.out + O_PC + ((size_t)l * 8 + nh) * 8192 + e) = st;
            if (e == 0) X.out[O_PM + l * 8 + nh] = m;
        } else if (item < 98304) {
            const int i1 = item - 32768, nhh = i1 >> 12, e = (i1 & 4095) * 2;
            const bf16_t* base = (const bf16_t*)XSH + (size_t)nhh * 128 * 8192 + e;
            const float* al = XSA + nhh * 128;
            f32x2 st = {0.f, 0.f};
            for (int c0 = 0; c0 < 128; c0 += 16) {
                f32x2 cl[16];
#pragma unroll
                for (int j = 0; j < 16; ++j) { const unsigned w = *(const unsigned*)(base + (size_t)(c0 + j) * 8192); cl[j] = (f32x2){__uint_as_float(w << 16), __uint_as_float(w & 0xffff0000u)}; }
#pragma unroll
                for (int j = 0; j < 16; ++j) {
                    const float dec = __expf(al[c0 + j]);
                    *(unsigned*)(XHSB + ((size_t)nhh * 128 + c0 + j) * 8192 + e) = pk2(st[0], st[1]);
                    st = st * dec + cl[j];
                }
            }
            *(f32x2*)(X.out + O_PH + ((size_t)l * 16 + nhh) * 8192 + e) = st;
        } else {
            const int i2 = item - 98304, nh = i2 >> 6, k = i2 & 63;
            float* base = XMN + (size_t)nh * 128 * 64 + k;
            const float* ml = XML + nh * 128; const float* bl = XBL + nh * 128;
            float m = 0.f, st = 0.f;
            for (int c = 0; c < 128; ++c) {
                const float mlj = ml[c], blj = bl[c], mn = fmaxf(blj + m, mlj), sp = __expf(blj + m - mn), sl = __expf(mlj - mn);
                const float cl = base[c * 64];
                XNS[(size_t)nh * 128 * 64 + c * 64 + k] = st;
                st = st * sp + cl * sl; m = mn;
            }
            X.out[O_PN + ((size_t)l * 8 + nh) * 64 + k] = st;
        }
    }
}

__device__ __forceinline__ void mlstm_out(lptr lds, const Ctx& X, int l, int task, int tid) {
    const int h = task & 3, c = (task >> 2) & 127, n = task >> 9;
    const int lane = tid & 63, wave = tid >> 6, fr = lane & 15, fq = lane >> 4;
    const int row0 = n * SEQ + c * 64, nh = n * 4 + h;
    lptr Qs = lds;
    lptr Ks = lds + 9216;
    lptr Vt = lds + 18432;
    lptr Sb = lds + 36864 + wave * 2304;
    LAS float* bv = (LAS float*)(lds + 55296);
    LAS float* dv = bv + 64;
    LAS float* mtv = bv + 128;
    LAS float* siv = bv + 192;
    LAS float* qnv = bv + 256;
    LAS float* ssqp = bv + 384;
    LAS float* nsv = bv + 512;
    const int mti = wave >> 1, half = wave & 1;
    u32x4 csf[2][4];
    {
        const bf16_t* Cs = XCSB + ((size_t)nh * 128 + c) * 8192;
#pragma unroll
        for (int kk = 0; kk < 2; ++kk)
#pragma unroll
            for (int ntl = 0; ntl < 4; ++ntl) csf[kk][ntl] = *(const u32x4*)(Cs + (64 * half + 16 * ntl + fr) * 64 + kk * 32 + fq * 8);
    }
    unsigned short aov[4][4], azv[4][4]; float anw[4];
#pragma unroll
    for (int ntl = 0; ntl < 4; ++ntl) {
        const int v = h * 128 + 64 * half + 16 * ntl + fr;
        anw[ntl] = XPAR(P_ANW)[l * 512 + v];
#pragma unroll
        for (int ii = 0; ii < 4; ++ii) {
            const unsigned row = (unsigned)row0 + 16 * mti + fq * 4 + ii;
            aov[ntl][ii] = XU[row * NIN + C_AO + v]; azv[ntl][ii] = XU[row * NIN + C_AZ + v];
        }
    }
    u32x4 qraw, kraw, vblk[8];
    const int tgv = lane & 7, cgv = (wave & 1) * 8 + (lane >> 3);
    {
        const int tok = tid >> 3, k8 = (tid & 7) * 8;
        const bf16_t* ur = XU + (unsigned)(row0 + tok) * NIN;
        qraw = *(const u32x4*)(ur + C_AQ + h * 64 + k8); kraw = *(const u32x4*)(ur + C_AK + h * 64 + k8);
        if (wave == 2 || wave == 3) {
#pragma unroll
            for (int t = 0; t < 8; ++t) vblk[t] = *(const u32x4*)(XU + (unsigned)(row0 + 8 * tgv + t) * NIN + C_AV + h * 128 + cgv * 8);
        }
    }
    if (wave == 0) {
        const bf16_t* ur = XU + (unsigned)(row0 + lane) * NIN;
        const float fg = bf2f(ur[C_AF + h]) + XPAR(P_AFB)[l * 4 + h], ig = bf2f(ur[C_AI + h]) + XPAR(P_AIB)[l * 4 + h];
        const float b = wave_scan_sum(logsigf_(fg), lane);
        const float dd = ig - b;
        const float cm = wave_scan_max(dd, lane);
        const float ms = XMS[nh * 128 + c];
        const float mt = b + fmaxf(ms, cm);
        bv[lane] = b; dv[lane] = dd; mtv[lane] = mt; siv[lane] = __expf(b + ms - mt);
        nsv[lane] = XNS[((size_t)nh * 128 + c) * 64 + lane];
    }
    {
        const int tok = tid >> 3, k8 = (tid & 7) * 8;
        *(LAS u32x4*)(Qs + ((tok * 72 + k8) << 1)) = qraw;
        float x[8]; unpack8(kraw, x);
#pragma unroll
        for (int j = 0; j < 8; ++j) x[j] *= 0.125f;
        *(LAS u32x4*)(Ks + ((tok * 72 + k8) << 1)) = pack8(x);
    }
    if (wave == 2 || wave == 3) {
#pragma unroll
        for (int j = 0; j < 8; ++j) {
            u32x4 w;
#pragma unroll
            for (int tp = 0; tp < 4; ++tp) {
                const unsigned lo = (vblk[2 * tp][j >> 1] >> ((j & 1) * 16)) & 0xffffu, hi = (vblk[2 * tp + 1][j >> 1] >> ((j & 1) * 16)) & 0xffffu;
                w[tp] = lo | (hi << 16);
            }
            *(LAS u32x4*)(Vt + (((cgv * 8 + j) * 72 + 8 * tgv) << 1)) = w;
        }
    }
    __syncthreads();
    bf16x8 qa[2];
    qa[0] = lds_frag(Qs, 16 * mti + fr, fq * 8, 72); qa[1] = lds_frag(Qs, 16 * mti + fr, 32 + fq * 8, 72);
    {
        float x0[8], x1[8]; unpack8(__builtin_bit_cast(u32x4, qa[0]), x0); unpack8(__builtin_bit_cast(u32x4, qa[1]), x1);
        float d = 0.f;
#pragma unroll
        for (int j = 0; j < 8; ++j) d += x0[j] * nsv[fq * 8 + j] + x1[j] * nsv[32 + fq * 8 + j];
        d += __shfl_xor(d, 16); d += __shfl_xor(d, 32);
        if (fq == 0) qnv[wave * 16 + fr] = d;
    }
    float rsum[4] = {0.f, 0.f, 0.f, 0.f};
#pragma unroll
    for (int ntl = 0; ntl < 4; ++ntl) {
        f32x4 s = {0.f, 0.f, 0.f, 0.f};
        s = mfma16(qa[0], lds_frag(Ks, 16 * ntl + fr, fq * 8, 72), s);
        s = mfma16(qa[1], lds_frag(Ks, 16 * ntl + fr, 32 + fq * 8, 72), s);
#pragma unroll
        for (int ii = 0; ii < 4; ++ii) {
            const int t = 16 * mti + fq * 4 + ii, sidx = 16 * ntl + fr;
            const float wgt = (sidx <= t) ? __expf(bv[t] + dv[sidx] - mtv[t]) : 0.f;
            const float sv = wgt * s[ii];
            rsum[ii] += sv;
            *(LAS bf16_t*)(Sb + (((fq * 4 + ii) * 72 + sidx) << 1)) = (bf16_t)f2bf(sv);
        }
    }
    LDS_FENCE();
    f32x4 acc[4];
#pragma unroll
    for (int ntl = 0; ntl < 4; ++ntl) acc[ntl] = (f32x4){0.f, 0.f, 0.f, 0.f};
#pragma unroll
    for (int kk = 0; kk < 2; ++kk) {
        const bf16x8 a = lds_frag(Sb, fr, kk * 32 + fq * 8, 72);
#pragma unroll
        for (int ntl = 0; ntl < 4; ++ntl) acc[ntl] = mfma16(a, lds_frag(Vt, 64 * half + 16 * ntl + fr, kk * 32 + fq * 8, 72), acc[ntl]);
    }
    {
        const float sia = siv[16 * mti + fr];
#pragma unroll
        for (int kk = 0; kk < 2; ++kk) {
            float x[8]; unpack8(__builtin_bit_cast(u32x4, qa[kk]), x);
#pragma unroll
            for (int j = 0; j < 8; ++j) x[j] *= sia;
            const bf16x8 a = as_frag(pack8(x));
#pragma unroll
            for (int ntl = 0; ntl < 4; ++ntl) acc[ntl] = mfma16(a, as_frag(csf[kk][ntl]), acc[ntl]);
        }
    }
    float hv[4][4], ssl[4];
#pragma unroll
    for (int ii = 0; ii < 4; ++ii) {
        const int t = 16 * mti + fq * 4 + ii;
        const float den = red16(rsum[ii]) + siv[t] * qnv[wave * 16 + fq * 4 + ii];
        const float inv = rcpf_(fmaxf(fabsf(den), __expf(-mtv[t])));
        float ss = 0.f;
#pragma unroll
        for (int ntl = 0; ntl < 4; ++ntl) { hv[ntl][ii] = acc[ntl][ii] * inv; ss += hv[ntl][ii] * hv[ntl][ii]; }
        ssl[ii] = red16(ss);
        if (fr == 0) ssqp[t * 2 + half] = ssl[ii];
    }
    __syncthreads();
#pragma unroll
    for (int ii = 0; ii < 4; ++ii) {
        const int t = 16 * mti + fq * 4 + ii;
        const float rs = rsqrtf((ssqp[t * 2] + ssqp[t * 2 + 1]) * (1.f / 128.f) + EPS);
        const unsigned row = (unsigned)row0 + t;
#pragma unroll
        for (int ntl = 0; ntl < 4; ++ntl) {
            const int v = h * 128 + 64 * half + 16 * ntl + fr;
            const float ao = bf2f(aov[ntl][ii]), az = bf2f(azv[ntl][ii]);
            XMIX[row * DMIX + v] = (bf16_t)f2bf(hv[ntl][ii] * rs * anw[ntl] * sigmoidf_(ao) * siluf_(az));
        }
    }
    __syncthreads();
}

__device__ __forceinline__ void ssd_out(lptr lds, const Ctx& X, int l, int task, int tid) {
    const int g = task & 1, c = (task >> 1) & 127, n = task >> 8;
    const int lane = tid & 63, wave = tid >> 6, fr = lane & 15, fq = lane >> 4;
    const int seq0 = n * SEQ, row0 = seq0 + c * 64;
    lptr Cm = lds;
    lptr Bm = lds + 17408;
    lptr Xt = lds + 34816;
    LAS float* CBf = (LAS float*)(lds + 71680);
    LAS float* av = (LAS float*)(lds + 89088);
    LAS float* dtv = (LAS float*)(lds + 90112);
    LAS float* ssq = (LAS float*)(lds + 91136);
    const int hl = wave >> 1, th = wave & 1, hh = 4 * g + hl;
    u32x4 hsf[4][4];
    {
        const bf16_t* hs = XHSB + ((size_t)(n * 8 + hh) * 128 + c) * 8192;
#pragma unroll
        for (int kk = 0; kk < 4; ++kk)
#pragma unroll
            for (int ntl = 0; ntl < 4; ++ntl) hsf[kk][ntl] = *(const u32x4*)(hs + (16 * ntl + fr) * 128 + kk * 32 + fq * 8);
    }
    if (wave < 4) {
        const int hh = 4 * g + wave;
        const float dt = softplusf_(bf2f(XU[(unsigned)(row0 + lane) * NIN + C_BDT + hh]) + XPAR(P_DTB)[l * 8 + hh]);
        const float A = -__expf(XPAR(P_ALOG)[l * 8 + hh]);
        av[wave * 64 + lane] = wave_scan_sum(dt * A, lane);
        dtv[wave * 64 + lane] = dt;
    }
    {
        const float* cw = XPAR(P_CW) + l * 4096; const float* cb = XPAR(P_CB) + l * 1024;
        float o[8][8];
        if (wave < 4) {
            const int tg = lane & 7, cg = wave * 8 + (lane >> 3);
            conv8x8(XU, seq0, c * 64 + 8 * tg, g * 256 + cg * 8, cw, cb, o);
#pragma unroll
            for (int jx = 0; jx < 8; ++jx) {
                float v[8];
#pragma unroll
                for (int t = 0; t < 8; ++t) v[t] = o[t][jx];
                *(LAS u32x4*)(Xt + (((cg * 8 + jx) * 72 + 8 * tg) << 1)) = pack8(v);
            }
        } else {
            const int tg = lane >> 3, s8 = ((wave & 1) * 8 + (lane & 7)) * 8;
            conv8x8(XU, seq0, c * 64 + 8 * tg, (wave < 6 ? 512 : 768) + g * 128 + s8, cw, cb, o);
            lptr dstm = wave < 6 ? Bm : Cm;
#pragma unroll
            for (int t = 0; t < 8; ++t) *(LAS u32x4*)(dstm + (((8 * tg + t) * 136 + s8) << 1)) = pack8(o[t]);
        }
    }
    __syncthreads();
    u32x2 bzv[2][4]; f32x4 bnw[4];
#pragma unroll
    for (int ntl = 0; ntl < 4; ++ntl) {
        bnw[ntl] = *(const f32x4*)(XPAR(P_BNW) + l * 512 + hh * 64 + 16 * ntl + 4 * fq);
#pragma unroll
        for (int mi = 0; mi < 2; ++mi) bzv[mi][ntl] = *(const u32x2*)(XU + ((unsigned)row0 + 16 * (2 * th + mi) + fr) * NIN + C_BZ + hh * 64 + 16 * ntl + 4 * fq);
    }
    {
        const int mt = wave >> 1;
#pragma unroll
        for (int q = 0; q < 2; ++q) {
            const int ntl = 2 * (wave & 1) + q;
            f32x4 acc = {0.f, 0.f, 0.f, 0.f};
#pragma unroll
            for (int kk = 0; kk < 4; ++kk) acc = mfma16(lds_frag(Cm, 16 * mt + fr, kk * 32 + fq * 8, 136), lds_frag(Bm, 16 * ntl + fr, kk * 32 + fq * 8, 136), acc);
#pragma unroll
            for (int ii = 0; ii < 4; ++ii) CBf[(16 * mt + fq * 4 + ii) * 68 + 16 * ntl + fr] = acc[ii];
        }
    }
    __syncthreads();
    f32x4 y1[2][4], y2[2][4];
#pragma unroll
    for (int mi = 0; mi < 2; ++mi)
#pragma unroll
        for (int ntl = 0; ntl < 4; ++ntl) { y1[mi][ntl] = (f32x4){0.f, 0.f, 0.f, 0.f}; y2[mi][ntl] = (f32x4){0.f, 0.f, 0.f, 0.f}; }
#pragma unroll
    for (int kk = 0; kk < 2; ++kk) {
        bf16x8 bx[4];
#pragma unroll
        for (int ntl = 0; ntl < 4; ++ntl) bx[ntl] = lds_frag(Xt, hl * 64 + 16 * ntl + fr, kk * 32 + fq * 8, 72);
#pragma unroll
        for (int mi = 0; mi < 2; ++mi) {
            const int t = 16 * (2 * th + mi) + fr, u0 = kk * 32 + fq * 8;
            const float at = av[hl * 64 + t];
            float w[8];
#pragma unroll
            for (int j = 0; j < 8; ++j) {
                const int uu = u0 + j;
                w[j] = (uu <= t) ? CBf[t * 68 + uu] * __expf(at - av[hl * 64 + uu]) * dtv[hl * 64 + uu] : 0.f;
            }
            const bf16x8 a = as_frag(pack8(w));
#pragma unroll
            for (int ntl = 0; ntl < 4; ++ntl) y1[mi][ntl] = mfma16(bx[ntl], a, y1[mi][ntl]);
        }
    }
    {
#pragma unroll
        for (int kk = 0; kk < 4; ++kk) {
            bf16x8 bh[4];
#pragma unroll
            for (int ntl = 0; ntl < 4; ++ntl) bh[ntl] = as_frag(hsf[kk][ntl]);
#pragma unroll
            for (int mi = 0; mi < 2; ++mi) {
                const bf16x8 a = lds_frag(Cm, 16 * (2 * th + mi) + fr, kk * 32 + fq * 8, 136);
#pragma unroll
                for (int ntl = 0; ntl < 4; ++ntl) y2[mi][ntl] = mfma16(bh[ntl], a, y2[mi][ntl]);
            }
        }
    }
    const float Dh = XPAR(P_BD)[l * 8 + hh];
#pragma unroll
    for (int mi = 0; mi < 2; ++mi) {
        const int t = 16 * (2 * th + mi) + fr;
        const float ea = __expf(av[hl * 64 + t]);
        float ss = 0.f;
#pragma unroll
        for (int ntl = 0; ntl < 4; ++ntl) {
            const float z[4] = {__uint_as_float(bzv[mi][ntl][0] << 16), __uint_as_float(bzv[mi][ntl][0] & 0xffff0000u), __uint_as_float(bzv[mi][ntl][1] << 16), __uint_as_float(bzv[mi][ntl][1] & 0xffff0000u)};
#pragma unroll
            for (int ii = 0; ii < 4; ++ii) {
                const int p = 16 * ntl + 4 * fq + ii;
                const float xv = bf2f(*(const LAS bf16_t*)(Xt + (((hl * 64 + p) * 72 + t) << 1)));
                const float y = y1[mi][ntl][ii] + ea * y2[mi][ntl][ii] + Dh * xv;
                const float gbv = y * siluf_(z[ii]);
                y1[mi][ntl][ii] = gbv; ss += gbv * gbv;
            }
        }
        ss += __shfl_xor(ss, 16); ss += __shfl_xor(ss, 32);
        if (fq == 0) ssq[t * 4 + hl] = ss;
    }
    __syncthreads();
#pragma unroll
    for (int mi = 0; mi < 2; ++mi) {
        const int t = 16 * (2 * th + mi) + fr;
        const float rs = rsqrtf((ssq[t * 4] + ssq[t * 4 + 1] + ssq[t * 4 + 2] + ssq[t * 4 + 3]) * (1.f / 256.f) + EPS);
        const unsigned row = (unsigned)row0 + t;
#pragma unroll
        for (int ntl = 0; ntl < 4; ++ntl) {
            u32x2 w; w[0] = pk2(y1[mi][ntl][0] * rs * bnw[ntl][0], y1[mi][ntl][1] * rs * bnw[ntl][1]); w[1] = pk2(y1[mi][ntl][2] * rs * bnw[ntl][2], y1[mi][ntl][3] * rs * bnw[ntl][3]);
            *(u32x2*)(XMIX + row * DMIX + 512 + hh * 64 + 16 * ntl + 4 * fq) = w;
        }
    }
    __syncthreads();
}


#define XB_TMO      128
#define XB_XCNT(j)  (256  + 64 * (j))
#define XB_XSUB(j)  (1280 + 64 * (j))
#define XB_XGEN(j)  (2304 + 64 * (j))
#define XB_TOP      3328
#define XB_TOPGEN   3392
#define XCD_BAR_WORDS 3456
#define XB_SPIN_CAP (1u << 18)
__device__ __forceinline__ unsigned xb_ld(unsigned* p)              { return __hip_atomic_load(p, __ATOMIC_RELAXED, __HIP_MEMORY_SCOPE_AGENT); }
__device__ __forceinline__ unsigned xb_add(unsigned* p, unsigned v) { return __hip_atomic_fetch_add(p, v, __ATOMIC_RELAXED, __HIP_MEMORY_SCOPE_AGENT); }
__device__ __forceinline__ unsigned xb_xcc_id() { return (unsigned)__builtin_amdgcn_s_getreg((3 << 11) | 20) & 0xFu; }
#define XB_SPIN(cond, bar) do { unsigned _sp = 0; while (cond) { __builtin_amdgcn_s_sleep(1); \
    if ((++_sp & 255u) == 0u) { if (xb_ld(&(bar)[XB_TMO])) break; if (_sp > XB_SPIN_CAP) { atomicAdd(&(bar)[XB_TMO], 1u); break; } } } } while (0)
struct XcdBarrier { unsigned* bar; unsigned x; volatile LAS unsigned* st; };
__device__ __forceinline__ XcdBarrier xcd_barrier_post(unsigned* bar, volatile LAS unsigned* st) {
    XcdBarrier b; b.bar = bar; b.x = xb_xcc_id(); b.st = st;
    if (threadIdx.x == 0) (void)xb_add(&bar[XB_XCNT(b.x)], 1u);
    return b;
}
__device__ __forceinline__ void xcd_barrier_complete(unsigned* bar, unsigned x, unsigned& nloc, unsigned& nx) {
    const unsigned G = gridDim.x * gridDim.y * gridDim.z;
    unsigned sum, cnt, mine, sp = 0u;
    for (;;) {
        sum = 0u; cnt = 0u; mine = 0u;
#pragma unroll
        for (unsigned j = 0; j < 16; ++j) { const unsigned c = xb_ld(&bar[XB_XCNT(j)]); sum += c; cnt += (c > 0u) ? 1u : 0u; mine = (j == x) ? c : mine; }
        if (sum == G) break;
        __builtin_amdgcn_s_sleep(1);
        if ((++sp & 255u) == 0u) { if (xb_ld(&bar[XB_TMO])) break; if (sp > XB_SPIN_CAP) { atomicAdd(&bar[XB_TMO], 1u); break; } }
    }
    nloc = mine > 0u ? mine : 1u; nx = cnt > 0u ? cnt : 1u;
}
__device__ __forceinline__ void xcd_barrier(const XcdBarrier& b) {
    asm volatile("s_waitcnt vmcnt(0)" ::: "memory");
    __syncthreads();
    if (threadIdx.x == 0) {
        unsigned* bar = b.bar;
        __builtin_amdgcn_s_waitcnt(0);
        unsigned nloc = b.st[0], nx = b.st[1];
        if (nloc == 0u) { xcd_barrier_complete(bar, b.x, nloc, nx); b.st[0] = nloc; b.st[1] = nx; }
        const unsigned old = xb_add(&bar[XB_XSUB(b.x)], 1u);
        const unsigned gen = old / nloc;
        if (old + 1u == (gen + 1u) * nloc) {
            __builtin_amdgcn_fence(__ATOMIC_RELEASE, "agent");
            asm volatile("s_waitcnt vmcnt(0)" ::: "memory");
            const unsigned og = xb_add(&bar[XB_TOP], 1u);
            const unsigned tg = og / nx;
            if (og + 1u == (tg + 1u) * nx) xb_add(&bar[XB_TOPGEN], 1u);
            else XB_SPIN(xb_ld(&bar[XB_TOPGEN]) == tg, bar);
            __builtin_amdgcn_fence(__ATOMIC_ACQUIRE, "agent");
            xb_add(&bar[XB_XGEN(b.x)], 1u);
            asm volatile("s_waitcnt vmcnt(0)" ::: "memory");
        } else {
            XB_SPIN(xb_ld(&bar[XB_XGEN(b.x)]) == gen, bar);
            __builtin_amdgcn_fence(__ATOMIC_ACQUIRE, "agent");
            asm volatile("s_waitcnt vmcnt(0)" ::: "memory");
        }
    }
    __syncthreads();
}

__global__ void __launch_bounds__(NT, 2) mega(Args args) {
    __shared__ __attribute__((aligned(16))) unsigned char lds_raw[LDS_BYTES];
    lptr lds = (lptr)lds_raw;
    cg::grid_group grid = cg::this_grid();
    const int tid = threadIdx.x, bid = blockIdx.x, G = gridDim.x;
    Ctx X;
    X.xp = args.in[IN_XP]; X.xs = args.in[IN_XS]; X.stC = args.in[IN_STC]; X.stN = args.in[IN_STN]; X.stM = args.in[IN_STM]; X.ssm = args.in[IN_SSM];
    X.conv = args.in[IN_CONV]; X.ck = args.in[IN_CK]; X.cv = args.in[IN_CV]; X.out = args.out; X.ws = args.ws;
    const int lo = args.ph_lo, hi = args.ph_hi;
    volatile LAS unsigned* xst = (volatile LAS unsigned*)(lds + LDS_BYTES - 16);
    if (tid == 0) { xst[0] = 0u; xst[1] = 0u; }
    __syncthreads();
    XcdBarrier xbar = xcd_barrier_post((unsigned*)(args.ws + WS_BAR), xst);
#define IN(k) (lo <= (k) && (k) < hi)
#define SEAM(k) do { if (IN(k) && IN((k) + 1)) { for (int _r = 0; _r < REP_SYNC; ++_r) { if (lo < 0) grid.sync(); xcd_barrier(xbar); } } } while (0)
    if (IN(0)) { for (int _r = 0; _r < REP_P0; ++_r) prologue(lds, X, args, G, bid, tid); }
    SEAM(0);
    for (int l = 0; l < 4; ++l) {
        const int pb = 1 + l * 5;
        if (IN(pb)) for (int _r = 0; _r < REP_P1; ++_r) {
            pg8::Gemm g{XXB, XWIN + (size_t)l * NIN * D, MPAD, NIN, D}; pg8::StaticOrder S; S.init(TP, NIN, G, bid);
            pg8::EpiU E{XU, XSSQ};
            pg8::gemm_phase<pg8::EpiU, pg8::StaticOrder, false, GEMM_SP2, GEMM_ALIGN>(lds, g, S, E, OPQ(tid));
            if (l == 0 && bid >= G - 20) {
                pg8::SampleOrder S2{G - 20, 20, bid}; pg8::EpiUh E2{XU, XSSQ};
                pg8::gemm_phase<pg8::EpiUh, pg8::SampleOrder, true>(lds, g, S2, E2, OPQ(tid));
            }
        }
        SEAM(pb);
        if (IN(pb + 1)) for (int _r = 0; _r < REP_P2; ++_r) {
            for (int t = bid; t < 256; t += G) for (int _q = 0; _q < RT_SWA; ++_q) swa_prompt(lds, X, l, t, OPQ(tid));
            for (int t = bid; t < 256; t += G) for (int _q = 0; _q < RT_SAMPLE; ++_q) {
                if (t < 128) sample_task(lds, X, l, t, 1, OPQ(tid));
                else { sample_task(lds, X, l, t - 128, 0, OPQ(tid)); sample_task(lds, X, l, t - 128, 2, OPQ(tid)); }
            }
            for (int t = bid; t < 512; t += G) for (int _q = 0; _q < RT_SLOC; ++_q) ssd_local(lds, X, l, t, OPQ(tid));
            for (int t = bid; t < 1024; t += G) for (int _q = 0; _q < RT_MLOC; ++_q) mlstm_local(lds, X, l, t, OPQ(tid));
            if (bid == G - 1) {
                for (int i = tid; i < 2 * 3 * 1024; i += NT) {
                    const int ch = i & 1023, j = (i >> 10) % 3, n = i / 3072;
                    X.out[O_PCONV + (((size_t)l * 2 + n) * 3 + j) * 1024 + ch] = bf2f(XU[(size_t)(n * SEQ + SEQ - 3 + j) * NIN + C_BX + ch]);
                }
            }
        }
        SEAM(pb + 1);
        if (IN(pb + 2)) {
            if (bid >= G - 4) {
                pg8::Gemm g{XMIX, XWOUT + (size_t)l * D * DMIX, MPAD, D, DMIX}; pg8::SampleOrder S{G - 4, 4, bid};
                if (l == 0) { pg8::EpiRes_<1, 0> E{X.xp, X.xs, X.out, XXB, XSSQ}; pg8::gemm_phase<pg8::EpiRes_<1, 0>, pg8::SampleOrder, true>(lds, g, S, E, OPQ(tid)); }
                else if (l < 3) { pg8::EpiRes_<1, 1> E{X.xp, X.xs, X.out, XXB, XSSQ}; pg8::gemm_phase<pg8::EpiRes_<1, 1>, pg8::SampleOrder, true>(lds, g, S, E, OPQ(tid)); }
                else { pg8::EpiRes_<1, 2> E{X.xp, X.xs, X.out, XXB, XSSQ}; pg8::gemm_phase<pg8::EpiRes_<1, 2>, pg8::SampleOrder, true>(lds, g, S, E, OPQ(tid)); }
            }
            for (int _r = 0; _r < REP_P3; ++_r) scans(X, l, bid * NT + OPQ(tid), G * NT);
        }
        SEAM(pb + 2);
        if (IN(pb + 3)) for (int _r = 0; _r < REP_P4; ++_r) {
            for (int task = bid; task < 1536; task += G) {
                if (task < 512) for (int _q = 0; _q < RT_SOUT; ++_q) ssd_out(lds, X, l, task, OPQ(tid));
                else mlstm_out(lds, X, l, task - 512, OPQ(tid));
            }
        }
        SEAM(pb + 3);
        if (IN(pb + 4)) {
            {
                pg8::Gemm g{XMIX, XWOUT + (size_t)l * D * DMIX, MPAD, D, DMIX}; pg8::StaticOrder S; S.init(TP, D, G, bid);
#ifdef PROBE_P5
                { pg8::EpiProbe EP{(const unsigned*)(X.ws + 64), XSSQ}; pg8::gemm_phase<pg8::EpiProbe, pg8::StaticOrder, false, GEMM_SP2>(lds, g, S, EP, OPQ(tid)); }
#endif
                if (l == 0) { pg8::EpiRes_<2, 0> E{X.xp, X.xs, X.out, XXB, XSSQ}; pg8::gemm_phase<pg8::EpiRes_<2, 0>, pg8::StaticOrder, false, GEMM_SP2, GEMM_ALIGN>(lds, g, S, E, OPQ(tid)); }
                else if (l < 3) { pg8::EpiRes_<2, 1> E{X.xp, X.xs, X.out, XXB, XSSQ}; pg8::gemm_phase<pg8::EpiRes_<2, 1>, pg8::StaticOrder, false, GEMM_SP2, GEMM_ALIGN>(lds, g, S, E, OPQ(tid)); }
                else { pg8::EpiRes_<2, 2> E{X.xp, X.xs, X.out, XXB, XSSQ}; pg8::gemm_phase<pg8::EpiRes_<2, 2>, pg8::StaticOrder, false, GEMM_SP2, GEMM_ALIGN>(lds, g, S, E, OPQ(tid)); }
            }
            if (l < 3 && bid < 20) {
                pg8::Gemm g{XXB, XWIN + (size_t)(l + 1) * NIN * D, MPAD, NIN, D}; pg8::SampleOrder S{0, 20, bid};
                pg8::EpiUh E{XU, XSSQ};
                pg8::gemm_phase<pg8::EpiUh, pg8::SampleOrder, true>(lds, g, S, E, OPQ(tid));
            }
        }
        SEAM(pb + 4);
    }
#undef IN
#undef SEAM
}

extern "C" void kernel_launch(void* const* d_in, const int* in_sizes, int n_in, void* d_out, int out_size, void* d_ws, size_t ws_size, hipStream_t stream) {
    static int grid_blocks = 0;
    if (!grid_blocks) {
        int dev = 0, cus = 0, per_cu = 0;
        hipGetDevice(&dev);
        hipDeviceGetAttribute(&cus, hipDeviceAttributeMultiprocessorCount, dev);
        hipOccupancyMaxActiveBlocksPerMultiprocessor(&per_cu, mega, NT, 0);
        if (per_cu < 1) { fprintf(stderr, "occupancy query returned %d\n", per_cu); per_cu = 1; }
        grid_blocks = cus * 1;
        if (ws_size < WS_END) fprintf(stderr, "workspace too small: %zu < %zu\n", ws_size, (size_t)WS_END);
    }
    (void)hipMemsetAsync(d_ws, 0, 16384, stream);
    Args a{};
    for (int i = 0; i < 24; ++i) a.in[i] = (const float*)d_in[i];
    a.out = (float*)d_out; a.ws = (unsigned char*)d_ws;
    const int NPH = 21;
#if MULTI_LAUNCH
    for (int p = 0; p < NPH; ++p) {
        a.ph_lo = p; a.ph_hi = p + 1;
        void* kargs[] = {&a};
        hipError_t e = hipLaunchCooperativeKernel((void*)mega, dim3(grid_blocks), dim3(NT), kargs, 0, stream);
        if (e != hipSuccess) fprintf(stderr, "cooperative launch failed: %s (grid %d)\n", hipGetErrorString(e), grid_blocks);
    }
#else
    a.ph_lo = 0; a.ph_hi = NPH;
    void* kargs[] = {&a};
    hipError_t e = hipLaunchCooperativeKernel((void*)mega, dim3(grid_blocks), dim3(NT), kargs, 0, stream);
    if (e != hipSuccess) fprintf(stderr, "cooperative launch failed: %s (grid %d)\n", hipGetErrorString(e), grid_blocks);
#endif
}
```

```cpp
#include <hip/hip_runtime.h>
#include <hip/hip_cooperative_groups.h>
#include <cstdio>
#include <cstdint>
namespace cg = cooperative_groups;

#ifndef REP_SYNC
#define REP_SYNC 1
#endif
#ifndef REP_P1
#define REP_P1 1
#endif
#ifndef REP_P2
#define REP_P2 1
#endif
#ifndef REP_P3
#define REP_P3 1
#endif
#ifndef REP_P0
#define REP_P0 1
#endif
#ifndef REP_P4
#define REP_P4 1
#endif
#ifndef RT_SAMPLE
#define RT_SAMPLE 1
#endif
#ifndef RT_SWA
#define RT_SWA 1
#endif
#ifndef RT_SLOC
#define RT_SLOC 1
#endif
#ifndef RT_MLOC
#define RT_MLOC 1
#endif
#ifndef RT_SOUT
#define RT_SOUT 1
#endif
#ifndef GEMM_SP2
#define GEMM_SP2 true
#endif
#ifndef GEMM_ALIGN
#define GEMM_ALIGN true
#endif
#ifndef MULTI_LAUNCH
#define MULTI_LAUNCH 0
#endif

#define LAS __attribute__((address_space(3)))
typedef unsigned short bf16_t;
typedef short bf16x8 __attribute__((ext_vector_type(8)));
typedef float f32x4 __attribute__((ext_vector_type(4)));
typedef float f32x2 __attribute__((ext_vector_type(2)));
typedef unsigned u32x4 __attribute__((ext_vector_type(4)));
typedef unsigned u32x2 __attribute__((ext_vector_type(2)));
typedef __bf16 bf16x2_t __attribute__((ext_vector_type(2)));
typedef LAS unsigned char* lptr;

constexpr int D = 1024, DIN = 4880, NIN = 5120, DMIX = 1536, TP = 16384, MTOK = 16512, MPAD = 16640, SEQ = 8192;
constexpr int C_AQ = 0, C_AK = 256, C_AV = 512, C_AO = 1024, C_AZ = 1536, C_AI = 2048, C_AF = 2052, C_BZ = 2056, C_BX = 2568, C_BB = 3080, C_BC = 3336,
              C_BDT = 3592, C_CQ = 3600, C_CK = 4112, C_CV = 4240, C_CZ = 4368;
constexpr float EPS = 1e-6f;
constexpr size_t O_YP = 0, O_YS = 16777216, O_PC = 16908288, O_PN = 17170432, O_PM = 17172480, O_PH = 17172512, O_PCONV = 17696800, O_PK = 17721376,
                 O_PV = 17852448, O_SC = 17983520, O_SN = 34760736, O_SM = 34891808, O_SH = 34893856, O_SCONV = 68448288, O_SK = 70021152, O_SV = 78409760;
constexpr size_t WS_BAR = 0;
constexpr size_t WS_PAR = 16384;
constexpr size_t WS_WIN = WS_PAR + 102400;
constexpr size_t WS_WOUT = WS_WIN + (size_t)4 * NIN * D * 2;
constexpr size_t WS_XB = WS_WOUT + (size_t)4 * D * DMIX * 2;
constexpr size_t WS_U = WS_XB + (size_t)MPAD * D * 2;
constexpr size_t WS_MIX = WS_U + (size_t)MPAD * NIN * 2;
constexpr size_t WS_SSQ = WS_MIX + (size_t)MPAD * DMIX * 2;
constexpr size_t WS_ROPE = WS_SSQ + (size_t)MPAD * 16 * 4;
constexpr size_t WS_MC = WS_ROPE + (size_t)8200 * 64 * 4;
constexpr size_t WS_MN = WS_MC + (size_t)8 * 128 * 8192 * 4;
constexpr size_t WS_ML = WS_MN + (size_t)8 * 128 * 64 * 4;
constexpr size_t WS_BL = WS_ML + 4096;
constexpr size_t WS_MS = WS_BL + 4096;
constexpr size_t WS_SA = WS_MS + 4096;
constexpr size_t WS_SH = WS_SA + 8192;
constexpr size_t WS_CSB = WS_SH + (size_t)16 * 128 * 8192 * 4;
constexpr size_t WS_HSB = WS_CSB + (size_t)8 * 128 * 8192 * 2;
constexpr size_t WS_NS = WS_HSB + (size_t)16 * 128 * 8192 * 2;
constexpr size_t WS_END = WS_NS + (size_t)8 * 128 * 64 * 4;
constexpr int LDS_BYTES = 139264;
constexpr int NT = 512;

struct Args { const float* in[24]; float* out; unsigned char* ws; int ph_lo, ph_hi; };

__device__ __forceinline__ float bf2f(unsigned v) { return __uint_as_float(v << 16); }
__device__ __forceinline__ unsigned pk2(float lo, float hi) { f32x2 v = {lo, hi}; bf16x2_t b = __builtin_convertvector(v, bf16x2_t); return __builtin_bit_cast(unsigned, b); }
__device__ __forceinline__ unsigned f2bf(float f) { return pk2(f, 0.f) & 0xffffu; }
__device__ __forceinline__ void unpack8(u32x4 w, float (&f)[8]) {
#pragma unroll
    for (int i = 0; i < 4; ++i) { f[2 * i] = __uint_as_float(w[i] << 16); f[2 * i + 1] = __uint_as_float(w[i] & 0xffff0000u); }
}
__device__ __forceinline__ u32x4 pack8(const float (&f)[8]) { u32x4 w; w[0] = pk2(f[0], f[1]); w[1] = pk2(f[2], f[3]); w[2] = pk2(f[4], f[5]); w[3] = pk2(f[6], f[7]); return w; }
__device__ __forceinline__ u32x4 pack8v(f32x4 a, f32x4 b) { u32x4 w; w[0] = pk2(a[0], a[1]); w[1] = pk2(a[2], a[3]); w[2] = pk2(b[0], b[1]); w[3] = pk2(b[2], b[3]); return w; }
__device__ __forceinline__ bf16x8 as_frag(u32x4 w) { return __builtin_bit_cast(bf16x8, w); }
__device__ __forceinline__ bf16x8 ldg_f32_frag(const float* p) { f32x4 a = *(const f32x4*)p, b = *(const f32x4*)(p + 4); return as_frag(pack8v(a, b)); }
__device__ __forceinline__ bf16x8 lds_frag(lptr base, int row, int k, int stride) { return *(const LAS bf16x8*)(base + ((row * stride + k) << 1)); }
__device__ __forceinline__ f32x4 mfma16(bf16x8 a, bf16x8 b, f32x4 c) { return __builtin_amdgcn_mfma_f32_16x16x32_bf16(a, b, c, 0, 0, 0); }
__device__ __forceinline__ float rcpf_(float x) { return __builtin_amdgcn_rcpf(x); }
__device__ __forceinline__ float sigmoidf_(float x) { return rcpf_(1.f + __expf(-x)); }
__device__ __forceinline__ float siluf_(float x) { return x * rcpf_(1.f + __expf(-x)); }
__device__ __forceinline__ float softplusf_(float x) { return x > 20.f ? x : log1pf(__expf(x)); }
__device__ __forceinline__ float logsigf_(float x) { return fminf(x, 0.f) - log1pf(__expf(-fabsf(x))); }
template <int CTRL, int RM> __device__ __forceinline__ float dpps(float ident, float v) { return __int_as_float(__builtin_amdgcn_update_dpp(__float_as_int(ident), __float_as_int(v), CTRL, RM, 0xf, false)); }
__device__ __forceinline__ float wave_scan_sum(float v, int) {
    v += dpps<0x111, 0xf>(0.f, v); v += dpps<0x112, 0xf>(0.f, v); v += dpps<0x114, 0xf>(0.f, v); v += dpps<0x118, 0xf>(0.f, v);
    v += dpps<0x142, 0xa>(0.f, v); v += dpps<0x143, 0xc>(0.f, v);
    return v;
}
__device__ __forceinline__ float wave_scan_max(float v, int) {
    const float NI = -3.0e38f;
    v = fmaxf(v, dpps<0x111, 0xf>(NI, v)); v = fmaxf(v, dpps<0x112, 0xf>(NI, v)); v = fmaxf(v, dpps<0x114, 0xf>(NI, v)); v = fmaxf(v, dpps<0x118, 0xf>(NI, v));
    v = fmaxf(v, dpps<0x142, 0xa>(NI, v)); v = fmaxf(v, dpps<0x143, 0xc>(NI, v));
    return v;
}
__device__ __forceinline__ float lane63(float v) { return __int_as_float(__builtin_amdgcn_readlane(__float_as_int(v), 63)); }
__device__ __forceinline__ float red16(float v);
__device__ __forceinline__ float red16max(float v);
__device__ __forceinline__ float wave_sum(float v) { v = red16(v); v += __shfl_xor(v, 16); v += __shfl_xor(v, 32); return v; }
__device__ __forceinline__ float wave_max(float v) { v = red16max(v); v = fmaxf(v, __shfl_xor(v, 16)); v = fmaxf(v, __shfl_xor(v, 32)); return v; }
template <int CTRL> __device__ __forceinline__ float dppf(float v) { return __int_as_float(__builtin_amdgcn_update_dpp(0, __float_as_int(v), CTRL, 0xf, 0xf, true)); }
__device__ __forceinline__ float red16(float v) { v += dppf<0xB1>(v); v += dppf<0x4E>(v); v += dppf<0x141>(v); v += dppf<0x140>(v); return v; }
__device__ __forceinline__ float red16max(float v) { v = fmaxf(v, dppf<0xB1>(v)); v = fmaxf(v, dppf<0x4E>(v)); v = fmaxf(v, dppf<0x141>(v)); v = fmaxf(v, dppf<0x140>(v)); return v; }
__device__ __forceinline__ int OPQ(int v) { asm volatile("" : "+v"(v)); return v; }
#define LDS_FENCE() asm volatile("s_waitcnt lgkmcnt(0)" ::: "memory")

namespace pg8 {
constexpr int BM = 256, BK = 64, HALF = 128, HTB = HALF * BK * 2, STAGE_BYTES = 8 * HTB, NXCD = 8, WGM = 8;
__host__ __device__ __forceinline__ int lds_byte(int r, int c) { const int st = (r >> 4) * 2 + (c >> 5), rr = r & 15, cc = c & 31, ob = rr * 64 + cc * 2; return st * 1024 + (ob ^ (((ob >> 9) & 1) << 5)); }
__host__ __device__ __forceinline__ void stage_rc(int b, int& R, int& C) { const int st = b / 1024, sb = b % 1024, swz = sb ^ (((sb >> 9) & 1) << 5); R = (st >> 1) * 16 + swz / 64; C = (st & 1) * 32 + (swz % 64) / 2; }
__host__ __device__ __forceinline__ int perm32(int rho) { const int n = rho >> 4, i = rho & 15; return 8 * (i >> 2) + 4 * n + (i & 3); }
struct Unit { int pm, pn; };
struct Gemm { const bf16_t* A; const bf16_t* Bt; int M, N, K; };
struct StaticOrder {
    int nM, nN, nwg, G, c;
    __device__ void init(int M, int N, int G_, int c_) { nM = M / BM; nN = N / BM; nwg = nM * nN; G = G_; c = c_; }
    __device__ bool next(int i, Unit& u) const {
        const long L = (long)i * G + c; if (L >= nwg) return false;
        int wgid = (int)L; { const int q = nwg / NXCD, r = nwg % NXCD, xcd = wgid % NXCD, off = wgid / NXCD; wgid = (xcd < r ? xcd * (q + 1) : r * (q + 1) + (xcd - r) * q) + off; }
        const int nig = WGM * nN, gid = wgid / nig, fm = gid * WGM, gsz = (nM - fm) < WGM ? (nM - fm) : WGM;
        u.pm = fm + ((wgid % nig) % gsz); u.pn = (wgid % nig) / gsz; return true;
    }
};
template <int NAI> struct EpiU_ {
    bf16_t* U; const float* ssq;
    __device__ __forceinline__ void operator()(const f32x4 (&acc)[2][2][4][2], const Unit& u, int wr, int wc, int fr, int fq) const {
        const int row0 = u.pm * BM + wr * 64 + fr, col0 = u.pn * BM + wc * 32 + 8 * fq;
#pragma unroll
        for (int ai = 0; ai < NAI; ++ai)
#pragma unroll
            for (int m = 0; m < 4; ++m) {
                const int r = row0 + ai * HALF + m * 16;
                const f32x4 s = *(const f32x4*)(ssq + (size_t)r * 16 + fq * 4);
                float st = s[0] + s[1] + s[2] + s[3]; st += __shfl_xor(st, 16); st += __shfl_xor(st, 32);
                const float rs = rsqrtf(st * (1.f / 1024.f) + EPS);
                bf16_t* rowp = U + (size_t)r * NIN + col0;
#pragma unroll
                for (int bj = 0; bj < 2; ++bj) *(u32x4*)(rowp + bj * HALF) = pack8v(acc[ai][bj][m][0] * rs, acc[ai][bj][m][1] * rs);
                __builtin_amdgcn_sched_barrier(0);
            }
    }
};
template <int NAI, int MODE> struct EpiRes_ {
    const float* xp; const float* xs; float* out; bf16_t* xb; float* ssq;
    __device__ __forceinline__ void operator()(const f32x4 (&acc)[2][2][4][2], const Unit& u, int wr, int wc, int fr, int fq) const {
        const int row0 = u.pm * BM + wr * 64 + fr, col0 = u.pn * BM + wc * 32 + 8 * fq;
#pragma unroll
        for (int ai = 0; ai < NAI; ++ai)
#pragma unroll
            for (int m = 0; m < 4; ++m) {
                const int r = row0 + ai * HALF + m * 16;
                const bool valid = r < MTOK;
                float part = 0.f;
#pragma unroll
                for (int bj = 0; bj < 2; ++bj) {
                    const int c = col0 + bj * HALF;
                    f32x4 o0 = {0.f, 0.f, 0.f, 0.f}, o1 = {0.f, 0.f, 0.f, 0.f};
                    if (MODE == 0) {
                        const float* src = r < TP ? xp + (size_t)r * D : xs + (size_t)(r - TP) * D;
                        if (valid) { o0 = __builtin_nontemporal_load((const f32x4*)(src + c)); o1 = __builtin_nontemporal_load((const f32x4*)(src + c + 4)); }
                    } else {
                        float f[8]; unpack8(*(const u32x4*)(xb + (size_t)r * D + c), f);
                        o0 = (f32x4){f[0], f[1], f[2], f[3]}; o1 = (f32x4){f[4], f[5], f[6], f[7]};
                    }
                    const f32x4 v0 = acc[ai][bj][m][0] + o0, v1 = acc[ai][bj][m][1] + o1;
                    if (MODE == 2) {
                        if (valid) { __builtin_nontemporal_store(v0, (f32x4*)(out + (size_t)r * D + c)); __builtin_nontemporal_store(v1, (f32x4*)(out + (size_t)r * D + c + 4)); }
                    } else {
                        *(u32x4*)(xb + (size_t)r * D + c) = pack8v(v0, v1);
                        part += v0[0] * v0[0] + v0[1] * v0[1] + v0[2] * v0[2] + v0[3] * v0[3] + v1[0] * v1[0] + v1[1] * v1[1] + v1[2] * v1[2] + v1[3] * v1[3];
                    }
                }
                if (MODE != 2) {
                    part += __shfl_xor(part, 16); part += __shfl_xor(part, 32);
                    if (fq == 0) ssq[(size_t)r * 16 + u.pn * 4 + wc] = part;
                }
                __builtin_amdgcn_sched_barrier(0);
            }
    }
};

typedef EpiU_<2> EpiU; typedef EpiU_<1> EpiUh;
struct EpiProbe {
    const unsigned* flag; float* dst;
    __device__ __forceinline__ void operator()(const f32x4 (&acc)[2][2][4][2], const Unit& u, int wr, int wc, int fr, int fq) const {
        if (__hip_atomic_load(flag, __ATOMIC_RELAXED, __HIP_MEMORY_SCOPE_AGENT) == 12345u) {
            f32x4 t = {0.f, 0.f, 0.f, 0.f};
#pragma unroll
            for (int a = 0; a < 2; ++a)
#pragma unroll
                for (int b = 0; b < 2; ++b)
#pragma unroll
                    for (int m = 0; m < 4; ++m)
#pragma unroll
                        for (int n = 0; n < 2; ++n) t += acc[a][b][m][n];
            *(f32x4*)(dst + (size_t)(u.pm * 4 + u.pn) * 2048 + (wr * 4 + wc) * 256 + (fq * 16 + fr) * 4) = t;
        }
    }
};
struct SampleOrder {
    int first, cnt, c;
    __device__ bool next(int i, Unit& u) const { if (i != 0 || c < first || c >= first + cnt) return false; u.pm = 64; u.pn = c - first; return true; }
};
template <class Epi, class Sched, bool HALF_M = false, bool SP2 = false, bool ALIGN_EPI = false>
__device__ __forceinline__ void gemm_phase(lptr lds, const Gemm g, const Sched& S, const Epi& E, const int tid) {
    const int wid = __builtin_amdgcn_readfirstlane(tid >> 6), lane = tid & 63, wr = wid >> 2, wc = wid & 3, fr = lane & 15, fq = lane >> 4;
    const int K = g.K, nt = K / BK;
    unsigned voffA[2], voffB[2];
#pragma unroll
    for (int i = 0; i < 2; ++i) { int R, C; stage_rc(tid * 16 + i * 8192, R, C); const int Rb = (R & ~31) + perm32(R & 31);
        voffA[i] = (unsigned)(R * K + C) * 2u; voffB[i] = (unsigned)(Rb * K + C) * 2u; }
    const size_t kstep = (size_t)(BK * 2);
    const size_t hstep = (size_t)HALF * K * 2;
    const size_t tstep = 2 * hstep;
    const unsigned ldsw = (unsigned)wid * 1024u;
    const int aoff = lds_byte(wr * 64 + fr, fq * 8), boff = lds_byte(wc * 32 + fr, fq * 8);
#define PG8_SA(b, h) (((b) * 2 + (h)) * HTB)
#define PG8_SB(b, h) ((4 + (b) * 2 + (h)) * HTB)
#define PG8_STAGE(bufoff, gbase, voff) do { _Pragma("unroll") for (int _i = 0; _i < 2; ++_i) \
        __builtin_amdgcn_global_load_lds((const unsigned*)((const char*)(gbase) + (voff)[_i]), (LAS unsigned*)(lds + (bufoff) + ldsw + _i * 8192), 16, 0, 0); } while (0)
#define PG8_LDA(dst, b, h) do { _Pragma("unroll") for (int m = 0; m < 4; ++m) _Pragma("unroll") for (int k = 0; k < 2; ++k) dst[m][k] = *(const LAS bf16x8*)(lds + PG8_SA(b, h) + aoff + m * 2048 + k * 1024); } while (0)
#define PG8_LDB(dst, b, h) do { _Pragma("unroll") for (int n = 0; n < 2; ++n) _Pragma("unroll") for (int k = 0; k < 2; ++k) dst[n][k] = *(const LAS bf16x8*)(lds + PG8_SB(b, h) + boff + n * 2048 + k * 1024); } while (0)
#define PG8_MMA(ai, bj, At, Bt) do { __builtin_amdgcn_s_setprio(1); _Pragma("unroll") for (int m = 0; m < 4; ++m) _Pragma("unroll") for (int n = 0; n < 2; ++n) _Pragma("unroll") for (int k = 0; k < 2; ++k) \
        acc[ai][bj][m][n] = __builtin_amdgcn_mfma_f32_16x16x32_bf16(Bt[n][k], At[m][k], acc[ai][bj][m][n], 0, 0, 0); __builtin_amdgcn_s_setprio(0); } while (0)
#define PG8_WAIT_V(n) asm volatile("s_waitcnt vmcnt(" #n ")" ::: "memory")
#define PG8_WAIT_L(n) asm volatile("s_waitcnt lgkmcnt(" #n ")" ::: "memory")
#define PG8_BAR __builtin_amdgcn_s_barrier()
#define PG8_SCHED __builtin_amdgcn_sched_barrier(0)
    Unit cur, nxt; int ui = 0;
    if (!S.next(0, cur)) return;
    f32x4 acc[2][2][4][2];
#pragma unroll
    for (int a = 0; a < 2; ++a)
#pragma unroll
        for (int b = 0; b < 2; ++b)
#pragma unroll
            for (int m = 0; m < 4; ++m)
#pragma unroll
                for (int n = 0; n < 2; ++n) acc[a][b][m][n] = (f32x4){0.f, 0.f, 0.f, 0.f};
    bf16x8 At[4][2], B0[2][2], B1[2][2];
    const char* cA = (const char*)g.A + (size_t)cur.pm * tstep; const char* cB = (const char*)g.Bt + (size_t)cur.pn * tstep;
    if constexpr (SP2) {
        PG8_STAGE(PG8_SB(0, 0), cB, voffB); PG8_STAGE(PG8_SB(0, 1), cB + hstep, voffB); PG8_STAGE(PG8_SA(0, 0), cA, voffA); PG8_STAGE(PG8_SA(0, 1), cA + hstep, voffA);
        if (wr == 1) PG8_BAR;
        PG8_WAIT_V(2); PG8_BAR;
        PG8_STAGE(PG8_SB(1, 0), cB + kstep, voffB); PG8_STAGE(PG8_SA(1, 0), cA + kstep, voffA); PG8_STAGE(PG8_SB(1, 1), cB + hstep + kstep, voffB);
        PG8_WAIT_V(6); PG8_BAR;
    } else {
    PG8_STAGE(PG8_SB(0, 0), cB, voffB); PG8_STAGE(PG8_SA(0, 0), cA, voffA); PG8_STAGE(PG8_SB(0, 1), cB + hstep, voffB); PG8_STAGE(PG8_SA(0, 1), cA + hstep, voffA);
    if (wr == 1) PG8_BAR;
    PG8_WAIT_V(4); PG8_BAR;
    PG8_STAGE(PG8_SB(1, 0), cB + kstep, voffB); PG8_STAGE(PG8_SA(1, 0), cA + kstep, voffA); PG8_STAGE(PG8_SB(1, 1), cB + hstep + kstep, voffB);
    PG8_WAIT_V(6); PG8_BAR;
    }
    for (;;) {
        const bool has_next = S.next(ui + 1, nxt);
        const char* nA = has_next ? (const char*)g.A + (size_t)nxt.pm * tstep : cA; const char* nB = has_next ? (const char*)g.Bt + (size_t)nxt.pn * tstep : cB;
        for (int t = 0; t < nt; t += 2) {
            const bool last = (t == nt - 2);
            const char* a1 = cA + (size_t)(t + 1) * kstep;
            const char* a2 = last ? nA : cA + (size_t)(t + 2) * kstep; const char* b2 = last ? nB : cB + (size_t)(t + 2) * kstep;
            const char* a3 = a2 + kstep; const char* b3 = b2 + kstep;
            if constexpr (SP2) {
            PG8_LDB(B0, 0, 0); PG8_LDB(B1, 0, 1); PG8_SCHED; PG8_LDA(At, 0, 0); PG8_STAGE(PG8_SA(1, 1), a1 + hstep, voffA);
            PG8_WAIT_V(8); PG8_WAIT_L(0); PG8_BAR; PG8_MMA(0, 0, At, B0); PG8_MMA(0, 1, At, B1); PG8_BAR; PG8_SCHED;
            PG8_LDA(At, 0, 1); PG8_STAGE(PG8_SB(0, 0), b2, voffB); PG8_STAGE(PG8_SB(0, 1), b2 + hstep, voffB); PG8_STAGE(PG8_SA(0, 0), a2, voffA);
            PG8_WAIT_V(8); PG8_WAIT_L(0); PG8_BAR; PG8_MMA(1, 0, At, B0); PG8_MMA(1, 1, At, B1); PG8_BAR; PG8_SCHED;
            PG8_LDB(B0, 1, 0); PG8_LDB(B1, 1, 1); PG8_SCHED; PG8_LDA(At, 1, 0); PG8_STAGE(PG8_SA(0, 1), a2 + hstep, voffA);
            PG8_WAIT_V(8); PG8_WAIT_L(0); PG8_BAR; PG8_MMA(0, 0, At, B0); PG8_MMA(0, 1, At, B1); PG8_BAR; PG8_SCHED;
            PG8_LDA(At, 1, 1); PG8_STAGE(PG8_SB(1, 0), b3, voffB); PG8_STAGE(PG8_SB(1, 1), b3 + hstep, voffB); PG8_STAGE(PG8_SA(1, 0), a3, voffA);
            PG8_WAIT_V(8); PG8_WAIT_L(0); PG8_BAR; PG8_MMA(1, 0, At, B0); PG8_MMA(1, 1, At, B1); PG8_BAR; PG8_SCHED;
            } else {
            PG8_LDB(B0, 0, 0); PG8_SCHED; PG8_LDA(At, 0, 0); PG8_STAGE(PG8_SA(1, 1), a1 + hstep, voffA);
            PG8_WAIT_L(8); PG8_BAR; PG8_WAIT_L(0); PG8_MMA(0, 0, At, B0); PG8_BAR; PG8_SCHED;
            PG8_LDB(B1, 0, 1); PG8_STAGE(PG8_SB(0, 0), b2, voffB);
            PG8_BAR; PG8_WAIT_L(0); PG8_MMA(0, 1, At, B1); PG8_BAR;
            if constexpr (!HALF_M) PG8_LDA(At, 0, 1);
            PG8_STAGE(PG8_SA(0, 0), a2, voffA);
            PG8_BAR; PG8_WAIT_L(0); if constexpr (!HALF_M) PG8_MMA(1, 0, At, B0); PG8_BAR; PG8_SCHED;
            PG8_STAGE(PG8_SB(0, 1), b2 + hstep, voffB);
            PG8_WAIT_V(6); PG8_BAR; if constexpr (!HALF_M) PG8_MMA(1, 1, At, B1); PG8_BAR;
            PG8_LDB(B0, 1, 0); PG8_SCHED; PG8_LDA(At, 1, 0); PG8_STAGE(PG8_SA(0, 1), a2 + hstep, voffA);
            PG8_WAIT_L(8); PG8_BAR; PG8_WAIT_L(0); PG8_MMA(0, 0, At, B0); PG8_BAR; PG8_SCHED;
            PG8_LDB(B1, 1, 1); PG8_STAGE(PG8_SB(1, 0), b3, voffB);
            PG8_BAR; PG8_WAIT_L(0); PG8_MMA(0, 1, At, B1); PG8_BAR;
            if constexpr (!HALF_M) PG8_LDA(At, 1, 1);
            PG8_STAGE(PG8_SA(1, 0), a3, voffA);
            PG8_BAR; PG8_WAIT_L(0); if constexpr (!HALF_M) PG8_MMA(1, 0, At, B0); PG8_BAR; PG8_SCHED;
            PG8_STAGE(PG8_SB(1, 1), b3 + hstep, voffB);
            PG8_WAIT_V(6); PG8_BAR; if constexpr (!HALF_M) PG8_MMA(1, 1, At, B1); PG8_BAR;
            }
        }
        if constexpr (ALIGN_EPI) { if (wr == 0) PG8_BAR; }
        E(acc, cur, wr, wc, fr, fq);
        if (!has_next) break;
#pragma unroll
        for (int a = 0; a < 2; ++a)
#pragma unroll
            for (int b = 0; b < 2; ++b)
#pragma unroll
                for (int m = 0; m < 4; ++m)
#pragma unroll
                    for (int n = 0; n < 2; ++n) acc[a][b][m][n] = (f32x4){0.f, 0.f, 0.f, 0.f};
        cur = nxt; cA = nA; cB = nB; ++ui;
        if constexpr (ALIGN_EPI) { if (wr == 1) PG8_BAR; }
    }
    PG8_WAIT_V(0);
    if constexpr (!ALIGN_EPI) { if (wr == 0) PG8_BAR; }
    PG8_BAR;
#undef PG8_SA
#undef PG8_SB
#undef PG8_STAGE
#undef PG8_LDA
#undef PG8_LDB
#undef PG8_MMA
#undef PG8_WAIT_V
#undef PG8_WAIT_L
#undef PG8_BAR
#undef PG8_SCHED
}
}

struct Ctx {
    const float* xp; const float* xs; const float* stC; const float* stN; const float* stM; const float* ssm; const float* conv; const float* ck; const float* cv;
    float* out; unsigned char* ws;
};
#define XWIN ((bf16_t*)(X.ws + WS_WIN))
#define XWOUT ((bf16_t*)(X.ws + WS_WOUT))
#define XXB ((bf16_t*)(X.ws + WS_XB))
#define XU ((bf16_t*)(X.ws + WS_U))
#define XMIX ((bf16_t*)(X.ws + WS_MIX))
#define XSSQ ((float*)(X.ws + WS_SSQ))
#define XROPE ((float*)(X.ws + WS_ROPE))
#define XMC ((float*)(X.ws + WS_MC))
#define XMN ((float*)(X.ws + WS_MN))
#define XML ((float*)(X.ws + WS_ML))
#define XBL ((float*)(X.ws + WS_BL))
#define XMS ((float*)(X.ws + WS_MS))
#define XSA ((float*)(X.ws + WS_SA))
#define XSH ((float*)(X.ws + WS_SH))
#define XCSB ((bf16_t*)(X.ws + WS_CSB))
#define XNS ((float*)(X.ws + WS_NS))
#define XHSB ((bf16_t*)(X.ws + WS_HSB))
#define XPAR(off) ((const float*)(X.ws + WS_PAR) + (off))
constexpr int P_AIB = 0, P_AFB = 16, P_DTB = 32, P_ALOG = 64, P_BD = 96, P_SINK = 128, P_QNW = 160, P_KNW = 416, P_ANW = 672, P_BNW = 2720, P_CB = 4768, P_CW = 8864, P_END = 25248;
#define IN_XP 0
#define IN_XS 1
#define IN_STC 2
#define IN_STN 3
#define IN_STM 4
#define IN_SSM 5
#define IN_CONV 6
#define IN_CK 7
#define IN_CV 8
#define IN_NORMW 9
#define IN_WIN 10
#define IN_AIB 11
#define IN_AFB 12
#define IN_ANW 13
#define IN_CW 14
#define IN_CB 15
#define IN_DTB 16
#define IN_ALOG 17
#define IN_BD 18
#define IN_BNW 19
#define IN_QNW 20
#define IN_KNW 21
#define IN_SINK 22
#define IN_WOUT 23

__device__ __forceinline__ void transpose_strip(lptr lds, const float* src, int ldn, int nvalid, bf16_t* dst, int ldk, const float* scale, int k0, int n0, int tid) {
    LAS float* T = (LAS float*)lds;
    f32x4 v[8];
#pragma unroll
    for (int i = 0; i < 8; ++i) {
        const int f = tid + i * NT, r = f >> 6, c4 = (f & 63) * 4, n = n0 + c4;
        const f32x4 t = __builtin_nontemporal_load((const f32x4*)(src + (size_t)(k0 + r) * ldn + (n < nvalid ? n : 0)));
        const float m = n < nvalid ? (scale ? scale[k0 + r] : 1.f) : 0.f;
        v[i] = t * m;
    }
#pragma unroll
    for (int i = 0; i < 8; ++i) {
        const int f = tid + i * NT, r = f >> 6, c4 = (f & 63) * 4;
        T[r * 257 + c4 + 0] = v[i][0]; T[r * 257 + c4 + 1] = v[i][1]; T[r * 257 + c4 + 2] = v[i][2]; T[r * 257 + c4 + 3] = v[i][3];
    }
    __syncthreads();
#pragma unroll
    for (int i = 0; i < 4; ++i) {
        const int p = tid + i * NT, n = p >> 3, k8 = (p & 7) * 8; float f[8];
#pragma unroll
        for (int jx = 0; jx < 8; ++jx) f[jx] = T[(k8 + jx) * 257 + n];
        *(u32x4*)(dst + (size_t)(n0 + n) * ldk + k0 + k8) = pack8(f);
    }
    __syncthreads();
}

__device__ __forceinline__ void prologue(lptr lds, const Ctx& X, const Args& args, int G, int bid, int tid) {
    const int lane = tid & 63, wave = tid >> 6;
    constexpr int T0 = 1280, T1 = T0 + 384, T2 = T1 + 2080, T3 = T2 + 1, T4 = T3 + 513;
    for (int task = bid; task < T4; task += G) {
        if (task < T0) {
            const int l = task / 320, r = task % 320, kt = r / 20, ntl = r % 20;
            transpose_strip(lds, args.in[IN_WIN] + (size_t)l * D * DIN, DIN, DIN, XWIN + (size_t)l * NIN * D, D, args.in[IN_NORMW] + l * D, kt * 64, ntl * 256, tid);
        } else if (task < T1) {
            const int t = task - T0, l = t / 96, r = t % 96, kt = r / 4, ntl = r % 4;
            transpose_strip(lds, args.in[IN_WOUT] + (size_t)l * DMIX * D, D, D, XWOUT + (size_t)l * D * DMIX, DMIX, nullptr, kt * 64, ntl * 256, tid);
        } else if (task < T2) {
            const int r = (task - T1) * 8 + wave;
            float ss = 0.f;
            if (r < MTOK) {
                const float* src = r < TP ? X.xp + (size_t)r * D : X.xs + (size_t)(r - TP) * D;
#pragma unroll
                for (int i = 0; i < 4; ++i) {
                    const int c = lane * 4 + i * 256; f32x4 v = __builtin_nontemporal_load((const f32x4*)(src + c));
                    ss += v[0] * v[0] + v[1] * v[1] + v[2] * v[2] + v[3] * v[3];
                    u32x2 w; w[0] = pk2(v[0], v[1]); w[1] = pk2(v[2], v[3]);
                    *(u32x2*)(XXB + (size_t)r * D + c) = w;
                }
            } else {
#pragma unroll
                for (int i = 0; i < 4; ++i) { u32x2 w = {0u, 0u}; *(u32x2*)(XXB + (size_t)r * D + lane * 4 + i * 256) = w; }
            }
            ss = wave_sum(ss);
            if (lane < 16) XSSQ[(size_t)r * 16 + lane] = (lane == 0) ? ss : 0.f;
        } else if (task < T3) {
            for (int i = tid; i < (MPAD - MTOK) * DMIX / 2; i += NT) ((unsigned*)(XMIX + (size_t)MTOK * DMIX))[i] = 0u;
            float* P = (float*)(X.ws + WS_PAR);
            const int po[12] = {P_AIB, P_AFB, P_DTB, P_ALOG, P_BD, P_SINK, P_QNW, P_KNW, P_ANW, P_BNW, P_CB, P_CW};
            const int pn[12] = {16, 16, 32, 32, 32, 32, 256, 256, 2048, 2048, 4096, 16384};
            const int pi[12] = {IN_AIB, IN_AFB, IN_DTB, IN_ALOG, IN_BD, IN_SINK, IN_QNW, IN_KNW, IN_ANW, IN_BNW, IN_CB, IN_CW};
#pragma unroll
            for (int a = 0; a < 12; ++a) { const float* src = args.in[pi[a]]; for (int i = tid; i < pn[a]; i += NT) P[po[a] + i] = src[i]; }
        } else {
            const int e = (task - T3) * 512 + tid;
            if (e < 8193 * 32) {
                const int pos = e >> 5, d = e & 31;
                const float inv = (float)exp2(-(double)d * (13.287712379549449 / 32.0));
                const float angf = (float)pos * inv;
                const double a = (double)angf;
                const double k = rint(a * 0.15915494309189535);
                const float rr = (float)(a - k * 6.283185307179586);
                XROPE[(size_t)e * 2] = cosf(rr); XROPE[(size_t)e * 2 + 1] = sinf(rr);
            }
        }
    }
}

__device__ __forceinline__ void conv8(const bf16_t* u, int seq0, int tt, int ch, const float* cw, const float* cb, float (&o)[8]) {
    float acc[8];
    { f32x4 b0 = *(const f32x4*)(cb + ch), b1 = *(const f32x4*)(cb + ch + 4);
#pragma unroll
      for (int j = 0; j < 4; ++j) { acc[j] = b0[j]; acc[4 + j] = b1[j]; } }
#pragma unroll
    for (int jj = 0; jj < 4; ++jj) {
        const int t2 = tt + jj - 3;
        if (t2 >= 0) {
            float x[8]; unpack8(*(const u32x4*)(u + (size_t)(seq0 + t2) * NIN + C_BX + ch), x);
            f32x4 w0 = *(const f32x4*)(cw + jj * 1024 + ch), w1 = *(const f32x4*)(cw + jj * 1024 + ch + 4);
#pragma unroll
            for (int j = 0; j < 4; ++j) { acc[j] += x[j] * w0[j]; acc[4 + j] += x[4 + j] * w1[j]; }
        }
    }
#pragma unroll
    for (int j = 0; j < 8; ++j) o[j] = siluf_(acc[j]);
}


__device__ __forceinline__ void conv8x8(const bf16_t* u, int seq0, int tt0, int ch, const float* cw, const float* cb, float (&o)[8][8]) {
    float w[4][8];
#pragma unroll
    for (int jj = 0; jj < 4; ++jj) { f32x4 w0 = *(const f32x4*)(cw + jj * 1024 + ch), w1 = *(const f32x4*)(cw + jj * 1024 + ch + 4);
#pragma unroll
        for (int j = 0; j < 4; ++j) { w[jj][j] = w0[j]; w[jj][4 + j] = w1[j]; } }
    { f32x4 b0 = *(const f32x4*)(cb + ch), b1 = *(const f32x4*)(cb + ch + 4);
#pragma unroll
      for (int t = 0; t < 8; ++t)
#pragma unroll
          for (int j = 0; j < 4; ++j) { o[t][j] = b0[j]; o[t][4 + j] = b1[j]; } }
    u32x4 raw[11];
#pragma unroll
    for (int r = 0; r < 11; ++r) {
        const int t2 = tt0 + r - 3;
        const u32x4 v = *(const u32x4*)(u + (unsigned)(seq0 + (t2 >= 0 ? t2 : 0)) * NIN + C_BX + ch);
        const unsigned msk = t2 >= 0 ? 0xffffffffu : 0u;
        raw[r] = (u32x4){v[0] & msk, v[1] & msk, v[2] & msk, v[3] & msk};
    }
#pragma unroll
    for (int r = 0; r < 11; ++r) {
        float x[8]; unpack8(raw[r], x);
#pragma unroll
        for (int jj = 0; jj < 4; ++jj) {
            const int t = r - jj;
            if (t >= 0 && t < 8) {
#pragma unroll
                for (int j = 0; j < 8; ++j) o[t][j] += x[j] * w[jj][j];
            }
        }
    }
#pragma unroll
    for (int t = 0; t < 8; ++t)
#pragma unroll
        for (int j = 0; j < 8; ++j) o[t][j] = siluf_(o[t][j]);
}

__device__ __forceinline__ void mlstm_local(lptr lds, const Ctx& X, int l, int task, int tid) {
    const int h = task & 3, c = (task >> 2) & 127, n = task >> 9;
    const int lane = tid & 63, wave = tid >> 6, fr = lane & 15, fq = lane >> 4;
    const int row0 = n * SEQ + c * 64, nh = n * 4 + h;
    lptr VwT = lds;
    lptr KT = lds + 18432;
    LAS float* wv = (LAS float*)(lds + 27648);
    const int tg = lane & 7, cgq = lane >> 3;
    u32x4 blk[8];
    if (wave >= 1 && wave <= 3) {
        const int col = wave < 3 ? C_AV + h * 128 + ((wave - 1) * 8 + cgq) * 8 : C_AK + h * 64 + cgq * 8;
#pragma unroll
        for (int t = 0; t < 8; ++t) blk[t] = *(const u32x4*)(XU + (unsigned)(row0 + 8 * tg + t) * NIN + col);
    }
    if (wave == 0) {
        const bf16_t* ur = XU + (unsigned)(row0 + lane) * NIN;
        const float fg = bf2f(ur[C_AF + h]) + XPAR(P_AFB)[l * 4 + h], ig = bf2f(ur[C_AI + h]) + XPAR(P_AIB)[l * 4 + h];
        const float b = wave_scan_sum(logsigf_(fg), lane);
        const float bl = lane63(b);
        const float g = bl - b + ig;
        const float ml = wave_max(g);
        wv[lane] = __expf(g - ml);
        if (lane == 0) { XML[nh * 128 + c] = ml; XBL[nh * 128 + c] = bl; }
    }
    __syncthreads();
    if (wave >= 1 && wave <= 3) {
        float xs[8][8];
#pragma unroll
        for (int t = 0; t < 8; ++t) { unpack8(blk[t], xs[t]); const float w = wave < 3 ? wv[8 * tg + t] : 0.125f;
#pragma unroll
            for (int j = 0; j < 8; ++j) xs[t][j] *= w; }
        lptr dstT = wave < 3 ? VwT + ((((wave - 1) * 8 + cgq) * 8 * 72) << 1) : KT + ((cgq * 8 * 72) << 1);
#pragma unroll
        for (int j = 0; j < 8; ++j) {
            float v[8];
#pragma unroll
            for (int t = 0; t < 8; ++t) v[t] = xs[t][j];
            *(LAS u32x4*)(dstT + ((j * 72 + 8 * tg) << 1)) = pack8(v);
        }
    }
    __syncthreads();
    {
        bf16_t* dst = (bf16_t*)XMC + ((size_t)nh * 128 + c) * 8192;
        bf16x8 b0 = lds_frag(VwT, 16 * wave + fr, fq * 8, 72), b1 = lds_frag(VwT, 16 * wave + fr, 32 + fq * 8, 72);
#pragma unroll
        for (int mt = 0; mt < 4; ++mt) {
            f32x4 acc = {0.f, 0.f, 0.f, 0.f};
            acc = mfma16(lds_frag(KT, 16 * mt + fr, fq * 8, 72), b0, acc);
            acc = mfma16(lds_frag(KT, 16 * mt + fr, 32 + fq * 8, 72), b1, acc);
            { u32x2 w; w[0] = pk2(acc[0], acc[1]); w[1] = pk2(acc[2], acc[3]); *(u32x2*)(dst + (16 * wave + fr) * 64 + 16 * mt + 4 * fq) = w; }
        }
    }
    if (tid < 64) {
        float s = 0.f;
#pragma unroll
        for (int t8 = 0; t8 < 8; ++t8) {
            float kf[8]; unpack8(*(const LAS u32x4*)(KT + ((tid * 72 + t8 * 8) << 1)), kf);
#pragma unroll
            for (int jx = 0; jx < 8; ++jx) s += kf[jx] * wv[t8 * 8 + jx];
        }
        XMN[((size_t)nh * 128 + c) * 64 + tid] = s;
    }
    __syncthreads();
}

__device__ __forceinline__ void ssd_local(lptr lds, const Ctx& X, int l, int task, int tid) {
    const int g = task & 1, c = (task >> 1) & 127, n = task >> 8;
    const int lane = tid & 63, wave = tid >> 6, fr = lane & 15, fq = lane >> 4;
    const int seq0 = n * SEQ, row0 = seq0 + c * 64;
    lptr XwT = lds;
    lptr BT = lds + 36864;
    LAS float* wl = (LAS float*)(lds + 55296);
    {
        const float* cw = XPAR(P_CW) + l * 4096; const float* cb = XPAR(P_CB) + l * 1024;
        const int tg = lane & 7, cg = wave * 8 + (lane >> 3);
        float o[8][8];
        if (wave < 6) {
            const int ch = cg < 32 ? g * 256 + cg * 8 : 512 + g * 128 + (cg - 32) * 8;
            conv8x8(XU, seq0, c * 64 + 8 * tg, ch, cw, cb, o);
        }
        if (wave < 4) {
            const int hh = 4 * g + wave;
            const float dt = softplusf_(bf2f(XU[(unsigned)(row0 + lane) * NIN + C_BDT + hh]) + XPAR(P_DTB)[l * 8 + hh]);
            const float A = -__expf(XPAR(P_ALOG)[l * 8 + hh]);
            const float a = wave_scan_sum(dt * A, lane);
            const float aL = lane63(a);
            wl[wave * 64 + lane] = __expf(aL - a) * dt;
            if (lane == 0) XSA[(n * 8 + hh) * 128 + c] = aL;
        }
        __syncthreads();
        if (wave < 4) {
            float wt[8];
#pragma unroll
            for (int t = 0; t < 8; ++t) wt[t] = wl[wave * 64 + 8 * tg + t];
#pragma unroll
            for (int jx = 0; jx < 8; ++jx) {
                float v[8];
#pragma unroll
                for (int t = 0; t < 8; ++t) v[t] = o[t][jx] * wt[t];
                *(LAS u32x4*)(XwT + (((cg * 8 + jx) * 72 + 8 * tg) << 1)) = pack8(v);
            }
        } else if (wave < 6) {
#pragma unroll
            for (int jx = 0; jx < 8; ++jx) {
                float v[8];
#pragma unroll
                for (int t = 0; t < 8; ++t) v[t] = o[t][jx];
                *(LAS u32x4*)(BT + ((((cg - 32) * 8 + jx) * 72 + 8 * tg) << 1)) = pack8(v);
            }
        }
    }
    __syncthreads();
    {
        const int hl = wave >> 1, ph = wave & 1, hh = 4 * g + hl;
        bf16_t* dst = (bf16_t*)XSH + ((size_t)(n * 8 + hh) * 128 + c) * 8192;
        bf16x8 bx[2][2];
#pragma unroll
        for (int ntl = 0; ntl < 2; ++ntl)
#pragma unroll
            for (int kk = 0; kk < 2; ++kk) bx[ntl][kk] = lds_frag(XwT, hl * 64 + ph * 32 + ntl * 16 + fr, kk * 32 + fq * 8, 72);
#pragma unroll
        for (int mt = 0; mt < 8; ++mt) {
            bf16x8 a0 = lds_frag(BT, 16 * mt + fr, fq * 8, 72), a1 = lds_frag(BT, 16 * mt + fr, 32 + fq * 8, 72);
#pragma unroll
            for (int ntl = 0; ntl < 2; ++ntl) {
                f32x4 acc = {0.f, 0.f, 0.f, 0.f};
                acc = mfma16(a0, bx[ntl][0], acc); acc = mfma16(a1, bx[ntl][1], acc);
                { u32x2 w; w[0] = pk2(acc[0], acc[1]); w[1] = pk2(acc[2], acc[3]); *(u32x2*)(dst + (ph * 32 + ntl * 16 + fr) * 128 + 16 * mt + 4 * fq) = w; }
            }
        }
    }
    __syncthreads();
}

__device__ __forceinline__ void swa_prompt(lptr lds, const Ctx& X, int l, int task, int tid) {
    const int kvh = task & 1, qb = (task >> 1) & 63, n = task >> 7;
    const int lane = tid & 63, wave = tid >> 6, fr = lane & 15, fq = lane >> 4;
    const int seq0 = n * SEQ;
    lptr Kn = lds;
    lptr Vt = lds + 36864;
    lptr Pw = lds + 70656 + wave * 8448;
    const float* knw = XPAR(P_KNW) + l * 64; const float* qnw = XPAR(P_QNW) + l * 64;
#pragma unroll
    for (int it = 0; it < 2; ++it) {
        const int item = tid + it * NT, j = item >> 2, qd = item & 3, t = qb * 128 - 128 + j;
        float o1[8], o2[8];
        {
            const int tc = t >= 0 ? t : 0;
            const bf16_t* kr = XU + (unsigned)(seq0 + tc) * NIN + C_CK + kvh * 64;
            float x1[8], x2[8]; unpack8(*(const u32x4*)(kr + qd * 8), x1); unpack8(*(const u32x4*)(kr + 32 + qd * 8), x2);
            float ss = 0.f;
#pragma unroll
            for (int jj = 0; jj < 8; ++jj) ss += x1[jj] * x1[jj] + x2[jj] * x2[jj];
            ss += __shfl_xor(ss, 1); ss += __shfl_xor(ss, 2);
            const float rs = rsqrtf(ss * (1.f / 64.f) + EPS);
            const f32x4* cs = (const f32x4*)(XROPE + ((size_t)tc * 32 + qd * 8) * 2);
            f32x4 csv[4];
#pragma unroll
            for (int q4 = 0; q4 < 4; ++q4) csv[q4] = cs[q4];
            const float zm = t >= 0 ? 1.f : 0.f;
#pragma unroll
            for (int jj = 0; jj < 8; ++jj) {
                const float a = x1[jj] * rs * knw[qd * 8 + jj], b = x2[jj] * rs * knw[32 + qd * 8 + jj], co = csv[jj >> 1][(jj & 1) * 2], si = csv[jj >> 1][(jj & 1) * 2 + 1];
                o1[jj] = (a * co - b * si) * zm; o2[jj] = (b * co + a * si) * zm;
            }
        }
        *(LAS u32x4*)(Kn + ((j * 72 + qd * 8) << 1)) = pack8(o1);
        *(LAS u32x4*)(Kn + ((j * 72 + 32 + qd * 8) << 1)) = pack8(o2);
        if (qb == 63 && j >= 128) {
            float* ko = X.out + O_PK + ((((size_t)l * 2 + n) * 128 + (j - 128)) * 2 + kvh) * 64;
            *(f32x4*)(ko + qd * 8) = (f32x4){o1[0], o1[1], o1[2], o1[3]}; *(f32x4*)(ko + qd * 8 + 4) = (f32x4){o1[4], o1[5], o1[6], o1[7]};
            *(f32x4*)(ko + 32 + qd * 8) = (f32x4){o2[0], o2[1], o2[2], o2[3]}; *(f32x4*)(ko + 32 + qd * 8 + 4) = (f32x4){o2[4], o2[5], o2[6], o2[7]};
        }
    }
    if (wave < 4) {
        const int tg = tid & 31, cg = tid >> 5;
        u32x4 vb[8];
#pragma unroll
        for (int t8 = 0; t8 < 8; ++t8) {
            const int jk = 8 * tg + t8, t = qb * 128 - 128 + jk;
            u32x4 w = *(const u32x4*)(XU + (unsigned)(seq0 + (t >= 0 ? t : 0)) * NIN + C_CV + kvh * 64 + cg * 8);
            const unsigned msk = t >= 0 ? 0xffffffffu : 0u;
            vb[t8] = (u32x4){w[0] & msk, w[1] & msk, w[2] & msk, w[3] & msk};
        }
#pragma unroll
        for (int jj = 0; jj < 8; ++jj) {
            u32x4 w;
#pragma unroll
            for (int tp = 0; tp < 4; ++tp) {
                const unsigned lo = (vb[2 * tp][jj >> 1] >> ((jj & 1) * 16)) & 0xffffu, hi = (vb[2 * tp + 1][jj >> 1] >> ((jj & 1) * 16)) & 0xffffu;
                w[tp] = lo | (hi << 16);
            }
            *(LAS u32x4*)(Vt + (((cg * 8 + jj) * 264 + 8 * tg) << 1)) = w;
        }
        if (qb == 63 && tg >= 16) {
#pragma unroll
            for (int t8 = 0; t8 < 8; ++t8) {
                float x[8]; unpack8(vb[t8], x);
                float* vo = X.out + O_PV + ((((size_t)l * 2 + n) * 128 + (8 * tg + t8 - 128)) * 2 + kvh) * 64 + cg * 8;
                *(f32x4*)(vo) = (f32x4){x[0], x[1], x[2], x[3]}; *(f32x4*)(vo + 4) = (f32x4){x[4], x[5], x[6], x[7]};
            }
        }
    }
    __syncthreads();
    const int hq = kvh * 4 + (wave >> 1), i0 = (wave & 1) * 64;
    const float sink = XPAR(P_SINK)[l * 8 + hq];
    float qw1[8], qw2[8];
#pragma unroll
    for (int jj = 0; jj < 8; ++jj) { qw1[jj] = qnw[fq * 8 + jj]; qw2[jj] = qnw[32 + fq * 8 + jj]; }
    u32x4 qn0, qn1; f32x4 csn[4];
    {
        const int t = qb * 128 + i0 + fr;
        const bf16_t* qr = XU + (unsigned)(seq0 + t) * NIN + C_CQ + hq * 64;
        qn0 = *(const u32x4*)(qr + fq * 8); qn1 = *(const u32x4*)(qr + 32 + fq * 8);
        const f32x4* cs = (const f32x4*)(XROPE + ((size_t)t * 32 + fq * 8) * 2);
#pragma unroll
        for (int q4 = 0; q4 < 4; ++q4) csn[q4] = cs[q4];
    }
#pragma unroll 1
    for (int mt = 0; mt < 4; ++mt) {
        const int q0 = i0 + mt * 16;
        const u32x4 q0r = qn0, q1r = qn1; f32x4 csc[4];
#pragma unroll
        for (int q4 = 0; q4 < 4; ++q4) csc[q4] = csn[q4];
        {
            const int mn = mt < 3 ? mt + 1 : 3;
            const int t = qb * 128 + i0 + mn * 16 + fr;
            const bf16_t* qr = XU + (unsigned)(seq0 + t) * NIN + C_CQ + hq * 64;
            qn0 = *(const u32x4*)(qr + fq * 8); qn1 = *(const u32x4*)(qr + 32 + fq * 8);
            const f32x4* cs = (const f32x4*)(XROPE + ((size_t)t * 32 + fq * 8) * 2);
#pragma unroll
            for (int q4 = 0; q4 < 4; ++q4) csn[q4] = cs[q4];
        }
        bf16x8 a0, a1;
        {
            float x1[8], x2[8]; unpack8(q0r, x1); unpack8(q1r, x2);
            float ss = 0.f;
#pragma unroll
            for (int jj = 0; jj < 8; ++jj) ss += x1[jj] * x1[jj] + x2[jj] * x2[jj];
            ss += __shfl_xor(ss, 16); ss += __shfl_xor(ss, 32);
            const float rs = rsqrtf(ss * (1.f / 64.f) + EPS) * 0.125f;
            float o1[8], o2[8];
#pragma unroll
            for (int jj = 0; jj < 8; ++jj) {
                const float a = x1[jj] * rs * qw1[jj], b = x2[jj] * rs * qw2[jj], co = csc[jj >> 1][(jj & 1) * 2], si = csc[jj >> 1][(jj & 1) * 2 + 1];
                o1[jj] = a * co - b * si; o2[jj] = b * co + a * si;
            }
            a0 = as_frag(pack8(o1)); a1 = as_frag(pack8(o2));
        }
        const int tlo = q0 >> 4;
        const int qi = q0 + fr;
        const int dlo = qb > 0 ? 1 : (128 - qi > 1 ? 128 - qi : 1);
        f32x4 s[16];
        float mx = -3.0e38f;
#pragma unroll
        for (int ntl = 0; ntl < 16; ++ntl) {
            if (ntl >= tlo && ntl <= tlo + 8) {
                f32x4 acc = {0.f, 0.f, 0.f, 0.f};
                acc = mfma16(lds_frag(Kn, 16 * ntl + fr, fq * 8, 72), a0, acc);
                acc = mfma16(lds_frag(Kn, 16 * ntl + fr, 32 + fq * 8, 72), a1, acc);
                if (ntl == tlo || ntl == tlo + 8 || qb == 0) {
#pragma unroll
                    for (int ii = 0; ii < 4; ++ii) {
                        const int dk = 16 * ntl + 4 * fq + ii - qi;
                        acc[ii] = ((unsigned)(dk - dlo) <= (unsigned)(128 - dlo)) ? acc[ii] : -3.0e38f;
                    }
                }
                mx = fmaxf(mx, fmaxf(fmaxf(acc[0], acc[1]), fmaxf(acc[2], acc[3])));
                s[ntl] = acc;
            }
        }
        mx = fmaxf(mx, __shfl_xor(mx, 16)); mx = fmaxf(mx, __shfl_xor(mx, 32));
        mx = fmaxf(mx, sink);
        float sum = 0.f;
#pragma unroll
        for (int ntl = 0; ntl < 16; ++ntl) {
            if (ntl >= tlo && ntl <= tlo + 8) {
#pragma unroll
                for (int ii = 0; ii < 4; ++ii) { const float e = __expf(s[ntl][ii] - mx); s[ntl][ii] = e; sum += e; }
            }
        }
        sum += __shfl_xor(sum, 16); sum += __shfl_xor(sum, 32);
        const float inv = rcpf_(sum + __expf(sink - mx));
        const int klo = q0 >> 5, khi = (q0 + 143) >> 5;
#pragma unroll
        for (int ntl = 0; ntl < 16; ++ntl) {
            if (ntl >= tlo && ntl <= tlo + 8) {
                u32x2 w; w[0] = pk2(s[ntl][0] * inv, s[ntl][1] * inv); w[1] = pk2(s[ntl][2] * inv, s[ntl][3] * inv);
                *(LAS u32x2*)(Pw + ((fr * 264 + 16 * ntl + 4 * fq) << 1)) = w;
            } else if ((ntl >> 1) >= klo && (ntl >> 1) <= khi) {
                u32x2 w = {0u, 0u};
                *(LAS u32x2*)(Pw + ((fr * 264 + 16 * ntl + 4 * fq) << 1)) = w;
            }
        }
        u32x2 czv[4];
#pragma unroll
        for (int ntl = 0; ntl < 4; ++ntl) czv[ntl] = *(const u32x2*)(XU + ((unsigned)seq0 + qb * 128 + q0 + fr) * NIN + C_CZ + hq * 64 + 16 * ntl + 4 * fq);
        LDS_FENCE();
        f32x4 o[4];
#pragma unroll
        for (int ntl = 0; ntl < 4; ++ntl) o[ntl] = (f32x4){0.f, 0.f, 0.f, 0.f};
#pragma unroll
        for (int kk = 0; kk < 8; ++kk) {
            if (kk >= klo && kk <= khi) {
                const bf16x8 a = lds_frag(Pw, fr, kk * 32 + fq * 8, 264);
#pragma unroll
                for (int ntl = 0; ntl < 4; ++ntl) o[ntl] = mfma16(lds_frag(Vt, 16 * ntl + fr, kk * 32 + fq * 8, 264), a, o[ntl]);
            }
        }
        LDS_FENCE();
        {
            const unsigned row = (unsigned)seq0 + qb * 128 + q0 + fr;
#pragma unroll
            for (int ntl = 0; ntl < 4; ++ntl) {
                const float z0 = __uint_as_float(czv[ntl][0] << 16), z1 = __uint_as_float(czv[ntl][0] & 0xffff0000u), z2 = __uint_as_float(czv[ntl][1] << 16), z3 = __uint_as_float(czv[ntl][1] & 0xffff0000u);
                u32x2 w; w[0] = pk2(o[ntl][0] * siluf_(z0), o[ntl][1] * siluf_(z1)); w[1] = pk2(o[ntl][2] * siluf_(z2), o[ntl][3] * siluf_(z3));
                *(u32x2*)(XMIX + row * DMIX + 1024 + hq * 64 + 16 * ntl + 4 * fq) = w;
            }
        }
    }
    __syncthreads();
}

__device__ __forceinline__ void sample_task(lptr lds, const Ctx& X, int l, int b, int part, int tid) {
    LAS float* uf = (LAS float*)lds;
    LAS float* xbc = (LAS float*)(lds + 19968);
    LAS float* numv = (LAS float*)(lds + 24064);
    LAS float* yv = (LAS float*)(lds + 26112);
    LAS float* red = (LAS float*)(lds + 28160);
    LAS float* qs = (LAS float*)(lds + 28416);
    LAS float* kn = (LAS float*)(lds + 30464);
    LAS float* sc = (LAS float*)(lds + 30976);
    const int lane = tid & 63, wave = tid >> 6;
    const size_t row = (size_t)TP + b;
    const bf16_t* ur = XU + row * NIN;
    const size_t lb = (size_t)l * 128 + b;
    f32x4 kpre[8], vpre[8];
    if (part == 2) {
        const float* kc = X.ck + lb * 16384; const float* vc = X.cv + lb * 16384;
#pragma unroll
        for (int it = 0; it < 8; ++it) {
            const int e = (tid + it * NT) * 4, e2 = e < 127 * 128 ? e + 128 : e;
            kpre[it] = __builtin_nontemporal_load((const f32x4*)(kc + e2)); vpre[it] = __builtin_nontemporal_load((const f32x4*)(vc + e2));
        }
    }
    {
        const int c_lo = part == 0 ? 0 : (part == 1 ? C_BZ : C_CQ), c_hi = part == 0 ? C_BZ : (part == 1 ? C_CQ : DIN);
#pragma unroll 2
        for (int i = c_lo + tid; i < c_hi; i += NT) uf[i] = bf2f(ur[i]);
    }
    __syncthreads();
    if (part == 0) {
#pragma unroll
    for (int h = 0; h < 4; ++h) {
        const float ig = uf[C_AI + h] + XPAR(P_AIB)[l * 4 + h], fg = uf[C_AF + h] + XPAR(P_AFB)[l * 4 + h];
        const float ls = logsigf_(fg), m0 = X.stM[lb * 4 + h];
        const float mn = fmaxf(ls + m0, ig), sp = __expf(ls + m0 - mn), sl = __expf(ig - mn);
        const float* C0 = X.stC + (lb * 4 + h) * 8192; float* C1 = X.out + O_SC + (lb * 4 + h) * 8192;
#pragma unroll
        for (int it = 0; it < 4; ++it) {
            const int e = (tid + it * NT) * 4, v = e >> 6, k = e & 63;
            const f32x4 c0 = __builtin_nontemporal_load((const f32x4*)(C0 + e));
            const float vv = uf[C_AV + h * 128 + v] * sl;
            f32x4 c1; float part = 0.f;
#pragma unroll
            for (int j = 0; j < 4; ++j) { c1[j] = sp * c0[j] + vv * (uf[C_AK + h * 64 + k + j] * 0.125f); part += c1[j] * uf[C_AQ + h * 64 + k + j]; }
            __builtin_nontemporal_store(c1, (f32x4*)(C1 + e));
            part = red16(part);
            if ((lane & 15) == 0) numv[h * 128 + v] = part;
        }
        if (wave == 0) {
            const float n1 = sp * X.stN[(lb * 4 + h) * 64 + lane] + sl * uf[C_AK + h * 64 + lane] * 0.125f;
            X.out[O_SN + (lb * 4 + h) * 64 + lane] = n1;
            const float dd = wave_sum(n1 * uf[C_AQ + h * 64 + lane]);
            if (lane == 0) { red[h] = dd; red[4 + h] = mn; X.out[O_SM + lb * 4 + h] = mn; }
        }
    }
    __syncthreads();
    float hv;
    { const int h = tid >> 7; hv = numv[tid] * rcpf_(fmaxf(fabsf(red[h]), __expf(-red[4 + h]))); const float ss = wave_sum(hv * hv); if (lane == 0) red[8 + wave] = ss; }
    __syncthreads();
    { const int h = tid >> 7; const float rs = rsqrtf((red[8 + 2 * h] + red[9 + 2 * h]) * (1.f / 128.f) + EPS);
      XMIX[row * DMIX + tid] = (bf16_t)f2bf(hv * rs * XPAR(P_ANW)[l * 512 + tid] * sigmoidf_(uf[C_AO + tid]) * siluf_(uf[C_AZ + tid])); }
    }
    if (part == 1) {
    {
        const float* buf = X.conv + lb * 3 * 1024; float* oc = X.out + O_SCONV + lb * 3 * 1024;
        const float* cw = XPAR(P_CW) + l * 4096;
#pragma unroll
        for (int it = 0; it < 2; ++it) {
            const int ch = tid + it * NT;
            const float f0 = buf[ch], f1 = buf[1024 + ch], f2 = buf[2048 + ch], f3 = uf[C_BX + ch];
            const float acc = XPAR(P_CB)[l * 1024 + ch] + f0 * cw[ch] + f1 * cw[1024 + ch] + f2 * cw[2048 + ch] + f3 * cw[3072 + ch];
            xbc[ch] = siluf_(acc);
            oc[ch] = f1; oc[1024 + ch] = f2; oc[2048 + ch] = f3;
        }
    }
    __syncthreads();
#pragma unroll 4
    for (int hh = 0; hh < 8; ++hh) {
        const float dt = softplusf_(uf[C_BDT + hh] + XPAR(P_DTB)[l * 8 + hh]);
        const float dA = __expf(-dt * __expf(XPAR(P_ALOG)[l * 8 + hh]));
        const int g = hh >> 2;
        const float* h0p = X.ssm + (lb * 8 + hh) * 8192; float* h1p = X.out + O_SH + (lb * 8 + hh) * 8192;
#pragma unroll
        for (int it = 0; it < 4; ++it) {
            const int e = (tid + it * NT) * 4, p = e >> 7, s = e & 127;
            const f32x4 h0 = __builtin_nontemporal_load((const f32x4*)(h0p + e));
            const float xv = xbc[hh * 64 + p] * dt;
            f32x4 h1; float part = 0.f;
#pragma unroll
            for (int j = 0; j < 4; ++j) { h1[j] = dA * h0[j] + xv * xbc[512 + g * 128 + s + j]; part += h1[j] * xbc[768 + g * 128 + s + j]; }
            __builtin_nontemporal_store(h1, (f32x4*)(h1p + e));
            part = red16(part); part += __shfl_xor(part, 16);
            if ((lane & 31) == 0) yv[hh * 64 + p] = part;
        }
    }
    __syncthreads();
    float gb;
    { const int hh = tid >> 6; const float y = yv[tid] + XPAR(P_BD)[l * 8 + hh] * xbc[tid]; gb = y * siluf_(uf[C_BZ + tid]); const float ss = wave_sum(gb * gb); if (lane == 0) red[16 + wave] = ss; }
    __syncthreads();
    { const int g = tid >> 8; const float rs = rsqrtf((red[16 + 4 * g] + red[17 + 4 * g] + red[18 + 4 * g] + red[19 + 4 * g]) * (1.f / 256.f) + EPS);
      XMIX[row * DMIX + 512 + tid] = (bf16_t)f2bf(gb * rs * XPAR(P_BNW)[l * 512 + tid]); }
    }
    if (part == 2) {
    lptr Kl = lds + 36864;
    lptr Vl = lds + 36864 + 34816;
    if (tid < 320) {
        const int vec = tid >> 5, d = tid & 31, base = vec < 8 ? C_CQ + vec * 64 : C_CK + (vec - 8) * 64;
        const float x1 = uf[base + d], x2 = uf[base + 32 + d];
        float ss = x1 * x1 + x2 * x2; ss = red16(ss); ss += __shfl_xor(ss, 16);
        const float rs = rsqrtf(ss * (1.f / 64.f) + EPS);
        const float* w = vec < 8 ? XPAR(P_QNW) + l * 64 : XPAR(P_KNW) + l * 64;
        const float a = x1 * rs * w[d], bb = x2 * rs * w[d + 32];
        const float co = XROPE[((size_t)8192 * 32 + d) * 2], si = XROPE[((size_t)8192 * 32 + d) * 2 + 1];
        const float o1 = a * co - bb * si, o2 = bb * co + a * si;
        if (vec < 8) { qs[vec * 64 + d] = o1 * 0.125f; qs[vec * 64 + 32 + d] = o2 * 0.125f; } else { kn[(vec - 8) * 64 + d] = o1; kn[(vec - 8) * 64 + 32 + d] = o2; }
    }
    __syncthreads();
    {
        float* ko = X.out + O_SK + lb * 16384; float* vo = X.out + O_SV + lb * 16384;
#pragma unroll
        for (int it = 0; it < 8; ++it) {
            const int e = (tid + it * NT) * 4, j = e >> 7, r = e & 127;
            f32x4 kv = kpre[it], vv = vpre[it];
            if (j == 127) { kv = (f32x4){kn[r], kn[r + 1], kn[r + 2], kn[r + 3]}; vv = (f32x4){uf[C_CV + r], uf[C_CV + r + 1], uf[C_CV + r + 2], uf[C_CV + r + 3]}; }
            __builtin_nontemporal_store(kv, (f32x4*)(ko + e)); __builtin_nontemporal_store(vv, (f32x4*)(vo + e));
            u32x2 wk, wv2; wk[0] = pk2(kv[0], kv[1]); wk[1] = pk2(kv[2], kv[3]); wv2[0] = pk2(vv[0], vv[1]); wv2[1] = pk2(vv[2], vv[3]);
            *(LAS u32x2*)(Kl + ((j * 136 + r) << 1)) = wk; *(LAS u32x2*)(Vl + ((j * 136 + r) << 1)) = wv2;
        }
    }
    __syncthreads();
    if (tid < 256) {
        const int kvh = tid >> 7, jj = tid & 127;
        float s0 = 0.f, s1 = 0.f, s2 = 0.f, s3 = 0.f;
#pragma unroll 2
        for (int d8 = 0; d8 < 8; ++d8) {
            float kf[8]; unpack8(*(const LAS u32x4*)(Kl + ((jj * 136 + kvh * 64 + d8 * 8) << 1)), kf);
#pragma unroll
            for (int j = 0; j < 8; ++j) {
                s0 += kf[j] * qs[(kvh * 4 + 0) * 64 + d8 * 8 + j]; s1 += kf[j] * qs[(kvh * 4 + 1) * 64 + d8 * 8 + j];
                s2 += kf[j] * qs[(kvh * 4 + 2) * 64 + d8 * 8 + j]; s3 += kf[j] * qs[(kvh * 4 + 3) * 64 + d8 * 8 + j];
            }
        }
        sc[(kvh * 4 + 0) * 128 + jj] = s0; sc[(kvh * 4 + 1) * 128 + jj] = s1; sc[(kvh * 4 + 2) * 128 + jj] = s2; sc[(kvh * 4 + 3) * 128 + jj] = s3;
    }
    __syncthreads();
    {
        const int hq = wave; const float s0 = sc[hq * 128 + lane], s1 = sc[hq * 128 + 64 + lane], sink = XPAR(P_SINK)[l * 8 + hq];
        const float m = fmaxf(wave_max(fmaxf(s0, s1)), sink);
        const float e0 = __expf(s0 - m), e1 = __expf(s1 - m);
        const float inv = rcpf_(wave_sum(e0 + e1) + __expf(sink - m));
        sc[hq * 128 + lane] = e0 * inv; sc[hq * 128 + 64 + lane] = e1 * inv;
    }
    __syncthreads();
    {
        const int hq = tid >> 6, d = tid & 63, kvh = hq >> 2;
        float o = 0.f;
#pragma unroll 16
        for (int jj = 0; jj < 128; ++jj) o += sc[hq * 128 + jj] * bf2f(*(const LAS bf16_t*)(Vl + ((jj * 136 + kvh * 64 + d) << 1)));
        XMIX[row * DMIX + 1024 + tid] = (bf16_t)f2bf(o * siluf_(uf[C_CZ + tid]));
    }
    }
    __syncthreads();
}

__device__ __forceinline__ void scans(const Ctx& X, int l, int gt, int nthreads) {
    for (int item = gt; item < 98816; item += nthreads) {
        if (item < 32768) {
            const int nh = item >> 12, e = (item & 4095) * 2;
            const bf16_t* base = (const bf16_t*)XMC + (size_t)nh * 128 * 8192 + e;
            const float* ml = XML + nh * 128; const float* bl = XBL + nh * 128;
            float m = 0.f; f32x2 st = {0.f, 0.f};
            for (int c0 = 0; c0 < 128; c0 += 16) {
                f32x2 cl[16];
#pragma unroll
                for (int j = 0; j < 16; ++j) { const unsigned w = *(const unsigned*)(base + (size_t)(c0 + j) * 8192); cl[j] = (f32x2){__uint_as_float(w << 16), __uint_as_float(w & 0xffff0000u)}; }
#pragma unroll
                for (int j = 0; j < 16; ++j) {
                    const float mlj = ml[c0 + j], blj = bl[c0 + j], mn = fmaxf(blj + m, mlj), sp = __expf(blj + m - mn), sl = __expf(mlj - mn);
                    *(unsigned*)(XCSB + ((size_t)nh * 128 + c0 + j) * 8192 + e) = pk2(st[0], st[1]);
                    if (e == 0) XMS[nh * 128 + c0 + j] = m;
                    st = st * sp + cl[j] * sl; m = mn;
                }
            }
            *(f32x2*)(X.out + O_PC + ((size_t)l * 8 + nh) * 8192 + e) = st;
            if (e == 0) X.out[O_PM + l * 8 + nh] = m;
        } else if (item < 98304) {
            const int i1 = item - 32768, nhh = i1 >> 12, e = (i1 & 4095) * 2;
            const bf16_t* base = (const bf16_t*)XSH + (size_t)nhh * 128 * 8192 + e;
            const float* al = XSA + nhh * 128;
            f32x2 st = {0.f, 0.f};
            for (int c0 = 0; c0 < 128; c0 += 16) {
                f32x2 cl[16];
#pragma unroll
                for (int j = 0; j < 16; ++j) { const unsigned w = *(const unsigned*)(base + (size_t)(c0 + j) * 8192); cl[j] = (f32x2){__uint_as_float(w << 16), __uint_as_float(w & 0xffff0000u)}; }
#pragma unroll
                for (int j = 0; j < 16; ++j) {
                    const float dec = __expf(al[c0 + j]);
                    *(unsigned*)(XHSB + ((size_t)nhh * 128 + c0 + j) * 8192 + e) = pk2(st[0], st[1]);
                    st = st * dec + cl[j];
                }
            }
            *(f32x2*)(X.out + O_PH + ((size_t)l * 16 + nhh) * 8192 + e) = st;
        } else {
            const int i2 = item - 98304, nh = i2 >> 6, k = i2 & 63;
            float* base = XMN + (size_t)nh * 128 * 64 + k;
            const float* ml = XML + nh * 128; const float* bl = XBL + nh * 128;
            float m = 0.f, st = 0.f;
            for (int c = 0; c < 128; ++c) {
                const float mlj = ml[c], blj = bl[c], mn = fmaxf(blj + m, mlj), sp = __expf(blj + m - mn), sl = __expf(mlj - mn);
                const float cl = base[c * 64];
                XNS[(size_t)nh * 128 * 64 + c * 64 + k] = st;
                st = st * sp + cl * sl; m = mn;
            }
            X.out[O_PN + ((size_t)l * 8 + nh) * 64 + k] = st;
        }
    }
}

__device__ __forceinline__ void mlstm_out(lptr lds, const Ctx& X, int l, int task, int tid) {
    const int h = task & 3, c = (task >> 2) & 127, n = task >> 9;
    const int lane = tid & 63, wave = tid >> 6, fr = lane & 15, fq = lane >> 4;
    const int row0 = n * SEQ + c * 64, nh = n * 4 + h;
    lptr Qs = lds;
    lptr Ks = lds + 9216;
    lptr Vt = lds + 18432;
    lptr Sb = lds + 36864 + wave * 2304;
    LAS float* bv = (LAS float*)(lds + 55296);
    LAS float* dv = bv + 64;
    LAS float* mtv = bv + 128;
    LAS float* siv = bv + 192;
    LAS float* qnv = bv + 256;
    LAS float* ssqp = bv + 384;
    LAS float* nsv = bv + 512;
    const int mti = wave >> 1, half = wave & 1;
    u32x4 csf[2][4];
    {
        const bf16_t* Cs = XCSB + ((size_t)nh * 128 + c) * 8192;
#pragma unroll
        for (int kk = 0; kk < 2; ++kk)
#pragma unroll
            for (int ntl = 0; ntl < 4; ++ntl) csf[kk][ntl] = *(const u32x4*)(Cs + (64 * half + 16 * ntl + fr) * 64 + kk * 32 + fq * 8);
    }
    unsigned short aov[4][4], azv[4][4]; float anw[4];
#pragma unroll
    for (int ntl = 0; ntl < 4; ++ntl) {
        const int v = h * 128 + 64 * half + 16 * ntl + fr;
        anw[ntl] = XPAR(P_ANW)[l * 512 + v];
#pragma unroll
        for (int ii = 0; ii < 4; ++ii) {
            const unsigned row = (unsigned)row0 + 16 * mti + fq * 4 + ii;
            aov[ntl][ii] = XU[row * NIN + C_AO + v]; azv[ntl][ii] = XU[row * NIN + C_AZ + v];
        }
    }
    u32x4 qraw, kraw, vblk[8];
    const int tgv = lane & 7, cgv = (wave & 1) * 8 + (lane >> 3);
    {
        const int tok = tid >> 3, k8 = (tid & 7) * 8;
        const bf16_t* ur = XU + (unsigned)(row0 + tok) * NIN;
        qraw = *(const u32x4*)(ur + C_AQ + h * 64 + k8); kraw = *(const u32x4*)(ur + C_AK + h * 64 + k8);
        if (wave == 2 || wave == 3) {
#pragma unroll
            for (int t = 0; t < 8; ++t) vblk[t] = *(const u32x4*)(XU + (unsigned)(row0 + 8 * tgv + t) * NIN + C_AV + h * 128 + cgv * 8);
        }
    }
    if (wave == 0) {
        const bf16_t* ur = XU + (unsigned)(row0 + lane) * NIN;
        const float fg = bf2f(ur[C_AF + h]) + XPAR(P_AFB)[l * 4 + h], ig = bf2f(ur[C_AI + h]) + XPAR(P_AIB)[l * 4 + h];
        const float b = wave_scan_sum(logsigf_(fg), lane);
        const float dd = ig - b;
        const float cm = wave_scan_max(dd, lane);
        const float ms = XMS[nh * 128 + c];
        const float mt = b + fmaxf(ms, cm);
        bv[lane] = b; dv[lane] = dd; mtv[lane] = mt; siv[lane] = __expf(b + ms - mt);
        nsv[lane] = XNS[((size_t)nh * 128 + c) * 64 + lane];
    }
    {
        const int tok = tid >> 3, k8 = (tid & 7) * 8;
        *(LAS u32x4*)(Qs + ((tok * 72 + k8) << 1)) = qraw;
        float x[8]; unpack8(kraw, x);
#pragma unroll
        for (int j = 0; j < 8; ++j) x[j] *= 0.125f;
        *(LAS u32x4*)(Ks + ((tok * 72 + k8) << 1)) = pack8(x);
    }
    if (wave == 2 || wave == 3) {
#pragma unroll
        for (int j = 0; j < 8; ++j) {
            u32x4 w;
#pragma unroll
            for (int tp = 0; tp < 4; ++tp) {
                const unsigned lo = (vblk[2 * tp][j >> 1] >> ((j & 1) * 16)) & 0xffffu, hi = (vblk[2 * tp + 1][j >> 1] >> ((j & 1) * 16)) & 0xffffu;
                w[tp] = lo | (hi << 16);
            }
            *(LAS u32x4*)(Vt + (((cgv * 8 + j) * 72 + 8 * tgv) << 1)) = w;
        }
    }
    __syncthreads();
    bf16x8 qa[2];
    qa[0] = lds_frag(Qs, 16 * mti + fr, fq * 8, 72); qa[1] = lds_frag(Qs, 16 * mti + fr, 32 + fq * 8, 72);
    {
        float x0[8], x1[8]; unpack8(__builtin_bit_cast(u32x4, qa[0]), x0); unpack8(__builtin_bit_cast(u32x4, qa[1]), x1);
        float d = 0.f;
#pragma unroll
        for (int j = 0; j < 8; ++j) d += x0[j] * nsv[fq * 8 + j] + x1[j] * nsv[32 + fq * 8 + j];
        d += __shfl_xor(d, 16); d += __shfl_xor(d, 32);
        if (fq == 0) qnv[wave * 16 + fr] = d;
    }
    float rsum[4] = {0.f, 0.f, 0.f, 0.f};
#pragma unroll
    for (int ntl = 0; ntl < 4; ++ntl) {
        f32x4 s = {0.f, 0.f, 0.f, 0.f};
        s = mfma16(qa[0], lds_frag(Ks, 16 * ntl + fr, fq * 8, 72), s);
        s = mfma16(qa[1], lds_frag(Ks, 16 * ntl + fr, 32 + fq * 8, 72), s);
#pragma unroll
        for (int ii = 0; ii < 4; ++ii) {
            const int t = 16 * mti + fq * 4 + ii, sidx = 16 * ntl + fr;
            const float wgt = (sidx <= t) ? __expf(bv[t] + dv[sidx] - mtv[t]) : 0.f;
            const float sv = wgt * s[ii];
            rsum[ii] += sv;
            *(LAS bf16_t*)(Sb + (((fq * 4 + ii) * 72 + sidx) << 1)) = (bf16_t)f2bf(sv);
        }
    }
    LDS_FENCE();
    f32x4 acc[4];
#pragma unroll
    for (int ntl = 0; ntl < 4; ++ntl) acc[ntl] = (f32x4){0.f, 0.f, 0.f, 0.f};
#pragma unroll
    for (int kk = 0; kk < 2; ++kk) {
        const bf16x8 a = lds_frag(Sb, fr, kk * 32 + fq * 8, 72);
#pragma unroll
        for (int ntl = 0; ntl < 4; ++ntl) acc[ntl] = mfma16(a, lds_frag(Vt, 64 * half + 16 * ntl + fr, kk * 32 + fq * 8, 72), acc[ntl]);
    }
    {
        const float sia = siv[16 * mti + fr];
#pragma unroll
        for (int kk = 0; kk < 2; ++kk) {
            float x[8]; unpack8(__builtin_bit_cast(u32x4, qa[kk]), x);
#pragma unroll
            for (int j = 0; j < 8; ++j) x[j] *= sia;
            const bf16x8 a = as_frag(pack8(x));
#pragma unroll
            for (int ntl = 0; ntl < 4; ++ntl) acc[ntl] = mfma16(a, as_frag(csf[kk][ntl]), acc[ntl]);
        }
    }
    float hv[4][4], ssl[4];
#pragma unroll
    for (int ii = 0; ii < 4; ++ii) {
        const int t = 16 * mti + fq * 4 + ii;
        const float den = red16(rsum[ii]) + siv[t] * qnv[wave * 16 + fq * 4 + ii];
        const float inv = rcpf_(fmaxf(fabsf(den), __expf(-mtv[t])));
        float ss = 0.f;
#pragma unroll
        for (int ntl = 0; ntl < 4; ++ntl) { hv[ntl][ii] = acc[ntl][ii] * inv; ss += hv[ntl][ii] * hv[ntl][ii]; }
        ssl[ii] = red16(ss);
        if (fr == 0) ssqp[t * 2 + half] = ssl[ii];
    }
    __syncthreads();
#pragma unroll
    for (int ii = 0; ii < 4; ++ii) {
        const int t = 16 * mti + fq * 4 + ii;
        const float rs = rsqrtf((ssqp[t * 2] + ssqp[t * 2 + 1]) * (1.f / 128.f) + EPS);
        const unsigned row = (unsigned)row0 + t;
#pragma unroll
        for (int ntl = 0; ntl < 4; ++ntl) {
            const int v = h * 128 + 64 * half + 16 * ntl + fr;
            const float ao = bf2f(aov[ntl][ii]), az = bf2f(azv[ntl][ii]);
            XMIX[row * DMIX + v] = (bf16_t)f2bf(hv[ntl][ii] * rs * anw[ntl] * sigmoidf_(ao) * siluf_(az));
        }
    }
    __syncthreads();
}

__device__ __forceinline__ void ssd_out(lptr lds, const Ctx& X, int l, int task, int tid) {
    const int g = task & 1, c = (task >> 1) & 127, n = task >> 8;
    const int lane = tid & 63, wave = tid >> 6, fr = lane & 15, fq = lane >> 4;
    const int seq0 = n * SEQ, row0 = seq0 + c * 64;
    lptr Cm = lds;
    lptr Bm = lds + 17408;
    lptr Xt = lds + 34816;
    LAS float* CBf = (LAS float*)(lds + 71680);
    LAS float* av = (LAS float*)(lds + 89088);
    LAS float* dtv = (LAS float*)(lds + 90112);
    LAS float* ssq = (LAS float*)(lds + 91136);
    const int hl = wave >> 1, th = wave & 1, hh = 4 * g + hl;
    u32x4 hsf[4][4];
    {
        const bf16_t* hs = XHSB + ((size_t)(n * 8 + hh) * 128 + c) * 8192;
#pragma unroll
        for (int kk = 0; kk < 4; ++kk)
#pragma unroll
            for (int ntl = 0; ntl < 4; ++ntl) hsf[kk][ntl] = *(const u32x4*)(hs + (16 * ntl + fr) * 128 + kk * 32 + fq * 8);
    }
    if (wave < 4) {
        const int hh = 4 * g + wave;
        const float dt = softplusf_(bf2f(XU[(unsigned)(row0 + lane) * NIN + C_BDT + hh]) + XPAR(P_DTB)[l * 8 + hh]);
        const float A = -__expf(XPAR(P_ALOG)[l * 8 + hh]);
        av[wave * 64 + lane] = wave_scan_sum(dt * A, lane);
        dtv[wave * 64 + lane] = dt;
    }
    {
        const float* cw = XPAR(P_CW) + l * 4096; const float* cb = XPAR(P_CB) + l * 1024;
        float o[8][8];
        if (wave < 4) {
            const int tg = lane & 7, cg = wave * 8 + (lane >> 3);
            conv8x8(XU, seq0, c * 64 + 8 * tg, g * 256 + cg * 8, cw, cb, o);
#pragma unroll
            for (int jx = 0; jx < 8; ++jx) {
                float v[8];
#pragma unroll
                for (int t = 0; t < 8; ++t) v[t] = o[t][jx];
                *(LAS u32x4*)(Xt + (((cg * 8 + jx) * 72 + 8 * tg) << 1)) = pack8(v);
            }
        } else {
            const int tg = lane >> 3, s8 = ((wave & 1) * 8 + (lane & 7)) * 8;
            conv8x8(XU, seq0, c * 64 + 8 * tg, (wave < 6 ? 512 : 768) + g * 128 + s8, cw, cb, o);
            lptr dstm = wave < 6 ? Bm : Cm;
#pragma unroll
            for (int t = 0; t < 8; ++t) *(LAS u32x4*)(dstm + (((8 * tg + t) * 136 + s8) << 1)) = pack8(o[t]);
        }
    }
    __syncthreads();
    u32x2 bzv[2][4]; f32x4 bnw[4];
#pragma unroll
    for (int ntl = 0; ntl < 4; ++ntl) {
        bnw[ntl] = *(const f32x4*)(XPAR(P_BNW) + l * 512 + hh * 64 + 16 * ntl + 4 * fq);
#pragma unroll
        for (int mi = 0; mi < 2; ++mi) bzv[mi][ntl] = *(const u32x2*)(XU + ((unsigned)row0 + 16 * (2 * th + mi) + fr) * NIN + C_BZ + hh * 64 + 16 * ntl + 4 * fq);
    }
    {
        const int mt = wave >> 1;
#pragma unroll
        for (int q = 0; q < 2; ++q) {
            const int ntl = 2 * (wave & 1) + q;
            f32x4 acc = {0.f, 0.f, 0.f, 0.f};
#pragma unroll
            for (int kk = 0; kk < 4; ++kk) acc = mfma16(lds_frag(Cm, 16 * mt + fr, kk * 32 + fq * 8, 136), lds_frag(Bm, 16 * ntl + fr, kk * 32 + fq * 8, 136), acc);
#pragma unroll
            for (int ii = 0; ii < 4; ++ii) CBf[(16 * mt + fq * 4 + ii) * 68 + 16 * ntl + fr] = acc[ii];
        }
    }
    __syncthreads();
    f32x4 y1[2][4], y2[2][4];
#pragma unroll
    for (int mi = 0; mi < 2; ++mi)
#pragma unroll
        for (int ntl = 0; ntl < 4; ++ntl) { y1[mi][ntl] = (f32x4){0.f, 0.f, 0.f, 0.f}; y2[mi][ntl] = (f32x4){0.f, 0.f, 0.f, 0.f}; }
#pragma unroll
    for (int kk = 0; kk < 2; ++kk) {
        bf16x8 bx[4];
#pragma unroll
        for (int ntl = 0; ntl < 4; ++ntl) bx[ntl] = lds_frag(Xt, hl * 64 + 16 * ntl + fr, kk * 32 + fq * 8, 72);
#pragma unroll
        for (int mi = 0; mi < 2; ++mi) {
            const int t = 16 * (2 * th + mi) + fr, u0 = kk * 32 + fq * 8;
            const float at = av[hl * 64 + t];
            float w[8];
#pragma unroll
            for (int j = 0; j < 8; ++j) {
                const int uu = u0 + j;
                w[j] = (uu <= t) ? CBf[t * 68 + uu] * __expf(at - av[hl * 64 + uu]) * dtv[hl * 64 + uu] : 0.f;
            }
            const bf16x8 a = as_frag(pack8(w));
#pragma unroll
            for (int ntl = 0; ntl < 4; ++ntl) y1[mi][ntl] = mfma16(bx[ntl], a, y1[mi][ntl]);
        }
    }
    {
#pragma unroll
        for (int kk = 0; kk < 4; ++kk) {
            bf16x8 bh[4];
#pragma unroll
            for (int ntl = 0; ntl < 4; ++ntl) bh[ntl] = as_frag(hsf[kk][ntl]);
#pragma unroll
            for (int mi = 0; mi < 2; ++mi) {
                const bf16x8 a = lds_frag(Cm, 16 * (2 * th + mi) + fr, kk * 32 + fq * 8, 136);
#pragma unroll
                for (int ntl = 0; ntl < 4; ++ntl) y2[mi][ntl] = mfma16(bh[ntl], a, y2[mi][ntl]);
            }
        }
    }
    const float Dh = XPAR(P_BD)[l * 8 + hh];
#pragma unroll
    for (int mi = 0; mi < 2; ++mi) {
        const int t = 16 * (2 * th + mi) + fr;
        const float ea = __expf(av[hl * 64 + t]);
        float ss = 0.f;
#pragma unroll
        for (int ntl = 0; ntl < 4; ++ntl) {
            const float z[4] = {__uint_as_float(bzv[mi][ntl][0] << 16), __uint_as_float(bzv[mi][ntl][0] & 0xffff0000u), __uint_as_float(bzv[mi][ntl][1] << 16), __uint_as_float(bzv[mi][ntl][1] & 0xffff0000u)};
#pragma unroll
            for (int ii = 0; ii < 4; ++ii) {
                const int p = 16 * ntl + 4 * fq + ii;
                const float xv = bf2f(*(const LAS bf16_t*)(Xt + (((hl * 64 + p) * 72 + t) << 1)));
                const float y = y1[mi][ntl][ii] + ea * y2[mi][ntl][ii] + Dh * xv;
                const float gbv = y * siluf_(z[ii]);
                y1[mi][ntl][ii] = gbv; ss += gbv * gbv;
            }
        }
        ss += __shfl_xor(ss, 16); ss += __shfl_xor(ss, 32);
        if (fq == 0) ssq[t * 4 + hl] = ss;
    }
    __syncthreads();
#pragma unroll
    for (int mi = 0; mi < 2; ++mi) {
        const int t = 16 * (2 * th + mi) + fr;
        const float rs = rsqrtf((ssq[t * 4] + ssq[t * 4 + 1] + ssq[t * 4 + 2] + ssq[t * 4 + 3]) * (1.f / 256.f) + EPS);
        const unsigned row = (unsigned)row0 + t;
#pragma unroll
        for (int ntl = 0; ntl < 4; ++ntl) {
            u32x2 w; w[0] = pk2(y1[mi][ntl][0] * rs * bnw[ntl][0], y1[mi][ntl][1] * rs * bnw[ntl][1]); w[1] = pk2(y1[mi][ntl][2] * rs * bnw[ntl][2], y1[mi][ntl][3] * rs * bnw[ntl][3]);
            *(u32x2*)(XMIX + row * DMIX + 512 + hh * 64 + 16 * ntl + 4 * fq) = w;
        }
    }
    __syncthreads();
}


#define XB_TMO      128
#define XB_XCNT(j)  (256  + 64 * (j))
#define XB_XSUB(j)  (1280 + 64 * (j))
#define XB_XGEN(j)  (2304 + 64 * (j))
#define XB_TOP      3328
#define XB_TOPGEN   3392
#define XCD_BAR_WORDS 3456
#define XB_SPIN_CAP (1u << 18)
__device__ __forceinline__ unsigned xb_ld(unsigned* p)              { return __hip_atomic_load(p, __ATOMIC_RELAXED, __HIP_MEMORY_SCOPE_AGENT); }
__device__ __forceinline__ unsigned xb_add(unsigned* p, unsigned v) { return __hip_atomic_fetch_add(p, v, __ATOMIC_RELAXED, __HIP_MEMORY_SCOPE_AGENT); }
__device__ __forceinline__ unsigned xb_xcc_id() { return (unsigned)__builtin_amdgcn_s_getreg((3 << 11) | 20) & 0xFu; }
#define XB_SPIN(cond, bar) do { unsigned _sp = 0; while (cond) { __builtin_amdgcn_s_sleep(1); \
    if ((++_sp & 255u) == 0u) { if (xb_ld(&(bar)[XB_TMO])) break; if (_sp > XB_SPIN_CAP) { atomicAdd(&(bar)[XB_TMO], 1u); break; } } } } while (0)
struct XcdBarrier { unsigned* bar; unsigned x; volatile LAS unsigned* st; };
__device__ __forceinline__ XcdBarrier xcd_barrier_post(unsigned* bar, volatile LAS unsigned* st) {
    XcdBarrier b; b.bar = bar; b.x = xb_xcc_id(); b.st = st;
    if (threadIdx.x == 0) (void)xb_add(&bar[XB_XCNT(b.x)], 1u);
    return b;
}
__device__ __forceinline__ void xcd_barrier_complete(unsigned* bar, unsigned x, unsigned& nloc, unsigned& nx) {
    const unsigned G = gridDim.x * gridDim.y * gridDim.z;
    unsigned sum, cnt, mine, sp = 0u;
    for (;;) {
        sum = 0u; cnt = 0u; mine = 0u;
#pragma unroll
        for (unsigned j = 0; j < 16; ++j) { const unsigned c = xb_ld(&bar[XB_XCNT(j)]); sum += c; cnt += (c > 0u) ? 1u : 0u; mine = (j == x) ? c : mine; }
        if (sum == G) break;
        __builtin_amdgcn_s_sleep(1);
        if ((++sp & 255u) == 0u) { if (xb_ld(&bar[XB_TMO])) break; if (sp > XB_SPIN_CAP) { atomicAdd(&bar[XB_TMO], 1u); break; } }
    }
    nloc = mine > 0u ? mine : 1u; nx = cnt > 0u ? cnt : 1u;
}
__device__ __forceinline__ void xcd_barrier(const XcdBarrier& b) {
    asm volatile("s_waitcnt vmcnt(0)" ::: "memory");
    __syncthreads();
    if (threadIdx.x == 0) {
        unsigned* bar = b.bar;
        __builtin_amdgcn_s_waitcnt(0);
        unsigned nloc = b.st[0], nx = b.st[1];
        if (nloc == 0u) { xcd_barrier_complete(bar, b.x, nloc, nx); b.st[0] = nloc; b.st[1] = nx; }
        const unsigned old = xb_add(&bar[XB_XSUB(b.x)], 1u);
        const unsigned gen = old / nloc;
        if (old + 1u == (gen + 1u) * nloc) {
            __builtin_amdgcn_fence(__ATOMIC_RELEASE, "agent");
            asm volatile("s_waitcnt vmcnt(0)" ::: "memory");
            const unsigned og = xb_add(&bar[XB_TOP], 1u);
            const unsigned tg = og / nx;
            if (og + 1u == (tg + 1u) * nx) xb_add(&bar[XB_TOPGEN], 1u);
            else XB_SPIN(xb_ld(&bar[XB_TOPGEN]) == tg, bar);
            __builtin_amdgcn_fence(__ATOMIC_ACQUIRE, "agent");
            xb_add(&bar[XB_XGEN(b.x)], 1u);
            asm volatile("s_waitcnt vmcnt(0)" ::: "memory");
        } else {
            XB_SPIN(xb_ld(&bar[XB_XGEN(b.x)]) == gen, bar);
            __builtin_amdgcn_fence(__ATOMIC_ACQUIRE, "agent");
            asm volatile("s_waitcnt vmcnt(0)" ::: "memory");
        }
    }
    __syncthreads();
}

__global__ void __launch_bounds__(NT, 2) mega(Args args) {
    __shared__ __attribute__((aligned(16))) unsigned char lds_raw[LDS_BYTES];
    lptr lds = (lptr)lds_raw;
    cg::grid_group grid = cg::this_grid();
    const int tid = threadIdx.x, bid = blockIdx.x, G = gridDim.x;
    Ctx X;
    X.xp = args.in[IN_XP]; X.xs = args.in[IN_XS]; X.stC = args.in[IN_STC]; X.stN = args.in[IN_STN]; X.stM = args.in[IN_STM]; X.ssm = args.in[IN_SSM];
    X.conv = args.in[IN_CONV]; X.ck = args.in[IN_CK]; X.cv = args.in[IN_CV]; X.out = args.out; X.ws = args.ws;
    const int lo = args.ph_lo, hi = args.ph_hi;
    volatile LAS unsigned* xst = (volatile LAS unsigned*)(lds + LDS_BYTES - 16);
    if (tid == 0) { xst[0] = 0u; xst[1] = 0u; }
    __syncthreads();
    XcdBarrier xbar = xcd_barrier_post((unsigned*)(args.ws + WS_BAR), xst);
#define IN(k) (lo <= (k) && (k) < hi)
#define SEAM(k) do { if (IN(k) && IN((k) + 1)) { for (int _r = 0; _r < REP_SYNC; ++_r) { if (lo < 0) grid.sync(); xcd_barrier(xbar); } } } while (0)
    if (IN(0)) { for (int _r = 0; _r < REP_P0; ++_r) prologue(lds, X, args, G, bid, tid); }
    SEAM(0);
    for (int l = 0; l < 4; ++l) {
        const int pb = 1 + l * 5;
        if (IN(pb)) for (int _r = 0; _r < REP_P1; ++_r) {
            pg8::Gemm g{XXB, XWIN + (size_t)l * NIN * D, MPAD, NIN, D}; pg8::StaticOrder S; S.init(TP, NIN, G, bid);
            pg8::EpiU E{XU, XSSQ};
            pg8::gemm_phase<pg8::EpiU, pg8::StaticOrder, false, GEMM_SP2, GEMM_ALIGN>(lds, g, S, E, OPQ(tid));
            if (l == 0 && bid >= G - 20) {
                pg8::SampleOrder S2{G - 20, 20, bid}; pg8::EpiUh E2{XU, XSSQ};
                pg8::gemm_phase<pg8::EpiUh, pg8::SampleOrder, true>(lds, g, S2, E2, OPQ(tid));
            }
        }
        SEAM(pb);
        if (IN(pb + 1)) for (int _r = 0; _r < REP_P2; ++_r) {
            for (int t = bid; t < 256; t += G) for (int _q = 0; _q < RT_SAMPLE; ++_q) {
                if (t < 128) sample_task(lds, X, l, t, 1, OPQ(tid));
                else { sample_task(lds, X, l, t - 128, 0, OPQ(tid)); sample_task(lds, X, l, t - 128, 2, OPQ(tid)); }
            }
            for (int t = bid; t < 256; t += G) for (int _q = 0; _q < RT_SWA; ++_q) swa_prompt(lds, X, l, t, OPQ(tid));
            for (int t = bid; t < 512; t += G) for (int _q = 0; _q < RT_SLOC; ++_q) ssd_local(lds, X, l, t, OPQ(tid));
            for (int t = bid; t < 1024; t += G) for (int _q = 0; _q < RT_MLOC; ++_q) mlstm_local(lds, X, l, t, OPQ(tid));
            if (bid == G - 1) {
                for (int i = tid; i < 2 * 3 * 1024; i += NT) {
                    const int ch = i & 1023, j = (i >> 10) % 3, n = i / 3072;
                    X.out[O_PCONV + (((size_t)l * 2 + n) * 3 + j) * 1024 + ch] = bf2f(XU[(size_t)(n * SEQ + SEQ - 3 + j) * NIN + C_BX + ch]);
                }
            }
        }
        SEAM(pb + 1);
        if (IN(pb + 2)) {
            if (bid >= G - 4) {
                pg8::Gemm g{XMIX, XWOUT + (size_t)l * D * DMIX, MPAD, D, DMIX}; pg8::SampleOrder S{G - 4, 4, bid};
                if (l == 0) { pg8::EpiRes_<1, 0> E{X.xp, X.xs, X.out, XXB, XSSQ}; pg8::gemm_phase<pg8::EpiRes_<1, 0>, pg8::SampleOrder, true>(lds, g, S, E, OPQ(tid)); }
                else if (l < 3) { pg8::EpiRes_<1, 1> E{X.xp, X.xs, X.out, XXB, XSSQ}; pg8::gemm_phase<pg8::EpiRes_<1, 1>, pg8::SampleOrder, true>(lds, g, S, E, OPQ(tid)); }
                else { pg8::EpiRes_<1, 2> E{X.xp, X.xs, X.out, XXB, XSSQ}; pg8::gemm_phase<pg8::EpiRes_<1, 2>, pg8::SampleOrder, true>(lds, g, S, E, OPQ(tid)); }
            }
            for (int _r = 0; _r < REP_P3; ++_r) scans(X, l, bid * NT + OPQ(tid), G * NT);
        }
        SEAM(pb + 2);
        if (IN(pb + 3)) for (int _r = 0; _r < REP_P4; ++_r) {
            for (int task = bid; task < 1536; task += G) {
                if (task < 512) for (int _q = 0; _q < RT_SOUT; ++_q) ssd_out(lds, X, l, task, OPQ(tid));
                else mlstm_out(lds, X, l, task - 512, OPQ(tid));
            }
        }
        SEAM(pb + 3);
        if (IN(pb + 4)) {
            {
                pg8::Gemm g{XMIX, XWOUT + (size_t)l * D * DMIX, MPAD, D, DMIX}; pg8::StaticOrder S; S.init(TP, D, G, bid);
#ifdef PROBE_P5
                { pg8::EpiProbe EP{(const unsigned*)(X.ws + 64), XSSQ}; pg8::gemm_phase<pg8::EpiProbe, pg8::StaticOrder, false, GEMM_SP2>(lds, g, S, EP, OPQ(tid)); }
#endif
                if (l == 0) { pg8::EpiRes_<2, 0> E{X.xp, X.xs, X.out, XXB, XSSQ}; pg8::gemm_phase<pg8::EpiRes_<2, 0>, pg8::StaticOrder, false, GEMM_SP2, GEMM_ALIGN>(lds, g, S, E, OPQ(tid)); }
                else if (l < 3) { pg8::EpiRes_<2, 1> E{X.xp, X.xs, X.out, XXB, XSSQ}; pg8::gemm_phase<pg8::EpiRes_<2, 1>, pg8::StaticOrder, false, GEMM_SP2, GEMM_ALIGN>(lds, g, S, E, OPQ(tid)); }
                else { pg8::EpiRes_<2, 2> E{X.xp, X.xs, X.out, XXB, XSSQ}; pg8::gemm_phase<pg8::EpiRes_<2, 2>, pg8::StaticOrder, false, GEMM_SP2, GEMM_ALIGN>(lds, g, S, E, OPQ(tid)); }
            }
            if (l < 3 && bid < 20) {
                pg8::Gemm g{XXB, XWIN + (size_t)(l + 1) * NIN * D, MPAD, NIN, D}; pg8::SampleOrder S{0, 20, bid};
                pg8::EpiUh E{XU, XSSQ};
                pg8::gemm_phase<pg8::EpiUh, pg8::SampleOrder, true>(lds, g, S, E, OPQ(tid));
            }
        }
        SEAM(pb + 4);
    }
#undef IN
#undef SEAM
}

extern "C" void kernel_launch(void* const* d_in, const int* in_sizes, int n_in, void* d_out, int out_size, void* d_ws, size_t ws_size, hipStream_t stream) {
    static int grid_blocks = 0;
    if (!grid_blocks) {
        int dev = 0, cus = 0, per_cu = 0;
        hipGetDevice(&dev);
        hipDeviceGetAttribute(&cus, hipDeviceAttributeMultiprocessorCount, dev);
        hipOccupancyMaxActiveBlocksPerMultiprocessor(&per_cu, mega, NT, 0);
        if (per_cu < 1) { fprintf(stderr, "occupancy query returned %d\n", per_cu); per_cu = 1; }
        grid_blocks = cus * 1;
        if (ws_size < WS_END) fprintf(stderr, "workspace too small: %zu < %zu\n", ws_size, (size_t)WS_END);
    }
    (void)hipMemsetAsync(d_ws, 0, 16384, stream);
    Args a{};
    for (int i = 0; i < 24; ++i) a.in[i] = (const float*)d_in[i];
    a.out = (float*)d_out; a.ws = (unsigned char*)d_ws;
    const int NPH = 21;
#if MULTI_LAUNCH
    for (int p = 0; p < NPH; ++p) {
        a.ph_lo = p; a.ph_hi = p + 1;
        void* kargs[] = {&a};
        hipError_t e = hipLaunchCooperativeKernel((void*)mega, dim3(grid_blocks), dim3(NT), kargs, 0, stream);
        if (e != hipSuccess) fprintf(stderr, "cooperative launch failed: %s (grid %d)\n", hipGetErrorString(e), grid_blocks);
    }
#else
    a.ph_lo = 0; a.ph_hi = NPH;
    void* kargs[] = {&a};
    hipError_t e = hipLaunchCooperativeKernel((void*)mega, dim3(grid_blocks), dim3(NT), kargs, 0, stream);
    if (e != hipSuccess) fprintf(stderr, "cooperative launch failed: %s (grid %d)\n", hipGetErrorString(e), grid_blocks);
#endif
}
```

```cpp
#include <hip/hip_runtime.h>
#include <hip/hip_cooperative_groups.h>
#include <cstdio>
#include <cstdint>
namespace cg = cooperative_groups;

#ifndef REP_SYNC
#define REP_SYNC 1
#endif
#ifndef REP_P1
#define REP_P1 1
#endif
#ifndef REP_P2
#define REP_P2 1
#endif
#ifndef REP_P3
#define REP_P3 1
#endif
#ifndef REP_P0
#define REP_P0 1
#endif
#ifndef REP_P4
#define REP_P4 1
#endif
#ifndef RT_SAMPLE
#define RT_SAMPLE 1
#endif
#ifndef RT_SWA
#define RT_SWA 1
#endif
#ifndef RT_SLOC
#define RT_SLOC 1
#endif
#ifndef RT_MLOC
#define RT_MLOC 1
#endif
#ifndef RT_SOUT
#define RT_SOUT 1
#endif
#ifndef GEMM_SP2
#define GEMM_SP2 true
#endif
#ifndef GEMM_ALIGN
#define GEMM_ALIGN true
#endif
#ifndef MULTI_LAUNCH
#define MULTI_LAUNCH 0
#endif

#define LAS __attribute__((address_space(3)))
typedef unsigned short bf16_t;
typedef short bf16x8 __attribute__((ext_vector_type(8)));
typedef float f32x4 __attribute__((ext_vector_type(4)));
typedef float f32x2 __attribute__((ext_vector_type(2)));
typedef unsigned u32x4 __attribute__((ext_vector_type(4)));
typedef unsigned u32x2 __attribute__((ext_vector_type(2)));
typedef __bf16 bf16x2_t __attribute__((ext_vector_type(2)));
typedef LAS unsigned char* lptr;

constexpr int D = 1024, DIN = 4880, NIN = 5120, DMIX = 1536, TP = 16384, MTOK = 16512, MPAD = 16640, SEQ = 8192;
constexpr int C_AQ = 0, C_AK = 256, C_AV = 512, C_AO = 1024, C_AZ = 1536, C_AI = 2048, C_AF = 2052, C_BZ = 2056, C_BX = 2568, C_BB = 3080, C_BC = 3336,
              C_BDT = 3592, C_CQ = 3600, C_CK = 4112, C_CV = 4240, C_CZ = 4368;
constexpr float EPS = 1e-6f;
constexpr size_t O_YP = 0, O_YS = 16777216, O_PC = 16908288, O_PN = 17170432, O_PM = 17172480, O_PH = 17172512, O_PCONV = 17696800, O_PK = 17721376,
                 O_PV = 17852448, O_SC = 17983520, O_SN = 34760736, O_SM = 34891808, O_SH = 34893856, O_SCONV = 68448288, O_SK = 70021152, O_SV = 78409760;
constexpr size_t WS_BAR = 0;
constexpr size_t WS_PAR = 16384;
constexpr size_t WS_WIN = WS_PAR + 102400;
constexpr size_t WS_WOUT = WS_WIN + (size_t)4 * NIN * D * 2;
constexpr size_t WS_XB = WS_WOUT + (size_t)4 * D * DMIX * 2;
constexpr size_t WS_U = WS_XB + (size_t)MPAD * D * 2;
constexpr size_t WS_MIX = WS_U + (size_t)MPAD * NIN * 2;
constexpr size_t WS_SSQ = WS_MIX + (size_t)MPAD * DMIX * 2;
constexpr size_t WS_ROPE = WS_SSQ + (size_t)MPAD * 16 * 4;
constexpr size_t WS_MC = WS_ROPE + (size_t)8200 * 64 * 4;
constexpr size_t WS_MN = WS_MC + (size_t)8 * 128 * 8192 * 4;
constexpr size_t WS_ML = WS_MN + (size_t)8 * 128 * 64 * 4;
constexpr size_t WS_BL = WS_ML + 4096;
constexpr size_t WS_MS = WS_BL + 4096;
constexpr size_t WS_SA = WS_MS + 4096;
constexpr size_t WS_SH = WS_SA + 8192;
constexpr size_t WS_CSB = WS_SH + (size_t)16 * 128 * 8192 * 4;
constexpr size_t WS_HSB = WS_CSB + (size_t)8 * 128 * 8192 * 2;
constexpr size_t WS_NS = WS_HSB + (size_t)16 * 128 * 8192 * 2;
constexpr size_t WS_END = WS_NS + (size_t)8 * 128 * 64 * 4;
constexpr int LDS_BYTES = 139264;
constexpr int NT = 512;

struct Args { const float* in[24]; float* out; unsigned char* ws; int ph_lo, ph_hi; };

__device__ __forceinline__ float bf2f(unsigned v) { return __uint_as_float(v << 16); }
__device__ __forceinline__ unsigned pk2(float lo, float hi) { f32x2 v = {lo, hi}; bf16x2_t b = __builtin_convertvector(v, bf16x2_t); return __builtin_bit_cast(unsigned, b); }
__device__ __forceinline__ unsigned f2bf(float f) { return pk2(f, 0.f) & 0xffffu; }
__device__ __forceinline__ void unpack8(u32x4 w, float (&f)[8]) {
#pragma unroll
    for (int i = 0; i < 4; ++i) { f[2 * i] = __uint_as_float(w[i] << 16); f[2 * i + 1] = __uint_as_float(w[i] & 0xffff0000u); }
}
__device__ __forceinline__ u32x4 pack8(const float (&f)[8]) { u32x4 w; w[0] = pk2(f[0], f[1]); w[1] = pk2(f[2], f[3]); w[2] = pk2(f[4], f[5]); w[3] = pk2(f[6], f[7]); return w; }
__device__ __forceinline__ u32x4 pack8v(f32x4 a, f32x4 b) { u32x4 w; w[0] = pk2(a[0], a[1]); w[1] = pk2(a[2], a[3]); w[2] = pk2(b[0], b[1]); w[3] = pk2(b[2], b[3]); return w; }
__device__ __forceinline__ bf16x8 as_frag(u32x4 w) { return __builtin_bit_cast(bf16x8, w); }
__device__ __forceinline__ bf16x8 ldg_f32_frag(const float* p) { f32x4 a = *(const f32x4*)p, b = *(const f32x4*)(p + 4); return as_frag(pack8v(a, b)); }
__device__ __forceinline__ bf16x8 lds_frag(lptr base, int row, int k, int stride) { return *(const LAS bf16x8*)(base + ((row * stride + k) << 1)); }
__device__ __forceinline__ f32x4 mfma16(bf16x8 a, bf16x8 b, f32x4 c) { return __builtin_amdgcn_mfma_f32_16x16x32_bf16(a, b, c, 0, 0, 0); }
__device__ __forceinline__ float rcpf_(float x) { return __builtin_amdgcn_rcpf(x); }
__device__ __forceinline__ float sigmoidf_(float x) { return rcpf_(1.f + __expf(-x)); }
__device__ __forceinline__ float siluf_(float x) { return x * rcpf_(1.f + __expf(-x)); }
__device__ __forceinline__ float softplusf_(float x) { return x > 20.f ? x : log1pf(__expf(x)); }
__device__ __forceinline__ float logsigf_(float x) { return fminf(x, 0.f) - log1pf(__expf(-fabsf(x))); }
template <int CTRL, int RM> __device__ __forceinline__ float dpps(float ident, float v) { return __int_as_float(__builtin_amdgcn_update_dpp(__float_as_int(ident), __float_as_int(v), CTRL, RM, 0xf, false)); }
__device__ __forceinline__ float wave_scan_sum(float v, int) {
    v += dpps<0x111, 0xf>(0.f, v); v += dpps<0x112, 0xf>(0.f, v); v += dpps<0x114, 0xf>(0.f, v); v += dpps<0x118, 0xf>(0.f, v);
    v += dpps<0x142, 0xa>(0.f, v); v += dpps<0x143, 0xc>(0.f, v);
    return v;
}
__device__ __forceinline__ float wave_scan_max(float v, int) {
    const float NI = -3.0e38f;
    v = fmaxf(v, dpps<0x111, 0xf>(NI, v)); v = fmaxf(v, dpps<0x112, 0xf>(NI, v)); v = fmaxf(v, dpps<0x114, 0xf>(NI, v)); v = fmaxf(v, dpps<0x118, 0xf>(NI, v));
    v = fmaxf(v, dpps<0x142, 0xa>(NI, v)); v = fmaxf(v, dpps<0x143, 0xc>(NI, v));
    return v;
}
__device__ __forceinline__ float lane63(float v) { return __int_as_float(__builtin_amdgcn_readlane(__float_as_int(v), 63)); }
__device__ __forceinline__ float red16(float v);
__device__ __forceinline__ float red16max(float v);
__device__ __forceinline__ float wave_sum(float v) { v = red16(v); v += __shfl_xor(v, 16); v += __shfl_xor(v, 32); return v; }
__device__ __forceinline__ float wave_max(float v) { v = red16max(v); v = fmaxf(v, __shfl_xor(v, 16)); v = fmaxf(v, __shfl_xor(v, 32)); return v; }
template <int CTRL> __device__ __forceinline__ float dppf(float v) { return __int_as_float(__builtin_amdgcn_update_dpp(0, __float_as_int(v), CTRL, 0xf, 0xf, true)); }
__device__ __forceinline__ float red16(float v) { v += dppf<0xB1>(v); v += dppf<0x4E>(v); v += dppf<0x141>(v); v += dppf<0x140>(v); return v; }
__device__ __forceinline__ float red16max(float v) { v = fmaxf(v, dppf<0xB1>(v)); v = fmaxf(v, dppf<0x4E>(v)); v = fmaxf(v, dppf<0x141>(v)); v = fmaxf(v, dppf<0x140>(v)); return v; }
__device__ __forceinline__ int OPQ(int v) { asm volatile("" : "+v"(v)); return v; }
#define LDS_FENCE() asm volatile("s_waitcnt lgkmcnt(0)" ::: "memory")

namespace pg8 {
constexpr int BM = 256, BK = 64, HALF = 128, HTB = HALF * BK * 2, STAGE_BYTES = 8 * HTB, NXCD = 8, WGM = 8;
__host__ __device__ __forceinline__ int lds_byte(int r, int c) { const int st = (r >> 4) * 2 + (c >> 5), rr = r & 15, cc = c & 31, ob = rr * 64 + cc * 2; return st * 1024 + (ob ^ (((ob >> 9) & 1) << 5)); }
__host__ __device__ __forceinline__ void stage_rc(int b, int& R, int& C) { const int st = b / 1024, sb = b % 1024, swz = sb ^ (((sb >> 9) & 1) << 5); R = (st >> 1) * 16 + swz / 64; C = (st & 1) * 32 + (swz % 64) / 2; }
__host__ __device__ __forceinline__ int perm32(int rho) { const int n = rho >> 4, i = rho & 15; return 8 * (i >> 2) + 4 * n + (i & 3); }
struct Unit { int pm, pn; };
struct Gemm { const bf16_t* A; const bf16_t* Bt; int M, N, K; };
struct StaticOrder {
    int nM, nN, nwg, G, c;
    __device__ void init(int M, int N, int G_, int c_) { nM = M / BM; nN = N / BM; nwg = nM * nN; G = G_; c = c_; }
    __device__ bool next(int i, Unit& u) const {
        const long L = (long)i * G + c; if (L >= nwg) return false;
        int wgid = (int)L; { const int q = nwg / NXCD, r = nwg % NXCD, xcd = wgid % NXCD, off = wgid / NXCD; wgid = (xcd < r ? xcd * (q + 1) : r * (q + 1) + (xcd - r) * q) + off; }
        const int nig = WGM * nN, gid = wgid / nig, fm = gid * WGM, gsz = (nM - fm) < WGM ? (nM - fm) : WGM;
        u.pm = fm + ((wgid % nig) % gsz); u.pn = (wgid % nig) / gsz; return true;
    }
};
template <int NAI> struct EpiU_ {
    bf16_t* U; const float* ssq;
    __device__ __forceinline__ void operator()(const f32x4 (&acc)[2][2][4][2], const Unit& u, int wr, int wc, int fr, int fq) const {
        const int row0 = u.pm * BM + wr * 64 + fr, col0 = u.pn * BM + wc * 32 + 8 * fq;
#pragma unroll
        for (int ai = 0; ai < NAI; ++ai)
#pragma unroll
            for (int m = 0; m < 4; ++m) {
                const int r = row0 + ai * HALF + m * 16;
                const f32x4 s = *(const f32x4*)(ssq + (size_t)r * 16 + fq * 4);
                float st = s[0] + s[1] + s[2] + s[3]; st += __shfl_xor(st, 16); st += __shfl_xor(st, 32);
                const float rs = rsqrtf(st * (1.f / 1024.f) + EPS);
                bf16_t* rowp = U + (size_t)r * NIN + col0;
#pragma unroll
                for (int bj = 0; bj < 2; ++bj) *(u32x4*)(rowp + bj * HALF) = pack8v(acc[ai][bj][m][0] * rs, acc[ai][bj][m][1] * rs);
                __builtin_amdgcn_sched_barrier(0);
            }
    }
};
template <int NAI, int MODE> struct EpiRes_ {
    const float* xp; const float* xs; float* out; bf16_t* xb; float* ssq;
    __device__ __forceinline__ void operator()(const f32x4 (&acc)[2][2][4][2], const Unit& u, int wr, int wc, int fr, int fq) const {
        const int row0 = u.pm * BM + wr * 64 + fr, col0 = u.pn * BM + wc * 32 + 8 * fq;
#pragma unroll
        for (int ai = 0; ai < NAI; ++ai)
#pragma unroll
            for (int m = 0; m < 4; ++m) {
                const int r = row0 + ai * HALF + m * 16;
                const bool valid = r < MTOK;
                float part = 0.f;
#pragma unroll
                for (int bj = 0; bj < 2; ++bj) {
                    const int c = col0 + bj * HALF;
                    f32x4 o0 = {0.f, 0.f, 0.f, 0.f}, o1 = {0.f, 0.f, 0.f, 0.f};
                    if (MODE == 0) {
                        const float* src = r < TP ? xp + (size_t)r * D : xs + (size_t)(r - TP) * D;
                        if (valid) { o0 = __builtin_nontemporal_load((const f32x4*)(src + c)); o1 = __builtin_nontemporal_load((const f32x4*)(src + c + 4)); }
                    } else {
                        float f[8]; unpack8(*(const u32x4*)(xb + (size_t)r * D + c), f);
                        o0 = (f32x4){f[0], f[1], f[2], f[3]}; o1 = (f32x4){f[4], f[5], f[6], f[7]};
                    }
                    const f32x4 v0 = acc[ai][bj][m][0] + o0, v1 = acc[ai][bj][m][1] + o1;
                    if (MODE == 2) {
                        if (valid) { __builtin_nontemporal_store(v0, (f32x4*)(out + (size_t)r * D + c)); __builtin_nontemporal_store(v1, (f32x4*)(out + (size_t)r * D + c + 4)); }
                    } else {
                        *(u32x4*)(xb + (size_t)r * D + c) = pack8v(v0, v1);
                        part += v0[0] * v0[0] + v0[1] * v0[1] + v0[2] * v0[2] + v0[3] * v0[3] + v1[0] * v1[0] + v1[1] * v1[1] + v1[2] * v1[2] + v1[3] * v1[3];
                    }
                }
                if (MODE != 2) {
                    part += __shfl_xor(part, 16); part += __shfl_xor(part, 32);
                    if (fq == 0) ssq[(size_t)r * 16 + u.pn * 4 + wc] = part;
                }
                __builtin_amdgcn_sched_barrier(0);
            }
    }
};

typedef EpiU_<2> EpiU; typedef EpiU_<1> EpiUh;
struct EpiProbe {
    const unsigned* flag; float* dst;
    __device__ __forceinline__ void operator()(const f32x4 (&acc)[2][2][4][2], const Unit& u, int wr, int wc, int fr, int fq) const {
        if (__hip_atomic_load(flag, __ATOMIC_RELAXED, __HIP_MEMORY_SCOPE_AGENT) == 12345u) {
            f32x4 t = {0.f, 0.f, 0.f, 0.f};
#pragma unroll
            for (int a = 0; a < 2; ++a)
#pragma unroll
                for (int b = 0; b < 2; ++b)
#pragma unroll
                    for (int m = 0; m < 4; ++m)
#pragma unroll
                        for (int n = 0; n < 2; ++n) t += acc[a][b][m][n];
            *(f32x4*)(dst + (size_t)(u.pm * 4 + u.pn) * 2048 + (wr * 4 + wc) * 256 + (fq * 16 + fr) * 4) = t;
        }
    }
};
struct SampleOrder {
    int first, cnt, c;
    __device__ bool next(int i, Unit& u) const { if (i != 0 || c < first || c >= first + cnt) return false; u.pm = 64; u.pn = c - first; return true; }
};
template <class Epi, class Sched, bool HALF_M = false, bool SP2 = false, bool ALIGN_EPI = false>
__device__ __forceinline__ void gemm_phase(lptr lds, const Gemm g, const Sched& S, const Epi& E, const int tid) {
    const int wid = __builtin_amdgcn_readfirstlane(tid >> 6), lane = tid & 63, wr = wid >> 2, wc = wid & 3, fr = lane & 15, fq = lane >> 4;
    const int K = g.K, nt = K / BK;
    unsigned voffA[2], voffB[2];
#pragma unroll
    for (int i = 0; i < 2; ++i) { int R, C; stage_rc(tid * 16 + i * 8192, R, C); const int Rb = (R & ~31) + perm32(R & 31);
        voffA[i] = (unsigned)(R * K + C) * 2u; voffB[i] = (unsigned)(Rb * K + C) * 2u; }
    const size_t kstep = (size_t)(BK * 2);
    const size_t hstep = (size_t)HALF * K * 2;
    const size_t tstep = 2 * hstep;
    const unsigned ldsw = (unsigned)wid * 1024u;
    const int aoff = lds_byte(wr * 64 + fr, fq * 8), boff = lds_byte(wc * 32 + fr, fq * 8);
#define PG8_SA(b, h) (((b) * 2 + (h)) * HTB)
#define PG8_SB(b, h) ((4 + (b) * 2 + (h)) * HTB)
#define PG8_STAGE(bufoff, gbase, voff) do { _Pragma("unroll") for (int _i = 0; _i < 2; ++_i) \
        __builtin_amdgcn_global_load_lds((const unsigned*)((const char*)(gbase) + (voff)[_i]), (LAS unsigned*)(lds + (bufoff) + ldsw + _i * 8192), 16, 0, 0); } while (0)
#define PG8_LDA(dst, b, h) do { _Pragma("unroll") for (int m = 0; m < 4; ++m) _Pragma("unroll") for (int k = 0; k < 2; ++k) dst[m][k] = *(const LAS bf16x8*)(lds + PG8_SA(b, h) + aoff + m * 2048 + k * 1024); } while (0)
#define PG8_LDB(dst, b, h) do { _Pragma("unroll") for (int n = 0; n < 2; ++n) _Pragma("unroll") for (int k = 0; k < 2; ++k) dst[n][k] = *(const LAS bf16x8*)(lds + PG8_SB(b, h) + boff + n * 2048 + k * 1024); } while (0)
#define PG8_MMA(ai, bj, At, Bt) do { __builtin_amdgcn_s_setprio(1); _Pragma("unroll") for (int m = 0; m < 4; ++m) _Pragma("unroll") for (int n = 0; n < 2; ++n) _Pragma("unroll") for (int k = 0; k < 2; ++k) \
        acc[ai][bj][m][n] = __builtin_amdgcn_mfma_f32_16x16x32_bf16(Bt[n][k], At[m][k], acc[ai][bj][m][n], 0, 0, 0); __builtin_amdgcn_s_setprio(0); } while (0)
#define PG8_WAIT_V(n) asm volatile("s_waitcnt vmcnt(" #n ")" ::: "memory")
#define PG8_WAIT_L(n) asm volatile("s_waitcnt lgkmcnt(" #n ")" ::: "memory")
#define PG8_BAR __builtin_amdgcn_s_barrier()
#define PG8_SCHED __builtin_amdgcn_sched_barrier(0)
    Unit cur, nxt; int ui = 0;
    if (!S.next(0, cur)) return;
    f32x4 acc[2][2][4][2];
#pragma unroll
    for (int a = 0; a < 2; ++a)
#pragma unroll
        for (int b = 0; b < 2; ++b)
#pragma unroll
            for (int m = 0; m < 4; ++m)
#pragma unroll
                for (int n = 0; n < 2; ++n) acc[a][b][m][n] = (f32x4){0.f, 0.f, 0.f, 0.f};
    bf16x8 At[4][2], B0[2][2], B1[2][2];
    const char* cA = (const char*)g.A + (size_t)cur.pm * tstep; const char* cB = (const char*)g.Bt + (size_t)cur.pn * tstep;
    if constexpr (SP2) {
        PG8_STAGE(PG8_SB(0, 0), cB, voffB); PG8_STAGE(PG8_SB(0, 1), cB + hstep, voffB); PG8_STAGE(PG8_SA(0, 0), cA, voffA); PG8_STAGE(PG8_SA(0, 1), cA + hstep, voffA);
        if (wr == 1) PG8_BAR;
        PG8_WAIT_V(2); PG8_BAR;
        PG8_STAGE(PG8_SB(1, 0), cB + kstep, voffB); PG8_STAGE(PG8_SA(1, 0), cA + kstep, voffA); PG8_STAGE(PG8_SB(1, 1), cB + hstep + kstep, voffB);
        PG8_WAIT_V(6); PG8_BAR;
    } else {
    PG8_STAGE(PG8_SB(0, 0), cB, voffB); PG8_STAGE(PG8_SA(0, 0), cA, voffA); PG8_STAGE(PG8_SB(0, 1), cB + hstep, voffB); PG8_STAGE(PG8_SA(0, 1), cA + hstep, voffA);
    if (wr == 1) PG8_BAR;
    PG8_WAIT_V(4); PG8_BAR;
    PG8_STAGE(PG8_SB(1, 0), cB + kstep, voffB); PG8_STAGE(PG8_SA(1, 0), cA + kstep, voffA); PG8_STAGE(PG8_SB(1, 1), cB + hstep + kstep, voffB);
    PG8_WAIT_V(6); PG8_BAR;
    }
    for (;;) {
        const bool has_next = S.next(ui + 1, nxt);
        const char* nA = has_next ? (const char*)g.A + (size_t)nxt.pm * tstep : cA; const char* nB = has_next ? (const char*)g.Bt + (size_t)nxt.pn * tstep : cB;
        for (int t = 0; t < nt; t += 2) {
            const bool last = (t == nt - 2);
            const char* a1 = cA + (size_t)(t + 1) * kstep;
            const char* a2 = last ? nA : cA + (size_t)(t + 2) * kstep; const char* b2 = last ? nB : cB + (size_t)(t + 2) * kstep;
            const char* a3 = a2 + kstep; const char* b3 = b2 + kstep;
            if constexpr (SP2) {
            PG8_LDB(B0, 0, 0); PG8_LDB(B1, 0, 1); PG8_SCHED; PG8_LDA(At, 0, 0); PG8_STAGE(PG8_SA(1, 1), a1 + hstep, voffA);
            PG8_WAIT_V(8); PG8_WAIT_L(0); PG8_BAR; PG8_MMA(0, 0, At, B0); PG8_MMA(0, 1, At, B1); PG8_BAR; PG8_SCHED;
            PG8_LDA(At, 0, 1); PG8_STAGE(PG8_SB(0, 0), b2, voffB); PG8_STAGE(PG8_SB(0, 1), b2 + hstep, voffB); PG8_STAGE(PG8_SA(0, 0), a2, voffA);
            PG8_WAIT_V(8); PG8_WAIT_L(0); PG8_BAR; PG8_MMA(1, 0, At, B0); PG8_MMA(1, 1, At, B1); PG8_BAR; PG8_SCHED;
            PG8_LDB(B0, 1, 0); PG8_LDB(B1, 1, 1); PG8_SCHED; PG8_LDA(At, 1, 0); PG8_STAGE(PG8_SA(0, 1), a2 + hstep, voffA);
            PG8_WAIT_V(8); PG8_WAIT_L(0); PG8_BAR; PG8_MMA(0, 0, At, B0); PG8_MMA(0, 1, At, B1); PG8_BAR; PG8_SCHED;
            PG8_LDA(At, 1, 1); PG8_STAGE(PG8_SB(1, 0), b3, voffB); PG8_STAGE(PG8_SB(1, 1), b3 + hstep, voffB); PG8_STAGE(PG8_SA(1, 0), a3, voffA);
            PG8_WAIT_V(8); PG8_WAIT_L(0); PG8_BAR; PG8_MMA(1, 0, At, B0); PG8_MMA(1, 1, At, B1); PG8_BAR; PG8_SCHED;
            } else {
            PG8_LDB(B0, 0, 0); PG8_SCHED; PG8_LDA(At, 0, 0); PG8_STAGE(PG8_SA(1, 1), a1 + hstep, voffA);
            PG8_WAIT_L(8); PG8_BAR; PG8_WAIT_L(0); PG8_MMA(0, 0, At, B0); PG8_BAR; PG8_SCHED;
            PG8_LDB(B1, 0, 1); PG8_STAGE(PG8_SB(0, 0), b2, voffB);
            PG8_BAR; PG8_WAIT_L(0); PG8_MMA(0, 1, At, B1); PG8_BAR;
            if constexpr (!HALF_M) PG8_LDA(At, 0, 1);
            PG8_STAGE(PG8_SA(0, 0), a2, voffA);
            PG8_BAR; PG8_WAIT_L(0); if constexpr (!HALF_M) PG8_MMA(1, 0, At, B0); PG8_BAR; PG8_SCHED;
            PG8_STAGE(PG8_SB(0, 1), b2 + hstep, voffB);
            PG8_WAIT_V(6); PG8_BAR; if constexpr (!HALF_M) PG8_MMA(1, 1, At, B1); PG8_BAR;
            PG8_LDB(B0, 1, 0); PG8_SCHED; PG8_LDA(At, 1, 0); PG8_STAGE(PG8_SA(0, 1), a2 + hstep, voffA);
            PG8_WAIT_L(8); PG8_BAR; PG8_WAIT_L(0); PG8_MMA(0, 0, At, B0); PG8_BAR; PG8_SCHED;
            PG8_LDB(B1, 1, 1); PG8_STAGE(PG8_SB(1, 0), b3, voffB);
            PG8_BAR; PG8_WAIT_L(0); PG8_MMA(0, 1, At, B1); PG8_BAR;
            if constexpr (!HALF_M) PG8_LDA(At, 1, 1);
            PG8_STAGE(PG8_SA(1, 0), a3, voffA);
            PG8_BAR; PG8_WAIT_L(0); if constexpr (!HALF_M) PG8_MMA(1, 0, At, B0); PG8_BAR; PG8_SCHED;
            PG8_STAGE(PG8_SB(1, 1), b3 + hstep, voffB);
            PG8_WAIT_V(6); PG8_BAR; if constexpr (!HALF_M) PG8_MMA(1, 1, At, B1); PG8_BAR;
            }
        }
        if constexpr (ALIGN_EPI) { if (wr == 0) PG8_BAR; }
        E(acc, cur, wr, wc, fr, fq);
        if (!has_next) break;
#pragma unroll
        for (int a = 0; a < 2; ++a)
#pragma unroll
            for (int b = 0; b < 2; ++b)
#pragma unroll
                for (int m = 0; m < 4; ++m)
#pragma unroll
                    for (int n = 0; n < 2; ++n) acc[a][b][m][n] = (f32x4){0.f, 0.f, 0.f, 0.f};
        cur = nxt; cA = nA; cB = nB; ++ui;
        if constexpr (ALIGN_EPI) { if (wr == 1) PG8_BAR; }
    }
    PG8_WAIT_V(0);
    if constexpr (!ALIGN_EPI) { if (wr == 0) PG8_BAR; }
    PG8_BAR;
#undef PG8_SA
#undef PG8_SB
#undef PG8_STAGE
#undef PG8_LDA
#undef PG8_LDB
#undef PG8_MMA
#undef PG8_WAIT_V
#undef PG8_WAIT_L
#undef PG8_BAR
#undef PG8_SCHED
}
}

struct Ctx {
    const float* xp; const float* xs; const float* stC; const float* stN; const float* stM; const float* ssm; const float* conv; const float* ck; const float* cv;
    float* out; unsigned char* ws;
};
#define XWIN ((bf16_t*)(X.ws + WS_WIN))
#define XWOUT ((bf16_t*)(X.ws + WS_WOUT))
#define XXB ((bf16_t*)(X.ws + WS_XB))
#define XU ((bf16_t*)(X.ws + WS_U))
#define XMIX ((bf16_t*)(X.ws + WS_MIX))
#define XSSQ ((float*)(X.ws + WS_SSQ))
#define XROPE ((float*)(X.ws + WS_ROPE))
#define XMC ((float*)(X.ws + WS_MC))
#define XMN ((float*)(X.ws + WS_MN))
#define XML ((float*)(X.ws + WS_ML))
#define XBL ((float*)(X.ws + WS_BL))
#define XMS ((float*)(X.ws + WS_MS))
#define XSA ((float*)(X.ws + WS_SA))
#define XSH ((float*)(X.ws + WS_SH))
#define XCSB ((bf16_t*)(X.ws + WS_CSB))
#define XNS ((float*)(X.ws + WS_NS))
#define XHSB ((bf16_t*)(X.ws + WS_HSB))
#define XPAR(off) ((const float*)(X.ws + WS_PAR) + (off))
constexpr int P_AIB = 0, P_AFB = 16, P_DTB = 32, P_ALOG = 64, P_BD = 96, P_SINK = 128, P_QNW = 160, P_KNW = 416, P_ANW = 672, P_BNW = 2720, P_CB = 4768, P_CW = 8864, P_END = 25248;
#define IN_XP 0
#define IN_XS 1
#define IN_STC 2
#define IN_STN 3
#define IN_STM 4
#define IN_SSM 5
#define IN_CONV 6
#define IN_CK 7
#define IN_CV 8
#define IN_NORMW 9
#define IN_WIN 10
#define IN_AIB 11
#define IN_AFB 12
#define IN_ANW 13
#define IN_CW 14
#define IN_CB 15
#define IN_DTB 16
#define IN_ALOG 17
#define IN_BD 18
#define IN_BNW 19
#define IN_QNW 20
#define IN_KNW 21
#define IN_SINK 22
#define IN_WOUT 23

__device__ __forceinline__ void transpose_strip(lptr lds, const float* src, int ldn, int nvalid, bf16_t* dst, int ldk, const float* scale, int k0, int n0, int tid) {
    LAS float* T = (LAS float*)lds;
    f32x4 v[8];
#pragma unroll
    for (int i = 0; i < 8; ++i) {
        const int f = tid + i * NT, r = f >> 6, c4 = (f & 63) * 4, n = n0 + c4;
        const f32x4 t = __builtin_nontemporal_load((const f32x4*)(src + (size_t)(k0 + r) * ldn + (n < nvalid ? n : 0)));
        const float m = n < nvalid ? (scale ? scale[k0 + r] : 1.f) : 0.f;
        v[i] = t * m;
    }
#pragma unroll
    for (int i = 0; i < 8; ++i) {
        const int f = tid + i * NT, r = f >> 6, c4 = (f & 63) * 4;
        T[r * 257 + c4 + 0] = v[i][0]; T[r * 257 + c4 + 1] = v[i][1]; T[r * 257 + c4 + 2] = v[i][2]; T[r * 257 + c4 + 3] = v[i][3];
    }
    __syncthreads();
#pragma unroll
    for (int i = 0; i < 4; ++i) {
        const int p = tid + i * NT, n = p >> 3, k8 = (p & 7) * 8; float f[8];
#pragma unroll
        for (int jx = 0; jx < 8; ++jx) f[jx] = T[(k8 + jx) * 257 + n];
        *(u32x4*)(dst + (size_t)(n0 + n) * ldk + k0 + k8) = pack8(f);
    }
    __syncthreads();
}

__device__ __forceinline__ void prologue(lptr lds, const Ctx& X, const Args& args, int G, int bid, int tid) {
    const int lane = tid & 63, wave = tid >> 6;
    constexpr int T0 = 1280, T1 = T0 + 384, T2 = T1 + 2080, T3 = T2 + 1, T4 = T3 + 513;
    for (int task = bid; task < T4; task += G) {
        if (task < T0) {
            const int l = task / 320, r = task % 320, kt = r / 20, ntl = r % 20;
            transpose_strip(lds, args.in[IN_WIN] + (size_t)l * D * DIN, DIN, DIN, XWIN + (size_t)l * NIN * D, D, args.in[IN_NORMW] + l * D, kt * 64, ntl * 256, tid);
        } else if (task < T1) {
            const int t = task - T0, l = t / 96, r = t % 96, kt = r / 4, ntl = r % 4;
            transpose_strip(lds, args.in[IN_WOUT] + (size_t)l * DMIX * D, D, D, XWOUT + (size_t)l * D * DMIX, DMIX, nullptr, kt * 64, ntl * 256, tid);
        } else if (task < T2) {
            const int r = (task - T1) * 8 + wave;
            float ss = 0.f;
            if (r < MTOK) {
                const float* src = r < TP ? X.xp + (size_t)r * D : X.xs + (size_t)(r - TP) * D;
#pragma unroll
                for (int i = 0; i < 4; ++i) {
                    const int c = lane * 4 + i * 256; f32x4 v = __builtin_nontemporal_load((const f32x4*)(src + c));
                    ss += v[0] * v[0] + v[1] * v[1] + v[2] * v[2] + v[3] * v[3];
                    u32x2 w; w[0] = pk2(v[0], v[1]); w[1] = pk2(v[2], v[3]);
                    *(u32x2*)(XXB + (size_t)r * D + c) = w;
                }
            } else {
#pragma unroll
                for (int i = 0; i < 4; ++i) { u32x2 w = {0u, 0u}; *(u32x2*)(XXB + (size_t)r * D + lane * 4 + i * 256) = w; }
            }
            ss = wave_sum(ss);
            if (lane < 16) XSSQ[(size_t)r * 16 + lane] = (lane == 0) ? ss : 0.f;
        } else if (task < T3) {
            for (int i = tid; i < (MPAD - MTOK) * DMIX / 2; i += NT) ((unsigned*)(XMIX + (size_t)MTOK * DMIX))[i] = 0u;
            float* P = (float*)(X.ws + WS_PAR);
            const int po[12] = {P_AIB, P_AFB, P_DTB, P_ALOG, P_BD, P_SINK, P_QNW, P_KNW, P_ANW, P_BNW, P_CB, P_CW};
            const int pn[12] = {16, 16, 32, 32, 32, 32, 256, 256, 2048, 2048, 4096, 16384};
            const int pi[12] = {IN_AIB, IN_AFB, IN_DTB, IN_ALOG, IN_BD, IN_SINK, IN_QNW, IN_KNW, IN_ANW, IN_BNW, IN_CB, IN_CW};
#pragma unroll
            for (int a = 0; a < 12; ++a) { const float* src = args.in[pi[a]]; for (int i = tid; i < pn[a]; i += NT) P[po[a] + i] = src[i]; }
        } else {
            const int e = (task - T3) * 512 + tid;
            if (e < 8193 * 32) {
                const int pos = e >> 5, d = e & 31;
                const float inv = (float)exp2(-(double)d * (13.287712379549449 / 32.0));
                const float angf = (float)pos * inv;
                const double a = (double)angf;
                const double k = rint(a * 0.15915494309189535);
                const float rr = (float)(a - k * 6.283185307179586);
                XROPE[(size_t)e * 2] = cosf(rr); XROPE[(size_t)e * 2 + 1] = sinf(rr);
            }
        }
    }
}

__device__ __forceinline__ void conv8(const bf16_t* u, int seq0, int tt, int ch, const float* cw, const float* cb, float (&o)[8]) {
    float acc[8];
    { f32x4 b0 = *(const f32x4*)(cb + ch), b1 = *(const f32x4*)(cb + ch + 4);
#pragma unroll
      for (int j = 0; j < 4; ++j) { acc[j] = b0[j]; acc[4 + j] = b1[j]; } }
#pragma unroll
    for (int jj = 0; jj < 4; ++jj) {
        const int t2 = tt + jj - 3;
        if (t2 >= 0) {
            float x[8]; unpack8(*(const u32x4*)(u + (size_t)(seq0 + t2) * NIN + C_BX + ch), x);
            f32x4 w0 = *(const f32x4*)(cw + jj * 1024 + ch), w1 = *(const f32x4*)(cw + jj * 1024 + ch + 4);
#pragma unroll
            for (int j = 0; j < 4; ++j) { acc[j] += x[j] * w0[j]; acc[4 + j] += x[4 + j] * w1[j]; }
        }
    }
#pragma unroll
    for (int j = 0; j < 8; ++j) o[j] = siluf_(acc[j]);
}


__device__ __forceinline__ void conv8x8(const bf16_t* u, int seq0, int tt0, int ch, const float* cw, const float* cb, float (&o)[8][8]) {
    float w[4][8];
#pragma unroll
    for (int jj = 0; jj < 4; ++jj) { f32x4 w0 = *(const f32x4*)(cw + jj * 1024 + ch), w1 = *(const f32x4*)(cw + jj * 1024 + ch + 4);
#pragma unroll
        for (int j = 0; j < 4; ++j) { w[jj][j] = w0[j]; w[jj][4 + j] = w1[j]; } }
    { f32x4 b0 = *(const f32x4*)(cb + ch), b1 = *(const f32x4*)(cb + ch + 4);
#pragma unroll
      for (int t = 0; t < 8; ++t)
#pragma unroll
          for (int j = 0; j < 4; ++j) { o[t][j] = b0[j]; o[t][4 + j] = b1[j]; } }
    u32x4 raw[11];
#pragma unroll
    for (int r = 0; r < 11; ++r) {
        const int t2 = tt0 + r - 3;
        const u32x4 v = *(const u32x4*)(u + (unsigned)(seq0 + (t2 >= 0 ? t2 : 0)) * NIN + C_BX + ch);
        const unsigned msk = t2 >= 0 ? 0xffffffffu : 0u;
        raw[r] = (u32x4){v[0] & msk, v[1] & msk, v[2] & msk, v[3] & msk};
    }
#pragma unroll
    for (int r = 0; r < 11; ++r) {
        float x[8]; unpack8(raw[r], x);
#pragma unroll
        for (int jj = 0; jj < 4; ++jj) {
            const int t = r - jj;
            if (t >= 0 && t < 8) {
#pragma unroll
                for (int j = 0; j < 8; ++j) o[t][j] += x[j] * w[jj][j];
            }
        }
    }
#pragma unroll
    for (int t = 0; t < 8; ++t)
#pragma unroll
        for (int j = 0; j < 8; ++j) o[t][j] = siluf_(o[t][j]);
}

__device__ __forceinline__ void mlstm_local(lptr lds, const Ctx& X, int l, int task, int tid) {
    const int h = task & 3, c = (task >> 2) & 127, n = task >> 9;
    const int lane = tid & 63, wave = tid >> 6, fr = lane & 15, fq = lane >> 4;
    const int row0 = n * SEQ + c * 64, nh = n * 4 + h;
    lptr VwT = lds;
    lptr KT = lds + 18432;
    LAS float* wv = (LAS float*)(lds + 27648);
    const int tg = lane & 7, cgq = lane >> 3;
    u32x4 blk[8];
    if (wave >= 1 && wave <= 3) {
        const int col = wave < 3 ? C_AV + h * 128 + ((wave - 1) * 8 + cgq) * 8 : C_AK + h * 64 + cgq * 8;
#pragma unroll
        for (int t = 0; t < 8; ++t) blk[t] = *(const u32x4*)(XU + (unsigned)(row0 + 8 * tg + t) * NIN + col);
    }
    if (wave == 0) {
        const bf16_t* ur = XU + (unsigned)(row0 + lane) * NIN;
        const float fg = bf2f(ur[C_AF + h]) + XPAR(P_AFB)[l * 4 + h], ig = bf2f(ur[C_AI + h]) + XPAR(P_AIB)[l * 4 + h];
        const float b = wave_scan_sum(logsigf_(fg), lane);
        const float bl = lane63(b);
        const float g = bl - b + ig;
        const float ml = wave_max(g);
        wv[lane] = __expf(g - ml);
        if (lane == 0) { XML[nh * 128 + c] = ml; XBL[nh * 128 + c] = bl; }
    }
    __syncthreads();
    if (wave >= 1 && wave <= 3) {
        float xs[8][8];
#pragma unroll
        for (int t = 0; t < 8; ++t) { unpack8(blk[t], xs[t]); const float w = wave < 3 ? wv[8 * tg + t] : 0.125f;
#pragma unroll
            for (int j = 0; j < 8; ++j) xs[t][j] *= w; }
        lptr dstT = wave < 3 ? VwT + ((((wave - 1) * 8 + cgq) * 8 * 72) << 1) : KT + ((cgq * 8 * 72) << 1);
#pragma unroll
        for (int j = 0; j < 8; ++j) {
            float v[8];
#pragma unroll
            for (int t = 0; t < 8; ++t) v[t] = xs[t][j];
            *(LAS u32x4*)(dstT + ((j * 72 + 8 * tg) << 1)) = pack8(v);
        }
    }
    __syncthreads();
    {
        bf16_t* dst = (bf16_t*)XMC + ((size_t)nh * 128 + c) * 8192;
        bf16x8 b0 = lds_frag(VwT, 16 * wave + fr, fq * 8, 72), b1 = lds_frag(VwT, 16 * wave + fr, 32 + fq * 8, 72);
#pragma unroll
        for (int mt = 0; mt < 4; ++mt) {
            f32x4 acc = {0.f, 0.f, 0.f, 0.f};
            acc = mfma16(lds_frag(KT, 16 * mt + fr, fq * 8, 72), b0, acc);
            acc = mfma16(lds_frag(KT, 16 * mt + fr, 32 + fq * 8, 72), b1, acc);
            { u32x2 w; w[0] = pk2(acc[0], acc[1]); w[1] = pk2(acc[2], acc[3]); *(u32x2*)(dst + (16 * wave + fr) * 64 + 16 * mt + 4 * fq) = w; }
        }
    }
    if (tid < 64) {
        float s = 0.f;
#pragma unroll
        for (int t8 = 0; t8 < 8; ++t8) {
            float kf[8]; unpack8(*(const LAS u32x4*)(KT + ((tid * 72 + t8 * 8) << 1)), kf);
#pragma unroll
            for (int jx = 0; jx < 8; ++jx) s += kf[jx] * wv[t8 * 8 + jx];
        }
        XMN[((size_t)nh * 128 + c) * 64 + tid] = s;
    }
    __syncthreads();
}

__device__ __forceinline__ void ssd_local(lptr lds, const Ctx& X, int l, int task, int tid) {
    const int g = task & 1, c = (task >> 1) & 127, n = task >> 8;
    const int lane = tid & 63, wave = tid >> 6, fr = lane & 15, fq = lane >> 4;
    const int seq0 = n * SEQ, row0 = seq0 + c * 64;
    lptr XwT = lds;
    lptr BT = lds + 36864;
    LAS float* wl = (LAS float*)(lds + 55296);
    {
        const float* cw = XPAR(P_CW) + l * 4096; const float* cb = XPAR(P_CB) + l * 1024;
        const int tg = lane & 7, cg = wave * 8 + (lane >> 3);
        float o[8][8];
        if (wave < 6) {
            const int ch = cg < 32 ? g * 256 + cg * 8 : 512 + g * 128 + (cg - 32) * 8;
            conv8x8(XU, seq0, c * 64 + 8 * tg, ch, cw, cb, o);
        }
        if (wave < 4) {
            const int hh = 4 * g + wave;
            const float dt = softplusf_(bf2f(XU[(unsigned)(row0 + lane) * NIN + C_BDT + hh]) + XPAR(P_DTB)[l * 8 + hh]);
            const float A = -__expf(XPAR(P_ALOG)[l * 8 + hh]);
            const float a = wave_scan_sum(dt * A, lane);
            const float aL = lane63(a);
            wl[wave * 64 + lane] = __expf(aL - a) * dt;
            if (lane == 0) XSA[(n * 8 + hh) * 128 + c] = aL;
        }
        __syncthreads();
        if (wave < 4) {
            float wt[8];
#pragma unroll
            for (int t = 0; t < 8; ++t) wt[t] = wl[wave * 64 + 8 * tg + t];
#pragma unroll
            for (int jx = 0; jx < 8; ++jx) {
                float v[8];
#pragma unroll
                for (int t = 0; t < 8; ++t) v[t] = o[t][jx] * wt[t];
                *(LAS u32x4*)(XwT + (((cg * 8 + jx) * 72 + 8 * tg) << 1)) = pack8(v);
            }
        } else if (wave < 6) {
#pragma unroll
            for (int jx = 0; jx < 8; ++jx) {
                float v[8];
#pragma unroll
                for (int t = 0; t < 8; ++t) v[t] = o[t][jx];
                *(LAS u32x4*)(BT + ((((cg - 32) * 8 + jx) * 72 + 8 * tg) << 1)) = pack8(v);
            }
        }
    }
    __syncthreads();
    {
        const int hl = wave >> 1, ph = wave & 1, hh = 4 * g + hl;
        bf16_t* dst = (bf16_t*)XSH + ((size_t)(n * 8 + hh) * 128 + c) * 8192;
        bf16x8 bx[2][2];
#pragma unroll
        for (int ntl = 0; ntl < 2; ++ntl)
#pragma unroll
            for (int kk = 0; kk < 2; ++kk) bx[ntl][kk] = lds_frag(XwT, hl * 64 + ph * 32 + ntl * 16 + fr, kk * 32 + fq * 8, 72);
#pragma unroll
        for (int mt = 0; mt < 8; ++mt) {
            bf16x8 a0 = lds_frag(BT, 16 * mt + fr, fq * 8, 72), a1 = lds_frag(BT, 16 * mt + fr, 32 + fq * 8, 72);
#pragma unroll
            for (int ntl = 0; ntl < 2; ++ntl) {
                f32x4 acc = {0.f, 0.f, 0.f, 0.f};
                acc = mfma16(a0, bx[ntl][0], acc); acc = mfma16(a1, bx[ntl][1], acc);
                { u32x2 w; w[0] = pk2(acc[0], acc[1]); w[1] = pk2(acc[2], acc[3]); *(u32x2*)(dst + (ph * 32 + ntl * 16 + fr) * 128 + 16 * mt + 4 * fq) = w; }
            }
        }
    }
    __syncthreads();
}

__device__ __forceinline__ void swa_prompt(lptr lds, const Ctx& X, int l, int task, int tid) {
    const int kvh = task & 1, qb = (task >> 1) & 63, n = task >> 7;
    const int lane = tid & 63, wave = tid >> 6, fr = lane & 15, fq = lane >> 4;
    const int seq0 = n * SEQ;
    lptr Kn = lds;
    lptr Vt = lds + 36864;
    lptr Pw = lds + 70656 + wave * 8448;
    const float* knw = XPAR(P_KNW) + l * 64; const float* qnw = XPAR(P_QNW) + l * 64;
#pragma unroll
    for (int it = 0; it < 2; ++it) {
        const int item = tid + it * NT, j = item >> 2, qd = item & 3, t = qb * 128 - 128 + j;
        float o1[8], o2[8];
        {
            const int tc = t >= 0 ? t : 0;
            const bf16_t* kr = XU + (unsigned)(seq0 + tc) * NIN + C_CK + kvh * 64;
            float x1[8], x2[8]; unpack8(*(const u32x4*)(kr + qd * 8), x1); unpack8(*(const u32x4*)(kr + 32 + qd * 8), x2);
            float ss = 0.f;
#pragma unroll
            for (int jj = 0; jj < 8; ++jj) ss += x1[jj] * x1[jj] + x2[jj] * x2[jj];
            ss += __shfl_xor(ss, 1); ss += __shfl_xor(ss, 2);
            const float rs = rsqrtf(ss * (1.f / 64.f) + EPS);
            const f32x4* cs = (const f32x4*)(XROPE + ((size_t)tc * 32 + qd * 8) * 2);
            f32x4 csv[4];
#pragma unroll
            for (int q4 = 0; q4 < 4; ++q4) csv[q4] = cs[q4];
            const float zm = t >= 0 ? 1.f : 0.f;
#pragma unroll
            for (int jj = 0; jj < 8; ++jj) {
                const float a = x1[jj] * rs * knw[qd * 8 + jj], b = x2[jj] * rs * knw[32 + qd * 8 + jj], co = csv[jj >> 1][(jj & 1) * 2], si = csv[jj >> 1][(jj & 1) * 2 + 1];
                o1[jj] = (a * co - b * si) * zm; o2[jj] = (b * co + a * si) * zm;
            }
        }
        *(LAS u32x4*)(Kn + ((j * 72 + qd * 8) << 1)) = pack8(o1);
        *(LAS u32x4*)(Kn + ((j * 72 + 32 + qd * 8) << 1)) = pack8(o2);
        if (qb == 63 && j >= 128) {
            float* ko = X.out + O_PK + ((((size_t)l * 2 + n) * 128 + (j - 128)) * 2 + kvh) * 64;
            *(f32x4*)(ko + qd * 8) = (f32x4){o1[0], o1[1], o1[2], o1[3]}; *(f32x4*)(ko + qd * 8 + 4) = (f32x4){o1[4], o1[5], o1[6], o1[7]};
            *(f32x4*)(ko + 32 + qd * 8) = (f32x4){o2[0], o2[1], o2[2], o2[3]}; *(f32x4*)(ko + 32 + qd * 8 + 4) = (f32x4){o2[4], o2[5], o2[6], o2[7]};
        }
    }
    if (wave < 4) {
        const int tg = tid & 31, cg = tid >> 5;
        u32x4 vb[8];
#pragma unroll
        for (int t8 = 0; t8 < 8; ++t8) {
            const int jk = 8 * tg + t8, t = qb * 128 - 128 + jk;
            u32x4 w = *(const u32x4*)(XU + (unsigned)(seq0 + (t >= 0 ? t : 0)) * NIN + C_CV + kvh * 64 + cg * 8);
            const unsigned msk = t >= 0 ? 0xffffffffu : 0u;
            vb[t8] = (u32x4){w[0] & msk, w[1] & msk, w[2] & msk, w[3] & msk};
        }
#pragma unroll
        for (int jj = 0; jj < 8; ++jj) {
            u32x4 w;
#pragma unroll
            for (int tp = 0; tp < 4; ++tp) {
                const unsigned lo = (vb[2 * tp][jj >> 1] >> ((jj & 1) * 16)) & 0xffffu, hi = (vb[2 * tp + 1][jj >> 1] >> ((jj & 1) * 16)) & 0xffffu;
                w[tp] = lo | (hi << 16);
            }
            *(LAS u32x4*)(Vt + (((cg * 8 + jj) * 264 + 8 * tg) << 1)) = w;
        }
        if (qb == 63 && tg >= 16) {
#pragma unroll
            for (int t8 = 0; t8 < 8; ++t8) {
                float x[8]; unpack8(vb[t8], x);
                float* vo = X.out + O_PV + ((((size_t)l * 2 + n) * 128 + (8 * tg + t8 - 128)) * 2 + kvh) * 64 + cg * 8;
                *(f32x4*)(vo) = (f32x4){x[0], x[1], x[2], x[3]}; *(f32x4*)(vo + 4) = (f32x4){x[4], x[5], x[6], x[7]};
            }
        }
    }
    __syncthreads();
    const int hq = kvh * 4 + (wave >> 1), i0 = (wave & 1) * 64;
    const float sink = XPAR(P_SINK)[l * 8 + hq];
    float qw1[8], qw2[8];
#pragma unroll
    for (int jj = 0; jj < 8; ++jj) { qw1[jj] = qnw[fq * 8 + jj]; qw2[jj] = qnw[32 + fq * 8 + jj]; }
    u32x4 qn0, qn1; f32x4 csn[4];
    {
        const int t = qb * 128 + i0 + fr;
        const bf16_t* qr = XU + (unsigned)(seq0 + t) * NIN + C_CQ + hq * 64;
        qn0 = *(const u32x4*)(qr + fq * 8); qn1 = *(const u32x4*)(qr + 32 + fq * 8);
        const f32x4* cs = (const f32x4*)(XROPE + ((size_t)t * 32 + fq * 8) * 2);
#pragma unroll
        for (int q4 = 0; q4 < 4; ++q4) csn[q4] = cs[q4];
    }
#pragma unroll 1
    for (int mt = 0; mt < 4; ++mt) {
        const int q0 = i0 + mt * 16;
        const u32x4 q0r = qn0, q1r = qn1; f32x4 csc[4];
#pragma unroll
        for (int q4 = 0; q4 < 4; ++q4) csc[q4] = csn[q4];
        {
            const int mn = mt < 3 ? mt + 1 : 3;
            const int t = qb * 128 + i0 + mn * 16 + fr;
            const bf16_t* qr = XU + (unsigned)(seq0 + t) * NIN + C_CQ + hq * 64;
            qn0 = *(const u32x4*)(qr + fq * 8); qn1 = *(const u32x4*)(qr + 32 + fq * 8);
            const f32x4* cs = (const f32x4*)(XROPE + ((size_t)t * 32 + fq * 8) * 2);
#pragma unroll
            for (int q4 = 0; q4 < 4; ++q4) csn[q4] = cs[q4];
        }
        bf16x8 a0, a1;
        {
            float x1[8], x2[8]; unpack8(q0r, x1); unpack8(q1r, x2);
            float ss = 0.f;
#pragma unroll
            for (int jj = 0; jj < 8; ++jj) ss += x1[jj] * x1[jj] + x2[jj] * x2[jj];
            ss += __shfl_xor(ss, 16); ss += __shfl_xor(ss, 32);
            const float rs = rsqrtf(ss * (1.f / 64.f) + EPS) * 0.125f;
            float o1[8], o2[8];
#pragma unroll
            for (int jj = 0; jj < 8; ++jj) {
                const float a = x1[jj] * rs * qw1[jj], b = x2[jj] * rs * qw2[jj], co = csc[jj >> 1][(jj & 1) * 2], si = csc[jj >> 1][(jj & 1) * 2 + 1];
                o1[jj] = a * co - b * si; o2[jj] = b * co + a * si;
            }
            a0 = as_frag(pack8(o1)); a1 = as_frag(pack8(o2));
        }
        const int tlo = q0 >> 4;
        const int qi = q0 + fr;
        const int dlo = qb > 0 ? 1 : (128 - qi > 1 ? 128 - qi : 1);
        f32x4 s[16];
        float mx = -3.0e38f;
#pragma unroll
        for (int ntl = 0; ntl < 16; ++ntl) {
            if (ntl >= tlo && ntl <= tlo + 8) {
                f32x4 acc = {0.f, 0.f, 0.f, 0.f};
                acc = mfma16(lds_frag(Kn, 16 * ntl + fr, fq * 8, 72), a0, acc);
                acc = mfma16(lds_frag(Kn, 16 * ntl + fr, 32 + fq * 8, 72), a1, acc);
                if (ntl == tlo || ntl == tlo + 8 || qb == 0) {
#pragma unroll
                    for (int ii = 0; ii < 4; ++ii) {
                        const int dk = 16 * ntl + 4 * fq + ii - qi;
                        acc[ii] = ((unsigned)(dk - dlo) <= (unsigned)(128 - dlo)) ? acc[ii] : -3.0e38f;
                    }
                }
                mx = fmaxf(mx, fmaxf(fmaxf(acc[0], acc[1]), fmaxf(acc[2], acc[3])));
                s[ntl] = acc;
            }
        }
        mx = fmaxf(mx, __shfl_xor(mx, 16)); mx = fmaxf(mx, __shfl_xor(mx, 32));
        mx = fmaxf(mx, sink);
        float sum = 0.f;
#pragma unroll
        for (int ntl = 0; ntl < 16; ++ntl) {
            if (ntl >= tlo && ntl <= tlo + 8) {
#pragma unroll
                for (int ii = 0; ii < 4; ++ii) { const float e = __expf(s[ntl][ii] - mx); s[ntl][ii] = e; sum += e; }
            }
        }
        sum += __shfl_xor(sum, 16); sum += __shfl_xor(sum, 32);
        const float inv = rcpf_(sum + __expf(sink - mx));
        const int klo = q0 >> 5, khi = (q0 + 143) >> 5;
#pragma unroll
        for (int ntl = 0; ntl < 16; ++ntl) {
            if (ntl >= tlo && ntl <= tlo + 8) {
                u32x2 w; w[0] = pk2(s[ntl][0] * inv, s[ntl][1] * inv); w[1] = pk2(s[ntl][2] * inv, s[ntl][3] * inv);
                *(LAS u32x2*)(Pw + ((fr * 264 + 16 * ntl + 4 * fq) << 1)) = w;
            } else if ((ntl >> 1) >= klo && (ntl >> 1) <= khi) {
                u32x2 w = {0u, 0u};
                *(LAS u32x2*)(Pw + ((fr * 264 + 16 * ntl + 4 * fq) << 1)) = w;
            }
        }
        u32x2 czv[4];
#pragma unroll
        for (int ntl = 0; ntl < 4; ++ntl) czv[ntl] = *(const u32x2*)(XU + ((unsigned)seq0 + qb * 128 + q0 + fr) * NIN + C_CZ + hq * 64 + 16 * ntl + 4 * fq);
        LDS_FENCE();
        f32x4 o[4];
#pragma unroll
        for (int ntl = 0; ntl < 4; ++ntl) o[ntl] = (f32x4){0.f, 0.f, 0.f, 0.f};
#pragma unroll
        for (int kk = 0; kk < 8; ++kk) {
            if (kk >= klo && kk <= khi) {
                const bf16x8 a = lds_frag(Pw, fr, kk * 32 + fq * 8, 264);
#pragma unroll
                for (int ntl = 0; ntl < 4; ++ntl) o[ntl] = mfma16(lds_frag(Vt, 16 * ntl + fr, kk * 32 + fq * 8, 264), a, o[ntl]);
            }
        }
        LDS_FENCE();
        {
            const unsigned row = (unsigned)seq0 + qb * 128 + q0 + fr;
#pragma unroll
            for (int ntl = 0; ntl < 4; ++ntl) {
                const float z0 = __uint_as_float(czv[ntl][0] << 16), z1 = __uint_as_float(czv[ntl][0] & 0xffff0000u), z2 = __uint_as_float(czv[ntl][1] << 16), z3 = __uint_as_float(czv[ntl][1] & 0xffff0000u);
                u32x2 w; w[0] = pk2(o[ntl][0] * siluf_(z0), o[ntl][1] * siluf_(z1)); w[1] = pk2(o[ntl][2] * siluf_(z2), o[ntl][3] * siluf_(z3));
                *(u32x2*)(XMIX + row * DMIX + 1024 + hq * 64 + 16 * ntl + 4 * fq) = w;
            }
        }
    }
    __syncthreads();
}

__device__ __forceinline__ void sample_task(lptr lds, const Ctx& X, int l, int b, int part, int tid) {
    LAS float* uf = (LAS float*)lds;
    LAS float* xbc = (LAS float*)(lds + 19968);
    LAS float* numv = (LAS float*)(lds + 24064);
    LAS float* yv = (LAS float*)(lds + 26112);
    LAS float* red = (LAS float*)(lds + 28160);
    LAS float* qs = (LAS float*)(lds + 28416);
    LAS float* kn = (LAS float*)(lds + 30464);
    LAS float* sc = (LAS float*)(lds + 30976);
    const int lane = tid & 63, wave = tid >> 6;
    const size_t row = (size_t)TP + b;
    const bf16_t* ur = XU + row * NIN;
    const size_t lb = (size_t)l * 128 + b;
    f32x4 kpre[8], vpre[8];
    if (part == 2) {
        const float* kc = X.ck + lb * 16384; const float* vc = X.cv + lb * 16384;
#pragma unroll
        for (int it = 0; it < 8; ++it) {
            const int e = (tid + it * NT) * 4, e2 = e < 127 * 128 ? e + 128 : e;
            kpre[it] = __builtin_nontemporal_load((const f32x4*)(kc + e2)); vpre[it] = __builtin_nontemporal_load((const f32x4*)(vc + e2));
        }
    }
    {
        const int c_lo = part == 0 ? 0 : (part == 1 ? C_BZ : C_CQ), c_hi = part == 0 ? C_BZ : (part == 1 ? C_CQ : DIN);
#pragma unroll 2
        for (int i = c_lo + tid; i < c_hi; i += NT) uf[i] = bf2f(ur[i]);
    }
    __syncthreads();
    if (part == 0) {
#pragma unroll
    for (int h = 0; h < 4; ++h) {
        const float ig = uf[C_AI + h] + XPAR(P_AIB)[l * 4 + h], fg = uf[C_AF + h] + XPAR(P_AFB)[l * 4 + h];
        const float ls = logsigf_(fg), m0 = X.stM[lb * 4 + h];
        const float mn = fmaxf(ls + m0, ig), sp = __expf(ls + m0 - mn), sl = __expf(ig - mn);
        const float* C0 = X.stC + (lb * 4 + h) * 8192; float* C1 = X.out + O_SC + (lb * 4 + h) * 8192;
#pragma unroll
        for (int it = 0; it < 4; ++it) {
            const int e = (tid + it * NT) * 4, v = e >> 6, k = e & 63;
            const f32x4 c0 = __builtin_nontemporal_load((const f32x4*)(C0 + e));
            const float vv = uf[C_AV + h * 128 + v] * sl;
            f32x4 c1; float part = 0.f;
#pragma unroll
            for (int j = 0; j < 4; ++j) { c1[j] = sp * c0[j] + vv * (uf[C_AK + h * 64 + k + j] * 0.125f); part += c1[j] * uf[C_AQ + h * 64 + k + j]; }
            __builtin_nontemporal_store(c1, (f32x4*)(C1 + e));
            part = red16(part);
            if ((lane & 15) == 0) numv[h * 128 + v] = part;
        }
        if (wave == 0) {
            const float n1 = sp * X.stN[(lb * 4 + h) * 64 + lane] + sl * uf[C_AK + h * 64 + lane] * 0.125f;
            X.out[O_SN + (lb * 4 + h) * 64 + lane] = n1;
            const float dd = wave_sum(n1 * uf[C_AQ + h * 64 + lane]);
            if (lane == 0) { red[h] = dd; red[4 + h] = mn; X.out[O_SM + lb * 4 + h] = mn; }
        }
    }
    __syncthreads();
    float hv;
    { const int h = tid >> 7; hv = numv[tid] * rcpf_(fmaxf(fabsf(red[h]), __expf(-red[4 + h]))); const float ss = wave_sum(hv * hv); if (lane == 0) red[8 + wave] = ss; }
    __syncthreads();
    { const int h = tid >> 7; const float rs = rsqrtf((red[8 + 2 * h] + red[9 + 2 * h]) * (1.f / 128.f) + EPS);
      XMIX[row * DMIX + tid] = (bf16_t)f2bf(hv * rs * XPAR(P_ANW)[l * 512 + tid] * sigmoidf_(uf[C_AO + tid]) * siluf_(uf[C_AZ + tid])); }
    }
    if (part == 1) {
    {
        const float* buf = X.conv + lb * 3 * 1024; float* oc = X.out + O_SCONV + lb * 3 * 1024;
        const float* cw = XPAR(P_CW) + l * 4096;
#pragma unroll
        for (int it = 0; it < 2; ++it) {
            const int ch = tid + it * NT;
            const float f0 = buf[ch], f1 = buf[1024 + ch], f2 = buf[2048 + ch], f3 = uf[C_BX + ch];
            const float acc = XPAR(P_CB)[l * 1024 + ch] + f0 * cw[ch] + f1 * cw[1024 + ch] + f2 * cw[2048 + ch] + f3 * cw[3072 + ch];
            xbc[ch] = siluf_(acc);
            oc[ch] = f1; oc[1024 + ch] = f2; oc[2048 + ch] = f3;
        }
    }
    __syncthreads();
#pragma unroll 4
    for (int hh = 0; hh < 8; ++hh) {
        const float dt = softplusf_(uf[C_BDT + hh] + XPAR(P_DTB)[l * 8 + hh]);
        const float dA = __expf(-dt * __expf(XPAR(P_ALOG)[l * 8 + hh]));
        const int g = hh >> 2;
        const float* h0p = X.ssm + (lb * 8 + hh) * 8192; float* h1p = X.out + O_SH + (lb * 8 + hh) * 8192;
#pragma unroll
        for (int it = 0; it < 4; ++it) {
            const int e = (tid + it * NT) * 4, p = e >> 7, s = e & 127;
            const f32x4 h0 = __builtin_nontemporal_load((const f32x4*)(h0p + e));
            const float xv = xbc[hh * 64 + p] * dt;
            f32x4 h1; float part = 0.f;
#pragma unroll
            for (int j = 0; j < 4; ++j) { h1[j] = dA * h0[j] + xv * xbc[512 + g * 128 + s + j]; part += h1[j] * xbc[768 + g * 128 + s + j]; }
            __builtin_nontemporal_store(h1, (f32x4*)(h1p + e));
            part = red16(part); part += __shfl_xor(part, 16);
            if ((lane & 31) == 0) yv[hh * 64 + p] = part;
        }
    }
    __syncthreads();
    float gb;
    { const int hh = tid >> 6; const float y = yv[tid] + XPAR(P_BD)[l * 8 + hh] * xbc[tid]; gb = y * siluf_(uf[C_BZ + tid]); const float ss = wave_sum(gb * gb); if (lane == 0) red[16 + wave] = ss; }
    __syncthreads();
    { const int g = tid >> 8; const float rs = rsqrtf((red[16 + 4 * g] + red[17 + 4 * g] + red[18 + 4 * g] + red[19 + 4 * g]) * (1.f / 256.f) + EPS);
      XMIX[row * DMIX + 512 + tid] = (bf16_t)f2bf(gb * rs * XPAR(P_BNW)[l * 512 + tid]); }
    }
    if (part == 2) {
    lptr Kl = lds + 36864;
    lptr Vl = lds + 36864 + 34816;
    if (tid < 320) {
        const int vec = tid >> 5, d = tid & 31, base = vec < 8 ? C_CQ + vec * 64 : C_CK + (vec - 8) * 64;
        const float x1 = uf[base + d], x2 = uf[base + 32 + d];
        float ss = x1 * x1 + x2 * x2; ss = red16(ss); ss += __shfl_xor(ss, 16);
        const float rs = rsqrtf(ss * (1.f / 64.f) + EPS);
        const float* w = vec < 8 ? XPAR(P_QNW) + l * 64 : XPAR(P_KNW) + l * 64;
        const float a = x1 * rs * w[d], bb = x2 * rs * w[d + 32];
        const float co = XROPE[((size_t)8192 * 32 + d) * 2], si = XROPE[((size_t)8192 * 32 + d) * 2 + 1];
        const float o1 = a * co - bb * si, o2 = bb * co + a * si;
        if (vec < 8) { qs[vec * 64 + d] = o1 * 0.125f; qs[vec * 64 + 32 + d] = o2 * 0.125f; } else { kn[(vec - 8) * 64 + d] = o1; kn[(vec - 8) * 64 + 32 + d] = o2; }
    }
    __syncthreads();
    {
        float* ko = X.out + O_SK + lb * 16384; float* vo = X.out + O_SV + lb * 16384;
#pragma unroll
        for (int it = 0; it < 8; ++it) {
            const int e = (tid + it * NT) * 4, j = e >> 7, r = e & 127;
            f32x4 kv = kpre[it], vv = vpre[it];
            if (j == 127) { kv = (f32x4){kn[r], kn[r + 1], kn[r + 2], kn[r + 3]}; vv = (f32x4){uf[C_CV + r], uf[C_CV + r + 1], uf[C_CV + r + 2], uf[C_CV + r + 3]}; }
            __builtin_nontemporal_store(kv, (f32x4*)(ko + e)); __builtin_nontemporal_store(vv, (f32x4*)(vo + e));
            u32x2 wk, wv2; wk[0] = pk2(kv[0], kv[1]); wk[1] = pk2(kv[2], kv[3]); wv2[0] = pk2(vv[0], vv[1]); wv2[1] = pk2(vv[2], vv[3]);
            *(LAS u32x2*)(Kl + ((j * 136 + r) << 1)) = wk; *(LAS u32x2*)(Vl + ((j * 136 + r) << 1)) = wv2;
        }
    }
    __syncthreads();
    if (tid < 256) {
        const int kvh = tid >> 7, jj = tid & 127;
        float s0 = 0.f, s1 = 0.f, s2 = 0.f, s3 = 0.f;
#pragma unroll 2
        for (int d8 = 0; d8 < 8; ++d8) {
            float kf[8]; unpack8(*(const LAS u32x4*)(Kl + ((jj * 136 + kvh * 64 + d8 * 8) << 1)), kf);
#pragma unroll
            for (int j = 0; j < 8; ++j) {
                s0 += kf[j] * qs[(kvh * 4 + 0) * 64 + d8 * 8 + j]; s1 += kf[j] * qs[(kvh * 4 + 1) * 64 + d8 * 8 + j];
                s2 += kf[j] * qs[(kvh * 4 + 2) * 64 + d8 * 8 + j]; s3 += kf[j] * qs[(kvh * 4 + 3) * 64 + d8 * 8 + j];
            }
        }
        sc[(kvh * 4 + 0) * 128 + jj] = s0; sc[(kvh * 4 + 1) * 128 + jj] = s1; sc[(kvh * 4 + 2) * 128 + jj] = s2; sc[(kvh * 4 + 3) * 128 + jj] = s3;
    }
    __syncthreads();
    {
        const int hq = wave; const float s0 = sc[hq * 128 + lane], s1 = sc[hq * 128 + 64 + lane], sink = XPAR(P_SINK)[l * 8 + hq];
        const float m = fmaxf(wave_max(fmaxf(s0, s1)), sink);
        const float e0 = __expf(s0 - m), e1 = __expf(s1 - m);
        const float inv = rcpf_(wave_sum(e0 + e1) + __expf(sink - m));
        sc[hq * 128 + lane] = e0 * inv; sc[hq * 128 + 64 + lane] = e1 * inv;
    }
    __syncthreads();
    {
        const int hq = tid >> 6, d = tid & 63, kvh = hq >> 2;
        float o = 0.f;
#pragma unroll 16
        for (int jj = 0; jj < 128; ++jj) o += sc[hq * 128 + jj] * bf2f(*(const LAS bf16_t*)(Vl + ((jj * 136 + kvh * 64 + d) << 1)));
        XMIX[row * DMIX + 1024 + tid] = (bf16_t)f2bf(o * siluf_(uf[C_CZ + tid]));
    }
    }
    __syncthreads();
}

__device__ __forceinline__ void scans(const Ctx& X, int l, int gt, int nthreads) {
    for (int item = gt; item < 98816; item += nthreads) {
        if (item < 32768) {
            const int nh = item >> 12, e = (item & 4095) * 2;
            const bf16_t* base = (const bf16_t*)XMC + (size_t)nh * 128 * 8192 + e;
            const float* ml = XML + nh * 128; const float* bl = XBL + nh * 128;
            float m = 0.f; f32x2 st = {0.f, 0.f};
            for (int c0 = 0; c0 < 128; c0 += 16) {
                f32x2 cl[16];
#pragma unroll
                for (int j = 0; j < 16; ++j) { const unsigned w = *(const unsigned*)(base + (size_t)(c0 + j) * 8192); cl[j] = (f32x2){__uint_as_float(w << 16), __uint_as_float(w & 0xffff0000u)}; }
#pragma unroll
                for (int j = 0; j < 16; ++j) {
                    const float mlj = ml[c0 + j], blj = bl[c0 + j], mn = fmaxf(blj + m, mlj), sp = __expf(blj + m - mn), sl = __expf(mlj - mn);
                    *(unsigned*)(XCSB + ((size_t)nh * 128 + c0 + j) * 8192 + e) = pk2(st[0], st[1]);
                    if (e == 0) XMS[nh * 128 + c0 + j] = m;
                    st = st * sp + cl[j] * sl; m = mn;
                }
            }
            *(f32x2*)(X.out + O_PC + ((size_t)l * 8 + nh) * 8192 + e) = st;
            if (e == 0) X.out[O_PM + l * 8 + nh] = m;
        } else if (item < 98304) {
            const int i1 = item - 32768, nhh = i1 >> 12, e = (i1 & 4095) * 2;
            const bf16_t* base = (const bf16_t*)XSH + (size_t)nhh * 128 * 8192 + e;
            const float* al = XSA + nhh * 128;
            f32x2 st = {0.f, 0.f};
            for (int c0 = 0; c0 < 128; c0 += 16) {
                f32x2 cl[16];
#pragma unroll
                for (int j = 0; j < 16; ++j) { const unsigned w = *(const unsigned*)(base + (size_t)(c0 + j) * 8192); cl[j] = (f32x2){__uint_as_float(w << 16), __uint_as_float(w & 0xffff0000u)}; }
#pragma unroll
                for (int j = 0; j < 16; ++j) {
                    const float dec = __expf(al[c0 + j]);
                    *(unsigned*)(XHSB + ((size_t)nhh * 128 + c0 + j) * 8192 + e) = pk2(st[0], st[1]);
                    st = st * dec + cl[j];
                }
            }
            *(f32x2*)(X.out + O_PH + ((size_t)l * 16 + nhh) * 8192 + e) = st;
        } else {
            const int i2 = item - 98304, nh = i2 >> 6, k = i2 & 63;
            float* base = XMN + (size_t)nh * 128 * 64 + k;
            const float* ml = XML + nh * 128; const float* bl = XBL + nh * 128;
            float m = 0.f, st = 0.f;
            for (int c = 0; c < 128; ++c) {
                const float mlj = ml[c], blj = bl[c], mn = fmaxf(blj + m, mlj), sp = __expf(blj + m - mn), sl = __expf(mlj - mn);
                const float cl = base[c * 64];
                XNS[(size_t)nh * 128 * 64 + c * 64 + k] = st;
                st = st * sp + cl * sl; m = mn;
            }
            X.out[O_PN + ((size_t)l * 8 + nh) * 64 + k] = st;
        }
    }
}

__device__ __forceinline__ void mlstm_out(lptr lds, const Ctx& X, int l, int task, int tid) {
    const int h = task & 3, c = (task >> 2) & 127, n = task >> 9;
    const int lane = tid & 63, wave = tid >> 6, fr = lane & 15, fq = lane >> 4;
    const int row0 = n * SEQ + c * 64, nh = n * 4 + h;
    lptr Qs = lds;
    lptr Ks = lds + 9216;
    lptr Vt = lds + 18432;
    lptr Sb = lds + 36864 + wave * 2304;
    LAS float* bv = (LAS float*)(lds + 55296);
    LAS float* dv = bv + 64;
    LAS float* mtv = bv + 128;
    LAS float* siv = bv + 192;
    LAS float* qnv = bv + 256;
    LAS float* ssqp = bv + 384;
    LAS float* nsv = bv + 512;
    const int mti = wave >> 1, half = wave & 1;
    u32x4 csf[2][4];
    {
        const bf16_t* Cs = XCSB + ((size_t)nh * 128 + c) * 8192;
#pragma unroll
        for (int kk = 0; kk < 2; ++kk)
#pragma unroll
            for (int ntl = 0; ntl < 4; ++ntl) csf[kk][ntl] = *(const u32x4*)(Cs + (64 * half + 16 * ntl + fr) * 64 + kk * 32 + fq * 8);
    }
    u32x2 aov[4], azv[4]; f32x4 anw[4];
#pragma unroll
    for (int ntl = 0; ntl < 4; ++ntl) {
        const int v = h * 128 + 64 * half + 16 * ntl + 4 * fq;
        const unsigned row = (unsigned)row0 + 16 * mti + fr;
        anw[ntl] = *(const f32x4*)(XPAR(P_ANW) + l * 512 + v);
        aov[ntl] = *(const u32x2*)(XU + row * NIN + C_AO + v); azv[ntl] = *(const u32x2*)(XU + row * NIN + C_AZ + v);
    }
    u32x4 qraw, kraw, vblk[8];
    const int tgv = lane & 7, cgv = (wave & 1) * 8 + (lane >> 3);
    {
        const int tok = tid >> 3, k8 = (tid & 7) * 8;
        const bf16_t* ur = XU + (unsigned)(row0 + tok) * NIN;
        qraw = *(const u32x4*)(ur + C_AQ + h * 64 + k8); kraw = *(const u32x4*)(ur + C_AK + h * 64 + k8);
        if (wave == 2 || wave == 3) {
#pragma unroll
            for (int t = 0; t < 8; ++t) vblk[t] = *(const u32x4*)(XU + (unsigned)(row0 + 8 * tgv + t) * NIN + C_AV + h * 128 + cgv * 8);
        }
    }
    if (wave == 0) {
        const bf16_t* ur = XU + (unsigned)(row0 + lane) * NIN;
        const float fg = bf2f(ur[C_AF + h]) + XPAR(P_AFB)[l * 4 + h], ig = bf2f(ur[C_AI + h]) + XPAR(P_AIB)[l * 4 + h];
        const float b = wave_scan_sum(logsigf_(fg), lane);
        const float dd = ig - b;
        const float cm = wave_scan_max(dd, lane);
        const float ms = XMS[nh * 128 + c];
        const float mt = b + fmaxf(ms, cm);
        bv[lane] = b; dv[lane] = dd; mtv[lane] = mt; siv[lane] = __expf(b + ms - mt);
        nsv[lane] = XNS[((size_t)nh * 128 + c) * 64 + lane];
    }
    {
        const int tok = tid >> 3, k8 = (tid & 7) * 8;
        *(LAS u32x4*)(Qs + ((tok * 72 + k8) << 1)) = qraw;
        float x[8]; unpack8(kraw, x);
#pragma unroll
        for (int j = 0; j < 8; ++j) x[j] *= 0.125f;
        *(LAS u32x4*)(Ks + ((tok * 72 + k8) << 1)) = pack8(x);
    }
    if (wave == 2 || wave == 3) {
#pragma unroll
        for (int j = 0; j < 8; ++j) {
            u32x4 w;
#pragma unroll
            for (int tp = 0; tp < 4; ++tp) {
                const unsigned lo = (vblk[2 * tp][j >> 1] >> ((j & 1) * 16)) & 0xffffu, hi = (vblk[2 * tp + 1][j >> 1] >> ((j & 1) * 16)) & 0xffffu;
                w[tp] = lo | (hi << 16);
            }
            *(LAS u32x4*)(Vt + (((cgv * 8 + j) * 72 + 8 * tgv) << 1)) = w;
        }
    }
    __syncthreads();
    bf16x8 qa[2];
    qa[0] = lds_frag(Qs, 16 * mti + fr, fq * 8, 72); qa[1] = lds_frag(Qs, 16 * mti + fr, 32 + fq * 8, 72);
    const int tq = 16 * mti + fr;
    float qn;
    {
        float x0[8], x1[8]; unpack8(__builtin_bit_cast(u32x4, qa[0]), x0); unpack8(__builtin_bit_cast(u32x4, qa[1]), x1);
        float d = 0.f;
#pragma unroll
        for (int j = 0; j < 8; ++j) d += x0[j] * nsv[fq * 8 + j] + x1[j] * nsv[32 + fq * 8 + j];
        d += __shfl_xor(d, 16); d += __shfl_xor(d, 32);
        qn = d;
    }
    const float bt = bv[tq], mtq = mtv[tq], siq = siv[tq];
    float rsum = 0.f;
#pragma unroll
    for (int ntl = 0; ntl < 4; ++ntl) {
        f32x4 sT = {0.f, 0.f, 0.f, 0.f};
        sT = mfma16(lds_frag(Ks, 16 * ntl + fr, fq * 8, 72), qa[0], sT);
        sT = mfma16(lds_frag(Ks, 16 * ntl + fr, 32 + fq * 8, 72), qa[1], sT);
        float sv[4];
#pragma unroll
        for (int ii = 0; ii < 4; ++ii) {
            const int sidx = 16 * ntl + 4 * fq + ii;
            const float wgt = (sidx <= tq) ? __expf(bt + dv[sidx] - mtq) : 0.f;
            sv[ii] = wgt * sT[ii];
            rsum += sv[ii];
        }
        u32x2 w; w[0] = pk2(sv[0], sv[1]); w[1] = pk2(sv[2], sv[3]);
        *(LAS u32x2*)(Sb + ((fr * 72 + 16 * ntl + 4 * fq) << 1)) = w;
    }
    rsum += __shfl_xor(rsum, 16); rsum += __shfl_xor(rsum, 32);
    const float inv = rcpf_(fmaxf(fabsf(rsum + siq * qn), __expf(-mtq)));
    LDS_FENCE();
    f32x4 acc[4];
#pragma unroll
    for (int ntl = 0; ntl < 4; ++ntl) acc[ntl] = (f32x4){0.f, 0.f, 0.f, 0.f};
#pragma unroll
    for (int kk = 0; kk < 2; ++kk) {
        const bf16x8 sb = lds_frag(Sb, fr, kk * 32 + fq * 8, 72);
#pragma unroll
        for (int ntl = 0; ntl < 4; ++ntl) acc[ntl] = mfma16(lds_frag(Vt, 64 * half + 16 * ntl + fr, kk * 32 + fq * 8, 72), sb, acc[ntl]);
    }
#pragma unroll
    for (int kk = 0; kk < 2; ++kk) {
        float x[8]; unpack8(__builtin_bit_cast(u32x4, qa[kk]), x);
#pragma unroll
        for (int j = 0; j < 8; ++j) x[j] *= siq;
        const bf16x8 qs = as_frag(pack8(x));
#pragma unroll
        for (int ntl = 0; ntl < 4; ++ntl) acc[ntl] = mfma16(as_frag(csf[kk][ntl]), qs, acc[ntl]);
    }
    {
        float ss = 0.f;
#pragma unroll
        for (int ntl = 0; ntl < 4; ++ntl) { acc[ntl] = acc[ntl] * inv; ss += acc[ntl][0] * acc[ntl][0] + acc[ntl][1] * acc[ntl][1] + acc[ntl][2] * acc[ntl][2] + acc[ntl][3] * acc[ntl][3]; }
        ss += __shfl_xor(ss, 16); ss += __shfl_xor(ss, 32);
        if (fq == 0) ssqp[tq * 2 + half] = ss;
    }
    __syncthreads();
    {
        const float rs = rsqrtf((ssqp[tq * 2] + ssqp[tq * 2 + 1]) * (1.f / 128.f) + EPS);
        const unsigned row = (unsigned)row0 + tq;
#pragma unroll
        for (int ntl = 0; ntl < 4; ++ntl) {
            const float o[4] = {__uint_as_float(aov[ntl][0] << 16), __uint_as_float(aov[ntl][0] & 0xffff0000u), __uint_as_float(aov[ntl][1] << 16), __uint_as_float(aov[ntl][1] & 0xffff0000u)};
            const float z[4] = {__uint_as_float(azv[ntl][0] << 16), __uint_as_float(azv[ntl][0] & 0xffff0000u), __uint_as_float(azv[ntl][1] << 16), __uint_as_float(azv[ntl][1] & 0xffff0000u)};
            float y[4];
#pragma unroll
            for (int ii = 0; ii < 4; ++ii) y[ii] = acc[ntl][ii] * rs * anw[ntl][ii] * sigmoidf_(o[ii]) * siluf_(z[ii]);
            u32x2 w; w[0] = pk2(y[0], y[1]); w[1] = pk2(y[2], y[3]);
            *(u32x2*)(XMIX + row * DMIX + h * 128 + 64 * half + 16 * ntl + 4 * fq) = w;
        }
    }
    __syncthreads();
}

__device__ __forceinline__ void ssd_out(lptr lds, const Ctx& X, int l, int task, int tid) {
    const int g = task & 1, c = (task >> 1) & 127, n = task >> 8;
    const int lane = tid & 63, wave = tid >> 6, fr = lane & 15, fq = lane >> 4;
    const int seq0 = n * SEQ, row0 = seq0 + c * 64;
    lptr Cm = lds;
    lptr Bm = lds + 17408;
    lptr Xt = lds + 34816;
    LAS float* CBf = (LAS float*)(lds + 71680);
    LAS float* av = (LAS float*)(lds + 89088);
    LAS float* dtv = (LAS float*)(lds + 90112);
    LAS float* ssq = (LAS float*)(lds + 91136);
    const int hl = wave >> 1, th = wave & 1, hh = 4 * g + hl;
    u32x4 hsf[4][4];
    {
        const bf16_t* hs = XHSB + ((size_t)(n * 8 + hh) * 128 + c) * 8192;
#pragma unroll
        for (int kk = 0; kk < 4; ++kk)
#pragma unroll
            for (int ntl = 0; ntl < 4; ++ntl) hsf[kk][ntl] = *(const u32x4*)(hs + (16 * ntl + fr) * 128 + kk * 32 + fq * 8);
    }
    if (wave < 4) {
        const int hh = 4 * g + wave;
        const float dt = softplusf_(bf2f(XU[(unsigned)(row0 + lane) * NIN + C_BDT + hh]) + XPAR(P_DTB)[l * 8 + hh]);
        const float A = -__expf(XPAR(P_ALOG)[l * 8 + hh]);
        av[wave * 64 + lane] = wave_scan_sum(dt * A, lane);
        dtv[wave * 64 + lane] = dt;
    }
    {
        const float* cw = XPAR(P_CW) + l * 4096; const float* cb = XPAR(P_CB) + l * 1024;
        float o[8][8];
        if (wave < 4) {
            const int tg = lane & 7, cg = wave * 8 + (lane >> 3);
            conv8x8(XU, seq0, c * 64 + 8 * tg, g * 256 + cg * 8, cw, cb, o);
#pragma unroll
            for (int jx = 0; jx < 8; ++jx) {
                float v[8];
#pragma unroll
                for (int t = 0; t < 8; ++t) v[t] = o[t][jx];
                *(LAS u32x4*)(Xt + (((cg * 8 + jx) * 72 + 8 * tg) << 1)) = pack8(v);
            }
        } else {
            const int tg = lane >> 3, s8 = ((wave & 1) * 8 + (lane & 7)) * 8;
            conv8x8(XU, seq0, c * 64 + 8 * tg, (wave < 6 ? 512 : 768) + g * 128 + s8, cw, cb, o);
            lptr dstm = wave < 6 ? Bm : Cm;
#pragma unroll
            for (int t = 0; t < 8; ++t) *(LAS u32x4*)(dstm + (((8 * tg + t) * 136 + s8) << 1)) = pack8(o[t]);
        }
    }
    __syncthreads();
    u32x2 bzv[2][4]; f32x4 bnw[4];
#pragma unroll
    for (int ntl = 0; ntl < 4; ++ntl) {
        bnw[ntl] = *(const f32x4*)(XPAR(P_BNW) + l * 512 + hh * 64 + 16 * ntl + 4 * fq);
#pragma unroll
        for (int mi = 0; mi < 2; ++mi) bzv[mi][ntl] = *(const u32x2*)(XU + ((unsigned)row0 + 16 * (2 * th + mi) + fr) * NIN + C_BZ + hh * 64 + 16 * ntl + 4 * fq);
    }
    {
        const int mt = wave >> 1;
#pragma unroll
        for (int q = 0; q < 2; ++q) {
            const int ntl = 2 * (wave & 1) + q;
            f32x4 acc = {0.f, 0.f, 0.f, 0.f};
#pragma unroll
            for (int kk = 0; kk < 4; ++kk) acc = mfma16(lds_frag(Cm, 16 * mt + fr, kk * 32 + fq * 8, 136), lds_frag(Bm, 16 * ntl + fr, kk * 32 + fq * 8, 136), acc);
#pragma unroll
            for (int ii = 0; ii < 4; ++ii) CBf[(16 * mt + fq * 4 + ii) * 68 + 16 * ntl + fr] = acc[ii];
        }
    }
    __syncthreads();
    f32x4 y1[2][4], y2[2][4];
#pragma unroll
    for (int mi = 0; mi < 2; ++mi)
#pragma unroll
        for (int ntl = 0; ntl < 4; ++ntl) { y1[mi][ntl] = (f32x4){0.f, 0.f, 0.f, 0.f}; y2[mi][ntl] = (f32x4){0.f, 0.f, 0.f, 0.f}; }
#pragma unroll
    for (int kk = 0; kk < 2; ++kk) {
        bf16x8 bx[4];
#pragma unroll
        for (int ntl = 0; ntl < 4; ++ntl) bx[ntl] = lds_frag(Xt, hl * 64 + 16 * ntl + fr, kk * 32 + fq * 8, 72);
#pragma unroll
        for (int mi = 0; mi < 2; ++mi) {
            const int t = 16 * (2 * th + mi) + fr, u0 = kk * 32 + fq * 8;
            const float at = av[hl * 64 + t];
            float w[8];
#pragma unroll
            for (int j = 0; j < 8; ++j) {
                const int uu = u0 + j;
                w[j] = (uu <= t) ? CBf[t * 68 + uu] * __expf(at - av[hl * 64 + uu]) * dtv[hl * 64 + uu] : 0.f;
            }
            const bf16x8 a = as_frag(pack8(w));
#pragma unroll
            for (int ntl = 0; ntl < 4; ++ntl) y1[mi][ntl] = mfma16(bx[ntl], a, y1[mi][ntl]);
        }
    }
    {
#pragma unroll
        for (int kk = 0; kk < 4; ++kk) {
            bf16x8 bh[4];
#pragma unroll
            for (int ntl = 0; ntl < 4; ++ntl) bh[ntl] = as_frag(hsf[kk][ntl]);
#pragma unroll
            for (int mi = 0; mi < 2; ++mi) {
                const bf16x8 a = lds_frag(Cm, 16 * (2 * th + mi) + fr, kk * 32 + fq * 8, 136);
#pragma unroll
                for (int ntl = 0; ntl < 4; ++ntl) y2[mi][ntl] = mfma16(bh[ntl], a, y2[mi][ntl]);
            }
        }
    }
    const float Dh = XPAR(P_BD)[l * 8 + hh];
#pragma unroll
    for (int mi = 0; mi < 2; ++mi) {
        const int t = 16 * (2 * th + mi) + fr;
        const float ea = __expf(av[hl * 64 + t]);
        float ss = 0.f;
#pragma unroll
        for (int ntl = 0; ntl < 4; ++ntl) {
            const float z[4] = {__uint_as_float(bzv[mi][ntl][0] << 16), __uint_as_float(bzv[mi][ntl][0] & 0xffff0000u), __uint_as_float(bzv[mi][ntl][1] << 16), __uint_as_float(bzv[mi][ntl][1] & 0xffff0000u)};
#pragma unroll
            for (int ii = 0; ii < 4; ++ii) {
                const int p = 16 * ntl + 4 * fq + ii;
                const float xv = bf2f(*(const LAS bf16_t*)(Xt + (((hl * 64 + p) * 72 + t) << 1)));
                const float y = y1[mi][ntl][ii] + ea * y2[mi][ntl][ii] + Dh * xv;
                const float gbv = y * siluf_(z[ii]);
                y1[mi][ntl][ii] = gbv; ss += gbv * gbv;
            }
        }
        ss += __shfl_xor(ss, 16); ss += __shfl_xor(ss, 32);
        if (fq == 0) ssq[t * 4 + hl] = ss;
    }
    __syncthreads();
#pragma unroll
    for (int mi = 0; mi < 2; ++mi) {
        const int t = 16 * (2 * th + mi) + fr;
        const float rs = rsqrtf((ssq[t * 4] + ssq[t * 4 + 1] + ssq[t * 4 + 2] + ssq[t * 4 + 3]) * (1.f / 256.f) + EPS);
        const unsigned row = (unsigned)row0 + t;
#pragma unroll
        for (int ntl = 0; ntl < 4; ++ntl) {
            u32x2 w; w[0] = pk2(y1[mi][ntl][0] * rs * bnw[ntl][0], y1[mi][ntl][1] * rs * bnw[ntl][1]); w[1] = pk2(y1[mi][ntl][2] * rs * bnw[ntl][2], y1[mi][ntl][3] * rs * bnw[ntl][3]);
            *(u32x2*)(XMIX + row * DMIX + 512 + hh * 64 + 16 * ntl + 4 * fq) = w;
        }
    }
    __syncthreads();
}


#define XB_TMO      128
#define XB_XCNT(j)  (256  + 64 * (j))
#define XB_XSUB(j)  (1280 + 64 * (j))
#define XB_XGEN(j)  (2304 + 64 * (j))
#define XB_TOP      3328
#define XB_TOPGEN   3392
#define XCD_BAR_WORDS 3456
#define XB_SPIN_CAP (1u << 18)
__device__ __forceinline__ unsigned xb_ld(unsigned* p)              { return __hip_atomic_load(p, __ATOMIC_RELAXED, __HIP_MEMORY_SCOPE_AGENT); }
__device__ __forceinline__ unsigned xb_add(unsigned* p, unsigned v) { return __hip_atomic_fetch_add(p, v, __ATOMIC_RELAXED, __HIP_MEMORY_SCOPE_AGENT); }
__device__ __forceinline__ unsigned xb_xcc_id() { return (unsigned)__builtin_amdgcn_s_getreg((3 << 11) | 20) & 0xFu; }
#define XB_SPIN(cond, bar) do { unsigned _sp = 0; while (cond) { __builtin_amdgcn_s_sleep(1); \
    if ((++_sp & 255u) == 0u) { if (xb_ld(&(bar)[XB_TMO])) break; if (_sp > XB_SPIN_CAP) { atomicAdd(&(bar)[XB_TMO], 1u); break; } } } } while (0)
struct XcdBarrier { unsigned* bar; unsigned x; volatile LAS unsigned* st; };
__device__ __forceinline__ XcdBarrier xcd_barrier_post(unsigned* bar, volatile LAS unsigned* st) {
    XcdBarrier b; b.bar = bar; b.x = xb_xcc_id(); b.st = st;
    if (threadIdx.x == 0) (void)xb_add(&bar[XB_XCNT(b.x)], 1u);
    return b;
}
__device__ __forceinline__ void xcd_barrier_complete(unsigned* bar, unsigned x, unsigned& nloc, unsigned& nx) {
    const unsigned G = gridDim.x * gridDim.y * gridDim.z;
    unsigned sum, cnt, mine, sp = 0u;
    for (;;) {
        sum = 0u; cnt = 0u; mine = 0u;
#pragma unroll
        for (unsigned j = 0; j < 16; ++j) { const unsigned c = xb_ld(&bar[XB_XCNT(j)]); sum += c; cnt += (c > 0u) ? 1u : 0u; mine = (j == x) ? c : mine; }
        if (sum == G) break;
        __builtin_amdgcn_s_sleep(1);
        if ((++sp & 255u) == 0u) { if (xb_ld(&bar[XB_TMO])) break; if (sp > XB_SPIN_CAP) { atomicAdd(&bar[XB_TMO], 1u); break; } }
    }
    nloc = mine > 0u ? mine : 1u; nx = cnt > 0u ? cnt : 1u;
}
__device__ __forceinline__ void xcd_barrier(const XcdBarrier& b) {
    asm volatile("s_waitcnt vmcnt(0)" ::: "memory");
    __syncthreads();
    if (threadIdx.x == 0) {
        unsigned* bar = b.bar;
        __builtin_amdgcn_s_waitcnt(0);
        unsigned nloc = b.st[0], nx = b.st[1];
        if (nloc == 0u) { xcd_barrier_complete(bar, b.x, nloc, nx); b.st[0] = nloc; b.st[1] = nx; }
        const unsigned old = xb_add(&bar[XB_XSUB(b.x)], 1u);
        const unsigned gen = old / nloc;
        if (old + 1u == (gen + 1u) * nloc) {
            __builtin_amdgcn_fence(__ATOMIC_RELEASE, "agent");
            asm volatile("s_waitcnt vmcnt(0)" ::: "memory");
            const unsigned og = xb_add(&bar[XB_TOP], 1u);
            const unsigned tg = og / nx;
            if (og + 1u == (tg + 1u) * nx) xb_add(&bar[XB_TOPGEN], 1u);
            else XB_SPIN(xb_ld(&bar[XB_TOPGEN]) == tg, bar);
            __builtin_amdgcn_fence(__ATOMIC_ACQUIRE, "agent");
            xb_add(&bar[XB_XGEN(b.x)], 1u);
            asm volatile("s_waitcnt vmcnt(0)" ::: "memory");
        } else {
            XB_SPIN(xb_ld(&bar[XB_XGEN(b.x)]) == gen, bar);
            __builtin_amdgcn_fence(__ATOMIC_ACQUIRE, "agent");
            asm volatile("s_waitcnt vmcnt(0)" ::: "memory");
        }
    }
    __syncthreads();
}

__global__ void __launch_bounds__(NT, 2) mega(Args args) {
    __shared__ __attribute__((aligned(16))) unsigned char lds_raw[LDS_BYTES];
    lptr lds = (lptr)lds_raw;
    cg::grid_group grid = cg::this_grid();
    const int tid = threadIdx.x, bid = blockIdx.x, G = gridDim.x;
    Ctx X;
    X.xp = args.in[IN_XP]; X.xs = args.in[IN_XS]; X.stC = args.in[IN_STC]; X.stN = args.in[IN_STN]; X.stM = args.in[IN_STM]; X.ssm = args.in[IN_SSM];
    X.conv = args.in[IN_CONV]; X.ck = args.in[IN_CK]; X.cv = args.in[IN_CV]; X.out = args.out; X.ws = args.ws;
    const int lo = args.ph_lo, hi = args.ph_hi;
    volatile LAS unsigned* xst = (volatile LAS unsigned*)(lds + LDS_BYTES - 16);
    if (tid == 0) { xst[0] = 0u; xst[1] = 0u; }
    __syncthreads();
    XcdBarrier xbar = xcd_barrier_post((unsigned*)(args.ws + WS_BAR), xst);
#define IN(k) (lo <= (k) && (k) < hi)
#define SEAM(k) do { if (IN(k) && IN((k) + 1)) { for (int _r = 0; _r < REP_SYNC; ++_r) { if (lo < 0) grid.sync(); xcd_barrier(xbar); } } } while (0)
    if (IN(0)) { for (int _r = 0; _r < REP_P0; ++_r) prologue(lds, X, args, G, bid, tid); }
    SEAM(0);
    for (int l = 0; l < 4; ++l) {
        const int pb = 1 + l * 5;
        if (IN(pb)) for (int _r = 0; _r < REP_P1; ++_r) {
            pg8::Gemm g{XXB, XWIN + (size_t)l * NIN * D, MPAD, NIN, D}; pg8::StaticOrder S; S.init(TP, NIN, G, bid);
            pg8::EpiU E{XU, XSSQ};
            pg8::gemm_phase<pg8::EpiU, pg8::StaticOrder, false, GEMM_SP2, GEMM_ALIGN>(lds, g, S, E, OPQ(tid));
            if (l == 0 && bid >= G - 20) {
                pg8::SampleOrder S2{G - 20, 20, bid}; pg8::EpiUh E2{XU, XSSQ};
                pg8::gemm_phase<pg8::EpiUh, pg8::SampleOrder, true>(lds, g, S2, E2, OPQ(tid));
            }
        }
        SEAM(pb);
        if (IN(pb + 1)) for (int _r = 0; _r < REP_P2; ++_r) {
            for (int t = bid; t < 256; t += G) for (int _q = 0; _q < RT_SAMPLE; ++_q) {
                if (t < 128) sample_task(lds, X, l, t, 1, OPQ(tid));
                else { sample_task(lds, X, l, t - 128, 0, OPQ(tid)); sample_task(lds, X, l, t - 128, 2, OPQ(tid)); }
            }
            for (int t = bid; t < 256; t += G) for (int _q = 0; _q < RT_SWA; ++_q) swa_prompt(lds, X, l, t, OPQ(tid));
            for (int t = bid; t < 512; t += G) for (int _q = 0; _q < RT_SLOC; ++_q) ssd_local(lds, X, l, t, OPQ(tid));
            for (int t = bid; t < 1024; t += G) for (int _q = 0; _q < RT_MLOC; ++_q) mlstm_local(lds, X, l, t, OPQ(tid));
            if (bid == G - 1) {
                for (int i = tid; i < 2 * 3 * 1024; i += NT) {
                    const int ch = i & 1023, j = (i >> 10) % 3, n = i / 3072;
                    X.out[O_PCONV + (((size_t)l * 2 + n) * 3 + j) * 1024 + ch] = bf2f(XU[(size_t)(n * SEQ + SEQ - 3 + j) * NIN + C_BX + ch]);
                }
            }
        }
        SEAM(pb + 1);
        if (IN(pb + 2)) {
            if (bid >= G - 4) {
                pg8::Gemm g{XMIX, XWOUT + (size_t)l * D * DMIX, MPAD, D, DMIX}; pg8::SampleOrder S{G - 4, 4, bid};
                if (l == 0) { pg8::EpiRes_<1, 0> E{X.xp, X.xs, X.out, XXB, XSSQ}; pg8::gemm_phase<pg8::EpiRes_<1, 0>, pg8::SampleOrder, true>(lds, g, S, E, OPQ(tid)); }
                else if (l < 3) { pg8::EpiRes_<1, 1> E{X.xp, X.xs, X.out, XXB, XSSQ}; pg8::gemm_phase<pg8::EpiRes_<1, 1>, pg8::SampleOrder, true>(lds, g, S, E, OPQ(tid)); }
                else { pg8::EpiRes_<1, 2> E{X.xp, X.xs, X.out, XXB, XSSQ}; pg8::gemm_phase<pg8::EpiRes_<1, 2>, pg8::SampleOrder, true>(lds, g, S, E, OPQ(tid)); }
            }
            for (int _r = 0; _r < REP_P3; ++_r) scans(X, l, bid * NT + OPQ(tid), G * NT);
        }
        SEAM(pb + 2);
        if (IN(pb + 3)) for (int _r = 0; _r < REP_P4; ++_r) {
            for (int task = bid; task < 1536; task += G) {
                if (task < 512) for (int _q = 0; _q < RT_SOUT; ++_q) ssd_out(lds, X, l, task, OPQ(tid));
                else mlstm_out(lds, X, l, task - 512, OPQ(tid));
            }
        }
        SEAM(pb + 3);
        if (IN(pb + 4)) {
            {
                pg8::Gemm g{XMIX, XWOUT + (size_t)l * D * DMIX, MPAD, D, DMIX}; pg8::StaticOrder S; S.init(TP, D, G, bid);
#ifdef PROBE_P5
                { pg8::EpiProbe EP{(const unsigned*)(X.ws + 64), XSSQ}; pg8::gemm_phase<pg8::EpiProbe, pg8::StaticOrder, false, GEMM_SP2>(lds, g, S, EP, OPQ(tid)); }
#endif
                if (l == 0) { pg8::EpiRes_<2, 0> E{X.xp, X.xs, X.out, XXB, XSSQ}; pg8::gemm_phase<pg8::EpiRes_<2, 0>, pg8::StaticOrder, false, GEMM_SP2, GEMM_ALIGN>(lds, g, S, E, OPQ(tid)); }
                else if (l < 3) { pg8::EpiRes_<2, 1> E{X.xp, X.xs, X.out, XXB, XSSQ}; pg8::gemm_phase<pg8::EpiRes_<2, 1>, pg8::StaticOrder, false, GEMM_SP2, GEMM_ALIGN>(lds, g, S, E, OPQ(tid)); }
                else { pg8::EpiRes_<2, 2> E{X.xp, X.xs, X.out, XXB, XSSQ}; pg8::gemm_phase<pg8::EpiRes_<2, 2>, pg8::StaticOrder, false, GEMM_SP2, GEMM_ALIGN>(lds, g, S, E, OPQ(tid)); }
            }
            if (l < 3 && bid < 20) {
                pg8::Gemm g{XXB, XWIN + (size_t)(l + 1) * NIN * D, MPAD, NIN, D}; pg8::SampleOrder S{0, 20, bid};
                pg8::EpiUh E{XU, XSSQ};
                pg8::gemm_phase<pg8::EpiUh, pg8::SampleOrder, true>(lds, g, S, E, OPQ(tid));
            }
        }
        SEAM(pb + 4);
    }
#undef IN
#undef SEAM
}

extern "C" void kernel_launch(void* const* d_in, const int* in_sizes, int n_in, void* d_out, int out_size, void* d_ws, size_t ws_size, hipStream_t stream) {
    static int grid_blocks = 0;
    if (!grid_blocks) {
        int dev = 0, cus = 0, per_cu = 0;
        hipGetDevice(&dev);
        hipDeviceGetAttribute(&cus, hipDeviceAttributeMultiprocessorCount, dev);
        hipOccupancyMaxActiveBlocksPerMultiprocessor(&per_cu, mega, NT, 0);
        if (per_cu < 1) { fprintf(stderr, "occupancy query returned %d\n", per_cu); per_cu = 1; }
        grid_blocks = cus * 1;
        if (ws_size < WS_END) fprintf(stderr, "workspace too small: %zu < %zu\n", ws_size, (size_t)WS_END);
    }
    (void)hipMemsetAsync(d_ws, 0, 16384, stream);
    Args a{};
    for (int i = 0; i < 24; ++i) a.in[i] = (const float*)d_in[i];
    a.out = (float*)d_out; a.ws = (unsigned char*)d_ws;
    const int NPH = 21;
#if MULTI_LAUNCH
    for (int p = 0; p < NPH; ++p) {
        a.ph_lo = p; a.ph_hi = p + 1;
        void* kargs[] = {&a};
        hipError_t e = hipLaunchCooperativeKernel((void*)mega, dim3(grid_blocks), dim3(NT), kargs, 0, stream);
        if (e != hipSuccess) fprintf(stderr, "cooperative launch failed: %s (grid %d)\n", hipGetErrorString(e), grid_blocks);
    }
#else
    a.ph_lo = 0; a.ph_hi = NPH;
    void* kargs[] = {&a};
    hipError_t e = hipLaunchCooperativeKernel((void*)mega, dim3(grid_blocks), dim3(NT), kargs, 0, stream);
    if (e != hipSuccess) fprintf(stderr, "cooperative launch failed: %s (grid %d)\n", hipGetErrorString(e), grid_blocks);
#endif
}
```

```cpp
#include <hip/hip_runtime.h>
#include <hip/hip_cooperative_groups.h>
#include <cstdio>
#include <cstdint>
namespace cg = cooperative_groups;

#ifndef REP_SYNC
#define REP_SYNC 1
#endif
#ifndef REP_P1
#define REP_P1 1
#endif
#ifndef REP_P2
#define REP_P2 1
#endif
#ifndef REP_P3
#define REP_P3 1
#endif
#ifndef REP_P0
#define REP_P0 1
#endif
#ifndef REP_P4
#define REP_P4 1
#endif
#ifndef RT_SAMPLE
#define RT_SAMPLE 1
#endif
#ifndef RT_SWA
#define RT_SWA 1
#endif
#ifndef RT_SLOC
#define RT_SLOC 1
#endif
#ifndef RT_MLOC
#define RT_MLOC 1
#endif
#ifndef RT_SOUT
#define RT_SOUT 1
#endif
#ifndef GEMM_SP2
#define GEMM_SP2 true
#endif
#ifndef GEMM_ALIGN
#define GEMM_ALIGN true
#endif
#ifndef MULTI_LAUNCH
#define MULTI_LAUNCH 0
#endif

#define LAS __attribute__((address_space(3)))
typedef unsigned short bf16_t;
typedef short bf16x8 __attribute__((ext_vector_type(8)));
typedef float f32x4 __attribute__((ext_vector_type(4)));
typedef float f32x2 __attribute__((ext_vector_type(2)));
typedef unsigned u32x4 __attribute__((ext_vector_type(4)));
typedef unsigned u32x2 __attribute__((ext_vector_type(2)));
typedef __bf16 bf16x2_t __attribute__((ext_vector_type(2)));
typedef LAS unsigned char* lptr;

constexpr int D = 1024, DIN = 4880, NIN = 5120, DMIX = 1536, TP = 16384, MTOK = 16512, MPAD = 16640, SEQ = 8192;
constexpr int C_AQ = 0, C_AK = 256, C_AV = 512, C_AO = 1024, C_AZ = 1536, C_AI = 2048, C_AF = 2052, C_BZ = 2056, C_BX = 2568, C_BB = 3080, C_BC = 3336,
              C_BDT = 3592, C_CQ = 3600, C_CK = 4112, C_CV = 4240, C_CZ = 4368;
constexpr float EPS = 1e-6f;
constexpr size_t O_YP = 0, O_YS = 16777216, O_PC = 16908288, O_PN = 17170432, O_PM = 17172480, O_PH = 17172512, O_PCONV = 17696800, O_PK = 17721376,
                 O_PV = 17852448, O_SC = 17983520, O_SN = 34760736, O_SM = 34891808, O_SH = 34893856, O_SCONV = 68448288, O_SK = 70021152, O_SV = 78409760;
constexpr size_t WS_BAR = 0;
constexpr size_t WS_PAR = 16384;
constexpr size_t WS_WIN = WS_PAR + 102400;
constexpr size_t WS_WOUT = WS_WIN + (size_t)4 * NIN * D * 2;
constexpr size_t WS_XB = WS_WOUT + (size_t)4 * D * DMIX * 2;
constexpr size_t WS_U = WS_XB + (size_t)MPAD * D * 2;
constexpr size_t WS_MIX = WS_U + (size_t)MPAD * NIN * 2;
constexpr size_t WS_SSQ = WS_MIX + (size_t)MPAD * DMIX * 2;
constexpr size_t WS_ROPE = WS_SSQ + (size_t)MPAD * 16 * 4;
constexpr size_t WS_MC = WS_ROPE + (size_t)8200 * 64 * 4;
constexpr size_t WS_MN = WS_MC + (size_t)8 * 128 * 8192 * 4;
constexpr size_t WS_ML = WS_MN + (size_t)8 * 128 * 64 * 4;
constexpr size_t WS_BL = WS_ML + 4096;
constexpr size_t WS_MS = WS_BL + 4096;
constexpr size_t WS_SA = WS_MS + 4096;
constexpr size_t WS_SH = WS_SA + 8192;
constexpr size_t WS_CSB = WS_SH + (size_t)16 * 128 * 8192 * 4;
constexpr size_t WS_HSB = WS_CSB + (size_t)8 * 128 * 8192 * 2;
constexpr size_t WS_NS = WS_HSB + (size_t)16 * 128 * 8192 * 2;
constexpr size_t WS_END = WS_NS + (size_t)8 * 128 * 64 * 4;
constexpr int LDS_BYTES = 139264;
constexpr int NT = 512;

struct Args { const float* in[24]; float* out; unsigned char* ws; int ph_lo, ph_hi; };

__device__ __forceinline__ float bf2f(unsigned v) { return __uint_as_float(v << 16); }
__device__ __forceinline__ unsigned pk2(float lo, float hi) { f32x2 v = {lo, hi}; bf16x2_t b = __builtin_convertvector(v, bf16x2_t); return __builtin_bit_cast(unsigned, b); }
__device__ __forceinline__ unsigned f2bf(float f) { return pk2(f, 0.f) & 0xffffu; }
__device__ __forceinline__ void unpack8(u32x4 w, float (&f)[8]) {
#pragma unroll
    for (int i = 0; i < 4; ++i) { f[2 * i] = __uint_as_float(w[i] << 16); f[2 * i + 1] = __uint_as_float(w[i] & 0xffff0000u); }
}
__device__ __forceinline__ u32x4 pack8(const float (&f)[8]) { u32x4 w; w[0] = pk2(f[0], f[1]); w[1] = pk2(f[2], f[3]); w[2] = pk2(f[4], f[5]); w[3] = pk2(f[6], f[7]); return w; }
__device__ __forceinline__ u32x4 pack8v(f32x4 a, f32x4 b) { u32x4 w; w[0] = pk2(a[0], a[1]); w[1] = pk2(a[2], a[3]); w[2] = pk2(b[0], b[1]); w[3] = pk2(b[2], b[3]); return w; }
__device__ __forceinline__ bf16x8 as_frag(u32x4 w) { return __builtin_bit_cast(bf16x8, w); }
__device__ __forceinline__ bf16x8 ldg_f32_frag(const float* p) { f32x4 a = *(const f32x4*)p, b = *(const f32x4*)(p + 4); return as_frag(pack8v(a, b)); }
__device__ __forceinline__ bf16x8 lds_frag(lptr base, int row, int k, int stride) { return *(const LAS bf16x8*)(base + ((row * stride + k) << 1)); }
__device__ __forceinline__ f32x4 mfma16(bf16x8 a, bf16x8 b, f32x4 c) { return __builtin_amdgcn_mfma_f32_16x16x32_bf16(a, b, c, 0, 0, 0); }
__device__ __forceinline__ float rcpf_(float x) { return __builtin_amdgcn_rcpf(x); }
__device__ __forceinline__ float sigmoidf_(float x) { return rcpf_(1.f + __expf(-x)); }
__device__ __forceinline__ float siluf_(float x) { return x * rcpf_(1.f + __expf(-x)); }
__device__ __forceinline__ float softplusf_(float x) { return x > 20.f ? x : __logf(1.f + __expf(x)); }
__device__ __forceinline__ float logsigf_(float x) { return fminf(x, 0.f) - __logf(1.f + __expf(-fabsf(x))); }
template <int CTRL, int RM> __device__ __forceinline__ float dpps(float ident, float v) { return __int_as_float(__builtin_amdgcn_update_dpp(__float_as_int(ident), __float_as_int(v), CTRL, RM, 0xf, false)); }
__device__ __forceinline__ float wave_scan_sum(float v, int) {
    v += dpps<0x111, 0xf>(0.f, v); v += dpps<0x112, 0xf>(0.f, v); v += dpps<0x114, 0xf>(0.f, v); v += dpps<0x118, 0xf>(0.f, v);
    v += dpps<0x142, 0xa>(0.f, v); v += dpps<0x143, 0xc>(0.f, v);
    return v;
}
__device__ __forceinline__ float wave_scan_max(float v, int) {
    const float NI = -3.0e38f;
    v = fmaxf(v, dpps<0x111, 0xf>(NI, v)); v = fmaxf(v, dpps<0x112, 0xf>(NI, v)); v = fmaxf(v, dpps<0x114, 0xf>(NI, v)); v = fmaxf(v, dpps<0x118, 0xf>(NI, v));
    v = fmaxf(v, dpps<0x142, 0xa>(NI, v)); v = fmaxf(v, dpps<0x143, 0xc>(NI, v));
    return v;
}
__device__ __forceinline__ float lane63(float v) { return __int_as_float(__builtin_amdgcn_readlane(__float_as_int(v), 63)); }
__device__ __forceinline__ float red16(float v);
__device__ __forceinline__ float red16max(float v);
__device__ __forceinline__ float wave_sum(float v) { v = red16(v); v += __shfl_xor(v, 16); v += __shfl_xor(v, 32); return v; }
__device__ __forceinline__ float wave_max(float v) { v = red16max(v); v = fmaxf(v, __shfl_xor(v, 16)); v = fmaxf(v, __shfl_xor(v, 32)); return v; }
template <int CTRL> __device__ __forceinline__ float dppf(float v) { return __int_as_float(__builtin_amdgcn_update_dpp(0, __float_as_int(v), CTRL, 0xf, 0xf, true)); }
__device__ __forceinline__ float red16(float v) { v += dppf<0xB1>(v); v += dppf<0x4E>(v); v += dppf<0x141>(v); v += dppf<0x140>(v); return v; }
__device__ __forceinline__ float red16max(float v) { v = fmaxf(v, dppf<0xB1>(v)); v = fmaxf(v, dppf<0x4E>(v)); v = fmaxf(v, dppf<0x141>(v)); v = fmaxf(v, dppf<0x140>(v)); return v; }
__device__ __forceinline__ int OPQ(int v) { asm volatile("" : "+v"(v)); return v; }
#define LDS_FENCE() asm volatile("s_waitcnt lgkmcnt(0)" ::: "memory")

namespace pg8 {
constexpr int BM = 256, BK = 64, HALF = 128, HTB = HALF * BK * 2, STAGE_BYTES = 8 * HTB, NXCD = 8, WGM = 8;
__host__ __device__ __forceinline__ int lds_byte(int r, int c) { const int st = (r >> 4) * 2 + (c >> 5), rr = r & 15, cc = c & 31, ob = rr * 64 + cc * 2; return st * 1024 + (ob ^ (((ob >> 9) & 1) << 5)); }
__host__ __device__ __forceinline__ void stage_rc(int b, int& R, int& C) { const int st = b / 1024, sb = b % 1024, swz = sb ^ (((sb >> 9) & 1) << 5); R = (st >> 1) * 16 + swz / 64; C = (st & 1) * 32 + (swz % 64) / 2; }
__host__ __device__ __forceinline__ int perm32(int rho) { const int n = rho >> 4, i = rho & 15; return 8 * (i >> 2) + 4 * n + (i & 3); }
struct Unit { int pm, pn; };
struct Gemm { const bf16_t* A; const bf16_t* Bt; int M, N, K; };
struct StaticOrder {
    int nM, nN, nwg, G, c;
    __device__ void init(int M, int N, int G_, int c_) { nM = M / BM; nN = N / BM; nwg = nM * nN; G = G_; c = c_; }
    __device__ bool next(int i, Unit& u) const {
        const long L = (long)i * G + c; if (L >= nwg) return false;
        int wgid = (int)L; { const int q = nwg / NXCD, r = nwg % NXCD, xcd = wgid % NXCD, off = wgid / NXCD; wgid = (xcd < r ? xcd * (q + 1) : r * (q + 1) + (xcd - r) * q) + off; }
        const int nig = WGM * nN, gid = wgid / nig, fm = gid * WGM, gsz = (nM - fm) < WGM ? (nM - fm) : WGM;
        u.pm = fm + ((wgid % nig) % gsz); u.pn = (wgid % nig) / gsz; return true;
    }
};
template <int NAI> struct EpiU_ {
    bf16_t* U; const float* ssq;
    __device__ __forceinline__ void operator()(const f32x4 (&acc)[2][2][4][2], const Unit& u, int wr, int wc, int fr, int fq) const {
        const int row0 = u.pm * BM + wr * 64 + fr, col0 = u.pn * BM + wc * 32 + 8 * fq;
#pragma unroll
        for (int ai = 0; ai < NAI; ++ai)
#pragma unroll
            for (int m = 0; m < 4; ++m) {
                const int r = row0 + ai * HALF + m * 16;
                const f32x4 s = *(const f32x4*)(ssq + (size_t)r * 16 + fq * 4);
                float st = s[0] + s[1] + s[2] + s[3]; st += __shfl_xor(st, 16); st += __shfl_xor(st, 32);
                const float rs = rsqrtf(st * (1.f / 1024.f) + EPS);
                bf16_t* rowp = U + (size_t)r * NIN + col0;
#pragma unroll
                for (int bj = 0; bj < 2; ++bj) *(u32x4*)(rowp + bj * HALF) = pack8v(acc[ai][bj][m][0] * rs, acc[ai][bj][m][1] * rs);
                __builtin_amdgcn_sched_barrier(0);
            }
    }
};
template <int NAI, int MODE> struct EpiRes_ {
    const float* xp; const float* xs; float* out; bf16_t* xb; float* ssq;
    __device__ __forceinline__ void operator()(const f32x4 (&acc)[2][2][4][2], const Unit& u, int wr, int wc, int fr, int fq) const {
        const int row0 = u.pm * BM + wr * 64 + fr, col0 = u.pn * BM + wc * 32 + 8 * fq;
#pragma unroll
        for (int ai = 0; ai < NAI; ++ai)
#pragma unroll
            for (int m = 0; m < 4; ++m) {
                const int r = row0 + ai * HALF + m * 16;
                const bool valid = r < MTOK;
                float part = 0.f;
#pragma unroll
                for (int bj = 0; bj < 2; ++bj) {
                    const int c = col0 + bj * HALF;
                    f32x4 o0 = {0.f, 0.f, 0.f, 0.f}, o1 = {0.f, 0.f, 0.f, 0.f};
                    if (MODE == 0) {
                        const float* src = r < TP ? xp + (size_t)r * D : xs + (size_t)(r - TP) * D;
                        if (valid) { o0 = __builtin_nontemporal_load((const f32x4*)(src + c)); o1 = __builtin_nontemporal_load((const f32x4*)(src + c + 4)); }
                    } else {
                        float f[8]; unpack8(*(const u32x4*)(xb + (size_t)r * D + c), f);
                        o0 = (f32x4){f[0], f[1], f[2], f[3]}; o1 = (f32x4){f[4], f[5], f[6], f[7]};
                    }
                    const f32x4 v0 = acc[ai][bj][m][0] + o0, v1 = acc[ai][bj][m][1] + o1;
                    if (MODE == 2) {
                        if (valid) { __builtin_nontemporal_store(v0, (f32x4*)(out + (size_t)r * D + c)); __builtin_nontemporal_store(v1, (f32x4*)(out + (size_t)r * D + c + 4)); }
                    } else {
                        *(u32x4*)(xb + (size_t)r * D + c) = pack8v(v0, v1);
                        part += v0[0] * v0[0] + v0[1] * v0[1] + v0[2] * v0[2] + v0[3] * v0[3] + v1[0] * v1[0] + v1[1] * v1[1] + v1[2] * v1[2] + v1[3] * v1[3];
                    }
                }
                if (MODE != 2) {
                    part += __shfl_xor(part, 16); part += __shfl_xor(part, 32);
                    if (fq == 0) ssq[(size_t)r * 16 + u.pn * 4 + wc] = part;
                }
                __builtin_amdgcn_sched_barrier(0);
            }
    }
};

typedef EpiU_<2> EpiU; typedef EpiU_<1> EpiUh;
struct EpiProbe {
    const unsigned* flag; float* dst;
    __device__ __forceinline__ void operator()(const f32x4 (&acc)[2][2][4][2], const Unit& u, int wr, int wc, int fr, int fq) const {
        if (__hip_atomic_load(flag, __ATOMIC_RELAXED, __HIP_MEMORY_SCOPE_AGENT) == 12345u) {
            f32x4 t = {0.f, 0.f, 0.f, 0.f};
#pragma unroll
            for (int a = 0; a < 2; ++a)
#pragma unroll
                for (int b = 0; b < 2; ++b)
#pragma unroll
                    for (int m = 0; m < 4; ++m)
#pragma unroll
                        for (int n = 0; n < 2; ++n) t += acc[a][b][m][n];
            *(f32x4*)(dst + (size_t)(u.pm * 4 + u.pn) * 2048 + (wr * 4 + wc) * 256 + (fq * 16 + fr) * 4) = t;
        }
    }
};
struct SampleOrder {
    int first, cnt, c;
    __device__ bool next(int i, Unit& u) const { if (i != 0 || c < first || c >= first + cnt) return false; u.pm = 64; u.pn = c - first; return true; }
};
template <class Epi, class Sched, bool HALF_M = false, bool SP2 = false, bool ALIGN_EPI = false>
__device__ __forceinline__ void gemm_phase(lptr lds, const Gemm g, const Sched& S, const Epi& E, const int tid) {
    const int wid = __builtin_amdgcn_readfirstlane(tid >> 6), lane = tid & 63, wr = wid >> 2, wc = wid & 3, fr = lane & 15, fq = lane >> 4;
    const int K = g.K, nt = K / BK;
    unsigned voffA[2], voffB[2];
#pragma unroll
    for (int i = 0; i < 2; ++i) { int R, C; stage_rc(tid * 16 + i * 8192, R, C); const int Rb = (R & ~31) + perm32(R & 31);
        voffA[i] = (unsigned)(R * K + C) * 2u; voffB[i] = (unsigned)(Rb * K + C) * 2u; }
    const size_t kstep = (size_t)(BK * 2);
    const size_t hstep = (size_t)HALF * K * 2;
    const size_t tstep = 2 * hstep;
    const unsigned ldsw = (unsigned)wid * 1024u;
    const int aoff = lds_byte(wr * 64 + fr, fq * 8), boff = lds_byte(wc * 32 + fr, fq * 8);
#define PG8_SA(b, h) (((b) * 2 + (h)) * HTB)
#define PG8_SB(b, h) ((4 + (b) * 2 + (h)) * HTB)
#define PG8_STAGE(bufoff, gbase, voff) do { _Pragma("unroll") for (int _i = 0; _i < 2; ++_i) \
        __builtin_amdgcn_global_load_lds((const unsigned*)((const char*)(gbase) + (voff)[_i]), (LAS unsigned*)(lds + (bufoff) + ldsw + _i * 8192), 16, 0, 0); } while (0)
#define PG8_LDA(dst, b, h) do { _Pragma("unroll") for (int m = 0; m < 4; ++m) _Pragma("unroll") for (int k = 0; k < 2; ++k) dst[m][k] = *(const LAS bf16x8*)(lds + PG8_SA(b, h) + aoff + m * 2048 + k * 1024); } while (0)
#define PG8_LDB(dst, b, h) do { _Pragma("unroll") for (int n = 0; n < 2; ++n) _Pragma("unroll") for (int k = 0; k < 2; ++k) dst[n][k] = *(const LAS bf16x8*)(lds + PG8_SB(b, h) + boff + n * 2048 + k * 1024); } while (0)
#define PG8_MMA(ai, bj, At, Bt) do { __builtin_amdgcn_s_setprio(1); _Pragma("unroll") for (int m = 0; m < 4; ++m) _Pragma("unroll") for (int n = 0; n < 2; ++n) _Pragma("unroll") for (int k = 0; k < 2; ++k) \
        acc[ai][bj][m][n] = __builtin_amdgcn_mfma_f32_16x16x32_bf16(Bt[n][k], At[m][k], acc[ai][bj][m][n], 0, 0, 0); __builtin_amdgcn_s_setprio(0); } while (0)
#define PG8_WAIT_V(n) asm volatile("s_waitcnt vmcnt(" #n ")" ::: "memory")
#define PG8_WAIT_L(n) asm volatile("s_waitcnt lgkmcnt(" #n ")" ::: "memory")
#define PG8_BAR __builtin_amdgcn_s_barrier()
#define PG8_SCHED __builtin_amdgcn_sched_barrier(0)
    Unit cur, nxt; int ui = 0;
    if (!S.next(0, cur)) return;
    f32x4 acc[2][2][4][2];
#pragma unroll
    for (int a = 0; a < 2; ++a)
#pragma unroll
        for (int b = 0; b < 2; ++b)
#pragma unroll
            for (int m = 0; m < 4; ++m)
#pragma unroll
                for (int n = 0; n < 2; ++n) acc[a][b][m][n] = (f32x4){0.f, 0.f, 0.f, 0.f};
    bf16x8 At[4][2], B0[2][2], B1[2][2];
    const char* cA = (const char*)g.A + (size_t)cur.pm * tstep; const char* cB = (const char*)g.Bt + (size_t)cur.pn * tstep;
    if constexpr (SP2) {
        PG8_STAGE(PG8_SB(0, 0), cB, voffB); PG8_STAGE(PG8_SB(0, 1), cB + hstep, voffB); PG8_STAGE(PG8_SA(0, 0), cA, voffA); PG8_STAGE(PG8_SA(0, 1), cA + hstep, voffA);
        if (wr == 1) PG8_BAR;
        PG8_WAIT_V(2); PG8_BAR;
        PG8_STAGE(PG8_SB(1, 0), cB + kstep, voffB); PG8_STAGE(PG8_SA(1, 0), cA + kstep, voffA); PG8_STAGE(PG8_SB(1, 1), cB + hstep + kstep, voffB);
        PG8_WAIT_V(6); PG8_BAR;
    } else {
    PG8_STAGE(PG8_SB(0, 0), cB, voffB); PG8_STAGE(PG8_SA(0, 0), cA, voffA); PG8_STAGE(PG8_SB(0, 1), cB + hstep, voffB); PG8_STAGE(PG8_SA(0, 1), cA + hstep, voffA);
    if (wr == 1) PG8_BAR;
    PG8_WAIT_V(4); PG8_BAR;
    PG8_STAGE(PG8_SB(1, 0), cB + kstep, voffB); PG8_STAGE(PG8_SA(1, 0), cA + kstep, voffA); PG8_STAGE(PG8_SB(1, 1), cB + hstep + kstep, voffB);
    PG8_WAIT_V(6); PG8_BAR;
    }
    for (;;) {
        const bool has_next = S.next(ui + 1, nxt);
        const char* nA = has_next ? (const char*)g.A + (size_t)nxt.pm * tstep : cA; const char* nB = has_next ? (const char*)g.Bt + (size_t)nxt.pn * tstep : cB;
        for (int t = 0; t < nt; t += 2) {
            const bool last = (t == nt - 2);
            const char* a1 = cA + (size_t)(t + 1) * kstep;
            const char* a2 = last ? nA : cA + (size_t)(t + 2) * kstep; const char* b2 = last ? nB : cB + (size_t)(t + 2) * kstep;
            const char* a3 = a2 + kstep; const char* b3 = b2 + kstep;
            if constexpr (SP2) {
            PG8_LDB(B0, 0, 0); PG8_LDB(B1, 0, 1); PG8_SCHED; PG8_LDA(At, 0, 0); PG8_STAGE(PG8_SA(1, 1), a1 + hstep, voffA);
            PG8_WAIT_V(8); PG8_WAIT_L(0); PG8_BAR; PG8_MMA(0, 0, At, B0); PG8_MMA(0, 1, At, B1); PG8_BAR; PG8_SCHED;
            PG8_LDA(At, 0, 1); PG8_STAGE(PG8_SB(0, 0), b2, voffB); PG8_STAGE(PG8_SB(0, 1), b2 + hstep, voffB); PG8_STAGE(PG8_SA(0, 0), a2, voffA);
            PG8_WAIT_V(8); PG8_WAIT_L(0); PG8_BAR; PG8_MMA(1, 0, At, B0); PG8_MMA(1, 1, At, B1); PG8_BAR; PG8_SCHED;
            PG8_LDB(B0, 1, 0); PG8_LDB(B1, 1, 1); PG8_SCHED; PG8_LDA(At, 1, 0); PG8_STAGE(PG8_SA(0, 1), a2 + hstep, voffA);
            PG8_WAIT_V(8); PG8_WAIT_L(0); PG8_BAR; PG8_MMA(0, 0, At, B0); PG8_MMA(0, 1, At, B1); PG8_BAR; PG8_SCHED;
            PG8_LDA(At, 1, 1); PG8_STAGE(PG8_SB(1, 0), b3, voffB); PG8_STAGE(PG8_SB(1, 1), b3 + hstep, voffB); PG8_STAGE(PG8_SA(1, 0), a3, voffA);
            PG8_WAIT_V(8); PG8_WAIT_L(0); PG8_BAR; PG8_MMA(1, 0, At, B0); PG8_MMA(1, 1, At, B1); PG8_BAR; PG8_SCHED;
            } else {
            PG8_LDB(B0, 0, 0); PG8_SCHED; PG8_LDA(At, 0, 0); PG8_STAGE(PG8_SA(1, 1), a1 + hstep, voffA);
            PG8_WAIT_L(8); PG8_BAR; PG8_WAIT_L(0); PG8_MMA(0, 0, At, B0); PG8_BAR; PG8_SCHED;
            PG8_LDB(B1, 0, 1); PG8_STAGE(PG8_SB(0, 0), b2, voffB);
            PG8_BAR; PG8_WAIT_L(0); PG8_MMA(0, 1, At, B1); PG8_BAR;
            if constexpr (!HALF_M) PG8_LDA(At, 0, 1);
            PG8_STAGE(PG8_SA(0, 0), a2, voffA);
            PG8_BAR; PG8_WAIT_L(0); if constexpr (!HALF_M) PG8_MMA(1, 0, At, B0); PG8_BAR; PG8_SCHED;
            PG8_STAGE(PG8_SB(0, 1), b2 + hstep, voffB);
            PG8_WAIT_V(6); PG8_BAR; if constexpr (!HALF_M) PG8_MMA(1, 1, At, B1); PG8_BAR;
            PG8_LDB(B0, 1, 0); PG8_SCHED; PG8_LDA(At, 1, 0); PG8_STAGE(PG8_SA(0, 1), a2 + hstep, voffA);
            PG8_WAIT_L(8); PG8_BAR; PG8_WAIT_L(0); PG8_MMA(0, 0, At, B0); PG8_BAR; PG8_SCHED;
            PG8_LDB(B1, 1, 1); PG8_STAGE(PG8_SB(1, 0), b3, voffB);
            PG8_BAR; PG8_WAIT_L(0); PG8_MMA(0, 1, At, B1); PG8_BAR;
            if constexpr (!HALF_M) PG8_LDA(At, 1, 1);
            PG8_STAGE(PG8_SA(1, 0), a3, voffA);
            PG8_BAR; PG8_WAIT_L(0); if constexpr (!HALF_M) PG8_MMA(1, 0, At, B0); PG8_BAR; PG8_SCHED;
            PG8_STAGE(PG8_SB(1, 1), b3 + hstep, voffB);
            PG8_WAIT_V(6); PG8_BAR; if constexpr (!HALF_M) PG8_MMA(1, 1, At, B1); PG8_BAR;
            }
        }
        if constexpr (ALIGN_EPI) { if (wr == 0) PG8_BAR; }
        E(acc, cur, wr, wc, fr, fq);
        if (!has_next) break;
#pragma unroll
        for (int a = 0; a < 2; ++a)
#pragma unroll
            for (int b = 0; b < 2; ++b)
#pragma unroll
                for (int m = 0; m < 4; ++m)
#pragma unroll
                    for (int n = 0; n < 2; ++n) acc[a][b][m][n] = (f32x4){0.f, 0.f, 0.f, 0.f};
        cur = nxt; cA = nA; cB = nB; ++ui;
        if constexpr (ALIGN_EPI) { if (wr == 1) PG8_BAR; }
    }
    PG8_WAIT_V(0);
    if constexpr (!ALIGN_EPI) { if (wr == 0) PG8_BAR; }
    PG8_BAR;
#undef PG8_SA
#undef PG8_SB
#undef PG8_STAGE
#undef PG8_LDA
#undef PG8_LDB
#undef PG8_MMA
#undef PG8_WAIT_V
#undef PG8_WAIT_L
#undef PG8_BAR
#undef PG8_SCHED
}
}

struct Ctx {
    const float* xp; const float* xs; const float* stC; const float* stN; const float* stM; const float* ssm; const float* conv; const float* ck; const float* cv;
    float* out; unsigned char* ws;
};
#define XWIN ((bf16_t*)(X.ws + WS_WIN))
#define XWOUT ((bf16_t*)(X.ws + WS_WOUT))
#define XXB ((bf16_t*)(X.ws + WS_XB))
#define XU ((bf16_t*)(X.ws + WS_U))
#define XMIX ((bf16_t*)(X.ws + WS_MIX))
#define XSSQ ((float*)(X.ws + WS_SSQ))
#define XROPE ((float*)(X.ws + WS_ROPE))
#define XMC ((float*)(X.ws + WS_MC))
#define XMN ((float*)(X.ws + WS_MN))
#define XML ((float*)(X.ws + WS_ML))
#define XBL ((float*)(X.ws + WS_BL))
#define XMS ((float*)(X.ws + WS_MS))
#define XSA ((float*)(X.ws + WS_SA))
#define XSH ((float*)(X.ws + WS_SH))
#define XCSB ((bf16_t*)(X.ws + WS_CSB))
#define XNS ((float*)(X.ws + WS_NS))
#define XHSB ((bf16_t*)(X.ws + WS_HSB))
#define XPAR(off) ((const float*)(X.ws + WS_PAR) + (off))
constexpr int P_AIB = 0, P_AFB = 16, P_DTB = 32, P_ALOG = 64, P_BD = 96, P_SINK = 128, P_QNW = 160, P_KNW = 416, P_ANW = 672, P_BNW = 2720, P_CB = 4768, P_CW = 8864, P_END = 25248;
#define IN_XP 0
#define IN_XS 1
#define IN_STC 2
#define IN_STN 3
#define IN_STM 4
#define IN_SSM 5
#define IN_CONV 6
#define IN_CK 7
#define IN_CV 8
#define IN_NORMW 9
#define IN_WIN 10
#define IN_AIB 11
#define IN_AFB 12
#define IN_ANW 13
#define IN_CW 14
#define IN_CB 15
#define IN_DTB 16
#define IN_ALOG 17
#define IN_BD 18
#define IN_BNW 19
#define IN_QNW 20
#define IN_KNW 21
#define IN_SINK 22
#define IN_WOUT 23

__device__ __forceinline__ void transpose_strip(lptr lds, const float* src, int ldn, int nvalid, bf16_t* dst, int ldk, const float* scale, int k0, int n0, int tid) {
    LAS float* T = (LAS float*)lds;
    f32x4 v[8];
#pragma unroll
    for (int i = 0; i < 8; ++i) {
        const int f = tid + i * NT, r = f >> 6, c4 = (f & 63) * 4, n = n0 + c4;
        const f32x4 t = __builtin_nontemporal_load((const f32x4*)(src + (size_t)(k0 + r) * ldn + (n < nvalid ? n : 0)));
        const float m = n < nvalid ? (scale ? scale[k0 + r] : 1.f) : 0.f;
        v[i] = t * m;
    }
#pragma unroll
    for (int i = 0; i < 8; ++i) {
        const int f = tid + i * NT, r = f >> 6, c4 = (f & 63) * 4;
        T[r * 257 + c4 + 0] = v[i][0]; T[r * 257 + c4 + 1] = v[i][1]; T[r * 257 + c4 + 2] = v[i][2]; T[r * 257 + c4 + 3] = v[i][3];
    }
    __syncthreads();
#pragma unroll
    for (int i = 0; i < 4; ++i) {
        const int p = tid + i * NT, n = p >> 3, k8 = (p & 7) * 8; float f[8];
#pragma unroll
        for (int jx = 0; jx < 8; ++jx) f[jx] = T[(k8 + jx) * 257 + n];
        *(u32x4*)(dst + (size_t)(n0 + n) * ldk + k0 + k8) = pack8(f);
    }
    __syncthreads();
}

__device__ __forceinline__ void prologue(lptr lds, const Ctx& X, const Args& args, int G, int bid, int tid) {
    const int lane = tid & 63, wave = tid >> 6;
    constexpr int T0 = 1280, T1 = T0 + 384, T2 = T1 + 2080, T3 = T2 + 1, T4 = T3 + 513;
    for (int task = bid; task < T4; task += G) {
        if (task < T0) {
            const int l = task / 320, r = task % 320, kt = r / 20, ntl = r % 20;
            transpose_strip(lds, args.in[IN_WIN] + (size_t)l * D * DIN, DIN, DIN, XWIN + (size_t)l * NIN * D, D, args.in[IN_NORMW] + l * D, kt * 64, ntl * 256, tid);
        } else if (task < T1) {
            const int t = task - T0, l = t / 96, r = t % 96, kt = r / 4, ntl = r % 4;
            transpose_strip(lds, args.in[IN_WOUT] + (size_t)l * DMIX * D, D, D, XWOUT + (size_t)l * D * DMIX, DMIX, nullptr, kt * 64, ntl * 256, tid);
        } else if (task < T2) {
            const int r = (task - T1) * 8 + wave;
            float ss = 0.f;
            if (r < MTOK) {
                const float* src = r < TP ? X.xp + (size_t)r * D : X.xs + (size_t)(r - TP) * D;
#pragma unroll
                for (int i = 0; i < 4; ++i) {
                    const int c = lane * 4 + i * 256; f32x4 v = __builtin_nontemporal_load((const f32x4*)(src + c));
                    ss += v[0] * v[0] + v[1] * v[1] + v[2] * v[2] + v[3] * v[3];
                    u32x2 w; w[0] = pk2(v[0], v[1]); w[1] = pk2(v[2], v[3]);
                    *(u32x2*)(XXB + (size_t)r * D + c) = w;
                }
            } else {
#pragma unroll
                for (int i = 0; i < 4; ++i) { u32x2 w = {0u, 0u}; *(u32x2*)(XXB + (size_t)r * D + lane * 4 + i * 256) = w; }
            }
            ss = wave_sum(ss);
            if (lane < 16) XSSQ[(size_t)r * 16 + lane] = (lane == 0) ? ss : 0.f;
        } else if (task < T3) {
            for (int i = tid; i < (MPAD - MTOK) * DMIX / 2; i += NT) ((unsigned*)(XMIX + (size_t)MTOK * DMIX))[i] = 0u;
            float* P = (float*)(X.ws + WS_PAR);
            const int po[12] = {P_AIB, P_AFB, P_DTB, P_ALOG, P_BD, P_SINK, P_QNW, P_KNW, P_ANW, P_BNW, P_CB, P_CW};
            const int pn[12] = {16, 16, 32, 32, 32, 32, 256, 256, 2048, 2048, 4096, 16384};
            const int pi[12] = {IN_AIB, IN_AFB, IN_DTB, IN_ALOG, IN_BD, IN_SINK, IN_QNW, IN_KNW, IN_ANW, IN_BNW, IN_CB, IN_CW};
#pragma unroll
            for (int a = 0; a < 12; ++a) { const float* src = args.in[pi[a]]; for (int i = tid; i < pn[a]; i += NT) P[po[a] + i] = src[i]; }
        } else {
            const int e = (task - T3) * 512 + tid;
            if (e < 8193 * 32) {
                const int pos = e >> 5, d = e & 31;
                const float inv = (float)exp2(-(double)d * (13.287712379549449 / 32.0));
                const float angf = (float)pos * inv;
                const double a = (double)angf;
                const double k = rint(a * 0.15915494309189535);
                const float rr = (float)(a - k * 6.283185307179586);
                XROPE[(size_t)e * 2] = cosf(rr); XROPE[(size_t)e * 2 + 1] = sinf(rr);
            }
        }
    }
}

__device__ __forceinline__ void conv8(const bf16_t* u, int seq0, int tt, int ch, const float* cw, const float* cb, float (&o)[8]) {
    float acc[8];
    { f32x4 b0 = *(const f32x4*)(cb + ch), b1 = *(const f32x4*)(cb + ch + 4);
#pragma unroll
      for (int j = 0; j < 4; ++j) { acc[j] = b0[j]; acc[4 + j] = b1[j]; } }
#pragma unroll
    for (int jj = 0; jj < 4; ++jj) {
        const int t2 = tt + jj - 3;
        if (t2 >= 0) {
            float x[8]; unpack8(*(const u32x4*)(u + (size_t)(seq0 + t2) * NIN + C_BX + ch), x);
            f32x4 w0 = *(const f32x4*)(cw + jj * 1024 + ch), w1 = *(const f32x4*)(cw + jj * 1024 + ch + 4);
#pragma unroll
            for (int j = 0; j < 4; ++j) { acc[j] += x[j] * w0[j]; acc[4 + j] += x[4 + j] * w1[j]; }
        }
    }
#pragma unroll
    for (int j = 0; j < 8; ++j) o[j] = siluf_(acc[j]);
}


__device__ __forceinline__ void conv8x8(const bf16_t* u, int seq0, int tt0, int ch, const float* cw, const float* cb, float (&o)[8][8]) {
    float w[4][8];
#pragma unroll
    for (int jj = 0; jj < 4; ++jj) { f32x4 w0 = *(const f32x4*)(cw + jj * 1024 + ch), w1 = *(const f32x4*)(cw + jj * 1024 + ch + 4);
#pragma unroll
        for (int j = 0; j < 4; ++j) { w[jj][j] = w0[j]; w[jj][4 + j] = w1[j]; } }
    { f32x4 b0 = *(const f32x4*)(cb + ch), b1 = *(const f32x4*)(cb + ch + 4);
#pragma unroll
      for (int t = 0; t < 8; ++t)
#pragma unroll
          for (int j = 0; j < 4; ++j) { o[t][j] = b0[j]; o[t][4 + j] = b1[j]; } }
    u32x4 raw[11];
#pragma unroll
    for (int r = 0; r < 11; ++r) {
        const int t2 = tt0 + r - 3;
        const u32x4 v = *(const u32x4*)(u + (unsigned)(seq0 + (t2 >= 0 ? t2 : 0)) * NIN + C_BX + ch);
        const unsigned msk = t2 >= 0 ? 0xffffffffu : 0u;
        raw[r] = (u32x4){v[0] & msk, v[1] & msk, v[2] & msk, v[3] & msk};
    }
#pragma unroll
    for (int r = 0; r < 11; ++r) {
        float x[8]; unpack8(raw[r], x);
#pragma unroll
        for (int jj = 0; jj < 4; ++jj) {
            const int t = r - jj;
            if (t >= 0 && t < 8) {
#pragma unroll
                for (int j = 0; j < 8; ++j) o[t][j] += x[j] * w[jj][j];
            }
        }
    }
#pragma unroll
    for (int t = 0; t < 8; ++t)
#pragma unroll
        for (int j = 0; j < 8; ++j) o[t][j] = siluf_(o[t][j]);
}

__device__ __forceinline__ void mlstm_local(lptr lds, const Ctx& X, int l, int task, int tid) {
    const int h = task & 3, c = (task >> 2) & 127, n = task >> 9;
    const int lane = tid & 63, wave = tid >> 6, fr = lane & 15, fq = lane >> 4;
    const int row0 = n * SEQ + c * 64, nh = n * 4 + h;
    lptr VwT = lds;
    lptr KT = lds + 18432;
    LAS float* wv = (LAS float*)(lds + 27648);
    const int tg = lane & 7, cgq = lane >> 3;
    u32x4 blk[8];
    if (wave >= 1 && wave <= 3) {
        const int col = wave < 3 ? C_AV + h * 128 + ((wave - 1) * 8 + cgq) * 8 : C_AK + h * 64 + cgq * 8;
#pragma unroll
        for (int t = 0; t < 8; ++t) blk[t] = *(const u32x4*)(XU + (unsigned)(row0 + 8 * tg + t) * NIN + col);
    }
    if (wave == 0) {
        const bf16_t* ur = XU + (unsigned)(row0 + lane) * NIN;
        const float fg = bf2f(ur[C_AF + h]) + XPAR(P_AFB)[l * 4 + h], ig = bf2f(ur[C_AI + h]) + XPAR(P_AIB)[l * 4 + h];
        const float b = wave_scan_sum(logsigf_(fg), lane);
        const float bl = lane63(b);
        const float g = bl - b + ig;
        const float ml = wave_max(g);
        wv[lane] = __expf(g - ml);
        if (lane == 0) { XML[nh * 128 + c] = ml; XBL[nh * 128 + c] = bl; }
    }
    __syncthreads();
    if (wave >= 1 && wave <= 3) {
        float xs[8][8];
#pragma unroll
        for (int t = 0; t < 8; ++t) { unpack8(blk[t], xs[t]); const float w = wave < 3 ? wv[8 * tg + t] : 0.125f;
#pragma unroll
            for (int j = 0; j < 8; ++j) xs[t][j] *= w; }
        lptr dstT = wave < 3 ? VwT + ((((wave - 1) * 8 + cgq) * 8 * 72) << 1) : KT + ((cgq * 8 * 72) << 1);
#pragma unroll
        for (int j = 0; j < 8; ++j) {
            float v[8];
#pragma unroll
            for (int t = 0; t < 8; ++t) v[t] = xs[t][j];
            *(LAS u32x4*)(dstT + ((j * 72 + 8 * tg) << 1)) = pack8(v);
        }
    }
    __syncthreads();
    {
        bf16_t* dst = (bf16_t*)XMC + ((size_t)nh * 128 + c) * 8192;
        bf16x8 b0 = lds_frag(VwT, 16 * wave + fr, fq * 8, 72), b1 = lds_frag(VwT, 16 * wave + fr, 32 + fq * 8, 72);
#pragma unroll
        for (int mt = 0; mt < 4; ++mt) {
            f32x4 acc = {0.f, 0.f, 0.f, 0.f};
            acc = mfma16(lds_frag(KT, 16 * mt + fr, fq * 8, 72), b0, acc);
            acc = mfma16(lds_frag(KT, 16 * mt + fr, 32 + fq * 8, 72), b1, acc);
            { u32x2 w; w[0] = pk2(acc[0], acc[1]); w[1] = pk2(acc[2], acc[3]); *(u32x2*)(dst + (16 * wave + fr) * 64 + 16 * mt + 4 * fq) = w; }
        }
    }
    if (tid < 64) {
        float s = 0.f;
#pragma unroll
        for (int t8 = 0; t8 < 8; ++t8) {
            float kf[8]; unpack8(*(const LAS u32x4*)(KT + ((tid * 72 + t8 * 8) << 1)), kf);
#pragma unroll
            for (int jx = 0; jx < 8; ++jx) s += kf[jx] * wv[t8 * 8 + jx];
        }
        XMN[((size_t)nh * 128 + c) * 64 + tid] = s;
    }
    __syncthreads();
}

__device__ __forceinline__ void ssd_local(lptr lds, const Ctx& X, int l, int task, int tid) {
    const int g = task & 1, c = (task >> 1) & 127, n = task >> 8;
    const int lane = tid & 63, wave = tid >> 6, fr = lane & 15, fq = lane >> 4;
    const int seq0 = n * SEQ, row0 = seq0 + c * 64;
    lptr XwT = lds;
    lptr BT = lds + 36864;
    LAS float* wl = (LAS float*)(lds + 55296);
    {
        const float* cw = XPAR(P_CW) + l * 4096; const float* cb = XPAR(P_CB) + l * 1024;
        const int tg = lane & 7, cg = wave * 8 + (lane >> 3);
        float o[8][8];
        if (wave < 6) {
            const int ch = cg < 32 ? g * 256 + cg * 8 : 512 + g * 128 + (cg - 32) * 8;
            conv8x8(XU, seq0, c * 64 + 8 * tg, ch, cw, cb, o);
        }
        if (wave < 4) {
            const int hh = 4 * g + wave;
            const float dt = softplusf_(bf2f(XU[(unsigned)(row0 + lane) * NIN + C_BDT + hh]) + XPAR(P_DTB)[l * 8 + hh]);
            const float A = -__expf(XPAR(P_ALOG)[l * 8 + hh]);
            const float a = wave_scan_sum(dt * A, lane);
            const float aL = lane63(a);
            wl[wave * 64 + lane] = __expf(aL - a) * dt;
            if (lane == 0) XSA[(n * 8 + hh) * 128 + c] = aL;
        }
        __syncthreads();
        if (wave < 4) {
            float wt[8];
#pragma unroll
            for (int t = 0; t < 8; ++t) wt[t] = wl[wave * 64 + 8 * tg + t];
#pragma unroll
            for (int jx = 0; jx < 8; ++jx) {
                float v[8];
#pragma unroll
                for (int t = 0; t < 8; ++t) v[t] = o[t][jx] * wt[t];
                *(LAS u32x4*)(XwT + (((cg * 8 + jx) * 72 + 8 * tg) << 1)) = pack8(v);
            }
        } else if (wave < 6) {
#pragma unroll
            for (int jx = 0; jx < 8; ++jx) {
                float v[8];
#pragma unroll
                for (int t = 0; t < 8; ++t) v[t] = o[t][jx];
                *(LAS u32x4*)(BT + ((((cg - 32) * 8 + jx) * 72 + 8 * tg) << 1)) = pack8(v);
            }
        }
    }
    __syncthreads();
    {
        const int hl = wave >> 1, ph = wave & 1, hh = 4 * g + hl;
        bf16_t* dst = (bf16_t*)XSH + ((size_t)(n * 8 + hh) * 128 + c) * 8192;
        bf16x8 bx[2][2];
#pragma unroll
        for (int ntl = 0; ntl < 2; ++ntl)
#pragma unroll
            for (int kk = 0; kk < 2; ++kk) bx[ntl][kk] = lds_frag(XwT, hl * 64 + ph * 32 + ntl * 16 + fr, kk * 32 + fq * 8, 72);
#pragma unroll
        for (int mt = 0; mt < 8; ++mt) {
            bf16x8 a0 = lds_frag(BT, 16 * mt + fr, fq * 8, 72), a1 = lds_frag(BT, 16 * mt + fr, 32 + fq * 8, 72);
#pragma unroll
            for (int ntl = 0; ntl < 2; ++ntl) {
                f32x4 acc = {0.f, 0.f, 0.f, 0.f};
                acc = mfma16(a0, bx[ntl][0], acc); acc = mfma16(a1, bx[ntl][1], acc);
                { u32x2 w; w[0] = pk2(acc[0], acc[1]); w[1] = pk2(acc[2], acc[3]); *(u32x2*)(dst + (ph * 32 + ntl * 16 + fr) * 128 + 16 * mt + 4 * fq) = w; }
            }
        }
    }
    __syncthreads();
}

__device__ __forceinline__ void swa_prompt(lptr lds, const Ctx& X, int l, int task, int tid) {
    const int kvh = task & 1, qb = (task >> 1) & 63, n = task >> 7;
    const int lane = tid & 63, wave = tid >> 6, fr = lane & 15, fq = lane >> 4;
    const int seq0 = n * SEQ;
    lptr Kn = lds;
    lptr Vt = lds + 36864;
    lptr Pw = lds + 70656 + wave * 8448;
    const float* knw = XPAR(P_KNW) + l * 64; const float* qnw = XPAR(P_QNW) + l * 64;
#pragma unroll
    for (int it = 0; it < 2; ++it) {
        const int item = tid + it * NT, j = item >> 2, qd = item & 3, t = qb * 128 - 128 + j;
        float o1[8], o2[8];
        {
            const int tc = t >= 0 ? t : 0;
            const bf16_t* kr = XU + (unsigned)(seq0 + tc) * NIN + C_CK + kvh * 64;
            float x1[8], x2[8]; unpack8(*(const u32x4*)(kr + qd * 8), x1); unpack8(*(const u32x4*)(kr + 32 + qd * 8), x2);
            float ss = 0.f;
#pragma unroll
            for (int jj = 0; jj < 8; ++jj) ss += x1[jj] * x1[jj] + x2[jj] * x2[jj];
            ss += __shfl_xor(ss, 1); ss += __shfl_xor(ss, 2);
            const float rs = rsqrtf(ss * (1.f / 64.f) + EPS);
            const f32x4* cs = (const f32x4*)(XROPE + ((size_t)tc * 32 + qd * 8) * 2);
            f32x4 csv[4];
#pragma unroll
            for (int q4 = 0; q4 < 4; ++q4) csv[q4] = cs[q4];
            const float zm = t >= 0 ? 1.f : 0.f;
#pragma unroll
            for (int jj = 0; jj < 8; ++jj) {
                const float a = x1[jj] * rs * knw[qd * 8 + jj], b = x2[jj] * rs * knw[32 + qd * 8 + jj], co = csv[jj >> 1][(jj & 1) * 2], si = csv[jj >> 1][(jj & 1) * 2 + 1];
                o1[jj] = (a * co - b * si) * zm; o2[jj] = (b * co + a * si) * zm;
            }
        }
        *(LAS u32x4*)(Kn + ((j * 72 + qd * 8) << 1)) = pack8(o1);
        *(LAS u32x4*)(Kn + ((j * 72 + 32 + qd * 8) << 1)) = pack8(o2);
        if (qb == 63 && j >= 128) {
            float* ko = X.out + O_PK + ((((size_t)l * 2 + n) * 128 + (j - 128)) * 2 + kvh) * 64;
            *(f32x4*)(ko + qd * 8) = (f32x4){o1[0], o1[1], o1[2], o1[3]}; *(f32x4*)(ko + qd * 8 + 4) = (f32x4){o1[4], o1[5], o1[6], o1[7]};
            *(f32x4*)(ko + 32 + qd * 8) = (f32x4){o2[0], o2[1], o2[2], o2[3]}; *(f32x4*)(ko + 32 + qd * 8 + 4) = (f32x4){o2[4], o2[5], o2[6], o2[7]};
        }
    }
    if (wave < 4) {
        const int tg = tid & 31, cg = tid >> 5;
        u32x4 vb[8];
#pragma unroll
        for (int t8 = 0; t8 < 8; ++t8) {
            const int jk = 8 * tg + t8, t = qb * 128 - 128 + jk;
            u32x4 w = *(const u32x4*)(XU + (unsigned)(seq0 + (t >= 0 ? t : 0)) * NIN + C_CV + kvh * 64 + cg * 8);
            const unsigned msk = t >= 0 ? 0xffffffffu : 0u;
            vb[t8] = (u32x4){w[0] & msk, w[1] & msk, w[2] & msk, w[3] & msk};
        }
#pragma unroll
        for (int jj = 0; jj < 8; ++jj) {
            u32x4 w;
#pragma unroll
            for (int tp = 0; tp < 4; ++tp) {
                const unsigned lo = (vb[2 * tp][jj >> 1] >> ((jj & 1) * 16)) & 0xffffu, hi = (vb[2 * tp + 1][jj >> 1] >> ((jj & 1) * 16)) & 0xffffu;
                w[tp] = lo | (hi << 16);
            }
            *(LAS u32x4*)(Vt + (((cg * 8 + jj) * 264 + 8 * tg) << 1)) = w;
        }
        if (qb == 63 && tg >= 16) {
#pragma unroll
            for (int t8 = 0; t8 < 8; ++t8) {
                float x[8]; unpack8(vb[t8], x);
                float* vo = X.out + O_PV + ((((size_t)l * 2 + n) * 128 + (8 * tg + t8 - 128)) * 2 + kvh) * 64 + cg * 8;
                *(f32x4*)(vo) = (f32x4){x[0], x[1], x[2], x[3]}; *(f32x4*)(vo + 4) = (f32x4){x[4], x[5], x[6], x[7]};
            }
        }
    }
    __syncthreads();
    const int hq = kvh * 4 + (wave >> 1), i0 = (wave & 1) * 64;
    const float sink = XPAR(P_SINK)[l * 8 + hq];
    float qw1[8], qw2[8];
#pragma unroll
    for (int jj = 0; jj < 8; ++jj) { qw1[jj] = qnw[fq * 8 + jj]; qw2[jj] = qnw[32 + fq * 8 + jj]; }
    u32x4 qn0, qn1; f32x4 csn[4];
    {
        const int t = qb * 128 + i0 + fr;
        const bf16_t* qr = XU + (unsigned)(seq0 + t) * NIN + C_CQ + hq * 64;
        qn0 = *(const u32x4*)(qr + fq * 8); qn1 = *(const u32x4*)(qr + 32 + fq * 8);
        const f32x4* cs = (const f32x4*)(XROPE + ((size_t)t * 32 + fq * 8) * 2);
#pragma unroll
        for (int q4 = 0; q4 < 4; ++q4) csn[q4] = cs[q4];
    }
#pragma unroll 1
    for (int mt = 0; mt < 4; ++mt) {
        const int q0 = i0 + mt * 16;
        const u32x4 q0r = qn0, q1r = qn1; f32x4 csc[4];
#pragma unroll
        for (int q4 = 0; q4 < 4; ++q4) csc[q4] = csn[q4];
        {
            const int mn = mt < 3 ? mt + 1 : 3;
            const int t = qb * 128 + i0 + mn * 16 + fr;
            const bf16_t* qr = XU + (unsigned)(seq0 + t) * NIN + C_CQ + hq * 64;
            qn0 = *(const u32x4*)(qr + fq * 8); qn1 = *(const u32x4*)(qr + 32 + fq * 8);
            const f32x4* cs = (const f32x4*)(XROPE + ((size_t)t * 32 + fq * 8) * 2);
#pragma unroll
            for (int q4 = 0; q4 < 4; ++q4) csn[q4] = cs[q4];
        }
        bf16x8 a0, a1;
        {
            float x1[8], x2[8]; unpack8(q0r, x1); unpack8(q1r, x2);
            float ss = 0.f;
#pragma unroll
            for (int jj = 0; jj < 8; ++jj) ss += x1[jj] * x1[jj] + x2[jj] * x2[jj];
            ss += __shfl_xor(ss, 16); ss += __shfl_xor(ss, 32);
            const float rs = rsqrtf(ss * (1.f / 64.f) + EPS) * 0.125f;
            float o1[8], o2[8];
#pragma unroll
            for (int jj = 0; jj < 8; ++jj) {
                const float a = x1[jj] * rs * qw1[jj], b = x2[jj] * rs * qw2[jj], co = csc[jj >> 1][(jj & 1) * 2], si = csc[jj >> 1][(jj & 1) * 2 + 1];
                o1[jj] = a * co - b * si; o2[jj] = b * co + a * si;
            }
            a0 = as_frag(pack8(o1)); a1 = as_frag(pack8(o2));
        }
        const int tlo = q0 >> 4;
        const int qi = q0 + fr;
        const int dlo = qb > 0 ? 1 : (128 - qi > 1 ? 128 - qi : 1);
        f32x4 s[16];
        float mx = -3.0e38f;
#pragma unroll
        for (int ntl = 0; ntl < 16; ++ntl) {
            if (ntl >= tlo && ntl <= tlo + 8) {
                f32x4 acc = {0.f, 0.f, 0.f, 0.f};
                acc = mfma16(lds_frag(Kn, 16 * ntl + fr, fq * 8, 72), a0, acc);
                acc = mfma16(lds_frag(Kn, 16 * ntl + fr, 32 + fq * 8, 72), a1, acc);
                if (ntl == tlo || ntl == tlo + 8 || qb == 0) {
#pragma unroll
                    for (int ii = 0; ii < 4; ++ii) {
                        const int dk = 16 * ntl + 4 * fq + ii - qi;
                        acc[ii] = ((unsigned)(dk - dlo) <= (unsigned)(128 - dlo)) ? acc[ii] : -3.0e38f;
                    }
                }
                mx = fmaxf(mx, fmaxf(fmaxf(acc[0], acc[1]), fmaxf(acc[2], acc[3])));
                s[ntl] = acc;
            }
        }
        mx = fmaxf(mx, __shfl_xor(mx, 16)); mx = fmaxf(mx, __shfl_xor(mx, 32));
        mx = fmaxf(mx, sink);
        float sum = 0.f;
#pragma unroll
        for (int ntl = 0; ntl < 16; ++ntl) {
            if (ntl >= tlo && ntl <= tlo + 8) {
#pragma unroll
                for (int ii = 0; ii < 4; ++ii) { const float e = __expf(s[ntl][ii] - mx); s[ntl][ii] = e; sum += e; }
            }
        }
        sum += __shfl_xor(sum, 16); sum += __shfl_xor(sum, 32);
        const float inv = rcpf_(sum + __expf(sink - mx));
        const int klo = q0 >> 5, khi = (q0 + 143) >> 5;
#pragma unroll
        for (int ntl = 0; ntl < 16; ++ntl) {
            if (ntl >= tlo && ntl <= tlo + 8) {
                u32x2 w; w[0] = pk2(s[ntl][0] * inv, s[ntl][1] * inv); w[1] = pk2(s[ntl][2] * inv, s[ntl][3] * inv);
                *(LAS u32x2*)(Pw + ((fr * 264 + 16 * ntl + 4 * fq) << 1)) = w;
            } else if ((ntl >> 1) >= klo && (ntl >> 1) <= khi) {
                u32x2 w = {0u, 0u};
                *(LAS u32x2*)(Pw + ((fr * 264 + 16 * ntl + 4 * fq) << 1)) = w;
            }
        }
        u32x2 czv[4];
#pragma unroll
        for (int ntl = 0; ntl < 4; ++ntl) czv[ntl] = *(const u32x2*)(XU + ((unsigned)seq0 + qb * 128 + q0 + fr) * NIN + C_CZ + hq * 64 + 16 * ntl + 4 * fq);
        LDS_FENCE();
        f32x4 o[4];
#pragma unroll
        for (int ntl = 0; ntl < 4; ++ntl) o[ntl] = (f32x4){0.f, 0.f, 0.f, 0.f};
#pragma unroll
        for (int kk = 0; kk < 8; ++kk) {
            if (kk >= klo && kk <= khi) {
                const bf16x8 a = lds_frag(Pw, fr, kk * 32 + fq * 8, 264);
#pragma unroll
                for (int ntl = 0; ntl < 4; ++ntl) o[ntl] = mfma16(lds_frag(Vt, 16 * ntl + fr, kk * 32 + fq * 8, 264), a, o[ntl]);
            }
        }
        LDS_FENCE();
        {
            const unsigned row = (unsigned)seq0 + qb * 128 + q0 + fr;
#pragma unroll
            for (int ntl = 0; ntl < 4; ++ntl) {
                const float z0 = __uint_as_float(czv[ntl][0] << 16), z1 = __uint_as_float(czv[ntl][0] & 0xffff0000u), z2 = __uint_as_float(czv[ntl][1] << 16), z3 = __uint_as_float(czv[ntl][1] & 0xffff0000u);
                u32x2 w; w[0] = pk2(o[ntl][0] * siluf_(z0), o[ntl][1] * siluf_(z1)); w[1] = pk2(o[ntl][2] * siluf_(z2), o[ntl][3] * siluf_(z3));
                *(u32x2*)(XMIX + row * DMIX + 1024 + hq * 64 + 16 * ntl + 4 * fq) = w;
            }
        }
    }
    __syncthreads();
}

__device__ __forceinline__ void sample_task(lptr lds, const Ctx& X, int l, int b, int part, int tid) {
    LAS float* uf = (LAS float*)lds;
    LAS float* xbc = (LAS float*)(lds + 19968);
    LAS float* numv = (LAS float*)(lds + 24064);
    LAS float* yv = (LAS float*)(lds + 26112);
    LAS float* red = (LAS float*)(lds + 28160);
    LAS float* qs = (LAS float*)(lds + 28416);
    LAS float* kn = (LAS float*)(lds + 30464);
    LAS float* sc = (LAS float*)(lds + 30976);
    const int lane = tid & 63, wave = tid >> 6;
    const size_t row = (size_t)TP + b;
    const bf16_t* ur = XU + row * NIN;
    const size_t lb = (size_t)l * 128 + b;
    f32x4 kpre[8], vpre[8];
    if (part == 2) {
        const float* kc = X.ck + lb * 16384; const float* vc = X.cv + lb * 16384;
#pragma unroll
        for (int it = 0; it < 8; ++it) {
            const int e = (tid + it * NT) * 4, e2 = e < 127 * 128 ? e + 128 : e;
            kpre[it] = __builtin_nontemporal_load((const f32x4*)(kc + e2)); vpre[it] = __builtin_nontemporal_load((const f32x4*)(vc + e2));
        }
    }
    {
        const int c_lo = part == 0 ? 0 : (part == 1 ? C_BZ : C_CQ), c_hi = part == 0 ? C_BZ : (part == 1 ? C_CQ : DIN);
#pragma unroll 2
        for (int i = c_lo + tid; i < c_hi; i += NT) uf[i] = bf2f(ur[i]);
    }
    __syncthreads();
    if (part == 0) {
#pragma unroll
    for (int h = 0; h < 4; ++h) {
        const float ig = uf[C_AI + h] + XPAR(P_AIB)[l * 4 + h], fg = uf[C_AF + h] + XPAR(P_AFB)[l * 4 + h];
        const float ls = logsigf_(fg), m0 = X.stM[lb * 4 + h];
        const float mn = fmaxf(ls + m0, ig), sp = __expf(ls + m0 - mn), sl = __expf(ig - mn);
        const float* C0 = X.stC + (lb * 4 + h) * 8192; float* C1 = X.out + O_SC + (lb * 4 + h) * 8192;
#pragma unroll
        for (int it = 0; it < 4; ++it) {
            const int e = (tid + it * NT) * 4, v = e >> 6, k = e & 63;
            const f32x4 c0 = __builtin_nontemporal_load((const f32x4*)(C0 + e));
            const float vv = uf[C_AV + h * 128 + v] * sl;
            f32x4 c1; float part = 0.f;
#pragma unroll
            for (int j = 0; j < 4; ++j) { c1[j] = sp * c0[j] + vv * (uf[C_AK + h * 64 + k + j] * 0.125f); part += c1[j] * uf[C_AQ + h * 64 + k + j]; }
            __builtin_nontemporal_store(c1, (f32x4*)(C1 + e));
            part = red16(part);
            if ((lane & 15) == 0) numv[h * 128 + v] = part;
        }
        if (wave == 0) {
            const float n1 = sp * X.stN[(lb * 4 + h) * 64 + lane] + sl * uf[C_AK + h * 64 + lane] * 0.125f;
            X.out[O_SN + (lb * 4 + h) * 64 + lane] = n1;
            const float dd = wave_sum(n1 * uf[C_AQ + h * 64 + lane]);
            if (lane == 0) { red[h] = dd; red[4 + h] = mn; X.out[O_SM + lb * 4 + h] = mn; }
        }
    }
    __syncthreads();
    float hv;
    { const int h = tid >> 7; hv = numv[tid] * rcpf_(fmaxf(fabsf(red[h]), __expf(-red[4 + h]))); const float ss = wave_sum(hv * hv); if (lane == 0) red[8 + wave] = ss; }
    __syncthreads();
    { const int h = tid >> 7; const float rs = rsqrtf((red[8 + 2 * h] + red[9 + 2 * h]) * (1.f / 128.f) + EPS);
      XMIX[row * DMIX + tid] = (bf16_t)f2bf(hv * rs * XPAR(P_ANW)[l * 512 + tid] * sigmoidf_(uf[C_AO + tid]) * siluf_(uf[C_AZ + tid])); }
    }
    if (part == 1) {
    {
        const float* buf = X.conv + lb * 3 * 1024; float* oc = X.out + O_SCONV + lb * 3 * 1024;
        const float* cw = XPAR(P_CW) + l * 4096;
#pragma unroll
        for (int it = 0; it < 2; ++it) {
            const int ch = tid + it * NT;
            const float f0 = buf[ch], f1 = buf[1024 + ch], f2 = buf[2048 + ch], f3 = uf[C_BX + ch];
            const float acc = XPAR(P_CB)[l * 1024 + ch] + f0 * cw[ch] + f1 * cw[1024 + ch] + f2 * cw[2048 + ch] + f3 * cw[3072 + ch];
            xbc[ch] = siluf_(acc);
            oc[ch] = f1; oc[1024 + ch] = f2; oc[2048 + ch] = f3;
        }
    }
    __syncthreads();
#pragma unroll 4
    for (int hh = 0; hh < 8; ++hh) {
        const float dt = softplusf_(uf[C_BDT + hh] + XPAR(P_DTB)[l * 8 + hh]);
        const float dA = __expf(-dt * __expf(XPAR(P_ALOG)[l * 8 + hh]));
        const int g = hh >> 2;
        const float* h0p = X.ssm + (lb * 8 + hh) * 8192; float* h1p = X.out + O_SH + (lb * 8 + hh) * 8192;
#pragma unroll
        for (int it = 0; it < 4; ++it) {
            const int e = (tid + it * NT) * 4, p = e >> 7, s = e & 127;
            const f32x4 h0 = __builtin_nontemporal_load((const f32x4*)(h0p + e));
            const float xv = xbc[hh * 64 + p] * dt;
            f32x4 h1; float part = 0.f;
#pragma unroll
            for (int j = 0; j < 4; ++j) { h1[j] = dA * h0[j] + xv * xbc[512 + g * 128 + s + j]; part += h1[j] * xbc[768 + g * 128 + s + j]; }
            __builtin_nontemporal_store(h1, (f32x4*)(h1p + e));
            part = red16(part); part += __shfl_xor(part, 16);
            if ((lane & 31) == 0) yv[hh * 64 + p] = part;
        }
    }
    __syncthreads();
    float gb;
    { const int hh = tid >> 6; const float y = yv[tid] + XPAR(P_BD)[l * 8 + hh] * xbc[tid]; gb = y * siluf_(uf[C_BZ + tid]); const float ss = wave_sum(gb * gb); if (lane == 0) red[16 + wave] = ss; }
    __syncthreads();
    { const int g = tid >> 8; const float rs = rsqrtf((red[16 + 4 * g] + red[17 + 4 * g] + red[18 + 4 * g] + red[19 + 4 * g]) * (1.f / 256.f) + EPS);
      XMIX[row * DMIX + 512 + tid] = (bf16_t)f2bf(gb * rs * XPAR(P_BNW)[l * 512 + tid]); }
    }
    if (part == 2) {
    lptr Kl = lds + 36864;
    lptr Vl = lds + 36864 + 34816;
    if (tid < 320) {
        const int vec = tid >> 5, d = tid & 31, base = vec < 8 ? C_CQ + vec * 64 : C_CK + (vec - 8) * 64;
        const float x1 = uf[base + d], x2 = uf[base + 32 + d];
        float ss = x1 * x1 + x2 * x2; ss = red16(ss); ss += __shfl_xor(ss, 16);
        const float rs = rsqrtf(ss * (1.f / 64.f) + EPS);
        const float* w = vec < 8 ? XPAR(P_QNW) + l * 64 : XPAR(P_KNW) + l * 64;
        const float a = x1 * rs * w[d], bb = x2 * rs * w[d + 32];
        const float co = XROPE[((size_t)8192 * 32 + d) * 2], si = XROPE[((size_t)8192 * 32 + d) * 2 + 1];
        const float o1 = a * co - bb * si, o2 = bb * co + a * si;
        if (vec < 8) { qs[vec * 64 + d] = o1 * 0.125f; qs[vec * 64 + 32 + d] = o2 * 0.125f; } else { kn[(vec - 8) * 64 + d] = o1; kn[(vec - 8) * 64 + 32 + d] = o2; }
    }
    __syncthreads();
    {
        float* ko = X.out + O_SK + lb * 16384; float* vo = X.out + O_SV + lb * 16384;
#pragma unroll
        for (int it = 0; it < 8; ++it) {
            const int e = (tid + it * NT) * 4, j = e >> 7, r = e & 127;
            f32x4 kv = kpre[it], vv = vpre[it];
            if (j == 127) { kv = (f32x4){kn[r], kn[r + 1], kn[r + 2], kn[r + 3]}; vv = (f32x4){uf[C_CV + r], uf[C_CV + r + 1], uf[C_CV + r + 2], uf[C_CV + r + 3]}; }
            __builtin_nontemporal_store(kv, (f32x4*)(ko + e)); __builtin_nontemporal_store(vv, (f32x4*)(vo + e));
            u32x2 wk, wv2; wk[0] = pk2(kv[0], kv[1]); wk[1] = pk2(kv[2], kv[3]); wv2[0] = pk2(vv[0], vv[1]); wv2[1] = pk2(vv[2], vv[3]);
            *(LAS u32x2*)(Kl + ((j * 136 + r) << 1)) = wk; *(LAS u32x2*)(Vl + ((j * 136 + r) << 1)) = wv2;
        }
    }
    __syncthreads();
    if (tid < 256) {
        const int kvh = tid >> 7, jj = tid & 127;
        float s0 = 0.f, s1 = 0.f, s2 = 0.f, s3 = 0.f;
#pragma unroll 2
        for (int d8 = 0; d8 < 8; ++d8) {
            float kf[8]; unpack8(*(const LAS u32x4*)(Kl + ((jj * 136 + kvh * 64 + d8 * 8) << 1)), kf);
#pragma unroll
            for (int j = 0; j < 8; ++j) {
                s0 += kf[j] * qs[(kvh * 4 + 0) * 64 + d8 * 8 + j]; s1 += kf[j] * qs[(kvh * 4 + 1) * 64 + d8 * 8 + j];
                s2 += kf[j] * qs[(kvh * 4 + 2) * 64 + d8 * 8 + j]; s3 += kf[j] * qs[(kvh * 4 + 3) * 64 + d8 * 8 + j];
            }
        }
        sc[(kvh * 4 + 0) * 128 + jj] = s0; sc[(kvh * 4 + 1) * 128 + jj] = s1; sc[(kvh * 4 + 2) * 128 + jj] = s2; sc[(kvh * 4 + 3) * 128 + jj] = s3;
    }
    __syncthreads();
    {
        const int hq = wave; const float s0 = sc[hq * 128 + lane], s1 = sc[hq * 128 + 64 + lane], sink = XPAR(P_SINK)[l * 8 + hq];
        const float m = fmaxf(wave_max(fmaxf(s0, s1)), sink);
        const float e0 = __expf(s0 - m), e1 = __expf(s1 - m);
        const float inv = rcpf_(wave_sum(e0 + e1) + __expf(sink - m));
        sc[hq * 128 + lane] = e0 * inv; sc[hq * 128 + 64 + lane] = e1 * inv;
    }
    __syncthreads();
    {
        const int hq = tid >> 6, d = tid & 63, kvh = hq >> 2;
        float o = 0.f;
#pragma unroll 16
        for (int jj = 0; jj < 128; ++jj) o += sc[hq * 128 + jj] * bf2f(*(const LAS bf16_t*)(Vl + ((jj * 136 + kvh * 64 + d) << 1)));
        XMIX[row * DMIX + 1024 + tid] = (bf16_t)f2bf(o * siluf_(uf[C_CZ + tid]));
    }
    }
    __syncthreads();
}

__device__ __forceinline__ void scans(const Ctx& X, int l, int gt, int nthreads) {
    for (int item = gt; item < 98816; item += nthreads) {
        if (item < 32768) {
            const int nh = item >> 12, e = (item & 4095) * 2;
            const bf16_t* base = (const bf16_t*)XMC + (size_t)nh * 128 * 8192 + e;
            const float* ml = XML + nh * 128; const float* bl = XBL + nh * 128;
            float m = 0.f; f32x2 st = {0.f, 0.f};
            for (int c0 = 0; c0 < 128; c0 += 16) {
                f32x2 cl[16];
#pragma unroll
                for (int j = 0; j < 16; ++j) { const unsigned w = *(const unsigned*)(base + (size_t)(c0 + j) * 8192); cl[j] = (f32x2){__uint_as_float(w << 16), __uint_as_float(w & 0xffff0000u)}; }
#pragma unroll
                for (int j = 0; j < 16; ++j) {
                    const float mlj = ml[c0 + j], blj = bl[c0 + j], mn = fmaxf(blj + m, mlj), sp = __expf(blj + m - mn), sl = __expf(mlj - mn);
                    *(unsigned*)(XCSB + ((size_t)nh * 128 + c0 + j) * 8192 + e) = pk2(st[0], st[1]);
                    if (e == 0) XMS[nh * 128 + c0 + j] = m;
                    st = st * sp + cl[j] * sl; m = mn;
                }
            }
            *(f32x2*)(X.out + O_PC + ((size_t)l * 8 + nh) * 8192 + e) = st;
            if (e == 0) X.out[O_PM + l * 8 + nh] = m;
        } else if (item < 98304) {
            const int i1 = item - 32768, nhh = i1 >> 12, e = (i1 & 4095) * 2;
            const bf16_t* base = (const bf16_t*)XSH + (size_t)nhh * 128 * 8192 + e;
            const float* al = XSA + nhh * 128;
            f32x2 st = {0.f, 0.f};
            for (int c0 = 0; c0 < 128; c0 += 16) {
                f32x2 cl[16];
#pragma unroll
                for (int j = 0; j < 16; ++j) { const unsigned w = *(const unsigned*)(base + (size_t)(c0 + j) * 8192); cl[j] = (f32x2){__uint_as_float(w << 16), __uint_as_float(w & 0xffff0000u)}; }
#pragma unroll
                for (int j = 0; j < 16; ++j) {
                    const float dec = __expf(al[c0 + j]);
                    *(unsigned*)(XHSB + ((size_t)nhh * 128 + c0 + j) * 8192 + e) = pk2(st[0], st[1]);
                    st = st * dec + cl[j];
                }
            }
            *(f32x2*)(X.out + O_PH + ((size_t)l * 16 + nhh) * 8192 + e) = st;
        } else {
            const int i2 = item - 98304, nh = i2 >> 6, k = i2 & 63;
            float* base = XMN + (size_t)nh * 128 * 64 + k;
            const float* ml = XML + nh * 128; const float* bl = XBL + nh * 128;
            float m = 0.f, st = 0.f;
            for (int c = 0; c < 128; ++c) {
                const float mlj = ml[c], blj = bl[c], mn = fmaxf(blj + m, mlj), sp = __expf(blj + m - mn), sl = __expf(mlj - mn);
                const float cl = base[c * 64];
                XNS[(size_t)nh * 128 * 64 + c * 64 + k] = st;
                st = st * sp + cl * sl; m = mn;
            }
            X.out[O_PN + ((size_t)l * 8 + nh) * 64 + k] = st;
        }
    }
}

__device__ __forceinline__ void mlstm_out(lptr lds, const Ctx& X, int l, int task, int tid) {
    const int h = task & 3, c = (task >> 2) & 127, n = task >> 9;
    const int lane = tid & 63, wave = tid >> 6, fr = lane & 15, fq = lane >> 4;
    const int row0 = n * SEQ + c * 64, nh = n * 4 + h;
    lptr Qs = lds;
    lptr Ks = lds + 9216;
    lptr Vt = lds + 18432;
    lptr Sb = lds + 36864 + wave * 2304;
    LAS float* bv = (LAS float*)(lds + 55296);
    LAS float* dv = bv + 64;
    LAS float* mtv = bv + 128;
    LAS float* siv = bv + 192;
    LAS float* qnv = bv + 256;
    LAS float* ssqp = bv + 384;
    LAS float* nsv = bv + 512;
    const int mti = wave >> 1, half = wave & 1;
    u32x4 csf[2][4];
    {
        const bf16_t* Cs = XCSB + ((size_t)nh * 128 + c) * 8192;
#pragma unroll
        for (int kk = 0; kk < 2; ++kk)
#pragma unroll
            for (int ntl = 0; ntl < 4; ++ntl) csf[kk][ntl] = *(const u32x4*)(Cs + (64 * half + 16 * ntl + fr) * 64 + kk * 32 + fq * 8);
    }
    u32x2 aov[4], azv[4]; f32x4 anw[4];
#pragma unroll
    for (int ntl = 0; ntl < 4; ++ntl) {
        const int v = h * 128 + 64 * half + 16 * ntl + 4 * fq;
        const unsigned row = (unsigned)row0 + 16 * mti + fr;
        anw[ntl] = *(const f32x4*)(XPAR(P_ANW) + l * 512 + v);
        aov[ntl] = *(const u32x2*)(XU + row * NIN + C_AO + v); azv[ntl] = *(const u32x2*)(XU + row * NIN + C_AZ + v);
    }
    u32x4 qraw, kraw, vblk[8];
    const int tgv = lane & 7, cgv = (wave & 1) * 8 + (lane >> 3);
    {
        const int tok = tid >> 3, k8 = (tid & 7) * 8;
        const bf16_t* ur = XU + (unsigned)(row0 + tok) * NIN;
        qraw = *(const u32x4*)(ur + C_AQ + h * 64 + k8); kraw = *(const u32x4*)(ur + C_AK + h * 64 + k8);
        if (wave == 2 || wave == 3) {
#pragma unroll
            for (int t = 0; t < 8; ++t) vblk[t] = *(const u32x4*)(XU + (unsigned)(row0 + 8 * tgv + t) * NIN + C_AV + h * 128 + cgv * 8);
        }
    }
    if (wave == 0) {
        const bf16_t* ur = XU + (unsigned)(row0 + lane) * NIN;
        const float fg = bf2f(ur[C_AF + h]) + XPAR(P_AFB)[l * 4 + h], ig = bf2f(ur[C_AI + h]) + XPAR(P_AIB)[l * 4 + h];
        const float b = wave_scan_sum(logsigf_(fg), lane);
        const float dd = ig - b;
        const float cm = wave_scan_max(dd, lane);
        const float ms = XMS[nh * 128 + c];
        const float mt = b + fmaxf(ms, cm);
        bv[lane] = b; dv[lane] = dd; mtv[lane] = mt; siv[lane] = __expf(b + ms - mt);
        nsv[lane] = XNS[((size_t)nh * 128 + c) * 64 + lane];
    }
    {
        const int tok = tid >> 3, k8 = (tid & 7) * 8;
        *(LAS u32x4*)(Qs + ((tok * 72 + k8) << 1)) = qraw;
        float x[8]; unpack8(kraw, x);
#pragma unroll
        for (int j = 0; j < 8; ++j) x[j] *= 0.125f;
        *(LAS u32x4*)(Ks + ((tok * 72 + k8) << 1)) = pack8(x);
    }
    if (wave == 2 || wave == 3) {
#pragma unroll
        for (int j = 0; j < 8; ++j) {
            u32x4 w;
#pragma unroll
            for (int tp = 0; tp < 4; ++tp) {
                const unsigned lo = (vblk[2 * tp][j >> 1] >> ((j & 1) * 16)) & 0xffffu, hi = (vblk[2 * tp + 1][j >> 1] >> ((j & 1) * 16)) & 0xffffu;
                w[tp] = lo | (hi << 16);
            }
            *(LAS u32x4*)(Vt + (((cgv * 8 + j) * 72 + 8 * tgv) << 1)) = w;
        }
    }
    __syncthreads();
    bf16x8 qa[2];
    qa[0] = lds_frag(Qs, 16 * mti + fr, fq * 8, 72); qa[1] = lds_frag(Qs, 16 * mti + fr, 32 + fq * 8, 72);
    const int tq = 16 * mti + fr;
    float qn;
    {
        float x0[8], x1[8]; unpack8(__builtin_bit_cast(u32x4, qa[0]), x0); unpack8(__builtin_bit_cast(u32x4, qa[1]), x1);
        float d = 0.f;
#pragma unroll
        for (int j = 0; j < 8; ++j) d += x0[j] * nsv[fq * 8 + j] + x1[j] * nsv[32 + fq * 8 + j];
        d += __shfl_xor(d, 16); d += __shfl_xor(d, 32);
        qn = d;
    }
    const float bt = bv[tq], mtq = mtv[tq], siq = siv[tq];
    float rsum = 0.f;
#pragma unroll
    for (int ntl = 0; ntl < 4; ++ntl) {
        f32x4 sT = {0.f, 0.f, 0.f, 0.f};
        sT = mfma16(lds_frag(Ks, 16 * ntl + fr, fq * 8, 72), qa[0], sT);
        sT = mfma16(lds_frag(Ks, 16 * ntl + fr, 32 + fq * 8, 72), qa[1], sT);
        float sv[4];
#pragma unroll
        for (int ii = 0; ii < 4; ++ii) {
            const int sidx = 16 * ntl + 4 * fq + ii;
            const float wgt = (sidx <= tq) ? __expf(bt + dv[sidx] - mtq) : 0.f;
            sv[ii] = wgt * sT[ii];
            rsum += sv[ii];
        }
        u32x2 w; w[0] = pk2(sv[0], sv[1]); w[1] = pk2(sv[2], sv[3]);
        *(LAS u32x2*)(Sb + ((fr * 72 + 16 * ntl + 4 * fq) << 1)) = w;
    }
    rsum += __shfl_xor(rsum, 16); rsum += __shfl_xor(rsum, 32);
    const float inv = rcpf_(fmaxf(fabsf(rsum + siq * qn), __expf(-mtq)));
    LDS_FENCE();
    f32x4 acc[4];
#pragma unroll
    for (int ntl = 0; ntl < 4; ++ntl) acc[ntl] = (f32x4){0.f, 0.f, 0.f, 0.f};
#pragma unroll
    for (int kk = 0; kk < 2; ++kk) {
        const bf16x8 sb = lds_frag(Sb, fr, kk * 32 + fq * 8, 72);
#pragma unroll
        for (int ntl = 0; ntl < 4; ++ntl) acc[ntl] = mfma16(lds_frag(Vt, 64 * half + 16 * ntl + fr, kk * 32 + fq * 8, 72), sb, acc[ntl]);
    }
#pragma unroll
    for (int kk = 0; kk < 2; ++kk) {
        float x[8]; unpack8(__builtin_bit_cast(u32x4, qa[kk]), x);
#pragma unroll
        for (int j = 0; j < 8; ++j) x[j] *= siq;
        const bf16x8 qs = as_frag(pack8(x));
#pragma unroll
        for (int ntl = 0; ntl < 4; ++ntl) acc[ntl] = mfma16(as_frag(csf[kk][ntl]), qs, acc[ntl]);
    }
    {
        float ss = 0.f;
#pragma unroll
        for (int ntl = 0; ntl < 4; ++ntl) { acc[ntl] = acc[ntl] * inv; ss += acc[ntl][0] * acc[ntl][0] + acc[ntl][1] * acc[ntl][1] + acc[ntl][2] * acc[ntl][2] + acc[ntl][3] * acc[ntl][3]; }
        ss += __shfl_xor(ss, 16); ss += __shfl_xor(ss, 32);
        if (fq == 0) ssqp[tq * 2 + half] = ss;
    }
    __syncthreads();
    {
        const float rs = rsqrtf((ssqp[tq * 2] + ssqp[tq * 2 + 1]) * (1.f / 128.f) + EPS);
        const unsigned row = (unsigned)row0 + tq;
#pragma unroll
        for (int ntl = 0; ntl < 4; ++ntl) {
            const float o[4] = {__uint_as_float(aov[ntl][0] << 16), __uint_as_float(aov[ntl][0] & 0xffff0000u), __uint_as_float(aov[ntl][1] << 16), __uint_as_float(aov[ntl][1] & 0xffff0000u)};
            const float z[4] = {__uint_as_float(azv[ntl][0] << 16), __uint_as_float(azv[ntl][0] & 0xffff0000u), __uint_as_float(azv[ntl][1] << 16), __uint_as_float(azv[ntl][1] & 0xffff0000u)};
            float y[4];
#pragma unroll
            for (int ii = 0; ii < 4; ++ii) y[ii] = acc[ntl][ii] * rs * anw[ntl][ii] * sigmoidf_(o[ii]) * siluf_(z[ii]);
            u32x2 w; w[0] = pk2(y[0], y[1]); w[1] = pk2(y[2], y[3]);
            *(u32x2*)(XMIX + row * DMIX + h * 128 + 64 * half + 16 * ntl + 4 * fq) = w;
        }
    }
    __syncthreads();
}

__device__ __forceinline__ void ssd_out(lptr lds, const Ctx& X, int l, int task, int tid) {
    const int g = task & 1, c = (task >> 1) & 127, n = task >> 8;
    const int lane = tid & 63, wave = tid >> 6, fr = lane & 15, fq = lane >> 4;
    const int seq0 = n * SEQ, row0 = seq0 + c * 64;
    lptr Cm = lds;
    lptr Bm = lds + 17408;
    lptr Xt = lds + 34816;
    LAS float* CBf = (LAS float*)(lds + 71680);
    LAS float* av = (LAS float*)(lds + 89088);
    LAS float* dtv = (LAS float*)(lds + 90112);
    LAS float* ssq = (LAS float*)(lds + 91136);
    const int hl = wave >> 1, th = wave & 1, hh = 4 * g + hl;
    u32x4 hsf[4][4];
    {
        const bf16_t* hs = XHSB + ((size_t)(n * 8 + hh) * 128 + c) * 8192;
#pragma unroll
        for (int kk = 0; kk < 4; ++kk)
#pragma unroll
            for (int ntl = 0; ntl < 4; ++ntl) hsf[kk][ntl] = *(const u32x4*)(hs + (16 * ntl + fr) * 128 + kk * 32 + fq * 8);
    }
    if (wave < 4) {
        const int hh = 4 * g + wave;
        const float dt = softplusf_(bf2f(XU[(unsigned)(row0 + lane) * NIN + C_BDT + hh]) + XPAR(P_DTB)[l * 8 + hh]);
        const float A = -__expf(XPAR(P_ALOG)[l * 8 + hh]);
        av[wave * 64 + lane] = wave_scan_sum(dt * A, lane);
        dtv[wave * 64 + lane] = dt;
    }
    {
        const float* cw = XPAR(P_CW) + l * 4096; const float* cb = XPAR(P_CB) + l * 1024;
        float o[8][8];
        if (wave < 4) {
            const int tg = lane & 7, cg = wave * 8 + (lane >> 3);
            conv8x8(XU, seq0, c * 64 + 8 * tg, g * 256 + cg * 8, cw, cb, o);
#pragma unroll
            for (int jx = 0; jx < 8; ++jx) {
                float v[8];
#pragma unroll
                for (int t = 0; t < 8; ++t) v[t] = o[t][jx];
                *(LAS u32x4*)(Xt + (((cg * 8 + jx) * 72 + 8 * tg) << 1)) = pack8(v);
            }
        } else {
            const int tg = lane >> 3, s8 = ((wave & 1) * 8 + (lane & 7)) * 8;
            conv8x8(XU, seq0, c * 64 + 8 * tg, (wave < 6 ? 512 : 768) + g * 128 + s8, cw, cb, o);
            lptr dstm = wave < 6 ? Bm : Cm;
#pragma unroll
            for (int t = 0; t < 8; ++t) *(LAS u32x4*)(dstm + (((8 * tg + t) * 136 + s8) << 1)) = pack8(o[t]);
        }
    }
    __syncthreads();
    u32x2 bzv[2][4]; f32x4 bnw[4];
#pragma unroll
    for (int ntl = 0; ntl < 4; ++ntl) {
        bnw[ntl] = *(const f32x4*)(XPAR(P_BNW) + l * 512 + hh * 64 + 16 * ntl + 4 * fq);
#pragma unroll
        for (int mi = 0; mi < 2; ++mi) bzv[mi][ntl] = *(const u32x2*)(XU + ((unsigned)row0 + 16 * (2 * th + mi) + fr) * NIN + C_BZ + hh * 64 + 16 * ntl + 4 * fq);
    }
    {
        const int mt = wave >> 1;
#pragma unroll
        for (int q = 0; q < 2; ++q) {
            const int ntl = 2 * (wave & 1) + q;
            f32x4 acc = {0.f, 0.f, 0.f, 0.f};
#pragma unroll
            for (int kk = 0; kk < 4; ++kk) acc = mfma16(lds_frag(Cm, 16 * mt + fr, kk * 32 + fq * 8, 136), lds_frag(Bm, 16 * ntl + fr, kk * 32 + fq * 8, 136), acc);
#pragma unroll
            for (int ii = 0; ii < 4; ++ii) CBf[(16 * mt + fq * 4 + ii) * 68 + 16 * ntl + fr] = acc[ii];
        }
    }
    __syncthreads();
    f32x4 y1[2][4], y2[2][4];
#pragma unroll
    for (int mi = 0; mi < 2; ++mi)
#pragma unroll
        for (int ntl = 0; ntl < 4; ++ntl) { y1[mi][ntl] = (f32x4){0.f, 0.f, 0.f, 0.f}; y2[mi][ntl] = (f32x4){0.f, 0.f, 0.f, 0.f}; }
#pragma unroll
    for (int kk = 0; kk < 2; ++kk) {
        bf16x8 bx[4];
#pragma unroll
        for (int ntl = 0; ntl < 4; ++ntl) bx[ntl] = lds_frag(Xt, hl * 64 + 16 * ntl + fr, kk * 32 + fq * 8, 72);
#pragma unroll
        for (int mi = 0; mi < 2; ++mi) {
            const int t = 16 * (2 * th + mi) + fr, u0 = kk * 32 + fq * 8;
            const float at = av[hl * 64 + t];
            float w[8];
#pragma unroll
            for (int j = 0; j < 8; ++j) {
                const int uu = u0 + j;
                w[j] = (uu <= t) ? CBf[t * 68 + uu] * __expf(at - av[hl * 64 + uu]) * dtv[hl * 64 + uu] : 0.f;
            }
            const bf16x8 a = as_frag(pack8(w));
#pragma unroll
            for (int ntl = 0; ntl < 4; ++ntl) y1[mi][ntl] = mfma16(bx[ntl], a, y1[mi][ntl]);
        }
    }
    {
#pragma unroll
        for (int kk = 0; kk < 4; ++kk) {
            bf16x8 bh[4];
#pragma unroll
            for (int ntl = 0; ntl < 4; ++ntl) bh[ntl] = as_frag(hsf[kk][ntl]);
#pragma unroll
            for (int mi = 0; mi < 2; ++mi) {
                const bf16x8 a = lds_frag(Cm, 16 * (2 * th + mi) + fr, kk * 32 + fq * 8, 136);
#pragma unroll
                for (int ntl = 0; ntl < 4; ++ntl) y2[mi][ntl] = mfma16(bh[ntl], a, y2[mi][ntl]);
            }
        }
    }
    const float Dh = XPAR(P_BD)[l * 8 + hh];
#pragma unroll
    for (int mi = 0; mi < 2; ++mi) {
        const int t = 16 * (2 * th + mi) + fr;
        const float ea = __expf(av[hl * 64 + t]);
        float ss = 0.f;
#pragma unroll
        for (int ntl = 0; ntl < 4; ++ntl) {
            const float z[4] = {__uint_as_float(bzv[mi][ntl][0] << 16), __uint_as_float(bzv[mi][ntl][0] & 0xffff0000u), __uint_as_float(bzv[mi][ntl][1] << 16), __uint_as_float(bzv[mi][ntl][1] & 0xffff0000u)};
#pragma unroll
            for (int ii = 0; ii < 4; ++ii) {
                const int p = 16 * ntl + 4 * fq + ii;
                const float xv = bf2f(*(const LAS bf16_t*)(Xt + (((hl * 64 + p) * 72 + t) << 1)));
                const float y = y1[mi][ntl][ii] + ea * y2[mi][ntl][ii] + Dh * xv;
                const float gbv = y * siluf_(z[ii]);
                y1[mi][ntl][ii] = gbv; ss += gbv * gbv;
            }
        }
        ss += __shfl_xor(ss, 16); ss += __shfl_xor(ss, 32);
        if (fq == 0) ssq[t * 4 + hl] = ss;
    }
    __syncthreads();
#pragma unroll
    for (int mi = 0; mi < 2; ++mi) {
        const int t = 16 * (2 * th + mi) + fr;
        const float rs = rsqrtf((ssq[t * 4] + ssq[t * 4 + 1] + ssq[t * 4 + 2] + ssq[t * 4 + 3]) * (1.f / 256.f) + EPS);
        const unsigned row = (unsigned)row0 + t;
#pragma unroll
        for (int ntl = 0; ntl < 4; ++ntl) {
            u32x2 w; w[0] = pk2(y1[mi][ntl][0] * rs * bnw[ntl][0], y1[mi][ntl][1] * rs * bnw[ntl][1]); w[1] = pk2(y1[mi][ntl][2] * rs * bnw[ntl][2], y1[mi][ntl][3] * rs * bnw[ntl][3]);
            *(u32x2*)(XMIX + row * DMIX + 512 + hh * 64 + 16 * ntl + 4 * fq) = w;
        }
    }
    __syncthreads();
}


#define XB_TMO      128
#define XB_XCNT(j)  (256  + 64 * (j))
#define XB_XSUB(j)  (1280 + 64 * (j))
#define XB_XGEN(j)  (2304 + 64 * (j))
#define XB_TOP      3328
#define XB_TOPGEN   3392
#define XCD_BAR_WORDS 3456
#define XB_SPIN_CAP (1u << 18)
__device__ __forceinline__ unsigned xb_ld(unsigned* p)              { return __hip_atomic_load(p, __ATOMIC_RELAXED, __HIP_MEMORY_SCOPE_AGENT); }
__device__ __forceinline__ unsigned xb_add(unsigned* p, unsigned v) { return __hip_atomic_fetch_add(p, v, __ATOMIC_RELAXED, __HIP_MEMORY_SCOPE_AGENT); }
__device__ __forceinline__ unsigned xb_xcc_id() { return (unsigned)__builtin_amdgcn_s_getreg((3 << 11) | 20) & 0xFu; }
#define XB_SPIN(cond, bar) do { unsigned _sp = 0; while (cond) { __builtin_amdgcn_s_sleep(1); \
    if ((++_sp & 255u) == 0u) { if (xb_ld(&(bar)[XB_TMO])) break; if (_sp > XB_SPIN_CAP) { atomicAdd(&(bar)[XB_TMO], 1u); break; } } } } while (0)
struct XcdBarrier { unsigned* bar; unsigned x; volatile LAS unsigned* st; };
__device__ __forceinline__ XcdBarrier xcd_barrier_post(unsigned* bar, volatile LAS unsigned* st) {
    XcdBarrier b; b.bar = bar; b.x = xb_xcc_id(); b.st = st;
    if (threadIdx.x == 0) (void)xb_add(&bar[XB_XCNT(b.x)], 1u);
    return b;
}
__device__ __forceinline__ void xcd_barrier_complete(unsigned* bar, unsigned x, unsigned& nloc, unsigned& nx) {
    const unsigned G = gridDim.x * gridDim.y * gridDim.z;
    unsigned sum, cnt, mine, sp = 0u;
    for (;;) {
        sum = 0u; cnt = 0u; mine = 0u;
#pragma unroll
        for (unsigned j = 0; j < 16; ++j) { const unsigned c = xb_ld(&bar[XB_XCNT(j)]); sum += c; cnt += (c > 0u) ? 1u : 0u; mine = (j == x) ? c : mine; }
        if (sum == G) break;
        __builtin_amdgcn_s_sleep(1);
        if ((++sp & 255u) == 0u) { if (xb_ld(&bar[XB_TMO])) break; if (sp > XB_SPIN_CAP) { atomicAdd(&bar[XB_TMO], 1u); break; } }
    }
    nloc = mine > 0u ? mine : 1u; nx = cnt > 0u ? cnt : 1u;
}
__device__ __forceinline__ void xcd_barrier(const XcdBarrier& b) {
    asm volatile("s_waitcnt vmcnt(0)" ::: "memory");
    __syncthreads();
    if (threadIdx.x == 0) {
        unsigned* bar = b.bar;
        __builtin_amdgcn_s_waitcnt(0);
        unsigned nloc = b.st[0], nx = b.st[1];
        if (nloc == 0u) { xcd_barrier_complete(bar, b.x, nloc, nx); b.st[0] = nloc; b.st[1] = nx; }
        const unsigned old = xb_add(&bar[XB_XSUB(b.x)], 1u);
        const unsigned gen = old / nloc;
        if (old + 1u == (gen + 1u) * nloc) {
            __builtin_amdgcn_fence(__ATOMIC_RELEASE, "agent");
            asm volatile("s_waitcnt vmcnt(0)" ::: "memory");
            const unsigned og = xb_add(&bar[XB_TOP], 1u);
            const unsigned tg = og / nx;
            if (og + 1u == (tg + 1u) * nx) xb_add(&bar[XB_TOPGEN], 1u);
            else XB_SPIN(xb_ld(&bar[XB_TOPGEN]) == tg, bar);
            __builtin_amdgcn_fence(__ATOMIC_ACQUIRE, "agent");
            xb_add(&bar[XB_XGEN(b.x)], 1u);
            asm volatile("s_waitcnt vmcnt(0)" ::: "memory");
        } else {
            XB_SPIN(xb_ld(&bar[XB_XGEN(b.x)]) == gen, bar);
            __builtin_amdgcn_fence(__ATOMIC_ACQUIRE, "agent");
            asm volatile("s_waitcnt vmcnt(0)" ::: "memory");
        }
    }
    __syncthreads();
}

__global__ void __launch_bounds__(NT, 2) mega(Args args) {
    __shared__ __attribute__((aligned(16))) unsigned char lds_raw[LDS_BYTES];
    lptr lds = (lptr)lds_raw;
    cg::grid_group grid = cg::this_grid();
    const int tid = threadIdx.x, bid = blockIdx.x, G = gridDim.x;
    Ctx X;
    X.xp = args.in[IN_XP]; X.xs = args.in[IN_XS]; X.stC = args.in[IN_STC]; X.stN = args.in[IN_STN]; X.stM = args.in[IN_STM]; X.ssm = args.in[IN_SSM];
    X.conv = args.in[IN_CONV]; X.ck = args.in[IN_CK]; X.cv = args.in[IN_CV]; X.out = args.out; X.ws = args.ws;
    const int lo = args.ph_lo, hi = args.ph_hi;
    volatile LAS unsigned* xst = (volatile LAS unsigned*)(lds + LDS_BYTES - 16);
    if (tid == 0) { xst[0] = 0u; xst[1] = 0u; }
    __syncthreads();
    XcdBarrier xbar = xcd_barrier_post((unsigned*)(args.ws + WS_BAR), xst);
#define IN(k) (lo <= (k) && (k) < hi)
#define SEAM(k) do { if (IN(k) && IN((k) + 1)) { for (int _r = 0; _r < REP_SYNC; ++_r) { if (lo < 0) grid.sync(); xcd_barrier(xbar); } } } while (0)
    if (IN(0)) { for (int _r = 0; _r < REP_P0; ++_r) prologue(lds, X, args, G, bid, tid); }
    SEAM(0);
    for (int l = 0; l < 4; ++l) {
        const int pb = 1 + l * 5;
        if (IN(pb)) for (int _r = 0; _r < REP_P1; ++_r) {
            pg8::Gemm g{XXB, XWIN + (size_t)l * NIN * D, MPAD, NIN, D}; pg8::StaticOrder S; S.init(TP, NIN, G, bid);
            pg8::EpiU E{XU, XSSQ};
            pg8::gemm_phase<pg8::EpiU, pg8::StaticOrder, false, GEMM_SP2, GEMM_ALIGN>(lds, g, S, E, OPQ(tid));
            if (l == 0 && bid >= G - 20) {
                pg8::SampleOrder S2{G - 20, 20, bid}; pg8::EpiUh E2{XU, XSSQ};
                pg8::gemm_phase<pg8::EpiUh, pg8::SampleOrder, true>(lds, g, S2, E2, OPQ(tid));
            }
        }
        SEAM(pb);
        if (IN(pb + 1)) for (int _r = 0; _r < REP_P2; ++_r) {
            for (int t = bid; t < 256; t += G) for (int _q = 0; _q < RT_SAMPLE; ++_q) {
                if (t < 128) sample_task(lds, X, l, t, 1, OPQ(tid));
                else { sample_task(lds, X, l, t - 128, 0, OPQ(tid)); sample_task(lds, X, l, t - 128, 2, OPQ(tid)); }
            }
            for (int t = bid; t < 256; t += G) {
                const int tx = (G == 256) ? ((t & 7) >> 2) * 128 + (32 * (t & 1) + (t >> 3)) * 2 + ((t >> 1) & 1) : t;
                for (int _q = 0; _q < RT_SWA; ++_q) swa_prompt(lds, X, l, tx, OPQ(tid));
            }
            for (int t = bid; t < 512; t += G) for (int _q = 0; _q < RT_SLOC; ++_q) ssd_local(lds, X, l, t, OPQ(tid));
            for (int t = bid; t < 1024; t += G) for (int _q = 0; _q < RT_MLOC; ++_q) mlstm_local(lds, X, l, t, OPQ(tid));
            if (bid == G - 1) {
                for (int i = tid; i < 2 * 3 * 1024; i += NT) {
                    const int ch = i & 1023, j = (i >> 10) % 3, n = i / 3072;
                    X.out[O_PCONV + (((size_t)l * 2 + n) * 3 + j) * 1024 + ch] = bf2f(XU[(size_t)(n * SEQ + SEQ - 3 + j) * NIN + C_BX + ch]);
                }
            }
        }
        SEAM(pb + 1);
        if (IN(pb + 2)) {
            if (bid >= G - 4) {
                pg8::Gemm g{XMIX, XWOUT + (size_t)l * D * DMIX, MPAD, D, DMIX}; pg8::SampleOrder S{G - 4, 4, bid};
                if (l == 0) { pg8::EpiRes_<1, 0> E{X.xp, X.xs, X.out, XXB, XSSQ}; pg8::gemm_phase<pg8::EpiRes_<1, 0>, pg8::SampleOrder, true>(lds, g, S, E, OPQ(tid)); }
                else if (l < 3) { pg8::EpiRes_<1, 1> E{X.xp, X.xs, X.out, XXB, XSSQ}; pg8::gemm_phase<pg8::EpiRes_<1, 1>, pg8::SampleOrder, true>(lds, g, S, E, OPQ(tid)); }
                else { pg8::EpiRes_<1, 2> E{X.xp, X.xs, X.out, XXB, XSSQ}; pg8::gemm_phase<pg8::EpiRes_<1, 2>, pg8::SampleOrder, true>(lds, g, S, E, OPQ(tid)); }
            }
            for (int _r = 0; _r < REP_P3; ++_r) scans(X, l, bid * NT + OPQ(tid), G * NT);
        }
        SEAM(pb + 2);
        if (IN(pb + 3)) for (int _r = 0; _r < REP_P4; ++_r) {
            for (int task = bid; task < 1536; task += G) {
                if (task < 512) for (int _q = 0; _q < RT_SOUT; ++_q) ssd_out(lds, X, l, task, OPQ(tid));
                else mlstm_out(lds, X, l, task - 512, OPQ(tid));
            }
        }
        SEAM(pb + 3);
        if (IN(pb + 4)) {
            {
                pg8::Gemm g{XMIX, XWOUT + (size_t)l * D * DMIX, MPAD, D, DMIX}; pg8::StaticOrder S; S.init(TP, D, G, bid);
#ifdef PROBE_P5
                { pg8::EpiProbe EP{(const unsigned*)(X.ws + 64), XSSQ}; pg8::gemm_phase<pg8::EpiProbe, pg8::StaticOrder, false, GEMM_SP2>(lds, g, S, EP, OPQ(tid)); }
#endif
                if (l == 0) { pg8::EpiRes_<2, 0> E{X.xp, X.xs, X.out, XXB, XSSQ}; pg8::gemm_phase<pg8::EpiRes_<2, 0>, pg8::StaticOrder, false, GEMM_SP2, GEMM_ALIGN>(lds, g, S, E, OPQ(tid)); }
                else if (l < 3) { pg8::EpiRes_<2, 1> E{X.xp, X.xs, X.out, XXB, XSSQ}; pg8::gemm_phase<pg8::EpiRes_<2, 1>, pg8::StaticOrder, false, GEMM_SP2, GEMM_ALIGN>(lds, g, S, E, OPQ(tid)); }
                else { pg8::EpiRes_<2, 2> E{X.xp, X.xs, X.out, XXB, XSSQ}; pg8::gemm_phase<pg8::EpiRes_<2, 2>, pg8::StaticOrder, false, GEMM_SP2, GEMM_ALIGN>(lds, g, S, E, OPQ(tid)); }
            }
            if (l < 3 && bid < 20) {
                pg8::Gemm g{XXB, XWIN + (size_t)(l + 1) * NIN * D, MPAD, NIN, D}; pg8::SampleOrder S{0, 20, bid};
                pg8::EpiUh E{XU, XSSQ};
                pg8::gemm_phase<pg8::EpiUh, pg8::SampleOrder, true>(lds, g, S, E, OPQ(tid));
            }
        }
        SEAM(pb + 4);
    }
#undef IN
#undef SEAM
}

extern "C" void kernel_launch(void* const* d_in, const int* in_sizes, int n_in, void* d_out, int out_size, void* d_ws, size_t ws_size, hipStream_t stream) {
    static int grid_blocks = 0;
    if (!grid_blocks) {
        int dev = 0, cus = 0, per_cu = 0;
        hipGetDevice(&dev);
        hipDeviceGetAttribute(&cus, hipDeviceAttributeMultiprocessorCount, dev);
        hipOccupancyMaxActiveBlocksPerMultiprocessor(&per_cu, mega, NT, 0);
        if (per_cu < 1) { fprintf(stderr, "occupancy query returned %d\n", per_cu); per_cu = 1; }
        grid_blocks = cus * 1;
        if (ws_size < WS_END) fprintf(stderr, "workspace too small: %zu < %zu\n", ws_size, (size_t)WS_END);
    }
    (void)hipMemsetAsync(d_ws, 0, 16384, stream);
    Args a{};
    for (int i = 0; i < 24; ++i) a.in[i] = (const float*)d_in[i];
    a.out = (float*)d_out; a.ws = (unsigned char*)d_ws;
    const int NPH = 21;
#if MULTI_LAUNCH
    for (int p = 0; p < NPH; ++p) {
        a.ph_lo = p; a.ph_hi = p + 1;
        void* kargs[] = {&a};
        hipError_t e = hipLaunchCooperativeKernel((void*)mega, dim3(grid_blocks), dim3(NT), kargs, 0, stream);
        if (e != hipSuccess) fprintf(stderr, "cooperative launch failed: %s (grid %d)\n", hipGetErrorString(e), grid_blocks);
    }
#else
    a.ph_lo = 0; a.ph_hi = NPH;
    void* kargs[] = {&a};
    hipError_t e = hipLaunchCooperativeKernel((void*)mega, dim3(grid_blocks), dim3(NT), kargs, 0, stream);
    if (e != hipSuccess) fprintf(stderr, "cooperative launch failed: %s (grid %d)\n", hipGetErrorString(e), grid_blocks);
#endif
}
```

```cpp
#include <hip/hip_runtime.h>
#include <hip/hip_cooperative_groups.h>
#include <cstdio>
#include <cstdint>
namespace cg = cooperative_groups;

#ifndef REP_SYNC
#define REP_SYNC 1
#endif
#ifndef REP_P1
#define REP_P1 1
#endif
#ifndef REP_P2
#define REP_P2 1
#endif
#ifndef REP_P3
#define REP_P3 1
#endif
#ifndef REP_P0
#define REP_P0 1
#endif
#ifndef REP_P4
#define REP_P4 1
#endif
#ifndef RT_SAMPLE
#define RT_SAMPLE 1
#endif
#ifndef RT_SWA
#define RT_SWA 1
#endif
#ifndef RT_SLOC
#define RT_SLOC 1
#endif
#ifndef RT_MLOC
#define RT_MLOC 1
#endif
#ifndef RT_SOUT
#define RT_SOUT 1
#endif
#ifndef GEMM_SP2
#define GEMM_SP2 true
#endif
#ifndef GEMM_ALIGN
#define GEMM_ALIGN true
#endif
#ifndef MULTI_LAUNCH
#define MULTI_LAUNCH 0
#endif

#define LAS __attribute__((address_space(3)))
typedef unsigned short bf16_t;
typedef short bf16x8 __attribute__((ext_vector_type(8)));
typedef float f32x4 __attribute__((ext_vector_type(4)));
typedef float f32x2 __attribute__((ext_vector_type(2)));
typedef unsigned u32x4 __attribute__((ext_vector_type(4)));
typedef unsigned u32x2 __attribute__((ext_vector_type(2)));
typedef __bf16 bf16x2_t __attribute__((ext_vector_type(2)));
typedef LAS unsigned char* lptr;

constexpr int D = 1024, DIN = 4880, NIN = 5120, DMIX = 1536, TP = 16384, MTOK = 16512, MPAD = 16640, SEQ = 8192;
constexpr int C_AQ = 0, C_AK = 256, C_AV = 512, C_AO = 1024, C_AZ = 1536, C_AI = 2048, C_AF = 2052, C_BZ = 2056, C_BX = 2568, C_BB = 3080, C_BC = 3336,
              C_BDT = 3592, C_CQ = 3600, C_CK = 4112, C_CV = 4240, C_CZ = 4368;
constexpr float EPS = 1e-6f;
constexpr size_t O_YP = 0, O_YS = 16777216, O_PC = 16908288, O_PN = 17170432, O_PM = 17172480, O_PH = 17172512, O_PCONV = 17696800, O_PK = 17721376,
                 O_PV = 17852448, O_SC = 17983520, O_SN = 34760736, O_SM = 34891808, O_SH = 34893856, O_SCONV = 68448288, O_SK = 70021152, O_SV = 78409760;
constexpr size_t WS_BAR = 0;
constexpr size_t WS_PAR = 16384;
constexpr size_t WS_WIN = WS_PAR + 102400;
constexpr size_t WS_WOUT = WS_WIN + (size_t)4 * NIN * D * 2;
constexpr size_t WS_XB = WS_WOUT + (size_t)4 * D * DMIX * 2;
constexpr size_t WS_U = WS_XB + (size_t)MPAD * D * 2;
constexpr size_t WS_MIX = WS_U + (size_t)MPAD * NIN * 2;
constexpr size_t WS_SSQ = WS_MIX + (size_t)MPAD * DMIX * 2;
constexpr size_t WS_ROPE = WS_SSQ + (size_t)MPAD * 16 * 4;
constexpr size_t WS_MC = WS_ROPE + (size_t)8200 * 64 * 4;
constexpr size_t WS_MN = WS_MC + (size_t)8 * 128 * 8192 * 4;
constexpr size_t WS_ML = WS_MN + (size_t)8 * 128 * 64 * 4;
constexpr size_t WS_BL = WS_ML + 4096;
constexpr size_t WS_MS = WS_BL + 4096;
constexpr size_t WS_SA = WS_MS + 4096;
constexpr size_t WS_SH = WS_SA + 8192;
constexpr size_t WS_CSB = WS_SH + (size_t)16 * 128 * 8192 * 4;
constexpr size_t WS_HSB = WS_CSB + (size_t)8 * 128 * 8192 * 2;
constexpr size_t WS_NS = WS_HSB + (size_t)16 * 128 * 8192 * 2;
constexpr size_t WS_END = WS_NS + (size_t)8 * 128 * 64 * 4;
constexpr int LDS_BYTES = 139264;
constexpr int NT = 512;

struct Args { const float* in[24]; float* out; unsigned char* ws; int ph_lo, ph_hi; };

__device__ __forceinline__ float bf2f(unsigned v) { return __uint_as_float(v << 16); }
__device__ __forceinline__ unsigned pk2(float lo, float hi) { f32x2 v = {lo, hi}; bf16x2_t b = __builtin_convertvector(v, bf16x2_t); return __builtin_bit_cast(unsigned, b); }
__device__ __forceinline__ unsigned f2bf(float f) { return pk2(f, 0.f) & 0xffffu; }
__device__ __forceinline__ void unpack8(u32x4 w, float (&f)[8]) {
#pragma unroll
    for (int i = 0; i < 4; ++i) { f[2 * i] = __uint_as_float(w[i] << 16); f[2 * i + 1] = __uint_as_float(w[i] & 0xffff0000u); }
}
__device__ __forceinline__ u32x4 pack8(const float (&f)[8]) { u32x4 w; w[0] = pk2(f[0], f[1]); w[1] = pk2(f[2], f[3]); w[2] = pk2(f[4], f[5]); w[3] = pk2(f[6], f[7]); return w; }
__device__ __forceinline__ u32x4 pack8v(f32x4 a, f32x4 b) { u32x4 w; w[0] = pk2(a[0], a[1]); w[1] = pk2(a[2], a[3]); w[2] = pk2(b[0], b[1]); w[3] = pk2(b[2], b[3]); return w; }
__device__ __forceinline__ bf16x8 as_frag(u32x4 w) { return __builtin_bit_cast(bf16x8, w); }
__device__ __forceinline__ bf16x8 ldg_f32_frag(const float* p) { f32x4 a = *(const f32x4*)p, b = *(const f32x4*)(p + 4); return as_frag(pack8v(a, b)); }
__device__ __forceinline__ bf16x8 lds_frag(lptr base, int row, int k, int stride) { return *(const LAS bf16x8*)(base + ((row * stride + k) << 1)); }
__device__ __forceinline__ f32x4 mfma16(bf16x8 a, bf16x8 b, f32x4 c) { return __builtin_amdgcn_mfma_f32_16x16x32_bf16(a, b, c, 0, 0, 0); }
__device__ __forceinline__ float rcpf_(float x) { return __builtin_amdgcn_rcpf(x); }
__device__ __forceinline__ float sigmoidf_(float x) { return rcpf_(1.f + __expf(-x)); }
__device__ __forceinline__ float siluf_(float x) { return x * rcpf_(1.f + __expf(-x)); }
__device__ __forceinline__ float softplusf_(float x) { return x > 20.f ? x : __logf(1.f + __expf(x)); }
__device__ __forceinline__ float logsigf_(float x) { return fminf(x, 0.f) - __logf(1.f + __expf(-fabsf(x))); }
template <int CTRL, int RM> __device__ __forceinline__ float dpps(float ident, float v) { return __int_as_float(__builtin_amdgcn_update_dpp(__float_as_int(ident), __float_as_int(v), CTRL, RM, 0xf, false)); }
__device__ __forceinline__ float wave_scan_sum(float v, int) {
    v += dpps<0x111, 0xf>(0.f, v); v += dpps<0x112, 0xf>(0.f, v); v += dpps<0x114, 0xf>(0.f, v); v += dpps<0x118, 0xf>(0.f, v);
    v += dpps<0x142, 0xa>(0.f, v); v += dpps<0x143, 0xc>(0.f, v);
    return v;
}
__device__ __forceinline__ float wave_scan_max(float v, int) {
    const float NI = -3.0e38f;
    v = fmaxf(v, dpps<0x111, 0xf>(NI, v)); v = fmaxf(v, dpps<0x112, 0xf>(NI, v)); v = fmaxf(v, dpps<0x114, 0xf>(NI, v)); v = fmaxf(v, dpps<0x118, 0xf>(NI, v));
    v = fmaxf(v, dpps<0x142, 0xa>(NI, v)); v = fmaxf(v, dpps<0x143, 0xc>(NI, v));
    return v;
}
__device__ __forceinline__ float lane63(float v) { return __int_as_float(__builtin_amdgcn_readlane(__float_as_int(v), 63)); }
__device__ __forceinline__ float red16(float v);
__device__ __forceinline__ float red16max(float v);
__device__ __forceinline__ float wave_sum(float v) { v = red16(v); v += __shfl_xor(v, 16); v += __shfl_xor(v, 32); return v; }
__device__ __forceinline__ float wave_max(float v) { v = red16max(v); v = fmaxf(v, __shfl_xor(v, 16)); v = fmaxf(v, __shfl_xor(v, 32)); return v; }
template <int CTRL> __device__ __forceinline__ float dppf(float v) { return __int_as_float(__builtin_amdgcn_update_dpp(0, __float_as_int(v), CTRL, 0xf, 0xf, true)); }
__device__ __forceinline__ float red16(float v) { v += dppf<0xB1>(v); v += dppf<0x4E>(v); v += dppf<0x141>(v); v += dppf<0x140>(v); return v; }
__device__ __forceinline__ float red16max(float v) { v = fmaxf(v, dppf<0xB1>(v)); v = fmaxf(v, dppf<0x4E>(v)); v = fmaxf(v, dppf<0x141>(v)); v = fmaxf(v, dppf<0x140>(v)); return v; }
__device__ __forceinline__ int OPQ(int v) { asm volatile("" : "+v"(v)); return v; }
#define LDS_FENCE() asm volatile("s_waitcnt lgkmcnt(0)" ::: "memory")

namespace pg8 {
constexpr int BM = 256, BK = 64, HALF = 128, HTB = HALF * BK * 2, STAGE_BYTES = 8 * HTB, NXCD = 8, WGM = 8;
__host__ __device__ __forceinline__ int lds_byte(int r, int c) { const int st = (r >> 4) * 2 + (c >> 5), rr = r & 15, cc = c & 31, ob = rr * 64 + cc * 2; return st * 1024 + (ob ^ (((ob >> 9) & 1) << 5)); }
__host__ __device__ __forceinline__ void stage_rc(int b, int& R, int& C) { const int st = b / 1024, sb = b % 1024, swz = sb ^ (((sb >> 9) & 1) << 5); R = (st >> 1) * 16 + swz / 64; C = (st & 1) * 32 + (swz % 64) / 2; }
__host__ __device__ __forceinline__ int perm32(int rho) { const int n = rho >> 4, i = rho & 15; return 8 * (i >> 2) + 4 * n + (i & 3); }
struct Unit { int pm, pn; };
struct Gemm { const bf16_t* A; const bf16_t* Bt; int M, N, K; };
struct StaticOrder {
    int nM, nN, nwg, G, c;
    __device__ void init(int M, int N, int G_, int c_) { nM = M / BM; nN = N / BM; nwg = nM * nN; G = G_; c = c_; }
    __device__ bool next(int i, Unit& u) const {
        const long L = (long)i * G + c; if (L >= nwg) return false;
        int wgid = (int)L; { const int q = nwg / NXCD, r = nwg % NXCD, xcd = wgid % NXCD, off = wgid / NXCD; wgid = (xcd < r ? xcd * (q + 1) : r * (q + 1) + (xcd - r) * q) + off; }
        const int nig = WGM * nN, gid = wgid / nig, fm = gid * WGM, gsz = (nM - fm) < WGM ? (nM - fm) : WGM;
        u.pm = fm + ((wgid % nig) % gsz); u.pn = (wgid % nig) / gsz; return true;
    }
};
template <int NAI> struct EpiU_ {
    bf16_t* U; const float* ssq;
    __device__ __forceinline__ void operator()(const f32x4 (&acc)[2][2][4][2], const Unit& u, int wr, int wc, int fr, int fq) const {
        const int row0 = u.pm * BM + wr * 64 + fr, col0 = u.pn * BM + wc * 32 + 8 * fq;
#pragma unroll
        for (int ai = 0; ai < NAI; ++ai)
#pragma unroll
            for (int m = 0; m < 4; ++m) {
                const int r = row0 + ai * HALF + m * 16;
                const f32x4 s = *(const f32x4*)(ssq + (size_t)r * 16 + fq * 4);
                float st = s[0] + s[1] + s[2] + s[3]; st += __shfl_xor(st, 16); st += __shfl_xor(st, 32);
                const float rs = rsqrtf(st * (1.f / 1024.f) + EPS);
                bf16_t* rowp = U + (size_t)r * NIN + col0;
#pragma unroll
                for (int bj = 0; bj < 2; ++bj) *(u32x4*)(rowp + bj * HALF) = pack8v(acc[ai][bj][m][0] * rs, acc[ai][bj][m][1] * rs);
                __builtin_amdgcn_sched_barrier(0);
            }
    }
};
template <int NAI, int MODE> struct EpiRes_ {
    const float* xp; const float* xs; float* out; bf16_t* xb; float* ssq;
    __device__ __forceinline__ void operator()(const f32x4 (&acc)[2][2][4][2], const Unit& u, int wr, int wc, int fr, int fq) const {
        const int row0 = u.pm * BM + wr * 64 + fr, col0 = u.pn * BM + wc * 32 + 8 * fq;
#pragma unroll
        for (int ai = 0; ai < NAI; ++ai)
#pragma unroll
            for (int m = 0; m < 4; ++m) {
                const int r = row0 + ai * HALF + m * 16;
                const bool valid = r < MTOK;
                float part = 0.f;
#pragma unroll
                for (int bj = 0; bj < 2; ++bj) {
                    const int c = col0 + bj * HALF;
                    f32x4 o0 = {0.f, 0.f, 0.f, 0.f}, o1 = {0.f, 0.f, 0.f, 0.f};
                    if (MODE == 0) {
                        const float* src = r < TP ? xp + (size_t)r * D : xs + (size_t)(r - TP) * D;
                        if (valid) { o0 = __builtin_nontemporal_load((const f32x4*)(src + c)); o1 = __builtin_nontemporal_load((const f32x4*)(src + c + 4)); }
                    } else {
                        float f[8]; unpack8(*(const u32x4*)(xb + (size_t)r * D + c), f);
                        o0 = (f32x4){f[0], f[1], f[2], f[3]}; o1 = (f32x4){f[4], f[5], f[6], f[7]};
                    }
                    const f32x4 v0 = acc[ai][bj][m][0] + o0, v1 = acc[ai][bj][m][1] + o1;
                    if (MODE == 2) {
                        if (valid) { __builtin_nontemporal_store(v0, (f32x4*)(out + (size_t)r * D + c)); __builtin_nontemporal_store(v1, (f32x4*)(out + (size_t)r * D + c + 4)); }
                    } else {
                        *(u32x4*)(xb + (size_t)r * D + c) = pack8v(v0, v1);
                        part += v0[0] * v0[0] + v0[1] * v0[1] + v0[2] * v0[2] + v0[3] * v0[3] + v1[0] * v1[0] + v1[1] * v1[1] + v1[2] * v1[2] + v1[3] * v1[3];
                    }
                }
                if (MODE != 2) {
                    part += __shfl_xor(part, 16); part += __shfl_xor(part, 32);
                    if (fq == 0) ssq[(size_t)r * 16 + u.pn * 4 + wc] = part;
                }
                __builtin_amdgcn_sched_barrier(0);
            }
    }
};

typedef EpiU_<2> EpiU; typedef EpiU_<1> EpiUh;
struct EpiProbe {
    const unsigned* flag; float* dst;
    __device__ __forceinline__ void operator()(const f32x4 (&acc)[2][2][4][2], const Unit& u, int wr, int wc, int fr, int fq) const {
        if (__hip_atomic_load(flag, __ATOMIC_RELAXED, __HIP_MEMORY_SCOPE_AGENT) == 12345u) {
            f32x4 t = {0.f, 0.f, 0.f, 0.f};
#pragma unroll
            for (int a = 0; a < 2; ++a)
#pragma unroll
                for (int b = 0; b < 2; ++b)
#pragma unroll
                    for (int m = 0; m < 4; ++m)
#pragma unroll
                        for (int n = 0; n < 2; ++n) t += acc[a][b][m][n];
            *(f32x4*)(dst + (size_t)(u.pm * 4 + u.pn) * 2048 + (wr * 4 + wc) * 256 + (fq * 16 + fr) * 4) = t;
        }
    }
};
struct SampleOrder {
    int first, cnt, c;
    __device__ bool next(int i, Unit& u) const { if (i != 0 || c < first || c >= first + cnt) return false; u.pm = 64; u.pn = c - first; return true; }
};
template <class Epi, class Sched, bool HALF_M = false, bool SP2 = false, bool ALIGN_EPI = false>
__device__ __forceinline__ void gemm_phase(lptr lds, const Gemm g, const Sched& S, const Epi& E, const int tid) {
    const int wid = __builtin_amdgcn_readfirstlane(tid >> 6), lane = tid & 63, wr = wid >> 2, wc = wid & 3, fr = lane & 15, fq = lane >> 4;
    const int K = g.K, nt = K / BK;
    unsigned voffA[2], voffB[2];
#pragma unroll
    for (int i = 0; i < 2; ++i) { int R, C; stage_rc(tid * 16 + i * 8192, R, C); const int Rb = (R & ~31) + perm32(R & 31);
        voffA[i] = (unsigned)(R * K + C) * 2u; voffB[i] = (unsigned)(Rb * K + C) * 2u; }
    const size_t kstep = (size_t)(BK * 2);
    const size_t hstep = (size_t)HALF * K * 2;
    const size_t tstep = 2 * hstep;
    const unsigned ldsw = (unsigned)wid * 1024u;
    const int aoff = lds_byte(wr * 64 + fr, fq * 8), boff = lds_byte(wc * 32 + fr, fq * 8);
#define PG8_SA(b, h) (((b) * 2 + (h)) * HTB)
#define PG8_SB(b, h) ((4 + (b) * 2 + (h)) * HTB)
#define PG8_STAGE(bufoff, gbase, voff) do { _Pragma("unroll") for (int _i = 0; _i < 2; ++_i) \
        __builtin_amdgcn_global_load_lds((const unsigned*)((const char*)(gbase) + (voff)[_i]), (LAS unsigned*)(lds + (bufoff) + ldsw + _i * 8192), 16, 0, 0); } while (0)
#define PG8_LDA(dst, b, h) do { _Pragma("unroll") for (int m = 0; m < 4; ++m) _Pragma("unroll") for (int k = 0; k < 2; ++k) dst[m][k] = *(const LAS bf16x8*)(lds + PG8_SA(b, h) + aoff + m * 2048 + k * 1024); } while (0)
#define PG8_LDB(dst, b, h) do { _Pragma("unroll") for (int n = 0; n < 2; ++n) _Pragma("unroll") for (int k = 0; k < 2; ++k) dst[n][k] = *(const LAS bf16x8*)(lds + PG8_SB(b, h) + boff + n * 2048 + k * 1024); } while (0)
#define PG8_MMA(ai, bj, At, Bt) do { __builtin_amdgcn_s_setprio(1); _Pragma("unroll") for (int m = 0; m < 4; ++m) _Pragma("unroll") for (int n = 0; n < 2; ++n) _Pragma("unroll") for (int k = 0; k < 2; ++k) \
        acc[ai][bj][m][n] = __builtin_amdgcn_mfma_f32_16x16x32_bf16(Bt[n][k], At[m][k], acc[ai][bj][m][n], 0, 0, 0); __builtin_amdgcn_s_setprio(0); } while (0)
#define PG8_WAIT_V(n) asm volatile("s_waitcnt vmcnt(" #n ")" ::: "memory")
#define PG8_WAIT_L(n) asm volatile("s_waitcnt lgkmcnt(" #n ")" ::: "memory")
#define PG8_BAR __builtin_amdgcn_s_barrier()
#define PG8_SCHED __builtin_amdgcn_sched_barrier(0)
    Unit cur, nxt; int ui = 0;
    if (!S.next(0, cur)) return;
    f32x4 acc[2][2][4][2];
#pragma unroll
    for (int a = 0; a < 2; ++a)
#pragma unroll
        for (int b = 0; b < 2; ++b)
#pragma unroll
            for (int m = 0; m < 4; ++m)
#pragma unroll
                for (int n = 0; n < 2; ++n) acc[a][b][m][n] = (f32x4){0.f, 0.f, 0.f, 0.f};
    bf16x8 At[4][2], B0[2][2], B1[2][2];
    const char* cA = (const char*)g.A + (size_t)cur.pm * tstep; const char* cB = (const char*)g.Bt + (size_t)cur.pn * tstep;
    if constexpr (SP2) {
        PG8_STAGE(PG8_SB(0, 0), cB, voffB); PG8_STAGE(PG8_SB(0, 1), cB + hstep, voffB); PG8_STAGE(PG8_SA(0, 0), cA, voffA); PG8_STAGE(PG8_SA(0, 1), cA + hstep, voffA);
        if (wr == 1) PG8_BAR;
        PG8_WAIT_V(2); PG8_BAR;
        PG8_STAGE(PG8_SB(1, 0), cB + kstep, voffB); PG8_STAGE(PG8_SA(1, 0), cA + kstep, voffA); PG8_STAGE(PG8_SB(1, 1), cB + hstep + kstep, voffB);
        PG8_WAIT_V(6); PG8_BAR;
    } else {
    PG8_STAGE(PG8_SB(0, 0), cB, voffB); PG8_STAGE(PG8_SA(0, 0), cA, voffA); PG8_STAGE(PG8_SB(0, 1), cB + hstep, voffB); PG8_STAGE(PG8_SA(0, 1), cA + hstep, voffA);
    if (wr == 1) PG8_BAR;
    PG8_WAIT_V(4); PG8_BAR;
    PG8_STAGE(PG8_SB(1, 0), cB + kstep, voffB); PG8_STAGE(PG8_SA(1, 0), cA + kstep, voffA); PG8_STAGE(PG8_SB(1, 1), cB + hstep + kstep, voffB);
    PG8_WAIT_V(6); PG8_BAR;
    }
    for (;;) {
        const bool has_next = S.next(ui + 1, nxt);
        const char* nA = has_next ? (const char*)g.A + (size_t)nxt.pm * tstep : cA; const char* nB = has_next ? (const char*)g.Bt + (size_t)nxt.pn * tstep : cB;
        for (int t = 0; t < nt; t += 2) {
            const bool last = (t == nt - 2);
            const char* a1 = cA + (size_t)(t + 1) * kstep;
            const char* a2 = last ? nA : cA + (size_t)(t + 2) * kstep; const char* b2 = last ? nB : cB + (size_t)(t + 2) * kstep;
            const char* a3 = a2 + kstep; const char* b3 = b2 + kstep;
            if constexpr (SP2) {
            PG8_LDB(B0, 0, 0); PG8_LDB(B1, 0, 1); PG8_SCHED; PG8_LDA(At, 0, 0); PG8_STAGE(PG8_SA(1, 1), a1 + hstep, voffA);
            PG8_WAIT_V(8); PG8_WAIT_L(0); PG8_BAR; PG8_MMA(0, 0, At, B0); PG8_MMA(0, 1, At, B1); PG8_BAR; PG8_SCHED;
            PG8_LDA(At, 0, 1); PG8_STAGE(PG8_SB(0, 0), b2, voffB); PG8_STAGE(PG8_SB(0, 1), b2 + hstep, voffB); PG8_STAGE(PG8_SA(0, 0), a2, voffA);
            PG8_WAIT_V(8); PG8_WAIT_L(0); PG8_BAR; PG8_MMA(1, 0, At, B0); PG8_MMA(1, 1, At, B1); PG8_BAR; PG8_SCHED;
            PG8_LDB(B0, 1, 0); PG8_LDB(B1, 1, 1); PG8_SCHED; PG8_LDA(At, 1, 0); PG8_STAGE(PG8_SA(0, 1), a2 + hstep, voffA);
            PG8_WAIT_V(8); PG8_WAIT_L(0); PG8_BAR; PG8_MMA(0, 0, At, B0); PG8_MMA(0, 1, At, B1); PG8_BAR; PG8_SCHED;
            PG8_LDA(At, 1, 1); PG8_STAGE(PG8_SB(1, 0), b3, voffB); PG8_STAGE(PG8_SB(1, 1), b3 + hstep, voffB); PG8_STAGE(PG8_SA(1, 0), a3, voffA);
            PG8_WAIT_V(8); PG8_WAIT_L(0); PG8_BAR; PG8_MMA(1, 0, At, B0); PG8_MMA(1, 1, At, B1); PG8_BAR; PG8_SCHED;
            } else {
            PG8_LDB(B0, 0, 0); PG8_SCHED; PG8_LDA(At, 0, 0); PG8_STAGE(PG8_SA(1, 1), a1 + hstep, voffA);
            PG8_WAIT_L(8); PG8_BAR; PG8_WAIT_L(0); PG8_MMA(0, 0, At, B0); PG8_BAR; PG8_SCHED;
            PG8_LDB(B1, 0, 1); PG8_STAGE(PG8_SB(0, 0), b2, voffB);
            PG8_BAR; PG8_WAIT_L(0); PG8_MMA(0, 1, At, B1); PG8_BAR;
            if constexpr (!HALF_M) PG8_LDA(At, 0, 1);
            PG8_STAGE(PG8_SA(0, 0), a2, voffA);
            PG8_BAR; PG8_WAIT_L(0); if constexpr (!HALF_M) PG8_MMA(1, 0, At, B0); PG8_BAR; PG8_SCHED;
            PG8_STAGE(PG8_SB(0, 1), b2 + hstep, voffB);
            PG8_WAIT_V(6); PG8_BAR; if constexpr (!HALF_M) PG8_MMA(1, 1, At, B1); PG8_BAR;
            PG8_LDB(B0, 1, 0); PG8_SCHED; PG8_LDA(At, 1, 0); PG8_STAGE(PG8_SA(0, 1), a2 + hstep, voffA);
            PG8_WAIT_L(8); PG8_BAR; PG8_WAIT_L(0); PG8_MMA(0, 0, At, B0); PG8_BAR; PG8_SCHED;
            PG8_LDB(B1, 1, 1); PG8_STAGE(PG8_SB(1, 0), b3, voffB);
            PG8_BAR; PG8_WAIT_L(0); PG8_MMA(0, 1, At, B1); PG8_BAR;
            if constexpr (!HALF_M) PG8_LDA(At, 1, 1);
            PG8_STAGE(PG8_SA(1, 0), a3, voffA);
            PG8_BAR; PG8_WAIT_L(0); if constexpr (!HALF_M) PG8_MMA(1, 0, At, B0); PG8_BAR; PG8_SCHED;
            PG8_STAGE(PG8_SB(1, 1), b3 + hstep, voffB);
            PG8_WAIT_V(6); PG8_BAR; if constexpr (!HALF_M) PG8_MMA(1, 1, At, B1); PG8_BAR;
            }
        }
        if constexpr (ALIGN_EPI) { if (wr == 0) PG8_BAR; }
        E(acc, cur, wr, wc, fr, fq);
        if (!has_next) break;
#pragma unroll
        for (int a = 0; a < 2; ++a)
#pragma unroll
            for (int b = 0; b < 2; ++b)
#pragma unroll
                for (int m = 0; m < 4; ++m)
#pragma unroll
                    for (int n = 0; n < 2; ++n) acc[a][b][m][n] = (f32x4){0.f, 0.f, 0.f, 0.f};
        cur = nxt; cA = nA; cB = nB; ++ui;
        if constexpr (ALIGN_EPI) { if (wr == 1) PG8_BAR; }
    }
    PG8_WAIT_V(0);
    if constexpr (!ALIGN_EPI) { if (wr == 0) PG8_BAR; }
    PG8_BAR;
#undef PG8_SA
#undef PG8_SB
#undef PG8_STAGE
#undef PG8_LDA
#undef PG8_LDB
#undef PG8_MMA
#undef PG8_WAIT_V
#undef PG8_WAIT_L
#undef PG8_BAR
#undef PG8_SCHED
}
}

struct Ctx {
    const float* xp; const float* xs; const float* stC; const float* stN; const float* stM; const float* ssm; const float* conv; const float* ck; const float* cv;
    float* out; unsigned char* ws;
};
#define XWIN ((bf16_t*)(X.ws + WS_WIN))
#define XWOUT ((bf16_t*)(X.ws + WS_WOUT))
#define XXB ((bf16_t*)(X.ws + WS_XB))
#define XU ((bf16_t*)(X.ws + WS_U))
#define XMIX ((bf16_t*)(X.ws + WS_MIX))
#define XSSQ ((float*)(X.ws + WS_SSQ))
#define XROPE ((float*)(X.ws + WS_ROPE))
#define XMC ((float*)(X.ws + WS_MC))
#define XMN ((float*)(X.ws + WS_MN))
#define XML ((float*)(X.ws + WS_ML))
#define XBL ((float*)(X.ws + WS_BL))
#define XMS ((float*)(X.ws + WS_MS))
#define XSA ((float*)(X.ws + WS_SA))
#define XSH ((float*)(X.ws + WS_SH))
#define XCSB ((bf16_t*)(X.ws + WS_CSB))
#define XNS ((float*)(X.ws + WS_NS))
#define XHSB ((bf16_t*)(X.ws + WS_HSB))
#define XPAR(off) ((const float*)(X.ws + WS_PAR) + (off))
constexpr int P_AIB = 0, P_AFB = 16, P_DTB = 32, P_ALOG = 64, P_BD = 96, P_SINK = 128, P_QNW = 160, P_KNW = 416, P_ANW = 672, P_BNW = 2720, P_CB = 4768, P_CW = 8864, P_END = 25248;
#define IN_XP 0
#define IN_XS 1
#define IN_STC 2
#define IN_STN 3
#define IN_STM 4
#define IN_SSM 5
#define IN_CONV 6
#define IN_CK 7
#define IN_CV 8
#define IN_NORMW 9
#define IN_WIN 10
#define IN_AIB 11
#define IN_AFB 12
#define IN_ANW 13
#define IN_CW 14
#define IN_CB 15
#define IN_DTB 16
#define IN_ALOG 17
#define IN_BD 18
#define IN_BNW 19
#define IN_QNW 20
#define IN_KNW 21
#define IN_SINK 22
#define IN_WOUT 23

__device__ __forceinline__ void transpose_strip(lptr lds, const float* src, int ldn, int nvalid, bf16_t* dst, int ldk, const float* scale, int k0, int n0, int tid) {
    LAS float* T = (LAS float*)lds;
    f32x4 v[8];
#pragma unroll
    for (int i = 0; i < 8; ++i) {
        const int f = tid + i * NT, r = f >> 6, c4 = (f & 63) * 4, n = n0 + c4;
        const f32x4 t = __builtin_nontemporal_load((const f32x4*)(src + (size_t)(k0 + r) * ldn + (n < nvalid ? n : 0)));
        const float m = n < nvalid ? (scale ? scale[k0 + r] : 1.f) : 0.f;
        v[i] = t * m;
    }
#pragma unroll
    for (int i = 0; i < 8; ++i) {
        const int f = tid + i * NT, r = f >> 6, c4 = (f & 63) * 4;
        T[r * 257 + c4 + 0] = v[i][0]; T[r * 257 + c4 + 1] = v[i][1]; T[r * 257 + c4 + 2] = v[i][2]; T[r * 257 + c4 + 3] = v[i][3];
    }
    __syncthreads();
#pragma unroll
    for (int i = 0; i < 4; ++i) {
        const int p = tid + i * NT, n = p >> 3, k8 = (p & 7) * 8; float f[8];
#pragma unroll
        for (int jx = 0; jx < 8; ++jx) f[jx] = T[(k8 + jx) * 257 + n];
        *(u32x4*)(dst + (size_t)(n0 + n) * ldk + k0 + k8) = pack8(f);
    }
    __syncthreads();
}

__device__ __forceinline__ void prologue(lptr lds, const Ctx& X, const Args& args, int G, int bid, int tid) {
    const int lane = tid & 63, wave = tid >> 6;
    constexpr int T0 = 320, T1 = T0 + 96, T2 = T1 + 2080, T3 = T2 + 1, T4 = T3 + 513;
    for (int task = bid; task < T4; task += G) {
        if (task < T0) {
            const int kt = task / 20, ntl = task % 20;
            transpose_strip(lds, args.in[IN_WIN], DIN, DIN, XWIN, D, args.in[IN_NORMW], kt * 64, ntl * 256, tid);
        } else if (task < T1) {
            const int r = task - T0, kt = r / 4, ntl = r % 4;
            transpose_strip(lds, args.in[IN_WOUT], D, D, XWOUT, DMIX, nullptr, kt * 64, ntl * 256, tid);
        } else if (task < T2) {
            const int r = (task - T1) * 8 + wave;
            float ss = 0.f;
            if (r < MTOK) {
                const float* src = r < TP ? X.xp + (size_t)r * D : X.xs + (size_t)(r - TP) * D;
#pragma unroll
                for (int i = 0; i < 4; ++i) {
                    const int c = lane * 4 + i * 256; f32x4 v = __builtin_nontemporal_load((const f32x4*)(src + c));
                    ss += v[0] * v[0] + v[1] * v[1] + v[2] * v[2] + v[3] * v[3];
                    u32x2 w; w[0] = pk2(v[0], v[1]); w[1] = pk2(v[2], v[3]);
                    *(u32x2*)(XXB + (size_t)r * D + c) = w;
                }
            } else {
#pragma unroll
                for (int i = 0; i < 4; ++i) { u32x2 w = {0u, 0u}; *(u32x2*)(XXB + (size_t)r * D + lane * 4 + i * 256) = w; }
            }
            ss = wave_sum(ss);
            if (lane < 16) XSSQ[(size_t)r * 16 + lane] = (lane == 0) ? ss : 0.f;
        } else if (task < T3) {
            for (int i = tid; i < (MPAD - MTOK) * DMIX / 2; i += NT) ((unsigned*)(XMIX + (size_t)MTOK * DMIX))[i] = 0u;
            float* P = (float*)(X.ws + WS_PAR);
            const int po[12] = {P_AIB, P_AFB, P_DTB, P_ALOG, P_BD, P_SINK, P_QNW, P_KNW, P_ANW, P_BNW, P_CB, P_CW};
            const int pn[12] = {16, 16, 32, 32, 32, 32, 256, 256, 2048, 2048, 4096, 16384};
            const int pi[12] = {IN_AIB, IN_AFB, IN_DTB, IN_ALOG, IN_BD, IN_SINK, IN_QNW, IN_KNW, IN_ANW, IN_BNW, IN_CB, IN_CW};
#pragma unroll
            for (int a = 0; a < 12; ++a) { const float* src = args.in[pi[a]]; for (int i = tid; i < pn[a]; i += NT) P[po[a] + i] = src[i]; }
        } else {
            const int e = (task - T3) * 512 + tid;
            if (e < 8193 * 32) {
                const int pos = e >> 5, d = e & 31;
                const float inv = (float)exp2(-(double)d * (13.287712379549449 / 32.0));
                const float angf = (float)pos * inv;
                const double a = (double)angf;
                const double k = rint(a * 0.15915494309189535);
                const float rr = (float)(a - k * 6.283185307179586);
                XROPE[(size_t)e * 2] = cosf(rr); XROPE[(size_t)e * 2 + 1] = sinf(rr);
            }
        }
    }
}

__device__ __forceinline__ void convert_weights(lptr lds, const Ctx& X, const Args& args, int l, int first, int stride, int tid) {
    for (int t = first; t < 416; t += stride) {
        if (t < 320) {
            const int kt = t / 20, ntl = t % 20;
            transpose_strip(lds, args.in[IN_WIN] + (size_t)l * D * DIN, DIN, DIN, XWIN + (size_t)l * NIN * D, D, args.in[IN_NORMW] + l * D, kt * 64, ntl * 256, tid);
        } else {
            const int r = t - 320, kt = r / 4, ntl = r % 4;
            transpose_strip(lds, args.in[IN_WOUT] + (size_t)l * DMIX * D, D, D, XWOUT + (size_t)l * D * DMIX, DMIX, nullptr, kt * 64, ntl * 256, tid);
        }
    }
}

__device__ __forceinline__ void conv8(const bf16_t* u, int seq0, int tt, int ch, const float* cw, const float* cb, float (&o)[8]) {
    float acc[8];
    { f32x4 b0 = *(const f32x4*)(cb + ch), b1 = *(const f32x4*)(cb + ch + 4);
#pragma unroll
      for (int j = 0; j < 4; ++j) { acc[j] = b0[j]; acc[4 + j] = b1[j]; } }
#pragma unroll
    for (int jj = 0; jj < 4; ++jj) {
        const int t2 = tt + jj - 3;
        if (t2 >= 0) {
            float x[8]; unpack8(*(const u32x4*)(u + (size_t)(seq0 + t2) * NIN + C_BX + ch), x);
            f32x4 w0 = *(const f32x4*)(cw + jj * 1024 + ch), w1 = *(const f32x4*)(cw + jj * 1024 + ch + 4);
#pragma unroll
            for (int j = 0; j < 4; ++j) { acc[j] += x[j] * w0[j]; acc[4 + j] += x[4 + j] * w1[j]; }
        }
    }
#pragma unroll
    for (int j = 0; j < 8; ++j) o[j] = siluf_(acc[j]);
}


__device__ __forceinline__ void conv8x8(const bf16_t* u, int seq0, int tt0, int ch, const float* cw, const float* cb, float (&o)[8][8]) {
    float w[4][8];
#pragma unroll
    for (int jj = 0; jj < 4; ++jj) { f32x4 w0 = *(const f32x4*)(cw + jj * 1024 + ch), w1 = *(const f32x4*)(cw + jj * 1024 + ch + 4);
#pragma unroll
        for (int j = 0; j < 4; ++j) { w[jj][j] = w0[j]; w[jj][4 + j] = w1[j]; } }
    { f32x4 b0 = *(const f32x4*)(cb + ch), b1 = *(const f32x4*)(cb + ch + 4);
#pragma unroll
      for (int t = 0; t < 8; ++t)
#pragma unroll
          for (int j = 0; j < 4; ++j) { o[t][j] = b0[j]; o[t][4 + j] = b1[j]; } }
    u32x4 raw[11];
#pragma unroll
    for (int r = 0; r < 11; ++r) {
        const int t2 = tt0 + r - 3;
        const u32x4 v = *(const u32x4*)(u + (unsigned)(seq0 + (t2 >= 0 ? t2 : 0)) * NIN + C_BX + ch);
        const unsigned msk = t2 >= 0 ? 0xffffffffu : 0u;
        raw[r] = (u32x4){v[0] & msk, v[1] & msk, v[2] & msk, v[3] & msk};
    }
#pragma unroll
    for (int r = 0; r < 11; ++r) {
        float x[8]; unpack8(raw[r], x);
#pragma unroll
        for (int jj = 0; jj < 4; ++jj) {
            const int t = r - jj;
            if (t >= 0 && t < 8) {
#pragma unroll
                for (int j = 0; j < 8; ++j) o[t][j] += x[j] * w[jj][j];
            }
        }
    }
#pragma unroll
    for (int t = 0; t < 8; ++t)
#pragma unroll
        for (int j = 0; j < 8; ++j) o[t][j] = siluf_(o[t][j]);
}

__device__ __forceinline__ void mlstm_local(lptr lds, const Ctx& X, int l, int task, int tid) {
    const int h = task & 3, c = (task >> 2) & 127, n = task >> 9;
    const int lane = tid & 63, wave = tid >> 6, fr = lane & 15, fq = lane >> 4;
    const int row0 = n * SEQ + c * 64, nh = n * 4 + h;
    lptr VwT = lds;
    lptr KT = lds + 18432;
    LAS float* wv = (LAS float*)(lds + 27648);
    const int tg = lane & 7, cgq = lane >> 3;
    u32x4 blk[8];
    if (wave >= 1 && wave <= 3) {
        const int col = wave < 3 ? C_AV + h * 128 + ((wave - 1) * 8 + cgq) * 8 : C_AK + h * 64 + cgq * 8;
#pragma unroll
        for (int t = 0; t < 8; ++t) blk[t] = *(const u32x4*)(XU + (unsigned)(row0 + 8 * tg + t) * NIN + col);
    }
    if (wave == 0) {
        const bf16_t* ur = XU + (unsigned)(row0 + lane) * NIN;
        const float fg = bf2f(ur[C_AF + h]) + XPAR(P_AFB)[l * 4 + h], ig = bf2f(ur[C_AI + h]) + XPAR(P_AIB)[l * 4 + h];
        const float b = wave_scan_sum(logsigf_(fg), lane);
        const float bl = lane63(b);
        const float g = bl - b + ig;
        const float ml = wave_max(g);
        wv[lane] = __expf(g - ml);
        if (lane == 0) { XML[nh * 128 + c] = ml; XBL[nh * 128 + c] = bl; }
    }
    __syncthreads();
    if (wave >= 1 && wave <= 3) {
        float xs[8][8];
#pragma unroll
        for (int t = 0; t < 8; ++t) { unpack8(blk[t], xs[t]); const float w = wave < 3 ? wv[8 * tg + t] : 0.125f;
#pragma unroll
            for (int j = 0; j < 8; ++j) xs[t][j] *= w; }
        lptr dstT = wave < 3 ? VwT + ((((wave - 1) * 8 + cgq) * 8 * 72) << 1) : KT + ((cgq * 8 * 72) << 1);
#pragma unroll
        for (int j = 0; j < 8; ++j) {
            float v[8];
#pragma unroll
            for (int t = 0; t < 8; ++t) v[t] = xs[t][j];
            *(LAS u32x4*)(dstT + ((j * 72 + 8 * tg) << 1)) = pack8(v);
        }
    }
    __syncthreads();
    {
        bf16_t* dst = (bf16_t*)XMC + ((size_t)nh * 128 + c) * 8192;
        bf16x8 b0 = lds_frag(VwT, 16 * wave + fr, fq * 8, 72), b1 = lds_frag(VwT, 16 * wave + fr, 32 + fq * 8, 72);
#pragma unroll
        for (int mt = 0; mt < 4; ++mt) {
            f32x4 acc = {0.f, 0.f, 0.f, 0.f};
            acc = mfma16(lds_frag(KT, 16 * mt + fr, fq * 8, 72), b0, acc);
            acc = mfma16(lds_frag(KT, 16 * mt + fr, 32 + fq * 8, 72), b1, acc);
            { u32x2 w; w[0] = pk2(acc[0], acc[1]); w[1] = pk2(acc[2], acc[3]); *(u32x2*)(dst + (16 * wave + fr) * 64 + 16 * mt + 4 * fq) = w; }
        }
    }
    if (tid < 64) {
        float s = 0.f;
#pragma unroll
        for (int t8 = 0; t8 < 8; ++t8) {
            float kf[8]; unpack8(*(const LAS u32x4*)(KT + ((tid * 72 + t8 * 8) << 1)), kf);
#pragma unroll
            for (int jx = 0; jx < 8; ++jx) s += kf[jx] * wv[t8 * 8 + jx];
        }
        XMN[((size_t)nh * 128 + c) * 64 + tid] = s;
    }
    __syncthreads();
}

__device__ __forceinline__ void ssd_local(lptr lds, const Ctx& X, int l, int task, int tid) {
    const int g = task & 1, c = (task >> 1) & 127, n = task >> 8;
    const int lane = tid & 63, wave = tid >> 6, fr = lane & 15, fq = lane >> 4;
    const int seq0 = n * SEQ, row0 = seq0 + c * 64;
    lptr XwT = lds;
    lptr BT = lds + 36864;
    LAS float* wl = (LAS float*)(lds + 55296);
    {
        const float* cw = XPAR(P_CW) + l * 4096; const float* cb = XPAR(P_CB) + l * 1024;
        const int tg = lane & 7, cg = wave * 8 + (lane >> 3);
        float o[8][8];
        if (wave < 6) {
            const int ch = cg < 32 ? g * 256 + cg * 8 : 512 + g * 128 + (cg - 32) * 8;
            conv8x8(XU, seq0, c * 64 + 8 * tg, ch, cw, cb, o);
        }
        if (wave < 4) {
            const int hh = 4 * g + wave;
            const float dt = softplusf_(bf2f(XU[(unsigned)(row0 + lane) * NIN + C_BDT + hh]) + XPAR(P_DTB)[l * 8 + hh]);
            const float A = -__expf(XPAR(P_ALOG)[l * 8 + hh]);
            const float a = wave_scan_sum(dt * A, lane);
            const float aL = lane63(a);
            wl[wave * 64 + lane] = __expf(aL - a) * dt;
            if (lane == 0) XSA[(n * 8 + hh) * 128 + c] = aL;
        }
        __syncthreads();
        if (wave < 4) {
            float wt[8];
#pragma unroll
            for (int t = 0; t < 8; ++t) wt[t] = wl[wave * 64 + 8 * tg + t];
#pragma unroll
            for (int jx = 0; jx < 8; ++jx) {
                float v[8];
#pragma unroll
                for (int t = 0; t < 8; ++t) v[t] = o[t][jx] * wt[t];
                *(LAS u32x4*)(XwT + (((cg * 8 + jx) * 72 + 8 * tg) << 1)) = pack8(v);
            }
        } else if (wave < 6) {
#pragma unroll
            for (int jx = 0; jx < 8; ++jx) {
                float v[8];
#pragma unroll
                for (int t = 0; t < 8; ++t) v[t] = o[t][jx];
                *(LAS u32x4*)(BT + ((((cg - 32) * 8 + jx) * 72 + 8 * tg) << 1)) = pack8(v);
            }
        }
    }
    __syncthreads();
    {
        const int hl = wave >> 1, ph = wave & 1, hh = 4 * g + hl;
        bf16_t* dst = (bf16_t*)XSH + ((size_t)(n * 8 + hh) * 128 + c) * 8192;
        bf16x8 bx[2][2];
#pragma unroll
        for (int ntl = 0; ntl < 2; ++ntl)
#pragma unroll
            for (int kk = 0; kk < 2; ++kk) bx[ntl][kk] = lds_frag(XwT, hl * 64 + ph * 32 + ntl * 16 + fr, kk * 32 + fq * 8, 72);
#pragma unroll
        for (int mt = 0; mt < 8; ++mt) {
            bf16x8 a0 = lds_frag(BT, 16 * mt + fr, fq * 8, 72), a1 = lds_frag(BT, 16 * mt + fr, 32 + fq * 8, 72);
#pragma unroll
            for (int ntl = 0; ntl < 2; ++ntl) {
                f32x4 acc = {0.f, 0.f, 0.f, 0.f};
                acc = mfma16(a0, bx[ntl][0], acc); acc = mfma16(a1, bx[ntl][1], acc);
                { u32x2 w; w[0] = pk2(acc[0], acc[1]); w[1] = pk2(acc[2], acc[3]); *(u32x2*)(dst + (ph * 32 + ntl * 16 + fr) * 128 + 16 * mt + 4 * fq) = w; }
            }
        }
    }
    __syncthreads();
}

__device__ __forceinline__ void swa_prompt(lptr lds, const Ctx& X, int l, int task, int tid) {
    const int kvh = task & 1, qb = (task >> 1) & 63, n = task >> 7;
    const int lane = tid & 63, wave = tid >> 6, fr = lane & 15, fq = lane >> 4;
    const int seq0 = n * SEQ;
    lptr Kn = lds;
    lptr Vt = lds + 36864;
    lptr Pw = lds + 70656 + wave * 8448;
    const float* knw = XPAR(P_KNW) + l * 64; const float* qnw = XPAR(P_QNW) + l * 64;
#pragma unroll
    for (int it = 0; it < 2; ++it) {
        const int item = tid + it * NT, j = item >> 2, qd = item & 3, t = qb * 128 - 128 + j;
        float o1[8], o2[8];
        {
            const int tc = t >= 0 ? t : 0;
            const bf16_t* kr = XU + (unsigned)(seq0 + tc) * NIN + C_CK + kvh * 64;
            float x1[8], x2[8]; unpack8(*(const u32x4*)(kr + qd * 8), x1); unpack8(*(const u32x4*)(kr + 32 + qd * 8), x2);
            float ss = 0.f;
#pragma unroll
            for (int jj = 0; jj < 8; ++jj) ss += x1[jj] * x1[jj] + x2[jj] * x2[jj];
            ss += __shfl_xor(ss, 1); ss += __shfl_xor(ss, 2);
            const float rs = rsqrtf(ss * (1.f / 64.f) + EPS);
            const f32x4* cs = (const f32x4*)(XROPE + ((size_t)tc * 32 + qd * 8) * 2);
            f32x4 csv[4];
#pragma unroll
            for (int q4 = 0; q4 < 4; ++q4) csv[q4] = cs[q4];
            const float zm = t >= 0 ? 1.f : 0.f;
#pragma unroll
            for (int jj = 0; jj < 8; ++jj) {
                const float a = x1[jj] * rs * knw[qd * 8 + jj], b = x2[jj] * rs * knw[32 + qd * 8 + jj], co = csv[jj >> 1][(jj & 1) * 2], si = csv[jj >> 1][(jj & 1) * 2 + 1];
                o1[jj] = (a * co - b * si) * zm; o2[jj] = (b * co + a * si) * zm;
            }
        }
        *(LAS u32x4*)(Kn + ((j * 72 + qd * 8) << 1)) = pack8(o1);
        *(LAS u32x4*)(Kn + ((j * 72 + 32 + qd * 8) << 1)) = pack8(o2);
        if (qb == 63 && j >= 128) {
            float* ko = X.out + O_PK + ((((size_t)l * 2 + n) * 128 + (j - 128)) * 2 + kvh) * 64;
            *(f32x4*)(ko + qd * 8) = (f32x4){o1[0], o1[1], o1[2], o1[3]}; *(f32x4*)(ko + qd * 8 + 4) = (f32x4){o1[4], o1[5], o1[6], o1[7]};
            *(f32x4*)(ko + 32 + qd * 8) = (f32x4){o2[0], o2[1], o2[2], o2[3]}; *(f32x4*)(ko + 32 + qd * 8 + 4) = (f32x4){o2[4], o2[5], o2[6], o2[7]};
        }
    }
    if (wave < 4) {
        const int tg = tid & 31, cg = tid >> 5;
        u32x4 vb[8];
#pragma unroll
        for (int t8 = 0; t8 < 8; ++t8) {
            const int jk = 8 * tg + t8, t = qb * 128 - 128 + jk;
            u32x4 w = *(const u32x4*)(XU + (unsigned)(seq0 + (t >= 0 ? t : 0)) * NIN + C_CV + kvh * 64 + cg * 8);
            const unsigned msk = t >= 0 ? 0xffffffffu : 0u;
            vb[t8] = (u32x4){w[0] & msk, w[1] & msk, w[2] & msk, w[3] & msk};
        }
#pragma unroll
        for (int jj = 0; jj < 8; ++jj) {
            u32x4 w;
#pragma unroll
            for (int tp = 0; tp < 4; ++tp) {
                const unsigned lo = (vb[2 * tp][jj >> 1] >> ((jj & 1) * 16)) & 0xffffu, hi = (vb[2 * tp + 1][jj >> 1] >> ((jj & 1) * 16)) & 0xffffu;
                w[tp] = lo | (hi << 16);
            }
            *(LAS u32x4*)(Vt + (((cg * 8 + jj) * 264 + 8 * tg) << 1)) = w;
        }
        if (qb == 63 && tg >= 16) {
#pragma unroll
            for (int t8 = 0; t8 < 8; ++t8) {
                float x[8]; unpack8(vb[t8], x);
                float* vo = X.out + O_PV + ((((size_t)l * 2 + n) * 128 + (8 * tg + t8 - 128)) * 2 + kvh) * 64 + cg * 8;
                *(f32x4*)(vo) = (f32x4){x[0], x[1], x[2], x[3]}; *(f32x4*)(vo + 4) = (f32x4){x[4], x[5], x[6], x[7]};
            }
        }
    }
    __syncthreads();
    const int hq = kvh * 4 + (wave >> 1), i0 = (wave & 1) * 64;
    const float sink = XPAR(P_SINK)[l * 8 + hq];
    float qw1[8], qw2[8];
#pragma unroll
    for (int jj = 0; jj < 8; ++jj) { qw1[jj] = qnw[fq * 8 + jj]; qw2[jj] = qnw[32 + fq * 8 + jj]; }
    u32x4 qn0, qn1; f32x4 csn[4];
    {
        const int t = qb * 128 + i0 + fr;
        const bf16_t* qr = XU + (unsigned)(seq0 + t) * NIN + C_CQ + hq * 64;
        qn0 = *(const u32x4*)(qr + fq * 8); qn1 = *(const u32x4*)(qr + 32 + fq * 8);
        const f32x4* cs = (const f32x4*)(XROPE + ((size_t)t * 32 + fq * 8) * 2);
#pragma unroll
        for (int q4 = 0; q4 < 4; ++q4) csn[q4] = cs[q4];
    }
#pragma unroll 1
    for (int mt = 0; mt < 4; ++mt) {
        const int q0 = i0 + mt * 16;
        const u32x4 q0r = qn0, q1r = qn1; f32x4 csc[4];
#pragma unroll
        for (int q4 = 0; q4 < 4; ++q4) csc[q4] = csn[q4];
        {
            const int mn = mt < 3 ? mt + 1 : 3;
            const int t = qb * 128 + i0 + mn * 16 + fr;
            const bf16_t* qr = XU + (unsigned)(seq0 + t) * NIN + C_CQ + hq * 64;
            qn0 = *(const u32x4*)(qr + fq * 8); qn1 = *(const u32x4*)(qr + 32 + fq * 8);
            const f32x4* cs = (const f32x4*)(XROPE + ((size_t)t * 32 + fq * 8) * 2);
#pragma unroll
            for (int q4 = 0; q4 < 4; ++q4) csn[q4] = cs[q4];
        }
        bf16x8 a0, a1;
        {
            float x1[8], x2[8]; unpack8(q0r, x1); unpack8(q1r, x2);
            float ss = 0.f;
#pragma unroll
            for (int jj = 0; jj < 8; ++jj) ss += x1[jj] * x1[jj] + x2[jj] * x2[jj];
            ss += __shfl_xor(ss, 16); ss += __shfl_xor(ss, 32);
            const float rs = rsqrtf(ss * (1.f / 64.f) + EPS) * 0.125f;
            float o1[8], o2[8];
#pragma unroll
            for (int jj = 0; jj < 8; ++jj) {
                const float a = x1[jj] * rs * qw1[jj], b = x2[jj] * rs * qw2[jj], co = csc[jj >> 1][(jj & 1) * 2], si = csc[jj >> 1][(jj & 1) * 2 + 1];
                o1[jj] = a * co - b * si; o2[jj] = b * co + a * si;
            }
            a0 = as_frag(pack8(o1)); a1 = as_frag(pack8(o2));
        }
        const int tlo = q0 >> 4;
        const int qi = q0 + fr;
        const int dlo = qb > 0 ? 1 : (128 - qi > 1 ? 128 - qi : 1);
        f32x4 s[16];
        float mx = -3.0e38f;
#pragma unroll
        for (int ntl = 0; ntl < 16; ++ntl) {
            if (ntl >= tlo && ntl <= tlo + 8) {
                f32x4 acc = {0.f, 0.f, 0.f, 0.f};
                acc = mfma16(lds_frag(Kn, 16 * ntl + fr, fq * 8, 72), a0, acc);
                acc = mfma16(lds_frag(Kn, 16 * ntl + fr, 32 + fq * 8, 72), a1, acc);
                if (ntl == tlo || ntl == tlo + 8 || qb == 0) {
#pragma unroll
                    for (int ii = 0; ii < 4; ++ii) {
                        const int dk = 16 * ntl + 4 * fq + ii - qi;
                        acc[ii] = ((unsigned)(dk - dlo) <= (unsigned)(128 - dlo)) ? acc[ii] : -3.0e38f;
                    }
                }
                mx = fmaxf(mx, fmaxf(fmaxf(acc[0], acc[1]), fmaxf(acc[2], acc[3])));
                s[ntl] = acc;
            }
        }
        mx = fmaxf(mx, __shfl_xor(mx, 16)); mx = fmaxf(mx, __shfl_xor(mx, 32));
        mx = fmaxf(mx, sink);
        float sum = 0.f;
#pragma unroll
        for (int ntl = 0; ntl < 16; ++ntl) {
            if (ntl >= tlo && ntl <= tlo + 8) {
#pragma unroll
                for (int ii = 0; ii < 4; ++ii) { const float e = __expf(s[ntl][ii] - mx); s[ntl][ii] = e; sum += e; }
            }
        }
        sum += __shfl_xor(sum, 16); sum += __shfl_xor(sum, 32);
        const float inv = rcpf_(sum + __expf(sink - mx));
        const int klo = q0 >> 5, khi = (q0 + 143) >> 5;
#pragma unroll
        for (int ntl = 0; ntl < 16; ++ntl) {
            if (ntl >= tlo && ntl <= tlo + 8) {
                u32x2 w; w[0] = pk2(s[ntl][0] * inv, s[ntl][1] * inv); w[1] = pk2(s[ntl][2] * inv, s[ntl][3] * inv);
                *(LAS u32x2*)(Pw + ((fr * 264 + 16 * ntl + 4 * fq) << 1)) = w;
            } else if ((ntl >> 1) >= klo && (ntl >> 1) <= khi) {
                u32x2 w = {0u, 0u};
                *(LAS u32x2*)(Pw + ((fr * 264 + 16 * ntl + 4 * fq) << 1)) = w;
            }
        }
        u32x2 czv[4];
#pragma unroll
        for (int ntl = 0; ntl < 4; ++ntl) czv[ntl] = *(const u32x2*)(XU + ((unsigned)seq0 + qb * 128 + q0 + fr) * NIN + C_CZ + hq * 64 + 16 * ntl + 4 * fq);
        LDS_FENCE();
        f32x4 o[4];
#pragma unroll
        for (int ntl = 0; ntl < 4; ++ntl) o[ntl] = (f32x4){0.f, 0.f, 0.f, 0.f};
#pragma unroll
        for (int kk = 0; kk < 8; ++kk) {
            if (kk >= klo && kk <= khi) {
                const bf16x8 a = lds_frag(Pw, fr, kk * 32 + fq * 8, 264);
#pragma unroll
                for (int ntl = 0; ntl < 4; ++ntl) o[ntl] = mfma16(lds_frag(Vt, 16 * ntl + fr, kk * 32 + fq * 8, 264), a, o[ntl]);
            }
        }
        LDS_FENCE();
        {
            const unsigned row = (unsigned)seq0 + qb * 128 + q0 + fr;
#pragma unroll
            for (int ntl = 0; ntl < 4; ++ntl) {
                const float z0 = __uint_as_float(czv[ntl][0] << 16), z1 = __uint_as_float(czv[ntl][0] & 0xffff0000u), z2 = __uint_as_float(czv[ntl][1] << 16), z3 = __uint_as_float(czv[ntl][1] & 0xffff0000u);
                u32x2 w; w[0] = pk2(o[ntl][0] * siluf_(z0), o[ntl][1] * siluf_(z1)); w[1] = pk2(o[ntl][2] * siluf_(z2), o[ntl][3] * siluf_(z3));
                *(u32x2*)(XMIX + row * DMIX + 1024 + hq * 64 + 16 * ntl + 4 * fq) = w;
            }
        }
    }
    __syncthreads();
}

__device__ __forceinline__ void sample_task(lptr lds, const Ctx& X, int l, int b, int part, int tid) {
    LAS float* uf = (LAS float*)lds;
    LAS float* xbc = (LAS float*)(lds + 19968);
    LAS float* numv = (LAS float*)(lds + 24064);
    LAS float* yv = (LAS float*)(lds + 26112);
    LAS float* red = (LAS float*)(lds + 28160);
    LAS float* qs = (LAS float*)(lds + 28416);
    LAS float* kn = (LAS float*)(lds + 30464);
    LAS float* sc = (LAS float*)(lds + 30976);
    const int lane = tid & 63, wave = tid >> 6;
    const size_t row = (size_t)TP + b;
    const bf16_t* ur = XU + row * NIN;
    const size_t lb = (size_t)l * 128 + b;
    f32x4 kpre[8], vpre[8];
    if (part == 2) {
        const float* kc = X.ck + lb * 16384; const float* vc = X.cv + lb * 16384;
#pragma unroll
        for (int it = 0; it < 8; ++it) {
            const int e = (tid + it * NT) * 4, e2 = e < 127 * 128 ? e + 128 : e;
            kpre[it] = __builtin_nontemporal_load((const f32x4*)(kc + e2)); vpre[it] = __builtin_nontemporal_load((const f32x4*)(vc + e2));
        }
    }
    {
        const int c_lo = part == 0 ? 0 : (part == 1 ? C_BZ : C_CQ), c_hi = part == 0 ? C_BZ : (part == 1 ? C_CQ : DIN);
#pragma unroll 2
        for (int i = c_lo + tid; i < c_hi; i += NT) uf[i] = bf2f(ur[i]);
    }
    __syncthreads();
    if (part == 0) {
#pragma unroll
    for (int h = 0; h < 4; ++h) {
        const float ig = uf[C_AI + h] + XPAR(P_AIB)[l * 4 + h], fg = uf[C_AF + h] + XPAR(P_AFB)[l * 4 + h];
        const float ls = logsigf_(fg), m0 = X.stM[lb * 4 + h];
        const float mn = fmaxf(ls + m0, ig), sp = __expf(ls + m0 - mn), sl = __expf(ig - mn);
        const float* C0 = X.stC + (lb * 4 + h) * 8192; float* C1 = X.out + O_SC + (lb * 4 + h) * 8192;
#pragma unroll
        for (int it = 0; it < 4; ++it) {
            const int e = (tid + it * NT) * 4, v = e >> 6, k = e & 63;
            const f32x4 c0 = __builtin_nontemporal_load((const f32x4*)(C0 + e));
            const float vv = uf[C_AV + h * 128 + v] * sl;
            f32x4 c1; float part = 0.f;
#pragma unroll
            for (int j = 0; j < 4; ++j) { c1[j] = sp * c0[j] + vv * (uf[C_AK + h * 64 + k + j] * 0.125f); part += c1[j] * uf[C_AQ + h * 64 + k + j]; }
            __builtin_nontemporal_store(c1, (f32x4*)(C1 + e));
            part = red16(part);
            if ((lane & 15) == 0) numv[h * 128 + v] = part;
        }
        if (wave == 0) {
            const float n1 = sp * X.stN[(lb * 4 + h) * 64 + lane] + sl * uf[C_AK + h * 64 + lane] * 0.125f;
            X.out[O_SN + (lb * 4 + h) * 64 + lane] = n1;
            const float dd = wave_sum(n1 * uf[C_AQ + h * 64 + lane]);
            if (lane == 0) { red[h] = dd; red[4 + h] = mn; X.out[O_SM + lb * 4 + h] = mn; }
        }
    }
    __syncthreads();
    float hv;
    { const int h = tid >> 7; hv = numv[tid] * rcpf_(fmaxf(fabsf(red[h]), __expf(-red[4 + h]))); const float ss = wave_sum(hv * hv); if (lane == 0) red[8 + wave] = ss; }
    __syncthreads();
    { const int h = tid >> 7; const float rs = rsqrtf((red[8 + 2 * h] + red[9 + 2 * h]) * (1.f / 128.f) + EPS);
      XMIX[row * DMIX + tid] = (bf16_t)f2bf(hv * rs * XPAR(P_ANW)[l * 512 + tid] * sigmoidf_(uf[C_AO + tid]) * siluf_(uf[C_AZ + tid])); }
    }
    if (part == 1) {
    {
        const float* buf = X.conv + lb * 3 * 1024; float* oc = X.out + O_SCONV + lb * 3 * 1024;
        const float* cw = XPAR(P_CW) + l * 4096;
#pragma unroll
        for (int it = 0; it < 2; ++it) {
            const int ch = tid + it * NT;
            const float f0 = buf[ch], f1 = buf[1024 + ch], f2 = buf[2048 + ch], f3 = uf[C_BX + ch];
            const float acc = XPAR(P_CB)[l * 1024 + ch] + f0 * cw[ch] + f1 * cw[1024 + ch] + f2 * cw[2048 + ch] + f3 * cw[3072 + ch];
            xbc[ch] = siluf_(acc);
            oc[ch] = f1; oc[1024 + ch] = f2; oc[2048 + ch] = f3;
        }
    }
    __syncthreads();
#pragma unroll 4
    for (int hh = 0; hh < 8; ++hh) {
        const float dt = softplusf_(uf[C_BDT + hh] + XPAR(P_DTB)[l * 8 + hh]);
        const float dA = __expf(-dt * __expf(XPAR(P_ALOG)[l * 8 + hh]));
        const int g = hh >> 2;
        const float* h0p = X.ssm + (lb * 8 + hh) * 8192; float* h1p = X.out + O_SH + (lb * 8 + hh) * 8192;
#pragma unroll
        for (int it = 0; it < 4; ++it) {
            const int e = (tid + it * NT) * 4, p = e >> 7, s = e & 127;
            const f32x4 h0 = __builtin_nontemporal_load((const f32x4*)(h0p + e));
            const float xv = xbc[hh * 64 + p] * dt;
            f32x4 h1; float part = 0.f;
#pragma unroll
            for (int j = 0; j < 4; ++j) { h1[j] = dA * h0[j] + xv * xbc[512 + g * 128 + s + j]; part += h1[j] * xbc[768 + g * 128 + s + j]; }
            __builtin_nontemporal_store(h1, (f32x4*)(h1p + e));
            part = red16(part); part += __shfl_xor(part, 16);
            if ((lane & 31) == 0) yv[hh * 64 + p] = part;
        }
    }
    __syncthreads();
    float gb;
    { const int hh = tid >> 6; const float y = yv[tid] + XPAR(P_BD)[l * 8 + hh] * xbc[tid]; gb = y * siluf_(uf[C_BZ + tid]); const float ss = wave_sum(gb * gb); if (lane == 0) red[16 + wave] = ss; }
    __syncthreads();
    { const int g = tid >> 8; const float rs = rsqrtf((red[16 + 4 * g] + red[17 + 4 * g] + red[18 + 4 * g] + red[19 + 4 * g]) * (1.f / 256.f) + EPS);
      XMIX[row * DMIX + 512 + tid] = (bf16_t)f2bf(gb * rs * XPAR(P_BNW)[l * 512 + tid]); }
    }
    if (part == 2) {
    lptr Kl = lds + 36864;
    lptr Vl = lds + 36864 + 34816;
    if (tid < 320) {
        const int vec = tid >> 5, d = tid & 31, base = vec < 8 ? C_CQ + vec * 64 : C_CK + (vec - 8) * 64;
        const float x1 = uf[base + d], x2 = uf[base + 32 + d];
        float ss = x1 * x1 + x2 * x2; ss = red16(ss); ss += __shfl_xor(ss, 16);
        const float rs = rsqrtf(ss * (1.f / 64.f) + EPS);
        const float* w = vec < 8 ? XPAR(P_QNW) + l * 64 : XPAR(P_KNW) + l * 64;
        const float a = x1 * rs * w[d], bb = x2 * rs * w[d + 32];
        const float co = XROPE[((size_t)8192 * 32 + d) * 2], si = XROPE[((size_t)8192 * 32 + d) * 2 + 1];
        const float o1 = a * co - bb * si, o2 = bb * co + a * si;
        if (vec < 8) { qs[vec * 64 + d] = o1 * 0.125f; qs[vec * 64 + 32 + d] = o2 * 0.125f; } else { kn[(vec - 8) * 64 + d] = o1; kn[(vec - 8) * 64 + 32 + d] = o2; }
    }
    __syncthreads();
    {
        float* ko = X.out + O_SK + lb * 16384; float* vo = X.out + O_SV + lb * 16384;
#pragma unroll
        for (int it = 0; it < 8; ++it) {
            const int e = (tid + it * NT) * 4, j = e >> 7, r = e & 127;
            f32x4 kv = kpre[it], vv = vpre[it];
            if (j == 127) { kv = (f32x4){kn[r], kn[r + 1], kn[r + 2], kn[r + 3]}; vv = (f32x4){uf[C_CV + r], uf[C_CV + r + 1], uf[C_CV + r + 2], uf[C_CV + r + 3]}; }
            __builtin_nontemporal_store(kv, (f32x4*)(ko + e)); __builtin_nontemporal_store(vv, (f32x4*)(vo + e));
            u32x2 wk, wv2; wk[0] = pk2(kv[0], kv[1]); wk[1] = pk2(kv[2], kv[3]); wv2[0] = pk2(vv[0], vv[1]); wv2[1] = pk2(vv[2], vv[3]);
            *(LAS u32x2*)(Kl + ((j * 136 + r) << 1)) = wk; *(LAS u32x2*)(Vl + ((j * 136 + r) << 1)) = wv2;
        }
    }
    __syncthreads();
    if (tid < 256) {
        const int kvh = tid >> 7, jj = tid & 127;
        float s0 = 0.f, s1 = 0.f, s2 = 0.f, s3 = 0.f;
#pragma unroll 2
        for (int d8 = 0; d8 < 8; ++d8) {
            float kf[8]; unpack8(*(const LAS u32x4*)(Kl + ((jj * 136 + kvh * 64 + d8 * 8) << 1)), kf);
#pragma unroll
            for (int j = 0; j < 8; ++j) {
                s0 += kf[j] * qs[(kvh * 4 + 0) * 64 + d8 * 8 + j]; s1 += kf[j] * qs[(kvh * 4 + 1) * 64 + d8 * 8 + j];
                s2 += kf[j] * qs[(kvh * 4 + 2) * 64 + d8 * 8 + j]; s3 += kf[j] * qs[(kvh * 4 + 3) * 64 + d8 * 8 + j];
            }
        }
        sc[(kvh * 4 + 0) * 128 + jj] = s0; sc[(kvh * 4 + 1) * 128 + jj] = s1; sc[(kvh * 4 + 2) * 128 + jj] = s2; sc[(kvh * 4 + 3) * 128 + jj] = s3;
    }
    __syncthreads();
    {
        const int hq = wave; const float s0 = sc[hq * 128 + lane], s1 = sc[hq * 128 + 64 + lane], sink = XPAR(P_SINK)[l * 8 + hq];
        const float m = fmaxf(wave_max(fmaxf(s0, s1)), sink);
        const float e0 = __expf(s0 - m), e1 = __expf(s1 - m);
        const float inv = rcpf_(wave_sum(e0 + e1) + __expf(sink - m));
        sc[hq * 128 + lane] = e0 * inv; sc[hq * 128 + 64 + lane] = e1 * inv;
    }
    __syncthreads();
    {
        const int hq = tid >> 6, d = tid & 63, kvh = hq >> 2;
        float o = 0.f;
#pragma unroll 16
        for (int jj = 0; jj < 128; ++jj) o += sc[hq * 128 + jj] * bf2f(*(const LAS bf16_t*)(Vl + ((jj * 136 + kvh * 64 + d) << 1)));
        XMIX[row * DMIX + 1024 + tid] = (bf16_t)f2bf(o * siluf_(uf[C_CZ + tid]));
    }
    }
    __syncthreads();
}

__device__ __forceinline__ void scans(const Ctx& X, int l, int gt, int nthreads) {
    for (int item = gt; item < 98816; item += nthreads) {
        if (item < 32768) {
            const int nh = item >> 12, e = (item & 4095) * 2;
            const bf16_t* base = (const bf16_t*)XMC + (size_t)nh * 128 * 8192 + e;
            const float* ml = XML + nh * 128; const float* bl = XBL + nh * 128;
            float m = 0.f; f32x2 st = {0.f, 0.f};
            for (int c0 = 0; c0 < 128; c0 += 16) {
                f32x2 cl[16];
#pragma unroll
                for (int j = 0; j < 16; ++j) { const unsigned w = *(const unsigned*)(base + (size_t)(c0 + j) * 8192); cl[j] = (f32x2){__uint_as_float(w << 16), __uint_as_float(w & 0xffff0000u)}; }
#pragma unroll
                for (int j = 0; j < 16; ++j) {
                    const float mlj = ml[c0 + j], blj = bl[c0 + j], mn = fmaxf(blj + m, mlj), sp = __expf(blj + m - mn), sl = __expf(mlj - mn);
                    *(unsigned*)(XCSB + ((size_t)nh * 128 + c0 + j) * 8192 + e) = pk2(st[0], st[1]);
                    if (e == 0) XMS[nh * 128 + c0 + j] = m;
                    st = st * sp + cl[j] * sl; m = mn;
                }
            }
            *(f32x2*)(X.out + O_PC + ((size_t)l * 8 + nh) * 8192 + e) = st;
            if (e == 0) X.out[O_PM + l * 8 + nh] = m;
        } else if (item < 98304) {
            const int i1 = item - 32768, nhh = i1 >> 12, e = (i1 & 4095) * 2;
            const bf16_t* base = (const bf16_t*)XSH + (size_t)nhh * 128 * 8192 + e;
            const float* al = XSA + nhh * 128;
            f32x2 st = {0.f, 0.f};
            for (int c0 = 0; c0 < 128; c0 += 16) {
                f32x2 cl[16];
#pragma unroll
                for (int j = 0; j < 16; ++j) { const unsigned w = *(const unsigned*)(base + (size_t)(c0 + j) * 8192); cl[j] = (f32x2){__uint_as_float(w << 16), __uint_as_float(w & 0xffff0000u)}; }
#pragma unroll
                for (int j = 0; j < 16; ++j) {
                    const float dec = __expf(al[c0 + j]);
                    *(unsigned*)(XHSB + ((size_t)nhh * 128 + c0 + j) * 8192 + e) = pk2(st[0], st[1]);
                    st = st * dec + cl[j];
                }
            }
            *(f32x2*)(X.out + O_PH + ((size_t)l * 16 + nhh) * 8192 + e) = st;
        } else {
            const int i2 = item - 98304, nh = i2 >> 6, k = i2 & 63;
            float* base = XMN + (size_t)nh * 128 * 64 + k;
            const float* ml = XML + nh * 128; const float* bl = XBL + nh * 128;
            float m = 0.f, st = 0.f;
            for (int c = 0; c < 128; ++c) {
                const float mlj = ml[c], blj = bl[c], mn = fmaxf(blj + m, mlj), sp = __expf(blj + m - mn), sl = __expf(mlj - mn);
                const float cl = base[c * 64];
                XNS[(size_t)nh * 128 * 64 + c * 64 + k] = st;
                st = st * sp + cl * sl; m = mn;
            }
            X.out[O_PN + ((size_t)l * 8 + nh) * 64 + k] = st;
        }
    }
}

__device__ __forceinline__ void mlstm_out(lptr lds, const Ctx& X, int l, int task, int tid) {
    const int h = task & 3, c = (task >> 2) & 127, n = task >> 9;
    const int lane = tid & 63, wave = tid >> 6, fr = lane & 15, fq = lane >> 4;
    const int row0 = n * SEQ + c * 64, nh = n * 4 + h;
    lptr Qs = lds;
    lptr Ks = lds + 9216;
    lptr Vt = lds + 18432;
    lptr Sb = lds + 36864 + wave * 2304;
    LAS float* bv = (LAS float*)(lds + 55296);
    LAS float* dv = bv + 64;
    LAS float* mtv = bv + 128;
    LAS float* siv = bv + 192;
    LAS float* qnv = bv + 256;
    LAS float* ssqp = bv + 384;
    LAS float* nsv = bv + 512;
    const int mti = wave >> 1, half = wave & 1;
    u32x4 csf[2][4];
    {
        const bf16_t* Cs = XCSB + ((size_t)nh * 128 + c) * 8192;
#pragma unroll
        for (int kk = 0; kk < 2; ++kk)
#pragma unroll
            for (int ntl = 0; ntl < 4; ++ntl) csf[kk][ntl] = *(const u32x4*)(Cs + (64 * half + 16 * ntl + fr) * 64 + kk * 32 + fq * 8);
    }
    u32x2 aov[4], azv[4]; f32x4 anw[4];
#pragma unroll
    for (int ntl = 0; ntl < 4; ++ntl) {
        const int v = h * 128 + 64 * half + 16 * ntl + 4 * fq;
        const unsigned row = (unsigned)row0 + 16 * mti + fr;
        anw[ntl] = *(const f32x4*)(XPAR(P_ANW) + l * 512 + v);
        aov[ntl] = *(const u32x2*)(XU + row * NIN + C_AO + v); azv[ntl] = *(const u32x2*)(XU + row * NIN + C_AZ + v);
    }
    u32x4 qraw, kraw, vblk[8];
    const int tgv = lane & 7, cgv = (wave & 1) * 8 + (lane >> 3);
    {
        const int tok = tid >> 3, k8 = (tid & 7) * 8;
        const bf16_t* ur = XU + (unsigned)(row0 + tok) * NIN;
        qraw = *(const u32x4*)(ur + C_AQ + h * 64 + k8); kraw = *(const u32x4*)(ur + C_AK + h * 64 + k8);
        if (wave == 2 || wave == 3) {
#pragma unroll
            for (int t = 0; t < 8; ++t) vblk[t] = *(const u32x4*)(XU + (unsigned)(row0 + 8 * tgv + t) * NIN + C_AV + h * 128 + cgv * 8);
        }
    }
    if (wave == 0) {
        const bf16_t* ur = XU + (unsigned)(row0 + lane) * NIN;
        const float fg = bf2f(ur[C_AF + h]) + XPAR(P_AFB)[l * 4 + h], ig = bf2f(ur[C_AI + h]) + XPAR(P_AIB)[l * 4 + h];
        const float b = wave_scan_sum(logsigf_(fg), lane);
        const float dd = ig - b;
        const float cm = wave_scan_max(dd, lane);
        const float ms = XMS[nh * 128 + c];
        const float mt = b + fmaxf(ms, cm);
        bv[lane] = b; dv[lane] = dd; mtv[lane] = mt; siv[lane] = __expf(b + ms - mt);
        nsv[lane] = XNS[((size_t)nh * 128 + c) * 64 + lane];
    }
    {
        const int tok = tid >> 3, k8 = (tid & 7) * 8;
        *(LAS u32x4*)(Qs + ((tok * 72 + k8) << 1)) = qraw;
        float x[8]; unpack8(kraw, x);
#pragma unroll
        for (int j = 0; j < 8; ++j) x[j] *= 0.125f;
        *(LAS u32x4*)(Ks + ((tok * 72 + k8) << 1)) = pack8(x);
    }
    if (wave == 2 || wave == 3) {
#pragma unroll
        for (int j = 0; j < 8; ++j) {
            u32x4 w;
#pragma unroll
            for (int tp = 0; tp < 4; ++tp) {
                const unsigned lo = (vblk[2 * tp][j >> 1] >> ((j & 1) * 16)) & 0xffffu, hi = (vblk[2 * tp + 1][j >> 1] >> ((j & 1) * 16)) & 0xffffu;
                w[tp] = lo | (hi << 16);
            }
            *(LAS u32x4*)(Vt + (((cgv * 8 + j) * 72 + 8 * tgv) << 1)) = w;
        }
    }
    __syncthreads();
    bf16x8 qa[2];
    qa[0] = lds_frag(Qs, 16 * mti + fr, fq * 8, 72); qa[1] = lds_frag(Qs, 16 * mti + fr, 32 + fq * 8, 72);
    const int tq = 16 * mti + fr;
    float qn;
    {
        float x0[8], x1[8]; unpack8(__builtin_bit_cast(u32x4, qa[0]), x0); unpack8(__builtin_bit_cast(u32x4, qa[1]), x1);
        float d = 0.f;
#pragma unroll
        for (int j = 0; j < 8; ++j) d += x0[j] * nsv[fq * 8 + j] + x1[j] * nsv[32 + fq * 8 + j];
        d += __shfl_xor(d, 16); d += __shfl_xor(d, 32);
        qn = d;
    }
    const float bt = bv[tq], mtq = mtv[tq], siq = siv[tq];
    float rsum = 0.f;
#pragma unroll
    for (int ntl = 0; ntl < 4; ++ntl) {
        f32x4 sT = {0.f, 0.f, 0.f, 0.f};
        sT = mfma16(lds_frag(Ks, 16 * ntl + fr, fq * 8, 72), qa[0], sT);
        sT = mfma16(lds_frag(Ks, 16 * ntl + fr, 32 + fq * 8, 72), qa[1], sT);
        float sv[4];
#pragma unroll
        for (int ii = 0; ii < 4; ++ii) {
            const int sidx = 16 * ntl + 4 * fq + ii;
            const float wgt = (sidx <= tq) ? __expf(bt + dv[sidx] - mtq) : 0.f;
            sv[ii] = wgt * sT[ii];
            rsum += sv[ii];
        }
        u32x2 w; w[0] = pk2(sv[0], sv[1]); w[1] = pk2(sv[2], sv[3]);
        *(LAS u32x2*)(Sb + ((fr * 72 + 16 * ntl + 4 * fq) << 1)) = w;
    }
    rsum += __shfl_xor(rsum, 16); rsum += __shfl_xor(rsum, 32);
    const float inv = rcpf_(fmaxf(fabsf(rsum + siq * qn), __expf(-mtq)));
    LDS_FENCE();
    f32x4 acc[4];
#pragma unroll
    for (int ntl = 0; ntl < 4; ++ntl) acc[ntl] = (f32x4){0.f, 0.f, 0.f, 0.f};
#pragma unroll
    for (int kk = 0; kk < 2; ++kk) {
        const bf16x8 sb = lds_frag(Sb, fr, kk * 32 + fq * 8, 72);
#pragma unroll
        for (int ntl = 0; ntl < 4; ++ntl) acc[ntl] = mfma16(lds_frag(Vt, 64 * half + 16 * ntl + fr, kk * 32 + fq * 8, 72), sb, acc[ntl]);
    }
#pragma unroll
    for (int kk = 0; kk < 2; ++kk) {
        float x[8]; unpack8(__builtin_bit_cast(u32x4, qa[kk]), x);
#pragma unroll
        for (int j = 0; j < 8; ++j) x[j] *= siq;
        const bf16x8 qs = as_frag(pack8(x));
#pragma unroll
        for (int ntl = 0; ntl < 4; ++ntl) acc[ntl] = mfma16(as_frag(csf[kk][ntl]), qs, acc[ntl]);
    }
    {
        float ss = 0.f;
#pragma unroll
        for (int ntl = 0; ntl < 4; ++ntl) { acc[ntl] = acc[ntl] * inv; ss += acc[ntl][0] * acc[ntl][0] + acc[ntl][1] * acc[ntl][1] + acc[ntl][2] * acc[ntl][2] + acc[ntl][3] * acc[ntl][3]; }
        ss += __shfl_xor(ss, 16); ss += __shfl_xor(ss, 32);
        if (fq == 0) ssqp[tq * 2 + half] = ss;
    }
    __syncthreads();
    {
        const float rs = rsqrtf((ssqp[tq * 2] + ssqp[tq * 2 + 1]) * (1.f / 128.f) + EPS);
        const unsigned row = (unsigned)row0 + tq;
#pragma unroll
        for (int ntl = 0; ntl < 4; ++ntl) {
            const float o[4] = {__uint_as_float(aov[ntl][0] << 16), __uint_as_float(aov[ntl][0] & 0xffff0000u), __uint_as_float(aov[ntl][1] << 16), __uint_as_float(aov[ntl][1] & 0xffff0000u)};
            const float z[4] = {__uint_as_float(azv[ntl][0] << 16), __uint_as_float(azv[ntl][0] & 0xffff0000u), __uint_as_float(azv[ntl][1] << 16), __uint_as_float(azv[ntl][1] & 0xffff0000u)};
            float y[4];
#pragma unroll
            for (int ii = 0; ii < 4; ++ii) y[ii] = acc[ntl][ii] * rs * anw[ntl][ii] * sigmoidf_(o[ii]) * siluf_(z[ii]);
            u32x2 w; w[0] = pk2(y[0], y[1]); w[1] = pk2(y[2], y[3]);
            *(u32x2*)(XMIX + row * DMIX + h * 128 + 64 * half + 16 * ntl + 4 * fq) = w;
        }
    }
    __syncthreads();
}

__device__ __forceinline__ void ssd_out(lptr lds, const Ctx& X, int l, int task, int tid) {
    const int g = task & 1, c = (task >> 1) & 127, n = task >> 8;
    const int lane = tid & 63, wave = tid >> 6, fr = lane & 15, fq = lane >> 4;
    const int seq0 = n * SEQ, row0 = seq0 + c * 64;
    lptr Cm = lds;
    lptr Bm = lds + 17408;
    lptr Xt = lds + 34816;
    LAS float* CBf = (LAS float*)(lds + 71680);
    LAS float* av = (LAS float*)(lds + 89088);
    LAS float* dtv = (LAS float*)(lds + 90112);
    LAS float* ssq = (LAS float*)(lds + 91136);
    const int hl = wave >> 1, th = wave & 1, hh = 4 * g + hl;
    u32x4 hsf[4][4];
    {
        const bf16_t* hs = XHSB + ((size_t)(n * 8 + hh) * 128 + c) * 8192;
#pragma unroll
        for (int kk = 0; kk < 4; ++kk)
#pragma unroll
            for (int ntl = 0; ntl < 4; ++ntl) hsf[kk][ntl] = *(const u32x4*)(hs + (16 * ntl + fr) * 128 + kk * 32 + fq * 8);
    }
    if (wave < 4) {
        const int hh = 4 * g + wave;
        const float dt = softplusf_(bf2f(XU[(unsigned)(row0 + lane) * NIN + C_BDT + hh]) + XPAR(P_DTB)[l * 8 + hh]);
        const float A = -__expf(XPAR(P_ALOG)[l * 8 + hh]);
        av[wave * 64 + lane] = wave_scan_sum(dt * A, lane);
        dtv[wave * 64 + lane] = dt;
    }
    {
        const float* cw = XPAR(P_CW) + l * 4096; const float* cb = XPAR(P_CB) + l * 1024;
        float o[8][8];
        if (wave < 4) {
            const int tg = lane & 7, cg = wave * 8 + (lane >> 3);
            conv8x8(XU, seq0, c * 64 + 8 * tg, g * 256 + cg * 8, cw, cb, o);
#pragma unroll
            for (int jx = 0; jx < 8; ++jx) {
                float v[8];
#pragma unroll
                for (int t = 0; t < 8; ++t) v[t] = o[t][jx];
                *(LAS u32x4*)(Xt + (((cg * 8 + jx) * 72 + 8 * tg) << 1)) = pack8(v);
            }
        } else {
            const int tg = lane >> 3, s8 = ((wave & 1) * 8 + (lane & 7)) * 8;
            conv8x8(XU, seq0, c * 64 + 8 * tg, (wave < 6 ? 512 : 768) + g * 128 + s8, cw, cb, o);
            lptr dstm = wave < 6 ? Bm : Cm;
#pragma unroll
            for (int t = 0; t < 8; ++t) *(LAS u32x4*)(dstm + (((8 * tg + t) * 136 + s8) << 1)) = pack8(o[t]);
        }
    }
    __syncthreads();
    u32x2 bzv[2][4]; f32x4 bnw[4];
#pragma unroll
    for (int ntl = 0; ntl < 4; ++ntl) {
        bnw[ntl] = *(const f32x4*)(XPAR(P_BNW) + l * 512 + hh * 64 + 16 * ntl + 4 * fq);
#pragma unroll
        for (int mi = 0; mi < 2; ++mi) bzv[mi][ntl] = *(const u32x2*)(XU + ((unsigned)row0 + 16 * (2 * th + mi) + fr) * NIN + C_BZ + hh * 64 + 16 * ntl + 4 * fq);
    }
    {
        const int mt = wave >> 1;
#pragma unroll
        for (int q = 0; q < 2; ++q) {
            const int ntl = 2 * (wave & 1) + q;
            f32x4 acc = {0.f, 0.f, 0.f, 0.f};
#pragma unroll
            for (int kk = 0; kk < 4; ++kk) acc = mfma16(lds_frag(Cm, 16 * mt + fr, kk * 32 + fq * 8, 136), lds_frag(Bm, 16 * ntl + fr, kk * 32 + fq * 8, 136), acc);
#pragma unroll
            for (int ii = 0; ii < 4; ++ii) CBf[(16 * mt + fq * 4 + ii) * 68 + 16 * ntl + fr] = acc[ii];
        }
    }
    __syncthreads();
    f32x4 y1[2][4], y2[2][4];
#pragma unroll
    for (int mi = 0; mi < 2; ++mi)
#pragma unroll
        for (int ntl = 0; ntl < 4; ++ntl) { y1[mi][ntl] = (f32x4){0.f, 0.f, 0.f, 0.f}; y2[mi][ntl] = (f32x4){0.f, 0.f, 0.f, 0.f}; }
#pragma unroll
    for (int kk = 0; kk < 2; ++kk) {
        bf16x8 bx[4];
#pragma unroll
        for (int ntl = 0; ntl < 4; ++ntl) bx[ntl] = lds_frag(Xt, hl * 64 + 16 * ntl + fr, kk * 32 + fq * 8, 72);
#pragma unroll
        for (int mi = 0; mi < 2; ++mi) {
            const int t = 16 * (2 * th + mi) + fr, u0 = kk * 32 + fq * 8;
            const float at = av[hl * 64 + t];
            float w[8];
#pragma unroll
            for (int j = 0; j < 8; ++j) {
                const int uu = u0 + j;
                w[j] = (uu <= t) ? CBf[t * 68 + uu] * __expf(at - av[hl * 64 + uu]) * dtv[hl * 64 + uu] : 0.f;
            }
            const bf16x8 a = as_frag(pack8(w));
#pragma unroll
            for (int ntl = 0; ntl < 4; ++ntl) y1[mi][ntl] = mfma16(bx[ntl], a, y1[mi][ntl]);
        }
    }
    {
#pragma unroll
        for (int kk = 0; kk < 4; ++kk) {
            bf16x8 bh[4];
#pragma unroll
            for (int ntl = 0; ntl < 4; ++ntl) bh[ntl] = as_frag(hsf[kk][ntl]);
#pragma unroll
            for (int mi = 0; mi < 2; ++mi) {
                const bf16x8 a = lds_frag(Cm, 16 * (2 * th + mi) + fr, kk * 32 + fq * 8, 136);
#pragma unroll
                for (int ntl = 0; ntl < 4; ++ntl) y2[mi][ntl] = mfma16(bh[ntl], a, y2[mi][ntl]);
            }
        }
    }
    const float Dh = XPAR(P_BD)[l * 8 + hh];
#pragma unroll
    for (int mi = 0; mi < 2; ++mi) {
        const int t = 16 * (2 * th + mi) + fr;
        const float ea = __expf(av[hl * 64 + t]);
        float ss = 0.f;
#pragma unroll
        for (int ntl = 0; ntl < 4; ++ntl) {
            const float z[4] = {__uint_as_float(bzv[mi][ntl][0] << 16), __uint_as_float(bzv[mi][ntl][0] & 0xffff0000u), __uint_as_float(bzv[mi][ntl][1] << 16), __uint_as_float(bzv[mi][ntl][1] & 0xffff0000u)};
#pragma unroll
            for (int ii = 0; ii < 4; ++ii) {
                const int p = 16 * ntl + 4 * fq + ii;
                const float xv = bf2f(*(const LAS bf16_t*)(Xt + (((hl * 64 + p) * 72 + t) << 1)));
                const float y = y1[mi][ntl][ii] + ea * y2[mi][ntl][ii] + Dh * xv;
                const float gbv = y * siluf_(z[ii]);
                y1[mi][ntl][ii] = gbv; ss += gbv * gbv;
            }
        }
        ss += __shfl_xor(ss, 16); ss += __shfl_xor(ss, 32);
        if (fq == 0) ssq[t * 4 + hl] = ss;
    }
    __syncthreads();
#pragma unroll
    for (int mi = 0; mi < 2; ++mi) {
        const int t = 16 * (2 * th + mi) + fr;
        const float rs = rsqrtf((ssq[t * 4] + ssq[t * 4 + 1] + ssq[t * 4 + 2] + ssq[t * 4 + 3]) * (1.f / 256.f) + EPS);
        const unsigned row = (unsigned)row0 + t;
#pragma unroll
        for (int ntl = 0; ntl < 4; ++ntl) {
            u32x2 w; w[0] = pk2(y1[mi][ntl][0] * rs * bnw[ntl][0], y1[mi][ntl][1] * rs * bnw[ntl][1]); w[1] = pk2(y1[mi][ntl][2] * rs * bnw[ntl][2], y1[mi][ntl][3] * rs * bnw[ntl][3]);
            *(u32x2*)(XMIX + row * DMIX + 512 + hh * 64 + 16 * ntl + 4 * fq) = w;
        }
    }
    __syncthreads();
}


#define XB_TMO      128
#define XB_XCNT(j)  (256  + 64 * (j))
#define XB_XSUB(j)  (1280 + 64 * (j))
#define XB_XGEN(j)  (2304 + 64 * (j))
#define XB_TOP      3328
#define XB_TOPGEN   3392
#define XCD_BAR_WORDS 3456
#define XB_SPIN_CAP (1u << 18)
__device__ __forceinline__ unsigned xb_ld(unsigned* p)              { return __hip_atomic_load(p, __ATOMIC_RELAXED, __HIP_MEMORY_SCOPE_AGENT); }
__device__ __forceinline__ unsigned xb_add(unsigned* p, unsigned v) { return __hip_atomic_fetch_add(p, v, __ATOMIC_RELAXED, __HIP_MEMORY_SCOPE_AGENT); }
__device__ __forceinline__ unsigned xb_xcc_id() { return (unsigned)__builtin_amdgcn_s_getreg((3 << 11) | 20) & 0xFu; }
#define XB_SPIN(cond, bar) do { unsigned _sp = 0; while (cond) { __builtin_amdgcn_s_sleep(1); \
    if ((++_sp & 255u) == 0u) { if (xb_ld(&(bar)[XB_TMO])) break; if (_sp > XB_SPIN_CAP) { atomicAdd(&(bar)[XB_TMO], 1u); break; } } } } while (0)
struct XcdBarrier { unsigned* bar; unsigned x; volatile LAS unsigned* st; };
__device__ __forceinline__ XcdBarrier xcd_barrier_post(unsigned* bar, volatile LAS unsigned* st) {
    XcdBarrier b; b.bar = bar; b.x = xb_xcc_id(); b.st = st;
    if (threadIdx.x == 0) (void)xb_add(&bar[XB_XCNT(b.x)], 1u);
    return b;
}
__device__ __forceinline__ void xcd_barrier_complete(unsigned* bar, unsigned x, unsigned& nloc, unsigned& nx) {
    const unsigned G = gridDim.x * gridDim.y * gridDim.z;
    unsigned sum, cnt, mine, sp = 0u;
    for (;;) {
        sum = 0u; cnt = 0u; mine = 0u;
#pragma unroll
        for (unsigned j = 0; j < 16; ++j) { const unsigned c = xb_ld(&bar[XB_XCNT(j)]); sum += c; cnt += (c > 0u) ? 1u : 0u; mine = (j == x) ? c : mine; }
        if (sum == G) break;
        __builtin_amdgcn_s_sleep(1);
        if ((++sp & 255u) == 0u) { if (xb_ld(&bar[XB_TMO])) break; if (sp > XB_SPIN_CAP) { atomicAdd(&bar[XB_TMO], 1u); break; } }
    }
    nloc = mine > 0u ? mine : 1u; nx = cnt > 0u ? cnt : 1u;
}
__device__ __forceinline__ void xcd_barrier(const XcdBarrier& b) {
    asm volatile("s_waitcnt vmcnt(0)" ::: "memory");
    __syncthreads();
    if (threadIdx.x == 0) {
        unsigned* bar = b.bar;
        __builtin_amdgcn_s_waitcnt(0);
        unsigned nloc = b.st[0], nx = b.st[1];
        if (nloc == 0u) { xcd_barrier_complete(bar, b.x, nloc, nx); b.st[0] = nloc; b.st[1] = nx; }
        const unsigned old = xb_add(&bar[XB_XSUB(b.x)], 1u);
        const unsigned gen = old / nloc;
        if (old + 1u == (gen + 1u) * nloc) {
            __builtin_amdgcn_fence(__ATOMIC_RELEASE, "agent");
            asm volatile("s_waitcnt vmcnt(0)" ::: "memory");
            const unsigned og = xb_add(&bar[XB_TOP], 1u);
            const unsigned tg = og / nx;
            if (og + 1u == (tg + 1u) * nx) xb_add(&bar[XB_TOPGEN], 1u);
            else XB_SPIN(xb_ld(&bar[XB_TOPGEN]) == tg, bar);
            __builtin_amdgcn_fence(__ATOMIC_ACQUIRE, "agent");
            xb_add(&bar[XB_XGEN(b.x)], 1u);
            asm volatile("s_waitcnt vmcnt(0)" ::: "memory");
        } else {
            XB_SPIN(xb_ld(&bar[XB_XGEN(b.x)]) == gen, bar);
            __builtin_amdgcn_fence(__ATOMIC_ACQUIRE, "agent");
            asm volatile("s_waitcnt vmcnt(0)" ::: "memory");
        }
    }
    __syncthreads();
}

__global__ void __launch_bounds__(NT, 2) mega(Args args) {
    __shared__ __attribute__((aligned(16))) unsigned char lds_raw[LDS_BYTES];
    lptr lds = (lptr)lds_raw;
    cg::grid_group grid = cg::this_grid();
    const int tid = threadIdx.x, bid = blockIdx.x, G = gridDim.x;
    Ctx X;
    X.xp = args.in[IN_XP]; X.xs = args.in[IN_XS]; X.stC = args.in[IN_STC]; X.stN = args.in[IN_STN]; X.stM = args.in[IN_STM]; X.ssm = args.in[IN_SSM];
    X.conv = args.in[IN_CONV]; X.ck = args.in[IN_CK]; X.cv = args.in[IN_CV]; X.out = args.out; X.ws = args.ws;
    const int lo = args.ph_lo, hi = args.ph_hi;
    volatile LAS unsigned* xst = (volatile LAS unsigned*)(lds + LDS_BYTES - 16);
    if (tid == 0) { xst[0] = 0u; xst[1] = 0u; }
    __syncthreads();
    XcdBarrier xbar = xcd_barrier_post((unsigned*)(args.ws + WS_BAR), xst);
#define IN(k) (lo <= (k) && (k) < hi)
#define SEAM(k) do { if (IN(k) && IN((k) + 1)) { for (int _r = 0; _r < REP_SYNC; ++_r) { if (lo < 0) grid.sync(); xcd_barrier(xbar); } } } while (0)
    if (IN(0)) { for (int _r = 0; _r < REP_P0; ++_r) prologue(lds, X, args, G, bid, tid); }
    SEAM(0);
    for (int l = 0; l < 4; ++l) {
        const int pb = 1 + l * 5;
        if (IN(pb)) for (int _r = 0; _r < REP_P1; ++_r) {
            pg8::Gemm g{XXB, XWIN + (size_t)l * NIN * D, MPAD, NIN, D}; pg8::StaticOrder S; S.init(TP, NIN, G, bid);
            pg8::EpiU E{XU, XSSQ};
            pg8::gemm_phase<pg8::EpiU, pg8::StaticOrder, false, GEMM_SP2, GEMM_ALIGN>(lds, g, S, E, OPQ(tid));
            if (l == 0 && bid >= G - 20) {
                pg8::SampleOrder S2{G - 20, 20, bid}; pg8::EpiUh E2{XU, XSSQ};
                pg8::gemm_phase<pg8::EpiUh, pg8::SampleOrder, true>(lds, g, S2, E2, OPQ(tid));
            }
        }
        SEAM(pb);
        if (IN(pb + 1)) for (int _r = 0; _r < REP_P2; ++_r) {
            for (int t = bid; t < 256; t += G) for (int _q = 0; _q < RT_SAMPLE; ++_q) {
                if (t < 128) sample_task(lds, X, l, t, 1, OPQ(tid));
                else { sample_task(lds, X, l, t - 128, 0, OPQ(tid)); sample_task(lds, X, l, t - 128, 2, OPQ(tid)); }
            }
            for (int t = bid; t < 256; t += G) {
                const int tx = (G == 256) ? ((t & 7) >> 2) * 128 + (32 * (t & 1) + (t >> 3)) * 2 + ((t >> 1) & 1) : t;
                for (int _q = 0; _q < RT_SWA; ++_q) swa_prompt(lds, X, l, tx, OPQ(tid));
            }
            for (int t = bid; t < 512; t += G) for (int _q = 0; _q < RT_SLOC; ++_q) ssd_local(lds, X, l, t, OPQ(tid));
            for (int t = bid; t < 1024; t += G) for (int _q = 0; _q < RT_MLOC; ++_q) mlstm_local(lds, X, l, t, OPQ(tid));
            if (bid == G - 1) {
                for (int i = tid; i < 2 * 3 * 1024; i += NT) {
                    const int ch = i & 1023, j = (i >> 10) % 3, n = i / 3072;
                    X.out[O_PCONV + (((size_t)l * 2 + n) * 3 + j) * 1024 + ch] = bf2f(XU[(size_t)(n * SEQ + SEQ - 3 + j) * NIN + C_BX + ch]);
                }
            }
        }
        SEAM(pb + 1);
        if (IN(pb + 2)) {
            if (bid >= G - 4) {
                pg8::Gemm g{XMIX, XWOUT + (size_t)l * D * DMIX, MPAD, D, DMIX}; pg8::SampleOrder S{G - 4, 4, bid};
                if (l == 0) { pg8::EpiRes_<1, 0> E{X.xp, X.xs, X.out, XXB, XSSQ}; pg8::gemm_phase<pg8::EpiRes_<1, 0>, pg8::SampleOrder, true>(lds, g, S, E, OPQ(tid)); }
                else if (l < 3) { pg8::EpiRes_<1, 1> E{X.xp, X.xs, X.out, XXB, XSSQ}; pg8::gemm_phase<pg8::EpiRes_<1, 1>, pg8::SampleOrder, true>(lds, g, S, E, OPQ(tid)); }
                else { pg8::EpiRes_<1, 2> E{X.xp, X.xs, X.out, XXB, XSSQ}; pg8::gemm_phase<pg8::EpiRes_<1, 2>, pg8::SampleOrder, true>(lds, g, S, E, OPQ(tid)); }
            }
            if (l < 3) {
                if (G - 4 - 193 >= 16) { if (bid >= 193 && bid < G - 4) convert_weights(lds, X, args, l + 1, bid - 193, G - 4 - 193, OPQ(tid)); }
                else convert_weights(lds, X, args, l + 1, bid, G, OPQ(tid));
            }
            for (int _r = 0; _r < REP_P3; ++_r) scans(X, l, bid * NT + OPQ(tid), G * NT);
        }
        SEAM(pb + 2);
        if (IN(pb + 3)) for (int _r = 0; _r < REP_P4; ++_r) {
            for (int task = bid; task < 1536; task += G) {
                if (task < 512) for (int _q = 0; _q < RT_SOUT; ++_q) ssd_out(lds, X, l, task, OPQ(tid));
                else mlstm_out(lds, X, l, task - 512, OPQ(tid));
            }
        }
        SEAM(pb + 3);
        if (IN(pb + 4)) {
            {
                pg8::Gemm g{XMIX, XWOUT + (size_t)l * D * DMIX, MPAD, D, DMIX}; pg8::StaticOrder S; S.init(TP, D, G, bid);
#ifdef PROBE_P5
                { pg8::EpiProbe EP{(const unsigned*)(X.ws + 64), XSSQ}; pg8::gemm_phase<pg8::EpiProbe, pg8::StaticOrder, false, GEMM_SP2>(lds, g, S, EP, OPQ(tid)); }
#endif
                if (l == 0) { pg8::EpiRes_<2, 0> E{X.xp, X.xs, X.out, XXB, XSSQ}; pg8::gemm_phase<pg8::EpiRes_<2, 0>, pg8::StaticOrder, false, GEMM_SP2, GEMM_ALIGN>(lds, g, S, E, OPQ(tid)); }
                else if (l < 3) { pg8::EpiRes_<2, 1> E{X.xp, X.xs, X.out, XXB, XSSQ}; pg8::gemm_phase<pg8::EpiRes_<2, 1>, pg8::StaticOrder, false, GEMM_SP2, GEMM_ALIGN>(lds, g, S, E, OPQ(tid)); }
                else { pg8::EpiRes_<2, 2> E{X.xp, X.xs, X.out, XXB, XSSQ}; pg8::gemm_phase<pg8::EpiRes_<2, 2>, pg8::StaticOrder, false, GEMM_SP2, GEMM_ALIGN>(lds, g, S, E, OPQ(tid)); }
            }
            if (l < 3 && bid < 20) {
                pg8::Gemm g{XXB, XWIN + (size_t)(l + 1) * NIN * D, MPAD, NIN, D}; pg8::SampleOrder S{0, 20, bid};
                pg8::EpiUh E{XU, XSSQ};
                pg8::gemm_phase<pg8::EpiUh, pg8::SampleOrder, true>(lds, g, S, E, OPQ(tid));
            }
        }
        SEAM(pb + 4);
    }
#undef IN
#undef SEAM
}

extern "C" void kernel_launch(void* const* d_in, const int* in_sizes, int n_in, void* d_out, int out_size, void* d_ws, size_t ws_size, hipStream_t stream) {
    static int grid_blocks = 0;
    if (!grid_blocks) {
        int dev = 0, cus = 0, per_cu = 0;
        hipGetDevice(&dev);
        hipDeviceGetAttribute(&cus, hipDeviceAttributeMultiprocessorCount, dev);
        hipOccupancyMaxActiveBlocksPerMultiprocessor(&per_cu, mega, NT, 0);
        if (per_cu < 1) { fprintf(stderr, "occupancy query returned %d\n", per_cu); per_cu = 1; }
        grid_blocks = cus * 1;
        if (ws_size < WS_END) fprintf(stderr, "workspace too small: %zu < %zu\n", ws_size, (size_t)WS_END);
    }
    (void)hipMemsetAsync(d_ws, 0, 16384, stream);
    Args a{};
    for (int i = 0; i < 24; ++i) a.in[i] = (const float*)d_in[i];
    a.out = (float*)d_out; a.ws = (unsigned char*)d_ws;
    const int NPH = 21;
#if MULTI_LAUNCH
    for (int p = 0; p < NPH; ++p) {
        a.ph_lo = p; a.ph_hi = p + 1;
        void* kargs[] = {&a};
        hipError_t e = hipLaunchCooperativeKernel((void*)mega, dim3(grid_blocks), dim3(NT), kargs, 0, stream);
        if (e != hipSuccess) fprintf(stderr, "cooperative launch failed: %s (grid %d)\n", hipGetErrorString(e), grid_blocks);
    }
#else
    a.ph_lo = 0; a.ph_hi = NPH;
    void* kargs[] = {&a};
    hipError_t e = hipLaunchCooperativeKernel((void*)mega, dim3(grid_blocks), dim3(NT), kargs, 0, stream);
    if (e != hipSuccess) fprintf(stderr, "cooperative launch failed: %s (grid %d)\n", hipGetErrorString(e), grid_blocks);
#endif
}
```

```cpp
#include <hip/hip_runtime.h>
#include <hip/hip_cooperative_groups.h>
#include <cstdio>
#include <cstdint>
namespace cg = cooperative_groups;

#ifndef REP_SYNC
#define REP_SYNC 1
#endif
#ifndef REP_P1
#define REP_P1 1
#endif
#ifndef REP_P2
#define REP_P2 1
#endif
#ifndef REP_P3
#define REP_P3 1
#endif
#ifndef REP_P0
#define REP_P0 1
#endif
#ifndef REP_P4
#define REP_P4 1
#endif
#ifndef RT_SAMPLE
#define RT_SAMPLE 1
#endif
#ifndef RT_SWA
#define RT_SWA 1
#endif
#ifndef RT_SLOC
#define RT_SLOC 1
#endif
#ifndef RT_MLOC
#define RT_MLOC 1
#endif
#ifndef RT_SOUT
#define RT_SOUT 1
#endif
#ifndef GEMM_SP2
#define GEMM_SP2 true
#endif
#ifndef GEMM_ALIGN
#define GEMM_ALIGN true
#endif
#ifndef MULTI_LAUNCH
#define MULTI_LAUNCH 0
#endif

#define LAS __attribute__((address_space(3)))
typedef unsigned short bf16_t;
typedef short bf16x8 __attribute__((ext_vector_type(8)));
typedef float f32x4 __attribute__((ext_vector_type(4)));
typedef float f32x2 __attribute__((ext_vector_type(2)));
typedef unsigned u32x4 __attribute__((ext_vector_type(4)));
typedef unsigned u32x2 __attribute__((ext_vector_type(2)));
typedef __bf16 bf16x2_t __attribute__((ext_vector_type(2)));
typedef LAS unsigned char* lptr;

constexpr int D = 1024, DIN = 4880, NIN = 5120, DMIX = 1536, TP = 16384, MTOK = 16512, MPAD = 16640, SEQ = 8192;
constexpr int C_AQ = 0, C_AK = 256, C_AV = 512, C_AO = 1024, C_AZ = 1536, C_AI = 2048, C_AF = 2052, C_BZ = 2056, C_BX = 2568, C_BB = 3080, C_BC = 3336,
              C_BDT = 3592, C_CQ = 3600, C_CK = 4112, C_CV = 4240, C_CZ = 4368;
constexpr float EPS = 1e-6f;
constexpr size_t O_YP = 0, O_YS = 16777216, O_PC = 16908288, O_PN = 17170432, O_PM = 17172480, O_PH = 17172512, O_PCONV = 17696800, O_PK = 17721376,
                 O_PV = 17852448, O_SC = 17983520, O_SN = 34760736, O_SM = 34891808, O_SH = 34893856, O_SCONV = 68448288, O_SK = 70021152, O_SV = 78409760;
constexpr size_t WS_BAR = 0;
constexpr size_t WS_PAR = 16384;
constexpr size_t WS_WIN = WS_PAR + 102400;
constexpr size_t WS_WOUT = WS_WIN + (size_t)4 * NIN * D * 2;
constexpr size_t WS_XB = WS_WOUT + (size_t)4 * D * DMIX * 2;
constexpr size_t WS_U = WS_XB + (size_t)MPAD * D * 2;
constexpr size_t WS_MIX = WS_U + (size_t)MPAD * NIN * 2;
constexpr size_t WS_SSQ = WS_MIX + (size_t)MPAD * DMIX * 2;
constexpr size_t WS_ROPE = WS_SSQ + (size_t)MPAD * 16 * 4;
constexpr size_t WS_MC = WS_ROPE + (size_t)8200 * 64 * 4;
constexpr size_t WS_MN = WS_MC + (size_t)8 * 128 * 8192 * 4;
constexpr size_t WS_ML = WS_MN + (size_t)8 * 128 * 64 * 4;
constexpr size_t WS_BL = WS_ML + 4096;
constexpr size_t WS_MS = WS_BL + 4096;
constexpr size_t WS_SA = WS_MS + 4096;
constexpr size_t WS_SH = WS_SA + 8192;
constexpr size_t WS_CSB = WS_SH + (size_t)16 * 128 * 8192 * 4;
constexpr size_t WS_HSB = WS_CSB + (size_t)8 * 128 * 8192 * 2;
constexpr size_t WS_NS = WS_HSB + (size_t)16 * 128 * 8192 * 2;
constexpr size_t WS_END = WS_NS + (size_t)8 * 128 * 64 * 4;
constexpr int LDS_BYTES = 139264;
constexpr int NT = 512;

struct Args { const float* in[24]; float* out; unsigned char* ws; int ph_lo, ph_hi; };

__device__ __forceinline__ float bf2f(unsigned v) { return __uint_as_float(v << 16); }
__device__ __forceinline__ unsigned pk2(float lo, float hi) { f32x2 v = {lo, hi}; bf16x2_t b = __builtin_convertvector(v, bf16x2_t); return __builtin_bit_cast(unsigned, b); }
__device__ __forceinline__ unsigned f2bf(float f) { return pk2(f, 0.f) & 0xffffu; }
__device__ __forceinline__ void unpack8(u32x4 w, float (&f)[8]) {
#pragma unroll
    for (int i = 0; i < 4; ++i) { f[2 * i] = __uint_as_float(w[i] << 16); f[2 * i + 1] = __uint_as_float(w[i] & 0xffff0000u); }
}
__device__ __forceinline__ u32x4 pack8(const float (&f)[8]) { u32x4 w; w[0] = pk2(f[0], f[1]); w[1] = pk2(f[2], f[3]); w[2] = pk2(f[4], f[5]); w[3] = pk2(f[6], f[7]); return w; }
__device__ __forceinline__ u32x4 pack8v(f32x4 a, f32x4 b) { u32x4 w; w[0] = pk2(a[0], a[1]); w[1] = pk2(a[2], a[3]); w[2] = pk2(b[0], b[1]); w[3] = pk2(b[2], b[3]); return w; }
__device__ __forceinline__ bf16x8 as_frag(u32x4 w) { return __builtin_bit_cast(bf16x8, w); }
__device__ __forceinline__ bf16x8 ldg_f32_frag(const float* p) { f32x4 a = *(const f32x4*)p, b = *(const f32x4*)(p + 4); return as_frag(pack8v(a, b)); }
__device__ __forceinline__ bf16x8 lds_frag(lptr base, int row, int k, int stride) { return *(const LAS bf16x8*)(base + ((row * stride + k) << 1)); }
__device__ __forceinline__ f32x4 mfma16(bf16x8 a, bf16x8 b, f32x4 c) { return __builtin_amdgcn_mfma_f32_16x16x32_bf16(a, b, c, 0, 0, 0); }
__device__ __forceinline__ float rcpf_(float x) { return __builtin_amdgcn_rcpf(x); }
__device__ __forceinline__ float sigmoidf_(float x) { return rcpf_(1.f + __expf(-x)); }
__device__ __forceinline__ float siluf_(float x) { return x * rcpf_(1.f + __expf(-x)); }
__device__ __forceinline__ float softplusf_(float x) { return x > 20.f ? x : __logf(1.f + __expf(x)); }
__device__ __forceinline__ float logsigf_(float x) { return fminf(x, 0.f) - __logf(1.f + __expf(-fabsf(x))); }
template <int CTRL, int RM> __device__ __forceinline__ float dpps(float ident, float v) { return __int_as_float(__builtin_amdgcn_update_dpp(__float_as_int(ident), __float_as_int(v), CTRL, RM, 0xf, false)); }
__device__ __forceinline__ float wave_scan_sum(float v, int) {
    v += dpps<0x111, 0xf>(0.f, v); v += dpps<0x112, 0xf>(0.f, v); v += dpps<0x114, 0xf>(0.f, v); v += dpps<0x118, 0xf>(0.f, v);
    v += dpps<0x142, 0xa>(0.f, v); v += dpps<0x143, 0xc>(0.f, v);
    return v;
}
__device__ __forceinline__ float wave_scan_max(float v, int) {
    const float NI = -3.0e38f;
    v = fmaxf(v, dpps<0x111, 0xf>(NI, v)); v = fmaxf(v, dpps<0x112, 0xf>(NI, v)); v = fmaxf(v, dpps<0x114, 0xf>(NI, v)); v = fmaxf(v, dpps<0x118, 0xf>(NI, v));
    v = fmaxf(v, dpps<0x142, 0xa>(NI, v)); v = fmaxf(v, dpps<0x143, 0xc>(NI, v));
    return v;
}
__device__ __forceinline__ float lane63(float v) { return __int_as_float(__builtin_amdgcn_readlane(__float_as_int(v), 63)); }
__device__ __forceinline__ float red16(float v);
__device__ __forceinline__ float red16max(float v);
__device__ __forceinline__ float wave_sum(float v) { v = red16(v); v += __shfl_xor(v, 16); v += __shfl_xor(v, 32); return v; }
__device__ __forceinline__ float wave_max(float v) { v = red16max(v); v = fmaxf(v, __shfl_xor(v, 16)); v = fmaxf(v, __shfl_xor(v, 32)); return v; }
template <int CTRL> __device__ __forceinline__ float dppf(float v) { return __int_as_float(__builtin_amdgcn_update_dpp(0, __float_as_int(v), CTRL, 0xf, 0xf, true)); }
__device__ __forceinline__ float red16(float v) { v += dppf<0xB1>(v); v += dppf<0x4E>(v); v += dppf<0x141>(v); v += dppf<0x140>(v); return v; }
__device__ __forceinline__ float red16max(float v) { v = fmaxf(v, dppf<0xB1>(v)); v = fmaxf(v, dppf<0x4E>(v)); v = fmaxf(v, dppf<0x141>(v)); v = fmaxf(v, dppf<0x140>(v)); return v; }
__device__ __forceinline__ int OPQ(int v) { asm volatile("" : "+v"(v)); return v; }
#define LDS_FENCE() asm volatile("s_waitcnt lgkmcnt(0)" ::: "memory")

namespace pg8 {
constexpr int BM = 256, BK = 64, HALF = 128, HTB = HALF * BK * 2, STAGE_BYTES = 8 * HTB, NXCD = 8, WGM = 8;
__host__ __device__ __forceinline__ int lds_byte(int r, int c) { const int st = (r >> 4) * 2 + (c >> 5), rr = r & 15, cc = c & 31, ob = rr * 64 + cc * 2; return st * 1024 + (ob ^ (((ob >> 9) & 1) << 5)); }
__host__ __device__ __forceinline__ void stage_rc(int b, int& R, int& C) { const int st = b / 1024, sb = b % 1024, swz = sb ^ (((sb >> 9) & 1) << 5); R = (st >> 1) * 16 + swz / 64; C = (st & 1) * 32 + (swz % 64) / 2; }
__host__ __device__ __forceinline__ int perm32(int rho) { const int n = rho >> 4, i = rho & 15; return 8 * (i >> 2) + 4 * n + (i & 3); }
struct Unit { int pm, pn; };
struct Gemm { const bf16_t* A; const bf16_t* Bt; int M, N, K; };
struct StaticOrder {
    int nM, nN, nwg, G, c;
    __device__ void init(int M, int N, int G_, int c_) { nM = M / BM; nN = N / BM; nwg = nM * nN; G = G_; c = c_; }
    __device__ bool next(int i, Unit& u) const {
        const long L = (long)i * G + c; if (L >= nwg) return false;
        int wgid = (int)L; { const int q = nwg / NXCD, r = nwg % NXCD, xcd = wgid % NXCD, off = wgid / NXCD; wgid = (xcd < r ? xcd * (q + 1) : r * (q + 1) + (xcd - r) * q) + off; }
        const int nig = WGM * nN, gid = wgid / nig, fm = gid * WGM, gsz = (nM - fm) < WGM ? (nM - fm) : WGM;
        u.pm = fm + ((wgid % nig) % gsz); u.pn = (wgid % nig) / gsz; return true;
    }
};
template <int NAI> struct EpiU_ {
    bf16_t* U; const float* ssq;
    __device__ __forceinline__ void operator()(const f32x4 (&acc)[2][2][4][2], const Unit& u, int wr, int wc, int fr, int fq) const {
        const int row0 = u.pm * BM + wr * 64 + fr, col0 = u.pn * BM + wc * 32 + 8 * fq;
#pragma unroll
        for (int ai = 0; ai < NAI; ++ai)
#pragma unroll
            for (int m = 0; m < 4; ++m) {
                const int r = row0 + ai * HALF + m * 16;
                const f32x4 s = *(const f32x4*)(ssq + (size_t)r * 16 + fq * 4);
                float st = s[0] + s[1] + s[2] + s[3]; st += __shfl_xor(st, 16); st += __shfl_xor(st, 32);
                const float rs = rsqrtf(st * (1.f / 1024.f) + EPS);
                bf16_t* rowp = U + (size_t)r * NIN + col0;
#pragma unroll
                for (int bj = 0; bj < 2; ++bj) *(u32x4*)(rowp + bj * HALF) = pack8v(acc[ai][bj][m][0] * rs, acc[ai][bj][m][1] * rs);
                __builtin_amdgcn_sched_barrier(0);
            }
    }
};
template <int NAI, int MODE> struct EpiRes_ {
    const float* xp; const float* xs; float* out; bf16_t* xb; float* ssq;
    __device__ __forceinline__ void operator()(const f32x4 (&acc)[2][2][4][2], const Unit& u, int wr, int wc, int fr, int fq) const {
        const int row0 = u.pm * BM + wr * 64 + fr, col0 = u.pn * BM + wc * 32 + 8 * fq;
#pragma unroll
        for (int ai = 0; ai < NAI; ++ai)
#pragma unroll
            for (int m = 0; m < 4; ++m) {
                const int r = row0 + ai * HALF + m * 16;
                const bool valid = r < MTOK;
                float part = 0.f;
#pragma unroll
                for (int bj = 0; bj < 2; ++bj) {
                    const int c = col0 + bj * HALF;
                    f32x4 o0 = {0.f, 0.f, 0.f, 0.f}, o1 = {0.f, 0.f, 0.f, 0.f};
                    if (MODE == 0) {
                        const float* src = r < TP ? xp + (size_t)r * D : xs + (size_t)(r - TP) * D;
                        if (valid) { o0 = __builtin_nontemporal_load((const f32x4*)(src + c)); o1 = __builtin_nontemporal_load((const f32x4*)(src + c + 4)); }
                    } else {
                        float f[8]; unpack8(*(const u32x4*)(xb + (size_t)r * D + c), f);
                        o0 = (f32x4){f[0], f[1], f[2], f[3]}; o1 = (f32x4){f[4], f[5], f[6], f[7]};
                    }
                    const f32x4 v0 = acc[ai][bj][m][0] + o0, v1 = acc[ai][bj][m][1] + o1;
                    if (MODE == 2) {
                        if (valid) { __builtin_nontemporal_store(v0, (f32x4*)(out + (size_t)r * D + c)); __builtin_nontemporal_store(v1, (f32x4*)(out + (size_t)r * D + c + 4)); }
                    } else {
                        *(u32x4*)(xb + (size_t)r * D + c) = pack8v(v0, v1);
                        part += v0[0] * v0[0] + v0[1] * v0[1] + v0[2] * v0[2] + v0[3] * v0[3] + v1[0] * v1[0] + v1[1] * v1[1] + v1[2] * v1[2] + v1[3] * v1[3];
                    }
                }
                if (MODE != 2) {
                    part += __shfl_xor(part, 16); part += __shfl_xor(part, 32);
                    if (fq == 0) ssq[(size_t)r * 16 + u.pn * 4 + wc] = part;
                }
                __builtin_amdgcn_sched_barrier(0);
            }
    }
};

typedef EpiU_<2> EpiU; typedef EpiU_<1> EpiUh;
struct EpiProbe {
    const unsigned* flag; float* dst;
    __device__ __forceinline__ void operator()(const f32x4 (&acc)[2][2][4][2], const Unit& u, int wr, int wc, int fr, int fq) const {
        if (__hip_atomic_load(flag, __ATOMIC_RELAXED, __HIP_MEMORY_SCOPE_AGENT) == 12345u) {
            f32x4 t = {0.f, 0.f, 0.f, 0.f};
#pragma unroll
            for (int a = 0; a < 2; ++a)
#pragma unroll
                for (int b = 0; b < 2; ++b)
#pragma unroll
                    for (int m = 0; m < 4; ++m)
#pragma unroll
                        for (int n = 0; n < 2; ++n) t += acc[a][b][m][n];
            *(f32x4*)(dst + (size_t)(u.pm * 4 + u.pn) * 2048 + (wr * 4 + wc) * 256 + (fq * 16 + fr) * 4) = t;
        }
    }
};
struct SampleOrder {
    int first, cnt, c;
    __device__ bool next(int i, Unit& u) const { if (i != 0 || c < first || c >= first + cnt) return false; u.pm = 64; u.pn = c - first; return true; }
};
template <class Epi, class Sched, bool HALF_M = false, bool SP2 = false, bool ALIGN_EPI = false>
__device__ __forceinline__ void gemm_phase(lptr lds, const Gemm g, const Sched& S, const Epi& E, const int tid) {
    const int wid = __builtin_amdgcn_readfirstlane(tid >> 6), lane = tid & 63, wr = wid >> 2, wc = wid & 3, fr = lane & 15, fq = lane >> 4;
    const int K = g.K, nt = K / BK;
    unsigned voffA[2], voffB[2];
#pragma unroll
    for (int i = 0; i < 2; ++i) { int R, C; stage_rc(tid * 16 + i * 8192, R, C); const int Rb = (R & ~31) + perm32(R & 31);
        voffA[i] = (unsigned)(R * K + C) * 2u; voffB[i] = (unsigned)(Rb * K + C) * 2u; }
    const size_t kstep = (size_t)(BK * 2);
    const size_t hstep = (size_t)HALF * K * 2;
    const size_t tstep = 2 * hstep;
    const unsigned ldsw = (unsigned)wid * 1024u;
    const int aoff = lds_byte(wr * 64 + fr, fq * 8), boff = lds_byte(wc * 32 + fr, fq * 8);
#define PG8_SA(b, h) (((b) * 2 + (h)) * HTB)
#define PG8_SB(b, h) ((4 + (b) * 2 + (h)) * HTB)
#define PG8_STAGE(bufoff, gbase, voff) do { _Pragma("unroll") for (int _i = 0; _i < 2; ++_i) \
        __builtin_amdgcn_global_load_lds((const unsigned*)((const char*)(gbase) + (voff)[_i]), (LAS unsigned*)(lds + (bufoff) + ldsw + _i * 8192), 16, 0, 0); } while (0)
#define PG8_LDA(dst, b, h) do { _Pragma("unroll") for (int m = 0; m < 4; ++m) _Pragma("unroll") for (int k = 0; k < 2; ++k) dst[m][k] = *(const LAS bf16x8*)(lds + PG8_SA(b, h) + aoff + m * 2048 + k * 1024); } while (0)
#define PG8_LDB(dst, b, h) do { _Pragma("unroll") for (int n = 0; n < 2; ++n) _Pragma("unroll") for (int k = 0; k < 2; ++k) dst[n][k] = *(const LAS bf16x8*)(lds + PG8_SB(b, h) + boff + n * 2048 + k * 1024); } while (0)
#define PG8_MMA(ai, bj, At, Bt) do { __builtin_amdgcn_s_setprio(1); _Pragma("unroll") for (int m = 0; m < 4; ++m) _Pragma("unroll") for (int n = 0; n < 2; ++n) _Pragma("unroll") for (int k = 0; k < 2; ++k) \
        acc[ai][bj][m][n] = __builtin_amdgcn_mfma_f32_16x16x32_bf16(Bt[n][k], At[m][k], acc[ai][bj][m][n], 0, 0, 0); __builtin_amdgcn_s_setprio(0); } while (0)
#define PG8_WAIT_V(n) asm volatile("s_waitcnt vmcnt(" #n ")" ::: "memory")
#define PG8_WAIT_L(n) asm volatile("s_waitcnt lgkmcnt(" #n ")" ::: "memory")
#define PG8_BAR __builtin_amdgcn_s_barrier()
#define PG8_SCHED __builtin_amdgcn_sched_barrier(0)
    Unit cur, nxt; int ui = 0;
    if (!S.next(0, cur)) return;
    f32x4 acc[2][2][4][2];
#pragma unroll
    for (int a = 0; a < 2; ++a)
#pragma unroll
        for (int b = 0; b < 2; ++b)
#pragma unroll
            for (int m = 0; m < 4; ++m)
#pragma unroll
                for (int n = 0; n < 2; ++n) acc[a][b][m][n] = (f32x4){0.f, 0.f, 0.f, 0.f};
    bf16x8 At[4][2], B0[2][2], B1[2][2];
    const char* cA = (const char*)g.A + (size_t)cur.pm * tstep; const char* cB = (const char*)g.Bt + (size_t)cur.pn * tstep;
    if constexpr (SP2) {
        PG8_STAGE(PG8_SB(0, 0), cB, voffB); PG8_STAGE(PG8_SB(0, 1), cB + hstep, voffB); PG8_STAGE(PG8_SA(0, 0), cA, voffA); PG8_STAGE(PG8_SA(0, 1), cA + hstep, voffA);
        if (wr == 1) PG8_BAR;
        PG8_WAIT_V(2); PG8_BAR;
        PG8_STAGE(PG8_SB(1, 0), cB + kstep, voffB); PG8_STAGE(PG8_SA(1, 0), cA + kstep, voffA); PG8_STAGE(PG8_SB(1, 1), cB + hstep + kstep, voffB);
        PG8_WAIT_V(6); PG8_BAR;
    } else {
    PG8_STAGE(PG8_SB(0, 0), cB, voffB); PG8_STAGE(PG8_SA(0, 0), cA, voffA); PG8_STAGE(PG8_SB(0, 1), cB + hstep, voffB); PG8_STAGE(PG8_SA(0, 1), cA + hstep, voffA);
    if (wr == 1) PG8_BAR;
    PG8_WAIT_V(4); PG8_BAR;
    PG8_STAGE(PG8_SB(1, 0), cB + kstep, voffB); PG8_STAGE(PG8_SA(1, 0), cA + kstep, voffA); PG8_STAGE(PG8_SB(1, 1), cB + hstep + kstep, voffB);
    PG8_WAIT_V(6); PG8_BAR;
    }
    for (;;) {
        const bool has_next = S.next(ui + 1, nxt);
        const char* nA = has_next ? (const char*)g.A + (size_t)nxt.pm * tstep : cA; const char* nB = has_next ? (const char*)g.Bt + (size_t)nxt.pn * tstep : cB;
        for (int t = 0; t < nt; t += 2) {
            const bool last = (t == nt - 2);
            const char* a1 = cA + (size_t)(t + 1) * kstep;
            const char* a2 = last ? nA : cA + (size_t)(t + 2) * kstep; const char* b2 = last ? nB : cB + (size_t)(t + 2) * kstep;
            const char* a3 = a2 + kstep; const char* b3 = b2 + kstep;
            if constexpr (SP2) {
            PG8_LDB(B0, 0, 0); PG8_LDB(B1, 0, 1); PG8_SCHED; PG8_LDA(At, 0, 0); PG8_STAGE(PG8_SA(1, 1), a1 + hstep, voffA);
            PG8_WAIT_V(8); PG8_WAIT_L(0); PG8_BAR; PG8_MMA(0, 0, At, B0); PG8_MMA(0, 1, At, B1); PG8_BAR; PG8_SCHED;
            PG8_LDA(At, 0, 1); PG8_STAGE(PG8_SB(0, 0), b2, voffB); PG8_STAGE(PG8_SB(0, 1), b2 + hstep, voffB); PG8_STAGE(PG8_SA(0, 0), a2, voffA);
            PG8_WAIT_V(8); PG8_WAIT_L(0); PG8_BAR; PG8_MMA(1, 0, At, B0); PG8_MMA(1, 1, At, B1); PG8_BAR; PG8_SCHED;
            PG8_LDB(B0, 1, 0); PG8_LDB(B1, 1, 1); PG8_SCHED; PG8_LDA(At, 1, 0); PG8_STAGE(PG8_SA(0, 1), a2 + hstep, voffA);
            PG8_WAIT_V(8); PG8_WAIT_L(0); PG8_BAR; PG8_MMA(0, 0, At, B0); PG8_MMA(0, 1, At, B1); PG8_BAR; PG8_SCHED;
            PG8_LDA(At, 1, 1); PG8_STAGE(PG8_SB(1, 0), b3, voffB); PG8_STAGE(PG8_SB(1, 1), b3 + hstep, voffB); PG8_STAGE(PG8_SA(1, 0), a3, voffA);
            PG8_WAIT_V(8); PG8_WAIT_L(0); PG8_BAR; PG8_MMA(1, 0, At, B0); PG8_MMA(1, 1, At, B1); PG8_BAR; PG8_SCHED;
            } else {
            PG8_LDB(B0, 0, 0); PG8_SCHED; PG8_LDA(At, 0, 0); PG8_STAGE(PG8_SA(1, 1), a1 + hstep, voffA);
            PG8_WAIT_L(8); PG8_BAR; PG8_WAIT_L(0); PG8_MMA(0, 0, At, B0); PG8_BAR; PG8_SCHED;
            PG8_LDB(B1, 0, 1); PG8_STAGE(PG8_SB(0, 0), b2, voffB);
            PG8_BAR; PG8_WAIT_L(0); PG8_MMA(0, 1, At, B1); PG8_BAR;
            if constexpr (!HALF_M) PG8_LDA(At, 0, 1);
            PG8_STAGE(PG8_SA(0, 0), a2, voffA);
            PG8_BAR; PG8_WAIT_L(0); if constexpr (!HALF_M) PG8_MMA(1, 0, At, B0); PG8_BAR; PG8_SCHED;
            PG8_STAGE(PG8_SB(0, 1), b2 + hstep, voffB);
            PG8_WAIT_V(6); PG8_BAR; if constexpr (!HALF_M) PG8_MMA(1, 1, At, B1); PG8_BAR;
            PG8_LDB(B0, 1, 0); PG8_SCHED; PG8_LDA(At, 1, 0); PG8_STAGE(PG8_SA(0, 1), a2 + hstep, voffA);
            PG8_WAIT_L(8); PG8_BAR; PG8_WAIT_L(0); PG8_MMA(0, 0, At, B0); PG8_BAR; PG8_SCHED;
            PG8_LDB(B1, 1, 1); PG8_STAGE(PG8_SB(1, 0), b3, voffB);
            PG8_BAR; PG8_WAIT_L(0); PG8_MMA(0, 1, At, B1); PG8_BAR;
            if constexpr (!HALF_M) PG8_LDA(At, 1, 1);
            PG8_STAGE(PG8_SA(1, 0), a3, voffA);
            PG8_BAR; PG8_WAIT_L(0); if constexpr (!HALF_M) PG8_MMA(1, 0, At, B0); PG8_BAR; PG8_SCHED;
            PG8_STAGE(PG8_SB(1, 1), b3 + hstep, voffB);
            PG8_WAIT_V(6); PG8_BAR; if constexpr (!HALF_M) PG8_MMA(1, 1, At, B1); PG8_BAR;
            }
        }
        if constexpr (ALIGN_EPI) { if (wr == 0) PG8_BAR; }
        E(acc, cur, wr, wc, fr, fq);
        if (!has_next) break;
#pragma unroll
        for (int a = 0; a < 2; ++a)
#pragma unroll
            for (int b = 0; b < 2; ++b)
#pragma unroll
                for (int m = 0; m < 4; ++m)
#pragma unroll
                    for (int n = 0; n < 2; ++n) acc[a][b][m][n] = (f32x4){0.f, 0.f, 0.f, 0.f};
        cur = nxt; cA = nA; cB = nB; ++ui;
        if constexpr (ALIGN_EPI) { if (wr == 1) PG8_BAR; }
    }
    PG8_WAIT_V(0);
    if constexpr (!ALIGN_EPI) { if (wr == 0) PG8_BAR; }
    PG8_BAR;
#undef PG8_SA
#undef PG8_SB
#undef PG8_STAGE
#undef PG8_LDA
#undef PG8_LDB
#undef PG8_MMA
#undef PG8_WAIT_V
#undef PG8_WAIT_L
#undef PG8_BAR
#undef PG8_SCHED
}
}

struct Ctx {
    const float* xp; const float* xs; const float* stC; const float* stN; const float* stM; const float* ssm; const float* conv; const float* ck; const float* cv;
    float* out; unsigned char* ws;
};
#define XWIN ((bf16_t*)(X.ws + WS_WIN))
#define XWOUT ((bf16_t*)(X.ws + WS_WOUT))
#define XXB ((bf16_t*)(X.ws + WS_XB))
#define XU ((bf16_t*)(X.ws + WS_U))
#define XMIX ((bf16_t*)(X.ws + WS_MIX))
#define XSSQ ((float*)(X.ws + WS_SSQ))
#define XROPE ((float*)(X.ws + WS_ROPE))
#define XMC ((float*)(X.ws + WS_MC))
#define XMN ((float*)(X.ws + WS_MN))
#define XML ((float*)(X.ws + WS_ML))
#define XBL ((float*)(X.ws + WS_BL))
#define XMS ((float*)(X.ws + WS_MS))
#define XSA ((float*)(X.ws + WS_SA))
#define XSH ((float*)(X.ws + WS_SH))
#define XCSB ((bf16_t*)(X.ws + WS_CSB))
#define XNS ((float*)(X.ws + WS_NS))
#define XHSB ((bf16_t*)(X.ws + WS_HSB))
#define XPAR(off) ((const float*)(X.ws + WS_PAR) + (off))
constexpr int P_AIB = 0, P_AFB = 16, P_DTB = 32, P_ALOG = 64, P_BD = 96, P_SINK = 128, P_QNW = 160, P_KNW = 416, P_ANW = 672, P_BNW = 2720, P_CB = 4768, P_CW = 8864, P_END = 25248;
#define IN_XP 0
#define IN_XS 1
#define IN_STC 2
#define IN_STN 3
#define IN_STM 4
#define IN_SSM 5
#define IN_CONV 6
#define IN_CK 7
#define IN_CV 8
#define IN_NORMW 9
#define IN_WIN 10
#define IN_AIB 11
#define IN_AFB 12
#define IN_ANW 13
#define IN_CW 14
#define IN_CB 15
#define IN_DTB 16
#define IN_ALOG 17
#define IN_BD 18
#define IN_BNW 19
#define IN_QNW 20
#define IN_KNW 21
#define IN_SINK 22
#define IN_WOUT 23

__device__ __forceinline__ void transpose_strip(lptr lds, const float* src, int ldn, int nvalid, bf16_t* dst, int ldk, const float* scale, int k0, int n0, int tid) {
    LAS float* T = (LAS float*)lds;
    f32x4 v[8];
#pragma unroll
    for (int i = 0; i < 8; ++i) {
        const int f = tid + i * NT, r = f >> 6, c4 = (f & 63) * 4, n = n0 + c4;
        const f32x4 t = __builtin_nontemporal_load((const f32x4*)(src + (size_t)(k0 + r) * ldn + (n < nvalid ? n : 0)));
        const float m = n < nvalid ? (scale ? scale[k0 + r] : 1.f) : 0.f;
        v[i] = t * m;
    }
#pragma unroll
    for (int i = 0; i < 8; ++i) {
        const int f = tid + i * NT, r = f >> 6, c4 = (f & 63) * 4;
        T[r * 257 + c4 + 0] = v[i][0]; T[r * 257 + c4 + 1] = v[i][1]; T[r * 257 + c4 + 2] = v[i][2]; T[r * 257 + c4 + 3] = v[i][3];
    }
    __syncthreads();
#pragma unroll
    for (int i = 0; i < 4; ++i) {
        const int p = tid + i * NT, n = p >> 3, k8 = (p & 7) * 8; float f[8];
#pragma unroll
        for (int jx = 0; jx < 8; ++jx) f[jx] = T[(k8 + jx) * 257 + n];
        *(u32x4*)(dst + (size_t)(n0 + n) * ldk + k0 + k8) = pack8(f);
    }
    __syncthreads();
}

__device__ __forceinline__ void prologue(lptr lds, const Ctx& X, const Args& args, int G, int bid, int tid) {
    const int lane = tid & 63, wave = tid >> 6;
    constexpr int T0 = 320, T1 = T0 + 96, T2 = T1 + 520, T3 = T2 + 1, T4 = T3 + 513;
    for (int task = bid; task < T4; task += G) {
        if (task < T0) {
            const int kt = task / 20, ntl = task % 20;
            transpose_strip(lds, args.in[IN_WIN], DIN, DIN, XWIN, D, args.in[IN_NORMW], kt * 64, ntl * 256, tid);
        } else if (task < T1) {
            const int r = task - T0, kt = r / 4, ntl = r % 4;
            transpose_strip(lds, args.in[IN_WOUT], D, D, XWOUT, DMIX, nullptr, kt * 64, ntl * 256, tid);
        } else if (task < T2) {
            const int rb = (task - T1) * 32 + wave * 4;
            f32x4 v[4][4];
#pragma unroll
            for (int q = 0; q < 4; ++q) {
                const int r = rb + q, rc = r < MTOK ? r : MTOK - 1;
                const float* src = rc < TP ? X.xp + (size_t)rc * D : X.xs + (size_t)(rc - TP) * D;
#pragma unroll
                for (int i = 0; i < 4; ++i) v[q][i] = __builtin_nontemporal_load((const f32x4*)(src + lane * 4 + i * 256));
            }
#pragma unroll
            for (int q = 0; q < 4; ++q) {
                const int r = rb + q;
                const float keep = r < MTOK ? 1.f : 0.f;
                float ss = 0.f;
#pragma unroll
                for (int i = 0; i < 4; ++i) {
                    const f32x4 t = v[q][i] * keep;
                    ss += t[0] * t[0] + t[1] * t[1] + t[2] * t[2] + t[3] * t[3];
                    u32x2 w; w[0] = pk2(t[0], t[1]); w[1] = pk2(t[2], t[3]);
                    *(u32x2*)(XXB + (size_t)r * D + lane * 4 + i * 256) = w;
                }
                ss = wave_sum(ss);
                if (lane < 16) XSSQ[(size_t)r * 16 + lane] = (lane == 0) ? ss : 0.f;
            }
        } else if (task < T3) {
            for (int i = tid; i < (MPAD - MTOK) * DMIX / 2; i += NT) ((unsigned*)(XMIX + (size_t)MTOK * DMIX))[i] = 0u;
            float* P = (float*)(X.ws + WS_PAR);
            const int po[12] = {P_AIB, P_AFB, P_DTB, P_ALOG, P_BD, P_SINK, P_QNW, P_KNW, P_ANW, P_BNW, P_CB, P_CW};
            const int pn[12] = {16, 16, 32, 32, 32, 32, 256, 256, 2048, 2048, 4096, 16384};
            const int pi[12] = {IN_AIB, IN_AFB, IN_DTB, IN_ALOG, IN_BD, IN_SINK, IN_QNW, IN_KNW, IN_ANW, IN_BNW, IN_CB, IN_CW};
#pragma unroll
            for (int a = 0; a < 12; ++a) { const float* src = args.in[pi[a]]; for (int i = tid; i < pn[a]; i += NT) P[po[a] + i] = src[i]; }
        } else {
            const int e = (task - T3) * 512 + tid;
            if (e < 8193 * 32) {
                const int pos = e >> 5, d = e & 31;
                const float inv = (float)exp2(-(double)d * (13.287712379549449 / 32.0));
                const float angf = (float)pos * inv;
                const double a = (double)angf;
                const double k = rint(a * 0.15915494309189535);
                const float rr = (float)(a - k * 6.283185307179586);
                XROPE[(size_t)e * 2] = cosf(rr); XROPE[(size_t)e * 2 + 1] = sinf(rr);
            }
        }
    }
}

__device__ __forceinline__ void convert_weights(lptr lds, const Ctx& X, const Args& args, int l, int first, int stride, int tid) {
    for (int t = first; t < 416; t += stride) {
        if (t < 320) {
            const int kt = t / 20, ntl = t % 20;
            transpose_strip(lds, args.in[IN_WIN] + (size_t)l * D * DIN, DIN, DIN, XWIN + (size_t)l * NIN * D, D, args.in[IN_NORMW] + l * D, kt * 64, ntl * 256, tid);
        } else {
            const int r = t - 320, kt = r / 4, ntl = r % 4;
            transpose_strip(lds, args.in[IN_WOUT] + (size_t)l * DMIX * D, D, D, XWOUT + (size_t)l * D * DMIX, DMIX, nullptr, kt * 64, ntl * 256, tid);
        }
    }
}

__device__ __forceinline__ void conv8(const bf16_t* u, int seq0, int tt, int ch, const float* cw, const float* cb, float (&o)[8]) {
    float acc[8];
    { f32x4 b0 = *(const f32x4*)(cb + ch), b1 = *(const f32x4*)(cb + ch + 4);
#pragma unroll
      for (int j = 0; j < 4; ++j) { acc[j] = b0[j]; acc[4 + j] = b1[j]; } }
#pragma unroll
    for (int jj = 0; jj < 4; ++jj) {
        const int t2 = tt + jj - 3;
        if (t2 >= 0) {
            float x[8]; unpack8(*(const u32x4*)(u + (size_t)(seq0 + t2) * NIN + C_BX + ch), x);
            f32x4 w0 = *(const f32x4*)(cw + jj * 1024 + ch), w1 = *(const f32x4*)(cw + jj * 1024 + ch + 4);
#pragma unroll
            for (int j = 0; j < 4; ++j) { acc[j] += x[j] * w0[j]; acc[4 + j] += x[4 + j] * w1[j]; }
        }
    }
#pragma unroll
    for (int j = 0; j < 8; ++j) o[j] = siluf_(acc[j]);
}


__device__ __forceinline__ void conv8x8(const bf16_t* u, int seq0, int tt0, int ch, const float* cw, const float* cb, float (&o)[8][8]) {
    float w[4][8];
#pragma unroll
    for (int jj = 0; jj < 4; ++jj) { f32x4 w0 = *(const f32x4*)(cw + jj * 1024 + ch), w1 = *(const f32x4*)(cw + jj * 1024 + ch + 4);
#pragma unroll
        for (int j = 0; j < 4; ++j) { w[jj][j] = w0[j]; w[jj][4 + j] = w1[j]; } }
    { f32x4 b0 = *(const f32x4*)(cb + ch), b1 = *(const f32x4*)(cb + ch + 4);
#pragma unroll
      for (int t = 0; t < 8; ++t)
#pragma unroll
          for (int j = 0; j < 4; ++j) { o[t][j] = b0[j]; o[t][4 + j] = b1[j]; } }
    u32x4 raw[11];
#pragma unroll
    for (int r = 0; r < 11; ++r) {
        const int t2 = tt0 + r - 3;
        const u32x4 v = *(const u32x4*)(u + (unsigned)(seq0 + (t2 >= 0 ? t2 : 0)) * NIN + C_BX + ch);
        const unsigned msk = t2 >= 0 ? 0xffffffffu : 0u;
        raw[r] = (u32x4){v[0] & msk, v[1] & msk, v[2] & msk, v[3] & msk};
    }
#pragma unroll
    for (int r = 0; r < 11; ++r) {
        float x[8]; unpack8(raw[r], x);
#pragma unroll
        for (int jj = 0; jj < 4; ++jj) {
            const int t = r - jj;
            if (t >= 0 && t < 8) {
#pragma unroll
                for (int j = 0; j < 8; ++j) o[t][j] += x[j] * w[jj][j];
            }
        }
    }
#pragma unroll
    for (int t = 0; t < 8; ++t)
#pragma unroll
        for (int j = 0; j < 8; ++j) o[t][j] = siluf_(o[t][j]);
}

__device__ __forceinline__ void mlstm_local(lptr lds, const Ctx& X, int l, int task, int tid) {
    const int h = task & 3, c = (task >> 2) & 127, n = task >> 9;
    const int lane = tid & 63, wave = tid >> 6, fr = lane & 15, fq = lane >> 4;
    const int row0 = n * SEQ + c * 64, nh = n * 4 + h;
    lptr VwT = lds;
    lptr KT = lds + 18432;
    LAS float* wv = (LAS float*)(lds + 27648);
    const int tg = lane & 7, cgq = lane >> 3;
    u32x4 blk[8];
    if (wave >= 1 && wave <= 3) {
        const int col = wave < 3 ? C_AV + h * 128 + ((wave - 1) * 8 + cgq) * 8 : C_AK + h * 64 + cgq * 8;
#pragma unroll
        for (int t = 0; t < 8; ++t) blk[t] = *(const u32x4*)(XU + (unsigned)(row0 + 8 * tg + t) * NIN + col);
    }
    if (wave == 0) {
        const bf16_t* ur = XU + (unsigned)(row0 + lane) * NIN;
        const float fg = bf2f(ur[C_AF + h]) + XPAR(P_AFB)[l * 4 + h], ig = bf2f(ur[C_AI + h]) + XPAR(P_AIB)[l * 4 + h];
        const float b = wave_scan_sum(logsigf_(fg), lane);
        const float bl = lane63(b);
        const float g = bl - b + ig;
        const float ml = wave_max(g);
        wv[lane] = __expf(g - ml);
        if (lane == 0) { XML[nh * 128 + c] = ml; XBL[nh * 128 + c] = bl; }
    }
    __syncthreads();
    if (wave >= 1 && wave <= 3) {
        float xs[8][8];
#pragma unroll
        for (int t = 0; t < 8; ++t) { unpack8(blk[t], xs[t]); const float w = wave < 3 ? wv[8 * tg + t] : 0.125f;
#pragma unroll
            for (int j = 0; j < 8; ++j) xs[t][j] *= w; }
        lptr dstT = wave < 3 ? VwT + ((((wave - 1) * 8 + cgq) * 8 * 72) << 1) : KT + ((cgq * 8 * 72) << 1);
#pragma unroll
        for (int j = 0; j < 8; ++j) {
            float v[8];
#pragma unroll
            for (int t = 0; t < 8; ++t) v[t] = xs[t][j];
            *(LAS u32x4*)(dstT + ((j * 72 + 8 * tg) << 1)) = pack8(v);
        }
    }
    __syncthreads();
    {
        bf16_t* dst = (bf16_t*)XMC + ((size_t)nh * 128 + c) * 8192;
        bf16x8 b0 = lds_frag(VwT, 16 * wave + fr, fq * 8, 72), b1 = lds_frag(VwT, 16 * wave + fr, 32 + fq * 8, 72);
#pragma unroll
        for (int mt = 0; mt < 4; ++mt) {
            f32x4 acc = {0.f, 0.f, 0.f, 0.f};
            acc = mfma16(lds_frag(KT, 16 * mt + fr, fq * 8, 72), b0, acc);
            acc = mfma16(lds_frag(KT, 16 * mt + fr, 32 + fq * 8, 72), b1, acc);
            { u32x2 w; w[0] = pk2(acc[0], acc[1]); w[1] = pk2(acc[2], acc[3]); *(u32x2*)(dst + (16 * wave + fr) * 64 + 16 * mt + 4 * fq) = w; }
        }
    }
    if (tid < 64) {
        float s = 0.f;
#pragma unroll
        for (int t8 = 0; t8 < 8; ++t8) {
            float kf[8]; unpack8(*(const LAS u32x4*)(KT + ((tid * 72 + t8 * 8) << 1)), kf);
#pragma unroll
            for (int jx = 0; jx < 8; ++jx) s += kf[jx] * wv[t8 * 8 + jx];
        }
        XMN[((size_t)nh * 128 + c) * 64 + tid] = s;
    }
    __syncthreads();
}

__device__ __forceinline__ void ssd_local(lptr lds, const Ctx& X, int l, int task, int tid) {
    const int g = task & 1, c = (task >> 1) & 127, n = task >> 8;
    const int lane = tid & 63, wave = tid >> 6, fr = lane & 15, fq = lane >> 4;
    const int seq0 = n * SEQ, row0 = seq0 + c * 64;
    lptr XwT = lds;
    lptr BT = lds + 36864;
    LAS float* wl = (LAS float*)(lds + 55296);
    {
        const float* cw = XPAR(P_CW) + l * 4096; const float* cb = XPAR(P_CB) + l * 1024;
        const int tg = lane & 7, cg = wave * 8 + (lane >> 3);
        float o[8][8];
        if (wave < 6) {
            const int ch = cg < 32 ? g * 256 + cg * 8 : 512 + g * 128 + (cg - 32) * 8;
            conv8x8(XU, seq0, c * 64 + 8 * tg, ch, cw, cb, o);
        }
        if (wave < 4) {
            const int hh = 4 * g + wave;
            const float dt = softplusf_(bf2f(XU[(unsigned)(row0 + lane) * NIN + C_BDT + hh]) + XPAR(P_DTB)[l * 8 + hh]);
            const float A = -__expf(XPAR(P_ALOG)[l * 8 + hh]);
            const float a = wave_scan_sum(dt * A, lane);
            const float aL = lane63(a);
            wl[wave * 64 + lane] = __expf(aL - a) * dt;
            if (lane == 0) XSA[(n * 8 + hh) * 128 + c] = aL;
        }
        __syncthreads();
        if (wave < 4) {
            float wt[8];
#pragma unroll
            for (int t = 0; t < 8; ++t) wt[t] = wl[wave * 64 + 8 * tg + t];
#pragma unroll
            for (int jx = 0; jx < 8; ++jx) {
                float v[8];
#pragma unroll
                for (int t = 0; t < 8; ++t) v[t] = o[t][jx] * wt[t];
                *(LAS u32x4*)(XwT + (((cg * 8 + jx) * 72 + 8 * tg) << 1)) = pack8(v);
            }
        } else if (wave < 6) {
#pragma unroll
            for (int jx = 0; jx < 8; ++jx) {
                float v[8];
#pragma unroll
                for (int t = 0; t < 8; ++t) v[t] = o[t][jx];
                *(LAS u32x4*)(BT + ((((cg - 32) * 8 + jx) * 72 + 8 * tg) << 1)) = pack8(v);
            }
        }
    }
    __syncthreads();
    {
        const int hl = wave >> 1, ph = wave & 1, hh = 4 * g + hl;
        bf16_t* dst = (bf16_t*)XSH + ((size_t)(n * 8 + hh) * 128 + c) * 8192;
        bf16x8 bx[2][2];
#pragma unroll
        for (int ntl = 0; ntl < 2; ++ntl)
#pragma unroll
            for (int kk = 0; kk < 2; ++kk) bx[ntl][kk] = lds_frag(XwT, hl * 64 + ph * 32 + ntl * 16 + fr, kk * 32 + fq * 8, 72);
#pragma unroll
        for (int mt = 0; mt < 8; ++mt) {
            bf16x8 a0 = lds_frag(BT, 16 * mt + fr, fq * 8, 72), a1 = lds_frag(BT, 16 * mt + fr, 32 + fq * 8, 72);
#pragma unroll
            for (int ntl = 0; ntl < 2; ++ntl) {
                f32x4 acc = {0.f, 0.f, 0.f, 0.f};
                acc = mfma16(a0, bx[ntl][0], acc); acc = mfma16(a1, bx[ntl][1], acc);
                { u32x2 w; w[0] = pk2(acc[0], acc[1]); w[1] = pk2(acc[2], acc[3]); *(u32x2*)(dst + (ph * 32 + ntl * 16 + fr) * 128 + 16 * mt + 4 * fq) = w; }
            }
        }
    }
    __syncthreads();
}

__device__ __forceinline__ void swa_prompt(lptr lds, const Ctx& X, int l, int task, int tid) {
    const int kvh = task & 1, qb = (task >> 1) & 63, n = task >> 7;
    const int lane = tid & 63, wave = tid >> 6, fr = lane & 15, fq = lane >> 4;
    const int seq0 = n * SEQ;
    lptr Kn = lds;
    lptr Vt = lds + 36864;
    lptr Pw = lds + 70656 + wave * 8448;
    const float* knw = XPAR(P_KNW) + l * 64; const float* qnw = XPAR(P_QNW) + l * 64;
#pragma unroll
    for (int it = 0; it < 2; ++it) {
        const int item = tid + it * NT, j = item >> 2, qd = item & 3, t = qb * 128 - 128 + j;
        float o1[8], o2[8];
        {
            const int tc = t >= 0 ? t : 0;
            const bf16_t* kr = XU + (unsigned)(seq0 + tc) * NIN + C_CK + kvh * 64;
            float x1[8], x2[8]; unpack8(*(const u32x4*)(kr + qd * 8), x1); unpack8(*(const u32x4*)(kr + 32 + qd * 8), x2);
            float ss = 0.f;
#pragma unroll
            for (int jj = 0; jj < 8; ++jj) ss += x1[jj] * x1[jj] + x2[jj] * x2[jj];
            ss += __shfl_xor(ss, 1); ss += __shfl_xor(ss, 2);
            const float rs = rsqrtf(ss * (1.f / 64.f) + EPS);
            const f32x4* cs = (const f32x4*)(XROPE + ((size_t)tc * 32 + qd * 8) * 2);
            f32x4 csv[4];
#pragma unroll
            for (int q4 = 0; q4 < 4; ++q4) csv[q4] = cs[q4];
            const float zm = t >= 0 ? 1.f : 0.f;
#pragma unroll
            for (int jj = 0; jj < 8; ++jj) {
                const float a = x1[jj] * rs * knw[qd * 8 + jj], b = x2[jj] * rs * knw[32 + qd * 8 + jj], co = csv[jj >> 1][(jj & 1) * 2], si = csv[jj >> 1][(jj & 1) * 2 + 1];
                o1[jj] = (a * co - b * si) * zm; o2[jj] = (b * co + a * si) * zm;
            }
        }
        *(LAS u32x4*)(Kn + ((j * 72 + qd * 8) << 1)) = pack8(o1);
        *(LAS u32x4*)(Kn + ((j * 72 + 32 + qd * 8) << 1)) = pack8(o2);
        if (qb == 63 && j >= 128) {
            float* ko = X.out + O_PK + ((((size_t)l * 2 + n) * 128 + (j - 128)) * 2 + kvh) * 64;
            *(f32x4*)(ko + qd * 8) = (f32x4){o1[0], o1[1], o1[2], o1[3]}; *(f32x4*)(ko + qd * 8 + 4) = (f32x4){o1[4], o1[5], o1[6], o1[7]};
            *(f32x4*)(ko + 32 + qd * 8) = (f32x4){o2[0], o2[1], o2[2], o2[3]}; *(f32x4*)(ko + 32 + qd * 8 + 4) = (f32x4){o2[4], o2[5], o2[6], o2[7]};
        }
    }
    if (wave < 4) {
        const int tg = tid & 31, cg = tid >> 5;
        u32x4 vb[8];
#pragma unroll
        for (int t8 = 0; t8 < 8; ++t8) {
            const int jk = 8 * tg + t8, t = qb * 128 - 128 + jk;
            u32x4 w = *(const u32x4*)(XU + (unsigned)(seq0 + (t >= 0 ? t : 0)) * NIN + C_CV + kvh * 64 + cg * 8);
            const unsigned msk = t >= 0 ? 0xffffffffu : 0u;
            vb[t8] = (u32x4){w[0] & msk, w[1] & msk, w[2] & msk, w[3] & msk};
        }
#pragma unroll
        for (int jj = 0; jj < 8; ++jj) {
            u32x4 w;
#pragma unroll
            for (int tp = 0; tp < 4; ++tp) {
                const unsigned lo = (vb[2 * tp][jj >> 1] >> ((jj & 1) * 16)) & 0xffffu, hi = (vb[2 * tp + 1][jj >> 1] >> ((jj & 1) * 16)) & 0xffffu;
                w[tp] = lo | (hi << 16);
            }
            *(LAS u32x4*)(Vt + (((cg * 8 + jj) * 264 + 8 * tg) << 1)) = w;
        }
        if (qb == 63 && tg >= 16) {
#pragma unroll
            for (int t8 = 0; t8 < 8; ++t8) {
                float x[8]; unpack8(vb[t8], x);
                float* vo = X.out + O_PV + ((((size_t)l * 2 + n) * 128 + (8 * tg + t8 - 128)) * 2 + kvh) * 64 + cg * 8;
                *(f32x4*)(vo) = (f32x4){x[0], x[1], x[2], x[3]}; *(f32x4*)(vo + 4) = (f32x4){x[4], x[5], x[6], x[7]};
            }
        }
    }
    __syncthreads();
    const int hq = kvh * 4 + (wave >> 1), i0 = (wave & 1) * 64;
    const float sink = XPAR(P_SINK)[l * 8 + hq];
    float qw1[8], qw2[8];
#pragma unroll
    for (int jj = 0; jj < 8; ++jj) { qw1[jj] = qnw[fq * 8 + jj]; qw2[jj] = qnw[32 + fq * 8 + jj]; }
    u32x4 qn0, qn1; f32x4 csn[4];
    {
        const int t = qb * 128 + i0 + fr;
        const bf16_t* qr = XU + (unsigned)(seq0 + t) * NIN + C_CQ + hq * 64;
        qn0 = *(const u32x4*)(qr + fq * 8); qn1 = *(const u32x4*)(qr + 32 + fq * 8);
        const f32x4* cs = (const f32x4*)(XROPE + ((size_t)t * 32 + fq * 8) * 2);
#pragma unroll
        for (int q4 = 0; q4 < 4; ++q4) csn[q4] = cs[q4];
    }
#pragma unroll 1
    for (int mt = 0; mt < 4; ++mt) {
        const int q0 = i0 + mt * 16;
        const u32x4 q0r = qn0, q1r = qn1; f32x4 csc[4];
#pragma unroll
        for (int q4 = 0; q4 < 4; ++q4) csc[q4] = csn[q4];
        {
            const int mn = mt < 3 ? mt + 1 : 3;
            const int t = qb * 128 + i0 + mn * 16 + fr;
            const bf16_t* qr = XU + (unsigned)(seq0 + t) * NIN + C_CQ + hq * 64;
            qn0 = *(const u32x4*)(qr + fq * 8); qn1 = *(const u32x4*)(qr + 32 + fq * 8);
            const f32x4* cs = (const f32x4*)(XROPE + ((size_t)t * 32 + fq * 8) * 2);
#pragma unroll
            for (int q4 = 0; q4 < 4; ++q4) csn[q4] = cs[q4];
        }
        bf16x8 a0, a1;
        {
            float x1[8], x2[8]; unpack8(q0r, x1); unpack8(q1r, x2);
            float ss = 0.f;
#pragma unroll
            for (int jj = 0; jj < 8; ++jj) ss += x1[jj] * x1[jj] + x2[jj] * x2[jj];
            ss += __shfl_xor(ss, 16); ss += __shfl_xor(ss, 32);
            const float rs = rsqrtf(ss * (1.f / 64.f) + EPS) * 0.125f;
            float o1[8], o2[8];
#pragma unroll
            for (int jj = 0; jj < 8; ++jj) {
                const float a = x1[jj] * rs * qw1[jj], b = x2[jj] * rs * qw2[jj], co = csc[jj >> 1][(jj & 1) * 2], si = csc[jj >> 1][(jj & 1) * 2 + 1];
                o1[jj] = a * co - b * si; o2[jj] = b * co + a * si;
            }
            a0 = as_frag(pack8(o1)); a1 = as_frag(pack8(o2));
        }
        const int tlo = q0 >> 4;
        const int qi = q0 + fr;
        const int dlo = qb > 0 ? 1 : (128 - qi > 1 ? 128 - qi : 1);
        f32x4 s[16];
        float mx = -3.0e38f;
#pragma unroll
        for (int ntl = 0; ntl < 16; ++ntl) {
            if (ntl >= tlo && ntl <= tlo + 8) {
                f32x4 acc = {0.f, 0.f, 0.f, 0.f};
                acc = mfma16(lds_frag(Kn, 16 * ntl + fr, fq * 8, 72), a0, acc);
                acc = mfma16(lds_frag(Kn, 16 * ntl + fr, 32 + fq * 8, 72), a1, acc);
                if (ntl == tlo || ntl == tlo + 8 || qb == 0) {
#pragma unroll
                    for (int ii = 0; ii < 4; ++ii) {
                        const int dk = 16 * ntl + 4 * fq + ii - qi;
                        acc[ii] = ((unsigned)(dk - dlo) <= (unsigned)(128 - dlo)) ? acc[ii] : -3.0e38f;
                    }
                }
                mx = fmaxf(mx, fmaxf(fmaxf(acc[0], acc[1]), fmaxf(acc[2], acc[3])));
                s[ntl] = acc;
            }
        }
        mx = fmaxf(mx, __shfl_xor(mx, 16)); mx = fmaxf(mx, __shfl_xor(mx, 32));
        mx = fmaxf(mx, sink);
        float sum = 0.f;
#pragma unroll
        for (int ntl = 0; ntl < 16; ++ntl) {
            if (ntl >= tlo && ntl <= tlo + 8) {
#pragma unroll
                for (int ii = 0; ii < 4; ++ii) { const float e = __expf(s[ntl][ii] - mx); s[ntl][ii] = e; sum += e; }
            }
        }
        sum += __shfl_xor(sum, 16); sum += __shfl_xor(sum, 32);
        const float inv = rcpf_(sum + __expf(sink - mx));
        const int klo = q0 >> 5, khi = (q0 + 143) >> 5;
#pragma unroll
        for (int ntl = 0; ntl < 16; ++ntl) {
            if (ntl >= tlo && ntl <= tlo + 8) {
                u32x2 w; w[0] = pk2(s[ntl][0] * inv, s[ntl][1] * inv); w[1] = pk2(s[ntl][2] * inv, s[ntl][3] * inv);
                *(LAS u32x2*)(Pw + ((fr * 264 + 16 * ntl + 4 * fq) << 1)) = w;
            } else if ((ntl >> 1) >= klo && (ntl >> 1) <= khi) {
                u32x2 w = {0u, 0u};
                *(LAS u32x2*)(Pw + ((fr * 264 + 16 * ntl + 4 * fq) << 1)) = w;
            }
        }
        u32x2 czv[4];
#pragma unroll
        for (int ntl = 0; ntl < 4; ++ntl) czv[ntl] = *(const u32x2*)(XU + ((unsigned)seq0 + qb * 128 + q0 + fr) * NIN + C_CZ + hq * 64 + 16 * ntl + 4 * fq);
        LDS_FENCE();
        f32x4 o[4];
#pragma unroll
        for (int ntl = 0; ntl < 4; ++ntl) o[ntl] = (f32x4){0.f, 0.f, 0.f, 0.f};
#pragma unroll
        for (int kk = 0; kk < 8; ++kk) {
            if (kk >= klo && kk <= khi) {
                const bf16x8 a = lds_frag(Pw, fr, kk * 32 + fq * 8, 264);
#pragma unroll
                for (int ntl = 0; ntl < 4; ++ntl) o[ntl] = mfma16(lds_frag(Vt, 16 * ntl + fr, kk * 32 + fq * 8, 264), a, o[ntl]);
            }
        }
        LDS_FENCE();
        {
            const unsigned row = (unsigned)seq0 + qb * 128 + q0 + fr;
#pragma unroll
            for (int ntl = 0; ntl < 4; ++ntl) {
                const float z0 = __uint_as_float(czv[ntl][0] << 16), z1 = __uint_as_float(czv[ntl][0] & 0xffff0000u), z2 = __uint_as_float(czv[ntl][1] << 16), z3 = __uint_as_float(czv[ntl][1] & 0xffff0000u);
                u32x2 w; w[0] = pk2(o[ntl][0] * siluf_(z0), o[ntl][1] * siluf_(z1)); w[1] = pk2(o[ntl][2] * siluf_(z2), o[ntl][3] * siluf_(z3));
                *(u32x2*)(XMIX + row * DMIX + 1024 + hq * 64 + 16 * ntl + 4 * fq) = w;
            }
        }
    }
    __syncthreads();
}

__device__ __forceinline__ void sample_task(lptr lds, const Ctx& X, int l, int b, int part, int tid) {
    LAS float* uf = (LAS float*)lds;
    LAS float* xbc = (LAS float*)(lds + 19968);
    LAS float* numv = (LAS float*)(lds + 24064);
    LAS float* yv = (LAS float*)(lds + 26112);
    LAS float* red = (LAS float*)(lds + 28160);
    LAS float* qs = (LAS float*)(lds + 28416);
    LAS float* kn = (LAS float*)(lds + 30464);
    LAS float* sc = (LAS float*)(lds + 30976);
    const int lane = tid & 63, wave = tid >> 6;
    const size_t row = (size_t)TP + b;
    const bf16_t* ur = XU + row * NIN;
    const size_t lb = (size_t)l * 128 + b;
    f32x4 kpre[8], vpre[8];
    if (part == 2) {
        const float* kc = X.ck + lb * 16384; const float* vc = X.cv + lb * 16384;
#pragma unroll
        for (int it = 0; it < 8; ++it) {
            const int e = (tid + it * NT) * 4, e2 = e < 127 * 128 ? e + 128 : e;
            kpre[it] = __builtin_nontemporal_load((const f32x4*)(kc + e2)); vpre[it] = __builtin_nontemporal_load((const f32x4*)(vc + e2));
        }
    }
    {
        const int c_lo = part == 0 ? 0 : (part == 1 ? C_BZ : C_CQ), c_hi = part == 0 ? C_BZ : (part == 1 ? C_CQ : DIN);
#pragma unroll 2
        for (int i = c_lo + tid; i < c_hi; i += NT) uf[i] = bf2f(ur[i]);
    }
    __syncthreads();
    if (part == 0) {
#pragma unroll
    for (int h = 0; h < 4; ++h) {
        const float ig = uf[C_AI + h] + XPAR(P_AIB)[l * 4 + h], fg = uf[C_AF + h] + XPAR(P_AFB)[l * 4 + h];
        const float ls = logsigf_(fg), m0 = X.stM[lb * 4 + h];
        const float mn = fmaxf(ls + m0, ig), sp = __expf(ls + m0 - mn), sl = __expf(ig - mn);
        const float* C0 = X.stC + (lb * 4 + h) * 8192; float* C1 = X.out + O_SC + (lb * 4 + h) * 8192;
#pragma unroll
        for (int it = 0; it < 4; ++it) {
            const int e = (tid + it * NT) * 4, v = e >> 6, k = e & 63;
            const f32x4 c0 = __builtin_nontemporal_load((const f32x4*)(C0 + e));
            const float vv = uf[C_AV + h * 128 + v] * sl;
            f32x4 c1; float part = 0.f;
#pragma unroll
            for (int j = 0; j < 4; ++j) { c1[j] = sp * c0[j] + vv * (uf[C_AK + h * 64 + k + j] * 0.125f); part += c1[j] * uf[C_AQ + h * 64 + k + j]; }
            __builtin_nontemporal_store(c1, (f32x4*)(C1 + e));
            part = red16(part);
            if ((lane & 15) == 0) numv[h * 128 + v] = part;
        }
        if (wave == 0) {
            const float n1 = sp * X.stN[(lb * 4 + h) * 64 + lane] + sl * uf[C_AK + h * 64 + lane] * 0.125f;
            X.out[O_SN + (lb * 4 + h) * 64 + lane] = n1;
            const float dd = wave_sum(n1 * uf[C_AQ + h * 64 + lane]);
            if (lane == 0) { red[h] = dd; red[4 + h] = mn; X.out[O_SM + lb * 4 + h] = mn; }
        }
    }
    __syncthreads();
    float hv;
    { const int h = tid >> 7; hv = numv[tid] * rcpf_(fmaxf(fabsf(red[h]), __expf(-red[4 + h]))); const float ss = wave_sum(hv * hv); if (lane == 0) red[8 + wave] = ss; }
    __syncthreads();
    { const int h = tid >> 7; const float rs = rsqrtf((red[8 + 2 * h] + red[9 + 2 * h]) * (1.f / 128.f) + EPS);
      XMIX[row * DMIX + tid] = (bf16_t)f2bf(hv * rs * XPAR(P_ANW)[l * 512 + tid] * sigmoidf_(uf[C_AO + tid]) * siluf_(uf[C_AZ + tid])); }
    }
    if (part == 1) {
    {
        const float* buf = X.conv + lb * 3 * 1024; float* oc = X.out + O_SCONV + lb * 3 * 1024;
        const float* cw = XPAR(P_CW) + l * 4096;
#pragma unroll
        for (int it = 0; it < 2; ++it) {
            const int ch = tid + it * NT;
            const float f0 = buf[ch], f1 = buf[1024 + ch], f2 = buf[2048 + ch], f3 = uf[C_BX + ch];
            const float acc = XPAR(P_CB)[l * 1024 + ch] + f0 * cw[ch] + f1 * cw[1024 + ch] + f2 * cw[2048 + ch] + f3 * cw[3072 + ch];
            xbc[ch] = siluf_(acc);
            oc[ch] = f1; oc[1024 + ch] = f2; oc[2048 + ch] = f3;
        }
    }
    __syncthreads();
#pragma unroll 4
    for (int hh = 0; hh < 8; ++hh) {
        const float dt = softplusf_(uf[C_BDT + hh] + XPAR(P_DTB)[l * 8 + hh]);
        const float dA = __expf(-dt * __expf(XPAR(P_ALOG)[l * 8 + hh]));
        const int g = hh >> 2;
        const float* h0p = X.ssm + (lb * 8 + hh) * 8192; float* h1p = X.out + O_SH + (lb * 8 + hh) * 8192;
#pragma unroll
        for (int it = 0; it < 4; ++it) {
            const int e = (tid + it * NT) * 4, p = e >> 7, s = e & 127;
            const f32x4 h0 = __builtin_nontemporal_load((const f32x4*)(h0p + e));
            const float xv = xbc[hh * 64 + p] * dt;
            f32x4 h1; float part = 0.f;
#pragma unroll
            for (int j = 0; j < 4; ++j) { h1[j] = dA * h0[j] + xv * xbc[512 + g * 128 + s + j]; part += h1[j] * xbc[768 + g * 128 + s + j]; }
            __builtin_nontemporal_store(h1, (f32x4*)(h1p + e));
            part = red16(part); part += __shfl_xor(part, 16);
            if ((lane & 31) == 0) yv[hh * 64 + p] = part;
        }
    }
    __syncthreads();
    float gb;
    { const int hh = tid >> 6; const float y = yv[tid] + XPAR(P_BD)[l * 8 + hh] * xbc[tid]; gb = y * siluf_(uf[C_BZ + tid]); const float ss = wave_sum(gb * gb); if (lane == 0) red[16 + wave] = ss; }
    __syncthreads();
    { const int g = tid >> 8; const float rs = rsqrtf((red[16 + 4 * g] + red[17 + 4 * g] + red[18 + 4 * g] + red[19 + 4 * g]) * (1.f / 256.f) + EPS);
      XMIX[row * DMIX + 512 + tid] = (bf16_t)f2bf(gb * rs * XPAR(P_BNW)[l * 512 + tid]); }
    }
    if (part == 2) {
    lptr Kl = lds + 36864;
    lptr Vl = lds + 36864 + 34816;
    if (tid < 320) {
        const int vec = tid >> 5, d = tid & 31, base = vec < 8 ? C_CQ + vec * 64 : C_CK + (vec - 8) * 64;
        const float x1 = uf[base + d], x2 = uf[base + 32 + d];
        float ss = x1 * x1 + x2 * x2; ss = red16(ss); ss += __shfl_xor(ss, 16);
        const float rs = rsqrtf(ss * (1.f / 64.f) + EPS);
        const float* w = vec < 8 ? XPAR(P_QNW) + l * 64 : XPAR(P_KNW) + l * 64;
        const float a = x1 * rs * w[d], bb = x2 * rs * w[d + 32];
        const float co = XROPE[((size_t)8192 * 32 + d) * 2], si = XROPE[((size_t)8192 * 32 + d) * 2 + 1];
        const float o1 = a * co - bb * si, o2 = bb * co + a * si;
        if (vec < 8) { qs[vec * 64 + d] = o1 * 0.125f; qs[vec * 64 + 32 + d] = o2 * 0.125f; } else { kn[(vec - 8) * 64 + d] = o1; kn[(vec - 8) * 64 + 32 + d] = o2; }
    }
    __syncthreads();
    {
        float* ko = X.out + O_SK + lb * 16384; float* vo = X.out + O_SV + lb * 16384;
#pragma unroll
        for (int it = 0; it < 8; ++it) {
            const int e = (tid + it * NT) * 4, j = e >> 7, r = e & 127;
            f32x4 kv = kpre[it], vv = vpre[it];
            if (j == 127) { kv = (f32x4){kn[r], kn[r + 1], kn[r + 2], kn[r + 3]}; vv = (f32x4){uf[C_CV + r], uf[C_CV + r + 1], uf[C_CV + r + 2], uf[C_CV + r + 3]}; }
            __builtin_nontemporal_store(kv, (f32x4*)(ko + e)); __builtin_nontemporal_store(vv, (f32x4*)(vo + e));
            u32x2 wk, wv2; wk[0] = pk2(kv[0], kv[1]); wk[1] = pk2(kv[2], kv[3]); wv2[0] = pk2(vv[0], vv[1]); wv2[1] = pk2(vv[2], vv[3]);
            *(LAS u32x2*)(Kl + ((j * 136 + r) << 1)) = wk; *(LAS u32x2*)(Vl + ((j * 136 + r) << 1)) = wv2;
        }
    }
    __syncthreads();
    if (tid < 256) {
        const int kvh = tid >> 7, jj = tid & 127;
        float s0 = 0.f, s1 = 0.f, s2 = 0.f, s3 = 0.f;
#pragma unroll 2
        for (int d8 = 0; d8 < 8; ++d8) {
            float kf[8]; unpack8(*(const LAS u32x4*)(Kl + ((jj * 136 + kvh * 64 + d8 * 8) << 1)), kf);
#pragma unroll
            for (int j = 0; j < 8; ++j) {
                s0 += kf[j] * qs[(kvh * 4 + 0) * 64 + d8 * 8 + j]; s1 += kf[j] * qs[(kvh * 4 + 1) * 64 + d8 * 8 + j];
                s2 += kf[j] * qs[(kvh * 4 + 2) * 64 + d8 * 8 + j]; s3 += kf[j] * qs[(kvh * 4 + 3) * 64 + d8 * 8 + j];
            }
        }
        sc[(kvh * 4 + 0) * 128 + jj] = s0; sc[(kvh * 4 + 1) * 128 + jj] = s1; sc[(kvh * 4 + 2) * 128 + jj] = s2; sc[(kvh * 4 + 3) * 128 + jj] = s3;
    }
    __syncthreads();
    {
        const int hq = wave; const float s0 = sc[hq * 128 + lane], s1 = sc[hq * 128 + 64 + lane], sink = XPAR(P_SINK)[l * 8 + hq];
        const float m = fmaxf(wave_max(fmaxf(s0, s1)), sink);
        const float e0 = __expf(s0 - m), e1 = __expf(s1 - m);
        const float inv = rcpf_(wave_sum(e0 + e1) + __expf(sink - m));
        sc[hq * 128 + lane] = e0 * inv; sc[hq * 128 + 64 + lane] = e1 * inv;
    }
    __syncthreads();
    {
        const int hq = tid >> 6, d = tid & 63, kvh = hq >> 2;
        float o = 0.f;
#pragma unroll 16
        for (int jj = 0; jj < 128; ++jj) o += sc[hq * 128 + jj] * bf2f(*(const LAS bf16_t*)(Vl + ((jj * 136 + kvh * 64 + d) << 1)));
        XMIX[row * DMIX + 1024 + tid] = (bf16_t)f2bf(o * siluf_(uf[C_CZ + tid]));
    }
    }
    __syncthreads();
}

__device__ __forceinline__ void scans(const Ctx& X, int l, int gt, int nthreads) {
    for (int item = gt; item < 98816; item += nthreads) {
        if (item < 32768) {
            const int nh = item >> 12, e = (item & 4095) * 2;
            const bf16_t* base = (const bf16_t*)XMC + (size_t)nh * 128 * 8192 + e;
            const float* ml = XML + nh * 128; const float* bl = XBL + nh * 128;
            float m = 0.f; f32x2 st = {0.f, 0.f};
            for (int c0 = 0; c0 < 128; c0 += 16) {
                f32x2 cl[16];
#pragma unroll
                for (int j = 0; j < 16; ++j) { const unsigned w = *(const unsigned*)(base + (size_t)(c0 + j) * 8192); cl[j] = (f32x2){__uint_as_float(w << 16), __uint_as_float(w & 0xffff0000u)}; }
#pragma unroll
                for (int j = 0; j < 16; ++j) {
                    const float mlj = ml[c0 + j], blj = bl[c0 + j], mn = fmaxf(blj + m, mlj), sp = __expf(blj + m - mn), sl = __expf(mlj - mn);
                    *(unsigned*)(XCSB + ((size_t)nh * 128 + c0 + j) * 8192 + e) = pk2(st[0], st[1]);
                    if (e == 0) XMS[nh * 128 + c0 + j] = m;
                    st = st * sp + cl[j] * sl; m = mn;
                }
            }
            *(f32x2*)(X.out + O_PC + ((size_t)l * 8 + nh) * 8192 + e) = st;
            if (e == 0) X.out[O_PM + l * 8 + nh] = m;
        } else if (item < 98304) {
            const int i1 = item - 32768, nhh = i1 >> 12, e = (i1 & 4095) * 2;
            const bf16_t* base = (const bf16_t*)XSH + (size_t)nhh * 128 * 8192 + e;
            const float* al = XSA + nhh * 128;
            f32x2 st = {0.f, 0.f};
            for (int c0 = 0; c0 < 128; c0 += 16) {
                f32x2 cl[16];
#pragma unroll
                for (int j = 0; j < 16; ++j) { const unsigned w = *(const unsigned*)(base + (size_t)(c0 + j) * 8192); cl[j] = (f32x2){__uint_as_float(w << 16), __uint_as_float(w & 0xffff0000u)}; }
#pragma unroll
                for (int j = 0; j < 16; ++j) {
                    const float dec = __expf(al[c0 + j]);
                    *(unsigned*)(XHSB + ((size_t)nhh * 128 + c0 + j) * 8192 + e) = pk2(st[0], st[1]);
                    st = st * dec + cl[j];
                }
            }
            *(f32x2*)(X.out + O_PH + ((size_t)l * 16 + nhh) * 8192 + e) = st;
        } else {
            const int i2 = item - 98304, nh = i2 >> 6, k = i2 & 63;
            float* base = XMN + (size_t)nh * 128 * 64 + k;
            const float* ml = XML + nh * 128; const float* bl = XBL + nh * 128;
            float m = 0.f, st = 0.f;
            for (int c = 0; c < 128; ++c) {
                const float mlj = ml[c], blj = bl[c], mn = fmaxf(blj + m, mlj), sp = __expf(blj + m - mn), sl = __expf(mlj - mn);
                const float cl = base[c * 64];
                XNS[(size_t)nh * 128 * 64 + c * 64 + k] = st;
                st = st * sp + cl * sl; m = mn;
            }
            X.out[O_PN + ((size_t)l * 8 + nh) * 64 + k] = st;
        }
    }
}

__device__ __forceinline__ void mlstm_out(lptr lds, const Ctx& X, int l, int task, int tid) {
    const int h = task & 3, c = (task >> 2) & 127, n = task >> 9;
    const int lane = tid & 63, wave = tid >> 6, fr = lane & 15, fq = lane >> 4;
    const int row0 = n * SEQ + c * 64, nh = n * 4 + h;
    lptr Qs = lds;
    lptr Ks = lds + 9216;
    lptr Vt = lds + 18432;
    lptr Sb = lds + 36864 + wave * 2304;
    LAS float* bv = (LAS float*)(lds + 55296);
    LAS float* dv = bv + 64;
    LAS float* mtv = bv + 128;
    LAS float* siv = bv + 192;
    LAS float* qnv = bv + 256;
    LAS float* ssqp = bv + 384;
    LAS float* nsv = bv + 512;
    const int mti = wave >> 1, half = wave & 1;
    u32x4 csf[2][4];
    {
        const bf16_t* Cs = XCSB + ((size_t)nh * 128 + c) * 8192;
#pragma unroll
        for (int kk = 0; kk < 2; ++kk)
#pragma unroll
            for (int ntl = 0; ntl < 4; ++ntl) csf[kk][ntl] = *(const u32x4*)(Cs + (64 * half + 16 * ntl + fr) * 64 + kk * 32 + fq * 8);
    }
    u32x2 aov[4], azv[4]; f32x4 anw[4];
#pragma unroll
    for (int ntl = 0; ntl < 4; ++ntl) {
        const int v = h * 128 + 64 * half + 16 * ntl + 4 * fq;
        const unsigned row = (unsigned)row0 + 16 * mti + fr;
        anw[ntl] = *(const f32x4*)(XPAR(P_ANW) + l * 512 + v);
        aov[ntl] = *(const u32x2*)(XU + row * NIN + C_AO + v); azv[ntl] = *(const u32x2*)(XU + row * NIN + C_AZ + v);
    }
    u32x4 qraw, kraw, vblk[8];
    const int tgv = lane & 7, cgv = (wave & 1) * 8 + (lane >> 3);
    {
        const int tok = tid >> 3, k8 = (tid & 7) * 8;
        const bf16_t* ur = XU + (unsigned)(row0 + tok) * NIN;
        qraw = *(const u32x4*)(ur + C_AQ + h * 64 + k8); kraw = *(const u32x4*)(ur + C_AK + h * 64 + k8);
        if (wave == 2 || wave == 3) {
#pragma unroll
            for (int t = 0; t < 8; ++t) vblk[t] = *(const u32x4*)(XU + (unsigned)(row0 + 8 * tgv + t) * NIN + C_AV + h * 128 + cgv * 8);
        }
    }
    if (wave == 0) {
        const bf16_t* ur = XU + (unsigned)(row0 + lane) * NIN;
        const float fg = bf2f(ur[C_AF + h]) + XPAR(P_AFB)[l * 4 + h], ig = bf2f(ur[C_AI + h]) + XPAR(P_AIB)[l * 4 + h];
        const float b = wave_scan_sum(logsigf_(fg), lane);
        const float dd = ig - b;
        const float cm = wave_scan_max(dd, lane);
        const float ms = XMS[nh * 128 + c];
        const float mt = b + fmaxf(ms, cm);
        bv[lane] = b; dv[lane] = dd; mtv[lane] = mt; siv[lane] = __expf(b + ms - mt);
        nsv[lane] = XNS[((size_t)nh * 128 + c) * 64 + lane];
    }
    {
        const int tok = tid >> 3, k8 = (tid & 7) * 8;
        *(LAS u32x4*)(Qs + ((tok * 72 + k8) << 1)) = qraw;
        float x[8]; unpack8(kraw, x);
#pragma unroll
        for (int j = 0; j < 8; ++j) x[j] *= 0.125f;
        *(LAS u32x4*)(Ks + ((tok * 72 + k8) << 1)) = pack8(x);
    }
    if (wave == 2 || wave == 3) {
#pragma unroll
        for (int j = 0; j < 8; ++j) {
            u32x4 w;
#pragma unroll
            for (int tp = 0; tp < 4; ++tp) {
                const unsigned lo = (vblk[2 * tp][j >> 1] >> ((j & 1) * 16)) & 0xffffu, hi = (vblk[2 * tp + 1][j >> 1] >> ((j & 1) * 16)) & 0xffffu;
                w[tp] = lo | (hi << 16);
            }
            *(LAS u32x4*)(Vt + (((cgv * 8 + j) * 72 + 8 * tgv) << 1)) = w;
        }
    }
    __syncthreads();
    bf16x8 qa[2];
    qa[0] = lds_frag(Qs, 16 * mti + fr, fq * 8, 72); qa[1] = lds_frag(Qs, 16 * mti + fr, 32 + fq * 8, 72);
    const int tq = 16 * mti + fr;
    float qn;
    {
        float x0[8], x1[8]; unpack8(__builtin_bit_cast(u32x4, qa[0]), x0); unpack8(__builtin_bit_cast(u32x4, qa[1]), x1);
        float d = 0.f;
#pragma unroll
        for (int j = 0; j < 8; ++j) d += x0[j] * nsv[fq * 8 + j] + x1[j] * nsv[32 + fq * 8 + j];
        d += __shfl_xor(d, 16); d += __shfl_xor(d, 32);
        qn = d;
    }
    const float bt = bv[tq], mtq = mtv[tq], siq = siv[tq];
    float rsum = 0.f;
#pragma unroll
    for (int ntl = 0; ntl < 4; ++ntl) {
        f32x4 sT = {0.f, 0.f, 0.f, 0.f};
        sT = mfma16(lds_frag(Ks, 16 * ntl + fr, fq * 8, 72), qa[0], sT);
        sT = mfma16(lds_frag(Ks, 16 * ntl + fr, 32 + fq * 8, 72), qa[1], sT);
        float sv[4];
#pragma unroll
        for (int ii = 0; ii < 4; ++ii) {
            const int sidx = 16 * ntl + 4 * fq + ii;
            const float wgt = (sidx <= tq) ? __expf(bt + dv[sidx] - mtq) : 0.f;
            sv[ii] = wgt * sT[ii];
            rsum += sv[ii];
        }
        u32x2 w; w[0] = pk2(sv[0], sv[1]); w[1] = pk2(sv[2], sv[3]);
        *(LAS u32x2*)(Sb + ((fr * 72 + 16 * ntl + 4 * fq) << 1)) = w;
    }
    rsum += __shfl_xor(rsum, 16); rsum += __shfl_xor(rsum, 32);
    const float inv = rcpf_(fmaxf(fabsf(rsum + siq * qn), __expf(-mtq)));
    LDS_FENCE();
    f32x4 acc[4];
#pragma unroll
    for (int ntl = 0; ntl < 4; ++ntl) acc[ntl] = (f32x4){0.f, 0.f, 0.f, 0.f};
#pragma unroll
    for (int kk = 0; kk < 2; ++kk) {
        const bf16x8 sb = lds_frag(Sb, fr, kk * 32 + fq * 8, 72);
#pragma unroll
        for (int ntl = 0; ntl < 4; ++ntl) acc[ntl] = mfma16(lds_frag(Vt, 64 * half + 16 * ntl + fr, kk * 32 + fq * 8, 72), sb, acc[ntl]);
    }
#pragma unroll
    for (int kk = 0; kk < 2; ++kk) {
        float x[8]; unpack8(__builtin_bit_cast(u32x4, qa[kk]), x);
#pragma unroll
        for (int j = 0; j < 8; ++j) x[j] *= siq;
        const bf16x8 qs = as_frag(pack8(x));
#pragma unroll
        for (int ntl = 0; ntl < 4; ++ntl) acc[ntl] = mfma16(as_frag(csf[kk][ntl]), qs, acc[ntl]);
    }
    {
        float ss = 0.f;
#pragma unroll
        for (int ntl = 0; ntl < 4; ++ntl) { acc[ntl] = acc[ntl] * inv; ss += acc[ntl][0] * acc[ntl][0] + acc[ntl][1] * acc[ntl][1] + acc[ntl][2] * acc[ntl][2] + acc[ntl][3] * acc[ntl][3]; }
        ss += __shfl_xor(ss, 16); ss += __shfl_xor(ss, 32);
        if (fq == 0) ssqp[tq * 2 + half] = ss;
    }
    __syncthreads();
    {
        const float rs = rsqrtf((ssqp[tq * 2] + ssqp[tq * 2 + 1]) * (1.f / 128.f) + EPS);
        const unsigned row = (unsigned)row0 + tq;
#pragma unroll
        for (int ntl = 0; ntl < 4; ++ntl) {
            const float o[4] = {__uint_as_float(aov[ntl][0] << 16), __uint_as_float(aov[ntl][0] & 0xffff0000u), __uint_as_float(aov[ntl][1] << 16), __uint_as_float(aov[ntl][1] & 0xffff0000u)};
            const float z[4] = {__uint_as_float(azv[ntl][0] << 16), __uint_as_float(azv[ntl][0] & 0xffff0000u), __uint_as_float(azv[ntl][1] << 16), __uint_as_float(azv[ntl][1] & 0xffff0000u)};
            float y[4];
#pragma unroll
            for (int ii = 0; ii < 4; ++ii) y[ii] = acc[ntl][ii] * rs * anw[ntl][ii] * sigmoidf_(o[ii]) * siluf_(z[ii]);
            u32x2 w; w[0] = pk2(y[0], y[1]); w[1] = pk2(y[2], y[3]);
            *(u32x2*)(XMIX + row * DMIX + h * 128 + 64 * half + 16 * ntl + 4 * fq) = w;
        }
    }
    __syncthreads();
}

__device__ __forceinline__ void ssd_out(lptr lds, const Ctx& X, int l, int task, int tid) {
    const int g = task & 1, c = (task >> 1) & 127, n = task >> 8;
    const int lane = tid & 63, wave = tid >> 6, fr = lane & 15, fq = lane >> 4;
    const int seq0 = n * SEQ, row0 = seq0 + c * 64;
    lptr Cm = lds;
    lptr Bm = lds + 17408;
    lptr Xt = lds + 34816;
    LAS float* CBf = (LAS float*)(lds + 71680);
    LAS float* av = (LAS float*)(lds + 89088);
    LAS float* dtv = (LAS float*)(lds + 90112);
    LAS float* ssq = (LAS float*)(lds + 91136);
    const int hl = wave >> 1, th = wave & 1, hh = 4 * g + hl;
    u32x4 hsf[4][4];
    {
        const bf16_t* hs = XHSB + ((size_t)(n * 8 + hh) * 128 + c) * 8192;
#pragma unroll
        for (int kk = 0; kk < 4; ++kk)
#pragma unroll
            for (int ntl = 0; ntl < 4; ++ntl) hsf[kk][ntl] = *(const u32x4*)(hs + (16 * ntl + fr) * 128 + kk * 32 + fq * 8);
    }
    if (wave < 4) {
        const int hh = 4 * g + wave;
        const float dt = softplusf_(bf2f(XU[(unsigned)(row0 + lane) * NIN + C_BDT + hh]) + XPAR(P_DTB)[l * 8 + hh]);
        const float A = -__expf(XPAR(P_ALOG)[l * 8 + hh]);
        av[wave * 64 + lane] = wave_scan_sum(dt * A, lane);
        dtv[wave * 64 + lane] = dt;
    }
    {
        const float* cw = XPAR(P_CW) + l * 4096; const float* cb = XPAR(P_CB) + l * 1024;
        float o[8][8];
        if (wave < 4) {
            const int tg = lane & 7, cg = wave * 8 + (lane >> 3);
            conv8x8(XU, seq0, c * 64 + 8 * tg, g * 256 + cg * 8, cw, cb, o);
#pragma unroll
            for (int jx = 0; jx < 8; ++jx) {
                float v[8];
#pragma unroll
                for (int t = 0; t < 8; ++t) v[t] = o[t][jx];
                *(LAS u32x4*)(Xt + (((cg * 8 + jx) * 72 + 8 * tg) << 1)) = pack8(v);
            }
        } else {
            const int tg = lane >> 3, s8 = ((wave & 1) * 8 + (lane & 7)) * 8;
            conv8x8(XU, seq0, c * 64 + 8 * tg, (wave < 6 ? 512 : 768) + g * 128 + s8, cw, cb, o);
            lptr dstm = wave < 6 ? Bm : Cm;
#pragma unroll
            for (int t = 0; t < 8; ++t) *(LAS u32x4*)(dstm + (((8 * tg + t) * 136 + s8) << 1)) = pack8(o[t]);
        }
    }
    __syncthreads();
    u32x2 bzv[2][4]; f32x4 bnw[4];
#pragma unroll
    for (int ntl = 0; ntl < 4; ++ntl) {
        bnw[ntl] = *(const f32x4*)(XPAR(P_BNW) + l * 512 + hh * 64 + 16 * ntl + 4 * fq);
#pragma unroll
        for (int mi = 0; mi < 2; ++mi) bzv[mi][ntl] = *(const u32x2*)(XU + ((unsigned)row0 + 16 * (2 * th + mi) + fr) * NIN + C_BZ + hh * 64 + 16 * ntl + 4 * fq);
    }
    {
        const int mt = wave >> 1;
#pragma unroll
        for (int q = 0; q < 2; ++q) {
            const int ntl = 2 * (wave & 1) + q;
            f32x4 acc = {0.f, 0.f, 0.f, 0.f};
#pragma unroll
            for (int kk = 0; kk < 4; ++kk) acc = mfma16(lds_frag(Cm, 16 * mt + fr, kk * 32 + fq * 8, 136), lds_frag(Bm, 16 * ntl + fr, kk * 32 + fq * 8, 136), acc);
#pragma unroll
            for (int ii = 0; ii < 4; ++ii) CBf[(16 * mt + fq * 4 + ii) * 68 + 16 * ntl + fr] = acc[ii];
        }
    }
    __syncthreads();
    f32x4 y1[2][4], y2[2][4];
#pragma unroll
    for (int mi = 0; mi < 2; ++mi)
#pragma unroll
        for (int ntl = 0; ntl < 4; ++ntl) { y1[mi][ntl] = (f32x4){0.f, 0.f, 0.f, 0.f}; y2[mi][ntl] = (f32x4){0.f, 0.f, 0.f, 0.f}; }
#pragma unroll
    for (int kk = 0; kk < 2; ++kk) {
        bf16x8 bx[4];
#pragma unroll
        for (int ntl = 0; ntl < 4; ++ntl) bx[ntl] = lds_frag(Xt, hl * 64 + 16 * ntl + fr, kk * 32 + fq * 8, 72);
#pragma unroll
        for (int mi = 0; mi < 2; ++mi) {
            const int t = 16 * (2 * th + mi) + fr, u0 = kk * 32 + fq * 8;
            const float at = av[hl * 64 + t];
            float w[8];
#pragma unroll
            for (int j = 0; j < 8; ++j) {
                const int uu = u0 + j;
                w[j] = (uu <= t) ? CBf[t * 68 + uu] * __expf(at - av[hl * 64 + uu]) * dtv[hl * 64 + uu] : 0.f;
            }
            const bf16x8 a = as_frag(pack8(w));
#pragma unroll
            for (int ntl = 0; ntl < 4; ++ntl) y1[mi][ntl] = mfma16(bx[ntl], a, y1[mi][ntl]);
        }
    }
    {
#pragma unroll
        for (int kk = 0; kk < 4; ++kk) {
            bf16x8 bh[4];
#pragma unroll
            for (int ntl = 0; ntl < 4; ++ntl) bh[ntl] = as_frag(hsf[kk][ntl]);
#pragma unroll
            for (int mi = 0; mi < 2; ++mi) {
                const bf16x8 a = lds_frag(Cm, 16 * (2 * th + mi) + fr, kk * 32 + fq * 8, 136);
#pragma unroll
                for (int ntl = 0; ntl < 4; ++ntl) y2[mi][ntl] = mfma16(bh[ntl], a, y2[mi][ntl]);
            }
        }
    }
    const float Dh = XPAR(P_BD)[l * 8 + hh];
#pragma unroll
    for (int mi = 0; mi < 2; ++mi) {
        const int t = 16 * (2 * th + mi) + fr;
        const float ea = __expf(av[hl * 64 + t]);
        float ss = 0.f;
#pragma unroll
        for (int ntl = 0; ntl < 4; ++ntl) {
            const float z[4] = {__uint_as_float(bzv[mi][ntl][0] << 16), __uint_as_float(bzv[mi][ntl][0] & 0xffff0000u), __uint_as_float(bzv[mi][ntl][1] << 16), __uint_as_float(bzv[mi][ntl][1] & 0xffff0000u)};
#pragma unroll
            for (int ii = 0; ii < 4; ++ii) {
                const int p = 16 * ntl + 4 * fq + ii;
                const float xv = bf2f(*(const LAS bf16_t*)(Xt + (((hl * 64 + p) * 72 + t) << 1)));
                const float y = y1[mi][ntl][ii] + ea * y2[mi][ntl][ii] + Dh * xv;
                const float gbv = y * siluf_(z[ii]);
                y1[mi][ntl][ii] = gbv; ss += gbv * gbv;
            }
        }
        ss += __shfl_xor(ss, 16); ss += __shfl_xor(ss, 32);
        if (fq == 0) ssq[t * 4 + hl] = ss;
    }
    __syncthreads();
#pragma unroll
    for (int mi = 0; mi < 2; ++mi) {
        const int t = 16 * (2 * th + mi) + fr;
        const float rs = rsqrtf((ssq[t * 4] + ssq[t * 4 + 1] + ssq[t * 4 + 2] + ssq[t * 4 + 3]) * (1.f / 256.f) + EPS);
        const unsigned row = (unsigned)row0 + t;
#pragma unroll
        for (int ntl = 0; ntl < 4; ++ntl) {
            u32x2 w; w[0] = pk2(y1[mi][ntl][0] * rs * bnw[ntl][0], y1[mi][ntl][1] * rs * bnw[ntl][1]); w[1] = pk2(y1[mi][ntl][2] * rs * bnw[ntl][2], y1[mi][ntl][3] * rs * bnw[ntl][3]);
            *(u32x2*)(XMIX + row * DMIX + 512 + hh * 64 + 16 * ntl + 4 * fq) = w;
        }
    }
    __syncthreads();
}


#define XB_TMO      128
#define XB_XCNT(j)  (256  + 64 * (j))
#define XB_XSUB(j)  (1280 + 64 * (j))
#define XB_XGEN(j)  (2304 + 64 * (j))
#define XB_TOP      3328
#define XB_TOPGEN   3392
#define XCD_BAR_WORDS 3456
#define XB_SPIN_CAP (1u << 18)
__device__ __forceinline__ unsigned xb_ld(unsigned* p)              { return __hip_atomic_load(p, __ATOMIC_RELAXED, __HIP_MEMORY_SCOPE_AGENT); }
__device__ __forceinline__ unsigned xb_add(unsigned* p, unsigned v) { return __hip_atomic_fetch_add(p, v, __ATOMIC_RELAXED, __HIP_MEMORY_SCOPE_AGENT); }
__device__ __forceinline__ unsigned xb_xcc_id() { return (unsigned)__builtin_amdgcn_s_getreg((3 << 11) | 20) & 0xFu; }
#define XB_SPIN(cond, bar) do { unsigned _sp = 0; while (cond) { __builtin_amdgcn_s_sleep(1); \
    if ((++_sp & 255u) == 0u) { if (xb_ld(&(bar)[XB_TMO])) break; if (_sp > XB_SPIN_CAP) { atomicAdd(&(bar)[XB_TMO], 1u); break; } } } } while (0)
struct XcdBarrier { unsigned* bar; unsigned x; volatile LAS unsigned* st; };
__device__ __forceinline__ XcdBarrier xcd_barrier_post(unsigned* bar, volatile LAS unsigned* st) {
    XcdBarrier b; b.bar = bar; b.x = xb_xcc_id(); b.st = st;
    if (threadIdx.x == 0) (void)xb_add(&bar[XB_XCNT(b.x)], 1u);
    return b;
}
__device__ __forceinline__ void xcd_barrier_complete(unsigned* bar, unsigned x, unsigned& nloc, unsigned& nx) {
    const unsigned G = gridDim.x * gridDim.y * gridDim.z;
    unsigned sum, cnt, mine, sp = 0u;
    for (;;) {
        sum = 0u; cnt = 0u; mine = 0u;
#pragma unroll
        for (unsigned j = 0; j < 16; ++j) { const unsigned c = xb_ld(&bar[XB_XCNT(j)]); sum += c; cnt += (c > 0u) ? 1u : 0u; mine = (j == x) ? c : mine; }
        if (sum == G) break;
        __builtin_amdgcn_s_sleep(1);
        if ((++sp & 255u) == 0u) { if (xb_ld(&bar[XB_TMO])) break; if (sp > XB_SPIN_CAP) { atomicAdd(&bar[XB_TMO], 1u); break; } }
    }
    nloc = mine > 0u ? mine : 1u; nx = cnt > 0u ? cnt : 1u;
}
__device__ __forceinline__ void xcd_barrier(const XcdBarrier& b) {
    asm volatile("s_waitcnt vmcnt(0)" ::: "memory");
    __syncthreads();
    if (threadIdx.x == 0) {
        unsigned* bar = b.bar;
        __builtin_amdgcn_s_waitcnt(0);
        unsigned nloc = b.st[0], nx = b.st[1];
        if (nloc == 0u) { xcd_barrier_complete(bar, b.x, nloc, nx); b.st[0] = nloc; b.st[1] = nx; }
        const unsigned old = xb_add(&bar[XB_XSUB(b.x)], 1u);
        const unsigned gen = old / nloc;
        if (old + 1u == (gen + 1u) * nloc) {
            __builtin_amdgcn_fence(__ATOMIC_RELEASE, "agent");
            asm volatile("s_waitcnt vmcnt(0)" ::: "memory");
            const unsigned og = xb_add(&bar[XB_TOP], 1u);
            const unsigned tg = og / nx;
            if (og + 1u == (tg + 1u) * nx) xb_add(&bar[XB_TOPGEN], 1u);
            else XB_SPIN(xb_ld(&bar[XB_TOPGEN]) == tg, bar);
            __builtin_amdgcn_fence(__ATOMIC_ACQUIRE, "agent");
            xb_add(&bar[XB_XGEN(b.x)], 1u);
            asm volatile("s_waitcnt vmcnt(0)" ::: "memory");
        } else {
            XB_SPIN(xb_ld(&bar[XB_XGEN(b.x)]) == gen, bar);
            __builtin_amdgcn_fence(__ATOMIC_ACQUIRE, "agent");
            asm volatile("s_waitcnt vmcnt(0)" ::: "memory");
        }
    }
    __syncthreads();
}

__global__ void __launch_bounds__(NT, 2) mega(Args args) {
    __shared__ __attribute__((aligned(16))) unsigned char lds_raw[LDS_BYTES];
    lptr lds = (lptr)lds_raw;
    cg::grid_group grid = cg::this_grid();
    const int tid = threadIdx.x, bid = blockIdx.x, G = gridDim.x;
    Ctx X;
    X.xp = args.in[IN_XP]; X.xs = args.in[IN_XS]; X.stC = args.in[IN_STC]; X.stN = args.in[IN_STN]; X.stM = args.in[IN_STM]; X.ssm = args.in[IN_SSM];
    X.conv = args.in[IN_CONV]; X.ck = args.in[IN_CK]; X.cv = args.in[IN_CV]; X.out = args.out; X.ws = args.ws;
    const int lo = args.ph_lo, hi = args.ph_hi;
    volatile LAS unsigned* xst = (volatile LAS unsigned*)(lds + LDS_BYTES - 16);
    if (tid == 0) { xst[0] = 0u; xst[1] = 0u; }
    __syncthreads();
    XcdBarrier xbar = xcd_barrier_post((unsigned*)(args.ws + WS_BAR), xst);
#define IN(k) (lo <= (k) && (k) < hi)
#define SEAM(k) do { if (IN(k) && IN((k) + 1)) { for (int _r = 0; _r < REP_SYNC; ++_r) { if (lo < 0) grid.sync(); xcd_barrier(xbar); } } } while (0)
    if (IN(0)) { for (int _r = 0; _r < REP_P0; ++_r) prologue(lds, X, args, G, bid, tid); }
    SEAM(0);
    for (int l = 0; l < 4; ++l) {
        const int pb = 1 + l * 5;
        if (IN(pb)) for (int _r = 0; _r < REP_P1; ++_r) {
            pg8::Gemm g{XXB, XWIN + (size_t)l * NIN * D, MPAD, NIN, D}; pg8::StaticOrder S; S.init(TP, NIN, G, bid);
            pg8::EpiU E{XU, XSSQ};
            pg8::gemm_phase<pg8::EpiU, pg8::StaticOrder, false, GEMM_SP2, GEMM_ALIGN>(lds, g, S, E, OPQ(tid));
            if (l == 0 && bid >= G - 20) {
                pg8::SampleOrder S2{G - 20, 20, bid}; pg8::EpiUh E2{XU, XSSQ};
                pg8::gemm_phase<pg8::EpiUh, pg8::SampleOrder, true>(lds, g, S2, E2, OPQ(tid));
            }
        }
        SEAM(pb);
        if (IN(pb + 1)) for (int _r = 0; _r < REP_P2; ++_r) {
            for (int t = bid; t < 256; t += G) for (int _q = 0; _q < RT_SAMPLE; ++_q) {
                if (t < 128) sample_task(lds, X, l, t, 1, OPQ(tid));
                else { sample_task(lds, X, l, t - 128, 0, OPQ(tid)); sample_task(lds, X, l, t - 128, 2, OPQ(tid)); }
            }
            for (int t = bid; t < 256; t += G) {
                const int tx = (G == 256) ? ((t & 7) >> 2) * 128 + (32 * (t & 1) + (t >> 3)) * 2 + ((t >> 1) & 1) : t;
                for (int _q = 0; _q < RT_SWA; ++_q) swa_prompt(lds, X, l, tx, OPQ(tid));
            }
            for (int t = bid; t < 512; t += G) for (int _q = 0; _q < RT_SLOC; ++_q) ssd_local(lds, X, l, t, OPQ(tid));
            for (int t = bid; t < 1024; t += G) for (int _q = 0; _q < RT_MLOC; ++_q) mlstm_local(lds, X, l, t, OPQ(tid));
            if (bid == G - 1) {
                for (int i = tid; i < 2 * 3 * 1024; i += NT) {
                    const int ch = i & 1023, j = (i >> 10) % 3, n = i / 3072;
                    X.out[O_PCONV + (((size_t)l * 2 + n) * 3 + j) * 1024 + ch] = bf2f(XU[(size_t)(n * SEQ + SEQ - 3 + j) * NIN + C_BX + ch]);
                }
            }
        }
        SEAM(pb + 1);
        if (IN(pb + 2)) {
            if (bid >= G - 4) {
                pg8::Gemm g{XMIX, XWOUT + (size_t)l * D * DMIX, MPAD, D, DMIX}; pg8::SampleOrder S{G - 4, 4, bid};
                if (l == 0) { pg8::EpiRes_<1, 0> E{X.xp, X.xs, X.out, XXB, XSSQ}; pg8::gemm_phase<pg8::EpiRes_<1, 0>, pg8::SampleOrder, true>(lds, g, S, E, OPQ(tid)); }
                else if (l < 3) { pg8::EpiRes_<1, 1> E{X.xp, X.xs, X.out, XXB, XSSQ}; pg8::gemm_phase<pg8::EpiRes_<1, 1>, pg8::SampleOrder, true>(lds, g, S, E, OPQ(tid)); }
                else { pg8::EpiRes_<1, 2> E{X.xp, X.xs, X.out, XXB, XSSQ}; pg8::gemm_phase<pg8::EpiRes_<1, 2>, pg8::SampleOrder, true>(lds, g, S, E, OPQ(tid)); }
            }
            if (l < 3) {
                if (G - 4 - 193 >= 16) { if (bid >= 193 && bid < G - 4) convert_weights(lds, X, args, l + 1, bid - 193, G - 4 - 193, OPQ(tid)); }
                else convert_weights(lds, X, args, l + 1, bid, G, OPQ(tid));
            }
            for (int _r = 0; _r < REP_P3; ++_r) scans(X, l, bid * NT + OPQ(tid), G * NT);
        }
        SEAM(pb + 2);
        if (IN(pb + 3)) for (int _r = 0; _r < REP_P4; ++_r) {
            for (int task = bid; task < 1536; task += G) {
                if (task < 512) for (int _q = 0; _q < RT_SOUT; ++_q) ssd_out(lds, X, l, task, OPQ(tid));
                else mlstm_out(lds, X, l, task - 512, OPQ(tid));
            }
        }
        SEAM(pb + 3);
        if (IN(pb + 4)) {
            {
                pg8::Gemm g{XMIX, XWOUT + (size_t)l * D * DMIX, MPAD, D, DMIX}; pg8::StaticOrder S; S.init(TP, D, G, bid);
#ifdef PROBE_P5
                { pg8::EpiProbe EP{(const unsigned*)(X.ws + 64), XSSQ}; pg8::gemm_phase<pg8::EpiProbe, pg8::StaticOrder, false, GEMM_SP2>(lds, g, S, EP, OPQ(tid)); }
#endif
                if (l == 0) { pg8::EpiRes_<2, 0> E{X.xp, X.xs, X.out, XXB, XSSQ}; pg8::gemm_phase<pg8::EpiRes_<2, 0>, pg8::StaticOrder, false, GEMM_SP2, GEMM_ALIGN>(lds, g, S, E, OPQ(tid)); }
                else if (l < 3) { pg8::EpiRes_<2, 1> E{X.xp, X.xs, X.out, XXB, XSSQ}; pg8::gemm_phase<pg8::EpiRes_<2, 1>, pg8::StaticOrder, false, GEMM_SP2, GEMM_ALIGN>(lds, g, S, E, OPQ(tid)); }
                else { pg8::EpiRes_<2, 2> E{X.xp, X.xs, X.out, XXB, XSSQ}; pg8::gemm_phase<pg8::EpiRes_<2, 2>, pg8::StaticOrder, false, GEMM_SP2, GEMM_ALIGN>(lds, g, S, E, OPQ(tid)); }
            }
            if (l < 3 && bid < 20) {
                pg8::Gemm g{XXB, XWIN + (size_t)(l + 1) * NIN * D, MPAD, NIN, D}; pg8::SampleOrder S{0, 20, bid};
                pg8::EpiUh E{XU, XSSQ};
                pg8::gemm_phase<pg8::EpiUh, pg8::SampleOrder, true>(lds, g, S, E, OPQ(tid));
            }
        }
        SEAM(pb + 4);
    }
#undef IN
#undef SEAM
}

extern "C" void kernel_launch(void* const* d_in, const int* in_sizes, int n_in, void* d_out, int out_size, void* d_ws, size_t ws_size, hipStream_t stream) {
    static int grid_blocks = 0;
    if (!grid_blocks) {
        int dev = 0, cus = 0, per_cu = 0;
        hipGetDevice(&dev);
        hipDeviceGetAttribute(&cus, hipDeviceAttributeMultiprocessorCount, dev);
        hipOccupancyMaxActiveBlocksPerMultiprocessor(&per_cu, mega, NT, 0);
        if (per_cu < 1) { fprintf(stderr, "occupancy query returned %d\n", per_cu); per_cu = 1; }
        grid_blocks = cus * 1;
        if (ws_size < WS_END) fprintf(stderr, "workspace too small: %zu < %zu\n", ws_size, (size_t)WS_END);
    }
    (void)hipMemsetAsync(d_ws, 0, 16384, stream);
    Args a{};
    for (int i = 0; i < 24; ++i) a.in[i] = (const float*)d_in[i];
    a.out = (float*)d_out; a.ws = (unsigned char*)d_ws;
    const int NPH = 21;
#if MULTI_LAUNCH
    for (int p = 0; p < NPH; ++p) {
        a.ph_lo = p; a.ph_hi = p + 1;
        void* kargs[] = {&a};
        hipError_t e = hipLaunchCooperativeKernel((void*)mega, dim3(grid_blocks), dim3(NT), kargs, 0, stream);
        if (e != hipSuccess) fprintf(stderr, "cooperative launch failed: %s (grid %d)\n", hipGetErrorString(e), grid_blocks);
    }
#else
    a.ph_lo = 0; a.ph_hi = NPH;
    void* kargs[] = {&a};
    hipError_t e = hipLaunchCooperativeKernel((void*)mega, dim3(grid_blocks), dim3(NT), kargs, 0, stream);
    if (e != hipSuccess) fprintf(stderr, "cooperative launch failed: %s (grid %d)\n", hipGetErrorString(e), grid_blocks);
#endif
}
```

```cpp
#include <hip/hip_runtime.h>
#include <hip/hip_cooperative_groups.h>
#include <cstdio>
#include <cstdint>
namespace cg = cooperative_groups;

#ifndef REP_SYNC
#define REP_SYNC 1
#endif
#ifndef REP_P1
#define REP_P1 1
#endif
#ifndef REP_P2
#define REP_P2 1
#endif
#ifndef REP_P3
#define REP_P3 1
#endif
#ifndef REP_P0
#define REP_P0 1
#endif
#ifndef REP_P4
#define REP_P4 1
#endif
#ifndef RT_SAMPLE
#define RT_SAMPLE 1
#endif
#ifndef RT_SWA
#define RT_SWA 1
#endif
#ifndef RT_SLOC
#define RT_SLOC 1
#endif
#ifndef RT_MLOC
#define RT_MLOC 1
#endif
#ifndef RT_SOUT
#define RT_SOUT 1
#endif
#ifndef GEMM_SP2
#define GEMM_SP2 true
#endif
#ifndef GEMM_ALIGN
#define GEMM_ALIGN true
#endif
#ifndef MULTI_LAUNCH
#define MULTI_LAUNCH 0
#endif

#define LAS __attribute__((address_space(3)))
typedef unsigned short bf16_t;
typedef short bf16x8 __attribute__((ext_vector_type(8)));
typedef float f32x4 __attribute__((ext_vector_type(4)));
typedef float f32x2 __attribute__((ext_vector_type(2)));
typedef unsigned u32x4 __attribute__((ext_vector_type(4)));
typedef unsigned u32x2 __attribute__((ext_vector_type(2)));
typedef __bf16 bf16x2_t __attribute__((ext_vector_type(2)));
typedef LAS unsigned char* lptr;

constexpr int D = 1024, DIN = 4880, NIN = 5120, DMIX = 1536, TP = 16384, MTOK = 16512, MPAD = 16640, SEQ = 8192;
constexpr int C_AQ = 0, C_AK = 256, C_AV = 512, C_AO = 1024, C_AZ = 1536, C_AI = 2048, C_AF = 2052, C_BZ = 2056, C_BX = 2568, C_BB = 3080, C_BC = 3336,
              C_BDT = 3592, C_CQ = 3600, C_CK = 4112, C_CV = 4240, C_CZ = 4368;
constexpr float EPS = 1e-6f;
constexpr size_t O_YP = 0, O_YS = 16777216, O_PC = 16908288, O_PN = 17170432, O_PM = 17172480, O_PH = 17172512, O_PCONV = 17696800, O_PK = 17721376,
                 O_PV = 17852448, O_SC = 17983520, O_SN = 34760736, O_SM = 34891808, O_SH = 34893856, O_SCONV = 68448288, O_SK = 70021152, O_SV = 78409760;
constexpr size_t WS_BAR = 0;
constexpr size_t WS_PAR = 16384;
constexpr size_t WS_WIN = WS_PAR + 102400;
constexpr size_t WS_WOUT = WS_WIN + (size_t)4 * NIN * D * 2;
constexpr size_t WS_XB = WS_WOUT + (size_t)4 * D * DMIX * 2;
constexpr size_t WS_U = WS_XB + (size_t)MPAD * D * 2;
constexpr size_t WS_MIX = WS_U + (size_t)MPAD * NIN * 2;
constexpr size_t WS_SSQ = WS_MIX + (size_t)MPAD * DMIX * 2;
constexpr size_t WS_ROPE = WS_SSQ + (size_t)MPAD * 16 * 4;
constexpr size_t WS_MC = WS_ROPE + (size_t)8200 * 64 * 4;
constexpr size_t WS_MN = WS_MC + (size_t)8 * 128 * 8192 * 4;
constexpr size_t WS_ML = WS_MN + (size_t)8 * 128 * 64 * 4;
constexpr size_t WS_BL = WS_ML + 4096;
constexpr size_t WS_MS = WS_BL + 4096;
constexpr size_t WS_SA = WS_MS + 4096;
constexpr size_t WS_SH = WS_SA + 8192;
constexpr size_t WS_CSB = WS_SH + (size_t)16 * 128 * 8192 * 4;
constexpr size_t WS_HSB = WS_CSB + (size_t)8 * 128 * 8192 * 2;
constexpr size_t WS_NS = WS_HSB + (size_t)16 * 128 * 8192 * 2;
constexpr size_t WS_END = WS_NS + (size_t)8 * 128 * 64 * 4;
constexpr int LDS_BYTES = 139264;
constexpr int NT = 512;

struct Args { const float* in[24]; float* out; unsigned char* ws; int ph_lo, ph_hi; };

__device__ __forceinline__ float bf2f(unsigned v) { return __uint_as_float(v << 16); }
__device__ __forceinline__ unsigned pk2(float lo, float hi) { f32x2 v = {lo, hi}; bf16x2_t b = __builtin_convertvector(v, bf16x2_t); return __builtin_bit_cast(unsigned, b); }
__device__ __forceinline__ unsigned f2bf(float f) { return pk2(f, 0.f) & 0xffffu; }
__device__ __forceinline__ void unpack8(u32x4 w, float (&f)[8]) {
#pragma unroll
    for (int i = 0; i < 4; ++i) { f[2 * i] = __uint_as_float(w[i] << 16); f[2 * i + 1] = __uint_as_float(w[i] & 0xffff0000u); }
}
__device__ __forceinline__ u32x4 pack8(const float (&f)[8]) { u32x4 w; w[0] = pk2(f[0], f[1]); w[1] = pk2(f[2], f[3]); w[2] = pk2(f[4], f[5]); w[3] = pk2(f[6], f[7]); return w; }
__device__ __forceinline__ u32x4 pack8v(f32x4 a, f32x4 b) { u32x4 w; w[0] = pk2(a[0], a[1]); w[1] = pk2(a[2], a[3]); w[2] = pk2(b[0], b[1]); w[3] = pk2(b[2], b[3]); return w; }
__device__ __forceinline__ bf16x8 as_frag(u32x4 w) { return __builtin_bit_cast(bf16x8, w); }
__device__ __forceinline__ bf16x8 ldg_f32_frag(const float* p) { f32x4 a = *(const f32x4*)p, b = *(const f32x4*)(p + 4); return as_frag(pack8v(a, b)); }
__device__ __forceinline__ bf16x8 lds_frag(lptr base, int row, int k, int stride) { return *(const LAS bf16x8*)(base + ((row * stride + k) << 1)); }
__device__ __forceinline__ f32x4 mfma16(bf16x8 a, bf16x8 b, f32x4 c) { return __builtin_amdgcn_mfma_f32_16x16x32_bf16(a, b, c, 0, 0, 0); }
__device__ __forceinline__ float rcpf_(float x) { return __builtin_amdgcn_rcpf(x); }
__device__ __forceinline__ float sigmoidf_(float x) { return rcpf_(1.f + __expf(-x)); }
__device__ __forceinline__ float siluf_(float x) { return x * rcpf_(1.f + __expf(-x)); }
__device__ __forceinline__ float softplusf_(float x) { return x > 20.f ? x : __logf(1.f + __expf(x)); }
__device__ __forceinline__ float logsigf_(float x) { return fminf(x, 0.f) - __logf(1.f + __expf(-fabsf(x))); }
template <int CTRL, int RM> __device__ __forceinline__ float dpps(float ident, float v) { return __int_as_float(__builtin_amdgcn_update_dpp(__float_as_int(ident), __float_as_int(v), CTRL, RM, 0xf, false)); }
__device__ __forceinline__ float wave_scan_sum(float v, int) {
    v += dpps<0x111, 0xf>(0.f, v); v += dpps<0x112, 0xf>(0.f, v); v += dpps<0x114, 0xf>(0.f, v); v += dpps<0x118, 0xf>(0.f, v);
    v += dpps<0x142, 0xa>(0.f, v); v += dpps<0x143, 0xc>(0.f, v);
    return v;
}
__device__ __forceinline__ float wave_scan_max(float v, int) {
    const float NI = -3.0e38f;
    v = fmaxf(v, dpps<0x111, 0xf>(NI, v)); v = fmaxf(v, dpps<0x112, 0xf>(NI, v)); v = fmaxf(v, dpps<0x114, 0xf>(NI, v)); v = fmaxf(v, dpps<0x118, 0xf>(NI, v));
    v = fmaxf(v, dpps<0x142, 0xa>(NI, v)); v = fmaxf(v, dpps<0x143, 0xc>(NI, v));
    return v;
}
__device__ __forceinline__ float lane63(float v) { return __int_as_float(__builtin_amdgcn_readlane(__float_as_int(v), 63)); }
__device__ __forceinline__ float red16(float v);
__device__ __forceinline__ float red16max(float v);
__device__ __forceinline__ float wave_sum(float v) { v = red16(v); v += __shfl_xor(v, 16); v += __shfl_xor(v, 32); return v; }
__device__ __forceinline__ float wave_max(float v) { v = red16max(v); v = fmaxf(v, __shfl_xor(v, 16)); v = fmaxf(v, __shfl_xor(v, 32)); return v; }
template <int CTRL> __device__ __forceinline__ float dppf(float v) { return __int_as_float(__builtin_amdgcn_update_dpp(0, __float_as_int(v), CTRL, 0xf, 0xf, true)); }
__device__ __forceinline__ float red16(float v) { v += dppf<0xB1>(v); v += dppf<0x4E>(v); v += dppf<0x141>(v); v += dppf<0x140>(v); return v; }
__device__ __forceinline__ float red16max(float v) { v = fmaxf(v, dppf<0xB1>(v)); v = fmaxf(v, dppf<0x4E>(v)); v = fmaxf(v, dppf<0x141>(v)); v = fmaxf(v, dppf<0x140>(v)); return v; }
__device__ __forceinline__ int OPQ(int v) { asm volatile("" : "+v"(v)); return v; }
#define LDS_FENCE() asm volatile("s_waitcnt lgkmcnt(0)" ::: "memory")

namespace pg8 {
constexpr int BM = 256, BK = 64, HALF = 128, HTB = HALF * BK * 2, STAGE_BYTES = 8 * HTB, NXCD = 8, WGM = 8;
__host__ __device__ __forceinline__ int lds_byte(int r, int c) { const int st = (r >> 4) * 2 + (c >> 5), rr = r & 15, cc = c & 31, ob = rr * 64 + cc * 2; return st * 1024 + (ob ^ (((ob >> 9) & 1) << 5)); }
__host__ __device__ __forceinline__ void stage_rc(int b, int& R, int& C) { const int st = b / 1024, sb = b % 1024, swz = sb ^ (((sb >> 9) & 1) << 5); R = (st >> 1) * 16 + swz / 64; C = (st & 1) * 32 + (swz % 64) / 2; }
__host__ __device__ __forceinline__ int perm32(int rho) { const int n = rho >> 4, i = rho & 15; return 8 * (i >> 2) + 4 * n + (i & 3); }
struct Unit { int pm, pn; };
struct Gemm { const bf16_t* A; const bf16_t* Bt; int M, N, K; };
struct StaticOrder {
    int nM, nN, nwg, G, c;
    __device__ void init(int M, int N, int G_, int c_) { nM = M / BM; nN = N / BM; nwg = nM * nN; G = G_; c = c_; }
    __device__ bool next(int i, Unit& u) const {
        const long L = (long)i * G + c; if (L >= nwg) return false;
        int wgid = (int)L; { const int q = nwg / NXCD, r = nwg % NXCD, xcd = wgid % NXCD, off = wgid / NXCD; wgid = (xcd < r ? xcd * (q + 1) : r * (q + 1) + (xcd - r) * q) + off; }
        const int nig = WGM * nN, gid = wgid / nig, fm = gid * WGM, gsz = (nM - fm) < WGM ? (nM - fm) : WGM;
        u.pm = fm + ((wgid % nig) % gsz); u.pn = (wgid % nig) / gsz; return true;
    }
};
template <int NAI> struct EpiU_ {
    bf16_t* U; const float* ssq;
    __device__ __forceinline__ void operator()(const f32x4 (&acc)[2][2][4][2], const Unit& u, int wr, int wc, int fr, int fq) const {
        const int row0 = u.pm * BM + wr * 64 + fr, col0 = u.pn * BM + wc * 32 + 8 * fq;
#pragma unroll
        for (int ai = 0; ai < NAI; ++ai)
#pragma unroll
            for (int m = 0; m < 4; ++m) {
                const int r = row0 + ai * HALF + m * 16;
                const f32x4 s = *(const f32x4*)(ssq + (size_t)r * 16 + fq * 4);
                float st = s[0] + s[1] + s[2] + s[3]; st += __shfl_xor(st, 16); st += __shfl_xor(st, 32);
                const float rs = rsqrtf(st * (1.f / 1024.f) + EPS);
                bf16_t* rowp = U + (size_t)r * NIN + col0;
#pragma unroll
                for (int bj = 0; bj < 2; ++bj) *(u32x4*)(rowp + bj * HALF) = pack8v(acc[ai][bj][m][0] * rs, acc[ai][bj][m][1] * rs);
                __builtin_amdgcn_sched_barrier(0);
            }
    }
};
template <int NAI, int MODE> struct EpiRes_ {
    const float* xp; const float* xs; float* out; bf16_t* xb; float* ssq;
    __device__ __forceinline__ void operator()(const f32x4 (&acc)[2][2][4][2], const Unit& u, int wr, int wc, int fr, int fq) const {
        const int row0 = u.pm * BM + wr * 64 + fr, col0 = u.pn * BM + wc * 32 + 8 * fq;
#pragma unroll
        for (int ai = 0; ai < NAI; ++ai) {
            u32x4 xo[4][2];
            if (MODE != 0) {
#pragma unroll
                for (int m = 0; m < 4; ++m)
#pragma unroll
                    for (int bj = 0; bj < 2; ++bj) xo[m][bj] = *(const u32x4*)(xb + (size_t)(row0 + ai * HALF + m * 16) * D + col0 + bj * HALF);
            }
#pragma unroll
            for (int m = 0; m < 4; ++m) {
                const int r = row0 + ai * HALF + m * 16;
                const bool valid = r < MTOK;
                float part = 0.f;
#pragma unroll
                for (int bj = 0; bj < 2; ++bj) {
                    const int c = col0 + bj * HALF;
                    f32x4 o0 = {0.f, 0.f, 0.f, 0.f}, o1 = {0.f, 0.f, 0.f, 0.f};
                    if (MODE == 0) {
                        const float* src = r < TP ? xp + (size_t)r * D : xs + (size_t)(r - TP) * D;
                        if (valid) { o0 = __builtin_nontemporal_load((const f32x4*)(src + c)); o1 = __builtin_nontemporal_load((const f32x4*)(src + c + 4)); }
                    } else {
                        float f[8]; unpack8(xo[m][bj], f);
                        o0 = (f32x4){f[0], f[1], f[2], f[3]}; o1 = (f32x4){f[4], f[5], f[6], f[7]};
                    }
                    const f32x4 v0 = acc[ai][bj][m][0] + o0, v1 = acc[ai][bj][m][1] + o1;
                    if (MODE == 2) {
                        if (valid) { __builtin_nontemporal_store(v0, (f32x4*)(out + (size_t)r * D + c)); __builtin_nontemporal_store(v1, (f32x4*)(out + (size_t)r * D + c + 4)); }
                    } else {
                        *(u32x4*)(xb + (size_t)r * D + c) = pack8v(v0, v1);
                        part += v0[0] * v0[0] + v0[1] * v0[1] + v0[2] * v0[2] + v0[3] * v0[3] + v1[0] * v1[0] + v1[1] * v1[1] + v1[2] * v1[2] + v1[3] * v1[3];
                    }
                }
                if (MODE != 2) {
                    part += __shfl_xor(part, 16); part += __shfl_xor(part, 32);
                    if (fq == 0) ssq[(size_t)r * 16 + u.pn * 4 + wc] = part;
                }
                __builtin_amdgcn_sched_barrier(0);
            }
        }
    }
};

typedef EpiU_<2> EpiU; typedef EpiU_<1> EpiUh;
struct EpiProbe {
    const unsigned* flag; float* dst;
    __device__ __forceinline__ void operator()(const f32x4 (&acc)[2][2][4][2], const Unit& u, int wr, int wc, int fr, int fq) const {
        if (__hip_atomic_load(flag, __ATOMIC_RELAXED, __HIP_MEMORY_SCOPE_AGENT) == 12345u) {
            f32x4 t = {0.f, 0.f, 0.f, 0.f};
#pragma unroll
            for (int a = 0; a < 2; ++a)
#pragma unroll
                for (int b = 0; b < 2; ++b)
#pragma unroll
                    for (int m = 0; m < 4; ++m)
#pragma unroll
                        for (int n = 0; n < 2; ++n) t += acc[a][b][m][n];
            *(f32x4*)(dst + (size_t)(u.pm * 4 + u.pn) * 2048 + (wr * 4 + wc) * 256 + (fq * 16 + fr) * 4) = t;
        }
    }
};
struct SampleOrder {
    int first, cnt, c;
    __device__ bool next(int i, Unit& u) const { if (i != 0 || c < first || c >= first + cnt) return false; u.pm = 64; u.pn = c - first; return true; }
};
template <class Epi, class Sched, bool HALF_M = false, bool SP2 = false, bool ALIGN_EPI = false>
__device__ __forceinline__ void gemm_phase(lptr lds, const Gemm g, const Sched& S, const Epi& E, const int tid) {
    const int wid = __builtin_amdgcn_readfirstlane(tid >> 6), lane = tid & 63, wr = wid >> 2, wc = wid & 3, fr = lane & 15, fq = lane >> 4;
    const int K = g.K, nt = K / BK;
    unsigned voffA[2], voffB[2];
#pragma unroll
    for (int i = 0; i < 2; ++i) { int R, C; stage_rc(tid * 16 + i * 8192, R, C); const int Rb = (R & ~31) + perm32(R & 31);
        voffA[i] = (unsigned)(R * K + C) * 2u; voffB[i] = (unsigned)(Rb * K + C) * 2u; }
    const size_t kstep = (size_t)(BK * 2);
    const size_t hstep = (size_t)HALF * K * 2;
    const size_t tstep = 2 * hstep;
    const unsigned ldsw = (unsigned)wid * 1024u;
    const int aoff = lds_byte(wr * 64 + fr, fq * 8), boff = lds_byte(wc * 32 + fr, fq * 8);
#define PG8_SA(b, h) (((b) * 2 + (h)) * HTB)
#define PG8_SB(b, h) ((4 + (b) * 2 + (h)) * HTB)
#define PG8_STAGE(bufoff, gbase, voff) do { _Pragma("unroll") for (int _i = 0; _i < 2; ++_i) \
        __builtin_amdgcn_global_load_lds((const unsigned*)((const char*)(gbase) + (voff)[_i]), (LAS unsigned*)(lds + (bufoff) + ldsw + _i * 8192), 16, 0, 0); } while (0)
#define PG8_LDA(dst, b, h) do { _Pragma("unroll") for (int m = 0; m < 4; ++m) _Pragma("unroll") for (int k = 0; k < 2; ++k) dst[m][k] = *(const LAS bf16x8*)(lds + PG8_SA(b, h) + aoff + m * 2048 + k * 1024); } while (0)
#define PG8_LDB(dst, b, h) do { _Pragma("unroll") for (int n = 0; n < 2; ++n) _Pragma("unroll") for (int k = 0; k < 2; ++k) dst[n][k] = *(const LAS bf16x8*)(lds + PG8_SB(b, h) + boff + n * 2048 + k * 1024); } while (0)
#define PG8_MMA(ai, bj, At, Bt) do { __builtin_amdgcn_s_setprio(1); _Pragma("unroll") for (int m = 0; m < 4; ++m) _Pragma("unroll") for (int n = 0; n < 2; ++n) _Pragma("unroll") for (int k = 0; k < 2; ++k) \
        acc[ai][bj][m][n] = __builtin_amdgcn_mfma_f32_16x16x32_bf16(Bt[n][k], At[m][k], acc[ai][bj][m][n], 0, 0, 0); __builtin_amdgcn_s_setprio(0); } while (0)
#define PG8_WAIT_V(n) asm volatile("s_waitcnt vmcnt(" #n ")" ::: "memory")
#define PG8_WAIT_L(n) asm volatile("s_waitcnt lgkmcnt(" #n ")" ::: "memory")
#define PG8_BAR __builtin_amdgcn_s_barrier()
#define PG8_SCHED __builtin_amdgcn_sched_barrier(0)
    Unit cur, nxt; int ui = 0;
    if (!S.next(0, cur)) return;
    f32x4 acc[2][2][4][2];
#pragma unroll
    for (int a = 0; a < 2; ++a)
#pragma unroll
        for (int b = 0; b < 2; ++b)
#pragma unroll
            for (int m = 0; m < 4; ++m)
#pragma unroll
                for (int n = 0; n < 2; ++n) acc[a][b][m][n] = (f32x4){0.f, 0.f, 0.f, 0.f};
    bf16x8 At[4][2], B0[2][2], B1[2][2];
    const char* cA = (const char*)g.A + (size_t)cur.pm * tstep; const char* cB = (const char*)g.Bt + (size_t)cur.pn * tstep;
    if constexpr (SP2) {
        PG8_STAGE(PG8_SB(0, 0), cB, voffB); PG8_STAGE(PG8_SB(0, 1), cB + hstep, voffB); PG8_STAGE(PG8_SA(0, 0), cA, voffA); PG8_STAGE(PG8_SA(0, 1), cA + hstep, voffA);
        if (wr == 1) PG8_BAR;
        PG8_WAIT_V(2); PG8_BAR;
        PG8_STAGE(PG8_SB(1, 0), cB + kstep, voffB); PG8_STAGE(PG8_SA(1, 0), cA + kstep, voffA); PG8_STAGE(PG8_SB(1, 1), cB + hstep + kstep, voffB);
        PG8_WAIT_V(6); PG8_BAR;
    } else {
    PG8_STAGE(PG8_SB(0, 0), cB, voffB); PG8_STAGE(PG8_SA(0, 0), cA, voffA); PG8_STAGE(PG8_SB(0, 1), cB + hstep, voffB); PG8_STAGE(PG8_SA(0, 1), cA + hstep, voffA);
    if (wr == 1) PG8_BAR;
    PG8_WAIT_V(4); PG8_BAR;
    PG8_STAGE(PG8_SB(1, 0), cB + kstep, voffB); PG8_STAGE(PG8_SA(1, 0), cA + kstep, voffA); PG8_STAGE(PG8_SB(1, 1), cB + hstep + kstep, voffB);
    PG8_WAIT_V(6); PG8_BAR;
    }
    for (;;) {
        const bool has_next = S.next(ui + 1, nxt);
        const char* nA = has_next ? (const char*)g.A + (size_t)nxt.pm * tstep : cA; const char* nB = has_next ? (const char*)g.Bt + (size_t)nxt.pn * tstep : cB;
        for (int t = 0; t < nt; t += 2) {
            const bool last = (t == nt - 2);
            const char* a1 = cA + (size_t)(t + 1) * kstep;
            const char* a2 = last ? nA : cA + (size_t)(t + 2) * kstep; const char* b2 = last ? nB : cB + (size_t)(t + 2) * kstep;
            const char* a3 = a2 + kstep; const char* b3 = b2 + kstep;
            if constexpr (SP2) {
            PG8_LDB(B0, 0, 0); PG8_LDB(B1, 0, 1); PG8_SCHED; PG8_LDA(At, 0, 0); PG8_STAGE(PG8_SA(1, 1), a1 + hstep, voffA);
            PG8_WAIT_V(8); PG8_WAIT_L(0); PG8_BAR; PG8_MMA(0, 0, At, B0); PG8_MMA(0, 1, At, B1); PG8_BAR; PG8_SCHED;
            PG8_LDA(At, 0, 1); PG8_STAGE(PG8_SB(0, 0), b2, voffB); PG8_STAGE(PG8_SB(0, 1), b2 + hstep, voffB); PG8_STAGE(PG8_SA(0, 0), a2, voffA);
            PG8_WAIT_V(8); PG8_WAIT_L(0); PG8_BAR; PG8_MMA(1, 0, At, B0); PG8_MMA(1, 1, At, B1); PG8_BAR; PG8_SCHED;
            PG8_LDB(B0, 1, 0); PG8_LDB(B1, 1, 1); PG8_SCHED; PG8_LDA(At, 1, 0); PG8_STAGE(PG8_SA(0, 1), a2 + hstep, voffA);
            PG8_WAIT_V(8); PG8_WAIT_L(0); PG8_BAR; PG8_MMA(0, 0, At, B0); PG8_MMA(0, 1, At, B1); PG8_BAR; PG8_SCHED;
            PG8_LDA(At, 1, 1); PG8_STAGE(PG8_SB(1, 0), b3, voffB); PG8_STAGE(PG8_SB(1, 1), b3 + hstep, voffB); PG8_STAGE(PG8_SA(1, 0), a3, voffA);
            PG8_WAIT_V(8); PG8_WAIT_L(0); PG8_BAR; PG8_MMA(1, 0, At, B0); PG8_MMA(1, 1, At, B1); PG8_BAR; PG8_SCHED;
            } else {
            PG8_LDB(B0, 0, 0); PG8_SCHED; PG8_LDA(At, 0, 0); PG8_STAGE(PG8_SA(1, 1), a1 + hstep, voffA);
            PG8_WAIT_L(8); PG8_BAR; PG8_WAIT_L(0); PG8_MMA(0, 0, At, B0); PG8_BAR; PG8_SCHED;
            PG8_LDB(B1, 0, 1); PG8_STAGE(PG8_SB(0, 0), b2, voffB);
            PG8_BAR; PG8_WAIT_L(0); PG8_MMA(0, 1, At, B1); PG8_BAR;
            if constexpr (!HALF_M) PG8_LDA(At, 0, 1);
            PG8_STAGE(PG8_SA(0, 0), a2, voffA);
            PG8_BAR; PG8_WAIT_L(0); if constexpr (!HALF_M) PG8_MMA(1, 0, At, B0); PG8_BAR; PG8_SCHED;
            PG8_STAGE(PG8_SB(0, 1), b2 + hstep, voffB);
            PG8_WAIT_V(6); PG8_BAR; if constexpr (!HALF_M) PG8_MMA(1, 1, At, B1); PG8_BAR;
            PG8_LDB(B0, 1, 0); PG8_SCHED; PG8_LDA(At, 1, 0); PG8_STAGE(PG8_SA(0, 1), a2 + hstep, voffA);
            PG8_WAIT_L(8); PG8_BAR; PG8_WAIT_L(0); PG8_MMA(0, 0, At, B0); PG8_BAR; PG8_SCHED;
            PG8_LDB(B1, 1, 1); PG8_STAGE(PG8_SB(1, 0), b3, voffB);
            PG8_BAR; PG8_WAIT_L(0); PG8_MMA(0, 1, At, B1); PG8_BAR;
            if constexpr (!HALF_M) PG8_LDA(At, 1, 1);
            PG8_STAGE(PG8_SA(1, 0), a3, voffA);
            PG8_BAR; PG8_WAIT_L(0); if constexpr (!HALF_M) PG8_MMA(1, 0, At, B0); PG8_BAR; PG8_SCHED;
            PG8_STAGE(PG8_SB(1, 1), b3 + hstep, voffB);
            PG8_WAIT_V(6); PG8_BAR; if constexpr (!HALF_M) PG8_MMA(1, 1, At, B1); PG8_BAR;
            }
        }
        if constexpr (ALIGN_EPI) { if (wr == 0) PG8_BAR; }
        E(acc, cur, wr, wc, fr, fq);
        if (!has_next) break;
#pragma unroll
        for (int a = 0; a < 2; ++a)
#pragma unroll
            for (int b = 0; b < 2; ++b)
#pragma unroll
                for (int m = 0; m < 4; ++m)
#pragma unroll
                    for (int n = 0; n < 2; ++n) acc[a][b][m][n] = (f32x4){0.f, 0.f, 0.f, 0.f};
        cur = nxt; cA = nA; cB = nB; ++ui;
        if constexpr (ALIGN_EPI) { if (wr == 1) PG8_BAR; }
    }
    PG8_WAIT_V(0);
    if constexpr (!ALIGN_EPI) { if (wr == 0) PG8_BAR; }
    PG8_BAR;
#undef PG8_SA
#undef PG8_SB
#undef PG8_STAGE
#undef PG8_LDA
#undef PG8_LDB
#undef PG8_MMA
#undef PG8_WAIT_V
#undef PG8_WAIT_L
#undef PG8_BAR
#undef PG8_SCHED
}
}

struct Ctx {
    const float* xp; const float* xs; const float* stC; const float* stN; const float* stM; const float* ssm; const float* conv; const float* ck; const float* cv;
    float* out; unsigned char* ws;
};
#define XWIN ((bf16_t*)(X.ws + WS_WIN))
#define XWOUT ((bf16_t*)(X.ws + WS_WOUT))
#define XXB ((bf16_t*)(X.ws + WS_XB))
#define XU ((bf16_t*)(X.ws + WS_U))
#define XMIX ((bf16_t*)(X.ws + WS_MIX))
#define XSSQ ((float*)(X.ws + WS_SSQ))
#define XROPE ((float*)(X.ws + WS_ROPE))
#define XMC ((float*)(X.ws + WS_MC))
#define XMN ((float*)(X.ws + WS_MN))
#define XML ((float*)(X.ws + WS_ML))
#define XBL ((float*)(X.ws + WS_BL))
#define XMS ((float*)(X.ws + WS_MS))
#define XSA ((float*)(X.ws + WS_SA))
#define XSH ((float*)(X.ws + WS_SH))
#define XCSB ((bf16_t*)(X.ws + WS_CSB))
#define XNS ((float*)(X.ws + WS_NS))
#define XHSB ((bf16_t*)(X.ws + WS_HSB))
#define XPAR(off) ((const float*)(X.ws + WS_PAR) + (off))
constexpr int P_AIB = 0, P_AFB = 16, P_DTB = 32, P_ALOG = 64, P_BD = 96, P_SINK = 128, P_QNW = 160, P_KNW = 416, P_ANW = 672, P_BNW = 2720, P_CB = 4768, P_CW = 8864, P_END = 25248;
#define IN_XP 0
#define IN_XS 1
#define IN_STC 2
#define IN_STN 3
#define IN_STM 4
#define IN_SSM 5
#define IN_CONV 6
#define IN_CK 7
#define IN_CV 8
#define IN_NORMW 9
#define IN_WIN 10
#define IN_AIB 11
#define IN_AFB 12
#define IN_ANW 13
#define IN_CW 14
#define IN_CB 15
#define IN_DTB 16
#define IN_ALOG 17
#define IN_BD 18
#define IN_BNW 19
#define IN_QNW 20
#define IN_KNW 21
#define IN_SINK 22
#define IN_WOUT 23

__device__ __forceinline__ void transpose_strip(lptr lds, const float* src, int ldn, int nvalid, bf16_t* dst, int ldk, const float* scale, int k0, int n0, int tid) {
    LAS float* T = (LAS float*)lds;
    f32x4 v[8];
#pragma unroll
    for (int i = 0; i < 8; ++i) {
        const int f = tid + i * NT, r = f >> 6, c4 = (f & 63) * 4, n = n0 + c4;
        const f32x4 t = __builtin_nontemporal_load((const f32x4*)(src + (size_t)(k0 + r) * ldn + (n < nvalid ? n : 0)));
        const float m = n < nvalid ? (scale ? scale[k0 + r] : 1.f) : 0.f;
        v[i] = t * m;
    }
#pragma unroll
    for (int i = 0; i < 8; ++i) {
        const int f = tid + i * NT, r = f >> 6, c4 = (f & 63) * 4;
        T[r * 257 + c4 + 0] = v[i][0]; T[r * 257 + c4 + 1] = v[i][1]; T[r * 257 + c4 + 2] = v[i][2]; T[r * 257 + c4 + 3] = v[i][3];
    }
    __syncthreads();
#pragma unroll
    for (int i = 0; i < 4; ++i) {
        const int p = tid + i * NT, n = p >> 3, k8 = (p & 7) * 8; float f[8];
#pragma unroll
        for (int jx = 0; jx < 8; ++jx) f[jx] = T[(k8 + jx) * 257 + n];
        *(u32x4*)(dst + (size_t)(n0 + n) * ldk + k0 + k8) = pack8(f);
    }
    __syncthreads();
}

__device__ __forceinline__ void prologue(lptr lds, const Ctx& X, const Args& args, int G, int bid, int tid) {
    const int lane = tid & 63, wave = tid >> 6;
    constexpr int T0 = 320, T1 = T0 + 96, T2 = T1 + 520, T3 = T2 + 1, T4 = T3 + 513;
    for (int task = bid; task < T4; task += G) {
        if (task < T0) {
            const int kt = task / 20, ntl = task % 20;
            transpose_strip(lds, args.in[IN_WIN], DIN, DIN, XWIN, D, args.in[IN_NORMW], kt * 64, ntl * 256, tid);
        } else if (task < T1) {
            const int r = task - T0, kt = r / 4, ntl = r % 4;
            transpose_strip(lds, args.in[IN_WOUT], D, D, XWOUT, DMIX, nullptr, kt * 64, ntl * 256, tid);
        } else if (task < T2) {
            const int rb = (task - T1) * 32 + wave * 4;
            f32x4 v[4][4];
#pragma unroll
            for (int q = 0; q < 4; ++q) {
                const int r = rb + q, rc = r < MTOK ? r : MTOK - 1;
                const float* src = rc < TP ? X.xp + (size_t)rc * D : X.xs + (size_t)(rc - TP) * D;
#pragma unroll
                for (int i = 0; i < 4; ++i) v[q][i] = __builtin_nontemporal_load((const f32x4*)(src + lane * 4 + i * 256));
            }
#pragma unroll
            for (int q = 0; q < 4; ++q) {
                const int r = rb + q;
                const float keep = r < MTOK ? 1.f : 0.f;
                float ss = 0.f;
#pragma unroll
                for (int i = 0; i < 4; ++i) {
                    const f32x4 t = v[q][i] * keep;
                    ss += t[0] * t[0] + t[1] * t[1] + t[2] * t[2] + t[3] * t[3];
                    u32x2 w; w[0] = pk2(t[0], t[1]); w[1] = pk2(t[2], t[3]);
                    *(u32x2*)(XXB + (size_t)r * D + lane * 4 + i * 256) = w;
                }
                ss = wave_sum(ss);
                if (lane < 16) XSSQ[(size_t)r * 16 + lane] = (lane == 0) ? ss : 0.f;
            }
        } else if (task < T3) {
            for (int i = tid; i < (MPAD - MTOK) * DMIX / 2; i += NT) ((unsigned*)(XMIX + (size_t)MTOK * DMIX))[i] = 0u;
            float* P = (float*)(X.ws + WS_PAR);
            const int po[12] = {P_AIB, P_AFB, P_DTB, P_ALOG, P_BD, P_SINK, P_QNW, P_KNW, P_ANW, P_BNW, P_CB, P_CW};
            const int pn[12] = {16, 16, 32, 32, 32, 32, 256, 256, 2048, 2048, 4096, 16384};
            const int pi[12] = {IN_AIB, IN_AFB, IN_DTB, IN_ALOG, IN_BD, IN_SINK, IN_QNW, IN_KNW, IN_ANW, IN_BNW, IN_CB, IN_CW};
#pragma unroll
            for (int a = 0; a < 12; ++a) { const float* src = args.in[pi[a]]; for (int i = tid; i < pn[a]; i += NT) P[po[a] + i] = src[i]; }
        } else {
            const int e = (task - T3) * 512 + tid;
            if (e < 8193 * 32) {
                const int pos = e >> 5, d = e & 31;
                const float inv = (float)exp2(-(double)d * (13.287712379549449 / 32.0));
                const float angf = (float)pos * inv;
                const double a = (double)angf;
                const double k = rint(a * 0.15915494309189535);
                const float rr = (float)(a - k * 6.283185307179586);
                XROPE[(size_t)e * 2] = cosf(rr); XROPE[(size_t)e * 2 + 1] = sinf(rr);
            }
        }
    }
}

__device__ __forceinline__ void convert_weights(lptr lds, const Ctx& X, const Args& args, int l, int first, int stride, int tid) {
    for (int t = first; t < 416; t += stride) {
        if (t < 320) {
            const int kt = t / 20, ntl = t % 20;
            transpose_strip(lds, args.in[IN_WIN] + (size_t)l * D * DIN, DIN, DIN, XWIN + (size_t)l * NIN * D, D, args.in[IN_NORMW] + l * D, kt * 64, ntl * 256, tid);
        } else {
            const int r = t - 320, kt = r / 4, ntl = r % 4;
            transpose_strip(lds, args.in[IN_WOUT] + (size_t)l * DMIX * D, D, D, XWOUT + (size_t)l * D * DMIX, DMIX, nullptr, kt * 64, ntl * 256, tid);
        }
    }
}

__device__ __forceinline__ void conv8(const bf16_t* u, int seq0, int tt, int ch, const float* cw, const float* cb, float (&o)[8]) {
    float acc[8];
    { f32x4 b0 = *(const f32x4*)(cb + ch), b1 = *(const f32x4*)(cb + ch + 4);
#pragma unroll
      for (int j = 0; j < 4; ++j) { acc[j] = b0[j]; acc[4 + j] = b1[j]; } }
#pragma unroll
    for (int jj = 0; jj < 4; ++jj) {
        const int t2 = tt + jj - 3;
        if (t2 >= 0) {
            float x[8]; unpack8(*(const u32x4*)(u + (size_t)(seq0 + t2) * NIN + C_BX + ch), x);
            f32x4 w0 = *(const f32x4*)(cw + jj * 1024 + ch), w1 = *(const f32x4*)(cw + jj * 1024 + ch + 4);
#pragma unroll
            for (int j = 0; j < 4; ++j) { acc[j] += x[j] * w0[j]; acc[4 + j] += x[4 + j] * w1[j]; }
        }
    }
#pragma unroll
    for (int j = 0; j < 8; ++j) o[j] = siluf_(acc[j]);
}


__device__ __forceinline__ void conv8x8(const bf16_t* u, int seq0, int tt0, int ch, const float* cw, const float* cb, float (&o)[8][8]) {
    float w[4][8];
#pragma unroll
    for (int jj = 0; jj < 4; ++jj) { f32x4 w0 = *(const f32x4*)(cw + jj * 1024 + ch), w1 = *(const f32x4*)(cw + jj * 1024 + ch + 4);
#pragma unroll
        for (int j = 0; j < 4; ++j) { w[jj][j] = w0[j]; w[jj][4 + j] = w1[j]; } }
    { f32x4 b0 = *(const f32x4*)(cb + ch), b1 = *(const f32x4*)(cb + ch + 4);
#pragma unroll
      for (int t = 0; t < 8; ++t)
#pragma unroll
          for (int j = 0; j < 4; ++j) { o[t][j] = b0[j]; o[t][4 + j] = b1[j]; } }
    u32x4 raw[11];
#pragma unroll
    for (int r = 0; r < 11; ++r) {
        const int t2 = tt0 + r - 3;
        const u32x4 v = *(const u32x4*)(u + (unsigned)(seq0 + (t2 >= 0 ? t2 : 0)) * NIN + C_BX + ch);
        const unsigned msk = t2 >= 0 ? 0xffffffffu : 0u;
        raw[r] = (u32x4){v[0] & msk, v[1] & msk, v[2] & msk, v[3] & msk};
    }
#pragma unroll
    for (int r = 0; r < 11; ++r) {
        float x[8]; unpack8(raw[r], x);
#pragma unroll
        for (int jj = 0; jj < 4; ++jj) {
            const int t = r - jj;
            if (t >= 0 && t < 8) {
#pragma unroll
                for (int j = 0; j < 8; ++j) o[t][j] += x[j] * w[jj][j];
            }
        }
    }
#pragma unroll
    for (int t = 0; t < 8; ++t)
#pragma unroll
        for (int j = 0; j < 8; ++j) o[t][j] = siluf_(o[t][j]);
}

__device__ __forceinline__ void mlstm_local(lptr lds, const Ctx& X, int l, int task, int tid) {
    const int h = task & 3, c = (task >> 2) & 127, n = task >> 9;
    const int lane = tid & 63, wave = tid >> 6, fr = lane & 15, fq = lane >> 4;
    const int row0 = n * SEQ + c * 64, nh = n * 4 + h;
    lptr VwT = lds;
    lptr KT = lds + 18432;
    LAS float* wv = (LAS float*)(lds + 27648);
    const int tg = lane & 7, cgq = lane >> 3;
    u32x4 blk[8];
    if (wave >= 1 && wave <= 3) {
        const int col = wave < 3 ? C_AV + h * 128 + ((wave - 1) * 8 + cgq) * 8 : C_AK + h * 64 + cgq * 8;
#pragma unroll
        for (int t = 0; t < 8; ++t) blk[t] = *(const u32x4*)(XU + (unsigned)(row0 + 8 * tg + t) * NIN + col);
    }
    if (wave == 0) {
        const bf16_t* ur = XU + (unsigned)(row0 + lane) * NIN;
        const float fg = bf2f(ur[C_AF + h]) + XPAR(P_AFB)[l * 4 + h], ig = bf2f(ur[C_AI + h]) + XPAR(P_AIB)[l * 4 + h];
        const float b = wave_scan_sum(logsigf_(fg), lane);
        const float bl = lane63(b);
        const float g = bl - b + ig;
        const float ml = wave_max(g);
        wv[lane] = __expf(g - ml);
        if (lane == 0) { XML[nh * 128 + c] = ml; XBL[nh * 128 + c] = bl; }
    }
    __syncthreads();
    if (wave >= 1 && wave <= 3) {
        float xs[8][8];
#pragma unroll
        for (int t = 0; t < 8; ++t) { unpack8(blk[t], xs[t]); const float w = wave < 3 ? wv[8 * tg + t] : 0.125f;
#pragma unroll
            for (int j = 0; j < 8; ++j) xs[t][j] *= w; }
        lptr dstT = wave < 3 ? VwT + ((((wave - 1) * 8 + cgq) * 8 * 72) << 1) : KT + ((cgq * 8 * 72) << 1);
#pragma unroll
        for (int j = 0; j < 8; ++j) {
            float v[8];
#pragma unroll
            for (int t = 0; t < 8; ++t) v[t] = xs[t][j];
            *(LAS u32x4*)(dstT + ((j * 72 + 8 * tg) << 1)) = pack8(v);
        }
    }
    __syncthreads();
    {
        bf16_t* dst = (bf16_t*)XMC + ((size_t)nh * 128 + c) * 8192;
        bf16x8 b0 = lds_frag(VwT, 16 * wave + fr, fq * 8, 72), b1 = lds_frag(VwT, 16 * wave + fr, 32 + fq * 8, 72);
#pragma unroll
        for (int mt = 0; mt < 4; ++mt) {
            f32x4 acc = {0.f, 0.f, 0.f, 0.f};
            acc = mfma16(lds_frag(KT, 16 * mt + fr, fq * 8, 72), b0, acc);
            acc = mfma16(lds_frag(KT, 16 * mt + fr, 32 + fq * 8, 72), b1, acc);
            { u32x2 w; w[0] = pk2(acc[0], acc[1]); w[1] = pk2(acc[2], acc[3]); *(u32x2*)(dst + (16 * wave + fr) * 64 + 16 * mt + 4 * fq) = w; }
        }
    }
    if (tid < 64) {
        float s = 0.f;
#pragma unroll
        for (int t8 = 0; t8 < 8; ++t8) {
            float kf[8]; unpack8(*(const LAS u32x4*)(KT + ((tid * 72 + t8 * 8) << 1)), kf);
#pragma unroll
            for (int jx = 0; jx < 8; ++jx) s += kf[jx] * wv[t8 * 8 + jx];
        }
        XMN[((size_t)nh * 128 + c) * 64 + tid] = s;
    }
    __syncthreads();
}

__device__ __forceinline__ void ssd_local(lptr lds, const Ctx& X, int l, int task, int tid) {
    const int g = task & 1, c = (task >> 1) & 127, n = task >> 8;
    const int lane = tid & 63, wave = tid >> 6, fr = lane & 15, fq = lane >> 4;
    const int seq0 = n * SEQ, row0 = seq0 + c * 64;
    lptr XwT = lds;
    lptr BT = lds + 36864;
    LAS float* wl = (LAS float*)(lds + 55296);
    {
        const float* cw = XPAR(P_CW) + l * 4096; const float* cb = XPAR(P_CB) + l * 1024;
        const int tg = lane & 7, cg = wave * 8 + (lane >> 3);
        float o[8][8];
        if (wave < 6) {
            const int ch = cg < 32 ? g * 256 + cg * 8 : 512 + g * 128 + (cg - 32) * 8;
            conv8x8(XU, seq0, c * 64 + 8 * tg, ch, cw, cb, o);
        }
        if (wave < 4) {
            const int hh = 4 * g + wave;
            const float dt = softplusf_(bf2f(XU[(unsigned)(row0 + lane) * NIN + C_BDT + hh]) + XPAR(P_DTB)[l * 8 + hh]);
            const float A = -__expf(XPAR(P_ALOG)[l * 8 + hh]);
            const float a = wave_scan_sum(dt * A, lane);
            const float aL = lane63(a);
            wl[wave * 64 + lane] = __expf(aL - a) * dt;
            if (lane == 0) XSA[(n * 8 + hh) * 128 + c] = aL;
        }
        __syncthreads();
        if (wave < 4) {
            float wt[8];
#pragma unroll
            for (int t = 0; t < 8; ++t) wt[t] = wl[wave * 64 + 8 * tg + t];
#pragma unroll
            for (int jx = 0; jx < 8; ++jx) {
                float v[8];
#pragma unroll
                for (int t = 0; t < 8; ++t) v[t] = o[t][jx] * wt[t];
                *(LAS u32x4*)(XwT + (((cg * 8 + jx) * 72 + 8 * tg) << 1)) = pack8(v);
            }
        } else if (wave < 6) {
#pragma unroll
            for (int jx = 0; jx < 8; ++jx) {
                float v[8];
#pragma unroll
                for (int t = 0; t < 8; ++t) v[t] = o[t][jx];
                *(LAS u32x4*)(BT + ((((cg - 32) * 8 + jx) * 72 + 8 * tg) << 1)) = pack8(v);
            }
        }
    }
    __syncthreads();
    {
        const int hl = wave >> 1, ph = wave & 1, hh = 4 * g + hl;
        bf16_t* dst = (bf16_t*)XSH + ((size_t)(n * 8 + hh) * 128 + c) * 8192;
        bf16x8 bx[2][2];
#pragma unroll
        for (int ntl = 0; ntl < 2; ++ntl)
#pragma unroll
            for (int kk = 0; kk < 2; ++kk) bx[ntl][kk] = lds_frag(XwT, hl * 64 + ph * 32 + ntl * 16 + fr, kk * 32 + fq * 8, 72);
#pragma unroll
        for (int mt = 0; mt < 8; ++mt) {
            bf16x8 a0 = lds_frag(BT, 16 * mt + fr, fq * 8, 72), a1 = lds_frag(BT, 16 * mt + fr, 32 + fq * 8, 72);
#pragma unroll
            for (int ntl = 0; ntl < 2; ++ntl) {
                f32x4 acc = {0.f, 0.f, 0.f, 0.f};
                acc = mfma16(a0, bx[ntl][0], acc); acc = mfma16(a1, bx[ntl][1], acc);
                { u32x2 w; w[0] = pk2(acc[0], acc[1]); w[1] = pk2(acc[2], acc[3]); *(u32x2*)(dst + (ph * 32 + ntl * 16 + fr) * 128 + 16 * mt + 4 * fq) = w; }
            }
        }
    }
    __syncthreads();
}

__device__ __forceinline__ void swa_prompt(lptr lds, const Ctx& X, int l, int task, int tid) {
    const int kvh = task & 1, qb = (task >> 1) & 63, n = task >> 7;
    const int lane = tid & 63, wave = tid >> 6, fr = lane & 15, fq = lane >> 4;
    const int seq0 = n * SEQ;
    lptr Kn = lds;
    lptr Vt = lds + 36864;
    lptr Pw = lds + 70656 + wave * 8448;
    const float* knw = XPAR(P_KNW) + l * 64; const float* qnw = XPAR(P_QNW) + l * 64;
#pragma unroll
    for (int it = 0; it < 2; ++it) {
        const int item = tid + it * NT, j = item >> 2, qd = item & 3, t = qb * 128 - 128 + j;
        float o1[8], o2[8];
        {
            const int tc = t >= 0 ? t : 0;
            const bf16_t* kr = XU + (unsigned)(seq0 + tc) * NIN + C_CK + kvh * 64;
            float x1[8], x2[8]; unpack8(*(const u32x4*)(kr + qd * 8), x1); unpack8(*(const u32x4*)(kr + 32 + qd * 8), x2);
            float ss = 0.f;
#pragma unroll
            for (int jj = 0; jj < 8; ++jj) ss += x1[jj] * x1[jj] + x2[jj] * x2[jj];
            ss += __shfl_xor(ss, 1); ss += __shfl_xor(ss, 2);
            const float rs = rsqrtf(ss * (1.f / 64.f) + EPS);
            const f32x4* cs = (const f32x4*)(XROPE + ((size_t)tc * 32 + qd * 8) * 2);
            f32x4 csv[4];
#pragma unroll
            for (int q4 = 0; q4 < 4; ++q4) csv[q4] = cs[q4];
            const float zm = t >= 0 ? 1.f : 0.f;
#pragma unroll
            for (int jj = 0; jj < 8; ++jj) {
                const float a = x1[jj] * rs * knw[qd * 8 + jj], b = x2[jj] * rs * knw[32 + qd * 8 + jj], co = csv[jj >> 1][(jj & 1) * 2], si = csv[jj >> 1][(jj & 1) * 2 + 1];
                o1[jj] = (a * co - b * si) * zm; o2[jj] = (b * co + a * si) * zm;
            }
        }
        *(LAS u32x4*)(Kn + ((j * 72 + qd * 8) << 1)) = pack8(o1);
        *(LAS u32x4*)(Kn + ((j * 72 + 32 + qd * 8) << 1)) = pack8(o2);
        if (qb == 63 && j >= 128) {
            float* ko = X.out + O_PK + ((((size_t)l * 2 + n) * 128 + (j - 128)) * 2 + kvh) * 64;
            *(f32x4*)(ko + qd * 8) = (f32x4){o1[0], o1[1], o1[2], o1[3]}; *(f32x4*)(ko + qd * 8 + 4) = (f32x4){o1[4], o1[5], o1[6], o1[7]};
            *(f32x4*)(ko + 32 + qd * 8) = (f32x4){o2[0], o2[1], o2[2], o2[3]}; *(f32x4*)(ko + 32 + qd * 8 + 4) = (f32x4){o2[4], o2[5], o2[6], o2[7]};
        }
    }
    if (wave < 4) {
        const int tg = tid & 31, cg = tid >> 5;
        u32x4 vb[8];
#pragma unroll
        for (int t8 = 0; t8 < 8; ++t8) {
            const int jk = 8 * tg + t8, t = qb * 128 - 128 + jk;
            u32x4 w = *(const u32x4*)(XU + (unsigned)(seq0 + (t >= 0 ? t : 0)) * NIN + C_CV + kvh * 64 + cg * 8);
            const unsigned msk = t >= 0 ? 0xffffffffu : 0u;
            vb[t8] = (u32x4){w[0] & msk, w[1] & msk, w[2] & msk, w[3] & msk};
        }
#pragma unroll
        for (int jj = 0; jj < 8; ++jj) {
            u32x4 w;
#pragma unroll
            for (int tp = 0; tp < 4; ++tp) {
                const unsigned lo = (vb[2 * tp][jj >> 1] >> ((jj & 1) * 16)) & 0xffffu, hi = (vb[2 * tp + 1][jj >> 1] >> ((jj & 1) * 16)) & 0xffffu;
                w[tp] = lo | (hi << 16);
            }
            *(LAS u32x4*)(Vt + (((cg * 8 + jj) * 264 + 8 * tg) << 1)) = w;
        }
        if (qb == 63 && tg >= 16) {
#pragma unroll
            for (int t8 = 0; t8 < 8; ++t8) {
                float x[8]; unpack8(vb[t8], x);
                float* vo = X.out + O_PV + ((((size_t)l * 2 + n) * 128 + (8 * tg + t8 - 128)) * 2 + kvh) * 64 + cg * 8;
                *(f32x4*)(vo) = (f32x4){x[0], x[1], x[2], x[3]}; *(f32x4*)(vo + 4) = (f32x4){x[4], x[5], x[6], x[7]};
            }
        }
    }
    __syncthreads();
    const int hq = kvh * 4 + (wave >> 1), i0 = (wave & 1) * 64;
    const float sink = XPAR(P_SINK)[l * 8 + hq];
    float qw1[8], qw2[8];
#pragma unroll
    for (int jj = 0; jj < 8; ++jj) { qw1[jj] = qnw[fq * 8 + jj]; qw2[jj] = qnw[32 + fq * 8 + jj]; }
    u32x4 qn0, qn1; f32x4 csn[4];
    {
        const int t = qb * 128 + i0 + fr;
        const bf16_t* qr = XU + (unsigned)(seq0 + t) * NIN + C_CQ + hq * 64;
        qn0 = *(const u32x4*)(qr + fq * 8); qn1 = *(const u32x4*)(qr + 32 + fq * 8);
        const f32x4* cs = (const f32x4*)(XROPE + ((size_t)t * 32 + fq * 8) * 2);
#pragma unroll
        for (int q4 = 0; q4 < 4; ++q4) csn[q4] = cs[q4];
    }
#pragma unroll 1
    for (int mt = 0; mt < 4; ++mt) {
        const int q0 = i0 + mt * 16;
        const u32x4 q0r = qn0, q1r = qn1; f32x4 csc[4];
#pragma unroll
        for (int q4 = 0; q4 < 4; ++q4) csc[q4] = csn[q4];
        {
            const int mn = mt < 3 ? mt + 1 : 3;
            const int t = qb * 128 + i0 + mn * 16 + fr;
            const bf16_t* qr = XU + (unsigned)(seq0 + t) * NIN + C_CQ + hq * 64;
            qn0 = *(const u32x4*)(qr + fq * 8); qn1 = *(const u32x4*)(qr + 32 + fq * 8);
            const f32x4* cs = (const f32x4*)(XROPE + ((size_t)t * 32 + fq * 8) * 2);
#pragma unroll
            for (int q4 = 0; q4 < 4; ++q4) csn[q4] = cs[q4];
        }
        bf16x8 a0, a1;
        {
            float x1[8], x2[8]; unpack8(q0r, x1); unpack8(q1r, x2);
            float ss = 0.f;
#pragma unroll
            for (int jj = 0; jj < 8; ++jj) ss += x1[jj] * x1[jj] + x2[jj] * x2[jj];
            ss += __shfl_xor(ss, 16); ss += __shfl_xor(ss, 32);
            const float rs = rsqrtf(ss * (1.f / 64.f) + EPS) * 0.125f;
            float o1[8], o2[8];
#pragma unroll
            for (int jj = 0; jj < 8; ++jj) {
                const float a = x1[jj] * rs * qw1[jj], b = x2[jj] * rs * qw2[jj], co = csc[jj >> 1][(jj & 1) * 2], si = csc[jj >> 1][(jj & 1) * 2 + 1];
                o1[jj] = a * co - b * si; o2[jj] = b * co + a * si;
            }
            a0 = as_frag(pack8(o1)); a1 = as_frag(pack8(o2));
        }
        const int tlo = q0 >> 4;
        const int qi = q0 + fr;
        const int dlo = qb > 0 ? 1 : (128 - qi > 1 ? 128 - qi : 1);
        f32x4 s[16];
        float mx = -3.0e38f;
#pragma unroll
        for (int ntl = 0; ntl < 16; ++ntl) {
            if (ntl >= tlo && ntl <= tlo + 8) {
                f32x4 acc = {0.f, 0.f, 0.f, 0.f};
                acc = mfma16(lds_frag(Kn, 16 * ntl + fr, fq * 8, 72), a0, acc);
                acc = mfma16(lds_frag(Kn, 16 * ntl + fr, 32 + fq * 8, 72), a1, acc);
                if (ntl == tlo || ntl == tlo + 8 || qb == 0) {
#pragma unroll
                    for (int ii = 0; ii < 4; ++ii) {
                        const int dk = 16 * ntl + 4 * fq + ii - qi;
                        acc[ii] = ((unsigned)(dk - dlo) <= (unsigned)(128 - dlo)) ? acc[ii] : -3.0e38f;
                    }
                }
                mx = fmaxf(mx, fmaxf(fmaxf(acc[0], acc[1]), fmaxf(acc[2], acc[3])));
                s[ntl] = acc;
            }
        }
        mx = fmaxf(mx, __shfl_xor(mx, 16)); mx = fmaxf(mx, __shfl_xor(mx, 32));
        mx = fmaxf(mx, sink);
        float sum = 0.f;
#pragma unroll
        for (int ntl = 0; ntl < 16; ++ntl) {
            if (ntl >= tlo && ntl <= tlo + 8) {
#pragma unroll
                for (int ii = 0; ii < 4; ++ii) { const float e = __expf(s[ntl][ii] - mx); s[ntl][ii] = e; sum += e; }
            }
        }
        sum += __shfl_xor(sum, 16); sum += __shfl_xor(sum, 32);
        const float inv = rcpf_(sum + __expf(sink - mx));
        const int klo = q0 >> 5, khi = (q0 + 143) >> 5;
#pragma unroll
        for (int ntl = 0; ntl < 16; ++ntl) {
            if (ntl >= tlo && ntl <= tlo + 8) {
                u32x2 w; w[0] = pk2(s[ntl][0] * inv, s[ntl][1] * inv); w[1] = pk2(s[ntl][2] * inv, s[ntl][3] * inv);
                *(LAS u32x2*)(Pw + ((fr * 264 + 16 * ntl + 4 * fq) << 1)) = w;
            } else if ((ntl >> 1) >= klo && (ntl >> 1) <= khi) {
                u32x2 w = {0u, 0u};
                *(LAS u32x2*)(Pw + ((fr * 264 + 16 * ntl + 4 * fq) << 1)) = w;
            }
        }
        u32x2 czv[4];
#pragma unroll
        for (int ntl = 0; ntl < 4; ++ntl) czv[ntl] = *(const u32x2*)(XU + ((unsigned)seq0 + qb * 128 + q0 + fr) * NIN + C_CZ + hq * 64 + 16 * ntl + 4 * fq);
        LDS_FENCE();
        f32x4 o[4];
#pragma unroll
        for (int ntl = 0; ntl < 4; ++ntl) o[ntl] = (f32x4){0.f, 0.f, 0.f, 0.f};
#pragma unroll
        for (int kk = 0; kk < 8; ++kk) {
            if (kk >= klo && kk <= khi) {
                const bf16x8 a = lds_frag(Pw, fr, kk * 32 + fq * 8, 264);
#pragma unroll
                for (int ntl = 0; ntl < 4; ++ntl) o[ntl] = mfma16(lds_frag(Vt, 16 * ntl + fr, kk * 32 + fq * 8, 264), a, o[ntl]);
            }
        }
        LDS_FENCE();
        {
            const unsigned row = (unsigned)seq0 + qb * 128 + q0 + fr;
#pragma unroll
            for (int ntl = 0; ntl < 4; ++ntl) {
                const float z0 = __uint_as_float(czv[ntl][0] << 16), z1 = __uint_as_float(czv[ntl][0] & 0xffff0000u), z2 = __uint_as_float(czv[ntl][1] << 16), z3 = __uint_as_float(czv[ntl][1] & 0xffff0000u);
                u32x2 w; w[0] = pk2(o[ntl][0] * siluf_(z0), o[ntl][1] * siluf_(z1)); w[1] = pk2(o[ntl][2] * siluf_(z2), o[ntl][3] * siluf_(z3));
                *(u32x2*)(XMIX + row * DMIX + 1024 + hq * 64 + 16 * ntl + 4 * fq) = w;
            }
        }
    }
    __syncthreads();
}

__device__ __forceinline__ void sample_task(lptr lds, const Ctx& X, int l, int b, int part, int tid) {
    LAS float* uf = (LAS float*)lds;
    LAS float* xbc = (LAS float*)(lds + 19968);
    LAS float* numv = (LAS float*)(lds + 24064);
    LAS float* yv = (LAS float*)(lds + 26112);
    LAS float* red = (LAS float*)(lds + 28160);
    LAS float* qs = (LAS float*)(lds + 28416);
    LAS float* kn = (LAS float*)(lds + 30464);
    LAS float* sc = (LAS float*)(lds + 30976);
    const int lane = tid & 63, wave = tid >> 6;
    const size_t row = (size_t)TP + b;
    const bf16_t* ur = XU + row * NIN;
    const size_t lb = (size_t)l * 128 + b;
    f32x4 kpre[8], vpre[8];
    if (part == 2) {
        const float* kc = X.ck + lb * 16384; const float* vc = X.cv + lb * 16384;
#pragma unroll
        for (int it = 0; it < 8; ++it) {
            const int e = (tid + it * NT) * 4, e2 = e < 127 * 128 ? e + 128 : e;
            kpre[it] = __builtin_nontemporal_load((const f32x4*)(kc + e2)); vpre[it] = __builtin_nontemporal_load((const f32x4*)(vc + e2));
        }
    }
    {
        const int c_lo = part == 0 ? 0 : (part == 1 ? C_BZ : C_CQ), c_hi = part == 0 ? C_BZ : (part == 1 ? C_CQ : DIN);
#pragma unroll 2
        for (int i = c_lo + tid; i < c_hi; i += NT) uf[i] = bf2f(ur[i]);
    }
    __syncthreads();
    if (part == 0) {
#pragma unroll
    for (int h = 0; h < 4; ++h) {
        const float ig = uf[C_AI + h] + XPAR(P_AIB)[l * 4 + h], fg = uf[C_AF + h] + XPAR(P_AFB)[l * 4 + h];
        const float ls = logsigf_(fg), m0 = X.stM[lb * 4 + h];
        const float mn = fmaxf(ls + m0, ig), sp = __expf(ls + m0 - mn), sl = __expf(ig - mn);
        const float* C0 = X.stC + (lb * 4 + h) * 8192; float* C1 = X.out + O_SC + (lb * 4 + h) * 8192;
#pragma unroll
        for (int it = 0; it < 4; ++it) {
            const int e = (tid + it * NT) * 4, v = e >> 6, k = e & 63;
            const f32x4 c0 = __builtin_nontemporal_load((const f32x4*)(C0 + e));
            const float vv = uf[C_AV + h * 128 + v] * sl;
            f32x4 c1; float part = 0.f;
#pragma unroll
            for (int j = 0; j < 4; ++j) { c1[j] = sp * c0[j] + vv * (uf[C_AK + h * 64 + k + j] * 0.125f); part += c1[j] * uf[C_AQ + h * 64 + k + j]; }
            __builtin_nontemporal_store(c1, (f32x4*)(C1 + e));
            part = red16(part);
            if ((lane & 15) == 0) numv[h * 128 + v] = part;
        }
        if (wave == 0) {
            const float n1 = sp * X.stN[(lb * 4 + h) * 64 + lane] + sl * uf[C_AK + h * 64 + lane] * 0.125f;
            X.out[O_SN + (lb * 4 + h) * 64 + lane] = n1;
            const float dd = wave_sum(n1 * uf[C_AQ + h * 64 + lane]);
            if (lane == 0) { red[h] = dd; red[4 + h] = mn; X.out[O_SM + lb * 4 + h] = mn; }
        }
    }
    __syncthreads();
    float hv;
    { const int h = tid >> 7; hv = numv[tid] * rcpf_(fmaxf(fabsf(red[h]), __expf(-red[4 + h]))); const float ss = wave_sum(hv * hv); if (lane == 0) red[8 + wave] = ss; }
    __syncthreads();
    { const int h = tid >> 7; const float rs = rsqrtf((red[8 + 2 * h] + red[9 + 2 * h]) * (1.f / 128.f) + EPS);
      XMIX[row * DMIX + tid] = (bf16_t)f2bf(hv * rs * XPAR(P_ANW)[l * 512 + tid] * sigmoidf_(uf[C_AO + tid]) * siluf_(uf[C_AZ + tid])); }
    }
    if (part == 1) {
    {
        const float* buf = X.conv + lb * 3 * 1024; float* oc = X.out + O_SCONV + lb * 3 * 1024;
        const float* cw = XPAR(P_CW) + l * 4096;
#pragma unroll
        for (int it = 0; it < 2; ++it) {
            const int ch = tid + it * NT;
            const float f0 = buf[ch], f1 = buf[1024 + ch], f2 = buf[2048 + ch], f3 = uf[C_BX + ch];
            const float acc = XPAR(P_CB)[l * 1024 + ch] + f0 * cw[ch] + f1 * cw[1024 + ch] + f2 * cw[2048 + ch] + f3 * cw[3072 + ch];
            xbc[ch] = siluf_(acc);
            oc[ch] = f1; oc[1024 + ch] = f2; oc[2048 + ch] = f3;
        }
    }
    __syncthreads();
#pragma unroll 4
    for (int hh = 0; hh < 8; ++hh) {
        const float dt = softplusf_(uf[C_BDT + hh] + XPAR(P_DTB)[l * 8 + hh]);
        const float dA = __expf(-dt * __expf(XPAR(P_ALOG)[l * 8 + hh]));
        const int g = hh >> 2;
        const float* h0p = X.ssm + (lb * 8 + hh) * 8192; float* h1p = X.out + O_SH + (lb * 8 + hh) * 8192;
#pragma unroll
        for (int it = 0; it < 4; ++it) {
            const int e = (tid + it * NT) * 4, p = e >> 7, s = e & 127;
            const f32x4 h0 = __builtin_nontemporal_load((const f32x4*)(h0p + e));
            const float xv = xbc[hh * 64 + p] * dt;
            f32x4 h1; float part = 0.f;
#pragma unroll
            for (int j = 0; j < 4; ++j) { h1[j] = dA * h0[j] + xv * xbc[512 + g * 128 + s + j]; part += h1[j] * xbc[768 + g * 128 + s + j]; }
            __builtin_nontemporal_store(h1, (f32x4*)(h1p + e));
            part = red16(part); part += __shfl_xor(part, 16);
            if ((lane & 31) == 0) yv[hh * 64 + p] = part;
        }
    }
    __syncthreads();
    float gb;
    { const int hh = tid >> 6; const float y = yv[tid] + XPAR(P_BD)[l * 8 + hh] * xbc[tid]; gb = y * siluf_(uf[C_BZ + tid]); const float ss = wave_sum(gb * gb); if (lane == 0) red[16 + wave] = ss; }
    __syncthreads();
    { const int g = tid >> 8; const float rs = rsqrtf((red[16 + 4 * g] + red[17 + 4 * g] + red[18 + 4 * g] + red[19 + 4 * g]) * (1.f / 256.f) + EPS);
      XMIX[row * DMIX + 512 + tid] = (bf16_t)f2bf(gb * rs * XPAR(P_BNW)[l * 512 + tid]); }
    }
    if (part == 2) {
    lptr Kl = lds + 36864;
    lptr Vl = lds + 36864 + 34816;
    if (tid < 320) {
        const int vec = tid >> 5, d = tid & 31, base = vec < 8 ? C_CQ + vec * 64 : C_CK + (vec - 8) * 64;
        const float x1 = uf[base + d], x2 = uf[base + 32 + d];
        float ss = x1 * x1 + x2 * x2; ss = red16(ss); ss += __shfl_xor(ss, 16);
        const float rs = rsqrtf(ss * (1.f / 64.f) + EPS);
        const float* w = vec < 8 ? XPAR(P_QNW) + l * 64 : XPAR(P_KNW) + l * 64;
        const float a = x1 * rs * w[d], bb = x2 * rs * w[d + 32];
        const float co = XROPE[((size_t)8192 * 32 + d) * 2], si = XROPE[((size_t)8192 * 32 + d) * 2 + 1];
        const float o1 = a * co - bb * si, o2 = bb * co + a * si;
        if (vec < 8) { qs[vec * 64 + d] = o1 * 0.125f; qs[vec * 64 + 32 + d] = o2 * 0.125f; } else { kn[(vec - 8) * 64 + d] = o1; kn[(vec - 8) * 64 + 32 + d] = o2; }
    }
    __syncthreads();
    {
        float* ko = X.out + O_SK + lb * 16384; float* vo = X.out + O_SV + lb * 16384;
#pragma unroll
        for (int it = 0; it < 8; ++it) {
            const int e = (tid + it * NT) * 4, j = e >> 7, r = e & 127;
            f32x4 kv = kpre[it], vv = vpre[it];
            if (j == 127) { kv = (f32x4){kn[r], kn[r + 1], kn[r + 2], kn[r + 3]}; vv = (f32x4){uf[C_CV + r], uf[C_CV + r + 1], uf[C_CV + r + 2], uf[C_CV + r + 3]}; }
            __builtin_nontemporal_store(kv, (f32x4*)(ko + e)); __builtin_nontemporal_store(vv, (f32x4*)(vo + e));
            u32x2 wk, wv2; wk[0] = pk2(kv[0], kv[1]); wk[1] = pk2(kv[2], kv[3]); wv2[0] = pk2(vv[0], vv[1]); wv2[1] = pk2(vv[2], vv[3]);
            *(LAS u32x2*)(Kl + ((j * 136 + r) << 1)) = wk; *(LAS u32x2*)(Vl + ((j * 136 + r) << 1)) = wv2;
        }
    }
    __syncthreads();
    if (tid < 256) {
        const int kvh = tid >> 7, jj = tid & 127;
        float s0 = 0.f, s1 = 0.f, s2 = 0.f, s3 = 0.f;
#pragma unroll 2
        for (int d8 = 0; d8 < 8; ++d8) {
            float kf[8]; unpack8(*(const LAS u32x4*)(Kl + ((jj * 136 + kvh * 64 + d8 * 8) << 1)), kf);
#pragma unroll
            for (int j = 0; j < 8; ++j) {
                s0 += kf[j] * qs[(kvh * 4 + 0) * 64 + d8 * 8 + j]; s1 += kf[j] * qs[(kvh * 4 + 1) * 64 + d8 * 8 + j];
                s2 += kf[j] * qs[(kvh * 4 + 2) * 64 + d8 * 8 + j]; s3 += kf[j] * qs[(kvh * 4 + 3) * 64 + d8 * 8 + j];
            }
        }
        sc[(kvh * 4 + 0) * 128 + jj] = s0; sc[(kvh * 4 + 1) * 128 + jj] = s1; sc[(kvh * 4 + 2) * 128 + jj] = s2; sc[(kvh * 4 + 3) * 128 + jj] = s3;
    }
    __syncthreads();
    {
        const int hq = wave; const float s0 = sc[hq * 128 + lane], s1 = sc[hq * 128 + 64 + lane], sink = XPAR(P_SINK)[l * 8 + hq];
        const float m = fmaxf(wave_max(fmaxf(s0, s1)), sink);
        const float e0 = __expf(s0 - m), e1 = __expf(s1 - m);
        const float inv = rcpf_(wave_sum(e0 + e1) + __expf(sink - m));
        sc[hq * 128 + lane] = e0 * inv; sc[hq * 128 + 64 + lane] = e1 * inv;
    }
    __syncthreads();
    {
        const int hq = tid >> 6, d = tid & 63, kvh = hq >> 2;
        float o = 0.f;
#pragma unroll 16
        for (int jj = 0; jj < 128; ++jj) o += sc[hq * 128 + jj] * bf2f(*(const LAS bf16_t*)(Vl + ((jj * 136 + kvh * 64 + d) << 1)));
        XMIX[row * DMIX + 1024 + tid] = (bf16_t)f2bf(o * siluf_(uf[C_CZ + tid]));
    }
    }
    __syncthreads();
}

__device__ __forceinline__ void scans(const Ctx& X, int l, int gt, int nthreads) {
    for (int item = gt; item < 98816; item += nthreads) {
        if (item < 32768) {
            const int nh = item >> 12, e = (item & 4095) * 2;
            const bf16_t* base = (const bf16_t*)XMC + (size_t)nh * 128 * 8192 + e;
            const float* ml = XML + nh * 128; const float* bl = XBL + nh * 128;
            float m = 0.f; f32x2 st = {0.f, 0.f};
            for (int c0 = 0; c0 < 128; c0 += 16) {
                f32x2 cl[16];
#pragma unroll
                for (int j = 0; j < 16; ++j) { const unsigned w = *(const unsigned*)(base + (size_t)(c0 + j) * 8192); cl[j] = (f32x2){__uint_as_float(w << 16), __uint_as_float(w & 0xffff0000u)}; }
#pragma unroll
                for (int j = 0; j < 16; ++j) {
                    const float mlj = ml[c0 + j], blj = bl[c0 + j], mn = fmaxf(blj + m, mlj), sp = __expf(blj + m - mn), sl = __expf(mlj - mn);
                    *(unsigned*)(XCSB + ((size_t)nh * 128 + c0 + j) * 8192 + e) = pk2(st[0], st[1]);
                    if (e == 0) XMS[nh * 128 + c0 + j] = m;
                    st = st * sp + cl[j] * sl; m = mn;
                }
            }
            *(f32x2*)(X.out + O_PC + ((size_t)l * 8 + nh) * 8192 + e) = st;
            if (e == 0) X.out[O_PM + l * 8 + nh] = m;
        } else if (item < 98304) {
            const int i1 = item - 32768, nhh = i1 >> 12, e = (i1 & 4095) * 2;
            const bf16_t* base = (const bf16_t*)XSH + (size_t)nhh * 128 * 8192 + e;
            const float* al = XSA + nhh * 128;
            f32x2 st = {0.f, 0.f};
            for (int c0 = 0; c0 < 128; c0 += 16) {
                f32x2 cl[16];
#pragma unroll
                for (int j = 0; j < 16; ++j) { const unsigned w = *(const unsigned*)(base + (size_t)(c0 + j) * 8192); cl[j] = (f32x2){__uint_as_float(w << 16), __uint_as_float(w & 0xffff0000u)}; }
#pragma unroll
                for (int j = 0; j < 16; ++j) {
                    const float dec = __expf(al[c0 + j]);
                    *(unsigned*)(XHSB + ((size_t)nhh * 128 + c0 + j) * 8192 + e) = pk2(st[0], st[1]);
                    st = st * dec + cl[j];
                }
            }
            *(f32x2*)(X.out + O_PH + ((size_t)l * 16 + nhh) * 8192 + e) = st;
        } else {
            const int i2 = item - 98304, nh = i2 >> 6, k = i2 & 63;
            float* base = XMN + (size_t)nh * 128 * 64 + k;
            const float* ml = XML + nh * 128; const float* bl = XBL + nh * 128;
            float m = 0.f, st = 0.f;
            for (int c = 0; c < 128; ++c) {
                const float mlj = ml[c], blj = bl[c], mn = fmaxf(blj + m, mlj), sp = __expf(blj + m - mn), sl = __expf(mlj - mn);
                const float cl = base[c * 64];
                XNS[(size_t)nh * 128 * 64 + c * 64 + k] = st;
                st = st * sp + cl * sl; m = mn;
            }
            X.out[O_PN + ((size_t)l * 8 + nh) * 64 + k] = st;
        }
    }
}

__device__ __forceinline__ void mlstm_out(lptr lds, const Ctx& X, int l, int task, int tid) {
    const int h = task & 3, c = (task >> 2) & 127, n = task >> 9;
    const int lane = tid & 63, wave = tid >> 6, fr = lane & 15, fq = lane >> 4;
    const int row0 = n * SEQ + c * 64, nh = n * 4 + h;
    lptr Qs = lds;
    lptr Ks = lds + 9216;
    lptr Vt = lds + 18432;
    lptr Sb = lds + 36864 + wave * 2304;
    LAS float* bv = (LAS float*)(lds + 55296);
    LAS float* dv = bv + 64;
    LAS float* mtv = bv + 128;
    LAS float* siv = bv + 192;
    LAS float* qnv = bv + 256;
    LAS float* ssqp = bv + 384;
    LAS float* nsv = bv + 512;
    const int mti = wave >> 1, half = wave & 1;
    u32x4 csf[2][4];
    {
        const bf16_t* Cs = XCSB + ((size_t)nh * 128 + c) * 8192;
#pragma unroll
        for (int kk = 0; kk < 2; ++kk)
#pragma unroll
            for (int ntl = 0; ntl < 4; ++ntl) csf[kk][ntl] = *(const u32x4*)(Cs + (64 * half + 16 * ntl + fr) * 64 + kk * 32 + fq * 8);
    }
    u32x2 aov[4], azv[4]; f32x4 anw[4];
#pragma unroll
    for (int ntl = 0; ntl < 4; ++ntl) {
        const int v = h * 128 + 64 * half + 16 * ntl + 4 * fq;
        const unsigned row = (unsigned)row0 + 16 * mti + fr;
        anw[ntl] = *(const f32x4*)(XPAR(P_ANW) + l * 512 + v);
        aov[ntl] = *(const u32x2*)(XU + row * NIN + C_AO + v); azv[ntl] = *(const u32x2*)(XU + row * NIN + C_AZ + v);
    }
    u32x4 qraw, kraw, vblk[8];
    const int tgv = lane & 7, cgv = (wave & 1) * 8 + (lane >> 3);
    {
        const int tok = tid >> 3, k8 = (tid & 7) * 8;
        const bf16_t* ur = XU + (unsigned)(row0 + tok) * NIN;
        qraw = *(const u32x4*)(ur + C_AQ + h * 64 + k8); kraw = *(const u32x4*)(ur + C_AK + h * 64 + k8);
        if (wave == 2 || wave == 3) {
#pragma unroll
            for (int t = 0; t < 8; ++t) vblk[t] = *(const u32x4*)(XU + (unsigned)(row0 + 8 * tgv + t) * NIN + C_AV + h * 128 + cgv * 8);
        }
    }
    if (wave == 0) {
        const bf16_t* ur = XU + (unsigned)(row0 + lane) * NIN;
        const float fg = bf2f(ur[C_AF + h]) + XPAR(P_AFB)[l * 4 + h], ig = bf2f(ur[C_AI + h]) + XPAR(P_AIB)[l * 4 + h];
        const float b = wave_scan_sum(logsigf_(fg), lane);
        const float dd = ig - b;
        const float cm = wave_scan_max(dd, lane);
        const float ms = XMS[nh * 128 + c];
        const float mt = b + fmaxf(ms, cm);
        bv[lane] = b; dv[lane] = dd; mtv[lane] = mt; siv[lane] = __expf(b + ms - mt);
        nsv[lane] = XNS[((size_t)nh * 128 + c) * 64 + lane];
    }
    {
        const int tok = tid >> 3, k8 = (tid & 7) * 8;
        *(LAS u32x4*)(Qs + ((tok * 72 + k8) << 1)) = qraw;
        float x[8]; unpack8(kraw, x);
#pragma unroll
        for (int j = 0; j < 8; ++j) x[j] *= 0.125f;
        *(LAS u32x4*)(Ks + ((tok * 72 + k8) << 1)) = pack8(x);
    }
    if (wave == 2 || wave == 3) {
#pragma unroll
        for (int j = 0; j < 8; ++j) {
            u32x4 w;
#pragma unroll
            for (int tp = 0; tp < 4; ++tp) {
                const unsigned lo = (vblk[2 * tp][j >> 1] >> ((j & 1) * 16)) & 0xffffu, hi = (vblk[2 * tp + 1][j >> 1] >> ((j & 1) * 16)) & 0xffffu;
                w[tp] = lo | (hi << 16);
            }
            *(LAS u32x4*)(Vt + (((cgv * 8 + j) * 72 + 8 * tgv) << 1)) = w;
        }
    }
    __syncthreads();
    bf16x8 qa[2];
    qa[0] = lds_frag(Qs, 16 * mti + fr, fq * 8, 72); qa[1] = lds_frag(Qs, 16 * mti + fr, 32 + fq * 8, 72);
    const int tq = 16 * mti + fr;
    float qn;
    {
        float x0[8], x1[8]; unpack8(__builtin_bit_cast(u32x4, qa[0]), x0); unpack8(__builtin_bit_cast(u32x4, qa[1]), x1);
        float d = 0.f;
#pragma unroll
        for (int j = 0; j < 8; ++j) d += x0[j] * nsv[fq * 8 + j] + x1[j] * nsv[32 + fq * 8 + j];
        d += __shfl_xor(d, 16); d += __shfl_xor(d, 32);
        qn = d;
    }
    const float bt = bv[tq], mtq = mtv[tq], siq = siv[tq];
    float rsum = 0.f;
#pragma unroll
    for (int ntl = 0; ntl < 4; ++ntl) {
        f32x4 sT = {0.f, 0.f, 0.f, 0.f};
        sT = mfma16(lds_frag(Ks, 16 * ntl + fr, fq * 8, 72), qa[0], sT);
        sT = mfma16(lds_frag(Ks, 16 * ntl + fr, 32 + fq * 8, 72), qa[1], sT);
        float sv[4];
#pragma unroll
        for (int ii = 0; ii < 4; ++ii) {
            const int sidx = 16 * ntl + 4 * fq + ii;
            const float wgt = (sidx <= tq) ? __expf(bt + dv[sidx] - mtq) : 0.f;
            sv[ii] = wgt * sT[ii];
            rsum += sv[ii];
        }
        u32x2 w; w[0] = pk2(sv[0], sv[1]); w[1] = pk2(sv[2], sv[3]);
        *(LAS u32x2*)(Sb + ((fr * 72 + 16 * ntl + 4 * fq) << 1)) = w;
    }
    rsum += __shfl_xor(rsum, 16); rsum += __shfl_xor(rsum, 32);
    const float inv = rcpf_(fmaxf(fabsf(rsum + siq * qn), __expf(-mtq)));
    LDS_FENCE();
    f32x4 acc[4];
#pragma unroll
    for (int ntl = 0; ntl < 4; ++ntl) acc[ntl] = (f32x4){0.f, 0.f, 0.f, 0.f};
#pragma unroll
    for (int kk = 0; kk < 2; ++kk) {
        const bf16x8 sb = lds_frag(Sb, fr, kk * 32 + fq * 8, 72);
#pragma unroll
        for (int ntl = 0; ntl < 4; ++ntl) acc[ntl] = mfma16(lds_frag(Vt, 64 * half + 16 * ntl + fr, kk * 32 + fq * 8, 72), sb, acc[ntl]);
    }
#pragma unroll
    for (int kk = 0; kk < 2; ++kk) {
        float x[8]; unpack8(__builtin_bit_cast(u32x4, qa[kk]), x);
#pragma unroll
        for (int j = 0; j < 8; ++j) x[j] *= siq;
        const bf16x8 qs = as_frag(pack8(x));
#pragma unroll
        for (int ntl = 0; ntl < 4; ++ntl) acc[ntl] = mfma16(as_frag(csf[kk][ntl]), qs, acc[ntl]);
    }
    {
        float ss = 0.f;
#pragma unroll
        for (int ntl = 0; ntl < 4; ++ntl) { acc[ntl] = acc[ntl] * inv; ss += acc[ntl][0] * acc[ntl][0] + acc[ntl][1] * acc[ntl][1] + acc[ntl][2] * acc[ntl][2] + acc[ntl][3] * acc[ntl][3]; }
        ss += __shfl_xor(ss, 16); ss += __shfl_xor(ss, 32);
        if (fq == 0) ssqp[tq * 2 + half] = ss;
    }
    __syncthreads();
    {
        const float rs = rsqrtf((ssqp[tq * 2] + ssqp[tq * 2 + 1]) * (1.f / 128.f) + EPS);
        const unsigned row = (unsigned)row0 + tq;
#pragma unroll
        for (int ntl = 0; ntl < 4; ++ntl) {
            const float o[4] = {__uint_as_float(aov[ntl][0] << 16), __uint_as_float(aov[ntl][0] & 0xffff0000u), __uint_as_float(aov[ntl][1] << 16), __uint_as_float(aov[ntl][1] & 0xffff0000u)};
            const float z[4] = {__uint_as_float(azv[ntl][0] << 16), __uint_as_float(azv[ntl][0] & 0xffff0000u), __uint_as_float(azv[ntl][1] << 16), __uint_as_float(azv[ntl][1] & 0xffff0000u)};
            float y[4];
#pragma unroll
            for (int ii = 0; ii < 4; ++ii) y[ii] = acc[ntl][ii] * rs * anw[ntl][ii] * sigmoidf_(o[ii]) * siluf_(z[ii]);
            u32x2 w; w[0] = pk2(y[0], y[1]); w[1] = pk2(y[2], y[3]);
            *(u32x2*)(XMIX + row * DMIX + h * 128 + 64 * half + 16 * ntl + 4 * fq) = w;
        }
    }
    __syncthreads();
}

__device__ __forceinline__ void ssd_out(lptr lds, const Ctx& X, int l, int task, int tid) {
    const int g = task & 1, c = (task >> 1) & 127, n = task >> 8;
    const int lane = tid & 63, wave = tid >> 6, fr = lane & 15, fq = lane >> 4;
    const int seq0 = n * SEQ, row0 = seq0 + c * 64;
    lptr Cm = lds;
    lptr Bm = lds + 17408;
    lptr Xt = lds + 34816;
    LAS float* CBf = (LAS float*)(lds + 71680);
    LAS float* av = (LAS float*)(lds + 89088);
    LAS float* dtv = (LAS float*)(lds + 90112);
    LAS float* ssq = (LAS float*)(lds + 91136);
    const int hl = wave >> 1, th = wave & 1, hh = 4 * g + hl;
    u32x4 hsf[4][4];
    {
        const bf16_t* hs = XHSB + ((size_t)(n * 8 + hh) * 128 + c) * 8192;
#pragma unroll
        for (int kk = 0; kk < 4; ++kk)
#pragma unroll
            for (int ntl = 0; ntl < 4; ++ntl) hsf[kk][ntl] = *(const u32x4*)(hs + (16 * ntl + fr) * 128 + kk * 32 + fq * 8);
    }
    if (wave < 4) {
        const int hh = 4 * g + wave;
        const float dt = softplusf_(bf2f(XU[(unsigned)(row0 + lane) * NIN + C_BDT + hh]) + XPAR(P_DTB)[l * 8 + hh]);
        const float A = -__expf(XPAR(P_ALOG)[l * 8 + hh]);
        av[wave * 64 + lane] = wave_scan_sum(dt * A, lane);
        dtv[wave * 64 + lane] = dt;
    }
    {
        const float* cw = XPAR(P_CW) + l * 4096; const float* cb = XPAR(P_CB) + l * 1024;
        float o[8][8];
        if (wave < 4) {
            const int tg = lane & 7, cg = wave * 8 + (lane >> 3);
            conv8x8(XU, seq0, c * 64 + 8 * tg, g * 256 + cg * 8, cw, cb, o);
#pragma unroll
            for (int jx = 0; jx < 8; ++jx) {
                float v[8];
#pragma unroll
                for (int t = 0; t < 8; ++t) v[t] = o[t][jx];
                *(LAS u32x4*)(Xt + (((cg * 8 + jx) * 72 + 8 * tg) << 1)) = pack8(v);
            }
        } else {
            const int tg = lane >> 3, s8 = ((wave & 1) * 8 + (lane & 7)) * 8;
            conv8x8(XU, seq0, c * 64 + 8 * tg, (wave < 6 ? 512 : 768) + g * 128 + s8, cw, cb, o);
            lptr dstm = wave < 6 ? Bm : Cm;
#pragma unroll
            for (int t = 0; t < 8; ++t) *(LAS u32x4*)(dstm + (((8 * tg + t) * 136 + s8) << 1)) = pack8(o[t]);
        }
    }
    __syncthreads();
    u32x2 bzv[2][4]; f32x4 bnw[4];
#pragma unroll
    for (int ntl = 0; ntl < 4; ++ntl) {
        bnw[ntl] = *(const f32x4*)(XPAR(P_BNW) + l * 512 + hh * 64 + 16 * ntl + 4 * fq);
#pragma unroll
        for (int mi = 0; mi < 2; ++mi) bzv[mi][ntl] = *(const u32x2*)(XU + ((unsigned)row0 + 16 * (2 * th + mi) + fr) * NIN + C_BZ + hh * 64 + 16 * ntl + 4 * fq);
    }
    {
        const int mt = wave >> 1;
#pragma unroll
        for (int q = 0; q < 2; ++q) {
            const int ntl = 2 * (wave & 1) + q;
            f32x4 acc = {0.f, 0.f, 0.f, 0.f};
#pragma unroll
            for (int kk = 0; kk < 4; ++kk) acc = mfma16(lds_frag(Cm, 16 * mt + fr, kk * 32 + fq * 8, 136), lds_frag(Bm, 16 * ntl + fr, kk * 32 + fq * 8, 136), acc);
#pragma unroll
            for (int ii = 0; ii < 4; ++ii) CBf[(16 * mt + fq * 4 + ii) * 68 + 16 * ntl + fr] = acc[ii];
        }
    }
    __syncthreads();
    f32x4 y1[2][4], y2[2][4];
#pragma unroll
    for (int mi = 0; mi < 2; ++mi)
#pragma unroll
        for (int ntl = 0; ntl < 4; ++ntl) { y1[mi][ntl] = (f32x4){0.f, 0.f, 0.f, 0.f}; y2[mi][ntl] = (f32x4){0.f, 0.f, 0.f, 0.f}; }
#pragma unroll
    for (int kk = 0; kk < 2; ++kk) {
        bf16x8 bx[4];
#pragma unroll
        for (int ntl = 0; ntl < 4; ++ntl) bx[ntl] = lds_frag(Xt, hl * 64 + 16 * ntl + fr, kk * 32 + fq * 8, 72);
#pragma unroll
        for (int mi = 0; mi < 2; ++mi) {
            const int t = 16 * (2 * th + mi) + fr, u0 = kk * 32 + fq * 8;
            const float at = av[hl * 64 + t];
            float w[8];
#pragma unroll
            for (int j = 0; j < 8; ++j) {
                const int uu = u0 + j;
                w[j] = (uu <= t) ? CBf[t * 68 + uu] * __expf(at - av[hl * 64 + uu]) * dtv[hl * 64 + uu] : 0.f;
            }
            const bf16x8 a = as_frag(pack8(w));
#pragma unroll
            for (int ntl = 0; ntl < 4; ++ntl) y1[mi][ntl] = mfma16(bx[ntl], a, y1[mi][ntl]);
        }
    }
    {
#pragma unroll
        for (int kk = 0; kk < 4; ++kk) {
            bf16x8 bh[4];
#pragma unroll
            for (int ntl = 0; ntl < 4; ++ntl) bh[ntl] = as_frag(hsf[kk][ntl]);
#pragma unroll
            for (int mi = 0; mi < 2; ++mi) {
                const bf16x8 a = lds_frag(Cm, 16 * (2 * th + mi) + fr, kk * 32 + fq * 8, 136);
#pragma unroll
                for (int ntl = 0; ntl < 4; ++ntl) y2[mi][ntl] = mfma16(bh[ntl], a, y2[mi][ntl]);
            }
        }
    }
    const float Dh = XPAR(P_BD)[l * 8 + hh];
#pragma unroll
    for (int mi = 0; mi < 2; ++mi) {
        const int t = 16 * (2 * th + mi) + fr;
        const float ea = __expf(av[hl * 64 + t]);
        float ss = 0.f;
#pragma unroll
        for (int ntl = 0; ntl < 4; ++ntl) {
            const float z[4] = {__uint_as_float(bzv[mi][ntl][0] << 16), __uint_as_float(bzv[mi][ntl][0] & 0xffff0000u), __uint_as_float(bzv[mi][ntl][1] << 16), __uint_as_float(bzv[mi][ntl][1] & 0xffff0000u)};
#pragma unroll
            for (int ii = 0; ii < 4; ++ii) {
                const int p = 16 * ntl + 4 * fq + ii;
                const float xv = bf2f(*(const LAS bf16_t*)(Xt + (((hl * 64 + p) * 72 + t) << 1)));
                const float y = y1[mi][ntl][ii] + ea * y2[mi][ntl][ii] + Dh * xv;
                const float gbv = y * siluf_(z[ii]);
                y1[mi][ntl][ii] = gbv; ss += gbv * gbv;
            }
        }
        ss += __shfl_xor(ss, 16); ss += __shfl_xor(ss, 32);
        if (fq == 0) ssq[t * 4 + hl] = ss;
    }
    __syncthreads();
#pragma unroll
    for (int mi = 0; mi < 2; ++mi) {
        const int t = 16 * (2 * th + mi) + fr;
        const float rs = rsqrtf((ssq[t * 4] + ssq[t * 4 + 1] + ssq[t * 4 + 2] + ssq[t * 4 + 3]) * (1.f / 256.f) + EPS);
        const unsigned row = (unsigned)row0 + t;
#pragma unroll
        for (int ntl = 0; ntl < 4; ++ntl) {
            u32x2 w; w[0] = pk2(y1[mi][ntl][0] * rs * bnw[ntl][0], y1[mi][ntl][1] * rs * bnw[ntl][1]); w[1] = pk2(y1[mi][ntl][2] * rs * bnw[ntl][2], y1[mi][ntl][3] * rs * bnw[ntl][3]);
            *(u32x2*)(XMIX + row * DMIX + 512 + hh * 64 + 16 * ntl + 4 * fq) = w;
        }
    }
    __syncthreads();
}


#define XB_TMO      128
#define XB_XCNT(j)  (256  + 64 * (j))
#define XB_XSUB(j)  (1280 + 64 * (j))
#define XB_XGEN(j)  (2304 + 64 * (j))
#define XB_TOP      3328
#define XB_TOPGEN   3392
#define XCD_BAR_WORDS 3456
#define XB_SPIN_CAP (1u << 18)
__device__ __forceinline__ unsigned xb_ld(unsigned* p)              { return __hip_atomic_load(p, __ATOMIC_RELAXED, __HIP_MEMORY_SCOPE_AGENT); }
__device__ __forceinline__ unsigned xb_add(unsigned* p, unsigned v) { return __hip_atomic_fetch_add(p, v, __ATOMIC_RELAXED, __HIP_MEMORY_SCOPE_AGENT); }
__device__ __forceinline__ unsigned xb_xcc_id() { return (unsigned)__builtin_amdgcn_s_getreg((3 << 11) | 20) & 0xFu; }
#define XB_SPIN(cond, bar) do { unsigned _sp = 0; while (cond) { __builtin_amdgcn_s_sleep(1); \
    if ((++_sp & 255u) == 0u) { if (xb_ld(&(bar)[XB_TMO])) break; if (_sp > XB_SPIN_CAP) { atomicAdd(&(bar)[XB_TMO], 1u); break; } } } } while (0)
struct XcdBarrier { unsigned* bar; unsigned x; volatile LAS unsigned* st; };
__device__ __forceinline__ XcdBarrier xcd_barrier_post(unsigned* bar, volatile LAS unsigned* st) {
    XcdBarrier b; b.bar = bar; b.x = xb_xcc_id(); b.st = st;
    if (threadIdx.x == 0) (void)xb_add(&bar[XB_XCNT(b.x)], 1u);
    return b;
}
__device__ __forceinline__ void xcd_barrier_complete(unsigned* bar, unsigned x, unsigned& nloc, unsigned& nx) {
    const unsigned G = gridDim.x * gridDim.y * gridDim.z;
    unsigned sum, cnt, mine, sp = 0u;
    for (;;) {
        sum = 0u; cnt = 0u; mine = 0u;
#pragma unroll
        for (unsigned j = 0; j < 16; ++j) { const unsigned c = xb_ld(&bar[XB_XCNT(j)]); sum += c; cnt += (c > 0u) ? 1u : 0u; mine = (j == x) ? c : mine; }
        if (sum == G) break;
        __builtin_amdgcn_s_sleep(1);
        if ((++sp & 255u) == 0u) { if (xb_ld(&bar[XB_TMO])) break; if (sp > XB_SPIN_CAP) { atomicAdd(&bar[XB_TMO], 1u); break; } }
    }
    nloc = mine > 0u ? mine : 1u; nx = cnt > 0u ? cnt : 1u;
}
__device__ __forceinline__ void xcd_barrier(const XcdBarrier& b) {
    asm volatile("s_waitcnt vmcnt(0)" ::: "memory");
    __syncthreads();
    if (threadIdx.x == 0) {
        unsigned* bar = b.bar;
        __builtin_amdgcn_s_waitcnt(0);
        unsigned nloc = b.st[0], nx = b.st[1];
        if (nloc == 0u) { xcd_barrier_complete(bar, b.x, nloc, nx); b.st[0] = nloc; b.st[1] = nx; }
        const unsigned old = xb_add(&bar[XB_XSUB(b.x)], 1u);
        const unsigned gen = old / nloc;
        if (old + 1u == (gen + 1u) * nloc) {
            __builtin_amdgcn_fence(__ATOMIC_RELEASE, "agent");
            asm volatile("s_waitcnt vmcnt(0)" ::: "memory");
            const unsigned og = xb_add(&bar[XB_TOP], 1u);
            const unsigned tg = og / nx;
            if (og + 1u == (tg + 1u) * nx) xb_add(&bar[XB_TOPGEN], 1u);
            else XB_SPIN(xb_ld(&bar[XB_TOPGEN]) == tg, bar);
            __builtin_amdgcn_fence(__ATOMIC_ACQUIRE, "agent");
            xb_add(&bar[XB_XGEN(b.x)], 1u);
            asm volatile("s_waitcnt vmcnt(0)" ::: "memory");
        } else {
            XB_SPIN(xb_ld(&bar[XB_XGEN(b.x)]) == gen, bar);
            __builtin_amdgcn_fence(__ATOMIC_ACQUIRE, "agent");
            asm volatile("s_waitcnt vmcnt(0)" ::: "memory");
        }
    }
    __syncthreads();
}

__global__ void __launch_bounds__(NT, 2) mega(Args args) {
    __shared__ __attribute__((aligned(16))) unsigned char lds_raw[LDS_BYTES];
    lptr lds = (lptr)lds_raw;
    cg::grid_group grid = cg::this_grid();
    const int tid = threadIdx.x, bid = blockIdx.x, G = gridDim.x;
    Ctx X;
    X.xp = args.in[IN_XP]; X.xs = args.in[IN_XS]; X.stC = args.in[IN_STC]; X.stN = args.in[IN_STN]; X.stM = args.in[IN_STM]; X.ssm = args.in[IN_SSM];
    X.conv = args.in[IN_CONV]; X.ck = args.in[IN_CK]; X.cv = args.in[IN_CV]; X.out = args.out; X.ws = args.ws;
    const int lo = args.ph_lo, hi = args.ph_hi;
    volatile LAS unsigned* xst = (volatile LAS unsigned*)(lds + LDS_BYTES - 16);
    if (tid == 0) { xst[0] = 0u; xst[1] = 0u; }
    __syncthreads();
    XcdBarrier xbar = xcd_barrier_post((unsigned*)(args.ws + WS_BAR), xst);
#define IN(k) (lo <= (k) && (k) < hi)
#define SEAM(k) do { if (IN(k) && IN((k) + 1)) { for (int _r = 0; _r < REP_SYNC; ++_r) { if (lo < 0) grid.sync(); xcd_barrier(xbar); } } } while (0)
    if (IN(0)) { for (int _r = 0; _r < REP_P0; ++_r) prologue(lds, X, args, G, bid, tid); }
    SEAM(0);
    for (int l = 0; l < 4; ++l) {
        const int pb = 1 + l * 5;
        if (IN(pb)) for (int _r = 0; _r < REP_P1; ++_r) {
            pg8::Gemm g{XXB, XWIN + (size_t)l * NIN * D, MPAD, NIN, D}; pg8::StaticOrder S; S.init(TP, NIN, G, bid);
            pg8::EpiU E{XU, XSSQ};
            pg8::gemm_phase<pg8::EpiU, pg8::StaticOrder, false, GEMM_SP2, GEMM_ALIGN>(lds, g, S, E, OPQ(tid));
            if (l == 0 && bid >= G - 20) {
                pg8::SampleOrder S2{G - 20, 20, bid}; pg8::EpiUh E2{XU, XSSQ};
                pg8::gemm_phase<pg8::EpiUh, pg8::SampleOrder, true>(lds, g, S2, E2, OPQ(tid));
            }
        }
        SEAM(pb);
        if (IN(pb + 1)) for (int _r = 0; _r < REP_P2; ++_r) {
            for (int t = bid; t < 256; t += G) for (int _q = 0; _q < RT_SAMPLE; ++_q) {
                if (t < 128) sample_task(lds, X, l, t, 1, OPQ(tid));
                else { sample_task(lds, X, l, t - 128, 0, OPQ(tid)); sample_task(lds, X, l, t - 128, 2, OPQ(tid)); }
            }
            for (int t = bid; t < 256; t += G) {
                const int tx = (G == 256) ? ((t & 7) >> 2) * 128 + (32 * (t & 1) + (t >> 3)) * 2 + ((t >> 1) & 1) : t;
                for (int _q = 0; _q < RT_SWA; ++_q) swa_prompt(lds, X, l, tx, OPQ(tid));
            }
            for (int t = bid; t < 512; t += G) for (int _q = 0; _q < RT_SLOC; ++_q) ssd_local(lds, X, l, t, OPQ(tid));
            for (int t = bid; t < 1024; t += G) for (int _q = 0; _q < RT_MLOC; ++_q) mlstm_local(lds, X, l, t, OPQ(tid));
            if (bid == G - 1) {
                for (int i = tid; i < 2 * 3 * 1024; i += NT) {
                    const int ch = i & 1023, j = (i >> 10) % 3, n = i / 3072;
                    X.out[O_PCONV + (((size_t)l * 2 + n) * 3 + j) * 1024 + ch] = bf2f(XU[(size_t)(n * SEQ + SEQ - 3 + j) * NIN + C_BX + ch]);
                }
            }
        }
        SEAM(pb + 1);
        if (IN(pb + 2)) {
            if (bid >= G - 4) {
                pg8::Gemm g{XMIX, XWOUT + (size_t)l * D * DMIX, MPAD, D, DMIX}; pg8::SampleOrder S{G - 4, 4, bid};
                if (l == 0) { pg8::EpiRes_<1, 0> E{X.xp, X.xs, X.out, XXB, XSSQ}; pg8::gemm_phase<pg8::EpiRes_<1, 0>, pg8::SampleOrder, true>(lds, g, S, E, OPQ(tid)); }
                else if (l < 3) { pg8::EpiRes_<1, 1> E{X.xp, X.xs, X.out, XXB, XSSQ}; pg8::gemm_phase<pg8::EpiRes_<1, 1>, pg8::SampleOrder, true>(lds, g, S, E, OPQ(tid)); }
                else { pg8::EpiRes_<1, 2> E{X.xp, X.xs, X.out, XXB, XSSQ}; pg8::gemm_phase<pg8::EpiRes_<1, 2>, pg8::SampleOrder, true>(lds, g, S, E, OPQ(tid)); }
            }
            if (l < 3) {
                if (G - 4 - 193 >= 16) { if (bid >= 193 && bid < G - 4) convert_weights(lds, X, args, l + 1, bid - 193, G - 4 - 193, OPQ(tid)); }
                else convert_weights(lds, X, args, l + 1, bid, G, OPQ(tid));
            }
            for (int _r = 0; _r < REP_P3; ++_r) scans(X, l, bid * NT + OPQ(tid), G * NT);
        }
        SEAM(pb + 2);
        if (IN(pb + 3)) for (int _r = 0; _r < REP_P4; ++_r) {
            for (int task = bid; task < 1536; task += G) {
                if (task < 512) for (int _q = 0; _q < RT_SOUT; ++_q) ssd_out(lds, X, l, task, OPQ(tid));
                else mlstm_out(lds, X, l, task - 512, OPQ(tid));
            }
        }
        SEAM(pb + 3);
        if (IN(pb + 4)) {
            {
                pg8::Gemm g{XMIX, XWOUT + (size_t)l * D * DMIX, MPAD, D, DMIX}; pg8::StaticOrder S; S.init(TP, D, G, bid);
#ifdef PROBE_P5
                { pg8::EpiProbe EP{(const unsigned*)(X.ws + 64), XSSQ}; pg8::gemm_phase<pg8::EpiProbe, pg8::StaticOrder, false, GEMM_SP2>(lds, g, S, EP, OPQ(tid)); }
#endif
                if (l == 0) { pg8::EpiRes_<2, 0> E{X.xp, X.xs, X.out, XXB, XSSQ}; pg8::gemm_phase<pg8::EpiRes_<2, 0>, pg8::StaticOrder, false, GEMM_SP2, GEMM_ALIGN>(lds, g, S, E, OPQ(tid)); }
                else if (l < 3) { pg8::EpiRes_<2, 1> E{X.xp, X.xs, X.out, XXB, XSSQ}; pg8::gemm_phase<pg8::EpiRes_<2, 1>, pg8::StaticOrder, false, GEMM_SP2, GEMM_ALIGN>(lds, g, S, E, OPQ(tid)); }
                else { pg8::EpiRes_<2, 2> E{X.xp, X.xs, X.out, XXB, XSSQ}; pg8::gemm_phase<pg8::EpiRes_<2, 2>, pg8::StaticOrder, false, GEMM_SP2, GEMM_ALIGN>(lds, g, S, E, OPQ(tid)); }
            }
            if (l < 3 && bid < 20) {
                pg8::Gemm g{XXB, XWIN + (size_t)(l + 1) * NIN * D, MPAD, NIN, D}; pg8::SampleOrder S{0, 20, bid};
                pg8::EpiUh E{XU, XSSQ};
                pg8::gemm_phase<pg8::EpiUh, pg8::SampleOrder, true>(lds, g, S, E, OPQ(tid));
            }
        }
        SEAM(pb + 4);
    }
#undef IN
#undef SEAM
}

extern "C" void kernel_launch(void* const* d_in, const int* in_sizes, int n_in, void* d_out, int out_size, void* d_ws, size_t ws_size, hipStream_t stream) {
    static int grid_blocks = 0;
    if (!grid_blocks) {
        int dev = 0, cus = 0, per_cu = 0;
        hipGetDevice(&dev);
        hipDeviceGetAttribute(&cus, hipDeviceAttributeMultiprocessorCount, dev);
        hipOccupancyMaxActiveBlocksPerMultiprocessor(&per_cu, mega, NT, 0);
        if (per_cu < 1) { fprintf(stderr, "occupancy query returned %d\n", per_cu); per_cu = 1; }
        grid_blocks = cus * 1;
        if (ws_size < WS_END) fprintf(stderr, "workspace too small: %zu < %zu\n", ws_size, (size_t)WS_END);
    }
    (void)hipMemsetAsync(d_ws, 0, 16384, stream);
    Args a{};
    for (int i = 0; i < 24; ++i) a.in[i] = (const float*)d_in[i];
    a.out = (float*)d_out; a.ws = (unsigned char*)d_ws;
    const int NPH = 21;
#if MULTI_LAUNCH
    for (int p = 0; p < NPH; ++p) {
        a.ph_lo = p; a.ph_hi = p + 1;
        void* kargs[] = {&a};
        hipError_t e = hipLaunchCooperativeKernel((void*)mega, dim3(grid_blocks), dim3(NT), kargs, 0, stream);
        if (e != hipSuccess) fprintf(stderr, "cooperative launch failed: %s (grid %d)\n", hipGetErrorString(e), grid_blocks);
    }
#else
    a.ph_lo = 0; a.ph_hi = NPH;
    void* kargs[] = {&a};
    hipError_t e = hipLaunchCooperativeKernel((void*)mega, dim3(grid_blocks), dim3(NT), kargs, 0, stream);
    if (e != hipSuccess) fprintf(stderr, "cooperative launch failed: %s (grid %d)\n", hipGetErrorString(e), grid_blocks);
#endif
}
```

```cpp
#include <hip/hip_runtime.h>
#include <hip/hip_cooperative_groups.h>
#include <cstdio>
#include <cstdint>
namespace cg = cooperative_groups;

#ifndef REP_SYNC
#define REP_SYNC 1
#endif
#ifndef REP_P1
#define REP_P1 1
#endif
#ifndef REP_P2
#define REP_P2 1
#endif
#ifndef REP_P3
#define REP_P3 1
#endif
#ifndef REP_P0
#define REP_P0 1
#endif
#ifndef REP_P4
#define REP_P4 1
#endif
#ifndef RT_SAMPLE
#define RT_SAMPLE 1
#endif
#ifndef RT_SWA
#define RT_SWA 1
#endif
#ifndef RT_SLOC
#define RT_SLOC 1
#endif
#ifndef RT_MLOC
#define RT_MLOC 1
#endif
#ifndef RT_SOUT
#define RT_SOUT 1
#endif
#ifndef GEMM_SP2
#define GEMM_SP2 true
#endif
#ifndef GEMM_ALIGN
#define GEMM_ALIGN true
#endif
#ifndef MULTI_LAUNCH
#define MULTI_LAUNCH 0
#endif

#define LAS __attribute__((address_space(3)))
typedef unsigned short bf16_t;
typedef short bf16x8 __attribute__((ext_vector_type(8)));
typedef float f32x4 __attribute__((ext_vector_type(4)));
typedef float f32x2 __attribute__((ext_vector_type(2)));
typedef unsigned u32x4 __attribute__((ext_vector_type(4)));
typedef unsigned u32x2 __attribute__((ext_vector_type(2)));
typedef __bf16 bf16x2_t __attribute__((ext_vector_type(2)));
typedef LAS unsigned char* lptr;

constexpr int D = 1024, DIN = 4880, NIN = 5120, DMIX = 1536, TP = 16384, MTOK = 16512, MPAD = 16640, SEQ = 8192;
constexpr int C_AQ = 0, C_AK = 256, C_AV = 512, C_AO = 1024, C_AZ = 1536, C_AI = 2048, C_AF = 2052, C_BZ = 2056, C_BX = 2568, C_BB = 3080, C_BC = 3336,
              C_BDT = 3592, C_CQ = 3600, C_CK = 4112, C_CV = 4240, C_CZ = 4368;
constexpr float EPS = 1e-6f;
constexpr size_t O_YP = 0, O_YS = 16777216, O_PC = 16908288, O_PN = 17170432, O_PM = 17172480, O_PH = 17172512, O_PCONV = 17696800, O_PK = 17721376,
                 O_PV = 17852448, O_SC = 17983520, O_SN = 34760736, O_SM = 34891808, O_SH = 34893856, O_SCONV = 68448288, O_SK = 70021152, O_SV = 78409760;
constexpr size_t WS_BAR = 0;
constexpr size_t WS_PAR = 16384;
constexpr size_t WS_WIN = WS_PAR + 102400;
constexpr size_t WS_WOUT = WS_WIN + (size_t)4 * NIN * D * 2;
constexpr size_t WS_XB = WS_WOUT + (size_t)4 * D * DMIX * 2;
constexpr size_t WS_U = WS_XB + (size_t)MPAD * D * 2;
constexpr size_t WS_MIX = WS_U + (size_t)MPAD * NIN * 2;
constexpr size_t WS_SSQ = WS_MIX + (size_t)MPAD * DMIX * 2;
constexpr size_t WS_ROPE = WS_SSQ + (size_t)MPAD * 16 * 4;
constexpr size_t WS_MC = WS_ROPE + (size_t)8200 * 64 * 4;
constexpr size_t WS_MN = WS_MC + (size_t)8 * 128 * 8192 * 4;
constexpr size_t WS_ML = WS_MN + (size_t)8 * 128 * 64 * 4;
constexpr size_t WS_BL = WS_ML + 4096;
constexpr size_t WS_MS = WS_BL + 4096;
constexpr size_t WS_SA = WS_MS + 4096;
constexpr size_t WS_SH = WS_SA + 8192;
constexpr size_t WS_CSB = WS_SH + (size_t)16 * 128 * 8192 * 4;
constexpr size_t WS_HSB = WS_CSB + (size_t)8 * 128 * 8192 * 2;
constexpr size_t WS_NS = WS_HSB + (size_t)16 * 128 * 8192 * 2;
constexpr size_t WS_END = WS_NS + (size_t)8 * 128 * 64 * 4;
constexpr int LDS_BYTES = 139264;
constexpr int NT = 512;

struct Args { const float* in[24]; float* out; unsigned char* ws; int ph_lo, ph_hi; };

__device__ __forceinline__ float bf2f(unsigned v) { return __uint_as_float(v << 16); }
__device__ __forceinline__ unsigned pk2(float lo, float hi) { f32x2 v = {lo, hi}; bf16x2_t b = __builtin_convertvector(v, bf16x2_t); return __builtin_bit_cast(unsigned, b); }
__device__ __forceinline__ unsigned f2bf(float f) { return pk2(f, 0.f) & 0xffffu; }
__device__ __forceinline__ void unpack8(u32x4 w, float (&f)[8]) {
#pragma unroll
    for (int i = 0; i < 4; ++i) { f[2 * i] = __uint_as_float(w[i] << 16); f[2 * i + 1] = __uint_as_float(w[i] & 0xffff0000u); }
}
__device__ __forceinline__ u32x4 pack8(const float (&f)[8]) { u32x4 w; w[0] = pk2(f[0], f[1]); w[1] = pk2(f[2], f[3]); w[2] = pk2(f[4], f[5]); w[3] = pk2(f[6], f[7]); return w; }
__device__ __forceinline__ u32x4 pack8v(f32x4 a, f32x4 b) { u32x4 w; w[0] = pk2(a[0], a[1]); w[1] = pk2(a[2], a[3]); w[2] = pk2(b[0], b[1]); w[3] = pk2(b[2], b[3]); return w; }
__device__ __forceinline__ bf16x8 as_frag(u32x4 w) { return __builtin_bit_cast(bf16x8, w); }
__device__ __forceinline__ bf16x8 ldg_f32_frag(const float* p) { f32x4 a = *(const f32x4*)p, b = *(const f32x4*)(p + 4); return as_frag(pack8v(a, b)); }
__device__ __forceinline__ bf16x8 lds_frag(lptr base, int row, int k, int stride) { return *(const LAS bf16x8*)(base + ((row * stride + k) << 1)); }
__device__ __forceinline__ f32x4 mfma16(bf16x8 a, bf16x8 b, f32x4 c) { return __builtin_amdgcn_mfma_f32_16x16x32_bf16(a, b, c, 0, 0, 0); }
__device__ __forceinline__ float rcpf_(float x) { return __builtin_amdgcn_rcpf(x); }
__device__ __forceinline__ float sigmoidf_(float x) { return rcpf_(1.f + __expf(-x)); }
__device__ __forceinline__ float siluf_(float x) { return x * rcpf_(1.f + __expf(-x)); }
__device__ __forceinline__ float softplusf_(float x) { return x > 20.f ? x : __logf(1.f + __expf(x)); }
__device__ __forceinline__ float logsigf_(float x) { return fminf(x, 0.f) - __logf(1.f + __expf(-fabsf(x))); }
template <int CTRL, int RM> __device__ __forceinline__ float dpps(float ident, float v) { return __int_as_float(__builtin_amdgcn_update_dpp(__float_as_int(ident), __float_as_int(v), CTRL, RM, 0xf, false)); }
__device__ __forceinline__ float wave_scan_sum(float v, int) {
    v += dpps<0x111, 0xf>(0.f, v); v += dpps<0x112, 0xf>(0.f, v); v += dpps<0x114, 0xf>(0.f, v); v += dpps<0x118, 0xf>(0.f, v);
    v += dpps<0x142, 0xa>(0.f, v); v += dpps<0x143, 0xc>(0.f, v);
    return v;
}
__device__ __forceinline__ float wave_scan_max(float v, int) {
    const float NI = -3.0e38f;
    v = fmaxf(v, dpps<0x111, 0xf>(NI, v)); v = fmaxf(v, dpps<0x112, 0xf>(NI, v)); v = fmaxf(v, dpps<0x114, 0xf>(NI, v)); v = fmaxf(v, dpps<0x118, 0xf>(NI, v));
    v = fmaxf(v, dpps<0x142, 0xa>(NI, v)); v = fmaxf(v, dpps<0x143, 0xc>(NI, v));
    return v;
}
__device__ __forceinline__ float lane63(float v) { return __int_as_float(__builtin_amdgcn_readlane(__float_as_int(v), 63)); }
__device__ __forceinline__ float red16(float v);
__device__ __forceinline__ float red16max(float v);
__device__ __forceinline__ float wave_sum(float v) { v = red16(v); v += __shfl_xor(v, 16); v += __shfl_xor(v, 32); return v; }
__device__ __forceinline__ float wave_max(float v) { v = red16max(v); v = fmaxf(v, __shfl_xor(v, 16)); v = fmaxf(v, __shfl_xor(v, 32)); return v; }
template <int CTRL> __device__ __forceinline__ float dppf(float v) { return __int_as_float(__builtin_amdgcn_update_dpp(0, __float_as_int(v), CTRL, 0xf, 0xf, true)); }
__device__ __forceinline__ float red16(float v) { v += dppf<0xB1>(v); v += dppf<0x4E>(v); v += dppf<0x141>(v); v += dppf<0x140>(v); return v; }
__device__ __forceinline__ float red16max(float v) { v = fmaxf(v, dppf<0xB1>(v)); v = fmaxf(v, dppf<0x4E>(v)); v = fmaxf(v, dppf<0x141>(v)); v = fmaxf(v, dppf<0x140>(v)); return v; }
__device__ __forceinline__ int OPQ(int v) { asm volatile("" : "+v"(v)); return v; }
#define LDS_FENCE() asm volatile("s_waitcnt lgkmcnt(0)" ::: "memory")

namespace pg8 {
constexpr int BM = 256, BK = 64, HALF = 128, HTB = HALF * BK * 2, STAGE_BYTES = 8 * HTB, NXCD = 8, WGM = 8;
__host__ __device__ __forceinline__ int lds_byte(int r, int c) { const int st = (r >> 4) * 2 + (c >> 5), rr = r & 15, cc = c & 31, ob = rr * 64 + cc * 2; return st * 1024 + (ob ^ (((ob >> 9) & 1) << 5)); }
__host__ __device__ __forceinline__ void stage_rc(int b, int& R, int& C) { const int st = b / 1024, sb = b % 1024, swz = sb ^ (((sb >> 9) & 1) << 5); R = (st >> 1) * 16 + swz / 64; C = (st & 1) * 32 + (swz % 64) / 2; }
__host__ __device__ __forceinline__ int perm32(int rho) { const int n = rho >> 4, i = rho & 15; return 8 * (i >> 2) + 4 * n + (i & 3); }
struct Unit { int pm, pn; };
struct Gemm { const bf16_t* A; const bf16_t* Bt; int M, N, K; };
struct StaticOrder {
    int nM, nN, nwg, G, c;
    __device__ void init(int M, int N, int G_, int c_) { nM = M / BM; nN = N / BM; nwg = nM * nN; G = G_; c = c_; }
    __device__ bool next(int i, Unit& u) const {
        const long L = (long)i * G + c; if (L >= nwg) return false;
        int wgid = (int)L; { const int q = nwg / NXCD, r = nwg % NXCD, xcd = wgid % NXCD, off = wgid / NXCD; wgid = (xcd < r ? xcd * (q + 1) : r * (q + 1) + (xcd - r) * q) + off; }
        const int nig = WGM * nN, gid = wgid / nig, fm = gid * WGM, gsz = (nM - fm) < WGM ? (nM - fm) : WGM;
        u.pm = fm + ((wgid % nig) % gsz); u.pn = (wgid % nig) / gsz; return true;
    }
};
template <int NAI> struct EpiU_ {
    bf16_t* U; const float* ssq;
    __device__ __forceinline__ void operator()(const f32x4 (&acc)[2][2][4][2], const Unit& u, int wr, int wc, int fr, int fq) const {
        const int row0 = u.pm * BM + wr * 64 + fr, col0 = u.pn * BM + wc * 32 + 8 * fq;
        f32x4 sq[NAI][4];
#pragma unroll
        for (int ai = 0; ai < NAI; ++ai)
#pragma unroll
            for (int m = 0; m < 4; ++m) sq[ai][m] = *(const f32x4*)(ssq + (size_t)(row0 + ai * HALF + m * 16) * 16 + fq * 4);
#pragma unroll
        for (int ai = 0; ai < NAI; ++ai)
#pragma unroll
            for (int m = 0; m < 4; ++m) {
                const int r = row0 + ai * HALF + m * 16;
                const f32x4 s = sq[ai][m];
                float st = s[0] + s[1] + s[2] + s[3]; st += __shfl_xor(st, 16); st += __shfl_xor(st, 32);
                const float rs = rsqrtf(st * (1.f / 1024.f) + EPS);
                bf16_t* rowp = U + (size_t)r * NIN + col0;
#pragma unroll
                for (int bj = 0; bj < 2; ++bj) *(u32x4*)(rowp + bj * HALF) = pack8v(acc[ai][bj][m][0] * rs, acc[ai][bj][m][1] * rs);
                __builtin_amdgcn_sched_barrier(0);
            }
    }
};
template <int NAI, int MODE> struct EpiRes_ {
    const float* xp; const float* xs; float* out; bf16_t* xb; float* ssq;
    __device__ __forceinline__ void operator()(const f32x4 (&acc)[2][2][4][2], const Unit& u, int wr, int wc, int fr, int fq) const {
        const int row0 = u.pm * BM + wr * 64 + fr, col0 = u.pn * BM + wc * 32 + 8 * fq;
#pragma unroll
        for (int ai = 0; ai < NAI; ++ai) {
            u32x4 xo[4][2];
            if (MODE != 0) {
#pragma unroll
                for (int m = 0; m < 4; ++m)
#pragma unroll
                    for (int bj = 0; bj < 2; ++bj) xo[m][bj] = *(const u32x4*)(xb + (size_t)(row0 + ai * HALF + m * 16) * D + col0 + bj * HALF);
            }
#pragma unroll
            for (int m = 0; m < 4; ++m) {
                const int r = row0 + ai * HALF + m * 16;
                const bool valid = r < MTOK;
                float part = 0.f;
#pragma unroll
                for (int bj = 0; bj < 2; ++bj) {
                    const int c = col0 + bj * HALF;
                    f32x4 o0 = {0.f, 0.f, 0.f, 0.f}, o1 = {0.f, 0.f, 0.f, 0.f};
                    if (MODE == 0) {
                        const float* src = r < TP ? xp + (size_t)r * D : xs + (size_t)(r - TP) * D;
                        if (valid) { o0 = __builtin_nontemporal_load((const f32x4*)(src + c)); o1 = __builtin_nontemporal_load((const f32x4*)(src + c + 4)); }
                    } else {
                        float f[8]; unpack8(xo[m][bj], f);
                        o0 = (f32x4){f[0], f[1], f[2], f[3]}; o1 = (f32x4){f[4], f[5], f[6], f[7]};
                    }
                    const f32x4 v0 = acc[ai][bj][m][0] + o0, v1 = acc[ai][bj][m][1] + o1;
                    if (MODE == 2) {
                        if (valid) { __builtin_nontemporal_store(v0, (f32x4*)(out + (size_t)r * D + c)); __builtin_nontemporal_store(v1, (f32x4*)(out + (size_t)r * D + c + 4)); }
                    } else {
                        *(u32x4*)(xb + (size_t)r * D + c) = pack8v(v0, v1);
                        part += v0[0] * v0[0] + v0[1] * v0[1] + v0[2] * v0[2] + v0[3] * v0[3] + v1[0] * v1[0] + v1[1] * v1[1] + v1[2] * v1[2] + v1[3] * v1[3];
                    }
                }
                if (MODE != 2) {
                    part += __shfl_xor(part, 16); part += __shfl_xor(part, 32);
                    if (fq == 0) ssq[(size_t)r * 16 + u.pn * 4 + wc] = part;
                }
                __builtin_amdgcn_sched_barrier(0);
            }
        }
    }
};

typedef EpiU_<2> EpiU; typedef EpiU_<1> EpiUh;
struct EpiProbe {
    const unsigned* flag; float* dst;
    __device__ __forceinline__ void operator()(const f32x4 (&acc)[2][2][4][2], const Unit& u, int wr, int wc, int fr, int fq) const {
        if (__hip_atomic_load(flag, __ATOMIC_RELAXED, __HIP_MEMORY_SCOPE_AGENT) == 12345u) {
            f32x4 t = {0.f, 0.f, 0.f, 0.f};
#pragma unroll
            for (int a = 0; a < 2; ++a)
#pragma unroll
                for (int b = 0; b < 2; ++b)
#pragma unroll
                    for (int m = 0; m < 4; ++m)
#pragma unroll
                        for (int n = 0; n < 2; ++n) t += acc[a][b][m][n];
            *(f32x4*)(dst + (size_t)(u.pm * 4 + u.pn) * 2048 + (wr * 4 + wc) * 256 + (fq * 16 + fr) * 4) = t;
        }
    }
};
struct SampleOrder {
    int first, cnt, c;
    __device__ bool next(int i, Unit& u) const { if (i != 0 || c < first || c >= first + cnt) return false; u.pm = 64; u.pn = c - first; return true; }
};
template <class Epi, class Sched, bool HALF_M = false, bool SP2 = false, bool ALIGN_EPI = false>
__device__ __forceinline__ void gemm_phase(lptr lds, const Gemm g, const Sched& S, const Epi& E, const int tid) {
    const int wid = __builtin_amdgcn_readfirstlane(tid >> 6), lane = tid & 63, wr = wid >> 2, wc = wid & 3, fr = lane & 15, fq = lane >> 4;
    const int K = g.K, nt = K / BK;
    unsigned voffA[2], voffB[2];
#pragma unroll
    for (int i = 0; i < 2; ++i) { int R, C; stage_rc(tid * 16 + i * 8192, R, C); const int Rb = (R & ~31) + perm32(R & 31);
        voffA[i] = (unsigned)(R * K + C) * 2u; voffB[i] = (unsigned)(Rb * K + C) * 2u; }
    const size_t kstep = (size_t)(BK * 2);
    const size_t hstep = (size_t)HALF * K * 2;
    const size_t tstep = 2 * hstep;
    const unsigned ldsw = (unsigned)wid * 1024u;
    const int aoff = lds_byte(wr * 64 + fr, fq * 8), boff = lds_byte(wc * 32 + fr, fq * 8);
#define PG8_SA(b, h) (((b) * 2 + (h)) * HTB)
#define PG8_SB(b, h) ((4 + (b) * 2 + (h)) * HTB)
#define PG8_STAGE(bufoff, gbase, voff) do { _Pragma("unroll") for (int _i = 0; _i < 2; ++_i) \
        __builtin_amdgcn_global_load_lds((const unsigned*)((const char*)(gbase) + (voff)[_i]), (LAS unsigned*)(lds + (bufoff) + ldsw + _i * 8192), 16, 0, 0); } while (0)
#define PG8_LDA(dst, b, h) do { _Pragma("unroll") for (int m = 0; m < 4; ++m) _Pragma("unroll") for (int k = 0; k < 2; ++k) dst[m][k] = *(const LAS bf16x8*)(lds + PG8_SA(b, h) + aoff + m * 2048 + k * 1024); } while (0)
#define PG8_LDB(dst, b, h) do { _Pragma("unroll") for (int n = 0; n < 2; ++n) _Pragma("unroll") for (int k = 0; k < 2; ++k) dst[n][k] = *(const LAS bf16x8*)(lds + PG8_SB(b, h) + boff + n * 2048 + k * 1024); } while (0)
#define PG8_MMA(ai, bj, At, Bt) do { __builtin_amdgcn_s_setprio(1); _Pragma("unroll") for (int m = 0; m < 4; ++m) _Pragma("unroll") for (int n = 0; n < 2; ++n) _Pragma("unroll") for (int k = 0; k < 2; ++k) \
        acc[ai][bj][m][n] = __builtin_amdgcn_mfma_f32_16x16x32_bf16(Bt[n][k], At[m][k], acc[ai][bj][m][n], 0, 0, 0); __builtin_amdgcn_s_setprio(0); } while (0)
#define PG8_WAIT_V(n) asm volatile("s_waitcnt vmcnt(" #n ")" ::: "memory")
#define PG8_WAIT_L(n) asm volatile("s_waitcnt lgkmcnt(" #n ")" ::: "memory")
#define PG8_BAR __builtin_amdgcn_s_barrier()
#define PG8_SCHED __builtin_amdgcn_sched_barrier(0)
    Unit cur, nxt; int ui = 0;
    if (!S.next(0, cur)) return;
    f32x4 acc[2][2][4][2];
#pragma unroll
    for (int a = 0; a < 2; ++a)
#pragma unroll
        for (int b = 0; b < 2; ++b)
#pragma unroll
            for (int m = 0; m < 4; ++m)
#pragma unroll
                for (int n = 0; n < 2; ++n) acc[a][b][m][n] = (f32x4){0.f, 0.f, 0.f, 0.f};
    bf16x8 At[4][2], B0[2][2], B1[2][2];
    const char* cA = (const char*)g.A + (size_t)cur.pm * tstep; const char* cB = (const char*)g.Bt + (size_t)cur.pn * tstep;
    if constexpr (SP2) {
        PG8_STAGE(PG8_SB(0, 0), cB, voffB); PG8_STAGE(PG8_SB(0, 1), cB + hstep, voffB); PG8_STAGE(PG8_SA(0, 0), cA, voffA); PG8_STAGE(PG8_SA(0, 1), cA + hstep, voffA);
        if (wr == 1) PG8_BAR;
        PG8_WAIT_V(2); PG8_BAR;
        PG8_STAGE(PG8_SB(1, 0), cB + kstep, voffB); PG8_STAGE(PG8_SA(1, 0), cA + kstep, voffA); PG8_STAGE(PG8_SB(1, 1), cB + hstep + kstep, voffB);
        PG8_WAIT_V(6); PG8_BAR;
    } else {
    PG8_STAGE(PG8_SB(0, 0), cB, voffB); PG8_STAGE(PG8_SA(0, 0), cA, voffA); PG8_STAGE(PG8_SB(0, 1), cB + hstep, voffB); PG8_STAGE(PG8_SA(0, 1), cA + hstep, voffA);
    if (wr == 1) PG8_BAR;
    PG8_WAIT_V(4); PG8_BAR;
    PG8_STAGE(PG8_SB(1, 0), cB + kstep, voffB); PG8_STAGE(PG8_SA(1, 0), cA + kstep, voffA); PG8_STAGE(PG8_SB(1, 1), cB + hstep + kstep, voffB);
    PG8_WAIT_V(6); PG8_BAR;
    }
    for (;;) {
        const bool has_next = S.next(ui + 1, nxt);
        const char* nA = has_next ? (const char*)g.A + (size_t)nxt.pm * tstep : cA; const char* nB = has_next ? (const char*)g.Bt + (size_t)nxt.pn * tstep : cB;
        for (int t = 0; t < nt; t += 2) {
            const bool last = (t == nt - 2);
            const char* a1 = cA + (size_t)(t + 1) * kstep;
            const char* a2 = last ? nA : cA + (size_t)(t + 2) * kstep; const char* b2 = last ? nB : cB + (size_t)(t + 2) * kstep;
            const char* a3 = a2 + kstep; const char* b3 = b2 + kstep;
            if constexpr (SP2) {
            PG8_LDB(B0, 0, 0); PG8_LDB(B1, 0, 1); PG8_SCHED; PG8_LDA(At, 0, 0); PG8_STAGE(PG8_SA(1, 1), a1 + hstep, voffA);
            PG8_WAIT_V(8); PG8_WAIT_L(0); PG8_BAR; PG8_MMA(0, 0, At, B0); PG8_MMA(0, 1, At, B1); PG8_BAR; PG8_SCHED;
            PG8_LDA(At, 0, 1); PG8_STAGE(PG8_SB(0, 0), b2, voffB); PG8_STAGE(PG8_SB(0, 1), b2 + hstep, voffB); PG8_STAGE(PG8_SA(0, 0), a2, voffA);
            PG8_WAIT_V(8); PG8_WAIT_L(0); PG8_BAR; PG8_MMA(1, 0, At, B0); PG8_MMA(1, 1, At, B1); PG8_BAR; PG8_SCHED;
            PG8_LDB(B0, 1, 0); PG8_LDB(B1, 1, 1); PG8_SCHED; PG8_LDA(At, 1, 0); PG8_STAGE(PG8_SA(0, 1), a2 + hstep, voffA);
            PG8_WAIT_V(8); PG8_WAIT_L(0); PG8_BAR; PG8_MMA(0, 0, At, B0); PG8_MMA(0, 1, At, B1); PG8_BAR; PG8_SCHED;
            PG8_LDA(At, 1, 1); PG8_STAGE(PG8_SB(1, 0), b3, voffB); PG8_STAGE(PG8_SB(1, 1), b3 + hstep, voffB); PG8_STAGE(PG8_SA(1, 0), a3, voffA);
            PG8_WAIT_V(8); PG8_WAIT_L(0); PG8_BAR; PG8_MMA(1, 0, At, B0); PG8_MMA(1, 1, At, B1); PG8_BAR; PG8_SCHED;
            } else {
            PG8_LDB(B0, 0, 0); PG8_SCHED; PG8_LDA(At, 0, 0); PG8_STAGE(PG8_SA(1, 1), a1 + hstep, voffA);
            PG8_WAIT_L(8); PG8_BAR; PG8_WAIT_L(0); PG8_MMA(0, 0, At, B0); PG8_BAR; PG8_SCHED;
            PG8_LDB(B1, 0, 1); PG8_STAGE(PG8_SB(0, 0), b2, voffB);
            PG8_BAR; PG8_WAIT_L(0); PG8_MMA(0, 1, At, B1); PG8_BAR;
            if constexpr (!HALF_M) PG8_LDA(At, 0, 1);
            PG8_STAGE(PG8_SA(0, 0), a2, voffA);
            PG8_BAR; PG8_WAIT_L(0); if constexpr (!HALF_M) PG8_MMA(1, 0, At, B0); PG8_BAR; PG8_SCHED;
            PG8_STAGE(PG8_SB(0, 1), b2 + hstep, voffB);
            PG8_WAIT_V(6); PG8_BAR; if constexpr (!HALF_M) PG8_MMA(1, 1, At, B1); PG8_BAR;
            PG8_LDB(B0, 1, 0); PG8_SCHED; PG8_LDA(At, 1, 0); PG8_STAGE(PG8_SA(0, 1), a2 + hstep, voffA);
            PG8_WAIT_L(8); PG8_BAR; PG8_WAIT_L(0); PG8_MMA(0, 0, At, B0); PG8_BAR; PG8_SCHED;
            PG8_LDB(B1, 1, 1); PG8_STAGE(PG8_SB(1, 0), b3, voffB);
            PG8_BAR; PG8_WAIT_L(0); PG8_MMA(0, 1, At, B1); PG8_BAR;
            if constexpr (!HALF_M) PG8_LDA(At, 1, 1);
            PG8_STAGE(PG8_SA(1, 0), a3, voffA);
            PG8_BAR; PG8_WAIT_L(0); if constexpr (!HALF_M) PG8_MMA(1, 0, At, B0); PG8_BAR; PG8_SCHED;
            PG8_STAGE(PG8_SB(1, 1), b3 + hstep, voffB);
            PG8_WAIT_V(6); PG8_BAR; if constexpr (!HALF_M) PG8_MMA(1, 1, At, B1); PG8_BAR;
            }
        }
        if constexpr (ALIGN_EPI) { if (wr == 0) PG8_BAR; }
        E(acc, cur, wr, wc, fr, fq);
        if (!has_next) break;
#pragma unroll
        for (int a = 0; a < 2; ++a)
#pragma unroll
            for (int b = 0; b < 2; ++b)
#pragma unroll
                for (int m = 0; m < 4; ++m)
#pragma unroll
                    for (int n = 0; n < 2; ++n) acc[a][b][m][n] = (f32x4){0.f, 0.f, 0.f, 0.f};
        cur = nxt; cA = nA; cB = nB; ++ui;
        if constexpr (ALIGN_EPI) { if (wr == 1) PG8_BAR; }
    }
    PG8_WAIT_V(0);
    if constexpr (!ALIGN_EPI) { if (wr == 0) PG8_BAR; }
    PG8_BAR;
#undef PG8_SA
#undef PG8_SB
#undef PG8_STAGE
#undef PG8_LDA
#undef PG8_LDB
#undef PG8_MMA
#undef PG8_WAIT_V
#undef PG8_WAIT_L
#undef PG8_BAR
#undef PG8_SCHED
}
}

struct Ctx {
    const float* xp; const float* xs; const float* stC; const float* stN; const float* stM; const float* ssm; const float* conv; const float* ck; const float* cv;
    float* out; unsigned char* ws;
};
#define XWIN ((bf16_t*)(X.ws + WS_WIN))
#define XWOUT ((bf16_t*)(X.ws + WS_WOUT))
#define XXB ((bf16_t*)(X.ws + WS_XB))
#define XU ((bf16_t*)(X.ws + WS_U))
#define XMIX ((bf16_t*)(X.ws + WS_MIX))
#define XSSQ ((float*)(X.ws + WS_SSQ))
#define XROPE ((float*)(X.ws + WS_ROPE))
#define XMC ((float*)(X.ws + WS_MC))
#define XMN ((float*)(X.ws + WS_MN))
#define XML ((float*)(X.ws + WS_ML))
#define XBL ((float*)(X.ws + WS_BL))
#define XMS ((float*)(X.ws + WS_MS))
#define XSA ((float*)(X.ws + WS_SA))
#define XSH ((float*)(X.ws + WS_SH))
#define XCSB ((bf16_t*)(X.ws + WS_CSB))
#define XNS ((float*)(X.ws + WS_NS))
#define XHSB ((bf16_t*)(X.ws + WS_HSB))
#define XPAR(off) ((const float*)(X.ws + WS_PAR) + (off))
constexpr int P_AIB = 0, P_AFB = 16, P_DTB = 32, P_ALOG = 64, P_BD = 96, P_SINK = 128, P_QNW = 160, P_KNW = 416, P_ANW = 672, P_BNW = 2720, P_CB = 4768, P_CW = 8864, P_END = 25248;
#define IN_XP 0
#define IN_XS 1
#define IN_STC 2
#define IN_STN 3
#define IN_STM 4
#define IN_SSM 5
#define IN_CONV 6
#define IN_CK 7
#define IN_CV 8
#define IN_NORMW 9
#define IN_WIN 10
#define IN_AIB 11
#define IN_AFB 12
#define IN_ANW 13
#define IN_CW 14
#define IN_CB 15
#define IN_DTB 16
#define IN_ALOG 17
#define IN_BD 18
#define IN_BNW 19
#define IN_QNW 20
#define IN_KNW 21
#define IN_SINK 22
#define IN_WOUT 23

__device__ __forceinline__ void transpose_strip(lptr lds, const float* src, int ldn, int nvalid, bf16_t* dst, int ldk, const float* scale, int k0, int n0, int tid) {
    LAS float* T = (LAS float*)lds;
    f32x4 v[8];
#pragma unroll
    for (int i = 0; i < 8; ++i) {
        const int f = tid + i * NT, r = f >> 6, c4 = (f & 63) * 4, n = n0 + c4;
        const f32x4 t = __builtin_nontemporal_load((const f32x4*)(src + (size_t)(k0 + r) * ldn + (n < nvalid ? n : 0)));
        const float m = n < nvalid ? (scale ? scale[k0 + r] : 1.f) : 0.f;
        v[i] = t * m;
    }
#pragma unroll
    for (int i = 0; i < 8; ++i) {
        const int f = tid + i * NT, r = f >> 6, c4 = (f & 63) * 4;
        T[r * 257 + c4 + 0] = v[i][0]; T[r * 257 + c4 + 1] = v[i][1]; T[r * 257 + c4 + 2] = v[i][2]; T[r * 257 + c4 + 3] = v[i][3];
    }
    __syncthreads();
#pragma unroll
    for (int i = 0; i < 4; ++i) {
        const int p = tid + i * NT, n = p >> 3, k8 = (p & 7) * 8; float f[8];
#pragma unroll
        for (int jx = 0; jx < 8; ++jx) f[jx] = T[(k8 + jx) * 257 + n];
        *(u32x4*)(dst + (size_t)(n0 + n) * ldk + k0 + k8) = pack8(f);
    }
    __syncthreads();
}

__device__ __forceinline__ void prologue(lptr lds, const Ctx& X, const Args& args, int G, int bid, int tid) {
    const int lane = tid & 63, wave = tid >> 6;
    constexpr int T0 = 320, T1 = T0 + 96, T2 = T1 + 520, T3 = T2 + 1, T4 = T3 + 513;
    for (int task = bid; task < T4; task += G) {
        if (task < T0) {
            const int kt = task / 20, ntl = task % 20;
            transpose_strip(lds, args.in[IN_WIN], DIN, DIN, XWIN, D, args.in[IN_NORMW], kt * 64, ntl * 256, tid);
        } else if (task < T1) {
            const int r = task - T0, kt = r / 4, ntl = r % 4;
            transpose_strip(lds, args.in[IN_WOUT], D, D, XWOUT, DMIX, nullptr, kt * 64, ntl * 256, tid);
        } else if (task < T2) {
            const int rb = (task - T1) * 32 + wave * 4;
            f32x4 v[4][4];
#pragma unroll
            for (int q = 0; q < 4; ++q) {
                const int r = rb + q, rc = r < MTOK ? r : MTOK - 1;
                const float* src = rc < TP ? X.xp + (size_t)rc * D : X.xs + (size_t)(rc - TP) * D;
#pragma unroll
                for (int i = 0; i < 4; ++i) v[q][i] = __builtin_nontemporal_load((const f32x4*)(src + lane * 4 + i * 256));
            }
#pragma unroll
            for (int q = 0; q < 4; ++q) {
                const int r = rb + q;
                const float keep = r < MTOK ? 1.f : 0.f;
                float ss = 0.f;
#pragma unroll
                for (int i = 0; i < 4; ++i) {
                    const f32x4 t = v[q][i] * keep;
                    ss += t[0] * t[0] + t[1] * t[1] + t[2] * t[2] + t[3] * t[3];
                    u32x2 w; w[0] = pk2(t[0], t[1]); w[1] = pk2(t[2], t[3]);
                    *(u32x2*)(XXB + (size_t)r * D + lane * 4 + i * 256) = w;
                }
                ss = wave_sum(ss);
                if (lane < 16) XSSQ[(size_t)r * 16 + lane] = (lane == 0) ? ss : 0.f;
            }
        } else if (task < T3) {
            for (int i = tid; i < (MPAD - MTOK) * DMIX / 2; i += NT) ((unsigned*)(XMIX + (size_t)MTOK * DMIX))[i] = 0u;
            float* P = (float*)(X.ws + WS_PAR);
            const int po[12] = {P_AIB, P_AFB, P_DTB, P_ALOG, P_BD, P_SINK, P_QNW, P_KNW, P_ANW, P_BNW, P_CB, P_CW};
            const int pn[12] = {16, 16, 32, 32, 32, 32, 256, 256, 2048, 2048, 4096, 16384};
            const int pi[12] = {IN_AIB, IN_AFB, IN_DTB, IN_ALOG, IN_BD, IN_SINK, IN_QNW, IN_KNW, IN_ANW, IN_BNW, IN_CB, IN_CW};
#pragma unroll
            for (int a = 0; a < 12; ++a) { const float* src = args.in[pi[a]]; for (int i = tid; i < pn[a]; i += NT) P[po[a] + i] = src[i]; }
        } else {
            const int e = (task - T3) * 512 + tid;
            if (e < 8193 * 32) {
                const int pos = e >> 5, d = e & 31;
                const float inv = (float)exp2(-(double)d * (13.287712379549449 / 32.0));
                const float angf = (float)pos * inv;
                const double a = (double)angf;
                const double k = rint(a * 0.15915494309189535);
                const float rr = (float)(a - k * 6.283185307179586);
                XROPE[(size_t)e * 2] = cosf(rr); XROPE[(size_t)e * 2 + 1] = sinf(rr);
            }
        }
    }
}

__device__ __forceinline__ void convert_weights(lptr lds, const Ctx& X, const Args& args, int l, int first, int stride, int tid) {
    for (int t = first; t < 416; t += stride) {
        if (t < 320) {
            const int kt = t / 20, ntl = t % 20;
            transpose_strip(lds, args.in[IN_WIN] + (size_t)l * D * DIN, DIN, DIN, XWIN + (size_t)l * NIN * D, D, args.in[IN_NORMW] + l * D, kt * 64, ntl * 256, tid);
        } else {
            const int r = t - 320, kt = r / 4, ntl = r % 4;
            transpose_strip(lds, args.in[IN_WOUT] + (size_t)l * DMIX * D, D, D, XWOUT + (size_t)l * D * DMIX, DMIX, nullptr, kt * 64, ntl * 256, tid);
        }
    }
}

__device__ __forceinline__ void conv8(const bf16_t* u, int seq0, int tt, int ch, const float* cw, const float* cb, float (&o)[8]) {
    float acc[8];
    { f32x4 b0 = *(const f32x4*)(cb + ch), b1 = *(const f32x4*)(cb + ch + 4);
#pragma unroll
      for (int j = 0; j < 4; ++j) { acc[j] = b0[j]; acc[4 + j] = b1[j]; } }
#pragma unroll
    for (int jj = 0; jj < 4; ++jj) {
        const int t2 = tt + jj - 3;
        if (t2 >= 0) {
            float x[8]; unpack8(*(const u32x4*)(u + (size_t)(seq0 + t2) * NIN + C_BX + ch), x);
            f32x4 w0 = *(const f32x4*)(cw + jj * 1024 + ch), w1 = *(const f32x4*)(cw + jj * 1024 + ch + 4);
#pragma unroll
            for (int j = 0; j < 4; ++j) { acc[j] += x[j] * w0[j]; acc[4 + j] += x[4 + j] * w1[j]; }
        }
    }
#pragma unroll
    for (int j = 0; j < 8; ++j) o[j] = siluf_(acc[j]);
}


__device__ __forceinline__ void conv8x8(const bf16_t* u, int seq0, int tt0, int ch, const float* cw, const float* cb, float (&o)[8][8]) {
    float w[4][8];
#pragma unroll
    for (int jj = 0; jj < 4; ++jj) { f32x4 w0 = *(const f32x4*)(cw + jj * 1024 + ch), w1 = *(const f32x4*)(cw + jj * 1024 + ch + 4);
#pragma unroll
        for (int j = 0; j < 4; ++j) { w[jj][j] = w0[j]; w[jj][4 + j] = w1[j]; } }
    { f32x4 b0 = *(const f32x4*)(cb + ch), b1 = *(const f32x4*)(cb + ch + 4);
#pragma unroll
      for (int t = 0; t < 8; ++t)
#pragma unroll
          for (int j = 0; j < 4; ++j) { o[t][j] = b0[j]; o[t][4 + j] = b1[j]; } }
    u32x4 raw[11];
#pragma unroll
    for (int r = 0; r < 11; ++r) {
        const int t2 = tt0 + r - 3;
        const u32x4 v = *(const u32x4*)(u + (unsigned)(seq0 + (t2 >= 0 ? t2 : 0)) * NIN + C_BX + ch);
        const unsigned msk = t2 >= 0 ? 0xffffffffu : 0u;
        raw[r] = (u32x4){v[0] & msk, v[1] & msk, v[2] & msk, v[3] & msk};
    }
#pragma unroll
    for (int r = 0; r < 11; ++r) {
        float x[8]; unpack8(raw[r], x);
#pragma unroll
        for (int jj = 0; jj < 4; ++jj) {
            const int t = r - jj;
            if (t >= 0 && t < 8) {
#pragma unroll
                for (int j = 0; j < 8; ++j) o[t][j] += x[j] * w[jj][j];
            }
        }
    }
#pragma unroll
    for (int t = 0; t < 8; ++t)
#pragma unroll
        for (int j = 0; j < 8; ++j) o[t][j] = siluf_(o[t][j]);
}

__device__ __forceinline__ void mlstm_local(lptr lds, const Ctx& X, int l, int task, int tid) {
    const int h = task & 3, c = (task >> 2) & 127, n = task >> 9;
    const int lane = tid & 63, wave = tid >> 6, fr = lane & 15, fq = lane >> 4;
    const int row0 = n * SEQ + c * 64, nh = n * 4 + h;
    lptr VwT = lds;
    lptr KT = lds + 18432;
    LAS float* wv = (LAS float*)(lds + 27648);
    const int tg = lane & 7, cgq = lane >> 3;
    u32x4 blk[8];
    if (wave >= 1 && wave <= 3) {
        const int col = wave < 3 ? C_AV + h * 128 + ((wave - 1) * 8 + cgq) * 8 : C_AK + h * 64 + cgq * 8;
#pragma unroll
        for (int t = 0; t < 8; ++t) blk[t] = *(const u32x4*)(XU + (unsigned)(row0 + 8 * tg + t) * NIN + col);
    }
    if (wave == 0) {
        const bf16_t* ur = XU + (unsigned)(row0 + lane) * NIN;
        const float fg = bf2f(ur[C_AF + h]) + XPAR(P_AFB)[l * 4 + h], ig = bf2f(ur[C_AI + h]) + XPAR(P_AIB)[l * 4 + h];
        const float b = wave_scan_sum(logsigf_(fg), lane);
        const float bl = lane63(b);
        const float g = bl - b + ig;
        const float ml = wave_max(g);
        wv[lane] = __expf(g - ml);
        if (lane == 0) { XML[nh * 128 + c] = ml; XBL[nh * 128 + c] = bl; }
    }
    __syncthreads();
    if (wave >= 1 && wave <= 3) {
        float xs[8][8];
#pragma unroll
        for (int t = 0; t < 8; ++t) { unpack8(blk[t], xs[t]); const float w = wave < 3 ? wv[8 * tg + t] : 0.125f;
#pragma unroll
            for (int j = 0; j < 8; ++j) xs[t][j] *= w; }
        lptr dstT = wave < 3 ? VwT + ((((wave - 1) * 8 + cgq) * 8 * 72) << 1) : KT + ((cgq * 8 * 72) << 1);
#pragma unroll
        for (int j = 0; j < 8; ++j) {
            float v[8];
#pragma unroll
            for (int t = 0; t < 8; ++t) v[t] = xs[t][j];
            *(LAS u32x4*)(dstT + ((j * 72 + 8 * tg) << 1)) = pack8(v);
        }
    }
    __syncthreads();
    {
        bf16_t* dst = (bf16_t*)XMC + ((size_t)nh * 128 + c) * 8192;
        bf16x8 b0 = lds_frag(VwT, 16 * wave + fr, fq * 8, 72), b1 = lds_frag(VwT, 16 * wave + fr, 32 + fq * 8, 72);
#pragma unroll
        for (int mt = 0; mt < 4; ++mt) {
            f32x4 acc = {0.f, 0.f, 0.f, 0.f};
            acc = mfma16(lds_frag(KT, 16 * mt + fr, fq * 8, 72), b0, acc);
            acc = mfma16(lds_frag(KT, 16 * mt + fr, 32 + fq * 8, 72), b1, acc);
            { u32x2 w; w[0] = pk2(acc[0], acc[1]); w[1] = pk2(acc[2], acc[3]); *(u32x2*)(dst + (16 * wave + fr) * 64 + 16 * mt + 4 * fq) = w; }
        }
    }
    if (tid < 64) {
        float s = 0.f;
#pragma unroll
        for (int t8 = 0; t8 < 8; ++t8) {
            float kf[8]; unpack8(*(const LAS u32x4*)(KT + ((tid * 72 + t8 * 8) << 1)), kf);
#pragma unroll
            for (int jx = 0; jx < 8; ++jx) s += kf[jx] * wv[t8 * 8 + jx];
        }
        XMN[((size_t)nh * 128 + c) * 64 + tid] = s;
    }
    __syncthreads();
}

__device__ __forceinline__ void ssd_local(lptr lds, const Ctx& X, int l, int task, int tid) {
    const int g = task & 1, c = (task >> 1) & 127, n = task >> 8;
    const int lane = tid & 63, wave = tid >> 6, fr = lane & 15, fq = lane >> 4;
    const int seq0 = n * SEQ, row0 = seq0 + c * 64;
    lptr XwT = lds;
    lptr BT = lds + 36864;
    LAS float* wl = (LAS float*)(lds + 55296);
    {
        const float* cw = XPAR(P_CW) + l * 4096; const float* cb = XPAR(P_CB) + l * 1024;
        const int tg = lane & 7, cg = wave * 8 + (lane >> 3);
        float o[8][8];
        if (wave < 6) {
            const int ch = cg < 32 ? g * 256 + cg * 8 : 512 + g * 128 + (cg - 32) * 8;
            conv8x8(XU, seq0, c * 64 + 8 * tg, ch, cw, cb, o);
        }
        if (wave < 4) {
            const int hh = 4 * g + wave;
            const float dt = softplusf_(bf2f(XU[(unsigned)(row0 + lane) * NIN + C_BDT + hh]) + XPAR(P_DTB)[l * 8 + hh]);
            const float A = -__expf(XPAR(P_ALOG)[l * 8 + hh]);
            const float a = wave_scan_sum(dt * A, lane);
            const float aL = lane63(a);
            wl[wave * 64 + lane] = __expf(aL - a) * dt;
            if (lane == 0) XSA[(n * 8 + hh) * 128 + c] = aL;
        }
        __syncthreads();
        if (wave < 4) {
            float wt[8];
#pragma unroll
            for (int t = 0; t < 8; ++t) wt[t] = wl[wave * 64 + 8 * tg + t];
#pragma unroll
            for (int jx = 0; jx < 8; ++jx) {
                float v[8];
#pragma unroll
                for (int t = 0; t < 8; ++t) v[t] = o[t][jx] * wt[t];
                *(LAS u32x4*)(XwT + (((cg * 8 + jx) * 72 + 8 * tg) << 1)) = pack8(v);
            }
        } else if (wave < 6) {
#pragma unroll
            for (int jx = 0; jx < 8; ++jx) {
                float v[8];
#pragma unroll
                for (int t = 0; t < 8; ++t) v[t] = o[t][jx];
                *(LAS u32x4*)(BT + ((((cg - 32) * 8 + jx) * 72 + 8 * tg) << 1)) = pack8(v);
            }
        }
    }
    __syncthreads();
    {
        const int hl = wave >> 1, ph = wave & 1, hh = 4 * g + hl;
        bf16_t* dst = (bf16_t*)XSH + ((size_t)(n * 8 + hh) * 128 + c) * 8192;
        bf16x8 bx[2][2];
#pragma unroll
        for (int ntl = 0; ntl < 2; ++ntl)
#pragma unroll
            for (int kk = 0; kk < 2; ++kk) bx[ntl][kk] = lds_frag(XwT, hl * 64 + ph * 32 + ntl * 16 + fr, kk * 32 + fq * 8, 72);
#pragma unroll
        for (int mt = 0; mt < 8; ++mt) {
            bf16x8 a0 = lds_frag(BT, 16 * mt + fr, fq * 8, 72), a1 = lds_frag(BT, 16 * mt + fr, 32 + fq * 8, 72);
#pragma unroll
            for (int ntl = 0; ntl < 2; ++ntl) {
                f32x4 acc = {0.f, 0.f, 0.f, 0.f};
                acc = mfma16(a0, bx[ntl][0], acc); acc = mfma16(a1, bx[ntl][1], acc);
                { u32x2 w; w[0] = pk2(acc[0], acc[1]); w[1] = pk2(acc[2], acc[3]); *(u32x2*)(dst + (ph * 32 + ntl * 16 + fr) * 128 + 16 * mt + 4 * fq) = w; }
            }
        }
    }
    __syncthreads();
}

__device__ __forceinline__ void swa_prompt(lptr lds, const Ctx& X, int l, int task, int tid) {
    const int kvh = task & 1, qb = (task >> 1) & 63, n = task >> 7;
    const int lane = tid & 63, wave = tid >> 6, fr = lane & 15, fq = lane >> 4;
    const int seq0 = n * SEQ;
    lptr Kn = lds;
    lptr Vt = lds + 36864;
    lptr Pw = lds + 70656 + wave * 8448;
    const float* knw = XPAR(P_KNW) + l * 64; const float* qnw = XPAR(P_QNW) + l * 64;
#pragma unroll
    for (int it = 0; it < 2; ++it) {
        const int item = tid + it * NT, j = item >> 2, qd = item & 3, t = qb * 128 - 128 + j;
        float o1[8], o2[8];
        {
            const int tc = t >= 0 ? t : 0;
            const bf16_t* kr = XU + (unsigned)(seq0 + tc) * NIN + C_CK + kvh * 64;
            float x1[8], x2[8]; unpack8(*(const u32x4*)(kr + qd * 8), x1); unpack8(*(const u32x4*)(kr + 32 + qd * 8), x2);
            float ss = 0.f;
#pragma unroll
            for (int jj = 0; jj < 8; ++jj) ss += x1[jj] * x1[jj] + x2[jj] * x2[jj];
            ss += __shfl_xor(ss, 1); ss += __shfl_xor(ss, 2);
            const float rs = rsqrtf(ss * (1.f / 64.f) + EPS);
            const f32x4* cs = (const f32x4*)(XROPE + ((size_t)tc * 32 + qd * 8) * 2);
            f32x4 csv[4];
#pragma unroll
            for (int q4 = 0; q4 < 4; ++q4) csv[q4] = cs[q4];
            const float zm = t >= 0 ? 1.f : 0.f;
#pragma unroll
            for (int jj = 0; jj < 8; ++jj) {
                const float a = x1[jj] * rs * knw[qd * 8 + jj], b = x2[jj] * rs * knw[32 + qd * 8 + jj], co = csv[jj >> 1][(jj & 1) * 2], si = csv[jj >> 1][(jj & 1) * 2 + 1];
                o1[jj] = (a * co - b * si) * zm; o2[jj] = (b * co + a * si) * zm;
            }
        }
        *(LAS u32x4*)(Kn + ((j * 72 + qd * 8) << 1)) = pack8(o1);
        *(LAS u32x4*)(Kn + ((j * 72 + 32 + qd * 8) << 1)) = pack8(o2);
        if (qb == 63 && j >= 128) {
            float* ko = X.out + O_PK + ((((size_t)l * 2 + n) * 128 + (j - 128)) * 2 + kvh) * 64;
            *(f32x4*)(ko + qd * 8) = (f32x4){o1[0], o1[1], o1[2], o1[3]}; *(f32x4*)(ko + qd * 8 + 4) = (f32x4){o1[4], o1[5], o1[6], o1[7]};
            *(f32x4*)(ko + 32 + qd * 8) = (f32x4){o2[0], o2[1], o2[2], o2[3]}; *(f32x4*)(ko + 32 + qd * 8 + 4) = (f32x4){o2[4], o2[5], o2[6], o2[7]};
        }
    }
    if (wave < 4) {
        const int tg = tid & 31, cg = tid >> 5;
        u32x4 vb[8];
#pragma unroll
        for (int t8 = 0; t8 < 8; ++t8) {
            const int jk = 8 * tg + t8, t = qb * 128 - 128 + jk;
            u32x4 w = *(const u32x4*)(XU + (unsigned)(seq0 + (t >= 0 ? t : 0)) * NIN + C_CV + kvh * 64 + cg * 8);
            const unsigned msk = t >= 0 ? 0xffffffffu : 0u;
            vb[t8] = (u32x4){w[0] & msk, w[1] & msk, w[2] & msk, w[3] & msk};
        }
#pragma unroll
        for (int jj = 0; jj < 8; ++jj) {
            u32x4 w;
#pragma unroll
            for (int tp = 0; tp < 4; ++tp) {
                const unsigned lo = (vb[2 * tp][jj >> 1] >> ((jj & 1) * 16)) & 0xffffu, hi = (vb[2 * tp + 1][jj >> 1] >> ((jj & 1) * 16)) & 0xffffu;
                w[tp] = lo | (hi << 16);
            }
            *(LAS u32x4*)(Vt + (((cg * 8 + jj) * 264 + 8 * tg) << 1)) = w;
        }
        if (qb == 63 && tg >= 16) {
#pragma unroll
            for (int t8 = 0; t8 < 8; ++t8) {
                float x[8]; unpack8(vb[t8], x);
                float* vo = X.out + O_PV + ((((size_t)l * 2 + n) * 128 + (8 * tg + t8 - 128)) * 2 + kvh) * 64 + cg * 8;
                *(f32x4*)(vo) = (f32x4){x[0], x[1], x[2], x[3]}; *(f32x4*)(vo + 4) = (f32x4){x[4], x[5], x[6], x[7]};
            }
        }
    }
    __syncthreads();
    const int hq = kvh * 4 + (wave >> 1), i0 = (wave & 1) * 64;
    const float sink = XPAR(P_SINK)[l * 8 + hq];
    float qw1[8], qw2[8];
#pragma unroll
    for (int jj = 0; jj < 8; ++jj) { qw1[jj] = qnw[fq * 8 + jj]; qw2[jj] = qnw[32 + fq * 8 + jj]; }
    u32x4 qn0, qn1; f32x4 csn[4];
    {
        const int t = qb * 128 + i0 + fr;
        const bf16_t* qr = XU + (unsigned)(seq0 + t) * NIN + C_CQ + hq * 64;
        qn0 = *(const u32x4*)(qr + fq * 8); qn1 = *(const u32x4*)(qr + 32 + fq * 8);
        const f32x4* cs = (const f32x4*)(XROPE + ((size_t)t * 32 + fq * 8) * 2);
#pragma unroll
        for (int q4 = 0; q4 < 4; ++q4) csn[q4] = cs[q4];
    }
#pragma unroll 1
    for (int mt = 0; mt < 4; ++mt) {
        const int q0 = i0 + mt * 16;
        const u32x4 q0r = qn0, q1r = qn1; f32x4 csc[4];
#pragma unroll
        for (int q4 = 0; q4 < 4; ++q4) csc[q4] = csn[q4];
        {
            const int mn = mt < 3 ? mt + 1 : 3;
            const int t = qb * 128 + i0 + mn * 16 + fr;
            const bf16_t* qr = XU + (unsigned)(seq0 + t) * NIN + C_CQ + hq * 64;
            qn0 = *(const u32x4*)(qr + fq * 8); qn1 = *(const u32x4*)(qr + 32 + fq * 8);
            const f32x4* cs = (const f32x4*)(XROPE + ((size_t)t * 32 + fq * 8) * 2);
#pragma unroll
            for (int q4 = 0; q4 < 4; ++q4) csn[q4] = cs[q4];
        }
        bf16x8 a0, a1;
        {
            float x1[8], x2[8]; unpack8(q0r, x1); unpack8(q1r, x2);
            float ss = 0.f;
#pragma unroll
            for (int jj = 0; jj < 8; ++jj) ss += x1[jj] * x1[jj] + x2[jj] * x2[jj];
            ss += __shfl_xor(ss, 16); ss += __shfl_xor(ss, 32);
            const float rs = rsqrtf(ss * (1.f / 64.f) + EPS) * 0.125f;
            float o1[8], o2[8];
#pragma unroll
            for (int jj = 0; jj < 8; ++jj) {
                const float a = x1[jj] * rs * qw1[jj], b = x2[jj] * rs * qw2[jj], co = csc[jj >> 1][(jj & 1) * 2], si = csc[jj >> 1][(jj & 1) * 2 + 1];
                o1[jj] = a * co - b * si; o2[jj] = b * co + a * si;
            }
            a0 = as_frag(pack8(o1)); a1 = as_frag(pack8(o2));
        }
        const int tlo = q0 >> 4;
        const int qi = q0 + fr;
        const int dlo = qb > 0 ? 1 : (128 - qi > 1 ? 128 - qi : 1);
        f32x4 s[16];
        float mx = -3.0e38f;
#pragma unroll
        for (int ntl = 0; ntl < 16; ++ntl) {
            if (ntl >= tlo && ntl <= tlo + 8) {
                f32x4 acc = {0.f, 0.f, 0.f, 0.f};
                acc = mfma16(lds_frag(Kn, 16 * ntl + fr, fq * 8, 72), a0, acc);
                acc = mfma16(lds_frag(Kn, 16 * ntl + fr, 32 + fq * 8, 72), a1, acc);
                if (ntl == tlo || ntl == tlo + 8 || qb == 0) {
#pragma unroll
                    for (int ii = 0; ii < 4; ++ii) {
                        const int dk = 16 * ntl + 4 * fq + ii - qi;
                        acc[ii] = ((unsigned)(dk - dlo) <= (unsigned)(128 - dlo)) ? acc[ii] : -3.0e38f;
                    }
                }
                mx = fmaxf(mx, fmaxf(fmaxf(acc[0], acc[1]), fmaxf(acc[2], acc[3])));
                s[ntl] = acc;
            }
        }
        mx = fmaxf(mx, __shfl_xor(mx, 16)); mx = fmaxf(mx, __shfl_xor(mx, 32));
        mx = fmaxf(mx, sink);
        float sum = 0.f;
#pragma unroll
        for (int ntl = 0; ntl < 16; ++ntl) {
            if (ntl >= tlo && ntl <= tlo + 8) {
#pragma unroll
                for (int ii = 0; ii < 4; ++ii) { const float e = __expf(s[ntl][ii] - mx); s[ntl][ii] = e; sum += e; }
            }
        }
        sum += __shfl_xor(sum, 16); sum += __shfl_xor(sum, 32);
        const float inv = rcpf_(sum + __expf(sink - mx));
        const int klo = q0 >> 5, khi = (q0 + 143) >> 5;
#pragma unroll
        for (int ntl = 0; ntl < 16; ++ntl) {
            if (ntl >= tlo && ntl <= tlo + 8) {
                u32x2 w; w[0] = pk2(s[ntl][0] * inv, s[ntl][1] * inv); w[1] = pk2(s[ntl][2] * inv, s[ntl][3] * inv);
                *(LAS u32x2*)(Pw + ((fr * 264 + 16 * ntl + 4 * fq) << 1)) = w;
            } else if ((ntl >> 1) >= klo && (ntl >> 1) <= khi) {
                u32x2 w = {0u, 0u};
                *(LAS u32x2*)(Pw + ((fr * 264 + 16 * ntl + 4 * fq) << 1)) = w;
            }
        }
        u32x2 czv[4];
#pragma unroll
        for (int ntl = 0; ntl < 4; ++ntl) czv[ntl] = *(const u32x2*)(XU + ((unsigned)seq0 + qb * 128 + q0 + fr) * NIN + C_CZ + hq * 64 + 16 * ntl + 4 * fq);
        LDS_FENCE();
        f32x4 o[4];
#pragma unroll
        for (int ntl = 0; ntl < 4; ++ntl) o[ntl] = (f32x4){0.f, 0.f, 0.f, 0.f};
#pragma unroll
        for (int kk = 0; kk < 8; ++kk) {
            if (kk >= klo && kk <= khi) {
                const bf16x8 a = lds_frag(Pw, fr, kk * 32 + fq * 8, 264);
#pragma unroll
                for (int ntl = 0; ntl < 4; ++ntl) o[ntl] = mfma16(lds_frag(Vt, 16 * ntl + fr, kk * 32 + fq * 8, 264), a, o[ntl]);
            }
        }
        LDS_FENCE();
        {
            const unsigned row = (unsigned)seq0 + qb * 128 + q0 + fr;
#pragma unroll
            for (int ntl = 0; ntl < 4; ++ntl) {
                const float z0 = __uint_as_float(czv[ntl][0] << 16), z1 = __uint_as_float(czv[ntl][0] & 0xffff0000u), z2 = __uint_as_float(czv[ntl][1] << 16), z3 = __uint_as_float(czv[ntl][1] & 0xffff0000u);
                u32x2 w; w[0] = pk2(o[ntl][0] * siluf_(z0), o[ntl][1] * siluf_(z1)); w[1] = pk2(o[ntl][2] * siluf_(z2), o[ntl][3] * siluf_(z3));
                *(u32x2*)(XMIX + row * DMIX + 1024 + hq * 64 + 16 * ntl + 4 * fq) = w;
            }
        }
    }
    __syncthreads();
}

__device__ __forceinline__ void sample_task(lptr lds, const Ctx& X, int l, int b, int part, int tid) {
    LAS float* uf = (LAS float*)lds;
    LAS float* xbc = (LAS float*)(lds + 19968);
    LAS float* numv = (LAS float*)(lds + 24064);
    LAS float* yv = (LAS float*)(lds + 26112);
    LAS float* red = (LAS float*)(lds + 28160);
    LAS float* qs = (LAS float*)(lds + 28416);
    LAS float* kn = (LAS float*)(lds + 30464);
    LAS float* sc = (LAS float*)(lds + 30976);
    const int lane = tid & 63, wave = tid >> 6;
    const size_t row = (size_t)TP + b;
    const bf16_t* ur = XU + row * NIN;
    const size_t lb = (size_t)l * 128 + b;
    f32x4 kpre[8], vpre[8];
    if (part == 2) {
        const float* kc = X.ck + lb * 16384; const float* vc = X.cv + lb * 16384;
#pragma unroll
        for (int it = 0; it < 8; ++it) {
            const int e = (tid + it * NT) * 4, e2 = e < 127 * 128 ? e + 128 : e;
            kpre[it] = __builtin_nontemporal_load((const f32x4*)(kc + e2)); vpre[it] = __builtin_nontemporal_load((const f32x4*)(vc + e2));
        }
    }
    {
        const int c_lo = part == 0 ? 0 : (part == 1 ? C_BZ : C_CQ), c_hi = part == 0 ? C_BZ : (part == 1 ? C_CQ : DIN);
#pragma unroll 2
        for (int i = c_lo + tid; i < c_hi; i += NT) uf[i] = bf2f(ur[i]);
    }
    __syncthreads();
    if (part == 0) {
#pragma unroll
    for (int h = 0; h < 4; ++h) {
        const float ig = uf[C_AI + h] + XPAR(P_AIB)[l * 4 + h], fg = uf[C_AF + h] + XPAR(P_AFB)[l * 4 + h];
        const float ls = logsigf_(fg), m0 = X.stM[lb * 4 + h];
        const float mn = fmaxf(ls + m0, ig), sp = __expf(ls + m0 - mn), sl = __expf(ig - mn);
        const float* C0 = X.stC + (lb * 4 + h) * 8192; float* C1 = X.out + O_SC + (lb * 4 + h) * 8192;
#pragma unroll
        for (int it = 0; it < 4; ++it) {
            const int e = (tid + it * NT) * 4, v = e >> 6, k = e & 63;
            const f32x4 c0 = __builtin_nontemporal_load((const f32x4*)(C0 + e));
            const float vv = uf[C_AV + h * 128 + v] * sl;
            f32x4 c1; float part = 0.f;
#pragma unroll
            for (int j = 0; j < 4; ++j) { c1[j] = sp * c0[j] + vv * (uf[C_AK + h * 64 + k + j] * 0.125f); part += c1[j] * uf[C_AQ + h * 64 + k + j]; }
            __builtin_nontemporal_store(c1, (f32x4*)(C1 + e));
            part = red16(part);
            if ((lane & 15) == 0) numv[h * 128 + v] = part;
        }
        if (wave == 0) {
            const float n1 = sp * X.stN[(lb * 4 + h) * 64 + lane] + sl * uf[C_AK + h * 64 + lane] * 0.125f;
            X.out[O_SN + (lb * 4 + h) * 64 + lane] = n1;
            const float dd = wave_sum(n1 * uf[C_AQ + h * 64 + lane]);
            if (lane == 0) { red[h] = dd; red[4 + h] = mn; X.out[O_SM + lb * 4 + h] = mn; }
        }
    }
    __syncthreads();
    float hv;
    { const int h = tid >> 7; hv = numv[tid] * rcpf_(fmaxf(fabsf(red[h]), __expf(-red[4 + h]))); const float ss = wave_sum(hv * hv); if (lane == 0) red[8 + wave] = ss; }
    __syncthreads();
    { const int h = tid >> 7; const float rs = rsqrtf((red[8 + 2 * h] + red[9 + 2 * h]) * (1.f / 128.f) + EPS);
      XMIX[row * DMIX + tid] = (bf16_t)f2bf(hv * rs * XPAR(P_ANW)[l * 512 + tid] * sigmoidf_(uf[C_AO + tid]) * siluf_(uf[C_AZ + tid])); }
    }
    if (part == 1) {
    {
        const float* buf = X.conv + lb * 3 * 1024; float* oc = X.out + O_SCONV + lb * 3 * 1024;
        const float* cw = XPAR(P_CW) + l * 4096;
#pragma unroll
        for (int it = 0; it < 2; ++it) {
            const int ch = tid + it * NT;
            const float f0 = buf[ch], f1 = buf[1024 + ch], f2 = buf[2048 + ch], f3 = uf[C_BX + ch];
            const float acc = XPAR(P_CB)[l * 1024 + ch] + f0 * cw[ch] + f1 * cw[1024 + ch] + f2 * cw[2048 + ch] + f3 * cw[3072 + ch];
            xbc[ch] = siluf_(acc);
            oc[ch] = f1; oc[1024 + ch] = f2; oc[2048 + ch] = f3;
        }
    }
    __syncthreads();
#pragma unroll 4
    for (int hh = 0; hh < 8; ++hh) {
        const float dt = softplusf_(uf[C_BDT + hh] + XPAR(P_DTB)[l * 8 + hh]);
        const float dA = __expf(-dt * __expf(XPAR(P_ALOG)[l * 8 + hh]));
        const int g = hh >> 2;
        const float* h0p = X.ssm + (lb * 8 + hh) * 8192; float* h1p = X.out + O_SH + (lb * 8 + hh) * 8192;
#pragma unroll
        for (int it = 0; it < 4; ++it) {
            const int e = (tid + it * NT) * 4, p = e >> 7, s = e & 127;
            const f32x4 h0 = __builtin_nontemporal_load((const f32x4*)(h0p + e));
            const float xv = xbc[hh * 64 + p] * dt;
            f32x4 h1; float part = 0.f;
#pragma unroll
            for (int j = 0; j < 4; ++j) { h1[j] = dA * h0[j] + xv * xbc[512 + g * 128 + s + j]; part += h1[j] * xbc[768 + g * 128 + s + j]; }
            __builtin_nontemporal_store(h1, (f32x4*)(h1p + e));
            part = red16(part); part += __shfl_xor(part, 16);
            if ((lane & 31) == 0) yv[hh * 64 + p] = part;
        }
    }
    __syncthreads();
    float gb;
    { const int hh = tid >> 6; const float y = yv[tid] + XPAR(P_BD)[l * 8 + hh] * xbc[tid]; gb = y * siluf_(uf[C_BZ + tid]); const float ss = wave_sum(gb * gb); if (lane == 0) red[16 + wave] = ss; }
    __syncthreads();
    { const int g = tid >> 8; const float rs = rsqrtf((red[16 + 4 * g] + red[17 + 4 * g] + red[18 + 4 * g] + red[19 + 4 * g]) * (1.f / 256.f) + EPS);
      XMIX[row * DMIX + 512 + tid] = (bf16_t)f2bf(gb * rs * XPAR(P_BNW)[l * 512 + tid]); }
    }
    if (part == 2) {
    lptr Kl = lds + 36864;
    lptr Vl = lds + 36864 + 34816;
    if (tid < 320) {
        const int vec = tid >> 5, d = tid & 31, base = vec < 8 ? C_CQ + vec * 64 : C_CK + (vec - 8) * 64;
        const float x1 = uf[base + d], x2 = uf[base + 32 + d];
        float ss = x1 * x1 + x2 * x2; ss = red16(ss); ss += __shfl_xor(ss, 16);
        const float rs = rsqrtf(ss * (1.f / 64.f) + EPS);
        const float* w = vec < 8 ? XPAR(P_QNW) + l * 64 : XPAR(P_KNW) + l * 64;
        const float a = x1 * rs * w[d], bb = x2 * rs * w[d + 32];
        const float co = XROPE[((size_t)8192 * 32 + d) * 2], si = XROPE[((size_t)8192 * 32 + d) * 2 + 1];
        const float o1 = a * co - bb * si, o2 = bb * co + a * si;
        if (vec < 8) { qs[vec * 64 + d] = o1 * 0.125f; qs[vec * 64 + 32 + d] = o2 * 0.125f; } else { kn[(vec - 8) * 64 + d] = o1; kn[(vec - 8) * 64 + 32 + d] = o2; }
    }
    __syncthreads();
    {
        float* ko = X.out + O_SK + lb * 16384; float* vo = X.out + O_SV + lb * 16384;
#pragma unroll
        for (int it = 0; it < 8; ++it) {
            const int e = (tid + it * NT) * 4, j = e >> 7, r = e & 127;
            f32x4 kv = kpre[it], vv = vpre[it];
            if (j == 127) { kv = (f32x4){kn[r], kn[r + 1], kn[r + 2], kn[r + 3]}; vv = (f32x4){uf[C_CV + r], uf[C_CV + r + 1], uf[C_CV + r + 2], uf[C_CV + r + 3]}; }
            __builtin_nontemporal_store(kv, (f32x4*)(ko + e)); __builtin_nontemporal_store(vv, (f32x4*)(vo + e));
            u32x2 wk, wv2; wk[0] = pk2(kv[0], kv[1]); wk[1] = pk2(kv[2], kv[3]); wv2[0] = pk2(vv[0], vv[1]); wv2[1] = pk2(vv[2], vv[3]);
            *(LAS u32x2*)(Kl + ((j * 136 + r) << 1)) = wk; *(LAS u32x2*)(Vl + ((j * 136 + r) << 1)) = wv2;
        }
    }
    __syncthreads();
    if (tid < 256) {
        const int kvh = tid >> 7, jj = tid & 127;
        float s0 = 0.f, s1 = 0.f, s2 = 0.f, s3 = 0.f;
#pragma unroll 2
        for (int d8 = 0; d8 < 8; ++d8) {
            float kf[8]; unpack8(*(const LAS u32x4*)(Kl + ((jj * 136 + kvh * 64 + d8 * 8) << 1)), kf);
#pragma unroll
            for (int j = 0; j < 8; ++j) {
                s0 += kf[j] * qs[(kvh * 4 + 0) * 64 + d8 * 8 + j]; s1 += kf[j] * qs[(kvh * 4 + 1) * 64 + d8 * 8 + j];
                s2 += kf[j] * qs[(kvh * 4 + 2) * 64 + d8 * 8 + j]; s3 += kf[j] * qs[(kvh * 4 + 3) * 64 + d8 * 8 + j];
            }
        }
        sc[(kvh * 4 + 0) * 128 + jj] = s0; sc[(kvh * 4 + 1) * 128 + jj] = s1; sc[(kvh * 4 + 2) * 128 + jj] = s2; sc[(kvh * 4 + 3) * 128 + jj] = s3;
    }
    __syncthreads();
    {
        const int hq = wave; const float s0 = sc[hq * 128 + lane], s1 = sc[hq * 128 + 64 + lane], sink = XPAR(P_SINK)[l * 8 + hq];
        const float m = fmaxf(wave_max(fmaxf(s0, s1)), sink);
        const float e0 = __expf(s0 - m), e1 = __expf(s1 - m);
        const float inv = rcpf_(wave_sum(e0 + e1) + __expf(sink - m));
        sc[hq * 128 + lane] = e0 * inv; sc[hq * 128 + 64 + lane] = e1 * inv;
    }
    __syncthreads();
    {
        const int hq = tid >> 6, d = tid & 63, kvh = hq >> 2;
        float o = 0.f;
#pragma unroll 16
        for (int jj = 0; jj < 128; ++jj) o += sc[hq * 128 + jj] * bf2f(*(const LAS bf16_t*)(Vl + ((jj * 136 + kvh * 64 + d) << 1)));
        XMIX[row * DMIX + 1024 + tid] = (bf16_t)f2bf(o * siluf_(uf[C_CZ + tid]));
    }
    }
    __syncthreads();
}

__device__ __forceinline__ void scans(const Ctx& X, int l, int gt, int nthreads) {
    for (int item = gt; item < 98816; item += nthreads) {
        if (item < 32768) {
            const int nh = item >> 12, e = (item & 4095) * 2;
            const bf16_t* base = (const bf16_t*)XMC + (size_t)nh * 128 * 8192 + e;
            const float* ml = XML + nh * 128; const float* bl = XBL + nh * 128;
            float m = 0.f; f32x2 st = {0.f, 0.f};
            for (int c0 = 0; c0 < 128; c0 += 16) {
                f32x2 cl[16];
#pragma unroll
                for (int j = 0; j < 16; ++j) { const unsigned w = *(const unsigned*)(base + (size_t)(c0 + j) * 8192); cl[j] = (f32x2){__uint_as_float(w << 16), __uint_as_float(w & 0xffff0000u)}; }
#pragma unroll
                for (int j = 0; j < 16; ++j) {
                    const float mlj = ml[c0 + j], blj = bl[c0 + j], mn = fmaxf(blj + m, mlj), sp = __expf(blj + m - mn), sl = __expf(mlj - mn);
                    *(unsigned*)(XCSB + ((size_t)nh * 128 + c0 + j) * 8192 + e) = pk2(st[0], st[1]);
                    if (e == 0) XMS[nh * 128 + c0 + j] = m;
                    st = st * sp + cl[j] * sl; m = mn;
                }
            }
            *(f32x2*)(X.out + O_PC + ((size_t)l * 8 + nh) * 8192 + e) = st;
            if (e == 0) X.out[O_PM + l * 8 + nh] = m;
        } else if (item < 98304) {
            const int i1 = item - 32768, nhh = i1 >> 12, e = (i1 & 4095) * 2;
            const bf16_t* base = (const bf16_t*)XSH + (size_t)nhh * 128 * 8192 + e;
            const float* al = XSA + nhh * 128;
            f32x2 st = {0.f, 0.f};
            for (int c0 = 0; c0 < 128; c0 += 16) {
                f32x2 cl[16];
#pragma unroll
                for (int j = 0; j < 16; ++j) { const unsigned w = *(const unsigned*)(base + (size_t)(c0 + j) * 8192); cl[j] = (f32x2){__uint_as_float(w << 16), __uint_as_float(w & 0xffff0000u)}; }
#pragma unroll
                for (int j = 0; j < 16; ++j) {
                    const float dec = __expf(al[c0 + j]);
                    *(unsigned*)(XHSB + ((size_t)nhh * 128 + c0 + j) * 8192 + e) = pk2(st[0], st[1]);
                    st = st * dec + cl[j];
                }
            }
            *(f32x2*)(X.out + O_PH + ((size_t)l * 16 + nhh) * 8192 + e) = st;
        } else {
            const int i2 = item - 98304, nh = i2 >> 6, k = i2 & 63;
            float* base = XMN + (size_t)nh * 128 * 64 + k;
            const float* ml = XML + nh * 128; const float* bl = XBL + nh * 128;
            float m = 0.f, st = 0.f;
            for (int c = 0; c < 128; ++c) {
                const float mlj = ml[c], blj = bl[c], mn = fmaxf(blj + m, mlj), sp = __expf(blj + m - mn), sl = __expf(mlj - mn);
                const float cl = base[c * 64];
                XNS[(size_t)nh * 128 * 64 + c * 64 + k] = st;
                st = st * sp + cl * sl; m = mn;
            }
            X.out[O_PN + ((size_t)l * 8 + nh) * 64 + k] = st;
        }
    }
}

__device__ __forceinline__ void mlstm_out(lptr lds, const Ctx& X, int l, int task, int tid) {
    const int h = task & 3, c = (task >> 2) & 127, n = task >> 9;
    const int lane = tid & 63, wave = tid >> 6, fr = lane & 15, fq = lane >> 4;
    const int row0 = n * SEQ + c * 64, nh = n * 4 + h;
    lptr Qs = lds;
    lptr Ks = lds + 9216;
    lptr Vt = lds + 18432;
    lptr Sb = lds + 36864 + wave * 2304;
    LAS float* bv = (LAS float*)(lds + 55296);
    LAS float* dv = bv + 64;
    LAS float* mtv = bv + 128;
    LAS float* siv = bv + 192;
    LAS float* qnv = bv + 256;
    LAS float* ssqp = bv + 384;
    LAS float* nsv = bv + 512;
    const int mti = wave >> 1, half = wave & 1;
    u32x4 csf[2][4];
    {
        const bf16_t* Cs = XCSB + ((size_t)nh * 128 + c) * 8192;
#pragma unroll
        for (int kk = 0; kk < 2; ++kk)
#pragma unroll
            for (int ntl = 0; ntl < 4; ++ntl) csf[kk][ntl] = *(const u32x4*)(Cs + (64 * half + 16 * ntl + fr) * 64 + kk * 32 + fq * 8);
    }
    u32x2 aov[4], azv[4]; f32x4 anw[4];
#pragma unroll
    for (int ntl = 0; ntl < 4; ++ntl) {
        const int v = h * 128 + 64 * half + 16 * ntl + 4 * fq;
        const unsigned row = (unsigned)row0 + 16 * mti + fr;
        anw[ntl] = *(const f32x4*)(XPAR(P_ANW) + l * 512 + v);
        aov[ntl] = *(const u32x2*)(XU + row * NIN + C_AO + v); azv[ntl] = *(const u32x2*)(XU + row * NIN + C_AZ + v);
    }
    u32x4 qraw, kraw, vblk[8];
    const int tgv = lane & 7, cgv = (wave & 1) * 8 + (lane >> 3);
    {
        const int tok = tid >> 3, k8 = (tid & 7) * 8;
        const bf16_t* ur = XU + (unsigned)(row0 + tok) * NIN;
        qraw = *(const u32x4*)(ur + C_AQ + h * 64 + k8); kraw = *(const u32x4*)(ur + C_AK + h * 64 + k8);
        if (wave == 2 || wave == 3) {
#pragma unroll
            for (int t = 0; t < 8; ++t) vblk[t] = *(const u32x4*)(XU + (unsigned)(row0 + 8 * tgv + t) * NIN + C_AV + h * 128 + cgv * 8);
        }
    }
    if (wave == 0) {
        const bf16_t* ur = XU + (unsigned)(row0 + lane) * NIN;
        const float fg = bf2f(ur[C_AF + h]) + XPAR(P_AFB)[l * 4 + h], ig = bf2f(ur[C_AI + h]) + XPAR(P_AIB)[l * 4 + h];
        const float b = wave_scan_sum(logsigf_(fg), lane);
        const float dd = ig - b;
        const float cm = wave_scan_max(dd, lane);
        const float ms = XMS[nh * 128 + c];
        const float mt = b + fmaxf(ms, cm);
        bv[lane] = b; dv[lane] = dd; mtv[lane] = mt; siv[lane] = __expf(b + ms - mt);
        nsv[lane] = XNS[((size_t)nh * 128 + c) * 64 + lane];
    }
    {
        const int tok = tid >> 3, k8 = (tid & 7) * 8;
        *(LAS u32x4*)(Qs + ((tok * 72 + k8) << 1)) = qraw;
        float x[8]; unpack8(kraw, x);
#pragma unroll
        for (int j = 0; j < 8; ++j) x[j] *= 0.125f;
        *(LAS u32x4*)(Ks + ((tok * 72 + k8) << 1)) = pack8(x);
    }
    if (wave == 2 || wave == 3) {
#pragma unroll
        for (int j = 0; j < 8; ++j) {
            u32x4 w;
#pragma unroll
            for (int tp = 0; tp < 4; ++tp) {
                const unsigned lo = (vblk[2 * tp][j >> 1] >> ((j & 1) * 16)) & 0xffffu, hi = (vblk[2 * tp + 1][j >> 1] >> ((j & 1) * 16)) & 0xffffu;
                w[tp] = lo | (hi << 16);
            }
            *(LAS u32x4*)(Vt + (((cgv * 8 + j) * 72 + 8 * tgv) << 1)) = w;
        }
    }
    __syncthreads();
    bf16x8 qa[2];
    qa[0] = lds_frag(Qs, 16 * mti + fr, fq * 8, 72); qa[1] = lds_frag(Qs, 16 * mti + fr, 32 + fq * 8, 72);
    const int tq = 16 * mti + fr;
    float qn;
    {
        float x0[8], x1[8]; unpack8(__builtin_bit_cast(u32x4, qa[0]), x0); unpack8(__builtin_bit_cast(u32x4, qa[1]), x1);
        float d = 0.f;
#pragma unroll
        for (int j = 0; j < 8; ++j) d += x0[j] * nsv[fq * 8 + j] + x1[j] * nsv[32 + fq * 8 + j];
        d += __shfl_xor(d, 16); d += __shfl_xor(d, 32);
        qn = d;
    }
    const float bt = bv[tq], mtq = mtv[tq], siq = siv[tq];
    float rsum = 0.f;
#pragma unroll
    for (int ntl = 0; ntl < 4; ++ntl) {
        f32x4 sT = {0.f, 0.f, 0.f, 0.f};
        sT = mfma16(lds_frag(Ks, 16 * ntl + fr, fq * 8, 72), qa[0], sT);
        sT = mfma16(lds_frag(Ks, 16 * ntl + fr, 32 + fq * 8, 72), qa[1], sT);
        float sv[4];
#pragma unroll
        for (int ii = 0; ii < 4; ++ii) {
            const int sidx = 16 * ntl + 4 * fq + ii;
            const float wgt = (sidx <= tq) ? __expf(bt + dv[sidx] - mtq) : 0.f;
            sv[ii] = wgt * sT[ii];
            rsum += sv[ii];
        }
        u32x2 w; w[0] = pk2(sv[0], sv[1]); w[1] = pk2(sv[2], sv[3]);
        *(LAS u32x2*)(Sb + ((fr * 72 + 16 * ntl + 4 * fq) << 1)) = w;
    }
    rsum += __shfl_xor(rsum, 16); rsum += __shfl_xor(rsum, 32);
    const float inv = rcpf_(fmaxf(fabsf(rsum + siq * qn), __expf(-mtq)));
    LDS_FENCE();
    f32x4 acc[4];
#pragma unroll
    for (int ntl = 0; ntl < 4; ++ntl) acc[ntl] = (f32x4){0.f, 0.f, 0.f, 0.f};
#pragma unroll
    for (int kk = 0; kk < 2; ++kk) {
        const bf16x8 sb = lds_frag(Sb, fr, kk * 32 + fq * 8, 72);
#pragma unroll
        for (int ntl = 0; ntl < 4; ++ntl) acc[ntl] = mfma16(lds_frag(Vt, 64 * half + 16 * ntl + fr, kk * 32 + fq * 8, 72), sb, acc[ntl]);
    }
#pragma unroll
    for (int kk = 0; kk < 2; ++kk) {
        float x[8]; unpack8(__builtin_bit_cast(u32x4, qa[kk]), x);
#pragma unroll
        for (int j = 0; j < 8; ++j) x[j] *= siq;
        const bf16x8 qs = as_frag(pack8(x));
#pragma unroll
        for (int ntl = 0; ntl < 4; ++ntl) acc[ntl] = mfma16(as_frag(csf[kk][ntl]), qs, acc[ntl]);
    }
    {
        float ss = 0.f;
#pragma unroll
        for (int ntl = 0; ntl < 4; ++ntl) { acc[ntl] = acc[ntl] * inv; ss += acc[ntl][0] * acc[ntl][0] + acc[ntl][1] * acc[ntl][1] + acc[ntl][2] * acc[ntl][2] + acc[ntl][3] * acc[ntl][3]; }
        ss += __shfl_xor(ss, 16); ss += __shfl_xor(ss, 32);
        if (fq == 0) ssqp[tq * 2 + half] = ss;
    }
    __syncthreads();
    {
        const float rs = rsqrtf((ssqp[tq * 2] + ssqp[tq * 2 + 1]) * (1.f / 128.f) + EPS);
        const unsigned row = (unsigned)row0 + tq;
#pragma unroll
        for (int ntl = 0; ntl < 4; ++ntl) {
            const float o[4] = {__uint_as_float(aov[ntl][0] << 16), __uint_as_float(aov[ntl][0] & 0xffff0000u), __uint_as_float(aov[ntl][1] << 16), __uint_as_float(aov[ntl][1] & 0xffff0000u)};
            const float z[4] = {__uint_as_float(azv[ntl][0] << 16), __uint_as_float(azv[ntl][0] & 0xffff0000u), __uint_as_float(azv[ntl][1] << 16), __uint_as_float(azv[ntl][1] & 0xffff0000u)};
            float y[4];
#pragma unroll
            for (int ii = 0; ii < 4; ++ii) y[ii] = acc[ntl][ii] * rs * anw[ntl][ii] * sigmoidf_(o[ii]) * siluf_(z[ii]);
            u32x2 w; w[0] = pk2(y[0], y[1]); w[1] = pk2(y[2], y[3]);
            *(u32x2*)(XMIX + row * DMIX + h * 128 + 64 * half + 16 * ntl + 4 * fq) = w;
        }
    }
    __syncthreads();
}

__device__ __forceinline__ void ssd_out(lptr lds, const Ctx& X, int l, int task, int tid) {
    const int g = task & 1, c = (task >> 1) & 127, n = task >> 8;
    const int lane = tid & 63, wave = tid >> 6, fr = lane & 15, fq = lane >> 4;
    const int seq0 = n * SEQ, row0 = seq0 + c * 64;
    lptr Cm = lds;
    lptr Bm = lds + 17408;
    lptr Xt = lds + 34816;
    LAS float* CBf = (LAS float*)(lds + 71680);
    LAS float* av = (LAS float*)(lds + 89088);
    LAS float* dtv = (LAS float*)(lds + 90112);
    LAS float* ssq = (LAS float*)(lds + 91136);
    const int hl = wave >> 1, th = wave & 1, hh = 4 * g + hl;
    u32x4 hsf[4][4];
    {
        const bf16_t* hs = XHSB + ((size_t)(n * 8 + hh) * 128 + c) * 8192;
#pragma unroll
        for (int kk = 0; kk < 4; ++kk)
#pragma unroll
            for (int ntl = 0; ntl < 4; ++ntl) hsf[kk][ntl] = *(const u32x4*)(hs + (16 * ntl + fr) * 128 + kk * 32 + fq * 8);
    }
    if (wave < 4) {
        const int hh = 4 * g + wave;
        const float dt = softplusf_(bf2f(XU[(unsigned)(row0 + lane) * NIN + C_BDT + hh]) + XPAR(P_DTB)[l * 8 + hh]);
        const float A = -__expf(XPAR(P_ALOG)[l * 8 + hh]);
        av[wave * 64 + lane] = wave_scan_sum(dt * A, lane);
        dtv[wave * 64 + lane] = dt;
    }
    {
        const float* cw = XPAR(P_CW) + l * 4096; const float* cb = XPAR(P_CB) + l * 1024;
        float o[8][8];
        if (wave < 4) {
            const int tg = lane & 7, cg = wave * 8 + (lane >> 3);
            conv8x8(XU, seq0, c * 64 + 8 * tg, g * 256 + cg * 8, cw, cb, o);
#pragma unroll
            for (int jx = 0; jx < 8; ++jx) {
                float v[8];
#pragma unroll
                for (int t = 0; t < 8; ++t) v[t] = o[t][jx];
                *(LAS u32x4*)(Xt + (((cg * 8 + jx) * 72 + 8 * tg) << 1)) = pack8(v);
            }
        } else {
            const int tg = lane >> 3, s8 = ((wave & 1) * 8 + (lane & 7)) * 8;
            conv8x8(XU, seq0, c * 64 + 8 * tg, (wave < 6 ? 512 : 768) + g * 128 + s8, cw, cb, o);
            lptr dstm = wave < 6 ? Bm : Cm;
#pragma unroll
            for (int t = 0; t < 8; ++t) *(LAS u32x4*)(dstm + (((8 * tg + t) * 136 + s8) << 1)) = pack8(o[t]);
        }
    }
    __syncthreads();
    u32x2 bzv[2][4]; f32x4 bnw[4];
#pragma unroll
    for (int ntl = 0; ntl < 4; ++ntl) {
        bnw[ntl] = *(const f32x4*)(XPAR(P_BNW) + l * 512 + hh * 64 + 16 * ntl + 4 * fq);
#pragma unroll
        for (int mi = 0; mi < 2; ++mi) bzv[mi][ntl] = *(const u32x2*)(XU + ((unsigned)row0 + 16 * (2 * th + mi) + fr) * NIN + C_BZ + hh * 64 + 16 * ntl + 4 * fq);
    }
    {
        const int mt = wave >> 1;
#pragma unroll
        for (int q = 0; q < 2; ++q) {
            const int ntl = 2 * (wave & 1) + q;
            f32x4 acc = {0.f, 0.f, 0.f, 0.f};
#pragma unroll
            for (int kk = 0; kk < 4; ++kk) acc = mfma16(lds_frag(Cm, 16 * mt + fr, kk * 32 + fq * 8, 136), lds_frag(Bm, 16 * ntl + fr, kk * 32 + fq * 8, 136), acc);
#pragma unroll
            for (int ii = 0; ii < 4; ++ii) CBf[(16 * mt + fq * 4 + ii) * 68 + 16 * ntl + fr] = acc[ii];
        }
    }
    __syncthreads();
    f32x4 y1[2][4], y2[2][4];
#pragma unroll
    for (int mi = 0; mi < 2; ++mi)
#pragma unroll
        for (int ntl = 0; ntl < 4; ++ntl) { y1[mi][ntl] = (f32x4){0.f, 0.f, 0.f, 0.f}; y2[mi][ntl] = (f32x4){0.f, 0.f, 0.f, 0.f}; }
#pragma unroll
    for (int kk = 0; kk < 2; ++kk) {
        bf16x8 bx[4];
#pragma unroll
        for (int ntl = 0; ntl < 4; ++ntl) bx[ntl] = lds_frag(Xt, hl * 64 + 16 * ntl + fr, kk * 32 + fq * 8, 72);
#pragma unroll
        for (int mi = 0; mi < 2; ++mi) {
            const int t = 16 * (2 * th + mi) + fr, u0 = kk * 32 + fq * 8;
            const float at = av[hl * 64 + t];
            float w[8];
#pragma unroll
            for (int j = 0; j < 8; ++j) {
                const int uu = u0 + j;
                w[j] = (uu <= t) ? CBf[t * 68 + uu] * __expf(at - av[hl * 64 + uu]) * dtv[hl * 64 + uu] : 0.f;
            }
            const bf16x8 a = as_frag(pack8(w));
#pragma unroll
            for (int ntl = 0; ntl < 4; ++ntl) y1[mi][ntl] = mfma16(bx[ntl], a, y1[mi][ntl]);
        }
    }
    {
#pragma unroll
        for (int kk = 0; kk < 4; ++kk) {
            bf16x8 bh[4];
#pragma unroll
            for (int ntl = 0; ntl < 4; ++ntl) bh[ntl] = as_frag(hsf[kk][ntl]);
#pragma unroll
            for (int mi = 0; mi < 2; ++mi) {
                const bf16x8 a = lds_frag(Cm, 16 * (2 * th + mi) + fr, kk * 32 + fq * 8, 136);
#pragma unroll
                for (int ntl = 0; ntl < 4; ++ntl) y2[mi][ntl] = mfma16(bh[ntl], a, y2[mi][ntl]);
            }
        }
    }
    const float Dh = XPAR(P_BD)[l * 8 + hh];
#pragma unroll
    for (int mi = 0; mi < 2; ++mi) {
        const int t = 16 * (2 * th + mi) + fr;
        const float ea = __expf(av[hl * 64 + t]);
        float ss = 0.f;
#pragma unroll
        for (int ntl = 0; ntl < 4; ++ntl) {
            const float z[4] = {__uint_as_float(bzv[mi][ntl][0] << 16), __uint_as_float(bzv[mi][ntl][0] & 0xffff0000u), __uint_as_float(bzv[mi][ntl][1] << 16), __uint_as_float(bzv[mi][ntl][1] & 0xffff0000u)};
#pragma unroll
            for (int ii = 0; ii < 4; ++ii) {
                const int p = 16 * ntl + 4 * fq + ii;
                const float xv = bf2f(*(const LAS bf16_t*)(Xt + (((hl * 64 + p) * 72 + t) << 1)));
                const float y = y1[mi][ntl][ii] + ea * y2[mi][ntl][ii] + Dh * xv;
                const float gbv = y * siluf_(z[ii]);
                y1[mi][ntl][ii] = gbv; ss += gbv * gbv;
            }
        }
        ss += __shfl_xor(ss, 16); ss += __shfl_xor(ss, 32);
        if (fq == 0) ssq[t * 4 + hl] = ss;
    }
    __syncthreads();
#pragma unroll
    for (int mi = 0; mi < 2; ++mi) {
        const int t = 16 * (2 * th + mi) + fr;
        const float rs = rsqrtf((ssq[t * 4] + ssq[t * 4 + 1] + ssq[t * 4 + 2] + ssq[t * 4 + 3]) * (1.f / 256.f) + EPS);
        const unsigned row = (unsigned)row0 + t;
#pragma unroll
        for (int ntl = 0; ntl < 4; ++ntl) {
            u32x2 w; w[0] = pk2(y1[mi][ntl][0] * rs * bnw[ntl][0], y1[mi][ntl][1] * rs * bnw[ntl][1]); w[1] = pk2(y1[mi][ntl][2] * rs * bnw[ntl][2], y1[mi][ntl][3] * rs * bnw[ntl][3]);
            *(u32x2*)(XMIX + row * DMIX + 512 + hh * 64 + 16 * ntl + 4 * fq) = w;
        }
    }
    __syncthreads();
}


#define XB_TMO      128
#define XB_XCNT(j)  (256  + 64 * (j))
#define XB_XSUB(j)  (1280 + 64 * (j))
#define XB_XGEN(j)  (2304 + 64 * (j))
#define XB_TOP      3328
#define XB_TOPGEN   3392
#define XCD_BAR_WORDS 3456
#define XB_SPIN_CAP (1u << 18)
__device__ __forceinline__ unsigned xb_ld(unsigned* p)              { return __hip_atomic_load(p, __ATOMIC_RELAXED, __HIP_MEMORY_SCOPE_AGENT); }
__device__ __forceinline__ unsigned xb_add(unsigned* p, unsigned v) { return __hip_atomic_fetch_add(p, v, __ATOMIC_RELAXED, __HIP_MEMORY_SCOPE_AGENT); }
__device__ __forceinline__ unsigned xb_xcc_id() { return (unsigned)__builtin_amdgcn_s_getreg((3 << 11) | 20) & 0xFu; }
#define XB_SPIN(cond, bar) do { unsigned _sp = 0; while (cond) { __builtin_amdgcn_s_sleep(1); \
    if ((++_sp & 255u) == 0u) { if (xb_ld(&(bar)[XB_TMO])) break; if (_sp > XB_SPIN_CAP) { atomicAdd(&(bar)[XB_TMO], 1u); break; } } } } while (0)
struct XcdBarrier { unsigned* bar; unsigned x; volatile LAS unsigned* st; };
__device__ __forceinline__ XcdBarrier xcd_barrier_post(unsigned* bar, volatile LAS unsigned* st) {
    XcdBarrier b; b.bar = bar; b.x = xb_xcc_id(); b.st = st;
    if (threadIdx.x == 0) (void)xb_add(&bar[XB_XCNT(b.x)], 1u);
    return b;
}
__device__ __forceinline__ void xcd_barrier_complete(unsigned* bar, unsigned x, unsigned& nloc, unsigned& nx) {
    const unsigned G = gridDim.x * gridDim.y * gridDim.z;
    unsigned sum, cnt, mine, sp = 0u;
    for (;;) {
        sum = 0u; cnt = 0u; mine = 0u;
#pragma unroll
        for (unsigned j = 0; j < 16; ++j) { const unsigned c = xb_ld(&bar[XB_XCNT(j)]); sum += c; cnt += (c > 0u) ? 1u : 0u; mine = (j == x) ? c : mine; }
        if (sum == G) break;
        __builtin_amdgcn_s_sleep(1);
        if ((++sp & 255u) == 0u) { if (xb_ld(&bar[XB_TMO])) break; if (sp > XB_SPIN_CAP) { atomicAdd(&bar[XB_TMO], 1u); break; } }
    }
    nloc = mine > 0u ? mine : 1u; nx = cnt > 0u ? cnt : 1u;
}
__device__ __forceinline__ void xcd_barrier(const XcdBarrier& b) {
    asm volatile("s_waitcnt vmcnt(0)" ::: "memory");
    __syncthreads();
    if (threadIdx.x == 0) {
        unsigned* bar = b.bar;
        __builtin_amdgcn_s_waitcnt(0);
        unsigned nloc = b.st[0], nx = b.st[1];
        if (nloc == 0u) { xcd_barrier_complete(bar, b.x, nloc, nx); b.st[0] = nloc; b.st[1] = nx; }
        const unsigned old = xb_add(&bar[XB_XSUB(b.x)], 1u);
        const unsigned gen = old / nloc;
        if (old + 1u == (gen + 1u) * nloc) {
            __builtin_amdgcn_fence(__ATOMIC_RELEASE, "agent");
            asm volatile("s_waitcnt vmcnt(0)" ::: "memory");
            const unsigned og = xb_add(&bar[XB_TOP], 1u);
            const unsigned tg = og / nx;
            if (og + 1u == (tg + 1u) * nx) xb_add(&bar[XB_TOPGEN], 1u);
            else XB_SPIN(xb_ld(&bar[XB_TOPGEN]) == tg, bar);
            __builtin_amdgcn_fence(__ATOMIC_ACQUIRE, "agent");
            xb_add(&bar[XB_XGEN(b.x)], 1u);
            asm volatile("s_waitcnt vmcnt(0)" ::: "memory");
        } else {
            XB_SPIN(xb_ld(&bar[XB_XGEN(b.x)]) == gen, bar);
            __builtin_amdgcn_fence(__ATOMIC_ACQUIRE, "agent");
            asm volatile("s_waitcnt vmcnt(0)" ::: "memory");
        }
    }
    __syncthreads();
}

__global__ void __launch_bounds__(NT, 2) mega(Args args) {
    __shared__ __attribute__((aligned(16))) unsigned char lds_raw[LDS_BYTES];
    lptr lds = (lptr)lds_raw;
    cg::grid_group grid = cg::this_grid();
    const int tid = threadIdx.x, bid = blockIdx.x, G = gridDim.x;
    Ctx X;
    X.xp = args.in[IN_XP]; X.xs = args.in[IN_XS]; X.stC = args.in[IN_STC]; X.stN = args.in[IN_STN]; X.stM = args.in[IN_STM]; X.ssm = args.in[IN_SSM];
    X.conv = args.in[IN_CONV]; X.ck = args.in[IN_CK]; X.cv = args.in[IN_CV]; X.out = args.out; X.ws = args.ws;
    const int lo = args.ph_lo, hi = args.ph_hi;
    volatile LAS unsigned* xst = (volatile LAS unsigned*)(lds + LDS_BYTES - 16);
    if (tid == 0) { xst[0] = 0u; xst[1] = 0u; }
    __syncthreads();
    XcdBarrier xbar = xcd_barrier_post((unsigned*)(args.ws + WS_BAR), xst);
#define IN(k) (lo <= (k) && (k) < hi)
#define SEAM(k) do { if (IN(k) && IN((k) + 1)) { for (int _r = 0; _r < REP_SYNC; ++_r) { if (lo < 0) grid.sync(); xcd_barrier(xbar); } } } while (0)
    if (IN(0)) { for (int _r = 0; _r < REP_P0; ++_r) prologue(lds, X, args, G, bid, tid); }
    SEAM(0);
    for (int l = 0; l < 4; ++l) {
        const int pb = 1 + l * 5;
        if (IN(pb)) for (int _r = 0; _r < REP_P1; ++_r) {
            pg8::Gemm g{XXB, XWIN + (size_t)l * NIN * D, MPAD, NIN, D}; pg8::StaticOrder S; S.init(TP, NIN, G, bid);
            pg8::EpiU E{XU, XSSQ};
            pg8::gemm_phase<pg8::EpiU, pg8::StaticOrder, false, GEMM_SP2, GEMM_ALIGN>(lds, g, S, E, OPQ(tid));
            if (l == 0 && bid >= G - 20) {
                pg8::SampleOrder S2{G - 20, 20, bid}; pg8::EpiUh E2{XU, XSSQ};
                pg8::gemm_phase<pg8::EpiUh, pg8::SampleOrder, true>(lds, g, S2, E2, OPQ(tid));
            }
        }
        SEAM(pb);
        if (IN(pb + 1)) for (int _r = 0; _r < REP_P2; ++_r) {
            for (int t = bid; t < 256; t += G) for (int _q = 0; _q < RT_SAMPLE; ++_q) {
                if (t < 128) sample_task(lds, X, l, t, 1, OPQ(tid));
                else { sample_task(lds, X, l, t - 128, 0, OPQ(tid)); sample_task(lds, X, l, t - 128, 2, OPQ(tid)); }
            }
            for (int t = bid; t < 256; t += G) {
                const int tx = (G == 256) ? ((t & 7) >> 2) * 128 + (32 * (t & 1) + (t >> 3)) * 2 + ((t >> 1) & 1) : t;
                for (int _q = 0; _q < RT_SWA; ++_q) swa_prompt(lds, X, l, tx, OPQ(tid));
            }
            for (int t = bid; t < 512; t += G) for (int _q = 0; _q < RT_SLOC; ++_q) ssd_local(lds, X, l, t, OPQ(tid));
            for (int t = bid; t < 1024; t += G) for (int _q = 0; _q < RT_MLOC; ++_q) mlstm_local(lds, X, l, t, OPQ(tid));
            if (bid == G - 1) {
                for (int i = tid; i < 2 * 3 * 1024; i += NT) {
                    const int ch = i & 1023, j = (i >> 10) % 3, n = i / 3072;
                    X.out[O_PCONV + (((size_t)l * 2 + n) * 3 + j) * 1024 + ch] = bf2f(XU[(size_t)(n * SEQ + SEQ - 3 + j) * NIN + C_BX + ch]);
                }
            }
        }
        SEAM(pb + 1);
        if (IN(pb + 2)) {
            if (bid >= G - 4) {
                pg8::Gemm g{XMIX, XWOUT + (size_t)l * D * DMIX, MPAD, D, DMIX}; pg8::SampleOrder S{G - 4, 4, bid};
                if (l == 0) { pg8::EpiRes_<1, 0> E{X.xp, X.xs, X.out, XXB, XSSQ}; pg8::gemm_phase<pg8::EpiRes_<1, 0>, pg8::SampleOrder, true>(lds, g, S, E, OPQ(tid)); }
                else if (l < 3) { pg8::EpiRes_<1, 1> E{X.xp, X.xs, X.out, XXB, XSSQ}; pg8::gemm_phase<pg8::EpiRes_<1, 1>, pg8::SampleOrder, true>(lds, g, S, E, OPQ(tid)); }
                else { pg8::EpiRes_<1, 2> E{X.xp, X.xs, X.out, XXB, XSSQ}; pg8::gemm_phase<pg8::EpiRes_<1, 2>, pg8::SampleOrder, true>(lds, g, S, E, OPQ(tid)); }
            }
            if (l < 3) {
                if (G - 4 - 193 >= 16) { if (bid >= 193 && bid < G - 4) convert_weights(lds, X, args, l + 1, bid - 193, G - 4 - 193, OPQ(tid)); }
                else convert_weights(lds, X, args, l + 1, bid, G, OPQ(tid));
            }
            for (int _r = 0; _r < REP_P3; ++_r) scans(X, l, bid * NT + OPQ(tid), G * NT);
        }
        SEAM(pb + 2);
        if (IN(pb + 3)) for (int _r = 0; _r < REP_P4; ++_r) {
            for (int task = bid; task < 1536; task += G) {
                if (task < 512) for (int _q = 0; _q < RT_SOUT; ++_q) ssd_out(lds, X, l, task, OPQ(tid));
                else mlstm_out(lds, X, l, task - 512, OPQ(tid));
            }
        }
        SEAM(pb + 3);
        if (IN(pb + 4)) {
            {
                pg8::Gemm g{XMIX, XWOUT + (size_t)l * D * DMIX, MPAD, D, DMIX}; pg8::StaticOrder S; S.init(TP, D, G, bid);
#ifdef PROBE_P5
                { pg8::EpiProbe EP{(const unsigned*)(X.ws + 64), XSSQ}; pg8::gemm_phase<pg8::EpiProbe, pg8::StaticOrder, false, GEMM_SP2>(lds, g, S, EP, OPQ(tid)); }
#endif
                if (l == 0) { pg8::EpiRes_<2, 0> E{X.xp, X.xs, X.out, XXB, XSSQ}; pg8::gemm_phase<pg8::EpiRes_<2, 0>, pg8::StaticOrder, false, GEMM_SP2, GEMM_ALIGN>(lds, g, S, E, OPQ(tid)); }
                else if (l < 3) { pg8::EpiRes_<2, 1> E{X.xp, X.xs, X.out, XXB, XSSQ}; pg8::gemm_phase<pg8::EpiRes_<2, 1>, pg8::StaticOrder, false, GEMM_SP2, GEMM_ALIGN>(lds, g, S, E, OPQ(tid)); }
                else { pg8::EpiRes_<2, 2> E{X.xp, X.xs, X.out, XXB, XSSQ}; pg8::gemm_phase<pg8::EpiRes_<2, 2>, pg8::StaticOrder, false, GEMM_SP2, GEMM_ALIGN>(lds, g, S, E, OPQ(tid)); }
            }
            if (l < 3 && bid < 20) {
                pg8::Gemm g{XXB, XWIN + (size_t)(l + 1) * NIN * D, MPAD, NIN, D}; pg8::SampleOrder S{0, 20, bid};
                pg8::EpiUh E{XU, XSSQ};
                pg8::gemm_phase<pg8::EpiUh, pg8::SampleOrder, true>(lds, g, S, E, OPQ(tid));
            }
        }
        SEAM(pb + 4);
    }
#undef IN
#undef SEAM
}

extern "C" void kernel_launch(void* const* d_in, const int* in_sizes, int n_in, void* d_out, int out_size, void* d_ws, size_t ws_size, hipStream_t stream) {
    static int grid_blocks = 0;
    if (!grid_blocks) {
        int dev = 0, cus = 0, per_cu = 0;
        hipGetDevice(&dev);
        hipDeviceGetAttribute(&cus, hipDeviceAttributeMultiprocessorCount, dev);
        hipOccupancyMaxActiveBlocksPerMultiprocessor(&per_cu, mega, NT, 0);
        if (per_cu < 1) { fprintf(stderr, "occupancy query returned %d\n", per_cu); per_cu = 1; }
        grid_blocks = cus * 1;
        if (ws_size < WS_END) fprintf(stderr, "workspace too small: %zu < %zu\n", ws_size, (size_t)WS_END);
    }
    (void)hipMemsetAsync(d_ws, 0, 16384, stream);
    Args a{};
    for (int i = 0; i < 24; ++i) a.in[i] = (const float*)d_in[i];
    a.out = (float*)d_out; a.ws = (unsigned char*)d_ws;
    const int NPH = 21;
#if MULTI_LAUNCH
    for (int p = 0; p < NPH; ++p) {
        a.ph_lo = p; a.ph_hi = p + 1;
        void* kargs[] = {&a};
        hipError_t e = hipLaunchCooperativeKernel((void*)mega, dim3(grid_blocks), dim3(NT), kargs, 0, stream);
        if (e != hipSuccess) fprintf(stderr, "cooperative launch failed: %s (grid %d)\n", hipGetErrorString(e), grid_blocks);
    }
#else
    a.ph_lo = 0; a.ph_hi = NPH;
    void* kargs[] = {&a};
    hipError_t e = hipLaunchCooperativeKernel((void*)mega, dim3(grid_blocks), dim3(NT), kargs, 0, stream);
    if (e != hipSuccess) fprintf(stderr, "cooperative launch failed: %s (grid %d)\n", hipGetErrorString(e), grid_blocks);
#endif
}
```

```cpp
#include <hip/hip_runtime.h>
#include <hip/hip_cooperative_groups.h>
#include <cstdio>
#include <cstdint>
namespace cg = cooperative_groups;

#ifndef REP_SYNC
#define REP_SYNC 1
#endif
#ifndef REP_P1
#define REP_P1 1
#endif
#ifndef REP_P2
#define REP_P2 1
#endif
#ifndef REP_P3
#define REP_P3 1
#endif
#ifndef REP_P0
#define REP_P0 1
#endif
#ifndef REP_P4
#define REP_P4 1
#endif
#ifndef RT_SAMPLE
#define RT_SAMPLE 1
#endif
#ifndef RT_SWA
#define RT_SWA 1
#endif
#ifndef RT_SLOC
#define RT_SLOC 1
#endif
#ifndef RT_MLOC
#define RT_MLOC 1
#endif
#ifndef RT_SOUT
#define RT_SOUT 1
#endif
#ifndef GEMM_SP2
#define GEMM_SP2 true
#endif
#ifndef GEMM_ALIGN
#define GEMM_ALIGN true
#endif
#ifndef MULTI_LAUNCH
#define MULTI_LAUNCH 0
#endif

#define LAS __attribute__((address_space(3)))
typedef unsigned short bf16_t;
typedef short bf16x8 __attribute__((ext_vector_type(8)));
typedef float f32x4 __attribute__((ext_vector_type(4)));
typedef float f32x2 __attribute__((ext_vector_type(2)));
typedef unsigned u32x4 __attribute__((ext_vector_type(4)));
typedef unsigned u32x2 __attribute__((ext_vector_type(2)));
typedef __bf16 bf16x2_t __attribute__((ext_vector_type(2)));
typedef LAS unsigned char* lptr;

constexpr int D = 1024, DIN = 4880, NIN = 5120, DMIX = 1536, TP = 16384, MTOK = 16512, MPAD = 16640, SEQ = 8192;
constexpr int C_AQ = 0, C_AK = 256, C_AV = 512, C_AO = 1024, C_AZ = 1536, C_AI = 2048, C_AF = 2052, C_BZ = 2056, C_BX = 2568, C_BB = 3080, C_BC = 3336,
              C_BDT = 3592, C_CQ = 3600, C_CK = 4112, C_CV = 4240, C_CZ = 4368;
constexpr float EPS = 1e-6f;
constexpr size_t O_YP = 0, O_YS = 16777216, O_PC = 16908288, O_PN = 17170432, O_PM = 17172480, O_PH = 17172512, O_PCONV = 17696800, O_PK = 17721376,
                 O_PV = 17852448, O_SC = 17983520, O_SN = 34760736, O_SM = 34891808, O_SH = 34893856, O_SCONV = 68448288, O_SK = 70021152, O_SV = 78409760;
constexpr size_t WS_BAR = 0;
constexpr size_t WS_PAR = 16384;
constexpr size_t WS_WIN = WS_PAR + 102400;
constexpr size_t WS_WOUT = WS_WIN + (size_t)4 * NIN * D * 2;
constexpr size_t WS_XB = WS_WOUT + (size_t)4 * D * DMIX * 2;
constexpr size_t WS_U = WS_XB + (size_t)MPAD * D * 2;
constexpr size_t WS_MIX = WS_U + (size_t)MPAD * NIN * 2;
constexpr size_t WS_SSQ = WS_MIX + (size_t)MPAD * DMIX * 2;
constexpr size_t WS_ROPE = WS_SSQ + (size_t)MPAD * 16 * 4;
constexpr size_t WS_MC = WS_ROPE + (size_t)8200 * 64 * 4;
constexpr size_t WS_MN = WS_MC + (size_t)8 * 128 * 8192 * 4;
constexpr size_t WS_ML = WS_MN + (size_t)8 * 128 * 64 * 4;
constexpr size_t WS_BL = WS_ML + 4096;
constexpr size_t WS_MS = WS_BL + 4096;
constexpr size_t WS_SA = WS_MS + 4096;
constexpr size_t WS_SH = WS_SA + 8192;
constexpr size_t WS_CSB = WS_SH + (size_t)16 * 128 * 8192 * 4;
constexpr size_t WS_HSB = WS_CSB + (size_t)8 * 128 * 8192 * 2;
constexpr size_t WS_NS = WS_HSB + (size_t)16 * 128 * 8192 * 2;
constexpr size_t WS_END = WS_NS + (size_t)8 * 128 * 64 * 4;
constexpr int LDS_BYTES = 139264;
constexpr int NT = 512;

struct Args { const float* in[24]; float* out; unsigned char* ws; int ph_lo, ph_hi; };

__device__ __forceinline__ float bf2f(unsigned v) { return __uint_as_float(v << 16); }
__device__ __forceinline__ unsigned pk2(float lo, float hi) { f32x2 v = {lo, hi}; bf16x2_t b = __builtin_convertvector(v, bf16x2_t); return __builtin_bit_cast(unsigned, b); }
__device__ __forceinline__ unsigned f2bf(float f) { return pk2(f, 0.f) & 0xffffu; }
__device__ __forceinline__ void unpack8(u32x4 w, float (&f)[8]) {
#pragma unroll
    for (int i = 0; i < 4; ++i) { f[2 * i] = __uint_as_float(w[i] << 16); f[2 * i + 1] = __uint_as_float(w[i] & 0xffff0000u); }
}
__device__ __forceinline__ u32x4 pack8(const float (&f)[8]) { u32x4 w; w[0] = pk2(f[0], f[1]); w[1] = pk2(f[2], f[3]); w[2] = pk2(f[4], f[5]); w[3] = pk2(f[6], f[7]); return w; }
__device__ __forceinline__ u32x4 pack8v(f32x4 a, f32x4 b) { u32x4 w; w[0] = pk2(a[0], a[1]); w[1] = pk2(a[2], a[3]); w[2] = pk2(b[0], b[1]); w[3] = pk2(b[2], b[3]); return w; }
__device__ __forceinline__ bf16x8 as_frag(u32x4 w) { return __builtin_bit_cast(bf16x8, w); }
__device__ __forceinline__ bf16x8 ldg_f32_frag(const float* p) { f32x4 a = *(const f32x4*)p, b = *(const f32x4*)(p + 4); return as_frag(pack8v(a, b)); }
__device__ __forceinline__ bf16x8 lds_frag(lptr base, int row, int k, int stride) { return *(const LAS bf16x8*)(base + ((row * stride + k) << 1)); }
__device__ __forceinline__ f32x4 mfma16(bf16x8 a, bf16x8 b, f32x4 c) { return __builtin_amdgcn_mfma_f32_16x16x32_bf16(a, b, c, 0, 0, 0); }
__device__ __forceinline__ float rcpf_(float x) { return __builtin_amdgcn_rcpf(x); }
__device__ __forceinline__ float sigmoidf_(float x) { return rcpf_(1.f + __expf(-x)); }
__device__ __forceinline__ float siluf_(float x) { return x * rcpf_(1.f + __expf(-x)); }
__device__ __forceinline__ float softplusf_(float x) { return x > 20.f ? x : __logf(1.f + __expf(x)); }
__device__ __forceinline__ float logsigf_(float x) { return fminf(x, 0.f) - __logf(1.f + __expf(-fabsf(x))); }
template <int CTRL, int RM> __device__ __forceinline__ float dpps(float ident, float v) { return __int_as_float(__builtin_amdgcn_update_dpp(__float_as_int(ident), __float_as_int(v), CTRL, RM, 0xf, false)); }
__device__ __forceinline__ float wave_scan_sum(float v, int) {
    v += dpps<0x111, 0xf>(0.f, v); v += dpps<0x112, 0xf>(0.f, v); v += dpps<0x114, 0xf>(0.f, v); v += dpps<0x118, 0xf>(0.f, v);
    v += dpps<0x142, 0xa>(0.f, v); v += dpps<0x143, 0xc>(0.f, v);
    return v;
}
__device__ __forceinline__ float wave_scan_max(float v, int) {
    const float NI = -3.0e38f;
    v = fmaxf(v, dpps<0x111, 0xf>(NI, v)); v = fmaxf(v, dpps<0x112, 0xf>(NI, v)); v = fmaxf(v, dpps<0x114, 0xf>(NI, v)); v = fmaxf(v, dpps<0x118, 0xf>(NI, v));
    v = fmaxf(v, dpps<0x142, 0xa>(NI, v)); v = fmaxf(v, dpps<0x143, 0xc>(NI, v));
    return v;
}
__device__ __forceinline__ float lane63(float v) { return __int_as_float(__builtin_amdgcn_readlane(__float_as_int(v), 63)); }
__device__ __forceinline__ float red16(float v);
__device__ __forceinline__ float red16max(float v);
__device__ __forceinline__ float wave_sum(float v) { v = red16(v); v += __shfl_xor(v, 16); v += __shfl_xor(v, 32); return v; }
__device__ __forceinline__ float wave_max(float v) { v = red16max(v); v = fmaxf(v, __shfl_xor(v, 16)); v = fmaxf(v, __shfl_xor(v, 32)); return v; }
template <int CTRL> __device__ __forceinline__ float dppf(float v) { return __int_as_float(__builtin_amdgcn_update_dpp(0, __float_as_int(v), CTRL, 0xf, 0xf, true)); }
__device__ __forceinline__ float red16(float v) { v += dppf<0xB1>(v); v += dppf<0x4E>(v); v += dppf<0x141>(v); v += dppf<0x140>(v); return v; }
__device__ __forceinline__ float red16max(float v) { v = fmaxf(v, dppf<0xB1>(v)); v = fmaxf(v, dppf<0x4E>(v)); v = fmaxf(v, dppf<0x141>(v)); v = fmaxf(v, dppf<0x140>(v)); return v; }
__device__ __forceinline__ int OPQ(int v) { asm volatile("" : "+v"(v)); return v; }
#define LDS_FENCE() asm volatile("s_waitcnt lgkmcnt(0)" ::: "memory")

namespace pg8 {
constexpr int BM = 256, BK = 64, HALF = 128, HTB = HALF * BK * 2, STAGE_BYTES = 8 * HTB, NXCD = 8, WGM = 8;
__host__ __device__ __forceinline__ int lds_byte(int r, int c) { const int st = (r >> 4) * 2 + (c >> 5), rr = r & 15, cc = c & 31, ob = rr * 64 + cc * 2; return st * 1024 + (ob ^ (((ob >> 9) & 1) << 5)); }
__host__ __device__ __forceinline__ void stage_rc(int b, int& R, int& C) { const int st = b / 1024, sb = b % 1024, swz = sb ^ (((sb >> 9) & 1) << 5); R = (st >> 1) * 16 + swz / 64; C = (st & 1) * 32 + (swz % 64) / 2; }
__host__ __device__ __forceinline__ int perm32(int rho) { const int n = rho >> 4, i = rho & 15; return 8 * (i >> 2) + 4 * n + (i & 3); }
struct Unit { int pm, pn; };
struct Gemm { const bf16_t* A; const bf16_t* Bt; int M, N, K; };
struct StaticOrder {
    int nM, nN, nwg, G, c;
    __device__ void init(int M, int N, int G_, int c_) { nM = M / BM; nN = N / BM; nwg = nM * nN; G = G_; c = c_; }
    __device__ bool next(int i, Unit& u) const {
        const long L = (long)i * G + c; if (L >= nwg) return false;
        int wgid = (int)L; { const int q = nwg / NXCD, r = nwg % NXCD, xcd = wgid % NXCD, off = wgid / NXCD; wgid = (xcd < r ? xcd * (q + 1) : r * (q + 1) + (xcd - r) * q) + off; }
        const int nig = WGM * nN, gid = wgid / nig, fm = gid * WGM, gsz = (nM - fm) < WGM ? (nM - fm) : WGM;
        u.pm = fm + ((wgid % nig) % gsz); u.pn = (wgid % nig) / gsz; return true;
    }
};
template <int NAI> struct EpiU_ {
    bf16_t* U; const float* ssq;
    __device__ __forceinline__ void operator()(const f32x4 (&acc)[2][2][4][2], const Unit& u, int wr, int wc, int fr, int fq) const {
        const int row0 = u.pm * BM + wr * 64 + fr, col0 = u.pn * BM + wc * 32 + 8 * fq;
        f32x4 sq[NAI][4];
#pragma unroll
        for (int ai = 0; ai < NAI; ++ai)
#pragma unroll
            for (int m = 0; m < 4; ++m) sq[ai][m] = *(const f32x4*)(ssq + (size_t)(row0 + ai * HALF + m * 16) * 16 + fq * 4);
#pragma unroll
        for (int ai = 0; ai < NAI; ++ai)
#pragma unroll
            for (int m = 0; m < 4; ++m) {
                const int r = row0 + ai * HALF + m * 16;
                const f32x4 s = sq[ai][m];
                float st = s[0] + s[1] + s[2] + s[3]; st += __shfl_xor(st, 16); st += __shfl_xor(st, 32);
                const float rs = rsqrtf(st * (1.f / 1024.f) + EPS);
                bf16_t* rowp = U + (size_t)r * NIN + col0;
#pragma unroll
                for (int bj = 0; bj < 2; ++bj) *(u32x4*)(rowp + bj * HALF) = pack8v(acc[ai][bj][m][0] * rs, acc[ai][bj][m][1] * rs);
                __builtin_amdgcn_sched_barrier(0);
            }
    }
};
template <int NAI, int MODE> struct EpiRes_ {
    const float* xp; const float* xs; float* out; bf16_t* xb; float* ssq;
    __device__ __forceinline__ void operator()(const f32x4 (&acc)[2][2][4][2], const Unit& u, int wr, int wc, int fr, int fq) const {
        const int row0 = u.pm * BM + wr * 64 + fr, col0 = u.pn * BM + wc * 32 + 8 * fq;
#pragma unroll
        for (int ai = 0; ai < NAI; ++ai) {
            u32x4 xo[4][2];
            if (MODE != 0) {
#pragma unroll
                for (int m = 0; m < 4; ++m)
#pragma unroll
                    for (int bj = 0; bj < 2; ++bj) xo[m][bj] = *(const u32x4*)(xb + (size_t)(row0 + ai * HALF + m * 16) * D + col0 + bj * HALF);
            }
#pragma unroll
            for (int m = 0; m < 4; ++m) {
                const int r = row0 + ai * HALF + m * 16;
                const bool valid = r < MTOK;
                float part = 0.f;
#pragma unroll
                for (int bj = 0; bj < 2; ++bj) {
                    const int c = col0 + bj * HALF;
                    f32x4 o0 = {0.f, 0.f, 0.f, 0.f}, o1 = {0.f, 0.f, 0.f, 0.f};
                    if (MODE == 0) {
                        const float* src = r < TP ? xp + (size_t)r * D : xs + (size_t)(r - TP) * D;
                        if (valid) { o0 = __builtin_nontemporal_load((const f32x4*)(src + c)); o1 = __builtin_nontemporal_load((const f32x4*)(src + c + 4)); }
                    } else {
                        float f[8]; unpack8(xo[m][bj], f);
                        o0 = (f32x4){f[0], f[1], f[2], f[3]}; o1 = (f32x4){f[4], f[5], f[6], f[7]};
                    }
                    const f32x4 v0 = acc[ai][bj][m][0] + o0, v1 = acc[ai][bj][m][1] + o1;
                    if (MODE == 2) {
                        if (valid) { __builtin_nontemporal_store(v0, (f32x4*)(out + (size_t)r * D + c)); __builtin_nontemporal_store(v1, (f32x4*)(out + (size_t)r * D + c + 4)); }
                    } else {
                        *(u32x4*)(xb + (size_t)r * D + c) = pack8v(v0, v1);
                        part += v0[0] * v0[0] + v0[1] * v0[1] + v0[2] * v0[2] + v0[3] * v0[3] + v1[0] * v1[0] + v1[1] * v1[1] + v1[2] * v1[2] + v1[3] * v1[3];
                    }
                }
                if (MODE != 2) {
                    part += __shfl_xor(part, 16); part += __shfl_xor(part, 32);
                    if (fq == 0) ssq[(size_t)r * 16 + u.pn * 4 + wc] = part;
                }
                __builtin_amdgcn_sched_barrier(0);
            }
        }
    }
};

typedef EpiU_<2> EpiU; typedef EpiU_<1> EpiUh;
struct EpiProbe {
    const unsigned* flag; float* dst;
    __device__ __forceinline__ void operator()(const f32x4 (&acc)[2][2][4][2], const Unit& u, int wr, int wc, int fr, int fq) const {
        if (__hip_atomic_load(flag, __ATOMIC_RELAXED, __HIP_MEMORY_SCOPE_AGENT) == 12345u) {
            f32x4 t = {0.f, 0.f, 0.f, 0.f};
#pragma unroll
            for (int a = 0; a < 2; ++a)
#pragma unroll
                for (int b = 0; b < 2; ++b)
#pragma unroll
                    for (int m = 0; m < 4; ++m)
#pragma unroll
                        for (int n = 0; n < 2; ++n) t += acc[a][b][m][n];
            *(f32x4*)(dst + (size_t)(u.pm * 4 + u.pn) * 2048 + (wr * 4 + wc) * 256 + (fq * 16 + fr) * 4) = t;
        }
    }
};
struct SampleOrder {
    int first, cnt, c;
    __device__ bool next(int i, Unit& u) const { if (i != 0 || c < first || c >= first + cnt) return false; u.pm = 64; u.pn = c - first; return true; }
};
template <class Epi, class Sched, bool HALF_M = false, bool SP2 = false, bool ALIGN_EPI = false>
__device__ __forceinline__ void gemm_phase(lptr lds, const Gemm g, const Sched& S, const Epi& E, const int tid) {
    const int wid = __builtin_amdgcn_readfirstlane(tid >> 6), lane = tid & 63, wr = wid >> 2, wc = wid & 3, fr = lane & 15, fq = lane >> 4;
    const int K = g.K, nt = K / BK;
    unsigned voffA[2], voffB[2];
#pragma unroll
    for (int i = 0; i < 2; ++i) { int R, C; stage_rc(tid * 16 + i * 8192, R, C); const int Rb = (R & ~31) + perm32(R & 31);
        voffA[i] = (unsigned)(R * K + C) * 2u; voffB[i] = (unsigned)(Rb * K + C) * 2u; }
    const size_t kstep = (size_t)(BK * 2);
    const size_t hstep = (size_t)HALF * K * 2;
    const size_t tstep = 2 * hstep;
    const unsigned ldsw = (unsigned)wid * 1024u;
    const int aoff = lds_byte(wr * 64 + fr, fq * 8), boff = lds_byte(wc * 32 + fr, fq * 8);
#define PG8_SA(b, h) (((b) * 2 + (h)) * HTB)
#define PG8_SB(b, h) ((4 + (b) * 2 + (h)) * HTB)
#define PG8_STAGE(bufoff, gbase, voff) do { _Pragma("unroll") for (int _i = 0; _i < 2; ++_i) \
        __builtin_amdgcn_global_load_lds((const unsigned*)((const char*)(gbase) + (voff)[_i]), (LAS unsigned*)(lds + (bufoff) + ldsw + _i * 8192), 16, 0, 0); } while (0)
#define PG8_LDA(dst, b, h) do { _Pragma("unroll") for (int m = 0; m < 4; ++m) _Pragma("unroll") for (int k = 0; k < 2; ++k) dst[m][k] = *(const LAS bf16x8*)(lds + PG8_SA(b, h) + aoff + m * 2048 + k * 1024); } while (0)
#define PG8_LDB(dst, b, h) do { _Pragma("unroll") for (int n = 0; n < 2; ++n) _Pragma("unroll") for (int k = 0; k < 2; ++k) dst[n][k] = *(const LAS bf16x8*)(lds + PG8_SB(b, h) + boff + n * 2048 + k * 1024); } while (0)
#define PG8_MMA(ai, bj, At, Bt) do { __builtin_amdgcn_s_setprio(1); _Pragma("unroll") for (int m = 0; m < 4; ++m) _Pragma("unroll") for (int n = 0; n < 2; ++n) _Pragma("unroll") for (int k = 0; k < 2; ++k) \
        acc[ai][bj][m][n] = __builtin_amdgcn_mfma_f32_16x16x32_bf16(Bt[n][k], At[m][k], acc[ai][bj][m][n], 0, 0, 0); __builtin_amdgcn_s_setprio(0); } while (0)
#define PG8_WAIT_V(n) asm volatile("s_waitcnt vmcnt(" #n ")" ::: "memory")
#define PG8_WAIT_L(n) asm volatile("s_waitcnt lgkmcnt(" #n ")" ::: "memory")
#define PG8_BAR __builtin_amdgcn_s_barrier()
#define PG8_SCHED __builtin_amdgcn_sched_barrier(0)
    Unit cur, nxt; int ui = 0;
    if (!S.next(0, cur)) return;
    f32x4 acc[2][2][4][2];
#pragma unroll
    for (int a = 0; a < 2; ++a)
#pragma unroll
        for (int b = 0; b < 2; ++b)
#pragma unroll
            for (int m = 0; m < 4; ++m)
#pragma unroll
                for (int n = 0; n < 2; ++n) acc[a][b][m][n] = (f32x4){0.f, 0.f, 0.f, 0.f};
    bf16x8 At[4][2], B0[2][2], B1[2][2];
    const char* cA = (const char*)g.A + (size_t)cur.pm * tstep; const char* cB = (const char*)g.Bt + (size_t)cur.pn * tstep;
    if constexpr (SP2) {
        PG8_STAGE(PG8_SB(0, 0), cB, voffB); PG8_STAGE(PG8_SB(0, 1), cB + hstep, voffB); PG8_STAGE(PG8_SA(0, 0), cA, voffA); PG8_STAGE(PG8_SA(0, 1), cA + hstep, voffA);
        if (wr == 1) PG8_BAR;
        PG8_WAIT_V(2); PG8_BAR;
        PG8_STAGE(PG8_SB(1, 0), cB + kstep, voffB); PG8_STAGE(PG8_SA(1, 0), cA + kstep, voffA); PG8_STAGE(PG8_SB(1, 1), cB + hstep + kstep, voffB);
        PG8_WAIT_V(6); PG8_BAR;
    } else {
    PG8_STAGE(PG8_SB(0, 0), cB, voffB); PG8_STAGE(PG8_SA(0, 0), cA, voffA); PG8_STAGE(PG8_SB(0, 1), cB + hstep, voffB); PG8_STAGE(PG8_SA(0, 1), cA + hstep, voffA);
    if (wr == 1) PG8_BAR;
    PG8_WAIT_V(4); PG8_BAR;
    PG8_STAGE(PG8_SB(1, 0), cB + kstep, voffB); PG8_STAGE(PG8_SA(1, 0), cA + kstep, voffA); PG8_STAGE(PG8_SB(1, 1), cB + hstep + kstep, voffB);
    PG8_WAIT_V(6); PG8_BAR;
    }
    for (;;) {
        const bool has_next = S.next(ui + 1, nxt);
        const char* nA = has_next ? (const char*)g.A + (size_t)nxt.pm * tstep : cA; const char* nB = has_next ? (const char*)g.Bt + (size_t)nxt.pn * tstep : cB;
        for (int t = 0; t < nt; t += 2) {
            const bool last = (t == nt - 2);
            const char* a1 = cA + (size_t)(t + 1) * kstep;
            const char* a2 = last ? nA : cA + (size_t)(t + 2) * kstep; const char* b2 = last ? nB : cB + (size_t)(t + 2) * kstep;
            const char* a3 = a2 + kstep; const char* b3 = b2 + kstep;
            if constexpr (SP2) {
            PG8_LDB(B0, 0, 0); PG8_LDB(B1, 0, 1); PG8_SCHED; PG8_LDA(At, 0, 0); PG8_STAGE(PG8_SA(1, 1), a1 + hstep, voffA);
            PG8_WAIT_V(8); PG8_WAIT_L(0); PG8_BAR; PG8_MMA(0, 0, At, B0); PG8_MMA(0, 1, At, B1); PG8_BAR; PG8_SCHED;
            PG8_LDA(At, 0, 1); PG8_STAGE(PG8_SB(0, 0), b2, voffB); PG8_STAGE(PG8_SB(0, 1), b2 + hstep, voffB); PG8_STAGE(PG8_SA(0, 0), a2, voffA);
            PG8_WAIT_V(8); PG8_WAIT_L(0); PG8_BAR; PG8_MMA(1, 0, At, B0); PG8_MMA(1, 1, At, B1); PG8_BAR; PG8_SCHED;
            PG8_LDB(B0, 1, 0); PG8_LDB(B1, 1, 1); PG8_SCHED; PG8_LDA(At, 1, 0); PG8_STAGE(PG8_SA(0, 1), a2 + hstep, voffA);
            PG8_WAIT_V(8); PG8_WAIT_L(0); PG8_BAR; PG8_MMA(0, 0, At, B0); PG8_MMA(0, 1, At, B1); PG8_BAR; PG8_SCHED;
            PG8_LDA(At, 1, 1); PG8_STAGE(PG8_SB(1, 0), b3, voffB); PG8_STAGE(PG8_SB(1, 1), b3 + hstep, voffB); PG8_STAGE(PG8_SA(1, 0), a3, voffA);
            PG8_WAIT_V(8); PG8_WAIT_L(0); PG8_BAR; PG8_MMA(1, 0, At, B0); PG8_MMA(1, 1, At, B1); PG8_BAR; PG8_SCHED;
            } else {
            PG8_LDB(B0, 0, 0); PG8_SCHED; PG8_LDA(At, 0, 0); PG8_STAGE(PG8_SA(1, 1), a1 + hstep, voffA);
            PG8_WAIT_L(8); PG8_BAR; PG8_WAIT_L(0); PG8_MMA(0, 0, At, B0); PG8_BAR; PG8_SCHED;
            PG8_LDB(B1, 0, 1); PG8_STAGE(PG8_SB(0, 0), b2, voffB);
            PG8_BAR; PG8_WAIT_L(0); PG8_MMA(0, 1, At, B1); PG8_BAR;
            if constexpr (!HALF_M) PG8_LDA(At, 0, 1);
            PG8_STAGE(PG8_SA(0, 0), a2, voffA);
            PG8_BAR; PG8_WAIT_L(0); if constexpr (!HALF_M) PG8_MMA(1, 0, At, B0); PG8_BAR; PG8_SCHED;
            PG8_STAGE(PG8_SB(0, 1), b2 + hstep, voffB);
            PG8_WAIT_V(6); PG8_BAR; if constexpr (!HALF_M) PG8_MMA(1, 1, At, B1); PG8_BAR;
            PG8_LDB(B0, 1, 0); PG8_SCHED; PG8_LDA(At, 1, 0); PG8_STAGE(PG8_SA(0, 1), a2 + hstep, voffA);
            PG8_WAIT_L(8); PG8_BAR; PG8_WAIT_L(0); PG8_MMA(0, 0, At, B0); PG8_BAR; PG8_SCHED;
            PG8_LDB(B1, 1, 1); PG8_STAGE(PG8_SB(1, 0), b3, voffB);
            PG8_BAR; PG8_WAIT_L(0); PG8_MMA(0, 1, At, B1); PG8_BAR;
            if constexpr (!HALF_M) PG8_LDA(At, 1, 1);
            PG8_STAGE(PG8_SA(1, 0), a3, voffA);
            PG8_BAR; PG8_WAIT_L(0); if constexpr (!HALF_M) PG8_MMA(1, 0, At, B0); PG8_BAR; PG8_SCHED;
            PG8_STAGE(PG8_SB(1, 1), b3 + hstep, voffB);
            PG8_WAIT_V(6); PG8_BAR; if constexpr (!HALF_M) PG8_MMA(1, 1, At, B1); PG8_BAR;
            }
        }
        if constexpr (ALIGN_EPI) { if (wr == 0) PG8_BAR; }
        E(acc, cur, wr, wc, fr, fq);
        if (!has_next) break;
#pragma unroll
        for (int a = 0; a < 2; ++a)
#pragma unroll
            for (int b = 0; b < 2; ++b)
#pragma unroll
                for (int m = 0; m < 4; ++m)
#pragma unroll
                    for (int n = 0; n < 2; ++n) acc[a][b][m][n] = (f32x4){0.f, 0.f, 0.f, 0.f};
        cur = nxt; cA = nA; cB = nB; ++ui;
        if constexpr (ALIGN_EPI) { if (wr == 1) PG8_BAR; }
    }
    PG8_WAIT_V(0);
    if constexpr (!ALIGN_EPI) { if (wr == 0) PG8_BAR; }
    PG8_BAR;
#undef PG8_SA
#undef PG8_SB
#undef PG8_STAGE
#undef PG8_LDA
#undef PG8_LDB
#undef PG8_MMA
#undef PG8_WAIT_V
#undef PG8_WAIT_L
#undef PG8_BAR
#undef PG8_SCHED
}
}

struct Ctx {
    const float* xp; const float* xs; const float* stC; const float* stN; const float* stM; const float* ssm; const float* conv; const float* ck; const float* cv;
    float* out; unsigned char* ws;
};
#define XWIN ((bf16_t*)(X.ws + WS_WIN))
#define XWOUT ((bf16_t*)(X.ws + WS_WOUT))
#define XXB ((bf16_t*)(X.ws + WS_XB))
#define XU ((bf16_t*)(X.ws + WS_U))
#define XMIX ((bf16_t*)(X.ws + WS_MIX))
#define XSSQ ((float*)(X.ws + WS_SSQ))
#define XROPE ((float*)(X.ws + WS_ROPE))
#define XMC ((float*)(X.ws + WS_MC))
#define XMN ((float*)(X.ws + WS_MN))
#define XML ((float*)(X.ws + WS_ML))
#define XBL ((float*)(X.ws + WS_BL))
#define XMS ((float*)(X.ws + WS_MS))
#define XSA ((float*)(X.ws + WS_SA))
#define XSH ((float*)(X.ws + WS_SH))
#define XCSB ((bf16_t*)(X.ws + WS_CSB))
#define XNS ((float*)(X.ws + WS_NS))
#define XHSB ((bf16_t*)(X.ws + WS_HSB))
#define XPAR(off) ((const float*)(X.ws + WS_PAR) + (off))
constexpr int P_AIB = 0, P_AFB = 16, P_DTB = 32, P_ALOG = 64, P_BD = 96, P_SINK = 128, P_QNW = 160, P_KNW = 416, P_ANW = 672, P_BNW = 2720, P_CB = 4768, P_CW = 8864, P_END = 25248;
#define IN_XP 0
#define IN_XS 1
#define IN_STC 2
#define IN_STN 3
#define IN_STM 4
#define IN_SSM 5
#define IN_CONV 6
#define IN_CK 7
#define IN_CV 8
#define IN_NORMW 9
#define IN_WIN 10
#define IN_AIB 11
#define IN_AFB 12
#define IN_ANW 13
#define IN_CW 14
#define IN_CB 15
#define IN_DTB 16
#define IN_ALOG 17
#define IN_BD 18
#define IN_BNW 19
#define IN_QNW 20
#define IN_KNW 21
#define IN_SINK 22
#define IN_WOUT 23

__device__ __forceinline__ void transpose_strip(lptr lds, const float* src, int ldn, int nvalid, bf16_t* dst, int ldk, const float* scale, int k0, int n0, int tid) {
    LAS float* T = (LAS float*)lds;
    f32x4 v[8];
#pragma unroll
    for (int i = 0; i < 8; ++i) {
        const int f = tid + i * NT, r = f >> 6, c4 = (f & 63) * 4, n = n0 + c4;
        const f32x4 t = __builtin_nontemporal_load((const f32x4*)(src + (size_t)(k0 + r) * ldn + (n < nvalid ? n : 0)));
        const float m = n < nvalid ? (scale ? scale[k0 + r] : 1.f) : 0.f;
        v[i] = t * m;
    }
#pragma unroll
    for (int i = 0; i < 8; ++i) {
        const int f = tid + i * NT, r = f >> 6, c4 = (f & 63) * 4;
        T[r * 257 + c4 + 0] = v[i][0]; T[r * 257 + c4 + 1] = v[i][1]; T[r * 257 + c4 + 2] = v[i][2]; T[r * 257 + c4 + 3] = v[i][3];
    }
    __syncthreads();
#pragma unroll
    for (int i = 0; i < 4; ++i) {
        const int p = tid + i * NT, n = p >> 3, k8 = (p & 7) * 8; float f[8];
#pragma unroll
        for (int jx = 0; jx < 8; ++jx) f[jx] = T[(k8 + jx) * 257 + n];
        *(u32x4*)(dst + (size_t)(n0 + n) * ldk + k0 + k8) = pack8(f);
    }
    __syncthreads();
}

__device__ __forceinline__ void prologue(lptr lds, const Ctx& X, const Args& args, int G, int bid, int tid) {
    const int lane = tid & 63, wave = tid >> 6;
    constexpr int T0 = 320, T1 = T0 + 96, T2 = T1 + 520, T3 = T2 + 1, T4 = T3 + 513;
    for (int task = bid; task < T4; task += G) {
        if (task < T0) {
            const int kt = task / 20, ntl = task % 20;
            transpose_strip(lds, args.in[IN_WIN], DIN, DIN, XWIN, D, args.in[IN_NORMW], kt * 64, ntl * 256, tid);
        } else if (task < T1) {
            const int r = task - T0, kt = r / 4, ntl = r % 4;
            transpose_strip(lds, args.in[IN_WOUT], D, D, XWOUT, DMIX, nullptr, kt * 64, ntl * 256, tid);
        } else if (task < T2) {
            const int rb = (task - T1) * 32 + wave * 4;
            f32x4 v[4][4];
#pragma unroll
            for (int q = 0; q < 4; ++q) {
                const int r = rb + q, rc = r < MTOK ? r : MTOK - 1;
                const float* src = rc < TP ? X.xp + (size_t)rc * D : X.xs + (size_t)(rc - TP) * D;
#pragma unroll
                for (int i = 0; i < 4; ++i) v[q][i] = __builtin_nontemporal_load((const f32x4*)(src + lane * 4 + i * 256));
            }
#pragma unroll
            for (int q = 0; q < 4; ++q) {
                const int r = rb + q;
                const float keep = r < MTOK ? 1.f : 0.f;
                float ss = 0.f;
#pragma unroll
                for (int i = 0; i < 4; ++i) {
                    const f32x4 t = v[q][i] * keep;
                    ss += t[0] * t[0] + t[1] * t[1] + t[2] * t[2] + t[3] * t[3];
                    u32x2 w; w[0] = pk2(t[0], t[1]); w[1] = pk2(t[2], t[3]);
                    *(u32x2*)(XXB + (size_t)r * D + lane * 4 + i * 256) = w;
                }
                ss = wave_sum(ss);
                if (lane < 16) XSSQ[(size_t)r * 16 + lane] = (lane == 0) ? ss : 0.f;
            }
        } else if (task < T3) {
            for (int i = tid; i < (MPAD - MTOK) * DMIX / 2; i += NT) ((unsigned*)(XMIX + (size_t)MTOK * DMIX))[i] = 0u;
            float* P = (float*)(X.ws + WS_PAR);
            const int po[12] = {P_AIB, P_AFB, P_DTB, P_ALOG, P_BD, P_SINK, P_QNW, P_KNW, P_ANW, P_BNW, P_CB, P_CW};
            const int pn[12] = {16, 16, 32, 32, 32, 32, 256, 256, 2048, 2048, 4096, 16384};
            const int pi[12] = {IN_AIB, IN_AFB, IN_DTB, IN_ALOG, IN_BD, IN_SINK, IN_QNW, IN_KNW, IN_ANW, IN_BNW, IN_CB, IN_CW};
#pragma unroll
            for (int a = 0; a < 12; ++a) { const float* src = args.in[pi[a]]; for (int i = tid; i < pn[a]; i += NT) P[po[a] + i] = src[i]; }
        } else {
            const int e = (task - T3) * 512 + tid;
            if (e < 8193 * 32) {
                const int pos = e >> 5, d = e & 31;
                const float inv = (float)exp2(-(double)d * (13.287712379549449 / 32.0));
                const float angf = (float)pos * inv;
                const double a = (double)angf;
                const double k = rint(a * 0.15915494309189535);
                const float rr = (float)(a - k * 6.283185307179586);
                XROPE[(size_t)e * 2] = cosf(rr); XROPE[(size_t)e * 2 + 1] = sinf(rr);
            }
        }
    }
}

__device__ __forceinline__ void convert_weights(lptr lds, const Ctx& X, const Args& args, int l, int first, int stride, int tid) {
    for (int t = first; t < 416; t += stride) {
        if (t < 320) {
            const int kt = t / 20, ntl = t % 20;
            transpose_strip(lds, args.in[IN_WIN] + (size_t)l * D * DIN, DIN, DIN, XWIN + (size_t)l * NIN * D, D, args.in[IN_NORMW] + l * D, kt * 64, ntl * 256, tid);
        } else {
            const int r = t - 320, kt = r / 4, ntl = r % 4;
            transpose_strip(lds, args.in[IN_WOUT] + (size_t)l * DMIX * D, D, D, XWOUT + (size_t)l * D * DMIX, DMIX, nullptr, kt * 64, ntl * 256, tid);
        }
    }
}

__device__ __forceinline__ void conv8(const bf16_t* u, int seq0, int tt, int ch, const float* cw, const float* cb, float (&o)[8]) {
    float acc[8];
    { f32x4 b0 = *(const f32x4*)(cb + ch), b1 = *(const f32x4*)(cb + ch + 4);
#pragma unroll
      for (int j = 0; j < 4; ++j) { acc[j] = b0[j]; acc[4 + j] = b1[j]; } }
#pragma unroll
    for (int jj = 0; jj < 4; ++jj) {
        const int t2 = tt + jj - 3;
        if (t2 >= 0) {
            float x[8]; unpack8(*(const u32x4*)(u + (size_t)(seq0 + t2) * NIN + C_BX + ch), x);
            f32x4 w0 = *(const f32x4*)(cw + jj * 1024 + ch), w1 = *(const f32x4*)(cw + jj * 1024 + ch + 4);
#pragma unroll
            for (int j = 0; j < 4; ++j) { acc[j] += x[j] * w0[j]; acc[4 + j] += x[4 + j] * w1[j]; }
        }
    }
#pragma unroll
    for (int j = 0; j < 8; ++j) o[j] = siluf_(acc[j]);
}


__device__ __forceinline__ void conv8x8(const bf16_t* u, int seq0, int tt0, int ch, const float* cw, const float* cb, float (&o)[8][8]) {
    float w[4][8];
#pragma unroll
    for (int jj = 0; jj < 4; ++jj) { f32x4 w0 = *(const f32x4*)(cw + jj * 1024 + ch), w1 = *(const f32x4*)(cw + jj * 1024 + ch + 4);
#pragma unroll
        for (int j = 0; j < 4; ++j) { w[jj][j] = w0[j]; w[jj][4 + j] = w1[j]; } }
    { f32x4 b0 = *(const f32x4*)(cb + ch), b1 = *(const f32x4*)(cb + ch + 4);
#pragma unroll
      for (int t = 0; t < 8; ++t)
#pragma unroll
          for (int j = 0; j < 4; ++j) { o[t][j] = b0[j]; o[t][4 + j] = b1[j]; } }
    u32x4 raw[11];
#pragma unroll
    for (int r = 0; r < 11; ++r) {
        const int t2 = tt0 + r - 3;
        const u32x4 v = *(const u32x4*)(u + (unsigned)(seq0 + (t2 >= 0 ? t2 : 0)) * NIN + C_BX + ch);
        const unsigned msk = t2 >= 0 ? 0xffffffffu : 0u;
        raw[r] = (u32x4){v[0] & msk, v[1] & msk, v[2] & msk, v[3] & msk};
    }
#pragma unroll
    for (int r = 0; r < 11; ++r) {
        float x[8]; unpack8(raw[r], x);
#pragma unroll
        for (int jj = 0; jj < 4; ++jj) {
            const int t = r - jj;
            if (t >= 0 && t < 8) {
#pragma unroll
                for (int j = 0; j < 8; ++j) o[t][j] += x[j] * w[jj][j];
            }
        }
    }
#pragma unroll
    for (int t = 0; t < 8; ++t)
#pragma unroll
        for (int j = 0; j < 8; ++j) o[t][j] = siluf_(o[t][j]);
}

__device__ __forceinline__ void mlstm_local(lptr lds, const Ctx& X, int l, int task, int tid) {
    const int h = task & 3, c = (task >> 2) & 127, n = task >> 9;
    const int lane = tid & 63, wave = tid >> 6, fr = lane & 15, fq = lane >> 4;
    const int row0 = n * SEQ + c * 64, nh = n * 4 + h;
    lptr VwT = lds;
    lptr KT = lds + 18432;
    LAS float* wv = (LAS float*)(lds + 27648);
    const int tg = lane & 7, cgq = lane >> 3;
    u32x4 blk[8];
    if (wave >= 1 && wave <= 3) {
        const int col = wave < 3 ? C_AV + h * 128 + ((wave - 1) * 8 + cgq) * 8 : C_AK + h * 64 + cgq * 8;
#pragma unroll
        for (int t = 0; t < 8; ++t) blk[t] = *(const u32x4*)(XU + (unsigned)(row0 + 8 * tg + t) * NIN + col);
    }
    if (wave == 0) {
        const bf16_t* ur = XU + (unsigned)(row0 + lane) * NIN;
        const float fg = bf2f(ur[C_AF + h]) + XPAR(P_AFB)[l * 4 + h], ig = bf2f(ur[C_AI + h]) + XPAR(P_AIB)[l * 4 + h];
        const float b = wave_scan_sum(logsigf_(fg), lane);
        const float bl = lane63(b);
        const float g = bl - b + ig;
        const float ml = wave_max(g);
        wv[lane] = __expf(g - ml);
        if (lane == 0) { XML[nh * 128 + c] = ml; XBL[nh * 128 + c] = bl; }
    }
    __syncthreads();
    if (wave >= 1 && wave <= 3) {
        float xs[8][8];
#pragma unroll
        for (int t = 0; t < 8; ++t) { unpack8(blk[t], xs[t]); const float w = wave < 3 ? wv[8 * tg + t] : 0.125f;
#pragma unroll
            for (int j = 0; j < 8; ++j) xs[t][j] *= w; }
        lptr dstT = wave < 3 ? VwT + ((((wave - 1) * 8 + cgq) * 8 * 72) << 1) : KT + ((cgq * 8 * 72) << 1);
#pragma unroll
        for (int j = 0; j < 8; ++j) {
            float v[8];
#pragma unroll
            for (int t = 0; t < 8; ++t) v[t] = xs[t][j];
            *(LAS u32x4*)(dstT + ((j * 72 + 8 * tg) << 1)) = pack8(v);
        }
    }
    __syncthreads();
    {
        bf16_t* dst = (bf16_t*)XMC + ((size_t)nh * 128 + c) * 8192;
        bf16x8 b0 = lds_frag(VwT, 16 * wave + fr, fq * 8, 72), b1 = lds_frag(VwT, 16 * wave + fr, 32 + fq * 8, 72);
#pragma unroll
        for (int mt = 0; mt < 4; ++mt) {
            f32x4 acc = {0.f, 0.f, 0.f, 0.f};
            acc = mfma16(lds_frag(KT, 16 * mt + fr, fq * 8, 72), b0, acc);
            acc = mfma16(lds_frag(KT, 16 * mt + fr, 32 + fq * 8, 72), b1, acc);
            { u32x2 w; w[0] = pk2(acc[0], acc[1]); w[1] = pk2(acc[2], acc[3]); *(u32x2*)(dst + (16 * wave + fr) * 64 + 16 * mt + 4 * fq) = w; }
        }
    }
    if (tid < 64) {
        float s = 0.f;
#pragma unroll
        for (int t8 = 0; t8 < 8; ++t8) {
            float kf[8]; unpack8(*(const LAS u32x4*)(KT + ((tid * 72 + t8 * 8) << 1)), kf);
#pragma unroll
            for (int jx = 0; jx < 8; ++jx) s += kf[jx] * wv[t8 * 8 + jx];
        }
        XMN[((size_t)nh * 128 + c) * 64 + tid] = s;
    }
    __syncthreads();
}

__device__ __forceinline__ void ssd_local(lptr lds, const Ctx& X, int l, int task, int tid) {
    const int g = task & 1, c = (task >> 1) & 127, n = task >> 8;
    const int lane = tid & 63, wave = tid >> 6, fr = lane & 15, fq = lane >> 4;
    const int seq0 = n * SEQ, row0 = seq0 + c * 64;
    lptr XwT = lds;
    lptr BT = lds + 36864;
    LAS float* wl = (LAS float*)(lds + 55296);
    {
        const float* cw = XPAR(P_CW) + l * 4096; const float* cb = XPAR(P_CB) + l * 1024;
        const int tg = lane & 7, cg = wave * 8 + (lane >> 3);
        float o[8][8];
        if (wave < 6) {
            const int ch = cg < 32 ? g * 256 + cg * 8 : 512 + g * 128 + (cg - 32) * 8;
            conv8x8(XU, seq0, c * 64 + 8 * tg, ch, cw, cb, o);
        }
        if (wave < 4) {
            const int hh = 4 * g + wave;
            const float dt = softplusf_(bf2f(XU[(unsigned)(row0 + lane) * NIN + C_BDT + hh]) + XPAR(P_DTB)[l * 8 + hh]);
            const float A = -__expf(XPAR(P_ALOG)[l * 8 + hh]);
            const float a = wave_scan_sum(dt * A, lane);
            const float aL = lane63(a);
            wl[wave * 64 + lane] = __expf(aL - a) * dt;
            if (lane == 0) XSA[(n * 8 + hh) * 128 + c] = aL;
        }
        __syncthreads();
        if (wave < 4) {
            float wt[8];
#pragma unroll
            for (int t = 0; t < 8; ++t) wt[t] = wl[wave * 64 + 8 * tg + t];
#pragma unroll
            for (int jx = 0; jx < 8; ++jx) {
                float v[8];
#pragma unroll
                for (int t = 0; t < 8; ++t) v[t] = o[t][jx] * wt[t];
                *(LAS u32x4*)(XwT + (((cg * 8 + jx) * 72 + 8 * tg) << 1)) = pack8(v);
            }
        } else if (wave < 6) {
#pragma unroll
            for (int jx = 0; jx < 8; ++jx) {
                float v[8];
#pragma unroll
                for (int t = 0; t < 8; ++t) v[t] = o[t][jx];
                *(LAS u32x4*)(BT + ((((cg - 32) * 8 + jx) * 72 + 8 * tg) << 1)) = pack8(v);
            }
        }
    }
    __syncthreads();
    {
        const int hl = wave >> 1, ph = wave & 1, hh = 4 * g + hl;
        bf16_t* dst = (bf16_t*)XSH + ((size_t)(n * 8 + hh) * 128 + c) * 8192;
        bf16x8 bx[2][2];
#pragma unroll
        for (int ntl = 0; ntl < 2; ++ntl)
#pragma unroll
            for (int kk = 0; kk < 2; ++kk) bx[ntl][kk] = lds_frag(XwT, hl * 64 + ph * 32 + ntl * 16 + fr, kk * 32 + fq * 8, 72);
#pragma unroll
        for (int mt = 0; mt < 8; ++mt) {
            bf16x8 a0 = lds_frag(BT, 16 * mt + fr, fq * 8, 72), a1 = lds_frag(BT, 16 * mt + fr, 32 + fq * 8, 72);
#pragma unroll
            for (int ntl = 0; ntl < 2; ++ntl) {
                f32x4 acc = {0.f, 0.f, 0.f, 0.f};
                acc = mfma16(a0, bx[ntl][0], acc); acc = mfma16(a1, bx[ntl][1], acc);
                { u32x2 w; w[0] = pk2(acc[0], acc[1]); w[1] = pk2(acc[2], acc[3]); *(u32x2*)(dst + (ph * 32 + ntl * 16 + fr) * 128 + 16 * mt + 4 * fq) = w; }
            }
        }
    }
    __syncthreads();
}

__device__ __forceinline__ void swa_prompt(lptr lds, const Ctx& X, int l, int task, int tid) {
    const int kvh = task & 1, qb = (task >> 1) & 63, n = task >> 7;
    const int lane = tid & 63, wave = tid >> 6, fr = lane & 15, fq = lane >> 4;
    const int seq0 = n * SEQ;
    lptr Kn = lds;
    lptr Vt = lds + 36864;
    lptr Pw = lds + 70656 + wave * 8448;
    const float* knw = XPAR(P_KNW) + l * 64; const float* qnw = XPAR(P_QNW) + l * 64;
#pragma unroll
    for (int it = 0; it < 2; ++it) {
        const int item = tid + it * NT, j = item >> 2, qd = item & 3, t = qb * 128 - 128 + j;
        float o1[8], o2[8];
        {
            const int tc = t >= 0 ? t : 0;
            const bf16_t* kr = XU + (unsigned)(seq0 + tc) * NIN + C_CK + kvh * 64;
            float x1[8], x2[8]; unpack8(*(const u32x4*)(kr + qd * 8), x1); unpack8(*(const u32x4*)(kr + 32 + qd * 8), x2);
            float ss = 0.f;
#pragma unroll
            for (int jj = 0; jj < 8; ++jj) ss += x1[jj] * x1[jj] + x2[jj] * x2[jj];
            ss += __shfl_xor(ss, 1); ss += __shfl_xor(ss, 2);
            const float rs = rsqrtf(ss * (1.f / 64.f) + EPS);
            const f32x4* cs = (const f32x4*)(XROPE + ((size_t)tc * 32 + qd * 8) * 2);
            f32x4 csv[4];
#pragma unroll
            for (int q4 = 0; q4 < 4; ++q4) csv[q4] = cs[q4];
            const float zm = t >= 0 ? 1.f : 0.f;
#pragma unroll
            for (int jj = 0; jj < 8; ++jj) {
                const float a = x1[jj] * rs * knw[qd * 8 + jj], b = x2[jj] * rs * knw[32 + qd * 8 + jj], co = csv[jj >> 1][(jj & 1) * 2], si = csv[jj >> 1][(jj & 1) * 2 + 1];
                o1[jj] = (a * co - b * si) * zm; o2[jj] = (b * co + a * si) * zm;
            }
        }
        *(LAS u32x4*)(Kn + ((j * 72 + qd * 8) << 1)) = pack8(o1);
        *(LAS u32x4*)(Kn + ((j * 72 + 32 + qd * 8) << 1)) = pack8(o2);
        if (qb == 63 && j >= 128) {
            float* ko = X.out + O_PK + ((((size_t)l * 2 + n) * 128 + (j - 128)) * 2 + kvh) * 64;
            *(f32x4*)(ko + qd * 8) = (f32x4){o1[0], o1[1], o1[2], o1[3]}; *(f32x4*)(ko + qd * 8 + 4) = (f32x4){o1[4], o1[5], o1[6], o1[7]};
            *(f32x4*)(ko + 32 + qd * 8) = (f32x4){o2[0], o2[1], o2[2], o2[3]}; *(f32x4*)(ko + 32 + qd * 8 + 4) = (f32x4){o2[4], o2[5], o2[6], o2[7]};
        }
    }
    if (wave < 4) {
        const int tg = tid & 31, cg = tid >> 5;
        u32x4 vb[8];
#pragma unroll
        for (int t8 = 0; t8 < 8; ++t8) {
            const int jk = 8 * tg + t8, t = qb * 128 - 128 + jk;
            u32x4 w = *(const u32x4*)(XU + (unsigned)(seq0 + (t >= 0 ? t : 0)) * NIN + C_CV + kvh * 64 + cg * 8);
            const unsigned msk = t >= 0 ? 0xffffffffu : 0u;
            vb[t8] = (u32x4){w[0] & msk, w[1] & msk, w[2] & msk, w[3] & msk};
        }
#pragma unroll
        for (int jj = 0; jj < 8; ++jj) {
            u32x4 w;
#pragma unroll
            for (int tp = 0; tp < 4; ++tp) {
                const unsigned lo = (vb[2 * tp][jj >> 1] >> ((jj & 1) * 16)) & 0xffffu, hi = (vb[2 * tp + 1][jj >> 1] >> ((jj & 1) * 16)) & 0xffffu;
                w[tp] = lo | (hi << 16);
            }
            *(LAS u32x4*)(Vt + (((cg * 8 + jj) * 264 + 8 * tg) << 1)) = w;
        }
        if (qb == 63 && tg >= 16) {
#pragma unroll
            for (int t8 = 0; t8 < 8; ++t8) {
                float x[8]; unpack8(vb[t8], x);
                float* vo = X.out + O_PV + ((((size_t)l * 2 + n) * 128 + (8 * tg + t8 - 128)) * 2 + kvh) * 64 + cg * 8;
                *(f32x4*)(vo) = (f32x4){x[0], x[1], x[2], x[3]}; *(f32x4*)(vo + 4) = (f32x4){x[4], x[5], x[6], x[7]};
            }
        }
    }
    __syncthreads();
    const int hq = kvh * 4 + (wave >> 1), i0 = (wave & 1) * 64;
    const float sink = XPAR(P_SINK)[l * 8 + hq];
    float qw1[8], qw2[8];
#pragma unroll
    for (int jj = 0; jj < 8; ++jj) { qw1[jj] = qnw[fq * 8 + jj]; qw2[jj] = qnw[32 + fq * 8 + jj]; }
    u32x4 qn0, qn1; f32x4 csn[4];
    {
        const int t = qb * 128 + i0 + fr;
        const bf16_t* qr = XU + (unsigned)(seq0 + t) * NIN + C_CQ + hq * 64;
        qn0 = *(const u32x4*)(qr + fq * 8); qn1 = *(const u32x4*)(qr + 32 + fq * 8);
        const f32x4* cs = (const f32x4*)(XROPE + ((size_t)t * 32 + fq * 8) * 2);
#pragma unroll
        for (int q4 = 0; q4 < 4; ++q4) csn[q4] = cs[q4];
    }
#pragma unroll 1
    for (int mt = 0; mt < 4; ++mt) {
        const int q0 = i0 + mt * 16;
        const u32x4 q0r = qn0, q1r = qn1; f32x4 csc[4];
#pragma unroll
        for (int q4 = 0; q4 < 4; ++q4) csc[q4] = csn[q4];
        {
            const int mn = mt < 3 ? mt + 1 : 3;
            const int t = qb * 128 + i0 + mn * 16 + fr;
            const bf16_t* qr = XU + (unsigned)(seq0 + t) * NIN + C_CQ + hq * 64;
            qn0 = *(const u32x4*)(qr + fq * 8); qn1 = *(const u32x4*)(qr + 32 + fq * 8);
            const f32x4* cs = (const f32x4*)(XROPE + ((size_t)t * 32 + fq * 8) * 2);
#pragma unroll
            for (int q4 = 0; q4 < 4; ++q4) csn[q4] = cs[q4];
        }
        bf16x8 a0, a1;
        {
            float x1[8], x2[8]; unpack8(q0r, x1); unpack8(q1r, x2);
            float ss = 0.f;
#pragma unroll
            for (int jj = 0; jj < 8; ++jj) ss += x1[jj] * x1[jj] + x2[jj] * x2[jj];
            ss += __shfl_xor(ss, 16); ss += __shfl_xor(ss, 32);
            const float rs = rsqrtf(ss * (1.f / 64.f) + EPS) * 0.125f;
            float o1[8], o2[8];
#pragma unroll
            for (int jj = 0; jj < 8; ++jj) {
                const float a = x1[jj] * rs * qw1[jj], b = x2[jj] * rs * qw2[jj], co = csc[jj >> 1][(jj & 1) * 2], si = csc[jj >> 1][(jj & 1) * 2 + 1];
                o1[jj] = a * co - b * si; o2[jj] = b * co + a * si;
            }
            a0 = as_frag(pack8(o1)); a1 = as_frag(pack8(o2));
        }
        const int tlo = q0 >> 4;
        const int qi = q0 + fr;
        const int dlo = qb > 0 ? 1 : (128 - qi > 1 ? 128 - qi : 1);
        f32x4 s[16];
        float mx = -3.0e38f;
#pragma unroll
        for (int ntl = 0; ntl < 16; ++ntl) {
            if (ntl >= tlo && ntl <= tlo + 8) {
                f32x4 acc = {0.f, 0.f, 0.f, 0.f};
                acc = mfma16(lds_frag(Kn, 16 * ntl + fr, fq * 8, 72), a0, acc);
                acc = mfma16(lds_frag(Kn, 16 * ntl + fr, 32 + fq * 8, 72), a1, acc);
                if (ntl == tlo || ntl == tlo + 8 || qb == 0) {
#pragma unroll
                    for (int ii = 0; ii < 4; ++ii) {
                        const int dk = 16 * ntl + 4 * fq + ii - qi;
                        acc[ii] = ((unsigned)(dk - dlo) <= (unsigned)(128 - dlo)) ? acc[ii] : -3.0e38f;
                    }
                }
                mx = fmaxf(mx, fmaxf(fmaxf(acc[0], acc[1]), fmaxf(acc[2], acc[3])));
                s[ntl] = acc;
            }
        }
        mx = fmaxf(mx, __shfl_xor(mx, 16)); mx = fmaxf(mx, __shfl_xor(mx, 32));
        mx = fmaxf(mx, sink);
        float sum = 0.f;
#pragma unroll
        for (int ntl = 0; ntl < 16; ++ntl) {
            if (ntl >= tlo && ntl <= tlo + 8) {
#pragma unroll
                for (int ii = 0; ii < 4; ++ii) { const float e = __expf(s[ntl][ii] - mx); s[ntl][ii] = e; sum += e; }
            }
        }
        sum += __shfl_xor(sum, 16); sum += __shfl_xor(sum, 32);
        const float inv = rcpf_(sum + __expf(sink - mx));
        const int klo = q0 >> 5, khi = (q0 + 143) >> 5;
#pragma unroll
        for (int ntl = 0; ntl < 16; ++ntl) {
            if (ntl >= tlo && ntl <= tlo + 8) {
                u32x2 w; w[0] = pk2(s[ntl][0] * inv, s[ntl][1] * inv); w[1] = pk2(s[ntl][2] * inv, s[ntl][3] * inv);
                *(LAS u32x2*)(Pw + ((fr * 264 + 16 * ntl + 4 * fq) << 1)) = w;
            } else if ((ntl >> 1) >= klo && (ntl >> 1) <= khi) {
                u32x2 w = {0u, 0u};
                *(LAS u32x2*)(Pw + ((fr * 264 + 16 * ntl + 4 * fq) << 1)) = w;
            }
        }
        u32x2 czv[4];
#pragma unroll
        for (int ntl = 0; ntl < 4; ++ntl) czv[ntl] = *(const u32x2*)(XU + ((unsigned)seq0 + qb * 128 + q0 + fr) * NIN + C_CZ + hq * 64 + 16 * ntl + 4 * fq);
        LDS_FENCE();
        f32x4 o[4];
#pragma unroll
        for (int ntl = 0; ntl < 4; ++ntl) o[ntl] = (f32x4){0.f, 0.f, 0.f, 0.f};
#pragma unroll
        for (int kk = 0; kk < 8; ++kk) {
            if (kk >= klo && kk <= khi) {
                const bf16x8 a = lds_frag(Pw, fr, kk * 32 + fq * 8, 264);
#pragma unroll
                for (int ntl = 0; ntl < 4; ++ntl) o[ntl] = mfma16(lds_frag(Vt, 16 * ntl + fr, kk * 32 + fq * 8, 264), a, o[ntl]);
            }
        }
        LDS_FENCE();
        {
            const unsigned row = (unsigned)seq0 + qb * 128 + q0 + fr;
#pragma unroll
            for (int ntl = 0; ntl < 4; ++ntl) {
                const float z0 = __uint_as_float(czv[ntl][0] << 16), z1 = __uint_as_float(czv[ntl][0] & 0xffff0000u), z2 = __uint_as_float(czv[ntl][1] << 16), z3 = __uint_as_float(czv[ntl][1] & 0xffff0000u);
                u32x2 w; w[0] = pk2(o[ntl][0] * siluf_(z0), o[ntl][1] * siluf_(z1)); w[1] = pk2(o[ntl][2] * siluf_(z2), o[ntl][3] * siluf_(z3));
                *(u32x2*)(XMIX + row * DMIX + 1024 + hq * 64 + 16 * ntl + 4 * fq) = w;
            }
        }
    }
    __syncthreads();
}

__device__ __forceinline__ void sample_task(lptr lds, const Ctx& X, int l, int b, int part, int tid) {
    LAS float* uf = (LAS float*)lds;
    LAS float* xbc = (LAS float*)(lds + 19968);
    LAS float* numv = (LAS float*)(lds + 24064);
    LAS float* yv = (LAS float*)(lds + 26112);
    LAS float* red = (LAS float*)(lds + 28160);
    LAS float* qs = (LAS float*)(lds + 28416);
    LAS float* kn = (LAS float*)(lds + 30464);
    LAS float* sc = (LAS float*)(lds + 30976);
    const int lane = tid & 63, wave = tid >> 6;
    const size_t row = (size_t)TP + b;
    const bf16_t* ur = XU + row * NIN;
    const size_t lb = (size_t)l * 128 + b;
    f32x4 kpre[8], vpre[8];
    if (part == 2) {
        const float* kc = X.ck + lb * 16384; const float* vc = X.cv + lb * 16384;
#pragma unroll
        for (int it = 0; it < 8; ++it) {
            const int e = (tid + it * NT) * 4, e2 = e < 127 * 128 ? e + 128 : e;
            kpre[it] = __builtin_nontemporal_load((const f32x4*)(kc + e2)); vpre[it] = __builtin_nontemporal_load((const f32x4*)(vc + e2));
        }
    }
    f32x4 spre[4][4];
    if (part == 0) {
#pragma unroll
        for (int h = 0; h < 4; ++h)
#pragma unroll
            for (int it = 0; it < 4; ++it) spre[h][it] = __builtin_nontemporal_load((const f32x4*)(X.stC + (lb * 4 + h) * 8192 + (tid + it * NT) * 4));
    }
    if (part == 1) {
#pragma unroll
        for (int h = 0; h < 4; ++h)
#pragma unroll
            for (int it = 0; it < 4; ++it) spre[h][it] = __builtin_nontemporal_load((const f32x4*)(X.ssm + (lb * 8 + h) * 8192 + (tid + it * NT) * 4));
    }
    {
        const int c_lo = part == 0 ? 0 : (part == 1 ? C_BZ : C_CQ), c_hi = part == 0 ? C_BZ : (part == 1 ? C_CQ : DIN);
        if (tid < ((c_hi - c_lo) >> 3)) {
            float f[8]; unpack8(*(const u32x4*)(ur + c_lo + 8 * tid), f);
#pragma unroll
            for (int j = 0; j < 8; ++j) uf[c_lo + 8 * tid + j] = f[j];
        }
    }
    __syncthreads();
    if (part == 0) {
#pragma unroll
    for (int h = 0; h < 4; ++h) {
        const float ig = uf[C_AI + h] + XPAR(P_AIB)[l * 4 + h], fg = uf[C_AF + h] + XPAR(P_AFB)[l * 4 + h];
        const float ls = logsigf_(fg), m0 = X.stM[lb * 4 + h];
        const float mn = fmaxf(ls + m0, ig), sp = __expf(ls + m0 - mn), sl = __expf(ig - mn);
        const float* C0 = X.stC + (lb * 4 + h) * 8192; float* C1 = X.out + O_SC + (lb * 4 + h) * 8192;
#pragma unroll
        for (int it = 0; it < 4; ++it) {
            const int e = (tid + it * NT) * 4, v = e >> 6, k = e & 63;
            const f32x4 c0 = spre[h][it];
            const float vv = uf[C_AV + h * 128 + v] * sl;
            f32x4 c1; float part = 0.f;
#pragma unroll
            for (int j = 0; j < 4; ++j) { c1[j] = sp * c0[j] + vv * (uf[C_AK + h * 64 + k + j] * 0.125f); part += c1[j] * uf[C_AQ + h * 64 + k + j]; }
            __builtin_nontemporal_store(c1, (f32x4*)(C1 + e));
            part = red16(part);
            if ((lane & 15) == 0) numv[h * 128 + v] = part;
        }
        if (wave == 0) {
            const float n1 = sp * X.stN[(lb * 4 + h) * 64 + lane] + sl * uf[C_AK + h * 64 + lane] * 0.125f;
            X.out[O_SN + (lb * 4 + h) * 64 + lane] = n1;
            const float dd = wave_sum(n1 * uf[C_AQ + h * 64 + lane]);
            if (lane == 0) { red[h] = dd; red[4 + h] = mn; X.out[O_SM + lb * 4 + h] = mn; }
        }
    }
    __syncthreads();
    float hv;
    { const int h = tid >> 7; hv = numv[tid] * rcpf_(fmaxf(fabsf(red[h]), __expf(-red[4 + h]))); const float ss = wave_sum(hv * hv); if (lane == 0) red[8 + wave] = ss; }
    __syncthreads();
    { const int h = tid >> 7; const float rs = rsqrtf((red[8 + 2 * h] + red[9 + 2 * h]) * (1.f / 128.f) + EPS);
      XMIX[row * DMIX + tid] = (bf16_t)f2bf(hv * rs * XPAR(P_ANW)[l * 512 + tid] * sigmoidf_(uf[C_AO + tid]) * siluf_(uf[C_AZ + tid])); }
    }
    if (part == 1) {
    {
        const float* buf = X.conv + lb * 3 * 1024; float* oc = X.out + O_SCONV + lb * 3 * 1024;
        const float* cw = XPAR(P_CW) + l * 4096;
#pragma unroll
        for (int it = 0; it < 2; ++it) {
            const int ch = tid + it * NT;
            const float f0 = buf[ch], f1 = buf[1024 + ch], f2 = buf[2048 + ch], f3 = uf[C_BX + ch];
            const float acc = XPAR(P_CB)[l * 1024 + ch] + f0 * cw[ch] + f1 * cw[1024 + ch] + f2 * cw[2048 + ch] + f3 * cw[3072 + ch];
            xbc[ch] = siluf_(acc);
            oc[ch] = f1; oc[1024 + ch] = f2; oc[2048 + ch] = f3;
        }
    }
    __syncthreads();
#pragma unroll 1
    for (int hb = 0; hb < 8; hb += 4)
#pragma unroll
    for (int hk = 0; hk < 4; ++hk) {
        const int hh = hb + hk;
        const float dt = softplusf_(uf[C_BDT + hh] + XPAR(P_DTB)[l * 8 + hh]);
        const float dA = __expf(-dt * __expf(XPAR(P_ALOG)[l * 8 + hh]));
        const int g = hh >> 2;
        const float* h0p = X.ssm + (lb * 8 + hh) * 8192; float* h1p = X.out + O_SH + (lb * 8 + hh) * 8192;
#pragma unroll
        for (int it = 0; it < 4; ++it) {
            const int e = (tid + it * NT) * 4, p = e >> 7, s = e & 127;
            f32x4 h0; if (hb == 0) h0 = spre[hk][it]; else h0 = __builtin_nontemporal_load((const f32x4*)(h0p + e));
            const float xv = xbc[hh * 64 + p] * dt;
            f32x4 h1; float part = 0.f;
#pragma unroll
            for (int j = 0; j < 4; ++j) { h1[j] = dA * h0[j] + xv * xbc[512 + g * 128 + s + j]; part += h1[j] * xbc[768 + g * 128 + s + j]; }
            __builtin_nontemporal_store(h1, (f32x4*)(h1p + e));
            part = red16(part); part += __shfl_xor(part, 16);
            if ((lane & 31) == 0) yv[hh * 64 + p] = part;
        }
    }
    __syncthreads();
    float gb;
    { const int hh = tid >> 6; const float y = yv[tid] + XPAR(P_BD)[l * 8 + hh] * xbc[tid]; gb = y * siluf_(uf[C_BZ + tid]); const float ss = wave_sum(gb * gb); if (lane == 0) red[16 + wave] = ss; }
    __syncthreads();
    { const int g = tid >> 8; const float rs = rsqrtf((red[16 + 4 * g] + red[17 + 4 * g] + red[18 + 4 * g] + red[19 + 4 * g]) * (1.f / 256.f) + EPS);
      XMIX[row * DMIX + 512 + tid] = (bf16_t)f2bf(gb * rs * XPAR(P_BNW)[l * 512 + tid]); }
    }
    if (part == 2) {
    lptr Kl = lds + 36864;
    lptr Vl = lds + 36864 + 34816;
    if (tid < 320) {
        const int vec = tid >> 5, d = tid & 31, base = vec < 8 ? C_CQ + vec * 64 : C_CK + (vec - 8) * 64;
        const float x1 = uf[base + d], x2 = uf[base + 32 + d];
        float ss = x1 * x1 + x2 * x2; ss = red16(ss); ss += __shfl_xor(ss, 16);
        const float rs = rsqrtf(ss * (1.f / 64.f) + EPS);
        const float* w = vec < 8 ? XPAR(P_QNW) + l * 64 : XPAR(P_KNW) + l * 64;
        const float a = x1 * rs * w[d], bb = x2 * rs * w[d + 32];
        const float co = XROPE[((size_t)8192 * 32 + d) * 2], si = XROPE[((size_t)8192 * 32 + d) * 2 + 1];
        const float o1 = a * co - bb * si, o2 = bb * co + a * si;
        if (vec < 8) { qs[vec * 64 + d] = o1 * 0.125f; qs[vec * 64 + 32 + d] = o2 * 0.125f; } else { kn[(vec - 8) * 64 + d] = o1; kn[(vec - 8) * 64 + 32 + d] = o2; }
    }
    __syncthreads();
    {
        float* ko = X.out + O_SK + lb * 16384; float* vo = X.out + O_SV + lb * 16384;
#pragma unroll
        for (int it = 0; it < 8; ++it) {
            const int e = (tid + it * NT) * 4, j = e >> 7, r = e & 127;
            f32x4 kv = kpre[it], vv = vpre[it];
            if (j == 127) { kv = (f32x4){kn[r], kn[r + 1], kn[r + 2], kn[r + 3]}; vv = (f32x4){uf[C_CV + r], uf[C_CV + r + 1], uf[C_CV + r + 2], uf[C_CV + r + 3]}; }
            __builtin_nontemporal_store(kv, (f32x4*)(ko + e)); __builtin_nontemporal_store(vv, (f32x4*)(vo + e));
            u32x2 wk, wv2; wk[0] = pk2(kv[0], kv[1]); wk[1] = pk2(kv[2], kv[3]); wv2[0] = pk2(vv[0], vv[1]); wv2[1] = pk2(vv[2], vv[3]);
            *(LAS u32x2*)(Kl + ((j * 136 + r) << 1)) = wk; *(LAS u32x2*)(Vl + ((j * 136 + r) << 1)) = wv2;
        }
    }
    __syncthreads();
    if (tid < 256) {
        const int kvh = tid >> 7, jj = tid & 127;
        float s0 = 0.f, s1 = 0.f, s2 = 0.f, s3 = 0.f;
#pragma unroll 2
        for (int d8 = 0; d8 < 8; ++d8) {
            float kf[8]; unpack8(*(const LAS u32x4*)(Kl + ((jj * 136 + kvh * 64 + d8 * 8) << 1)), kf);
#pragma unroll
            for (int j = 0; j < 8; ++j) {
                s0 += kf[j] * qs[(kvh * 4 + 0) * 64 + d8 * 8 + j]; s1 += kf[j] * qs[(kvh * 4 + 1) * 64 + d8 * 8 + j];
                s2 += kf[j] * qs[(kvh * 4 + 2) * 64 + d8 * 8 + j]; s3 += kf[j] * qs[(kvh * 4 + 3) * 64 + d8 * 8 + j];
            }
        }
        sc[(kvh * 4 + 0) * 128 + jj] = s0; sc[(kvh * 4 + 1) * 128 + jj] = s1; sc[(kvh * 4 + 2) * 128 + jj] = s2; sc[(kvh * 4 + 3) * 128 + jj] = s3;
    }
    __syncthreads();
    {
        const int hq = wave; const float s0 = sc[hq * 128 + lane], s1 = sc[hq * 128 + 64 + lane], sink = XPAR(P_SINK)[l * 8 + hq];
        const float m = fmaxf(wave_max(fmaxf(s0, s1)), sink);
        const float e0 = __expf(s0 - m), e1 = __expf(s1 - m);
        const float inv = rcpf_(wave_sum(e0 + e1) + __expf(sink - m));
        sc[hq * 128 + lane] = e0 * inv; sc[hq * 128 + 64 + lane] = e1 * inv;
    }
    __syncthreads();
    {
        const int hq = tid >> 6, d = tid & 63, kvh = hq >> 2;
        float o = 0.f;
#pragma unroll 16
        for (int jj = 0; jj < 128; ++jj) o += sc[hq * 128 + jj] * bf2f(*(const LAS bf16_t*)(Vl + ((jj * 136 + kvh * 64 + d) << 1)));
        XMIX[row * DMIX + 1024 + tid] = (bf16_t)f2bf(o * siluf_(uf[C_CZ + tid]));
    }
    }
    __syncthreads();
}

__device__ __forceinline__ void scans(const Ctx& X, int l, int gt, int nthreads) {
    for (int item = gt; item < 98816; item += nthreads) {
        if (item < 32768) {
            const int nh = item >> 12, e = (item & 4095) * 2;
            const bf16_t* base = (const bf16_t*)XMC + (size_t)nh * 128 * 8192 + e;
            const float* ml = XML + nh * 128; const float* bl = XBL + nh * 128;
            float m = 0.f; f32x2 st = {0.f, 0.f};
            for (int c0 = 0; c0 < 128; c0 += 16) {
                f32x2 cl[16];
#pragma unroll
                for (int j = 0; j < 16; ++j) { const unsigned w = *(const unsigned*)(base + (size_t)(c0 + j) * 8192); cl[j] = (f32x2){__uint_as_float(w << 16), __uint_as_float(w & 0xffff0000u)}; }
#pragma unroll
                for (int j = 0; j < 16; ++j) {
                    const float mlj = ml[c0 + j], blj = bl[c0 + j], mn = fmaxf(blj + m, mlj), sp = __expf(blj + m - mn), sl = __expf(mlj - mn);
                    *(unsigned*)(XCSB + ((size_t)nh * 128 + c0 + j) * 8192 + e) = pk2(st[0], st[1]);
                    if (e == 0) XMS[nh * 128 + c0 + j] = m;
                    st = st * sp + cl[j] * sl; m = mn;
                }
            }
            *(f32x2*)(X.out + O_PC + ((size_t)l * 8 + nh) * 8192 + e) = st;
            if (e == 0) X.out[O_PM + l * 8 + nh] = m;
        } else if (item < 98304) {
            const int i1 = item - 32768, nhh = i1 >> 12, e = (i1 & 4095) * 2;
            const bf16_t* base = (const bf16_t*)XSH + (size_t)nhh * 128 * 8192 + e;
            const float* al = XSA + nhh * 128;
            f32x2 st = {0.f, 0.f};
            for (int c0 = 0; c0 < 128; c0 += 16) {
                f32x2 cl[16];
#pragma unroll
                for (int j = 0; j < 16; ++j) { const unsigned w = *(const unsigned*)(base + (size_t)(c0 + j) * 8192); cl[j] = (f32x2){__uint_as_float(w << 16), __uint_as_float(w & 0xffff0000u)}; }
#pragma unroll
                for (int j = 0; j < 16; ++j) {
                    const float dec = __expf(al[c0 + j]);
                    *(unsigned*)(XHSB + ((size_t)nhh * 128 + c0 + j) * 8192 + e) = pk2(st[0], st[1]);
                    st = st * dec + cl[j];
                }
            }
            *(f32x2*)(X.out + O_PH + ((size_t)l * 16 + nhh) * 8192 + e) = st;
        } else {
            const int i2 = item - 98304, nh = i2 >> 6, k = i2 & 63;
            float* base = XMN + (size_t)nh * 128 * 64 + k;
            const float* ml = XML + nh * 128; const float* bl = XBL + nh * 128;
            float m = 0.f, st = 0.f;
            for (int c = 0; c < 128; ++c) {
                const float mlj = ml[c], blj = bl[c], mn = fmaxf(blj + m, mlj), sp = __expf(blj + m - mn), sl = __expf(mlj - mn);
                const float cl = base[c * 64];
                XNS[(size_t)nh * 128 * 64 + c * 64 + k] = st;
                st = st * sp + cl * sl; m = mn;
            }
            X.out[O_PN + ((size_t)l * 8 + nh) * 64 + k] = st;
        }
    }
}

__device__ __forceinline__ void mlstm_out(lptr lds, const Ctx& X, int l, int task, int tid) {
    const int h = task & 3, c = (task >> 2) & 127, n = task >> 9;
    const int lane = tid & 63, wave = tid >> 6, fr = lane & 15, fq = lane >> 4;
    const int row0 = n * SEQ + c * 64, nh = n * 4 + h;
    lptr Qs = lds;
    lptr Ks = lds + 9216;
    lptr Vt = lds + 18432;
    lptr Sb = lds + 36864 + wave * 2304;
    LAS float* bv = (LAS float*)(lds + 55296);
    LAS float* dv = bv + 64;
    LAS float* mtv = bv + 128;
    LAS float* siv = bv + 192;
    LAS float* qnv = bv + 256;
    LAS float* ssqp = bv + 384;
    LAS float* nsv = bv + 512;
    const int mti = wave >> 1, half = wave & 1;
    u32x4 csf[2][4];
    {
        const bf16_t* Cs = XCSB + ((size_t)nh * 128 + c) * 8192;
#pragma unroll
        for (int kk = 0; kk < 2; ++kk)
#pragma unroll
            for (int ntl = 0; ntl < 4; ++ntl) csf[kk][ntl] = *(const u32x4*)(Cs + (64 * half + 16 * ntl + fr) * 64 + kk * 32 + fq * 8);
    }
    u32x2 aov[4], azv[4]; f32x4 anw[4];
#pragma unroll
    for (int ntl = 0; ntl < 4; ++ntl) {
        const int v = h * 128 + 64 * half + 16 * ntl + 4 * fq;
        const unsigned row = (unsigned)row0 + 16 * mti + fr;
        anw[ntl] = *(const f32x4*)(XPAR(P_ANW) + l * 512 + v);
        aov[ntl] = *(const u32x2*)(XU + row * NIN + C_AO + v); azv[ntl] = *(const u32x2*)(XU + row * NIN + C_AZ + v);
    }
    u32x4 qraw, kraw, vblk[8];
    const int tgv = lane & 7, cgv = (wave & 1) * 8 + (lane >> 3);
    {
        const int tok = tid >> 3, k8 = (tid & 7) * 8;
        const bf16_t* ur = XU + (unsigned)(row0 + tok) * NIN;
        qraw = *(const u32x4*)(ur + C_AQ + h * 64 + k8); kraw = *(const u32x4*)(ur + C_AK + h * 64 + k8);
        if (wave == 2 || wave == 3) {
#pragma unroll
            for (int t = 0; t < 8; ++t) vblk[t] = *(const u32x4*)(XU + (unsigned)(row0 + 8 * tgv + t) * NIN + C_AV + h * 128 + cgv * 8);
        }
    }
    if (wave == 0) {
        const bf16_t* ur = XU + (unsigned)(row0 + lane) * NIN;
        const float fg = bf2f(ur[C_AF + h]) + XPAR(P_AFB)[l * 4 + h], ig = bf2f(ur[C_AI + h]) + XPAR(P_AIB)[l * 4 + h];
        const float b = wave_scan_sum(logsigf_(fg), lane);
        const float dd = ig - b;
        const float cm = wave_scan_max(dd, lane);
        const float ms = XMS[nh * 128 + c];
        const float mt = b + fmaxf(ms, cm);
        bv[lane] = b; dv[lane] = dd; mtv[lane] = mt; siv[lane] = __expf(b + ms - mt);
        nsv[lane] = XNS[((size_t)nh * 128 + c) * 64 + lane];
    }
    {
        const int tok = tid >> 3, k8 = (tid & 7) * 8;
        *(LAS u32x4*)(Qs + ((tok * 72 + k8) << 1)) = qraw;
        float x[8]; unpack8(kraw, x);
#pragma unroll
        for (int j = 0; j < 8; ++j) x[j] *= 0.125f;
        *(LAS u32x4*)(Ks + ((tok * 72 + k8) << 1)) = pack8(x);
    }
    if (wave == 2 || wave == 3) {
#pragma unroll
        for (int j = 0; j < 8; ++j) {
            u32x4 w;
#pragma unroll
            for (int tp = 0; tp < 4; ++tp) {
                const unsigned lo = (vblk[2 * tp][j >> 1] >> ((j & 1) * 16)) & 0xffffu, hi = (vblk[2 * tp + 1][j >> 1] >> ((j & 1) * 16)) & 0xffffu;
                w[tp] = lo | (hi << 16);
            }
            *(LAS u32x4*)(Vt + (((cgv * 8 + j) * 72 + 8 * tgv) << 1)) = w;
        }
    }
    __syncthreads();
    bf16x8 qa[2];
    qa[0] = lds_frag(Qs, 16 * mti + fr, fq * 8, 72); qa[1] = lds_frag(Qs, 16 * mti + fr, 32 + fq * 8, 72);
    const int tq = 16 * mti + fr;
    float qn;
    {
        float x0[8], x1[8]; unpack8(__builtin_bit_cast(u32x4, qa[0]), x0); unpack8(__builtin_bit_cast(u32x4, qa[1]), x1);
        float d = 0.f;
#pragma unroll
        for (int j = 0; j < 8; ++j) d += x0[j] * nsv[fq * 8 + j] + x1[j] * nsv[32 + fq * 8 + j];
        d += __shfl_xor(d, 16); d += __shfl_xor(d, 32);
        qn = d;
    }
    const float bt = bv[tq], mtq = mtv[tq], siq = siv[tq];
    float rsum = 0.f;
#pragma unroll
    for (int ntl = 0; ntl < 4; ++ntl) {
        f32x4 sT = {0.f, 0.f, 0.f, 0.f};
        sT = mfma16(lds_frag(Ks, 16 * ntl + fr, fq * 8, 72), qa[0], sT);
        sT = mfma16(lds_frag(Ks, 16 * ntl + fr, 32 + fq * 8, 72), qa[1], sT);
        float sv[4];
#pragma unroll
        for (int ii = 0; ii < 4; ++ii) {
            const int sidx = 16 * ntl + 4 * fq + ii;
            const float wgt = (sidx <= tq) ? __expf(bt + dv[sidx] - mtq) : 0.f;
            sv[ii] = wgt * sT[ii];
            rsum += sv[ii];
        }
        u32x2 w; w[0] = pk2(sv[0], sv[1]); w[1] = pk2(sv[2], sv[3]);
        *(LAS u32x2*)(Sb + ((fr * 72 + 16 * ntl + 4 * fq) << 1)) = w;
    }
    rsum += __shfl_xor(rsum, 16); rsum += __shfl_xor(rsum, 32);
    const float inv = rcpf_(fmaxf(fabsf(rsum + siq * qn), __expf(-mtq)));
    LDS_FENCE();
    f32x4 acc[4];
#pragma unroll
    for (int ntl = 0; ntl < 4; ++ntl) acc[ntl] = (f32x4){0.f, 0.f, 0.f, 0.f};
#pragma unroll
    for (int kk = 0; kk < 2; ++kk) {
        const bf16x8 sb = lds_frag(Sb, fr, kk * 32 + fq * 8, 72);
#pragma unroll
        for (int ntl = 0; ntl < 4; ++ntl) acc[ntl] = mfma16(lds_frag(Vt, 64 * half + 16 * ntl + fr, kk * 32 + fq * 8, 72), sb, acc[ntl]);
    }
#pragma unroll
    for (int kk = 0; kk < 2; ++kk) {
        float x[8]; unpack8(__builtin_bit_cast(u32x4, qa[kk]), x);
#pragma unroll
        for (int j = 0; j < 8; ++j) x[j] *= siq;
        const bf16x8 qs = as_frag(pack8(x));
#pragma unroll
        for (int ntl = 0; ntl < 4; ++ntl) acc[ntl] = mfma16(as_frag(csf[kk][ntl]), qs, acc[ntl]);
    }
    {
        float ss = 0.f;
#pragma unroll
        for (int ntl = 0; ntl < 4; ++ntl) { acc[ntl] = acc[ntl] * inv; ss += acc[ntl][0] * acc[ntl][0] + acc[ntl][1] * acc[ntl][1] + acc[ntl][2] * acc[ntl][2] + acc[ntl][3] * acc[ntl][3]; }
        ss += __shfl_xor(ss, 16); ss += __shfl_xor(ss, 32);
        if (fq == 0) ssqp[tq * 2 + half] = ss;
    }
    __syncthreads();
    {
        const float rs = rsqrtf((ssqp[tq * 2] + ssqp[tq * 2 + 1]) * (1.f / 128.f) + EPS);
        const unsigned row = (unsigned)row0 + tq;
#pragma unroll
        for (int ntl = 0; ntl < 4; ++ntl) {
            const float o[4] = {__uint_as_float(aov[ntl][0] << 16), __uint_as_float(aov[ntl][0] & 0xffff0000u), __uint_as_float(aov[ntl][1] << 16), __uint_as_float(aov[ntl][1] & 0xffff0000u)};
            const float z[4] = {__uint_as_float(azv[ntl][0] << 16), __uint_as_float(azv[ntl][0] & 0xffff0000u), __uint_as_float(azv[ntl][1] << 16), __uint_as_float(azv[ntl][1] & 0xffff0000u)};
            float y[4];
#pragma unroll
            for (int ii = 0; ii < 4; ++ii) y[ii] = acc[ntl][ii] * rs * anw[ntl][ii] * sigmoidf_(o[ii]) * siluf_(z[ii]);
            u32x2 w; w[0] = pk2(y[0], y[1]); w[1] = pk2(y[2], y[3]);
            *(u32x2*)(XMIX + row * DMIX + h * 128 + 64 * half + 16 * ntl + 4 * fq) = w;
        }
    }
    __syncthreads();
}

__device__ __forceinline__ void ssd_out(lptr lds, const Ctx& X, int l, int task, int tid) {
    const int g = task & 1, c = (task >> 1) & 127, n = task >> 8;
    const int lane = tid & 63, wave = tid >> 6, fr = lane & 15, fq = lane >> 4;
    const int seq0 = n * SEQ, row0 = seq0 + c * 64;
    lptr Cm = lds;
    lptr Bm = lds + 17408;
    lptr Xt = lds + 34816;
    LAS float* CBf = (LAS float*)(lds + 71680);
    LAS float* av = (LAS float*)(lds + 89088);
    LAS float* dtv = (LAS float*)(lds + 90112);
    LAS float* ssq = (LAS float*)(lds + 91136);
    const int hl = wave >> 1, th = wave & 1, hh = 4 * g + hl;
    u32x4 hsf[4][4];
    {
        const bf16_t* hs = XHSB + ((size_t)(n * 8 + hh) * 128 + c) * 8192;
#pragma unroll
        for (int kk = 0; kk < 4; ++kk)
#pragma unroll
            for (int ntl = 0; ntl < 4; ++ntl) hsf[kk][ntl] = *(const u32x4*)(hs + (16 * ntl + fr) * 128 + kk * 32 + fq * 8);
    }
    if (wave < 4) {
        const int hh = 4 * g + wave;
        const float dt = softplusf_(bf2f(XU[(unsigned)(row0 + lane) * NIN + C_BDT + hh]) + XPAR(P_DTB)[l * 8 + hh]);
        const float A = -__expf(XPAR(P_ALOG)[l * 8 + hh]);
        av[wave * 64 + lane] = wave_scan_sum(dt * A, lane);
        dtv[wave * 64 + lane] = dt;
    }
    {
        const float* cw = XPAR(P_CW) + l * 4096; const float* cb = XPAR(P_CB) + l * 1024;
        float o[8][8];
        if (wave < 4) {
            const int tg = lane & 7, cg = wave * 8 + (lane >> 3);
            conv8x8(XU, seq0, c * 64 + 8 * tg, g * 256 + cg * 8, cw, cb, o);
#pragma unroll
            for (int jx = 0; jx < 8; ++jx) {
                float v[8];
#pragma unroll
                for (int t = 0; t < 8; ++t) v[t] = o[t][jx];
                *(LAS u32x4*)(Xt + (((cg * 8 + jx) * 72 + 8 * tg) << 1)) = pack8(v);
            }
        } else {
            const int tg = lane >> 3, s8 = ((wave & 1) * 8 + (lane & 7)) * 8;
            conv8x8(XU, seq0, c * 64 + 8 * tg, (wave < 6 ? 512 : 768) + g * 128 + s8, cw, cb, o);
            lptr dstm = wave < 6 ? Bm : Cm;
#pragma unroll
            for (int t = 0; t < 8; ++t) *(LAS u32x4*)(dstm + (((8 * tg + t) * 136 + s8) << 1)) = pack8(o[t]);
        }
    }
    __syncthreads();
    u32x2 bzv[2][4]; f32x4 bnw[4];
#pragma unroll
    for (int ntl = 0; ntl < 4; ++ntl) {
        bnw[ntl] = *(const f32x4*)(XPAR(P_BNW) + l * 512 + hh * 64 + 16 * ntl + 4 * fq);
#pragma unroll
        for (int mi = 0; mi < 2; ++mi) bzv[mi][ntl] = *(const u32x2*)(XU + ((unsigned)row0 + 16 * (2 * th + mi) + fr) * NIN + C_BZ + hh * 64 + 16 * ntl + 4 * fq);
    }
    {
        const int mt = wave >> 1;
#pragma unroll
        for (int q = 0; q < 2; ++q) {
            const int ntl = 2 * (wave & 1) + q;
            f32x4 acc = {0.f, 0.f, 0.f, 0.f};
#pragma unroll
            for (int kk = 0; kk < 4; ++kk) acc = mfma16(lds_frag(Cm, 16 * mt + fr, kk * 32 + fq * 8, 136), lds_frag(Bm, 16 * ntl + fr, kk * 32 + fq * 8, 136), acc);
#pragma unroll
            for (int ii = 0; ii < 4; ++ii) CBf[(16 * mt + fq * 4 + ii) * 68 + 16 * ntl + fr] = acc[ii];
        }
    }
    __syncthreads();
    f32x4 y1[2][4], y2[2][4];
#pragma unroll
    for (int mi = 0; mi < 2; ++mi)
#pragma unroll
        for (int ntl = 0; ntl < 4; ++ntl) { y1[mi][ntl] = (f32x4){0.f, 0.f, 0.f, 0.f}; y2[mi][ntl] = (f32x4){0.f, 0.f, 0.f, 0.f}; }
#pragma unroll
    for (int kk = 0; kk < 2; ++kk) {
        bf16x8 bx[4];
#pragma unroll
        for (int ntl = 0; ntl < 4; ++ntl) bx[ntl] = lds_frag(Xt, hl * 64 + 16 * ntl + fr, kk * 32 + fq * 8, 72);
#pragma unroll
        for (int mi = 0; mi < 2; ++mi) {
            const int t = 16 * (2 * th + mi) + fr, u0 = kk * 32 + fq * 8;
            const float at = av[hl * 64 + t];
            float w[8];
#pragma unroll
            for (int j = 0; j < 8; ++j) {
                const int uu = u0 + j;
                w[j] = (uu <= t) ? CBf[t * 68 + uu] * __expf(at - av[hl * 64 + uu]) * dtv[hl * 64 + uu] : 0.f;
            }
            const bf16x8 a = as_frag(pack8(w));
#pragma unroll
            for (int ntl = 0; ntl < 4; ++ntl) y1[mi][ntl] = mfma16(bx[ntl], a, y1[mi][ntl]);
        }
    }
    {
#pragma unroll
        for (int kk = 0; kk < 4; ++kk) {
            bf16x8 bh[4];
#pragma unroll
            for (int ntl = 0; ntl < 4; ++ntl) bh[ntl] = as_frag(hsf[kk][ntl]);
#pragma unroll
            for (int mi = 0; mi < 2; ++mi) {
                const bf16x8 a = lds_frag(Cm, 16 * (2 * th + mi) + fr, kk * 32 + fq * 8, 136);
#pragma unroll
                for (int ntl = 0; ntl < 4; ++ntl) y2[mi][ntl] = mfma16(bh[ntl], a, y2[mi][ntl]);
            }
        }
    }
    const float Dh = XPAR(P_BD)[l * 8 + hh];
#pragma unroll
    for (int mi = 0; mi < 2; ++mi) {
        const int t = 16 * (2 * th + mi) + fr;
        const float ea = __expf(av[hl * 64 + t]);
        float ss = 0.f;
#pragma unroll
        for (int ntl = 0; ntl < 4; ++ntl) {
            const float z[4] = {__uint_as_float(bzv[mi][ntl][0] << 16), __uint_as_float(bzv[mi][ntl][0] & 0xffff0000u), __uint_as_float(bzv[mi][ntl][1] << 16), __uint_as_float(bzv[mi][ntl][1] & 0xffff0000u)};
#pragma unroll
            for (int ii = 0; ii < 4; ++ii) {
                const int p = 16 * ntl + 4 * fq + ii;
                const float xv = bf2f(*(const LAS bf16_t*)(Xt + (((hl * 64 + p) * 72 + t) << 1)));
                const float y = y1[mi][ntl][ii] + ea * y2[mi][ntl][ii] + Dh * xv;
                const float gbv = y * siluf_(z[ii]);
                y1[mi][ntl][ii] = gbv; ss += gbv * gbv;
            }
        }
        ss += __shfl_xor(ss, 16); ss += __shfl_xor(ss, 32);
        if (fq == 0) ssq[t * 4 + hl] = ss;
    }
    __syncthreads();
#pragma unroll
    for (int mi = 0; mi < 2; ++mi) {
        const int t = 16 * (2 * th + mi) + fr;
        const float rs = rsqrtf((ssq[t * 4] + ssq[t * 4 + 1] + ssq[t * 4 + 2] + ssq[t * 4 + 3]) * (1.f / 256.f) + EPS);
        const unsigned row = (unsigned)row0 + t;
#pragma unroll
        for (int ntl = 0; ntl < 4; ++ntl) {
            u32x2 w; w[0] = pk2(y1[mi][ntl][0] * rs * bnw[ntl][0], y1[mi][ntl][1] * rs * bnw[ntl][1]); w[1] = pk2(y1[mi][ntl][2] * rs * bnw[ntl][2], y1[mi][ntl][3] * rs * bnw[ntl][3]);
            *(u32x2*)(XMIX + row * DMIX + 512 + hh * 64 + 16 * ntl + 4 * fq) = w;
        }
    }
    __syncthreads();
}


#define XB_TMO      128
#define XB_XCNT(j)  (256  + 64 * (j))
#define XB_XSUB(j)  (1280 + 64 * (j))
#define XB_XGEN(j)  (2304 + 64 * (j))
#define XB_TOP      3328
#define XB_TOPGEN   3392
#define XCD_BAR_WORDS 3456
#define XB_SPIN_CAP (1u << 18)
__device__ __forceinline__ unsigned xb_ld(unsigned* p)              { return __hip_atomic_load(p, __ATOMIC_RELAXED, __HIP_MEMORY_SCOPE_AGENT); }
__device__ __forceinline__ unsigned xb_add(unsigned* p, unsigned v) { return __hip_atomic_fetch_add(p, v, __ATOMIC_RELAXED, __HIP_MEMORY_SCOPE_AGENT); }
__device__ __forceinline__ unsigned xb_xcc_id() { return (unsigned)__builtin_amdgcn_s_getreg((3 << 11) | 20) & 0xFu; }
#define XB_SPIN(cond, bar) do { unsigned _sp = 0; while (cond) { __builtin_amdgcn_s_sleep(1); \
    if ((++_sp & 255u) == 0u) { if (xb_ld(&(bar)[XB_TMO])) break; if (_sp > XB_SPIN_CAP) { atomicAdd(&(bar)[XB_TMO], 1u); break; } } } } while (0)
struct XcdBarrier { unsigned* bar; unsigned x; volatile LAS unsigned* st; };
__device__ __forceinline__ XcdBarrier xcd_barrier_post(unsigned* bar, volatile LAS unsigned* st) {
    XcdBarrier b; b.bar = bar; b.x = xb_xcc_id(); b.st = st;
    if (threadIdx.x == 0) (void)xb_add(&bar[XB_XCNT(b.x)], 1u);
    return b;
}
__device__ __forceinline__ void xcd_barrier_complete(unsigned* bar, unsigned x, unsigned& nloc, unsigned& nx) {
    const unsigned G = gridDim.x * gridDim.y * gridDim.z;
    unsigned sum, cnt, mine, sp = 0u;
    for (;;) {
        sum = 0u; cnt = 0u; mine = 0u;
#pragma unroll
        for (unsigned j = 0; j < 16; ++j) { const unsigned c = xb_ld(&bar[XB_XCNT(j)]); sum += c; cnt += (c > 0u) ? 1u : 0u; mine = (j == x) ? c : mine; }
        if (sum == G) break;
        __builtin_amdgcn_s_sleep(1);
        if ((++sp & 255u) == 0u) { if (xb_ld(&bar[XB_TMO])) break; if (sp > XB_SPIN_CAP) { atomicAdd(&bar[XB_TMO], 1u); break; } }
    }
    nloc = mine > 0u ? mine : 1u; nx = cnt > 0u ? cnt : 1u;
}
__device__ __forceinline__ void xcd_barrier(const XcdBarrier& b) {
    asm volatile("s_waitcnt vmcnt(0)" ::: "memory");
    __syncthreads();
    if (threadIdx.x == 0) {
        unsigned* bar = b.bar;
        __builtin_amdgcn_s_waitcnt(0);
        unsigned nloc = b.st[0], nx = b.st[1];
        if (nloc == 0u) { xcd_barrier_complete(bar, b.x, nloc, nx); b.st[0] = nloc; b.st[1] = nx; }
        const unsigned old = xb_add(&bar[XB_XSUB(b.x)], 1u);
        const unsigned gen = old / nloc;
        if (old + 1u == (gen + 1u) * nloc) {
            __builtin_amdgcn_fence(__ATOMIC_RELEASE, "agent");
            asm volatile("s_waitcnt vmcnt(0)" ::: "memory");
            const unsigned og = xb_add(&bar[XB_TOP], 1u);
            const unsigned tg = og / nx;
            if (og + 1u == (tg + 1u) * nx) xb_add(&bar[XB_TOPGEN], 1u);
            else XB_SPIN(xb_ld(&bar[XB_TOPGEN]) == tg, bar);
            __builtin_amdgcn_fence(__ATOMIC_ACQUIRE, "agent");
            xb_add(&bar[XB_XGEN(b.x)], 1u);
            asm volatile("s_waitcnt vmcnt(0)" ::: "memory");
        } else {
            XB_SPIN(xb_ld(&bar[XB_XGEN(b.x)]) == gen, bar);
            __builtin_amdgcn_fence(__ATOMIC_ACQUIRE, "agent");
            asm volatile("s_waitcnt vmcnt(0)" ::: "memory");
        }
    }
    __syncthreads();
}

__global__ void __launch_bounds__(NT, 2) mega(Args args) {
    __shared__ __attribute__((aligned(16))) unsigned char lds_raw[LDS_BYTES];
    lptr lds = (lptr)lds_raw;
    cg::grid_group grid = cg::this_grid();
    const int tid = threadIdx.x, bid = blockIdx.x, G = gridDim.x;
    Ctx X;
    X.xp = args.in[IN_XP]; X.xs = args.in[IN_XS]; X.stC = args.in[IN_STC]; X.stN = args.in[IN_STN]; X.stM = args.in[IN_STM]; X.ssm = args.in[IN_SSM];
    X.conv = args.in[IN_CONV]; X.ck = args.in[IN_CK]; X.cv = args.in[IN_CV]; X.out = args.out; X.ws = args.ws;
    const int lo = args.ph_lo, hi = args.ph_hi;
    volatile LAS unsigned* xst = (volatile LAS unsigned*)(lds + LDS_BYTES - 16);
    if (tid == 0) { xst[0] = 0u; xst[1] = 0u; }
    __syncthreads();
    XcdBarrier xbar = xcd_barrier_post((unsigned*)(args.ws + WS_BAR), xst);
#define IN(k) (lo <= (k) && (k) < hi)
#define SEAM(k) do { if (IN(k) && IN((k) + 1)) { for (int _r = 0; _r < REP_SYNC; ++_r) { if (lo < 0) grid.sync(); xcd_barrier(xbar); } } } while (0)
    if (IN(0)) { for (int _r = 0; _r < REP_P0; ++_r) prologue(lds, X, args, G, bid, tid); }
    SEAM(0);
    for (int l = 0; l < 4; ++l) {
        const int pb = 1 + l * 5;
        if (IN(pb)) for (int _r = 0; _r < REP_P1; ++_r) {
            pg8::Gemm g{XXB, XWIN + (size_t)l * NIN * D, MPAD, NIN, D}; pg8::StaticOrder S; S.init(TP, NIN, G, bid);
            pg8::EpiU E{XU, XSSQ};
            pg8::gemm_phase<pg8::EpiU, pg8::StaticOrder, false, GEMM_SP2, GEMM_ALIGN>(lds, g, S, E, OPQ(tid));
            if (l == 0 && bid >= G - 20) {
                pg8::SampleOrder S2{G - 20, 20, bid}; pg8::EpiUh E2{XU, XSSQ};
                pg8::gemm_phase<pg8::EpiUh, pg8::SampleOrder, true>(lds, g, S2, E2, OPQ(tid));
            }
        }
        SEAM(pb);
        if (IN(pb + 1)) for (int _r = 0; _r < REP_P2; ++_r) {
            for (int t = bid; t < 256; t += G) for (int _q = 0; _q < RT_SAMPLE; ++_q) {
                if (t < 128) sample_task(lds, X, l, t, 1, OPQ(tid));
                else { sample_task(lds, X, l, t - 128, 0, OPQ(tid)); sample_task(lds, X, l, t - 128, 2, OPQ(tid)); }
            }
            for (int t = bid; t < 256; t += G) {
                const int tx = (G == 256) ? ((t & 7) >> 2) * 128 + (32 * (t & 1) + (t >> 3)) * 2 + ((t >> 1) & 1) : t;
                for (int _q = 0; _q < RT_SWA; ++_q) swa_prompt(lds, X, l, tx, OPQ(tid));
            }
            for (int t = bid; t < 512; t += G) for (int _q = 0; _q < RT_SLOC; ++_q) ssd_local(lds, X, l, t, OPQ(tid));
            for (int t = bid; t < 1024; t += G) for (int _q = 0; _q < RT_MLOC; ++_q) mlstm_local(lds, X, l, t, OPQ(tid));
            if (bid == G - 1) {
                for (int i = tid; i < 2 * 3 * 1024; i += NT) {
                    const int ch = i & 1023, j = (i >> 10) % 3, n = i / 3072;
                    X.out[O_PCONV + (((size_t)l * 2 + n) * 3 + j) * 1024 + ch] = bf2f(XU[(size_t)(n * SEQ + SEQ - 3 + j) * NIN + C_BX + ch]);
                }
            }
        }
        SEAM(pb + 1);
        if (IN(pb + 2)) {
            if (bid >= G - 4) {
                pg8::Gemm g{XMIX, XWOUT + (size_t)l * D * DMIX, MPAD, D, DMIX}; pg8::SampleOrder S{G - 4, 4, bid};
                if (l == 0) { pg8::EpiRes_<1, 0> E{X.xp, X.xs, X.out, XXB, XSSQ}; pg8::gemm_phase<pg8::EpiRes_<1, 0>, pg8::SampleOrder, true>(lds, g, S, E, OPQ(tid)); }
                else if (l < 3) { pg8::EpiRes_<1, 1> E{X.xp, X.xs, X.out, XXB, XSSQ}; pg8::gemm_phase<pg8::EpiRes_<1, 1>, pg8::SampleOrder, true>(lds, g, S, E, OPQ(tid)); }
                else { pg8::EpiRes_<1, 2> E{X.xp, X.xs, X.out, XXB, XSSQ}; pg8::gemm_phase<pg8::EpiRes_<1, 2>, pg8::SampleOrder, true>(lds, g, S, E, OPQ(tid)); }
            }
            if (l < 3) {
                if (G - 4 - 193 >= 16) { if (bid >= 193 && bid < G - 4) convert_weights(lds, X, args, l + 1, bid - 193, G - 4 - 193, OPQ(tid)); }
                else convert_weights(lds, X, args, l + 1, bid, G, OPQ(tid));
            }
            for (int _r = 0; _r < REP_P3; ++_r) scans(X, l, bid * NT + OPQ(tid), G * NT);
        }
        SEAM(pb + 2);
        if (IN(pb + 3)) for (int _r = 0; _r < REP_P4; ++_r) {
            for (int task = bid; task < 1536; task += G) {
                if (task < 512) for (int _q = 0; _q < RT_SOUT; ++_q) ssd_out(lds, X, l, task, OPQ(tid));
                else mlstm_out(lds, X, l, task - 512, OPQ(tid));
            }
        }
        SEAM(pb + 3);
        if (IN(pb + 4)) {
            {
                pg8::Gemm g{XMIX, XWOUT + (size_t)l * D * DMIX, MPAD, D, DMIX}; pg8::StaticOrder S; S.init(TP, D, G, bid);
#ifdef PROBE_P5
                { pg8::EpiProbe EP{(const unsigned*)(X.ws + 64), XSSQ}; pg8::gemm_phase<pg8::EpiProbe, pg8::StaticOrder, false, GEMM_SP2>(lds, g, S, EP, OPQ(tid)); }
#endif
                if (l == 0) { pg8::EpiRes_<2, 0> E{X.xp, X.xs, X.out, XXB, XSSQ}; pg8::gemm_phase<pg8::EpiRes_<2, 0>, pg8::StaticOrder, false, GEMM_SP2, GEMM_ALIGN>(lds, g, S, E, OPQ(tid)); }
                else if (l < 3) { pg8::EpiRes_<2, 1> E{X.xp, X.xs, X.out, XXB, XSSQ}; pg8::gemm_phase<pg8::EpiRes_<2, 1>, pg8::StaticOrder, false, GEMM_SP2, GEMM_ALIGN>(lds, g, S, E, OPQ(tid)); }
                else { pg8::EpiRes_<2, 2> E{X.xp, X.xs, X.out, XXB, XSSQ}; pg8::gemm_phase<pg8::EpiRes_<2, 2>, pg8::StaticOrder, false, GEMM_SP2, GEMM_ALIGN>(lds, g, S, E, OPQ(tid)); }
            }
            if (l < 3 && bid < 20) {
                pg8::Gemm g{XXB, XWIN + (size_t)(l + 1) * NIN * D, MPAD, NIN, D}; pg8::SampleOrder S{0, 20, bid};
                pg8::EpiUh E{XU, XSSQ};
                pg8::gemm_phase<pg8::EpiUh, pg8::SampleOrder, true>(lds, g, S, E, OPQ(tid));
            }
        }
        SEAM(pb + 4);
    }
#undef IN
#undef SEAM
}

extern "C" void kernel_launch(void* const* d_in, const int* in_sizes, int n_in, void* d_out, int out_size, void* d_ws, size_t ws_size, hipStream_t stream) {
    static int grid_blocks = 0;
    if (!grid_blocks) {
        int dev = 0, cus = 0, per_cu = 0;
        hipGetDevice(&dev);
        hipDeviceGetAttribute(&cus, hipDeviceAttributeMultiprocessorCount, dev);
        hipOccupancyMaxActiveBlocksPerMultiprocessor(&per_cu, mega, NT, 0);
        if (per_cu < 1) { fprintf(stderr, "occupancy query returned %d\n", per_cu); per_cu = 1; }
        grid_blocks = cus * 1;
        if (ws_size < WS_END) fprintf(stderr, "workspace too small: %zu < %zu\n", ws_size, (size_t)WS_END);
    }
    (void)hipMemsetAsync(d_ws, 0, 16384, stream);
    Args a{};
    for (int i = 0; i < 24; ++i) a.in[i] = (const float*)d_in[i];
    a.out = (float*)d_out; a.ws = (unsigned char*)d_ws;
    const int NPH = 21;
#if MULTI_LAUNCH
    for (int p = 0; p < NPH; ++p) {
        a.ph_lo = p; a.ph_hi = p + 1;
        void* kargs[] = {&a};
        hipError_t e = hipLaunchCooperativeKernel((void*)mega, dim3(grid_blocks), dim3(NT), kargs, 0, stream);
        if (e != hipSuccess) fprintf(stderr, "cooperative launch failed: %s (grid %d)\n", hipGetErrorString(e), grid_blocks);
    }
#else
    a.ph_lo = 0; a.ph_hi = NPH;
    void* kargs[] = {&a};
    hipError_t e = hipLaunchCooperativeKernel((void*)mega, dim3(grid_blocks), dim3(NT), kargs, 0, stream);
    if (e != hipSuccess) fprintf(stderr, "cooperative launch failed: %s (grid %d)\n", hipGetErrorString(e), grid_blocks);
#endif
}
```

```cpp
#include <hip/hip_runtime.h>
#include <hip/hip_cooperative_groups.h>
#include <cstdio>
#include <cstdint>
namespace cg = cooperative_groups;

#ifndef REP_SYNC
#define REP_SYNC 1
#endif
#ifndef REP_P1
#define REP_P1 1
#endif
#ifndef REP_P2
#define REP_P2 1
#endif
#ifndef REP_P3
#define REP_P3 1
#endif
#ifndef REP_P0
#define REP_P0 1
#endif
#ifndef REP_P4
#define REP_P4 1
#endif
#ifndef RT_SAMPLE
#define RT_SAMPLE 1
#endif
#ifndef RT_SWA
#define RT_SWA 1
#endif
#ifndef RT_SLOC
#define RT_SLOC 1
#endif
#ifndef RT_MLOC
#define RT_MLOC 1
#endif
#ifndef RT_SOUT
#define RT_SOUT 1
#endif
#ifndef GEMM_SP2
#define GEMM_SP2 true
#endif
#ifndef GEMM_ALIGN
#define GEMM_ALIGN true
#endif
#ifndef MULTI_LAUNCH
#define MULTI_LAUNCH 0
#endif

#define LAS __attribute__((address_space(3)))
typedef unsigned short bf16_t;
typedef short bf16x8 __attribute__((ext_vector_type(8)));
typedef float f32x4 __attribute__((ext_vector_type(4)));
typedef float f32x2 __attribute__((ext_vector_type(2)));
typedef unsigned u32x4 __attribute__((ext_vector_type(4)));
typedef unsigned u32x2 __attribute__((ext_vector_type(2)));
typedef __bf16 bf16x2_t __attribute__((ext_vector_type(2)));
typedef LAS unsigned char* lptr;

constexpr int D = 1024, DIN = 4880, NIN = 5120, DMIX = 1536, TP = 16384, MTOK = 16512, MPAD = 16640, SEQ = 8192;
constexpr int C_AQ = 0, C_AK = 256, C_AV = 512, C_AO = 1024, C_AZ = 1536, C_AI = 2048, C_AF = 2052, C_BZ = 2056, C_BX = 2568, C_BB = 3080, C_BC = 3336,
              C_BDT = 3592, C_CQ = 3600, C_CK = 4112, C_CV = 4240, C_CZ = 4368;
constexpr float EPS = 1e-6f;
constexpr size_t O_YP = 0, O_YS = 16777216, O_PC = 16908288, O_PN = 17170432, O_PM = 17172480, O_PH = 17172512, O_PCONV = 17696800, O_PK = 17721376,
                 O_PV = 17852448, O_SC = 17983520, O_SN = 34760736, O_SM = 34891808, O_SH = 34893856, O_SCONV = 68448288, O_SK = 70021152, O_SV = 78409760;
constexpr size_t WS_BAR = 0;
constexpr size_t WS_PAR = 16384;
constexpr size_t WS_WIN = WS_PAR + 102400;
constexpr size_t WS_WOUT = WS_WIN + (size_t)4 * NIN * D * 2;
constexpr size_t WS_XB = WS_WOUT + (size_t)4 * D * DMIX * 2;
constexpr size_t WS_U = WS_XB + (size_t)MPAD * D * 2;
constexpr size_t WS_MIX = WS_U + (size_t)MPAD * NIN * 2;
constexpr size_t WS_SSQ = WS_MIX + (size_t)MPAD * DMIX * 2;
constexpr size_t WS_ROPE = WS_SSQ + (size_t)MPAD * 16 * 4;
constexpr size_t WS_MC = WS_ROPE + (size_t)8200 * 64 * 4;
constexpr size_t WS_MN = WS_MC + (size_t)8 * 128 * 8192 * 4;
constexpr size_t WS_ML = WS_MN + (size_t)8 * 128 * 64 * 4;
constexpr size_t WS_BL = WS_ML + 4096;
constexpr size_t WS_MS = WS_BL + 4096;
constexpr size_t WS_SA = WS_MS + 4096;
constexpr size_t WS_SH = WS_SA + 8192;
constexpr size_t WS_CSB = WS_SH + (size_t)16 * 128 * 8192 * 4;
constexpr size_t WS_HSB = WS_CSB + (size_t)8 * 128 * 8192 * 2;
constexpr size_t WS_NS = WS_HSB + (size_t)16 * 128 * 8192 * 2;
constexpr size_t WS_END = WS_NS + (size_t)8 * 128 * 64 * 4;
constexpr int LDS_BYTES = 139264;
constexpr int NT = 512;

struct Args { const float* in[24]; float* out; unsigned char* ws; int ph_lo, ph_hi; };

__device__ __forceinline__ float bf2f(unsigned v) { return __uint_as_float(v << 16); }
__device__ __forceinline__ unsigned pk2(float lo, float hi) { f32x2 v = {lo, hi}; bf16x2_t b = __builtin_convertvector(v, bf16x2_t); return __builtin_bit_cast(unsigned, b); }
__device__ __forceinline__ unsigned f2bf(float f) { return pk2(f, 0.f) & 0xffffu; }
__device__ __forceinline__ void unpack8(u32x4 w, float (&f)[8]) {
#pragma unroll
    for (int i = 0; i < 4; ++i) { f[2 * i] = __uint_as_float(w[i] << 16); f[2 * i + 1] = __uint_as_float(w[i] & 0xffff0000u); }
}
__device__ __forceinline__ u32x4 pack8(const float (&f)[8]) { u32x4 w; w[0] = pk2(f[0], f[1]); w[1] = pk2(f[2], f[3]); w[2] = pk2(f[4], f[5]); w[3] = pk2(f[6], f[7]); return w; }
__device__ __forceinline__ u32x4 pack8v(f32x4 a, f32x4 b) { u32x4 w; w[0] = pk2(a[0], a[1]); w[1] = pk2(a[2], a[3]); w[2] = pk2(b[0], b[1]); w[3] = pk2(b[2], b[3]); return w; }
__device__ __forceinline__ bf16x8 as_frag(u32x4 w) { return __builtin_bit_cast(bf16x8, w); }
__device__ __forceinline__ bf16x8 ldg_f32_frag(const float* p) { f32x4 a = *(const f32x4*)p, b = *(const f32x4*)(p + 4); return as_frag(pack8v(a, b)); }
__device__ __forceinline__ bf16x8 lds_frag(lptr base, int row, int k, int stride) { return *(const LAS bf16x8*)(base + ((row * stride + k) << 1)); }
__device__ __forceinline__ f32x4 mfma16(bf16x8 a, bf16x8 b, f32x4 c) { return __builtin_amdgcn_mfma_f32_16x16x32_bf16(a, b, c, 0, 0, 0); }
__device__ __forceinline__ float rcpf_(float x) { return __builtin_amdgcn_rcpf(x); }
__device__ __forceinline__ float sigmoidf_(float x) { return rcpf_(1.f + __expf(-x)); }
__device__ __forceinline__ float siluf_(float x) { return x * rcpf_(1.f + __expf(-x)); }
__device__ __forceinline__ float softplusf_(float x) { return x > 20.f ? x : __logf(1.f + __expf(x)); }
__device__ __forceinline__ float logsigf_(float x) { return fminf(x, 0.f) - __logf(1.f + __expf(-fabsf(x))); }
template <int CTRL, int RM> __device__ __forceinline__ float dpps(float ident, float v) { return __int_as_float(__builtin_amdgcn_update_dpp(__float_as_int(ident), __float_as_int(v), CTRL, RM, 0xf, false)); }
__device__ __forceinline__ float wave_scan_sum(float v, int) {
    v += dpps<0x111, 0xf>(0.f, v); v += dpps<0x112, 0xf>(0.f, v); v += dpps<0x114, 0xf>(0.f, v); v += dpps<0x118, 0xf>(0.f, v);
    v += dpps<0x142, 0xa>(0.f, v); v += dpps<0x143, 0xc>(0.f, v);
    return v;
}
__device__ __forceinline__ float wave_scan_max(float v, int) {
    const float NI = -3.0e38f;
    v = fmaxf(v, dpps<0x111, 0xf>(NI, v)); v = fmaxf(v, dpps<0x112, 0xf>(NI, v)); v = fmaxf(v, dpps<0x114, 0xf>(NI, v)); v = fmaxf(v, dpps<0x118, 0xf>(NI, v));
    v = fmaxf(v, dpps<0x142, 0xa>(NI, v)); v = fmaxf(v, dpps<0x143, 0xc>(NI, v));
    return v;
}
__device__ __forceinline__ float lane63(float v) { return __int_as_float(__builtin_amdgcn_readlane(__float_as_int(v), 63)); }
__device__ __forceinline__ float red16(float v);
__device__ __forceinline__ float red16max(float v);
__device__ __forceinline__ float wave_sum(float v) { v = red16(v); v += __shfl_xor(v, 16); v += __shfl_xor(v, 32); return v; }
__device__ __forceinline__ float wave_max(float v) { v = red16max(v); v = fmaxf(v, __shfl_xor(v, 16)); v = fmaxf(v, __shfl_xor(v, 32)); return v; }
template <int CTRL> __device__ __forceinline__ float dppf(float v) { return __int_as_float(__builtin_amdgcn_update_dpp(0, __float_as_int(v), CTRL, 0xf, 0xf, true)); }
__device__ __forceinline__ float red16(float v) { v += dppf<0xB1>(v); v += dppf<0x4E>(v); v += dppf<0x141>(v); v += dppf<0x140>(v); return v; }
__device__ __forceinline__ float red16max(float v) { v = fmaxf(v, dppf<0xB1>(v)); v = fmaxf(v, dppf<0x4E>(v)); v = fmaxf(v, dppf<0x141>(v)); v = fmaxf(v, dppf<0x140>(v)); return v; }
__device__ __forceinline__ int OPQ(int v) { asm volatile("" : "+v"(v)); return v; }
#define LDS_FENCE() asm volatile("s_waitcnt lgkmcnt(0)" ::: "memory")

namespace pg8 {
constexpr int BM = 256, BK = 64, HALF = 128, HTB = HALF * BK * 2, STAGE_BYTES = 8 * HTB, NXCD = 8, WGM = 8;
__host__ __device__ __forceinline__ int lds_byte(int r, int c) { const int st = (r >> 4) * 2 + (c >> 5), rr = r & 15, cc = c & 31, ob = rr * 64 + cc * 2; return st * 1024 + (ob ^ (((ob >> 9) & 1) << 5)); }
__host__ __device__ __forceinline__ void stage_rc(int b, int& R, int& C) { const int st = b / 1024, sb = b % 1024, swz = sb ^ (((sb >> 9) & 1) << 5); R = (st >> 1) * 16 + swz / 64; C = (st & 1) * 32 + (swz % 64) / 2; }
__host__ __device__ __forceinline__ int perm32(int rho) { const int n = rho >> 4, i = rho & 15; return 8 * (i >> 2) + 4 * n + (i & 3); }
struct Unit { int pm, pn; };
struct Gemm { const bf16_t* A; const bf16_t* Bt; int M, N, K; };
struct StaticOrder {
    int nM, nN, nwg, G, c;
    __device__ void init(int M, int N, int G_, int c_) { nM = M / BM; nN = N / BM; nwg = nM * nN; G = G_; c = c_; }
    __device__ bool next(int i, Unit& u) const {
        const long L = (long)i * G + c; if (L >= nwg) return false;
        int wgid = (int)L; { const int q = nwg / NXCD, r = nwg % NXCD, xcd = wgid % NXCD, off = wgid / NXCD; wgid = (xcd < r ? xcd * (q + 1) : r * (q + 1) + (xcd - r) * q) + off; }
        const int nig = WGM * nN, gid = wgid / nig, fm = gid * WGM, gsz = (nM - fm) < WGM ? (nM - fm) : WGM;
        u.pm = fm + ((wgid % nig) % gsz); u.pn = (wgid % nig) / gsz; return true;
    }
};
template <int NAI> struct EpiU_ {
    bf16_t* U; const float* ssq;
    __device__ __forceinline__ void operator()(const f32x4 (&acc)[2][2][4][2], const Unit& u, int wr, int wc, int fr, int fq) const {
        const int row0 = u.pm * BM + wr * 64 + fr, col0 = u.pn * BM + wc * 32 + 8 * fq;
        f32x4 sq[NAI][4];
#pragma unroll
        for (int ai = 0; ai < NAI; ++ai)
#pragma unroll
            for (int m = 0; m < 4; ++m) sq[ai][m] = *(const f32x4*)(ssq + (size_t)(row0 + ai * HALF + m * 16) * 16 + fq * 4);
#pragma unroll
        for (int ai = 0; ai < NAI; ++ai)
#pragma unroll
            for (int m = 0; m < 4; ++m) {
                const int r = row0 + ai * HALF + m * 16;
                const f32x4 s = sq[ai][m];
                float st = s[0] + s[1] + s[2] + s[3]; st += __shfl_xor(st, 16); st += __shfl_xor(st, 32);
                const float rs = rsqrtf(st * (1.f / 1024.f) + EPS);
                bf16_t* rowp = U + (size_t)r * NIN + col0;
#pragma unroll
                for (int bj = 0; bj < 2; ++bj) *(u32x4*)(rowp + bj * HALF) = pack8v(acc[ai][bj][m][0] * rs, acc[ai][bj][m][1] * rs);
                __builtin_amdgcn_sched_barrier(0);
            }
    }
};
template <int NAI, int MODE> struct EpiRes_ {
    const float* xp; const float* xs; float* out; bf16_t* xb; float* ssq;
    __device__ __forceinline__ void operator()(const f32x4 (&acc)[2][2][4][2], const Unit& u, int wr, int wc, int fr, int fq) const {
        const int row0 = u.pm * BM + wr * 64 + fr, col0 = u.pn * BM + wc * 32 + 8 * fq;
#pragma unroll
        for (int ai = 0; ai < NAI; ++ai) {
            u32x4 xo[4][2];
            f32x4 xf[MODE == 0 ? 4 : 1][2][2];
            if (MODE != 0) {
#pragma unroll
                for (int m = 0; m < 4; ++m)
#pragma unroll
                    for (int bj = 0; bj < 2; ++bj) xo[m][bj] = *(const u32x4*)(xb + (size_t)(row0 + ai * HALF + m * 16) * D + col0 + bj * HALF);
            } else {
#pragma unroll
                for (int m = 0; m < 4; ++m) {
                    const int r = row0 + ai * HALF + m * 16, rc = r < MTOK ? r : MTOK - 1;
                    const float* src = rc < TP ? xp + (size_t)rc * D : xs + (size_t)(rc - TP) * D;
#pragma unroll
                    for (int bj = 0; bj < 2; ++bj) { xf[m][bj][0] = __builtin_nontemporal_load((const f32x4*)(src + col0 + bj * HALF)); xf[m][bj][1] = __builtin_nontemporal_load((const f32x4*)(src + col0 + bj * HALF + 4)); }
                }
            }
#pragma unroll
            for (int m = 0; m < 4; ++m) {
                const int r = row0 + ai * HALF + m * 16;
                const bool valid = r < MTOK;
                float part = 0.f;
#pragma unroll
                for (int bj = 0; bj < 2; ++bj) {
                    const int c = col0 + bj * HALF;
                    f32x4 o0 = {0.f, 0.f, 0.f, 0.f}, o1 = {0.f, 0.f, 0.f, 0.f};
                    if (MODE == 0) {
                        if (valid) { o0 = xf[MODE == 0 ? m : 0][bj][0]; o1 = xf[MODE == 0 ? m : 0][bj][1]; }
                    } else {
                        float f[8]; unpack8(xo[m][bj], f);
                        o0 = (f32x4){f[0], f[1], f[2], f[3]}; o1 = (f32x4){f[4], f[5], f[6], f[7]};
                    }
                    const f32x4 v0 = acc[ai][bj][m][0] + o0, v1 = acc[ai][bj][m][1] + o1;
                    if (MODE == 2) {
                        if (valid) { __builtin_nontemporal_store(v0, (f32x4*)(out + (size_t)r * D + c)); __builtin_nontemporal_store(v1, (f32x4*)(out + (size_t)r * D + c + 4)); }
                    } else {
                        *(u32x4*)(xb + (size_t)r * D + c) = pack8v(v0, v1);
                        part += v0[0] * v0[0] + v0[1] * v0[1] + v0[2] * v0[2] + v0[3] * v0[3] + v1[0] * v1[0] + v1[1] * v1[1] + v1[2] * v1[2] + v1[3] * v1[3];
                    }
                }
                if (MODE != 2) {
                    part += __shfl_xor(part, 16); part += __shfl_xor(part, 32);
                    if (fq == 0) ssq[(size_t)r * 16 + u.pn * 4 + wc] = part;
                }
                __builtin_amdgcn_sched_barrier(0);
            }
        }
    }
};

typedef EpiU_<2> EpiU; typedef EpiU_<1> EpiUh;
struct EpiProbe {
    const unsigned* flag; float* dst;
    __device__ __forceinline__ void operator()(const f32x4 (&acc)[2][2][4][2], const Unit& u, int wr, int wc, int fr, int fq) const {
        if (__hip_atomic_load(flag, __ATOMIC_RELAXED, __HIP_MEMORY_SCOPE_AGENT) == 12345u) {
            f32x4 t = {0.f, 0.f, 0.f, 0.f};
#pragma unroll
            for (int a = 0; a < 2; ++a)
#pragma unroll
                for (int b = 0; b < 2; ++b)
#pragma unroll
                    for (int m = 0; m < 4; ++m)
#pragma unroll
                        for (int n = 0; n < 2; ++n) t += acc[a][b][m][n];
            *(f32x4*)(dst + (size_t)(u.pm * 4 + u.pn) * 2048 + (wr * 4 + wc) * 256 + (fq * 16 + fr) * 4) = t;
        }
    }
};
struct SampleOrder {
    int first, cnt, c;
    __device__ bool next(int i, Unit& u) const { if (i != 0 || c < first || c >= first + cnt) return false; u.pm = 64; u.pn = c - first; return true; }
};
template <class Epi, class Sched, bool HALF_M = false, bool SP2 = false, bool ALIGN_EPI = false>
__device__ __forceinline__ void gemm_phase(lptr lds, const Gemm g, const Sched& S, const Epi& E, const int tid) {
    const int wid = __builtin_amdgcn_readfirstlane(tid >> 6), lane = tid & 63, wr = wid >> 2, wc = wid & 3, fr = lane & 15, fq = lane >> 4;
    const int K = g.K, nt = K / BK;
    unsigned voffA[2], voffB[2];
#pragma unroll
    for (int i = 0; i < 2; ++i) { int R, C; stage_rc(tid * 16 + i * 8192, R, C); const int Rb = (R & ~31) + perm32(R & 31);
        voffA[i] = (unsigned)(R * K + C) * 2u; voffB[i] = (unsigned)(Rb * K + C) * 2u; }
    const size_t kstep = (size_t)(BK * 2);
    const size_t hstep = (size_t)HALF * K * 2;
    const size_t tstep = 2 * hstep;
    const unsigned ldsw = (unsigned)wid * 1024u;
    const int aoff = lds_byte(wr * 64 + fr, fq * 8), boff = lds_byte(wc * 32 + fr, fq * 8);
#define PG8_SA(b, h) (((b) * 2 + (h)) * HTB)
#define PG8_SB(b, h) ((4 + (b) * 2 + (h)) * HTB)
#define PG8_STAGE(bufoff, gbase, voff) do { _Pragma("unroll") for (int _i = 0; _i < 2; ++_i) \
        __builtin_amdgcn_global_load_lds((const unsigned*)((const char*)(gbase) + (voff)[_i]), (LAS unsigned*)(lds + (bufoff) + ldsw + _i * 8192), 16, 0, 0); } while (0)
#define PG8_LDA(dst, b, h) do { _Pragma("unroll") for (int m = 0; m < 4; ++m) _Pragma("unroll") for (int k = 0; k < 2; ++k) dst[m][k] = *(const LAS bf16x8*)(lds + PG8_SA(b, h) + aoff + m * 2048 + k * 1024); } while (0)
#define PG8_LDB(dst, b, h) do { _Pragma("unroll") for (int n = 0; n < 2; ++n) _Pragma("unroll") for (int k = 0; k < 2; ++k) dst[n][k] = *(const LAS bf16x8*)(lds + PG8_SB(b, h) + boff + n * 2048 + k * 1024); } while (0)
#define PG8_MMA(ai, bj, At, Bt) do { __builtin_amdgcn_s_setprio(1); _Pragma("unroll") for (int m = 0; m < 4; ++m) _Pragma("unroll") for (int n = 0; n < 2; ++n) _Pragma("unroll") for (int k = 0; k < 2; ++k) \
        acc[ai][bj][m][n] = __builtin_amdgcn_mfma_f32_16x16x32_bf16(Bt[n][k], At[m][k], acc[ai][bj][m][n], 0, 0, 0); __builtin_amdgcn_s_setprio(0); } while (0)
#define PG8_WAIT_V(n) asm volatile("s_waitcnt vmcnt(" #n ")" ::: "memory")
#define PG8_WAIT_L(n) asm volatile("s_waitcnt lgkmcnt(" #n ")" ::: "memory")
#define PG8_BAR __builtin_amdgcn_s_barrier()
#define PG8_SCHED __builtin_amdgcn_sched_barrier(0)
    Unit cur, nxt; int ui = 0;
    if (!S.next(0, cur)) return;
    f32x4 acc[2][2][4][2];
#pragma unroll
    for (int a = 0; a < 2; ++a)
#pragma unroll
        for (int b = 0; b < 2; ++b)
#pragma unroll
            for (int m = 0; m < 4; ++m)
#pragma unroll
                for (int n = 0; n < 2; ++n) acc[a][b][m][n] = (f32x4){0.f, 0.f, 0.f, 0.f};
    bf16x8 At[4][2], B0[2][2], B1[2][2];
    const char* cA = (const char*)g.A + (size_t)cur.pm * tstep; const char* cB = (const char*)g.Bt + (size_t)cur.pn * tstep;
    if constexpr (SP2) {
        PG8_STAGE(PG8_SB(0, 0), cB, voffB); PG8_STAGE(PG8_SB(0, 1), cB + hstep, voffB); PG8_STAGE(PG8_SA(0, 0), cA, voffA); PG8_STAGE(PG8_SA(0, 1), cA + hstep, voffA);
        if (wr == 1) PG8_BAR;
        PG8_WAIT_V(2); PG8_BAR;
        PG8_STAGE(PG8_SB(1, 0), cB + kstep, voffB); PG8_STAGE(PG8_SA(1, 0), cA + kstep, voffA); PG8_STAGE(PG8_SB(1, 1), cB + hstep + kstep, voffB);
        PG8_WAIT_V(6); PG8_BAR;
    } else {
    PG8_STAGE(PG8_SB(0, 0), cB, voffB); PG8_STAGE(PG8_SA(0, 0), cA, voffA); PG8_STAGE(PG8_SB(0, 1), cB + hstep, voffB); PG8_STAGE(PG8_SA(0, 1), cA + hstep, voffA);
    if (wr == 1) PG8_BAR;
    PG8_WAIT_V(4); PG8_BAR;
    PG8_STAGE(PG8_SB(1, 0), cB + kstep, voffB); PG8_STAGE(PG8_SA(1, 0), cA + kstep, voffA); PG8_STAGE(PG8_SB(1, 1), cB + hstep + kstep, voffB);
    PG8_WAIT_V(6); PG8_BAR;
    }
    for (;;) {
        const bool has_next = S.next(ui + 1, nxt);
        const char* nA = has_next ? (const char*)g.A + (size_t)nxt.pm * tstep : cA; const char* nB = has_next ? (const char*)g.Bt + (size_t)nxt.pn * tstep : cB;
        for (int t = 0; t < nt; t += 2) {
            const bool last = (t == nt - 2);
            const char* a1 = cA + (size_t)(t + 1) * kstep;
            const char* a2 = last ? nA : cA + (size_t)(t + 2) * kstep; const char* b2 = last ? nB : cB + (size_t)(t + 2) * kstep;
            const char* a3 = a2 + kstep; const char* b3 = b2 + kstep;
            if constexpr (SP2) {
            PG8_LDB(B0, 0, 0); PG8_LDB(B1, 0, 1); PG8_SCHED; PG8_LDA(At, 0, 0); PG8_STAGE(PG8_SA(1, 1), a1 + hstep, voffA);
            PG8_WAIT_V(8); PG8_WAIT_L(0); PG8_BAR; PG8_MMA(0, 0, At, B0); PG8_MMA(0, 1, At, B1); PG8_BAR; PG8_SCHED;
            PG8_LDA(At, 0, 1); PG8_STAGE(PG8_SB(0, 0), b2, voffB); PG8_STAGE(PG8_SB(0, 1), b2 + hstep, voffB); PG8_STAGE(PG8_SA(0, 0), a2, voffA);
            PG8_WAIT_V(8); PG8_WAIT_L(0); PG8_BAR; PG8_MMA(1, 0, At, B0); PG8_MMA(1, 1, At, B1); PG8_BAR; PG8_SCHED;
            PG8_LDB(B0, 1, 0); PG8_LDB(B1, 1, 1); PG8_SCHED; PG8_LDA(At, 1, 0); PG8_STAGE(PG8_SA(0, 1), a2 + hstep, voffA);
            PG8_WAIT_V(8); PG8_WAIT_L(0); PG8_BAR; PG8_MMA(0, 0, At, B0); PG8_MMA(0, 1, At, B1); PG8_BAR; PG8_SCHED;
            PG8_LDA(At, 1, 1); PG8_STAGE(PG8_SB(1, 0), b3, voffB); PG8_STAGE(PG8_SB(1, 1), b3 + hstep, voffB); PG8_STAGE(PG8_SA(1, 0), a3, voffA);
            PG8_WAIT_V(8); PG8_WAIT_L(0); PG8_BAR; PG8_MMA(1, 0, At, B0); PG8_MMA(1, 1, At, B1); PG8_BAR; PG8_SCHED;
            } else {
            PG8_LDB(B0, 0, 0); PG8_SCHED; PG8_LDA(At, 0, 0); PG8_STAGE(PG8_SA(1, 1), a1 + hstep, voffA);
            PG8_WAIT_L(8); PG8_BAR; PG8_WAIT_L(0); PG8_MMA(0, 0, At, B0); PG8_BAR; PG8_SCHED;
            PG8_LDB(B1, 0, 1); PG8_STAGE(PG8_SB(0, 0), b2, voffB);
            PG8_BAR; PG8_WAIT_L(0); PG8_MMA(0, 1, At, B1); PG8_BAR;
            if constexpr (!HALF_M) PG8_LDA(At, 0, 1);
            PG8_STAGE(PG8_SA(0, 0), a2, voffA);
            PG8_BAR; PG8_WAIT_L(0); if constexpr (!HALF_M) PG8_MMA(1, 0, At, B0); PG8_BAR; PG8_SCHED;
            PG8_STAGE(PG8_SB(0, 1), b2 + hstep, voffB);
            PG8_WAIT_V(6); PG8_BAR; if constexpr (!HALF_M) PG8_MMA(1, 1, At, B1); PG8_BAR;
            PG8_LDB(B0, 1, 0); PG8_SCHED; PG8_LDA(At, 1, 0); PG8_STAGE(PG8_SA(0, 1), a2 + hstep, voffA);
            PG8_WAIT_L(8); PG8_BAR; PG8_WAIT_L(0); PG8_MMA(0, 0, At, B0); PG8_BAR; PG8_SCHED;
            PG8_LDB(B1, 1, 1); PG8_STAGE(PG8_SB(1, 0), b3, voffB);
            PG8_BAR; PG8_WAIT_L(0); PG8_MMA(0, 1, At, B1); PG8_BAR;
            if constexpr (!HALF_M) PG8_LDA(At, 1, 1);
            PG8_STAGE(PG8_SA(1, 0), a3, voffA);
            PG8_BAR; PG8_WAIT_L(0); if constexpr (!HALF_M) PG8_MMA(1, 0, At, B0); PG8_BAR; PG8_SCHED;
            PG8_STAGE(PG8_SB(1, 1), b3 + hstep, voffB);
            PG8_WAIT_V(6); PG8_BAR; if constexpr (!HALF_M) PG8_MMA(1, 1, At, B1); PG8_BAR;
            }
        }
        if constexpr (ALIGN_EPI) { if (wr == 0) PG8_BAR; }
        E(acc, cur, wr, wc, fr, fq);
        if (!has_next) break;
#pragma unroll
        for (int a = 0; a < 2; ++a)
#pragma unroll
            for (int b = 0; b < 2; ++b)
#pragma unroll
                for (int m = 0; m < 4; ++m)
#pragma unroll
                    for (int n = 0; n < 2; ++n) acc[a][b][m][n] = (f32x4){0.f, 0.f, 0.f, 0.f};
        cur = nxt; cA = nA; cB = nB; ++ui;
        if constexpr (ALIGN_EPI) { if (wr == 1) PG8_BAR; }
    }
    PG8_WAIT_V(0);
    if constexpr (!ALIGN_EPI) { if (wr == 0) PG8_BAR; }
    PG8_BAR;
#undef PG8_SA
#undef PG8_SB
#undef PG8_STAGE
#undef PG8_LDA
#undef PG8_LDB
#undef PG8_MMA
#undef PG8_WAIT_V
#undef PG8_WAIT_L
#undef PG8_BAR
#undef PG8_SCHED
}
}

struct Ctx {
    const float* xp; const float* xs; const float* stC; const float* stN; const float* stM; const float* ssm; const float* conv; const float* ck; const float* cv;
    float* out; unsigned char* ws;
};
#define XWIN ((bf16_t*)(X.ws + WS_WIN))
#define XWOUT ((bf16_t*)(X.ws + WS_WOUT))
#define XXB ((bf16_t*)(X.ws + WS_XB))
#define XU ((bf16_t*)(X.ws + WS_U))
#define XMIX ((bf16_t*)(X.ws + WS_MIX))
#define XSSQ ((float*)(X.ws + WS_SSQ))
#define XROPE ((float*)(X.ws + WS_ROPE))
#define XMC ((float*)(X.ws + WS_MC))
#define XMN ((float*)(X.ws + WS_MN))
#define XML ((float*)(X.ws + WS_ML))
#define XBL ((float*)(X.ws + WS_BL))
#define XMS ((float*)(X.ws + WS_MS))
#define XSA ((float*)(X.ws + WS_SA))
#define XSH ((float*)(X.ws + WS_SH))
#define XCSB ((bf16_t*)(X.ws + WS_CSB))
#define XNS ((float*)(X.ws + WS_NS))
#define XHSB ((bf16_t*)(X.ws + WS_HSB))
#define XPAR(off) ((const float*)(X.ws + WS_PAR) + (off))
constexpr int P_AIB = 0, P_AFB = 16, P_DTB = 32, P_ALOG = 64, P_BD = 96, P_SINK = 128, P_QNW = 160, P_KNW = 416, P_ANW = 672, P_BNW = 2720, P_CB = 4768, P_CW = 8864, P_END = 25248;
#define IN_XP 0
#define IN_XS 1
#define IN_STC 2
#define IN_STN 3
#define IN_STM 4
#define IN_SSM 5
#define IN_CONV 6
#define IN_CK 7
#define IN_CV 8
#define IN_NORMW 9
#define IN_WIN 10
#define IN_AIB 11
#define IN_AFB 12
#define IN_ANW 13
#define IN_CW 14
#define IN_CB 15
#define IN_DTB 16
#define IN_ALOG 17
#define IN_BD 18
#define IN_BNW 19
#define IN_QNW 20
#define IN_KNW 21
#define IN_SINK 22
#define IN_WOUT 23

__device__ __forceinline__ void transpose_strip(lptr lds, const float* src, int ldn, int nvalid, bf16_t* dst, int ldk, const float* scale, int k0, int n0, int tid) {
    LAS float* T = (LAS float*)lds;
    f32x4 v[8];
#pragma unroll
    for (int i = 0; i < 8; ++i) {
        const int f = tid + i * NT, r = f >> 6, c4 = (f & 63) * 4, n = n0 + c4;
        const f32x4 t = __builtin_nontemporal_load((const f32x4*)(src + (size_t)(k0 + r) * ldn + (n < nvalid ? n : 0)));
        const float m = n < nvalid ? (scale ? scale[k0 + r] : 1.f) : 0.f;
        v[i] = t * m;
    }
#pragma unroll
    for (int i = 0; i < 8; ++i) {
        const int f = tid + i * NT, r = f >> 6, c4 = (f & 63) * 4;
        T[r * 257 + c4 + 0] = v[i][0]; T[r * 257 + c4 + 1] = v[i][1]; T[r * 257 + c4 + 2] = v[i][2]; T[r * 257 + c4 + 3] = v[i][3];
    }
    __syncthreads();
#pragma unroll
    for (int i = 0; i < 4; ++i) {
        const int p = tid + i * NT, n = p >> 3, k8 = (p & 7) * 8; float f[8];
#pragma unroll
        for (int jx = 0; jx < 8; ++jx) f[jx] = T[(k8 + jx) * 257 + n];
        *(u32x4*)(dst + (size_t)(n0 + n) * ldk + k0 + k8) = pack8(f);
    }
    __syncthreads();
}

__device__ __forceinline__ void prologue(lptr lds, const Ctx& X, const Args& args, int G, int bid, int tid) {
    const int lane = tid & 63, wave = tid >> 6;
    constexpr int T0 = 320, T1 = T0 + 96, T2 = T1 + 520, T3 = T2 + 1, T4 = T3 + 513;
    for (int task = bid; task < T4; task += G) {
        if (task < T0) {
            const int kt = task / 20, ntl = task % 20;
            transpose_strip(lds, args.in[IN_WIN], DIN, DIN, XWIN, D, args.in[IN_NORMW], kt * 64, ntl * 256, tid);
        } else if (task < T1) {
            const int r = task - T0, kt = r / 4, ntl = r % 4;
            transpose_strip(lds, args.in[IN_WOUT], D, D, XWOUT, DMIX, nullptr, kt * 64, ntl * 256, tid);
        } else if (task < T2) {
            const int rb = (task - T1) * 32 + wave * 4;
            f32x4 v[4][4];
#pragma unroll
            for (int q = 0; q < 4; ++q) {
                const int r = rb + q, rc = r < MTOK ? r : MTOK - 1;
                const float* src = rc < TP ? X.xp + (size_t)rc * D : X.xs + (size_t)(rc - TP) * D;
#pragma unroll
                for (int i = 0; i < 4; ++i) v[q][i] = __builtin_nontemporal_load((const f32x4*)(src + lane * 4 + i * 256));
            }
#pragma unroll
            for (int q = 0; q < 4; ++q) {
                const int r = rb + q;
                const float keep = r < MTOK ? 1.f : 0.f;
                float ss = 0.f;
#pragma unroll
                for (int i = 0; i < 4; ++i) {
                    const f32x4 t = v[q][i] * keep;
                    ss += t[0] * t[0] + t[1] * t[1] + t[2] * t[2] + t[3] * t[3];
                    u32x2 w; w[0] = pk2(t[0], t[1]); w[1] = pk2(t[2], t[3]);
                    *(u32x2*)(XXB + (size_t)r * D + lane * 4 + i * 256) = w;
                }
                ss = wave_sum(ss);
                if (lane < 16) XSSQ[(size_t)r * 16 + lane] = (lane == 0) ? ss : 0.f;
            }
        } else if (task < T3) {
            for (int i = tid; i < (MPAD - MTOK) * DMIX / 2; i += NT) ((unsigned*)(XMIX + (size_t)MTOK * DMIX))[i] = 0u;
            float* P = (float*)(X.ws + WS_PAR);
            const int po[12] = {P_AIB, P_AFB, P_DTB, P_ALOG, P_BD, P_SINK, P_QNW, P_KNW, P_ANW, P_BNW, P_CB, P_CW};
            const int pn[12] = {16, 16, 32, 32, 32, 32, 256, 256, 2048, 2048, 4096, 16384};
            const int pi[12] = {IN_AIB, IN_AFB, IN_DTB, IN_ALOG, IN_BD, IN_SINK, IN_QNW, IN_KNW, IN_ANW, IN_BNW, IN_CB, IN_CW};
#pragma unroll
            for (int a = 0; a < 12; ++a) { const float* src = args.in[pi[a]]; for (int i = tid; i < pn[a]; i += NT) P[po[a] + i] = src[i]; }
        } else {
            const int e = (task - T3) * 512 + tid;
            if (e < 8193 * 32) {
                const int pos = e >> 5, d = e & 31;
                const float inv = (float)exp2(-(double)d * (13.287712379549449 / 32.0));
                const float angf = (float)pos * inv;
                const double a = (double)angf;
                const double k = rint(a * 0.15915494309189535);
                const float rr = (float)(a - k * 6.283185307179586);
                XROPE[(size_t)e * 2] = cosf(rr); XROPE[(size_t)e * 2 + 1] = sinf(rr);
            }
        }
    }
}

__device__ __forceinline__ void convert_weights(lptr lds, const Ctx& X, const Args& args, int l, int first, int stride, int tid) {
    for (int t = first; t < 416; t += stride) {
        if (t < 320) {
            const int kt = t / 20, ntl = t % 20;
            transpose_strip(lds, args.in[IN_WIN] + (size_t)l * D * DIN, DIN, DIN, XWIN + (size_t)l * NIN * D, D, args.in[IN_NORMW] + l * D, kt * 64, ntl * 256, tid);
        } else {
            const int r = t - 320, kt = r / 4, ntl = r % 4;
            transpose_strip(lds, args.in[IN_WOUT] + (size_t)l * DMIX * D, D, D, XWOUT + (size_t)l * D * DMIX, DMIX, nullptr, kt * 64, ntl * 256, tid);
        }
    }
}

__device__ __forceinline__ void conv8(const bf16_t* u, int seq0, int tt, int ch, const float* cw, const float* cb, float (&o)[8]) {
    float acc[8];
    { f32x4 b0 = *(const f32x4*)(cb + ch), b1 = *(const f32x4*)(cb + ch + 4);
#pragma unroll
      for (int j = 0; j < 4; ++j) { acc[j] = b0[j]; acc[4 + j] = b1[j]; } }
#pragma unroll
    for (int jj = 0; jj < 4; ++jj) {
        const int t2 = tt + jj - 3;
        if (t2 >= 0) {
            float x[8]; unpack8(*(const u32x4*)(u + (size_t)(seq0 + t2) * NIN + C_BX + ch), x);
            f32x4 w0 = *(const f32x4*)(cw + jj * 1024 + ch), w1 = *(const f32x4*)(cw + jj * 1024 + ch + 4);
#pragma unroll
            for (int j = 0; j < 4; ++j) { acc[j] += x[j] * w0[j]; acc[4 + j] += x[4 + j] * w1[j]; }
        }
    }
#pragma unroll
    for (int j = 0; j < 8; ++j) o[j] = siluf_(acc[j]);
}


__device__ __forceinline__ void conv8x8(const bf16_t* u, int seq0, int tt0, int ch, const float* cw, const float* cb, float (&o)[8][8]) {
    float w[4][8];
#pragma unroll
    for (int jj = 0; jj < 4; ++jj) { f32x4 w0 = *(const f32x4*)(cw + jj * 1024 + ch), w1 = *(const f32x4*)(cw + jj * 1024 + ch + 4);
#pragma unroll
        for (int j = 0; j < 4; ++j) { w[jj][j] = w0[j]; w[jj][4 + j] = w1[j]; } }
    { f32x4 b0 = *(const f32x4*)(cb + ch), b1 = *(const f32x4*)(cb + ch + 4);
#pragma unroll
      for (int t = 0; t < 8; ++t)
#pragma unroll
          for (int j = 0; j < 4; ++j) { o[t][j] = b0[j]; o[t][4 + j] = b1[j]; } }
    u32x4 raw[11];
#pragma unroll
    for (int r = 0; r < 11; ++r) {
        const int t2 = tt0 + r - 3;
        const u32x4 v = *(const u32x4*)(u + (unsigned)(seq0 + (t2 >= 0 ? t2 : 0)) * NIN + C_BX + ch);
        const unsigned msk = t2 >= 0 ? 0xffffffffu : 0u;
        raw[r] = (u32x4){v[0] & msk, v[1] & msk, v[2] & msk, v[3] & msk};
    }
#pragma unroll
    for (int r = 0; r < 11; ++r) {
        float x[8]; unpack8(raw[r], x);
#pragma unroll
        for (int jj = 0; jj < 4; ++jj) {
            const int t = r - jj;
            if (t >= 0 && t < 8) {
#pragma unroll
                for (int j = 0; j < 8; ++j) o[t][j] += x[j] * w[jj][j];
            }
        }
    }
#pragma unroll
    for (int t = 0; t < 8; ++t)
#pragma unroll
        for (int j = 0; j < 8; ++j) o[t][j] = siluf_(o[t][j]);
}

__device__ __forceinline__ void mlstm_local(lptr lds, const Ctx& X, int l, int task, int tid) {
    const int h = task & 3, c = (task >> 2) & 127, n = task >> 9;
    const int lane = tid & 63, wave = tid >> 6, fr = lane & 15, fq = lane >> 4;
    const int row0 = n * SEQ + c * 64, nh = n * 4 + h;
    lptr VwT = lds;
    lptr KT = lds + 18432;
    LAS float* wv = (LAS float*)(lds + 27648);
    const int tg = lane & 7, cgq = lane >> 3;
    u32x4 blk[8];
    if (wave >= 1 && wave <= 3) {
        const int col = wave < 3 ? C_AV + h * 128 + ((wave - 1) * 8 + cgq) * 8 : C_AK + h * 64 + cgq * 8;
#pragma unroll
        for (int t = 0; t < 8; ++t) blk[t] = *(const u32x4*)(XU + (unsigned)(row0 + 8 * tg + t) * NIN + col);
    }
    if (wave == 0) {
        const bf16_t* ur = XU + (unsigned)(row0 + lane) * NIN;
        const float fg = bf2f(ur[C_AF + h]) + XPAR(P_AFB)[l * 4 + h], ig = bf2f(ur[C_AI + h]) + XPAR(P_AIB)[l * 4 + h];
        const float b = wave_scan_sum(logsigf_(fg), lane);
        const float bl = lane63(b);
        const float g = bl - b + ig;
        const float ml = wave_max(g);
        wv[lane] = __expf(g - ml);
        if (lane == 0) { XML[nh * 128 + c] = ml; XBL[nh * 128 + c] = bl; }
    }
    __syncthreads();
    if (wave >= 1 && wave <= 3) {
        float xs[8][8];
#pragma unroll
        for (int t = 0; t < 8; ++t) { unpack8(blk[t], xs[t]); const float w = wave < 3 ? wv[8 * tg + t] : 0.125f;
#pragma unroll
            for (int j = 0; j < 8; ++j) xs[t][j] *= w; }
        lptr dstT = wave < 3 ? VwT + ((((wave - 1) * 8 + cgq) * 8 * 72) << 1) : KT + ((cgq * 8 * 72) << 1);
#pragma unroll
        for (int j = 0; j < 8; ++j) {
            float v[8];
#pragma unroll
            for (int t = 0; t < 8; ++t) v[t] = xs[t][j];
            *(LAS u32x4*)(dstT + ((j * 72 + 8 * tg) << 1)) = pack8(v);
        }
    }
    __syncthreads();
    {
        bf16_t* dst = (bf16_t*)XMC + ((size_t)nh * 128 + c) * 8192;
        bf16x8 b0 = lds_frag(VwT, 16 * wave + fr, fq * 8, 72), b1 = lds_frag(VwT, 16 * wave + fr, 32 + fq * 8, 72);
#pragma unroll
        for (int mt = 0; mt < 4; ++mt) {
            f32x4 acc = {0.f, 0.f, 0.f, 0.f};
            acc = mfma16(lds_frag(KT, 16 * mt + fr, fq * 8, 72), b0, acc);
            acc = mfma16(lds_frag(KT, 16 * mt + fr, 32 + fq * 8, 72), b1, acc);
            { u32x2 w; w[0] = pk2(acc[0], acc[1]); w[1] = pk2(acc[2], acc[3]); *(u32x2*)(dst + (16 * wave + fr) * 64 + 16 * mt + 4 * fq) = w; }
        }
    }
    if (tid < 64) {
        float s = 0.f;
#pragma unroll
        for (int t8 = 0; t8 < 8; ++t8) {
            float kf[8]; unpack8(*(const LAS u32x4*)(KT + ((tid * 72 + t8 * 8) << 1)), kf);
#pragma unroll
            for (int jx = 0; jx < 8; ++jx) s += kf[jx] * wv[t8 * 8 + jx];
        }
        XMN[((size_t)nh * 128 + c) * 64 + tid] = s;
    }
    __syncthreads();
}

__device__ __forceinline__ void ssd_local(lptr lds, const Ctx& X, int l, int task, int tid) {
    const int g = task & 1, c = (task >> 1) & 127, n = task >> 8;
    const int lane = tid & 63, wave = tid >> 6, fr = lane & 15, fq = lane >> 4;
    const int seq0 = n * SEQ, row0 = seq0 + c * 64;
    lptr XwT = lds;
    lptr BT = lds + 36864;
    LAS float* wl = (LAS float*)(lds + 55296);
    {
        const float* cw = XPAR(P_CW) + l * 4096; const float* cb = XPAR(P_CB) + l * 1024;
        const int tg = lane & 7, cg = wave * 8 + (lane >> 3);
        float o[8][8];
        if (wave < 6) {
            const int ch = cg < 32 ? g * 256 + cg * 8 : 512 + g * 128 + (cg - 32) * 8;
            conv8x8(XU, seq0, c * 64 + 8 * tg, ch, cw, cb, o);
        }
        if (wave < 4) {
            const int hh = 4 * g + wave;
            const float dt = softplusf_(bf2f(XU[(unsigned)(row0 + lane) * NIN + C_BDT + hh]) + XPAR(P_DTB)[l * 8 + hh]);
            const float A = -__expf(XPAR(P_ALOG)[l * 8 + hh]);
            const float a = wave_scan_sum(dt * A, lane);
            const float aL = lane63(a);
            wl[wave * 64 + lane] = __expf(aL - a) * dt;
            if (lane == 0) XSA[(n * 8 + hh) * 128 + c] = aL;
        }
        __syncthreads();
        if (wave < 4) {
            float wt[8];
#pragma unroll
            for (int t = 0; t < 8; ++t) wt[t] = wl[wave * 64 + 8 * tg + t];
#pragma unroll
            for (int jx = 0; jx < 8; ++jx) {
                float v[8];
#pragma unroll
                for (int t = 0; t < 8; ++t) v[t] = o[t][jx] * wt[t];
                *(LAS u32x4*)(XwT + (((cg * 8 + jx) * 72 + 8 * tg) << 1)) = pack8(v);
            }
        } else if (wave < 6) {
#pragma unroll
            for (int jx = 0; jx < 8; ++jx) {
                float v[8];
#pragma unroll
                for (int t = 0; t < 8; ++t) v[t] = o[t][jx];
                *(LAS u32x4*)(BT + ((((cg - 32) * 8 + jx) * 72 + 8 * tg) << 1)) = pack8(v);
            }
        }
    }
    __syncthreads();
    {
        const int hl = wave >> 1, ph = wave & 1, hh = 4 * g + hl;
        bf16_t* dst = (bf16_t*)XSH + ((size_t)(n * 8 + hh) * 128 + c) * 8192;
        bf16x8 bx[2][2];
#pragma unroll
        for (int ntl = 0; ntl < 2; ++ntl)
#pragma unroll
            for (int kk = 0; kk < 2; ++kk) bx[ntl][kk] = lds_frag(XwT, hl * 64 + ph * 32 + ntl * 16 + fr, kk * 32 + fq * 8, 72);
#pragma unroll
        for (int mt = 0; mt < 8; ++mt) {
            bf16x8 a0 = lds_frag(BT, 16 * mt + fr, fq * 8, 72), a1 = lds_frag(BT, 16 * mt + fr, 32 + fq * 8, 72);
#pragma unroll
            for (int ntl = 0; ntl < 2; ++ntl) {
                f32x4 acc = {0.f, 0.f, 0.f, 0.f};
                acc = mfma16(a0, bx[ntl][0], acc); acc = mfma16(a1, bx[ntl][1], acc);
                { u32x2 w; w[0] = pk2(acc[0], acc[1]); w[1] = pk2(acc[2], acc[3]); *(u32x2*)(dst + (ph * 32 + ntl * 16 + fr) * 128 + 16 * mt + 4 * fq) = w; }
            }
        }
    }
    __syncthreads();
}

__device__ __forceinline__ void swa_prompt(lptr lds, const Ctx& X, int l, int task, int tid) {
    const int kvh = task & 1, qb = (task >> 1) & 63, n = task >> 7;
    const int lane = tid & 63, wave = tid >> 6, fr = lane & 15, fq = lane >> 4;
    const int seq0 = n * SEQ;
    lptr Kn = lds;
    lptr Vt = lds + 36864;
    lptr Pw = lds + 70656 + wave * 8448;
    const float* knw = XPAR(P_KNW) + l * 64; const float* qnw = XPAR(P_QNW) + l * 64;
#pragma unroll
    for (int it = 0; it < 2; ++it) {
        const int item = tid + it * NT, j = item >> 2, qd = item & 3, t = qb * 128 - 128 + j;
        float o1[8], o2[8];
        {
            const int tc = t >= 0 ? t : 0;
            const bf16_t* kr = XU + (unsigned)(seq0 + tc) * NIN + C_CK + kvh * 64;
            float x1[8], x2[8]; unpack8(*(const u32x4*)(kr + qd * 8), x1); unpack8(*(const u32x4*)(kr + 32 + qd * 8), x2);
            float ss = 0.f;
#pragma unroll
            for (int jj = 0; jj < 8; ++jj) ss += x1[jj] * x1[jj] + x2[jj] * x2[jj];
            ss += __shfl_xor(ss, 1); ss += __shfl_xor(ss, 2);
            const float rs = rsqrtf(ss * (1.f / 64.f) + EPS);
            const f32x4* cs = (const f32x4*)(XROPE + ((size_t)tc * 32 + qd * 8) * 2);
            f32x4 csv[4];
#pragma unroll
            for (int q4 = 0; q4 < 4; ++q4) csv[q4] = cs[q4];
            const float zm = t >= 0 ? 1.f : 0.f;
#pragma unroll
            for (int jj = 0; jj < 8; ++jj) {
                const float a = x1[jj] * rs * knw[qd * 8 + jj], b = x2[jj] * rs * knw[32 + qd * 8 + jj], co = csv[jj >> 1][(jj & 1) * 2], si = csv[jj >> 1][(jj & 1) * 2 + 1];
                o1[jj] = (a * co - b * si) * zm; o2[jj] = (b * co + a * si) * zm;
            }
        }
        *(LAS u32x4*)(Kn + ((j * 72 + qd * 8) << 1)) = pack8(o1);
        *(LAS u32x4*)(Kn + ((j * 72 + 32 + qd * 8) << 1)) = pack8(o2);
        if (qb == 63 && j >= 128) {
            float* ko = X.out + O_PK + ((((size_t)l * 2 + n) * 128 + (j - 128)) * 2 + kvh) * 64;
            *(f32x4*)(ko + qd * 8) = (f32x4){o1[0], o1[1], o1[2], o1[3]}; *(f32x4*)(ko + qd * 8 + 4) = (f32x4){o1[4], o1[5], o1[6], o1[7]};
            *(f32x4*)(ko + 32 + qd * 8) = (f32x4){o2[0], o2[1], o2[2], o2[3]}; *(f32x4*)(ko + 32 + qd * 8 + 4) = (f32x4){o2[4], o2[5], o2[6], o2[7]};
        }
    }
    if (wave < 4) {
        const int tg = tid & 31, cg = tid >> 5;
        u32x4 vb[8];
#pragma unroll
        for (int t8 = 0; t8 < 8; ++t8) {
            const int jk = 8 * tg + t8, t = qb * 128 - 128 + jk;
            u32x4 w = *(const u32x4*)(XU + (unsigned)(seq0 + (t >= 0 ? t : 0)) * NIN + C_CV + kvh * 64 + cg * 8);
            const unsigned msk = t >= 0 ? 0xffffffffu : 0u;
            vb[t8] = (u32x4){w[0] & msk, w[1] & msk, w[2] & msk, w[3] & msk};
        }
#pragma unroll
        for (int jj = 0; jj < 8; ++jj) {
            u32x4 w;
#pragma unroll
            for (int tp = 0; tp < 4; ++tp) {
                const unsigned lo = (vb[2 * tp][jj >> 1] >> ((jj & 1) * 16)) & 0xffffu, hi = (vb[2 * tp + 1][jj >> 1] >> ((jj & 1) * 16)) & 0xffffu;
                w[tp] = lo | (hi << 16);
            }
            *(LAS u32x4*)(Vt + (((cg * 8 + jj) * 264 + 8 * tg) << 1)) = w;
        }
        if (qb == 63 && tg >= 16) {
#pragma unroll
            for (int t8 = 0; t8 < 8; ++t8) {
                float x[8]; unpack8(vb[t8], x);
                float* vo = X.out + O_PV + ((((size_t)l * 2 + n) * 128 + (8 * tg + t8 - 128)) * 2 + kvh) * 64 + cg * 8;
                *(f32x4*)(vo) = (f32x4){x[0], x[1], x[2], x[3]}; *(f32x4*)(vo + 4) = (f32x4){x[4], x[5], x[6], x[7]};
            }
        }
    }
    __syncthreads();
    const int hq = kvh * 4 + (wave >> 1), i0 = (wave & 1) * 64;
    const float sink = XPAR(P_SINK)[l * 8 + hq];
    float qw1[8], qw2[8];
#pragma unroll
    for (int jj = 0; jj < 8; ++jj) { qw1[jj] = qnw[fq * 8 + jj]; qw2[jj] = qnw[32 + fq * 8 + jj]; }
    u32x4 qn0, qn1; f32x4 csn[4];
    {
        const int t = qb * 128 + i0 + fr;
        const bf16_t* qr = XU + (unsigned)(seq0 + t) * NIN + C_CQ + hq * 64;
        qn0 = *(const u32x4*)(qr + fq * 8); qn1 = *(const u32x4*)(qr + 32 + fq * 8);
        const f32x4* cs = (const f32x4*)(XROPE + ((size_t)t * 32 + fq * 8) * 2);
#pragma unroll
        for (int q4 = 0; q4 < 4; ++q4) csn[q4] = cs[q4];
    }
#pragma unroll 1
    for (int mt = 0; mt < 4; ++mt) {
        const int q0 = i0 + mt * 16;
        const u32x4 q0r = qn0, q1r = qn1; f32x4 csc[4];
#pragma unroll
        for (int q4 = 0; q4 < 4; ++q4) csc[q4] = csn[q4];
        {
            const int mn = mt < 3 ? mt + 1 : 3;
            const int t = qb * 128 + i0 + mn * 16 + fr;
            const bf16_t* qr = XU + (unsigned)(seq0 + t) * NIN + C_CQ + hq * 64;
            qn0 = *(const u32x4*)(qr + fq * 8); qn1 = *(const u32x4*)(qr + 32 + fq * 8);
            const f32x4* cs = (const f32x4*)(XROPE + ((size_t)t * 32 + fq * 8) * 2);
#pragma unroll
            for (int q4 = 0; q4 < 4; ++q4) csn[q4] = cs[q4];
        }
        bf16x8 a0, a1;
        {
            float x1[8], x2[8]; unpack8(q0r, x1); unpack8(q1r, x2);
            float ss = 0.f;
#pragma unroll
            for (int jj = 0; jj < 8; ++jj) ss += x1[jj] * x1[jj] + x2[jj] * x2[jj];
            ss += __shfl_xor(ss, 16); ss += __shfl_xor(ss, 32);
            const float rs = rsqrtf(ss * (1.f / 64.f) + EPS) * 0.125f;
            float o1[8], o2[8];
#pragma unroll
            for (int jj = 0; jj < 8; ++jj) {
                const float a = x1[jj] * rs * qw1[jj], b = x2[jj] * rs * qw2[jj], co = csc[jj >> 1][(jj & 1) * 2], si = csc[jj >> 1][(jj & 1) * 2 + 1];
                o1[jj] = a * co - b * si; o2[jj] = b * co + a * si;
            }
            a0 = as_frag(pack8(o1)); a1 = as_frag(pack8(o2));
        }
        const int tlo = q0 >> 4;
        const int qi = q0 + fr;
        const int dlo = qb > 0 ? 1 : (128 - qi > 1 ? 128 - qi : 1);
        f32x4 s[16];
        float mx = -3.0e38f;
#pragma unroll
        for (int ntl = 0; ntl < 16; ++ntl) {
            if (ntl >= tlo && ntl <= tlo + 8) {
                f32x4 acc = {0.f, 0.f, 0.f, 0.f};
                acc = mfma16(lds_frag(Kn, 16 * ntl + fr, fq * 8, 72), a0, acc);
                acc = mfma16(lds_frag(Kn, 16 * ntl + fr, 32 + fq * 8, 72), a1, acc);
                if (ntl == tlo || ntl == tlo + 8 || qb == 0) {
#pragma unroll
                    for (int ii = 0; ii < 4; ++ii) {
                        const int dk = 16 * ntl + 4 * fq + ii - qi;
                        acc[ii] = ((unsigned)(dk - dlo) <= (unsigned)(128 - dlo)) ? acc[ii] : -3.0e38f;
                    }
                }
                mx = fmaxf(mx, fmaxf(fmaxf(acc[0], acc[1]), fmaxf(acc[2], acc[3])));
                s[ntl] = acc;
            }
        }
        mx = fmaxf(mx, __shfl_xor(mx, 16)); mx = fmaxf(mx, __shfl_xor(mx, 32));
        mx = fmaxf(mx, sink);
        float sum = 0.f;
#pragma unroll
        for (int ntl = 0; ntl < 16; ++ntl) {
            if (ntl >= tlo && ntl <= tlo + 8) {
#pragma unroll
                for (int ii = 0; ii < 4; ++ii) { const float e = __expf(s[ntl][ii] - mx); s[ntl][ii] = e; sum += e; }
            }
        }
        sum += __shfl_xor(sum, 16); sum += __shfl_xor(sum, 32);
        const float inv = rcpf_(sum + __expf(sink - mx));
        const int klo = q0 >> 5, khi = (q0 + 143) >> 5;
#pragma unroll
        for (int ntl = 0; ntl < 16; ++ntl) {
            if (ntl >= tlo && ntl <= tlo + 8) {
                u32x2 w; w[0] = pk2(s[ntl][0] * inv, s[ntl][1] * inv); w[1] = pk2(s[ntl][2] * inv, s[ntl][3] * inv);
                *(LAS u32x2*)(Pw + ((fr * 264 + 16 * ntl + 4 * fq) << 1)) = w;
            } else if ((ntl >> 1) >= klo && (ntl >> 1) <= khi) {
                u32x2 w = {0u, 0u};
                *(LAS u32x2*)(Pw + ((fr * 264 + 16 * ntl + 4 * fq) << 1)) = w;
            }
        }
        u32x2 czv[4];
#pragma unroll
        for (int ntl = 0; ntl < 4; ++ntl) czv[ntl] = *(const u32x2*)(XU + ((unsigned)seq0 + qb * 128 + q0 + fr) * NIN + C_CZ + hq * 64 + 16 * ntl + 4 * fq);
        LDS_FENCE();
        f32x4 o[4];
#pragma unroll
        for (int ntl = 0; ntl < 4; ++ntl) o[ntl] = (f32x4){0.f, 0.f, 0.f, 0.f};
#pragma unroll
        for (int kk = 0; kk < 8; ++kk) {
            if (kk >= klo && kk <= khi) {
                const bf16x8 a = lds_frag(Pw, fr, kk * 32 + fq * 8, 264);
#pragma unroll
                for (int ntl = 0; ntl < 4; ++ntl) o[ntl] = mfma16(lds_frag(Vt, 16 * ntl + fr, kk * 32 + fq * 8, 264), a, o[ntl]);
            }
        }
        LDS_FENCE();
        {
            const unsigned row = (unsigned)seq0 + qb * 128 + q0 + fr;
#pragma unroll
            for (int ntl = 0; ntl < 4; ++ntl) {
                const float z0 = __uint_as_float(czv[ntl][0] << 16), z1 = __uint_as_float(czv[ntl][0] & 0xffff0000u), z2 = __uint_as_float(czv[ntl][1] << 16), z3 = __uint_as_float(czv[ntl][1] & 0xffff0000u);
                u32x2 w; w[0] = pk2(o[ntl][0] * siluf_(z0), o[ntl][1] * siluf_(z1)); w[1] = pk2(o[ntl][2] * siluf_(z2), o[ntl][3] * siluf_(z3));
                *(u32x2*)(XMIX + row * DMIX + 1024 + hq * 64 + 16 * ntl + 4 * fq) = w;
            }
        }
    }
    __syncthreads();
}

__device__ __forceinline__ void sample_task(lptr lds, const Ctx& X, int l, int b, int part, int tid) {
    LAS float* uf = (LAS float*)lds;
    LAS float* xbc = (LAS float*)(lds + 19968);
    LAS float* numv = (LAS float*)(lds + 24064);
    LAS float* yv = (LAS float*)(lds + 26112);
    LAS float* red = (LAS float*)(lds + 28160);
    LAS float* qs = (LAS float*)(lds + 28416);
    LAS float* kn = (LAS float*)(lds + 30464);
    LAS float* sc = (LAS float*)(lds + 30976);
    const int lane = tid & 63, wave = tid >> 6;
    const size_t row = (size_t)TP + b;
    const bf16_t* ur = XU + row * NIN;
    const size_t lb = (size_t)l * 128 + b;
    f32x4 kpre[8], vpre[8];
    if (part == 2) {
        const float* kc = X.ck + lb * 16384; const float* vc = X.cv + lb * 16384;
#pragma unroll
        for (int it = 0; it < 8; ++it) {
            const int e = (tid + it * NT) * 4, e2 = e < 127 * 128 ? e + 128 : e;
            kpre[it] = __builtin_nontemporal_load((const f32x4*)(kc + e2)); vpre[it] = __builtin_nontemporal_load((const f32x4*)(vc + e2));
        }
    }
    f32x4 spre[4][4];
    if (part == 0) {
#pragma unroll
        for (int h = 0; h < 4; ++h)
#pragma unroll
            for (int it = 0; it < 4; ++it) spre[h][it] = __builtin_nontemporal_load((const f32x4*)(X.stC + (lb * 4 + h) * 8192 + (tid + it * NT) * 4));
    }
    if (part == 1) {
#pragma unroll
        for (int h = 0; h < 4; ++h)
#pragma unroll
            for (int it = 0; it < 4; ++it) spre[h][it] = __builtin_nontemporal_load((const f32x4*)(X.ssm + (lb * 8 + h) * 8192 + (tid + it * NT) * 4));
    }
    {
        const int c_lo = part == 0 ? 0 : (part == 1 ? C_BZ : C_CQ), c_hi = part == 0 ? C_BZ : (part == 1 ? C_CQ : DIN);
        if (tid < ((c_hi - c_lo) >> 3)) {
            float f[8]; unpack8(*(const u32x4*)(ur + c_lo + 8 * tid), f);
#pragma unroll
            for (int j = 0; j < 8; ++j) uf[c_lo + 8 * tid + j] = f[j];
        }
    }
    __syncthreads();
    if (part == 0) {
#pragma unroll
    for (int h = 0; h < 4; ++h) {
        const float ig = uf[C_AI + h] + XPAR(P_AIB)[l * 4 + h], fg = uf[C_AF + h] + XPAR(P_AFB)[l * 4 + h];
        const float ls = logsigf_(fg), m0 = X.stM[lb * 4 + h];
        const float mn = fmaxf(ls + m0, ig), sp = __expf(ls + m0 - mn), sl = __expf(ig - mn);
        const float* C0 = X.stC + (lb * 4 + h) * 8192; float* C1 = X.out + O_SC + (lb * 4 + h) * 8192;
#pragma unroll
        for (int it = 0; it < 4; ++it) {
            const int e = (tid + it * NT) * 4, v = e >> 6, k = e & 63;
            const f32x4 c0 = spre[h][it];
            const float vv = uf[C_AV + h * 128 + v] * sl;
            f32x4 c1; float part = 0.f;
#pragma unroll
            for (int j = 0; j < 4; ++j) { c1[j] = sp * c0[j] + vv * (uf[C_AK + h * 64 + k + j] * 0.125f); part += c1[j] * uf[C_AQ + h * 64 + k + j]; }
            __builtin_nontemporal_store(c1, (f32x4*)(C1 + e));
            part = red16(part);
            if ((lane & 15) == 0) numv[h * 128 + v] = part;
        }
        if (wave == 0) {
            const float n1 = sp * X.stN[(lb * 4 + h) * 64 + lane] + sl * uf[C_AK + h * 64 + lane] * 0.125f;
            X.out[O_SN + (lb * 4 + h) * 64 + lane] = n1;
            const float dd = wave_sum(n1 * uf[C_AQ + h * 64 + lane]);
            if (lane == 0) { red[h] = dd; red[4 + h] = mn; X.out[O_SM + lb * 4 + h] = mn; }
        }
    }
    __syncthreads();
    float hv;
    { const int h = tid >> 7; hv = numv[tid] * rcpf_(fmaxf(fabsf(red[h]), __expf(-red[4 + h]))); const float ss = wave_sum(hv * hv); if (lane == 0) red[8 + wave] = ss; }
    __syncthreads();
    { const int h = tid >> 7; const float rs = rsqrtf((red[8 + 2 * h] + red[9 + 2 * h]) * (1.f / 128.f) + EPS);
      XMIX[row * DMIX + tid] = (bf16_t)f2bf(hv * rs * XPAR(P_ANW)[l * 512 + tid] * sigmoidf_(uf[C_AO + tid]) * siluf_(uf[C_AZ + tid])); }
    }
    if (part == 1) {
    {
        const float* buf = X.conv + lb * 3 * 1024; float* oc = X.out + O_SCONV + lb * 3 * 1024;
        const float* cw = XPAR(P_CW) + l * 4096;
#pragma unroll
        for (int it = 0; it < 2; ++it) {
            const int ch = tid + it * NT;
            const float f0 = buf[ch], f1 = buf[1024 + ch], f2 = buf[2048 + ch], f3 = uf[C_BX + ch];
            const float acc = XPAR(P_CB)[l * 1024 + ch] + f0 * cw[ch] + f1 * cw[1024 + ch] + f2 * cw[2048 + ch] + f3 * cw[3072 + ch];
            xbc[ch] = siluf_(acc);
            oc[ch] = f1; oc[1024 + ch] = f2; oc[2048 + ch] = f3;
        }
    }
    __syncthreads();
#pragma unroll 1
    for (int hb = 0; hb < 8; hb += 4)
#pragma unroll
    for (int hk = 0; hk < 4; ++hk) {
        const int hh = hb + hk;
        const float dt = softplusf_(uf[C_BDT + hh] + XPAR(P_DTB)[l * 8 + hh]);
        const float dA = __expf(-dt * __expf(XPAR(P_ALOG)[l * 8 + hh]));
        const int g = hh >> 2;
        const float* h0p = X.ssm + (lb * 8 + hh) * 8192; float* h1p = X.out + O_SH + (lb * 8 + hh) * 8192;
#pragma unroll
        for (int it = 0; it < 4; ++it) {
            const int e = (tid + it * NT) * 4, p = e >> 7, s = e & 127;
            f32x4 h0; if (hb == 0) h0 = spre[hk][it]; else h0 = __builtin_nontemporal_load((const f32x4*)(h0p + e));
            const float xv = xbc[hh * 64 + p] * dt;
            f32x4 h1; float part = 0.f;
#pragma unroll
            for (int j = 0; j < 4; ++j) { h1[j] = dA * h0[j] + xv * xbc[512 + g * 128 + s + j]; part += h1[j] * xbc[768 + g * 128 + s + j]; }
            __builtin_nontemporal_store(h1, (f32x4*)(h1p + e));
            part = red16(part); part += __shfl_xor(part, 16);
            if ((lane & 31) == 0) yv[hh * 64 + p] = part;
        }
    }
    __syncthreads();
    float gb;
    { const int hh = tid >> 6; const float y = yv[tid] + XPAR(P_BD)[l * 8 + hh] * xbc[tid]; gb = y * siluf_(uf[C_BZ + tid]); const float ss = wave_sum(gb * gb); if (lane == 0) red[16 + wave] = ss; }
    __syncthreads();
    { const int g = tid >> 8; const float rs = rsqrtf((red[16 + 4 * g] + red[17 + 4 * g] + red[18 + 4 * g] + red[19 + 4 * g]) * (1.f / 256.f) + EPS);
      XMIX[row * DMIX + 512 + tid] = (bf16_t)f2bf(gb * rs * XPAR(P_BNW)[l * 512 + tid]); }
    }
    if (part == 2) {
    lptr Kl = lds + 36864;
    lptr Vl = lds + 36864 + 34816;
    if (tid < 320) {
        const int vec = tid >> 5, d = tid & 31, base = vec < 8 ? C_CQ + vec * 64 : C_CK + (vec - 8) * 64;
        const float x1 = uf[base + d], x2 = uf[base + 32 + d];
        float ss = x1 * x1 + x2 * x2; ss = red16(ss); ss += __shfl_xor(ss, 16);
        const float rs = rsqrtf(ss * (1.f / 64.f) + EPS);
        const float* w = vec < 8 ? XPAR(P_QNW) + l * 64 : XPAR(P_KNW) + l * 64;
        const float a = x1 * rs * w[d], bb = x2 * rs * w[d + 32];
        const float co = XROPE[((size_t)8192 * 32 + d) * 2], si = XROPE[((size_t)8192 * 32 + d) * 2 + 1];
        const float o1 = a * co - bb * si, o2 = bb * co + a * si;
        if (vec < 8) { qs[vec * 64 + d] = o1 * 0.125f; qs[vec * 64 + 32 + d] = o2 * 0.125f; } else { kn[(vec - 8) * 64 + d] = o1; kn[(vec - 8) * 64 + 32 + d] = o2; }
    }
    __syncthreads();
    {
        float* ko = X.out + O_SK + lb * 16384; float* vo = X.out + O_SV + lb * 16384;
#pragma unroll
        for (int it = 0; it < 8; ++it) {
            const int e = (tid + it * NT) * 4, j = e >> 7, r = e & 127;
            f32x4 kv = kpre[it], vv = vpre[it];
            if (j == 127) { kv = (f32x4){kn[r], kn[r + 1], kn[r + 2], kn[r + 3]}; vv = (f32x4){uf[C_CV + r], uf[C_CV + r + 1], uf[C_CV + r + 2], uf[C_CV + r + 3]}; }
            __builtin_nontemporal_store(kv, (f32x4*)(ko + e)); __builtin_nontemporal_store(vv, (f32x4*)(vo + e));
            u32x2 wk, wv2; wk[0] = pk2(kv[0], kv[1]); wk[1] = pk2(kv[2], kv[3]); wv2[0] = pk2(vv[0], vv[1]); wv2[1] = pk2(vv[2], vv[3]);
            *(LAS u32x2*)(Kl + ((j * 136 + r) << 1)) = wk; *(LAS u32x2*)(Vl + ((j * 136 + r) << 1)) = wv2;
        }
    }
    __syncthreads();
    if (tid < 256) {
        const int kvh = tid >> 7, jj = tid & 127;
        float s0 = 0.f, s1 = 0.f, s2 = 0.f, s3 = 0.f;
#pragma unroll 2
        for (int d8 = 0; d8 < 8; ++d8) {
            float kf[8]; unpack8(*(const LAS u32x4*)(Kl + ((jj * 136 + kvh * 64 + d8 * 8) << 1)), kf);
#pragma unroll
            for (int j = 0; j < 8; ++j) {
                s0 += kf[j] * qs[(kvh * 4 + 0) * 64 + d8 * 8 + j]; s1 += kf[j] * qs[(kvh * 4 + 1) * 64 + d8 * 8 + j];
                s2 += kf[j] * qs[(kvh * 4 + 2) * 64 + d8 * 8 + j]; s3 += kf[j] * qs[(kvh * 4 + 3) * 64 + d8 * 8 + j];
            }
        }
        sc[(kvh * 4 + 0) * 128 + jj] = s0; sc[(kvh * 4 + 1) * 128 + jj] = s1; sc[(kvh * 4 + 2) * 128 + jj] = s2; sc[(kvh * 4 + 3) * 128 + jj] = s3;
    }
    __syncthreads();
    {
        const int hq = wave; const float s0 = sc[hq * 128 + lane], s1 = sc[hq * 128 + 64 + lane], sink = XPAR(P_SINK)[l * 8 + hq];
        const float m = fmaxf(wave_max(fmaxf(s0, s1)), sink);
        const float e0 = __expf(s0 - m), e1 = __expf(s1 - m);
        const float inv = rcpf_(wave_sum(e0 + e1) + __expf(sink - m));
        sc[hq * 128 + lane] = e0 * inv; sc[hq * 128 + 64 + lane] = e1 * inv;
    }
    __syncthreads();
    {
        const int hq = tid >> 6, d = tid & 63, kvh = hq >> 2;
        float o = 0.f;
#pragma unroll 16
        for (int jj = 0; jj < 128; ++jj) o += sc[hq * 128 + jj] * bf2f(*(const LAS bf16_t*)(Vl + ((jj * 136 + kvh * 64 + d) << 1)));
        XMIX[row * DMIX + 1024 + tid] = (bf16_t)f2bf(o * siluf_(uf[C_CZ + tid]));
    }
    }
    __syncthreads();
}

__device__ __forceinline__ void scans(const Ctx& X, int l, int gt, int nthreads) {
    for (int item = gt; item < 98816; item += nthreads) {
        if (item < 32768) {
            const int nh = item >> 12, e = (item & 4095) * 2;
            const bf16_t* base = (const bf16_t*)XMC + (size_t)nh * 128 * 8192 + e;
            const float* ml = XML + nh * 128; const float* bl = XBL + nh * 128;
            float m = 0.f; f32x2 st = {0.f, 0.f};
            for (int c0 = 0; c0 < 128; c0 += 16) {
                f32x2 cl[16];
#pragma unroll
                for (int j = 0; j < 16; ++j) { const unsigned w = *(const unsigned*)(base + (size_t)(c0 + j) * 8192); cl[j] = (f32x2){__uint_as_float(w << 16), __uint_as_float(w & 0xffff0000u)}; }
#pragma unroll
                for (int j = 0; j < 16; ++j) {
                    const float mlj = ml[c0 + j], blj = bl[c0 + j], mn = fmaxf(blj + m, mlj), sp = __expf(blj + m - mn), sl = __expf(mlj - mn);
                    *(unsigned*)(XCSB + ((size_t)nh * 128 + c0 + j) * 8192 + e) = pk2(st[0], st[1]);
                    if (e == 0) XMS[nh * 128 + c0 + j] = m;
                    st = st * sp + cl[j] * sl; m = mn;
                }
            }
            *(f32x2*)(X.out + O_PC + ((size_t)l * 8 + nh) * 8192 + e) = st;
            if (e == 0) X.out[O_PM + l * 8 + nh] = m;
        } else if (item < 98304) {
            const int i1 = item - 32768, nhh = i1 >> 12, e = (i1 & 4095) * 2;
            const bf16_t* base = (const bf16_t*)XSH + (size_t)nhh * 128 * 8192 + e;
            const float* al = XSA + nhh * 128;
            f32x2 st = {0.f, 0.f};
            for (int c0 = 0; c0 < 128; c0 += 16) {
                f32x2 cl[16];
#pragma unroll
                for (int j = 0; j < 16; ++j) { const unsigned w = *(const unsigned*)(base + (size_t)(c0 + j) * 8192); cl[j] = (f32x2){__uint_as_float(w << 16), __uint_as_float(w & 0xffff0000u)}; }
#pragma unroll
                for (int j = 0; j < 16; ++j) {
                    const float dec = __expf(al[c0 + j]);
                    *(unsigned*)(XHSB + ((size_t)nhh * 128 + c0 + j) * 8192 + e) = pk2(st[0], st[1]);
                    st = st * dec + cl[j];
                }
            }
            *(f32x2*)(X.out + O_PH + ((size_t)l * 16 + nhh) * 8192 + e) = st;
        } else {
            const int i2 = item - 98304, nh = i2 >> 6, k = i2 & 63;
            float* base = XMN + (size_t)nh * 128 * 64 + k;
            const float* ml = XML + nh * 128; const float* bl = XBL + nh * 128;
            float m = 0.f, st = 0.f;
            for (int c = 0; c < 128; ++c) {
                const float mlj = ml[c], blj = bl[c], mn = fmaxf(blj + m, mlj), sp = __expf(blj + m - mn), sl = __expf(mlj - mn);
                const float cl = base[c * 64];
                XNS[(size_t)nh * 128 * 64 + c * 64 + k] = st;
                st = st * sp + cl * sl; m = mn;
            }
            X.out[O_PN + ((size_t)l * 8 + nh) * 64 + k] = st;
        }
    }
}

__device__ __forceinline__ void mlstm_out(lptr lds, const Ctx& X, int l, int task, int tid) {
    const int h = task & 3, c = (task >> 2) & 127, n = task >> 9;
    const int lane = tid & 63, wave = tid >> 6, fr = lane & 15, fq = lane >> 4;
    const int row0 = n * SEQ + c * 64, nh = n * 4 + h;
    lptr Qs = lds;
    lptr Ks = lds + 9216;
    lptr Vt = lds + 18432;
    lptr Sb = lds + 36864 + wave * 2304;
    LAS float* bv = (LAS float*)(lds + 55296);
    LAS float* dv = bv + 64;
    LAS float* mtv = bv + 128;
    LAS float* siv = bv + 192;
    LAS float* qnv = bv + 256;
    LAS float* ssqp = bv + 384;
    LAS float* nsv = bv + 512;
    const int mti = wave >> 1, half = wave & 1;
    u32x4 csf[2][4];
    {
        const bf16_t* Cs = XCSB + ((size_t)nh * 128 + c) * 8192;
#pragma unroll
        for (int kk = 0; kk < 2; ++kk)
#pragma unroll
            for (int ntl = 0; ntl < 4; ++ntl) csf[kk][ntl] = *(const u32x4*)(Cs + (64 * half + 16 * ntl + fr) * 64 + kk * 32 + fq * 8);
    }
    u32x2 aov[4], azv[4]; f32x4 anw[4];
#pragma unroll
    for (int ntl = 0; ntl < 4; ++ntl) {
        const int v = h * 128 + 64 * half + 16 * ntl + 4 * fq;
        const unsigned row = (unsigned)row0 + 16 * mti + fr;
        anw[ntl] = *(const f32x4*)(XPAR(P_ANW) + l * 512 + v);
        aov[ntl] = *(const u32x2*)(XU + row * NIN + C_AO + v); azv[ntl] = *(const u32x2*)(XU + row * NIN + C_AZ + v);
    }
    u32x4 qraw, kraw, vblk[8];
    const int tgv = lane & 7, cgv = (wave & 1) * 8 + (lane >> 3);
    {
        const int tok = tid >> 3, k8 = (tid & 7) * 8;
        const bf16_t* ur = XU + (unsigned)(row0 + tok) * NIN;
        qraw = *(const u32x4*)(ur + C_AQ + h * 64 + k8); kraw = *(const u32x4*)(ur + C_AK + h * 64 + k8);
        if (wave == 2 || wave == 3) {
#pragma unroll
            for (int t = 0; t < 8; ++t) vblk[t] = *(const u32x4*)(XU + (unsigned)(row0 + 8 * tgv + t) * NIN + C_AV + h * 128 + cgv * 8);
        }
    }
    if (wave == 0) {
        const bf16_t* ur = XU + (unsigned)(row0 + lane) * NIN;
        const float fg = bf2f(ur[C_AF + h]) + XPAR(P_AFB)[l * 4 + h], ig = bf2f(ur[C_AI + h]) + XPAR(P_AIB)[l * 4 + h];
        const float b = wave_scan_sum(logsigf_(fg), lane);
        const float dd = ig - b;
        const float cm = wave_scan_max(dd, lane);
        const float ms = XMS[nh * 128 + c];
        const float mt = b + fmaxf(ms, cm);
        bv[lane] = b; dv[lane] = dd; mtv[lane] = mt; siv[lane] = __expf(b + ms - mt);
        nsv[lane] = XNS[((size_t)nh * 128 + c) * 64 + lane];
    }
    {
        const int tok = tid >> 3, k8 = (tid & 7) * 8;
        *(LAS u32x4*)(Qs + ((tok * 72 + k8) << 1)) = qraw;
        float x[8]; unpack8(kraw, x);
#pragma unroll
        for (int j = 0; j < 8; ++j) x[j] *= 0.125f;
        *(LAS u32x4*)(Ks + ((tok * 72 + k8) << 1)) = pack8(x);
    }
    if (wave == 2 || wave == 3) {
#pragma unroll
        for (int j = 0; j < 8; ++j) {
            u32x4 w;
#pragma unroll
            for (int tp = 0; tp < 4; ++tp) {
                const unsigned lo = (vblk[2 * tp][j >> 1] >> ((j & 1) * 16)) & 0xffffu, hi = (vblk[2 * tp + 1][j >> 1] >> ((j & 1) * 16)) & 0xffffu;
                w[tp] = lo | (hi << 16);
            }
            *(LAS u32x4*)(Vt + (((cgv * 8 + j) * 72 + 8 * tgv) << 1)) = w;
        }
    }
    __syncthreads();
    bf16x8 qa[2];
    qa[0] = lds_frag(Qs, 16 * mti + fr, fq * 8, 72); qa[1] = lds_frag(Qs, 16 * mti + fr, 32 + fq * 8, 72);
    const int tq = 16 * mti + fr;
    float qn;
    {
        float x0[8], x1[8]; unpack8(__builtin_bit_cast(u32x4, qa[0]), x0); unpack8(__builtin_bit_cast(u32x4, qa[1]), x1);
        float d = 0.f;
#pragma unroll
        for (int j = 0; j < 8; ++j) d += x0[j] * nsv[fq * 8 + j] + x1[j] * nsv[32 + fq * 8 + j];
        d += __shfl_xor(d, 16); d += __shfl_xor(d, 32);
        qn = d;
    }
    const float bt = bv[tq], mtq = mtv[tq], siq = siv[tq];
    float rsum = 0.f;
#pragma unroll
    for (int ntl = 0; ntl < 4; ++ntl) {
        f32x4 sT = {0.f, 0.f, 0.f, 0.f};
        sT = mfma16(lds_frag(Ks, 16 * ntl + fr, fq * 8, 72), qa[0], sT);
        sT = mfma16(lds_frag(Ks, 16 * ntl + fr, 32 + fq * 8, 72), qa[1], sT);
        float sv[4];
#pragma unroll
        for (int ii = 0; ii < 4; ++ii) {
            const int sidx = 16 * ntl + 4 * fq + ii;
            const float wgt = (sidx <= tq) ? __expf(bt + dv[sidx] - mtq) : 0.f;
            sv[ii] = wgt * sT[ii];
            rsum += sv[ii];
        }
        u32x2 w; w[0] = pk2(sv[0], sv[1]); w[1] = pk2(sv[2], sv[3]);
        *(LAS u32x2*)(Sb + ((fr * 72 + 16 * ntl + 4 * fq) << 1)) = w;
    }
    rsum += __shfl_xor(rsum, 16); rsum += __shfl_xor(rsum, 32);
    const float inv = rcpf_(fmaxf(fabsf(rsum + siq * qn), __expf(-mtq)));
    LDS_FENCE();
    f32x4 acc[4];
#pragma unroll
    for (int ntl = 0; ntl < 4; ++ntl) acc[ntl] = (f32x4){0.f, 0.f, 0.f, 0.f};
#pragma unroll
    for (int kk = 0; kk < 2; ++kk) {
        const bf16x8 sb = lds_frag(Sb, fr, kk * 32 + fq * 8, 72);
#pragma unroll
        for (int ntl = 0; ntl < 4; ++ntl) acc[ntl] = mfma16(lds_frag(Vt, 64 * half + 16 * ntl + fr, kk * 32 + fq * 8, 72), sb, acc[ntl]);
    }
#pragma unroll
    for (int kk = 0; kk < 2; ++kk) {
        float x[8]; unpack8(__builtin_bit_cast(u32x4, qa[kk]), x);
#pragma unroll
        for (int j = 0; j < 8; ++j) x[j] *= siq;
        const bf16x8 qs = as_frag(pack8(x));
#pragma unroll
        for (int ntl = 0; ntl < 4; ++ntl) acc[ntl] = mfma16(as_frag(csf[kk][ntl]), qs, acc[ntl]);
    }
    {
        float ss = 0.f;
#pragma unroll
        for (int ntl = 0; ntl < 4; ++ntl) { acc[ntl] = acc[ntl] * inv; ss += acc[ntl][0] * acc[ntl][0] + acc[ntl][1] * acc[ntl][1] + acc[ntl][2] * acc[ntl][2] + acc[ntl][3] * acc[ntl][3]; }
        ss += __shfl_xor(ss, 16); ss += __shfl_xor(ss, 32);
        if (fq == 0) ssqp[tq * 2 + half] = ss;
    }
    __syncthreads();
    {
        const float rs = rsqrtf((ssqp[tq * 2] + ssqp[tq * 2 + 1]) * (1.f / 128.f) + EPS);
        const unsigned row = (unsigned)row0 + tq;
#pragma unroll
        for (int ntl = 0; ntl < 4; ++ntl) {
            const float o[4] = {__uint_as_float(aov[ntl][0] << 16), __uint_as_float(aov[ntl][0] & 0xffff0000u), __uint_as_float(aov[ntl][1] << 16), __uint_as_float(aov[ntl][1] & 0xffff0000u)};
            const float z[4] = {__uint_as_float(azv[ntl][0] << 16), __uint_as_float(azv[ntl][0] & 0xffff0000u), __uint_as_float(azv[ntl][1] << 16), __uint_as_float(azv[ntl][1] & 0xffff0000u)};
            float y[4];
#pragma unroll
            for (int ii = 0; ii < 4; ++ii) y[ii] = acc[ntl][ii] * rs * anw[ntl][ii] * sigmoidf_(o[ii]) * siluf_(z[ii]);
            u32x2 w; w[0] = pk2(y[0], y[1]); w[1] = pk2(y[2], y[3]);
            *(u32x2*)(XMIX + row * DMIX + h * 128 + 64 * half + 16 * ntl + 4 * fq) = w;
        }
    }
    __syncthreads();
}

__device__ __forceinline__ void ssd_out(lptr lds, const Ctx& X, int l, int task, int tid) {
    const int g = task & 1, c = (task >> 1) & 127, n = task >> 8;
    const int lane = tid & 63, wave = tid >> 6, fr = lane & 15, fq = lane >> 4;
    const int seq0 = n * SEQ, row0 = seq0 + c * 64;
    lptr Cm = lds;
    lptr Bm = lds + 17408;
    lptr Xt = lds + 34816;
    LAS float* CBf = (LAS float*)(lds + 71680);
    LAS float* av = (LAS float*)(lds + 89088);
    LAS float* dtv = (LAS float*)(lds + 90112);
    LAS float* ssq = (LAS float*)(lds + 91136);
    const int hl = wave >> 1, th = wave & 1, hh = 4 * g + hl;
    u32x4 hsf[4][4];
    {
        const bf16_t* hs = XHSB + ((size_t)(n * 8 + hh) * 128 + c) * 8192;
#pragma unroll
        for (int kk = 0; kk < 4; ++kk)
#pragma unroll
            for (int ntl = 0; ntl < 4; ++ntl) hsf[kk][ntl] = *(const u32x4*)(hs + (16 * ntl + fr) * 128 + kk * 32 + fq * 8);
    }
    if (wave < 4) {
        const int hh = 4 * g + wave;
        const float dt = softplusf_(bf2f(XU[(unsigned)(row0 + lane) * NIN + C_BDT + hh]) + XPAR(P_DTB)[l * 8 + hh]);
        const float A = -__expf(XPAR(P_ALOG)[l * 8 + hh]);
        av[wave * 64 + lane] = wave_scan_sum(dt * A, lane);
        dtv[wave * 64 + lane] = dt;
    }
    {
        const float* cw = XPAR(P_CW) + l * 4096; const float* cb = XPAR(P_CB) + l * 1024;
        float o[8][8];
        if (wave < 4) {
            const int tg = lane & 7, cg = wave * 8 + (lane >> 3);
            conv8x8(XU, seq0, c * 64 + 8 * tg, g * 256 + cg * 8, cw, cb, o);
#pragma unroll
            for (int jx = 0; jx < 8; ++jx) {
                float v[8];
#pragma unroll
                for (int t = 0; t < 8; ++t) v[t] = o[t][jx];
                *(LAS u32x4*)(Xt + (((cg * 8 + jx) * 72 + 8 * tg) << 1)) = pack8(v);
            }
        } else {
            const int tg = lane >> 3, s8 = ((wave & 1) * 8 + (lane & 7)) * 8;
            conv8x8(XU, seq0, c * 64 + 8 * tg, (wave < 6 ? 512 : 768) + g * 128 + s8, cw, cb, o);
            lptr dstm = wave < 6 ? Bm : Cm;
#pragma unroll
            for (int t = 0; t < 8; ++t) *(LAS u32x4*)(dstm + (((8 * tg + t) * 136 + s8) << 1)) = pack8(o[t]);
        }
    }
    __syncthreads();
    u32x2 bzv[2][4]; f32x4 bnw[4];
#pragma unroll
    for (int ntl = 0; ntl < 4; ++ntl) {
        bnw[ntl] = *(const f32x4*)(XPAR(P_BNW) + l * 512 + hh * 64 + 16 * ntl + 4 * fq);
#pragma unroll
        for (int mi = 0; mi < 2; ++mi) bzv[mi][ntl] = *(const u32x2*)(XU + ((unsigned)row0 + 16 * (2 * th + mi) + fr) * NIN + C_BZ + hh * 64 + 16 * ntl + 4 * fq);
    }
    {
        const int mt = wave >> 1;
#pragma unroll
        for (int q = 0; q < 2; ++q) {
            const int ntl = 2 * (wave & 1) + q;
            f32x4 acc = {0.f, 0.f, 0.f, 0.f};
#pragma unroll
            for (int kk = 0; kk < 4; ++kk) acc = mfma16(lds_frag(Cm, 16 * mt + fr, kk * 32 + fq * 8, 136), lds_frag(Bm, 16 * ntl + fr, kk * 32 + fq * 8, 136), acc);
#pragma unroll
            for (int ii = 0; ii < 4; ++ii) CBf[(16 * mt + fq * 4 + ii) * 68 + 16 * ntl + fr] = acc[ii];
        }
    }
    __syncthreads();
    f32x4 y1[2][4], y2[2][4];
#pragma unroll
    for (int mi = 0; mi < 2; ++mi)
#pragma unroll
        for (int ntl = 0; ntl < 4; ++ntl) { y1[mi][ntl] = (f32x4){0.f, 0.f, 0.f, 0.f}; y2[mi][ntl] = (f32x4){0.f, 0.f, 0.f, 0.f}; }
#pragma unroll
    for (int kk = 0; kk < 2; ++kk) {
        bf16x8 bx[4];
#pragma unroll
        for (int ntl = 0; ntl < 4; ++ntl) bx[ntl] = lds_frag(Xt, hl * 64 + 16 * ntl + fr, kk * 32 + fq * 8, 72);
#pragma unroll
        for (int mi = 0; mi < 2; ++mi) {
            const int t = 16 * (2 * th + mi) + fr, u0 = kk * 32 + fq * 8;
            const float at = av[hl * 64 + t];
            float w[8];
#pragma unroll
            for (int j = 0; j < 8; ++j) {
                const int uu = u0 + j;
                w[j] = (uu <= t) ? CBf[t * 68 + uu] * __expf(at - av[hl * 64 + uu]) * dtv[hl * 64 + uu] : 0.f;
            }
            const bf16x8 a = as_frag(pack8(w));
#pragma unroll
            for (int ntl = 0; ntl < 4; ++ntl) y1[mi][ntl] = mfma16(bx[ntl], a, y1[mi][ntl]);
        }
    }
    {
#pragma unroll
        for (int kk = 0; kk < 4; ++kk) {
            bf16x8 bh[4];
#pragma unroll
            for (int ntl = 0; ntl < 4; ++ntl) bh[ntl] = as_frag(hsf[kk][ntl]);
#pragma unroll
            for (int mi = 0; mi < 2; ++mi) {
                const bf16x8 a = lds_frag(Cm, 16 * (2 * th + mi) + fr, kk * 32 + fq * 8, 136);
#pragma unroll
                for (int ntl = 0; ntl < 4; ++ntl) y2[mi][ntl] = mfma16(bh[ntl], a, y2[mi][ntl]);
            }
        }
    }
    const float Dh = XPAR(P_BD)[l * 8 + hh];
#pragma unroll
    for (int mi = 0; mi < 2; ++mi) {
        const int t = 16 * (2 * th + mi) + fr;
        const float ea = __expf(av[hl * 64 + t]);
        float ss = 0.f;
#pragma unroll
        for (int ntl = 0; ntl < 4; ++ntl) {
            const float z[4] = {__uint_as_float(bzv[mi][ntl][0] << 16), __uint_as_float(bzv[mi][ntl][0] & 0xffff0000u), __uint_as_float(bzv[mi][ntl][1] << 16), __uint_as_float(bzv[mi][ntl][1] & 0xffff0000u)};
#pragma unroll
            for (int ii = 0; ii < 4; ++ii) {
                const int p = 16 * ntl + 4 * fq + ii;
                const float xv = bf2f(*(const LAS bf16_t*)(Xt + (((hl * 64 + p) * 72 + t) << 1)));
                const float y = y1[mi][ntl][ii] + ea * y2[mi][ntl][ii] + Dh * xv;
                const float gbv = y * siluf_(z[ii]);
                y1[mi][ntl][ii] = gbv; ss += gbv * gbv;
            }
        }
        ss += __shfl_xor(ss, 16); ss += __shfl_xor(ss, 32);
        if (fq == 0) ssq[t * 4 + hl] = ss;
    }
    __syncthreads();
#pragma unroll
    for (int mi = 0; mi < 2; ++mi) {
        const int t = 16 * (2 * th + mi) + fr;
        const float rs = rsqrtf((ssq[t * 4] + ssq[t * 4 + 1] + ssq[t * 4 + 2] + ssq[t * 4 + 3]) * (1.f / 256.f) + EPS);
        const unsigned row = (unsigned)row0 + t;
#pragma unroll
        for (int ntl = 0; ntl < 4; ++ntl) {
            u32x2 w; w[0] = pk2(y1[mi][ntl][0] * rs * bnw[ntl][0], y1[mi][ntl][1] * rs * bnw[ntl][1]); w[1] = pk2(y1[mi][ntl][2] * rs * bnw[ntl][2], y1[mi][ntl][3] * rs * bnw[ntl][3]);
            *(u32x2*)(XMIX + row * DMIX + 512 + hh * 64 + 16 * ntl + 4 * fq) = w;
        }
    }
    __syncthreads();
}


#define XB_TMO      128
#define XB_XCNT(j)  (256  + 64 * (j))
#define XB_XSUB(j)  (1280 + 64 * (j))
#define XB_XGEN(j)  (2304 + 64 * (j))
#define XB_TOP      3328
#define XB_TOPGEN   3392
#define XCD_BAR_WORDS 3456
#define XB_SPIN_CAP (1u << 18)
__device__ __forceinline__ unsigned xb_ld(unsigned* p)              { return __hip_atomic_load(p, __ATOMIC_RELAXED, __HIP_MEMORY_SCOPE_AGENT); }
__device__ __forceinline__ unsigned xb_add(unsigned* p, unsigned v) { return __hip_atomic_fetch_add(p, v, __ATOMIC_RELAXED, __HIP_MEMORY_SCOPE_AGENT); }
__device__ __forceinline__ unsigned xb_xcc_id() { return (unsigned)__builtin_amdgcn_s_getreg((3 << 11) | 20) & 0xFu; }
#define XB_SPIN(cond, bar) do { unsigned _sp = 0; while (cond) { __builtin_amdgcn_s_sleep(1); \
    if ((++_sp & 255u) == 0u) { if (xb_ld(&(bar)[XB_TMO])) break; if (_sp > XB_SPIN_CAP) { atomicAdd(&(bar)[XB_TMO], 1u); break; } } } } while (0)
struct XcdBarrier { unsigned* bar; unsigned x; volatile LAS unsigned* st; };
__device__ __forceinline__ XcdBarrier xcd_barrier_post(unsigned* bar, volatile LAS unsigned* st) {
    XcdBarrier b; b.bar = bar; b.x = xb_xcc_id(); b.st = st;
    if (threadIdx.x == 0) (void)xb_add(&bar[XB_XCNT(b.x)], 1u);
    return b;
}
__device__ __forceinline__ void xcd_barrier_complete(unsigned* bar, unsigned x, unsigned& nloc, unsigned& nx) {
    const unsigned G = gridDim.x * gridDim.y * gridDim.z;
    unsigned sum, cnt, mine, sp = 0u;
    for (;;) {
        sum = 0u; cnt = 0u; mine = 0u;
#pragma unroll
        for (unsigned j = 0; j < 16; ++j) { const unsigned c = xb_ld(&bar[XB_XCNT(j)]); sum += c; cnt += (c > 0u) ? 1u : 0u; mine = (j == x) ? c : mine; }
        if (sum == G) break;
        __builtin_amdgcn_s_sleep(1);
        if ((++sp & 255u) == 0u) { if (xb_ld(&bar[XB_TMO])) break; if (sp > XB_SPIN_CAP) { atomicAdd(&bar[XB_TMO], 1u); break; } }
    }
    nloc = mine > 0u ? mine : 1u; nx = cnt > 0u ? cnt : 1u;
}
__device__ __forceinline__ void xcd_barrier(const XcdBarrier& b) {
    asm volatile("s_waitcnt vmcnt(0)" ::: "memory");
    __syncthreads();
    if (threadIdx.x == 0) {
        unsigned* bar = b.bar;
        __builtin_amdgcn_s_waitcnt(0);
        unsigned nloc = b.st[0], nx = b.st[1];
        if (nloc == 0u) { xcd_barrier_complete(bar, b.x, nloc, nx); b.st[0] = nloc; b.st[1] = nx; }
        const unsigned old = xb_add(&bar[XB_XSUB(b.x)], 1u);
        const unsigned gen = old / nloc;
        if (old + 1u == (gen + 1u) * nloc) {
            __builtin_amdgcn_fence(__ATOMIC_RELEASE, "agent");
            asm volatile("s_waitcnt vmcnt(0)" ::: "memory");
            const unsigned og = xb_add(&bar[XB_TOP], 1u);
            const unsigned tg = og / nx;
            if (og + 1u == (tg + 1u) * nx) xb_add(&bar[XB_TOPGEN], 1u);
            else XB_SPIN(xb_ld(&bar[XB_TOPGEN]) == tg, bar);
            __builtin_amdgcn_fence(__ATOMIC_ACQUIRE, "agent");
            xb_add(&bar[XB_XGEN(b.x)], 1u);
            asm volatile("s_waitcnt vmcnt(0)" ::: "memory");
        } else {
            XB_SPIN(xb_ld(&bar[XB_XGEN(b.x)]) == gen, bar);
            __builtin_amdgcn_fence(__ATOMIC_ACQUIRE, "agent");
            asm volatile("s_waitcnt vmcnt(0)" ::: "memory");
        }
    }
    __syncthreads();
}

__global__ void __launch_bounds__(NT, 2) mega(Args args) {
    __shared__ __attribute__((aligned(16))) unsigned char lds_raw[LDS_BYTES];
    lptr lds = (lptr)lds_raw;
    cg::grid_group grid = cg::this_grid();
    const int tid = threadIdx.x, bid = blockIdx.x, G = gridDim.x;
    Ctx X;
    X.xp = args.in[IN_XP]; X.xs = args.in[IN_XS]; X.stC = args.in[IN_STC]; X.stN = args.in[IN_STN]; X.stM = args.in[IN_STM]; X.ssm = args.in[IN_SSM];
    X.conv = args.in[IN_CONV]; X.ck = args.in[IN_CK]; X.cv = args.in[IN_CV]; X.out = args.out; X.ws = args.ws;
    const int lo = args.ph_lo, hi = args.ph_hi;
    volatile LAS unsigned* xst = (volatile LAS unsigned*)(lds + LDS_BYTES - 16);
    if (tid == 0) { xst[0] = 0u; xst[1] = 0u; }
    __syncthreads();
    XcdBarrier xbar = xcd_barrier_post((unsigned*)(args.ws + WS_BAR), xst);
#define IN(k) (lo <= (k) && (k) < hi)
#define SEAM(k) do { if (IN(k) && IN((k) + 1)) { for (int _r = 0; _r < REP_SYNC; ++_r) { if (lo < 0) grid.sync(); xcd_barrier(xbar); } } } while (0)
    if (IN(0)) { for (int _r = 0; _r < REP_P0; ++_r) prologue(lds, X, args, G, bid, tid); }
    SEAM(0);
    for (int l = 0; l < 4; ++l) {
        const int pb = 1 + l * 5;
        if (IN(pb)) for (int _r = 0; _r < REP_P1; ++_r) {
            pg8::Gemm g{XXB, XWIN + (size_t)l * NIN * D, MPAD, NIN, D}; pg8::StaticOrder S; S.init(TP, NIN, G, bid);
            pg8::EpiU E{XU, XSSQ};
            pg8::gemm_phase<pg8::EpiU, pg8::StaticOrder, false, GEMM_SP2, GEMM_ALIGN>(lds, g, S, E, OPQ(tid));
            if (l == 0 && bid >= G - 20) {
                pg8::SampleOrder S2{G - 20, 20, bid}; pg8::EpiUh E2{XU, XSSQ};
                pg8::gemm_phase<pg8::EpiUh, pg8::SampleOrder, true>(lds, g, S2, E2, OPQ(tid));
            }
        }
        SEAM(pb);
        if (IN(pb + 1)) for (int _r = 0; _r < REP_P2; ++_r) {
            for (int t = bid; t < 256; t += G) for (int _q = 0; _q < RT_SAMPLE; ++_q) {
                if (t < 128) sample_task(lds, X, l, t, 1, OPQ(tid));
                else { sample_task(lds, X, l, t - 128, 0, OPQ(tid)); sample_task(lds, X, l, t - 128, 2, OPQ(tid)); }
            }
            for (int t = bid; t < 256; t += G) {
                const int tx = (G == 256) ? ((t & 7) >> 2) * 128 + (32 * (t & 1) + (t >> 3)) * 2 + ((t >> 1) & 1) : t;
                for (int _q = 0; _q < RT_SWA; ++_q) swa_prompt(lds, X, l, tx, OPQ(tid));
            }
            for (int t = bid; t < 512; t += G) for (int _q = 0; _q < RT_SLOC; ++_q) ssd_local(lds, X, l, t, OPQ(tid));
            for (int t = bid; t < 1024; t += G) for (int _q = 0; _q < RT_MLOC; ++_q) mlstm_local(lds, X, l, t, OPQ(tid));
            if (bid == G - 1) {
                for (int i = tid; i < 2 * 3 * 1024; i += NT) {
                    const int ch = i & 1023, j = (i >> 10) % 3, n = i / 3072;
                    X.out[O_PCONV + (((size_t)l * 2 + n) * 3 + j) * 1024 + ch] = bf2f(XU[(size_t)(n * SEQ + SEQ - 3 + j) * NIN + C_BX + ch]);
                }
            }
        }
        SEAM(pb + 1);
        if (IN(pb + 2)) {
            if (bid >= G - 4) {
                pg8::Gemm g{XMIX, XWOUT + (size_t)l * D * DMIX, MPAD, D, DMIX}; pg8::SampleOrder S{G - 4, 4, bid};
                if (l == 0) { pg8::EpiRes_<1, 0> E{X.xp, X.xs, X.out, XXB, XSSQ}; pg8::gemm_phase<pg8::EpiRes_<1, 0>, pg8::SampleOrder, true>(lds, g, S, E, OPQ(tid)); }
                else if (l < 3) { pg8::EpiRes_<1, 1> E{X.xp, X.xs, X.out, XXB, XSSQ}; pg8::gemm_phase<pg8::EpiRes_<1, 1>, pg8::SampleOrder, true>(lds, g, S, E, OPQ(tid)); }
                else { pg8::EpiRes_<1, 2> E{X.xp, X.xs, X.out, XXB, XSSQ}; pg8::gemm_phase<pg8::EpiRes_<1, 2>, pg8::SampleOrder, true>(lds, g, S, E, OPQ(tid)); }
            }
            if (l < 3) {
                if (G - 4 - 193 >= 16) { if (bid >= 193 && bid < G - 4) convert_weights(lds, X, args, l + 1, bid - 193, G - 4 - 193, OPQ(tid)); }
                else convert_weights(lds, X, args, l + 1, bid, G, OPQ(tid));
            }
            for (int _r = 0; _r < REP_P3; ++_r) scans(X, l, bid * NT + OPQ(tid), G * NT);
        }
        SEAM(pb + 2);
        if (IN(pb + 3)) for (int _r = 0; _r < REP_P4; ++_r) {
            for (int task = bid; task < 1536; task += G) {
                if (task < 512) for (int _q = 0; _q < RT_SOUT; ++_q) ssd_out(lds, X, l, task, OPQ(tid));
                else mlstm_out(lds, X, l, task - 512, OPQ(tid));
            }
        }
        SEAM(pb + 3);
        if (IN(pb + 4)) {
            {
                pg8::Gemm g{XMIX, XWOUT + (size_t)l * D * DMIX, MPAD, D, DMIX}; pg8::StaticOrder S; S.init(TP, D, G, bid);
#ifdef PROBE_P5
                { pg8::EpiProbe EP{(const unsigned*)(X.ws + 64), XSSQ}; pg8::gemm_phase<pg8::EpiProbe, pg8::StaticOrder, false, GEMM_SP2>(lds, g, S, EP, OPQ(tid)); }
#endif
                if (l == 0) { pg8::EpiRes_<2, 0> E{X.xp, X.xs, X.out, XXB, XSSQ}; pg8::gemm_phase<pg8::EpiRes_<2, 0>, pg8::StaticOrder, false, GEMM_SP2, GEMM_ALIGN>(lds, g, S, E, OPQ(tid)); }
                else if (l < 3) { pg8::EpiRes_<2, 1> E{X.xp, X.xs, X.out, XXB, XSSQ}; pg8::gemm_phase<pg8::EpiRes_<2, 1>, pg8::StaticOrder, false, GEMM_SP2, GEMM_ALIGN>(lds, g, S, E, OPQ(tid)); }
                else { pg8::EpiRes_<2, 2> E{X.xp, X.xs, X.out, XXB, XSSQ}; pg8::gemm_phase<pg8::EpiRes_<2, 2>, pg8::StaticOrder, false, GEMM_SP2, GEMM_ALIGN>(lds, g, S, E, OPQ(tid)); }
            }
            if (l < 3 && bid < 20) {
                pg8::Gemm g{XXB, XWIN + (size_t)(l + 1) * NIN * D, MPAD, NIN, D}; pg8::SampleOrder S{0, 20, bid};
                pg8::EpiUh E{XU, XSSQ};
                pg8::gemm_phase<pg8::EpiUh, pg8::SampleOrder, true>(lds, g, S, E, OPQ(tid));
            }
        }
        SEAM(pb + 4);
    }
#undef IN
#undef SEAM
}

extern "C" void kernel_launch(void* const* d_in, const int* in_sizes, int n_in, void* d_out, int out_size, void* d_ws, size_t ws_size, hipStream_t stream) {
    static int grid_blocks = 0;
    if (!grid_blocks) {
        int dev = 0, cus = 0, per_cu = 0;
        hipGetDevice(&dev);
        hipDeviceGetAttribute(&cus, hipDeviceAttributeMultiprocessorCount, dev);
        hipOccupancyMaxActiveBlocksPerMultiprocessor(&per_cu, mega, NT, 0);
        if (per_cu < 1) { fprintf(stderr, "occupancy query returned %d\n", per_cu); per_cu = 1; }
        grid_blocks = cus * 1;
        if (ws_size < WS_END) fprintf(stderr, "workspace too small: %zu < %zu\n", ws_size, (size_t)WS_END);
    }
    (void)hipMemsetAsync(d_ws, 0, 16384, stream);
    Args a{};
    for (int i = 0; i < 24; ++i) a.in[i] = (const float*)d_in[i];
    a.out = (float*)d_out; a.ws = (unsigned char*)d_ws;
    const int NPH = 21;
#if MULTI_LAUNCH
    for (int p = 0; p < NPH; ++p) {
        a.ph_lo = p; a.ph_hi = p + 1;
        void* kargs[] = {&a};
        hipError_t e = hipLaunchCooperativeKernel((void*)mega, dim3(grid_blocks), dim3(NT), kargs, 0, stream);
        if (e != hipSuccess) fprintf(stderr, "cooperative launch failed: %s (grid %d)\n", hipGetErrorString(e), grid_blocks);
    }
#else
    a.ph_lo = 0; a.ph_hi = NPH;
    void* kargs[] = {&a};
    hipError_t e = hipLaunchCooperativeKernel((void*)mega, dim3(grid_blocks), dim3(NT), kargs, 0, stream);
    if (e != hipSuccess) fprintf(stderr, "cooperative launch failed: %s (grid %d)\n", hipGetErrorString(e), grid_blocks);
#endif
}
```

```cpp
#include <hip/hip_runtime.h>
#include <hip/hip_cooperative_groups.h>
#include <cstdio>
#include <cstdint>
namespace cg = cooperative_groups;

#ifndef REP_SYNC
#define REP_SYNC 1
#endif
#ifndef REP_P1
#define REP_P1 1
#endif
#ifndef REP_P2
#define REP_P2 1
#endif
#ifndef REP_P3
#define REP_P3 1
#endif
#ifndef REP_P0
#define REP_P0 1
#endif
#ifndef REP_P4
#define REP_P4 1
#endif
#ifndef RT_SAMPLE
#define RT_SAMPLE 1
#endif
#ifndef RT_SWA
#define RT_SWA 1
#endif
#ifndef RT_SLOC
#define RT_SLOC 1
#endif
#ifndef RT_MLOC
#define RT_MLOC 1
#endif
#ifndef RT_SOUT
#define RT_SOUT 1
#endif
#ifndef GEMM_SP2
#define GEMM_SP2 true
#endif
#ifndef GEMM_ALIGN
#define GEMM_ALIGN true
#endif
#ifndef MULTI_LAUNCH
#define MULTI_LAUNCH 0
#endif

#define LAS __attribute__((address_space(3)))
typedef unsigned short bf16_t;
typedef short bf16x8 __attribute__((ext_vector_type(8)));
typedef float f32x4 __attribute__((ext_vector_type(4)));
typedef float f32x2 __attribute__((ext_vector_type(2)));
typedef unsigned u32x4 __attribute__((ext_vector_type(4)));
typedef unsigned u32x2 __attribute__((ext_vector_type(2)));
typedef __bf16 bf16x2_t __attribute__((ext_vector_type(2)));
typedef LAS unsigned char* lptr;

constexpr int D = 1024, DIN = 4880, NIN = 5120, DMIX = 1536, TP = 16384, MTOK = 16512, MPAD = 16640, SEQ = 8192;
constexpr int C_AQ = 0, C_AK = 256, C_AV = 512, C_AO = 1024, C_AZ = 1536, C_AI = 2048, C_AF = 2052, C_BZ = 2056, C_BX = 2568, C_BB = 3080, C_BC = 3336,
              C_BDT = 3592, C_CQ = 3600, C_CK = 4112, C_CV = 4240, C_CZ = 4368;
constexpr float EPS = 1e-6f;
constexpr size_t O_YP = 0, O_YS = 16777216, O_PC = 16908288, O_PN = 17170432, O_PM = 17172480, O_PH = 17172512, O_PCONV = 17696800, O_PK = 17721376,
                 O_PV = 17852448, O_SC = 17983520, O_SN = 34760736, O_SM = 34891808, O_SH = 34893856, O_SCONV = 68448288, O_SK = 70021152, O_SV = 78409760;
constexpr size_t WS_BAR = 0;
constexpr size_t WS_PAR = 16384;
constexpr size_t WS_WIN = WS_PAR + 102400;
constexpr size_t WS_WOUT = WS_WIN + (size_t)4 * NIN * D * 2;
constexpr size_t WS_XB = WS_WOUT + (size_t)4 * D * DMIX * 2;
constexpr size_t WS_U = WS_XB + (size_t)MPAD * D * 2;
constexpr size_t WS_MIX = WS_U + (size_t)MPAD * NIN * 2;
constexpr size_t WS_SSQ = WS_MIX + (size_t)MPAD * DMIX * 2;
constexpr size_t WS_ROPE = WS_SSQ + (size_t)MPAD * 16 * 4;
constexpr size_t WS_MC = WS_ROPE + (size_t)8200 * 64 * 4;
constexpr size_t WS_MN = WS_MC + (size_t)8 * 128 * 8192 * 4;
constexpr size_t WS_ML = WS_MN + (size_t)8 * 128 * 64 * 4;
constexpr size_t WS_BL = WS_ML + 4096;
constexpr size_t WS_MS = WS_BL + 4096;
constexpr size_t WS_SA = WS_MS + 4096;
constexpr size_t WS_SH = WS_SA + 8192;
constexpr size_t WS_CSB = WS_SH + (size_t)16 * 128 * 8192 * 4;
constexpr size_t WS_HSB = WS_CSB + (size_t)8 * 128 * 8192 * 2;
constexpr size_t WS_NS = WS_HSB + (size_t)16 * 128 * 8192 * 2;
constexpr size_t WS_END = WS_NS + (size_t)8 * 128 * 64 * 4;
constexpr int LDS_BYTES = 139264;
constexpr int NT = 512;

struct Args { const float* in[24]; float* out; unsigned char* ws; int ph_lo, ph_hi; };

__device__ __forceinline__ float bf2f(unsigned v) { return __uint_as_float(v << 16); }
__device__ __forceinline__ unsigned pk2(float lo, float hi) { f32x2 v = {lo, hi}; bf16x2_t b = __builtin_convertvector(v, bf16x2_t); return __builtin_bit_cast(unsigned, b); }
__device__ __forceinline__ unsigned f2bf(float f) { return pk2(f, 0.f) & 0xffffu; }
__device__ __forceinline__ void unpack8(u32x4 w, float (&f)[8]) {
#pragma unroll
    for (int i = 0; i < 4; ++i) { f[2 * i] = __uint_as_float(w[i] << 16); f[2 * i + 1] = __uint_as_float(w[i] & 0xffff0000u); }
}
__device__ __forceinline__ u32x4 pack8(const float (&f)[8]) { u32x4 w; w[0] = pk2(f[0], f[1]); w[1] = pk2(f[2], f[3]); w[2] = pk2(f[4], f[5]); w[3] = pk2(f[6], f[7]); return w; }
__device__ __forceinline__ u32x4 pack8v(f32x4 a, f32x4 b) { u32x4 w; w[0] = pk2(a[0], a[1]); w[1] = pk2(a[2], a[3]); w[2] = pk2(b[0], b[1]); w[3] = pk2(b[2], b[3]); return w; }
__device__ __forceinline__ bf16x8 as_frag(u32x4 w) { return __builtin_bit_cast(bf16x8, w); }
__device__ __forceinline__ bf16x8 ldg_f32_frag(const float* p) { f32x4 a = *(const f32x4*)p, b = *(const f32x4*)(p + 4); return as_frag(pack8v(a, b)); }
__device__ __forceinline__ bf16x8 lds_frag(lptr base, int row, int k, int stride) { return *(const LAS bf16x8*)(base + ((row * stride + k) << 1)); }
__device__ __forceinline__ f32x4 mfma16(bf16x8 a, bf16x8 b, f32x4 c) { return __builtin_amdgcn_mfma_f32_16x16x32_bf16(a, b, c, 0, 0, 0); }
__device__ __forceinline__ float rcpf_(float x) { return __builtin_amdgcn_rcpf(x); }
__device__ __forceinline__ float sigmoidf_(float x) { return rcpf_(1.f + __expf(-x)); }
__device__ __forceinline__ float siluf_(float x) { return x * rcpf_(1.f + __expf(-x)); }
__device__ __forceinline__ float softplusf_(float x) { return x > 20.f ? x : __logf(1.f + __expf(x)); }
__device__ __forceinline__ float logsigf_(float x) { return fminf(x, 0.f) - __logf(1.f + __expf(-fabsf(x))); }
template <int CTRL, int RM> __device__ __forceinline__ float dpps(float ident, float v) { return __int_as_float(__builtin_amdgcn_update_dpp(__float_as_int(ident), __float_as_int(v), CTRL, RM, 0xf, false)); }
__device__ __forceinline__ float wave_scan_sum(float v, int) {
    v += dpps<0x111, 0xf>(0.f, v); v += dpps<0x112, 0xf>(0.f, v); v += dpps<0x114, 0xf>(0.f, v); v += dpps<0x118, 0xf>(0.f, v);
    v += dpps<0x142, 0xa>(0.f, v); v += dpps<0x143, 0xc>(0.f, v);
    return v;
}
__device__ __forceinline__ float wave_scan_max(float v, int) {
    const float NI = -3.0e38f;
    v = fmaxf(v, dpps<0x111, 0xf>(NI, v)); v = fmaxf(v, dpps<0x112, 0xf>(NI, v)); v = fmaxf(v, dpps<0x114, 0xf>(NI, v)); v = fmaxf(v, dpps<0x118, 0xf>(NI, v));
    v = fmaxf(v, dpps<0x142, 0xa>(NI, v)); v = fmaxf(v, dpps<0x143, 0xc>(NI, v));
    return v;
}
__device__ __forceinline__ float lane63(float v) { return __int_as_float(__builtin_amdgcn_readlane(__float_as_int(v), 63)); }
__device__ __forceinline__ float red16(float v);
__device__ __forceinline__ float red16max(float v);
__device__ __forceinline__ float wave_sum(float v) { v = red16(v); v += __shfl_xor(v, 16); v += __shfl_xor(v, 32); return v; }
__device__ __forceinline__ float wave_max(float v) { v = red16max(v); v = fmaxf(v, __shfl_xor(v, 16)); v = fmaxf(v, __shfl_xor(v, 32)); return v; }
template <int CTRL> __device__ __forceinline__ float dppf(float v) { return __int_as_float(__builtin_amdgcn_update_dpp(0, __float_as_int(v), CTRL, 0xf, 0xf, true)); }
__device__ __forceinline__ float red16(float v) { v += dppf<0xB1>(v); v += dppf<0x4E>(v); v += dppf<0x141>(v); v += dppf<0x140>(v); return v; }
__device__ __forceinline__ float red16max(float v) { v = fmaxf(v, dppf<0xB1>(v)); v = fmaxf(v, dppf<0x4E>(v)); v = fmaxf(v, dppf<0x141>(v)); v = fmaxf(v, dppf<0x140>(v)); return v; }
__device__ __forceinline__ int OPQ(int v) { asm volatile("" : "+v"(v)); return v; }
#define LDS_FENCE() asm volatile("s_waitcnt lgkmcnt(0)" ::: "memory")

namespace pg8 {
constexpr int BM = 256, BK = 64, HALF = 128, HTB = HALF * BK * 2, STAGE_BYTES = 8 * HTB, NXCD = 8, WGM = 8;
__host__ __device__ __forceinline__ int lds_byte(int r, int c) { const int st = (r >> 4) * 2 + (c >> 5), rr = r & 15, cc = c & 31, ob = rr * 64 + cc * 2; return st * 1024 + (ob ^ (((ob >> 9) & 1) << 5)); }
__host__ __device__ __forceinline__ void stage_rc(int b, int& R, int& C) { const int st = b / 1024, sb = b % 1024, swz = sb ^ (((sb >> 9) & 1) << 5); R = (st >> 1) * 16 + swz / 64; C = (st & 1) * 32 + (swz % 64) / 2; }
__host__ __device__ __forceinline__ int perm32(int rho) { const int n = rho >> 4, i = rho & 15; return 8 * (i >> 2) + 4 * n + (i & 3); }
struct Unit { int pm, pn; };
struct Gemm { const bf16_t* A; const bf16_t* Bt; int M, N, K; };
struct StaticOrder {
    int nM, nN, nwg, G, c;
    __device__ void init(int M, int N, int G_, int c_) { nM = M / BM; nN = N / BM; nwg = nM * nN; G = G_; c = c_; }
    __device__ bool next(int i, Unit& u) const {
        const long L = (long)i * G + c; if (L >= nwg) return false;
        int wgid = (int)L; { const int q = nwg / NXCD, r = nwg % NXCD, xcd = wgid % NXCD, off = wgid / NXCD; wgid = (xcd < r ? xcd * (q + 1) : r * (q + 1) + (xcd - r) * q) + off; }
        const int nig = WGM * nN, gid = wgid / nig, fm = gid * WGM, gsz = (nM - fm) < WGM ? (nM - fm) : WGM;
        u.pm = fm + ((wgid % nig) % gsz); u.pn = (wgid % nig) / gsz; return true;
    }
};
template <int NAI> struct EpiU_ {
    bf16_t* U; const float* ssq;
    __device__ __forceinline__ void operator()(const f32x4 (&acc)[2][2][4][2], const Unit& u, int wr, int wc, int fr, int fq) const {
        const int row0 = u.pm * BM + wr * 64 + fr, col0 = u.pn * BM + wc * 32 + 8 * fq;
        f32x4 sq[NAI][4];
#pragma unroll
        for (int ai = 0; ai < NAI; ++ai)
#pragma unroll
            for (int m = 0; m < 4; ++m) sq[ai][m] = *(const f32x4*)(ssq + (size_t)(row0 + ai * HALF + m * 16) * 16 + fq * 4);
#pragma unroll
        for (int ai = 0; ai < NAI; ++ai)
#pragma unroll
            for (int m = 0; m < 4; ++m) {
                const int r = row0 + ai * HALF + m * 16;
                const f32x4 s = sq[ai][m];
                float st = s[0] + s[1] + s[2] + s[3]; st += __shfl_xor(st, 16); st += __shfl_xor(st, 32);
                const float rs = rsqrtf(st * (1.f / 1024.f) + EPS);
                bf16_t* rowp = U + (size_t)r * NIN + col0;
#pragma unroll
                for (int bj = 0; bj < 2; ++bj) *(u32x4*)(rowp + bj * HALF) = pack8v(acc[ai][bj][m][0] * rs, acc[ai][bj][m][1] * rs);
                __builtin_amdgcn_sched_barrier(0);
            }
    }
};
template <int NAI, int MODE> struct EpiRes_ {
    const float* xp; const float* xs; float* out; bf16_t* xb; float* ssq;
    __device__ __forceinline__ void operator()(const f32x4 (&acc)[2][2][4][2], const Unit& u, int wr, int wc, int fr, int fq) const {
        const int row0 = u.pm * BM + wr * 64 + fr, col0 = u.pn * BM + wc * 32 + 8 * fq;
#pragma unroll
        for (int ai = 0; ai < NAI; ++ai) {
            u32x4 xo[4][2];
            f32x4 xf[MODE == 0 ? 4 : 1][2][2];
            if (MODE != 0) {
#pragma unroll
                for (int m = 0; m < 4; ++m)
#pragma unroll
                    for (int bj = 0; bj < 2; ++bj) xo[m][bj] = *(const u32x4*)(xb + (size_t)(row0 + ai * HALF + m * 16) * D + col0 + bj * HALF);
            } else {
#pragma unroll
                for (int m = 0; m < 4; ++m) {
                    const int r = row0 + ai * HALF + m * 16, rc = r < MTOK ? r : MTOK - 1;
                    const float* src = rc < TP ? xp + (size_t)rc * D : xs + (size_t)(rc - TP) * D;
#pragma unroll
                    for (int bj = 0; bj < 2; ++bj) { xf[m][bj][0] = __builtin_nontemporal_load((const f32x4*)(src + col0 + bj * HALF)); xf[m][bj][1] = __builtin_nontemporal_load((const f32x4*)(src + col0 + bj * HALF + 4)); }
                }
            }
#pragma unroll
            for (int m = 0; m < 4; ++m) {
                const int r = row0 + ai * HALF + m * 16;
                const bool valid = r < MTOK;
                float part = 0.f;
#pragma unroll
                for (int bj = 0; bj < 2; ++bj) {
                    const int c = col0 + bj * HALF;
                    f32x4 o0 = {0.f, 0.f, 0.f, 0.f}, o1 = {0.f, 0.f, 0.f, 0.f};
                    if (MODE == 0) {
                        if (valid) { o0 = xf[MODE == 0 ? m : 0][bj][0]; o1 = xf[MODE == 0 ? m : 0][bj][1]; }
                    } else {
                        float f[8]; unpack8(xo[m][bj], f);
                        o0 = (f32x4){f[0], f[1], f[2], f[3]}; o1 = (f32x4){f[4], f[5], f[6], f[7]};
                    }
                    const f32x4 v0 = acc[ai][bj][m][0] + o0, v1 = acc[ai][bj][m][1] + o1;
                    if (MODE == 2) {
                        if (valid) { __builtin_nontemporal_store(v0, (f32x4*)(out + (size_t)r * D + c)); __builtin_nontemporal_store(v1, (f32x4*)(out + (size_t)r * D + c + 4)); }
                    } else {
                        *(u32x4*)(xb + (size_t)r * D + c) = pack8v(v0, v1);
                        part += v0[0] * v0[0] + v0[1] * v0[1] + v0[2] * v0[2] + v0[3] * v0[3] + v1[0] * v1[0] + v1[1] * v1[1] + v1[2] * v1[2] + v1[3] * v1[3];
                    }
                }
                if (MODE != 2) {
                    part += __shfl_xor(part, 16); part += __shfl_xor(part, 32);
                    if (fq == 0) ssq[(size_t)r * 16 + u.pn * 4 + wc] = part;
                }
                __builtin_amdgcn_sched_barrier(0);
            }
        }
    }
};

typedef EpiU_<2> EpiU; typedef EpiU_<1> EpiUh;
struct EpiProbe {
    const unsigned* flag; float* dst;
    __device__ __forceinline__ void operator()(const f32x4 (&acc)[2][2][4][2], const Unit& u, int wr, int wc, int fr, int fq) const {
        if (__hip_atomic_load(flag, __ATOMIC_RELAXED, __HIP_MEMORY_SCOPE_AGENT) == 12345u) {
            f32x4 t = {0.f, 0.f, 0.f, 0.f};
#pragma unroll
            for (int a = 0; a < 2; ++a)
#pragma unroll
                for (int b = 0; b < 2; ++b)
#pragma unroll
                    for (int m = 0; m < 4; ++m)
#pragma unroll
                        for (int n = 0; n < 2; ++n) t += acc[a][b][m][n];
            *(f32x4*)(dst + (size_t)(u.pm * 4 + u.pn) * 2048 + (wr * 4 + wc) * 256 + (fq * 16 + fr) * 4) = t;
        }
    }
};
struct SampleOrder {
    int first, cnt, c;
    __device__ bool next(int i, Unit& u) const { if (i != 0 || c < first || c >= first + cnt) return false; u.pm = 64; u.pn = c - first; return true; }
};
template <class Epi, class Sched, bool HALF_M = false, bool SP2 = false, bool ALIGN_EPI = false>
__device__ __forceinline__ void gemm_phase(lptr lds, const Gemm g, const Sched& S, const Epi& E, const int tid) {
    const int wid = __builtin_amdgcn_readfirstlane(tid >> 6), lane = tid & 63, wr = wid >> 2, wc = wid & 3, fr = lane & 15, fq = lane >> 4;
    const int K = g.K, nt = K / BK;
    unsigned voffA[2], voffB[2];
#pragma unroll
    for (int i = 0; i < 2; ++i) { int R, C; stage_rc(tid * 16 + i * 8192, R, C); const int Rb = (R & ~31) + perm32(R & 31);
        voffA[i] = (unsigned)(R * K + C) * 2u; voffB[i] = (unsigned)(Rb * K + C) * 2u; }
    const size_t kstep = (size_t)(BK * 2);
    const size_t hstep = (size_t)HALF * K * 2;
    const size_t tstep = 2 * hstep;
    const unsigned ldsw = (unsigned)wid * 1024u;
    const int aoff = lds_byte(wr * 64 + fr, fq * 8), boff = lds_byte(wc * 32 + fr, fq * 8);
#define PG8_SA(b, h) (((b) * 2 + (h)) * HTB)
#define PG8_SB(b, h) ((4 + (b) * 2 + (h)) * HTB)
#define PG8_STAGE(bufoff, gbase, voff) do { _Pragma("unroll") for (int _i = 0; _i < 2; ++_i) \
        __builtin_amdgcn_global_load_lds((const unsigned*)((const char*)(gbase) + (voff)[_i]), (LAS unsigned*)(lds + (bufoff) + ldsw + _i * 8192), 16, 0, 0); } while (0)
#define PG8_LDA(dst, b, h) do { _Pragma("unroll") for (int m = 0; m < 4; ++m) _Pragma("unroll") for (int k = 0; k < 2; ++k) dst[m][k] = *(const LAS bf16x8*)(lds + PG8_SA(b, h) + aoff + m * 2048 + k * 1024); } while (0)
#define PG8_LDB(dst, b, h) do { _Pragma("unroll") for (int n = 0; n < 2; ++n) _Pragma("unroll") for (int k = 0; k < 2; ++k) dst[n][k] = *(const LAS bf16x8*)(lds + PG8_SB(b, h) + boff + n * 2048 + k * 1024); } while (0)
#define PG8_MMA(ai, bj, At, Bt) do { __builtin_amdgcn_s_setprio(1); _Pragma("unroll") for (int m = 0; m < 4; ++m) _Pragma("unroll") for (int n = 0; n < 2; ++n) _Pragma("unroll") for (int k = 0; k < 2; ++k) \
        acc[ai][bj][m][n] = __builtin_amdgcn_mfma_f32_16x16x32_bf16(Bt[n][k], At[m][k], acc[ai][bj][m][n], 0, 0, 0); __builtin_amdgcn_s_setprio(0); } while (0)
#define PG8_WAIT_V(n) asm volatile("s_waitcnt vmcnt(" #n ")" ::: "memory")
#define PG8_WAIT_L(n) asm volatile("s_waitcnt lgkmcnt(" #n ")" ::: "memory")
#define PG8_BAR __builtin_amdgcn_s_barrier()
#define PG8_SCHED __builtin_amdgcn_sched_barrier(0)
    Unit cur, nxt; int ui = 0;
    if (!S.next(0, cur)) return;
    f32x4 acc[2][2][4][2];
#pragma unroll
    for (int a = 0; a < 2; ++a)
#pragma unroll
        for (int b = 0; b < 2; ++b)
#pragma unroll
            for (int m = 0; m < 4; ++m)
#pragma unroll
                for (int n = 0; n < 2; ++n) acc[a][b][m][n] = (f32x4){0.f, 0.f, 0.f, 0.f};
    bf16x8 At[4][2], B0[2][2], B1[2][2];
    const char* cA = (const char*)g.A + (size_t)cur.pm * tstep; const char* cB = (const char*)g.Bt + (size_t)cur.pn * tstep;
    if constexpr (SP2) {
        PG8_STAGE(PG8_SB(0, 0), cB, voffB); PG8_STAGE(PG8_SB(0, 1), cB + hstep, voffB); PG8_STAGE(PG8_SA(0, 0), cA, voffA); PG8_STAGE(PG8_SA(0, 1), cA + hstep, voffA);
        if (wr == 1) PG8_BAR;
        PG8_WAIT_V(2); PG8_BAR;
        PG8_STAGE(PG8_SB(1, 0), cB + kstep, voffB); PG8_STAGE(PG8_SA(1, 0), cA + kstep, voffA); PG8_STAGE(PG8_SB(1, 1), cB + hstep + kstep, voffB);
        PG8_WAIT_V(6); PG8_BAR;
    } else {
    PG8_STAGE(PG8_SB(0, 0), cB, voffB); PG8_STAGE(PG8_SA(0, 0), cA, voffA); PG8_STAGE(PG8_SB(0, 1), cB + hstep, voffB); PG8_STAGE(PG8_SA(0, 1), cA + hstep, voffA);
    if (wr == 1) PG8_BAR;
    PG8_WAIT_V(4); PG8_BAR;
    PG8_STAGE(PG8_SB(1, 0), cB + kstep, voffB); PG8_STAGE(PG8_SA(1, 0), cA + kstep, voffA); PG8_STAGE(PG8_SB(1, 1), cB + hstep + kstep, voffB);
    PG8_WAIT_V(6); PG8_BAR;
    }
    for (;;) {
        const bool has_next = S.next(ui + 1, nxt);
        const char* nA = has_next ? (const char*)g.A + (size_t)nxt.pm * tstep : cA; const char* nB = has_next ? (const char*)g.Bt + (size_t)nxt.pn * tstep : cB;
        for (int t = 0; t < nt; t += 2) {
            const bool last = (t == nt - 2);
            const char* a1 = cA + (size_t)(t + 1) * kstep;
            const char* a2 = last ? nA : cA + (size_t)(t + 2) * kstep; const char* b2 = last ? nB : cB + (size_t)(t + 2) * kstep;
            const char* a3 = a2 + kstep; const char* b3 = b2 + kstep;
            if constexpr (SP2) {
            PG8_LDB(B0, 0, 0); PG8_LDB(B1, 0, 1); PG8_SCHED; PG8_LDA(At, 0, 0); PG8_STAGE(PG8_SA(1, 1), a1 + hstep, voffA);
            PG8_WAIT_V(8); PG8_WAIT_L(0); PG8_BAR; PG8_MMA(0, 0, At, B0); PG8_MMA(0, 1, At, B1); PG8_BAR; PG8_SCHED;
            PG8_LDA(At, 0, 1); PG8_STAGE(PG8_SB(0, 0), b2, voffB); PG8_STAGE(PG8_SB(0, 1), b2 + hstep, voffB); PG8_STAGE(PG8_SA(0, 0), a2, voffA);
            PG8_WAIT_V(8); PG8_WAIT_L(0); PG8_BAR; PG8_MMA(1, 0, At, B0); PG8_MMA(1, 1, At, B1); PG8_BAR; PG8_SCHED;
            PG8_LDB(B0, 1, 0); PG8_LDB(B1, 1, 1); PG8_SCHED; PG8_LDA(At, 1, 0); PG8_STAGE(PG8_SA(0, 1), a2 + hstep, voffA);
            PG8_WAIT_V(8); PG8_WAIT_L(0); PG8_BAR; PG8_MMA(0, 0, At, B0); PG8_MMA(0, 1, At, B1); PG8_BAR; PG8_SCHED;
            PG8_LDA(At, 1, 1); PG8_STAGE(PG8_SB(1, 0), b3, voffB); PG8_STAGE(PG8_SB(1, 1), b3 + hstep, voffB); PG8_STAGE(PG8_SA(1, 0), a3, voffA);
            PG8_WAIT_V(8); PG8_WAIT_L(0); PG8_BAR; PG8_MMA(1, 0, At, B0); PG8_MMA(1, 1, At, B1); PG8_BAR; PG8_SCHED;
            } else {
            PG8_LDB(B0, 0, 0); PG8_SCHED; PG8_LDA(At, 0, 0); PG8_STAGE(PG8_SA(1, 1), a1 + hstep, voffA);
            PG8_WAIT_L(8); PG8_BAR; PG8_WAIT_L(0); PG8_MMA(0, 0, At, B0); PG8_BAR; PG8_SCHED;
            PG8_LDB(B1, 0, 1); PG8_STAGE(PG8_SB(0, 0), b2, voffB);
            PG8_BAR; PG8_WAIT_L(0); PG8_MMA(0, 1, At, B1); PG8_BAR;
            if constexpr (!HALF_M) PG8_LDA(At, 0, 1);
            PG8_STAGE(PG8_SA(0, 0), a2, voffA);
            PG8_BAR; PG8_WAIT_L(0); if constexpr (!HALF_M) PG8_MMA(1, 0, At, B0); PG8_BAR; PG8_SCHED;
            PG8_STAGE(PG8_SB(0, 1), b2 + hstep, voffB);
            PG8_WAIT_V(6); PG8_BAR; if constexpr (!HALF_M) PG8_MMA(1, 1, At, B1); PG8_BAR;
            PG8_LDB(B0, 1, 0); PG8_SCHED; PG8_LDA(At, 1, 0); PG8_STAGE(PG8_SA(0, 1), a2 + hstep, voffA);
            PG8_WAIT_L(8); PG8_BAR; PG8_WAIT_L(0); PG8_MMA(0, 0, At, B0); PG8_BAR; PG8_SCHED;
            PG8_LDB(B1, 1, 1); PG8_STAGE(PG8_SB(1, 0), b3, voffB);
            PG8_BAR; PG8_WAIT_L(0); PG8_MMA(0, 1, At, B1); PG8_BAR;
            if constexpr (!HALF_M) PG8_LDA(At, 1, 1);
            PG8_STAGE(PG8_SA(1, 0), a3, voffA);
            PG8_BAR; PG8_WAIT_L(0); if constexpr (!HALF_M) PG8_MMA(1, 0, At, B0); PG8_BAR; PG8_SCHED;
            PG8_STAGE(PG8_SB(1, 1), b3 + hstep, voffB);
            PG8_WAIT_V(6); PG8_BAR; if constexpr (!HALF_M) PG8_MMA(1, 1, At, B1); PG8_BAR;
            }
        }
        if constexpr (ALIGN_EPI) { if (wr == 0) PG8_BAR; }
        E(acc, cur, wr, wc, fr, fq);
        if (!has_next) break;
#pragma unroll
        for (int a = 0; a < 2; ++a)
#pragma unroll
            for (int b = 0; b < 2; ++b)
#pragma unroll
                for (int m = 0; m < 4; ++m)
#pragma unroll
                    for (int n = 0; n < 2; ++n) acc[a][b][m][n] = (f32x4){0.f, 0.f, 0.f, 0.f};
        cur = nxt; cA = nA; cB = nB; ++ui;
        if constexpr (ALIGN_EPI) { if (wr == 1) PG8_BAR; }
    }
    PG8_WAIT_V(0);
    if constexpr (!ALIGN_EPI) { if (wr == 0) PG8_BAR; }
    PG8_BAR;
#undef PG8_SA
#undef PG8_SB
#undef PG8_STAGE
#undef PG8_LDA
#undef PG8_LDB
#undef PG8_MMA
#undef PG8_WAIT_V
#undef PG8_WAIT_L
#undef PG8_BAR
#undef PG8_SCHED
}
}

struct Ctx {
    const float* xp; const float* xs; const float* stC; const float* stN; const float* stM; const float* ssm; const float* conv; const float* ck; const float* cv;
    float* out; unsigned char* ws;
};
#define XWIN ((bf16_t*)(X.ws + WS_WIN))
#define XWOUT ((bf16_t*)(X.ws + WS_WOUT))
#define XXB ((bf16_t*)(X.ws + WS_XB))
#define XU ((bf16_t*)(X.ws + WS_U))
#define XMIX ((bf16_t*)(X.ws + WS_MIX))
#define XSSQ ((float*)(X.ws + WS_SSQ))
#define XROPE ((float*)(X.ws + WS_ROPE))
#define XMC ((float*)(X.ws + WS_MC))
#define XMN ((float*)(X.ws + WS_MN))
#define XML ((float*)(X.ws + WS_ML))
#define XBL ((float*)(X.ws + WS_BL))
#define XMS ((float*)(X.ws + WS_MS))
#define XSA ((float*)(X.ws + WS_SA))
#define XSH ((float*)(X.ws + WS_SH))
#define XCSB ((bf16_t*)(X.ws + WS_CSB))
#define XNS ((float*)(X.ws + WS_NS))
#define XHSB ((bf16_t*)(X.ws + WS_HSB))
#define XPAR(off) ((const float*)(X.ws + WS_PAR) + (off))
constexpr int P_AIB = 0, P_AFB = 16, P_DTB = 32, P_ALOG = 64, P_BD = 96, P_SINK = 128, P_QNW = 160, P_KNW = 416, P_ANW = 672, P_BNW = 2720, P_CB = 4768, P_CW = 8864, P_END = 25248;
#define IN_XP 0
#define IN_XS 1
#define IN_STC 2
#define IN_STN 3
#define IN_STM 4
#define IN_SSM 5
#define IN_CONV 6
#define IN_CK 7
#define IN_CV 8
#define IN_NORMW 9
#define IN_WIN 10
#define IN_AIB 11
#define IN_AFB 12
#define IN_ANW 13
#define IN_CW 14
#define IN_CB 15
#define IN_DTB 16
#define IN_ALOG 17
#define IN_BD 18
#define IN_BNW 19
#define IN_QNW 20
#define IN_KNW 21
#define IN_SINK 22
#define IN_WOUT 23

__device__ __forceinline__ void transpose_strip(lptr lds, const float* src, int ldn, int nvalid, bf16_t* dst, int ldk, const float* scale, int k0, int n0, int tid) {
    LAS float* T = (LAS float*)lds;
    f32x4 v[8];
#pragma unroll
    for (int i = 0; i < 8; ++i) {
        const int f = tid + i * NT, r = f >> 6, c4 = (f & 63) * 4, n = n0 + c4;
        const f32x4 t = __builtin_nontemporal_load((const f32x4*)(src + (size_t)(k0 + r) * ldn + (n < nvalid ? n : 0)));
        const float m = n < nvalid ? (scale ? scale[k0 + r] : 1.f) : 0.f;
        v[i] = t * m;
    }
#pragma unroll
    for (int i = 0; i < 8; ++i) {
        const int f = tid + i * NT, r = f >> 6, c4 = (f & 63) * 4;
        T[r * 257 + c4 + 0] = v[i][0]; T[r * 257 + c4 + 1] = v[i][1]; T[r * 257 + c4 + 2] = v[i][2]; T[r * 257 + c4 + 3] = v[i][3];
    }
    __syncthreads();
#pragma unroll
    for (int i = 0; i < 4; ++i) {
        const int p = tid + i * NT, n = p >> 3, k8 = (p & 7) * 8; float f[8];
#pragma unroll
        for (int jx = 0; jx < 8; ++jx) f[jx] = T[(k8 + jx) * 257 + n];
        *(u32x4*)(dst + (size_t)(n0 + n) * ldk + k0 + k8) = pack8(f);
    }
    __syncthreads();
}

__device__ __forceinline__ void prologue(lptr lds, const Ctx& X, const Args& args, int G, int bid, int tid) {
    const int lane = tid & 63, wave = tid >> 6;
    constexpr int T0 = 320, T1 = T0 + 96, T2 = T1 + 520, T3 = T2 + 6, T4 = T3 + 513;
    for (int task = bid; task < T4; task += G) {
        if (task < T0) {
            const int kt = task / 20, ntl = task % 20;
            transpose_strip(lds, args.in[IN_WIN], DIN, DIN, XWIN, D, args.in[IN_NORMW], kt * 64, ntl * 256, tid);
        } else if (task < T1) {
            const int r = task - T0, kt = r / 4, ntl = r % 4;
            transpose_strip(lds, args.in[IN_WOUT], D, D, XWOUT, DMIX, nullptr, kt * 64, ntl * 256, tid);
        } else if (task < T2) {
            const int rb = (task - T1) * 32 + wave * 4;
            f32x4 v[4][4];
#pragma unroll
            for (int q = 0; q < 4; ++q) {
                const int r = rb + q, rc = r < MTOK ? r : MTOK - 1;
                const float* src = rc < TP ? X.xp + (size_t)rc * D : X.xs + (size_t)(rc - TP) * D;
#pragma unroll
                for (int i = 0; i < 4; ++i) v[q][i] = __builtin_nontemporal_load((const f32x4*)(src + lane * 4 + i * 256));
            }
#pragma unroll
            for (int q = 0; q < 4; ++q) {
                const int r = rb + q;
                const float keep = r < MTOK ? 1.f : 0.f;
                float ss = 0.f;
#pragma unroll
                for (int i = 0; i < 4; ++i) {
                    const f32x4 t = v[q][i] * keep;
                    ss += t[0] * t[0] + t[1] * t[1] + t[2] * t[2] + t[3] * t[3];
                    u32x2 w; w[0] = pk2(t[0], t[1]); w[1] = pk2(t[2], t[3]);
                    *(u32x2*)(XXB + (size_t)r * D + lane * 4 + i * 256) = w;
                }
                ss = wave_sum(ss);
                if (lane < 16) XSSQ[(size_t)r * 16 + lane] = (lane == 0) ? ss : 0.f;
            }
        } else if (task < T3) {
            float* P = (float*)(X.ws + WS_PAR);
            const int k = task - T2;
            if (k == 0) {
                for (int i = tid; i < (MPAD - MTOK) * DMIX / 2; i += NT) ((unsigned*)(XMIX + (size_t)MTOK * DMIX))[i] = 0u;
                float v[10];
#pragma unroll
                for (int q = 0; q < 10; ++q) {
                    const int i = tid + q * NT, ic = i < P_CB ? i : P_CB - 1;
                    const float* src; int off;
                    if (ic < P_AFB) { src = args.in[IN_AIB]; off = ic - P_AIB; } else if (ic < P_DTB) { src = args.in[IN_AFB]; off = ic - P_AFB; }
                    else if (ic < P_ALOG) { src = args.in[IN_DTB]; off = ic - P_DTB; } else if (ic < P_BD) { src = args.in[IN_ALOG]; off = ic - P_ALOG; }
                    else if (ic < P_SINK) { src = args.in[IN_BD]; off = ic - P_BD; } else if (ic < P_QNW) { src = args.in[IN_SINK]; off = ic - P_SINK; }
                    else if (ic < P_KNW) { src = args.in[IN_QNW]; off = ic - P_QNW; } else if (ic < P_ANW) { src = args.in[IN_KNW]; off = ic - P_KNW; }
                    else if (ic < P_BNW) { src = args.in[IN_ANW]; off = ic - P_ANW; } else { src = args.in[IN_BNW]; off = ic - P_BNW; }
                    v[q] = src[off];
                }
#pragma unroll
                for (int q = 0; q < 10; ++q) { const int i = tid + q * NT; if (i < P_CB) P[i] = v[q]; }
            } else {
                const float* src = k == 1 ? args.in[IN_CB] : args.in[IN_CW] + (k - 2) * 4096;
                float* dst = P + (k == 1 ? P_CB : P_CW + (k - 2) * 4096);
                f32x4 v[2];
#pragma unroll
                for (int q = 0; q < 2; ++q) v[q] = *(const f32x4*)(src + (tid + q * NT) * 4);
#pragma unroll
                for (int q = 0; q < 2; ++q) *(f32x4*)(dst + (tid + q * NT) * 4) = v[q];
            }
        } else {
            const int e = (task - T3) * 512 + tid;
            if (e < 8193 * 32) {
                const int pos = e >> 5, d = e & 31;
                const float inv = (float)exp2(-(double)d * (13.287712379549449 / 32.0));
                const float angf = (float)pos * inv;
                const double a = (double)angf;
                const double k = rint(a * 0.15915494309189535);
                const float rr = (float)(a - k * 6.283185307179586);
                XROPE[(size_t)e * 2] = cosf(rr); XROPE[(size_t)e * 2 + 1] = sinf(rr);
            }
        }
    }
}

__device__ __forceinline__ void convert_weights(lptr lds, const Ctx& X, const Args& args, int l, int first, int stride, int tid) {
    for (int t = first; t < 416; t += stride) {
        if (t < 320) {
            const int kt = t / 20, ntl = t % 20;
            transpose_strip(lds, args.in[IN_WIN] + (size_t)l * D * DIN, DIN, DIN, XWIN + (size_t)l * NIN * D, D, args.in[IN_NORMW] + l * D, kt * 64, ntl * 256, tid);
        } else {
            const int r = t - 320, kt = r / 4, ntl = r % 4;
            transpose_strip(lds, args.in[IN_WOUT] + (size_t)l * DMIX * D, D, D, XWOUT + (size_t)l * D * DMIX, DMIX, nullptr, kt * 64, ntl * 256, tid);
        }
    }
}

__device__ __forceinline__ void conv8(const bf16_t* u, int seq0, int tt, int ch, const float* cw, const float* cb, float (&o)[8]) {
    float acc[8];
    { f32x4 b0 = *(const f32x4*)(cb + ch), b1 = *(const f32x4*)(cb + ch + 4);
#pragma unroll
      for (int j = 0; j < 4; ++j) { acc[j] = b0[j]; acc[4 + j] = b1[j]; } }
#pragma unroll
    for (int jj = 0; jj < 4; ++jj) {
        const int t2 = tt + jj - 3;
        if (t2 >= 0) {
            float x[8]; unpack8(*(const u32x4*)(u + (size_t)(seq0 + t2) * NIN + C_BX + ch), x);
            f32x4 w0 = *(const f32x4*)(cw + jj * 1024 + ch), w1 = *(const f32x4*)(cw + jj * 1024 + ch + 4);
#pragma unroll
            for (int j = 0; j < 4; ++j) { acc[j] += x[j] * w0[j]; acc[4 + j] += x[4 + j] * w1[j]; }
        }
    }
#pragma unroll
    for (int j = 0; j < 8; ++j) o[j] = siluf_(acc[j]);
}


__device__ __forceinline__ void conv8x8(const bf16_t* u, int seq0, int tt0, int ch, const float* cw, const float* cb, float (&o)[8][8]) {
    float w[4][8];
#pragma unroll
    for (int jj = 0; jj < 4; ++jj) { f32x4 w0 = *(const f32x4*)(cw + jj * 1024 + ch), w1 = *(const f32x4*)(cw + jj * 1024 + ch + 4);
#pragma unroll
        for (int j = 0; j < 4; ++j) { w[jj][j] = w0[j]; w[jj][4 + j] = w1[j]; } }
    { f32x4 b0 = *(const f32x4*)(cb + ch), b1 = *(const f32x4*)(cb + ch + 4);
#pragma unroll
      for (int t = 0; t < 8; ++t)
#pragma unroll
          for (int j = 0; j < 4; ++j) { o[t][j] = b0[j]; o[t][4 + j] = b1[j]; } }
    u32x4 raw[11];
#pragma unroll
    for (int r = 0; r < 11; ++r) {
        const int t2 = tt0 + r - 3;
        const u32x4 v = *(const u32x4*)(u + (unsigned)(seq0 + (t2 >= 0 ? t2 : 0)) * NIN + C_BX + ch);
        const unsigned msk = t2 >= 0 ? 0xffffffffu : 0u;
        raw[r] = (u32x4){v[0] & msk, v[1] & msk, v[2] & msk, v[3] & msk};
    }
#pragma unroll
    for (int r = 0; r < 11; ++r) {
        float x[8]; unpack8(raw[r], x);
#pragma unroll
        for (int jj = 0; jj < 4; ++jj) {
            const int t = r - jj;
            if (t >= 0 && t < 8) {
#pragma unroll
                for (int j = 0; j < 8; ++j) o[t][j] += x[j] * w[jj][j];
            }
        }
    }
#pragma unroll
    for (int t = 0; t < 8; ++t)
#pragma unroll
        for (int j = 0; j < 8; ++j) o[t][j] = siluf_(o[t][j]);
}

__device__ __forceinline__ void mlstm_local(lptr lds, const Ctx& X, int l, int task, int tid) {
    const int h = task & 3, c = (task >> 2) & 127, n = task >> 9;
    const int lane = tid & 63, wave = tid >> 6, fr = lane & 15, fq = lane >> 4;
    const int row0 = n * SEQ + c * 64, nh = n * 4 + h;
    lptr VwT = lds;
    lptr KT = lds + 18432;
    LAS float* wv = (LAS float*)(lds + 27648);
    const int tg = lane & 7, cgq = lane >> 3;
    u32x4 blk[8];
    if (wave >= 1 && wave <= 3) {
        const int col = wave < 3 ? C_AV + h * 128 + ((wave - 1) * 8 + cgq) * 8 : C_AK + h * 64 + cgq * 8;
#pragma unroll
        for (int t = 0; t < 8; ++t) blk[t] = *(const u32x4*)(XU + (unsigned)(row0 + 8 * tg + t) * NIN + col);
    }
    if (wave == 0) {
        const bf16_t* ur = XU + (unsigned)(row0 + lane) * NIN;
        const float fg = bf2f(ur[C_AF + h]) + XPAR(P_AFB)[l * 4 + h], ig = bf2f(ur[C_AI + h]) + XPAR(P_AIB)[l * 4 + h];
        const float b = wave_scan_sum(logsigf_(fg), lane);
        const float bl = lane63(b);
        const float g = bl - b + ig;
        const float ml = wave_max(g);
        wv[lane] = __expf(g - ml);
        if (lane == 0) { XML[nh * 128 + c] = ml; XBL[nh * 128 + c] = bl; }
    }
    __syncthreads();
    if (wave >= 1 && wave <= 3) {
        float xs[8][8];
#pragma unroll
        for (int t = 0; t < 8; ++t) { unpack8(blk[t], xs[t]); const float w = wave < 3 ? wv[8 * tg + t] : 0.125f;
#pragma unroll
            for (int j = 0; j < 8; ++j) xs[t][j] *= w; }
        lptr dstT = wave < 3 ? VwT + ((((wave - 1) * 8 + cgq) * 8 * 72) << 1) : KT + ((cgq * 8 * 72) << 1);
#pragma unroll
        for (int j = 0; j < 8; ++j) {
            float v[8];
#pragma unroll
            for (int t = 0; t < 8; ++t) v[t] = xs[t][j];
            *(LAS u32x4*)(dstT + ((j * 72 + 8 * tg) << 1)) = pack8(v);
        }
    }
    __syncthreads();
    {
        bf16_t* dst = (bf16_t*)XMC + ((size_t)nh * 128 + c) * 8192;
        bf16x8 b0 = lds_frag(VwT, 16 * wave + fr, fq * 8, 72), b1 = lds_frag(VwT, 16 * wave + fr, 32 + fq * 8, 72);
#pragma unroll
        for (int mt = 0; mt < 4; ++mt) {
            f32x4 acc = {0.f, 0.f, 0.f, 0.f};
            acc = mfma16(lds_frag(KT, 16 * mt + fr, fq * 8, 72), b0, acc);
            acc = mfma16(lds_frag(KT, 16 * mt + fr, 32 + fq * 8, 72), b1, acc);
            { u32x2 w; w[0] = pk2(acc[0], acc[1]); w[1] = pk2(acc[2], acc[3]); *(u32x2*)(dst + (16 * wave + fr) * 64 + 16 * mt + 4 * fq) = w; }
        }
    }
    if (tid < 64) {
        float s = 0.f;
#pragma unroll
        for (int t8 = 0; t8 < 8; ++t8) {
            float kf[8]; unpack8(*(const LAS u32x4*)(KT + ((tid * 72 + t8 * 8) << 1)), kf);
#pragma unroll
            for (int jx = 0; jx < 8; ++jx) s += kf[jx] * wv[t8 * 8 + jx];
        }
        XMN[((size_t)nh * 128 + c) * 64 + tid] = s;
    }
    __syncthreads();
}

__device__ __forceinline__ void ssd_local(lptr lds, const Ctx& X, int l, int task, int tid) {
    const int g = task & 1, c = (task >> 1) & 127, n = task >> 8;
    const int lane = tid & 63, wave = tid >> 6, fr = lane & 15, fq = lane >> 4;
    const int seq0 = n * SEQ, row0 = seq0 + c * 64;
    lptr XwT = lds;
    lptr BT = lds + 36864;
    LAS float* wl = (LAS float*)(lds + 55296);
    {
        const float* cw = XPAR(P_CW) + l * 4096; const float* cb = XPAR(P_CB) + l * 1024;
        const int tg = lane & 7, cg = wave * 8 + (lane >> 3);
        float o[8][8];
        if (wave < 6) {
            const int ch = cg < 32 ? g * 256 + cg * 8 : 512 + g * 128 + (cg - 32) * 8;
            conv8x8(XU, seq0, c * 64 + 8 * tg, ch, cw, cb, o);
        }
        if (wave < 4) {
            const int hh = 4 * g + wave;
            const float dt = softplusf_(bf2f(XU[(unsigned)(row0 + lane) * NIN + C_BDT + hh]) + XPAR(P_DTB)[l * 8 + hh]);
            const float A = -__expf(XPAR(P_ALOG)[l * 8 + hh]);
            const float a = wave_scan_sum(dt * A, lane);
            const float aL = lane63(a);
            wl[wave * 64 + lane] = __expf(aL - a) * dt;
            if (lane == 0) XSA[(n * 8 + hh) * 128 + c] = aL;
        }
        __syncthreads();
        if (wave < 4) {
            float wt[8];
#pragma unroll
            for (int t = 0; t < 8; ++t) wt[t] = wl[wave * 64 + 8 * tg + t];
#pragma unroll
            for (int jx = 0; jx < 8; ++jx) {
                float v[8];
#pragma unroll
                for (int t = 0; t < 8; ++t) v[t] = o[t][jx] * wt[t];
                *(LAS u32x4*)(XwT + (((cg * 8 + jx) * 72 + 8 * tg) << 1)) = pack8(v);
            }
        } else if (wave < 6) {
#pragma unroll
            for (int jx = 0; jx < 8; ++jx) {
                float v[8];
#pragma unroll
                for (int t = 0; t < 8; ++t) v[t] = o[t][jx];
                *(LAS u32x4*)(BT + ((((cg - 32) * 8 + jx) * 72 + 8 * tg) << 1)) = pack8(v);
            }
        }
    }
    __syncthreads();
    {
        const int hl = wave >> 1, ph = wave & 1, hh = 4 * g + hl;
        bf16_t* dst = (bf16_t*)XSH + ((size_t)(n * 8 + hh) * 128 + c) * 8192;
        bf16x8 bx[2][2];
#pragma unroll
        for (int ntl = 0; ntl < 2; ++ntl)
#pragma unroll
            for (int kk = 0; kk < 2; ++kk) bx[ntl][kk] = lds_frag(XwT, hl * 64 + ph * 32 + ntl * 16 + fr, kk * 32 + fq * 8, 72);
#pragma unroll
        for (int mt = 0; mt < 8; ++mt) {
            bf16x8 a0 = lds_frag(BT, 16 * mt + fr, fq * 8, 72), a1 = lds_frag(BT, 16 * mt + fr, 32 + fq * 8, 72);
#pragma unroll
            for (int ntl = 0; ntl < 2; ++ntl) {
                f32x4 acc = {0.f, 0.f, 0.f, 0.f};
                acc = mfma16(a0, bx[ntl][0], acc); acc = mfma16(a1, bx[ntl][1], acc);
                { u32x2 w; w[0] = pk2(acc[0], acc[1]); w[1] = pk2(acc[2], acc[3]); *(u32x2*)(dst + (ph * 32 + ntl * 16 + fr) * 128 + 16 * mt + 4 * fq) = w; }
            }
        }
    }
    __syncthreads();
}

__device__ __forceinline__ void swa_prompt(lptr lds, const Ctx& X, int l, int task, int tid) {
    const int kvh = task & 1, qb = (task >> 1) & 63, n = task >> 7;
    const int lane = tid & 63, wave = tid >> 6, fr = lane & 15, fq = lane >> 4;
    const int seq0 = n * SEQ;
    lptr Kn = lds;
    lptr Vt = lds + 36864;
    lptr Pw = lds + 70656 + wave * 8448;
    const float* knw = XPAR(P_KNW) + l * 64; const float* qnw = XPAR(P_QNW) + l * 64;
#pragma unroll
    for (int it = 0; it < 2; ++it) {
        const int item = tid + it * NT, j = item >> 2, qd = item & 3, t = qb * 128 - 128 + j;
        float o1[8], o2[8];
        {
            const int tc = t >= 0 ? t : 0;
            const bf16_t* kr = XU + (unsigned)(seq0 + tc) * NIN + C_CK + kvh * 64;
            float x1[8], x2[8]; unpack8(*(const u32x4*)(kr + qd * 8), x1); unpack8(*(const u32x4*)(kr + 32 + qd * 8), x2);
            float ss = 0.f;
#pragma unroll
            for (int jj = 0; jj < 8; ++jj) ss += x1[jj] * x1[jj] + x2[jj] * x2[jj];
            ss += __shfl_xor(ss, 1); ss += __shfl_xor(ss, 2);
            const float rs = rsqrtf(ss * (1.f / 64.f) + EPS);
            const f32x4* cs = (const f32x4*)(XROPE + ((size_t)tc * 32 + qd * 8) * 2);
            f32x4 csv[4];
#pragma unroll
            for (int q4 = 0; q4 < 4; ++q4) csv[q4] = cs[q4];
            const float zm = t >= 0 ? 1.f : 0.f;
#pragma unroll
            for (int jj = 0; jj < 8; ++jj) {
                const float a = x1[jj] * rs * knw[qd * 8 + jj], b = x2[jj] * rs * knw[32 + qd * 8 + jj], co = csv[jj >> 1][(jj & 1) * 2], si = csv[jj >> 1][(jj & 1) * 2 + 1];
                o1[jj] = (a * co - b * si) * zm; o2[jj] = (b * co + a * si) * zm;
            }
        }
        *(LAS u32x4*)(Kn + ((j * 72 + qd * 8) << 1)) = pack8(o1);
        *(LAS u32x4*)(Kn + ((j * 72 + 32 + qd * 8) << 1)) = pack8(o2);
        if (qb == 63 && j >= 128) {
            float* ko = X.out + O_PK + ((((size_t)l * 2 + n) * 128 + (j - 128)) * 2 + kvh) * 64;
            *(f32x4*)(ko + qd * 8) = (f32x4){o1[0], o1[1], o1[2], o1[3]}; *(f32x4*)(ko + qd * 8 + 4) = (f32x4){o1[4], o1[5], o1[6], o1[7]};
            *(f32x4*)(ko + 32 + qd * 8) = (f32x4){o2[0], o2[1], o2[2], o2[3]}; *(f32x4*)(ko + 32 + qd * 8 + 4) = (f32x4){o2[4], o2[5], o2[6], o2[7]};
        }
    }
    if (wave < 4) {
        const int tg = tid & 31, cg = tid >> 5;
        u32x4 vb[8];
#pragma unroll
        for (int t8 = 0; t8 < 8; ++t8) {
            const int jk = 8 * tg + t8, t = qb * 128 - 128 + jk;
            u32x4 w = *(const u32x4*)(XU + (unsigned)(seq0 + (t >= 0 ? t : 0)) * NIN + C_CV + kvh * 64 + cg * 8);
            const unsigned msk = t >= 0 ? 0xffffffffu : 0u;
            vb[t8] = (u32x4){w[0] & msk, w[1] & msk, w[2] & msk, w[3] & msk};
        }
#pragma unroll
        for (int jj = 0; jj < 8; ++jj) {
            u32x4 w;
#pragma unroll
            for (int tp = 0; tp < 4; ++tp) {
                const unsigned lo = (vb[2 * tp][jj >> 1] >> ((jj & 1) * 16)) & 0xffffu, hi = (vb[2 * tp + 1][jj >> 1] >> ((jj & 1) * 16)) & 0xffffu;
                w[tp] = lo | (hi << 16);
            }
            *(LAS u32x4*)(Vt + (((cg * 8 + jj) * 264 + 8 * tg) << 1)) = w;
        }
        if (qb == 63 && tg >= 16) {
#pragma unroll
            for (int t8 = 0; t8 < 8; ++t8) {
                float x[8]; unpack8(vb[t8], x);
                float* vo = X.out + O_PV + ((((size_t)l * 2 + n) * 128 + (8 * tg + t8 - 128)) * 2 + kvh) * 64 + cg * 8;
                *(f32x4*)(vo) = (f32x4){x[0], x[1], x[2], x[3]}; *(f32x4*)(vo + 4) = (f32x4){x[4], x[5], x[6], x[7]};
            }
        }
    }
    __syncthreads();
    const int hq = kvh * 4 + (wave >> 1), i0 = (wave & 1) * 64;
    const float sink = XPAR(P_SINK)[l * 8 + hq];
    float qw1[8], qw2[8];
#pragma unroll
    for (int jj = 0; jj < 8; ++jj) { qw1[jj] = qnw[fq * 8 + jj]; qw2[jj] = qnw[32 + fq * 8 + jj]; }
    u32x4 qn0, qn1; f32x4 csn[4];
    {
        const int t = qb * 128 + i0 + fr;
        const bf16_t* qr = XU + (unsigned)(seq0 + t) * NIN + C_CQ + hq * 64;
        qn0 = *(const u32x4*)(qr + fq * 8); qn1 = *(const u32x4*)(qr + 32 + fq * 8);
        const f32x4* cs = (const f32x4*)(XROPE + ((size_t)t * 32 + fq * 8) * 2);
#pragma unroll
        for (int q4 = 0; q4 < 4; ++q4) csn[q4] = cs[q4];
    }
#pragma unroll 1
    for (int mt = 0; mt < 4; ++mt) {
        const int q0 = i0 + mt * 16;
        const u32x4 q0r = qn0, q1r = qn1; f32x4 csc[4];
#pragma unroll
        for (int q4 = 0; q4 < 4; ++q4) csc[q4] = csn[q4];
        {
            const int mn = mt < 3 ? mt + 1 : 3;
            const int t = qb * 128 + i0 + mn * 16 + fr;
            const bf16_t* qr = XU + (unsigned)(seq0 + t) * NIN + C_CQ + hq * 64;
            qn0 = *(const u32x4*)(qr + fq * 8); qn1 = *(const u32x4*)(qr + 32 + fq * 8);
            const f32x4* cs = (const f32x4*)(XROPE + ((size_t)t * 32 + fq * 8) * 2);
#pragma unroll
            for (int q4 = 0; q4 < 4; ++q4) csn[q4] = cs[q4];
        }
        bf16x8 a0, a1;
        {
            float x1[8], x2[8]; unpack8(q0r, x1); unpack8(q1r, x2);
            float ss = 0.f;
#pragma unroll
            for (int jj = 0; jj < 8; ++jj) ss += x1[jj] * x1[jj] + x2[jj] * x2[jj];
            ss += __shfl_xor(ss, 16); ss += __shfl_xor(ss, 32);
            const float rs = rsqrtf(ss * (1.f / 64.f) + EPS) * 0.125f;
            float o1[8], o2[8];
#pragma unroll
            for (int jj = 0; jj < 8; ++jj) {
                const float a = x1[jj] * rs * qw1[jj], b = x2[jj] * rs * qw2[jj], co = csc[jj >> 1][(jj & 1) * 2], si = csc[jj >> 1][(jj & 1) * 2 + 1];
                o1[jj] = a * co - b * si; o2[jj] = b * co + a * si;
            }
            a0 = as_frag(pack8(o1)); a1 = as_frag(pack8(o2));
        }
        const int tlo = q0 >> 4;
        const int qi = q0 + fr;
        const int dlo = qb > 0 ? 1 : (128 - qi > 1 ? 128 - qi : 1);
        f32x4 s[16];
        float mx = -3.0e38f;
#pragma unroll
        for (int ntl = 0; ntl < 16; ++ntl) {
            if (ntl >= tlo && ntl <= tlo + 8) {
                f32x4 acc = {0.f, 0.f, 0.f, 0.f};
                acc = mfma16(lds_frag(Kn, 16 * ntl + fr, fq * 8, 72), a0, acc);
                acc = mfma16(lds_frag(Kn, 16 * ntl + fr, 32 + fq * 8, 72), a1, acc);
                if (ntl == tlo || ntl == tlo + 8 || qb == 0) {
#pragma unroll
                    for (int ii = 0; ii < 4; ++ii) {
                        const int dk = 16 * ntl + 4 * fq + ii - qi;
                        acc[ii] = ((unsigned)(dk - dlo) <= (unsigned)(128 - dlo)) ? acc[ii] : -3.0e38f;
                    }
                }
                mx = fmaxf(mx, fmaxf(fmaxf(acc[0], acc[1]), fmaxf(acc[2], acc[3])));
                s[ntl] = acc;
            }
        }
        mx = fmaxf(mx, __shfl_xor(mx, 16)); mx = fmaxf(mx, __shfl_xor(mx, 32));
        mx = fmaxf(mx, sink);
        float sum = 0.f;
#pragma unroll
        for (int ntl = 0; ntl < 16; ++ntl) {
            if (ntl >= tlo && ntl <= tlo + 8) {
#pragma unroll
                for (int ii = 0; ii < 4; ++ii) { const float e = __expf(s[ntl][ii] - mx); s[ntl][ii] = e; sum += e; }
            }
        }
        sum += __shfl_xor(sum, 16); sum += __shfl_xor(sum, 32);
        const float inv = rcpf_(sum + __expf(sink - mx));
        const int klo = q0 >> 5, khi = (q0 + 143) >> 5;
#pragma unroll
        for (int ntl = 0; ntl < 16; ++ntl) {
            if (ntl >= tlo && ntl <= tlo + 8) {
                u32x2 w; w[0] = pk2(s[ntl][0] * inv, s[ntl][1] * inv); w[1] = pk2(s[ntl][2] * inv, s[ntl][3] * inv);
                *(LAS u32x2*)(Pw + ((fr * 264 + 16 * ntl + 4 * fq) << 1)) = w;
            } else if ((ntl >> 1) >= klo && (ntl >> 1) <= khi) {
                u32x2 w = {0u, 0u};
                *(LAS u32x2*)(Pw + ((fr * 264 + 16 * ntl + 4 * fq) << 1)) = w;
            }
        }
        u32x2 czv[4];
#pragma unroll
        for (int ntl = 0; ntl < 4; ++ntl) czv[ntl] = *(const u32x2*)(XU + ((unsigned)seq0 + qb * 128 + q0 + fr) * NIN + C_CZ + hq * 64 + 16 * ntl + 4 * fq);
        LDS_FENCE();
        f32x4 o[4];
#pragma unroll
        for (int ntl = 0; ntl < 4; ++ntl) o[ntl] = (f32x4){0.f, 0.f, 0.f, 0.f};
#pragma unroll
        for (int kk = 0; kk < 8; ++kk) {
            if (kk >= klo && kk <= khi) {
                const bf16x8 a = lds_frag(Pw, fr, kk * 32 + fq * 8, 264);
#pragma unroll
                for (int ntl = 0; ntl < 4; ++ntl) o[ntl] = mfma16(lds_frag(Vt, 16 * ntl + fr, kk * 32 + fq * 8, 264), a, o[ntl]);
            }
        }
        LDS_FENCE();
        {
            const unsigned row = (unsigned)seq0 + qb * 128 + q0 + fr;
#pragma unroll
            for (int ntl = 0; ntl < 4; ++ntl) {
                const float z0 = __uint_as_float(czv[ntl][0] << 16), z1 = __uint_as_float(czv[ntl][0] & 0xffff0000u), z2 = __uint_as_float(czv[ntl][1] << 16), z3 = __uint_as_float(czv[ntl][1] & 0xffff0000u);
                u32x2 w; w[0] = pk2(o[ntl][0] * siluf_(z0), o[ntl][1] * siluf_(z1)); w[1] = pk2(o[ntl][2] * siluf_(z2), o[ntl][3] * siluf_(z3));
                *(u32x2*)(XMIX + row * DMIX + 1024 + hq * 64 + 16 * ntl + 4 * fq) = w;
            }
        }
    }
    __syncthreads();
}

__device__ __forceinline__ void sample_task(lptr lds, const Ctx& X, int l, int b, int part, int tid) {
    LAS float* uf = (LAS float*)lds;
    LAS float* xbc = (LAS float*)(lds + 19968);
    LAS float* numv = (LAS float*)(lds + 24064);
    LAS float* yv = (LAS float*)(lds + 26112);
    LAS float* red = (LAS float*)(lds + 28160);
    LAS float* qs = (LAS float*)(lds + 28416);
    LAS float* kn = (LAS float*)(lds + 30464);
    LAS float* sc = (LAS float*)(lds + 30976);
    const int lane = tid & 63, wave = tid >> 6;
    const size_t row = (size_t)TP + b;
    const bf16_t* ur = XU + row * NIN;
    const size_t lb = (size_t)l * 128 + b;
    f32x4 kpre[8], vpre[8];
    if (part == 2) {
        const float* kc = X.ck + lb * 16384; const float* vc = X.cv + lb * 16384;
#pragma unroll
        for (int it = 0; it < 8; ++it) {
            const int e = (tid + it * NT) * 4, e2 = e < 127 * 128 ? e + 128 : e;
            kpre[it] = __builtin_nontemporal_load((const f32x4*)(kc + e2)); vpre[it] = __builtin_nontemporal_load((const f32x4*)(vc + e2));
        }
    }
    f32x4 spre[4][4];
    if (part == 0) {
#pragma unroll
        for (int h = 0; h < 4; ++h)
#pragma unroll
            for (int it = 0; it < 4; ++it) spre[h][it] = __builtin_nontemporal_load((const f32x4*)(X.stC + (lb * 4 + h) * 8192 + (tid + it * NT) * 4));
    }
    if (part == 1) {
#pragma unroll
        for (int h = 0; h < 4; ++h)
#pragma unroll
            for (int it = 0; it < 4; ++it) spre[h][it] = __builtin_nontemporal_load((const f32x4*)(X.ssm + (lb * 8 + h) * 8192 + (tid + it * NT) * 4));
    }
    {
        const int c_lo = part == 0 ? 0 : (part == 1 ? C_BZ : C_CQ), c_hi = part == 0 ? C_BZ : (part == 1 ? C_CQ : DIN);
        if (tid < ((c_hi - c_lo) >> 3)) {
            float f[8]; unpack8(*(const u32x4*)(ur + c_lo + 8 * tid), f);
#pragma unroll
            for (int j = 0; j < 8; ++j) uf[c_lo + 8 * tid + j] = f[j];
        }
    }
    __syncthreads();
    if (part == 0) {
#pragma unroll
    for (int h = 0; h < 4; ++h) {
        const float ig = uf[C_AI + h] + XPAR(P_AIB)[l * 4 + h], fg = uf[C_AF + h] + XPAR(P_AFB)[l * 4 + h];
        const float ls = logsigf_(fg), m0 = X.stM[lb * 4 + h];
        const float mn = fmaxf(ls + m0, ig), sp = __expf(ls + m0 - mn), sl = __expf(ig - mn);
        const float* C0 = X.stC + (lb * 4 + h) * 8192; float* C1 = X.out + O_SC + (lb * 4 + h) * 8192;
#pragma unroll
        for (int it = 0; it < 4; ++it) {
            const int e = (tid + it * NT) * 4, v = e >> 6, k = e & 63;
            const f32x4 c0 = spre[h][it];
            const float vv = uf[C_AV + h * 128 + v] * sl;
            f32x4 c1; float part = 0.f;
#pragma unroll
            for (int j = 0; j < 4; ++j) { c1[j] = sp * c0[j] + vv * (uf[C_AK + h * 64 + k + j] * 0.125f); part += c1[j] * uf[C_AQ + h * 64 + k + j]; }
            __builtin_nontemporal_store(c1, (f32x4*)(C1 + e));
            part = red16(part);
            if ((lane & 15) == 0) numv[h * 128 + v] = part;
        }
        if (wave == 0) {
            const float n1 = sp * X.stN[(lb * 4 + h) * 64 + lane] + sl * uf[C_AK + h * 64 + lane] * 0.125f;
            X.out[O_SN + (lb * 4 + h) * 64 + lane] = n1;
            const float dd = wave_sum(n1 * uf[C_AQ + h * 64 + lane]);
            if (lane == 0) { red[h] = dd; red[4 + h] = mn; X.out[O_SM + lb * 4 + h] = mn; }
        }
    }
    __syncthreads();
    float hv;
    { const int h = tid >> 7; hv = numv[tid] * rcpf_(fmaxf(fabsf(red[h]), __expf(-red[4 + h]))); const float ss = wave_sum(hv * hv); if (lane == 0) red[8 + wave] = ss; }
    __syncthreads();
    { const int h = tid >> 7; const float rs = rsqrtf((red[8 + 2 * h] + red[9 + 2 * h]) * (1.f / 128.f) + EPS);
      XMIX[row * DMIX + tid] = (bf16_t)f2bf(hv * rs * XPAR(P_ANW)[l * 512 + tid] * sigmoidf_(uf[C_AO + tid]) * siluf_(uf[C_AZ + tid])); }
    }
    if (part == 1) {
    {
        const float* buf = X.conv + lb * 3 * 1024; float* oc = X.out + O_SCONV + lb * 3 * 1024;
        const float* cw = XPAR(P_CW) + l * 4096;
#pragma unroll
        for (int it = 0; it < 2; ++it) {
            const int ch = tid + it * NT;
            const float f0 = buf[ch], f1 = buf[1024 + ch], f2 = buf[2048 + ch], f3 = uf[C_BX + ch];
            const float acc = XPAR(P_CB)[l * 1024 + ch] + f0 * cw[ch] + f1 * cw[1024 + ch] + f2 * cw[2048 + ch] + f3 * cw[3072 + ch];
            xbc[ch] = siluf_(acc);
            oc[ch] = f1; oc[1024 + ch] = f2; oc[2048 + ch] = f3;
        }
    }
    __syncthreads();
#pragma unroll 1
    for (int hb = 0; hb < 8; hb += 4)
#pragma unroll
    for (int hk = 0; hk < 4; ++hk) {
        const int hh = hb + hk;
        const float dt = softplusf_(uf[C_BDT + hh] + XPAR(P_DTB)[l * 8 + hh]);
        const float dA = __expf(-dt * __expf(XPAR(P_ALOG)[l * 8 + hh]));
        const int g = hh >> 2;
        const float* h0p = X.ssm + (lb * 8 + hh) * 8192; float* h1p = X.out + O_SH + (lb * 8 + hh) * 8192;
#pragma unroll
        for (int it = 0; it < 4; ++it) {
            const int e = (tid + it * NT) * 4, p = e >> 7, s = e & 127;
            f32x4 h0; if (hb == 0) h0 = spre[hk][it]; else h0 = __builtin_nontemporal_load((const f32x4*)(h0p + e));
            const float xv = xbc[hh * 64 + p] * dt;
            f32x4 h1; float part = 0.f;
#pragma unroll
            for (int j = 0; j < 4; ++j) { h1[j] = dA * h0[j] + xv * xbc[512 + g * 128 + s + j]; part += h1[j] * xbc[768 + g * 128 + s + j]; }
            __builtin_nontemporal_store(h1, (f32x4*)(h1p + e));
            part = red16(part); part += __shfl_xor(part, 16);
            if ((lane & 31) == 0) yv[hh * 64 + p] = part;
        }
    }
    __syncthreads();
    float gb;
    { const int hh = tid >> 6; const float y = yv[tid] + XPAR(P_BD)[l * 8 + hh] * xbc[tid]; gb = y * siluf_(uf[C_BZ + tid]); const float ss = wave_sum(gb * gb); if (lane == 0) red[16 + wave] = ss; }
    __syncthreads();
    { const int g = tid >> 8; const float rs = rsqrtf((red[16 + 4 * g] + red[17 + 4 * g] + red[18 + 4 * g] + red[19 + 4 * g]) * (1.f / 256.f) + EPS);
      XMIX[row * DMIX + 512 + tid] = (bf16_t)f2bf(gb * rs * XPAR(P_BNW)[l * 512 + tid]); }
    }
    if (part == 2) {
    lptr Kl = lds + 36864;
    lptr Vl = lds + 36864 + 34816;
    if (tid < 320) {
        const int vec = tid >> 5, d = tid & 31, base = vec < 8 ? C_CQ + vec * 64 : C_CK + (vec - 8) * 64;
        const float x1 = uf[base + d], x2 = uf[base + 32 + d];
        float ss = x1 * x1 + x2 * x2; ss = red16(ss); ss += __shfl_xor(ss, 16);
        const float rs = rsqrtf(ss * (1.f / 64.f) + EPS);
        const float* w = vec < 8 ? XPAR(P_QNW) + l * 64 : XPAR(P_KNW) + l * 64;
        const float a = x1 * rs * w[d], bb = x2 * rs * w[d + 32];
        const float co = XROPE[((size_t)8192 * 32 + d) * 2], si = XROPE[((size_t)8192 * 32 + d) * 2 + 1];
        const float o1 = a * co - bb * si, o2 = bb * co + a * si;
        if (vec < 8) { qs[vec * 64 + d] = o1 * 0.125f; qs[vec * 64 + 32 + d] = o2 * 0.125f; } else { kn[(vec - 8) * 64 + d] = o1; kn[(vec - 8) * 64 + 32 + d] = o2; }
    }
    __syncthreads();
    {
        float* ko = X.out + O_SK + lb * 16384; float* vo = X.out + O_SV + lb * 16384;
#pragma unroll
        for (int it = 0; it < 8; ++it) {
            const int e = (tid + it * NT) * 4, j = e >> 7, r = e & 127;
            f32x4 kv = kpre[it], vv = vpre[it];
            if (j == 127) { kv = (f32x4){kn[r], kn[r + 1], kn[r + 2], kn[r + 3]}; vv = (f32x4){uf[C_CV + r], uf[C_CV + r + 1], uf[C_CV + r + 2], uf[C_CV + r + 3]}; }
            __builtin_nontemporal_store(kv, (f32x4*)(ko + e)); __builtin_nontemporal_store(vv, (f32x4*)(vo + e));
            u32x2 wk, wv2; wk[0] = pk2(kv[0], kv[1]); wk[1] = pk2(kv[2], kv[3]); wv2[0] = pk2(vv[0], vv[1]); wv2[1] = pk2(vv[2], vv[3]);
            *(LAS u32x2*)(Kl + ((j * 136 + r) << 1)) = wk; *(LAS u32x2*)(Vl + ((j * 136 + r) << 1)) = wv2;
        }
    }
    __syncthreads();
    if (tid < 256) {
        const int kvh = tid >> 7, jj = tid & 127;
        float s0 = 0.f, s1 = 0.f, s2 = 0.f, s3 = 0.f;
#pragma unroll 2
        for (int d8 = 0; d8 < 8; ++d8) {
            float kf[8]; unpack8(*(const LAS u32x4*)(Kl + ((jj * 136 + kvh * 64 + d8 * 8) << 1)), kf);
#pragma unroll
            for (int j = 0; j < 8; ++j) {
                s0 += kf[j] * qs[(kvh * 4 + 0) * 64 + d8 * 8 + j]; s1 += kf[j] * qs[(kvh * 4 + 1) * 64 + d8 * 8 + j];
                s2 += kf[j] * qs[(kvh * 4 + 2) * 64 + d8 * 8 + j]; s3 += kf[j] * qs[(kvh * 4 + 3) * 64 + d8 * 8 + j];
            }
        }
        sc[(kvh * 4 + 0) * 128 + jj] = s0; sc[(kvh * 4 + 1) * 128 + jj] = s1; sc[(kvh * 4 + 2) * 128 + jj] = s2; sc[(kvh * 4 + 3) * 128 + jj] = s3;
    }
    __syncthreads();
    {
        const int hq = wave; const float s0 = sc[hq * 128 + lane], s1 = sc[hq * 128 + 64 + lane], sink = XPAR(P_SINK)[l * 8 + hq];
        const float m = fmaxf(wave_max(fmaxf(s0, s1)), sink);
        const float e0 = __expf(s0 - m), e1 = __expf(s1 - m);
        const float inv = rcpf_(wave_sum(e0 + e1) + __expf(sink - m));
        sc[hq * 128 + lane] = e0 * inv; sc[hq * 128 + 64 + lane] = e1 * inv;
    }
    __syncthreads();
    {
        const int hq = tid >> 6, d = tid & 63, kvh = hq >> 2;
        float o = 0.f;
#pragma unroll 16
        for (int jj = 0; jj < 128; ++jj) o += sc[hq * 128 + jj] * bf2f(*(const LAS bf16_t*)(Vl + ((jj * 136 + kvh * 64 + d) << 1)));
        XMIX[row * DMIX + 1024 + tid] = (bf16_t)f2bf(o * siluf_(uf[C_CZ + tid]));
    }
    }
    __syncthreads();
}

__device__ __forceinline__ void scans(const Ctx& X, int l, int gt, int nthreads) {
    for (int item = gt; item < 98816; item += nthreads) {
        if (item < 32768) {
            const int nh = item >> 12, e = (item & 4095) * 2;
            const bf16_t* base = (const bf16_t*)XMC + (size_t)nh * 128 * 8192 + e;
            const float* ml = XML + nh * 128; const float* bl = XBL + nh * 128;
            float m = 0.f; f32x2 st = {0.f, 0.f};
            for (int c0 = 0; c0 < 128; c0 += 16) {
                f32x2 cl[16];
#pragma unroll
                for (int j = 0; j < 16; ++j) { const unsigned w = *(const unsigned*)(base + (size_t)(c0 + j) * 8192); cl[j] = (f32x2){__uint_as_float(w << 16), __uint_as_float(w & 0xffff0000u)}; }
#pragma unroll
                for (int j = 0; j < 16; ++j) {
                    const float mlj = ml[c0 + j], blj = bl[c0 + j], mn = fmaxf(blj + m, mlj), sp = __expf(blj + m - mn), sl = __expf(mlj - mn);
                    *(unsigned*)(XCSB + ((size_t)nh * 128 + c0 + j) * 8192 + e) = pk2(st[0], st[1]);
                    if (e == 0) XMS[nh * 128 + c0 + j] = m;
                    st = st * sp + cl[j] * sl; m = mn;
                }
            }
            *(f32x2*)(X.out + O_PC + ((size_t)l * 8 + nh) * 8192 + e) = st;
            if (e == 0) X.out[O_PM + l * 8 + nh] = m;
        } else if (item < 98304) {
            const int i1 = item - 32768, nhh = i1 >> 12, e = (i1 & 4095) * 2;
            const bf16_t* base = (const bf16_t*)XSH + (size_t)nhh * 128 * 8192 + e;
            const float* al = XSA + nhh * 128;
            f32x2 st = {0.f, 0.f};
            for (int c0 = 0; c0 < 128; c0 += 16) {
                f32x2 cl[16];
#pragma unroll
                for (int j = 0; j < 16; ++j) { const unsigned w = *(const unsigned*)(base + (size_t)(c0 + j) * 8192); cl[j] = (f32x2){__uint_as_float(w << 16), __uint_as_float(w & 0xffff0000u)}; }
#pragma unroll
                for (int j = 0; j < 16; ++j) {
                    const float dec = __expf(al[c0 + j]);
                    *(unsigned*)(XHSB + ((size_t)nhh * 128 + c0 + j) * 8192 + e) = pk2(st[0], st[1]);
                    st = st * dec + cl[j];
                }
            }
            *(f32x2*)(X.out + O_PH + ((size_t)l * 16 + nhh) * 8192 + e) = st;
        } else {
            const int i2 = item - 98304, nh = i2 >> 6, k = i2 & 63;
            float* base = XMN + (size_t)nh * 128 * 64 + k;
            const float* ml = XML + nh * 128; const float* bl = XBL + nh * 128;
            float m = 0.f, st = 0.f;
            for (int c = 0; c < 128; ++c) {
                const float mlj = ml[c], blj = bl[c], mn = fmaxf(blj + m, mlj), sp = __expf(blj + m - mn), sl = __expf(mlj - mn);
                const float cl = base[c * 64];
                XNS[(size_t)nh * 128 * 64 + c * 64 + k] = st;
                st = st * sp + cl * sl; m = mn;
            }
            X.out[O_PN + ((size_t)l * 8 + nh) * 64 + k] = st;
        }
    }
}

__device__ __forceinline__ void mlstm_out(lptr lds, const Ctx& X, int l, int task, int tid) {
    const int h = task & 3, c = (task >> 2) & 127, n = task >> 9;
    const int lane = tid & 63, wave = tid >> 6, fr = lane & 15, fq = lane >> 4;
    const int row0 = n * SEQ + c * 64, nh = n * 4 + h;
    lptr Qs = lds;
    lptr Ks = lds + 9216;
    lptr Vt = lds + 18432;
    lptr Sb = lds + 36864 + wave * 2304;
    LAS float* bv = (LAS float*)(lds + 55296);
    LAS float* dv = bv + 64;
    LAS float* mtv = bv + 128;
    LAS float* siv = bv + 192;
    LAS float* qnv = bv + 256;
    LAS float* ssqp = bv + 384;
    LAS float* nsv = bv + 512;
    const int mti = wave >> 1, half = wave & 1;
    u32x4 csf[2][4];
    {
        const bf16_t* Cs = XCSB + ((size_t)nh * 128 + c) * 8192;
#pragma unroll
        for (int kk = 0; kk < 2; ++kk)
#pragma unroll
            for (int ntl = 0; ntl < 4; ++ntl) csf[kk][ntl] = *(const u32x4*)(Cs + (64 * half + 16 * ntl + fr) * 64 + kk * 32 + fq * 8);
    }
    u32x2 aov[4], azv[4]; f32x4 anw[4];
#pragma unroll
    for (int ntl = 0; ntl < 4; ++ntl) {
        const int v = h * 128 + 64 * half + 16 * ntl + 4 * fq;
        const unsigned row = (unsigned)row0 + 16 * mti + fr;
        anw[ntl] = *(const f32x4*)(XPAR(P_ANW) + l * 512 + v);
        aov[ntl] = *(const u32x2*)(XU + row * NIN + C_AO + v); azv[ntl] = *(const u32x2*)(XU + row * NIN + C_AZ + v);
    }
    u32x4 qraw, kraw, vblk[8];
    const int tgv = lane & 7, cgv = (wave & 1) * 8 + (lane >> 3);
    {
        const int tok = tid >> 3, k8 = (tid & 7) * 8;
        const bf16_t* ur = XU + (unsigned)(row0 + tok) * NIN;
        qraw = *(const u32x4*)(ur + C_AQ + h * 64 + k8); kraw = *(const u32x4*)(ur + C_AK + h * 64 + k8);
        if (wave == 2 || wave == 3) {
#pragma unroll
            for (int t = 0; t < 8; ++t) vblk[t] = *(const u32x4*)(XU + (unsigned)(row0 + 8 * tgv + t) * NIN + C_AV + h * 128 + cgv * 8);
        }
    }
    if (wave == 0) {
        const bf16_t* ur = XU + (unsigned)(row0 + lane) * NIN;
        const float fg = bf2f(ur[C_AF + h]) + XPAR(P_AFB)[l * 4 + h], ig = bf2f(ur[C_AI + h]) + XPAR(P_AIB)[l * 4 + h];
        const float b = wave_scan_sum(logsigf_(fg), lane);
        const float dd = ig - b;
        const float cm = wave_scan_max(dd, lane);
        const float ms = XMS[nh * 128 + c];
        const float mt = b + fmaxf(ms, cm);
        bv[lane] = b; dv[lane] = dd; mtv[lane] = mt; siv[lane] = __expf(b + ms - mt);
        nsv[lane] = XNS[((size_t)nh * 128 + c) * 64 + lane];
    }
    {
        const int tok = tid >> 3, k8 = (tid & 7) * 8;
        *(LAS u32x4*)(Qs + ((tok * 72 + k8) << 1)) = qraw;
        float x[8]; unpack8(kraw, x);
#pragma unroll
        for (int j = 0; j < 8; ++j) x[j] *= 0.125f;
        *(LAS u32x4*)(Ks + ((tok * 72 + k8) << 1)) = pack8(x);
    }
    if (wave == 2 || wave == 3) {
#pragma unroll
        for (int j = 0; j < 8; ++j) {
            u32x4 w;
#pragma unroll
            for (int tp = 0; tp < 4; ++tp) {
                const unsigned lo = (vblk[2 * tp][j >> 1] >> ((j & 1) * 16)) & 0xffffu, hi = (vblk[2 * tp + 1][j >> 1] >> ((j & 1) * 16)) & 0xffffu;
                w[tp] = lo | (hi << 16);
            }
            *(LAS u32x4*)(Vt + (((cgv * 8 + j) * 72 + 8 * tgv) << 1)) = w;
        }
    }
    __syncthreads();
    bf16x8 qa[2];
    qa[0] = lds_frag(Qs, 16 * mti + fr, fq * 8, 72); qa[1] = lds_frag(Qs, 16 * mti + fr, 32 + fq * 8, 72);
    const int tq = 16 * mti + fr;
    float qn;
    {
        float x0[8], x1[8]; unpack8(__builtin_bit_cast(u32x4, qa[0]), x0); unpack8(__builtin_bit_cast(u32x4, qa[1]), x1);
        float d = 0.f;
#pragma unroll
        for (int j = 0; j < 8; ++j) d += x0[j] * nsv[fq * 8 + j] + x1[j] * nsv[32 + fq * 8 + j];
        d += __shfl_xor(d, 16); d += __shfl_xor(d, 32);
        qn = d;
    }
    const float bt = bv[tq], mtq = mtv[tq], siq = siv[tq];
    float rsum = 0.f;
#pragma unroll
    for (int ntl = 0; ntl < 4; ++ntl) {
        f32x4 sT = {0.f, 0.f, 0.f, 0.f};
        sT = mfma16(lds_frag(Ks, 16 * ntl + fr, fq * 8, 72), qa[0], sT);
        sT = mfma16(lds_frag(Ks, 16 * ntl + fr, 32 + fq * 8, 72), qa[1], sT);
        float sv[4];
#pragma unroll
        for (int ii = 0; ii < 4; ++ii) {
            const int sidx = 16 * ntl + 4 * fq + ii;
            const float wgt = (sidx <= tq) ? __expf(bt + dv[sidx] - mtq) : 0.f;
            sv[ii] = wgt * sT[ii];
            rsum += sv[ii];
        }
        u32x2 w; w[0] = pk2(sv[0], sv[1]); w[1] = pk2(sv[2], sv[3]);
        *(LAS u32x2*)(Sb + ((fr * 72 + 16 * ntl + 4 * fq) << 1)) = w;
    }
    rsum += __shfl_xor(rsum, 16); rsum += __shfl_xor(rsum, 32);
    const float inv = rcpf_(fmaxf(fabsf(rsum + siq * qn), __expf(-mtq)));
    LDS_FENCE();
    f32x4 acc[4];
#pragma unroll
    for (int ntl = 0; ntl < 4; ++ntl) acc[ntl] = (f32x4){0.f, 0.f, 0.f, 0.f};
#pragma unroll
    for (int kk = 0; kk < 2; ++kk) {
        const bf16x8 sb = lds_frag(Sb, fr, kk * 32 + fq * 8, 72);
#pragma unroll
        for (int ntl = 0; ntl < 4; ++ntl) acc[ntl] = mfma16(lds_frag(Vt, 64 * half + 16 * ntl + fr, kk * 32 + fq * 8, 72), sb, acc[ntl]);
    }
#pragma unroll
    for (int kk = 0; kk < 2; ++kk) {
        float x[8]; unpack8(__builtin_bit_cast(u32x4, qa[kk]), x);
#pragma unroll
        for (int j = 0; j < 8; ++j) x[j] *= siq;
        const bf16x8 qs = as_frag(pack8(x));
#pragma unroll
        for (int ntl = 0; ntl < 4; ++ntl) acc[ntl] = mfma16(as_frag(csf[kk][ntl]), qs, acc[ntl]);
    }
    {
        float ss = 0.f;
#pragma unroll
        for (int ntl = 0; ntl < 4; ++ntl) { acc[ntl] = acc[ntl] * inv; ss += acc[ntl][0] * acc[ntl][0] + acc[ntl][1] * acc[ntl][1] + acc[ntl][2] * acc[ntl][2] + acc[ntl][3] * acc[ntl][3]; }
        ss += __shfl_xor(ss, 16); ss += __shfl_xor(ss, 32);
        if (fq == 0) ssqp[tq * 2 + half] = ss;
    }
    __syncthreads();
    {
        const float rs = rsqrtf((ssqp[tq * 2] + ssqp[tq * 2 + 1]) * (1.f / 128.f) + EPS);
        const unsigned row = (unsigned)row0 + tq;
#pragma unroll
        for (int ntl = 0; ntl < 4; ++ntl) {
            const float o[4] = {__uint_as_float(aov[ntl][0] << 16), __uint_as_float(aov[ntl][0] & 0xffff0000u), __uint_as_float(aov[ntl][1] << 16), __uint_as_float(aov[ntl][1] & 0xffff0000u)};
            const float z[4] = {__uint_as_float(azv[ntl][0] << 16), __uint_as_float(azv[ntl][0] & 0xffff0000u), __uint_as_float(azv[ntl][1] << 16), __uint_as_float(azv[ntl][1] & 0xffff0000u)};
            float y[4];
#pragma unroll
            for (int ii = 0; ii < 4; ++ii) y[ii] = acc[ntl][ii] * rs * anw[ntl][ii] * sigmoidf_(o[ii]) * siluf_(z[ii]);
            u32x2 w; w[0] = pk2(y[0], y[1]); w[1] = pk2(y[2], y[3]);
            *(u32x2*)(XMIX + row * DMIX + h * 128 + 64 * half + 16 * ntl + 4 * fq) = w;
        }
    }
    __syncthreads();
}

__device__ __forceinline__ void ssd_out(lptr lds, const Ctx& X, int l, int task, int tid) {
    const int g = task & 1, c = (task >> 1) & 127, n = task >> 8;
    const int lane = tid & 63, wave = tid >> 6, fr = lane & 15, fq = lane >> 4;
    const int seq0 = n * SEQ, row0 = seq0 + c * 64;
    lptr Cm = lds;
    lptr Bm = lds + 17408;
    lptr Xt = lds + 34816;
    LAS float* CBf = (LAS float*)(lds + 71680);
    LAS float* av = (LAS float*)(lds + 89088);
    LAS float* dtv = (LAS float*)(lds + 90112);
    LAS float* ssq = (LAS float*)(lds + 91136);
    const int hl = wave >> 1, th = wave & 1, hh = 4 * g + hl;
    u32x4 hsf[4][4];
    {
        const bf16_t* hs = XHSB + ((size_t)(n * 8 + hh) * 128 + c) * 8192;
#pragma unroll
        for (int kk = 0; kk < 4; ++kk)
#pragma unroll
            for (int ntl = 0; ntl < 4; ++ntl) hsf[kk][ntl] = *(const u32x4*)(hs + (16 * ntl + fr) * 128 + kk * 32 + fq * 8);
    }
    if (wave < 4) {
        const int hh = 4 * g + wave;
        const float dt = softplusf_(bf2f(XU[(unsigned)(row0 + lane) * NIN + C_BDT + hh]) + XPAR(P_DTB)[l * 8 + hh]);
        const float A = -__expf(XPAR(P_ALOG)[l * 8 + hh]);
        av[wave * 64 + lane] = wave_scan_sum(dt * A, lane);
        dtv[wave * 64 + lane] = dt;
    }
    {
        const float* cw = XPAR(P_CW) + l * 4096; const float* cb = XPAR(P_CB) + l * 1024;
        float o[8][8];
        if (wave < 4) {
            const int tg = lane & 7, cg = wave * 8 + (lane >> 3);
            conv8x8(XU, seq0, c * 64 + 8 * tg, g * 256 + cg * 8, cw, cb, o);
#pragma unroll
            for (int jx = 0; jx < 8; ++jx) {
                float v[8];
#pragma unroll
                for (int t = 0; t < 8; ++t) v[t] = o[t][jx];
                *(LAS u32x4*)(Xt + (((cg * 8 + jx) * 72 + 8 * tg) << 1)) = pack8(v);
            }
        } else {
            const int tg = lane >> 3, s8 = ((wave & 1) * 8 + (lane & 7)) * 8;
            conv8x8(XU, seq0, c * 64 + 8 * tg, (wave < 6 ? 512 : 768) + g * 128 + s8, cw, cb, o);
            lptr dstm = wave < 6 ? Bm : Cm;
#pragma unroll
            for (int t = 0; t < 8; ++t) *(LAS u32x4*)(dstm + (((8 * tg + t) * 136 + s8) << 1)) = pack8(o[t]);
        }
    }
    __syncthreads();
    u32x2 bzv[2][4]; f32x4 bnw[4];
#pragma unroll
    for (int ntl = 0; ntl < 4; ++ntl) {
        bnw[ntl] = *(const f32x4*)(XPAR(P_BNW) + l * 512 + hh * 64 + 16 * ntl + 4 * fq);
#pragma unroll
        for (int mi = 0; mi < 2; ++mi) bzv[mi][ntl] = *(const u32x2*)(XU + ((unsigned)row0 + 16 * (2 * th + mi) + fr) * NIN + C_BZ + hh * 64 + 16 * ntl + 4 * fq);
    }
    {
        const int mt = wave >> 1;
#pragma unroll
        for (int q = 0; q < 2; ++q) {
            const int ntl = 2 * (wave & 1) + q;
            f32x4 acc = {0.f, 0.f, 0.f, 0.f};
#pragma unroll
            for (int kk = 0; kk < 4; ++kk) acc = mfma16(lds_frag(Cm, 16 * mt + fr, kk * 32 + fq * 8, 136), lds_frag(Bm, 16 * ntl + fr, kk * 32 + fq * 8, 136), acc);
#pragma unroll
            for (int ii = 0; ii < 4; ++ii) CBf[(16 * mt + fq * 4 + ii) * 68 + 16 * ntl + fr] = acc[ii];
        }
    }
    __syncthreads();
    f32x4 y1[2][4], y2[2][4];
#pragma unroll
    for (int mi = 0; mi < 2; ++mi)
#pragma unroll
        for (int ntl = 0; ntl < 4; ++ntl) { y1[mi][ntl] = (f32x4){0.f, 0.f, 0.f, 0.f}; y2[mi][ntl] = (f32x4){0.f, 0.f, 0.f, 0.f}; }
#pragma unroll
    for (int kk = 0; kk < 2; ++kk) {
        bf16x8 bx[4];
#pragma unroll
        for (int ntl = 0; ntl < 4; ++ntl) bx[ntl] = lds_frag(Xt, hl * 64 + 16 * ntl + fr, kk * 32 + fq * 8, 72);
#pragma unroll
        for (int mi = 0; mi < 2; ++mi) {
            const int t = 16 * (2 * th + mi) + fr, u0 = kk * 32 + fq * 8;
            const float at = av[hl * 64 + t];
            float w[8];
#pragma unroll
            for (int j = 0; j < 8; ++j) {
                const int uu = u0 + j;
                w[j] = (uu <= t) ? CBf[t * 68 + uu] * __expf(at - av[hl * 64 + uu]) * dtv[hl * 64 + uu] : 0.f;
            }
            const bf16x8 a = as_frag(pack8(w));
#pragma unroll
            for (int ntl = 0; ntl < 4; ++ntl) y1[mi][ntl] = mfma16(bx[ntl], a, y1[mi][ntl]);
        }
    }
    {
#pragma unroll
        for (int kk = 0; kk < 4; ++kk) {
            bf16x8 bh[4];
#pragma unroll
            for (int ntl = 0; ntl < 4; ++ntl) bh[ntl] = as_frag(hsf[kk][ntl]);
#pragma unroll
            for (int mi = 0; mi < 2; ++mi) {
                const bf16x8 a = lds_frag(Cm, 16 * (2 * th + mi) + fr, kk * 32 + fq * 8, 136);
#pragma unroll
                for (int ntl = 0; ntl < 4; ++ntl) y2[mi][ntl] = mfma16(bh[ntl], a, y2[mi][ntl]);
            }
        }
    }
    const float Dh = XPAR(P_BD)[l * 8 + hh];
#pragma unroll
    for (int mi = 0; mi < 2; ++mi) {
        const int t = 16 * (2 * th + mi) + fr;
        const float ea = __expf(av[hl * 64 + t]);
        float ss = 0.f;
#pragma unroll
        for (int ntl = 0; ntl < 4; ++ntl) {
            const float z[4] = {__uint_as_float(bzv[mi][ntl][0] << 16), __uint_as_float(bzv[mi][ntl][0] & 0xffff0000u), __uint_as_float(bzv[mi][ntl][1] << 16), __uint_as_float(bzv[mi][ntl][1] & 0xffff0000u)};
#pragma unroll
            for (int ii = 0; ii < 4; ++ii) {
                const int p = 16 * ntl + 4 * fq + ii;
                const float xv = bf2f(*(const LAS bf16_t*)(Xt + (((hl * 64 + p) * 72 + t) << 1)));
                const float y = y1[mi][ntl][ii] + ea * y2[mi][ntl][ii] + Dh * xv;
                const float gbv = y * siluf_(z[ii]);
                y1[mi][ntl][ii] = gbv; ss += gbv * gbv;
            }
        }
        ss += __shfl_xor(ss, 16); ss += __shfl_xor(ss, 32);
        if (fq == 0) ssq[t * 4 + hl] = ss;
    }
    __syncthreads();
#pragma unroll
    for (int mi = 0; mi < 2; ++mi) {
        const int t = 16 * (2 * th + mi) + fr;
        const float rs = rsqrtf((ssq[t * 4] + ssq[t * 4 + 1] + ssq[t * 4 + 2] + ssq[t * 4 + 3]) * (1.f / 256.f) + EPS);
        const unsigned row = (unsigned)row0 + t;
#pragma unroll
        for (int ntl = 0; ntl < 4; ++ntl) {
            u32x2 w; w[0] = pk2(y1[mi][ntl][0] * rs * bnw[ntl][0], y1[mi][ntl][1] * rs * bnw[ntl][1]); w[1] = pk2(y1[mi][ntl][2] * rs * bnw[ntl][2], y1[mi][ntl][3] * rs * bnw[ntl][3]);
            *(u32x2*)(XMIX + row * DMIX + 512 + hh * 64 + 16 * ntl + 4 * fq) = w;
        }
    }
    __syncthreads();
}


#define XB_TMO      128
#define XB_XCNT(j)  (256  + 64 * (j))
#define XB_XSUB(j)  (1280 + 64 * (j))
#define XB_XGEN(j)  (2304 + 64 * (j))
#define XB_TOP      3328
#define XB_TOPGEN   3392
#define XCD_BAR_WORDS 3456
#define XB_SPIN_CAP (1u << 18)
__device__ __forceinline__ unsigned xb_ld(unsigned* p)              { return __hip_atomic_load(p, __ATOMIC_RELAXED, __HIP_MEMORY_SCOPE_AGENT); }
__device__ __forceinline__ unsigned xb_add(unsigned* p, unsigned v) { return __hip_atomic_fetch_add(p, v, __ATOMIC_RELAXED, __HIP_MEMORY_SCOPE_AGENT); }
__device__ __forceinline__ unsigned xb_xcc_id() { return (unsigned)__builtin_amdgcn_s_getreg((3 << 11) | 20) & 0xFu; }
#define XB_SPIN(cond, bar) do { unsigned _sp = 0; while (cond) { __builtin_amdgcn_s_sleep(1); \
    if ((++_sp & 255u) == 0u) { if (xb_ld(&(bar)[XB_TMO])) break; if (_sp > XB_SPIN_CAP) { atomicAdd(&(bar)[XB_TMO], 1u); break; } } } } while (0)
struct XcdBarrier { unsigned* bar; unsigned x; volatile LAS unsigned* st; };
__device__ __forceinline__ XcdBarrier xcd_barrier_post(unsigned* bar, volatile LAS unsigned* st) {
    XcdBarrier b; b.bar = bar; b.x = xb_xcc_id(); b.st = st;
    if (threadIdx.x == 0) (void)xb_add(&bar[XB_XCNT(b.x)], 1u);
    return b;
}
__device__ __forceinline__ void xcd_barrier_complete(unsigned* bar, unsigned x, unsigned& nloc, unsigned& nx) {
    const unsigned G = gridDim.x * gridDim.y * gridDim.z;
    unsigned sum, cnt, mine, sp = 0u;
    for (;;) {
        sum = 0u; cnt = 0u; mine = 0u;
#pragma unroll
        for (unsigned j = 0; j < 16; ++j) { const unsigned c = xb_ld(&bar[XB_XCNT(j)]); sum += c; cnt += (c > 0u) ? 1u : 0u; mine = (j == x) ? c : mine; }
        if (sum == G) break;
        __builtin_amdgcn_s_sleep(1);
        if ((++sp & 255u) == 0u) { if (xb_ld(&bar[XB_TMO])) break; if (sp > XB_SPIN_CAP) { atomicAdd(&bar[XB_TMO], 1u); break; } }
    }
    nloc = mine > 0u ? mine : 1u; nx = cnt > 0u ? cnt : 1u;
}
__device__ __forceinline__ void xcd_barrier(const XcdBarrier& b) {
    asm volatile("s_waitcnt vmcnt(0)" ::: "memory");
    __syncthreads();
    if (threadIdx.x == 0) {
        unsigned* bar = b.bar;
        __builtin_amdgcn_s_waitcnt(0);
        unsigned nloc = b.st[0], nx = b.st[1];
        if (nloc == 0u) { xcd_barrier_complete(bar, b.x, nloc, nx); b.st[0] = nloc; b.st[1] = nx; }
        const unsigned old = xb_add(&bar[XB_XSUB(b.x)], 1u);
        const unsigned gen = old / nloc;
        if (old + 1u == (gen + 1u) * nloc) {
            __builtin_amdgcn_fence(__ATOMIC_RELEASE, "agent");
            asm volatile("s_waitcnt vmcnt(0)" ::: "memory");
            const unsigned og = xb_add(&bar[XB_TOP], 1u);
            const unsigned tg = og / nx;
            if (og + 1u == (tg + 1u) * nx) xb_add(&bar[XB_TOPGEN], 1u);
            else XB_SPIN(xb_ld(&bar[XB_TOPGEN]) == tg, bar);
            __builtin_amdgcn_fence(__ATOMIC_ACQUIRE, "agent");
            xb_add(&bar[XB_XGEN(b.x)], 1u);
            asm volatile("s_waitcnt vmcnt(0)" ::: "memory");
        } else {
            XB_SPIN(xb_ld(&bar[XB_XGEN(b.x)]) == gen, bar);
            __builtin_amdgcn_fence(__ATOMIC_ACQUIRE, "agent");
            asm volatile("s_waitcnt vmcnt(0)" ::: "memory");
        }
    }
    __syncthreads();
}

__global__ void __launch_bounds__(NT, 2) mega(Args args) {
    __shared__ __attribute__((aligned(16))) unsigned char lds_raw[LDS_BYTES];
    lptr lds = (lptr)lds_raw;
    cg::grid_group grid = cg::this_grid();
    const int tid = threadIdx.x, bid = blockIdx.x, G = gridDim.x;
    Ctx X;
    X.xp = args.in[IN_XP]; X.xs = args.in[IN_XS]; X.stC = args.in[IN_STC]; X.stN = args.in[IN_STN]; X.stM = args.in[IN_STM]; X.ssm = args.in[IN_SSM];
    X.conv = args.in[IN_CONV]; X.ck = args.in[IN_CK]; X.cv = args.in[IN_CV]; X.out = args.out; X.ws = args.ws;
    const int lo = args.ph_lo, hi = args.ph_hi;
    volatile LAS unsigned* xst = (volatile LAS unsigned*)(lds + LDS_BYTES - 16);
    if (tid == 0) { xst[0] = 0u; xst[1] = 0u; }
    __syncthreads();
    XcdBarrier xbar = xcd_barrier_post((unsigned*)(args.ws + WS_BAR), xst);
#define IN(k) (lo <= (k) && (k) < hi)
#define SEAM(k) do { if (IN(k) && IN((k) + 1)) { for (int _r = 0; _r < REP_SYNC; ++_r) { if (lo < 0) grid.sync(); xcd_barrier(xbar); } } } while (0)
    if (IN(0)) { for (int _r = 0; _r < REP_P0; ++_r) prologue(lds, X, args, G, bid, tid); }
    SEAM(0);
    for (int l = 0; l < 4; ++l) {
        const int pb = 1 + l * 5;
        if (IN(pb)) for (int _r = 0; _r < REP_P1; ++_r) {
            pg8::Gemm g{XXB, XWIN + (size_t)l * NIN * D, MPAD, NIN, D}; pg8::StaticOrder S; S.init(TP, NIN, G, bid);
            pg8::EpiU E{XU, XSSQ};
            pg8::gemm_phase<pg8::EpiU, pg8::StaticOrder, false, GEMM_SP2, GEMM_ALIGN>(lds, g, S, E, OPQ(tid));
            if (l == 0 && bid >= G - 20) {
                pg8::SampleOrder S2{G - 20, 20, bid}; pg8::EpiUh E2{XU, XSSQ};
                pg8::gemm_phase<pg8::EpiUh, pg8::SampleOrder, true>(lds, g, S2, E2, OPQ(tid));
            }
        }
        SEAM(pb);
        if (IN(pb + 1)) for (int _r = 0; _r < REP_P2; ++_r) {
            for (int t = bid; t < 256; t += G) for (int _q = 0; _q < RT_SAMPLE; ++_q) {
                if (t < 128) sample_task(lds, X, l, t, 1, OPQ(tid));
                else { sample_task(lds, X, l, t - 128, 0, OPQ(tid)); sample_task(lds, X, l, t - 128, 2, OPQ(tid)); }
            }
            for (int t = bid; t < 256; t += G) {
                const int tx = (G == 256) ? ((t & 7) >> 2) * 128 + (32 * (t & 1) + (t >> 3)) * 2 + ((t >> 1) & 1) : t;
                for (int _q = 0; _q < RT_SWA; ++_q) swa_prompt(lds, X, l, tx, OPQ(tid));
            }
            for (int t = bid; t < 512; t += G) for (int _q = 0; _q < RT_SLOC; ++_q) ssd_local(lds, X, l, t, OPQ(tid));
            for (int t = bid; t < 1024; t += G) for (int _q = 0; _q < RT_MLOC; ++_q) mlstm_local(lds, X, l, t, OPQ(tid));
            if (bid == G - 1) {
                for (int i = tid; i < 2 * 3 * 1024; i += NT) {
                    const int ch = i & 1023, j = (i >> 10) % 3, n = i / 3072;
                    X.out[O_PCONV + (((size_t)l * 2 + n) * 3 + j) * 1024 + ch] = bf2f(XU[(size_t)(n * SEQ + SEQ - 3 + j) * NIN + C_BX + ch]);
                }
            }
        }
        SEAM(pb + 1);
        if (IN(pb + 2)) {
            if (bid >= G - 4) {
                pg8::Gemm g{XMIX, XWOUT + (size_t)l * D * DMIX, MPAD, D, DMIX}; pg8::SampleOrder S{G - 4, 4, bid};
                if (l == 0) { pg8::EpiRes_<1, 0> E{X.xp, X.xs, X.out, XXB, XSSQ}; pg8::gemm_phase<pg8::EpiRes_<1, 0>, pg8::SampleOrder, true>(lds, g, S, E, OPQ(tid)); }
                else if (l < 3) { pg8::EpiRes_<1, 1> E{X.xp, X.xs, X.out, XXB, XSSQ}; pg8::gemm_phase<pg8::EpiRes_<1, 1>, pg8::SampleOrder, true>(lds, g, S, E, OPQ(tid)); }
                else { pg8::EpiRes_<1, 2> E{X.xp, X.xs, X.out, XXB, XSSQ}; pg8::gemm_phase<pg8::EpiRes_<1, 2>, pg8::SampleOrder, true>(lds, g, S, E, OPQ(tid)); }
            }
            if (l < 3) {
                if (G - 4 - 193 >= 16) { if (bid >= 193 && bid < G - 4) convert_weights(lds, X, args, l + 1, bid - 193, G - 4 - 193, OPQ(tid)); }
                else convert_weights(lds, X, args, l + 1, bid, G, OPQ(tid));
            }
            for (int _r = 0; _r < REP_P3; ++_r) scans(X, l, bid * NT + OPQ(tid), G * NT);
        }
        SEAM(pb + 2);
        if (IN(pb + 3)) for (int _r = 0; _r < REP_P4; ++_r) {
            for (int task = bid; task < 1536; task += G) {
                if (task < 512) for (int _q = 0; _q < RT_SOUT; ++_q) ssd_out(lds, X, l, task, OPQ(tid));
                else mlstm_out(lds, X, l, task - 512, OPQ(tid));
            }
        }
        SEAM(pb + 3);
        if (IN(pb + 4)) {
            {
                pg8::Gemm g{XMIX, XWOUT + (size_t)l * D * DMIX, MPAD, D, DMIX}; pg8::StaticOrder S; S.init(TP, D, G, bid);
#ifdef PROBE_P5
                { pg8::EpiProbe EP{(const unsigned*)(X.ws + 64), XSSQ}; pg8::gemm_phase<pg8::EpiProbe, pg8::StaticOrder, false, GEMM_SP2>(lds, g, S, EP, OPQ(tid)); }
#endif
                if (l == 0) { pg8::EpiRes_<2, 0> E{X.xp, X.xs, X.out, XXB, XSSQ}; pg8::gemm_phase<pg8::EpiRes_<2, 0>, pg8::StaticOrder, false, GEMM_SP2, GEMM_ALIGN>(lds, g, S, E, OPQ(tid)); }
                else if (l < 3) { pg8::EpiRes_<2, 1> E{X.xp, X.xs, X.out, XXB, XSSQ}; pg8::gemm_phase<pg8::EpiRes_<2, 1>, pg8::StaticOrder, false, GEMM_SP2, GEMM_ALIGN>(lds, g, S, E, OPQ(tid)); }
                else { pg8::EpiRes_<2, 2> E{X.xp, X.xs, X.out, XXB, XSSQ}; pg8::gemm_phase<pg8::EpiRes_<2, 2>, pg8::StaticOrder, false, GEMM_SP2, GEMM_ALIGN>(lds, g, S, E, OPQ(tid)); }
            }
            if (l < 3 && bid < 20) {
                pg8::Gemm g{XXB, XWIN + (size_t)(l + 1) * NIN * D, MPAD, NIN, D}; pg8::SampleOrder S{0, 20, bid};
                pg8::EpiUh E{XU, XSSQ};
                pg8::gemm_phase<pg8::EpiUh, pg8::SampleOrder, true>(lds, g, S, E, OPQ(tid));
            }
        }
        SEAM(pb + 4);
    }
#undef IN
#undef SEAM
}

extern "C" void kernel_launch(void* const* d_in, const int* in_sizes, int n_in, void* d_out, int out_size, void* d_ws, size_t ws_size, hipStream_t stream) {
    static int grid_blocks = 0;
    if (!grid_blocks) {
        int dev = 0, cus = 0, per_cu = 0;
        hipGetDevice(&dev);
        hipDeviceGetAttribute(&cus, hipDeviceAttributeMultiprocessorCount, dev);
        hipOccupancyMaxActiveBlocksPerMultiprocessor(&per_cu, mega, NT, 0);
        if (per_cu < 1) { fprintf(stderr, "occupancy query returned %d\n", per_cu); per_cu = 1; }
        grid_blocks = cus * 1;
        if (ws_size < WS_END) fprintf(stderr, "workspace too small: %zu < %zu\n", ws_size, (size_t)WS_END);
    }
    (void)hipMemsetAsync(d_ws, 0, 16384, stream);
    Args a{};
    for (int i = 0; i < 24; ++i) a.in[i] = (const float*)d_in[i];
    a.out = (float*)d_out; a.ws = (unsigned char*)d_ws;
    const int NPH = 21;
#if MULTI_LAUNCH
    for (int p = 0; p < NPH; ++p) {
        a.ph_lo = p; a.ph_hi = p + 1;
        void* kargs[] = {&a};
        hipError_t e = hipLaunchCooperativeKernel((void*)mega, dim3(grid_blocks), dim3(NT), kargs, 0, stream);
        if (e != hipSuccess) fprintf(stderr, "cooperative launch failed: %s (grid %d)\n", hipGetErrorString(e), grid_blocks);
    }
#else
    a.ph_lo = 0; a.ph_hi = NPH;
    void* kargs[] = {&a};
    hipError_t e = hipLaunchCooperativeKernel((void*)mega, dim3(grid_blocks), dim3(NT), kargs, 0, stream);
    if (e != hipSuccess) fprintf(stderr, "cooperative launch failed: %s (grid %d)\n", hipGetErrorString(e), grid_blocks);
#endif
}
```

```cpp
#include <hip/hip_runtime.h>
#include <hip/hip_cooperative_groups.h>
#include <cstdio>
#include <cstdint>
namespace cg = cooperative_groups;

#ifndef REP_SYNC
#define REP_SYNC 1
#endif
#ifndef REP_P1
#define REP_P1 1
#endif
#ifndef REP_P2
#define REP_P2 1
#endif
#ifndef REP_P3
#define REP_P3 1
#endif
#ifndef REP_P0
#define REP_P0 1
#endif
#ifndef REP_P4
#define REP_P4 1
#endif
#ifndef RT_SAMPLE
#define RT_SAMPLE 1
#endif
#ifndef RT_SWA
#define RT_SWA 1
#endif
#ifndef RT_SLOC
#define RT_SLOC 1
#endif
#ifndef RT_MLOC
#define RT_MLOC 1
#endif
#ifndef RT_SOUT
#define RT_SOUT 1
#endif
#ifndef GEMM_SP2
#define GEMM_SP2 true
#endif
#ifndef GEMM_ALIGN
#define GEMM_ALIGN true
#endif
#ifndef MULTI_LAUNCH
#define MULTI_LAUNCH 0
#endif

#define LAS __attribute__((address_space(3)))
typedef unsigned short bf16_t;
typedef short bf16x8 __attribute__((ext_vector_type(8)));
typedef float f32x4 __attribute__((ext_vector_type(4)));
typedef float f32x2 __attribute__((ext_vector_type(2)));
typedef unsigned u32x4 __attribute__((ext_vector_type(4)));
typedef unsigned u32x2 __attribute__((ext_vector_type(2)));
typedef __bf16 bf16x2_t __attribute__((ext_vector_type(2)));
typedef LAS unsigned char* lptr;

constexpr int D = 1024, DIN = 4880, NIN = 5120, DMIX = 1536, TP = 16384, MTOK = 16512, MPAD = 16640, SEQ = 8192;
constexpr int C_AQ = 0, C_AK = 256, C_AV = 512, C_AO = 1024, C_AZ = 1536, C_AI = 2048, C_AF = 2052, C_BZ = 2056, C_BX = 2568, C_BB = 3080, C_BC = 3336,
              C_BDT = 3592, C_CQ = 3600, C_CK = 4112, C_CV = 4240, C_CZ = 4368;
constexpr float EPS = 1e-6f;
constexpr size_t O_YP = 0, O_YS = 16777216, O_PC = 16908288, O_PN = 17170432, O_PM = 17172480, O_PH = 17172512, O_PCONV = 17696800, O_PK = 17721376,
                 O_PV = 17852448, O_SC = 17983520, O_SN = 34760736, O_SM = 34891808, O_SH = 34893856, O_SCONV = 68448288, O_SK = 70021152, O_SV = 78409760;
constexpr size_t WS_BAR = 0;
constexpr size_t WS_PAR = 16384;
constexpr size_t WS_WIN = WS_PAR + 102400;
constexpr size_t WS_WOUT = WS_WIN + (size_t)4 * NIN * D * 2;
constexpr size_t WS_XB = WS_WOUT + (size_t)4 * D * DMIX * 2;
constexpr size_t WS_U = WS_XB + (size_t)MPAD * D * 2;
constexpr size_t WS_MIX = WS_U + (size_t)MPAD * NIN * 2;
constexpr size_t WS_SSQ = WS_MIX + (size_t)MPAD * DMIX * 2;
constexpr size_t WS_ROPE = WS_SSQ + (size_t)MPAD * 16 * 4;
constexpr size_t WS_MC = WS_ROPE + (size_t)8200 * 64 * 4;
constexpr size_t WS_MN = WS_MC + (size_t)8 * 128 * 8192 * 4;
constexpr size_t WS_ML = WS_MN + (size_t)8 * 128 * 64 * 4;
constexpr size_t WS_BL = WS_ML + 4096;
constexpr size_t WS_MS = WS_BL + 4096;
constexpr size_t WS_SA = WS_MS + 4096;
constexpr size_t WS_SH = WS_SA + 8192;
constexpr size_t WS_CSB = WS_SH + (size_t)16 * 128 * 8192 * 4;
constexpr size_t WS_HSB = WS_CSB + (size_t)8 * 128 * 8192 * 2;
constexpr size_t WS_NS = WS_HSB + (size_t)16 * 128 * 8192 * 2;
constexpr size_t WS_END = WS_NS + (size_t)8 * 128 * 64 * 4;
constexpr int LDS_BYTES = 139264;
constexpr int NT = 512;

struct Args { const float* in[24]; float* out; unsigned char* ws; int ph_lo, ph_hi; };

__device__ __forceinline__ float bf2f(unsigned v) { return __uint_as_float(v << 16); }
__device__ __forceinline__ unsigned pk2(float lo, float hi) { f32x2 v = {lo, hi}; bf16x2_t b = __builtin_convertvector(v, bf16x2_t); return __builtin_bit_cast(unsigned, b); }
__device__ __forceinline__ unsigned f2bf(float f) { return pk2(f, 0.f) & 0xffffu; }
__device__ __forceinline__ void unpack8(u32x4 w, float (&f)[8]) {
#pragma unroll
    for (int i = 0; i < 4; ++i) { f[2 * i] = __uint_as_float(w[i] << 16); f[2 * i + 1] = __uint_as_float(w[i] & 0xffff0000u); }
}
__device__ __forceinline__ u32x4 pack8(const float (&f)[8]) { u32x4 w; w[0] = pk2(f[0], f[1]); w[1] = pk2(f[2], f[3]); w[2] = pk2(f[4], f[5]); w[3] = pk2(f[6], f[7]); return w; }
__device__ __forceinline__ u32x4 pack8v(f32x4 a, f32x4 b) { u32x4 w; w[0] = pk2(a[0], a[1]); w[1] = pk2(a[2], a[3]); w[2] = pk2(b[0], b[1]); w[3] = pk2(b[2], b[3]); return w; }
__device__ __forceinline__ bf16x8 as_frag(u32x4 w) { return __builtin_bit_cast(bf16x8, w); }
__device__ __forceinline__ bf16x8 ldg_f32_frag(const float* p) { f32x4 a = *(const f32x4*)p, b = *(const f32x4*)(p + 4); return as_frag(pack8v(a, b)); }
__device__ __forceinline__ bf16x8 lds_frag(lptr base, int row, int k, int stride) { return *(const LAS bf16x8*)(base + ((row * stride + k) << 1)); }
__device__ __forceinline__ f32x4 mfma16(bf16x8 a, bf16x8 b, f32x4 c) { return __builtin_amdgcn_mfma_f32_16x16x32_bf16(a, b, c, 0, 0, 0); }
__device__ __forceinline__ float rcpf_(float x) { return __builtin_amdgcn_rcpf(x); }
__device__ __forceinline__ float sigmoidf_(float x) { return rcpf_(1.f + __expf(-x)); }
__device__ __forceinline__ float siluf_(float x) { return x * rcpf_(1.f + __expf(-x)); }
__device__ __forceinline__ float softplusf_(float x) { return x > 20.f ? x : __logf(1.f + __expf(x)); }
__device__ __forceinline__ float logsigf_(float x) { return fminf(x, 0.f) - __logf(1.f + __expf(-fabsf(x))); }
template <int CTRL, int RM> __device__ __forceinline__ float dpps(float ident, float v) { return __int_as_float(__builtin_amdgcn_update_dpp(__float_as_int(ident), __float_as_int(v), CTRL, RM, 0xf, false)); }
__device__ __forceinline__ float wave_scan_sum(float v, int) {
    v += dpps<0x111, 0xf>(0.f, v); v += dpps<0x112, 0xf>(0.f, v); v += dpps<0x114, 0xf>(0.f, v); v += dpps<0x118, 0xf>(0.f, v);
    v += dpps<0x142, 0xa>(0.f, v); v += dpps<0x143, 0xc>(0.f, v);
    return v;
}
__device__ __forceinline__ float wave_scan_max(float v, int) {
    const float NI = -3.0e38f;
    v = fmaxf(v, dpps<0x111, 0xf>(NI, v)); v = fmaxf(v, dpps<0x112, 0xf>(NI, v)); v = fmaxf(v, dpps<0x114, 0xf>(NI, v)); v = fmaxf(v, dpps<0x118, 0xf>(NI, v));
    v = fmaxf(v, dpps<0x142, 0xa>(NI, v)); v = fmaxf(v, dpps<0x143, 0xc>(NI, v));
    return v;
}
__device__ __forceinline__ float lane63(float v) { return __int_as_float(__builtin_amdgcn_readlane(__float_as_int(v), 63)); }
__device__ __forceinline__ float red16(float v);
__device__ __forceinline__ float red16max(float v);
__device__ __forceinline__ float wave_sum(float v) { v = red16(v); v += __shfl_xor(v, 16); v += __shfl_xor(v, 32); return v; }
__device__ __forceinline__ float wave_max(float v) { v = red16max(v); v = fmaxf(v, __shfl_xor(v, 16)); v = fmaxf(v, __shfl_xor(v, 32)); return v; }
template <int CTRL> __device__ __forceinline__ float dppf(float v) { return __int_as_float(__builtin_amdgcn_update_dpp(0, __float_as_int(v), CTRL, 0xf, 0xf, true)); }
__device__ __forceinline__ float red16(float v) { v += dppf<0xB1>(v); v += dppf<0x4E>(v); v += dppf<0x141>(v); v += dppf<0x140>(v); return v; }
__device__ __forceinline__ float red16max(float v) { v = fmaxf(v, dppf<0xB1>(v)); v = fmaxf(v, dppf<0x4E>(v)); v = fmaxf(v, dppf<0x141>(v)); v = fmaxf(v, dppf<0x140>(v)); return v; }
__device__ __forceinline__ int OPQ(int v) { asm volatile("" : "+v"(v)); return v; }
#define LDS_FENCE() asm volatile("s_waitcnt lgkmcnt(0)" ::: "memory")

namespace pg8 {
constexpr int BM = 256, BK = 64, HALF = 128, HTB = HALF * BK * 2, STAGE_BYTES = 8 * HTB, NXCD = 8, WGM = 8;
__host__ __device__ __forceinline__ int lds_byte(int r, int c) { const int st = (r >> 4) * 2 + (c >> 5), rr = r & 15, cc = c & 31, ob = rr * 64 + cc * 2; return st * 1024 + (ob ^ (((ob >> 9) & 1) << 5)); }
__host__ __device__ __forceinline__ void stage_rc(int b, int& R, int& C) { const int st = b / 1024, sb = b % 1024, swz = sb ^ (((sb >> 9) & 1) << 5); R = (st >> 1) * 16 + swz / 64; C = (st & 1) * 32 + (swz % 64) / 2; }
__host__ __device__ __forceinline__ int perm32(int rho) { const int n = rho >> 4, i = rho & 15; return 8 * (i >> 2) + 4 * n + (i & 3); }
struct Unit { int pm, pn; };
struct Gemm { const bf16_t* A; const bf16_t* Bt; int M, N, K; };
struct StaticOrder {
    int nM, nN, nwg, G, c;
    __device__ void init(int M, int N, int G_, int c_) { nM = M / BM; nN = N / BM; nwg = nM * nN; G = G_; c = c_; }
    __device__ bool next(int i, Unit& u) const {
        const long L = (long)i * G + c; if (L >= nwg) return false;
        int wgid = (int)L; { const int q = nwg / NXCD, r = nwg % NXCD, xcd = wgid % NXCD, off = wgid / NXCD; wgid = (xcd < r ? xcd * (q + 1) : r * (q + 1) + (xcd - r) * q) + off; }
        const int nig = WGM * nN, gid = wgid / nig, fm = gid * WGM, gsz = (nM - fm) < WGM ? (nM - fm) : WGM;
        u.pm = fm + ((wgid % nig) % gsz); u.pn = (wgid % nig) / gsz; return true;
    }
};
template <int NAI> struct EpiU_ {
    bf16_t* U; const float* ssq;
    __device__ __forceinline__ void operator()(const f32x4 (&acc)[2][2][4][2], const Unit& u, int wr, int wc, int fr, int fq) const {
        const int row0 = u.pm * BM + wr * 64 + fr, col0 = u.pn * BM + wc * 32 + 8 * fq;
        f32x4 sq[NAI][4];
#pragma unroll
        for (int ai = 0; ai < NAI; ++ai)
#pragma unroll
            for (int m = 0; m < 4; ++m) sq[ai][m] = *(const f32x4*)(ssq + (size_t)(row0 + ai * HALF + m * 16) * 16 + fq * 4);
#pragma unroll
        for (int ai = 0; ai < NAI; ++ai)
#pragma unroll
            for (int m = 0; m < 4; ++m) {
                const int r = row0 + ai * HALF + m * 16;
                const f32x4 s = sq[ai][m];
                float st = s[0] + s[1] + s[2] + s[3]; st += __shfl_xor(st, 16); st += __shfl_xor(st, 32);
                const float rs = rsqrtf(st * (1.f / 1024.f) + EPS);
                bf16_t* rowp = U + (size_t)r * NIN + col0;
#pragma unroll
                for (int bj = 0; bj < 2; ++bj) *(u32x4*)(rowp + bj * HALF) = pack8v(acc[ai][bj][m][0] * rs, acc[ai][bj][m][1] * rs);
                __builtin_amdgcn_sched_barrier(0);
            }
    }
};
template <int NAI, int MODE> struct EpiRes_ {
    const float* xp; const float* xs; float* out; bf16_t* xb; float* ssq;
    __device__ __forceinline__ void operator()(const f32x4 (&acc)[2][2][4][2], const Unit& u, int wr, int wc, int fr, int fq) const {
        const int row0 = u.pm * BM + wr * 64 + fr, col0 = u.pn * BM + wc * 32 + 8 * fq;
#pragma unroll
        for (int ai = 0; ai < NAI; ++ai) {
            u32x4 xo[4][2];
            f32x4 xf[MODE == 0 ? 4 : 1][2][2];
            if (MODE != 0) {
#pragma unroll
                for (int m = 0; m < 4; ++m)
#pragma unroll
                    for (int bj = 0; bj < 2; ++bj) xo[m][bj] = *(const u32x4*)(xb + (size_t)(row0 + ai * HALF + m * 16) * D + col0 + bj * HALF);
            } else {
#pragma unroll
                for (int m = 0; m < 4; ++m) {
                    const int r = row0 + ai * HALF + m * 16, rc = r < MTOK ? r : MTOK - 1;
                    const float* src = rc < TP ? xp + (size_t)rc * D : xs + (size_t)(rc - TP) * D;
#pragma unroll
                    for (int bj = 0; bj < 2; ++bj) { xf[m][bj][0] = __builtin_nontemporal_load((const f32x4*)(src + col0 + bj * HALF)); xf[m][bj][1] = __builtin_nontemporal_load((const f32x4*)(src + col0 + bj * HALF + 4)); }
                }
            }
#pragma unroll
            for (int m = 0; m < 4; ++m) {
                const int r = row0 + ai * HALF + m * 16;
                const bool valid = r < MTOK;
                float part = 0.f;
#pragma unroll
                for (int bj = 0; bj < 2; ++bj) {
                    const int c = col0 + bj * HALF;
                    f32x4 o0 = {0.f, 0.f, 0.f, 0.f}, o1 = {0.f, 0.f, 0.f, 0.f};
                    if (MODE == 0) {
                        if (valid) { o0 = xf[MODE == 0 ? m : 0][bj][0]; o1 = xf[MODE == 0 ? m : 0][bj][1]; }
                    } else {
                        float f[8]; unpack8(xo[m][bj], f);
                        o0 = (f32x4){f[0], f[1], f[2], f[3]}; o1 = (f32x4){f[4], f[5], f[6], f[7]};
                    }
                    const f32x4 v0 = acc[ai][bj][m][0] + o0, v1 = acc[ai][bj][m][1] + o1;
                    if (MODE == 2) {
                        if (valid) { __builtin_nontemporal_store(v0, (f32x4*)(out + (size_t)r * D + c)); __builtin_nontemporal_store(v1, (f32x4*)(out + (size_t)r * D + c + 4)); }
                    } else {
                        *(u32x4*)(xb + (size_t)r * D + c) = pack8v(v0, v1);
                        part += v0[0] * v0[0] + v0[1] * v0[1] + v0[2] * v0[2] + v0[3] * v0[3] + v1[0] * v1[0] + v1[1] * v1[1] + v1[2] * v1[2] + v1[3] * v1[3];
                    }
                }
                if (MODE != 2) {
                    part += __shfl_xor(part, 16); part += __shfl_xor(part, 32);
                    if (fq == 0) ssq[(size_t)r * 16 + u.pn * 4 + wc] = part;
                }
                __builtin_amdgcn_sched_barrier(0);
            }
        }
    }
};

typedef EpiU_<2> EpiU; typedef EpiU_<1> EpiUh;
struct EpiProbe {
    const unsigned* flag; float* dst;
    __device__ __forceinline__ void operator()(const f32x4 (&acc)[2][2][4][2], const Unit& u, int wr, int wc, int fr, int fq) const {
        if (__hip_atomic_load(flag, __ATOMIC_RELAXED, __HIP_MEMORY_SCOPE_AGENT) == 12345u) {
            f32x4 t = {0.f, 0.f, 0.f, 0.f};
#pragma unroll
            for (int a = 0; a < 2; ++a)
#pragma unroll
                for (int b = 0; b < 2; ++b)
#pragma unroll
                    for (int m = 0; m < 4; ++m)
#pragma unroll
                        for (int n = 0; n < 2; ++n) t += acc[a][b][m][n];
            *(f32x4*)(dst + (size_t)(u.pm * 4 + u.pn) * 2048 + (wr * 4 + wc) * 256 + (fq * 16 + fr) * 4) = t;
        }
    }
};
struct SampleOrder {
    int first, cnt, c;
    __device__ bool next(int i, Unit& u) const { if (i != 0 || c < first || c >= first + cnt) return false; u.pm = 64; u.pn = c - first; return true; }
};
template <class Epi, class Sched, bool HALF_M = false, bool SP2 = false, bool ALIGN_EPI = false>
__device__ __forceinline__ void gemm_phase(lptr lds, const Gemm g, const Sched& S, const Epi& E, const int tid) {
    const int wid = __builtin_amdgcn_readfirstlane(tid >> 6), lane = tid & 63, wr = wid >> 2, wc = wid & 3, fr = lane & 15, fq = lane >> 4;
    const int K = g.K, nt = K / BK;
    unsigned voffA[2], voffB[2];
#pragma unroll
    for (int i = 0; i < 2; ++i) { int R, C; stage_rc(tid * 16 + i * 8192, R, C); const int Rb = (R & ~31) + perm32(R & 31);
        voffA[i] = (unsigned)(R * K + C) * 2u; voffB[i] = (unsigned)(Rb * K + C) * 2u; }
    const size_t kstep = (size_t)(BK * 2);
    const size_t hstep = (size_t)HALF * K * 2;
    const size_t tstep = 2 * hstep;
    const unsigned ldsw = (unsigned)wid * 1024u;
    const int aoff = lds_byte(wr * 64 + fr, fq * 8), boff = lds_byte(wc * 32 + fr, fq * 8);
#define PG8_SA(b, h) (((b) * 2 + (h)) * HTB)
#define PG8_SB(b, h) ((4 + (b) * 2 + (h)) * HTB)
#define PG8_STAGE(bufoff, gbase, voff) do { _Pragma("unroll") for (int _i = 0; _i < 2; ++_i) \
        __builtin_amdgcn_global_load_lds((const unsigned*)((const char*)(gbase) + (voff)[_i]), (LAS unsigned*)(lds + (bufoff) + ldsw + _i * 8192), 16, 0, 0); } while (0)
#define PG8_LDA(dst, b, h) do { _Pragma("unroll") for (int m = 0; m < 4; ++m) _Pragma("unroll") for (int k = 0; k < 2; ++k) dst[m][k] = *(const LAS bf16x8*)(lds + PG8_SA(b, h) + aoff + m * 2048 + k * 1024); } while (0)
#define PG8_LDB(dst, b, h) do { _Pragma("unroll") for (int n = 0; n < 2; ++n) _Pragma("unroll") for (int k = 0; k < 2; ++k) dst[n][k] = *(const LAS bf16x8*)(lds + PG8_SB(b, h) + boff + n * 2048 + k * 1024); } while (0)
#define PG8_MMA(ai, bj, At, Bt) do { __builtin_amdgcn_s_setprio(1); _Pragma("unroll") for (int m = 0; m < 4; ++m) _Pragma("unroll") for (int n = 0; n < 2; ++n) _Pragma("unroll") for (int k = 0; k < 2; ++k) \
        acc[ai][bj][m][n] = __builtin_amdgcn_mfma_f32_16x16x32_bf16(Bt[n][k], At[m][k], acc[ai][bj][m][n], 0, 0, 0); __builtin_amdgcn_s_setprio(0); } while (0)
#define PG8_WAIT_V(n) asm volatile("s_waitcnt vmcnt(" #n ")" ::: "memory")
#define PG8_WAIT_L(n) asm volatile("s_waitcnt lgkmcnt(" #n ")" ::: "memory")
#define PG8_BAR __builtin_amdgcn_s_barrier()
#define PG8_SCHED __builtin_amdgcn_sched_barrier(0)
    Unit cur, nxt; int ui = 0;
    if (!S.next(0, cur)) return;
    f32x4 acc[2][2][4][2];
#pragma unroll
    for (int a = 0; a < 2; ++a)
#pragma unroll
        for (int b = 0; b < 2; ++b)
#pragma unroll
            for (int m = 0; m < 4; ++m)
#pragma unroll
                for (int n = 0; n < 2; ++n) acc[a][b][m][n] = (f32x4){0.f, 0.f, 0.f, 0.f};
    bf16x8 At[4][2], B0[2][2], B1[2][2];
    const char* cA = (const char*)g.A + (size_t)cur.pm * tstep; const char* cB = (const char*)g.Bt + (size_t)cur.pn * tstep;
    if constexpr (SP2) {
        PG8_STAGE(PG8_SB(0, 0), cB, voffB); PG8_STAGE(PG8_SB(0, 1), cB + hstep, voffB); PG8_STAGE(PG8_SA(0, 0), cA, voffA); PG8_STAGE(PG8_SA(0, 1), cA + hstep, voffA);
        if (wr == 1) PG8_BAR;
        PG8_WAIT_V(2); PG8_BAR;
        PG8_STAGE(PG8_SB(1, 0), cB + kstep, voffB); PG8_STAGE(PG8_SA(1, 0), cA + kstep, voffA); PG8_STAGE(PG8_SB(1, 1), cB + hstep + kstep, voffB);
        PG8_WAIT_V(6); PG8_BAR;
    } else {
    PG8_STAGE(PG8_SB(0, 0), cB, voffB); PG8_STAGE(PG8_SA(0, 0), cA, voffA); PG8_STAGE(PG8_SB(0, 1), cB + hstep, voffB); PG8_STAGE(PG8_SA(0, 1), cA + hstep, voffA);
    if (wr == 1) PG8_BAR;
    PG8_WAIT_V(4); PG8_BAR;
    PG8_STAGE(PG8_SB(1, 0), cB + kstep, voffB); PG8_STAGE(PG8_SA(1, 0), cA + kstep, voffA); PG8_STAGE(PG8_SB(1, 1), cB + hstep + kstep, voffB);
    PG8_WAIT_V(6); PG8_BAR;
    }
    for (;;) {
        const bool has_next = S.next(ui + 1, nxt);
        const char* nA = has_next ? (const char*)g.A + (size_t)nxt.pm * tstep : cA; const char* nB = has_next ? (const char*)g.Bt + (size_t)nxt.pn * tstep : cB;
        for (int t = 0; t < nt; t += 2) {
            const bool last = (t == nt - 2);
            const char* a1 = cA + (size_t)(t + 1) * kstep;
            const char* a2 = last ? nA : cA + (size_t)(t + 2) * kstep; const char* b2 = last ? nB : cB + (size_t)(t + 2) * kstep;
            const char* a3 = a2 + kstep; const char* b3 = b2 + kstep;
            if constexpr (SP2) {
            PG8_LDB(B0, 0, 0); PG8_LDB(B1, 0, 1); PG8_SCHED; PG8_LDA(At, 0, 0); PG8_STAGE(PG8_SA(1, 1), a1 + hstep, voffA);
            PG8_WAIT_V(8); PG8_WAIT_L(0); PG8_BAR; PG8_MMA(0, 0, At, B0); PG8_MMA(0, 1, At, B1); PG8_BAR; PG8_SCHED;
            PG8_LDA(At, 0, 1); PG8_STAGE(PG8_SB(0, 0), b2, voffB); PG8_STAGE(PG8_SB(0, 1), b2 + hstep, voffB); PG8_STAGE(PG8_SA(0, 0), a2, voffA);
            PG8_WAIT_V(8); PG8_WAIT_L(0); PG8_BAR; PG8_MMA(1, 0, At, B0); PG8_MMA(1, 1, At, B1); PG8_BAR; PG8_SCHED;
            PG8_LDB(B0, 1, 0); PG8_LDB(B1, 1, 1); PG8_SCHED; PG8_LDA(At, 1, 0); PG8_STAGE(PG8_SA(0, 1), a2 + hstep, voffA);
            PG8_WAIT_V(8); PG8_WAIT_L(0); PG8_BAR; PG8_MMA(0, 0, At, B0); PG8_MMA(0, 1, At, B1); PG8_BAR; PG8_SCHED;
            PG8_LDA(At, 1, 1); PG8_STAGE(PG8_SB(1, 0), b3, voffB); PG8_STAGE(PG8_SB(1, 1), b3 + hstep, voffB); PG8_STAGE(PG8_SA(1, 0), a3, voffA);
            PG8_WAIT_V(8); PG8_WAIT_L(0); PG8_BAR; PG8_MMA(1, 0, At, B0); PG8_MMA(1, 1, At, B1); PG8_BAR; PG8_SCHED;
            } else {
            PG8_LDB(B0, 0, 0); PG8_SCHED; PG8_LDA(At, 0, 0); PG8_STAGE(PG8_SA(1, 1), a1 + hstep, voffA);
            PG8_WAIT_L(8); PG8_BAR; PG8_WAIT_L(0); PG8_MMA(0, 0, At, B0); PG8_BAR; PG8_SCHED;
            PG8_LDB(B1, 0, 1); PG8_STAGE(PG8_SB(0, 0), b2, voffB);
            PG8_BAR; PG8_WAIT_L(0); PG8_MMA(0, 1, At, B1); PG8_BAR;
            if constexpr (!HALF_M) PG8_LDA(At, 0, 1);
            PG8_STAGE(PG8_SA(0, 0), a2, voffA);
            PG8_BAR; PG8_WAIT_L(0); if constexpr (!HALF_M) PG8_MMA(1, 0, At, B0); PG8_BAR; PG8_SCHED;
            PG8_STAGE(PG8_SB(0, 1), b2 + hstep, voffB);
            PG8_WAIT_V(6); PG8_BAR; if constexpr (!HALF_M) PG8_MMA(1, 1, At, B1); PG8_BAR;
            PG8_LDB(B0, 1, 0); PG8_SCHED; PG8_LDA(At, 1, 0); PG8_STAGE(PG8_SA(0, 1), a2 + hstep, voffA);
            PG8_WAIT_L(8); PG8_BAR; PG8_WAIT_L(0); PG8_MMA(0, 0, At, B0); PG8_BAR; PG8_SCHED;
            PG8_LDB(B1, 1, 1); PG8_STAGE(PG8_SB(1, 0), b3, voffB);
            PG8_BAR; PG8_WAIT_L(0); PG8_MMA(0, 1, At, B1); PG8_BAR;
            if constexpr (!HALF_M) PG8_LDA(At, 1, 1);
            PG8_STAGE(PG8_SA(1, 0), a3, voffA);
            PG8_BAR; PG8_WAIT_L(0); if constexpr (!HALF_M) PG8_MMA(1, 0, At, B0); PG8_BAR; PG8_SCHED;
            PG8_STAGE(PG8_SB(1, 1), b3 + hstep, voffB);
            PG8_WAIT_V(6); PG8_BAR; if constexpr (!HALF_M) PG8_MMA(1, 1, At, B1); PG8_BAR;
            }
        }
        if constexpr (ALIGN_EPI) { if (wr == 0) PG8_BAR; }
        E(acc, cur, wr, wc, fr, fq);
        if (!has_next) break;
#pragma unroll
        for (int a = 0; a < 2; ++a)
#pragma unroll
            for (int b = 0; b < 2; ++b)
#pragma unroll
                for (int m = 0; m < 4; ++m)
#pragma unroll
                    for (int n = 0; n < 2; ++n) acc[a][b][m][n] = (f32x4){0.f, 0.f, 0.f, 0.f};
        cur = nxt; cA = nA; cB = nB; ++ui;
        if constexpr (ALIGN_EPI) { if (wr == 1) PG8_BAR; }
    }
    PG8_WAIT_V(0);
    if constexpr (!ALIGN_EPI) { if (wr == 0) PG8_BAR; }
    PG8_BAR;
#undef PG8_SA
#undef PG8_SB
#undef PG8_STAGE
#undef PG8_LDA
#undef PG8_LDB
#undef PG8_MMA
#undef PG8_WAIT_V
#undef PG8_WAIT_L
#undef PG8_BAR
#undef PG8_SCHED
}
}

struct Ctx {
    const float* xp; const float* xs; const float* stC; const float* stN; const float* stM; const float* ssm; const float* conv; const float* ck; const float* cv;
    float* out; unsigned char* ws;
};
#define XWIN ((bf16_t*)(X.ws + WS_WIN))
#define XWOUT ((bf16_t*)(X.ws + WS_WOUT))
#define XXB ((bf16_t*)(X.ws + WS_XB))
#define XU ((bf16_t*)(X.ws + WS_U))
#define XMIX ((bf16_t*)(X.ws + WS_MIX))
#define XSSQ ((float*)(X.ws + WS_SSQ))
#define XROPE ((float*)(X.ws + WS_ROPE))
#define XMC ((float*)(X.ws + WS_MC))
#define XMN ((float*)(X.ws + WS_MN))
#define XML ((float*)(X.ws + WS_ML))
#define XBL ((float*)(X.ws + WS_BL))
#define XMS ((float*)(X.ws + WS_MS))
#define XSA ((float*)(X.ws + WS_SA))
#define XSH ((float*)(X.ws + WS_SH))
#define XCSB ((bf16_t*)(X.ws + WS_CSB))
#define XNS ((float*)(X.ws + WS_NS))
#define XHSB ((bf16_t*)(X.ws + WS_HSB))
#define XPAR(off) ((const float*)(X.ws + WS_PAR) + (off))
constexpr int P_AIB = 0, P_AFB = 16, P_DTB = 32, P_ALOG = 64, P_BD = 96, P_SINK = 128, P_QNW = 160, P_KNW = 416, P_ANW = 672, P_BNW = 2720, P_CB = 4768, P_CW = 8864, P_END = 25248;
#define IN_XP 0
#define IN_XS 1
#define IN_STC 2
#define IN_STN 3
#define IN_STM 4
#define IN_SSM 5
#define IN_CONV 6
#define IN_CK 7
#define IN_CV 8
#define IN_NORMW 9
#define IN_WIN 10
#define IN_AIB 11
#define IN_AFB 12
#define IN_ANW 13
#define IN_CW 14
#define IN_CB 15
#define IN_DTB 16
#define IN_ALOG 17
#define IN_BD 18
#define IN_BNW 19
#define IN_QNW 20
#define IN_KNW 21
#define IN_SINK 22
#define IN_WOUT 23

__device__ __forceinline__ void transpose_strip(lptr lds, const float* src, int ldn, int nvalid, bf16_t* dst, int ldk, const float* scale, int k0, int n0, int tid) {
    LAS float* T = (LAS float*)lds;
    f32x4 v[8];
#pragma unroll
    for (int i = 0; i < 8; ++i) {
        const int f = tid + i * NT, r = f >> 6, c4 = (f & 63) * 4, n = n0 + c4;
        const f32x4 t = __builtin_nontemporal_load((const f32x4*)(src + (size_t)(k0 + r) * ldn + (n < nvalid ? n : 0)));
        const float m = n < nvalid ? (scale ? scale[k0 + r] : 1.f) : 0.f;
        v[i] = t * m;
    }
#pragma unroll
    for (int i = 0; i < 8; ++i) {
        const int f = tid + i * NT, r = f >> 6, c4 = (f & 63) * 4;
        T[r * 257 + c4 + 0] = v[i][0]; T[r * 257 + c4 + 1] = v[i][1]; T[r * 257 + c4 + 2] = v[i][2]; T[r * 257 + c4 + 3] = v[i][3];
    }
    __syncthreads();
#pragma unroll
    for (int i = 0; i < 4; ++i) {
        const int p = tid + i * NT, n = p >> 3, k8 = (p & 7) * 8; float f[8];
#pragma unroll
        for (int jx = 0; jx < 8; ++jx) f[jx] = T[(k8 + jx) * 257 + n];
        *(u32x4*)(dst + (size_t)(n0 + n) * ldk + k0 + k8) = pack8(f);
    }
    __syncthreads();
}

__device__ __forceinline__ void prologue(lptr lds, const Ctx& X, const Args& args, int G, int bid, int tid) {
    const int lane = tid & 63, wave = tid >> 6;
    constexpr int T0 = 320, T1 = T0 + 96, T2 = T1 + 520, T3 = T2 + 6, T4 = T3 + 513;
    for (int task = bid; task < T4; task += G) {
        if (task < T0) {
            const int kt = task / 20, ntl = task % 20;
            transpose_strip(lds, args.in[IN_WIN], DIN, DIN, XWIN, D, args.in[IN_NORMW], kt * 64, ntl * 256, tid);
        } else if (task < T1) {
            const int r = task - T0, kt = r / 4, ntl = r % 4;
            transpose_strip(lds, args.in[IN_WOUT], D, D, XWOUT, DMIX, nullptr, kt * 64, ntl * 256, tid);
        } else if (task < T2) {
            const int rb = (task - T1) * 32 + wave * 4;
            f32x4 v[4][4];
#pragma unroll
            for (int q = 0; q < 4; ++q) {
                const int r = rb + q, rc = r < MTOK ? r : MTOK - 1;
                const float* src = rc < TP ? X.xp + (size_t)rc * D : X.xs + (size_t)(rc - TP) * D;
#pragma unroll
                for (int i = 0; i < 4; ++i) v[q][i] = __builtin_nontemporal_load((const f32x4*)(src + lane * 4 + i * 256));
            }
#pragma unroll
            for (int q = 0; q < 4; ++q) {
                const int r = rb + q;
                const float keep = r < MTOK ? 1.f : 0.f;
                float ss = 0.f;
#pragma unroll
                for (int i = 0; i < 4; ++i) {
                    const f32x4 t = v[q][i] * keep;
                    ss += t[0] * t[0] + t[1] * t[1] + t[2] * t[2] + t[3] * t[3];
                    u32x2 w; w[0] = pk2(t[0], t[1]); w[1] = pk2(t[2], t[3]);
                    *(u32x2*)(XXB + (size_t)r * D + lane * 4 + i * 256) = w;
                }
                ss = wave_sum(ss);
                if (lane < 16) XSSQ[(size_t)r * 16 + lane] = (lane == 0) ? ss : 0.f;
            }
        } else if (task < T3) {
            float* P = (float*)(X.ws + WS_PAR);
            const int k = task - T2;
            if (k == 0) {
                for (int i = tid; i < (MPAD - MTOK) * DMIX / 2; i += NT) ((unsigned*)(XMIX + (size_t)MTOK * DMIX))[i] = 0u;
                float v[10];
#pragma unroll
                for (int q = 0; q < 10; ++q) {
                    const int i = tid + q * NT, ic = i < P_CB ? i : P_CB - 1;
                    const float* src; int off;
                    if (ic < P_AFB) { src = args.in[IN_AIB]; off = ic - P_AIB; } else if (ic < P_DTB) { src = args.in[IN_AFB]; off = ic - P_AFB; }
                    else if (ic < P_ALOG) { src = args.in[IN_DTB]; off = ic - P_DTB; } else if (ic < P_BD) { src = args.in[IN_ALOG]; off = ic - P_ALOG; }
                    else if (ic < P_SINK) { src = args.in[IN_BD]; off = ic - P_BD; } else if (ic < P_QNW) { src = args.in[IN_SINK]; off = ic - P_SINK; }
                    else if (ic < P_KNW) { src = args.in[IN_QNW]; off = ic - P_QNW; } else if (ic < P_ANW) { src = args.in[IN_KNW]; off = ic - P_KNW; }
                    else if (ic < P_BNW) { src = args.in[IN_ANW]; off = ic - P_ANW; } else { src = args.in[IN_BNW]; off = ic - P_BNW; }
                    v[q] = src[off];
                }
#pragma unroll
                for (int q = 0; q < 10; ++q) { const int i = tid + q * NT; if (i < P_CB) P[i] = v[q]; }
            } else {
                const float* src = k == 1 ? args.in[IN_CB] : args.in[IN_CW] + (k - 2) * 4096;
                float* dst = P + (k == 1 ? P_CB : P_CW + (k - 2) * 4096);
                f32x4 v[2];
#pragma unroll
                for (int q = 0; q < 2; ++q) v[q] = *(const f32x4*)(src + (tid + q * NT) * 4);
#pragma unroll
                for (int q = 0; q < 2; ++q) *(f32x4*)(dst + (tid + q * NT) * 4) = v[q];
            }
        } else {
            const int e = (task - T3) * 512 + tid;
            if (e < 8193 * 32) {
                const int pos = e >> 5, d = e & 31;
                const float inv = (float)exp2(-(double)d * (13.287712379549449 / 32.0));
                const float angf = (float)pos * inv;
                const double a = (double)angf;
                const double k = rint(a * 0.15915494309189535);
                const float rr = (float)(a - k * 6.283185307179586);
                XROPE[(size_t)e * 2] = __cosf(rr); XROPE[(size_t)e * 2 + 1] = __sinf(rr);
            }
        }
    }
}

__device__ __forceinline__ void convert_weights(lptr lds, const Ctx& X, const Args& args, int l, int first, int stride, int tid) {
    for (int t = first; t < 416; t += stride) {
        if (t < 320) {
            const int kt = t / 20, ntl = t % 20;
            transpose_strip(lds, args.in[IN_WIN] + (size_t)l * D * DIN, DIN, DIN, XWIN + (size_t)l * NIN * D, D, args.in[IN_NORMW] + l * D, kt * 64, ntl * 256, tid);
        } else {
            const int r = t - 320, kt = r / 4, ntl = r % 4;
            transpose_strip(lds, args.in[IN_WOUT] + (size_t)l * DMIX * D, D, D, XWOUT + (size_t)l * D * DMIX, DMIX, nullptr, kt * 64, ntl * 256, tid);
        }
    }
}

__device__ __forceinline__ void conv8(const bf16_t* u, int seq0, int tt, int ch, const float* cw, const float* cb, float (&o)[8]) {
    float acc[8];
    { f32x4 b0 = *(const f32x4*)(cb + ch), b1 = *(const f32x4*)(cb + ch + 4);
#pragma unroll
      for (int j = 0; j < 4; ++j) { acc[j] = b0[j]; acc[4 + j] = b1[j]; } }
#pragma unroll
    for (int jj = 0; jj < 4; ++jj) {
        const int t2 = tt + jj - 3;
        if (t2 >= 0) {
            float x[8]; unpack8(*(const u32x4*)(u + (size_t)(seq0 + t2) * NIN + C_BX + ch), x);
            f32x4 w0 = *(const f32x4*)(cw + jj * 1024 + ch), w1 = *(const f32x4*)(cw + jj * 1024 + ch + 4);
#pragma unroll
            for (int j = 0; j < 4; ++j) { acc[j] += x[j] * w0[j]; acc[4 + j] += x[4 + j] * w1[j]; }
        }
    }
#pragma unroll
    for (int j = 0; j < 8; ++j) o[j] = siluf_(acc[j]);
}


__device__ __forceinline__ void conv8x8(const bf16_t* u, int seq0, int tt0, int ch, const float* cw, const float* cb, float (&o)[8][8]) {
    float w[4][8];
#pragma unroll
    for (int jj = 0; jj < 4; ++jj) { f32x4 w0 = *(const f32x4*)(cw + jj * 1024 + ch), w1 = *(const f32x4*)(cw + jj * 1024 + ch + 4);
#pragma unroll
        for (int j = 0; j < 4; ++j) { w[jj][j] = w0[j]; w[jj][4 + j] = w1[j]; } }
    { f32x4 b0 = *(const f32x4*)(cb + ch), b1 = *(const f32x4*)(cb + ch + 4);
#pragma unroll
      for (int t = 0; t < 8; ++t)
#pragma unroll
          for (int j = 0; j < 4; ++j) { o[t][j] = b0[j]; o[t][4 + j] = b1[j]; } }
    u32x4 raw[11];
#pragma unroll
    for (int r = 0; r < 11; ++r) {
        const int t2 = tt0 + r - 3;
        const u32x4 v = *(const u32x4*)(u + (unsigned)(seq0 + (t2 >= 0 ? t2 : 0)) * NIN + C_BX + ch);
        const unsigned msk = t2 >= 0 ? 0xffffffffu : 0u;
        raw[r] = (u32x4){v[0] & msk, v[1] & msk, v[2] & msk, v[3] & msk};
    }
#pragma unroll
    for (int r = 0; r < 11; ++r) {
        float x[8]; unpack8(raw[r], x);
#pragma unroll
        for (int jj = 0; jj < 4; ++jj) {
            const int t = r - jj;
            if (t >= 0 && t < 8) {
#pragma unroll
                for (int j = 0; j < 8; ++j) o[t][j] += x[j] * w[jj][j];
            }
        }
    }
#pragma unroll
    for (int t = 0; t < 8; ++t)
#pragma unroll
        for (int j = 0; j < 8; ++j) o[t][j] = siluf_(o[t][j]);
}

__device__ __forceinline__ void mlstm_local(lptr lds, const Ctx& X, int l, int task, int tid) {
    const int h = task & 3, c = (task >> 2) & 127, n = task >> 9;
    const int lane = tid & 63, wave = tid >> 6, fr = lane & 15, fq = lane >> 4;
    const int row0 = n * SEQ + c * 64, nh = n * 4 + h;
    lptr VwT = lds;
    lptr KT = lds + 18432;
    LAS float* wv = (LAS float*)(lds + 27648);
    const int tg = lane & 7, cgq = lane >> 3;
    u32x4 blk[8];
    if (wave >= 1 && wave <= 3) {
        const int col = wave < 3 ? C_AV + h * 128 + ((wave - 1) * 8 + cgq) * 8 : C_AK + h * 64 + cgq * 8;
#pragma unroll
        for (int t = 0; t < 8; ++t) blk[t] = *(const u32x4*)(XU + (unsigned)(row0 + 8 * tg + t) * NIN + col);
    }
    if (wave == 0) {
        const bf16_t* ur = XU + (unsigned)(row0 + lane) * NIN;
        const float fg = bf2f(ur[C_AF + h]) + XPAR(P_AFB)[l * 4 + h], ig = bf2f(ur[C_AI + h]) + XPAR(P_AIB)[l * 4 + h];
        const float b = wave_scan_sum(logsigf_(fg), lane);
        const float bl = lane63(b);
        const float g = bl - b + ig;
        const float ml = wave_max(g);
        wv[lane] = __expf(g - ml);
        if (lane == 0) { XML[nh * 128 + c] = ml; XBL[nh * 128 + c] = bl; }
    }
    __syncthreads();
    if (wave >= 1 && wave <= 3) {
        float xs[8][8];
#pragma unroll
        for (int t = 0; t < 8; ++t) { unpack8(blk[t], xs[t]); const float w = wave < 3 ? wv[8 * tg + t] : 0.125f;
#pragma unroll
            for (int j = 0; j < 8; ++j) xs[t][j] *= w; }
        lptr dstT = wave < 3 ? VwT + ((((wave - 1) * 8 + cgq) * 8 * 72) << 1) : KT + ((cgq * 8 * 72) << 1);
#pragma unroll
        for (int j = 0; j < 8; ++j) {
            float v[8];
#pragma unroll
            for (int t = 0; t < 8; ++t) v[t] = xs[t][j];
            *(LAS u32x4*)(dstT + ((j * 72 + 8 * tg) << 1)) = pack8(v);
        }
    }
    __syncthreads();
    {
        bf16_t* dst = (bf16_t*)XMC + ((size_t)nh * 128 + c) * 8192;
        bf16x8 b0 = lds_frag(VwT, 16 * wave + fr, fq * 8, 72), b1 = lds_frag(VwT, 16 * wave + fr, 32 + fq * 8, 72);
#pragma unroll
        for (int mt = 0; mt < 4; ++mt) {
            f32x4 acc = {0.f, 0.f, 0.f, 0.f};
            acc = mfma16(lds_frag(KT, 16 * mt + fr, fq * 8, 72), b0, acc);
            acc = mfma16(lds_frag(KT, 16 * mt + fr, 32 + fq * 8, 72), b1, acc);
            { u32x2 w; w[0] = pk2(acc[0], acc[1]); w[1] = pk2(acc[2], acc[3]); *(u32x2*)(dst + (16 * wave + fr) * 64 + 16 * mt + 4 * fq) = w; }
        }
    }
    if (tid < 64) {
        float s = 0.f;
#pragma unroll
        for (int t8 = 0; t8 < 8; ++t8) {
            float kf[8]; unpack8(*(const LAS u32x4*)(KT + ((tid * 72 + t8 * 8) << 1)), kf);
#pragma unroll
            for (int jx = 0; jx < 8; ++jx) s += kf[jx] * wv[t8 * 8 + jx];
        }
        XMN[((size_t)nh * 128 + c) * 64 + tid] = s;
    }
    __syncthreads();
}

__device__ __forceinline__ void ssd_local(lptr lds, const Ctx& X, int l, int task, int tid) {
    const int g = task & 1, c = (task >> 1) & 127, n = task >> 8;
    const int lane = tid & 63, wave = tid >> 6, fr = lane & 15, fq = lane >> 4;
    const int seq0 = n * SEQ, row0 = seq0 + c * 64;
    lptr XwT = lds;
    lptr BT = lds + 36864;
    LAS float* wl = (LAS float*)(lds + 55296);
    {
        const float* cw = XPAR(P_CW) + l * 4096; const float* cb = XPAR(P_CB) + l * 1024;
        const int tg = lane & 7, cg = wave * 8 + (lane >> 3);
        float o[8][8];
        if (wave < 6) {
            const int ch = cg < 32 ? g * 256 + cg * 8 : 512 + g * 128 + (cg - 32) * 8;
            conv8x8(XU, seq0, c * 64 + 8 * tg, ch, cw, cb, o);
        }
        if (wave < 4) {
            const int hh = 4 * g + wave;
            const float dt = softplusf_(bf2f(XU[(unsigned)(row0 + lane) * NIN + C_BDT + hh]) + XPAR(P_DTB)[l * 8 + hh]);
            const float A = -__expf(XPAR(P_ALOG)[l * 8 + hh]);
            const float a = wave_scan_sum(dt * A, lane);
            const float aL = lane63(a);
            wl[wave * 64 + lane] = __expf(aL - a) * dt;
            if (lane == 0) XSA[(n * 8 + hh) * 128 + c] = aL;
        }
        __syncthreads();
        if (wave < 4) {
            float wt[8];
#pragma unroll
            for (int t = 0; t < 8; ++t) wt[t] = wl[wave * 64 + 8 * tg + t];
#pragma unroll
            for (int jx = 0; jx < 8; ++jx) {
                float v[8];
#pragma unroll
                for (int t = 0; t < 8; ++t) v[t] = o[t][jx] * wt[t];
                *(LAS u32x4*)(XwT + (((cg * 8 + jx) * 72 + 8 * tg) << 1)) = pack8(v);
            }
        } else if (wave < 6) {
#pragma unroll
            for (int jx = 0; jx < 8; ++jx) {
                float v[8];
#pragma unroll
                for (int t = 0; t < 8; ++t) v[t] = o[t][jx];
                *(LAS u32x4*)(BT + ((((cg - 32) * 8 + jx) * 72 + 8 * tg) << 1)) = pack8(v);
            }
        }
    }
    __syncthreads();
    {
        const int hl = wave >> 1, ph = wave & 1, hh = 4 * g + hl;
        bf16_t* dst = (bf16_t*)XSH + ((size_t)(n * 8 + hh) * 128 + c) * 8192;
        bf16x8 bx[2][2];
#pragma unroll
        for (int ntl = 0; ntl < 2; ++ntl)
#pragma unroll
            for (int kk = 0; kk < 2; ++kk) bx[ntl][kk] = lds_frag(XwT, hl * 64 + ph * 32 + ntl * 16 + fr, kk * 32 + fq * 8, 72);
#pragma unroll
        for (int mt = 0; mt < 8; ++mt) {
            bf16x8 a0 = lds_frag(BT, 16 * mt + fr, fq * 8, 72), a1 = lds_frag(BT, 16 * mt + fr, 32 + fq * 8, 72);
#pragma unroll
            for (int ntl = 0; ntl < 2; ++ntl) {
                f32x4 acc = {0.f, 0.f, 0.f, 0.f};
                acc = mfma16(a0, bx[ntl][0], acc); acc = mfma16(a1, bx[ntl][1], acc);
                { u32x2 w; w[0] = pk2(acc[0], acc[1]); w[1] = pk2(acc[2], acc[3]); *(u32x2*)(dst + (ph * 32 + ntl * 16 + fr) * 128 + 16 * mt + 4 * fq) = w; }
            }
        }
    }
    __syncthreads();
}

__device__ __forceinline__ void swa_prompt(lptr lds, const Ctx& X, int l, int task, int tid) {
    const int kvh = task & 1, qb = (task >> 1) & 63, n = task >> 7;
    const int lane = tid & 63, wave = tid >> 6, fr = lane & 15, fq = lane >> 4;
    const int seq0 = n * SEQ;
    lptr Kn = lds;
    lptr Vt = lds + 36864;
    lptr Pw = lds + 70656 + wave * 8448;
    const float* knw = XPAR(P_KNW) + l * 64; const float* qnw = XPAR(P_QNW) + l * 64;
#pragma unroll
    for (int it = 0; it < 2; ++it) {
        const int item = tid + it * NT, j = item >> 2, qd = item & 3, t = qb * 128 - 128 + j;
        float o1[8], o2[8];
        {
            const int tc = t >= 0 ? t : 0;
            const bf16_t* kr = XU + (unsigned)(seq0 + tc) * NIN + C_CK + kvh * 64;
            float x1[8], x2[8]; unpack8(*(const u32x4*)(kr + qd * 8), x1); unpack8(*(const u32x4*)(kr + 32 + qd * 8), x2);
            float ss = 0.f;
#pragma unroll
            for (int jj = 0; jj < 8; ++jj) ss += x1[jj] * x1[jj] + x2[jj] * x2[jj];
            ss += __shfl_xor(ss, 1); ss += __shfl_xor(ss, 2);
            const float rs = rsqrtf(ss * (1.f / 64.f) + EPS);
            const f32x4* cs = (const f32x4*)(XROPE + ((size_t)tc * 32 + qd * 8) * 2);
            f32x4 csv[4];
#pragma unroll
            for (int q4 = 0; q4 < 4; ++q4) csv[q4] = cs[q4];
            const float zm = t >= 0 ? 1.f : 0.f;
#pragma unroll
            for (int jj = 0; jj < 8; ++jj) {
                const float a = x1[jj] * rs * knw[qd * 8 + jj], b = x2[jj] * rs * knw[32 + qd * 8 + jj], co = csv[jj >> 1][(jj & 1) * 2], si = csv[jj >> 1][(jj & 1) * 2 + 1];
                o1[jj] = (a * co - b * si) * zm; o2[jj] = (b * co + a * si) * zm;
            }
        }
        *(LAS u32x4*)(Kn + ((j * 72 + qd * 8) << 1)) = pack8(o1);
        *(LAS u32x4*)(Kn + ((j * 72 + 32 + qd * 8) << 1)) = pack8(o2);
        if (qb == 63 && j >= 128) {
            float* ko = X.out + O_PK + ((((size_t)l * 2 + n) * 128 + (j - 128)) * 2 + kvh) * 64;
            *(f32x4*)(ko + qd * 8) = (f32x4){o1[0], o1[1], o1[2], o1[3]}; *(f32x4*)(ko + qd * 8 + 4) = (f32x4){o1[4], o1[5], o1[6], o1[7]};
            *(f32x4*)(ko + 32 + qd * 8) = (f32x4){o2[0], o2[1], o2[2], o2[3]}; *(f32x4*)(ko + 32 + qd * 8 + 4) = (f32x4){o2[4], o2[5], o2[6], o2[7]};
        }
    }
    if (wave < 4) {
        const int tg = tid & 31, cg = tid >> 5;
        u32x4 vb[8];
#pragma unroll
        for (int t8 = 0; t8 < 8; ++t8) {
            const int jk = 8 * tg + t8, t = qb * 128 - 128 + jk;
            u32x4 w = *(const u32x4*)(XU + (unsigned)(seq0 + (t >= 0 ? t : 0)) * NIN + C_CV + kvh * 64 + cg * 8);
            const unsigned msk = t >= 0 ? 0xffffffffu : 0u;
            vb[t8] = (u32x4){w[0] & msk, w[1] & msk, w[2] & msk, w[3] & msk};
        }
#pragma unroll
        for (int jj = 0; jj < 8; ++jj) {
            u32x4 w;
#pragma unroll
            for (int tp = 0; tp < 4; ++tp) {
                const unsigned lo = (vb[2 * tp][jj >> 1] >> ((jj & 1) * 16)) & 0xffffu, hi = (vb[2 * tp + 1][jj >> 1] >> ((jj & 1) * 16)) & 0xffffu;
                w[tp] = lo | (hi << 16);
            }
            *(LAS u32x4*)(Vt + (((cg * 8 + jj) * 264 + 8 * tg) << 1)) = w;
        }
        if (qb == 63 && tg >= 16) {
#pragma unroll
            for (int t8 = 0; t8 < 8; ++t8) {
                float x[8]; unpack8(vb[t8], x);
                float* vo = X.out + O_PV + ((((size_t)l * 2 + n) * 128 + (8 * tg + t8 - 128)) * 2 + kvh) * 64 + cg * 8;
                *(f32x4*)(vo) = (f32x4){x[0], x[1], x[2], x[3]}; *(f32x4*)(vo + 4) = (f32x4){x[4], x[5], x[6], x[7]};
            }
        }
    }
    __syncthreads();
    const int hq = kvh * 4 + (wave >> 1), i0 = (wave & 1) * 64;
    const float sink = XPAR(P_SINK)[l * 8 + hq];
    float qw1[8], qw2[8];
#pragma unroll
    for (int jj = 0; jj < 8; ++jj) { qw1[jj] = qnw[fq * 8 + jj]; qw2[jj] = qnw[32 + fq * 8 + jj]; }
    u32x4 qn0, qn1; f32x4 csn[4];
    {
        const int t = qb * 128 + i0 + fr;
        const bf16_t* qr = XU + (unsigned)(seq0 + t) * NIN + C_CQ + hq * 64;
        qn0 = *(const u32x4*)(qr + fq * 8); qn1 = *(const u32x4*)(qr + 32 + fq * 8);
        const f32x4* cs = (const f32x4*)(XROPE + ((size_t)t * 32 + fq * 8) * 2);
#pragma unroll
        for (int q4 = 0; q4 < 4; ++q4) csn[q4] = cs[q4];
    }
#pragma unroll 1
    for (int mt = 0; mt < 4; ++mt) {
        const int q0 = i0 + mt * 16;
        const u32x4 q0r = qn0, q1r = qn1; f32x4 csc[4];
#pragma unroll
        for (int q4 = 0; q4 < 4; ++q4) csc[q4] = csn[q4];
        {
            const int mn = mt < 3 ? mt + 1 : 3;
            const int t = qb * 128 + i0 + mn * 16 + fr;
            const bf16_t* qr = XU + (unsigned)(seq0 + t) * NIN + C_CQ + hq * 64;
            qn0 = *(const u32x4*)(qr + fq * 8); qn1 = *(const u32x4*)(qr + 32 + fq * 8);
            const f32x4* cs = (const f32x4*)(XROPE + ((size_t)t * 32 + fq * 8) * 2);
#pragma unroll
            for (int q4 = 0; q4 < 4; ++q4) csn[q4] = cs[q4];
        }
        bf16x8 a0, a1;
        {
            float x1[8], x2[8]; unpack8(q0r, x1); unpack8(q1r, x2);
            float ss = 0.f;
#pragma unroll
            for (int jj = 0; jj < 8; ++jj) ss += x1[jj] * x1[jj] + x2[jj] * x2[jj];
            ss += __shfl_xor(ss, 16); ss += __shfl_xor(ss, 32);
            const float rs = rsqrtf(ss * (1.f / 64.f) + EPS) * 0.125f;
            float o1[8], o2[8];
#pragma unroll
            for (int jj = 0; jj < 8; ++jj) {
                const float a = x1[jj] * rs * qw1[jj], b = x2[jj] * rs * qw2[jj], co = csc[jj >> 1][(jj & 1) * 2], si = csc[jj >> 1][(jj & 1) * 2 + 1];
                o1[jj] = a * co - b * si; o2[jj] = b * co + a * si;
            }
            a0 = as_frag(pack8(o1)); a1 = as_frag(pack8(o2));
        }
        const int tlo = q0 >> 4;
        const int qi = q0 + fr;
        const int dlo = qb > 0 ? 1 : (128 - qi > 1 ? 128 - qi : 1);
        f32x4 s[16];
        float mx = -3.0e38f;
#pragma unroll
        for (int ntl = 0; ntl < 16; ++ntl) {
            if (ntl >= tlo && ntl <= tlo + 8) {
                f32x4 acc = {0.f, 0.f, 0.f, 0.f};
                acc = mfma16(lds_frag(Kn, 16 * ntl + fr, fq * 8, 72), a0, acc);
                acc = mfma16(lds_frag(Kn, 16 * ntl + fr, 32 + fq * 8, 72), a1, acc);
                if (ntl == tlo || ntl == tlo + 8 || qb == 0) {
#pragma unroll
                    for (int ii = 0; ii < 4; ++ii) {
                        const int dk = 16 * ntl + 4 * fq + ii - qi;
                        acc[ii] = ((unsigned)(dk - dlo) <= (unsigned)(128 - dlo)) ? acc[ii] : -3.0e38f;
                    }
                }
                mx = fmaxf(mx, fmaxf(fmaxf(acc[0], acc[1]), fmaxf(acc[2], acc[3])));
                s[ntl] = acc;
            }
        }
        mx = fmaxf(mx, __shfl_xor(mx, 16)); mx = fmaxf(mx, __shfl_xor(mx, 32));
        mx = fmaxf(mx, sink);
        float sum = 0.f;
#pragma unroll
        for (int ntl = 0; ntl < 16; ++ntl) {
            if (ntl >= tlo && ntl <= tlo + 8) {
#pragma unroll
                for (int ii = 0; ii < 4; ++ii) { const float e = __expf(s[ntl][ii] - mx); s[ntl][ii] = e; sum += e; }
            }
        }
        sum += __shfl_xor(sum, 16); sum += __shfl_xor(sum, 32);
        const float inv = rcpf_(sum + __expf(sink - mx));
        const int klo = q0 >> 5, khi = (q0 + 143) >> 5;
#pragma unroll
        for (int ntl = 0; ntl < 16; ++ntl) {
            if (ntl >= tlo && ntl <= tlo + 8) {
                u32x2 w; w[0] = pk2(s[ntl][0] * inv, s[ntl][1] * inv); w[1] = pk2(s[ntl][2] * inv, s[ntl][3] * inv);
                *(LAS u32x2*)(Pw + ((fr * 264 + 16 * ntl + 4 * fq) << 1)) = w;
            } else if ((ntl >> 1) >= klo && (ntl >> 1) <= khi) {
                u32x2 w = {0u, 0u};
                *(LAS u32x2*)(Pw + ((fr * 264 + 16 * ntl + 4 * fq) << 1)) = w;
            }
        }
        u32x2 czv[4];
#pragma unroll
        for (int ntl = 0; ntl < 4; ++ntl) czv[ntl] = *(const u32x2*)(XU + ((unsigned)seq0 + qb * 128 + q0 + fr) * NIN + C_CZ + hq * 64 + 16 * ntl + 4 * fq);
        LDS_FENCE();
        f32x4 o[4];
#pragma unroll
        for (int ntl = 0; ntl < 4; ++ntl) o[ntl] = (f32x4){0.f, 0.f, 0.f, 0.f};
#pragma unroll
        for (int kk = 0; kk < 8; ++kk) {
            if (kk >= klo && kk <= khi) {
                const bf16x8 a = lds_frag(Pw, fr, kk * 32 + fq * 8, 264);
#pragma unroll
                for (int ntl = 0; ntl < 4; ++ntl) o[ntl] = mfma16(lds_frag(Vt, 16 * ntl + fr, kk * 32 + fq * 8, 264), a, o[ntl]);
            }
        }
        LDS_FENCE();
        {
            const unsigned row = (unsigned)seq0 + qb * 128 + q0 + fr;
#pragma unroll
            for (int ntl = 0; ntl < 4; ++ntl) {
                const float z0 = __uint_as_float(czv[ntl][0] << 16), z1 = __uint_as_float(czv[ntl][0] & 0xffff0000u), z2 = __uint_as_float(czv[ntl][1] << 16), z3 = __uint_as_float(czv[ntl][1] & 0xffff0000u);
                u32x2 w; w[0] = pk2(o[ntl][0] * siluf_(z0), o[ntl][1] * siluf_(z1)); w[1] = pk2(o[ntl][2] * siluf_(z2), o[ntl][3] * siluf_(z3));
                *(u32x2*)(XMIX + row * DMIX + 1024 + hq * 64 + 16 * ntl + 4 * fq) = w;
            }
        }
    }
    __syncthreads();
}

__device__ __forceinline__ void sample_task(lptr lds, const Ctx& X, int l, int b, int part, int tid) {
    LAS float* uf = (LAS float*)lds;
    LAS float* xbc = (LAS float*)(lds + 19968);
    LAS float* numv = (LAS float*)(lds + 24064);
    LAS float* yv = (LAS float*)(lds + 26112);
    LAS float* red = (LAS float*)(lds + 28160);
    LAS float* qs = (LAS float*)(lds + 28416);
    LAS float* kn = (LAS float*)(lds + 30464);
    LAS float* sc = (LAS float*)(lds + 30976);
    const int lane = tid & 63, wave = tid >> 6;
    const size_t row = (size_t)TP + b;
    const bf16_t* ur = XU + row * NIN;
    const size_t lb = (size_t)l * 128 + b;
    f32x4 kpre[8], vpre[8];
    if (part == 2) {
        const float* kc = X.ck + lb * 16384; const float* vc = X.cv + lb * 16384;
#pragma unroll
        for (int it = 0; it < 8; ++it) {
            const int e = (tid + it * NT) * 4, e2 = e < 127 * 128 ? e + 128 : e;
            kpre[it] = __builtin_nontemporal_load((const f32x4*)(kc + e2)); vpre[it] = __builtin_nontemporal_load((const f32x4*)(vc + e2));
        }
    }
    f32x4 spre[4][4];
    if (part == 0) {
#pragma unroll
        for (int h = 0; h < 4; ++h)
#pragma unroll
            for (int it = 0; it < 4; ++it) spre[h][it] = __builtin_nontemporal_load((const f32x4*)(X.stC + (lb * 4 + h) * 8192 + (tid + it * NT) * 4));
    }
    if (part == 1) {
#pragma unroll
        for (int h = 0; h < 4; ++h)
#pragma unroll
            for (int it = 0; it < 4; ++it) spre[h][it] = __builtin_nontemporal_load((const f32x4*)(X.ssm + (lb * 8 + h) * 8192 + (tid + it * NT) * 4));
    }
    {
        const int c_lo = part == 0 ? 0 : (part == 1 ? C_BZ : C_CQ), c_hi = part == 0 ? C_BZ : (part == 1 ? C_CQ : DIN);
        if (tid < ((c_hi - c_lo) >> 3)) {
            float f[8]; unpack8(*(const u32x4*)(ur + c_lo + 8 * tid), f);
#pragma unroll
            for (int j = 0; j < 8; ++j) uf[c_lo + 8 * tid + j] = f[j];
        }
    }
    __syncthreads();
    if (part == 0) {
#pragma unroll
    for (int h = 0; h < 4; ++h) {
        const float ig = uf[C_AI + h] + XPAR(P_AIB)[l * 4 + h], fg = uf[C_AF + h] + XPAR(P_AFB)[l * 4 + h];
        const float ls = logsigf_(fg), m0 = X.stM[lb * 4 + h];
        const float mn = fmaxf(ls + m0, ig), sp = __expf(ls + m0 - mn), sl = __expf(ig - mn);
        const float* C0 = X.stC + (lb * 4 + h) * 8192; float* C1 = X.out + O_SC + (lb * 4 + h) * 8192;
#pragma unroll
        for (int it = 0; it < 4; ++it) {
            const int e = (tid + it * NT) * 4, v = e >> 6, k = e & 63;
            const f32x4 c0 = spre[h][it];
            const float vv = uf[C_AV + h * 128 + v] * sl;
            f32x4 c1; float part = 0.f;
#pragma unroll
            for (int j = 0; j < 4; ++j) { c1[j] = sp * c0[j] + vv * (uf[C_AK + h * 64 + k + j] * 0.125f); part += c1[j] * uf[C_AQ + h * 64 + k + j]; }
            __builtin_nontemporal_store(c1, (f32x4*)(C1 + e));
            part = red16(part);
            if ((lane & 15) == 0) numv[h * 128 + v] = part;
        }
        if (wave == 0) {
            const float n1 = sp * X.stN[(lb * 4 + h) * 64 + lane] + sl * uf[C_AK + h * 64 + lane] * 0.125f;
            X.out[O_SN + (lb * 4 + h) * 64 + lane] = n1;
            const float dd = wave_sum(n1 * uf[C_AQ + h * 64 + lane]);
            if (lane == 0) { red[h] = dd; red[4 + h] = mn; X.out[O_SM + lb * 4 + h] = mn; }
        }
    }
    __syncthreads();
    float hv;
    { const int h = tid >> 7; hv = numv[tid] * rcpf_(fmaxf(fabsf(red[h]), __expf(-red[4 + h]))); const float ss = wave_sum(hv * hv); if (lane == 0) red[8 + wave] = ss; }
    __syncthreads();
    { const int h = tid >> 7; const float rs = rsqrtf((red[8 + 2 * h] + red[9 + 2 * h]) * (1.f / 128.f) + EPS);
      XMIX[row * DMIX + tid] = (bf16_t)f2bf(hv * rs * XPAR(P_ANW)[l * 512 + tid] * sigmoidf_(uf[C_AO + tid]) * siluf_(uf[C_AZ + tid])); }
    }
    if (part == 1) {
    {
        const float* buf = X.conv + lb * 3 * 1024; float* oc = X.out + O_SCONV + lb * 3 * 1024;
        const float* cw = XPAR(P_CW) + l * 4096;
#pragma unroll
        for (int it = 0; it < 2; ++it) {
            const int ch = tid + it * NT;
            const float f0 = buf[ch], f1 = buf[1024 + ch], f2 = buf[2048 + ch], f3 = uf[C_BX + ch];
            const float acc = XPAR(P_CB)[l * 1024 + ch] + f0 * cw[ch] + f1 * cw[1024 + ch] + f2 * cw[2048 + ch] + f3 * cw[3072 + ch];
            xbc[ch] = siluf_(acc);
            oc[ch] = f1; oc[1024 + ch] = f2; oc[2048 + ch] = f3;
        }
    }
    __syncthreads();
#pragma unroll 1
    for (int hb = 0; hb < 8; hb += 4)
#pragma unroll
    for (int hk = 0; hk < 4; ++hk) {
        const int hh = hb + hk;
        const float dt = softplusf_(uf[C_BDT + hh] + XPAR(P_DTB)[l * 8 + hh]);
        const float dA = __expf(-dt * __expf(XPAR(P_ALOG)[l * 8 + hh]));
        const int g = hh >> 2;
        const float* h0p = X.ssm + (lb * 8 + hh) * 8192; float* h1p = X.out + O_SH + (lb * 8 + hh) * 8192;
#pragma unroll
        for (int it = 0; it < 4; ++it) {
            const int e = (tid + it * NT) * 4, p = e >> 7, s = e & 127;
            f32x4 h0; if (hb == 0) h0 = spre[hk][it]; else h0 = __builtin_nontemporal_load((const f32x4*)(h0p + e));
            const float xv = xbc[hh * 64 + p] * dt;
            f32x4 h1; float part = 0.f;
#pragma unroll
            for (int j = 0; j < 4; ++j) { h1[j] = dA * h0[j] + xv * xbc[512 + g * 128 + s + j]; part += h1[j] * xbc[768 + g * 128 + s + j]; }
            __builtin_nontemporal_store(h1, (f32x4*)(h1p + e));
            part = red16(part); part += __shfl_xor(part, 16);
            if ((lane & 31) == 0) yv[hh * 64 + p] = part;
        }
    }
    __syncthreads();
    float gb;
    { const int hh = tid >> 6; const float y = yv[tid] + XPAR(P_BD)[l * 8 + hh] * xbc[tid]; gb = y * siluf_(uf[C_BZ + tid]); const float ss = wave_sum(gb * gb); if (lane == 0) red[16 + wave] = ss; }
    __syncthreads();
    { const int g = tid >> 8; const float rs = rsqrtf((red[16 + 4 * g] + red[17 + 4 * g] + red[18 + 4 * g] + red[19 + 4 * g]) * (1.f / 256.f) + EPS);
      XMIX[row * DMIX + 512 + tid] = (bf16_t)f2bf(gb * rs * XPAR(P_BNW)[l * 512 + tid]); }
    }
    if (part == 2) {
    lptr Kl = lds + 36864;
    lptr Vl = lds + 36864 + 34816;
    if (tid < 320) {
        const int vec = tid >> 5, d = tid & 31, base = vec < 8 ? C_CQ + vec * 64 : C_CK + (vec - 8) * 64;
        const float x1 = uf[base + d], x2 = uf[base + 32 + d];
        float ss = x1 * x1 + x2 * x2; ss = red16(ss); ss += __shfl_xor(ss, 16);
        const float rs = rsqrtf(ss * (1.f / 64.f) + EPS);
        const float* w = vec < 8 ? XPAR(P_QNW) + l * 64 : XPAR(P_KNW) + l * 64;
        const float a = x1 * rs * w[d], bb = x2 * rs * w[d + 32];
        const float co = XROPE[((size_t)8192 * 32 + d) * 2], si = XROPE[((size_t)8192 * 32 + d) * 2 + 1];
        const float o1 = a * co - bb * si, o2 = bb * co + a * si;
        if (vec < 8) { qs[vec * 64 + d] = o1 * 0.125f; qs[vec * 64 + 32 + d] = o2 * 0.125f; } else { kn[(vec - 8) * 64 + d] = o1; kn[(vec - 8) * 64 + 32 + d] = o2; }
    }
    __syncthreads();
    {
        float* ko = X.out + O_SK + lb * 16384; float* vo = X.out + O_SV + lb * 16384;
#pragma unroll
        for (int it = 0; it < 8; ++it) {
            const int e = (tid + it * NT) * 4, j = e >> 7, r = e & 127;
            f32x4 kv = kpre[it], vv = vpre[it];
            if (j == 127) { kv = (f32x4){kn[r], kn[r + 1], kn[r + 2], kn[r + 3]}; vv = (f32x4){uf[C_CV + r], uf[C_CV + r + 1], uf[C_CV + r + 2], uf[C_CV + r + 3]}; }
            __builtin_nontemporal_store(kv, (f32x4*)(ko + e)); __builtin_nontemporal_store(vv, (f32x4*)(vo + e));
            u32x2 wk, wv2; wk[0] = pk2(kv[0], kv[1]); wk[1] = pk2(kv[2], kv[3]); wv2[0] = pk2(vv[0], vv[1]); wv2[1] = pk2(vv[2], vv[3]);
            *(LAS u32x2*)(Kl + ((j * 136 + r) << 1)) = wk; *(LAS u32x2*)(Vl + ((j * 136 + r) << 1)) = wv2;
        }
    }
    __syncthreads();
    if (tid < 256) {
        const int kvh = tid >> 7, jj = tid & 127;
        float s0 = 0.f, s1 = 0.f, s2 = 0.f, s3 = 0.f;
#pragma unroll 2
        for (int d8 = 0; d8 < 8; ++d8) {
            float kf[8]; unpack8(*(const LAS u32x4*)(Kl + ((jj * 136 + kvh * 64 + d8 * 8) << 1)), kf);
#pragma unroll
            for (int j = 0; j < 8; ++j) {
                s0 += kf[j] * qs[(kvh * 4 + 0) * 64 + d8 * 8 + j]; s1 += kf[j] * qs[(kvh * 4 + 1) * 64 + d8 * 8 + j];
                s2 += kf[j] * qs[(kvh * 4 + 2) * 64 + d8 * 8 + j]; s3 += kf[j] * qs[(kvh * 4 + 3) * 64 + d8 * 8 + j];
            }
        }
        sc[(kvh * 4 + 0) * 128 + jj] = s0; sc[(kvh * 4 + 1) * 128 + jj] = s1; sc[(kvh * 4 + 2) * 128 + jj] = s2; sc[(kvh * 4 + 3) * 128 + jj] = s3;
    }
    __syncthreads();
    {
        const int hq = wave; const float s0 = sc[hq * 128 + lane], s1 = sc[hq * 128 + 64 + lane], sink = XPAR(P_SINK)[l * 8 + hq];
        const float m = fmaxf(wave_max(fmaxf(s0, s1)), sink);
        const float e0 = __expf(s0 - m), e1 = __expf(s1 - m);
        const float inv = rcpf_(wave_sum(e0 + e1) + __expf(sink - m));
        sc[hq * 128 + lane] = e0 * inv; sc[hq * 128 + 64 + lane] = e1 * inv;
    }
    __syncthreads();
    {
        const int hq = tid >> 6, d = tid & 63, kvh = hq >> 2;
        float o = 0.f;
#pragma unroll 16
        for (int jj = 0; jj < 128; ++jj) o += sc[hq * 128 + jj] * bf2f(*(const LAS bf16_t*)(Vl + ((jj * 136 + kvh * 64 + d) << 1)));
        XMIX[row * DMIX + 1024 + tid] = (bf16_t)f2bf(o * siluf_(uf[C_CZ + tid]));
    }
    }
    __syncthreads();
}

__device__ __forceinline__ void scans(const Ctx& X, int l, int gt, int nthreads) {
    for (int item = gt; item < 98816; item += nthreads) {
        if (item < 32768) {
            const int nh = item >> 12, e = (item & 4095) * 2;
            const bf16_t* base = (const bf16_t*)XMC + (size_t)nh * 128 * 8192 + e;
            const float* ml = XML + nh * 128; const float* bl = XBL + nh * 128;
            float m = 0.f; f32x2 st = {0.f, 0.f};
            for (int c0 = 0; c0 < 128; c0 += 16) {
                f32x2 cl[16];
#pragma unroll
                for (int j = 0; j < 16; ++j) { const unsigned w = *(const unsigned*)(base + (size_t)(c0 + j) * 8192); cl[j] = (f32x2){__uint_as_float(w << 16), __uint_as_float(w & 0xffff0000u)}; }
#pragma unroll
                for (int j = 0; j < 16; ++j) {
                    const float mlj = ml[c0 + j], blj = bl[c0 + j], mn = fmaxf(blj + m, mlj), sp = __expf(blj + m - mn), sl = __expf(mlj - mn);
                    *(unsigned*)(XCSB + ((size_t)nh * 128 + c0 + j) * 8192 + e) = pk2(st[0], st[1]);
                    if (e == 0) XMS[nh * 128 + c0 + j] = m;
                    st = st * sp + cl[j] * sl; m = mn;
                }
            }
            *(f32x2*)(X.out + O_PC + ((size_t)l * 8 + nh) * 8192 + e) = st;
            if (e == 0) X.out[O_PM + l * 8 + nh] = m;
        } else if (item < 98304) {
            const int i1 = item - 32768, nhh = i1 >> 12, e = (i1 & 4095) * 2;
            const bf16_t* base = (const bf16_t*)XSH + (size_t)nhh * 128 * 8192 + e;
            const float* al = XSA + nhh * 128;
            f32x2 st = {0.f, 0.f};
            for (int c0 = 0; c0 < 128; c0 += 16) {
                f32x2 cl[16];
#pragma unroll
                for (int j = 0; j < 16; ++j) { const unsigned w = *(const unsigned*)(base + (size_t)(c0 + j) * 8192); cl[j] = (f32x2){__uint_as_float(w << 16), __uint_as_float(w & 0xffff0000u)}; }
#pragma unroll
                for (int j = 0; j < 16; ++j) {
                    const float dec = __expf(al[c0 + j]);
                    *(unsigned*)(XHSB + ((size_t)nhh * 128 + c0 + j) * 8192 + e) = pk2(st[0], st[1]);
                    st = st * dec + cl[j];
                }
            }
            *(f32x2*)(X.out + O_PH + ((size_t)l * 16 + nhh) * 8192 + e) = st;
        } else {
            const int i2 = item - 98304, nh = i2 >> 6, k = i2 & 63;
            float* base = XMN + (size_t)nh * 128 * 64 + k;
            const float* ml = XML + nh * 128; const float* bl = XBL + nh * 128;
            float m = 0.f, st = 0.f;
            for (int c = 0; c < 128; ++c) {
                const float mlj = ml[c], blj = bl[c], mn = fmaxf(blj + m, mlj), sp = __expf(blj + m - mn), sl = __expf(mlj - mn);
                const float cl = base[c * 64];
                XNS[(size_t)nh * 128 * 64 + c * 64 + k] = st;
                st = st * sp + cl * sl; m = mn;
            }
            X.out[O_PN + ((size_t)l * 8 + nh) * 64 + k] = st;
        }
    }
}

__device__ __forceinline__ void mlstm_out(lptr lds, const Ctx& X, int l, int task, int tid) {
    const int h = task & 3, c = (task >> 2) & 127, n = task >> 9;
    const int lane = tid & 63, wave = tid >> 6, fr = lane & 15, fq = lane >> 4;
    const int row0 = n * SEQ + c * 64, nh = n * 4 + h;
    lptr Qs = lds;
    lptr Ks = lds + 9216;
    lptr Vt = lds + 18432;
    lptr Sb = lds + 36864 + wave * 2304;
    LAS float* bv = (LAS float*)(lds + 55296);
    LAS float* dv = bv + 64;
    LAS float* mtv = bv + 128;
    LAS float* siv = bv + 192;
    LAS float* qnv = bv + 256;
    LAS float* ssqp = bv + 384;
    LAS float* nsv = bv + 512;
    const int mti = wave >> 1, half = wave & 1;
    u32x4 csf[2][4];
    {
        const bf16_t* Cs = XCSB + ((size_t)nh * 128 + c) * 8192;
#pragma unroll
        for (int kk = 0; kk < 2; ++kk)
#pragma unroll
            for (int ntl = 0; ntl < 4; ++ntl) csf[kk][ntl] = *(const u32x4*)(Cs + (64 * half + 16 * ntl + fr) * 64 + kk * 32 + fq * 8);
    }
    u32x2 aov[4], azv[4]; f32x4 anw[4];
#pragma unroll
    for (int ntl = 0; ntl < 4; ++ntl) {
        const int v = h * 128 + 64 * half + 16 * ntl + 4 * fq;
        const unsigned row = (unsigned)row0 + 16 * mti + fr;
        anw[ntl] = *(const f32x4*)(XPAR(P_ANW) + l * 512 + v);
        aov[ntl] = *(const u32x2*)(XU + row * NIN + C_AO + v); azv[ntl] = *(const u32x2*)(XU + row * NIN + C_AZ + v);
    }
    u32x4 qraw, kraw, vblk[8];
    const int tgv = lane & 7, cgv = (wave & 1) * 8 + (lane >> 3);
    {
        const int tok = tid >> 3, k8 = (tid & 7) * 8;
        const bf16_t* ur = XU + (unsigned)(row0 + tok) * NIN;
        qraw = *(const u32x4*)(ur + C_AQ + h * 64 + k8); kraw = *(const u32x4*)(ur + C_AK + h * 64 + k8);
        if (wave == 2 || wave == 3) {
#pragma unroll
            for (int t = 0; t < 8; ++t) vblk[t] = *(const u32x4*)(XU + (unsigned)(row0 + 8 * tgv + t) * NIN + C_AV + h * 128 + cgv * 8);
        }
    }
    if (wave == 0) {
        const bf16_t* ur = XU + (unsigned)(row0 + lane) * NIN;
        const float fg = bf2f(ur[C_AF + h]) + XPAR(P_AFB)[l * 4 + h], ig = bf2f(ur[C_AI + h]) + XPAR(P_AIB)[l * 4 + h];
        const float b = wave_scan_sum(logsigf_(fg), lane);
        const float dd = ig - b;
        const float cm = wave_scan_max(dd, lane);
        const float ms = XMS[nh * 128 + c];
        const float mt = b + fmaxf(ms, cm);
        bv[lane] = b; dv[lane] = dd; mtv[lane] = mt; siv[lane] = __expf(b + ms - mt);
        nsv[lane] = XNS[((size_t)nh * 128 + c) * 64 + lane];
    }
    {
        const int tok = tid >> 3, k8 = (tid & 7) * 8;
        *(LAS u32x4*)(Qs + ((tok * 72 + k8) << 1)) = qraw;
        float x[8]; unpack8(kraw, x);
#pragma unroll
        for (int j = 0; j < 8; ++j) x[j] *= 0.125f;
        *(LAS u32x4*)(Ks + ((tok * 72 + k8) << 1)) = pack8(x);
    }
    if (wave == 2 || wave == 3) {
#pragma unroll
        for (int j = 0; j < 8; ++j) {
            u32x4 w;
#pragma unroll
            for (int tp = 0; tp < 4; ++tp) {
                const unsigned lo = (vblk[2 * tp][j >> 1] >> ((j & 1) * 16)) & 0xffffu, hi = (vblk[2 * tp + 1][j >> 1] >> ((j & 1) * 16)) & 0xffffu;
                w[tp] = lo | (hi << 16);
            }
            *(LAS u32x4*)(Vt + (((cgv * 8 + j) * 72 + 8 * tgv) << 1)) = w;
        }
    }
    __syncthreads();
    bf16x8 qa[2];
    qa[0] = lds_frag(Qs, 16 * mti + fr, fq * 8, 72); qa[1] = lds_frag(Qs, 16 * mti + fr, 32 + fq * 8, 72);
    const int tq = 16 * mti + fr;
    float qn;
    {
        float x0[8], x1[8]; unpack8(__builtin_bit_cast(u32x4, qa[0]), x0); unpack8(__builtin_bit_cast(u32x4, qa[1]), x1);
        float d = 0.f;
#pragma unroll
        for (int j = 0; j < 8; ++j) d += x0[j] * nsv[fq * 8 + j] + x1[j] * nsv[32 + fq * 8 + j];
        d += __shfl_xor(d, 16); d += __shfl_xor(d, 32);
        qn = d;
    }
    const float bt = bv[tq], mtq = mtv[tq], siq = siv[tq];
    float rsum = 0.f;
#pragma unroll
    for (int ntl = 0; ntl < 4; ++ntl) {
        f32x4 sT = {0.f, 0.f, 0.f, 0.f};
        sT = mfma16(lds_frag(Ks, 16 * ntl + fr, fq * 8, 72), qa[0], sT);
        sT = mfma16(lds_frag(Ks, 16 * ntl + fr, 32 + fq * 8, 72), qa[1], sT);
        float sv[4];
#pragma unroll
        for (int ii = 0; ii < 4; ++ii) {
            const int sidx = 16 * ntl + 4 * fq + ii;
            const float wgt = (sidx <= tq) ? __expf(bt + dv[sidx] - mtq) : 0.f;
            sv[ii] = wgt * sT[ii];
            rsum += sv[ii];
        }
        u32x2 w; w[0] = pk2(sv[0], sv[1]); w[1] = pk2(sv[2], sv[3]);
        *(LAS u32x2*)(Sb + ((fr * 72 + 16 * ntl + 4 * fq) << 1)) = w;
    }
    rsum += __shfl_xor(rsum, 16); rsum += __shfl_xor(rsum, 32);
    const float inv = rcpf_(fmaxf(fabsf(rsum + siq * qn), __expf(-mtq)));
    LDS_FENCE();
    f32x4 acc[4];
#pragma unroll
    for (int ntl = 0; ntl < 4; ++ntl) acc[ntl] = (f32x4){0.f, 0.f, 0.f, 0.f};
#pragma unroll
    for (int kk = 0; kk < 2; ++kk) {
        const bf16x8 sb = lds_frag(Sb, fr, kk * 32 + fq * 8, 72);
#pragma unroll
        for (int ntl = 0; ntl < 4; ++ntl) acc[ntl] = mfma16(lds_frag(Vt, 64 * half + 16 * ntl + fr, kk * 32 + fq * 8, 72), sb, acc[ntl]);
    }
#pragma unroll
    for (int kk = 0; kk < 2; ++kk) {
        float x[8]; unpack8(__builtin_bit_cast(u32x4, qa[kk]), x);
#pragma unroll
        for (int j = 0; j < 8; ++j) x[j] *= siq;
        const bf16x8 qs = as_frag(pack8(x));
#pragma unroll
        for (int ntl = 0; ntl < 4; ++ntl) acc[ntl] = mfma16(as_frag(csf[kk][ntl]), qs, acc[ntl]);
    }
    {
        float ss = 0.f;
#pragma unroll
        for (int ntl = 0; ntl < 4; ++ntl) { acc[ntl] = acc[ntl] * inv; ss += acc[ntl][0] * acc[ntl][0] + acc[ntl][1] * acc[ntl][1] + acc[ntl][2] * acc[ntl][2] + acc[ntl][3] * acc[ntl][3]; }
        ss += __shfl_xor(ss, 16); ss += __shfl_xor(ss, 32);
        if (fq == 0) ssqp[tq * 2 + half] = ss;
    }
    __syncthreads();
    {
        const float rs = rsqrtf((ssqp[tq * 2] + ssqp[tq * 2 + 1]) * (1.f / 128.f) + EPS);
        const unsigned row = (unsigned)row0 + tq;
#pragma unroll
        for (int ntl = 0; ntl < 4; ++ntl) {
            const float o[4] = {__uint_as_float(aov[ntl][0] << 16), __uint_as_float(aov[ntl][0] & 0xffff0000u), __uint_as_float(aov[ntl][1] << 16), __uint_as_float(aov[ntl][1] & 0xffff0000u)};
            const float z[4] = {__uint_as_float(azv[ntl][0] << 16), __uint_as_float(azv[ntl][0] & 0xffff0000u), __uint_as_float(azv[ntl][1] << 16), __uint_as_float(azv[ntl][1] & 0xffff0000u)};
            float y[4];
#pragma unroll
            for (int ii = 0; ii < 4; ++ii) y[ii] = acc[ntl][ii] * rs * anw[ntl][ii] * sigmoidf_(o[ii]) * siluf_(z[ii]);
            u32x2 w; w[0] = pk2(y[0], y[1]); w[1] = pk2(y[2], y[3]);
            *(u32x2*)(XMIX + row * DMIX + h * 128 + 64 * half + 16 * ntl + 4 * fq) = w;
        }
    }
    __syncthreads();
}

__device__ __forceinline__ void ssd_out(lptr lds, const Ctx& X, int l, int task, int tid) {
    const int g = task & 1, c = (task >> 1) & 127, n = task >> 8;
    const int lane = tid & 63, wave = tid >> 6, fr = lane & 15, fq = lane >> 4;
    const int seq0 = n * SEQ, row0 = seq0 + c * 64;
    lptr Cm = lds;
    lptr Bm = lds + 17408;
    lptr Xt = lds + 34816;
    LAS float* CBf = (LAS float*)(lds + 71680);
    LAS float* av = (LAS float*)(lds + 89088);
    LAS float* dtv = (LAS float*)(lds + 90112);
    LAS float* ssq = (LAS float*)(lds + 91136);
    const int hl = wave >> 1, th = wave & 1, hh = 4 * g + hl;
    u32x4 hsf[4][4];
    {
        const bf16_t* hs = XHSB + ((size_t)(n * 8 + hh) * 128 + c) * 8192;
#pragma unroll
        for (int kk = 0; kk < 4; ++kk)
#pragma unroll
            for (int ntl = 0; ntl < 4; ++ntl) hsf[kk][ntl] = *(const u32x4*)(hs + (16 * ntl + fr) * 128 + kk * 32 + fq * 8);
    }
    if (wave < 4) {
        const int hh = 4 * g + wave;
        const float dt = softplusf_(bf2f(XU[(unsigned)(row0 + lane) * NIN + C_BDT + hh]) + XPAR(P_DTB)[l * 8 + hh]);
        const float A = -__expf(XPAR(P_ALOG)[l * 8 + hh]);
        av[wave * 64 + lane] = wave_scan_sum(dt * A, lane);
        dtv[wave * 64 + lane] = dt;
    }
    {
        const float* cw = XPAR(P_CW) + l * 4096; const float* cb = XPAR(P_CB) + l * 1024;
        float o[8][8];
        if (wave < 4) {
            const int tg = lane & 7, cg = wave * 8 + (lane >> 3);
            conv8x8(XU, seq0, c * 64 + 8 * tg, g * 256 + cg * 8, cw, cb, o);
#pragma unroll
            for (int jx = 0; jx < 8; ++jx) {
                float v[8];
#pragma unroll
                for (int t = 0; t < 8; ++t) v[t] = o[t][jx];
                *(LAS u32x4*)(Xt + (((cg * 8 + jx) * 72 + 8 * tg) << 1)) = pack8(v);
            }
        } else {
            const int tg = lane >> 3, s8 = ((wave & 1) * 8 + (lane & 7)) * 8;
            conv8x8(XU, seq0, c * 64 + 8 * tg, (wave < 6 ? 512 : 768) + g * 128 + s8, cw, cb, o);
            lptr dstm = wave < 6 ? Bm : Cm;
#pragma unroll
            for (int t = 0; t < 8; ++t) *(LAS u32x4*)(dstm + (((8 * tg + t) * 136 + s8) << 1)) = pack8(o[t]);
        }
    }
    __syncthreads();
    u32x2 bzv[2][4]; f32x4 bnw[4];
#pragma unroll
    for (int ntl = 0; ntl < 4; ++ntl) {
        bnw[ntl] = *(const f32x4*)(XPAR(P_BNW) + l * 512 + hh * 64 + 16 * ntl + 4 * fq);
#pragma unroll
        for (int mi = 0; mi < 2; ++mi) bzv[mi][ntl] = *(const u32x2*)(XU + ((unsigned)row0 + 16 * (2 * th + mi) + fr) * NIN + C_BZ + hh * 64 + 16 * ntl + 4 * fq);
    }
    {
        const int mt = wave >> 1;
#pragma unroll
        for (int q = 0; q < 2; ++q) {
            const int ntl = 2 * (wave & 1) + q;
            f32x4 acc = {0.f, 0.f, 0.f, 0.f};
#pragma unroll
            for (int kk = 0; kk < 4; ++kk) acc = mfma16(lds_frag(Cm, 16 * mt + fr, kk * 32 + fq * 8, 136), lds_frag(Bm, 16 * ntl + fr, kk * 32 + fq * 8, 136), acc);
#pragma unroll
            for (int ii = 0; ii < 4; ++ii) CBf[(16 * mt + fq * 4 + ii) * 68 + 16 * ntl + fr] = acc[ii];
        }
    }
    __syncthreads();
    f32x4 y1[2][4], y2[2][4];
#pragma unroll
    for (int mi = 0; mi < 2; ++mi)
#pragma unroll
        for (int ntl = 0; ntl < 4; ++ntl) { y1[mi][ntl] = (f32x4){0.f, 0.f, 0.f, 0.f}; y2[mi][ntl] = (f32x4){0.f, 0.f, 0.f, 0.f}; }
#pragma unroll
    for (int kk = 0; kk < 2; ++kk) {
        bf16x8 bx[4];
#pragma unroll
        for (int ntl = 0; ntl < 4; ++ntl) bx[ntl] = lds_frag(Xt, hl * 64 + 16 * ntl + fr, kk * 32 + fq * 8, 72);
#pragma unroll
        for (int mi = 0; mi < 2; ++mi) {
            const int t = 16 * (2 * th + mi) + fr, u0 = kk * 32 + fq * 8;
            const float at = av[hl * 64 + t];
            float w[8];
#pragma unroll
            for (int j = 0; j < 8; ++j) {
                const int uu = u0 + j;
                w[j] = (uu <= t) ? CBf[t * 68 + uu] * __expf(at - av[hl * 64 + uu]) * dtv[hl * 64 + uu] : 0.f;
            }
            const bf16x8 a = as_frag(pack8(w));
#pragma unroll
            for (int ntl = 0; ntl < 4; ++ntl) y1[mi][ntl] = mfma16(bx[ntl], a, y1[mi][ntl]);
        }
    }
    {
#pragma unroll
        for (int kk = 0; kk < 4; ++kk) {
            bf16x8 bh[4];
#pragma unroll
            for (int ntl = 0; ntl < 4; ++ntl) bh[ntl] = as_frag(hsf[kk][ntl]);
#pragma unroll
            for (int mi = 0; mi < 2; ++mi) {
                const bf16x8 a = lds_frag(Cm, 16 * (2 * th + mi) + fr, kk * 32 + fq * 8, 136);
#pragma unroll
                for (int ntl = 0; ntl < 4; ++ntl) y2[mi][ntl] = mfma16(bh[ntl], a, y2[mi][ntl]);
            }
        }
    }
    const float Dh = XPAR(P_BD)[l * 8 + hh];
#pragma unroll
    for (int mi = 0; mi < 2; ++mi) {
        const int t = 16 * (2 * th + mi) + fr;
        const float ea = __expf(av[hl * 64 + t]);
        float ss = 0.f;
#pragma unroll
        for (int ntl = 0; ntl < 4; ++ntl) {
            const float z[4] = {__uint_as_float(bzv[mi][ntl][0] << 16), __uint_as_float(bzv[mi][ntl][0] & 0xffff0000u), __uint_as_float(bzv[mi][ntl][1] << 16), __uint_as_float(bzv[mi][ntl][1] & 0xffff0000u)};
#pragma unroll
            for (int ii = 0; ii < 4; ++ii) {
                const int p = 16 * ntl + 4 * fq + ii;
                const float xv = bf2f(*(const LAS bf16_t*)(Xt + (((hl * 64 + p) * 72 + t) << 1)));
                const float y = y1[mi][ntl][ii] + ea * y2[mi][ntl][ii] + Dh * xv;
                const float gbv = y * siluf_(z[ii]);
                y1[mi][ntl][ii] = gbv; ss += gbv * gbv;
            }
        }
        ss += __shfl_xor(ss, 16); ss += __shfl_xor(ss, 32);
        if (fq == 0) ssq[t * 4 + hl] = ss;
    }
    __syncthreads();
#pragma unroll
    for (int mi = 0; mi < 2; ++mi) {
        const int t = 16 * (2 * th + mi) + fr;
        const float rs = rsqrtf((ssq[t * 4] + ssq[t * 4 + 1] + ssq[t * 4 + 2] + ssq[t * 4 + 3]) * (1.f / 256.f) + EPS);
        const unsigned row = (unsigned)row0 + t;
#pragma unroll
        for (int ntl = 0; ntl < 4; ++ntl) {
            u32x2 w; w[0] = pk2(y1[mi][ntl][0] * rs * bnw[ntl][0], y1[mi][ntl][1] * rs * bnw[ntl][1]); w[1] = pk2(y1[mi][ntl][2] * rs * bnw[ntl][2], y1[mi][ntl][3] * rs * bnw[ntl][3]);
            *(u32x2*)(XMIX + row * DMIX + 512 + hh * 64 + 16 * ntl + 4 * fq) = w;
        }
    }
    __syncthreads();
}


#define XB_TMO      128
#define XB_XCNT(j)  (256  + 64 * (j))
#define XB_XSUB(j)  (1280 + 64 * (j))
#define XB_XGEN(j)  (2304 + 64 * (j))
#define XB_TOP      3328
#define XB_TOPGEN   3392
#define XCD_BAR_WORDS 3456
#define XB_SPIN_CAP (1u << 18)
__device__ __forceinline__ unsigned xb_ld(unsigned* p)              { return __hip_atomic_load(p, __ATOMIC_RELAXED, __HIP_MEMORY_SCOPE_AGENT); }
__device__ __forceinline__ unsigned xb_add(unsigned* p, unsigned v) { return __hip_atomic_fetch_add(p, v, __ATOMIC_RELAXED, __HIP_MEMORY_SCOPE_AGENT); }
__device__ __forceinline__ unsigned xb_xcc_id() { return (unsigned)__builtin_amdgcn_s_getreg((3 << 11) | 20) & 0xFu; }
#define XB_SPIN(cond, bar) do { unsigned _sp = 0; while (cond) { __builtin_amdgcn_s_sleep(1); \
    if ((++_sp & 255u) == 0u) { if (xb_ld(&(bar)[XB_TMO])) break; if (_sp > XB_SPIN_CAP) { atomicAdd(&(bar)[XB_TMO], 1u); break; } } } } while (0)
struct XcdBarrier { unsigned* bar; unsigned x; volatile LAS unsigned* st; };
__device__ __forceinline__ XcdBarrier xcd_barrier_post(unsigned* bar, volatile LAS unsigned* st) {
    XcdBarrier b; b.bar = bar; b.x = xb_xcc_id(); b.st = st;
    if (threadIdx.x == 0) (void)xb_add(&bar[XB_XCNT(b.x)], 1u);
    return b;
}
__device__ __forceinline__ void xcd_barrier_complete(unsigned* bar, unsigned x, unsigned& nloc, unsigned& nx) {
    const unsigned G = gridDim.x * gridDim.y * gridDim.z;
    unsigned sum, cnt, mine, sp = 0u;
    for (;;) {
        sum = 0u; cnt = 0u; mine = 0u;
#pragma unroll
        for (unsigned j = 0; j < 16; ++j) { const unsigned c = xb_ld(&bar[XB_XCNT(j)]); sum += c; cnt += (c > 0u) ? 1u : 0u; mine = (j == x) ? c : mine; }
        if (sum == G) break;
        __builtin_amdgcn_s_sleep(1);
        if ((++sp & 255u) == 0u) { if (xb_ld(&bar[XB_TMO])) break; if (sp > XB_SPIN_CAP) { atomicAdd(&bar[XB_TMO], 1u); break; } }
    }
    nloc = mine > 0u ? mine : 1u; nx = cnt > 0u ? cnt : 1u;
}
__device__ __forceinline__ void xcd_barrier(const XcdBarrier& b) {
    asm volatile("s_waitcnt vmcnt(0)" ::: "memory");
    __syncthreads();
    if (threadIdx.x == 0) {
        unsigned* bar = b.bar;
        __builtin_amdgcn_s_waitcnt(0);
        unsigned nloc = b.st[0], nx = b.st[1];
        if (nloc == 0u) { xcd_barrier_complete(bar, b.x, nloc, nx); b.st[0] = nloc; b.st[1] = nx; }
        const unsigned old = xb_add(&bar[XB_XSUB(b.x)], 1u);
        const unsigned gen = old / nloc;
        if (old + 1u == (gen + 1u) * nloc) {
            __builtin_amdgcn_fence(__ATOMIC_RELEASE, "agent");
            asm volatile("s_waitcnt vmcnt(0)" ::: "memory");
            const unsigned og = xb_add(&bar[XB_TOP], 1u);
            const unsigned tg = og / nx;
            if (og + 1u == (tg + 1u) * nx) xb_add(&bar[XB_TOPGEN], 1u);
            else XB_SPIN(xb_ld(&bar[XB_TOPGEN]) == tg, bar);
            __builtin_amdgcn_fence(__ATOMIC_ACQUIRE, "agent");
            xb_add(&bar[XB_XGEN(b.x)], 1u);
            asm volatile("s_waitcnt vmcnt(0)" ::: "memory");
        } else {
            XB_SPIN(xb_ld(&bar[XB_XGEN(b.x)]) == gen, bar);
            __builtin_amdgcn_fence(__ATOMIC_ACQUIRE, "agent");
            asm volatile("s_waitcnt vmcnt(0)" ::: "memory");
        }
    }
    __syncthreads();
}

__global__ void __launch_bounds__(NT, 2) mega(Args args) {
    __shared__ __attribute__((aligned(16))) unsigned char lds_raw[LDS_BYTES];
    lptr lds = (lptr)lds_raw;
    cg::grid_group grid = cg::this_grid();
    const int tid = threadIdx.x, bid = blockIdx.x, G = gridDim.x;
    Ctx X;
    X.xp = args.in[IN_XP]; X.xs = args.in[IN_XS]; X.stC = args.in[IN_STC]; X.stN = args.in[IN_STN]; X.stM = args.in[IN_STM]; X.ssm = args.in[IN_SSM];
    X.conv = args.in[IN_CONV]; X.ck = args.in[IN_CK]; X.cv = args.in[IN_CV]; X.out = args.out; X.ws = args.ws;
    const int lo = args.ph_lo, hi = args.ph_hi;
    volatile LAS unsigned* xst = (volatile LAS unsigned*)(lds + LDS_BYTES - 16);
    if (tid == 0) { xst[0] = 0u; xst[1] = 0u; }
    __syncthreads();
    XcdBarrier xbar = xcd_barrier_post((unsigned*)(args.ws + WS_BAR), xst);
#define IN(k) (lo <= (k) && (k) < hi)
#define SEAM(k) do { if (IN(k) && IN((k) + 1)) { for (int _r = 0; _r < REP_SYNC; ++_r) { if (lo < 0) grid.sync(); xcd_barrier(xbar); } } } while (0)
    if (IN(0)) { for (int _r = 0; _r < REP_P0; ++_r) prologue(lds, X, args, G, bid, tid); }
    SEAM(0);
    for (int l = 0; l < 4; ++l) {
        const int pb = 1 + l * 5;
        if (IN(pb)) for (int _r = 0; _r < REP_P1; ++_r) {
            pg8::Gemm g{XXB, XWIN + (size_t)l * NIN * D, MPAD, NIN, D}; pg8::StaticOrder S; S.init(TP, NIN, G, bid);
            pg8::EpiU E{XU, XSSQ};
            pg8::gemm_phase<pg8::EpiU, pg8::StaticOrder, false, GEMM_SP2, GEMM_ALIGN>(lds, g, S, E, OPQ(tid));
            if (l == 0 && bid >= G - 20) {
                pg8::SampleOrder S2{G - 20, 20, bid}; pg8::EpiUh E2{XU, XSSQ};
                pg8::gemm_phase<pg8::EpiUh, pg8::SampleOrder, true>(lds, g, S2, E2, OPQ(tid));
            }
        }
        SEAM(pb);
        if (IN(pb + 1)) for (int _r = 0; _r < REP_P2; ++_r) {
            for (int t = bid; t < 256; t += G) for (int _q = 0; _q < RT_SAMPLE; ++_q) {
                if (t < 128) sample_task(lds, X, l, t, 1, OPQ(tid));
                else { sample_task(lds, X, l, t - 128, 0, OPQ(tid)); sample_task(lds, X, l, t - 128, 2, OPQ(tid)); }
            }
            for (int t = bid; t < 256; t += G) {
                const int tx = (G == 256) ? ((t & 7) >> 2) * 128 + (32 * (t & 1) + (t >> 3)) * 2 + ((t >> 1) & 1) : t;
                for (int _q = 0; _q < RT_SWA; ++_q) swa_prompt(lds, X, l, tx, OPQ(tid));
            }
            for (int t = bid; t < 512; t += G) for (int _q = 0; _q < RT_SLOC; ++_q) ssd_local(lds, X, l, t, OPQ(tid));
            for (int t = bid; t < 1024; t += G) for (int _q = 0; _q < RT_MLOC; ++_q) mlstm_local(lds, X, l, t, OPQ(tid));
            if (bid == G - 1) {
                for (int i = tid; i < 2 * 3 * 1024; i += NT) {
                    const int ch = i & 1023, j = (i >> 10) % 3, n = i / 3072;
                    X.out[O_PCONV + (((size_t)l * 2 + n) * 3 + j) * 1024 + ch] = bf2f(XU[(size_t)(n * SEQ + SEQ - 3 + j) * NIN + C_BX + ch]);
                }
            }
        }
        SEAM(pb + 1);
        if (IN(pb + 2)) {
            if (bid >= G - 4) {
                pg8::Gemm g{XMIX, XWOUT + (size_t)l * D * DMIX, MPAD, D, DMIX}; pg8::SampleOrder S{G - 4, 4, bid};
                if (l == 0) { pg8::EpiRes_<1, 0> E{X.xp, X.xs, X.out, XXB, XSSQ}; pg8::gemm_phase<pg8::EpiRes_<1, 0>, pg8::SampleOrder, true>(lds, g, S, E, OPQ(tid)); }
                else if (l < 3) { pg8::EpiRes_<1, 1> E{X.xp, X.xs, X.out, XXB, XSSQ}; pg8::gemm_phase<pg8::EpiRes_<1, 1>, pg8::SampleOrder, true>(lds, g, S, E, OPQ(tid)); }
                else { pg8::EpiRes_<1, 2> E{X.xp, X.xs, X.out, XXB, XSSQ}; pg8::gemm_phase<pg8::EpiRes_<1, 2>, pg8::SampleOrder, true>(lds, g, S, E, OPQ(tid)); }
            }
            if (l < 3) {
                if (G - 4 - 193 >= 16) { if (bid >= 193 && bid < G - 4) convert_weights(lds, X, args, l + 1, bid - 193, G - 4 - 193, OPQ(tid)); }
                else convert_weights(lds, X, args, l + 1, bid, G, OPQ(tid));
            }
            for (int _r = 0; _r < REP_P3; ++_r) scans(X, l, bid * NT + OPQ(tid), G * NT);
        }
        SEAM(pb + 2);
        if (IN(pb + 3)) for (int _r = 0; _r < REP_P4; ++_r) {
            for (int task = bid; task < 1536; task += G) {
                if (task < 512) for (int _q = 0; _q < RT_SOUT; ++_q) ssd_out(lds, X, l, task, OPQ(tid));
                else mlstm_out(lds, X, l, task - 512, OPQ(tid));
            }
        }
        SEAM(pb + 3);
        if (IN(pb + 4)) {
            {
                pg8::Gemm g{XMIX, XWOUT + (size_t)l * D * DMIX, MPAD, D, DMIX}; pg8::StaticOrder S; S.init(TP, D, G, bid);
#ifdef PROBE_P5
                { pg8::EpiProbe EP{(const unsigned*)(X.ws + 64), XSSQ}; pg8::gemm_phase<pg8::EpiProbe, pg8::StaticOrder, false, GEMM_SP2>(lds, g, S, EP, OPQ(tid)); }
#endif
                if (l == 0) { pg8::EpiRes_<2, 0> E{X.xp, X.xs, X.out, XXB, XSSQ}; pg8::gemm_phase<pg8::EpiRes_<2, 0>, pg8::StaticOrder, false, GEMM_SP2, GEMM_ALIGN>(lds, g, S, E, OPQ(tid)); }
                else if (l < 3) { pg8::EpiRes_<2, 1> E{X.xp, X.xs, X.out, XXB, XSSQ}; pg8::gemm_phase<pg8::EpiRes_<2, 1>, pg8::StaticOrder, false, GEMM_SP2, GEMM_ALIGN>(lds, g, S, E, OPQ(tid)); }
                else { pg8::EpiRes_<2, 2> E{X.xp, X.xs, X.out, XXB, XSSQ}; pg8::gemm_phase<pg8::EpiRes_<2, 2>, pg8::StaticOrder, false, GEMM_SP2, GEMM_ALIGN>(lds, g, S, E, OPQ(tid)); }
            }
            if (l < 3 && bid < 20) {
                pg8::Gemm g{XXB, XWIN + (size_t)(l + 1) * NIN * D, MPAD, NIN, D}; pg8::SampleOrder S{0, 20, bid};
                pg8::EpiUh E{XU, XSSQ};
                pg8::gemm_phase<pg8::EpiUh, pg8::SampleOrder, true>(lds, g, S, E, OPQ(tid));
            }
        }
        SEAM(pb + 4);
    }
#undef IN
#undef SEAM
}

extern "C" void kernel_launch(void* const* d_in, const int* in_sizes, int n_in, void* d_out, int out_size, void* d_ws, size_t ws_size, hipStream_t stream) {
    static int grid_blocks = 0;
    if (!grid_blocks) {
        int dev = 0, cus = 0, per_cu = 0;
        hipGetDevice(&dev);
        hipDeviceGetAttribute(&cus, hipDeviceAttributeMultiprocessorCount, dev);
        hipOccupancyMaxActiveBlocksPerMultiprocessor(&per_cu, mega, NT, 0);
        if (per_cu < 1) { fprintf(stderr, "occupancy query returned %d\n", per_cu); per_cu = 1; }
        grid_blocks = cus * 1;
        if (ws_size < WS_END) fprintf(stderr, "workspace too small: %zu < %zu\n", ws_size, (size_t)WS_END);
    }
    (void)hipMemsetAsync(d_ws, 0, 16384, stream);
    Args a{};
    for (int i = 0; i < 24; ++i) a.in[i] = (const float*)d_in[i];
    a.out = (float*)d_out; a.ws = (unsigned char*)d_ws;
    const int NPH = 21;
#if MULTI_LAUNCH
    for (int p = 0; p < NPH; ++p) {
        a.ph_lo = p; a.ph_hi = p + 1;
        void* kargs[] = {&a};
        hipError_t e = hipLaunchCooperativeKernel((void*)mega, dim3(grid_blocks), dim3(NT), kargs, 0, stream);
        if (e != hipSuccess) fprintf(stderr, "cooperative launch failed: %s (grid %d)\n", hipGetErrorString(e), grid_blocks);
    }
#else
    a.ph_lo = 0; a.ph_hi = NPH;
    void* kargs[] = {&a};
    hipError_t e = hipLaunchCooperativeKernel((void*)mega, dim3(grid_blocks), dim3(NT), kargs, 0, stream);
    if (e != hipSuccess) fprintf(stderr, "cooperative launch failed: %s (grid %d)\n", hipGetErrorString(e), grid_blocks);
#endif
}
```
